# Optimizing an MI355X kernel written in HIP

```python
import math
import numpy as np
import jax
import jax.numpy as jnp
from jax import lax

D_MODEL = 1024
BATCH = 2
SEQ = 16384
DEPTH = 4

N_EVEN = (DEPTH + 1) // 2
N_ODD = DEPTH // 2
DEEPNORM_ALPHA = (2.0 * DEPTH) ** 0.25
DEEPNORM_BETA = (8.0 * DEPTH) ** -0.25
LN_EPS = 1e-5
MIX_WIDTH = D_MODEL

GLA_HEADS = 4
GLA_DV = MIX_WIDTH // 2 // GLA_HEADS
GLA_DK = GLA_DV // 2
GLA_GATE_RANK = 16
GLA_GATE_TAU = 16.0
GLA_CHUNK = 64

S5_WIDTH = MIX_WIDTH // 2
S5_GROUP = 16
S5_GROUPS = S5_WIDTH // S5_GROUP
S5_STATE = 64
S5_DT_MIN = 1e-3
S5_DT_MAX = 1e-1
S5_MAX_RE = -1e-4

EV_SIZES = (GLA_HEADS * GLA_DK, GLA_HEADS * GLA_DK, GLA_HEADS * GLA_DV, GLA_HEADS * GLA_DV, GLA_GATE_RANK, S5_WIDTH)
EV_COLS = sum(EV_SIZES)

DSA_HEADS = 8
DSA_HEAD_DIM = 64
DSA_WIDTH = DSA_HEADS * DSA_HEAD_DIM
IDX_HEADS = 4
IDX_DIM = 64
DSA_TOPK_MAX = 256

DIL_PATTERNS = ((128, 1), (512, 4), (2048, 16))
DIL_GROUPS = len(DIL_PATTERNS)
DIL_HEADS = 8
DIL_HEAD_DIM = 64
DIL_WIDTH = DIL_HEADS * DIL_HEAD_DIM

OD_SIZES = (DSA_WIDTH, DSA_WIDTH, DSA_WIDTH, IDX_HEADS * IDX_DIM, IDX_DIM, IDX_HEADS, 3 * DIL_GROUPS * DIL_WIDTH)
OD_COLS = sum(OD_SIZES)
OD_WIDTH = DSA_WIDTH + DIL_WIDTH
Q_BLOCK = 128

N_EXPERTS = 32
TOP_K = 4
D_FF = D_MODEL
SWIGLU_ALPHA = 1.702
SWIGLU_LIMIT = 7.0
MOE_BLOCK = 512

kernel_name = 'hybrid_gla_s5_dsa_dilated_moe_deepnorm'


def _split(h, sizes):
    return jnp.split(h, [int(i) for i in np.cumsum(sizes)[:-1]], axis=-1)


def layer_norm(x, g, b):
    xf = x.astype(jnp.float32)
    mu = jnp.mean(xf, axis=-1, keepdims=True)
    var = jnp.mean(jnp.square(xf - mu), axis=-1, keepdims=True)
    return ((xf - mu) * lax.rsqrt(var + LN_EPS) * g.astype(jnp.float32) + b.astype(jnp.float32)).astype(x.dtype)


def gla_mix(q, k, v, r, gate_lr, w_gate2, b_gate2, norm_g):
    f32 = jnp.float32
    bsz, L, H, DK = q.shape
    DV = v.shape[-1]
    C = GLA_CHUNK
    NC = L // C
    logit = (gate_lr @ w_gate2 + b_gate2).astype(f32).reshape(bsz, L, H, DK)
    log_a = jax.nn.log_sigmoid(logit) / GLA_GATE_TAU
    chunk = lambda t: t.astype(f32).reshape(bsz, NC, C, H, t.shape[-1])
    qc = chunk(q) * DK ** -0.5
    kc, vc = chunk(k), chunk(v)
    b = jnp.cumsum(chunk(log_a), axis=2)
    b_last = b[:, :, -1:]
    q_t = qc * jnp.exp(b)
    k_t = kc * jnp.exp(-b)
    k_end = kc * jnp.exp(b_last - b)
    causal = jnp.tril(jnp.ones((C, C), dtype=bool))
    att = jnp.where(causal, jnp.einsum('bnihd,bnjhd->bnhij', q_t, k_t), 0.0)
    o_intra = jnp.einsum('bnhij,bnjhv->bnihv', att, vc)
    kv_chunk = jnp.einsum('bnjhd,bnjhv->bnhdv', k_end, vc)
    decay = jnp.exp(b_last[:, :, 0])

    def step(S, inp):
        dec, kv = inp
        return dec[..., None] * S + kv, S

    S0 = jnp.zeros((bsz, H, DK, DV), f32)
    _, S_start = lax.scan(step, S0, (jnp.moveaxis(decay, 1, 0), jnp.moveaxis(kv_chunk, 1, 0)))
    S_start = jnp.moveaxis(S_start, 0, 1)
    o = o_intra + jnp.einsum('bnihd,bnhdv->bnihv', q_t, S_start)
    o = o.reshape(bsz, L, H, DV)
    o = o * lax.rsqrt(jnp.mean(o * o, axis=-1, keepdims=True) + LN_EPS) * norm_g.astype(f32)
    o = o * jax.nn.silu(r.astype(f32))
    return o.reshape(bsz, L, H * DV).astype(q.dtype)


def _complex_affine_combine(e1, e2):
    a1r, a1i, b1r, b1i = e1
    a2r, a2i, b2r, b2i = e2
    return (a2r * a1r - a2i * a1i,
            a2r * a1i + a2i * a1r,
            a2r * b1r - a2i * b1i + b2r,
            a2r * b1i + a2i * b1r + b2i)


def s5_mix(u, a_re, a_im, log_dt, b_re, b_im, c_re, c_im, d_skip, w_glu, b_glu):
    f32 = jnp.float32
    bsz, L, _ = u.shape
    ug = u.astype(f32).reshape(bsz, L, S5_GROUPS, S5_GROUP)
    lam_re = jnp.minimum(a_re.astype(f32), S5_MAX_RE)
    lam_im = a_im.astype(f32)
    dt = jnp.exp(log_dt.astype(f32))[:, None]
    mag = jnp.exp(lam_re * dt)
    ab_re = mag * jnp.cos(lam_im * dt)
    ab_im = mag * jnp.sin(lam_im * dt)
    inv = 1.0 / (lam_re * lam_re + lam_im * lam_im)
    z_re = ((ab_re - 1.0) * lam_re + ab_im * lam_im) * inv
    z_im = (ab_im * lam_re - (ab_re - 1.0) * lam_im) * inv
    br, bi = b_re.astype(f32), b_im.astype(f32)
    bb_re = z_re[..., None] * br - z_im[..., None] * bi
    bb_im = z_re[..., None] * bi + z_im[..., None] * br
    bu_re = jnp.einsum('blgn,gpn->lbgp', ug, bb_re)
    bu_im = jnp.einsum('blgn,gpn->lbgp', ug, bb_im)
    a_seq_re = jnp.broadcast_to(ab_re, (L, 1) + ab_re.shape)
    a_seq_im = jnp.broadcast_to(ab_im, (L, 1) + ab_im.shape)
    _, _, xr, xi = lax.associative_scan(_complex_affine_combine, (a_seq_re, a_seq_im, bu_re, bu_im), axis=0)
    y = (jnp.einsum('lbgp,gnp->blgn', xr, c_re.astype(f32))
         - jnp.einsum('lbgp,gnp->blgn', xi, c_im.astype(f32)))
    y = y + d_skip.astype(f32).reshape(S5_GROUPS, S5_GROUP) * ug
    y = jax.nn.gelu(y.reshape(bsz, L, S5_WIDTH)).astype(u.dtype)
    return y * jax.nn.sigmoid(y @ w_glu + b_glu)


def dsa_mix(q, k, v, qi, ki, wi):
    f32 = jnp.float32
    bsz, L, H, Dh = q.shape
    topk = min(DSA_TOPK_MAX, L // 4)
    n_blocks = L // Q_BLOCK
    kpos = jnp.arange(L)
    ki32 = ki.astype(f32)
    gather = jax.vmap(lambda t, idx: t[idx])

    def block(i):
        s0 = i * Q_BLOCK
        qpos = s0 + jnp.arange(Q_BLOCK)
        qb = lax.dynamic_slice_in_dim(q, s0, Q_BLOCK, 1).astype(f32)
        qib = lax.dynamic_slice_in_dim(qi, s0, Q_BLOCK, 1).astype(f32)
        wib = lax.dynamic_slice_in_dim(wi, s0, Q_BLOCK, 1).astype(f32)
        dots = jnp.einsum('bqhd,bsd->bqhs', qib, ki32) * IDX_DIM ** -0.5
        score = jnp.einsum('bqh,bqhs->bqs', wib, jax.nn.relu(dots))
        score = jnp.where(kpos[None, :] <= qpos[:, None], score, -jnp.inf)
        _, idx = lax.top_k(score, topk)
        valid = idx <= qpos[None, :, None]
        kg = gather(k, idx).astype(f32)
        vg = gather(v, idx).astype(f32)
        s = jnp.einsum('bqhd,bqkhd->bqhk', qb, kg) * Dh ** -0.5
        s = jnp.where(valid[:, :, None, :], s, -jnp.inf)
        p = jax.nn.softmax(s, axis=-1)
        return jnp.einsum('bqhk,bqkhd->bqhd', p, vg).astype(q.dtype)

    out = lax.map(block, jnp.arange(n_blocks))
    return jnp.moveaxis(out, 0, 1).reshape(bsz, L, H * Dh)


def dilated_mix(q, k, v):
    f32 = jnp.float32
    bsz, L, NG, H, Dh = q.shape
    n_blocks = L // Q_BLOCK

    def block(i):
        s0 = i * Q_BLOCK
        qpos = s0 + jnp.arange(Q_BLOCK)
        qb = lax.dynamic_slice_in_dim(q, s0, Q_BLOCK, 1).astype(f32)
        outs, lses = [], []
        for g, (window, dil) in enumerate(DIL_PATTERNS):
            offs = dil * jnp.arange(window // dil + 1)
            src = qpos[:, None] - offs[None, :]
            valid = src >= 0
            src = jnp.maximum(src, 0)
            kg = k[:, :, g][:, src].astype(f32)
            vg = v[:, :, g][:, src].astype(f32)
            s = jnp.einsum('bqhd,bqwhd->bqhw', qb[:, :, g], kg) * Dh ** -0.5
            s = jnp.where(valid[None, :, None, :], s, -jnp.inf)
            lse = jax.nn.logsumexp(s, axis=-1)
            outs.append(jnp.einsum('bqhw,bqwhd->bqhd', jnp.exp(s - lse[..., None]), vg))
            lses.append(lse)
        wts = jax.nn.softmax(jnp.stack(lses, 0), axis=0)
        o = jnp.einsum('gbqh,gbqhd->bqhd', wts, jnp.stack(outs, 0))
        return o.astype(q.dtype)

    out = lax.map(block, jnp.arange(n_blocks))
    return jnp.moveaxis(out, 0, 1).reshape(bsz, L, H * Dh)


def moe_ffn(x, router_w, router_b, w1, b1, w2, b2):
    f32 = jnp.float32
    bsz, L, D = x.shape
    T = bsz * L
    A = T * TOP_K
    n_blocks = -(-(A + N_EXPERTS * (MOE_BLOCK - 1)) // MOE_BLOCK)
    P = n_blocks * MOE_BLOCK
    xt = x.reshape(T, D)
    logits = (xt @ router_w + router_b).astype(f32)
    top_logit, top_e = lax.top_k(logits, TOP_K)
    gate = jax.nn.softmax(top_logit, axis=-1)
    e_flat = top_e.reshape(A)
    order = jnp.argsort(e_flat)
    e_sorted = e_flat[order]
    counts = jnp.bincount(e_flat, length=N_EXPERTS)
    padded = (counts + MOE_BLOCK - 1) // MOE_BLOCK * MOE_BLOCK
    start = jnp.cumsum(counts) - counts
    pend = jnp.cumsum(padded)
    pstart = pend - padded
    dest = pstart[e_sorted] + jnp.arange(A) - start[e_sorted]
    tok_buf = jnp.full((P,), T, jnp.int32).at[dest].set((order // TOP_K).astype(jnp.int32))
    gate_buf = jnp.zeros((P,), f32).at[dest].set(gate.reshape(A)[order])
    x_buf = xt.at[tok_buf].get(mode='fill', fill_value=0)
    block_e = jnp.minimum(jnp.searchsorted(pend, jnp.arange(n_blocks) * MOE_BLOCK, side='right'), N_EXPERTS - 1)

    def expert_block(args):
        xb, e = args
        h = xb @ w1[e] + b1[e]
        glu = jnp.minimum(h[:, :D_FF], SWIGLU_LIMIT)
        lin = jnp.clip(h[:, D_FF:], -SWIGLU_LIMIT, SWIGLU_LIMIT)
        act = glu * jax.nn.sigmoid(SWIGLU_ALPHA * glu) * (lin + 1.0)
        return act @ w2[e] + b2[e]

    y_buf = lax.map(expert_block, (x_buf.reshape(n_blocks, MOE_BLOCK, D), block_e)).reshape(P, D)
    y = jax.ops.segment_sum(y_buf.astype(f32) * gate_buf[:, None], tok_buf, num_segments=T)
    return y.reshape(bsz, L, D).astype(x.dtype)


def even_mixer(x, w_in, w_gate2, b_gate2, norm_g, a_re, a_im, log_dt, b_re, b_im, c_re, c_im, d_skip, w_glu, b_glu, w_out):
    bsz, L, _ = x.shape
    q, k, v, r, g_lr, u = _split(x @ w_in, EV_SIZES)
    heads = lambda t, d: t.reshape(bsz, L, GLA_HEADS, d)
    o_a = gla_mix(heads(q, GLA_DK), heads(k, GLA_DK), heads(v, GLA_DV), heads(r, GLA_DV), g_lr, w_gate2, b_gate2, norm_g)
    o_b = s5_mix(u, a_re, a_im, log_dt, b_re, b_im, c_re, c_im, d_skip, w_glu, b_glu)
    return jnp.concatenate([o_a, o_b], axis=-1) @ w_out


def odd_mixer(x, w_in, w_out):
    bsz, L, _ = x.shape
    q, k, v, qi, ki, wi, dil = _split(x @ w_in, OD_SIZES)
    hd = lambda t: t.reshape(bsz, L, DSA_HEADS, DSA_HEAD_DIM)
    o_c = dsa_mix(hd(q), hd(k), hd(v), qi.reshape(bsz, L, IDX_HEADS, IDX_DIM), ki, wi * IDX_HEADS ** -0.5)
    dil = dil.reshape(bsz, L, 3, DIL_GROUPS, DIL_HEADS, DIL_HEAD_DIM)
    o_d = dilated_mix(dil[:, :, 0], dil[:, :, 1], dil[:, :, 2])
    return jnp.concatenate([o_c, o_d], axis=-1) @ w_out


def setup_inputs(seed: int = 0) -> dict:
    key = jax.random.key(seed)
    ks = iter(jax.random.split(key, 40))
    nrm = lambda shape, scale: scale * jax.random.normal(next(ks), shape, jnp.float32)
    NE, NO = N_EVEN, N_ODD
    G, P, N = S5_GROUPS, S5_STATE, S5_GROUP
    a_im0 = math.pi * jnp.arange(P, dtype=jnp.float32)
    return {
        'x': nrm((BATCH, SEQ, D_MODEL), 1.0),
        'ev_w_in': nrm((NE, D_MODEL, EV_COLS), D_MODEL ** -0.5),
        'gla_w_gate2': nrm((NE, GLA_GATE_RANK, GLA_HEADS * GLA_DK), GLA_GATE_RANK ** -0.5),
        'gla_b_gate2': nrm((NE, GLA_HEADS * GLA_DK), 0.1),
        'gla_norm_g': 1.0 + nrm((NE, GLA_DV), 0.02),
        's5_a_re': -0.5 + nrm((NE, G, P), 0.01),
        's5_a_im': a_im0 + nrm((NE, G, P), 0.01),
        's5_log_dt': jax.random.uniform(next(ks), (NE, G), jnp.float32, math.log(S5_DT_MIN), math.log(S5_DT_MAX)),
        's5_b_re': nrm((NE, G, P, N), (2.0 * N) ** -0.5),
        's5_b_im': nrm((NE, G, P, N), (2.0 * N) ** -0.5),
        's5_c_re': nrm((NE, G, N, P), P ** -0.5),
        's5_c_im': nrm((NE, G, N, P), P ** -0.5),
        's5_d': nrm((NE, S5_WIDTH), 1.0),
        's5_w_glu': nrm((NE, S5_WIDTH, S5_WIDTH), S5_WIDTH ** -0.5),
        's5_b_glu': nrm((NE, S5_WIDTH), 0.02),
        'ev_w_out': nrm((NE, MIX_WIDTH, D_MODEL), DEEPNORM_BETA * MIX_WIDTH ** -0.5),
        'od_w_in': nrm((NO, D_MODEL, OD_COLS), D_MODEL ** -0.5),
        'od_w_out': nrm((NO, OD_WIDTH, D_MODEL), DEEPNORM_BETA * OD_WIDTH ** -0.5),
        'ln1_g': 1.0 + nrm((DEPTH, D_MODEL), 0.02),
        'ln1_b': nrm((DEPTH, D_MODEL), 0.02),
        'ln2_g': 1.0 + nrm((DEPTH, D_MODEL), 0.02),
        'ln2_b': nrm((DEPTH, D_MODEL), 0.02),
        'router_w': nrm((DEPTH, D_MODEL, N_EXPERTS), D_MODEL ** -0.5),
        'router_b': nrm((DEPTH, N_EXPERTS), 0.01),
        'moe_w1': nrm((DEPTH, N_EXPERTS, D_MODEL, 2 * D_FF), DEEPNORM_BETA * D_MODEL ** -0.5),
        'moe_b1': nrm((DEPTH, N_EXPERTS, 2 * D_FF), 0.01),
        'moe_w2': nrm((DEPTH, N_EXPERTS, D_FF, D_MODEL), DEEPNORM_BETA * D_FF ** -0.5),
        'moe_b2': nrm((DEPTH, N_EXPERTS, D_MODEL), 0.01),
    }


def reference(x, ev_w_in, gla_w_gate2, gla_b_gate2, gla_norm_g, s5_a_re, s5_a_im, s5_log_dt, s5_b_re, s5_b_im,
              s5_c_re, s5_c_im, s5_d, s5_w_glu, s5_b_glu, ev_w_out, od_w_in, od_w_out, ln1_g, ln1_b, ln2_g, ln2_b,
              router_w, router_b, moe_w1, moe_b1, moe_w2, moe_b2):
    for layer in range(DEPTH):
        j = layer // 2
        if layer % 2 == 0:
            mix = even_mixer(x, ev_w_in[j], gla_w_gate2[j], gla_b_gate2[j], gla_norm_g[j], s5_a_re[j], s5_a_im[j],
                             s5_log_dt[j], s5_b_re[j], s5_b_im[j], s5_c_re[j], s5_c_im[j], s5_d[j], s5_w_glu[j],
                             s5_b_glu[j], ev_w_out[j])
        else:
            mix = odd_mixer(x, od_w_in[j], od_w_out[j])
        x = layer_norm(DEEPNORM_ALPHA * x + mix, ln1_g[layer], ln1_b[layer])
        ffn = moe_ffn(x, router_w[layer], router_b[layer], moe_w1[layer], moe_b1[layer], moe_w2[layer], moe_b2[layer])
        x = layer_norm(DEEPNORM_ALPHA * x + ffn, ln2_g[layer], ln2_b[layer])
    return x
```

```cpp
#include <hip/hip_runtime.h>
#include <stdint.h>
#include <stdio.h>

#ifndef MEGA
#define MEGA 0
#endif

typedef unsigned short bf16_t;
typedef short bf16x8 __attribute__((ext_vector_type(8)));
typedef float f32x4 __attribute__((ext_vector_type(4)));
typedef float f32x16 __attribute__((ext_vector_type(16)));
typedef unsigned u32x4 __attribute__((ext_vector_type(4)));
typedef unsigned u32x2 __attribute__((ext_vector_type(2)));

constexpr int T_ = 32768, D_ = 1024, L_ = 16384, NB_ = 2;
constexpr int NTHR = 512;
constexpr float ALPHA = 1.681792830507429f;
constexpr float LN_EPS = 1e-5f;
constexpr int EV_N = 2176;
constexpr int OD_N = 6528;
constexpr int OD_QI = 1536, OD_DIL = 1792, OD_KI = 6400, OD_WI = 6464;
constexpr int UHW = 1152;
constexpr int LISTCAP = 131072;

constexpr size_t OFF_BAR = 0;
constexpr size_t OFF_CNT = 16384;
constexpr size_t OFF_A64 = 32768;
constexpr size_t OFF_WT_EVIN = 131072;
constexpr size_t OFF_WT_ODIN = OFF_WT_EVIN + (size_t)2 * EV_N * 1024 * 2;
constexpr size_t OFF_WT_EVOUT = OFF_WT_ODIN + (size_t)2 * OD_N * 1024 * 2;
constexpr size_t OFF_WT_ODOUT = OFF_WT_EVOUT + (size_t)2 * 1024 * 1024 * 2;
constexpr size_t OFF_WT_GLU = OFF_WT_ODOUT + (size_t)2 * 1024 * 1024 * 2;
constexpr size_t OFF_WT_RT = OFF_WT_GLU + (size_t)2 * 512 * 512 * 2;
constexpr size_t OFF_WT_W1 = OFF_WT_RT + (size_t)4 * 128 * 1024 * 2;
constexpr size_t OFF_WT_W2 = OFF_WT_W1 + (size_t)4 * 32 * 2048 * 1024 * 2;
constexpr size_t OFF_TH = OFF_WT_W2 + (size_t)4 * 32 * 1024 * 1024 * 2;
constexpr size_t OFF_GM = OFF_TH + (size_t)2 * 32 * 1024 * UHW * 2;
constexpr size_t OFF_XR = OFF_GM + (size_t)2 * 32 * 128 * 1024 * 2;
constexpr size_t OFF_XB = OFF_XR + (size_t)T_ * 1024 * 4;
constexpr size_t OFF_MIX = OFF_XB + (size_t)T_ * 1024 * 2;
constexpr size_t OFF_CC = OFF_MIX + (size_t)T_ * 1024 * 4;
constexpr size_t OFF_LOGIT = OFF_CC + (size_t)T_ * 1024 * 2;
constexpr size_t OFF_LIST = OFF_LOGIT + (size_t)T_ * 32 * 4;
constexpr size_t OFF_GATE = OFF_LIST + (size_t)32 * LISTCAP * 4;
constexpr size_t OFF_ACT = OFF_GATE + (size_t)T_ * 4 * 4;
constexpr size_t OFF_SLOT = OFF_ACT + (size_t)T_ * 4 * 1024 * 2;
constexpr size_t OFF_MIXER = OFF_SLOT + (size_t)T_ * 4 * 1024 * 4;
constexpr size_t OFF_PE = OFF_MIXER;
constexpr size_t OFF_UH = OFF_PE + (size_t)T_ * 1536 * 2;
constexpr size_t OFF_GLR = OFF_UH + (size_t)(T_ / 64) * 32 * UHW * 2;
constexpr size_t OFF_VTE = OFF_GLR + (size_t)T_ * 16 * 4;
constexpr size_t OFF_KV = OFF_VTE + (size_t)2 * 4 * 128 * L_ * 2;
constexpr size_t OFF_SST = OFF_KV + (size_t)2 * 256 * 4 * 64 * 128 * 4;
constexpr size_t OFF_DEC = OFF_SST + (size_t)2 * 256 * 4 * 64 * 128 * 4;
constexpr size_t OFF_GBUF = OFF_DEC + (size_t)2 * 256 * 4 * 64 * 4;
constexpr size_t OFF_YA = OFF_GBUF + (size_t)512 * 32 * 128 * 4;
constexpr size_t END_EVEN = OFF_YA + (size_t)T_ * 512 * 2;
constexpr size_t OFF_PO = OFF_MIXER;
constexpr size_t OFF_WI = OFF_PO + (size_t)T_ * OD_N * 2;
constexpr size_t OFF_VTC = OFF_WI + (size_t)T_ * 4 * 4;
constexpr size_t OFF_VTD = OFF_VTC + (size_t)2 * 8 * 64 * L_ * 2;
constexpr size_t OFF_BM = OFF_VTD + (size_t)2 * 3 * 8 * 64 * L_ * 2;
constexpr size_t OFF_OD = OFF_BM + (size_t)T_ * 256 * 8;
constexpr size_t OFF_LSE = OFF_OD + (size_t)3 * T_ * 512 * 4;
constexpr size_t END_ODD = OFF_LSE + (size_t)3 * T_ * 8 * 4;
constexpr size_t WS_NEED = END_ODD > END_EVEN ? END_ODD : END_EVEN;
static_assert(WS_NEED < (size_t)4200000000ull, "workspace too large");

constexpr int LDS_BYTES = 131072;

struct Params {
    const float *x, *ev_w_in, *gla_w_gate2, *gla_b_gate2, *gla_norm_g, *s5_a_re, *s5_a_im, *s5_log_dt, *s5_b_re, *s5_b_im, *s5_c_re, *s5_c_im, *s5_d,
        *s5_w_glu, *s5_b_glu, *ev_w_out, *od_w_in, *od_w_out, *ln1_g, *ln1_b, *ln2_g, *ln2_b, *router_w, *router_b, *moe_w1, *moe_b1, *moe_w2, *moe_b2;
    float* out;
    char* ws;
};

__device__ __forceinline__ bf16_t f2bf(float f) { unsigned u = __float_as_uint(f); u += 0x7fffu + ((u >> 16) & 1u); return (bf16_t)(u >> 16); }
__device__ __forceinline__ float bf2f(bf16_t h) { return __uint_as_float(((unsigned)h) << 16); }
__device__ __forceinline__ unsigned pk2(float lo, float hi) { return (unsigned)f2bf(lo) | ((unsigned)f2bf(hi) << 16); }
__device__ __forceinline__ float sigmoidf_(float x) { return 1.f / (1.f + __expf(-x)); }
__device__ __forceinline__ float wave_sum(float v) {
#pragma unroll
    for (int m = 32; m >= 1; m >>= 1) v += __shfl_xor(v, m, 64);
    return v;
}
__device__ __forceinline__ float gelu_tanh(float x) {
    const float k0 = 0.7978845608028654f, k1 = 0.044715f;
    float u = k0 * (x + k1 * x * x * x);
    float t = 1.f - 2.f / (1.f + __expf(2.f * u));
    return 0.5f * x * (1.f + t);
}

#define XB_TMO      128
#define XB_XCNT(j)  (256  + 64 * (j))
#define XB_XSUB(j)  (1280 + 64 * (j))
#define XB_XGEN(j)  (2304 + 64 * (j))
#define XB_TOP      3328
#define XB_TOPGEN   3392
#define XCD_BAR_WORDS 3456
#define XB_SPIN_CAP (1u << 21)
#define LAS __attribute__((address_space(3)))

__device__ __forceinline__ unsigned xb_ld(unsigned* p)              { return __hip_atomic_load(p, __ATOMIC_RELAXED, __HIP_MEMORY_SCOPE_AGENT); }
__device__ __forceinline__ unsigned xb_add(unsigned* p, unsigned v) { return __hip_atomic_fetch_add(p, v, __ATOMIC_RELAXED, __HIP_MEMORY_SCOPE_AGENT); }
__device__ __forceinline__ unsigned xb_xcc_id() { return (unsigned)__builtin_amdgcn_s_getreg((3 << 11) | 20) & 0xFu; }
#define XB_SPIN(cond, bar) do { unsigned _sp = 0; while (cond) { __builtin_amdgcn_s_sleep(1); \
    if ((++_sp & 255u) == 0u) { if (xb_ld(&(bar)[XB_TMO])) break; if (_sp > XB_SPIN_CAP) { atomicAdd(&(bar)[XB_TMO], 1u); break; } } } } while (0)

struct XcdBarrier { unsigned* bar; unsigned x; volatile LAS unsigned* st; };

__device__ __forceinline__ XcdBarrier xcd_barrier_post(unsigned* bar, volatile LAS unsigned* st) {
    XcdBarrier b; b.bar = bar; b.x = xb_xcc_id(); b.st = st;
    if (threadIdx.x == 0) (void)xb_add(&bar[XB_XCNT(b.x)], 1u);
    return b;
}
__device__ __forceinline__ void xcd_barrier_complete(unsigned* bar, unsigned x, unsigned& nloc, unsigned& nx) {
    const unsigned G = gridDim.x * gridDim.y * gridDim.z;
    unsigned sum, cnt, mine, sp = 0u;
    for (;;) {
        sum = 0u; cnt = 0u; mine = 0u;
#pragma unroll
        for (unsigned j = 0; j < 16; ++j) { const unsigned c = xb_ld(&bar[XB_XCNT(j)]); sum += c; cnt += (c > 0u) ? 1u : 0u; mine = (j == x) ? c : mine; }
        if (sum == G) break;
        __builtin_amdgcn_s_sleep(1);
        if ((++sp & 255u) == 0u) { if (xb_ld(&bar[XB_TMO])) break; if (sp > XB_SPIN_CAP) { atomicAdd(&bar[XB_TMO], 1u); break; } }
    }
    nloc = mine > 0u ? mine : 1u; nx = cnt > 0u ? cnt : 1u;
}
__device__ __forceinline__ void xcd_barrier(const XcdBarrier& b) {
    asm volatile("s_waitcnt vmcnt(0)" ::: "memory");
    __syncthreads();
    if (threadIdx.x == 0) {
        unsigned* bar = b.bar;
        __builtin_amdgcn_s_waitcnt(0);
        unsigned nloc = b.st[0], nx = b.st[1];
        if (nloc == 0u) { xcd_barrier_complete(bar, b.x, nloc, nx); b.st[0] = nloc; b.st[1] = nx; }
        const unsigned old = xb_add(&bar[XB_XSUB(b.x)], 1u);
        const unsigned gen = old / nloc;
        if (old + 1u == (gen + 1u) * nloc) {
            __builtin_amdgcn_fence(__ATOMIC_RELEASE, "agent");
            asm volatile("s_waitcnt vmcnt(0)" ::: "memory");
            const unsigned og = xb_add(&bar[XB_TOP], 1u);
            const unsigned tg = og / nx;
            if (og + 1u == (tg + 1u) * nx) xb_add(&bar[XB_TOPGEN], 1u);
            else XB_SPIN(xb_ld(&bar[XB_TOPGEN]) == tg, bar);
            __builtin_amdgcn_fence(__ATOMIC_ACQUIRE, "agent");
            xb_add(&bar[XB_XGEN(b.x)], 1u);
            asm volatile("s_waitcnt vmcnt(0)" ::: "memory");
        } else {
            XB_SPIN(xb_ld(&bar[XB_XGEN(b.x)]) == gen, bar);
            __builtin_amdgcn_fence(__ATOMIC_ACQUIRE, "agent");
            asm volatile("s_waitcnt vmcnt(0)" ::: "memory");
        }
    }
    __syncthreads();
}

constexpr int G_LROW = 144;
constexpr int G_ASZ = 256 * G_LROW;
constexpr int G_BSZ = 128 * G_LROW;
constexpr int G_STAGE = G_ASZ + G_BSZ;
constexpr int G_ROWS_OFF = 2 * G_STAGE;

template <bool GATHER, class Epi>
__device__ __forceinline__ void gemm_tile(const bf16_t* __restrict__ A, long lda, int shift, int m0, const bf16_t* __restrict__ Bt, long ldb, int n0, int K,
                                          char* smem, Epi&& epi) {
    const int tid = threadIdx.x, lane = tid & 63, wave = tid >> 6, wr = wave >> 1, wc = wave & 1, fr = lane & 15, fq = lane >> 4;
    const int lrow = tid >> 3, lchunk = tid & 7;
    const int* sRow = (const int*)(smem + G_ROWS_OFF);
    const bf16_t* pa[4]; const bf16_t* pb[2];
#pragma unroll
    for (int i = 0; i < 4; ++i) {
        int r = lrow + 64 * i; long arow;
        if (GATHER) { int v = sRow[r]; arow = v < 0 ? 0 : (v >> shift); } else arow = m0 + r;
        pa[i] = A + arow * lda + lchunk * 8;
    }
#pragma unroll
    for (int i = 0; i < 2; ++i) pb[i] = Bt + (long)(n0 + lrow + 64 * i) * ldb + lchunk * 8;
    f32x4 acc[4][4];
#pragma unroll
    for (int m = 0; m < 4; ++m)
#pragma unroll
        for (int n = 0; n < 4; ++n) acc[m][n] = (f32x4){0.f, 0.f, 0.f, 0.f};
    u32x4 ra[4], rb[2];
    const int nk = K >> 6;
#pragma unroll
    for (int i = 0; i < 4; ++i) ra[i] = *(const u32x4*)(pa[i]);
#pragma unroll
    for (int i = 0; i < 2; ++i) rb[i] = *(const u32x4*)(pb[i]);
    {
        char* sa = smem; char* sb = smem + G_ASZ;
#pragma unroll
        for (int i = 0; i < 4; ++i) *(u32x4*)(sa + (lrow + 64 * i) * G_LROW + lchunk * 16) = ra[i];
#pragma unroll
        for (int i = 0; i < 2; ++i) *(u32x4*)(sb + (lrow + 64 * i) * G_LROW + lchunk * 16) = rb[i];
    }
    __syncthreads();
    for (int kt = 0; kt < nk; ++kt) {
        const bool more = (kt + 1 < nk);
        if (more) {
#pragma unroll
            for (int i = 0; i < 4; ++i) ra[i] = *(const u32x4*)(pa[i] + (kt + 1) * 64);
#pragma unroll
            for (int i = 0; i < 2; ++i) rb[i] = *(const u32x4*)(pb[i] + (kt + 1) * 64);
        }
        const char* sa = smem + (kt & 1) * G_STAGE; const char* sb = sa + G_ASZ;
#pragma unroll
        for (int ks = 0; ks < 2; ++ks) {
            bf16x8 af[4], bfr[4];
#pragma unroll
            for (int m = 0; m < 4; ++m) af[m] = *(const bf16x8*)(sa + (wr * 64 + m * 16 + fr) * G_LROW + (ks * 32 + fq * 8) * 2);
#pragma unroll
            for (int n = 0; n < 4; ++n) bfr[n] = *(const bf16x8*)(sb + (wc * 64 + n * 16 + fr) * G_LROW + (ks * 32 + fq * 8) * 2);
#pragma unroll
            for (int m = 0; m < 4; ++m)
#pragma unroll
                for (int n = 0; n < 4; ++n) acc[m][n] = __builtin_amdgcn_mfma_f32_16x16x32_bf16(af[m], bfr[n], acc[m][n], 0, 0, 0);
        }
        if (more) {
            char* wa = smem + ((kt + 1) & 1) * G_STAGE; char* wb = wa + G_ASZ;
#pragma unroll
            for (int i = 0; i < 4; ++i) *(u32x4*)(wa + (lrow + 64 * i) * G_LROW + lchunk * 16) = ra[i];
#pragma unroll
            for (int i = 0; i < 2; ++i) *(u32x4*)(wb + (lrow + 64 * i) * G_LROW + lchunk * 16) = rb[i];
        }
        __syncthreads();
    }
    epi(acc, wr * 64, n0 + wc * 64, fr, fq);
}

template <class Epi>
__device__ __forceinline__ void gemm_phase(const bf16_t* A, long lda, int M, const bf16_t* Bt, long ldb, int N, int K, char* smem, int bid, int nb, Epi&& epi) {
    const int ntn = N / 128, ntm = M / 256, nt = ntn * ntm;
    for (int t = bid; t < nt; t += nb) {
        const int mi = t / ntn, ni = t - mi * ntn;
        gemm_tile<false>(A, lda, 0, mi * 256, Bt, ldb, ni * 128, K, smem,
                         [&](f32x4 (&acc)[4][4], int rt0, int c0, int fr, int fq) { epi(acc, mi * 256 + rt0, c0, fr, fq); });
    }
}

__device__ __forceinline__ int colmap(int kind, int n, int nsrc) {
    if (kind == 0) return n < nsrc ? n : -1;
    if (kind == 1) { if (n < 1536) return n; if (n < 2048) return n + 16; if (n < 2064) return n - 512; return -1; }
    if (kind == 2) { if (n < 1792) return n; if (n < 6400) return n + 68; if (n < 6468) return n - 4608; return -1; }
    { const int grp = n >> 5, w = n & 31; return w < 16 ? grp * 16 + w : 1024 + grp * 16 + (w - 16); }
}
__device__ __forceinline__ void tconv_tile(const float* __restrict__ src, int sld, int nsrc, int kind, bf16_t* __restrict__ dst, int K, int n0, int k0, char* smem) {
    bf16_t* tile = (bf16_t*)smem;
    const int tid = threadIdx.x;
    {
        const int nl = tid & 63, kk = tid >> 6;
        const int sc = colmap(kind, n0 + nl, nsrc);
#pragma unroll
        for (int i = 0; i < 8; ++i) {
            const int k = kk + 8 * i;
            const float v = sc >= 0 ? src[(long)(k0 + k) * sld + sc] : 0.f;
            tile[nl * 66 + k] = f2bf(v);
        }
    }
    __syncthreads();
    {
        const int n = tid >> 3, kc = tid & 7;
        const unsigned* tp = (const unsigned*)(tile + n * 66 + kc * 8);
        u32x4 w; w.x = tp[0]; w.y = tp[1]; w.z = tp[2]; w.w = tp[3];
        *(u32x4*)(dst + (long)(n0 + n) * K + k0 + kc * 8) = w;
    }
    __syncthreads();
}

__device__ __forceinline__ void conv_phase(const Params& p, char* smem, int bid, int nb) {
    char* ws = p.ws;
    constexpr int S0 = 128 * 32 * 16, S1 = S0 + 128 * 16 * 16, S2 = S1 + 2 * 34 * 16, S3 = S2 + 2 * 102 * 16, S4 = S3 + 2 * 16 * 16, S5 = S4 + 2 * 16 * 16,
                  S6 = S5 + 2 * 8 * 8, S7 = S6 + 4 * 2 * 16;
    for (int t = bid; t < S7; t += nb) {
        const float* src; bf16_t* dst; int sld, nsrc, kind, K, NT, loc;
        if (t < S0) { loc = t; const int mat = loc / (32 * 16); loc -= mat * 32 * 16; src = p.moe_w1 + (size_t)mat * 1024 * 2048; dst = (bf16_t*)(ws + OFF_WT_W1) + (size_t)mat * 2048 * 1024; sld = 2048; nsrc = 2048; kind = 3; K = 1024; NT = 32; }
        else if (t < S1) { loc = t - S0; const int mat = loc / 256; loc -= mat * 256; src = p.moe_w2 + (size_t)mat * 1024 * 1024; dst = (bf16_t*)(ws + OFF_WT_W2) + (size_t)mat * 1024 * 1024; sld = 1024; nsrc = 1024; kind = 0; K = 1024; NT = 16; }
        else if (t < S2) { loc = t - S1; const int mat = loc / (34 * 16); loc -= mat * 34 * 16; src = p.ev_w_in + (size_t)mat * 1024 * 2064; dst = (bf16_t*)(ws + OFF_WT_EVIN) + (size_t)mat * EV_N * 1024; sld = 2064; nsrc = 2064; kind = 1; K = 1024; NT = 34; }
        else if (t < S3) { loc = t - S2; const int mat = loc / (102 * 16); loc -= mat * 102 * 16; src = p.od_w_in + (size_t)mat * 1024 * 6468; dst = (bf16_t*)(ws + OFF_WT_ODIN) + (size_t)mat * OD_N * 1024; sld = 6468; nsrc = 6468; kind = 2; K = 1024; NT = 102; }
        else if (t < S4) { loc = t - S3; const int mat = loc / 256; loc -= mat * 256; src = p.ev_w_out + (size_t)mat * 1024 * 1024; dst = (bf16_t*)(ws + OFF_WT_EVOUT) + (size_t)mat * 1024 * 1024; sld = 1024; nsrc = 1024; kind = 0; K = 1024; NT = 16; }
        else if (t < S5) { loc = t - S4; const int mat = loc / 256; loc -= mat * 256; src = p.od_w_out + (size_t)mat * 1024 * 1024; dst = (bf16_t*)(ws + OFF_WT_ODOUT) + (size_t)mat * 1024 * 1024; sld = 1024; nsrc = 1024; kind = 0; K = 1024; NT = 16; }
        else if (t < S6) { loc = t - S5; const int mat = loc / 64; loc -= mat * 64; src = p.s5_w_glu + (size_t)mat * 512 * 512; dst = (bf16_t*)(ws + OFF_WT_GLU) + (size_t)mat * 512 * 512; sld = 512; nsrc = 512; kind = 0; K = 512; NT = 8; }
        else { loc = t - S6; const int mat = loc / 32; loc -= mat * 32; src = p.router_w + (size_t)mat * 1024 * 32; dst = (bf16_t*)(ws + OFF_WT_RT) + (size_t)mat * 128 * 1024; sld = 32; nsrc = 32; kind = 0; K = 1024; NT = 2; }
        const int kt = loc / NT, nt = loc - kt * NT;
        tconv_tile(src, sld, nsrc, kind, dst, K, nt * 64, kt * 64, smem);
    }
    {
        const float* x = p.x; bf16_t* xb = (bf16_t*)(ws + OFF_XB);
        const long nch = (long)T_ * 1024 / 8;
        for (long c = (long)bid * NTHR + threadIdx.x; c < nch; c += (long)nb * NTHR) {
            const f32x4 a = *(const f32x4*)(x + c * 8), b = *(const f32x4*)(x + c * 8 + 4);
            u32x4 w; w.x = pk2(a[0], a[1]); w.y = pk2(a[2], a[3]); w.z = pk2(b[0], b[1]); w.w = pk2(b[2], b[3]);
            *(u32x4*)(xb + c * 8) = w;
        }
    }
    if (bid == 0 && threadIdx.x < 128) ((int*)(ws + OFF_CNT))[threadIdx.x] = 0;
}

__device__ __forceinline__ void s5mat_unit(const Params& p, int j, int g, char* smem) {
    float* cre = (float*)smem;
    float* cim = cre + 1024;
    float* bbr = cim + 1024;
    float* bbi = bbr + 1024;
    float* pwr = bbi + 1024;
    float* pwi = pwr + 65 * 64;
    float* zr = pwi + 65 * 64;
    float* zi = zr + 64;
    float* Kd = zi + 64;
    const int tid = threadIdx.x;
    const int jg = j * 32 + g;
    if (tid < 64) {
        const int pp = tid;
        const float lre = fminf(p.s5_a_re[jg * 64 + pp], -1e-4f), lim = p.s5_a_im[jg * 64 + pp];
        const float dt = expf(p.s5_log_dt[jg]);
        const float xr = lre * dt, th = lim * dt;
        const float mag = expf(xr);
        const float ar = mag * cosf(th), ai = mag * sinf(th);
        const float inv = 1.f / (lre * lre + lim * lim);
        zr[pp] = ((ar - 1.f) * lre + ai * lim) * inv;
        zi[pp] = (ai * lre - (ar - 1.f) * lim) * inv;
        const double thd = (double)th;
        for (int d = 0; d <= 64; ++d) {
            const float mg = expf((float)d * xr);
            double ang = (double)d * thd;
            const double kk = rint(ang * 0.15915494309189535);
            ang -= kk * 6.283185307179586;
            const float a = (float)ang;
            pwr[d * 64 + pp] = mg * cosf(a);
            pwi[d * 64 + pp] = mg * sinf(a);
        }
    }
    for (int e = tid; e < 1024; e += NTHR) {
        cre[e] = p.s5_c_re[(size_t)jg * 1024 + e];
        cim[e] = p.s5_c_im[(size_t)jg * 1024 + e];
    }
    __syncthreads();
    for (int e = tid; e < 1024; e += NTHR) {
        const int pp = e >> 4;
        const float br = p.s5_b_re[(size_t)jg * 1024 + e], bi = p.s5_b_im[(size_t)jg * 1024 + e];
        bbr[e] = zr[pp] * br - zi[pp] * bi;
        bbi[e] = zr[pp] * bi + zi[pp] * br;
    }
    __syncthreads();
    for (int e = tid; e < 64 * 256; e += NTHR) {
        const int d = e >> 8, n = (e >> 4) & 15, m = e & 15;
        float s = 0.f;
        for (int pp = 0; pp < 64; ++pp) {
            const float cr = cre[n * 64 + pp], ci = cim[n * 64 + pp], qr = pwr[d * 64 + pp], qi = pwi[d * 64 + pp];
            const float wr_ = cr * qr - ci * qi, wi_ = cr * qi + ci * qr;
            s += wr_ * bbr[pp * 16 + m] - wi_ * bbi[pp * 16 + m];
        }
        Kd[e] = s;
    }
    __syncthreads();
    bf16_t* TH = (bf16_t*)(p.ws + OFF_TH) + (size_t)jg * 1024 * UHW;
    for (int c = tid; c < 1024 * 144; c += NTHR) {
        const int row = c / 144, ch = c - row * 144;
        const int tau = row >> 4, n = row & 15;
        float v[8];
        if (ch < 128) {
            const int s = ch >> 1, m0 = (ch & 1) * 8;
            if (s <= tau) {
#pragma unroll
                for (int i = 0; i < 8; ++i) v[i] = Kd[(tau - s) * 256 + n * 16 + m0 + i];
            } else {
#pragma unroll
                for (int i = 0; i < 8; ++i) v[i] = 0.f;
            }
        } else {
            const int p0 = (ch - 128) * 4;
#pragma unroll
            for (int i = 0; i < 4; ++i) {
                const int pp = p0 + i;
                const float cr = cre[n * 64 + pp], ci = cim[n * 64 + pp], qr = pwr[(tau + 1) * 64 + pp], qi = pwi[(tau + 1) * 64 + pp];
                v[2 * i] = cr * qr - ci * qi;
                v[2 * i + 1] = -(cr * qi + ci * qr);
            }
        }
        u32x4 w; w.x = pk2(v[0], v[1]); w.y = pk2(v[2], v[3]); w.z = pk2(v[4], v[5]); w.w = pk2(v[6], v[7]);
        *(u32x4*)(TH + (size_t)row * UHW + ch * 8) = w;
    }
    bf16_t* GM = (bf16_t*)(p.ws + OFF_GM) + (size_t)jg * 128 * 1024;
    for (int c = tid; c < 128 * 128; c += NTHR) {
        const int row = c >> 7, ch = c & 127;
        const int pp = row >> 1, ri = row & 1;
        const int s = ch >> 1, m0 = (ch & 1) * 8;
        const float qr = pwr[(63 - s) * 64 + pp], qi = pwi[(63 - s) * 64 + pp];
        float v[8];
#pragma unroll
        for (int i = 0; i < 8; ++i) {
            const float br = bbr[pp * 16 + m0 + i], bi = bbi[pp * 16 + m0 + i];
            v[i] = ri == 0 ? (qr * br - qi * bi) : (qr * bi + qi * br);
        }
        u32x4 w; w.x = pk2(v[0], v[1]); w.y = pk2(v[2], v[3]); w.z = pk2(v[4], v[5]); w.w = pk2(v[6], v[7]);
        *(u32x4*)(GM + (size_t)row * 1024 + ch * 8) = w;
    }
    if (tid < 64) {
        float* A64 = (float*)(p.ws + OFF_A64) + (size_t)jg * 128;
        A64[tid * 2] = pwr[64 * 64 + tid];
        A64[tid * 2 + 1] = pwi[64 * 64 + tid];
    }
    __syncthreads();
}

__device__ __forceinline__ void epi_ev_in(const Params& p, f32x4 (&acc)[4][4], int row0, int c0, int fr, int fq) {
    char* ws = p.ws;
    bf16_t* PE = (bf16_t*)(ws + OFF_PE); bf16_t* UH = (bf16_t*)(ws + OFF_UH); float* GLR = (float*)(ws + OFF_GLR); bf16_t* VTE = (bf16_t*)(ws + OFF_VTE);
#pragma unroll
    for (int n = 0; n < 4; ++n) {
        const int cb = c0 + n * 16;
        const int col = cb + fr;
        if (cb < 1536) {
#pragma unroll
            for (int m = 0; m < 4; ++m) {
                const int t = row0 + m * 16 + fq * 4;
#pragma unroll
                for (int r = 0; r < 4; ++r) PE[(size_t)(t + r) * 1536 + col] = f2bf(acc[m][n][r]);
                if (cb >= 512 && cb < 1024) {
                    const int c = col - 512, h = c >> 7, vv = c & 127, b = t >> 14, pos = t & (L_ - 1);
                    u32x2 w; w.x = pk2(acc[m][n][0], acc[m][n][1]); w.y = pk2(acc[m][n][2], acc[m][n][3]);
                    *(u32x2*)(VTE + ((size_t)((b * 4 + h) * 128 + vv)) * L_ + pos) = w;
                }
            }
        } else if (cb < 2048) {
            const int ch = col - 1536, g = ch >> 4, mm = ch & 15;
#pragma unroll
            for (int m = 0; m < 4; ++m)
#pragma unroll
                for (int r = 0; r < 4; ++r) {
                    const int t = row0 + m * 16 + fq * 4 + r;
                    UH[((size_t)(t >> 6) * 32 + g) * UHW + (t & 63) * 16 + mm] = f2bf(acc[m][n][r]);
                }
        } else if (cb < 2064) {
#pragma unroll
            for (int m = 0; m < 4; ++m)
#pragma unroll
                for (int r = 0; r < 4; ++r) {
                    const int t = row0 + m * 16 + fq * 4 + r;
                    GLR[(size_t)t * 16 + (col - 2048)] = acc[m][n][r];
                }
        }
    }
}

__device__ __forceinline__ void gla_decay(const Params& p, int j, int t0, int h, float* sB) {
    const float* GLR = (const float*)(p.ws + OFF_GLR);
    const float* w2 = p.gla_w_gate2 + (size_t)j * 16 * 256;
    const float* b2 = p.gla_b_gate2 + (size_t)j * 256;
    const int tid = threadIdx.x;
    for (int e = tid; e < 4096; e += NTHR) {
        const int tau = e >> 6, d = e & 63;
        float a = b2[h * 64 + d];
#pragma unroll
        for (int r = 0; r < 16; ++r) a += GLR[(size_t)(t0 + tau) * 16 + r] * w2[r * 256 + h * 64 + d];
        const float ls = fminf(a, 0.f) - log1pf(__expf(-fabsf(a)));
        sB[tau * 65 + d] = ls * (1.f / 16.f);
    }
    __syncthreads();
    if (tid < 64) { float run = 0.f; for (int tau = 0; tau < 64; ++tau) { run += sB[tau * 65 + tid]; sB[tau * 65 + tid] = run; } }
    __syncthreads();
}

__device__ __forceinline__ void gla_a_item(const Params& p, int j, int item, char* smem) {
    const int h = item & 3, c = (item >> 2) & 255, b = item >> 10;
    const int t0 = b * L_ + c * 64;
    float* sB = (float*)smem;
    bf16_t* AK = (bf16_t*)(smem + 16640);
    const bf16_t* PE = (const bf16_t*)(p.ws + OFF_PE);
    const bf16_t* VTE = (const bf16_t*)(p.ws + OFF_VTE);
    const int tid = threadIdx.x, lane = tid & 63, wave = tid >> 6, fr = lane & 15, fq = lane >> 4;
    gla_decay(p, j, t0, h, sB);
    for (int e = tid; e < 4096; e += NTHR) {
        const int tau = e >> 6, d = e & 63;
        const float k = bf2f(PE[(size_t)(t0 + tau) * 1536 + 256 + h * 64 + d]);
        AK[d * 72 + tau] = f2bf(k * __expf(sB[63 * 65 + d] - sB[tau * 65 + d]));
    }
    __syncthreads();
    const int dblk = wave >> 1, vb = (wave & 1) * 64;
    f32x4 acc[4];
#pragma unroll
    for (int n = 0; n < 4; ++n) acc[n] = (f32x4){0.f, 0.f, 0.f, 0.f};
#pragma unroll
    for (int ks = 0; ks < 2; ++ks) {
        const bf16x8 af = *(const bf16x8*)(AK + (dblk * 16 + fr) * 72 + ks * 32 + fq * 8);
#pragma unroll
        for (int n = 0; n < 4; ++n) {
            const int v = vb + n * 16 + fr;
            const bf16x8 bfr = *(const bf16x8*)(VTE + ((size_t)((b * 4 + h) * 128 + v)) * L_ + (c * 64 + ks * 32 + fq * 8));
            acc[n] = __builtin_amdgcn_mfma_f32_16x16x32_bf16(af, bfr, acc[n], 0, 0, 0);
        }
    }
    float* KV = (float*)(p.ws + OFF_KV) + ((size_t)((b * 256 + c) * 4 + h)) * 64 * 128;
#pragma unroll
    for (int n = 0; n < 4; ++n)
#pragma unroll
        for (int r = 0; r < 4; ++r) KV[(dblk * 16 + fq * 4 + r) * 128 + vb + n * 16 + fr] = acc[n][r];
    if (tid < 64) ((float*)(p.ws + OFF_DEC))[((size_t)((b * 256 + c) * 4 + h)) * 64 + tid] = __expf(sB[63 * 65 + tid]);
    __syncthreads();
}

__device__ __forceinline__ void scan_phase(const Params& p, int j, int bid) {
    const int gid = bid * NTHR + threadIdx.x;
    if (gid < 65536) {
        const int v = gid & 127, d = (gid >> 7) & 63, h = (gid >> 13) & 3, b = gid >> 15;
        const float* KV = (const float*)(p.ws + OFF_KV); float* SST = (float*)(p.ws + OFF_SST); const float* DEC = (const float*)(p.ws + OFF_DEC);
        float S = 0.f;
        for (int c0 = 0; c0 < 256; c0 += 8) {
            float kv[8], dc[8];
#pragma unroll
            for (int i = 0; i < 8; ++i) {
                const size_t blk = (size_t)((b * 256 + c0 + i) * 4 + h);
                kv[i] = KV[(blk * 64 + d) * 128 + v]; dc[i] = DEC[blk * 64 + d];
            }
#pragma unroll
            for (int i = 0; i < 8; ++i) {
                const size_t blk = (size_t)((b * 256 + c0 + i) * 4 + h);
                SST[(blk * 64 + d) * 128 + v] = S;
                S = dc[i] * S + kv[i];
            }
        }
    } else if (gid < 65536 + 4096) {
        const int e = gid - 65536, pp = e & 63, g = (e >> 6) & 31, b = e >> 11;
        const float* A64 = (const float*)(p.ws + OFF_A64) + (size_t)(j * 32 + g) * 128;
        const float ar = A64[pp * 2], ai = A64[pp * 2 + 1];
        const float* GB = (const float*)(p.ws + OFF_GBUF); bf16_t* UH = (bf16_t*)(p.ws + OFF_UH);
        float hr = 0.f, hi = 0.f;
        for (int c0 = 0; c0 < 256; c0 += 8) {
            float gr[8], gi[8];
#pragma unroll
            for (int i = 0; i < 8; ++i) { const size_t row = (size_t)(b * 256 + c0 + i) * 32 + g; gr[i] = GB[row * 128 + 2 * pp]; gi[i] = GB[row * 128 + 2 * pp + 1]; }
#pragma unroll
            for (int i = 0; i < 8; ++i) {
                const size_t row = (size_t)(b * 256 + c0 + i) * 32 + g;
                *(unsigned*)(UH + row * UHW + 1024 + 2 * pp) = pk2(hr, hi);
                const float nr = ar * hr - ai * hi + gr[i], ni = ar * hi + ai * hr + gi[i];
                hr = nr; hi = ni;
            }
        }
    }
}

__device__ __forceinline__ void gla_c_item(const Params& p, int j, int item, char* smem) {
    const int h = item & 3, c = (item >> 2) & 255, b = item >> 10;
    const int t0 = b * L_ + c * 64;
    float* sB = (float*)smem;
    bf16_t* QT = (bf16_t*)(smem + 16640);
    bf16_t* KT = (bf16_t*)(smem + 16640 + 9216);
    bf16_t* ATT = (bf16_t*)(smem + 16640 + 18432);
    float* OS = (float*)(smem + 16640 + 27648);
    const bf16_t* PE = (const bf16_t*)(p.ws + OFF_PE);
    const bf16_t* VTE = (const bf16_t*)(p.ws + OFF_VTE);
    const int tid = threadIdx.x, lane = tid & 63, wave = tid >> 6, fr = lane & 15, fq = lane >> 4;
    gla_decay(p, j, t0, h, sB);
    for (int e = tid; e < 4096; e += NTHR) {
        const int tau = e >> 6, d = e & 63;
        const float bb = sB[tau * 65 + d];
        const float q = bf2f(PE[(size_t)(t0 + tau) * 1536 + h * 64 + d]);
        const float k = bf2f(PE[(size_t)(t0 + tau) * 1536 + 256 + h * 64 + d]);
        QT[tau * 72 + d] = f2bf(q * 0.125f * __expf(bb));
        KT[tau * 72 + d] = f2bf(k * __expf(-bb));
    }
    __syncthreads();
    const int iblk = wave >> 1;
    {
        f32x4 acc[2];
        acc[0] = (f32x4){0.f, 0.f, 0.f, 0.f}; acc[1] = acc[0];
#pragma unroll
        for (int ks = 0; ks < 2; ++ks) {
            const bf16x8 af = *(const bf16x8*)(QT + (iblk * 16 + fr) * 72 + ks * 32 + fq * 8);
#pragma unroll
            for (int n = 0; n < 2; ++n) {
                const int jb = (wave & 1) * 2 + n;
                const bf16x8 bfr = *(const bf16x8*)(KT + (jb * 16 + fr) * 72 + ks * 32 + fq * 8);
                acc[n] = __builtin_amdgcn_mfma_f32_16x16x32_bf16(af, bfr, acc[n], 0, 0, 0);
            }
        }
#pragma unroll
        for (int n = 0; n < 2; ++n) {
            const int jj = ((wave & 1) * 2 + n) * 16 + fr;
#pragma unroll
            for (int r = 0; r < 4; ++r) { const int ii = iblk * 16 + fq * 4 + r; ATT[ii * 72 + jj] = f2bf(jj <= ii ? acc[n][r] : 0.f); }
        }
    }
    __syncthreads();
    {
        const int vb = (wave & 1) * 64;
        const float* SST = (const float*)(p.ws + OFF_SST) + ((size_t)((b * 256 + c) * 4 + h)) * 64 * 128;
        f32x4 acc[4];
#pragma unroll
        for (int n = 0; n < 4; ++n) acc[n] = (f32x4){0.f, 0.f, 0.f, 0.f};
#pragma unroll
        for (int ks = 0; ks < 2; ++ks) {
            const bf16x8 af = *(const bf16x8*)(ATT + (iblk * 16 + fr) * 72 + ks * 32 + fq * 8);
            const bf16x8 aq = *(const bf16x8*)(QT + (iblk * 16 + fr) * 72 + ks * 32 + fq * 8);
#pragma unroll
            for (int n = 0; n < 4; ++n) {
                const int v = vb + n * 16 + fr;
                const bf16x8 bv = *(const bf16x8*)(VTE + ((size_t)((b * 4 + h) * 128 + v)) * L_ + (c * 64 + ks * 32 + fq * 8));
                acc[n] = __builtin_amdgcn_mfma_f32_16x16x32_bf16(af, bv, acc[n], 0, 0, 0);
                bf16x8 bs;
#pragma unroll
                for (int i = 0; i < 8; ++i) bs[i] = (short)f2bf(SST[(ks * 32 + fq * 8 + i) * 128 + v]);
                acc[n] = __builtin_amdgcn_mfma_f32_16x16x32_bf16(aq, bs, acc[n], 0, 0, 0);
            }
        }
#pragma unroll
        for (int n = 0; n < 4; ++n)
#pragma unroll
            for (int r = 0; r < 4; ++r) OS[(iblk * 16 + fq * 4 + r) * 132 + vb + n * 16 + fr] = acc[n][r];
    }
    __syncthreads();
    {
        const int i = tid >> 3, seg = tid & 7;
        float o[16]; float ss = 0.f;
#pragma unroll
        for (int q = 0; q < 16; ++q) { o[q] = OS[i * 132 + seg * 16 + q]; ss += o[q] * o[q]; }
        ss += __shfl_xor(ss, 1, 64); ss += __shfl_xor(ss, 2, 64); ss += __shfl_xor(ss, 4, 64);
        const float rs = rsqrtf(ss * (1.f / 128.f) + LN_EPS);
        const float* ng = p.gla_norm_g + (size_t)j * 128;
        bf16_t* CC = (bf16_t*)(p.ws + OFF_CC);
        const size_t t = (size_t)(t0 + i);
        unsigned w[8];
#pragma unroll
        for (int q = 0; q < 16; q += 2) {
            const int v0 = seg * 16 + q;
            const float r0 = bf2f(PE[t * 1536 + 1024 + h * 128 + v0]), r1 = bf2f(PE[t * 1536 + 1024 + h * 128 + v0 + 1]);
            const float a0 = o[q] * rs * ng[v0] * (r0 * sigmoidf_(r0)), a1 = o[q + 1] * rs * ng[v0 + 1] * (r1 * sigmoidf_(r1));
            w[q >> 1] = pk2(a0, a1);
        }
        u32x4 w0, w1; w0.x = w[0]; w0.y = w[1]; w0.z = w[2]; w0.w = w[3]; w1.x = w[4]; w1.y = w[5]; w1.z = w[6]; w1.w = w[7];
        *(u32x4*)(CC + t * 1024 + h * 128 + seg * 16) = w0;
        *(u32x4*)(CC + t * 1024 + h * 128 + seg * 16 + 8) = w1;
    }
    __syncthreads();
}

__device__ __forceinline__ void s5_g_phase(const Params& p, int j, char* smem, int bid, int nb) {
    const bf16_t* UH = (const bf16_t*)(p.ws + OFF_UH);
    float* GB = (float*)(p.ws + OFF_GBUF);
    for (int t = bid; t < 64; t += nb) {
        const int g = t >> 1, mi = t & 1;
        const bf16_t* Bt = (const bf16_t*)(p.ws + OFF_GM) + (size_t)(j * 32 + g) * 128 * 1024;
        gemm_tile<false>(UH + (size_t)g * UHW, (long)32 * UHW, 0, mi * 256, Bt, 1024, 0, 1024, smem,
            [&](f32x4 (&acc)[4][4], int rt0, int c0, int fr, int fq) {
#pragma unroll
                for (int m = 0; m < 4; ++m)
#pragma unroll
                    for (int n = 0; n < 4; ++n)
#pragma unroll
                        for (int r = 0; r < 4; ++r) {
                            const int row = mi * 256 + rt0 + m * 16 + fq * 4 + r;
                            GB[((size_t)row * 32 + g) * 128 + c0 + n * 16 + fr] = acc[m][n][r];
                        }
            });
    }
}
__device__ __forceinline__ void s5_y_phase(const Params& p, int j, char* smem, int bid, int nb) {
    const bf16_t* UH = (const bf16_t*)(p.ws + OFF_UH);
    bf16_t* YA = (bf16_t*)(p.ws + OFF_YA);
    const float* dsk = p.s5_d + (size_t)j * 512;
    for (int t = bid; t < 32 * 2 * 8; t += nb) {
        const int g = t >> 4, mi = (t >> 3) & 1, ni = t & 7;
        const bf16_t* Bt = (const bf16_t*)(p.ws + OFF_TH) + (size_t)(j * 32 + g) * 1024 * UHW;
        gemm_tile<false>(UH + (size_t)g * UHW, (long)32 * UHW, 0, mi * 256, Bt, UHW, ni * 128, UHW, smem,
            [&](f32x4 (&acc)[4][4], int rt0, int c0, int fr, int fq) {
#pragma unroll
                for (int m = 0; m < 4; ++m)
#pragma unroll
                    for (int n = 0; n < 4; ++n)
#pragma unroll
                        for (int r = 0; r < 4; ++r) {
                            const int row = mi * 256 + rt0 + m * 16 + fq * 4 + r;
                            const int col = c0 + n * 16 + fr;
                            const int tau = col >> 4, nn = col & 15, ch = g * 16 + nn;
                            const float u = bf2f(UH[((size_t)row * 32 + g) * UHW + col]);
                            const float y = gelu_tanh(acc[m][n][r] + dsk[ch] * u);
                            YA[((size_t)row * 64 + tau) * 512 + ch] = f2bf(y);
                        }
            });
    }
}

template <bool SLOTS>
__device__ __forceinline__ void ln_phase(const Params& p, const float* xin, const float* addb, const float* g, const float* bta, float* xout, bf16_t* xb, int bid, int nb) {
    const int lane = threadIdx.x & 63, wave = threadIdx.x >> 6;
    for (int t = bid * 8 + wave; t < T_; t += nb * 8) {
        f32x4 v[4];
        float s = 0.f;
#pragma unroll
        for (int i = 0; i < 4; ++i) {
            const int c = i * 256 + lane * 4;
            f32x4 a = *(const f32x4*)(xin + (size_t)t * 1024 + c);
            f32x4 m;
            if (SLOTS) {
                m = *(const f32x4*)(addb + ((size_t)t * 4 + 0) * 1024 + c);
                m += *(const f32x4*)(addb + ((size_t)t * 4 + 1) * 1024 + c);
                m += *(const f32x4*)(addb + ((size_t)t * 4 + 2) * 1024 + c);
                m += *(const f32x4*)(addb + ((size_t)t * 4 + 3) * 1024 + c);
            } else m = *(const f32x4*)(addb + (size_t)t * 1024 + c);
            v[i] = a * ALPHA + m;
            s += v[i][0] + v[i][1] + v[i][2] + v[i][3];
        }
        const float mu = wave_sum(s) * (1.f / 1024.f);
        float q = 0.f;
#pragma unroll
        for (int i = 0; i < 4; ++i) { v[i] -= mu; q += v[i][0] * v[i][0] + v[i][1] * v[i][1] + v[i][2] * v[i][2] + v[i][3] * v[i][3]; }
        const float rs = rsqrtf(wave_sum(q) * (1.f / 1024.f) + LN_EPS);
#pragma unroll
        for (int i = 0; i < 4; ++i) {
            const int c = i * 256 + lane * 4;
            const f32x4 gg = *(const f32x4*)(g + c), bb = *(const f32x4*)(bta + c);
            const f32x4 o = v[i] * rs * gg + bb;
            *(f32x4*)(xout + (size_t)t * 1024 + c) = o;
            if (xb) { u32x2 w; w.x = pk2(o[0], o[1]); w.y = pk2(o[2], o[3]); *(u32x2*)(xb + (size_t)t * 1024 + c) = w; }
        }
    }
}

__device__ __forceinline__ void topk_phase(const Params& p, int layer, int bid, int nb) {
    const float* LG = (const float*)(p.ws + OFF_LOGIT);
    int* cnt = (int*)(p.ws + OFF_CNT) + layer * 32;
    int* LIST = (int*)(p.ws + OFF_LIST);
    float* GATE = (float*)(p.ws + OFF_GATE);
    for (int t = bid * NTHR + threadIdx.x; t < T_; t += nb * NTHR) {
        float v0 = -INFINITY, v1 = -INFINITY, v2 = -INFINITY, v3 = -INFINITY; int i0 = 0, i1 = 0, i2 = 0, i3 = 0;
#pragma unroll
        for (int q = 0; q < 8; ++q) {
            const f32x4 l4 = *(const f32x4*)(LG + (size_t)t * 32 + q * 4);
#pragma unroll
            for (int r = 0; r < 4; ++r) {
                const float v = l4[r]; const int e = q * 4 + r;
                if (v > v0) { v3 = v2; i3 = i2; v2 = v1; i2 = i1; v1 = v0; i1 = i0; v0 = v; i0 = e; }
                else if (v > v1) { v3 = v2; i3 = i2; v2 = v1; i2 = i1; v1 = v; i1 = e; }
                else if (v > v2) { v3 = v2; i3 = i2; v2 = v; i2 = e; }
                else if (v > v3) { v3 = v; i3 = e; }
            }
        }
        const float e1 = __expf(v1 - v0), e2 = __expf(v2 - v0), e3 = __expf(v3 - v0);
        const float inv = 1.f / (1.f + e1 + e2 + e3);
        int pos;
        pos = atomicAdd(&cnt[i0], 1); LIST[(size_t)i0 * LISTCAP + pos] = t * 4 + 0; GATE[t * 4 + 0] = inv;
        pos = atomicAdd(&cnt[i1], 1); LIST[(size_t)i1 * LISTCAP + pos] = t * 4 + 1; GATE[t * 4 + 1] = e1 * inv;
        pos = atomicAdd(&cnt[i2], 1); LIST[(size_t)i2 * LISTCAP + pos] = t * 4 + 2; GATE[t * 4 + 2] = e2 * inv;
        pos = atomicAdd(&cnt[i3], 1); LIST[(size_t)i3 * LISTCAP + pos] = t * 4 + 3; GATE[t * 4 + 3] = e3 * inv;
    }
}

template <int WHICH>
__device__ __forceinline__ void moe_gemm_phase(const Params& p, int layer, char* smem, int bid, int nb) {
    const int* cnt = (const int*)(p.ws + OFF_CNT) + layer * 32;
    const int* LIST = (const int*)(p.ws + OFF_LIST);
    int* sRow = (int*)(smem + G_ROWS_OFF);
    constexpr int NTN = WHICH == 1 ? 16 : 8;
    int e = 0, base = 0, ce = cnt[0], mt = (ce + 255) >> 8;
    for (int t = bid;; t += nb) {
        while (e < 32 && t >= base + mt * NTN) { base += mt * NTN; ++e; if (e < 32) { ce = cnt[e]; mt = (ce + 255) >> 8; } }
        if (e >= 32) break;
        const int loc = t - base, mi = loc / NTN, ni = loc - mi * NTN;
        __syncthreads();
        if (threadIdx.x < 256) { const int r = mi * 256 + threadIdx.x; sRow[threadIdx.x] = r < ce ? LIST[(size_t)e * LISTCAP + r] : -1; }
        __syncthreads();
        if (WHICH == 1) {
            const bf16_t* Bt = (const bf16_t*)(p.ws + OFF_WT_W1) + (size_t)(layer * 32 + e) * 2048 * 1024;
            const float* b1 = p.moe_b1 + (size_t)(layer * 32 + e) * 2048;
            bf16_t* ACT = (bf16_t*)(p.ws + OFF_ACT);
            gemm_tile<true>((const bf16_t*)(p.ws + OFF_XB), 1024, 2, 0, Bt, 1024, ni * 128, 1024, smem,
                [&](f32x4 (&acc)[4][4], int rt0, int c0, int fr, int fq) {
#pragma unroll
                    for (int n = 0; n < 4; n += 2) {
                        const int gcol = ((c0 + n * 16) >> 5) * 16 + fr;
                        const float bg = b1[gcol], bl = b1[1024 + gcol];
#pragma unroll
                        for (int m = 0; m < 4; ++m)
#pragma unroll
                            for (int r = 0; r < 4; ++r) {
                                const int pair = sRow[rt0 + m * 16 + fq * 4 + r];
                                if (pair >= 0) {
                                    const float gl = fminf(acc[m][n][r] + bg, 7.f);
                                    const float li = fminf(fmaxf(acc[m][n + 1][r] + bl, -7.f), 7.f);
                                    const float a = gl * sigmoidf_(1.702f * gl) * (li + 1.f);
                                    ACT[(size_t)pair * 1024 + gcol] = f2bf(a);
                                }
                            }
                    }
                });
        } else {
            const bf16_t* Bt = (const bf16_t*)(p.ws + OFF_WT_W2) + (size_t)(layer * 32 + e) * 1024 * 1024;
            const float* b2 = p.moe_b2 + (size_t)(layer * 32 + e) * 1024;
            const float* GATE = (const float*)(p.ws + OFF_GATE);
            float* SLOT = (float*)(p.ws + OFF_SLOT);
            gemm_tile<true>((const bf16_t*)(p.ws + OFF_ACT), 1024, 0, 0, Bt, 1024, ni * 128, 1024, smem,
                [&](f32x4 (&acc)[4][4], int rt0, int c0, int fr, int fq) {
#pragma unroll
                    for (int m = 0; m < 4; ++m)
#pragma unroll
                        for (int r = 0; r < 4; ++r) {
                            const int pair = sRow[rt0 + m * 16 + fq * 4 + r];
                            if (pair >= 0) {
                                const float gt = GATE[pair];
#pragma unroll
                                for (int n = 0; n < 4; ++n) { const int col = c0 + n * 16 + fr; SLOT[(size_t)pair * 1024 + col] = (acc[m][n][r] + b2[col]) * gt; }
                            }
                        }
                });
        }
    }
}

__device__ __forceinline__ void epi_od_in(const Params& p, f32x4 (&acc)[4][4], int row0, int c0, int fr, int fq) {
    char* ws = p.ws;
    bf16_t* PO = (bf16_t*)(ws + OFF_PO); float* WI = (float*)(ws + OFF_WI); bf16_t* VTC = (bf16_t*)(ws + OFF_VTC); bf16_t* VTD = (bf16_t*)(ws + OFF_VTD);
#pragma unroll
    for (int n = 0; n < 4; ++n) {
        const int cb = c0 + n * 16, col = cb + fr;
        if (cb < 6464) {
#pragma unroll
            for (int m = 0; m < 4; ++m) {
                const int t = row0 + m * 16 + fq * 4;
#pragma unroll
                for (int r = 0; r < 4; ++r) PO[(size_t)(t + r) * OD_N + col] = f2bf(acc[m][n][r]);
                const int b = t >> 14, pos = t & (L_ - 1);
                if (cb >= 1024 && cb < 1536) {
                    const int c = col - 1024, hd = c >> 6, d = c & 63;
                    u32x2 w; w.x = pk2(acc[m][n][0], acc[m][n][1]); w.y = pk2(acc[m][n][2], acc[m][n][3]);
                    *(u32x2*)(VTC + ((size_t)((b * 8 + hd) * 64 + d)) * L_ + pos) = w;
                } else if (cb >= 4864 && cb < 6400) {
                    const int c = col - 4864, g = c >> 9, hd = (c >> 6) & 7, d = c & 63;
                    bf16_t* vrow = VTD + ((size_t)(((b * 3 + g) * 8 + hd) * 64 + d)) * L_;
                    if (g == 0) {
                        u32x2 w; w.x = pk2(acc[m][n][0], acc[m][n][1]); w.y = pk2(acc[m][n][2], acc[m][n][3]);
                        *(u32x2*)(vrow + pos) = w;
                    } else {
                        const int sh = g == 1 ? 2 : 4, ld = L_ >> sh;
#pragma unroll
                        for (int r = 0; r < 4; ++r) { const int ps = pos + r; vrow[(ps & ((1 << sh) - 1)) * ld + (ps >> sh)] = f2bf(acc[m][n][r]); }
                    }
                }
            }
        } else if (cb < 6480) {
            if (fr < 4) {
#pragma unroll
                for (int m = 0; m < 4; ++m)
#pragma unroll
                    for (int r = 0; r < 4; ++r) WI[(size_t)(row0 + m * 16 + fq * 4 + r) * 4 + fr] = acc[m][n][r];
            }
        }
    }
}

__device__ __forceinline__ void idx_scores(const bf16_t* __restrict__ PO, int b, int keybase, const bf16x8 (&qf)[4][4], const float (&wi)[4], int lane, float (&sc)[16]) {
    const int r = lane & 31, h2 = lane >> 5;
    const bf16_t* kp = PO + (size_t)(b * L_ + keybase + r) * OD_N + OD_KI + h2 * 8;
    bf16x8 kf[4];
#pragma unroll
    for (int s = 0; s < 4; ++s) kf[s] = *(const bf16x8*)(kp + s * 16);
#pragma unroll
    for (int i = 0; i < 16; ++i) sc[i] = 0.f;
#pragma unroll
    for (int hd = 0; hd < 4; ++hd) {
        f32x16 a;
#pragma unroll
        for (int i = 0; i < 16; ++i) a[i] = 0.f;
#pragma unroll
        for (int s = 0; s < 4; ++s) a = __builtin_amdgcn_mfma_f32_32x32x16_bf16(kf[s], qf[hd][s], a, 0, 0, 0);
#pragma unroll
        for (int i = 0; i < 16; ++i) sc[i] += wi[hd] * fmaxf(a[i], 0.f);
    }
}
__device__ __forceinline__ unsigned ord_key(float s) {
    unsigned u = __float_as_uint(s);
    if (u == 0x80000000u) u = 0u;
    return (u & 0x80000000u) ? ~u : (u | 0x80000000u);
}

__device__ __forceinline__ void dsa_select_item(const Params& p, int b, int qb, char* smem) {
    unsigned* hist = (unsigned*)smem;
    unsigned* pref = (unsigned*)(smem + 65536);
    int* krem = (int*)(smem + 65536 + 256);
    unsigned* GW = (unsigned*)(smem + 65536 + 512);
    unsigned* EW = (unsigned*)(smem + 65536 + 512 + 1024);
    const bf16_t* PO = (const bf16_t*)(p.ws + OFF_PO);
    const float* WI = (const float*)(p.ws + OFF_WI);
    unsigned* BM32 = (unsigned*)(p.ws + OFF_BM);
    const int tid = threadIdx.x, lane = tid & 63, wave = tid >> 6, kw = wave >> 1, qw = wave & 1, h2 = lane >> 5;
    const int p0 = qb * 64;
    const int ql = qw * 32 + (lane & 31);
    const int qpos = p0 + ql;
    const size_t tq = (size_t)b * L_ + qpos;
    const int nkt = (p0 + 64 + 127) >> 7;
    bf16x8 qf[4][4]; float wi[4];
#pragma unroll
    for (int hd = 0; hd < 4; ++hd) {
        wi[hd] = WI[tq * 4 + hd];
#pragma unroll
        for (int s = 0; s < 4; ++s) qf[hd][s] = *(const bf16x8*)(PO + tq * OD_N + OD_QI + hd * 64 + s * 16 + h2 * 8);
    }
    for (int e = tid; e < 64 * 256; e += NTHR) hist[e] = 0u;
    if (tid < 64) { pref[tid] = 0u; krem[tid] = 256; }
    __syncthreads();
    const bool selall = qpos < 256;
    if (p0 + 63 >= 256) {
        for (int pass = 0; pass < 4; ++pass) {
            const int sh = 24 - 8 * pass;
            const unsigned mypref = pref[ql];
            for (int kt = 0; kt < nkt; ++kt) {
                float sc[16];
                const int keybase = kt * 128 + kw * 32;
                idx_scores(PO, b, keybase, qf, wi, lane, sc);
#pragma unroll
                for (int i = 0; i < 16; ++i) {
                    const int key = keybase + (i & 3) + 8 * (i >> 2) + 4 * h2;
                    const unsigned k32 = ord_key(sc[i]);
                    const bool match = pass == 0 ? true : ((k32 >> (sh + 8)) == mypref);
                    if (key <= qpos && !selall && match) atomicAdd(&hist[ql * 256 + ((k32 >> sh) & 255u)], 1u);
                }
            }
            __syncthreads();
            if (tid < 64 && (p0 + tid) >= 256) {
                int need = krem[tid]; unsigned cum = 0; int dg = 255;
                for (; dg > 0; --dg) { const unsigned c = hist[tid * 256 + dg]; if (cum + c >= (unsigned)need) break; cum += c; }
                pref[tid] = (pref[tid] << 8) | (unsigned)dg;
                krem[tid] = need - (int)cum;
            }
            __syncthreads();
            for (int e = tid; e < 64 * 256; e += NTHR) hist[e] = 0u;
            __syncthreads();
        }
    }
    const unsigned TK = pref[ql];
    int ceq = 0;
    const int rsel = tid < 64 ? krem[tid] : 0;
    for (int kt = 0; kt < nkt; ++kt) {
        float sc[16];
        const int keybase = kt * 128 + kw * 32;
        idx_scores(PO, b, keybase, qf, wi, lane, sc);
        unsigned gw = 0u, ew = 0u;
#pragma unroll
        for (int i = 0; i < 16; ++i) {
            const int ko = (i & 3) + 8 * (i >> 2) + 4 * h2;
            const int key = keybase + ko;
            const unsigned k32 = ord_key(sc[i]);
            const bool valid = key <= qpos;
            const bool g = valid && (selall || k32 > TK);
            const bool e = valid && !selall && k32 == TK;
            gw |= (g ? 1u : 0u) << ko; ew |= (e ? 1u : 0u) << ko;
        }
        gw |= __shfl_xor(gw, 32, 64); ew |= __shfl_xor(ew, 32, 64);
        if (h2 == 0) { GW[ql * 4 + kw] = gw; EW[ql * 4 + kw] = ew; }
        __syncthreads();
        if (tid < 64) {
            unsigned g4[4], e4[4];
#pragma unroll
            for (int w = 0; w < 4; ++w) { g4[w] = GW[tid * 4 + w]; e4[w] = EW[tid * 4 + w]; }
            int need = rsel - ceq; if (need < 0) need = 0;
#pragma unroll
            for (int w = 0; w < 4; ++w) {
                const int pc = __popc(e4[w]);
                ceq += pc;
                if (need >= pc) need -= pc;
                else { unsigned m = e4[w], kept = 0u; for (int k = 0; k < need; ++k) { const unsigned low = m & (0u - m); kept |= low; m ^= low; } e4[w] = kept; need = 0; }
                g4[w] |= e4[w];
            }
            u32x4 o; o.x = g4[0]; o.y = g4[1]; o.z = g4[2]; o.w = g4[3];
            *(u32x4*)(BM32 + ((size_t)b * L_ + p0 + tid) * 512 + kt * 4) = o;
        }
        __syncthreads();
    }
}

template <int MODE>
__device__ __forceinline__ void attn_wave(const Params& p, int b, int head, int qcol, int kcol, const bf16_t* __restrict__ VT, int voff,
                                          int i0, int sh  , int rho, int kt_lo, int kt_hi, int grp) {
    const bf16_t* PO = (const bf16_t*)(p.ws + OFF_PO);
    const unsigned* BM32 = (const unsigned*)(p.ws + OFF_BM);
    const int lane = threadIdx.x & 63, r = lane & 31, h2 = lane >> 5;
    const int pr = (r & 0x13) | ((r & 4) << 1) | ((r & 8) >> 1);
    const float SC = 0.125f * 1.4426950408889634f;
    bf16x8 qf[2][4]; size_t tq[2]; int qi[2];
#pragma unroll
    for (int qt = 0; qt < 2; ++qt) {
        qi[qt] = i0 + qt * 32 + r;
        tq[qt] = (size_t)b * L_ + ((size_t)qi[qt] << sh) + rho;
#pragma unroll
        for (int s = 0; s < 4; ++s) qf[qt][s] = *(const bf16x8*)(PO + tq[qt] * OD_N + qcol + head * 64 + s * 16 + h2 * 8);
    }
    f32x16 oacc[2][2];
#pragma unroll
    for (int a = 0; a < 2; ++a)
#pragma unroll
        for (int c = 0; c < 2; ++c)
#pragma unroll
            for (int i = 0; i < 16; ++i) oacc[a][c][i] = 0.f;
    float mrun[2] = {-1e30f, -1e30f}, lrun[2] = {0.f, 0.f};
    bf16x8 kf[4]; unsigned mw[2] = {0u, 0u};
    auto load_k = [&](int kt, bf16x8 (&k_)[4], unsigned (&m_)[2]) {
        const size_t krow = (size_t)b * L_ + ((size_t)(kt * 32 + pr) << sh) + rho;
#pragma unroll
        for (int s = 0; s < 4; ++s) k_[s] = *(const bf16x8*)(PO + krow * OD_N + kcol + head * 64 + s * 16 + h2 * 8);
        if (MODE == 0) { m_[0] = BM32[tq[0] * 512 + kt]; m_[1] = BM32[tq[1] * 512 + kt]; }
    };
    load_k(kt_lo, kf, mw);
    for (int kt = kt_lo; kt <= kt_hi; ++kt) {
        bf16x8 vf[2][2];
#pragma unroll
        for (int db = 0; db < 2; ++db)
#pragma unroll
            for (int s2 = 0; s2 < 2; ++s2) vf[db][s2] = *(const bf16x8*)(VT + (size_t)(db * 32 + r) * L_ + voff + kt * 32 + s2 * 16 + h2 * 8);
        bf16x8 kn[4]; unsigned mn[2] = {0u, 0u};
        if (kt < kt_hi) load_k(kt + 1, kn, mn);
#pragma unroll
        for (int qt = 0; qt < 2; ++qt) {
            f32x16 s;
#pragma unroll
            for (int i = 0; i < 16; ++i) s[i] = 0.f;
#pragma unroll
            for (int ks = 0; ks < 4; ++ks) s = __builtin_amdgcn_mfma_f32_32x32x16_bf16(kf[ks], qf[qt][ks], s, 0, 0, 0);
            unsigned selm = 0u; float mx = -1e30f;
#pragma unroll
            for (int i = 0; i < 16; ++i) {
                const int ko = 16 * (i >> 3) + 8 * h2 + 4 * ((i >> 2) & 1) + (i & 3);
                bool sl;
                if (MODE == 0) sl = (mw[qt] >> ko) & 1u;
                else { const int kk = kt * 32 + ko; sl = (kk <= qi[qt]) && (kk >= qi[qt] - 128); }
                selm |= (sl ? 1u : 0u) << i;
                s[i] = sl ? s[i] * SC : -1e30f;
                mx = fmaxf(mx, s[i]);
            }
            mx = fmaxf(mx, __shfl_xor(mx, 32, 64));
            const float mnew = fmaxf(mrun[qt], mx);
            const float corr = exp2f(mrun[qt] - mnew);
            mrun[qt] = mnew;
            float ps = 0.f;
#pragma unroll
            for (int i = 0; i < 16; ++i) { s[i] = ((selm >> i) & 1u) ? exp2f(s[i] - mnew) : 0.f; ps += s[i]; }
            lrun[qt] = lrun[qt] * corr + ps;
#pragma unroll
            for (int db = 0; db < 2; ++db)
#pragma unroll
                for (int i = 0; i < 16; ++i) oacc[qt][db][i] *= corr;
#pragma unroll
            for (int s2 = 0; s2 < 2; ++s2) {
                bf16x8 pf;
#pragma unroll
                for (int jj = 0; jj < 8; ++jj) pf[jj] = (short)f2bf(s[8 * s2 + jj]);
#pragma unroll
                for (int db = 0; db < 2; ++db) oacc[qt][db] = __builtin_amdgcn_mfma_f32_32x32x16_bf16(vf[db][s2], pf, oacc[qt][db], 0, 0, 0);
            }
        }
        if (kt < kt_hi) {
#pragma unroll
            for (int s = 0; s < 4; ++s) kf[s] = kn[s];
            mw[0] = mn[0]; mw[1] = mn[1];
        }
    }
#pragma unroll
    for (int qt = 0; qt < 2; ++qt) {
        const float lt = lrun[qt] + __shfl_xor(lrun[qt], 32, 64);
        const float inv = 1.f / lt;
        if (MODE == 0) {
            bf16_t* CC = (bf16_t*)(p.ws + OFF_CC);
#pragma unroll
            for (int db = 0; db < 2; ++db)
#pragma unroll
                for (int i = 0; i < 16; ++i) {
                    const int d = db * 32 + (i & 3) + 8 * (i >> 2) + 4 * h2;
                    CC[tq[qt] * 1024 + head * 64 + d] = f2bf(oacc[qt][db][i] * inv);
                }
        } else {
            float* OD = (float*)(p.ws + OFF_OD) + (size_t)grp * T_ * 512;
#pragma unroll
            for (int db = 0; db < 2; ++db)
#pragma unroll
                for (int i = 0; i < 16; ++i) {
                    const int d = db * 32 + (i & 3) + 8 * (i >> 2) + 4 * h2;
                    OD[tq[qt] * 512 + head * 64 + d] = oacc[qt][db][i] * inv;
                }
            if (h2 == 0) ((float*)(p.ws + OFF_LSE))[((size_t)grp * T_ + tq[qt]) * 8 + head] = mrun[qt] + log2f(lt);
        }
    }
}

__device__ __forceinline__ void dil_combine_phase(const Params& p, int bid, int nb) {
    const float* OD = (const float*)(p.ws + OFF_OD); const float* LSE = (const float*)(p.ws + OFF_LSE);
    bf16_t* CC = (bf16_t*)(p.ws + OFF_CC);
    const long n = (long)T_ * 128;
    for (long c = (long)bid * NTHR + threadIdx.x; c < n; c += (long)nb * NTHR) {
        const long t = c >> 7; const int ch = (int)(c & 127) * 4, hd = ch >> 6;
        const float l0 = LSE[((size_t)0 * T_ + t) * 8 + hd], l1 = LSE[((size_t)1 * T_ + t) * 8 + hd], l2 = LSE[((size_t)2 * T_ + t) * 8 + hd];
        const float mx = fmaxf(l0, fmaxf(l1, l2));
        const float w0 = exp2f(l0 - mx), w1 = exp2f(l1 - mx), w2 = exp2f(l2 - mx);
        const float inv = 1.f / (w0 + w1 + w2);
        const f32x4 a = *(const f32x4*)(OD + ((size_t)0 * T_ + t) * 512 + ch), bq = *(const f32x4*)(OD + ((size_t)1 * T_ + t) * 512 + ch),
                    cq = *(const f32x4*)(OD + ((size_t)2 * T_ + t) * 512 + ch);
        const f32x4 o = (a * w0 + bq * w1 + cq * w2) * inv;
        u32x2 w; w.x = pk2(o[0], o[1]); w.y = pk2(o[2], o[3]);
        *(u32x2*)(CC + (size_t)t * 1024 + 512 + ch) = w;
    }
}

enum { K_PRO = 0, K_E1, K_E2, K_E3, K_E4, K_E5, K_E6, K_LN1, K_O1, K_O2, K_O3, K_O4, K_M1, K_M2, K_M3, K_M4, K_LN2, K_COUNT };

template <int KIND>
__device__ __forceinline__ void run_phase(const Params& p, int layer, char* smem, int bid, int nb) {
    char* ws = p.ws;
    const int j = layer >> 1;
    if (KIND == K_PRO) {
        for (int u = bid; u < 64; u += nb) s5mat_unit(p, u >> 5, u & 31, smem);
        conv_phase(p, smem, bid, nb);
    } else if (KIND == K_E1) {
        gemm_phase((const bf16_t*)(ws + OFF_XB), 1024, T_, (const bf16_t*)(ws + OFF_WT_EVIN) + (size_t)j * EV_N * 1024, 1024, EV_N, 1024, smem, bid, nb,
                   [&](f32x4 (&acc)[4][4], int row0, int c0, int fr, int fq) { epi_ev_in(p, acc, row0, c0, fr, fq); });
    } else if (KIND == K_E2) {
        for (int it = bid; it < 2048; it += nb) gla_a_item(p, j, it, smem);
        s5_g_phase(p, j, smem, bid, nb);
    } else if (KIND == K_E3) {
        scan_phase(p, j, bid);
    } else if (KIND == K_E4) {
        for (int it = bid; it < 2048; it += nb) gla_c_item(p, j, it, smem);
        s5_y_phase(p, j, smem, bid, nb);
    } else if (KIND == K_E5) {
        const bf16_t* YA = (const bf16_t*)(ws + OFF_YA); bf16_t* CC = (bf16_t*)(ws + OFF_CC); const float* bg = p.s5_b_glu + (size_t)j * 512;
        gemm_phase(YA, 512, T_, (const bf16_t*)(ws + OFF_WT_GLU) + (size_t)j * 512 * 512, 512, 512, 512, smem, bid, nb,
                   [&](f32x4 (&acc)[4][4], int row0, int c0, int fr, int fq) {
#pragma unroll
                       for (int m = 0; m < 4; ++m)
#pragma unroll
                           for (int n = 0; n < 4; ++n)
#pragma unroll
                               for (int r = 0; r < 4; ++r) {
                                   const size_t t = (size_t)(row0 + m * 16 + fq * 4 + r); const int col = c0 + n * 16 + fr;
                                   const float y = bf2f(YA[t * 512 + col]);
                                   CC[t * 1024 + 512 + col] = f2bf(y * sigmoidf_(acc[m][n][r] + bg[col]));
                               }
                   });
    } else if (KIND == K_E6 || KIND == K_O4) {
        float* MIX = (float*)(ws + OFF_MIX);
        const bf16_t* W = (const bf16_t*)(ws + (KIND == K_E6 ? OFF_WT_EVOUT : OFF_WT_ODOUT)) + (size_t)j * 1024 * 1024;
        gemm_phase((const bf16_t*)(ws + OFF_CC), 1024, T_, W, 1024, 1024, 1024, smem, bid, nb,
                   [&](f32x4 (&acc)[4][4], int row0, int c0, int fr, int fq) {
#pragma unroll
                       for (int m = 0; m < 4; ++m)
#pragma unroll
                           for (int n = 0; n < 4; ++n)
#pragma unroll
                               for (int r = 0; r < 4; ++r) MIX[(size_t)(row0 + m * 16 + fq * 4 + r) * 1024 + c0 + n * 16 + fr] = acc[m][n][r];
                   });
    } else if (KIND == K_LN1) {
        const float* xin = layer == 0 ? p.x : (const float*)(ws + OFF_XR);
        ln_phase<false>(p, xin, (const float*)(ws + OFF_MIX), p.ln1_g + (size_t)layer * 1024, p.ln1_b + (size_t)layer * 1024, (float*)(ws + OFF_XR), (bf16_t*)(ws + OFF_XB), bid, nb);
    } else if (KIND == K_O1) {
        gemm_phase((const bf16_t*)(ws + OFF_XB), 1024, T_, (const bf16_t*)(ws + OFF_WT_ODIN) + (size_t)j * OD_N * 1024, 1024, OD_N, 1024, smem, bid, nb,
                   [&](f32x4 (&acc)[4][4], int row0, int c0, int fr, int fq) { epi_od_in(p, acc, row0, c0, fr, fq); });
    } else if (KIND == K_O2) {
        for (int k = bid; k < 256; k += nb) {
            dsa_select_item(p, k & 1, k >> 1, smem);
            __syncthreads();
            const int k2 = 511 - k;
            dsa_select_item(p, k2 & 1, k2 >> 1, smem);
            __syncthreads();
        }
        const int head = threadIdx.x >> 6;
        for (int it = bid; it < 1536; it += nb) {
            const int b = it / 768, rem = it - b * 768, g = rem >> 8, u = rem & 255;
            const int sh = g * 2, per = 256 >> sh, rho = u / per, qblk = u - rho * per;
            const bf16_t* VT = (const bf16_t*)(ws + OFF_VTD) + ((size_t)((b * 3 + g) * 8 + head)) * 64 * L_;
            const int lo = 2 * qblk - 4;
            attn_wave<1>(p, b, head, OD_DIL + g * 512, OD_DIL + 1536 + g * 512, VT, rho * (L_ >> sh), qblk * 64, sh, rho, lo < 0 ? 0 : lo, 2 * qblk + 1, g);
        }
    } else if (KIND == K_O3) {
        const int head = threadIdx.x >> 6;
        for (int k = bid; k < 256; k += nb) {
#pragma unroll 1
            for (int half = 0; half < 2; ++half) {
                const int I = half == 0 ? k : 511 - k, b = I & 1, qb = I >> 1;
                const bf16_t* VT = (const bf16_t*)(ws + OFF_VTC) + ((size_t)(b * 8 + head)) * 64 * L_;
                attn_wave<0>(p, b, head, 0, 512, VT, 0, qb * 64, 0, 0, 0, 2 * qb + 1, 0);
            }
        }
        dil_combine_phase(p, bid, nb);
    } else if (KIND == K_M1) {
        float* LG = (float*)(ws + OFF_LOGIT); const float* rb = p.router_b + (size_t)layer * 32;
        gemm_phase((const bf16_t*)(ws + OFF_XB), 1024, T_, (const bf16_t*)(ws + OFF_WT_RT) + (size_t)layer * 128 * 1024, 1024, 128, 1024, smem, bid, nb,
                   [&](f32x4 (&acc)[4][4], int row0, int c0, int fr, int fq) {
#pragma unroll
                       for (int n = 0; n < 2; ++n) {
                           const int col = c0 + n * 16 + fr;
                           if (col < 32) {
#pragma unroll
                               for (int m = 0; m < 4; ++m)
#pragma unroll
                                   for (int r = 0; r < 4; ++r) LG[(size_t)(row0 + m * 16 + fq * 4 + r) * 32 + col] = acc[m][n][r] + rb[col];
                           }
                       }
                   });
    } else if (KIND == K_M2) {
        topk_phase(p, layer, bid, nb);
    } else if (KIND == K_M3) {
        moe_gemm_phase<1>(p, layer, smem, bid, nb);
    } else if (KIND == K_M4) {
        moe_gemm_phase<2>(p, layer, smem, bid, nb);
    } else if (KIND == K_LN2) {
        float* xo = layer == 3 ? p.out : (float*)(ws + OFF_XR);
        ln_phase<true>(p, (const float*)(ws + OFF_XR), (const float*)(ws + OFF_SLOT), p.ln2_g + (size_t)layer * 1024, p.ln2_b + (size_t)layer * 1024, xo,
                       layer == 3 ? (bf16_t*)nullptr : (bf16_t*)(ws + OFF_XB), bid, nb);
    }
}

extern __shared__ __attribute__((aligned(16))) char dyn_smem[];

#if !MEGA
template <int KIND>
__global__ void __launch_bounds__(NTHR, 2) k_phase(Params p, int layer) { run_phase<KIND>(p, layer, dyn_smem, blockIdx.x, gridDim.x); }
#else
#define PHASE(K) do { run_phase<K>(p, layer, smem, bid, nb); xcd_barrier(bar); } while (0)
template <int LAYER>
__device__ __forceinline__ void mega_layer(const Params& p, char* smem, int bid, int nb, const XcdBarrier& bar) {
    constexpr int layer = LAYER;
    if ((layer & 1) == 0) { PHASE(K_E1); PHASE(K_E2); PHASE(K_E3); PHASE(K_E4); PHASE(K_E5); PHASE(K_E6); }
    else { PHASE(K_O1); PHASE(K_O2); PHASE(K_O3); PHASE(K_O4); }
    PHASE(K_LN1); PHASE(K_M1); PHASE(K_M2); PHASE(K_M3); PHASE(K_M4);
    run_phase<K_LN2>(p, layer, smem, bid, nb);
    if (layer < 3) xcd_barrier(bar);
}
__global__ void __launch_bounds__(NTHR, 2) k_mega(Params p) {
    char* smem = dyn_smem;
    const int bid = blockIdx.x, nb = gridDim.x;
    volatile LAS unsigned* st = (volatile LAS unsigned*)(dyn_smem + LDS_BYTES - 16);
    if (threadIdx.x == 0) { st[0] = 0u; st[1] = 0u; }
    __syncthreads();
    XcdBarrier bar = xcd_barrier_post((unsigned*)(p.ws + OFF_BAR), st);
    { const int layer = 0; PHASE(K_PRO); }
    mega_layer<0>(p, smem, bid, nb, bar);
    mega_layer<1>(p, smem, bid, nb, bar);
    mega_layer<2>(p, smem, bid, nb, bar);
    mega_layer<3>(p, smem, bid, nb, bar);
}
#endif

extern "C" void kernel_launch(void* const* d_in, const int* in_sizes, int n_in, void* d_out, int out_size, void* d_ws, size_t ws_size, hipStream_t stream) {
    Params p{};
    const float** f = (const float**)&p;
    for (int i = 0; i < 28; ++i) f[i] = (const float*)d_in[i];
    p.out = (float*)d_out; p.ws = (char*)d_ws;
    if (ws_size < WS_NEED) { fprintf(stderr, "workspace too small: %zu < %zu\n", ws_size, (size_t)WS_NEED); return; }
#if !MEGA
#define SETATTR(K) hipFuncSetAttribute((const void*)k_phase<K>, hipFuncAttributeMaxDynamicSharedMemorySize, LDS_BYTES)
#define LAUNCH(K, layer) k_phase<K><<<256, NTHR, LDS_BYTES, stream>>>(p, layer)
    static bool attr_done = false;
    if (!attr_done) {
        SETATTR(K_PRO); SETATTR(K_E1); SETATTR(K_E2); SETATTR(K_E3); SETATTR(K_E4); SETATTR(K_E5); SETATTR(K_E6); SETATTR(K_LN1); SETATTR(K_O1); SETATTR(K_O2); SETATTR(K_O3);
        SETATTR(K_O4); SETATTR(K_M1); SETATTR(K_M2); SETATTR(K_M3); SETATTR(K_M4); SETATTR(K_LN2);
        attr_done = true;
    }
    LAUNCH(K_PRO, 0);
    for (int layer = 0; layer < 4; ++layer) {
        if ((layer & 1) == 0) { LAUNCH(K_E1, layer); LAUNCH(K_E2, layer); LAUNCH(K_E3, layer); LAUNCH(K_E4, layer); LAUNCH(K_E5, layer); LAUNCH(K_E6, layer); }
        else { LAUNCH(K_O1, layer); LAUNCH(K_O2, layer); LAUNCH(K_O3, layer); LAUNCH(K_O4, layer); }
        LAUNCH(K_LN1, layer); LAUNCH(K_M1, layer); LAUNCH(K_M2, layer); LAUNCH(K_M3, layer); LAUNCH(K_M4, layer); LAUNCH(K_LN2, layer);
    }
#else
    static int grid = 0;
    if (!grid) {
        hipFuncSetAttribute((const void*)k_mega, hipFuncAttributeMaxDynamicSharedMemorySize, LDS_BYTES);
        int dev = 0, cus = 0, per_cu = 0;
        hipGetDevice(&dev);
        hipDeviceGetAttribute(&cus, hipDeviceAttributeMultiprocessorCount, dev);
        hipOccupancyMaxActiveBlocksPerMultiprocessor(&per_cu, (const void*)k_mega, NTHR, LDS_BYTES);
        grid = cus * (per_cu < 1 ? per_cu : 1);
        if (grid <= 0) grid = 0;
    }
    if (!grid) { fprintf(stderr, "occupancy query says 0 blocks per CU\n"); return; }
    hipMemsetAsync((char*)d_ws + OFF_BAR, 0, XCD_BAR_WORDS * sizeof(unsigned), stream);
    k_mega<<<grid, NTHR, LDS_BYTES, stream>>>(p);
#endif
}
```

```cpp
#include <hip/hip_runtime.h>
#include <stdint.h>
#include <stdio.h>

#ifndef MEGA
#define MEGA 1
#endif

typedef unsigned short bf16_t;
typedef short bf16x8 __attribute__((ext_vector_type(8)));
typedef float f32x4 __attribute__((ext_vector_type(4)));
typedef float f32x16 __attribute__((ext_vector_type(16)));
typedef unsigned u32x4 __attribute__((ext_vector_type(4)));
typedef unsigned u32x2 __attribute__((ext_vector_type(2)));

constexpr int T_ = 32768, D_ = 1024, L_ = 16384, NB_ = 2;
constexpr int NTHR = 512;
constexpr float ALPHA = 1.681792830507429f;
constexpr float LN_EPS = 1e-5f;
constexpr int EV_N = 2176;
constexpr int OD_N = 6528;
constexpr int OD_QI = 1536, OD_DIL = 1792, OD_KI = 6400, OD_WI = 6464;
constexpr int UHW = 1152;
constexpr int LISTCAP = 131072;

constexpr size_t OFF_BAR = 0;
constexpr size_t OFF_CNT = 16384;
constexpr size_t OFF_A64 = 32768;
constexpr size_t OFF_WT_EVIN = 131072;
constexpr size_t OFF_WT_ODIN = OFF_WT_EVIN + (size_t)2 * EV_N * 1024 * 2;
constexpr size_t OFF_WT_EVOUT = OFF_WT_ODIN + (size_t)2 * OD_N * 1024 * 2;
constexpr size_t OFF_WT_ODOUT = OFF_WT_EVOUT + (size_t)2 * 1024 * 1024 * 2;
constexpr size_t OFF_WT_GLU = OFF_WT_ODOUT + (size_t)2 * 1024 * 1024 * 2;
constexpr size_t OFF_WT_RT = OFF_WT_GLU + (size_t)2 * 512 * 512 * 2;
constexpr size_t OFF_WT_W1 = OFF_WT_RT + (size_t)4 * 128 * 1024 * 2;
constexpr size_t OFF_WT_W2 = OFF_WT_W1 + (size_t)4 * 32 * 2048 * 1024 * 2;
constexpr size_t OFF_TH = OFF_WT_W2 + (size_t)4 * 32 * 1024 * 1024 * 2;
constexpr size_t OFF_GM = OFF_TH + (size_t)2 * 32 * 1024 * UHW * 2;
constexpr size_t OFF_XR = OFF_GM + (size_t)2 * 32 * 128 * 1024 * 2;
constexpr size_t OFF_XB = OFF_XR + (size_t)T_ * 1024 * 4;
constexpr size_t OFF_MIX = OFF_XB + (size_t)T_ * 1024 * 2;
constexpr size_t OFF_CC = OFF_MIX + (size_t)T_ * 1024 * 4;
constexpr size_t OFF_LOGIT = OFF_CC + (size_t)T_ * 1024 * 2;
constexpr size_t OFF_LIST = OFF_LOGIT + (size_t)T_ * 32 * 4;
constexpr size_t OFF_GATE = OFF_LIST + (size_t)32 * LISTCAP * 4;
constexpr size_t OFF_ACT = OFF_GATE + (size_t)T_ * 4 * 4;
constexpr size_t OFF_SLOT = OFF_ACT + (size_t)T_ * 4 * 1024 * 2;
constexpr size_t OFF_MIXER = OFF_SLOT + (size_t)T_ * 4 * 1024 * 4;
constexpr size_t OFF_PE = OFF_MIXER;
constexpr size_t OFF_UH = OFF_PE + (size_t)T_ * 1536 * 2;
constexpr size_t OFF_GLR = OFF_UH + (size_t)(T_ / 64) * 32 * UHW * 2;
constexpr size_t OFF_VTE = OFF_GLR + (size_t)T_ * 16 * 4;
constexpr size_t OFF_KV = OFF_VTE + (size_t)2 * 4 * 128 * L_ * 2;
constexpr size_t OFF_SST = OFF_KV + (size_t)2 * 256 * 4 * 64 * 128 * 4;
constexpr size_t OFF_DEC = OFF_SST + (size_t)2 * 256 * 4 * 64 * 128 * 4;
constexpr size_t OFF_GBUF = OFF_DEC + (size_t)2 * 256 * 4 * 64 * 4;
constexpr size_t OFF_YA = OFF_GBUF + (size_t)512 * 32 * 128 * 4;
constexpr size_t END_EVEN = OFF_YA + (size_t)T_ * 512 * 2;
constexpr size_t OFF_PO = OFF_MIXER;
constexpr size_t OFF_WI = OFF_PO + (size_t)T_ * OD_N * 2;
constexpr size_t OFF_VTC = OFF_WI + (size_t)T_ * 4 * 4;
constexpr size_t OFF_VTD = OFF_VTC + (size_t)2 * 8 * 64 * L_ * 2;
constexpr size_t OFF_BM = OFF_VTD + (size_t)2 * 3 * 8 * 64 * L_ * 2;
constexpr size_t OFF_OD = OFF_BM + (size_t)T_ * 256 * 8;
constexpr size_t OFF_LSE = OFF_OD + (size_t)3 * T_ * 512 * 4;
constexpr size_t END_ODD = OFF_LSE + (size_t)3 * T_ * 8 * 4;
constexpr size_t WS_NEED = END_ODD > END_EVEN ? END_ODD : END_EVEN;
static_assert(WS_NEED < (size_t)4200000000ull, "workspace too large");

constexpr int LDS_BYTES = 131072;

struct Params {
    const float *x, *ev_w_in, *gla_w_gate2, *gla_b_gate2, *gla_norm_g, *s5_a_re, *s5_a_im, *s5_log_dt, *s5_b_re, *s5_b_im, *s5_c_re, *s5_c_im, *s5_d,
        *s5_w_glu, *s5_b_glu, *ev_w_out, *od_w_in, *od_w_out, *ln1_g, *ln1_b, *ln2_g, *ln2_b, *router_w, *router_b, *moe_w1, *moe_b1, *moe_w2, *moe_b2;
    float* out;
    char* ws;
};

__device__ __forceinline__ bf16_t f2bf(float f) { unsigned u = __float_as_uint(f); u += 0x7fffu + ((u >> 16) & 1u); return (bf16_t)(u >> 16); }
__device__ __forceinline__ float bf2f(bf16_t h) { return __uint_as_float(((unsigned)h) << 16); }
__device__ __forceinline__ unsigned pk2(float lo, float hi) { return (unsigned)f2bf(lo) | ((unsigned)f2bf(hi) << 16); }
__device__ __forceinline__ float sigmoidf_(float x) { return 1.f / (1.f + __expf(-x)); }
__device__ __forceinline__ float wave_sum(float v) {
#pragma unroll
    for (int m = 32; m >= 1; m >>= 1) v += __shfl_xor(v, m, 64);
    return v;
}
__device__ __forceinline__ float gelu_tanh(float x) {
    const float k0 = 0.7978845608028654f, k1 = 0.044715f;
    float u = k0 * (x + k1 * x * x * x);
    float t = 1.f - 2.f / (1.f + __expf(2.f * u));
    return 0.5f * x * (1.f + t);
}
__device__ __forceinline__ int otid() { int t = threadIdx.x; asm volatile("" : "+v"(t)); return t; }

#define XB_TMO      128
#define XB_XCNT(j)  (256  + 64 * (j))
#define XB_XSUB(j)  (1280 + 64 * (j))
#define XB_XGEN(j)  (2304 + 64 * (j))
#define XB_TOP      3328
#define XB_TOPGEN   3392
#define XCD_BAR_WORDS 3456
#define XB_SPIN_CAP (1u << 21)
#define LAS __attribute__((address_space(3)))

__device__ __forceinline__ unsigned xb_ld(unsigned* p)              { return __hip_atomic_load(p, __ATOMIC_RELAXED, __HIP_MEMORY_SCOPE_AGENT); }
__device__ __forceinline__ unsigned xb_add(unsigned* p, unsigned v) { return __hip_atomic_fetch_add(p, v, __ATOMIC_RELAXED, __HIP_MEMORY_SCOPE_AGENT); }
__device__ __forceinline__ unsigned xb_xcc_id() { return (unsigned)__builtin_amdgcn_s_getreg((3 << 11) | 20) & 0xFu; }
#define XB_SPIN(cond, bar) do { unsigned _sp = 0; while (cond) { __builtin_amdgcn_s_sleep(1); \
    if ((++_sp & 255u) == 0u) { if (xb_ld(&(bar)[XB_TMO])) break; if (_sp > XB_SPIN_CAP) { atomicAdd(&(bar)[XB_TMO], 1u); break; } } } } while (0)

struct XcdBarrier { unsigned* bar; unsigned x; volatile LAS unsigned* st; };

__device__ __forceinline__ XcdBarrier xcd_barrier_post(unsigned* bar, volatile LAS unsigned* st) {
    XcdBarrier b; b.bar = bar; b.x = xb_xcc_id(); b.st = st;
    if (threadIdx.x == 0) (void)xb_add(&bar[XB_XCNT(b.x)], 1u);
    return b;
}
__device__ __forceinline__ void xcd_barrier_complete(unsigned* bar, unsigned x, unsigned& nloc, unsigned& nx) {
    const unsigned G = gridDim.x * gridDim.y * gridDim.z;
    unsigned sum, cnt, mine, sp = 0u;
    for (;;) {
        sum = 0u; cnt = 0u; mine = 0u;
#pragma unroll
        for (unsigned j = 0; j < 16; ++j) { const unsigned c = xb_ld(&bar[XB_XCNT(j)]); sum += c; cnt += (c > 0u) ? 1u : 0u; mine = (j == x) ? c : mine; }
        if (sum == G) break;
        __builtin_amdgcn_s_sleep(1);
        if ((++sp & 255u) == 0u) { if (xb_ld(&bar[XB_TMO])) break; if (sp > XB_SPIN_CAP) { atomicAdd(&bar[XB_TMO], 1u); break; } }
    }
    nloc = mine > 0u ? mine : 1u; nx = cnt > 0u ? cnt : 1u;
}
__device__ __forceinline__ void xcd_barrier(const XcdBarrier& b) {
    asm volatile("s_waitcnt vmcnt(0)" ::: "memory");
    __syncthreads();
    if (threadIdx.x == 0) {
        unsigned* bar = b.bar;
        __builtin_amdgcn_s_waitcnt(0);
        unsigned nloc = b.st[0], nx = b.st[1];
        if (nloc == 0u) { xcd_barrier_complete(bar, b.x, nloc, nx); b.st[0] = nloc; b.st[1] = nx; }
        const unsigned old = xb_add(&bar[XB_XSUB(b.x)], 1u);
        const unsigned gen = old / nloc;
        if (old + 1u == (gen + 1u) * nloc) {
            __builtin_amdgcn_fence(__ATOMIC_RELEASE, "agent");
            asm volatile("s_waitcnt vmcnt(0)" ::: "memory");
            const unsigned og = xb_add(&bar[XB_TOP], 1u);
            const unsigned tg = og / nx;
            if (og + 1u == (tg + 1u) * nx) xb_add(&bar[XB_TOPGEN], 1u);
            else XB_SPIN(xb_ld(&bar[XB_TOPGEN]) == tg, bar);
            __builtin_amdgcn_fence(__ATOMIC_ACQUIRE, "agent");
            xb_add(&bar[XB_XGEN(b.x)], 1u);
            asm volatile("s_waitcnt vmcnt(0)" ::: "memory");
        } else {
            XB_SPIN(xb_ld(&bar[XB_XGEN(b.x)]) == gen, bar);
            __builtin_amdgcn_fence(__ATOMIC_ACQUIRE, "agent");
            asm volatile("s_waitcnt vmcnt(0)" ::: "memory");
        }
    }
    __syncthreads();
}

constexpr int G_LROW = 144;
constexpr int G_ASZ = 256 * G_LROW;
constexpr int G_BSZ = 128 * G_LROW;
constexpr int G_STAGE = G_ASZ + G_BSZ;
constexpr int G_ROWS_OFF = 2 * G_STAGE;

template <bool GATHER, class Epi>
__device__ __forceinline__ void gemm_tile(const bf16_t* __restrict__ A, long lda, int shift, int m0, const bf16_t* __restrict__ Bt, long ldb, int n0, int K,
                                          char* smem, Epi&& epi) {
    const int tid = otid(), lane = tid & 63, wave = tid >> 6, wr = wave >> 1, wc = wave & 1, fr = lane & 15, fq = lane >> 4;
    const int lrow = tid >> 3, lchunk = tid & 7;
    const int* sRow = (const int*)(smem + G_ROWS_OFF);
    const bf16_t* pa[4]; const bf16_t* pb[2];
#pragma unroll
    for (int i = 0; i < 4; ++i) {
        int r = lrow + 64 * i; long arow;
        if (GATHER) { int v = sRow[r]; arow = v < 0 ? 0 : (v >> shift); } else arow = m0 + r;
        pa[i] = A + arow * lda + lchunk * 8;
    }
#pragma unroll
    for (int i = 0; i < 2; ++i) pb[i] = Bt + (long)(n0 + lrow + 64 * i) * ldb + lchunk * 8;
    f32x4 acc[4][4];
#pragma unroll
    for (int m = 0; m < 4; ++m)
#pragma unroll
        for (int n = 0; n < 4; ++n) acc[m][n] = (f32x4){0.f, 0.f, 0.f, 0.f};
    u32x4 ra[4], rb[2];
    const int nk = K >> 6;
#pragma unroll
    for (int i = 0; i < 4; ++i) ra[i] = *(const u32x4*)(pa[i]);
#pragma unroll
    for (int i = 0; i < 2; ++i) rb[i] = *(const u32x4*)(pb[i]);
    {
        char* sa = smem; char* sb = smem + G_ASZ;
#pragma unroll
        for (int i = 0; i < 4; ++i) *(u32x4*)(sa + (lrow + 64 * i) * G_LROW + lchunk * 16) = ra[i];
#pragma unroll
        for (int i = 0; i < 2; ++i) *(u32x4*)(sb + (lrow + 64 * i) * G_LROW + lchunk * 16) = rb[i];
    }
    __syncthreads();
    for (int kt = 0; kt < nk; ++kt) {
        const bool more = (kt + 1 < nk);
        if (more) {
#pragma unroll
            for (int i = 0; i < 4; ++i) ra[i] = *(const u32x4*)(pa[i] + (kt + 1) * 64);
#pragma unroll
            for (int i = 0; i < 2; ++i) rb[i] = *(const u32x4*)(pb[i] + (kt + 1) * 64);
        }
        const char* sa = smem + (kt & 1) * G_STAGE; const char* sb = sa + G_ASZ;
#pragma unroll
        for (int ks = 0; ks < 2; ++ks) {
            bf16x8 af[4], bfr[4];
#pragma unroll
            for (int m = 0; m < 4; ++m) af[m] = *(const bf16x8*)(sa + (wr * 64 + m * 16 + fr) * G_LROW + (ks * 32 + fq * 8) * 2);
#pragma unroll
            for (int n = 0; n < 4; ++n) bfr[n] = *(const bf16x8*)(sb + (wc * 64 + n * 16 + fr) * G_LROW + (ks * 32 + fq * 8) * 2);
#pragma unroll
            for (int m = 0; m < 4; ++m)
#pragma unroll
                for (int n = 0; n < 4; ++n) acc[m][n] = __builtin_amdgcn_mfma_f32_16x16x32_bf16(af[m], bfr[n], acc[m][n], 0, 0, 0);
        }
        if (more) {
            char* wa = smem + ((kt + 1) & 1) * G_STAGE; char* wb = wa + G_ASZ;
#pragma unroll
            for (int i = 0; i < 4; ++i) *(u32x4*)(wa + (lrow + 64 * i) * G_LROW + lchunk * 16) = ra[i];
#pragma unroll
            for (int i = 0; i < 2; ++i) *(u32x4*)(wb + (lrow + 64 * i) * G_LROW + lchunk * 16) = rb[i];
        }
        __syncthreads();
    }
    epi(acc, wr * 64, n0 + wc * 64, fr, fq);
}

template <class Epi>
__device__ __forceinline__ void gemm_phase(const bf16_t* A, long lda, int M, const bf16_t* Bt, long ldb, int N, int K, char* smem, int bid, int nb, Epi&& epi) {
    const int ntn = N / 128, ntm = M / 256, nt = ntn * ntm;
    for (int t = bid; t < nt; t += nb) {
        const int mi = t / ntn, ni = t - mi * ntn;
        gemm_tile<false>(A, lda, 0, mi * 256, Bt, ldb, ni * 128, K, smem,
                         [&](f32x4 (&acc)[4][4], int rt0, int c0, int fr, int fq) { epi(acc, mi * 256 + rt0, c0, fr, fq); });
    }
}

__device__ __forceinline__ int colmap(int kind, int n, int nsrc) {
    if (kind == 0) return n < nsrc ? n : -1;
    if (kind == 1) { if (n < 1536) return n; if (n < 2048) return n + 16; if (n < 2064) return n - 512; return -1; }
    if (kind == 2) { if (n < 1792) return n; if (n < 6400) return n + 68; if (n < 6468) return n - 4608; return -1; }
    { const int grp = n >> 5, w = n & 31; return w < 16 ? grp * 16 + w : 1024 + grp * 16 + (w - 16); }
}
__device__ __forceinline__ void tconv_tile(const float* __restrict__ src, int sld, int nsrc, int kind, bf16_t* __restrict__ dst, int K, int n0, int k0, char* smem) {
    bf16_t* tile = (bf16_t*)smem;
    const int tid = otid();
    {
        const int nl = tid & 63, kk = tid >> 6;
        const int sc = colmap(kind, n0 + nl, nsrc);
#pragma unroll
        for (int i = 0; i < 8; ++i) {
            const int k = kk + 8 * i;
            const float v = sc >= 0 ? src[(long)(k0 + k) * sld + sc] : 0.f;
            tile[nl * 66 + k] = f2bf(v);
        }
    }
    __syncthreads();
    {
        const int n = tid >> 3, kc = tid & 7;
        const unsigned* tp = (const unsigned*)(tile + n * 66 + kc * 8);
        u32x4 w; w.x = tp[0]; w.y = tp[1]; w.z = tp[2]; w.w = tp[3];
        *(u32x4*)(dst + (long)(n0 + n) * K + k0 + kc * 8) = w;
    }
    __syncthreads();
}

__device__ __forceinline__ void conv_phase(const Params& p, char* smem, int bid, int nb) {
    char* ws = p.ws;
    constexpr int S0 = 128 * 32 * 16, S1 = S0 + 128 * 16 * 16, S2 = S1 + 2 * 34 * 16, S3 = S2 + 2 * 102 * 16, S4 = S3 + 2 * 16 * 16, S5 = S4 + 2 * 16 * 16,
                  S6 = S5 + 2 * 8 * 8, S7 = S6 + 4 * 2 * 16;
    for (int t = bid; t < S7; t += nb) {
        const float* src; bf16_t* dst; int sld, nsrc, kind, K, NT, loc;
        if (t < S0) { loc = t; const int mat = loc / (32 * 16); loc -= mat * 32 * 16; src = p.moe_w1 + (size_t)mat * 1024 * 2048; dst = (bf16_t*)(ws + OFF_WT_W1) + (size_t)mat * 2048 * 1024; sld = 2048; nsrc = 2048; kind = 3; K = 1024; NT = 32; }
        else if (t < S1) { loc = t - S0; const int mat = loc / 256; loc -= mat * 256; src = p.moe_w2 + (size_t)mat * 1024 * 1024; dst = (bf16_t*)(ws + OFF_WT_W2) + (size_t)mat * 1024 * 1024; sld = 1024; nsrc = 1024; kind = 0; K = 1024; NT = 16; }
        else if (t < S2) { loc = t - S1; const int mat = loc / (34 * 16); loc -= mat * 34 * 16; src = p.ev_w_in + (size_t)mat * 1024 * 2064; dst = (bf16_t*)(ws + OFF_WT_EVIN) + (size_t)mat * EV_N * 1024; sld = 2064; nsrc = 2064; kind = 1; K = 1024; NT = 34; }
        else if (t < S3) { loc = t - S2; const int mat = loc / (102 * 16); loc -= mat * 102 * 16; src = p.od_w_in + (size_t)mat * 1024 * 6468; dst = (bf16_t*)(ws + OFF_WT_ODIN) + (size_t)mat * OD_N * 1024; sld = 6468; nsrc = 6468; kind = 2; K = 1024; NT = 102; }
        else if (t < S4) { loc = t - S3; const int mat = loc / 256; loc -= mat * 256; src = p.ev_w_out + (size_t)mat * 1024 * 1024; dst = (bf16_t*)(ws + OFF_WT_EVOUT) + (size_t)mat * 1024 * 1024; sld = 1024; nsrc = 1024; kind = 0; K = 1024; NT = 16; }
        else if (t < S5) { loc = t - S4; const int mat = loc / 256; loc -= mat * 256; src = p.od_w_out + (size_t)mat * 1024 * 1024; dst = (bf16_t*)(ws + OFF_WT_ODOUT) + (size_t)mat * 1024 * 1024; sld = 1024; nsrc = 1024; kind = 0; K = 1024; NT = 16; }
        else if (t < S6) { loc = t - S5; const int mat = loc / 64; loc -= mat * 64; src = p.s5_w_glu + (size_t)mat * 512 * 512; dst = (bf16_t*)(ws + OFF_WT_GLU) + (size_t)mat * 512 * 512; sld = 512; nsrc = 512; kind = 0; K = 512; NT = 8; }
        else { loc = t - S6; const int mat = loc / 32; loc -= mat * 32; src = p.router_w + (size_t)mat * 1024 * 32; dst = (bf16_t*)(ws + OFF_WT_RT) + (size_t)mat * 128 * 1024; sld = 32; nsrc = 32; kind = 0; K = 1024; NT = 2; }
        const int kt = loc / NT, nt = loc - kt * NT;
        tconv_tile(src, sld, nsrc, kind, dst, K, nt * 64, kt * 64, smem);
    }
    {
        const float* x = p.x; bf16_t* xb = (bf16_t*)(ws + OFF_XB);
        const long nch = (long)T_ * 1024 / 8;
        for (long c = (long)bid * NTHR + otid(); c < nch; c += (long)nb * NTHR) {
            const f32x4 a = *(const f32x4*)(x + c * 8), b = *(const f32x4*)(x + c * 8 + 4);
            u32x4 w; w.x = pk2(a[0], a[1]); w.y = pk2(a[2], a[3]); w.z = pk2(b[0], b[1]); w.w = pk2(b[2], b[3]);
            *(u32x4*)(xb + c * 8) = w;
        }
    }
    if (bid == 0 && otid() < 128) ((int*)(ws + OFF_CNT))[otid()] = 0;
}

__device__ __forceinline__ void s5mat_unit(const Params& p, int j, int g, char* smem) {
    float* cre = (float*)smem;
    float* cim = cre + 1024;
    float* bbr = cim + 1024;
    float* bbi = bbr + 1024;
    float* pwr = bbi + 1024;
    float* pwi = pwr + 65 * 64;
    float* zr = pwi + 65 * 64;
    float* zi = zr + 64;
    float* Kd = zi + 64;
    const int tid = otid();
    const int jg = j * 32 + g;
    if (tid < 64) {
        const int pp = tid;
        const float lre = fminf(p.s5_a_re[jg * 64 + pp], -1e-4f), lim = p.s5_a_im[jg * 64 + pp];
        const float dt = expf(p.s5_log_dt[jg]);
        const float xr = lre * dt, th = lim * dt;
        const float mag = expf(xr);
        const float ar = mag * cosf(th), ai = mag * sinf(th);
        const float inv = 1.f / (lre * lre + lim * lim);
        zr[pp] = ((ar - 1.f) * lre + ai * lim) * inv;
        zi[pp] = (ai * lre - (ar - 1.f) * lim) * inv;
        const double thd = (double)th;
        for (int d = 0; d <= 64; ++d) {
            const float mg = expf((float)d * xr);
            double ang = (double)d * thd;
            const double kk = rint(ang * 0.15915494309189535);
            ang -= kk * 6.283185307179586;
            const float a = (float)ang;
            pwr[d * 64 + pp] = mg * cosf(a);
            pwi[d * 64 + pp] = mg * sinf(a);
        }
    }
    for (int e = tid; e < 1024; e += NTHR) {
        cre[e] = p.s5_c_re[(size_t)jg * 1024 + e];
        cim[e] = p.s5_c_im[(size_t)jg * 1024 + e];
    }
    __syncthreads();
    for (int e = tid; e < 1024; e += NTHR) {
        const int pp = e >> 4;
        const float br = p.s5_b_re[(size_t)jg * 1024 + e], bi = p.s5_b_im[(size_t)jg * 1024 + e];
        bbr[e] = zr[pp] * br - zi[pp] * bi;
        bbi[e] = zr[pp] * bi + zi[pp] * br;
    }
    __syncthreads();
    for (int e = tid; e < 64 * 256; e += NTHR) {
        const int d = e >> 8, n = (e >> 4) & 15, m = e & 15;
        float s = 0.f;
        for (int pp = 0; pp < 64; ++pp) {
            const float cr = cre[n * 64 + pp], ci = cim[n * 64 + pp], qr = pwr[d * 64 + pp], qi = pwi[d * 64 + pp];
            const float wr_ = cr * qr - ci * qi, wi_ = cr * qi + ci * qr;
            s += wr_ * bbr[pp * 16 + m] - wi_ * bbi[pp * 16 + m];
        }
        Kd[e] = s;
    }
    __syncthreads();
    bf16_t* TH = (bf16_t*)(p.ws + OFF_TH) + (size_t)jg * 1024 * UHW;
    for (int c = tid; c < 1024 * 144; c += NTHR) {
        const int row = c / 144, ch = c - row * 144;
        const int tau = row >> 4, n = row & 15;
        float v[8];
        if (ch < 128) {
            const int s = ch >> 1, m0 = (ch & 1) * 8;
            if (s <= tau) {
#pragma unroll
                for (int i = 0; i < 8; ++i) v[i] = Kd[(tau - s) * 256 + n * 16 + m0 + i];
            } else {
#pragma unroll
                for (int i = 0; i < 8; ++i) v[i] = 0.f;
            }
        } else {
            const int p0 = (ch - 128) * 4;
#pragma unroll
            for (int i = 0; i < 4; ++i) {
                const int pp = p0 + i;
                const float cr = cre[n * 64 + pp], ci = cim[n * 64 + pp], qr = pwr[(tau + 1) * 64 + pp], qi = pwi[(tau + 1) * 64 + pp];
                v[2 * i] = cr * qr - ci * qi;
                v[2 * i + 1] = -(cr * qi + ci * qr);
            }
        }
        u32x4 w; w.x = pk2(v[0], v[1]); w.y = pk2(v[2], v[3]); w.z = pk2(v[4], v[5]); w.w = pk2(v[6], v[7]);
        *(u32x4*)(TH + (size_t)row * UHW + ch * 8) = w;
    }
    bf16_t* GM = (bf16_t*)(p.ws + OFF_GM) + (size_t)jg * 128 * 1024;
    for (int c = tid; c < 128 * 128; c += NTHR) {
        const int row = c >> 7, ch = c & 127;
        const int pp = row >> 1, ri = row & 1;
        const int s = ch >> 1, m0 = (ch & 1) * 8;
        const float qr = pwr[(63 - s) * 64 + pp], qi = pwi[(63 - s) * 64 + pp];
        float v[8];
#pragma unroll
        for (int i = 0; i < 8; ++i) {
            const float br = bbr[pp * 16 + m0 + i], bi = bbi[pp * 16 + m0 + i];
            v[i] = ri == 0 ? (qr * br - qi * bi) : (qr * bi + qi * br);
        }
        u32x4 w; w.x = pk2(v[0], v[1]); w.y = pk2(v[2], v[3]); w.z = pk2(v[4], v[5]); w.w = pk2(v[6], v[7]);
        *(u32x4*)(GM + (size_t)row * 1024 + ch * 8) = w;
    }
    if (tid < 64) {
        float* A64 = (float*)(p.ws + OFF_A64) + (size_t)jg * 128;
        A64[tid * 2] = pwr[64 * 64 + tid];
        A64[tid * 2 + 1] = pwi[64 * 64 + tid];
    }
    __syncthreads();
}

__device__ __forceinline__ void epi_ev_in(const Params& p, f32x4 (&acc)[4][4], int row0, int c0, int fr, int fq) {
    char* ws = p.ws;
    bf16_t* PE = (bf16_t*)(ws + OFF_PE); bf16_t* UH = (bf16_t*)(ws + OFF_UH); float* GLR = (float*)(ws + OFF_GLR); bf16_t* VTE = (bf16_t*)(ws + OFF_VTE);
#pragma unroll
    for (int n = 0; n < 4; ++n) {
        const int cb = c0 + n * 16;
        const int col = cb + fr;
        if (cb < 1536) {
#pragma unroll
            for (int m = 0; m < 4; ++m) {
                const int t = row0 + m * 16 + fq * 4;
#pragma unroll
                for (int r = 0; r < 4; ++r) PE[(size_t)(t + r) * 1536 + col] = f2bf(acc[m][n][r]);
                if (cb >= 512 && cb < 1024) {
                    const int c = col - 512, h = c >> 7, vv = c & 127, b = t >> 14, pos = t & (L_ - 1);
                    u32x2 w; w.x = pk2(acc[m][n][0], acc[m][n][1]); w.y = pk2(acc[m][n][2], acc[m][n][3]);
                    *(u32x2*)(VTE + ((size_t)((b * 4 + h) * 128 + vv)) * L_ + pos) = w;
                }
            }
        } else if (cb < 2048) {
            const int ch = col - 1536, g = ch >> 4, mm = ch & 15;
#pragma unroll
            for (int m = 0; m < 4; ++m)
#pragma unroll
                for (int r = 0; r < 4; ++r) {
                    const int t = row0 + m * 16 + fq * 4 + r;
                    UH[((size_t)(t >> 6) * 32 + g) * UHW + (t & 63) * 16 + mm] = f2bf(acc[m][n][r]);
                }
        } else if (cb < 2064) {
#pragma unroll
            for (int m = 0; m < 4; ++m)
#pragma unroll
                for (int r = 0; r < 4; ++r) {
                    const int t = row0 + m * 16 + fq * 4 + r;
                    GLR[(size_t)t * 16 + (col - 2048)] = acc[m][n][r];
                }
        }
    }
}

__device__ __forceinline__ void gla_decay(const Params& p, int j, int t0, int h, float* sB) {
    const float* GLR = (const float*)(p.ws + OFF_GLR);
    const float* w2 = p.gla_w_gate2 + (size_t)j * 16 * 256;
    const float* b2 = p.gla_b_gate2 + (size_t)j * 256;
    const int tid = otid();
    for (int e = tid; e < 4096; e += NTHR) {
        const int tau = e >> 6, d = e & 63;
        float a = b2[h * 64 + d];
#pragma unroll
        for (int r = 0; r < 16; ++r) a += GLR[(size_t)(t0 + tau) * 16 + r] * w2[r * 256 + h * 64 + d];
        const float ls = fminf(a, 0.f) - log1pf(__expf(-fabsf(a)));
        sB[tau * 65 + d] = ls * (1.f / 16.f);
    }
    __syncthreads();
    if (tid < 64) { float run = 0.f; for (int tau = 0; tau < 64; ++tau) { run += sB[tau * 65 + tid]; sB[tau * 65 + tid] = run; } }
    __syncthreads();
}

__device__ __forceinline__ void gla_a_item(const Params& p, int j, int item, char* smem) {
    const int h = item & 3, c = (item >> 2) & 255, b = item >> 10;
    const int t0 = b * L_ + c * 64;
    float* sB = (float*)smem;
    bf16_t* AK = (bf16_t*)(smem + 16640);
    const bf16_t* PE = (const bf16_t*)(p.ws + OFF_PE);
    const bf16_t* VTE = (const bf16_t*)(p.ws + OFF_VTE);
    const int tid = otid(), lane = tid & 63, wave = tid >> 6, fr = lane & 15, fq = lane >> 4;
    gla_decay(p, j, t0, h, sB);
    for (int e = tid; e < 4096; e += NTHR) {
        const int tau = e >> 6, d = e & 63;
        const float k = bf2f(PE[(size_t)(t0 + tau) * 1536 + 256 + h * 64 + d]);
        AK[d * 72 + tau] = f2bf(k * __expf(sB[63 * 65 + d] - sB[tau * 65 + d]));
    }
    __syncthreads();
    const int dblk = wave >> 1, vb = (wave & 1) * 64;
    f32x4 acc[4];
#pragma unroll
    for (int n = 0; n < 4; ++n) acc[n] = (f32x4){0.f, 0.f, 0.f, 0.f};
#pragma unroll
    for (int ks = 0; ks < 2; ++ks) {
        const bf16x8 af = *(const bf16x8*)(AK + (dblk * 16 + fr) * 72 + ks * 32 + fq * 8);
#pragma unroll
        for (int n = 0; n < 4; ++n) {
            const int v = vb + n * 16 + fr;
            const bf16x8 bfr = *(const bf16x8*)(VTE + ((size_t)((b * 4 + h) * 128 + v)) * L_ + (c * 64 + ks * 32 + fq * 8));
            acc[n] = __builtin_amdgcn_mfma_f32_16x16x32_bf16(af, bfr, acc[n], 0, 0, 0);
        }
    }
    float* KV = (float*)(p.ws + OFF_KV) + ((size_t)((b * 256 + c) * 4 + h)) * 64 * 128;
#pragma unroll
    for (int n = 0; n < 4; ++n)
#pragma unroll
        for (int r = 0; r < 4; ++r) KV[(dblk * 16 + fq * 4 + r) * 128 + vb + n * 16 + fr] = acc[n][r];
    if (tid < 64) ((float*)(p.ws + OFF_DEC))[((size_t)((b * 256 + c) * 4 + h)) * 64 + tid] = __expf(sB[63 * 65 + tid]);
    __syncthreads();
}

__device__ __forceinline__ void scan_phase(const Params& p, int j, int bid) {
    const int gid = bid * NTHR + otid();
    if (gid < 65536) {
        const int v = gid & 127, d = (gid >> 7) & 63, h = (gid >> 13) & 3, b = gid >> 15;
        const float* KV = (const float*)(p.ws + OFF_KV); float* SST = (float*)(p.ws + OFF_SST); const float* DEC = (const float*)(p.ws + OFF_DEC);
        float S = 0.f;
        for (int c0 = 0; c0 < 256; c0 += 8) {
            float kv[8], dc[8];
#pragma unroll
            for (int i = 0; i < 8; ++i) {
                const size_t blk = (size_t)((b * 256 + c0 + i) * 4 + h);
                kv[i] = KV[(blk * 64 + d) * 128 + v]; dc[i] = DEC[blk * 64 + d];
            }
#pragma unroll
            for (int i = 0; i < 8; ++i) {
                const size_t blk = (size_t)((b * 256 + c0 + i) * 4 + h);
                SST[(blk * 64 + d) * 128 + v] = S;
                S = dc[i] * S + kv[i];
            }
        }
    } else if (gid < 65536 + 4096) {
        const int e = gid - 65536, pp = e & 63, g = (e >> 6) & 31, b = e >> 11;
        const float* A64 = (const float*)(p.ws + OFF_A64) + (size_t)(j * 32 + g) * 128;
        const float ar = A64[pp * 2], ai = A64[pp * 2 + 1];
        const float* GB = (const float*)(p.ws + OFF_GBUF); bf16_t* UH = (bf16_t*)(p.ws + OFF_UH);
        float hr = 0.f, hi = 0.f;
        for (int c0 = 0; c0 < 256; c0 += 8) {
            float gr[8], gi[8];
#pragma unroll
            for (int i = 0; i < 8; ++i) { const size_t row = (size_t)(b * 256 + c0 + i) * 32 + g; gr[i] = GB[row * 128 + 2 * pp]; gi[i] = GB[row * 128 + 2 * pp + 1]; }
#pragma unroll
            for (int i = 0; i < 8; ++i) {
                const size_t row = (size_t)(b * 256 + c0 + i) * 32 + g;
                *(unsigned*)(UH + row * UHW + 1024 + 2 * pp) = pk2(hr, hi);
                const float nr = ar * hr - ai * hi + gr[i], ni = ar * hi + ai * hr + gi[i];
                hr = nr; hi = ni;
            }
        }
    }
}

__device__ __forceinline__ void gla_c_item(const Params& p, int j, int item, char* smem) {
    const int h = item & 3, c = (item >> 2) & 255, b = item >> 10;
    const int t0 = b * L_ + c * 64;
    float* sB = (float*)smem;
    bf16_t* QT = (bf16_t*)(smem + 16640);
    bf16_t* KT = (bf16_t*)(smem + 16640 + 9216);
    bf16_t* ATT = (bf16_t*)(smem + 16640 + 18432);
    float* OS = (float*)(smem + 16640 + 27648);
    const bf16_t* PE = (const bf16_t*)(p.ws + OFF_PE);
    const bf16_t* VTE = (const bf16_t*)(p.ws + OFF_VTE);
    const int tid = otid(), lane = tid & 63, wave = tid >> 6, fr = lane & 15, fq = lane >> 4;
    gla_decay(p, j, t0, h, sB);
    for (int e = tid; e < 4096; e += NTHR) {
        const int tau = e >> 6, d = e & 63;
        const float bb = sB[tau * 65 + d];
        const float q = bf2f(PE[(size_t)(t0 + tau) * 1536 + h * 64 + d]);
        const float k = bf2f(PE[(size_t)(t0 + tau) * 1536 + 256 + h * 64 + d]);
        QT[tau * 72 + d] = f2bf(q * 0.125f * __expf(bb));
        KT[tau * 72 + d] = f2bf(k * __expf(-bb));
    }
    __syncthreads();
    const int iblk = wave >> 1;
    {
        f32x4 acc[2];
        acc[0] = (f32x4){0.f, 0.f, 0.f, 0.f}; acc[1] = acc[0];
#pragma unroll
        for (int ks = 0; ks < 2; ++ks) {
            const bf16x8 af = *(const bf16x8*)(QT + (iblk * 16 + fr) * 72 + ks * 32 + fq * 8);
#pragma unroll
            for (int n = 0; n < 2; ++n) {
                const int jb = (wave & 1) * 2 + n;
                const bf16x8 bfr = *(const bf16x8*)(KT + (jb * 16 + fr) * 72 + ks * 32 + fq * 8);
                acc[n] = __builtin_amdgcn_mfma_f32_16x16x32_bf16(af, bfr, acc[n], 0, 0, 0);
            }
        }
#pragma unroll
        for (int n = 0; n < 2; ++n) {
            const int jj = ((wave & 1) * 2 + n) * 16 + fr;
#pragma unroll
            for (int r = 0; r < 4; ++r) { const int ii = iblk * 16 + fq * 4 + r; ATT[ii * 72 + jj] = f2bf(jj <= ii ? acc[n][r] : 0.f); }
        }
    }
    __syncthreads();
    {
        const int vb = (wave & 1) * 64;
        const float* SST = (const float*)(p.ws + OFF_SST) + ((size_t)((b * 256 + c) * 4 + h)) * 64 * 128;
        f32x4 acc[4];
#pragma unroll
        for (int n = 0; n < 4; ++n) acc[n] = (f32x4){0.f, 0.f, 0.f, 0.f};
#pragma unroll
        for (int ks = 0; ks < 2; ++ks) {
            const bf16x8 af = *(const bf16x8*)(ATT + (iblk * 16 + fr) * 72 + ks * 32 + fq * 8);
            const bf16x8 aq = *(const bf16x8*)(QT + (iblk * 16 + fr) * 72 + ks * 32 + fq * 8);
#pragma unroll
            for (int n = 0; n < 4; ++n) {
                const int v = vb + n * 16 + fr;
                const bf16x8 bv = *(const bf16x8*)(VTE + ((size_t)((b * 4 + h) * 128 + v)) * L_ + (c * 64 + ks * 32 + fq * 8));
                acc[n] = __builtin_amdgcn_mfma_f32_16x16x32_bf16(af, bv, acc[n], 0, 0, 0);
                bf16x8 bs;
#pragma unroll
                for (int i = 0; i < 8; ++i) bs[i] = (short)f2bf(SST[(ks * 32 + fq * 8 + i) * 128 + v]);
                acc[n] = __builtin_amdgcn_mfma_f32_16x16x32_bf16(aq, bs, acc[n], 0, 0, 0);
            }
        }
#pragma unroll
        for (int n = 0; n < 4; ++n)
#pragma unroll
            for (int r = 0; r < 4; ++r) OS[(iblk * 16 + fq * 4 + r) * 132 + vb + n * 16 + fr] = acc[n][r];
    }
    __syncthreads();
    {
        const int i = tid >> 3, seg = tid & 7;
        float o[16]; float ss = 0.f;
#pragma unroll
        for (int q = 0; q < 16; ++q) { o[q] = OS[i * 132 + seg * 16 + q]; ss += o[q] * o[q]; }
        ss += __shfl_xor(ss, 1, 64); ss += __shfl_xor(ss, 2, 64); ss += __shfl_xor(ss, 4, 64);
        const float rs = rsqrtf(ss * (1.f / 128.f) + LN_EPS);
        const float* ng = p.gla_norm_g + (size_t)j * 128;
        bf16_t* CC = (bf16_t*)(p.ws + OFF_CC);
        const size_t t = (size_t)(t0 + i);
        unsigned w[8];
#pragma unroll
        for (int q = 0; q < 16; q += 2) {
            const int v0 = seg * 16 + q;
            const float r0 = bf2f(PE[t * 1536 + 1024 + h * 128 + v0]), r1 = bf2f(PE[t * 1536 + 1024 + h * 128 + v0 + 1]);
            const float a0 = o[q] * rs * ng[v0] * (r0 * sigmoidf_(r0)), a1 = o[q + 1] * rs * ng[v0 + 1] * (r1 * sigmoidf_(r1));
            w[q >> 1] = pk2(a0, a1);
        }
        u32x4 w0, w1; w0.x = w[0]; w0.y = w[1]; w0.z = w[2]; w0.w = w[3]; w1.x = w[4]; w1.y = w[5]; w1.z = w[6]; w1.w = w[7];
        *(u32x4*)(CC + t * 1024 + h * 128 + seg * 16) = w0;
        *(u32x4*)(CC + t * 1024 + h * 128 + seg * 16 + 8) = w1;
    }
    __syncthreads();
}

__device__ __forceinline__ void s5_g_phase(const Params& p, int j, char* smem, int bid, int nb) {
    const bf16_t* UH = (const bf16_t*)(p.ws + OFF_UH);
    float* GB = (float*)(p.ws + OFF_GBUF);
    for (int t = bid; t < 64; t += nb) {
        const int g = t >> 1, mi = t & 1;
        const bf16_t* Bt = (const bf16_t*)(p.ws + OFF_GM) + (size_t)(j * 32 + g) * 128 * 1024;
        gemm_tile<false>(UH + (size_t)g * UHW, (long)32 * UHW, 0, mi * 256, Bt, 1024, 0, 1024, smem,
            [&](f32x4 (&acc)[4][4], int rt0, int c0, int fr, int fq) {
#pragma unroll
                for (int m = 0; m < 4; ++m)
#pragma unroll
                    for (int n = 0; n < 4; ++n)
#pragma unroll
                        for (int r = 0; r < 4; ++r) {
                            const int row = mi * 256 + rt0 + m * 16 + fq * 4 + r;
                            GB[((size_t)row * 32 + g) * 128 + c0 + n * 16 + fr] = acc[m][n][r];
                        }
            });
    }
}
__device__ __forceinline__ void s5_y_phase(const Params& p, int j, char* smem, int bid, int nb) {
    const bf16_t* UH = (const bf16_t*)(p.ws + OFF_UH);
    bf16_t* YA = (bf16_t*)(p.ws + OFF_YA);
    const float* dsk = p.s5_d + (size_t)j * 512;
    for (int t = bid; t < 32 * 2 * 8; t += nb) {
        const int g = t >> 4, mi = (t >> 3) & 1, ni = t & 7;
        const bf16_t* Bt = (const bf16_t*)(p.ws + OFF_TH) + (size_t)(j * 32 + g) * 1024 * UHW;
        gemm_tile<false>(UH + (size_t)g * UHW, (long)32 * UHW, 0, mi * 256, Bt, UHW, ni * 128, UHW, smem,
            [&](f32x4 (&acc)[4][4], int rt0, int c0, int fr, int fq) {
#pragma unroll
                for (int m = 0; m < 4; ++m)
#pragma unroll
                    for (int n = 0; n < 4; ++n)
#pragma unroll
                        for (int r = 0; r < 4; ++r) {
                            const int row = mi * 256 + rt0 + m * 16 + fq * 4 + r;
                            const int col = c0 + n * 16 + fr;
                            const int tau = col >> 4, nn = col & 15, ch = g * 16 + nn;
                            const float u = bf2f(UH[((size_t)row * 32 + g) * UHW + col]);
                            const float y = gelu_tanh(acc[m][n][r] + dsk[ch] * u);
                            YA[((size_t)row * 64 + tau) * 512 + ch] = f2bf(y);
                        }
            });
    }
}

template <bool SLOTS>
__device__ __forceinline__ void ln_phase(const Params& p, const float* xin, const float* addb, const float* g, const float* bta, float* xout, bf16_t* xb, int bid, int nb) {
    const int lane = otid() & 63, wave = otid() >> 6;
    for (int t = bid * 8 + wave; t < T_; t += nb * 8) {
        f32x4 v[4];
        float s = 0.f;
#pragma unroll
        for (int i = 0; i < 4; ++i) {
            const int c = i * 256 + lane * 4;
            f32x4 a = *(const f32x4*)(xin + (size_t)t * 1024 + c);
            f32x4 m;
            if (SLOTS) {
                m = *(const f32x4*)(addb + ((size_t)t * 4 + 0) * 1024 + c);
                m += *(const f32x4*)(addb + ((size_t)t * 4 + 1) * 1024 + c);
                m += *(const f32x4*)(addb + ((size_t)t * 4 + 2) * 1024 + c);
                m += *(const f32x4*)(addb + ((size_t)t * 4 + 3) * 1024 + c);
            } else m = *(const f32x4*)(addb + (size_t)t * 1024 + c);
            v[i] = a * ALPHA + m;
            s += v[i][0] + v[i][1] + v[i][2] + v[i][3];
        }
        const float mu = wave_sum(s) * (1.f / 1024.f);
        float q = 0.f;
#pragma unroll
        for (int i = 0; i < 4; ++i) { v[i] -= mu; q += v[i][0] * v[i][0] + v[i][1] * v[i][1] + v[i][2] * v[i][2] + v[i][3] * v[i][3]; }
        const float rs = rsqrtf(wave_sum(q) * (1.f / 1024.f) + LN_EPS);
#pragma unroll
        for (int i = 0; i < 4; ++i) {
            const int c = i * 256 + lane * 4;
            const f32x4 gg = *(const f32x4*)(g + c), bb = *(const f32x4*)(bta + c);
            const f32x4 o = v[i] * rs * gg + bb;
            *(f32x4*)(xout + (size_t)t * 1024 + c) = o;
            if (xb) { u32x2 w; w.x = pk2(o[0], o[1]); w.y = pk2(o[2], o[3]); *(u32x2*)(xb + (size_t)t * 1024 + c) = w; }
        }
    }
}

__device__ __forceinline__ void topk_phase(const Params& p, int layer, int bid, int nb) {
    const float* LG = (const float*)(p.ws + OFF_LOGIT);
    int* cnt = (int*)(p.ws + OFF_CNT) + layer * 32;
    int* LIST = (int*)(p.ws + OFF_LIST);
    float* GATE = (float*)(p.ws + OFF_GATE);
    for (int t = bid * NTHR + otid(); t < T_; t += nb * NTHR) {
        float v0 = -INFINITY, v1 = -INFINITY, v2 = -INFINITY, v3 = -INFINITY; int i0 = 0, i1 = 0, i2 = 0, i3 = 0;
#pragma unroll
        for (int q = 0; q < 8; ++q) {
            const f32x4 l4 = *(const f32x4*)(LG + (size_t)t * 32 + q * 4);
#pragma unroll
            for (int r = 0; r < 4; ++r) {
                const float v = l4[r]; const int e = q * 4 + r;
                if (v > v0) { v3 = v2; i3 = i2; v2 = v1; i2 = i1; v1 = v0; i1 = i0; v0 = v; i0 = e; }
                else if (v > v1) { v3 = v2; i3 = i2; v2 = v1; i2 = i1; v1 = v; i1 = e; }
                else if (v > v2) { v3 = v2; i3 = i2; v2 = v; i2 = e; }
                else if (v > v3) { v3 = v; i3 = e; }
            }
        }
        const float e1 = __expf(v1 - v0), e2 = __expf(v2 - v0), e3 = __expf(v3 - v0);
        const float inv = 1.f / (1.f + e1 + e2 + e3);
        int pos;
        pos = atomicAdd(&cnt[i0], 1); LIST[(size_t)i0 * LISTCAP + pos] = t * 4 + 0; GATE[t * 4 + 0] = inv;
        pos = atomicAdd(&cnt[i1], 1); LIST[(size_t)i1 * LISTCAP + pos] = t * 4 + 1; GATE[t * 4 + 1] = e1 * inv;
        pos = atomicAdd(&cnt[i2], 1); LIST[(size_t)i2 * LISTCAP + pos] = t * 4 + 2; GATE[t * 4 + 2] = e2 * inv;
        pos = atomicAdd(&cnt[i3], 1); LIST[(size_t)i3 * LISTCAP + pos] = t * 4 + 3; GATE[t * 4 + 3] = e3 * inv;
    }
}

template <int WHICH>
__device__ __forceinline__ void moe_gemm_phase(const Params& p, int layer, char* smem, int bid, int nb) {
    const int* cnt = (const int*)(p.ws + OFF_CNT) + layer * 32;
    const int* LIST = (const int*)(p.ws + OFF_LIST);
    int* sRow = (int*)(smem + G_ROWS_OFF);
    constexpr int NTN = WHICH == 1 ? 16 : 8;
    int e = 0, base = 0, ce = cnt[0], mt = (ce + 255) >> 8;
    for (int t = bid;; t += nb) {
        while (e < 32 && t >= base + mt * NTN) { base += mt * NTN; ++e; if (e < 32) { ce = cnt[e]; mt = (ce + 255) >> 8; } }
        if (e >= 32) break;
        const int loc = t - base, mi = loc / NTN, ni = loc - mi * NTN;
        __syncthreads();
        if (otid() < 256) { const int r = mi * 256 + otid(); sRow[otid()] = r < ce ? LIST[(size_t)e * LISTCAP + r] : -1; }
        __syncthreads();
        if (WHICH == 1) {
            const bf16_t* Bt = (const bf16_t*)(p.ws + OFF_WT_W1) + (size_t)(layer * 32 + e) * 2048 * 1024;
            const float* b1 = p.moe_b1 + (size_t)(layer * 32 + e) * 2048;
            bf16_t* ACT = (bf16_t*)(p.ws + OFF_ACT);
            gemm_tile<true>((const bf16_t*)(p.ws + OFF_XB), 1024, 2, 0, Bt, 1024, ni * 128, 1024, smem,
                [&](f32x4 (&acc)[4][4], int rt0, int c0, int fr, int fq) {
#pragma unroll
                    for (int n = 0; n < 4; n += 2) {
                        const int gcol = ((c0 + n * 16) >> 5) * 16 + fr;
                        const float bg = b1[gcol], bl = b1[1024 + gcol];
#pragma unroll
                        for (int m = 0; m < 4; ++m)
#pragma unroll
                            for (int r = 0; r < 4; ++r) {
                                const int pair = sRow[rt0 + m * 16 + fq * 4 + r];
                                if (pair >= 0) {
                                    const float gl = fminf(acc[m][n][r] + bg, 7.f);
                                    const float li = fminf(fmaxf(acc[m][n + 1][r] + bl, -7.f), 7.f);
                                    const float a = gl * sigmoidf_(1.702f * gl) * (li + 1.f);
                                    ACT[(size_t)pair * 1024 + gcol] = f2bf(a);
                                }
                            }
                    }
                });
        } else {
            const bf16_t* Bt = (const bf16_t*)(p.ws + OFF_WT_W2) + (size_t)(layer * 32 + e) * 1024 * 1024;
            const float* b2 = p.moe_b2 + (size_t)(layer * 32 + e) * 1024;
            const float* GATE = (const float*)(p.ws + OFF_GATE);
            float* SLOT = (float*)(p.ws + OFF_SLOT);
            gemm_tile<true>((const bf16_t*)(p.ws + OFF_ACT), 1024, 0, 0, Bt, 1024, ni * 128, 1024, smem,
                [&](f32x4 (&acc)[4][4], int rt0, int c0, int fr, int fq) {
#pragma unroll
                    for (int m = 0; m < 4; ++m)
#pragma unroll
                        for (int r = 0; r < 4; ++r) {
                            const int pair = sRow[rt0 + m * 16 + fq * 4 + r];
                            if (pair >= 0) {
                                const float gt = GATE[pair];
#pragma unroll
                                for (int n = 0; n < 4; ++n) { const int col = c0 + n * 16 + fr; SLOT[(size_t)pair * 1024 + col] = (acc[m][n][r] + b2[col]) * gt; }
                            }
                        }
                });
        }
    }
}

__device__ __forceinline__ void epi_od_in(const Params& p, f32x4 (&acc)[4][4], int row0, int c0, int fr, int fq) {
    char* ws = p.ws;
    bf16_t* PO = (bf16_t*)(ws + OFF_PO); float* WI = (float*)(ws + OFF_WI); bf16_t* VTC = (bf16_t*)(ws + OFF_VTC); bf16_t* VTD = (bf16_t*)(ws + OFF_VTD);
#pragma unroll
    for (int n = 0; n < 4; ++n) {
        const int cb = c0 + n * 16, col = cb + fr;
        if (cb < 6464) {
#pragma unroll
            for (int m = 0; m < 4; ++m) {
                const int t = row0 + m * 16 + fq * 4;
#pragma unroll
                for (int r = 0; r < 4; ++r) PO[(size_t)(t + r) * OD_N + col] = f2bf(acc[m][n][r]);
                const int b = t >> 14, pos = t & (L_ - 1);
                if (cb >= 1024 && cb < 1536) {
                    const int c = col - 1024, hd = c >> 6, d = c & 63;
                    u32x2 w; w.x = pk2(acc[m][n][0], acc[m][n][1]); w.y = pk2(acc[m][n][2], acc[m][n][3]);
                    *(u32x2*)(VTC + ((size_t)((b * 8 + hd) * 64 + d)) * L_ + pos) = w;
                } else if (cb >= 4864 && cb < 6400) {
                    const int c = col - 4864, g = c >> 9, hd = (c >> 6) & 7, d = c & 63;
                    bf16_t* vrow = VTD + ((size_t)(((b * 3 + g) * 8 + hd) * 64 + d)) * L_;
                    if (g == 0) {
                        u32x2 w; w.x = pk2(acc[m][n][0], acc[m][n][1]); w.y = pk2(acc[m][n][2], acc[m][n][3]);
                        *(u32x2*)(vrow + pos) = w;
                    } else {
                        const int sh = g == 1 ? 2 : 4, ld = L_ >> sh;
#pragma unroll
                        for (int r = 0; r < 4; ++r) { const int ps = pos + r; vrow[(ps & ((1 << sh) - 1)) * ld + (ps >> sh)] = f2bf(acc[m][n][r]); }
                    }
                }
            }
        } else if (cb < 6480) {
            if (fr < 4) {
#pragma unroll
                for (int m = 0; m < 4; ++m)
#pragma unroll
                    for (int r = 0; r < 4; ++r) WI[(size_t)(row0 + m * 16 + fq * 4 + r) * 4 + fr] = acc[m][n][r];
            }
        }
    }
}

__device__ __forceinline__ void idx_scores(const bf16_t* __restrict__ PO, int b, int keybase, const bf16x8 (&qf)[4][4], const float (&wi)[4], int lane, float (&sc)[16]) {
    const int r = lane & 31, h2 = lane >> 5;
    const bf16_t* kp = PO + (size_t)(b * L_ + keybase + r) * OD_N + OD_KI + h2 * 8;
    bf16x8 kf[4];
#pragma unroll
    for (int s = 0; s < 4; ++s) kf[s] = *(const bf16x8*)(kp + s * 16);
#pragma unroll
    for (int i = 0; i < 16; ++i) sc[i] = 0.f;
#pragma unroll
    for (int hd = 0; hd < 4; ++hd) {
        f32x16 a;
#pragma unroll
        for (int i = 0; i < 16; ++i) a[i] = 0.f;
#pragma unroll
        for (int s = 0; s < 4; ++s) a = __builtin_amdgcn_mfma_f32_32x32x16_bf16(kf[s], qf[hd][s], a, 0, 0, 0);
#pragma unroll
        for (int i = 0; i < 16; ++i) sc[i] += wi[hd] * fmaxf(a[i], 0.f);
    }
}
__device__ __forceinline__ unsigned ord_key(float s) {
    unsigned u = __float_as_uint(s);
    if (u == 0x80000000u) u = 0u;
    return (u & 0x80000000u) ? ~u : (u | 0x80000000u);
}

__device__ __forceinline__ void dsa_select_item(const Params& p, int b, int qb, char* smem) {
    unsigned* hist = (unsigned*)smem;
    unsigned* pref = (unsigned*)(smem + 65536);
    int* krem = (int*)(smem + 65536 + 256);
    unsigned* GW = (unsigned*)(smem + 65536 + 512);
    unsigned* EW = (unsigned*)(smem + 65536 + 512 + 1024);
    const bf16_t* PO = (const bf16_t*)(p.ws + OFF_PO);
    const float* WI = (const float*)(p.ws + OFF_WI);
    unsigned* BM32 = (unsigned*)(p.ws + OFF_BM);
    const int tid = otid(), lane = tid & 63, wave = tid >> 6, kw = wave >> 1, qw = wave & 1, h2 = lane >> 5;
    const int p0 = qb * 64;
    const int ql = qw * 32 + (lane & 31);
    const int qpos = p0 + ql;
    const size_t tq = (size_t)b * L_ + qpos;
    const int nkt = (p0 + 64 + 127) >> 7;
    bf16x8 qf[4][4]; float wi[4];
#pragma unroll
    for (int hd = 0; hd < 4; ++hd) {
        wi[hd] = WI[tq * 4 + hd];
#pragma unroll
        for (int s = 0; s < 4; ++s) qf[hd][s] = *(const bf16x8*)(PO + tq * OD_N + OD_QI + hd * 64 + s * 16 + h2 * 8);
    }
    for (int e = tid; e < 64 * 256; e += NTHR) hist[e] = 0u;
    if (tid < 64) { pref[tid] = 0u; krem[tid] = 256; }
    __syncthreads();
    const bool selall = qpos < 256;
    if (p0 + 63 >= 256) {
        for (int pass = 0; pass < 4; ++pass) {
            const int sh = 24 - 8 * pass;
            const unsigned mypref = pref[ql];
            for (int kt = 0; kt < nkt; ++kt) {
                float sc[16];
                const int keybase = kt * 128 + kw * 32;
                idx_scores(PO, b, keybase, qf, wi, lane, sc);
#pragma unroll
                for (int i = 0; i < 16; ++i) {
                    const int key = keybase + (i & 3) + 8 * (i >> 2) + 4 * h2;
                    const unsigned k32 = ord_key(sc[i]);
                    const bool match = pass == 0 ? true : ((k32 >> (sh + 8)) == mypref);
                    if (key <= qpos && !selall && match) atomicAdd(&hist[ql * 256 + ((k32 >> sh) & 255u)], 1u);
                }
            }
            __syncthreads();
            if (tid < 64 && (p0 + tid) >= 256) {
                int need = krem[tid]; unsigned cum = 0; int dg = 255;
                for (; dg > 0; --dg) { const unsigned c = hist[tid * 256 + dg]; if (cum + c >= (unsigned)need) break; cum += c; }
                pref[tid] = (pref[tid] << 8) | (unsigned)dg;
                krem[tid] = need - (int)cum;
            }
            __syncthreads();
            for (int e = tid; e < 64 * 256; e += NTHR) hist[e] = 0u;
            __syncthreads();
        }
    }
    const unsigned TK = pref[ql];
    int ceq = 0;
    const int rsel = tid < 64 ? krem[tid] : 0;
    for (int kt = 0; kt < nkt; ++kt) {
        float sc[16];
        const int keybase = kt * 128 + kw * 32;
        idx_scores(PO, b, keybase, qf, wi, lane, sc);
        unsigned gw = 0u, ew = 0u;
#pragma unroll
        for (int i = 0; i < 16; ++i) {
            const int ko = (i & 3) + 8 * (i >> 2) + 4 * h2;
            const int key = keybase + ko;
            const unsigned k32 = ord_key(sc[i]);
            const bool valid = key <= qpos;
            const bool g = valid && (selall || k32 > TK);
            const bool e = valid && !selall && k32 == TK;
            gw |= (g ? 1u : 0u) << ko; ew |= (e ? 1u : 0u) << ko;
        }
        gw |= __shfl_xor(gw, 32, 64); ew |= __shfl_xor(ew, 32, 64);
        if (h2 == 0) { GW[ql * 4 + kw] = gw; EW[ql * 4 + kw] = ew; }
        __syncthreads();
        if (tid < 64) {
            unsigned g4[4], e4[4];
#pragma unroll
            for (int w = 0; w < 4; ++w) { g4[w] = GW[tid * 4 + w]; e4[w] = EW[tid * 4 + w]; }
            int need = rsel - ceq; if (need < 0) need = 0;
#pragma unroll
            for (int w = 0; w < 4; ++w) {
                const int pc = __popc(e4[w]);
                ceq += pc;
                if (need >= pc) need -= pc;
                else { unsigned m = e4[w], kept = 0u; for (int k = 0; k < need; ++k) { const unsigned low = m & (0u - m); kept |= low; m ^= low; } e4[w] = kept; need = 0; }
                g4[w] |= e4[w];
            }
            u32x4 o; o.x = g4[0]; o.y = g4[1]; o.z = g4[2]; o.w = g4[3];
            *(u32x4*)(BM32 + ((size_t)b * L_ + p0 + tid) * 512 + kt * 4) = o;
        }
        __syncthreads();
    }
}

template <int MODE, int NQT>
__device__ __forceinline__ void attn_wave(const Params& p, int b, int head, int qcol, int kcol, const bf16_t* __restrict__ VT, int voff,
                                          int i0, int sh  , int rho, int kt_lo, int kt_hi, int grp) {
    const bf16_t* PO = (const bf16_t*)(p.ws + OFF_PO);
    const unsigned* BM32 = (const unsigned*)(p.ws + OFF_BM);
    const int lane = otid() & 63, r = lane & 31, h2 = lane >> 5;
    const int pr = (r & 0x13) | ((r & 4) << 1) | ((r & 8) >> 1);
    const float SC = 0.125f * 1.4426950408889634f;
    bf16x8 qf[NQT][4]; size_t tq[NQT]; int qi[NQT];
#pragma unroll
    for (int qt = 0; qt < NQT; ++qt) {
        qi[qt] = i0 + qt * 32 + r;
        tq[qt] = (size_t)b * L_ + ((size_t)qi[qt] << sh) + rho;
#pragma unroll
        for (int s = 0; s < 4; ++s) qf[qt][s] = *(const bf16x8*)(PO + tq[qt] * OD_N + qcol + head * 64 + s * 16 + h2 * 8);
    }
    f32x16 oacc[NQT][2];
#pragma unroll
    for (int a = 0; a < NQT; ++a)
#pragma unroll
        for (int c = 0; c < 2; ++c)
#pragma unroll
            for (int i = 0; i < 16; ++i) oacc[a][c][i] = 0.f;
    float mrun[NQT], lrun[NQT];
#pragma unroll
    for (int a = 0; a < NQT; ++a) { mrun[a] = -1e30f; lrun[a] = 0.f; }
    bf16x8 kf[4]; unsigned mw[NQT];
    auto load_k = [&](int kt, bf16x8 (&k_)[4], unsigned (&m_)[NQT]) {
        const size_t krow = (size_t)b * L_ + ((size_t)(kt * 32 + pr) << sh) + rho;
#pragma unroll
        for (int s = 0; s < 4; ++s) k_[s] = *(const bf16x8*)(PO + krow * OD_N + kcol + head * 64 + s * 16 + h2 * 8);
#pragma unroll
        for (int a = 0; a < NQT; ++a) m_[a] = MODE == 0 ? BM32[tq[a] * 512 + kt] : 0u;
    };
    load_k(kt_lo, kf, mw);
#pragma unroll 1
    for (int kt = kt_lo; kt <= kt_hi; ++kt) {
        bf16x8 vf[2][2];
#pragma unroll
        for (int db = 0; db < 2; ++db)
#pragma unroll
            for (int s2 = 0; s2 < 2; ++s2) vf[db][s2] = *(const bf16x8*)(VT + (size_t)(db * 32 + r) * L_ + voff + kt * 32 + s2 * 16 + h2 * 8);
        bf16x8 kn[4]; unsigned mn[NQT];
#pragma unroll
        for (int a = 0; a < NQT; ++a) mn[a] = 0u;
        if (kt < kt_hi) load_k(kt + 1, kn, mn);
#pragma unroll
        for (int qt = 0; qt < NQT; ++qt) {
            f32x16 s;
#pragma unroll
            for (int i = 0; i < 16; ++i) s[i] = 0.f;
#pragma unroll
            for (int ks = 0; ks < 4; ++ks) s = __builtin_amdgcn_mfma_f32_32x32x16_bf16(kf[ks], qf[qt][ks], s, 0, 0, 0);
            unsigned selm = 0u; float mx = -1e30f;
#pragma unroll
            for (int i = 0; i < 16; ++i) {
                const int ko = 16 * (i >> 3) + 8 * h2 + 4 * ((i >> 2) & 1) + (i & 3);
                bool sl;
                if (MODE == 0) sl = (mw[qt] >> ko) & 1u;
                else { const int kk = kt * 32 + ko; sl = (kk <= qi[qt]) && (kk >= qi[qt] - 128); }
                selm |= (sl ? 1u : 0u) << i;
                s[i] = sl ? s[i] * SC : -1e30f;
                mx = fmaxf(mx, s[i]);
            }
            mx = fmaxf(mx, __shfl_xor(mx, 32, 64));
            const float mnew = fmaxf(mrun[qt], mx);
            const float corr = __builtin_amdgcn_exp2f(mrun[qt] - mnew);
            mrun[qt] = mnew;
            float ps = 0.f;
#pragma unroll
            for (int i = 0; i < 16; ++i) { s[i] = ((selm >> i) & 1u) ? __builtin_amdgcn_exp2f(s[i] - mnew) : 0.f; ps += s[i]; }
            lrun[qt] = lrun[qt] * corr + ps;
#pragma unroll
            for (int db = 0; db < 2; ++db)
#pragma unroll
                for (int i = 0; i < 16; ++i) oacc[qt][db][i] *= corr;
#pragma unroll
            for (int s2 = 0; s2 < 2; ++s2) {
                bf16x8 pf;
#pragma unroll
                for (int jj = 0; jj < 8; ++jj) pf[jj] = (short)f2bf(s[8 * s2 + jj]);
#pragma unroll
                for (int db = 0; db < 2; ++db) oacc[qt][db] = __builtin_amdgcn_mfma_f32_32x32x16_bf16(vf[db][s2], pf, oacc[qt][db], 0, 0, 0);
            }
        }
        if (kt < kt_hi) {
#pragma unroll
            for (int s = 0; s < 4; ++s) kf[s] = kn[s];
#pragma unroll
            for (int a = 0; a < NQT; ++a) mw[a] = mn[a];
        }
    }
#pragma unroll
    for (int qt = 0; qt < NQT; ++qt) {
        const float lt = lrun[qt] + __shfl_xor(lrun[qt], 32, 64);
        const float inv = 1.f / lt;
        if (MODE == 0) {
            bf16_t* CC = (bf16_t*)(p.ws + OFF_CC);
#pragma unroll
            for (int db = 0; db < 2; ++db)
#pragma unroll
                for (int i = 0; i < 16; ++i) {
                    const int d = db * 32 + (i & 3) + 8 * (i >> 2) + 4 * h2;
                    CC[tq[qt] * 1024 + head * 64 + d] = f2bf(oacc[qt][db][i] * inv);
                }
        } else {
            float* OD = (float*)(p.ws + OFF_OD) + (size_t)grp * T_ * 512;
#pragma unroll
            for (int db = 0; db < 2; ++db)
#pragma unroll
                for (int i = 0; i < 16; ++i) {
                    const int d = db * 32 + (i & 3) + 8 * (i >> 2) + 4 * h2;
                    OD[tq[qt] * 512 + head * 64 + d] = oacc[qt][db][i] * inv;
                }
            if (h2 == 0) ((float*)(p.ws + OFF_LSE))[((size_t)grp * T_ + tq[qt]) * 8 + head] = mrun[qt] + log2f(lt);
        }
    }
}

__device__ __forceinline__ void dil_combine_phase(const Params& p, int bid, int nb) {
    const float* OD = (const float*)(p.ws + OFF_OD); const float* LSE = (const float*)(p.ws + OFF_LSE);
    bf16_t* CC = (bf16_t*)(p.ws + OFF_CC);
    const long n = (long)T_ * 128;
    for (long c = (long)bid * NTHR + otid(); c < n; c += (long)nb * NTHR) {
        const long t = c >> 7; const int ch = (int)(c & 127) * 4, hd = ch >> 6;
        const float l0 = LSE[((size_t)0 * T_ + t) * 8 + hd], l1 = LSE[((size_t)1 * T_ + t) * 8 + hd], l2 = LSE[((size_t)2 * T_ + t) * 8 + hd];
        const float mx = fmaxf(l0, fmaxf(l1, l2));
        const float w0 = exp2f(l0 - mx), w1 = exp2f(l1 - mx), w2 = exp2f(l2 - mx);
        const float inv = 1.f / (w0 + w1 + w2);
        const f32x4 a = *(const f32x4*)(OD + ((size_t)0 * T_ + t) * 512 + ch), bq = *(const f32x4*)(OD + ((size_t)1 * T_ + t) * 512 + ch),
                    cq = *(const f32x4*)(OD + ((size_t)2 * T_ + t) * 512 + ch);
        const f32x4 o = (a * w0 + bq * w1 + cq * w2) * inv;
        u32x2 w; w.x = pk2(o[0], o[1]); w.y = pk2(o[2], o[3]);
        *(u32x2*)(CC + (size_t)t * 1024 + 512 + ch) = w;
    }
}

enum { K_PRO = 0, K_E1, K_E2, K_E3, K_E4, K_E5, K_E6, K_LN1, K_O1, K_O2, K_O3, K_O4, K_M1, K_M2, K_M3, K_M4, K_LN2, K_COUNT };

template <int KIND>
__device__ __forceinline__ void run_phase(const Params& p, int layer, char* smem, int bid, int nb) {
    char* ws = p.ws;
    const int j = layer >> 1;
    if (KIND == K_PRO) {
        for (int u = bid; u < 64; u += nb) s5mat_unit(p, u >> 5, u & 31, smem);
        conv_phase(p, smem, bid, nb);
    } else if (KIND == K_E1) {
        gemm_phase((const bf16_t*)(ws + OFF_XB), 1024, T_, (const bf16_t*)(ws + OFF_WT_EVIN) + (size_t)j * EV_N * 1024, 1024, EV_N, 1024, smem, bid, nb,
                   [&](f32x4 (&acc)[4][4], int row0, int c0, int fr, int fq) { epi_ev_in(p, acc, row0, c0, fr, fq); });
    } else if (KIND == K_E2) {
        for (int it = bid; it < 2048; it += nb) gla_a_item(p, j, it, smem);
        s5_g_phase(p, j, smem, bid, nb);
    } else if (KIND == K_E3) {
        scan_phase(p, j, bid);
    } else if (KIND == K_E4) {
        for (int it = bid; it < 2048; it += nb) gla_c_item(p, j, it, smem);
        s5_y_phase(p, j, smem, bid, nb);
    } else if (KIND == K_E5) {
        const bf16_t* YA = (const bf16_t*)(ws + OFF_YA); bf16_t* CC = (bf16_t*)(ws + OFF_CC); const float* bg = p.s5_b_glu + (size_t)j * 512;
        gemm_phase(YA, 512, T_, (const bf16_t*)(ws + OFF_WT_GLU) + (size_t)j * 512 * 512, 512, 512, 512, smem, bid, nb,
                   [&](f32x4 (&acc)[4][4], int row0, int c0, int fr, int fq) {
#pragma unroll
                       for (int m = 0; m < 4; ++m)
#pragma unroll
                           for (int n = 0; n < 4; ++n)
#pragma unroll
                               for (int r = 0; r < 4; ++r) {
                                   const size_t t = (size_t)(row0 + m * 16 + fq * 4 + r); const int col = c0 + n * 16 + fr;
                                   const float y = bf2f(YA[t * 512 + col]);
                                   CC[t * 1024 + 512 + col] = f2bf(y * sigmoidf_(acc[m][n][r] + bg[col]));
                               }
                   });
    } else if (KIND == K_E6 || KIND == K_O4) {
        float* MIX = (float*)(ws + OFF_MIX);
        const bf16_t* W = (const bf16_t*)(ws + (KIND == K_E6 ? OFF_WT_EVOUT : OFF_WT_ODOUT)) + (size_t)j * 1024 * 1024;
        gemm_phase((const bf16_t*)(ws + OFF_CC), 1024, T_, W, 1024, 1024, 1024, smem, bid, nb,
                   [&](f32x4 (&acc)[4][4], int row0, int c0, int fr, int fq) {
#pragma unroll
                       for (int m = 0; m < 4; ++m)
#pragma unroll
                           for (int n = 0; n < 4; ++n)
#pragma unroll
                               for (int r = 0; r < 4; ++r) MIX[(size_t)(row0 + m * 16 + fq * 4 + r) * 1024 + c0 + n * 16 + fr] = acc[m][n][r];
                   });
    } else if (KIND == K_LN1) {
        const float* xin = layer == 0 ? p.x : (const float*)(ws + OFF_XR);
        ln_phase<false>(p, xin, (const float*)(ws + OFF_MIX), p.ln1_g + (size_t)layer * 1024, p.ln1_b + (size_t)layer * 1024, (float*)(ws + OFF_XR), (bf16_t*)(ws + OFF_XB), bid, nb);
    } else if (KIND == K_O1) {
        gemm_phase((const bf16_t*)(ws + OFF_XB), 1024, T_, (const bf16_t*)(ws + OFF_WT_ODIN) + (size_t)j * OD_N * 1024, 1024, OD_N, 1024, smem, bid, nb,
                   [&](f32x4 (&acc)[4][4], int row0, int c0, int fr, int fq) { epi_od_in(p, acc, row0, c0, fr, fq); });
    } else if (KIND == K_O2) {
        for (int k = bid; k < 256; k += nb) {
            dsa_select_item(p, k & 1, k >> 1, smem);
            __syncthreads();
            const int k2 = 511 - k;
            dsa_select_item(p, k2 & 1, k2 >> 1, smem);
            __syncthreads();
        }
        const int head = otid() >> 6;
        for (int it = bid; it < 1536; it += nb) {
            const int b = it / 768, rem = it - b * 768, g = rem >> 8, u = rem & 255;
            const int sh = g * 2, per = 256 >> sh, rho = u / per, qblk = u - rho * per;
            const bf16_t* VT = (const bf16_t*)(ws + OFF_VTD) + ((size_t)((b * 3 + g) * 8 + head)) * 64 * L_;
#pragma unroll 1
            for (int hf = 0; hf < 2; ++hf) {
                const int hi = 2 * qblk + hf, lo = hi - 4;
                attn_wave<1, 1>(p, b, head, OD_DIL + g * 512, OD_DIL + 1536 + g * 512, VT, rho * (L_ >> sh), qblk * 64 + hf * 32, sh, rho, lo < 0 ? 0 : lo, hi, g);
            }
        }
    } else if (KIND == K_O3) {
        const int head = otid() >> 6;
        for (int k = bid; k < 256; k += nb) {
#pragma unroll 1
            for (int half = 0; half < 4; ++half) {
                const int I = (half >> 1) == 0 ? k : 511 - k, b = I & 1, qb = I >> 1, hf = half & 1;
                const bf16_t* VT = (const bf16_t*)(ws + OFF_VTC) + ((size_t)(b * 8 + head)) * 64 * L_;
                attn_wave<0, 1>(p, b, head, 0, 512, VT, 0, qb * 64 + hf * 32, 0, 0, 0, 2 * qb + hf, 0);
            }
        }
        dil_combine_phase(p, bid, nb);
    } else if (KIND == K_M1) {
        float* LG = (float*)(ws + OFF_LOGIT); const float* rb = p.router_b + (size_t)layer * 32;
        gemm_phase((const bf16_t*)(ws + OFF_XB), 1024, T_, (const bf16_t*)(ws + OFF_WT_RT) + (size_t)layer * 128 * 1024, 1024, 128, 1024, smem, bid, nb,
                   [&](f32x4 (&acc)[4][4], int row0, int c0, int fr, int fq) {
#pragma unroll
                       for (int n = 0; n < 2; ++n) {
                           const int col = c0 + n * 16 + fr;
                           if (col < 32) {
#pragma unroll
                               for (int m = 0; m < 4; ++m)
#pragma unroll
                                   for (int r = 0; r < 4; ++r) LG[(size_t)(row0 + m * 16 + fq * 4 + r) * 32 + col] = acc[m][n][r] + rb[col];
                           }
                       }
                   });
    } else if (KIND == K_M2) {
        topk_phase(p, layer, bid, nb);
    } else if (KIND == K_M3) {
        moe_gemm_phase<1>(p, layer, smem, bid, nb);
    } else if (KIND == K_M4) {
        moe_gemm_phase<2>(p, layer, smem, bid, nb);
    } else if (KIND == K_LN2) {
        float* xo = layer == 3 ? p.out : (float*)(ws + OFF_XR);
        ln_phase<true>(p, (const float*)(ws + OFF_XR), (const float*)(ws + OFF_SLOT), p.ln2_g + (size_t)layer * 1024, p.ln2_b + (size_t)layer * 1024, xo,
                       layer == 3 ? (bf16_t*)nullptr : (bf16_t*)(ws + OFF_XB), bid, nb);
    }
}

extern __shared__ __attribute__((aligned(16))) char dyn_smem[];

#if !MEGA
template <int KIND>
__global__ void __launch_bounds__(NTHR, 2) k_phase(Params p, int layer) { run_phase<KIND>(p, layer, dyn_smem, blockIdx.x, gridDim.x); }
#else
#define PHASE(K) do { run_phase<K>(p, layer, smem, bid, nb); xcd_barrier(bar); } while (0)
template <int LAYER>
__device__ __forceinline__ void mega_layer(const Params& p, char* smem, int bid, int nb, const XcdBarrier& bar) {
    constexpr int layer = LAYER;
    if ((layer & 1) == 0) { PHASE(K_E1); PHASE(K_E2); PHASE(K_E3); PHASE(K_E4); PHASE(K_E5); PHASE(K_E6); }
    else { PHASE(K_O1); PHASE(K_O2); PHASE(K_O3); PHASE(K_O4); }
    PHASE(K_LN1); PHASE(K_M1); PHASE(K_M2); PHASE(K_M3); PHASE(K_M4);
    run_phase<K_LN2>(p, layer, smem, bid, nb);
    if (layer < 3) xcd_barrier(bar);
}
__global__ void __launch_bounds__(NTHR, 2) k_mega(Params p) {
    char* smem = dyn_smem;
    const int bid = blockIdx.x, nb = gridDim.x;
    volatile LAS unsigned* st = (volatile LAS unsigned*)(dyn_smem + LDS_BYTES - 16);
    if (otid() == 0) { st[0] = 0u; st[1] = 0u; }
    __syncthreads();
    XcdBarrier bar = xcd_barrier_post((unsigned*)(p.ws + OFF_BAR), st);
    { const int layer = 0; PHASE(K_PRO); }
    mega_layer<0>(p, smem, bid, nb, bar);
    mega_layer<1>(p, smem, bid, nb, bar);
    mega_layer<2>(p, smem, bid, nb, bar);
    mega_layer<3>(p, smem, bid, nb, bar);
}
#endif

extern "C" void kernel_launch(void* const* d_in, const int* in_sizes, int n_in, void* d_out, int out_size, void* d_ws, size_t ws_size, hipStream_t stream) {
    Params p{};
    const float** f = (const float**)&p;
    for (int i = 0; i < 28; ++i) f[i] = (const float*)d_in[i];
    p.out = (float*)d_out; p.ws = (char*)d_ws;
    if (ws_size < WS_NEED) { fprintf(stderr, "workspace too small: %zu < %zu\n", ws_size, (size_t)WS_NEED); return; }
#if !MEGA
#define SETATTR(K) hipFuncSetAttribute((const void*)k_phase<K>, hipFuncAttributeMaxDynamicSharedMemorySize, LDS_BYTES)
#define LAUNCH(K, layer) k_phase<K><<<256, NTHR, LDS_BYTES, stream>>>(p, layer)
    static bool attr_done = false;
    if (!attr_done) {
        SETATTR(K_PRO); SETATTR(K_E1); SETATTR(K_E2); SETATTR(K_E3); SETATTR(K_E4); SETATTR(K_E5); SETATTR(K_E6); SETATTR(K_LN1); SETATTR(K_O1); SETATTR(K_O2); SETATTR(K_O3);
        SETATTR(K_O4); SETATTR(K_M1); SETATTR(K_M2); SETATTR(K_M3); SETATTR(K_M4); SETATTR(K_LN2);
        attr_done = true;
    }
    LAUNCH(K_PRO, 0);
    for (int layer = 0; layer < 4; ++layer) {
        if ((layer & 1) == 0) { LAUNCH(K_E1, layer); LAUNCH(K_E2, layer); LAUNCH(K_E3, layer); LAUNCH(K_E4, layer); LAUNCH(K_E5, layer); LAUNCH(K_E6, layer); }
        else { LAUNCH(K_O1, layer); LAUNCH(K_O2, layer); LAUNCH(K_O3, layer); LAUNCH(K_O4, layer); }
        LAUNCH(K_LN1, layer); LAUNCH(K_M1, layer); LAUNCH(K_M2, layer); LAUNCH(K_M3, layer); LAUNCH(K_M4, layer); LAUNCH(K_LN2, layer);
    }
#else
    static int grid = 0;
    if (!grid) {
        hipFuncSetAttribute((const void*)k_mega, hipFuncAttributeMaxDynamicSharedMemorySize, LDS_BYTES);
        int dev = 0, cus = 0, per_cu = 0;
        hipGetDevice(&dev);
        hipDeviceGetAttribute(&cus, hipDeviceAttributeMultiprocessorCount, dev);
        hipOccupancyMaxActiveBlocksPerMultiprocessor(&per_cu, (const void*)k_mega, NTHR, LDS_BYTES);
        grid = cus * (per_cu < 1 ? per_cu : 1);
        if (grid <= 0) grid = 0;
    }
    if (!grid) { fprintf(stderr, "occupancy query says 0 blocks per CU\n"); return; }
    hipMemsetAsync((char*)d_ws + OFF_BAR, 0, XCD_BAR_WORDS * sizeof(unsigned), stream);
    k_mega<<<grid, NTHR, LDS_BYTES, stream>>>(p);
#endif
}
```

```cpp
#include <hip/hip_runtime.h>
#include <stdint.h>
#include <stdio.h>

#ifndef MEGA
#define MEGA 1
#define DUPMASK 0
#endif

typedef unsigned short bf16_t;
typedef short bf16x8 __attribute__((ext_vector_type(8)));
typedef float f32x4 __attribute__((ext_vector_type(4)));
typedef float f32x16 __attribute__((ext_vector_type(16)));
typedef unsigned u32x4 __attribute__((ext_vector_type(4)));
typedef unsigned u32x2 __attribute__((ext_vector_type(2)));

constexpr int T_ = 32768, D_ = 1024, L_ = 16384, NB_ = 2;
constexpr int NTHR = 512;
constexpr float ALPHA = 1.681792830507429f;
constexpr float LN_EPS = 1e-5f;
constexpr int EV_N = 2304;
constexpr int OD_N = 6656;
constexpr int OD_QI = 1536, OD_DIL = 1792, OD_KI = 6400, OD_WI = 6464;
constexpr int UHW = 1152;
constexpr int LISTCAP = 131072;

constexpr size_t OFF_BAR = 0;
constexpr size_t OFF_CNT = 16384;
constexpr size_t OFF_A64 = 32768;
constexpr size_t OFF_WT_EVIN = 131072;
constexpr size_t OFF_WT_ODIN = OFF_WT_EVIN + (size_t)2 * EV_N * 1024 * 2;
constexpr size_t OFF_WT_EVOUT = OFF_WT_ODIN + (size_t)2 * OD_N * 1024 * 2;
constexpr size_t OFF_WT_ODOUT = OFF_WT_EVOUT + (size_t)2 * 1024 * 1024 * 2;
constexpr size_t OFF_WT_GLU = OFF_WT_ODOUT + (size_t)2 * 1024 * 1024 * 2;
constexpr size_t OFF_WT_RT = OFF_WT_GLU + (size_t)2 * 512 * 512 * 2;
constexpr size_t OFF_WT_W1 = OFF_WT_RT + (size_t)4 * 128 * 1024 * 2;
constexpr size_t OFF_WT_W2 = OFF_WT_W1 + (size_t)4 * 32 * 2048 * 1024 * 2;
constexpr size_t OFF_TH = OFF_WT_W2 + (size_t)4 * 32 * 1024 * 1024 * 2;
constexpr size_t OFF_GM = OFF_TH + (size_t)2 * 32 * 1024 * UHW * 2;
constexpr size_t OFF_XR = OFF_GM + (size_t)2 * 32 * 128 * 1024 * 2;
constexpr size_t OFF_XB = OFF_XR + (size_t)T_ * 1024 * 4;
constexpr size_t OFF_MIX = OFF_XB + (size_t)T_ * 1024 * 2;
constexpr size_t OFF_CC = OFF_MIX + (size_t)T_ * 1024 * 4;
constexpr size_t OFF_LOGIT = OFF_CC + (size_t)T_ * 1024 * 2;
constexpr size_t OFF_LIST = OFF_LOGIT + (size_t)T_ * 32 * 4;
constexpr size_t OFF_GATE = OFF_LIST + (size_t)32 * LISTCAP * 4;
constexpr size_t OFF_ACT = OFF_GATE + (size_t)T_ * 4 * 4;
constexpr size_t OFF_SLOT = OFF_ACT + (size_t)T_ * 4 * 1024 * 2;
constexpr size_t OFF_MIXER = OFF_SLOT + (size_t)T_ * 4 * 1024 * 4;
constexpr size_t OFF_PE = OFF_MIXER;
constexpr size_t OFF_UH = OFF_PE + (size_t)T_ * 1536 * 2;
constexpr size_t OFF_GLR = OFF_UH + (size_t)(T_ / 64) * 32 * UHW * 2;
constexpr size_t OFF_VTE = OFF_GLR + (size_t)T_ * 16 * 4;
constexpr size_t OFF_KV = OFF_VTE + (size_t)2 * 4 * 128 * L_ * 2;
constexpr size_t OFF_SST = OFF_KV + (size_t)2 * 256 * 4 * 64 * 128 * 4;
constexpr size_t OFF_DEC = OFF_SST + (size_t)2 * 256 * 4 * 64 * 128 * 4;
constexpr size_t OFF_GBUF = OFF_DEC + (size_t)2 * 256 * 4 * 64 * 4;
constexpr size_t OFF_YA = OFF_GBUF + (size_t)512 * 32 * 128 * 4;
constexpr size_t END_EVEN = OFF_YA + (size_t)T_ * 512 * 2;
constexpr size_t OFF_PO = OFF_MIXER;
constexpr size_t OFF_WI = OFF_PO + (size_t)T_ * OD_N * 2;
constexpr size_t OFF_VTC = OFF_WI + (size_t)T_ * 4 * 4;
constexpr size_t OFF_VTD = OFF_VTC + (size_t)2 * 8 * 64 * L_ * 2;
constexpr size_t OFF_BM = OFF_VTD + (size_t)2 * 3 * 8 * 64 * L_ * 2;
constexpr size_t OFF_OD = OFF_BM + (size_t)T_ * 256 * 8;
constexpr size_t OFF_LSE = OFF_OD + (size_t)3 * T_ * 512 * 4;
constexpr size_t END_ODD = OFF_LSE + (size_t)3 * T_ * 8 * 4;
constexpr size_t WS_NEED = END_ODD > END_EVEN ? END_ODD : END_EVEN;
static_assert(WS_NEED < (size_t)4200000000ull, "workspace too large");

constexpr int LDS_BYTES = 133120;

struct Params {
    const float *x, *ev_w_in, *gla_w_gate2, *gla_b_gate2, *gla_norm_g, *s5_a_re, *s5_a_im, *s5_log_dt, *s5_b_re, *s5_b_im, *s5_c_re, *s5_c_im, *s5_d,
        *s5_w_glu, *s5_b_glu, *ev_w_out, *od_w_in, *od_w_out, *ln1_g, *ln1_b, *ln2_g, *ln2_b, *router_w, *router_b, *moe_w1, *moe_b1, *moe_w2, *moe_b2;
    float* out;
    char* ws;
};

__device__ __forceinline__ unsigned pk2(float lo, float hi) { unsigned r; asm("v_cvt_pk_bf16_f32 %0, %1, %2" : "=v"(r) : "v"(lo), "v"(hi)); return r; }
__device__ __forceinline__ bf16_t f2bf(float f) { return (bf16_t)(pk2(f, 0.f) & 0xffffu); }
__device__ __forceinline__ float bf2f(bf16_t h) { return __uint_as_float(((unsigned)h) << 16); }
__device__ __forceinline__ float sigmoidf_(float x) { return 1.f / (1.f + __expf(-x)); }
__device__ __forceinline__ float wave_sum(float v) {
#pragma unroll
    for (int m = 32; m >= 1; m >>= 1) v += __shfl_xor(v, m, 64);
    return v;
}
__device__ __forceinline__ float gelu_tanh(float x) {
    const float k0 = 0.7978845608028654f, k1 = 0.044715f;
    float u = k0 * (x + k1 * x * x * x);
    float t = 1.f - 2.f / (1.f + __expf(2.f * u));
    return 0.5f * x * (1.f + t);
}
__device__ __forceinline__ int otid() { int t = threadIdx.x; asm volatile("" : "+v"(t)); return t; }

#define XB_TMO      128
#define XB_XCNT(j)  (256  + 64 * (j))
#define XB_XSUB(j)  (1280 + 64 * (j))
#define XB_XGEN(j)  (2304 + 64 * (j))
#define XB_TOP      3328
#define XB_TOPGEN   3392
#define XCD_BAR_WORDS 3456
#define XB_SPIN_CAP (1u << 21)
#define LAS __attribute__((address_space(3)))

__device__ __forceinline__ unsigned xb_ld(unsigned* p)              { return __hip_atomic_load(p, __ATOMIC_RELAXED, __HIP_MEMORY_SCOPE_AGENT); }
__device__ __forceinline__ unsigned xb_add(unsigned* p, unsigned v) { return __hip_atomic_fetch_add(p, v, __ATOMIC_RELAXED, __HIP_MEMORY_SCOPE_AGENT); }
__device__ __forceinline__ unsigned xb_xcc_id() { return (unsigned)__builtin_amdgcn_s_getreg((3 << 11) | 20) & 0xFu; }
#define XB_SPIN(cond, bar) do { unsigned _sp = 0; while (cond) { __builtin_amdgcn_s_sleep(1); \
    if ((++_sp & 255u) == 0u) { if (xb_ld(&(bar)[XB_TMO])) break; if (_sp > XB_SPIN_CAP) { atomicAdd(&(bar)[XB_TMO], 1u); break; } } } } while (0)

struct XcdBarrier { unsigned* bar; unsigned x; volatile LAS unsigned* st; };

__device__ __forceinline__ XcdBarrier xcd_barrier_post(unsigned* bar, volatile LAS unsigned* st) {
    XcdBarrier b; b.bar = bar; b.x = xb_xcc_id(); b.st = st;
    if (threadIdx.x == 0) (void)xb_add(&bar[XB_XCNT(b.x)], 1u);
    return b;
}
__device__ __forceinline__ void xcd_barrier_complete(unsigned* bar, unsigned x, unsigned& nloc, unsigned& nx) {
    const unsigned G = gridDim.x * gridDim.y * gridDim.z;
    unsigned sum, cnt, mine, sp = 0u;
    for (;;) {
        sum = 0u; cnt = 0u; mine = 0u;
#pragma unroll
        for (unsigned j = 0; j < 16; ++j) { const unsigned c = xb_ld(&bar[XB_XCNT(j)]); sum += c; cnt += (c > 0u) ? 1u : 0u; mine = (j == x) ? c : mine; }
        if (sum == G) break;
        __builtin_amdgcn_s_sleep(1);
        if ((++sp & 255u) == 0u) { if (xb_ld(&bar[XB_TMO])) break; if (sp > XB_SPIN_CAP) { atomicAdd(&bar[XB_TMO], 1u); break; } }
    }
    nloc = mine > 0u ? mine : 1u; nx = cnt > 0u ? cnt : 1u;
}
__device__ __forceinline__ void xcd_barrier(const XcdBarrier& b) {
    asm volatile("s_waitcnt vmcnt(0)" ::: "memory");
    __syncthreads();
    if (threadIdx.x == 0) {
        unsigned* bar = b.bar;
        __builtin_amdgcn_s_waitcnt(0);
        unsigned nloc = b.st[0], nx = b.st[1];
        if (nloc == 0u) { xcd_barrier_complete(bar, b.x, nloc, nx); b.st[0] = nloc; b.st[1] = nx; }
        const unsigned old = xb_add(&bar[XB_XSUB(b.x)], 1u);
        const unsigned gen = old / nloc;
        if (old + 1u == (gen + 1u) * nloc) {
            __builtin_amdgcn_fence(__ATOMIC_RELEASE, "agent");
            asm volatile("s_waitcnt vmcnt(0)" ::: "memory");
            const unsigned og = xb_add(&bar[XB_TOP], 1u);
            const unsigned tg = og / nx;
            if (og + 1u == (tg + 1u) * nx) xb_add(&bar[XB_TOPGEN], 1u);
            else XB_SPIN(xb_ld(&bar[XB_TOPGEN]) == tg, bar);
            __builtin_amdgcn_fence(__ATOMIC_ACQUIRE, "agent");
            xb_add(&bar[XB_XGEN(b.x)], 1u);
            asm volatile("s_waitcnt vmcnt(0)" ::: "memory");
        } else {
            XB_SPIN(xb_ld(&bar[XB_XGEN(b.x)]) == gen, bar);
            __builtin_amdgcn_fence(__ATOMIC_ACQUIRE, "agent");
            asm volatile("s_waitcnt vmcnt(0)" ::: "memory");
        }
    }
    __syncthreads();
}

constexpr int G_LROW = 144;
constexpr int G_ASZ = 256 * G_LROW;
constexpr int G_BSZ = 128 * G_LROW;
constexpr int G_STAGE = G_ASZ + G_BSZ;
constexpr int G_ROWS_OFF = 2 * G_STAGE;

template <bool GATHER, class Epi>
__device__ __forceinline__ void gemm_tile(const bf16_t* __restrict__ A, long lda, int shift, int m0, const bf16_t* __restrict__ Bt, long ldb, int n0, int K,
                                          char* smem, Epi&& epi) {
    const int tid = otid(), lane = tid & 63, wave = tid >> 6, wr = wave >> 1, wc = wave & 1, fr = lane & 15, fq = lane >> 4;
    const int lrow = tid >> 3, lchunk = tid & 7;
    const int* sRow = (const int*)(smem + G_ROWS_OFF);
    const bf16_t* pa[4]; const bf16_t* pb[2];
#pragma unroll
    for (int i = 0; i < 4; ++i) {
        int r = lrow + 64 * i; long arow;
        if (GATHER) { int v = sRow[r]; arow = v < 0 ? 0 : (v >> shift); } else arow = m0 + r;
        pa[i] = A + arow * lda + lchunk * 8;
    }
#pragma unroll
    for (int i = 0; i < 2; ++i) pb[i] = Bt + (long)(n0 + lrow + 64 * i) * ldb + lchunk * 8;
    f32x4 acc[4][4];
#pragma unroll
    for (int m = 0; m < 4; ++m)
#pragma unroll
        for (int n = 0; n < 4; ++n) acc[m][n] = (f32x4){0.f, 0.f, 0.f, 0.f};
    u32x4 ra[4], rb[2];
    const int nk = K >> 6;
#pragma unroll
    for (int i = 0; i < 4; ++i) ra[i] = *(const u32x4*)(pa[i]);
#pragma unroll
    for (int i = 0; i < 2; ++i) rb[i] = *(const u32x4*)(pb[i]);
    {
        char* sa = smem; char* sb = smem + G_ASZ;
#pragma unroll
        for (int i = 0; i < 4; ++i) *(u32x4*)(sa + (lrow + 64 * i) * G_LROW + lchunk * 16) = ra[i];
#pragma unroll
        for (int i = 0; i < 2; ++i) *(u32x4*)(sb + (lrow + 64 * i) * G_LROW + lchunk * 16) = rb[i];
    }
    __syncthreads();
    for (int kt = 0; kt < nk; ++kt) {
        const bool more = (kt + 1 < nk);
        if (more) {
#pragma unroll
            for (int i = 0; i < 4; ++i) ra[i] = *(const u32x4*)(pa[i] + (kt + 1) * 64);
#pragma unroll
            for (int i = 0; i < 2; ++i) rb[i] = *(const u32x4*)(pb[i] + (kt + 1) * 64);
        }
        const char* sa = smem + (kt & 1) * G_STAGE; const char* sb = sa + G_ASZ;
#pragma unroll
        for (int ks = 0; ks < 2; ++ks) {
            bf16x8 af[4], bfr[4];
#pragma unroll
            for (int m = 0; m < 4; ++m) af[m] = *(const bf16x8*)(sa + (wr * 64 + m * 16 + fr) * G_LROW + (ks * 32 + fq * 8) * 2);
#pragma unroll
            for (int n = 0; n < 4; ++n) bfr[n] = *(const bf16x8*)(sb + (wc * 64 + n * 16 + fr) * G_LROW + (ks * 32 + fq * 8) * 2);
#pragma unroll
            for (int m = 0; m < 4; ++m)
#pragma unroll
                for (int n = 0; n < 4; ++n) acc[m][n] = __builtin_amdgcn_mfma_f32_16x16x32_bf16(af[m], bfr[n], acc[m][n], 0, 0, 0);
        }
        if (more) {
            char* wa = smem + ((kt + 1) & 1) * G_STAGE; char* wb = wa + G_ASZ;
#pragma unroll
            for (int i = 0; i < 4; ++i) *(u32x4*)(wa + (lrow + 64 * i) * G_LROW + lchunk * 16) = ra[i];
#pragma unroll
            for (int i = 0; i < 2; ++i) *(u32x4*)(wb + (lrow + 64 * i) * G_LROW + lchunk * 16) = rb[i];
        }
        __syncthreads();
    }
    {
        f32x4 h0[4][2], h1[4][2];
#pragma unroll
        for (int m = 0; m < 4; ++m) { h0[m][0] = acc[m][0]; h0[m][1] = acc[m][1]; h1[m][0] = acc[m][2]; h1[m][1] = acc[m][3]; }
        epi(h0, wr * 64, n0 + wc * 64, fr, fq);
        epi(h1, wr * 64, n0 + wc * 64 + 32, fr, fq);
    }
}

template <class Epi>
__device__ __forceinline__ void gemm_phase(const bf16_t* A, long lda, int M, const bf16_t* Bt, long ldb, int N, int K, char* smem, int bid, int nb, Epi&& epi) {
    const int ntn = N / 128, ntm = M / 256, nt = ntn * ntm;
    for (int t = bid; t < nt; t += nb) {
        const int mi = t / ntn, ni = t - mi * ntn;
        gemm_tile<false>(A, lda, 0, mi * 256, Bt, ldb, ni * 128, K, smem,
                         [&](f32x4 (&acc)[4][2], int rt0, int c0, int fr, int fq) { epi(acc, mi * 256 + rt0, c0, fr, fq); });
    }
}

constexpr int G8_HT = 128 * 64 * 2;
constexpr int G8_ROWS_OFF = 8 * G8_HT;

__device__ __forceinline__ int g8_lds_byte(int r, int c) {
    const int st = (r >> 4) * 2 + (c >> 5), rr = r & 15, cc = c & 31, ob = rr * 64 + cc * 2;
    return st * 1024 + (ob ^ (((ob >> 9) & 1) << 5));
}
__device__ __forceinline__ void g8_stage_rc(int b, int& R, int& C) {
    const int st = b / 1024, sb = b % 1024, swz = sb ^ (((sb >> 9) & 1) << 5);
    R = (st >> 1) * 16 + swz / 64; C = (st & 1) * 32 + (swz % 64) / 2;
}

#define G8_SA(b, h) (lds + ((b) * 2 + (h)) * G8_HT)
#define G8_SB(b, h) (lds + (4 + (b) * 2 + (h)) * G8_HT)
#define G8_STAGE(P, BASE, OFF, kt) do { \
    _Pragma("unroll") for (int _i = 0; _i < 2; ++_i) \
        __builtin_amdgcn_global_load_lds((const unsigned*)((BASE) + (size_t)(OFF)[_i] + (size_t)(kt) * 64), (LAS unsigned*)((P) + tid * 16 + _i * 8192), 16, 0, 0); } while (0)
#define G8_LDA(dst, b, h) do { _Pragma("unroll") for (int m = 0; m < 4; ++m) _Pragma("unroll") for (int k = 0; k < 2; ++k) \
    dst[m][k] = *(const LAS bf16x8*)(G8_SA(b, h) + g8_lds_byte(wr * 64 + m * 16 + fr, k * 32 + fq * 8)); } while (0)
#define G8_LDB(dst, b, h) do { _Pragma("unroll") for (int n = 0; n < 2; ++n) _Pragma("unroll") for (int k = 0; k < 2; ++k) \
    dst[n][k] = *(const LAS bf16x8*)(G8_SB(b, h) + g8_lds_byte(wc * 32 + n * 16 + fr, k * 32 + fq * 8)); } while (0)
#define G8_MMA(ai, bj, At, Bt_) do { __builtin_amdgcn_s_setprio(1); \
    _Pragma("unroll") for (int m = 0; m < 4; ++m) _Pragma("unroll") for (int n = 0; n < 2; ++n) _Pragma("unroll") for (int k = 0; k < 2; ++k) \
        acc[ai][bj][m][n] = __builtin_amdgcn_mfma_f32_16x16x32_bf16(Bt_[n][k], At[m][k], acc[ai][bj][m][n], 0, 0, 0); \
    __builtin_amdgcn_s_setprio(0); } while (0)
#define G8_WAIT_V(n) asm volatile("s_waitcnt vmcnt(" #n ")" ::: "memory")
#define G8_WAIT_L(n) asm volatile("s_waitcnt lgkmcnt(" #n ")" ::: "memory")
#define G8_BAR __builtin_amdgcn_s_barrier()
#define G8_SCHED __builtin_amdgcn_sched_barrier(0)

template <bool GATHER, class Epi>
__device__ __forceinline__ void gemm256_tile(const bf16_t* __restrict__ A, long lda, int shift, int m0, const bf16_t* __restrict__ Bt, long ldb, int n0, int K,
                                             char* smem, Epi&& epi) {
    LAS char* lds = (LAS char*)smem;
    int tid = otid();
    int wid = tid >> 6, lane = tid & 63, wr = wid >> 2, wc = wid & 3, fr = lane & 15, fq = lane >> 4;
    unsigned aoff[2][2], boff[2];
    {
        const LAS int* sRow = (const LAS int*)(lds + G8_ROWS_OFF);
#pragma unroll
        for (int i = 0; i < 2; ++i) {
            int R, C; g8_stage_rc(tid * 16 + i * 8192, R, C);
            { const int rho = R & 31, nn = rho >> 4, ii = rho & 15; const int Rp = (R & ~31) + 8 * (ii >> 2) + 4 * nn + (ii & 3);
              boff[i] = (unsigned)((long)Rp * ldb + C); }
#pragma unroll
            for (int h = 0; h < 2; ++h) {
                long arow;
                if (GATHER) { const int v = sRow[h * 128 + R]; arow = v < 0 ? 0 : (v >> shift); } else arow = m0 + h * 128 + R;
                aoff[h][i] = (unsigned)(arow * lda + C);
            }
        }
    }
    f32x4 acc[2][2][4][2];
#pragma unroll
    for (int a = 0; a < 2; ++a)
#pragma unroll
        for (int b = 0; b < 2; ++b)
#pragma unroll
            for (int m = 0; m < 4; ++m)
#pragma unroll
                for (int n = 0; n < 2; ++n) acc[a][b][m][n] = (f32x4){0.f, 0.f, 0.f, 0.f};
    bf16x8 At[4][2], B0[2][2], B1[2][2];
    const int nt = K / 64;
    const bf16_t* Bt0 = Bt + (size_t)n0 * ldb; const bf16_t* Bt1 = Bt0 + (size_t)128 * ldb;
    G8_STAGE(G8_SB(0, 0), Bt0, boff, 0); G8_STAGE(G8_SA(0, 0), A, aoff[0], 0);
    G8_STAGE(G8_SB(0, 1), Bt1, boff, 0); G8_STAGE(G8_SA(0, 1), A, aoff[1], 0);
    if (wr == 1) G8_BAR;
    G8_WAIT_V(4); G8_BAR;
    G8_STAGE(G8_SB(1, 0), Bt0, boff, 1); G8_STAGE(G8_SA(1, 0), A, aoff[0], 1); G8_STAGE(G8_SB(1, 1), Bt1, boff, 1);
    G8_WAIT_V(6); G8_BAR;
    for (int t = 0; t < nt - 2; t += 2) {
        G8_LDB(B0, 0, 0); G8_SCHED; G8_LDA(At, 0, 0); G8_STAGE(G8_SA(1, 1), A, aoff[1], t + 1);
        G8_WAIT_L(8); G8_BAR; G8_WAIT_L(0); G8_MMA(0, 0, At, B0); G8_BAR; G8_SCHED;
        G8_LDB(B1, 0, 1); G8_STAGE(G8_SB(0, 0), Bt0, boff, t + 2);
        G8_BAR; G8_WAIT_L(0); G8_MMA(0, 1, At, B1); G8_BAR;
        G8_LDA(At, 0, 1); G8_STAGE(G8_SA(0, 0), A, aoff[0], t + 2);
        G8_BAR; G8_WAIT_L(0); G8_MMA(1, 0, At, B0); G8_BAR; G8_SCHED;
        G8_STAGE(G8_SB(0, 1), Bt1, boff, t + 2);
        G8_WAIT_V(6); G8_BAR; G8_MMA(1, 1, At, B1); G8_BAR;
        G8_LDB(B0, 1, 0); G8_SCHED; G8_LDA(At, 1, 0); G8_STAGE(G8_SA(0, 1), A, aoff[1], t + 2);
        G8_WAIT_L(8); G8_BAR; G8_WAIT_L(0); G8_MMA(0, 0, At, B0); G8_BAR; G8_SCHED;
        G8_LDB(B1, 1, 1); G8_STAGE(G8_SB(1, 0), Bt0, boff, t + 3);
        G8_BAR; G8_WAIT_L(0); G8_MMA(0, 1, At, B1); G8_BAR;
        G8_LDA(At, 1, 1); G8_STAGE(G8_SA(1, 0), A, aoff[0], t + 3);
        G8_BAR; G8_WAIT_L(0); G8_MMA(1, 0, At, B0); G8_BAR; G8_SCHED;
        G8_STAGE(G8_SB(1, 1), Bt1, boff, t + 3);
        G8_WAIT_V(6); G8_BAR; G8_MMA(1, 1, At, B1); G8_BAR;
    }
    { G8_LDB(B0, 0, 0); G8_WAIT_V(0); G8_LDA(At, 0, 0); G8_STAGE(G8_SA(1, 1), A, aoff[1], nt - 1);
      G8_BAR; G8_WAIT_L(0); G8_MMA(0, 0, At, B0); G8_BAR;
      G8_LDB(B1, 0, 1); G8_BAR; G8_WAIT_L(0); G8_MMA(0, 1, At, B1); G8_BAR;
      G8_LDA(At, 0, 1); G8_WAIT_V(4); G8_BAR; G8_WAIT_L(0); G8_MMA(1, 0, At, B0); G8_MMA(1, 1, At, B1); G8_BAR; }
    { G8_LDB(B0, 1, 0); G8_LDA(At, 1, 0); G8_WAIT_V(2); G8_BAR; G8_WAIT_L(0); G8_MMA(0, 0, At, B0); G8_BAR;
      G8_LDB(B1, 1, 1); G8_WAIT_V(0); G8_BAR; G8_WAIT_L(0); G8_MMA(0, 1, At, B1); G8_BAR;
      G8_LDA(At, 1, 1); G8_BAR; G8_WAIT_L(0); G8_MMA(1, 0, At, B0); G8_MMA(1, 1, At, B1); G8_BAR; }
    if (wr == 0) G8_BAR;
    int tz = otid(); wid = tz >> 6; lane = tz & 63; wr = wid >> 2; wc = wid & 3; fr = lane & 15; fq = lane >> 4;
#pragma unroll
    for (int ai = 0; ai < 2; ++ai)
#pragma unroll
        for (int bj = 0; bj < 2; ++bj) epi(acc[ai][bj], ai * 128 + wr * 64, n0 + bj * 128 + wc * 32, fr, fq);
}

template <class Epi>
__device__ __forceinline__ void gemm256_phase(const bf16_t* A, long lda, int M, const bf16_t* Bt, long ldb, int N, int K, char* smem, int bid, int nb, Epi&& epi) {
    const int ntn = N / 256, ntm = M / 256, nt = ntn * ntm;
    for (int t = bid; t < nt; t += nb) {
        const int mi = t / ntn, ni = t - mi * ntn;
        gemm256_tile<false>(A, lda, 0, mi * 256, Bt, ldb, ni * 256, K, smem,
                            [&](f32x4 (&acc)[4][2], int rt0, int c0, int fr, int fq) { epi(acc, mi * 256 + rt0, c0, fr, fq); });
    }
}

__device__ __forceinline__ int colmap(int kind, int n, int nsrc) {
    if (kind == 0) return n < nsrc ? n : -1;
    if (kind == 1) { if (n < 1536) return n; if (n < 2048) return n + 16; if (n < 2064) return n - 512; return -1; }
    if (kind == 2) { if (n < 1792) return n; if (n < 6400) return n + 68; if (n < 6468) return n - 4608; return -1; }
    { const int grp = n >> 5, w = n & 31; return ((w >> 2) & 1) * 1024 + grp * 16 + 4 * (w >> 3) + (w & 3); }
}
struct ConvTile { const float* src; bf16_t* dst; int sld, sc, K, n0, k0; };
__device__ __forceinline__ ConvTile conv_decode(const Params& p, int t, int n4) {
    constexpr int S0 = 128 * 32 * 4, S1 = S0 + 128 * 16 * 4, S2 = S1 + 2 * 36 * 4, S3 = S2 + 2 * 104 * 4, S4 = S3 + 2 * 16 * 4, S5 = S4 + 2 * 16 * 4, S6 = S5 + 2 * 8 * 2;
    char* ws = p.ws;
    ConvTile c; int nsrc, kind, NT, loc;
    if (t < S0) { loc = t; const int mat = loc / (32 * 4); loc -= mat * 32 * 4; c.src = p.moe_w1 + (size_t)mat * 1024 * 2048; c.dst = (bf16_t*)(ws + OFF_WT_W1) + (size_t)mat * 2048 * 1024; c.sld = 2048; nsrc = 2048; kind = 3; c.K = 1024; NT = 32; }
    else if (t < S1) { loc = t - S0; const int mat = loc / 64; loc -= mat * 64; c.src = p.moe_w2 + (size_t)mat * 1024 * 1024; c.dst = (bf16_t*)(ws + OFF_WT_W2) + (size_t)mat * 1024 * 1024; c.sld = 1024; nsrc = 1024; kind = 0; c.K = 1024; NT = 16; }
    else if (t < S2) { loc = t - S1; const int mat = loc / (36 * 4); loc -= mat * 36 * 4; c.src = p.ev_w_in + (size_t)mat * 1024 * 2064; c.dst = (bf16_t*)(ws + OFF_WT_EVIN) + (size_t)mat * EV_N * 1024; c.sld = 2064; nsrc = 2064; kind = 1; c.K = 1024; NT = 36; }
    else if (t < S3) { loc = t - S2; const int mat = loc / (104 * 4); loc -= mat * 104 * 4; c.src = p.od_w_in + (size_t)mat * 1024 * 6468; c.dst = (bf16_t*)(ws + OFF_WT_ODIN) + (size_t)mat * OD_N * 1024; c.sld = 6468; nsrc = 6468; kind = 2; c.K = 1024; NT = 104; }
    else if (t < S4) { loc = t - S3; const int mat = loc / 64; loc -= mat * 64; c.src = p.ev_w_out + (size_t)mat * 1024 * 1024; c.dst = (bf16_t*)(ws + OFF_WT_EVOUT) + (size_t)mat * 1024 * 1024; c.sld = 1024; nsrc = 1024; kind = 0; c.K = 1024; NT = 16; }
    else if (t < S5) { loc = t - S4; const int mat = loc / 64; loc -= mat * 64; c.src = p.od_w_out + (size_t)mat * 1024 * 1024; c.dst = (bf16_t*)(ws + OFF_WT_ODOUT) + (size_t)mat * 1024 * 1024; c.sld = 1024; nsrc = 1024; kind = 0; c.K = 1024; NT = 16; }
    else if (t < S6) { loc = t - S5; const int mat = loc / 16; loc -= mat * 16; c.src = p.s5_w_glu + (size_t)mat * 512 * 512; c.dst = (bf16_t*)(ws + OFF_WT_GLU) + (size_t)mat * 512 * 512; c.sld = 512; nsrc = 512; kind = 0; c.K = 512; NT = 8; }
    else { loc = t - S6; const int mat = loc / 8; loc -= mat * 8; c.src = p.router_w + (size_t)mat * 1024 * 32; c.dst = (bf16_t*)(ws + OFF_WT_RT) + (size_t)mat * 128 * 1024; c.sld = 32; nsrc = 32; kind = 0; c.K = 1024; NT = 2; }
    const int kt = loc / NT, nt = loc - kt * NT;
    c.n0 = nt * 64; c.k0 = kt * 256;
    c.sc = colmap(kind, c.n0 + n4 * 4, nsrc);
    return c;
}
__device__ __forceinline__ void conv_load(const ConvTile& c, int kp, f32x4 (&v)[8]) {
#pragma unroll
    for (int i = 0; i < 4; ++i)
#pragma unroll
        for (int e = 0; e < 2; ++e) {
            const int k = c.k0 + 2 * (kp + 32 * i) + e;
            v[2 * i + e] = c.sc >= 0 ? *(const f32x4*)(c.src + (size_t)k * c.sld + c.sc) : (f32x4){0.f, 0.f, 0.f, 0.f};
        }
}

__device__ __forceinline__ void conv_phase(const Params& p, char* smem, int bid, int nb) {
    char* ws = p.ws;
    constexpr int NTILES = 128 * 32 * 4 + 128 * 16 * 4 + 2 * 36 * 4 + 2 * 104 * 4 + 2 * 16 * 4 + 2 * 16 * 4 + 2 * 8 * 2 + 4 * 2 * 4;
    bf16_t* tile = (bf16_t*)smem;
    const int tid = otid(), n4 = tid & 15, kp = tid >> 4;
    if (bid < NTILES) {
        ConvTile cur = conv_decode(p, bid, n4);
        f32x4 v[8];
        conv_load(cur, kp, v);
        for (int t = bid; t < NTILES; t += nb) {
            const bool more = t + nb < NTILES;
            ConvTile nxt = cur; f32x4 w[8];
            if (more) { nxt = conv_decode(p, t + nb, n4); conv_load(nxt, kp, w); }
#pragma unroll
            for (int i = 0; i < 4; ++i)
#pragma unroll
                for (int j = 0; j < 4; ++j)
                    *(unsigned*)(tile + (n4 * 4 + j) * 258 + 2 * (kp + 32 * i)) = pk2(v[2 * i][j], v[2 * i + 1][j]);
            __syncthreads();
#pragma unroll
            for (int i = 0; i < 4; ++i) {
                const int c = tid + 512 * i, n = c >> 5, kc = c & 31;
                const unsigned* tp = (const unsigned*)(tile + n * 258 + kc * 8);
                u32x4 o; o.x = tp[0]; o.y = tp[1]; o.z = tp[2]; o.w = tp[3];
                *(u32x4*)(cur.dst + (size_t)(cur.n0 + n) * cur.K + cur.k0 + kc * 8) = o;
            }
            __syncthreads();
            if (more) {
                cur = nxt;
#pragma unroll
                for (int i = 0; i < 8; ++i) v[i] = w[i];
            }
        }
    }
    {
        const float* x = p.x; bf16_t* xb = (bf16_t*)(ws + OFF_XB);
        const long nch = (long)T_ * 1024 / 8;
        for (long c = (long)bid * NTHR + otid(); c < nch; c += (long)nb * NTHR) {
            const f32x4 a = *(const f32x4*)(x + c * 8), b = *(const f32x4*)(x + c * 8 + 4);
            u32x4 w; w.x = pk2(a[0], a[1]); w.y = pk2(a[2], a[3]); w.z = pk2(b[0], b[1]); w.w = pk2(b[2], b[3]);
            *(u32x4*)(xb + c * 8) = w;
        }
    }
    if (bid == 0 && otid() < 128) ((int*)(ws + OFF_CNT))[otid()] = 0;
}

__device__ __forceinline__ void s5mat_unit(const Params& p, int j, int g, char* smem) {
    float* cre = (float*)smem;
    float* cim = cre + 1024;
    float* bbr = cim + 1024;
    float* bbi = bbr + 1024;
    float* pwr = bbi + 1024;
    float* pwi = pwr + 65 * 64;
    float* zr = pwi + 65 * 64;
    float* zi = zr + 64;
    float* Kd = zi + 64;
    const int tid = otid();
    const int jg = j * 32 + g;
    if (tid < 64) {
        const int pp = tid;
        const float lre = fminf(p.s5_a_re[jg * 64 + pp], -1e-4f), lim = p.s5_a_im[jg * 64 + pp];
        const float dt = expf(p.s5_log_dt[jg]);
        const float xr = lre * dt, th = lim * dt;
        const float mag = expf(xr);
        const float ar = mag * cosf(th), ai = mag * sinf(th);
        const float inv = 1.f / (lre * lre + lim * lim);
        zr[pp] = ((ar - 1.f) * lre + ai * lim) * inv;
        zi[pp] = (ai * lre - (ar - 1.f) * lim) * inv;
        const double thd = (double)th;
        for (int d = 0; d <= 64; ++d) {
            const float mg = expf((float)d * xr);
            double ang = (double)d * thd;
            const double kk = rint(ang * 0.15915494309189535);
            ang -= kk * 6.283185307179586;
            const float a = (float)ang;
            pwr[d * 64 + pp] = mg * cosf(a);
            pwi[d * 64 + pp] = mg * sinf(a);
        }
    }
    for (int e = tid; e < 1024; e += NTHR) {
        cre[e] = p.s5_c_re[(size_t)jg * 1024 + e];
        cim[e] = p.s5_c_im[(size_t)jg * 1024 + e];
    }
    __syncthreads();
    for (int e = tid; e < 1024; e += NTHR) {
        const int pp = e >> 4;
        const float br = p.s5_b_re[(size_t)jg * 1024 + e], bi = p.s5_b_im[(size_t)jg * 1024 + e];
        bbr[e] = zr[pp] * br - zi[pp] * bi;
        bbi[e] = zr[pp] * bi + zi[pp] * br;
    }
    __syncthreads();
    for (int e = tid; e < 64 * 256; e += NTHR) {
        const int d = e >> 8, n = (e >> 4) & 15, m = e & 15;
        float s = 0.f;
        for (int pp = 0; pp < 64; ++pp) {
            const float cr = cre[n * 64 + pp], ci = cim[n * 64 + pp], qr = pwr[d * 64 + pp], qi = pwi[d * 64 + pp];
            const float wr_ = cr * qr - ci * qi, wi_ = cr * qi + ci * qr;
            s += wr_ * bbr[pp * 16 + m] - wi_ * bbi[pp * 16 + m];
        }
        Kd[e] = s;
    }
    __syncthreads();
    bf16_t* TH = (bf16_t*)(p.ws + OFF_TH) + (size_t)jg * 1024 * UHW;
    for (int c = tid; c < 1024 * 144; c += NTHR) {
        const int row = c / 144, ch = c - row * 144;
        const int tau = row >> 4, n = row & 15;
        float v[8];
        if (ch < 128) {
            const int s = ch >> 1, m0 = (ch & 1) * 8;
            if (s <= tau) {
#pragma unroll
                for (int i = 0; i < 8; ++i) v[i] = Kd[(tau - s) * 256 + n * 16 + m0 + i];
            } else {
#pragma unroll
                for (int i = 0; i < 8; ++i) v[i] = 0.f;
            }
        } else {
            const int p0 = (ch - 128) * 4;
#pragma unroll
            for (int i = 0; i < 4; ++i) {
                const int pp = p0 + i;
                const float cr = cre[n * 64 + pp], ci = cim[n * 64 + pp], qr = pwr[(tau + 1) * 64 + pp], qi = pwi[(tau + 1) * 64 + pp];
                v[2 * i] = cr * qr - ci * qi;
                v[2 * i + 1] = -(cr * qi + ci * qr);
            }
        }
        u32x4 w; w.x = pk2(v[0], v[1]); w.y = pk2(v[2], v[3]); w.z = pk2(v[4], v[5]); w.w = pk2(v[6], v[7]);
        *(u32x4*)(TH + (size_t)row * UHW + ch * 8) = w;
    }
    bf16_t* GM = (bf16_t*)(p.ws + OFF_GM) + (size_t)jg * 128 * 1024;
    for (int c = tid; c < 128 * 128; c += NTHR) {
        const int row = c >> 7, ch = c & 127;
        const int pp = row >> 1, ri = row & 1;
        const int s = ch >> 1, m0 = (ch & 1) * 8;
        const float qr = pwr[(63 - s) * 64 + pp], qi = pwi[(63 - s) * 64 + pp];
        float v[8];
#pragma unroll
        for (int i = 0; i < 8; ++i) {
            const float br = bbr[pp * 16 + m0 + i], bi = bbi[pp * 16 + m0 + i];
            v[i] = ri == 0 ? (qr * br - qi * bi) : (qr * bi + qi * br);
        }
        u32x4 w; w.x = pk2(v[0], v[1]); w.y = pk2(v[2], v[3]); w.z = pk2(v[4], v[5]); w.w = pk2(v[6], v[7]);
        *(u32x4*)(GM + (size_t)row * 1024 + ch * 8) = w;
    }
    if (tid < 64) {
        float* A64 = (float*)(p.ws + OFF_A64) + (size_t)jg * 128;
        A64[tid * 2] = pwr[64 * 64 + tid];
        A64[tid * 2 + 1] = pwi[64 * 64 + tid];
    }
    __syncthreads();
}

__device__ __forceinline__ void epi_ev_in(const Params& p, f32x4 (&acc)[4][2], int row0, int c0, int fr, int fq) {
    char* ws = p.ws;
    bf16_t* PE = (bf16_t*)(ws + OFF_PE); bf16_t* UH = (bf16_t*)(ws + OFF_UH); float* GLR = (float*)(ws + OFF_GLR); bf16_t* VTE = (bf16_t*)(ws + OFF_VTE);
    const int col = c0 + 8 * fq;
#pragma unroll
    for (int m = 0; m < 4; ++m) {
        const int t = row0 + m * 16 + fr;
        u32x4 w; w.x = pk2(acc[m][0][0], acc[m][0][1]); w.y = pk2(acc[m][0][2], acc[m][0][3]); w.z = pk2(acc[m][1][0], acc[m][1][1]); w.w = pk2(acc[m][1][2], acc[m][1][3]);
        if (c0 < 1536) {
            *(u32x4*)(PE + (size_t)t * 1536 + col) = w;
            if (c0 >= 512 && c0 < 1024) {
                const int c = col - 512, h = c >> 7, vv = c & 127, b = t >> 14, pos = t & (L_ - 1);
                bf16_t* vp = VTE + ((size_t)((b * 4 + h) * 128 + vv)) * L_ + pos;
                vp[0] = (bf16_t)(w.x & 0xffffu); vp[(size_t)L_] = (bf16_t)(w.x >> 16); vp[(size_t)2 * L_] = (bf16_t)(w.y & 0xffffu); vp[(size_t)3 * L_] = (bf16_t)(w.y >> 16);
                vp[(size_t)4 * L_] = (bf16_t)(w.z & 0xffffu); vp[(size_t)5 * L_] = (bf16_t)(w.z >> 16); vp[(size_t)6 * L_] = (bf16_t)(w.w & 0xffffu); vp[(size_t)7 * L_] = (bf16_t)(w.w >> 16);
            }
        } else if (c0 < 2048) {
            const int ch = col - 1536, g = ch >> 4, mm = ch & 15;
            *(u32x4*)(UH + ((size_t)(t >> 6) * 32 + g) * UHW + (t & 63) * 16 + mm) = w;
        } else if (col < 2064) {
            *(f32x4*)(GLR + (size_t)t * 16 + (col - 2048)) = acc[m][0];
            *(f32x4*)(GLR + (size_t)t * 16 + (col - 2048) + 4) = acc[m][1];
        }
    }
}

__device__ __forceinline__ void gla_decay(const Params& p, int j, int t0, int h, float* sB) {
    const float* GLR = (const float*)(p.ws + OFF_GLR);
    const float* w2 = p.gla_w_gate2 + (size_t)j * 16 * 256;
    const float* b2 = p.gla_b_gate2 + (size_t)j * 256;
    const int tid = otid();
    for (int e = tid; e < 4096; e += NTHR) {
        const int tau = e >> 6, d = e & 63;
        float a = b2[h * 64 + d];
#pragma unroll
        for (int r = 0; r < 16; ++r) a += GLR[(size_t)(t0 + tau) * 16 + r] * w2[r * 256 + h * 64 + d];
        const float ls = fminf(a, 0.f) - log1pf(__expf(-fabsf(a)));
        sB[tau * 65 + d] = ls * (1.f / 16.f);
    }
    __syncthreads();
    if (tid < 64) { float run = 0.f; for (int tau = 0; tau < 64; ++tau) { run += sB[tau * 65 + tid]; sB[tau * 65 + tid] = run; } }
    __syncthreads();
}

__device__ __forceinline__ void gla_a_item(const Params& p, int j, int item, char* smem) {
    const int h = item & 3, c = (item >> 2) & 255, b = item >> 10;
    const int t0 = b * L_ + c * 64;
    float* sB = (float*)smem;
    bf16_t* AK = (bf16_t*)(smem + 16640);
    const bf16_t* PE = (const bf16_t*)(p.ws + OFF_PE);
    const bf16_t* VTE = (const bf16_t*)(p.ws + OFF_VTE);
    const int tid = otid(), lane = tid & 63, wave = tid >> 6, fr = lane & 15, fq = lane >> 4;
    gla_decay(p, j, t0, h, sB);
    for (int e = tid; e < 4096; e += NTHR) {
        const int tau = e >> 6, d = e & 63;
        const float k = bf2f(PE[(size_t)(t0 + tau) * 1536 + 256 + h * 64 + d]);
        AK[d * 72 + tau] = f2bf(k * __expf(sB[63 * 65 + d] - sB[tau * 65 + d]));
    }
    __syncthreads();
    const int dblk = wave >> 1, vb = (wave & 1) * 64;
    f32x4 acc[4];
#pragma unroll
    for (int n = 0; n < 4; ++n) acc[n] = (f32x4){0.f, 0.f, 0.f, 0.f};
#pragma unroll
    for (int ks = 0; ks < 2; ++ks) {
        const bf16x8 af = *(const bf16x8*)(AK + (dblk * 16 + fr) * 72 + ks * 32 + fq * 8);
#pragma unroll
        for (int n = 0; n < 4; ++n) {
            const int v = vb + n * 16 + fr;
            const bf16x8 bfr = *(const bf16x8*)(VTE + ((size_t)((b * 4 + h) * 128 + v)) * L_ + (c * 64 + ks * 32 + fq * 8));
            acc[n] = __builtin_amdgcn_mfma_f32_16x16x32_bf16(af, bfr, acc[n], 0, 0, 0);
        }
    }
    float* KV = (float*)(p.ws + OFF_KV) + ((size_t)((b * 256 + c) * 4 + h)) * 64 * 128;
#pragma unroll
    for (int n = 0; n < 4; ++n)
#pragma unroll
        for (int r = 0; r < 4; ++r) KV[(dblk * 16 + fq * 4 + r) * 128 + vb + n * 16 + fr] = acc[n][r];
    if (tid < 64) ((float*)(p.ws + OFF_DEC))[((size_t)((b * 256 + c) * 4 + h)) * 64 + tid] = __expf(sB[63 * 65 + tid]);
    __syncthreads();
}

__device__ __forceinline__ void scan_phase(const Params& p, int j, int bid) {
    const int gid = bid * NTHR + otid();
    if (gid < 65536) {
        const int v = gid & 127, d = (gid >> 7) & 63, h = (gid >> 13) & 3, b = gid >> 15;
        const float* KV = (const float*)(p.ws + OFF_KV); float* SST = (float*)(p.ws + OFF_SST); const float* DEC = (const float*)(p.ws + OFF_DEC);
        float S = 0.f;
        for (int c0 = 0; c0 < 256; c0 += 8) {
            float kv[8], dc[8];
#pragma unroll
            for (int i = 0; i < 8; ++i) {
                const size_t blk = (size_t)((b * 256 + c0 + i) * 4 + h);
                kv[i] = KV[(blk * 64 + d) * 128 + v]; dc[i] = DEC[blk * 64 + d];
            }
#pragma unroll
            for (int i = 0; i < 8; ++i) {
                const size_t blk = (size_t)((b * 256 + c0 + i) * 4 + h);
                SST[(blk * 64 + d) * 128 + v] = S;
                S = dc[i] * S + kv[i];
            }
        }
    } else if (gid < 65536 + 4096) {
        const int e = gid - 65536, pp = e & 63, g = (e >> 6) & 31, b = e >> 11;
        const float* A64 = (const float*)(p.ws + OFF_A64) + (size_t)(j * 32 + g) * 128;
        const float ar = A64[pp * 2], ai = A64[pp * 2 + 1];
        const float* GB = (const float*)(p.ws + OFF_GBUF); bf16_t* UH = (bf16_t*)(p.ws + OFF_UH);
        float hr = 0.f, hi = 0.f;
        for (int c0 = 0; c0 < 256; c0 += 8) {
            float gr[8], gi[8];
#pragma unroll
            for (int i = 0; i < 8; ++i) { const size_t row = (size_t)(b * 256 + c0 + i) * 32 + g; gr[i] = GB[row * 128 + 2 * pp]; gi[i] = GB[row * 128 + 2 * pp + 1]; }
#pragma unroll
            for (int i = 0; i < 8; ++i) {
                const size_t row = (size_t)(b * 256 + c0 + i) * 32 + g;
                *(unsigned*)(UH + row * UHW + 1024 + 2 * pp) = pk2(hr, hi);
                const float nr = ar * hr - ai * hi + gr[i], ni = ar * hi + ai * hr + gi[i];
                hr = nr; hi = ni;
            }
        }
    }
}

__device__ __forceinline__ void gla_c_item(const Params& p, int j, int item, char* smem) {
    const int h = item & 3, c = (item >> 2) & 255, b = item >> 10;
    const int t0 = b * L_ + c * 64;
    float* sB = (float*)smem;
    bf16_t* QT = (bf16_t*)(smem + 16640);
    bf16_t* KT = (bf16_t*)(smem + 16640 + 9216);
    bf16_t* ATT = (bf16_t*)(smem + 16640 + 18432);
    float* OS = (float*)(smem + 16640 + 27648);
    const bf16_t* PE = (const bf16_t*)(p.ws + OFF_PE);
    const bf16_t* VTE = (const bf16_t*)(p.ws + OFF_VTE);
    const int tid = otid(), lane = tid & 63, wave = tid >> 6, fr = lane & 15, fq = lane >> 4;
    gla_decay(p, j, t0, h, sB);
    for (int e = tid; e < 4096; e += NTHR) {
        const int tau = e >> 6, d = e & 63;
        const float bb = sB[tau * 65 + d];
        const float q = bf2f(PE[(size_t)(t0 + tau) * 1536 + h * 64 + d]);
        const float k = bf2f(PE[(size_t)(t0 + tau) * 1536 + 256 + h * 64 + d]);
        QT[tau * 72 + d] = f2bf(q * 0.125f * __expf(bb));
        KT[tau * 72 + d] = f2bf(k * __expf(-bb));
    }
    __syncthreads();
    const int iblk = wave >> 1;
    {
        f32x4 acc[2];
        acc[0] = (f32x4){0.f, 0.f, 0.f, 0.f}; acc[1] = acc[0];
#pragma unroll
        for (int ks = 0; ks < 2; ++ks) {
            const bf16x8 af = *(const bf16x8*)(QT + (iblk * 16 + fr) * 72 + ks * 32 + fq * 8);
#pragma unroll
            for (int n = 0; n < 2; ++n) {
                const int jb = (wave & 1) * 2 + n;
                const bf16x8 bfr = *(const bf16x8*)(KT + (jb * 16 + fr) * 72 + ks * 32 + fq * 8);
                acc[n] = __builtin_amdgcn_mfma_f32_16x16x32_bf16(af, bfr, acc[n], 0, 0, 0);
            }
        }
#pragma unroll
        for (int n = 0; n < 2; ++n) {
            const int jj = ((wave & 1) * 2 + n) * 16 + fr;
#pragma unroll
            for (int r = 0; r < 4; ++r) { const int ii = iblk * 16 + fq * 4 + r; ATT[ii * 72 + jj] = f2bf(jj <= ii ? acc[n][r] : 0.f); }
        }
    }
    __syncthreads();
    {
        const int vb = (wave & 1) * 64;
        const float* SST = (const float*)(p.ws + OFF_SST) + ((size_t)((b * 256 + c) * 4 + h)) * 64 * 128;
        f32x4 acc[4];
#pragma unroll
        for (int n = 0; n < 4; ++n) acc[n] = (f32x4){0.f, 0.f, 0.f, 0.f};
#pragma unroll
        for (int ks = 0; ks < 2; ++ks) {
            const bf16x8 af = *(const bf16x8*)(ATT + (iblk * 16 + fr) * 72 + ks * 32 + fq * 8);
            const bf16x8 aq = *(const bf16x8*)(QT + (iblk * 16 + fr) * 72 + ks * 32 + fq * 8);
#pragma unroll
            for (int n = 0; n < 4; ++n) {
                const int v = vb + n * 16 + fr;
                const bf16x8 bv = *(const bf16x8*)(VTE + ((size_t)((b * 4 + h) * 128 + v)) * L_ + (c * 64 + ks * 32 + fq * 8));
                acc[n] = __builtin_amdgcn_mfma_f32_16x16x32_bf16(af, bv, acc[n], 0, 0, 0);
                bf16x8 bs;
#pragma unroll
                for (int i = 0; i < 8; ++i) bs[i] = (short)f2bf(SST[(ks * 32 + fq * 8 + i) * 128 + v]);
                acc[n] = __builtin_amdgcn_mfma_f32_16x16x32_bf16(aq, bs, acc[n], 0, 0, 0);
            }
        }
#pragma unroll
        for (int n = 0; n < 4; ++n)
#pragma unroll
            for (int r = 0; r < 4; ++r) OS[(iblk * 16 + fq * 4 + r) * 132 + vb + n * 16 + fr] = acc[n][r];
    }
    __syncthreads();
    {
        const int i = tid >> 3, seg = tid & 7;
        float o[16]; float ss = 0.f;
#pragma unroll
        for (int q = 0; q < 16; ++q) { o[q] = OS[i * 132 + seg * 16 + q]; ss += o[q] * o[q]; }
        ss += __shfl_xor(ss, 1, 64); ss += __shfl_xor(ss, 2, 64); ss += __shfl_xor(ss, 4, 64);
        const float rs = rsqrtf(ss * (1.f / 128.f) + LN_EPS);
        const float* ng = p.gla_norm_g + (size_t)j * 128;
        bf16_t* CC = (bf16_t*)(p.ws + OFF_CC);
        const size_t t = (size_t)(t0 + i);
        unsigned w[8];
#pragma unroll
        for (int q = 0; q < 16; q += 2) {
            const int v0 = seg * 16 + q;
            const float r0 = bf2f(PE[t * 1536 + 1024 + h * 128 + v0]), r1 = bf2f(PE[t * 1536 + 1024 + h * 128 + v0 + 1]);
            const float a0 = o[q] * rs * ng[v0] * (r0 * sigmoidf_(r0)), a1 = o[q + 1] * rs * ng[v0 + 1] * (r1 * sigmoidf_(r1));
            w[q >> 1] = pk2(a0, a1);
        }
        u32x4 w0, w1; w0.x = w[0]; w0.y = w[1]; w0.z = w[2]; w0.w = w[3]; w1.x = w[4]; w1.y = w[5]; w1.z = w[6]; w1.w = w[7];
        *(u32x4*)(CC + t * 1024 + h * 128 + seg * 16) = w0;
        *(u32x4*)(CC + t * 1024 + h * 128 + seg * 16 + 8) = w1;
    }
    __syncthreads();
}

__device__ __forceinline__ void s5_g_phase(const Params& p, int j, char* smem, int bid, int nb) {
    const bf16_t* UH = (const bf16_t*)(p.ws + OFF_UH);
    float* GB = (float*)(p.ws + OFF_GBUF);
    for (int t = bid; t < 64; t += nb) {
        const int g = t >> 1, mi = t & 1;
        const bf16_t* Bt = (const bf16_t*)(p.ws + OFF_GM) + (size_t)(j * 32 + g) * 128 * 1024;
        gemm_tile<false>(UH + (size_t)g * UHW, (long)32 * UHW, 0, mi * 256, Bt, 1024, 0, 1024, smem,
            [&](f32x4 (&acc)[4][2], int rt0, int c0, int fr, int fq) {
#pragma unroll
                for (int m = 0; m < 4; ++m)
#pragma unroll
                    for (int n = 0; n < 2; ++n)
#pragma unroll
                        for (int r = 0; r < 4; ++r) {
                            const int row = mi * 256 + rt0 + m * 16 + fq * 4 + r;
                            GB[((size_t)row * 32 + g) * 128 + c0 + n * 16 + fr] = acc[m][n][r];
                        }
            });
    }
}
__device__ __forceinline__ void s5_y_phase(const Params& p, int j, char* smem, int bid, int nb) {
    const bf16_t* UH = (const bf16_t*)(p.ws + OFF_UH);
    bf16_t* YA = (bf16_t*)(p.ws + OFF_YA);
    const float* dsk = p.s5_d + (size_t)j * 512;
    for (int t = bid; t < 32 * 2 * 4; t += nb) {
        const int g = t >> 3, mi = (t >> 2) & 1, ni = t & 3;
        const bf16_t* Bt = (const bf16_t*)(p.ws + OFF_TH) + (size_t)(j * 32 + g) * 1024 * UHW;
        gemm256_tile<false>(UH + (size_t)g * UHW, (long)32 * UHW, 0, mi * 256, Bt, UHW, ni * 256, UHW, smem,
            [&](f32x4 (&acc)[4][2], int rt0, int c0, int fr, int fq) {
                const int col = c0 + 8 * fq;
                const int tau = col >> 4, nn = col & 15, ch = g * 16 + nn;
                const f32x4 d0 = *(const f32x4*)(dsk + ch), d1 = *(const f32x4*)(dsk + ch + 4);
#pragma unroll
                for (int m = 0; m < 4; ++m) {
                    const int row = mi * 256 + rt0 + m * 16 + fr;
                    const u32x4 uw = *(const u32x4*)(UH + ((size_t)row * 32 + g) * UHW + col);
                    float y[8];
#pragma unroll
                    for (int q = 0; q < 4; ++q) {
                        const unsigned u2 = q == 0 ? uw.x : q == 1 ? uw.y : q == 2 ? uw.z : uw.w;
                        const float u0 = __uint_as_float(u2 << 16), u1 = __uint_as_float(u2 & 0xffff0000u);
                        const float a0 = q < 2 ? acc[m][0][2 * q] : acc[m][1][2 * q - 4], a1 = q < 2 ? acc[m][0][2 * q + 1] : acc[m][1][2 * q - 3];
                        const float dd0 = q < 2 ? d0[2 * q] : d1[2 * q - 4], dd1 = q < 2 ? d0[2 * q + 1] : d1[2 * q - 3];
                        y[2 * q] = gelu_tanh(a0 + dd0 * u0); y[2 * q + 1] = gelu_tanh(a1 + dd1 * u1);
                    }
                    u32x4 w; w.x = pk2(y[0], y[1]); w.y = pk2(y[2], y[3]); w.z = pk2(y[4], y[5]); w.w = pk2(y[6], y[7]);
                    *(u32x4*)(YA + ((size_t)row * 64 + tau) * 512 + ch) = w;
                }
            });
    }
}

template <bool SLOTS>
__device__ __forceinline__ void ln_phase(const Params& p, const float* xin, const float* addb, const float* g, const float* bta, float* xout, bf16_t* xb, int bid, int nb) {
    const int lane = otid() & 63, wave = otid() >> 6;
    for (int t = bid * 8 + wave; t < T_; t += nb * 8) {
        f32x4 v[4];
        float s = 0.f;
#pragma unroll
        for (int i = 0; i < 4; ++i) {
            const int c = i * 256 + lane * 4;
            f32x4 a = *(const f32x4*)(xin + (size_t)t * 1024 + c);
            f32x4 m;
            if (SLOTS) {
                m = *(const f32x4*)(addb + ((size_t)t * 4 + 0) * 1024 + c);
                m += *(const f32x4*)(addb + ((size_t)t * 4 + 1) * 1024 + c);
                m += *(const f32x4*)(addb + ((size_t)t * 4 + 2) * 1024 + c);
                m += *(const f32x4*)(addb + ((size_t)t * 4 + 3) * 1024 + c);
            } else m = *(const f32x4*)(addb + (size_t)t * 1024 + c);
            v[i] = a * ALPHA + m;
            s += v[i][0] + v[i][1] + v[i][2] + v[i][3];
        }
        const float mu = wave_sum(s) * (1.f / 1024.f);
        float q = 0.f;
#pragma unroll
        for (int i = 0; i < 4; ++i) { v[i] -= mu; q += v[i][0] * v[i][0] + v[i][1] * v[i][1] + v[i][2] * v[i][2] + v[i][3] * v[i][3]; }
        const float rs = rsqrtf(wave_sum(q) * (1.f / 1024.f) + LN_EPS);
#pragma unroll
        for (int i = 0; i < 4; ++i) {
            const int c = i * 256 + lane * 4;
            const f32x4 gg = *(const f32x4*)(g + c), bb = *(const f32x4*)(bta + c);
            const f32x4 o = v[i] * rs * gg + bb;
            *(f32x4*)(xout + (size_t)t * 1024 + c) = o;
            if (xb) { u32x2 w; w.x = pk2(o[0], o[1]); w.y = pk2(o[2], o[3]); *(u32x2*)(xb + (size_t)t * 1024 + c) = w; }
        }
    }
}

__device__ __forceinline__ void topk_phase(const Params& p, int layer, int bid, int nb) {
    const float* LG = (const float*)(p.ws + OFF_LOGIT);
    int* cnt = (int*)(p.ws + OFF_CNT) + layer * 32;
    int* LIST = (int*)(p.ws + OFF_LIST);
    float* GATE = (float*)(p.ws + OFF_GATE);
    for (int t = bid * NTHR + otid(); t < T_; t += nb * NTHR) {
        float v0 = -INFINITY, v1 = -INFINITY, v2 = -INFINITY, v3 = -INFINITY; int i0 = 0, i1 = 0, i2 = 0, i3 = 0;
#pragma unroll
        for (int q = 0; q < 8; ++q) {
            const f32x4 l4 = *(const f32x4*)(LG + (size_t)t * 32 + q * 4);
#pragma unroll
            for (int r = 0; r < 4; ++r) {
                const float v = l4[r]; const int e = q * 4 + r;
                if (v > v0) { v3 = v2; i3 = i2; v2 = v1; i2 = i1; v1 = v0; i1 = i0; v0 = v; i0 = e; }
                else if (v > v1) { v3 = v2; i3 = i2; v2 = v1; i2 = i1; v1 = v; i1 = e; }
                else if (v > v2) { v3 = v2; i3 = i2; v2 = v; i2 = e; }
                else if (v > v3) { v3 = v; i3 = e; }
            }
        }
        const float e1 = __expf(v1 - v0), e2 = __expf(v2 - v0), e3 = __expf(v3 - v0);
        const float inv = 1.f / (1.f + e1 + e2 + e3);
        int pos;
        pos = atomicAdd(&cnt[i0], 1); LIST[(size_t)i0 * LISTCAP + pos] = t * 4 + 0; GATE[t * 4 + 0] = inv;
        pos = atomicAdd(&cnt[i1], 1); LIST[(size_t)i1 * LISTCAP + pos] = t * 4 + 1; GATE[t * 4 + 1] = e1 * inv;
        pos = atomicAdd(&cnt[i2], 1); LIST[(size_t)i2 * LISTCAP + pos] = t * 4 + 2; GATE[t * 4 + 2] = e2 * inv;
        pos = atomicAdd(&cnt[i3], 1); LIST[(size_t)i3 * LISTCAP + pos] = t * 4 + 3; GATE[t * 4 + 3] = e3 * inv;
    }
}

template <int WHICH>
__device__ __forceinline__ void moe_gemm_phase(const Params& p, int layer, char* smem, int bid, int nb) {
    const int* cnt = (const int*)(p.ws + OFF_CNT) + layer * 32;
    const int* LIST = (const int*)(p.ws + OFF_LIST);
    int* sRow = (int*)(smem + G8_ROWS_OFF);
    constexpr int NTN = WHICH == 1 ? 8 : 4;
    int e = 0, base = 0, ce = cnt[0], mt = (ce + 255) >> 8;
    for (int t = bid;; t += nb) {
        while (e < 32 && t >= base + mt * NTN) { base += mt * NTN; ++e; if (e < 32) { ce = cnt[e]; mt = (ce + 255) >> 8; } }
        if (e >= 32) break;
        const int loc = t - base, mi = loc / NTN, ni = loc - mi * NTN;
        __syncthreads();
        if (otid() < 256) { const int r = mi * 256 + otid(); sRow[otid()] = r < ce ? LIST[(size_t)e * LISTCAP + r] : -1; }
        __syncthreads();
        if (WHICH == 1) {
            const bf16_t* Bt = (const bf16_t*)(p.ws + OFF_WT_W1) + (size_t)(layer * 32 + e) * 2048 * 1024;
            const float* b1 = p.moe_b1 + (size_t)(layer * 32 + e) * 2048;
            bf16_t* ACT = (bf16_t*)(p.ws + OFF_ACT);
            gemm256_tile<true>((const bf16_t*)(p.ws + OFF_XB), 1024, 2, 0, Bt, 1024, ni * 256, 1024, smem,
                [&](f32x4 (&acc)[4][2], int rt0, int c0, int fr, int fq) {
                    const int gcol = (c0 >> 5) * 16 + 4 * fq;
                    const f32x4 bg = *(const f32x4*)(b1 + gcol), bl = *(const f32x4*)(b1 + 1024 + gcol);
#pragma unroll
                    for (int m = 0; m < 4; ++m) {
                        const int pair = sRow[rt0 + m * 16 + fr];
                        if (pair >= 0) {
                            float a[4];
#pragma unroll
                            for (int r = 0; r < 4; ++r) {
                                const float gl = fminf(acc[m][0][r] + bg[r], 7.f);
                                const float li = fminf(fmaxf(acc[m][1][r] + bl[r], -7.f), 7.f);
                                a[r] = gl * sigmoidf_(1.702f * gl) * (li + 1.f);
                            }
                            u32x2 w; w.x = pk2(a[0], a[1]); w.y = pk2(a[2], a[3]);
                            *(u32x2*)(ACT + (size_t)pair * 1024 + gcol) = w;
                        }
                    }
                });
        } else {
            const bf16_t* Bt = (const bf16_t*)(p.ws + OFF_WT_W2) + (size_t)(layer * 32 + e) * 1024 * 1024;
            const float* b2 = p.moe_b2 + (size_t)(layer * 32 + e) * 1024;
            const float* GATE = (const float*)(p.ws + OFF_GATE);
            float* SLOT = (float*)(p.ws + OFF_SLOT);
            gemm256_tile<true>((const bf16_t*)(p.ws + OFF_ACT), 1024, 0, 0, Bt, 1024, ni * 256, 1024, smem,
                [&](f32x4 (&acc)[4][2], int rt0, int c0, int fr, int fq) {
                    const int col = c0 + 8 * fq;
                    const f32x4 b20 = *(const f32x4*)(b2 + col), b21 = *(const f32x4*)(b2 + col + 4);
#pragma unroll
                    for (int m = 0; m < 4; ++m) {
                        const int pair = sRow[rt0 + m * 16 + fr];
                        if (pair >= 0) {
                            const float gt = GATE[pair];
                            *(f32x4*)(SLOT + (size_t)pair * 1024 + col) = (acc[m][0] + b20) * gt;
                            *(f32x4*)(SLOT + (size_t)pair * 1024 + col + 4) = (acc[m][1] + b21) * gt;
                        }
                    }
                });
        }
    }
}

__device__ __forceinline__ void epi_od_in(const Params& p, f32x4 (&acc)[4][2], int row0, int c0, int fr, int fq) {
    char* ws = p.ws;
    bf16_t* PO = (bf16_t*)(ws + OFF_PO); float* WI = (float*)(ws + OFF_WI); bf16_t* VTC = (bf16_t*)(ws + OFF_VTC); bf16_t* VTD = (bf16_t*)(ws + OFF_VTD);
    const int col = c0 + 8 * fq;
#pragma unroll
    for (int m = 0; m < 4; ++m) {
        const int t = row0 + m * 16 + fr;
        if (c0 < 6464) {
            u32x4 w; w.x = pk2(acc[m][0][0], acc[m][0][1]); w.y = pk2(acc[m][0][2], acc[m][0][3]); w.z = pk2(acc[m][1][0], acc[m][1][1]); w.w = pk2(acc[m][1][2], acc[m][1][3]);
            *(u32x4*)(PO + (size_t)t * OD_N + col) = w;
            const int b = t >> 14, pos = t & (L_ - 1);
            bf16_t* vp = nullptr;
            if (c0 >= 1024 && c0 < 1536) {
                const int c = col - 1024, hd = c >> 6, d = c & 63;
                vp = VTC + ((size_t)((b * 8 + hd) * 64 + d)) * L_ + pos;
            } else if (c0 >= 4864 && c0 < 6400) {
                const int c = col - 4864, g = c >> 9, hd = (c >> 6) & 7, d = c & 63, sh = 2 * g;
                vp = VTD + ((size_t)(((b * 3 + g) * 8 + hd) * 64 + d)) * L_ + (size_t)(pos & ((1 << sh) - 1)) * (L_ >> sh) + (pos >> sh);
            }
            if (vp) {
                vp[0] = (bf16_t)(w.x & 0xffffu); vp[(size_t)L_] = (bf16_t)(w.x >> 16); vp[(size_t)2 * L_] = (bf16_t)(w.y & 0xffffu); vp[(size_t)3 * L_] = (bf16_t)(w.y >> 16);
                vp[(size_t)4 * L_] = (bf16_t)(w.z & 0xffffu); vp[(size_t)5 * L_] = (bf16_t)(w.z >> 16); vp[(size_t)6 * L_] = (bf16_t)(w.w & 0xffffu); vp[(size_t)7 * L_] = (bf16_t)(w.w >> 16);
            }
        } else if (col == 6464) {
            *(f32x4*)(WI + (size_t)t * 4) = acc[m][0];
        }
    }
}

__device__ __forceinline__ void idx_scores(const char* __restrict__ ktile, int kbase, const bf16x8 (&qf)[4][4], const float (&wi)[4], int lane, float (&sc)[16]) {
    const int r = lane & 31, h2 = lane >> 5;
    const char* kp = ktile + (kbase + r) * 144 + h2 * 16;
    bf16x8 kf[4];
#pragma unroll
    for (int s = 0; s < 4; ++s) kf[s] = *(const bf16x8*)(kp + s * 32);
#pragma unroll
    for (int i = 0; i < 16; ++i) sc[i] = 0.f;
#pragma unroll
    for (int hd = 0; hd < 4; ++hd) {
        f32x16 a;
#pragma unroll
        for (int i = 0; i < 16; ++i) a[i] = 0.f;
#pragma unroll
        for (int s = 0; s < 4; ++s) a = __builtin_amdgcn_mfma_f32_32x32x16_bf16(kf[s], qf[hd][s], a, 0, 0, 0);
#pragma unroll
        for (int i = 0; i < 16; ++i) sc[i] += wi[hd] * fmaxf(a[i], 0.f);
    }
}
__device__ __forceinline__ unsigned ord_key(float s) {
    unsigned u = __float_as_uint(s);
    if (u == 0x80000000u) u = 0u;
    return (u & 0x80000000u) ? ~u : (u | 0x80000000u);
}

constexpr int SEL_KT = 128 * 144;
__device__ __forceinline__ void dsa_select_item(const Params& p, int b, int qb, char* smem) {
    unsigned* hist = (unsigned*)smem;
    unsigned* pref = (unsigned*)(smem + 66048);
    int* krem = (int*)(smem + 66048 + 256);
    unsigned* GW = (unsigned*)(smem + 66048 + 512);
    unsigned* EW = (unsigned*)(smem + 66048 + 512 + 1024);
    char* kbuf = smem + 69632;
    const bf16_t* PO = (const bf16_t*)(p.ws + OFF_PO);
    const float* WI = (const float*)(p.ws + OFF_WI);
    unsigned long long* BMT = (unsigned long long*)(p.ws + OFF_BM);
    const int tid = otid(), lane = tid & 63, wave = tid >> 6, kw = wave >> 1, qw = wave & 1, h2 = lane >> 5;
    const int p0 = qb * 64;
    const int ql = qw * 32 + (lane & 31);
    const int qpos = p0 + ql;
    const size_t tq = (size_t)b * L_ + qpos;
    const int nkt = (p0 + 64 + 127) >> 7;
    bf16x8 qf[4][4]; float wi[4];
#pragma unroll
    for (int hd = 0; hd < 4; ++hd) {
        wi[hd] = WI[tq * 4 + hd];
#pragma unroll
        for (int s = 0; s < 4; ++s) qf[hd][s] = *(const bf16x8*)(PO + tq * OD_N + OD_QI + hd * 64 + s * 16 + h2 * 8);
    }
    const int srow = tid >> 3, sch = tid & 7;
    const bf16_t* ksrc = PO + ((size_t)b * L_ + srow) * OD_N + OD_KI + sch * 8;
    char* kdst = kbuf + srow * 144 + sch * 16;
    for (int e = tid; e < 64 * 257; e += NTHR) hist[e] = 0u;
    if (tid < 64) { pref[tid] = 0u; krem[tid] = 256; }
    __syncthreads();
    const bool selall = qpos < 256;
    const int npass = (p0 + 63 >= 256) ? 4 : 0;
    for (int pass = 0; pass <= npass; ++pass) {
        const bool maskpass = pass == npass;
        const int sh = 24 - 8 * pass;
        const unsigned mypref = pref[ql];
        int ceq = 0;
        const int rsel = tid < 64 ? krem[tid] : 0;
        u32x4 r0 = *(const u32x4*)ksrc, r1 = *(const u32x4*)(ksrc + (size_t)64 * OD_N);
        *(u32x4*)kdst = r0; *(u32x4*)(kdst + 64 * 144) = r1;
        __syncthreads();
        for (int kt = 0; kt < nkt; ++kt) {
            const bool more = kt + 1 < nkt;
            if (more) { r0 = *(const u32x4*)(ksrc + (size_t)(kt + 1) * 128 * OD_N); r1 = *(const u32x4*)(ksrc + (size_t)((kt + 1) * 128 + 64) * OD_N); }
            float sc[16];
            idx_scores(kbuf + (kt & 1) * SEL_KT, kw * 32, qf, wi, lane, sc);
            const int keybase = kt * 128 + kw * 32;
            if (!maskpass) {
#pragma unroll
                for (int i = 0; i < 16; ++i) {
                    const int key = keybase + (i & 3) + 8 * (i >> 2) + 4 * h2;
                    const unsigned k32 = ord_key(sc[i]);
                    const bool match = pass == 0 ? true : ((k32 >> (sh + 8)) == mypref);
                    if (key <= qpos && !selall && match) atomicAdd(&hist[ql * 257 + ((k32 >> sh) & 255u)], 1u);
                }
                if (more) { char* nd = kdst + ((kt + 1) & 1) * SEL_KT; *(u32x4*)nd = r0; *(u32x4*)(nd + 64 * 144) = r1; }
                __syncthreads();
            } else {
                unsigned gw = 0u, ew = 0u;
#pragma unroll
                for (int i = 0; i < 16; ++i) {
                    const int ko = (i & 3) + 8 * (i >> 2) + 4 * h2;
                    const int key = keybase + ko;
                    const unsigned k32 = ord_key(sc[i]);
                    const bool valid = key <= qpos;
                    const bool g = valid && (selall || k32 > mypref);
                    const bool e = valid && !selall && k32 == mypref;
                    gw |= (g ? 1u : 0u) << ko; ew |= (e ? 1u : 0u) << ko;
                }
                gw |= __shfl_xor(gw, 32, 64); ew |= __shfl_xor(ew, 32, 64);
                if (h2 == 0) { GW[ql * 4 + kw] = gw; EW[ql * 4 + kw] = ew; }
                if (more) { char* nd = kdst + ((kt + 1) & 1) * SEL_KT; *(u32x4*)nd = r0; *(u32x4*)(nd + 64 * 144) = r1; }
                __syncthreads();
                if (tid < 64) {
                    unsigned g4[4], e4[4];
#pragma unroll
                    for (int w = 0; w < 4; ++w) { g4[w] = GW[tid * 4 + w]; e4[w] = EW[tid * 4 + w]; }
                    int need = rsel - ceq; if (need < 0) need = 0;
#pragma unroll
                    for (int w = 0; w < 4; ++w) {
                        const int pc = __popc(e4[w]);
                        ceq += pc;
                        if (need >= pc) need -= pc;
                        else { unsigned m = e4[w], kept = 0u; for (int k = 0; k < need; ++k) { const unsigned low = m & (0u - m); kept |= low; m ^= low; } e4[w] = kept; need = 0; }
                        g4[w] |= e4[w];
                    }
                    BMT[((size_t)(b * 256 + 2 * kt)) * L_ + p0 + tid] = (unsigned long long)g4[0] | ((unsigned long long)g4[1] << 32);
                    BMT[((size_t)(b * 256 + 2 * kt + 1)) * L_ + p0 + tid] = (unsigned long long)g4[2] | ((unsigned long long)g4[3] << 32);
                }
                __syncthreads();
            }
        }
        if (!maskpass) {
            const int q = tid >> 3, part = tid & 7;
            unsigned c32[32]; unsigned tot = 0u;
#pragma unroll
            for (int i = 0; i < 32; ++i) { c32[i] = hist[q * 257 + part * 32 + i]; tot += c32[i]; }
            unsigned above = 0u;
#pragma unroll
            for (int d = 1; d < 8; ++d) { const unsigned o = __shfl(tot, (lane & ~7) + ((part + d) & 7), 64); if (part + d < 8) above += o; }
            const unsigned need = (unsigned)krem[q];
            __syncthreads();
            if ((p0 + q) >= 256 && above < need && above + tot >= need) {
                unsigned cum = above; int dg = 31;
#pragma unroll
                for (int i = 31; i >= 0; --i) { if (i == dg) { if (cum + c32[i] >= need) {   } else { cum += c32[i]; dg = i - 1; } } }
                pref[q] = (pref[q] << 8) | (unsigned)(part * 32 + dg);
                krem[q] = (int)(need - cum);
            }
            for (int e = tid; e < 64 * 257; e += NTHR) hist[e] = 0u;
            __syncthreads();
        }
    }
}

template <int MODE, int NQT>
__device__ __forceinline__ void attn_wave(const Params& p, int b, int head, int qcol, int kcol, const bf16_t* __restrict__ VT, int voff,
                                          int i0, int sh  , int rho, int kt_lo, int kt_hi, int grp) {
    const bf16_t* PO = (const bf16_t*)(p.ws + OFF_PO);
    const unsigned* BM32 = (const unsigned*)(p.ws + OFF_BM);
    const int lane = otid() & 63, r = lane & 31, h2 = lane >> 5;
    const int pr = (r & 0x13) | ((r & 4) << 1) | ((r & 8) >> 1);
    const float SC = 0.125f * 1.4426950408889634f;
    bf16x8 qf[NQT][4]; size_t tq[NQT]; int qi[NQT];
#pragma unroll
    for (int qt = 0; qt < NQT; ++qt) {
        qi[qt] = i0 + qt * 32 + r;
        tq[qt] = (size_t)b * L_ + ((size_t)qi[qt] << sh) + rho;
#pragma unroll
        for (int s = 0; s < 4; ++s) qf[qt][s] = *(const bf16x8*)(PO + tq[qt] * OD_N + qcol + head * 64 + s * 16 + h2 * 8);
    }
    f32x16 oacc[NQT][2];
#pragma unroll
    for (int a = 0; a < NQT; ++a)
#pragma unroll
        for (int c = 0; c < 2; ++c)
#pragma unroll
            for (int i = 0; i < 16; ++i) oacc[a][c][i] = 0.f;
    float mrun[NQT], lrun[NQT];
#pragma unroll
    for (int a = 0; a < NQT; ++a) { mrun[a] = -1e30f; lrun[a] = 0.f; }
    bf16x8 kf[4]; unsigned mw[NQT];
    auto load_k = [&](int kt, bf16x8 (&k_)[4], unsigned (&m_)[NQT]) {
        const size_t krow = (size_t)b * L_ + ((size_t)(kt * 32 + pr) << sh) + rho;
#pragma unroll
        for (int s = 0; s < 4; ++s) k_[s] = *(const bf16x8*)(PO + krow * OD_N + kcol + head * 64 + s * 16 + h2 * 8);
#pragma unroll
        for (int a = 0; a < NQT; ++a) m_[a] = MODE == 0 ? BM32[tq[a] * 512 + kt] : 0u;
    };
    load_k(kt_lo, kf, mw);
#pragma unroll 1
    for (int kt = kt_lo; kt <= kt_hi; ++kt) {
        bf16x8 vf[2][2];
#pragma unroll
        for (int db = 0; db < 2; ++db)
#pragma unroll
            for (int s2 = 0; s2 < 2; ++s2) vf[db][s2] = *(const bf16x8*)(VT + (size_t)(db * 32 + r) * L_ + voff + kt * 32 + s2 * 16 + h2 * 8);
        bf16x8 kn[4]; unsigned mn[NQT];
#pragma unroll
        for (int a = 0; a < NQT; ++a) mn[a] = 0u;
        if (kt < kt_hi) load_k(kt + 1, kn, mn);
#pragma unroll
        for (int qt = 0; qt < NQT; ++qt) {
            f32x16 s;
#pragma unroll
            for (int i = 0; i < 16; ++i) s[i] = 0.f;
#pragma unroll
            for (int ks = 0; ks < 4; ++ks) s = __builtin_amdgcn_mfma_f32_32x32x16_bf16(kf[ks], qf[qt][ks], s, 0, 0, 0);
            unsigned selm = 0u; float mx = -1e30f;
#pragma unroll
            for (int i = 0; i < 16; ++i) {
                const int ko = 16 * (i >> 3) + 8 * h2 + 4 * ((i >> 2) & 1) + (i & 3);
                bool sl;
                if (MODE == 0) sl = (mw[qt] >> ko) & 1u;
                else { const int kk = kt * 32 + ko; sl = (kk <= qi[qt]) && (kk >= qi[qt] - 128); }
                selm |= (sl ? 1u : 0u) << i;
                s[i] = sl ? s[i] * SC : -1e30f;
                mx = fmaxf(mx, s[i]);
            }
            mx = fmaxf(mx, __shfl_xor(mx, 32, 64));
            const float mnew = fmaxf(mrun[qt], mx);
            const float corr = __builtin_amdgcn_exp2f(mrun[qt] - mnew);
            mrun[qt] = mnew;
            float ps = 0.f;
#pragma unroll
            for (int i = 0; i < 16; ++i) { s[i] = ((selm >> i) & 1u) ? __builtin_amdgcn_exp2f(s[i] - mnew) : 0.f; ps += s[i]; }
            lrun[qt] = lrun[qt] * corr + ps;
#pragma unroll
            for (int db = 0; db < 2; ++db)
#pragma unroll
                for (int i = 0; i < 16; ++i) oacc[qt][db][i] *= corr;
#pragma unroll
            for (int s2 = 0; s2 < 2; ++s2) {
                u32x4 pw; pw.x = pk2(s[8 * s2], s[8 * s2 + 1]); pw.y = pk2(s[8 * s2 + 2], s[8 * s2 + 3]); pw.z = pk2(s[8 * s2 + 4], s[8 * s2 + 5]); pw.w = pk2(s[8 * s2 + 6], s[8 * s2 + 7]);
                const bf16x8 pf = __builtin_bit_cast(bf16x8, pw);
#pragma unroll
                for (int db = 0; db < 2; ++db) oacc[qt][db] = __builtin_amdgcn_mfma_f32_32x32x16_bf16(vf[db][s2], pf, oacc[qt][db], 0, 0, 0);
            }
        }
        if (kt < kt_hi) {
#pragma unroll
            for (int s = 0; s < 4; ++s) kf[s] = kn[s];
#pragma unroll
            for (int a = 0; a < NQT; ++a) mw[a] = mn[a];
        }
    }
#pragma unroll
    for (int qt = 0; qt < NQT; ++qt) {
        const float lt = lrun[qt] + __shfl_xor(lrun[qt], 32, 64);
        const float inv = 1.f / lt;
        if (MODE == 0) {
            bf16_t* CC = (bf16_t*)(p.ws + OFF_CC);
#pragma unroll
            for (int db = 0; db < 2; ++db)
#pragma unroll
                for (int i = 0; i < 16; ++i) {
                    const int d = db * 32 + (i & 3) + 8 * (i >> 2) + 4 * h2;
                    CC[tq[qt] * 1024 + head * 64 + d] = f2bf(oacc[qt][db][i] * inv);
                }
        } else {
            float* OD = (float*)(p.ws + OFF_OD) + (size_t)grp * T_ * 512;
#pragma unroll
            for (int db = 0; db < 2; ++db)
#pragma unroll
                for (int i = 0; i < 16; ++i) {
                    const int d = db * 32 + (i & 3) + 8 * (i >> 2) + 4 * h2;
                    OD[tq[qt] * 512 + head * 64 + d] = oacc[qt][db][i] * inv;
                }
            if (h2 == 0) ((float*)(p.ws + OFF_LSE))[((size_t)grp * T_ + tq[qt]) * 8 + head] = mrun[qt] + log2f(lt);
        }
    }
}

__device__ __forceinline__ void dil_combine_phase(const Params& p, int bid, int nb) {
    const float* OD = (const float*)(p.ws + OFF_OD); const float* LSE = (const float*)(p.ws + OFF_LSE);
    bf16_t* CC = (bf16_t*)(p.ws + OFF_CC);
    const long n = (long)T_ * 128;
    for (long c = (long)bid * NTHR + otid(); c < n; c += (long)nb * NTHR) {
        const long t = c >> 7; const int ch = (int)(c & 127) * 4, hd = ch >> 6;
        const float l0 = LSE[((size_t)0 * T_ + t) * 8 + hd], l1 = LSE[((size_t)1 * T_ + t) * 8 + hd], l2 = LSE[((size_t)2 * T_ + t) * 8 + hd];
        const float mx = fmaxf(l0, fmaxf(l1, l2));
        const float w0 = exp2f(l0 - mx), w1 = exp2f(l1 - mx), w2 = exp2f(l2 - mx);
        const float inv = 1.f / (w0 + w1 + w2);
        const f32x4 a = *(const f32x4*)(OD + ((size_t)0 * T_ + t) * 512 + ch), bq = *(const f32x4*)(OD + ((size_t)1 * T_ + t) * 512 + ch),
                    cq = *(const f32x4*)(OD + ((size_t)2 * T_ + t) * 512 + ch);
        const f32x4 o = (a * w0 + bq * w1 + cq * w2) * inv;
        u32x2 w; w.x = pk2(o[0], o[1]); w.y = pk2(o[2], o[3]);
        *(u32x2*)(CC + (size_t)t * 1024 + 512 + ch) = w;
    }
}

constexpr int DA_ROW = 144;
constexpr int DA_TILE = 64 * DA_ROW;
__device__ __forceinline__ void dsa_attn_item(const Params& p, int b, int head, int qb, char* smem) {
    const bf16_t* PO = (const bf16_t*)(p.ws + OFF_PO);
    const bf16_t* VT = (const bf16_t*)(p.ws + OFF_VTC) + ((size_t)(b * 8 + head)) * 64 * L_;
    const int tid = otid(), lane = tid & 63, wave = tid >> 6, r = lane & 31, h2 = lane >> 5;
    const int pr = (r & 0x13) | ((r & 4) << 1) | ((r & 8) >> 1);
    const float SC = 0.125f * 1.4426950408889634f;
    const int i0 = qb * 256 + wave * 32, qi = i0 + r;
    const unsigned long long* BMT = (const unsigned long long*)(p.ws + OFF_BM) + (size_t)b * 256 * L_ + qi;
    const size_t tq = (size_t)b * L_ + qi;
    bf16x8 qf[4];
#pragma unroll
    for (int s = 0; s < 4; ++s) qf[s] = *(const bf16x8*)(PO + tq * OD_N + head * 64 + s * 16 + h2 * 8);
    f32x16 oacc[2];
#pragma unroll
    for (int c = 0; c < 2; ++c)
#pragma unroll
        for (int i = 0; i < 16; ++i) oacc[c][i] = 0.f;
    float mrun = -1e30f, lrun = 0.f;
    const int nkt = qb * 4 + 4, my_last = (i0 + 31) >> 6;
    const int srow = tid >> 3, sch = tid & 7;
    const bf16_t* ksrc = PO + ((size_t)b * L_ + srow) * OD_N + 512 + head * 64 + sch * 8;
    const bf16_t* vsrc = VT + (size_t)srow * L_ + sch * 8;
    u32x4 rk = *(const u32x4*)ksrc, rv = *(const u32x4*)vsrc;
    __syncthreads();
    *(u32x4*)(smem + srow * DA_ROW + sch * 16) = rk;
    *(u32x4*)(smem + DA_TILE + srow * DA_ROW + sch * 16) = rv;
    __syncthreads();
    unsigned long long mwn = BMT[0];
#pragma unroll 1
    for (int kt = 0; kt < nkt; ++kt) {
        const bool more = kt + 1 < nkt;
        if (more) { rk = *(const u32x4*)(ksrc + (size_t)(kt + 1) * 64 * OD_N); rv = *(const u32x4*)(vsrc + (kt + 1) * 64); }
        const unsigned long long mw64 = mwn;
        if (kt < my_last) mwn = BMT[(size_t)(kt + 1) * L_];
        if (kt <= my_last) {
            const char* kb = smem + (kt & 1) * 2 * DA_TILE; const char* vb = kb + DA_TILE;
#pragma unroll
            for (int sub = 0; sub < 2; ++sub) {
                const unsigned mw = sub == 0 ? (unsigned)mw64 : (unsigned)(mw64 >> 32);
                bf16x8 kf[4], vf[2][2];
#pragma unroll
                for (int s = 0; s < 4; ++s) kf[s] = *(const bf16x8*)(kb + (sub * 32 + pr) * DA_ROW + (s * 16 + h2 * 8) * 2);
#pragma unroll
                for (int db = 0; db < 2; ++db)
#pragma unroll
                    for (int s2 = 0; s2 < 2; ++s2) vf[db][s2] = *(const bf16x8*)(vb + (db * 32 + r) * DA_ROW + (sub * 32 + s2 * 16 + h2 * 8) * 2);
                f32x16 s;
#pragma unroll
                for (int i = 0; i < 16; ++i) s[i] = 0.f;
#pragma unroll
                for (int ks = 0; ks < 4; ++ks) s = __builtin_amdgcn_mfma_f32_32x32x16_bf16(kf[ks], qf[ks], s, 0, 0, 0);
                float mx = fmaxf(fmaxf(s[0], s[1]), fmaxf(s[2], s[3]));
#pragma unroll
                for (int i = 4; i < 16; i += 2) mx = fmaxf(mx, fmaxf(s[i], s[i + 1]));
                mx = fmaxf(mx, __shfl_xor(mx, 32, 64)) * SC;
                if (__builtin_amdgcn_ballot_w64(mx > mrun) != 0ull) {
                    const float mnew = fmaxf(mrun, mx);
                    const float corr = __builtin_amdgcn_exp2f(mrun - mnew);
                    mrun = mnew; lrun *= corr;
#pragma unroll
                    for (int db = 0; db < 2; ++db)
#pragma unroll
                        for (int i = 0; i < 16; ++i) oacc[db][i] *= corr;
                }
                float ps = 0.f;
                const int mws = (int)(mw >> (8 * h2));
#pragma unroll
                for (int i = 0; i < 16; ++i) {
                    const int ko = 16 * (i >> 3) + 4 * ((i >> 2) & 1) + (i & 3);
                    const float e = __builtin_amdgcn_exp2f(__builtin_fmaf(s[i], SC, -mrun));
                    s[i] = __uint_as_float(__float_as_uint(e) & (unsigned)__builtin_amdgcn_sbfe(mws, ko, 1));
                    ps += s[i];
                }
                lrun += ps;
#pragma unroll
                for (int s2 = 0; s2 < 2; ++s2) {
                    u32x4 pw; pw.x = pk2(s[8 * s2], s[8 * s2 + 1]); pw.y = pk2(s[8 * s2 + 2], s[8 * s2 + 3]); pw.z = pk2(s[8 * s2 + 4], s[8 * s2 + 5]); pw.w = pk2(s[8 * s2 + 6], s[8 * s2 + 7]);
                    const bf16x8 pf = __builtin_bit_cast(bf16x8, pw);
#pragma unroll
                    for (int db = 0; db < 2; ++db) oacc[db] = __builtin_amdgcn_mfma_f32_32x32x16_bf16(vf[db][s2], pf, oacc[db], 0, 0, 0);
                }
            }
        }
        if (more) {
            char* nbuf = smem + ((kt + 1) & 1) * 2 * DA_TILE;
            *(u32x4*)(nbuf + srow * DA_ROW + sch * 16) = rk;
            *(u32x4*)(nbuf + DA_TILE + srow * DA_ROW + sch * 16) = rv;
        }
        __syncthreads();
    }
    const float lt = lrun + __shfl_xor(lrun, 32, 64);
    const float inv = 1.f / lt;
    bf16_t* CC = (bf16_t*)(p.ws + OFF_CC);
#pragma unroll
    for (int db = 0; db < 2; ++db)
#pragma unroll
        for (int i = 0; i < 16; i += 4) {
            const int d = db * 32 + 8 * (i >> 2) + 4 * h2;
            u32x2 w; w.x = pk2(oacc[db][i] * inv, oacc[db][i + 1] * inv); w.y = pk2(oacc[db][i + 2] * inv, oacc[db][i + 3] * inv);
            *(u32x2*)(CC + tq * 1024 + head * 64 + d) = w;
        }
}

enum { K_PRO = 0, K_E1, K_E2, K_E3, K_E4, K_E5, K_E6, K_LN1, K_O1, K_O2, K_O3, K_O4, K_M1, K_M2, K_M3, K_M4, K_LN2, K_COUNT };

template <int KIND>
__device__ __forceinline__ void run_phase(const Params& p, int layer, char* smem, int bid, int nb) {
    char* ws = p.ws;
    const int j = layer >> 1;
    if (KIND == K_PRO) {
        conv_phase(p, smem, bid, nb);
        __syncthreads();
        for (int u = nb - 1 - bid; u < 64; u += nb) s5mat_unit(p, u >> 5, u & 31, smem);
    } else if (KIND == K_E1) {
        gemm256_phase((const bf16_t*)(ws + OFF_XB), 1024, T_, (const bf16_t*)(ws + OFF_WT_EVIN) + (size_t)j * EV_N * 1024, 1024, EV_N, 1024, smem, bid, nb,
                   [&](f32x4 (&acc)[4][2], int row0, int c0, int fr, int fq) { epi_ev_in(p, acc, row0, c0, fr, fq); });
    } else if (KIND == K_E2) {
        for (int it = bid; it < 2048; it += nb) gla_a_item(p, j, it, smem);
        s5_g_phase(p, j, smem, bid, nb);
    } else if (KIND == K_E3) {
        scan_phase(p, j, bid);
    } else if (KIND == K_E4) {
        for (int it = bid; it < 2048; it += nb) gla_c_item(p, j, it, smem);
        s5_y_phase(p, j, smem, bid, nb);
    } else if (KIND == K_E5) {
        const bf16_t* YA = (const bf16_t*)(ws + OFF_YA); bf16_t* CC = (bf16_t*)(ws + OFF_CC); const float* bg = p.s5_b_glu + (size_t)j * 512;
        gemm256_phase(YA, 512, T_, (const bf16_t*)(ws + OFF_WT_GLU) + (size_t)j * 512 * 512, 512, 512, 512, smem, bid, nb,
                   [&](f32x4 (&acc)[4][2], int row0, int c0, int fr, int fq) {
                       const int col = c0 + 8 * fq;
                       const f32x4 g0 = *(const f32x4*)(bg + col), g1 = *(const f32x4*)(bg + col + 4);
#pragma unroll
                       for (int m = 0; m < 4; ++m) {
                           const size_t t = (size_t)(row0 + m * 16 + fr);
                           const u32x4 yw = *(const u32x4*)(YA + t * 512 + col);
                           float o[8];
#pragma unroll
                           for (int q = 0; q < 4; ++q) {
                               const unsigned y2 = q == 0 ? yw.x : q == 1 ? yw.y : q == 2 ? yw.z : yw.w;
                               const float y0 = __uint_as_float(y2 << 16), y1 = __uint_as_float(y2 & 0xffff0000u);
                               const float a0 = q < 2 ? acc[m][0][2 * q] + g0[2 * q] : acc[m][1][2 * q - 4] + g1[2 * q - 4];
                               const float a1 = q < 2 ? acc[m][0][2 * q + 1] + g0[2 * q + 1] : acc[m][1][2 * q - 3] + g1[2 * q - 3];
                               o[2 * q] = y0 * sigmoidf_(a0); o[2 * q + 1] = y1 * sigmoidf_(a1);
                           }
                           u32x4 w; w.x = pk2(o[0], o[1]); w.y = pk2(o[2], o[3]); w.z = pk2(o[4], o[5]); w.w = pk2(o[6], o[7]);
                           *(u32x4*)(CC + t * 1024 + 512 + col) = w;
                       }
                   });
    } else if (KIND == K_E6 || KIND == K_O4) {
        float* MIX = (float*)(ws + OFF_MIX);
        const bf16_t* W = (const bf16_t*)(ws + (KIND == K_E6 ? OFF_WT_EVOUT : OFF_WT_ODOUT)) + (size_t)j * 1024 * 1024;
        gemm256_phase((const bf16_t*)(ws + OFF_CC), 1024, T_, W, 1024, 1024, 1024, smem, bid, nb,
                   [&](f32x4 (&acc)[4][2], int row0, int c0, int fr, int fq) {
#pragma unroll
                       for (int m = 0; m < 4; ++m) {
                           float* o = MIX + (size_t)(row0 + m * 16 + fr) * 1024 + c0 + 8 * fq;
                           *(f32x4*)o = acc[m][0]; *(f32x4*)(o + 4) = acc[m][1];
                       }
                   });
    } else if (KIND == K_LN1) {
        const float* xin = layer == 0 ? p.x : (const float*)(ws + OFF_XR);
        ln_phase<false>(p, xin, (const float*)(ws + OFF_MIX), p.ln1_g + (size_t)layer * 1024, p.ln1_b + (size_t)layer * 1024, (float*)(ws + OFF_XR), (bf16_t*)(ws + OFF_XB), bid, nb);
    } else if (KIND == K_O1) {
        gemm256_phase((const bf16_t*)(ws + OFF_XB), 1024, T_, (const bf16_t*)(ws + OFF_WT_ODIN) + (size_t)j * OD_N * 1024, 1024, OD_N, 1024, smem, bid, nb,
                   [&](f32x4 (&acc)[4][2], int row0, int c0, int fr, int fq) { epi_od_in(p, acc, row0, c0, fr, fq); });
    } else if (KIND == K_O2) {
        for (int k = bid; k < 256; k += nb) {
            dsa_select_item(p, k & 1, k >> 1, smem);
            __syncthreads();
            const int k2 = 511 - k;
            dsa_select_item(p, k2 & 1, k2 >> 1, smem);
            __syncthreads();
        }
        const int head = otid() >> 6;
        for (int it = bid; it < 1536; it += nb) {
            const int b = it / 768, rem = it - b * 768, g = rem >> 8, u = rem & 255;
            const int sh = g * 2, per = 256 >> sh, rho = u / per, qblk = u - rho * per;
            const bf16_t* VT = (const bf16_t*)(ws + OFF_VTD) + ((size_t)((b * 3 + g) * 8 + head)) * 64 * L_;
#pragma unroll 1
            for (int hf = 0; hf < 2; ++hf) {
                const int hi = 2 * qblk + hf, lo = hi - 4;
                attn_wave<1, 1>(p, b, head, OD_DIL + g * 512, OD_DIL + 1536 + g * 512, VT, rho * (L_ >> sh), qblk * 64 + hf * 32, sh, rho, lo < 0 ? 0 : lo, hi, g);
            }
        }
    } else if (KIND == K_O3) {
        for (int k = bid; k < 512; k += nb) {
            const int bh = k >> 5, q0 = k & 31;
#pragma unroll 1
            for (int half = 0; half < 2; ++half) dsa_attn_item(p, bh >> 3, bh & 7, half == 0 ? q0 : 63 - q0, smem);
        }
        dil_combine_phase(p, bid, nb);
    } else if (KIND == K_M1) {
        float* LG = (float*)(ws + OFF_LOGIT); const float* rb = p.router_b + (size_t)layer * 32;
        gemm_phase((const bf16_t*)(ws + OFF_XB), 1024, T_, (const bf16_t*)(ws + OFF_WT_RT) + (size_t)layer * 128 * 1024, 1024, 128, 1024, smem, bid, nb,
                   [&](f32x4 (&acc)[4][2], int row0, int c0, int fr, int fq) {
#pragma unroll
                       for (int n = 0; n < 2; ++n) {
                           const int col = c0 + n * 16 + fr;
                           if (col < 32) {
#pragma unroll
                               for (int m = 0; m < 4; ++m)
#pragma unroll
                                   for (int r = 0; r < 4; ++r) LG[(size_t)(row0 + m * 16 + fq * 4 + r) * 32 + col] = acc[m][n][r] + rb[col];
                           }
                       }
                   });
    } else if (KIND == K_M2) {
        topk_phase(p, layer, bid, nb);
    } else if (KIND == K_M3) {
        moe_gemm_phase<1>(p, layer, smem, bid, nb);
    } else if (KIND == K_M4) {
        moe_gemm_phase<2>(p, layer, smem, bid, nb);
    } else if (KIND == K_LN2) {
        float* xo = layer == 3 ? p.out : (float*)(ws + OFF_XR);
        ln_phase<true>(p, (const float*)(ws + OFF_XR), (const float*)(ws + OFF_SLOT), p.ln2_g + (size_t)layer * 1024, p.ln2_b + (size_t)layer * 1024, xo,
                       layer == 3 ? (bf16_t*)nullptr : (bf16_t*)(ws + OFF_XB), bid, nb);
    }
}

extern __shared__ __attribute__((aligned(16))) char dyn_smem[];

#if !MEGA
template <int KIND>
__global__ void __launch_bounds__(NTHR, 2) k_phase(Params p, int layer) { run_phase<KIND>(p, layer, dyn_smem, blockIdx.x, gridDim.x); }
#else
#ifndef DUPMASK
#define DUPMASK 0
#endif
#define PHASE(K) do { run_phase<K>(p, layer, smem, bid, nb); xcd_barrier(bar); if ((DUPMASK >> K) & 1) { run_phase<K>(p, layer, smem, bid, nb); xcd_barrier(bar); } } while (0)
template <int LAYER>
__device__ __forceinline__ void mega_layer(const Params& p, char* smem, int bid, int nb, const XcdBarrier& bar) {
    constexpr int layer = LAYER;
    if ((layer & 1) == 0) { PHASE(K_E1); PHASE(K_E2); PHASE(K_E3); PHASE(K_E4); PHASE(K_E5); PHASE(K_E6); }
    else { PHASE(K_O1); PHASE(K_O2); PHASE(K_O3); PHASE(K_O4); }
    PHASE(K_LN1); PHASE(K_M1); PHASE(K_M2); PHASE(K_M3); PHASE(K_M4);
    run_phase<K_LN2>(p, layer, smem, bid, nb);
    if (layer < 3) xcd_barrier(bar);
}
__global__ void __launch_bounds__(NTHR, 2) k_mega(Params p) {
    char* smem = dyn_smem;
    const int bid = blockIdx.x, nb = gridDim.x;
    volatile LAS unsigned* st = (volatile LAS unsigned*)(dyn_smem + LDS_BYTES - 16);
    if (otid() == 0) { st[0] = 0u; st[1] = 0u; }
    __syncthreads();
    XcdBarrier bar = xcd_barrier_post((unsigned*)(p.ws + OFF_BAR), st);
    { const int layer = 0; PHASE(K_PRO); }
    mega_layer<0>(p, smem, bid, nb, bar);
    mega_layer<1>(p, smem, bid, nb, bar);
    mega_layer<2>(p, smem, bid, nb, bar);
    mega_layer<3>(p, smem, bid, nb, bar);
}
#endif

extern "C" void kernel_launch(void* const* d_in, const int* in_sizes, int n_in, void* d_out, int out_size, void* d_ws, size_t ws_size, hipStream_t stream) {
    Params p{};
    const float** f = (const float**)&p;
    for (int i = 0; i < 28; ++i) f[i] = (const float*)d_in[i];
    p.out = (float*)d_out; p.ws = (char*)d_ws;
    if (ws_size < WS_NEED) { fprintf(stderr, "workspace too small: %zu < %zu\n", ws_size, (size_t)WS_NEED); return; }
#if !MEGA
#define SETATTR(K) hipFuncSetAttribute((const void*)k_phase<K>, hipFuncAttributeMaxDynamicSharedMemorySize, LDS_BYTES)
#define LAUNCH(K, layer) k_phase<K><<<256, NTHR, LDS_BYTES, stream>>>(p, layer)
    static bool attr_done = false;
    if (!attr_done) {
        SETATTR(K_PRO); SETATTR(K_E1); SETATTR(K_E2); SETATTR(K_E3); SETATTR(K_E4); SETATTR(K_E5); SETATTR(K_E6); SETATTR(K_LN1); SETATTR(K_O1); SETATTR(K_O2); SETATTR(K_O3);
        SETATTR(K_O4); SETATTR(K_M1); SETATTR(K_M2); SETATTR(K_M3); SETATTR(K_M4); SETATTR(K_LN2);
        attr_done = true;
    }
    LAUNCH(K_PRO, 0);
    for (int layer = 0; layer < 4; ++layer) {
        if ((layer & 1) == 0) { LAUNCH(K_E1, layer); LAUNCH(K_E2, layer); LAUNCH(K_E3, layer); LAUNCH(K_E4, layer); LAUNCH(K_E5, layer); LAUNCH(K_E6, layer); }
        else { LAUNCH(K_O1, layer); LAUNCH(K_O2, layer); LAUNCH(K_O3, layer); LAUNCH(K_O4, layer); }
        LAUNCH(K_LN1, layer); LAUNCH(K_M1, layer); LAUNCH(K_M2, layer); LAUNCH(K_M3, layer); LAUNCH(K_M4, layer); LAUNCH(K_LN2, layer);
    }
#else
    static int grid = 0;
    if (!grid) {
        hipFuncSetAttribute((const void*)k_mega, hipFuncAttributeMaxDynamicSharedMemorySize, LDS_BYTES);
        int dev = 0, cus = 0, per_cu = 0;
        hipGetDevice(&dev);
        hipDeviceGetAttribute(&cus, hipDeviceAttributeMultiprocessorCount, dev);
        hipOccupancyMaxActiveBlocksPerMultiprocessor(&per_cu, (const void*)k_mega, NTHR, LDS_BYTES);
        grid = cus * (per_cu < 1 ? per_cu : 1);
        if (grid <= 0) grid = 0;
    }
    if (!grid) { fprintf(stderr, "occupancy query says 0 blocks per CU\n"); return; }
    hipMemsetAsync((char*)d_ws + OFF_BAR, 0, XCD_BAR_WORDS * sizeof(unsigned), stream);
    k_mega<<<grid, NTHR, LDS_BYTES, stream>>>(p);
#endif
}
```

```cpp
#include <hip/hip_runtime.h>
#include <stdint.h>
#include <stdio.h>

#ifndef MEGA
#define MEGA 1
#define DUPMASK 0
#endif

typedef unsigned short bf16_t;
typedef short bf16x8 __attribute__((ext_vector_type(8)));
typedef float f32x4 __attribute__((ext_vector_type(4)));
typedef float f32x16 __attribute__((ext_vector_type(16)));
typedef unsigned u32x4 __attribute__((ext_vector_type(4)));
typedef unsigned u32x2 __attribute__((ext_vector_type(2)));

constexpr int T_ = 32768, D_ = 1024, L_ = 16384, NB_ = 2;
constexpr int NTHR = 512;
constexpr float ALPHA = 1.681792830507429f;
constexpr float LN_EPS = 1e-5f;
constexpr int EV_N = 2304;
constexpr int OD_N = 6656;
constexpr int OD_QI = 1536, OD_DIL = 1792, OD_KI = 6400, OD_WI = 6464;
constexpr int UHW = 1152;
constexpr int LISTCAP = 131072;

constexpr size_t OFF_BAR = 0;
constexpr size_t OFF_CNT = 16384;
constexpr size_t OFF_A64 = 32768;
constexpr size_t OFF_WT_EVIN = 131072;
constexpr size_t OFF_WT_ODIN = OFF_WT_EVIN + (size_t)2 * EV_N * 1024 * 2;
constexpr size_t OFF_WT_EVOUT = OFF_WT_ODIN + (size_t)2 * OD_N * 1024 * 2;
constexpr size_t OFF_WT_ODOUT = OFF_WT_EVOUT + (size_t)2 * 1024 * 1024 * 2;
constexpr size_t OFF_WT_GLU = OFF_WT_ODOUT + (size_t)2 * 1024 * 1024 * 2;
constexpr size_t OFF_WT_RT = OFF_WT_GLU + (size_t)2 * 512 * 512 * 2;
constexpr size_t OFF_WT_W1 = OFF_WT_RT + (size_t)4 * 128 * 1024 * 2;
constexpr size_t OFF_WT_W2 = OFF_WT_W1 + (size_t)4 * 32 * 2048 * 1024 * 2;
constexpr size_t OFF_TH = OFF_WT_W2 + (size_t)4 * 32 * 1024 * 1024 * 2;
constexpr size_t OFF_GM = OFF_TH + (size_t)2 * 32 * 1024 * UHW * 2;
constexpr size_t OFF_XR = OFF_GM + (size_t)2 * 32 * 128 * 1024 * 2;
constexpr size_t OFF_XB = OFF_XR + (size_t)T_ * 1024 * 4;
constexpr size_t OFF_MIX = OFF_XB + (size_t)T_ * 1024 * 2;
constexpr size_t OFF_CC = OFF_MIX + (size_t)T_ * 1024 * 4;
constexpr size_t OFF_LOGIT = OFF_CC + (size_t)T_ * 1024 * 2;
constexpr size_t OFF_LIST = OFF_LOGIT + (size_t)T_ * 32 * 4;
constexpr size_t OFF_GATE = OFF_LIST + (size_t)32 * LISTCAP * 4;
constexpr size_t OFF_ACT = OFF_GATE + (size_t)T_ * 4 * 4;
constexpr size_t OFF_SLOT = OFF_ACT + (size_t)T_ * 4 * 1024 * 2;
constexpr size_t OFF_MIXER = OFF_SLOT + (size_t)T_ * 4 * 1024 * 4;
constexpr size_t OFF_PE = OFF_MIXER;
constexpr size_t OFF_UH = OFF_PE + (size_t)T_ * 1536 * 2;
constexpr size_t OFF_GLR = OFF_UH + (size_t)(T_ / 64) * 32 * UHW * 2;
constexpr size_t OFF_VTE = OFF_GLR + (size_t)T_ * 16 * 4;
constexpr size_t OFF_KV = OFF_VTE + (size_t)2 * 4 * 128 * L_ * 2;
constexpr size_t OFF_SST = OFF_KV + (size_t)2 * 256 * 4 * 64 * 128 * 4;
constexpr size_t OFF_DEC = OFF_SST + (size_t)2 * 256 * 4 * 64 * 128 * 4;
constexpr size_t OFF_GBUF = OFF_DEC + (size_t)2 * 256 * 4 * 64 * 4;
constexpr size_t OFF_YA = OFF_GBUF + (size_t)512 * 32 * 128 * 4;
constexpr size_t END_EVEN = OFF_YA + (size_t)T_ * 512 * 2;
constexpr size_t OFF_PO = OFF_MIXER;
constexpr size_t OFF_WI = OFF_PO + (size_t)T_ * OD_N * 2;
constexpr size_t OFF_VTC = OFF_WI + (size_t)T_ * 4 * 4;
constexpr size_t OFF_VTD = OFF_VTC + (size_t)2 * 8 * 64 * L_ * 2;
constexpr size_t OFF_BM = OFF_VTD + (size_t)2 * 3 * 8 * 64 * L_ * 2;
constexpr size_t OFF_OD = OFF_BM + (size_t)T_ * 256 * 8;
constexpr size_t OFF_LSE = OFF_OD + (size_t)3 * T_ * 512 * 4;
constexpr size_t END_ODD = OFF_LSE + (size_t)3 * T_ * 8 * 4;
constexpr size_t WS_NEED = END_ODD > END_EVEN ? END_ODD : END_EVEN;
static_assert(WS_NEED < (size_t)4200000000ull, "workspace too large");

constexpr int LDS_BYTES = 134144;

struct Params {
    const float *x, *ev_w_in, *gla_w_gate2, *gla_b_gate2, *gla_norm_g, *s5_a_re, *s5_a_im, *s5_log_dt, *s5_b_re, *s5_b_im, *s5_c_re, *s5_c_im, *s5_d,
        *s5_w_glu, *s5_b_glu, *ev_w_out, *od_w_in, *od_w_out, *ln1_g, *ln1_b, *ln2_g, *ln2_b, *router_w, *router_b, *moe_w1, *moe_b1, *moe_w2, *moe_b2;
    float* out;
    char* ws;
};

#if MEGA
typedef const __attribute__((address_space(4))) Params& PRef;
#else
typedef const Params& PRef;
#endif

__device__ __forceinline__ unsigned pk2(float lo, float hi) { unsigned r; asm("v_cvt_pk_bf16_f32 %0, %1, %2" : "=v"(r) : "v"(lo), "v"(hi)); return r; }
__device__ __forceinline__ bf16_t f2bf(float f) { return (bf16_t)(pk2(f, 0.f) & 0xffffu); }
__device__ __forceinline__ float bf2f(bf16_t h) { return __uint_as_float(((unsigned)h) << 16); }
__device__ __forceinline__ float sigmoidf_(float x) { return 1.f / (1.f + __expf(-x)); }
__device__ __forceinline__ float wave_sum(float v) {
#pragma unroll
    for (int m = 32; m >= 1; m >>= 1) v += __shfl_xor(v, m, 64);
    return v;
}
__device__ __forceinline__ float gelu_tanh(float x) {
    const float k0 = 0.7978845608028654f, k1 = 0.044715f;
    float u = k0 * (x + k1 * x * x * x);
    float t = 1.f - 2.f / (1.f + __expf(2.f * u));
    return 0.5f * x * (1.f + t);
}
__device__ __forceinline__ int otid() { int t = threadIdx.x; asm volatile("" : "+v"(t)); return t; }

#define XB_TMO      128
#define XB_XCNT(j)  (256  + 64 * (j))
#define XB_XSUB(j)  (1280 + 64 * (j))
#define XB_XGEN(j)  (2304 + 64 * (j))
#define XB_TOP      3328
#define XB_TOPGEN   3392
#define XCD_BAR_WORDS 3456
#define XB_SPIN_CAP (1u << 21)
#define LAS __attribute__((address_space(3)))

__device__ __forceinline__ unsigned xb_ld(unsigned* p)              { return __hip_atomic_load(p, __ATOMIC_RELAXED, __HIP_MEMORY_SCOPE_AGENT); }
__device__ __forceinline__ unsigned xb_add(unsigned* p, unsigned v) { return __hip_atomic_fetch_add(p, v, __ATOMIC_RELAXED, __HIP_MEMORY_SCOPE_AGENT); }
__device__ __forceinline__ unsigned xb_xcc_id() { return (unsigned)__builtin_amdgcn_s_getreg((3 << 11) | 20) & 0xFu; }
#define XB_SPIN(cond, bar) do { unsigned _sp = 0; while (cond) { __builtin_amdgcn_s_sleep(1); \
    if ((++_sp & 255u) == 0u) { if (xb_ld(&(bar)[XB_TMO])) break; if (_sp > XB_SPIN_CAP) { atomicAdd(&(bar)[XB_TMO], 1u); break; } } } } while (0)

struct XcdBarrier { unsigned* bar; unsigned x; volatile LAS unsigned* st; };

__device__ __forceinline__ XcdBarrier xcd_barrier_post(unsigned* bar, volatile LAS unsigned* st) {
    XcdBarrier b; b.bar = bar; b.x = xb_xcc_id(); b.st = st;
    if (threadIdx.x == 0) (void)xb_add(&bar[XB_XCNT(b.x)], 1u);
    return b;
}
__device__ __forceinline__ void xcd_barrier_complete(unsigned* bar, unsigned x, unsigned& nloc, unsigned& nx) {
    const unsigned G = gridDim.x * gridDim.y * gridDim.z;
    unsigned sum, cnt, mine, sp = 0u;
    for (;;) {
        sum = 0u; cnt = 0u; mine = 0u;
#pragma unroll
        for (unsigned j = 0; j < 16; ++j) { const unsigned c = xb_ld(&bar[XB_XCNT(j)]); sum += c; cnt += (c > 0u) ? 1u : 0u; mine = (j == x) ? c : mine; }
        if (sum == G) break;
        __builtin_amdgcn_s_sleep(1);
        if ((++sp & 255u) == 0u) { if (xb_ld(&bar[XB_TMO])) break; if (sp > XB_SPIN_CAP) { atomicAdd(&bar[XB_TMO], 1u); break; } }
    }
    nloc = mine > 0u ? mine : 1u; nx = cnt > 0u ? cnt : 1u;
}
__device__ __forceinline__ void xcd_barrier(const XcdBarrier& b) {
    asm volatile("s_waitcnt vmcnt(0)" ::: "memory");
    __syncthreads();
    if (threadIdx.x == 0) {
        unsigned* bar = b.bar;
        __builtin_amdgcn_s_waitcnt(0);
        unsigned nloc = b.st[0], nx = b.st[1];
        if (nloc == 0u) { xcd_barrier_complete(bar, b.x, nloc, nx); b.st[0] = nloc; b.st[1] = nx; }
        const unsigned old = xb_add(&bar[XB_XSUB(b.x)], 1u);
        const unsigned gen = old / nloc;
        if (old + 1u == (gen + 1u) * nloc) {
            __builtin_amdgcn_fence(__ATOMIC_RELEASE, "agent");
            asm volatile("s_waitcnt vmcnt(0)" ::: "memory");
            const unsigned og = xb_add(&bar[XB_TOP], 1u);
            const unsigned tg = og / nx;
            if (og + 1u == (tg + 1u) * nx) xb_add(&bar[XB_TOPGEN], 1u);
            else XB_SPIN(xb_ld(&bar[XB_TOPGEN]) == tg, bar);
            __builtin_amdgcn_fence(__ATOMIC_ACQUIRE, "agent");
            xb_add(&bar[XB_XGEN(b.x)], 1u);
            asm volatile("s_waitcnt vmcnt(0)" ::: "memory");
        } else {
            XB_SPIN(xb_ld(&bar[XB_XGEN(b.x)]) == gen, bar);
            __builtin_amdgcn_fence(__ATOMIC_ACQUIRE, "agent");
            asm volatile("s_waitcnt vmcnt(0)" ::: "memory");
        }
    }
    __syncthreads();
}

constexpr int G_LROW = 144;
constexpr int G_ASZ = 256 * G_LROW;
constexpr int G_BSZ = 128 * G_LROW;
constexpr int G_STAGE = G_ASZ + G_BSZ;
constexpr int G_ROWS_OFF = 2 * G_STAGE;

template <bool GATHER, class Epi>
__device__ __forceinline__ void gemm_tile(const bf16_t* __restrict__ A, long lda, int shift, int m0, const bf16_t* __restrict__ Bt, long ldb, int n0, int K,
                                          char* smem, Epi&& epi) {
    const int tid = otid(), lane = tid & 63, wave = tid >> 6, wr = wave >> 1, wc = wave & 1, fr = lane & 15, fq = lane >> 4;
    const int lrow = tid >> 3, lchunk = tid & 7;
    const int* sRow = (const int*)(smem + G_ROWS_OFF);
    const bf16_t* pa[4]; const bf16_t* pb[2];
#pragma unroll
    for (int i = 0; i < 4; ++i) {
        int r = lrow + 64 * i; long arow;
        if (GATHER) { int v = sRow[r]; arow = v < 0 ? 0 : (v >> shift); } else arow = m0 + r;
        pa[i] = A + arow * lda + lchunk * 8;
    }
#pragma unroll
    for (int i = 0; i < 2; ++i) pb[i] = Bt + (long)(n0 + lrow + 64 * i) * ldb + lchunk * 8;
    f32x4 acc[4][4];
#pragma unroll
    for (int m = 0; m < 4; ++m)
#pragma unroll
        for (int n = 0; n < 4; ++n) acc[m][n] = (f32x4){0.f, 0.f, 0.f, 0.f};
    u32x4 ra[4], rb[2];
    const int nk = K >> 6;
#pragma unroll
    for (int i = 0; i < 4; ++i) ra[i] = *(const u32x4*)(pa[i]);
#pragma unroll
    for (int i = 0; i < 2; ++i) rb[i] = *(const u32x4*)(pb[i]);
    {
        char* sa = smem; char* sb = smem + G_ASZ;
#pragma unroll
        for (int i = 0; i < 4; ++i) *(u32x4*)(sa + (lrow + 64 * i) * G_LROW + lchunk * 16) = ra[i];
#pragma unroll
        for (int i = 0; i < 2; ++i) *(u32x4*)(sb + (lrow + 64 * i) * G_LROW + lchunk * 16) = rb[i];
    }
    __syncthreads();
    for (int kt = 0; kt < nk; ++kt) {
        const bool more = (kt + 1 < nk);
        if (more) {
#pragma unroll
            for (int i = 0; i < 4; ++i) ra[i] = *(const u32x4*)(pa[i] + (kt + 1) * 64);
#pragma unroll
            for (int i = 0; i < 2; ++i) rb[i] = *(const u32x4*)(pb[i] + (kt + 1) * 64);
        }
        const char* sa = smem + (kt & 1) * G_STAGE; const char* sb = sa + G_ASZ;
#pragma unroll
        for (int ks = 0; ks < 2; ++ks) {
            bf16x8 af[4], bfr[4];
#pragma unroll
            for (int m = 0; m < 4; ++m) af[m] = *(const bf16x8*)(sa + (wr * 64 + m * 16 + fr) * G_LROW + (ks * 32 + fq * 8) * 2);
#pragma unroll
            for (int n = 0; n < 4; ++n) bfr[n] = *(const bf16x8*)(sb + (wc * 64 + n * 16 + fr) * G_LROW + (ks * 32 + fq * 8) * 2);
#pragma unroll
            for (int m = 0; m < 4; ++m)
#pragma unroll
                for (int n = 0; n < 4; ++n) acc[m][n] = __builtin_amdgcn_mfma_f32_16x16x32_bf16(af[m], bfr[n], acc[m][n], 0, 0, 0);
        }
        if (more) {
            char* wa = smem + ((kt + 1) & 1) * G_STAGE; char* wb = wa + G_ASZ;
#pragma unroll
            for (int i = 0; i < 4; ++i) *(u32x4*)(wa + (lrow + 64 * i) * G_LROW + lchunk * 16) = ra[i];
#pragma unroll
            for (int i = 0; i < 2; ++i) *(u32x4*)(wb + (lrow + 64 * i) * G_LROW + lchunk * 16) = rb[i];
        }
        __syncthreads();
    }
    {
        f32x4 h0[4][2], h1[4][2];
#pragma unroll
        for (int m = 0; m < 4; ++m) { h0[m][0] = acc[m][0]; h0[m][1] = acc[m][1]; h1[m][0] = acc[m][2]; h1[m][1] = acc[m][3]; }
        epi(h0, wr * 64, n0 + wc * 64, fr, fq);
        epi(h1, wr * 64, n0 + wc * 64 + 32, fr, fq);
    }
}

template <class Epi>
__device__ __forceinline__ void gemm_phase(const bf16_t* A, long lda, int M, const bf16_t* Bt, long ldb, int N, int K, char* smem, int bid, int nb, Epi&& epi) {
    const int ntn = N / 128, ntm = M / 256, nt = ntn * ntm;
    for (int t = bid; t < nt; t += nb) {
        const int mi = t / ntn, ni = t - mi * ntn;
        gemm_tile<false>(A, lda, 0, mi * 256, Bt, ldb, ni * 128, K, smem,
                         [&](f32x4 (&acc)[4][2], int rt0, int c0, int fr, int fq) { epi(acc, mi * 256 + rt0, c0, fr, fq); });
    }
}

constexpr int G8_HT = 128 * 64 * 2;
constexpr int G8_ROWS_OFF = 8 * G8_HT;

__device__ __forceinline__ int g8_lds_byte(int r, int c) {
    const int st = (r >> 4) * 2 + (c >> 5), rr = r & 15, cc = c & 31, ob = rr * 64 + cc * 2;
    return st * 1024 + (ob ^ (((ob >> 9) & 1) << 5));
}
__device__ __forceinline__ void g8_stage_rc(int b, int& R, int& C) {
    const int st = b / 1024, sb = b % 1024, swz = sb ^ (((sb >> 9) & 1) << 5);
    R = (st >> 1) * 16 + swz / 64; C = (st & 1) * 32 + (swz % 64) / 2;
}

#define G8_SA(b, h) (lds + ((b) * 2 + (h)) * G8_HT)
#define G8_SB(b, h) (lds + (4 + (b) * 2 + (h)) * G8_HT)
#define G8_STAGE(P, RS, OFF, soff) do { \
    _Pragma("unroll") for (int _i = 0; _i < 2; ++_i) \
        __builtin_amdgcn_raw_ptr_buffer_load_lds((RS), (LAS unsigned*)((P) + tid * 16 + _i * 8192), 16, (OFF)[_i], (soff), 0, 0); } while (0)
#define G8_LDA(dst, b, h) do { _Pragma("unroll") for (int m = 0; m < 4; ++m) _Pragma("unroll") for (int k = 0; k < 2; ++k) \
    dst[m][k] = *(const LAS bf16x8*)(G8_SA(b, h) + g8_lds_byte(wr * 64 + m * 16 + fr, k * 32 + fq * 8)); } while (0)
#define G8_LDB(dst, b, h) do { _Pragma("unroll") for (int n = 0; n < 2; ++n) _Pragma("unroll") for (int k = 0; k < 2; ++k) \
    dst[n][k] = *(const LAS bf16x8*)(G8_SB(b, h) + g8_lds_byte(wc * 32 + n * 16 + fr, k * 32 + fq * 8)); } while (0)
#define G8_MMA(ai, bj, At, Bt_) do { __builtin_amdgcn_s_setprio(1); \
    _Pragma("unroll") for (int m = 0; m < 4; ++m) _Pragma("unroll") for (int n = 0; n < 2; ++n) _Pragma("unroll") for (int k = 0; k < 2; ++k) \
        acc[ai][bj][m][n] = __builtin_amdgcn_mfma_f32_16x16x32_bf16(Bt_[n][k], At[m][k], acc[ai][bj][m][n], 0, 0, 0); \
    __builtin_amdgcn_s_setprio(0); } while (0)
#define G8_WAIT_V(n) asm volatile("s_waitcnt vmcnt(" #n ")" ::: "memory")
#define G8_WAIT_L(n) asm volatile("s_waitcnt lgkmcnt(" #n ")" ::: "memory")
#define G8_BAR __builtin_amdgcn_s_barrier()
#define G8_SCHED __builtin_amdgcn_sched_barrier(0)

template <bool GATHER, class Epi>
__device__ __forceinline__ void gemm256_tile(const bf16_t* __restrict__ A, long lda, int shift, int m0, const bf16_t* __restrict__ Bt, long ldb, int n0, int K,
                                             char* smem, Epi&& epi) {
    LAS char* lds = (LAS char*)smem;
    int tid = otid();
    int wid = tid >> 6, lane = tid & 63, wr = wid >> 2, wc = wid & 3, fr = lane & 15, fq = lane >> 4;
    unsigned aoff[2][2], boff[2];
    {
        const LAS int* sRow = (const LAS int*)(lds + G8_ROWS_OFF);
#pragma unroll
        for (int i = 0; i < 2; ++i) {
            int R, C; g8_stage_rc(tid * 16 + i * 8192, R, C);
            { const int rho = R & 31, nn = rho >> 4, ii = rho & 15; const int Rp = (R & ~31) + 8 * (ii >> 2) + 4 * nn + (ii & 3);
              boff[i] = (unsigned)((long)Rp * ldb + C) * 2u; }
#pragma unroll
            for (int h = 0; h < 2; ++h) {
                long arow;
                if (GATHER) { const int v = sRow[h * 128 + R]; arow = v < 0 ? 0 : (v >> shift); } else arow = m0 + h * 128 + R;
                aoff[h][i] = (unsigned)(arow * lda + C) * 2u;
            }
        }
    }
    f32x4 acc[2][2][4][2];
#pragma unroll
    for (int a = 0; a < 2; ++a)
#pragma unroll
        for (int b = 0; b < 2; ++b)
#pragma unroll
            for (int m = 0; m < 4; ++m)
#pragma unroll
                for (int n = 0; n < 2; ++n) acc[a][b][m][n] = (f32x4){0.f, 0.f, 0.f, 0.f};
    bf16x8 At[4][2], B0[2][2], B1[2][2];
    const int nt = K / 64;
    const __amdgpu_buffer_rsrc_t rA = __builtin_amdgcn_make_buffer_rsrc((void*)A, 0, 0x7fffffff, 0x00020000);
    const __amdgpu_buffer_rsrc_t rB = __builtin_amdgcn_make_buffer_rsrc((void*)(Bt + (size_t)n0 * ldb), 0, 0x7fffffff, 0x00020000);
    const int bh = (int)(128 * ldb * 2);
    G8_STAGE(G8_SB(0, 0), rB, boff, 0); G8_STAGE(G8_SA(0, 0), rA, aoff[0], 0);
    G8_STAGE(G8_SB(0, 1), rB, boff, bh); G8_STAGE(G8_SA(0, 1), rA, aoff[1], 0);
    if (wr == 1) G8_BAR;
    G8_WAIT_V(4); G8_BAR;
    G8_STAGE(G8_SB(1, 0), rB, boff, 128); G8_STAGE(G8_SA(1, 0), rA, aoff[0], 128); G8_STAGE(G8_SB(1, 1), rB, boff, 128 + bh);
    G8_WAIT_V(6); G8_BAR;
    for (int t = 0; t < nt - 2; t += 2) {
        G8_LDB(B0, 0, 0); G8_SCHED; G8_LDA(At, 0, 0); G8_STAGE(G8_SA(1, 1), rA, aoff[1], (t + 1) * 128);
        G8_WAIT_L(8); G8_BAR; G8_WAIT_L(0); G8_MMA(0, 0, At, B0); G8_BAR; G8_SCHED;
        G8_LDB(B1, 0, 1); G8_STAGE(G8_SB(0, 0), rB, boff, (t + 2) * 128);
        G8_BAR; G8_WAIT_L(0); G8_MMA(0, 1, At, B1); G8_BAR;
        G8_LDA(At, 0, 1); G8_STAGE(G8_SA(0, 0), rA, aoff[0], (t + 2) * 128);
        G8_BAR; G8_WAIT_L(0); G8_MMA(1, 0, At, B0); G8_BAR; G8_SCHED;
        G8_STAGE(G8_SB(0, 1), rB, boff, (t + 2) * 128 + bh);
        G8_WAIT_V(6); G8_BAR; G8_MMA(1, 1, At, B1); G8_BAR;
        G8_LDB(B0, 1, 0); G8_SCHED; G8_LDA(At, 1, 0); G8_STAGE(G8_SA(0, 1), rA, aoff[1], (t + 2) * 128);
        G8_WAIT_L(8); G8_BAR; G8_WAIT_L(0); G8_MMA(0, 0, At, B0); G8_BAR; G8_SCHED;
        G8_LDB(B1, 1, 1); G8_STAGE(G8_SB(1, 0), rB, boff, (t + 3) * 128);
        G8_BAR; G8_WAIT_L(0); G8_MMA(0, 1, At, B1); G8_BAR;
        G8_LDA(At, 1, 1); G8_STAGE(G8_SA(1, 0), rA, aoff[0], (t + 3) * 128);
        G8_BAR; G8_WAIT_L(0); G8_MMA(1, 0, At, B0); G8_BAR; G8_SCHED;
        G8_STAGE(G8_SB(1, 1), rB, boff, (t + 3) * 128 + bh);
        G8_WAIT_V(6); G8_BAR; G8_MMA(1, 1, At, B1); G8_BAR;
    }
    { G8_LDB(B0, 0, 0); G8_WAIT_V(0); G8_LDA(At, 0, 0); G8_STAGE(G8_SA(1, 1), rA, aoff[1], (nt - 1) * 128);
      G8_BAR; G8_WAIT_L(0); G8_MMA(0, 0, At, B0); G8_BAR;
      G8_LDB(B1, 0, 1); G8_BAR; G8_WAIT_L(0); G8_MMA(0, 1, At, B1); G8_BAR;
      G8_LDA(At, 0, 1); G8_WAIT_V(4); G8_BAR; G8_WAIT_L(0); G8_MMA(1, 0, At, B0); G8_MMA(1, 1, At, B1); G8_BAR; }
    { G8_LDB(B0, 1, 0); G8_LDA(At, 1, 0); G8_WAIT_V(2); G8_BAR; G8_WAIT_L(0); G8_MMA(0, 0, At, B0); G8_BAR;
      G8_LDB(B1, 1, 1); G8_WAIT_V(0); G8_BAR; G8_WAIT_L(0); G8_MMA(0, 1, At, B1); G8_BAR;
      G8_LDA(At, 1, 1); G8_BAR; G8_WAIT_L(0); G8_MMA(1, 0, At, B0); G8_MMA(1, 1, At, B1); G8_BAR; }
    if (wr == 0) G8_BAR;
    int tz = otid(); wid = tz >> 6; lane = tz & 63; wr = wid >> 2; wc = wid & 3; fr = lane & 15; fq = lane >> 4;
#pragma unroll
    for (int ai = 0; ai < 2; ++ai)
#pragma unroll
        for (int bj = 0; bj < 2; ++bj) epi(acc[ai][bj], ai * 128 + wr * 64, n0 + bj * 128 + wc * 32, fr, fq);
}

struct XcdSeq {
    int q, qend, step;
    __device__ __forceinline__ XcdSeq(int total, int bid, int nb) {
        if ((nb & 7) == 0) { const int chunk = (total + 7) >> 3, x = bid & 7; q = x * chunk + (bid >> 3); const int e = (x + 1) * chunk; qend = e < total ? e : total; step = nb >> 3; }
        else { q = bid; qend = total; step = nb; }
    }
};

template <class Epi>
__device__ __forceinline__ void gemm256_phase(const bf16_t* A, long lda, int M, const bf16_t* Bt, long ldb, int N, int K, char* smem, int bid, int nb, Epi&& epi) {
    const int ntn = N / 256, ntm = M / 256, nt = ntn * ntm;
    XcdSeq s(nt, bid, nb);
    for (int Q = s.q; Q < s.qend; Q += s.step) {
        const int pnl = Q / (4 * ntn), r = Q - pnl * 4 * ntn, ni = r >> 2, mi = pnl * 4 + (r & 3);
        gemm256_tile<false>(A, lda, 0, mi * 256, Bt, ldb, ni * 256, K, smem,
                            [&](f32x4 (&acc)[4][2], int rt0, int c0, int fr, int fq) { epi(acc, mi * 256 + rt0, c0, fr, fq); });
    }
}


__device__ __forceinline__ int colmap(int kind, int n, int nsrc) {
    if (kind == 0) return n < nsrc ? n : -1;
    if (kind == 1) { if (n < 1536) return n; if (n < 2048) return n + 16; if (n < 2064) return n - 512; return -1; }
    if (kind == 2) { if (n < 1792) return n; if (n < 6400) return n + 68; if (n < 6468) return n - 4608; return -1; }
    { const int grp = n >> 5, w = n & 31; return ((w >> 2) & 1) * 1024 + grp * 16 + 4 * (w >> 3) + (w & 3); }
}
struct ConvTile { const float* src; bf16_t* dst; int sld, sc, K, n0, k0; };
__device__ __forceinline__ ConvTile conv_decode(PRef p, int t, int n4) {
    constexpr int S0 = 128 * 32 * 4, S1 = S0 + 128 * 16 * 4, S2 = S1 + 2 * 36 * 4, S3 = S2 + 2 * 104 * 4, S4 = S3 + 2 * 16 * 4, S5 = S4 + 2 * 16 * 4, S6 = S5 + 2 * 8 * 2;
    char* ws = p.ws;
    ConvTile c; int nsrc, kind, NT, loc;
    if (t < S0) { loc = t; const int mat = loc / (32 * 4); loc -= mat * 32 * 4; c.src = p.moe_w1 + (size_t)mat * 1024 * 2048; c.dst = (bf16_t*)(ws + OFF_WT_W1) + (size_t)mat * 2048 * 1024; c.sld = 2048; nsrc = 2048; kind = 3; c.K = 1024; NT = 32; }
    else if (t < S1) { loc = t - S0; const int mat = loc / 64; loc -= mat * 64; c.src = p.moe_w2 + (size_t)mat * 1024 * 1024; c.dst = (bf16_t*)(ws + OFF_WT_W2) + (size_t)mat * 1024 * 1024; c.sld = 1024; nsrc = 1024; kind = 0; c.K = 1024; NT = 16; }
    else if (t < S2) { loc = t - S1; const int mat = loc / (36 * 4); loc -= mat * 36 * 4; c.src = p.ev_w_in + (size_t)mat * 1024 * 2064; c.dst = (bf16_t*)(ws + OFF_WT_EVIN) + (size_t)mat * EV_N * 1024; c.sld = 2064; nsrc = 2064; kind = 1; c.K = 1024; NT = 36; }
    else if (t < S3) { loc = t - S2; const int mat = loc / (104 * 4); loc -= mat * 104 * 4; c.src = p.od_w_in + (size_t)mat * 1024 * 6468; c.dst = (bf16_t*)(ws + OFF_WT_ODIN) + (size_t)mat * OD_N * 1024; c.sld = 6468; nsrc = 6468; kind = 2; c.K = 1024; NT = 104; }
    else if (t < S4) { loc = t - S3; const int mat = loc / 64; loc -= mat * 64; c.src = p.ev_w_out + (size_t)mat * 1024 * 1024; c.dst = (bf16_t*)(ws + OFF_WT_EVOUT) + (size_t)mat * 1024 * 1024; c.sld = 1024; nsrc = 1024; kind = 0; c.K = 1024; NT = 16; }
    else if (t < S5) { loc = t - S4; const int mat = loc / 64; loc -= mat * 64; c.src = p.od_w_out + (size_t)mat * 1024 * 1024; c.dst = (bf16_t*)(ws + OFF_WT_ODOUT) + (size_t)mat * 1024 * 1024; c.sld = 1024; nsrc = 1024; kind = 0; c.K = 1024; NT = 16; }
    else if (t < S6) { loc = t - S5; const int mat = loc / 16; loc -= mat * 16; c.src = p.s5_w_glu + (size_t)mat * 512 * 512; c.dst = (bf16_t*)(ws + OFF_WT_GLU) + (size_t)mat * 512 * 512; c.sld = 512; nsrc = 512; kind = 0; c.K = 512; NT = 8; }
    else { loc = t - S6; const int mat = loc / 8; loc -= mat * 8; c.src = p.router_w + (size_t)mat * 1024 * 32; c.dst = (bf16_t*)(ws + OFF_WT_RT) + (size_t)mat * 128 * 1024; c.sld = 32; nsrc = 32; kind = 0; c.K = 1024; NT = 2; }
    const int kt = loc / NT, nt = loc - kt * NT;
    c.n0 = nt * 64; c.k0 = kt * 256;
    c.sc = colmap(kind, c.n0 + n4 * 4, nsrc);
    return c;
}
__device__ __forceinline__ void conv_load(const ConvTile& c, int kp, f32x4 (&v)[8]) {
#pragma unroll
    for (int i = 0; i < 4; ++i)
#pragma unroll
        for (int e = 0; e < 2; ++e) {
            const int k = c.k0 + 2 * (kp + 32 * i) + e;
            v[2 * i + e] = c.sc >= 0 ? *(const f32x4*)(c.src + (size_t)k * c.sld + c.sc) : (f32x4){0.f, 0.f, 0.f, 0.f};
        }
}

__device__ __forceinline__ void conv_phase(PRef p, char* smem, int bid, int nb) {
    char* ws = p.ws;
    constexpr int NTILES = 128 * 32 * 4 + 128 * 16 * 4 + 2 * 36 * 4 + 2 * 104 * 4 + 2 * 16 * 4 + 2 * 16 * 4 + 2 * 8 * 2 + 4 * 2 * 4;
    bf16_t* tile = (bf16_t*)smem;
    const int tid = otid(), n4 = tid & 15, kp = tid >> 4;
    if (bid < NTILES) {
        ConvTile cur = conv_decode(p, bid, n4);
        f32x4 v[8];
        conv_load(cur, kp, v);
        for (int t = bid; t < NTILES; t += nb) {
            const bool more = t + nb < NTILES;
            ConvTile nxt = cur; f32x4 w[8];
            if (more) { nxt = conv_decode(p, t + nb, n4); conv_load(nxt, kp, w); }
#pragma unroll
            for (int i = 0; i < 4; ++i)
#pragma unroll
                for (int j = 0; j < 4; ++j)
                    *(unsigned*)(tile + (n4 * 4 + j) * 258 + 2 * (kp + 32 * i)) = pk2(v[2 * i][j], v[2 * i + 1][j]);
            __syncthreads();
#pragma unroll
            for (int i = 0; i < 4; ++i) {
                const int c = tid + 512 * i, n = c >> 5, kc = c & 31;
                const unsigned* tp = (const unsigned*)(tile + n * 258 + kc * 8);
                u32x4 o; o.x = tp[0]; o.y = tp[1]; o.z = tp[2]; o.w = tp[3];
                *(u32x4*)(cur.dst + (size_t)(cur.n0 + n) * cur.K + cur.k0 + kc * 8) = o;
            }
            __syncthreads();
            if (more) {
                cur = nxt;
#pragma unroll
                for (int i = 0; i < 8; ++i) v[i] = w[i];
            }
        }
    }
    {
        const float* x = p.x; bf16_t* xb = (bf16_t*)(ws + OFF_XB);
        const long nch = (long)T_ * 1024 / 8;
        for (long c = (long)bid * NTHR + otid(); c < nch; c += (long)nb * NTHR) {
            const f32x4 a = *(const f32x4*)(x + c * 8), b = *(const f32x4*)(x + c * 8 + 4);
            u32x4 w; w.x = pk2(a[0], a[1]); w.y = pk2(a[2], a[3]); w.z = pk2(b[0], b[1]); w.w = pk2(b[2], b[3]);
            *(u32x4*)(xb + c * 8) = w;
        }
    }
    if (bid == 0 && otid() < 128) ((int*)(ws + OFF_CNT))[otid()] = 0;
}

__device__ __forceinline__ void s5mat_unit(PRef p, int j, int g, char* smem) {
    float* cre = (float*)smem;
    float* cim = cre + 1024;
    float* bbr = cim + 1024;
    float* bbi = bbr + 1024;
    float* pwr = bbi + 1024;
    float* pwi = pwr + 65 * 64;
    float* zr = pwi + 65 * 64;
    float* zi = zr + 64;
    float* Kd = zi + 64;
    const int tid = otid();
    const int jg = j * 32 + g;
    if (tid < 64) {
        const int pp = tid;
        const float lre = fminf(p.s5_a_re[jg * 64 + pp], -1e-4f), lim = p.s5_a_im[jg * 64 + pp];
        const float dt = expf(p.s5_log_dt[jg]);
        const float xr = lre * dt, th = lim * dt;
        const float mag = expf(xr);
        const float ar = mag * cosf(th), ai = mag * sinf(th);
        const float inv = 1.f / (lre * lre + lim * lim);
        zr[pp] = ((ar - 1.f) * lre + ai * lim) * inv;
        zi[pp] = (ai * lre - (ar - 1.f) * lim) * inv;
        const double thd = (double)th;
        for (int d = 0; d <= 64; ++d) {
            const float mg = expf((float)d * xr);
            double ang = (double)d * thd;
            const double kk = rint(ang * 0.15915494309189535);
            ang -= kk * 6.283185307179586;
            const float a = (float)ang;
            pwr[d * 64 + pp] = mg * cosf(a);
            pwi[d * 64 + pp] = mg * sinf(a);
        }
    }
    for (int e = tid; e < 1024; e += NTHR) {
        cre[e] = p.s5_c_re[(size_t)jg * 1024 + e];
        cim[e] = p.s5_c_im[(size_t)jg * 1024 + e];
    }
    __syncthreads();
    for (int e = tid; e < 1024; e += NTHR) {
        const int pp = e >> 4;
        const float br = p.s5_b_re[(size_t)jg * 1024 + e], bi = p.s5_b_im[(size_t)jg * 1024 + e];
        bbr[e] = zr[pp] * br - zi[pp] * bi;
        bbi[e] = zr[pp] * bi + zi[pp] * br;
    }
    __syncthreads();
    for (int e = tid; e < 64 * 256; e += NTHR) {
        const int d = e >> 8, n = (e >> 4) & 15, m = e & 15;
        float s = 0.f;
        for (int pp = 0; pp < 64; ++pp) {
            const float cr = cre[n * 64 + pp], ci = cim[n * 64 + pp], qr = pwr[d * 64 + pp], qi = pwi[d * 64 + pp];
            const float wr_ = cr * qr - ci * qi, wi_ = cr * qi + ci * qr;
            s += wr_ * bbr[pp * 16 + m] - wi_ * bbi[pp * 16 + m];
        }
        Kd[e] = s;
    }
    __syncthreads();
    bf16_t* TH = (bf16_t*)(p.ws + OFF_TH) + (size_t)jg * 1024 * UHW;
    for (int c = tid; c < 1024 * 144; c += NTHR) {
        const int row = c / 144, ch = c - row * 144;
        const int tau = row >> 4, n = row & 15;
        float v[8];
        if (ch < 128) {
            const int s = ch >> 1, m0 = (ch & 1) * 8;
            if (s <= tau) {
#pragma unroll
                for (int i = 0; i < 8; ++i) v[i] = Kd[(tau - s) * 256 + n * 16 + m0 + i];
            } else {
#pragma unroll
                for (int i = 0; i < 8; ++i) v[i] = 0.f;
            }
        } else {
            const int p0 = (ch - 128) * 4;
#pragma unroll
            for (int i = 0; i < 4; ++i) {
                const int pp = p0 + i;
                const float cr = cre[n * 64 + pp], ci = cim[n * 64 + pp], qr = pwr[(tau + 1) * 64 + pp], qi = pwi[(tau + 1) * 64 + pp];
                v[2 * i] = cr * qr - ci * qi;
                v[2 * i + 1] = -(cr * qi + ci * qr);
            }
        }
        u32x4 w; w.x = pk2(v[0], v[1]); w.y = pk2(v[2], v[3]); w.z = pk2(v[4], v[5]); w.w = pk2(v[6], v[7]);
        *(u32x4*)(TH + (size_t)row * UHW + ch * 8) = w;
    }
    bf16_t* GM = (bf16_t*)(p.ws + OFF_GM) + (size_t)jg * 128 * 1024;
    for (int c = tid; c < 128 * 128; c += NTHR) {
        const int row = c >> 7, ch = c & 127;
        const int pp = row >> 1, ri = row & 1;
        const int s = ch >> 1, m0 = (ch & 1) * 8;
        const float qr = pwr[(63 - s) * 64 + pp], qi = pwi[(63 - s) * 64 + pp];
        float v[8];
#pragma unroll
        for (int i = 0; i < 8; ++i) {
            const float br = bbr[pp * 16 + m0 + i], bi = bbi[pp * 16 + m0 + i];
            v[i] = ri == 0 ? (qr * br - qi * bi) : (qr * bi + qi * br);
        }
        u32x4 w; w.x = pk2(v[0], v[1]); w.y = pk2(v[2], v[3]); w.z = pk2(v[4], v[5]); w.w = pk2(v[6], v[7]);
        *(u32x4*)(GM + (size_t)row * 1024 + ch * 8) = w;
    }
    if (tid < 64) {
        float* A64 = (float*)(p.ws + OFF_A64) + (size_t)jg * 128;
        A64[tid * 2] = pwr[64 * 64 + tid];
        A64[tid * 2 + 1] = pwi[64 * 64 + tid];
    }
    __syncthreads();
}

__device__ __forceinline__ void epi_ev_in(PRef p, f32x4 (&acc)[4][2], int row0, int c0, int fr, int fq) {
    char* ws = p.ws;
    bf16_t* PE = (bf16_t*)(ws + OFF_PE); bf16_t* UH = (bf16_t*)(ws + OFF_UH); float* GLR = (float*)(ws + OFF_GLR); bf16_t* VTE = (bf16_t*)(ws + OFF_VTE);
    const int col = c0 + 8 * fq;
#pragma unroll
    for (int m = 0; m < 4; ++m) {
        const int t = row0 + m * 16 + fr;
        u32x4 w; w.x = pk2(acc[m][0][0], acc[m][0][1]); w.y = pk2(acc[m][0][2], acc[m][0][3]); w.z = pk2(acc[m][1][0], acc[m][1][1]); w.w = pk2(acc[m][1][2], acc[m][1][3]);
        if (c0 < 1536) {
            *(u32x4*)(PE + (size_t)t * 1536 + col) = w;
            if (c0 >= 512 && c0 < 1024) {
                const int c = col - 512, h = c >> 7, vv = c & 127, b = t >> 14, pos = t & (L_ - 1);
                bf16_t* vp = VTE + ((size_t)((b * 4 + h) * 128 + vv)) * L_ + pos;
                vp[0] = (bf16_t)(w.x & 0xffffu); vp[(size_t)L_] = (bf16_t)(w.x >> 16); vp[(size_t)2 * L_] = (bf16_t)(w.y & 0xffffu); vp[(size_t)3 * L_] = (bf16_t)(w.y >> 16);
                vp[(size_t)4 * L_] = (bf16_t)(w.z & 0xffffu); vp[(size_t)5 * L_] = (bf16_t)(w.z >> 16); vp[(size_t)6 * L_] = (bf16_t)(w.w & 0xffffu); vp[(size_t)7 * L_] = (bf16_t)(w.w >> 16);
            }
        } else if (c0 < 2048) {
            const int ch = col - 1536, g = ch >> 4, mm = ch & 15;
            *(u32x4*)(UH + ((size_t)(t >> 6) * 32 + g) * UHW + (t & 63) * 16 + mm) = w;
        } else if (col < 2064) {
            *(f32x4*)(GLR + (size_t)t * 16 + (col - 2048)) = acc[m][0];
            *(f32x4*)(GLR + (size_t)t * 16 + (col - 2048) + 4) = acc[m][1];
        }
    }
}

__device__ __forceinline__ void gla_decay(PRef p, int j, int t0, int h, float* sB) {
    const float* GLR = (const float*)(p.ws + OFF_GLR);
    const float* w2 = p.gla_w_gate2 + (size_t)j * 16 * 256;
    const float* b2 = p.gla_b_gate2 + (size_t)j * 256;
    const int tid = otid();
    for (int e = tid; e < 4096; e += NTHR) {
        const int tau = e >> 6, d = e & 63;
        float a = b2[h * 64 + d];
#pragma unroll
        for (int r = 0; r < 16; ++r) a += GLR[(size_t)(t0 + tau) * 16 + r] * w2[r * 256 + h * 64 + d];
        const float ls = fminf(a, 0.f) - log1pf(__expf(-fabsf(a)));
        sB[tau * 65 + d] = ls * (1.f / 16.f);
    }
    __syncthreads();
    if (tid < 64) { float run = 0.f; for (int tau = 0; tau < 64; ++tau) { run += sB[tau * 65 + tid]; sB[tau * 65 + tid] = run; } }
    __syncthreads();
}

__device__ __forceinline__ void gla_a_item(PRef p, int j, int item, char* smem) {
    const int h = item & 3, c = (item >> 2) & 255, b = item >> 10;
    const int t0 = b * L_ + c * 64;
    float* sB = (float*)smem;
    bf16_t* AK = (bf16_t*)(smem + 16640);
    const bf16_t* PE = (const bf16_t*)(p.ws + OFF_PE);
    const bf16_t* VTE = (const bf16_t*)(p.ws + OFF_VTE);
    const int tid = otid(), lane = tid & 63, wave = tid >> 6, fr = lane & 15, fq = lane >> 4;
    gla_decay(p, j, t0, h, sB);
    for (int e = tid; e < 4096; e += NTHR) {
        const int tau = e >> 6, d = e & 63;
        const float k = bf2f(PE[(size_t)(t0 + tau) * 1536 + 256 + h * 64 + d]);
        AK[d * 72 + tau] = f2bf(k * __expf(sB[63 * 65 + d] - sB[tau * 65 + d]));
    }
    __syncthreads();
    const int dblk = wave >> 1, vb = (wave & 1) * 64;
    f32x4 acc[4];
#pragma unroll
    for (int n = 0; n < 4; ++n) acc[n] = (f32x4){0.f, 0.f, 0.f, 0.f};
#pragma unroll
    for (int ks = 0; ks < 2; ++ks) {
        const bf16x8 af = *(const bf16x8*)(AK + (dblk * 16 + fr) * 72 + ks * 32 + fq * 8);
#pragma unroll
        for (int n = 0; n < 4; ++n) {
            const int v = vb + n * 16 + fr;
            const bf16x8 bfr = *(const bf16x8*)(VTE + ((size_t)((b * 4 + h) * 128 + v)) * L_ + (c * 64 + ks * 32 + fq * 8));
            acc[n] = __builtin_amdgcn_mfma_f32_16x16x32_bf16(af, bfr, acc[n], 0, 0, 0);
        }
    }
    float* KV = (float*)(p.ws + OFF_KV) + ((size_t)((b * 256 + c) * 4 + h)) * 64 * 128;
#pragma unroll
    for (int n = 0; n < 4; ++n)
#pragma unroll
        for (int r = 0; r < 4; ++r) KV[(dblk * 16 + fq * 4 + r) * 128 + vb + n * 16 + fr] = acc[n][r];
    if (tid < 64) ((float*)(p.ws + OFF_DEC))[((size_t)((b * 256 + c) * 4 + h)) * 64 + tid] = __expf(sB[63 * 65 + tid]);
    __syncthreads();
}

__device__ __forceinline__ void scan_phase(PRef p, int j, int bid) {
    const int gid = bid * NTHR + otid();
    if (gid < 65536) {
        const int v = gid & 127, d = (gid >> 7) & 63, h = (gid >> 13) & 3, b = gid >> 15;
        const float* KV = (const float*)(p.ws + OFF_KV); float* SST = (float*)(p.ws + OFF_SST); const float* DEC = (const float*)(p.ws + OFF_DEC);
        float S = 0.f;
        for (int c0 = 0; c0 < 256; c0 += 8) {
            float kv[8], dc[8];
#pragma unroll
            for (int i = 0; i < 8; ++i) {
                const size_t blk = (size_t)((b * 256 + c0 + i) * 4 + h);
                kv[i] = KV[(blk * 64 + d) * 128 + v]; dc[i] = DEC[blk * 64 + d];
            }
#pragma unroll
            for (int i = 0; i < 8; ++i) {
                const size_t blk = (size_t)((b * 256 + c0 + i) * 4 + h);
                SST[(blk * 64 + d) * 128 + v] = S;
                S = dc[i] * S + kv[i];
            }
        }
    } else if (gid < 65536 + 4096) {
        const int e = gid - 65536, pp = e & 63, g = (e >> 6) & 31, b = e >> 11;
        const float* A64 = (const float*)(p.ws + OFF_A64) + (size_t)(j * 32 + g) * 128;
        const float ar = A64[pp * 2], ai = A64[pp * 2 + 1];
        const float* GB = (const float*)(p.ws + OFF_GBUF); bf16_t* UH = (bf16_t*)(p.ws + OFF_UH);
        float hr = 0.f, hi = 0.f;
        for (int c0 = 0; c0 < 256; c0 += 8) {
            float gr[8], gi[8];
#pragma unroll
            for (int i = 0; i < 8; ++i) { const size_t row = (size_t)(b * 256 + c0 + i) * 32 + g; gr[i] = GB[row * 128 + 2 * pp]; gi[i] = GB[row * 128 + 2 * pp + 1]; }
#pragma unroll
            for (int i = 0; i < 8; ++i) {
                const size_t row = (size_t)(b * 256 + c0 + i) * 32 + g;
                *(unsigned*)(UH + row * UHW + 1024 + 2 * pp) = pk2(hr, hi);
                const float nr = ar * hr - ai * hi + gr[i], ni = ar * hi + ai * hr + gi[i];
                hr = nr; hi = ni;
            }
        }
    }
}

__device__ __forceinline__ void gla_c_item(PRef p, int j, int item, char* smem) {
    const int h = item & 3, c = (item >> 2) & 255, b = item >> 10;
    const int t0 = b * L_ + c * 64;
    float* sB = (float*)smem;
    bf16_t* QT = (bf16_t*)(smem + 16640);
    bf16_t* KT = (bf16_t*)(smem + 16640 + 9216);
    bf16_t* ATT = (bf16_t*)(smem + 16640 + 18432);
    float* OS = (float*)(smem + 16640 + 27648);
    const bf16_t* PE = (const bf16_t*)(p.ws + OFF_PE);
    const bf16_t* VTE = (const bf16_t*)(p.ws + OFF_VTE);
    const int tid = otid(), lane = tid & 63, wave = tid >> 6, fr = lane & 15, fq = lane >> 4;
    gla_decay(p, j, t0, h, sB);
    for (int e = tid; e < 4096; e += NTHR) {
        const int tau = e >> 6, d = e & 63;
        const float bb = sB[tau * 65 + d];
        const float q = bf2f(PE[(size_t)(t0 + tau) * 1536 + h * 64 + d]);
        const float k = bf2f(PE[(size_t)(t0 + tau) * 1536 + 256 + h * 64 + d]);
        QT[tau * 72 + d] = f2bf(q * 0.125f * __expf(bb));
        KT[tau * 72 + d] = f2bf(k * __expf(-bb));
    }
    __syncthreads();
    const int iblk = wave >> 1;
    {
        f32x4 acc[2];
        acc[0] = (f32x4){0.f, 0.f, 0.f, 0.f}; acc[1] = acc[0];
#pragma unroll
        for (int ks = 0; ks < 2; ++ks) {
            const bf16x8 af = *(const bf16x8*)(QT + (iblk * 16 + fr) * 72 + ks * 32 + fq * 8);
#pragma unroll
            for (int n = 0; n < 2; ++n) {
                const int jb = (wave & 1) * 2 + n;
                const bf16x8 bfr = *(const bf16x8*)(KT + (jb * 16 + fr) * 72 + ks * 32 + fq * 8);
                acc[n] = __builtin_amdgcn_mfma_f32_16x16x32_bf16(af, bfr, acc[n], 0, 0, 0);
            }
        }
#pragma unroll
        for (int n = 0; n < 2; ++n) {
            const int jj = ((wave & 1) * 2 + n) * 16 + fr;
#pragma unroll
            for (int r = 0; r < 4; ++r) { const int ii = iblk * 16 + fq * 4 + r; ATT[ii * 72 + jj] = f2bf(jj <= ii ? acc[n][r] : 0.f); }
        }
    }
    __syncthreads();
    {
        const int vb = (wave & 1) * 64;
        const float* SST = (const float*)(p.ws + OFF_SST) + ((size_t)((b * 256 + c) * 4 + h)) * 64 * 128;
        f32x4 acc[4];
#pragma unroll
        for (int n = 0; n < 4; ++n) acc[n] = (f32x4){0.f, 0.f, 0.f, 0.f};
#pragma unroll
        for (int ks = 0; ks < 2; ++ks) {
            const bf16x8 af = *(const bf16x8*)(ATT + (iblk * 16 + fr) * 72 + ks * 32 + fq * 8);
            const bf16x8 aq = *(const bf16x8*)(QT + (iblk * 16 + fr) * 72 + ks * 32 + fq * 8);
#pragma unroll
            for (int n = 0; n < 4; ++n) {
                const int v = vb + n * 16 + fr;
                const bf16x8 bv = *(const bf16x8*)(VTE + ((size_t)((b * 4 + h) * 128 + v)) * L_ + (c * 64 + ks * 32 + fq * 8));
                acc[n] = __builtin_amdgcn_mfma_f32_16x16x32_bf16(af, bv, acc[n], 0, 0, 0);
                bf16x8 bs;
#pragma unroll
                for (int i = 0; i < 8; ++i) bs[i] = (short)f2bf(SST[(ks * 32 + fq * 8 + i) * 128 + v]);
                acc[n] = __builtin_amdgcn_mfma_f32_16x16x32_bf16(aq, bs, acc[n], 0, 0, 0);
            }
        }
#pragma unroll
        for (int n = 0; n < 4; ++n)
#pragma unroll
            for (int r = 0; r < 4; ++r) OS[(iblk * 16 + fq * 4 + r) * 132 + vb + n * 16 + fr] = acc[n][r];
    }
    __syncthreads();
    {
        const int i = tid >> 3, seg = tid & 7;
        float o[16]; float ss = 0.f;
#pragma unroll
        for (int q = 0; q < 16; ++q) { o[q] = OS[i * 132 + seg * 16 + q]; ss += o[q] * o[q]; }
        ss += __shfl_xor(ss, 1, 64); ss += __shfl_xor(ss, 2, 64); ss += __shfl_xor(ss, 4, 64);
        const float rs = rsqrtf(ss * (1.f / 128.f) + LN_EPS);
        const float* ng = p.gla_norm_g + (size_t)j * 128;
        bf16_t* CC = (bf16_t*)(p.ws + OFF_CC);
        const size_t t = (size_t)(t0 + i);
        unsigned w[8];
#pragma unroll
        for (int q = 0; q < 16; q += 2) {
            const int v0 = seg * 16 + q;
            const float r0 = bf2f(PE[t * 1536 + 1024 + h * 128 + v0]), r1 = bf2f(PE[t * 1536 + 1024 + h * 128 + v0 + 1]);
            const float a0 = o[q] * rs * ng[v0] * (r0 * sigmoidf_(r0)), a1 = o[q + 1] * rs * ng[v0 + 1] * (r1 * sigmoidf_(r1));
            w[q >> 1] = pk2(a0, a1);
        }
        u32x4 w0, w1; w0.x = w[0]; w0.y = w[1]; w0.z = w[2]; w0.w = w[3]; w1.x = w[4]; w1.y = w[5]; w1.z = w[6]; w1.w = w[7];
        *(u32x4*)(CC + t * 1024 + h * 128 + seg * 16) = w0;
        *(u32x4*)(CC + t * 1024 + h * 128 + seg * 16 + 8) = w1;
    }
    __syncthreads();
}

__device__ __forceinline__ void s5_g_phase(PRef p, int j, char* smem, int bid, int nb) {
    const bf16_t* UH = (const bf16_t*)(p.ws + OFF_UH);
    float* GB = (float*)(p.ws + OFF_GBUF);
    for (int t = bid; t < 64; t += nb) {
        const int g = t >> 1, mi = t & 1;
        const bf16_t* Bt = (const bf16_t*)(p.ws + OFF_GM) + (size_t)(j * 32 + g) * 128 * 1024;
        gemm_tile<false>(UH + (size_t)g * UHW, (long)32 * UHW, 0, mi * 256, Bt, 1024, 0, 1024, smem,
            [&](f32x4 (&acc)[4][2], int rt0, int c0, int fr, int fq) {
#pragma unroll
                for (int m = 0; m < 4; ++m)
#pragma unroll
                    for (int n = 0; n < 2; ++n)
#pragma unroll
                        for (int r = 0; r < 4; ++r) {
                            const int row = mi * 256 + rt0 + m * 16 + fq * 4 + r;
                            GB[((size_t)row * 32 + g) * 128 + c0 + n * 16 + fr] = acc[m][n][r];
                        }
            });
    }
}
__device__ __forceinline__ void s5_y_phase(PRef p, int j, char* smem, int bid, int nb) {
    const bf16_t* UH = (const bf16_t*)(p.ws + OFF_UH);
    bf16_t* YA = (bf16_t*)(p.ws + OFF_YA);
    const float* dsk = p.s5_d + (size_t)j * 512;
    XcdSeq sq(32 * 2 * 4, bid, nb);
    for (int t = sq.q; t < sq.qend; t += sq.step) {
        const int g = t >> 3, mi = (t >> 2) & 1, ni = t & 3;
        const bf16_t* Bt = (const bf16_t*)(p.ws + OFF_TH) + (size_t)(j * 32 + g) * 1024 * UHW;
        gemm256_tile<false>(UH + (size_t)g * UHW, (long)32 * UHW, 0, mi * 256, Bt, UHW, ni * 256, UHW, smem,
            [&](f32x4 (&acc)[4][2], int rt0, int c0, int fr, int fq) {
                const int col = c0 + 8 * fq;
                const int tau = col >> 4, nn = col & 15, ch = g * 16 + nn;
                const f32x4 d0 = *(const f32x4*)(dsk + ch), d1 = *(const f32x4*)(dsk + ch + 4);
#pragma unroll
                for (int m = 0; m < 4; ++m) {
                    const int row = mi * 256 + rt0 + m * 16 + fr;
                    const u32x4 uw = *(const u32x4*)(UH + ((size_t)row * 32 + g) * UHW + col);
                    float y[8];
#pragma unroll
                    for (int q = 0; q < 4; ++q) {
                        const unsigned u2 = q == 0 ? uw.x : q == 1 ? uw.y : q == 2 ? uw.z : uw.w;
                        const float u0 = __uint_as_float(u2 << 16), u1 = __uint_as_float(u2 & 0xffff0000u);
                        const float a0 = q < 2 ? acc[m][0][2 * q] : acc[m][1][2 * q - 4], a1 = q < 2 ? acc[m][0][2 * q + 1] : acc[m][1][2 * q - 3];
                        const float dd0 = q < 2 ? d0[2 * q] : d1[2 * q - 4], dd1 = q < 2 ? d0[2 * q + 1] : d1[2 * q - 3];
                        y[2 * q] = gelu_tanh(a0 + dd0 * u0); y[2 * q + 1] = gelu_tanh(a1 + dd1 * u1);
                    }
                    u32x4 w; w.x = pk2(y[0], y[1]); w.y = pk2(y[2], y[3]); w.z = pk2(y[4], y[5]); w.w = pk2(y[6], y[7]);
                    *(u32x4*)(YA + ((size_t)row * 64 + tau) * 512 + ch) = w;
                }
            });
    }
}

template <bool SLOTS>
__device__ __forceinline__ void ln_phase(PRef p, const float* xin, const float* addb, const float* g, const float* bta, float* xout, bf16_t* xb, int bid, int nb) {
    const int lane = otid() & 63, wave = otid() >> 6;
    for (int t = bid * 8 + wave; t < T_; t += nb * 8) {
        f32x4 v[4];
        float s = 0.f;
#pragma unroll
        for (int i = 0; i < 4; ++i) {
            const int c = i * 256 + lane * 4;
            f32x4 a = *(const f32x4*)(xin + (size_t)t * 1024 + c);
            f32x4 m;
            if (SLOTS) {
                const bf16_t* sl = (const bf16_t*)addb;
                m = (f32x4){0.f, 0.f, 0.f, 0.f};
#pragma unroll
                for (int k = 0; k < 4; ++k) {
                    const u32x2 w = *(const u32x2*)(sl + ((size_t)t * 4 + k) * 1024 + c);
                    m[0] += __uint_as_float(w.x << 16); m[1] += __uint_as_float(w.x & 0xffff0000u); m[2] += __uint_as_float(w.y << 16); m[3] += __uint_as_float(w.y & 0xffff0000u);
                }
            } else m = *(const f32x4*)(addb + (size_t)t * 1024 + c);
            v[i] = a * ALPHA + m;
            s += v[i][0] + v[i][1] + v[i][2] + v[i][3];
        }
        const float mu = wave_sum(s) * (1.f / 1024.f);
        float q = 0.f;
#pragma unroll
        for (int i = 0; i < 4; ++i) { v[i] -= mu; q += v[i][0] * v[i][0] + v[i][1] * v[i][1] + v[i][2] * v[i][2] + v[i][3] * v[i][3]; }
        const float rs = rsqrtf(wave_sum(q) * (1.f / 1024.f) + LN_EPS);
#pragma unroll
        for (int i = 0; i < 4; ++i) {
            const int c = i * 256 + lane * 4;
            const f32x4 gg = *(const f32x4*)(g + c), bb = *(const f32x4*)(bta + c);
            const f32x4 o = v[i] * rs * gg + bb;
            *(f32x4*)(xout + (size_t)t * 1024 + c) = o;
            if (xb) { u32x2 w; w.x = pk2(o[0], o[1]); w.y = pk2(o[2], o[3]); *(u32x2*)(xb + (size_t)t * 1024 + c) = w; }
        }
    }
}

__device__ __forceinline__ void topk_phase(PRef p, int layer, int bid, int nb) {
    const float* LG = (const float*)(p.ws + OFF_LOGIT);
    int* cnt = (int*)(p.ws + OFF_CNT) + layer * 32;
    int* LIST = (int*)(p.ws + OFF_LIST);
    float* GATE = (float*)(p.ws + OFF_GATE);
    for (int t = bid * NTHR + otid(); t < T_; t += nb * NTHR) {
        float v0 = -INFINITY, v1 = -INFINITY, v2 = -INFINITY, v3 = -INFINITY; int i0 = 0, i1 = 0, i2 = 0, i3 = 0;
#pragma unroll
        for (int q = 0; q < 8; ++q) {
            const f32x4 l4 = *(const f32x4*)(LG + (size_t)t * 32 + q * 4);
#pragma unroll
            for (int r = 0; r < 4; ++r) {
                const float v = l4[r]; const int e = q * 4 + r;
                if (v > v0) { v3 = v2; i3 = i2; v2 = v1; i2 = i1; v1 = v0; i1 = i0; v0 = v; i0 = e; }
                else if (v > v1) { v3 = v2; i3 = i2; v2 = v1; i2 = i1; v1 = v; i1 = e; }
                else if (v > v2) { v3 = v2; i3 = i2; v2 = v; i2 = e; }
                else if (v > v3) { v3 = v; i3 = e; }
            }
        }
        const float e1 = __expf(v1 - v0), e2 = __expf(v2 - v0), e3 = __expf(v3 - v0);
        const float inv = 1.f / (1.f + e1 + e2 + e3);
        int pos;
        pos = atomicAdd(&cnt[i0], 1); LIST[(size_t)i0 * LISTCAP + pos] = t * 4 + 0; GATE[t * 4 + 0] = inv;
        pos = atomicAdd(&cnt[i1], 1); LIST[(size_t)i1 * LISTCAP + pos] = t * 4 + 1; GATE[t * 4 + 1] = e1 * inv;
        pos = atomicAdd(&cnt[i2], 1); LIST[(size_t)i2 * LISTCAP + pos] = t * 4 + 2; GATE[t * 4 + 2] = e2 * inv;
        pos = atomicAdd(&cnt[i3], 1); LIST[(size_t)i3 * LISTCAP + pos] = t * 4 + 3; GATE[t * 4 + 3] = e3 * inv;
    }
}

template <int WHICH>
__device__ __forceinline__ void moe_gemm_phase(PRef p, int layer, char* smem, int bid, int nb) {
    const int* cnt = (const int*)(p.ws + OFF_CNT) + layer * 32;
    const int* LIST = (const int*)(p.ws + OFF_LIST);
    int* sRow = (int*)(smem + G8_ROWS_OFF);
    constexpr int NTN = WHICH == 1 ? 8 : 4;
    int total = 0;
    for (int i = 0; i < 32; ++i) total += ((cnt[i] + 255) >> 8) * NTN;
    XcdSeq sq(total, bid, nb);
    int e = 0, base = 0, ce = cnt[0], mt = (ce + 255) >> 8;
    for (int t = sq.q; t < sq.qend; t += sq.step) {
        while (e < 32 && t >= base + mt * NTN) { base += mt * NTN; ++e; if (e < 32) { ce = cnt[e]; mt = (ce + 255) >> 8; } }
        if (e >= 32) break;
        int mi, ni;
        { const int loc = t - base, pf = mt >> 2, full = pf * 4 * NTN;
          if (loc < full) { const int pn = loc / (4 * NTN), r = loc - pn * 4 * NTN; ni = r >> 2; mi = pn * 4 + (r & 3); }
          else { const int ph = mt - pf * 4, r = loc - full; ni = r / ph; mi = pf * 4 + (r - ni * ph); } }
        __syncthreads();
        if (otid() < 256) { const int r = mi * 256 + otid(); sRow[otid()] = r < ce ? LIST[(size_t)e * LISTCAP + r] : -1; }
        __syncthreads();
        if (WHICH == 1) {
            const bf16_t* Bt = (const bf16_t*)(p.ws + OFF_WT_W1) + (size_t)(layer * 32 + e) * 2048 * 1024;
            const float* b1 = p.moe_b1 + (size_t)(layer * 32 + e) * 2048;
            bf16_t* ACT = (bf16_t*)(p.ws + OFF_ACT);
            gemm256_tile<true>((const bf16_t*)(p.ws + OFF_XB), 1024, 2, 0, Bt, 1024, ni * 256, 1024, smem,
                [&](f32x4 (&acc)[4][2], int rt0, int c0, int fr, int fq) {
                    const int gcol = (c0 >> 5) * 16 + 4 * fq;
                    const f32x4 bg = *(const f32x4*)(b1 + gcol), bl = *(const f32x4*)(b1 + 1024 + gcol);
#pragma unroll
                    for (int m = 0; m < 4; ++m) {
                        const int pair = sRow[rt0 + m * 16 + fr];
                        if (pair >= 0) {
                            float a[4];
#pragma unroll
                            for (int r = 0; r < 4; ++r) {
                                const float gl = fminf(acc[m][0][r] + bg[r], 7.f);
                                const float li = fminf(fmaxf(acc[m][1][r] + bl[r], -7.f), 7.f);
                                a[r] = gl * sigmoidf_(1.702f * gl) * (li + 1.f);
                            }
                            u32x2 w; w.x = pk2(a[0], a[1]); w.y = pk2(a[2], a[3]);
                            *(u32x2*)(ACT + (size_t)pair * 1024 + gcol) = w;
                        }
                    }
                });
        } else {
            const bf16_t* Bt = (const bf16_t*)(p.ws + OFF_WT_W2) + (size_t)(layer * 32 + e) * 1024 * 1024;
            const float* b2 = p.moe_b2 + (size_t)(layer * 32 + e) * 1024;
            const float* GATE = (const float*)(p.ws + OFF_GATE);
            bf16_t* SLOT = (bf16_t*)(p.ws + OFF_SLOT);
            gemm256_tile<true>((const bf16_t*)(p.ws + OFF_ACT), 1024, 0, 0, Bt, 1024, ni * 256, 1024, smem,
                [&](f32x4 (&acc)[4][2], int rt0, int c0, int fr, int fq) {
                    const int col = c0 + 8 * fq;
                    const f32x4 b20 = *(const f32x4*)(b2 + col), b21 = *(const f32x4*)(b2 + col + 4);
#pragma unroll
                    for (int m = 0; m < 4; ++m) {
                        const int pair = sRow[rt0 + m * 16 + fr];
                        if (pair >= 0) {
                            const float gt = GATE[pair];
                            const f32x4 y0 = (acc[m][0] + b20) * gt, y1 = (acc[m][1] + b21) * gt;
                            u32x4 w; w.x = pk2(y0[0], y0[1]); w.y = pk2(y0[2], y0[3]); w.z = pk2(y1[0], y1[1]); w.w = pk2(y1[2], y1[3]);
                            *(u32x4*)(SLOT + (size_t)pair * 1024 + col) = w;
                        }
                    }
                });
        }
    }
}


__device__ __forceinline__ void epi_od_in(PRef p, f32x4 (&acc)[4][2], int row0, int c0, int fr, int fq) {
    char* ws = p.ws;
    bf16_t* PO = (bf16_t*)(ws + OFF_PO); float* WI = (float*)(ws + OFF_WI); bf16_t* VTC = (bf16_t*)(ws + OFF_VTC); bf16_t* VTD = (bf16_t*)(ws + OFF_VTD);
    const int col = c0 + 8 * fq;
#pragma unroll
    for (int m = 0; m < 4; ++m) {
        const int t = row0 + m * 16 + fr;
        if (c0 < 6464) {
            u32x4 w; w.x = pk2(acc[m][0][0], acc[m][0][1]); w.y = pk2(acc[m][0][2], acc[m][0][3]); w.z = pk2(acc[m][1][0], acc[m][1][1]); w.w = pk2(acc[m][1][2], acc[m][1][3]);
            *(u32x4*)(PO + (size_t)t * OD_N + col) = w;
            const int b = t >> 14, pos = t & (L_ - 1);
            bf16_t* vp = nullptr;
            if (c0 >= 1024 && c0 < 1536) {
                const int c = col - 1024, hd = c >> 6, d = c & 63;
                vp = VTC + ((size_t)((b * 8 + hd) * 64 + d)) * L_ + pos;
            } else if (c0 >= 4864 && c0 < 6400) {
                const int c = col - 4864, g = c >> 9, hd = (c >> 6) & 7, d = c & 63, sh = 2 * g;
                vp = VTD + ((size_t)(((b * 3 + g) * 8 + hd) * 64 + d)) * L_ + (size_t)(pos & ((1 << sh) - 1)) * (L_ >> sh) + (pos >> sh);
            }
            if (vp) {
                vp[0] = (bf16_t)(w.x & 0xffffu); vp[(size_t)L_] = (bf16_t)(w.x >> 16); vp[(size_t)2 * L_] = (bf16_t)(w.y & 0xffffu); vp[(size_t)3 * L_] = (bf16_t)(w.y >> 16);
                vp[(size_t)4 * L_] = (bf16_t)(w.z & 0xffffu); vp[(size_t)5 * L_] = (bf16_t)(w.z >> 16); vp[(size_t)6 * L_] = (bf16_t)(w.w & 0xffffu); vp[(size_t)7 * L_] = (bf16_t)(w.w >> 16);
            }
        } else if (col == 6464) {
            *(f32x4*)(WI + (size_t)t * 4) = acc[m][0];
        }
    }
}

__device__ __forceinline__ void idx_scores(const char* __restrict__ ktile, int kbase, const bf16x8 (&qf)[4][4], const float (&wi)[4], int lane, float (&sc)[16]) {
    const int r = lane & 31, h2 = lane >> 5;
    const char* kp = ktile + (kbase + r) * 144 + h2 * 16;
    bf16x8 kf[4];
#pragma unroll
    for (int s = 0; s < 4; ++s) kf[s] = *(const bf16x8*)(kp + s * 32);
#pragma unroll
    for (int i = 0; i < 16; ++i) sc[i] = 0.f;
#pragma unroll
    for (int hd = 0; hd < 4; ++hd) {
        f32x16 a;
#pragma unroll
        for (int i = 0; i < 16; ++i) a[i] = 0.f;
#pragma unroll
        for (int s = 0; s < 4; ++s) a = __builtin_amdgcn_mfma_f32_32x32x16_bf16(kf[s], qf[hd][s], a, 0, 0, 0);
#pragma unroll
        for (int i = 0; i < 16; ++i) { const int ai = __float_as_int(a[i]); sc[i] += wi[hd] * __int_as_float(ai > 0 ? ai : 0); }
    }
}
__device__ __forceinline__ unsigned ord_key(float s) {
    const unsigned u = __float_as_uint(s);
    return u ^ ((unsigned)((int)u >> 31) | 0x80000000u);
}

constexpr int SEL_KT = 128 * 144;
__device__ __forceinline__ void dsa_select_item(PRef p, int b, int qb, char* smem) {
    unsigned* hist = (unsigned*)smem;
    unsigned* pref = (unsigned*)(smem + 66048);
    int* krem = (int*)(smem + 66048 + 256);
    unsigned* GW = (unsigned*)(smem + 66048 + 512);
    unsigned* EW = (unsigned*)(smem + 66048 + 512 + 1024);
    char* kbuf = smem + 69632;
    const bf16_t* PO = (const bf16_t*)(p.ws + OFF_PO);
    const float* WI = (const float*)(p.ws + OFF_WI);
    unsigned long long* BMT = (unsigned long long*)(p.ws + OFF_BM);
    const int tid = otid(), lane = tid & 63, wave = tid >> 6, kw = wave >> 1, qw = wave & 1, h2 = lane >> 5;
    const int p0 = qb * 64;
    const int ql = qw * 32 + (lane & 31);
    const int qpos = p0 + ql;
    const size_t tq = (size_t)b * L_ + qpos;
    const int nkt = (p0 + 64 + 127) >> 7;
    bf16x8 qf[4][4]; float wi[4];
#pragma unroll
    for (int hd = 0; hd < 4; ++hd) {
        wi[hd] = WI[tq * 4 + hd];
#pragma unroll
        for (int s = 0; s < 4; ++s) qf[hd][s] = *(const bf16x8*)(PO + tq * OD_N + OD_QI + hd * 64 + s * 16 + h2 * 8);
    }
    const int srow = tid >> 3, sch = tid & 7;
    const bf16_t* ksrc = PO + ((size_t)b * L_ + srow) * OD_N + OD_KI + sch * 8;
    char* kdst = kbuf + srow * 144 + sch * 16;
    for (int e = tid; e < 64 * 257; e += NTHR) hist[e] = 0u;
    if (tid < 64) { pref[tid] = 0u; krem[tid] = 256; }
    __syncthreads();
    const bool selall = qpos < 256;
    const int npass = (p0 + 63 >= 256) ? 3 : 0;
    for (int pass = 0; pass <= npass; ++pass) {
        const bool maskpass = pass == npass;
        const int sh = 24 - 8 * pass;
        const unsigned mypref = pref[ql];
        int ceq = 0;
        const int rsel = tid < 64 ? krem[tid] : 0;
        u32x4 r0 = *(const u32x4*)ksrc, r1 = *(const u32x4*)(ksrc + (size_t)64 * OD_N);
        *(u32x4*)kdst = r0; *(u32x4*)(kdst + 64 * 144) = r1;
        __syncthreads();
        for (int kt = 0; kt < nkt; ++kt) {
            const bool more = kt + 1 < nkt;
            if (more) { r0 = *(const u32x4*)(ksrc + (size_t)(kt + 1) * 128 * OD_N); r1 = *(const u32x4*)(ksrc + (size_t)((kt + 1) * 128 + 64) * OD_N); }
            float sc[16];
            idx_scores(kbuf + (kt & 1) * SEL_KT, kw * 32, qf, wi, lane, sc);
            const int keybase = kt * 128 + kw * 32;
            const bool diag = kt == nkt - 1;
            if (!maskpass) {
#pragma unroll
                for (int i = 0; i < 16; ++i) {
                    const int key = keybase + (i & 3) + 8 * (i >> 2) + 4 * h2;
                    const unsigned k32 = ord_key(sc[i]);
                    const bool match = pass == 0 ? true : ((k32 >> (sh + 8)) == mypref);
                    const bool valid = diag ? key <= qpos : true;
                    if (valid && !selall && match) atomicAdd(&hist[ql * 257 + ((k32 >> sh) & 255u)], 1u);
                }
                if (more) { char* nd = kdst + ((kt + 1) & 1) * SEL_KT; *(u32x4*)nd = r0; *(u32x4*)(nd + 64 * 144) = r1; }
                __syncthreads();
            } else {
                unsigned gw = 0u, ew = 0u;
#pragma unroll
                for (int i = 0; i < 16; ++i) {
                    const int ko = (i & 3) + 8 * (i >> 2) + 4 * h2;
                    const int key = keybase + ko;
                    const unsigned k24 = ord_key(sc[i]) >> 8;
                    const bool valid = diag ? key <= qpos : true;
                    const bool g = valid && (selall || k24 > mypref);
                    const bool e = valid && !selall && k24 == mypref;
                    gw |= (g ? 1u : 0u) << ko; ew |= (e ? 1u : 0u) << ko;
                }
                gw |= __shfl_xor(gw, 32, 64); ew |= __shfl_xor(ew, 32, 64);
                if (h2 == 0) { GW[ql * 4 + kw] = gw; EW[ql * 4 + kw] = ew; }
                if (more) { char* nd = kdst + ((kt + 1) & 1) * SEL_KT; *(u32x4*)nd = r0; *(u32x4*)(nd + 64 * 144) = r1; }
                __syncthreads();
                if (tid < 64) {
                    unsigned g4[4], e4[4];
#pragma unroll
                    for (int w = 0; w < 4; ++w) { g4[w] = GW[tid * 4 + w]; e4[w] = EW[tid * 4 + w]; }
                    int need = rsel - ceq; if (need < 0) need = 0;
#pragma unroll
                    for (int w = 0; w < 4; ++w) {
                        const int pc = __popc(e4[w]);
                        ceq += pc;
                        if (need >= pc) need -= pc;
                        else { unsigned m = e4[w], kept = 0u; for (int k = 0; k < need; ++k) { const unsigned low = m & (0u - m); kept |= low; m ^= low; } e4[w] = kept; need = 0; }
                        g4[w] |= e4[w];
                    }
                    BMT[((size_t)(b * 256 + 2 * kt)) * L_ + p0 + tid] = (unsigned long long)g4[0] | ((unsigned long long)g4[1] << 32);
                    BMT[((size_t)(b * 256 + 2 * kt + 1)) * L_ + p0 + tid] = (unsigned long long)g4[2] | ((unsigned long long)g4[3] << 32);
                }
                __syncthreads();
            }
        }
        if (!maskpass) {
            const int q = tid >> 3, part = tid & 7;
            unsigned c32[32]; unsigned tot = 0u;
#pragma unroll
            for (int i = 0; i < 32; ++i) { c32[i] = hist[q * 257 + part * 32 + i]; tot += c32[i]; }
            unsigned above = 0u;
#pragma unroll
            for (int d = 1; d < 8; ++d) { const unsigned o = __shfl(tot, (lane & ~7) + ((part + d) & 7), 64); if (part + d < 8) above += o; }
            const unsigned need = (unsigned)krem[q];
            __syncthreads();
            if ((p0 + q) >= 256 && above < need && above + tot >= need) {
                unsigned cum = above; int dg = 31;
#pragma unroll
                for (int i = 31; i >= 0; --i) { if (i == dg) { if (cum + c32[i] >= need) {   } else { cum += c32[i]; dg = i - 1; } } }
                pref[q] = (pref[q] << 8) | (unsigned)(part * 32 + dg);
                krem[q] = (int)(need - cum);
            }
            for (int e = tid; e < 64 * 257; e += NTHR) hist[e] = 0u;
            __syncthreads();
        }
    }
}

template <int MODE, int NQT>
__device__ __forceinline__ void attn_wave(PRef p, int b, int head, int qcol, int kcol, const bf16_t* __restrict__ VT, int voff,
                                          int i0, int sh  , int rho, int kt_lo, int kt_hi, int grp) {
    const bf16_t* PO = (const bf16_t*)(p.ws + OFF_PO);
    const unsigned* BM32 = (const unsigned*)(p.ws + OFF_BM);
    const int lane = otid() & 63, r = lane & 31, h2 = lane >> 5;
    const int pr = (r & 0x13) | ((r & 4) << 1) | ((r & 8) >> 1);
    const float SC = 0.125f * 1.4426950408889634f;
    bf16x8 qf[NQT][4]; size_t tq[NQT]; int qi[NQT];
#pragma unroll
    for (int qt = 0; qt < NQT; ++qt) {
        qi[qt] = i0 + qt * 32 + r;
        tq[qt] = (size_t)b * L_ + ((size_t)qi[qt] << sh) + rho;
#pragma unroll
        for (int s = 0; s < 4; ++s) qf[qt][s] = *(const bf16x8*)(PO + tq[qt] * OD_N + qcol + head * 64 + s * 16 + h2 * 8);
    }
    f32x16 oacc[NQT][2];
#pragma unroll
    for (int a = 0; a < NQT; ++a)
#pragma unroll
        for (int c = 0; c < 2; ++c)
#pragma unroll
            for (int i = 0; i < 16; ++i) oacc[a][c][i] = 0.f;
    float mrun[NQT], lrun[NQT];
#pragma unroll
    for (int a = 0; a < NQT; ++a) { mrun[a] = -1e30f; lrun[a] = 0.f; }
    bf16x8 kf[4]; unsigned mw[NQT];
    auto load_k = [&](int kt, bf16x8 (&k_)[4], unsigned (&m_)[NQT]) {
        const size_t krow = (size_t)b * L_ + ((size_t)(kt * 32 + pr) << sh) + rho;
#pragma unroll
        for (int s = 0; s < 4; ++s) k_[s] = *(const bf16x8*)(PO + krow * OD_N + kcol + head * 64 + s * 16 + h2 * 8);
#pragma unroll
        for (int a = 0; a < NQT; ++a) m_[a] = MODE == 0 ? BM32[tq[a] * 512 + kt] : 0u;
    };
    load_k(kt_lo, kf, mw);
#pragma unroll 1
    for (int kt = kt_lo; kt <= kt_hi; ++kt) {
        bf16x8 vf[2][2];
#pragma unroll
        for (int db = 0; db < 2; ++db)
#pragma unroll
            for (int s2 = 0; s2 < 2; ++s2) vf[db][s2] = *(const bf16x8*)(VT + (size_t)(db * 32 + r) * L_ + voff + kt * 32 + s2 * 16 + h2 * 8);
        bf16x8 kn[4]; unsigned mn[NQT];
#pragma unroll
        for (int a = 0; a < NQT; ++a) mn[a] = 0u;
        if (kt < kt_hi) load_k(kt + 1, kn, mn);
#pragma unroll
        for (int qt = 0; qt < NQT; ++qt) {
            f32x16 s;
#pragma unroll
            for (int i = 0; i < 16; ++i) s[i] = 0.f;
#pragma unroll
            for (int ks = 0; ks < 4; ++ks) s = __builtin_amdgcn_mfma_f32_32x32x16_bf16(kf[ks], qf[qt][ks], s, 0, 0, 0);
            unsigned selm = 0u; float mx = -1e30f;
#pragma unroll
            for (int i = 0; i < 16; ++i) {
                const int ko = 16 * (i >> 3) + 8 * h2 + 4 * ((i >> 2) & 1) + (i & 3);
                bool sl;
                if (MODE == 0) sl = (mw[qt] >> ko) & 1u;
                else { const int kk = kt * 32 + ko; sl = (kk <= qi[qt]) && (kk >= qi[qt] - 128); }
                selm |= (sl ? 1u : 0u) << i;
                s[i] = sl ? s[i] * SC : -1e30f;
                mx = fmaxf(mx, s[i]);
            }
            mx = fmaxf(mx, __shfl_xor(mx, 32, 64));
            const float mnew = fmaxf(mrun[qt], mx);
            const float corr = __builtin_amdgcn_exp2f(mrun[qt] - mnew);
            mrun[qt] = mnew;
            float ps = 0.f;
#pragma unroll
            for (int i = 0; i < 16; ++i) { s[i] = ((selm >> i) & 1u) ? __builtin_amdgcn_exp2f(s[i] - mnew) : 0.f; ps += s[i]; }
            lrun[qt] = lrun[qt] * corr + ps;
#pragma unroll
            for (int db = 0; db < 2; ++db)
#pragma unroll
                for (int i = 0; i < 16; ++i) oacc[qt][db][i] *= corr;
#pragma unroll
            for (int s2 = 0; s2 < 2; ++s2) {
                u32x4 pw; pw.x = pk2(s[8 * s2], s[8 * s2 + 1]); pw.y = pk2(s[8 * s2 + 2], s[8 * s2 + 3]); pw.z = pk2(s[8 * s2 + 4], s[8 * s2 + 5]); pw.w = pk2(s[8 * s2 + 6], s[8 * s2 + 7]);
                const bf16x8 pf = __builtin_bit_cast(bf16x8, pw);
#pragma unroll
                for (int db = 0; db < 2; ++db) oacc[qt][db] = __builtin_amdgcn_mfma_f32_32x32x16_bf16(vf[db][s2], pf, oacc[qt][db], 0, 0, 0);
            }
        }
        if (kt < kt_hi) {
#pragma unroll
            for (int s = 0; s < 4; ++s) kf[s] = kn[s];
#pragma unroll
            for (int a = 0; a < NQT; ++a) mw[a] = mn[a];
        }
    }
#pragma unroll
    for (int qt = 0; qt < NQT; ++qt) {
        const float lt = lrun[qt] + __shfl_xor(lrun[qt], 32, 64);
        const float inv = 1.f / lt;
        if (MODE == 0) {
            bf16_t* CC = (bf16_t*)(p.ws + OFF_CC);
#pragma unroll
            for (int db = 0; db < 2; ++db)
#pragma unroll
                for (int i = 0; i < 16; ++i) {
                    const int d = db * 32 + (i & 3) + 8 * (i >> 2) + 4 * h2;
                    CC[tq[qt] * 1024 + head * 64 + d] = f2bf(oacc[qt][db][i] * inv);
                }
        } else {
            float* OD = (float*)(p.ws + OFF_OD) + (size_t)grp * T_ * 512;
#pragma unroll
            for (int db = 0; db < 2; ++db)
#pragma unroll
                for (int i = 0; i < 16; ++i) {
                    const int d = db * 32 + (i & 3) + 8 * (i >> 2) + 4 * h2;
                    OD[tq[qt] * 512 + head * 64 + d] = oacc[qt][db][i] * inv;
                }
            if (h2 == 0) ((float*)(p.ws + OFF_LSE))[((size_t)grp * T_ + tq[qt]) * 8 + head] = mrun[qt] + log2f(lt);
        }
    }
}

__device__ __forceinline__ void dil_combine_phase(PRef p, int bid, int nb) {
    const float* OD = (const float*)(p.ws + OFF_OD); const float* LSE = (const float*)(p.ws + OFF_LSE);
    bf16_t* CC = (bf16_t*)(p.ws + OFF_CC);
    const long n = (long)T_ * 128;
    for (long c = (long)bid * NTHR + otid(); c < n; c += (long)nb * NTHR) {
        const long t = c >> 7; const int ch = (int)(c & 127) * 4, hd = ch >> 6;
        const float l0 = LSE[((size_t)0 * T_ + t) * 8 + hd], l1 = LSE[((size_t)1 * T_ + t) * 8 + hd], l2 = LSE[((size_t)2 * T_ + t) * 8 + hd];
        const float mx = fmaxf(l0, fmaxf(l1, l2));
        const float w0 = exp2f(l0 - mx), w1 = exp2f(l1 - mx), w2 = exp2f(l2 - mx);
        const float inv = 1.f / (w0 + w1 + w2);
        const f32x4 a = *(const f32x4*)(OD + ((size_t)0 * T_ + t) * 512 + ch), bq = *(const f32x4*)(OD + ((size_t)1 * T_ + t) * 512 + ch),
                    cq = *(const f32x4*)(OD + ((size_t)2 * T_ + t) * 512 + ch);
        const f32x4 o = (a * w0 + bq * w1 + cq * w2) * inv;
        u32x2 w; w.x = pk2(o[0], o[1]); w.y = pk2(o[2], o[3]);
        *(u32x2*)(CC + (size_t)t * 1024 + 512 + ch) = w;
    }
}

constexpr int DA_ROW = 144;
constexpr int DA_TILE = 64 * DA_ROW;
__device__ __forceinline__ void dsa_attn_item(PRef p, int b, int head, int qb, char* smem) {
    const bf16_t* PO = (const bf16_t*)(p.ws + OFF_PO);
    const bf16_t* VT = (const bf16_t*)(p.ws + OFF_VTC) + ((size_t)(b * 8 + head)) * 64 * L_;
    const int tid = otid(), lane = tid & 63, wave = tid >> 6, r = lane & 31, h2 = lane >> 5;
    const int pr = (r & 0x13) | ((r & 4) << 1) | ((r & 8) >> 1);
    const float SC = 0.125f * 1.4426950408889634f;
    const int i0 = qb * 256 + wave * 32, qi = i0 + r;
    const unsigned long long* BMT = (const unsigned long long*)(p.ws + OFF_BM) + (size_t)b * 256 * L_ + qi;
    const size_t tq = (size_t)b * L_ + qi;
    bf16x8 qf[4];
#pragma unroll
    for (int s = 0; s < 4; ++s) qf[s] = *(const bf16x8*)(PO + tq * OD_N + head * 64 + s * 16 + h2 * 8);
    f32x16 oacc[2];
#pragma unroll
    for (int c = 0; c < 2; ++c)
#pragma unroll
        for (int i = 0; i < 16; ++i) oacc[c][i] = 0.f;
    float mrun = -1e30f, lrun = 0.f;
    const int nkt = qb * 4 + 4, my_last = (i0 + 31) >> 6;
    const int srow = tid >> 3, sch = tid & 7;
    const bf16_t* ksrc = PO + ((size_t)b * L_ + srow) * OD_N + 512 + head * 64 + sch * 8;
    const bf16_t* vsrc = VT + (size_t)srow * L_ + sch * 8;
    u32x4 rk = *(const u32x4*)ksrc, rv = *(const u32x4*)vsrc;
    __syncthreads();
    *(u32x4*)(smem + srow * DA_ROW + sch * 16) = rk;
    *(u32x4*)(smem + DA_TILE + srow * DA_ROW + sch * 16) = rv;
    __syncthreads();
    unsigned long long mwn = BMT[0];
#pragma unroll 1
    for (int kt = 0; kt < nkt; ++kt) {
        const bool more = kt + 1 < nkt;
        if (more) { rk = *(const u32x4*)(ksrc + (size_t)(kt + 1) * 64 * OD_N); rv = *(const u32x4*)(vsrc + (kt + 1) * 64); }
        const unsigned long long mw64 = mwn;
        if (kt < my_last) mwn = BMT[(size_t)(kt + 1) * L_];
        if (kt <= my_last) {
            const char* kb = smem + (kt & 1) * 2 * DA_TILE; const char* vb = kb + DA_TILE;
#pragma unroll
            for (int sub = 0; sub < 2; ++sub) {
                const unsigned mw = sub == 0 ? (unsigned)mw64 : (unsigned)(mw64 >> 32);
                bf16x8 kf[4], vf[2][2];
#pragma unroll
                for (int s = 0; s < 4; ++s) kf[s] = *(const bf16x8*)(kb + (sub * 32 + pr) * DA_ROW + (s * 16 + h2 * 8) * 2);
#pragma unroll
                for (int db = 0; db < 2; ++db)
#pragma unroll
                    for (int s2 = 0; s2 < 2; ++s2) vf[db][s2] = *(const bf16x8*)(vb + (db * 32 + r) * DA_ROW + (sub * 32 + s2 * 16 + h2 * 8) * 2);
                f32x16 s;
#pragma unroll
                for (int i = 0; i < 16; ++i) s[i] = 0.f;
#pragma unroll
                for (int ks = 0; ks < 4; ++ks) s = __builtin_amdgcn_mfma_f32_32x32x16_bf16(kf[ks], qf[ks], s, 0, 0, 0);
                float mx = fmaxf(fmaxf(s[0], s[1]), fmaxf(s[2], s[3]));
#pragma unroll
                for (int i = 4; i < 16; i += 2) mx = fmaxf(mx, fmaxf(s[i], s[i + 1]));
                mx = fmaxf(mx, __shfl_xor(mx, 32, 64)) * SC;
                if (__builtin_amdgcn_ballot_w64(mx > mrun) != 0ull) {
                    const float mnew = fmaxf(mrun, mx);
                    const float corr = __builtin_amdgcn_exp2f(mrun - mnew);
                    mrun = mnew; lrun *= corr;
#pragma unroll
                    for (int db = 0; db < 2; ++db)
#pragma unroll
                        for (int i = 0; i < 16; ++i) oacc[db][i] *= corr;
                }
                float ps = 0.f;
                const int mws = (int)(mw >> (8 * h2));
#pragma unroll
                for (int i = 0; i < 16; ++i) {
                    const int ko = 16 * (i >> 3) + 4 * ((i >> 2) & 1) + (i & 3);
                    const float e = __builtin_amdgcn_exp2f(__builtin_fmaf(s[i], SC, -mrun));
                    s[i] = __uint_as_float(__float_as_uint(e) & (unsigned)__builtin_amdgcn_sbfe(mws, ko, 1));
                    ps += s[i];
                }
                lrun += ps;
#pragma unroll
                for (int s2 = 0; s2 < 2; ++s2) {
                    u32x4 pw; pw.x = pk2(s[8 * s2], s[8 * s2 + 1]); pw.y = pk2(s[8 * s2 + 2], s[8 * s2 + 3]); pw.z = pk2(s[8 * s2 + 4], s[8 * s2 + 5]); pw.w = pk2(s[8 * s2 + 6], s[8 * s2 + 7]);
                    const bf16x8 pf = __builtin_bit_cast(bf16x8, pw);
#pragma unroll
                    for (int db = 0; db < 2; ++db) oacc[db] = __builtin_amdgcn_mfma_f32_32x32x16_bf16(vf[db][s2], pf, oacc[db], 0, 0, 0);
                }
            }
        }
        if (more) {
            char* nbuf = smem + ((kt + 1) & 1) * 2 * DA_TILE;
            *(u32x4*)(nbuf + srow * DA_ROW + sch * 16) = rk;
            *(u32x4*)(nbuf + DA_TILE + srow * DA_ROW + sch * 16) = rv;
        }
        __syncthreads();
    }
    const float lt = lrun + __shfl_xor(lrun, 32, 64);
    const float inv = 1.f / lt;
    bf16_t* CC = (bf16_t*)(p.ws + OFF_CC);
#pragma unroll
    for (int db = 0; db < 2; ++db)
#pragma unroll
        for (int i = 0; i < 16; i += 4) {
            const int d = db * 32 + 8 * (i >> 2) + 4 * h2;
            u32x2 w; w.x = pk2(oacc[db][i] * inv, oacc[db][i + 1] * inv); w.y = pk2(oacc[db][i + 2] * inv, oacc[db][i + 3] * inv);
            *(u32x2*)(CC + tq * 1024 + head * 64 + d) = w;
        }
}

enum { K_PRO = 0, K_E1, K_E2, K_E3, K_E4, K_E5, K_E6, K_LN1, K_O1, K_O2, K_O3, K_O4, K_M1, K_M2, K_M3, K_M4, K_LN2, K_COUNT };

template <int KIND>
__device__ __forceinline__ void run_phase(PRef p, int layer, char* smem, int bid, int nb) {
    char* ws = p.ws;
    const int j = layer >> 1;
    if (KIND == K_PRO) {
        conv_phase(p, smem, bid, nb);
        __syncthreads();
        for (int u = nb - 1 - bid; u < 64; u += nb) s5mat_unit(p, u >> 5, u & 31, smem);
    } else if (KIND == K_E1) {
        gemm256_phase((const bf16_t*)(ws + OFF_XB), 1024, T_, (const bf16_t*)(ws + OFF_WT_EVIN) + (size_t)j * EV_N * 1024, 1024, EV_N, 1024, smem, bid, nb,
                   [&](f32x4 (&acc)[4][2], int row0, int c0, int fr, int fq) { epi_ev_in(p, acc, row0, c0, fr, fq); });
    } else if (KIND == K_E2) {
        for (int it = bid; it < 2048; it += nb) gla_a_item(p, j, it, smem);
        s5_g_phase(p, j, smem, bid, nb);
    } else if (KIND == K_E3) {
        scan_phase(p, j, bid);
    } else if (KIND == K_E4) {
        for (int it = bid; it < 2048; it += nb) gla_c_item(p, j, it, smem);
        s5_y_phase(p, j, smem, bid, nb);
    } else if (KIND == K_E5) {
        const bf16_t* YA = (const bf16_t*)(ws + OFF_YA); bf16_t* CC = (bf16_t*)(ws + OFF_CC); const float* bg = p.s5_b_glu + (size_t)j * 512;
        gemm256_phase(YA, 512, T_, (const bf16_t*)(ws + OFF_WT_GLU) + (size_t)j * 512 * 512, 512, 512, 512, smem, bid, nb,
                   [&](f32x4 (&acc)[4][2], int row0, int c0, int fr, int fq) {
                       const int col = c0 + 8 * fq;
                       const f32x4 g0 = *(const f32x4*)(bg + col), g1 = *(const f32x4*)(bg + col + 4);
#pragma unroll
                       for (int m = 0; m < 4; ++m) {
                           const size_t t = (size_t)(row0 + m * 16 + fr);
                           const u32x4 yw = *(const u32x4*)(YA + t * 512 + col);
                           float o[8];
#pragma unroll
                           for (int q = 0; q < 4; ++q) {
                               const unsigned y2 = q == 0 ? yw.x : q == 1 ? yw.y : q == 2 ? yw.z : yw.w;
                               const float y0 = __uint_as_float(y2 << 16), y1 = __uint_as_float(y2 & 0xffff0000u);
                               const float a0 = q < 2 ? acc[m][0][2 * q] + g0[2 * q] : acc[m][1][2 * q - 4] + g1[2 * q - 4];
                               const float a1 = q < 2 ? acc[m][0][2 * q + 1] + g0[2 * q + 1] : acc[m][1][2 * q - 3] + g1[2 * q - 3];
                               o[2 * q] = y0 * sigmoidf_(a0); o[2 * q + 1] = y1 * sigmoidf_(a1);
                           }
                           u32x4 w; w.x = pk2(o[0], o[1]); w.y = pk2(o[2], o[3]); w.z = pk2(o[4], o[5]); w.w = pk2(o[6], o[7]);
                           *(u32x4*)(CC + t * 1024 + 512 + col) = w;
                       }
                   });
    } else if (KIND == K_E6 || KIND == K_O4) {
        float* MIX = (float*)(ws + OFF_MIX);
        const bf16_t* W = (const bf16_t*)(ws + (KIND == K_E6 ? OFF_WT_EVOUT : OFF_WT_ODOUT)) + (size_t)j * 1024 * 1024;
        gemm256_phase((const bf16_t*)(ws + OFF_CC), 1024, T_, W, 1024, 1024, 1024, smem, bid, nb,
                   [&](f32x4 (&acc)[4][2], int row0, int c0, int fr, int fq) {
#pragma unroll
                       for (int m = 0; m < 4; ++m) {
                           float* o = MIX + (size_t)(row0 + m * 16 + fr) * 1024 + c0 + 8 * fq;
                           *(f32x4*)o = acc[m][0]; *(f32x4*)(o + 4) = acc[m][1];
                       }
                   });
    } else if (KIND == K_LN1) {
        const float* xin = layer == 0 ? p.x : (const float*)(ws + OFF_XR);
        ln_phase<false>(p, xin, (const float*)(ws + OFF_MIX), p.ln1_g + (size_t)layer * 1024, p.ln1_b + (size_t)layer * 1024, (float*)(ws + OFF_XR), (bf16_t*)(ws + OFF_XB), bid, nb);
    } else if (KIND == K_O1) {
        gemm256_phase((const bf16_t*)(ws + OFF_XB), 1024, T_, (const bf16_t*)(ws + OFF_WT_ODIN) + (size_t)j * OD_N * 1024, 1024, OD_N, 1024, smem, bid, nb,
                   [&](f32x4 (&acc)[4][2], int row0, int c0, int fr, int fq) { epi_od_in(p, acc, row0, c0, fr, fq); });
    } else if (KIND == K_O2) {
        for (int k = bid; k < 256; k += nb) {
            dsa_select_item(p, k & 1, k >> 1, smem);
            __syncthreads();
            const int k2 = 511 - k;
            dsa_select_item(p, k2 & 1, k2 >> 1, smem);
            __syncthreads();
        }
        const int head = otid() >> 6;
        for (int it = bid; it < 1536; it += nb) {
            const int b = it / 768, rem = it - b * 768, g = rem >> 8, u = rem & 255;
            const int sh = g * 2, per = 256 >> sh, rho = u / per, qblk = u - rho * per;
            const bf16_t* VT = (const bf16_t*)(ws + OFF_VTD) + ((size_t)((b * 3 + g) * 8 + head)) * 64 * L_;
#pragma unroll 1
            for (int hf = 0; hf < 2; ++hf) {
                const int hi = 2 * qblk + hf, lo = hi - 4;
                attn_wave<1, 1>(p, b, head, OD_DIL + g * 512, OD_DIL + 1536 + g * 512, VT, rho * (L_ >> sh), qblk * 64 + hf * 32, sh, rho, lo < 0 ? 0 : lo, hi, g);
            }
        }
    } else if (KIND == K_O3) {
        for (int k = bid; k < 512; k += nb) {
            const int bh = k >> 5, q0 = k & 31;
#pragma unroll 1
            for (int half = 0; half < 2; ++half) dsa_attn_item(p, bh >> 3, bh & 7, half == 0 ? q0 : 63 - q0, smem);
        }
        dil_combine_phase(p, bid, nb);
    } else if (KIND == K_M1) {
        float* LG = (float*)(ws + OFF_LOGIT); const float* rb = p.router_b + (size_t)layer * 32;
        gemm_phase((const bf16_t*)(ws + OFF_XB), 1024, T_, (const bf16_t*)(ws + OFF_WT_RT) + (size_t)layer * 128 * 1024, 1024, 128, 1024, smem, bid, nb,
                   [&](f32x4 (&acc)[4][2], int row0, int c0, int fr, int fq) {
#pragma unroll
                       for (int n = 0; n < 2; ++n) {
                           const int col = c0 + n * 16 + fr;
                           if (col < 32) {
#pragma unroll
                               for (int m = 0; m < 4; ++m)
#pragma unroll
                                   for (int r = 0; r < 4; ++r) LG[(size_t)(row0 + m * 16 + fq * 4 + r) * 32 + col] = acc[m][n][r] + rb[col];
                           }
                       }
                   });
    } else if (KIND == K_M2) {
        topk_phase(p, layer, bid, nb);
    } else if (KIND == K_M3) {
        moe_gemm_phase<1>(p, layer, smem, bid, nb);
    } else if (KIND == K_M4) {
        moe_gemm_phase<2>(p, layer, smem, bid, nb);
    } else if (KIND == K_LN2) {
        float* xo = layer == 3 ? p.out : (float*)(ws + OFF_XR);
        ln_phase<true>(p, (const float*)(ws + OFF_XR), (const float*)(ws + OFF_SLOT), p.ln2_g + (size_t)layer * 1024, p.ln2_b + (size_t)layer * 1024, xo,
                       layer == 3 ? (bf16_t*)nullptr : (bf16_t*)(ws + OFF_XB), bid, nb);
    }
}

extern __shared__ __attribute__((aligned(16))) char dyn_smem[];

#if !MEGA
template <int KIND>
__global__ void __launch_bounds__(NTHR, 2) k_phase(Params p, int layer) { run_phase<KIND>(p, layer, dyn_smem, blockIdx.x, gridDim.x); }
#else
#ifndef DUPMASK
#define DUPMASK 0
#endif
typedef const __attribute__((address_space(4))) Params* KParams;
#define RUNP(K) do { KParams _q = kp0; asm volatile("" : "+s"(_q)); run_phase<K>(*_q, layer, smem, bid, nb); } while (0)
#define PHASE(K) do { RUNP(K); xcd_barrier(bar); if ((DUPMASK >> K) & 1) { RUNP(K); xcd_barrier(bar); } } while (0)
template <int LAYER>
__device__ __forceinline__ void mega_layer(KParams kp0, char* smem, int bid, int nb, const XcdBarrier& bar) {
    constexpr int layer = LAYER;
    if ((layer & 1) == 0) { PHASE(K_E1); PHASE(K_E2); PHASE(K_E3); PHASE(K_E4); PHASE(K_E5); PHASE(K_E6); }
    else { PHASE(K_O1); PHASE(K_O2); PHASE(K_O3); PHASE(K_O4); }
    PHASE(K_LN1); PHASE(K_M1); PHASE(K_M2); PHASE(K_M3); PHASE(K_M4);
    RUNP(K_LN2);
    if (layer < 3) xcd_barrier(bar);
}
__global__ void __launch_bounds__(NTHR, 2) k_mega(Params p) {
    char* smem = dyn_smem;
    const int bid = blockIdx.x, nb = gridDim.x;
    volatile LAS unsigned* st = (volatile LAS unsigned*)(dyn_smem + LDS_BYTES - 16);
    if (otid() == 0) { st[0] = 0u; st[1] = 0u; }
    __syncthreads();
    KParams kp0 = (KParams)__builtin_amdgcn_kernarg_segment_ptr();
    XcdBarrier bar = xcd_barrier_post((unsigned*)(kp0->ws + OFF_BAR), st);
    { const int layer = 0; PHASE(K_PRO); }
    mega_layer<0>(kp0, smem, bid, nb, bar);
    mega_layer<1>(kp0, smem, bid, nb, bar);
    mega_layer<2>(kp0, smem, bid, nb, bar);
    mega_layer<3>(kp0, smem, bid, nb, bar);
}
#endif

extern "C" void kernel_launch(void* const* d_in, const int* in_sizes, int n_in, void* d_out, int out_size, void* d_ws, size_t ws_size, hipStream_t stream) {
    Params p{};
    const float** f = (const float**)&p;
    for (int i = 0; i < 28; ++i) f[i] = (const float*)d_in[i];
    p.out = (float*)d_out; p.ws = (char*)d_ws;
    if (ws_size < WS_NEED) { fprintf(stderr, "workspace too small: %zu < %zu\n", ws_size, (size_t)WS_NEED); return; }
#if !MEGA
#define SETATTR(K) hipFuncSetAttribute((const void*)k_phase<K>, hipFuncAttributeMaxDynamicSharedMemorySize, LDS_BYTES)
#define LAUNCH(K, layer) k_phase<K><<<256, NTHR, LDS_BYTES, stream>>>(p, layer)
    static bool attr_done = false;
    if (!attr_done) {
        SETATTR(K_PRO); SETATTR(K_E1); SETATTR(K_E2); SETATTR(K_E3); SETATTR(K_E4); SETATTR(K_E5); SETATTR(K_E6); SETATTR(K_LN1); SETATTR(K_O1); SETATTR(K_O2); SETATTR(K_O3);
        SETATTR(K_O4); SETATTR(K_M1); SETATTR(K_M2); SETATTR(K_M3); SETATTR(K_M4); SETATTR(K_LN2);
        attr_done = true;
    }
    LAUNCH(K_PRO, 0);
    for (int layer = 0; layer < 4; ++layer) {
        if ((layer & 1) == 0) { LAUNCH(K_E1, layer); LAUNCH(K_E2, layer); LAUNCH(K_E3, layer); LAUNCH(K_E4, layer); LAUNCH(K_E5, layer); LAUNCH(K_E6, layer); }
        else { LAUNCH(K_O1, layer); LAUNCH(K_O2, layer); LAUNCH(K_O3, layer); LAUNCH(K_O4, layer); }
        LAUNCH(K_LN1, layer); LAUNCH(K_M1, layer); LAUNCH(K_M2, layer); LAUNCH(K_M3, layer); LAUNCH(K_M4, layer); LAUNCH(K_LN2, layer);
    }
#else
    static int grid = 0;
    if (!grid) {
        hipFuncSetAttribute((const void*)k_mega, hipFuncAttributeMaxDynamicSharedMemorySize, LDS_BYTES);
        int dev = 0, cus = 0, per_cu = 0;
        hipGetDevice(&dev);
        hipDeviceGetAttribute(&cus, hipDeviceAttributeMultiprocessorCount, dev);
        hipOccupancyMaxActiveBlocksPerMultiprocessor(&per_cu, (const void*)k_mega, NTHR, LDS_BYTES);
        grid = cus * (per_cu < 1 ? per_cu : 1);
        if (grid <= 0) grid = 0;
    }
    if (!grid) { fprintf(stderr, "occupancy query says 0 blocks per CU\n"); return; }
    hipMemsetAsync((char*)d_ws + OFF_BAR, 0, XCD_BAR_WORDS * sizeof(unsigned), stream);
    k_mega<<<grid, NTHR, LDS_BYTES, stream>>>(p);
#endif
}
```

```cpp
#include <hip/hip_runtime.h>
#include <stdint.h>
#include <stdio.h>

#ifndef MEGA
#define MEGA 1
#define DUPMASK 0
#define DUPNOEPI 0
#endif

typedef unsigned short bf16_t;
typedef short bf16x8 __attribute__((ext_vector_type(8)));
typedef float f32x4 __attribute__((ext_vector_type(4)));
typedef float f32x16 __attribute__((ext_vector_type(16)));
typedef unsigned u32x4 __attribute__((ext_vector_type(4)));
typedef unsigned u32x2 __attribute__((ext_vector_type(2)));

constexpr int T_ = 32768, D_ = 1024, L_ = 16384, NB_ = 2;
constexpr int NTHR = 512;
constexpr float ALPHA = 1.681792830507429f;
constexpr float LN_EPS = 1e-5f;
constexpr int EV_N = 2304;
constexpr int OD_N = 6656;
constexpr int OD_QI = 1536, OD_DIL = 1792, OD_KI = 6400, OD_WI = 6464;
constexpr int UHW = 1152;
constexpr int LISTCAP = 131072;

constexpr size_t OFF_BAR = 0;
constexpr size_t OFF_CNT = 16384;
constexpr size_t OFF_A64 = 32768;
constexpr size_t OFF_WT_EVIN = 131072;
constexpr size_t OFF_WT_ODIN = OFF_WT_EVIN + (size_t)2 * EV_N * 1024 * 2;
constexpr size_t OFF_WT_EVOUT = OFF_WT_ODIN + (size_t)2 * OD_N * 1024 * 2;
constexpr size_t OFF_WT_ODOUT = OFF_WT_EVOUT + (size_t)2 * 1024 * 1024 * 2;
constexpr size_t OFF_WT_GLU = OFF_WT_ODOUT + (size_t)2 * 1024 * 1024 * 2;
constexpr size_t OFF_WT_RT = OFF_WT_GLU + (size_t)2 * 512 * 512 * 2;
constexpr size_t OFF_WT_W1 = OFF_WT_RT + (size_t)4 * 128 * 1024 * 2;
constexpr size_t OFF_WT_W2 = OFF_WT_W1 + (size_t)4 * 32 * 2048 * 1024 * 2;
constexpr size_t OFF_TH = OFF_WT_W2 + (size_t)4 * 32 * 1024 * 1024 * 2;
constexpr size_t OFF_GM = OFF_TH + (size_t)2 * 32 * 1024 * UHW * 2;
constexpr size_t OFF_XR = OFF_GM + (size_t)2 * 32 * 128 * 1024 * 2;
constexpr size_t OFF_XB = OFF_XR + (size_t)T_ * 1024 * 4;
constexpr size_t OFF_MIX = OFF_XB + (size_t)T_ * 1024 * 2;
constexpr size_t OFF_CC = OFF_MIX + (size_t)T_ * 1024 * 4;
constexpr size_t OFF_LOGIT = OFF_CC + (size_t)T_ * 1024 * 2;
constexpr size_t OFF_LIST = OFF_LOGIT + (size_t)T_ * 32 * 4;
constexpr size_t OFF_GATE = OFF_LIST + (size_t)32 * LISTCAP * 4;
constexpr size_t OFF_ACT = OFF_GATE + (size_t)T_ * 4 * 4;
constexpr size_t OFF_SLOT = OFF_ACT + (size_t)T_ * 4 * 1024 * 2;
constexpr size_t OFF_MIXER = OFF_SLOT + (size_t)T_ * 4 * 1024 * 4;
constexpr size_t OFF_PE = OFF_MIXER;
constexpr size_t OFF_UH = OFF_PE + (size_t)T_ * 1536 * 2;
constexpr size_t OFF_GLR = OFF_UH + (size_t)(T_ / 64) * 32 * UHW * 2;
constexpr size_t OFF_VTE = OFF_GLR + (size_t)T_ * 16 * 4;
constexpr size_t OFF_KV = OFF_VTE + (size_t)2 * 4 * 128 * L_ * 2;
constexpr size_t OFF_SST = OFF_KV + (size_t)2 * 256 * 4 * 64 * 128 * 4;
constexpr size_t OFF_DEC = OFF_SST + (size_t)2 * 256 * 4 * 64 * 128 * 4;
constexpr size_t OFF_GBUF = OFF_DEC + (size_t)2 * 256 * 4 * 64 * 4;
constexpr size_t OFF_YA = OFF_GBUF + (size_t)512 * 32 * 128 * 4;
constexpr size_t END_EVEN = OFF_YA + (size_t)T_ * 512 * 2;
constexpr size_t OFF_PO = OFF_MIXER;
constexpr size_t OFF_WI = OFF_PO + (size_t)T_ * OD_N * 2;
constexpr size_t OFF_VTC = OFF_WI + (size_t)T_ * 4 * 4;
constexpr size_t OFF_VTD = OFF_VTC + (size_t)2 * 8 * 64 * L_ * 2;
constexpr size_t OFF_BM = OFF_VTD + (size_t)2 * 3 * 8 * 64 * L_ * 2;
constexpr size_t OFF_OD = OFF_BM + (size_t)T_ * 256 * 8;
constexpr size_t OFF_LSE = OFF_OD + (size_t)3 * T_ * 512 * 4;
constexpr size_t END_ODD = OFF_LSE + (size_t)3 * T_ * 8 * 4;
constexpr size_t WS_NEED = END_ODD > END_EVEN ? END_ODD : END_EVEN;
static_assert(WS_NEED < (size_t)4200000000ull, "workspace too large");

constexpr int LDS_BYTES = 153600;

struct Params {
    const float *x, *ev_w_in, *gla_w_gate2, *gla_b_gate2, *gla_norm_g, *s5_a_re, *s5_a_im, *s5_log_dt, *s5_b_re, *s5_b_im, *s5_c_re, *s5_c_im, *s5_d,
        *s5_w_glu, *s5_b_glu, *ev_w_out, *od_w_in, *od_w_out, *ln1_g, *ln1_b, *ln2_g, *ln2_b, *router_w, *router_b, *moe_w1, *moe_b1, *moe_w2, *moe_b2;
    float* out;
    char* ws;
};

#if MEGA
typedef const __attribute__((address_space(4))) Params& PRef;
#else
typedef const Params& PRef;
#endif

__device__ __forceinline__ unsigned pk2(float lo, float hi) { unsigned r; asm("v_cvt_pk_bf16_f32 %0, %1, %2" : "=v"(r) : "v"(lo), "v"(hi)); return r; }
__device__ __forceinline__ bf16_t f2bf(float f) { return (bf16_t)(pk2(f, 0.f) & 0xffffu); }
__device__ __forceinline__ float bf2f(bf16_t h) { return __uint_as_float(((unsigned)h) << 16); }
__device__ __forceinline__ float sigmoidf_(float x) { return 1.f / (1.f + __expf(-x)); }
__device__ __forceinline__ float wave_sum(float v) {
#pragma unroll
    for (int m = 32; m >= 1; m >>= 1) v += __shfl_xor(v, m, 64);
    return v;
}
__device__ __forceinline__ float gelu_tanh(float x) {
    const float k0 = 0.7978845608028654f, k1 = 0.044715f;
    float u = k0 * (x + k1 * x * x * x);
    float t = 1.f - 2.f / (1.f + __expf(2.f * u));
    return 0.5f * x * (1.f + t);
}
__device__ __forceinline__ int otid() { int t = threadIdx.x; asm volatile("" : "+v"(t)); return t; }

#define XB_TMO      128
#define XB_XCNT(j)  (256  + 64 * (j))
#define XB_XSUB(j)  (1280 + 64 * (j))
#define XB_XGEN(j)  (2304 + 64 * (j))
#define XB_TOP      3328
#define XB_TOPGEN   3392
#define XCD_BAR_WORDS 3456
#define XB_SPIN_CAP (1u << 21)
#define LAS __attribute__((address_space(3)))

__device__ __forceinline__ unsigned xb_ld(unsigned* p)              { return __hip_atomic_load(p, __ATOMIC_RELAXED, __HIP_MEMORY_SCOPE_AGENT); }
__device__ __forceinline__ unsigned xb_add(unsigned* p, unsigned v) { return __hip_atomic_fetch_add(p, v, __ATOMIC_RELAXED, __HIP_MEMORY_SCOPE_AGENT); }
__device__ __forceinline__ unsigned xb_xcc_id() { return (unsigned)__builtin_amdgcn_s_getreg((3 << 11) | 20) & 0xFu; }
#define XB_SPIN(cond, bar) do { unsigned _sp = 0; while (cond) { __builtin_amdgcn_s_sleep(1); \
    if ((++_sp & 255u) == 0u) { if (xb_ld(&(bar)[XB_TMO])) break; if (_sp > XB_SPIN_CAP) { atomicAdd(&(bar)[XB_TMO], 1u); break; } } } } while (0)

struct XcdBarrier { unsigned* bar; unsigned x; volatile LAS unsigned* st; };

__device__ __forceinline__ XcdBarrier xcd_barrier_post(unsigned* bar, volatile LAS unsigned* st) {
    XcdBarrier b; b.bar = bar; b.x = xb_xcc_id(); b.st = st;
    if (threadIdx.x == 0) (void)xb_add(&bar[XB_XCNT(b.x)], 1u);
    return b;
}
__device__ __forceinline__ void xcd_barrier_complete(unsigned* bar, unsigned x, unsigned& nloc, unsigned& nx) {
    const unsigned G = gridDim.x * gridDim.y * gridDim.z;
    unsigned sum, cnt, mine, sp = 0u;
    for (;;) {
        sum = 0u; cnt = 0u; mine = 0u;
#pragma unroll
        for (unsigned j = 0; j < 16; ++j) { const unsigned c = xb_ld(&bar[XB_XCNT(j)]); sum += c; cnt += (c > 0u) ? 1u : 0u; mine = (j == x) ? c : mine; }
        if (sum == G) break;
        __builtin_amdgcn_s_sleep(1);
        if ((++sp & 255u) == 0u) { if (xb_ld(&bar[XB_TMO])) break; if (sp > XB_SPIN_CAP) { atomicAdd(&bar[XB_TMO], 1u); break; } }
    }
    nloc = mine > 0u ? mine : 1u; nx = cnt > 0u ? cnt : 1u;
}
__device__ __forceinline__ void xcd_barrier(const XcdBarrier& b) {
    asm volatile("s_waitcnt vmcnt(0)" ::: "memory");
    __syncthreads();
    if (threadIdx.x == 0) {
        unsigned* bar = b.bar;
        __builtin_amdgcn_s_waitcnt(0);
        unsigned nloc = b.st[0], nx = b.st[1];
        if (nloc == 0u) { xcd_barrier_complete(bar, b.x, nloc, nx); b.st[0] = nloc; b.st[1] = nx; }
        const unsigned old = xb_add(&bar[XB_XSUB(b.x)], 1u);
        const unsigned gen = old / nloc;
        if (old + 1u == (gen + 1u) * nloc) {
            __builtin_amdgcn_fence(__ATOMIC_RELEASE, "agent");
            asm volatile("s_waitcnt vmcnt(0)" ::: "memory");
            const unsigned og = xb_add(&bar[XB_TOP], 1u);
            const unsigned tg = og / nx;
            if (og + 1u == (tg + 1u) * nx) xb_add(&bar[XB_TOPGEN], 1u);
            else XB_SPIN(xb_ld(&bar[XB_TOPGEN]) == tg, bar);
            __builtin_amdgcn_fence(__ATOMIC_ACQUIRE, "agent");
            xb_add(&bar[XB_XGEN(b.x)], 1u);
            asm volatile("s_waitcnt vmcnt(0)" ::: "memory");
        } else {
            XB_SPIN(xb_ld(&bar[XB_XGEN(b.x)]) == gen, bar);
            __builtin_amdgcn_fence(__ATOMIC_ACQUIRE, "agent");
            asm volatile("s_waitcnt vmcnt(0)" ::: "memory");
        }
    }
    __syncthreads();
}

constexpr int G_LROW = 144;
constexpr int G_ASZ = 256 * G_LROW;
constexpr int G_BSZ = 128 * G_LROW;
constexpr int G_STAGE = G_ASZ + G_BSZ;
constexpr int G_ROWS_OFF = 2 * G_STAGE;

template <bool GATHER, class Epi>
__device__ __forceinline__ void gemm_tile(const bf16_t* __restrict__ A, long lda, int shift, int m0, const bf16_t* __restrict__ Bt, long ldb, int n0, int K,
                                          char* smem, Epi&& epi) {
    const int tid = otid(), lane = tid & 63, wave = tid >> 6, wr = wave >> 1, wc = wave & 1, fr = lane & 15, fq = lane >> 4;
    const int lrow = tid >> 3, lchunk = tid & 7;
    const int* sRow = (const int*)(smem + G_ROWS_OFF);
    const bf16_t* pa[4]; const bf16_t* pb[2];
#pragma unroll
    for (int i = 0; i < 4; ++i) {
        int r = lrow + 64 * i; long arow;
        if (GATHER) { int v = sRow[r]; arow = v < 0 ? 0 : (v >> shift); } else arow = m0 + r;
        pa[i] = A + arow * lda + lchunk * 8;
    }
#pragma unroll
    for (int i = 0; i < 2; ++i) pb[i] = Bt + (long)(n0 + lrow + 64 * i) * ldb + lchunk * 8;
    f32x4 acc[4][4];
#pragma unroll
    for (int m = 0; m < 4; ++m)
#pragma unroll
        for (int n = 0; n < 4; ++n) acc[m][n] = (f32x4){0.f, 0.f, 0.f, 0.f};
    u32x4 ra[4], rb[2];
    const int nk = K >> 6;
#pragma unroll
    for (int i = 0; i < 4; ++i) ra[i] = *(const u32x4*)(pa[i]);
#pragma unroll
    for (int i = 0; i < 2; ++i) rb[i] = *(const u32x4*)(pb[i]);
    {
        char* sa = smem; char* sb = smem + G_ASZ;
#pragma unroll
        for (int i = 0; i < 4; ++i) *(u32x4*)(sa + (lrow + 64 * i) * G_LROW + lchunk * 16) = ra[i];
#pragma unroll
        for (int i = 0; i < 2; ++i) *(u32x4*)(sb + (lrow + 64 * i) * G_LROW + lchunk * 16) = rb[i];
    }
    __syncthreads();
    for (int kt = 0; kt < nk; ++kt) {
        const bool more = (kt + 1 < nk);
        if (more) {
#pragma unroll
            for (int i = 0; i < 4; ++i) ra[i] = *(const u32x4*)(pa[i] + (kt + 1) * 64);
#pragma unroll
            for (int i = 0; i < 2; ++i) rb[i] = *(const u32x4*)(pb[i] + (kt + 1) * 64);
        }
        const char* sa = smem + (kt & 1) * G_STAGE; const char* sb = sa + G_ASZ;
#pragma unroll
        for (int ks = 0; ks < 2; ++ks) {
            bf16x8 af[4], bfr[4];
#pragma unroll
            for (int m = 0; m < 4; ++m) af[m] = *(const bf16x8*)(sa + (wr * 64 + m * 16 + fr) * G_LROW + (ks * 32 + fq * 8) * 2);
#pragma unroll
            for (int n = 0; n < 4; ++n) bfr[n] = *(const bf16x8*)(sb + (wc * 64 + n * 16 + fr) * G_LROW + (ks * 32 + fq * 8) * 2);
#pragma unroll
            for (int m = 0; m < 4; ++m)
#pragma unroll
                for (int n = 0; n < 4; ++n) acc[m][n] = __builtin_amdgcn_mfma_f32_16x16x32_bf16(af[m], bfr[n], acc[m][n], 0, 0, 0);
        }
        if (more) {
            char* wa = smem + ((kt + 1) & 1) * G_STAGE; char* wb = wa + G_ASZ;
#pragma unroll
            for (int i = 0; i < 4; ++i) *(u32x4*)(wa + (lrow + 64 * i) * G_LROW + lchunk * 16) = ra[i];
#pragma unroll
            for (int i = 0; i < 2; ++i) *(u32x4*)(wb + (lrow + 64 * i) * G_LROW + lchunk * 16) = rb[i];
        }
        __syncthreads();
    }
    {
        f32x4 h0[4][2], h1[4][2];
#pragma unroll
        for (int m = 0; m < 4; ++m) { h0[m][0] = acc[m][0]; h0[m][1] = acc[m][1]; h1[m][0] = acc[m][2]; h1[m][1] = acc[m][3]; }
        epi(h0, wr * 64, n0 + wc * 64, fr, fq);
        epi(h1, wr * 64, n0 + wc * 64 + 32, fr, fq);
    }
}

template <class Epi>
__device__ __forceinline__ void gemm_phase(const bf16_t* A, long lda, int M, const bf16_t* Bt, long ldb, int N, int K, char* smem, int bid, int nb, Epi&& epi) {
    const int ntn = N / 128, ntm = M / 256, nt = ntn * ntm;
    for (int t = bid; t < nt; t += nb) {
        const int mi = t / ntn, ni = t - mi * ntn;
        gemm_tile<false>(A, lda, 0, mi * 256, Bt, ldb, ni * 128, K, smem,
                         [&](f32x4 (&acc)[4][2], int rt0, int c0, int fr, int fq) { epi(acc, mi * 256 + rt0, c0, fr, fq); });
    }
}

constexpr int G8_HT = 128 * 64 * 2;
constexpr int G8_ROWS_OFF = 8 * G8_HT;

__device__ __forceinline__ int g8_lds_byte(int r, int c) {
    const int st = (r >> 4) * 2 + (c >> 5), rr = r & 15, cc = c & 31, ob = rr * 64 + cc * 2;
    return st * 1024 + (ob ^ (((ob >> 9) & 1) << 5));
}
__device__ __forceinline__ void g8_stage_rc(int b, int& R, int& C) {
    const int st = b / 1024, sb = b % 1024, swz = sb ^ (((sb >> 9) & 1) << 5);
    R = (st >> 1) * 16 + swz / 64; C = (st & 1) * 32 + (swz % 64) / 2;
}

#define G8_SA(b, h) (lds + ((b) * 2 + (h)) * G8_HT)
#define G8_SB(b, h) (lds + (4 + (b) * 2 + (h)) * G8_HT)
#define G8_STAGE(P, RS, OFF, soff) do { \
    _Pragma("unroll") for (int _i = 0; _i < 2; ++_i) \
        __builtin_amdgcn_raw_ptr_buffer_load_lds((RS), (LAS unsigned*)((P) + tid * 16 + _i * 8192), 16, (OFF)[_i], (soff), 0, 0); } while (0)
#define G8_LDA(dst, b, h) do { _Pragma("unroll") for (int m = 0; m < 4; ++m) _Pragma("unroll") for (int k = 0; k < 2; ++k) \
    dst[m][k] = *(const LAS bf16x8*)(G8_SA(b, h) + g8_lds_byte(wr * 64 + m * 16 + fr, k * 32 + fq * 8)); } while (0)
#define G8_LDB(dst, b, h) do { _Pragma("unroll") for (int n = 0; n < 2; ++n) _Pragma("unroll") for (int k = 0; k < 2; ++k) \
    dst[n][k] = *(const LAS bf16x8*)(G8_SB(b, h) + g8_lds_byte(wc * 32 + n * 16 + fr, k * 32 + fq * 8)); } while (0)
#define G8_MMA(ai, bj, At, Bt_) do { __builtin_amdgcn_s_setprio(1); \
    _Pragma("unroll") for (int m = 0; m < 4; ++m) _Pragma("unroll") for (int n = 0; n < 2; ++n) _Pragma("unroll") for (int k = 0; k < 2; ++k) \
        acc[ai][bj][m][n] = __builtin_amdgcn_mfma_f32_16x16x32_bf16(Bt_[n][k], At[m][k], acc[ai][bj][m][n], 0, 0, 0); \
    __builtin_amdgcn_s_setprio(0); } while (0)
#define G8_WAIT_V(n) asm volatile("s_waitcnt vmcnt(" #n ")" ::: "memory")
#define G8_WAIT_L(n) asm volatile("s_waitcnt lgkmcnt(" #n ")" ::: "memory")
#define G8_BAR __builtin_amdgcn_s_barrier()
#define G8_SCHED __builtin_amdgcn_sched_barrier(0)

template <bool GATHER, class Epi>
__device__ __forceinline__ void gemm256_tile(const bf16_t* __restrict__ A, long lda, int shift, int m0, const bf16_t* __restrict__ Bt, long ldb, int n0, int K,
                                             char* smem, Epi&& epi) {
    LAS char* lds = (LAS char*)smem;
    int tid = otid();
    int wid = tid >> 6, lane = tid & 63, wr = wid >> 2, wc = wid & 3, fr = lane & 15, fq = lane >> 4;
    unsigned aoff[2][2], boff[2];
    {
        const LAS int* sRow = (const LAS int*)(lds + G8_ROWS_OFF);
#pragma unroll
        for (int i = 0; i < 2; ++i) {
            int R, C; g8_stage_rc(tid * 16 + i * 8192, R, C);
            { const int rho = R & 31, nn = rho >> 4, ii = rho & 15; const int Rp = (R & ~31) + 8 * (ii >> 2) + 4 * nn + (ii & 3);
              boff[i] = (unsigned)((long)Rp * ldb + C) * 2u; }
#pragma unroll
            for (int h = 0; h < 2; ++h) {
                long arow;
                if (GATHER) { const int v = sRow[h * 128 + R]; arow = v < 0 ? 0 : (v >> shift); } else arow = m0 + h * 128 + R;
                aoff[h][i] = (unsigned)(arow * lda + C) * 2u;
            }
        }
    }
    f32x4 acc[2][2][4][2];
#pragma unroll
    for (int a = 0; a < 2; ++a)
#pragma unroll
        for (int b = 0; b < 2; ++b)
#pragma unroll
            for (int m = 0; m < 4; ++m)
#pragma unroll
                for (int n = 0; n < 2; ++n) acc[a][b][m][n] = (f32x4){0.f, 0.f, 0.f, 0.f};
    bf16x8 At[4][2], B0[2][2], B1[2][2];
    const int nt = K / 64;
    const __amdgpu_buffer_rsrc_t rA = __builtin_amdgcn_make_buffer_rsrc((void*)A, 0, 0x7fffffff, 0x00020000);
    const __amdgpu_buffer_rsrc_t rB = __builtin_amdgcn_make_buffer_rsrc((void*)(Bt + (size_t)n0 * ldb), 0, 0x7fffffff, 0x00020000);
    const int bh = (int)(128 * ldb * 2);
    G8_STAGE(G8_SB(0, 0), rB, boff, 0); G8_STAGE(G8_SA(0, 0), rA, aoff[0], 0);
    G8_STAGE(G8_SB(0, 1), rB, boff, bh); G8_STAGE(G8_SA(0, 1), rA, aoff[1], 0);
    if (wr == 1) G8_BAR;
    G8_WAIT_V(4); G8_BAR;
    G8_STAGE(G8_SB(1, 0), rB, boff, 128); G8_STAGE(G8_SA(1, 0), rA, aoff[0], 128); G8_STAGE(G8_SB(1, 1), rB, boff, 128 + bh);
    G8_WAIT_V(6); G8_BAR;
    for (int t = 0; t < nt - 2; t += 2) {
        G8_LDB(B0, 0, 0); G8_SCHED; G8_LDA(At, 0, 0); G8_STAGE(G8_SA(1, 1), rA, aoff[1], (t + 1) * 128);
        G8_WAIT_L(8); G8_BAR; G8_WAIT_L(0); G8_MMA(0, 0, At, B0); G8_BAR; G8_SCHED;
        G8_LDB(B1, 0, 1); G8_STAGE(G8_SB(0, 0), rB, boff, (t + 2) * 128);
        G8_BAR; G8_WAIT_L(0); G8_MMA(0, 1, At, B1); G8_BAR;
        G8_LDA(At, 0, 1); G8_STAGE(G8_SA(0, 0), rA, aoff[0], (t + 2) * 128);
        G8_BAR; G8_WAIT_L(0); G8_MMA(1, 0, At, B0); G8_BAR; G8_SCHED;
        G8_STAGE(G8_SB(0, 1), rB, boff, (t + 2) * 128 + bh);
        G8_WAIT_V(6); G8_BAR; G8_MMA(1, 1, At, B1); G8_BAR;
        G8_LDB(B0, 1, 0); G8_SCHED; G8_LDA(At, 1, 0); G8_STAGE(G8_SA(0, 1), rA, aoff[1], (t + 2) * 128);
        G8_WAIT_L(8); G8_BAR; G8_WAIT_L(0); G8_MMA(0, 0, At, B0); G8_BAR; G8_SCHED;
        G8_LDB(B1, 1, 1); G8_STAGE(G8_SB(1, 0), rB, boff, (t + 3) * 128);
        G8_BAR; G8_WAIT_L(0); G8_MMA(0, 1, At, B1); G8_BAR;
        G8_LDA(At, 1, 1); G8_STAGE(G8_SA(1, 0), rA, aoff[0], (t + 3) * 128);
        G8_BAR; G8_WAIT_L(0); G8_MMA(1, 0, At, B0); G8_BAR; G8_SCHED;
        G8_STAGE(G8_SB(1, 1), rB, boff, (t + 3) * 128 + bh);
        G8_WAIT_V(6); G8_BAR; G8_MMA(1, 1, At, B1); G8_BAR;
    }
    { G8_LDB(B0, 0, 0); G8_WAIT_V(0); G8_LDA(At, 0, 0); G8_STAGE(G8_SA(1, 1), rA, aoff[1], (nt - 1) * 128);
      G8_BAR; G8_WAIT_L(0); G8_MMA(0, 0, At, B0); G8_BAR;
      G8_LDB(B1, 0, 1); G8_BAR; G8_WAIT_L(0); G8_MMA(0, 1, At, B1); G8_BAR;
      G8_LDA(At, 0, 1); G8_WAIT_V(4); G8_BAR; G8_WAIT_L(0); G8_MMA(1, 0, At, B0); G8_MMA(1, 1, At, B1); G8_BAR; }
    { G8_LDB(B0, 1, 0); G8_LDA(At, 1, 0); G8_WAIT_V(2); G8_BAR; G8_WAIT_L(0); G8_MMA(0, 0, At, B0); G8_BAR;
      G8_LDB(B1, 1, 1); G8_WAIT_V(0); G8_BAR; G8_WAIT_L(0); G8_MMA(0, 1, At, B1); G8_BAR;
      G8_LDA(At, 1, 1); G8_BAR; G8_WAIT_L(0); G8_MMA(1, 0, At, B0); G8_MMA(1, 1, At, B1); G8_BAR; }
    if (wr == 0) G8_BAR;
    int tz = otid(); wid = tz >> 6; lane = tz & 63; wr = wid >> 2; wc = wid & 3; fr = lane & 15; fq = lane >> 4;
#pragma unroll
    for (int ai = 0; ai < 2; ++ai)
#pragma unroll
        for (int bj = 0; bj < 2; ++bj) epi(acc[ai][bj], ai * 128 + wr * 64, n0 + bj * 128 + wc * 32, fr, fq);
}

struct G8Desc { const bf16_t* A; const bf16_t* Bt; const int* list; int m0, n0, count, u0; };

template <bool GATHER, int SHIFT, class Src, class Epi>
__device__ __forceinline__ void gemm256_stream(Src&& src, const int lda, const int ldb, const int K, char* smem, Epi&& epi) {
    LAS char* lds = (LAS char*)smem;
    int tid = otid();
    int wid = tid >> 6, lane = tid & 63, wr = wid >> 2, wc = wid & 3, fr = lane & 15, fq = lane >> 4;
    G8Desc nxt;
    if (!src(0, nxt)) return;
    int cm0 = nxt.m0, cn0 = nxt.n0, cu0 = nxt.u0;
    int* sRowG = (int*)(smem + G8_ROWS_OFF);
    __syncthreads();
    if (GATHER) { if (tid < 256) sRowG[tid] = tid < nxt.count ? nxt.list[tid] : -1; __syncthreads(); }
    unsigned aoff[2][2], boff[2];
    __amdgpu_buffer_rsrc_t rA, rB;
    const int bh = 128 * ldb * 2;
#define G8_PREP(D, SLOT) do { \
        const LAS int* _sr = (const LAS int*)(lds + G8_ROWS_OFF) + (SLOT) * 256; \
        _Pragma("unroll") for (int i = 0; i < 2; ++i) { \
            int R, C; g8_stage_rc(tid * 16 + i * 8192, R, C); \
            { const int rho = R & 31, nn = rho >> 4, ii = rho & 15; const int Rp = (R & ~31) + 8 * (ii >> 2) + 4 * nn + (ii & 3); boff[i] = (unsigned)(Rp * ldb + C) * 2u; } \
            _Pragma("unroll") for (int h = 0; h < 2; ++h) { \
                int arow; \
                if (GATHER) { const int v = _sr[h * 128 + R]; arow = v < 0 ? 0 : (v >> SHIFT); } else arow = (D).m0 + h * 128 + R; \
                aoff[h][i] = (unsigned)(arow * lda + C) * 2u; } } \
        rA = __builtin_amdgcn_make_buffer_rsrc((void*)(D).A, 0, 0x7fffffff, 0x00020000); \
        rB = __builtin_amdgcn_make_buffer_rsrc((void*)((D).Bt + (size_t)(D).n0 * ldb), 0, 0x7fffffff, 0x00020000); } while (0)
#define G8_PRO1() do { G8_STAGE(G8_SB(0, 0), rB, boff, 0); G8_STAGE(G8_SA(0, 0), rA, aoff[0], 0); G8_STAGE(G8_SB(0, 1), rB, boff, bh); G8_STAGE(G8_SA(0, 1), rA, aoff[1], 0); } while (0)
    G8_PREP(nxt, 0);
    G8_PRO1();
    f32x4 acc[2][2][4][2];
    const int nt = K / 64;
    for (int it = 0;; ++it) {
#pragma unroll
        for (int a = 0; a < 2; ++a)
#pragma unroll
            for (int b = 0; b < 2; ++b)
#pragma unroll
                for (int m = 0; m < 4; ++m)
#pragma unroll
                    for (int n = 0; n < 2; ++n) acc[a][b][m][n] = (f32x4){0.f, 0.f, 0.f, 0.f};
        const bool has_next = src(it + 1, nxt);
        if (GATHER && has_next && tid < 256) sRowG[((it + 1) % 3) * 256 + tid] = tid < nxt.count ? nxt.list[tid] : -1;
        bf16x8 At[4][2], B0[2][2], B1[2][2];
        if (wr == 1) G8_BAR;
        G8_WAIT_V(4); G8_BAR;
        G8_STAGE(G8_SB(1, 0), rB, boff, 128); G8_STAGE(G8_SA(1, 0), rA, aoff[0], 128); G8_STAGE(G8_SB(1, 1), rB, boff, 128 + bh);
        G8_WAIT_V(6); G8_BAR;
        for (int t = 0; t < nt - 2; t += 2) {
            G8_LDB(B0, 0, 0); G8_SCHED; G8_LDA(At, 0, 0); G8_STAGE(G8_SA(1, 1), rA, aoff[1], (t + 1) * 128);
            G8_WAIT_L(8); G8_BAR; G8_WAIT_L(0); G8_MMA(0, 0, At, B0); G8_BAR; G8_SCHED;
            G8_LDB(B1, 0, 1); G8_STAGE(G8_SB(0, 0), rB, boff, (t + 2) * 128);
            G8_BAR; G8_WAIT_L(0); G8_MMA(0, 1, At, B1); G8_BAR;
            G8_LDA(At, 0, 1); G8_STAGE(G8_SA(0, 0), rA, aoff[0], (t + 2) * 128);
            G8_BAR; G8_WAIT_L(0); G8_MMA(1, 0, At, B0); G8_BAR; G8_SCHED;
            G8_STAGE(G8_SB(0, 1), rB, boff, (t + 2) * 128 + bh);
            G8_WAIT_V(6); G8_BAR; G8_MMA(1, 1, At, B1); G8_BAR;
            G8_LDB(B0, 1, 0); G8_SCHED; G8_LDA(At, 1, 0); G8_STAGE(G8_SA(0, 1), rA, aoff[1], (t + 2) * 128);
            G8_WAIT_L(8); G8_BAR; G8_WAIT_L(0); G8_MMA(0, 0, At, B0); G8_BAR; G8_SCHED;
            G8_LDB(B1, 1, 1); G8_STAGE(G8_SB(1, 0), rB, boff, (t + 3) * 128);
            G8_BAR; G8_WAIT_L(0); G8_MMA(0, 1, At, B1); G8_BAR;
            G8_LDA(At, 1, 1); G8_STAGE(G8_SA(1, 0), rA, aoff[0], (t + 3) * 128);
            G8_BAR; G8_WAIT_L(0); G8_MMA(1, 0, At, B0); G8_BAR; G8_SCHED;
            G8_STAGE(G8_SB(1, 1), rB, boff, (t + 3) * 128 + bh);
            G8_WAIT_V(6); G8_BAR; G8_MMA(1, 1, At, B1); G8_BAR;
        }
        { G8_LDB(B0, 0, 0); G8_WAIT_V(0); G8_LDA(At, 0, 0); G8_STAGE(G8_SA(1, 1), rA, aoff[1], (nt - 1) * 128);
          G8_BAR; G8_WAIT_L(0); G8_MMA(0, 0, At, B0); G8_BAR;
          G8_LDB(B1, 0, 1); G8_BAR; G8_WAIT_L(0); G8_MMA(0, 1, At, B1); G8_BAR;
          G8_LDA(At, 0, 1); G8_WAIT_V(4); G8_BAR; G8_WAIT_L(0); G8_MMA(1, 0, At, B0); G8_MMA(1, 1, At, B1); G8_BAR; }
        { G8_LDB(B0, 1, 0); G8_LDA(At, 1, 0); G8_WAIT_V(2); G8_BAR; G8_WAIT_L(0); G8_MMA(0, 0, At, B0); G8_BAR;
          G8_LDB(B1, 1, 1); G8_WAIT_V(0); G8_BAR; G8_WAIT_L(0); G8_MMA(0, 1, At, B1); G8_BAR;
          G8_LDA(At, 1, 1); G8_BAR; G8_WAIT_L(0); G8_MMA(1, 0, At, B0); G8_MMA(1, 1, At, B1); G8_BAR; }
        if (wr == 0) G8_BAR;
        tid = otid(); wid = tid >> 6; lane = tid & 63; wr = wid >> 2; wc = wid & 3; fr = lane & 15; fq = lane >> 4;
        if (has_next) { G8_PREP(nxt, (it + 1) % 3); G8_PRO1(); }
        {
            const int* sr = sRowG + (it % 3) * 256;
#pragma unroll
            for (int ai = 0; ai < 2; ++ai)
#pragma unroll
                for (int bj = 0; bj < 2; ++bj) epi(cm0, cu0, acc[ai][bj], ai * 128 + wr * 64, cn0 + bj * 128 + wc * 32, fr, fq, sr);
        }
        if (!has_next) break;
        cm0 = nxt.m0; cn0 = nxt.n0; cu0 = nxt.u0;
    }
#undef G8_PREP
#undef G8_PRO1
}

struct XcdSeq {
    int q, qend, step;
    __device__ __forceinline__ XcdSeq(int total, int bid, int nb) {
        if ((nb & 7) == 0) { const int chunk = (total + 7) >> 3, x = bid & 7; q = x * chunk + (bid >> 3); const int e = (x + 1) * chunk; qend = e < total ? e : total; step = nb >> 3; }
        else { q = bid; qend = total; step = nb; }
    }
};

template <class Epi>
__device__ __forceinline__ void gemm256_phase(const bf16_t* A, long lda, int M, const bf16_t* Bt, long ldb, int N, int K, char* smem, int bid, int nb, Epi&& epi) {
    const int ntn = N / 256, ntm = M / 256, nt = ntn * ntm;
    XcdSeq s(nt, bid, nb);
    gemm256_stream<false, 0>(
        [&](int i, G8Desc& d) -> bool {
            const int Q = s.q + i * s.step; if (Q >= s.qend) return false;
            const int pnl = Q / (4 * ntn), r = Q - pnl * 4 * ntn;
            d.A = A; d.Bt = Bt; d.list = nullptr; d.m0 = (pnl * 4 + (r & 3)) * 256; d.n0 = (r >> 2) * 256; d.count = 0; d.u0 = 0;
            return true; },
        (int)lda, (int)ldb, K, smem,
        [&](int m0, int, f32x4 (&acc)[4][2], int rt0, int c0, int fr, int fq, const int*) { epi(acc, m0 + rt0, c0, fr, fq); });
}


__device__ __forceinline__ int colmap(int kind, int n, int nsrc) {
    if (kind == 0) return n < nsrc ? n : -1;
    if (kind == 1) { if (n < 1536) return n; if (n < 2048) return n + 16; if (n < 2064) return n - 512; return -1; }
    if (kind == 2) { if (n < 1792) return n; if (n < 6400) return n + 68; if (n < 6468) return n - 4608; return -1; }
    { const int grp = n >> 5, w = n & 31; return ((w >> 2) & 1) * 1024 + grp * 16 + 4 * (w >> 3) + (w & 3); }
}
struct ConvTile { const float* src; bf16_t* dst; int sld, sc, K, n0, k0; };
__device__ __forceinline__ ConvTile conv_decode(PRef p, int t, int n4) {
    constexpr int S0 = 128 * 32 * 4, S1 = S0 + 128 * 16 * 4, S2 = S1 + 2 * 36 * 4, S3 = S2 + 2 * 104 * 4, S4 = S3 + 2 * 16 * 4, S5 = S4 + 2 * 16 * 4, S6 = S5 + 2 * 8 * 2;
    char* ws = p.ws;
    ConvTile c; int nsrc, kind, NT, loc;
    if (t < S0) { loc = t; const int mat = loc / (32 * 4); loc -= mat * 32 * 4; c.src = p.moe_w1 + (size_t)mat * 1024 * 2048; c.dst = (bf16_t*)(ws + OFF_WT_W1) + (size_t)mat * 2048 * 1024; c.sld = 2048; nsrc = 2048; kind = 3; c.K = 1024; NT = 32; }
    else if (t < S1) { loc = t - S0; const int mat = loc / 64; loc -= mat * 64; c.src = p.moe_w2 + (size_t)mat * 1024 * 1024; c.dst = (bf16_t*)(ws + OFF_WT_W2) + (size_t)mat * 1024 * 1024; c.sld = 1024; nsrc = 1024; kind = 0; c.K = 1024; NT = 16; }
    else if (t < S2) { loc = t - S1; const int mat = loc / (36 * 4); loc -= mat * 36 * 4; c.src = p.ev_w_in + (size_t)mat * 1024 * 2064; c.dst = (bf16_t*)(ws + OFF_WT_EVIN) + (size_t)mat * EV_N * 1024; c.sld = 2064; nsrc = 2064; kind = 1; c.K = 1024; NT = 36; }
    else if (t < S3) { loc = t - S2; const int mat = loc / (104 * 4); loc -= mat * 104 * 4; c.src = p.od_w_in + (size_t)mat * 1024 * 6468; c.dst = (bf16_t*)(ws + OFF_WT_ODIN) + (size_t)mat * OD_N * 1024; c.sld = 6468; nsrc = 6468; kind = 2; c.K = 1024; NT = 104; }
    else if (t < S4) { loc = t - S3; const int mat = loc / 64; loc -= mat * 64; c.src = p.ev_w_out + (size_t)mat * 1024 * 1024; c.dst = (bf16_t*)(ws + OFF_WT_EVOUT) + (size_t)mat * 1024 * 1024; c.sld = 1024; nsrc = 1024; kind = 0; c.K = 1024; NT = 16; }
    else if (t < S5) { loc = t - S4; const int mat = loc / 64; loc -= mat * 64; c.src = p.od_w_out + (size_t)mat * 1024 * 1024; c.dst = (bf16_t*)(ws + OFF_WT_ODOUT) + (size_t)mat * 1024 * 1024; c.sld = 1024; nsrc = 1024; kind = 0; c.K = 1024; NT = 16; }
    else if (t < S6) { loc = t - S5; const int mat = loc / 16; loc -= mat * 16; c.src = p.s5_w_glu + (size_t)mat * 512 * 512; c.dst = (bf16_t*)(ws + OFF_WT_GLU) + (size_t)mat * 512 * 512; c.sld = 512; nsrc = 512; kind = 0; c.K = 512; NT = 8; }
    else { loc = t - S6; const int mat = loc / 8; loc -= mat * 8; c.src = p.router_w + (size_t)mat * 1024 * 32; c.dst = (bf16_t*)(ws + OFF_WT_RT) + (size_t)mat * 128 * 1024; c.sld = 32; nsrc = 32; kind = 0; c.K = 1024; NT = 2; }
    const int kt = loc / NT, nt = loc - kt * NT;
    c.n0 = nt * 64; c.k0 = kt * 256;
    c.sc = colmap(kind, c.n0 + n4 * 4, nsrc);
    return c;
}
__device__ __forceinline__ void conv_load(const ConvTile& c, int kp, f32x4 (&v)[8]) {
#pragma unroll
    for (int i = 0; i < 4; ++i)
#pragma unroll
        for (int e = 0; e < 2; ++e) {
            const int k = c.k0 + 2 * (kp + 32 * i) + e;
            v[2 * i + e] = c.sc >= 0 ? *(const f32x4*)(c.src + (size_t)k * c.sld + c.sc) : (f32x4){0.f, 0.f, 0.f, 0.f};
        }
}

__device__ __forceinline__ void conv_phase(PRef p, char* smem, int bid, int nb) {
    char* ws = p.ws;
    constexpr int NTILES = 128 * 32 * 4 + 128 * 16 * 4 + 2 * 36 * 4 + 2 * 104 * 4 + 2 * 16 * 4 + 2 * 16 * 4 + 2 * 8 * 2 + 4 * 2 * 4;
    bf16_t* tile = (bf16_t*)smem;
    const int tid = otid(), n4 = tid & 15, kp = tid >> 4;
    if (bid < NTILES) {
        ConvTile cur = conv_decode(p, bid, n4);
        f32x4 v[8];
        conv_load(cur, kp, v);
        for (int t = bid; t < NTILES; t += nb) {
            const bool more = t + nb < NTILES;
            ConvTile nxt = cur; f32x4 w[8];
            if (more) { nxt = conv_decode(p, t + nb, n4); conv_load(nxt, kp, w); }
#pragma unroll
            for (int i = 0; i < 4; ++i)
#pragma unroll
                for (int j = 0; j < 4; ++j)
                    *(unsigned*)(tile + (n4 * 4 + j) * 258 + 2 * (kp + 32 * i)) = pk2(v[2 * i][j], v[2 * i + 1][j]);
            __syncthreads();
#pragma unroll
            for (int i = 0; i < 4; ++i) {
                const int c = tid + 512 * i, n = c >> 5, kc = c & 31;
                const unsigned* tp = (const unsigned*)(tile + n * 258 + kc * 8);
                u32x4 o; o.x = tp[0]; o.y = tp[1]; o.z = tp[2]; o.w = tp[3];
                *(u32x4*)(cur.dst + (size_t)(cur.n0 + n) * cur.K + cur.k0 + kc * 8) = o;
            }
            __syncthreads();
            if (more) {
                cur = nxt;
#pragma unroll
                for (int i = 0; i < 8; ++i) v[i] = w[i];
            }
        }
    }
    {
        const float* x = p.x; bf16_t* xb = (bf16_t*)(ws + OFF_XB);
        const long nch = (long)T_ * 1024 / 8;
        for (long c = (long)bid * NTHR + otid(); c < nch; c += (long)nb * NTHR) {
            const f32x4 a = *(const f32x4*)(x + c * 8), b = *(const f32x4*)(x + c * 8 + 4);
            u32x4 w; w.x = pk2(a[0], a[1]); w.y = pk2(a[2], a[3]); w.z = pk2(b[0], b[1]); w.w = pk2(b[2], b[3]);
            *(u32x4*)(xb + c * 8) = w;
        }
    }
    if (bid == 0 && otid() < 128) ((int*)(ws + OFF_CNT))[otid()] = 0;
}

__device__ __forceinline__ void s5mat_unit(PRef p, int j, int g, char* smem) {
    float* cre = (float*)smem;
    float* cim = cre + 1024;
    float* bbr = cim + 1024;
    float* bbi = bbr + 1024;
    float* pwr = bbi + 1024;
    float* pwi = pwr + 65 * 64;
    float* zr = pwi + 65 * 64;
    float* zi = zr + 64;
    float* Kd = zi + 64;
    const int tid = otid();
    const int jg = j * 32 + g;
    if (tid < 64) {
        const int pp = tid;
        const float lre = fminf(p.s5_a_re[jg * 64 + pp], -1e-4f), lim = p.s5_a_im[jg * 64 + pp];
        const float dt = expf(p.s5_log_dt[jg]);
        const float xr = lre * dt, th = lim * dt;
        const float mag = expf(xr);
        const float ar = mag * cosf(th), ai = mag * sinf(th);
        const float inv = 1.f / (lre * lre + lim * lim);
        zr[pp] = ((ar - 1.f) * lre + ai * lim) * inv;
        zi[pp] = (ai * lre - (ar - 1.f) * lim) * inv;
        const double thd = (double)th;
        for (int d = 0; d <= 64; ++d) {
            const float mg = expf((float)d * xr);
            double ang = (double)d * thd;
            const double kk = rint(ang * 0.15915494309189535);
            ang -= kk * 6.283185307179586;
            const float a = (float)ang;
            pwr[d * 64 + pp] = mg * cosf(a);
            pwi[d * 64 + pp] = mg * sinf(a);
        }
    }
    for (int e = tid; e < 1024; e += NTHR) {
        cre[e] = p.s5_c_re[(size_t)jg * 1024 + e];
        cim[e] = p.s5_c_im[(size_t)jg * 1024 + e];
    }
    __syncthreads();
    for (int e = tid; e < 1024; e += NTHR) {
        const int pp = e >> 4;
        const float br = p.s5_b_re[(size_t)jg * 1024 + e], bi = p.s5_b_im[(size_t)jg * 1024 + e];
        bbr[e] = zr[pp] * br - zi[pp] * bi;
        bbi[e] = zr[pp] * bi + zi[pp] * br;
    }
    __syncthreads();
    for (int e = tid; e < 64 * 256; e += NTHR) {
        const int d = e >> 8, n = (e >> 4) & 15, m = e & 15;
        float s = 0.f;
        for (int pp = 0; pp < 64; ++pp) {
            const float cr = cre[n * 64 + pp], ci = cim[n * 64 + pp], qr = pwr[d * 64 + pp], qi = pwi[d * 64 + pp];
            const float wr_ = cr * qr - ci * qi, wi_ = cr * qi + ci * qr;
            s += wr_ * bbr[pp * 16 + m] - wi_ * bbi[pp * 16 + m];
        }
        Kd[e] = s;
    }
    __syncthreads();
    bf16_t* TH = (bf16_t*)(p.ws + OFF_TH) + (size_t)jg * 1024 * UHW;
    for (int c = tid; c < 1024 * 144; c += NTHR) {
        const int row = c / 144, ch = c - row * 144;
        const int tau = row >> 4, n = row & 15;
        float v[8];
        if (ch < 128) {
            const int s = ch >> 1, m0 = (ch & 1) * 8;
            if (s <= tau) {
#pragma unroll
                for (int i = 0; i < 8; ++i) v[i] = Kd[(tau - s) * 256 + n * 16 + m0 + i];
            } else {
#pragma unroll
                for (int i = 0; i < 8; ++i) v[i] = 0.f;
            }
        } else {
            const int p0 = (ch - 128) * 4;
#pragma unroll
            for (int i = 0; i < 4; ++i) {
                const int pp = p0 + i;
                const float cr = cre[n * 64 + pp], ci = cim[n * 64 + pp], qr = pwr[(tau + 1) * 64 + pp], qi = pwi[(tau + 1) * 64 + pp];
                v[2 * i] = cr * qr - ci * qi;
                v[2 * i + 1] = -(cr * qi + ci * qr);
            }
        }
        u32x4 w; w.x = pk2(v[0], v[1]); w.y = pk2(v[2], v[3]); w.z = pk2(v[4], v[5]); w.w = pk2(v[6], v[7]);
        *(u32x4*)(TH + (size_t)row * UHW + ch * 8) = w;
    }
    bf16_t* GM = (bf16_t*)(p.ws + OFF_GM) + (size_t)jg * 128 * 1024;
    for (int c = tid; c < 128 * 128; c += NTHR) {
        const int row = c >> 7, ch = c & 127;
        const int pp = row >> 1, ri = row & 1;
        const int s = ch >> 1, m0 = (ch & 1) * 8;
        const float qr = pwr[(63 - s) * 64 + pp], qi = pwi[(63 - s) * 64 + pp];
        float v[8];
#pragma unroll
        for (int i = 0; i < 8; ++i) {
            const float br = bbr[pp * 16 + m0 + i], bi = bbi[pp * 16 + m0 + i];
            v[i] = ri == 0 ? (qr * br - qi * bi) : (qr * bi + qi * br);
        }
        u32x4 w; w.x = pk2(v[0], v[1]); w.y = pk2(v[2], v[3]); w.z = pk2(v[4], v[5]); w.w = pk2(v[6], v[7]);
        *(u32x4*)(GM + (size_t)row * 1024 + ch * 8) = w;
    }
    if (tid < 64) {
        float* A64 = (float*)(p.ws + OFF_A64) + (size_t)jg * 128;
        A64[tid * 2] = pwr[64 * 64 + tid];
        A64[tid * 2 + 1] = pwi[64 * 64 + tid];
    }
    __syncthreads();
}

__device__ __forceinline__ void epi_ev_in(PRef p, f32x4 (&acc)[4][2], int row0, int c0, int fr, int fq) {
    char* ws = p.ws;
    bf16_t* PE = (bf16_t*)(ws + OFF_PE); bf16_t* UH = (bf16_t*)(ws + OFF_UH); float* GLR = (float*)(ws + OFF_GLR); bf16_t* VTE = (bf16_t*)(ws + OFF_VTE);
    const int col = c0 + 8 * fq;
#pragma unroll
    for (int m = 0; m < 4; ++m) {
        const int t = row0 + m * 16 + fr;
        u32x4 w; w.x = pk2(acc[m][0][0], acc[m][0][1]); w.y = pk2(acc[m][0][2], acc[m][0][3]); w.z = pk2(acc[m][1][0], acc[m][1][1]); w.w = pk2(acc[m][1][2], acc[m][1][3]);
        if (c0 < 1536) {
            *(u32x4*)(PE + (size_t)t * 1536 + col) = w;
            if (c0 >= 512 && c0 < 1024) {
                const int c = col - 512, h = c >> 7, vv = c & 127, b = t >> 14, pos = t & (L_ - 1);
                bf16_t* vp = VTE + ((size_t)((b * 4 + h) * 128 + vv)) * L_ + pos;
                vp[0] = (bf16_t)(w.x & 0xffffu); vp[(size_t)L_] = (bf16_t)(w.x >> 16); vp[(size_t)2 * L_] = (bf16_t)(w.y & 0xffffu); vp[(size_t)3 * L_] = (bf16_t)(w.y >> 16);
                vp[(size_t)4 * L_] = (bf16_t)(w.z & 0xffffu); vp[(size_t)5 * L_] = (bf16_t)(w.z >> 16); vp[(size_t)6 * L_] = (bf16_t)(w.w & 0xffffu); vp[(size_t)7 * L_] = (bf16_t)(w.w >> 16);
            }
        } else if (c0 < 2048) {
            const int ch = col - 1536, g = ch >> 4, mm = ch & 15;
            *(u32x4*)(UH + ((size_t)(t >> 6) * 32 + g) * UHW + (t & 63) * 16 + mm) = w;
        } else if (col < 2064) {
            *(f32x4*)(GLR + (size_t)t * 16 + (col - 2048)) = acc[m][0];
            *(f32x4*)(GLR + (size_t)t * 16 + (col - 2048) + 4) = acc[m][1];
        }
    }
}

__device__ __forceinline__ void gla_decay(PRef p, int j, int t0, int h, float* sB) {
    const float* GLR = (const float*)(p.ws + OFF_GLR);
    const float* w2 = p.gla_w_gate2 + (size_t)j * 16 * 256;
    const float* b2 = p.gla_b_gate2 + (size_t)j * 256;
    const int tid = otid();
    for (int e = tid; e < 4096; e += NTHR) {
        const int tau = e >> 6, d = e & 63;
        float a = b2[h * 64 + d];
#pragma unroll
        for (int r = 0; r < 16; ++r) a += GLR[(size_t)(t0 + tau) * 16 + r] * w2[r * 256 + h * 64 + d];
        const float ls = fminf(a, 0.f) - log1pf(__expf(-fabsf(a)));
        sB[tau * 65 + d] = ls * (1.f / 16.f);
    }
    __syncthreads();
    if (tid < 64) { float run = 0.f; for (int tau = 0; tau < 64; ++tau) { run += sB[tau * 65 + tid]; sB[tau * 65 + tid] = run; } }
    __syncthreads();
}

__device__ __forceinline__ void gla_a_item(PRef p, int j, int item, char* smem) {
    const int h = item & 3, c = (item >> 2) & 255, b = item >> 10;
    const int t0 = b * L_ + c * 64;
    float* sB = (float*)smem;
    bf16_t* AK = (bf16_t*)(smem + 16640);
    const bf16_t* PE = (const bf16_t*)(p.ws + OFF_PE);
    const bf16_t* VTE = (const bf16_t*)(p.ws + OFF_VTE);
    const int tid = otid(), lane = tid & 63, wave = tid >> 6, fr = lane & 15, fq = lane >> 4;
    gla_decay(p, j, t0, h, sB);
    for (int e = tid; e < 4096; e += NTHR) {
        const int tau = e >> 6, d = e & 63;
        const float k = bf2f(PE[(size_t)(t0 + tau) * 1536 + 256 + h * 64 + d]);
        AK[d * 72 + tau] = f2bf(k * __expf(sB[63 * 65 + d] - sB[tau * 65 + d]));
    }
    __syncthreads();
    const int dblk = wave >> 1, vb = (wave & 1) * 64;
    f32x4 acc[4];
#pragma unroll
    for (int n = 0; n < 4; ++n) acc[n] = (f32x4){0.f, 0.f, 0.f, 0.f};
#pragma unroll
    for (int ks = 0; ks < 2; ++ks) {
        const bf16x8 af = *(const bf16x8*)(AK + (dblk * 16 + fr) * 72 + ks * 32 + fq * 8);
#pragma unroll
        for (int n = 0; n < 4; ++n) {
            const int v = vb + n * 16 + fr;
            const bf16x8 bfr = *(const bf16x8*)(VTE + ((size_t)((b * 4 + h) * 128 + v)) * L_ + (c * 64 + ks * 32 + fq * 8));
            acc[n] = __builtin_amdgcn_mfma_f32_16x16x32_bf16(af, bfr, acc[n], 0, 0, 0);
        }
    }
    float* KV = (float*)(p.ws + OFF_KV) + ((size_t)((b * 256 + c) * 4 + h)) * 64 * 128;
#pragma unroll
    for (int n = 0; n < 4; ++n)
#pragma unroll
        for (int r = 0; r < 4; ++r) KV[(dblk * 16 + fq * 4 + r) * 128 + vb + n * 16 + fr] = acc[n][r];
    if (tid < 64) ((float*)(p.ws + OFF_DEC))[((size_t)((b * 256 + c) * 4 + h)) * 64 + tid] = __expf(sB[63 * 65 + tid]);
    __syncthreads();
}

__device__ __forceinline__ void scan_phase(PRef p, int j, int bid) {
    const int gid = bid * NTHR + otid();
    if (gid < 65536) {
        const int v = gid & 127, d = (gid >> 7) & 63, h = (gid >> 13) & 3, b = gid >> 15;
        const float* KV = (const float*)(p.ws + OFF_KV); float* SST = (float*)(p.ws + OFF_SST); const float* DEC = (const float*)(p.ws + OFF_DEC);
        float S = 0.f;
        for (int c0 = 0; c0 < 256; c0 += 8) {
            float kv[8], dc[8];
#pragma unroll
            for (int i = 0; i < 8; ++i) {
                const size_t blk = (size_t)((b * 256 + c0 + i) * 4 + h);
                kv[i] = KV[(blk * 64 + d) * 128 + v]; dc[i] = DEC[blk * 64 + d];
            }
#pragma unroll
            for (int i = 0; i < 8; ++i) {
                const size_t blk = (size_t)((b * 256 + c0 + i) * 4 + h);
                SST[(blk * 64 + d) * 128 + v] = S;
                S = dc[i] * S + kv[i];
            }
        }
    } else if (gid < 65536 + 4096) {
        const int e = gid - 65536, pp = e & 63, g = (e >> 6) & 31, b = e >> 11;
        const float* A64 = (const float*)(p.ws + OFF_A64) + (size_t)(j * 32 + g) * 128;
        const float ar = A64[pp * 2], ai = A64[pp * 2 + 1];
        const float* GB = (const float*)(p.ws + OFF_GBUF); bf16_t* UH = (bf16_t*)(p.ws + OFF_UH);
        float hr = 0.f, hi = 0.f;
        for (int c0 = 0; c0 < 256; c0 += 8) {
            float gr[8], gi[8];
#pragma unroll
            for (int i = 0; i < 8; ++i) { const size_t row = (size_t)(b * 256 + c0 + i) * 32 + g; gr[i] = GB[row * 128 + 2 * pp]; gi[i] = GB[row * 128 + 2 * pp + 1]; }
#pragma unroll
            for (int i = 0; i < 8; ++i) {
                const size_t row = (size_t)(b * 256 + c0 + i) * 32 + g;
                *(unsigned*)(UH + row * UHW + 1024 + 2 * pp) = pk2(hr, hi);
                const float nr = ar * hr - ai * hi + gr[i], ni = ar * hi + ai * hr + gi[i];
                hr = nr; hi = ni;
            }
        }
    }
}

__device__ __forceinline__ void gla_c_item(PRef p, int j, int item, char* smem) {
    const int h = item & 3, c = (item >> 2) & 255, b = item >> 10;
    const int t0 = b * L_ + c * 64;
    float* sB = (float*)smem;
    bf16_t* QT = (bf16_t*)(smem + 16640);
    bf16_t* KT = (bf16_t*)(smem + 16640 + 9216);
    bf16_t* ATT = (bf16_t*)(smem + 16640 + 18432);
    float* OS = (float*)(smem + 16640 + 27648);
    const bf16_t* PE = (const bf16_t*)(p.ws + OFF_PE);
    const bf16_t* VTE = (const bf16_t*)(p.ws + OFF_VTE);
    const int tid = otid(), lane = tid & 63, wave = tid >> 6, fr = lane & 15, fq = lane >> 4;
    gla_decay(p, j, t0, h, sB);
    for (int e = tid; e < 4096; e += NTHR) {
        const int tau = e >> 6, d = e & 63;
        const float bb = sB[tau * 65 + d];
        const float q = bf2f(PE[(size_t)(t0 + tau) * 1536 + h * 64 + d]);
        const float k = bf2f(PE[(size_t)(t0 + tau) * 1536 + 256 + h * 64 + d]);
        QT[tau * 72 + d] = f2bf(q * 0.125f * __expf(bb));
        KT[tau * 72 + d] = f2bf(k * __expf(-bb));
    }
    __syncthreads();
    const int iblk = wave >> 1;
    {
        f32x4 acc[2];
        acc[0] = (f32x4){0.f, 0.f, 0.f, 0.f}; acc[1] = acc[0];
#pragma unroll
        for (int ks = 0; ks < 2; ++ks) {
            const bf16x8 af = *(const bf16x8*)(QT + (iblk * 16 + fr) * 72 + ks * 32 + fq * 8);
#pragma unroll
            for (int n = 0; n < 2; ++n) {
                const int jb = (wave & 1) * 2 + n;
                const bf16x8 bfr = *(const bf16x8*)(KT + (jb * 16 + fr) * 72 + ks * 32 + fq * 8);
                acc[n] = __builtin_amdgcn_mfma_f32_16x16x32_bf16(af, bfr, acc[n], 0, 0, 0);
            }
        }
#pragma unroll
        for (int n = 0; n < 2; ++n) {
            const int jj = ((wave & 1) * 2 + n) * 16 + fr;
#pragma unroll
            for (int r = 0; r < 4; ++r) { const int ii = iblk * 16 + fq * 4 + r; ATT[ii * 72 + jj] = f2bf(jj <= ii ? acc[n][r] : 0.f); }
        }
    }
    __syncthreads();
    {
        const int vb = (wave & 1) * 64;
        const float* SST = (const float*)(p.ws + OFF_SST) + ((size_t)((b * 256 + c) * 4 + h)) * 64 * 128;
        f32x4 acc[4];
#pragma unroll
        for (int n = 0; n < 4; ++n) acc[n] = (f32x4){0.f, 0.f, 0.f, 0.f};
#pragma unroll
        for (int ks = 0; ks < 2; ++ks) {
            const bf16x8 af = *(const bf16x8*)(ATT + (iblk * 16 + fr) * 72 + ks * 32 + fq * 8);
            const bf16x8 aq = *(const bf16x8*)(QT + (iblk * 16 + fr) * 72 + ks * 32 + fq * 8);
#pragma unroll
            for (int n = 0; n < 4; ++n) {
                const int v = vb + n * 16 + fr;
                const bf16x8 bv = *(const bf16x8*)(VTE + ((size_t)((b * 4 + h) * 128 + v)) * L_ + (c * 64 + ks * 32 + fq * 8));
                acc[n] = __builtin_amdgcn_mfma_f32_16x16x32_bf16(af, bv, acc[n], 0, 0, 0);
                bf16x8 bs;
#pragma unroll
                for (int i = 0; i < 8; ++i) bs[i] = (short)f2bf(SST[(ks * 32 + fq * 8 + i) * 128 + v]);
                acc[n] = __builtin_amdgcn_mfma_f32_16x16x32_bf16(aq, bs, acc[n], 0, 0, 0);
            }
        }
#pragma unroll
        for (int n = 0; n < 4; ++n)
#pragma unroll
            for (int r = 0; r < 4; ++r) OS[(iblk * 16 + fq * 4 + r) * 132 + vb + n * 16 + fr] = acc[n][r];
    }
    __syncthreads();
    {
        const int i = tid >> 3, seg = tid & 7;
        float o[16]; float ss = 0.f;
#pragma unroll
        for (int q = 0; q < 16; ++q) { o[q] = OS[i * 132 + seg * 16 + q]; ss += o[q] * o[q]; }
        ss += __shfl_xor(ss, 1, 64); ss += __shfl_xor(ss, 2, 64); ss += __shfl_xor(ss, 4, 64);
        const float rs = rsqrtf(ss * (1.f / 128.f) + LN_EPS);
        const float* ng = p.gla_norm_g + (size_t)j * 128;
        bf16_t* CC = (bf16_t*)(p.ws + OFF_CC);
        const size_t t = (size_t)(t0 + i);
        unsigned w[8];
#pragma unroll
        for (int q = 0; q < 16; q += 2) {
            const int v0 = seg * 16 + q;
            const float r0 = bf2f(PE[t * 1536 + 1024 + h * 128 + v0]), r1 = bf2f(PE[t * 1536 + 1024 + h * 128 + v0 + 1]);
            const float a0 = o[q] * rs * ng[v0] * (r0 * sigmoidf_(r0)), a1 = o[q + 1] * rs * ng[v0 + 1] * (r1 * sigmoidf_(r1));
            w[q >> 1] = pk2(a0, a1);
        }
        u32x4 w0, w1; w0.x = w[0]; w0.y = w[1]; w0.z = w[2]; w0.w = w[3]; w1.x = w[4]; w1.y = w[5]; w1.z = w[6]; w1.w = w[7];
        *(u32x4*)(CC + t * 1024 + h * 128 + seg * 16) = w0;
        *(u32x4*)(CC + t * 1024 + h * 128 + seg * 16 + 8) = w1;
    }
    __syncthreads();
}

__device__ __forceinline__ void s5_g_phase(PRef p, int j, char* smem, int bid, int nb) {
    const bf16_t* UH = (const bf16_t*)(p.ws + OFF_UH);
    float* GB = (float*)(p.ws + OFF_GBUF);
    for (int t = bid; t < 64; t += nb) {
        const int g = t >> 1, mi = t & 1;
        const bf16_t* Bt = (const bf16_t*)(p.ws + OFF_GM) + (size_t)(j * 32 + g) * 128 * 1024;
        gemm_tile<false>(UH + (size_t)g * UHW, (long)32 * UHW, 0, mi * 256, Bt, 1024, 0, 1024, smem,
            [&](f32x4 (&acc)[4][2], int rt0, int c0, int fr, int fq) {
#pragma unroll
                for (int m = 0; m < 4; ++m)
#pragma unroll
                    for (int n = 0; n < 2; ++n)
#pragma unroll
                        for (int r = 0; r < 4; ++r) {
                            const int row = mi * 256 + rt0 + m * 16 + fq * 4 + r;
                            GB[((size_t)row * 32 + g) * 128 + c0 + n * 16 + fr] = acc[m][n][r];
                        }
            });
    }
}
__device__ __forceinline__ void s5_y_phase(PRef p, int j, char* smem, int bid, int nb) {
    const bf16_t* UH = (const bf16_t*)(p.ws + OFF_UH);
    bf16_t* YA = (bf16_t*)(p.ws + OFF_YA);
    const float* dsk = p.s5_d + (size_t)j * 512;
    XcdSeq sq(32 * 2 * 4, bid, nb);
    for (int t = sq.q; t < sq.qend; t += sq.step) {
        const int g = t >> 3, mi = (t >> 2) & 1, ni = t & 3;
        const bf16_t* Bt = (const bf16_t*)(p.ws + OFF_TH) + (size_t)(j * 32 + g) * 1024 * UHW;
        gemm256_tile<false>(UH + (size_t)g * UHW, (long)32 * UHW, 0, mi * 256, Bt, UHW, ni * 256, UHW, smem,
            [&](f32x4 (&acc)[4][2], int rt0, int c0, int fr, int fq) {
                const int col = c0 + 8 * fq;
                const int tau = col >> 4, nn = col & 15, ch = g * 16 + nn;
                const f32x4 d0 = *(const f32x4*)(dsk + ch), d1 = *(const f32x4*)(dsk + ch + 4);
#pragma unroll
                for (int m = 0; m < 4; ++m) {
                    const int row = mi * 256 + rt0 + m * 16 + fr;
                    const u32x4 uw = *(const u32x4*)(UH + ((size_t)row * 32 + g) * UHW + col);
                    float y[8];
#pragma unroll
                    for (int q = 0; q < 4; ++q) {
                        const unsigned u2 = q == 0 ? uw.x : q == 1 ? uw.y : q == 2 ? uw.z : uw.w;
                        const float u0 = __uint_as_float(u2 << 16), u1 = __uint_as_float(u2 & 0xffff0000u);
                        const float a0 = q < 2 ? acc[m][0][2 * q] : acc[m][1][2 * q - 4], a1 = q < 2 ? acc[m][0][2 * q + 1] : acc[m][1][2 * q - 3];
                        const float dd0 = q < 2 ? d0[2 * q] : d1[2 * q - 4], dd1 = q < 2 ? d0[2 * q + 1] : d1[2 * q - 3];
                        y[2 * q] = gelu_tanh(a0 + dd0 * u0); y[2 * q + 1] = gelu_tanh(a1 + dd1 * u1);
                    }
                    u32x4 w; w.x = pk2(y[0], y[1]); w.y = pk2(y[2], y[3]); w.z = pk2(y[4], y[5]); w.w = pk2(y[6], y[7]);
                    *(u32x4*)(YA + ((size_t)row * 64 + tau) * 512 + ch) = w;
                }
            });
    }
}

template <bool SLOTS>
__device__ __forceinline__ void ln_phase(PRef p, const float* xin, const float* addb, const float* g, const float* bta, float* xout, bf16_t* xb, int bid, int nb) {
    const int lane = otid() & 63, wave = otid() >> 6;
    for (int t = bid * 8 + wave; t < T_; t += nb * 8) {
        f32x4 v[4];
        float s = 0.f;
#pragma unroll
        for (int i = 0; i < 4; ++i) {
            const int c = i * 256 + lane * 4;
            f32x4 a = *(const f32x4*)(xin + (size_t)t * 1024 + c);
            f32x4 m;
            if (SLOTS) {
                const bf16_t* sl = (const bf16_t*)addb;
                m = (f32x4){0.f, 0.f, 0.f, 0.f};
#pragma unroll
                for (int k = 0; k < 4; ++k) {
                    const u32x2 w = *(const u32x2*)(sl + ((size_t)t * 4 + k) * 1024 + c);
                    m[0] += __uint_as_float(w.x << 16); m[1] += __uint_as_float(w.x & 0xffff0000u); m[2] += __uint_as_float(w.y << 16); m[3] += __uint_as_float(w.y & 0xffff0000u);
                }
            } else m = *(const f32x4*)(addb + (size_t)t * 1024 + c);
            v[i] = a * ALPHA + m;
            s += v[i][0] + v[i][1] + v[i][2] + v[i][3];
        }
        const float mu = wave_sum(s) * (1.f / 1024.f);
        float q = 0.f;
#pragma unroll
        for (int i = 0; i < 4; ++i) { v[i] -= mu; q += v[i][0] * v[i][0] + v[i][1] * v[i][1] + v[i][2] * v[i][2] + v[i][3] * v[i][3]; }
        const float rs = rsqrtf(wave_sum(q) * (1.f / 1024.f) + LN_EPS);
#pragma unroll
        for (int i = 0; i < 4; ++i) {
            const int c = i * 256 + lane * 4;
            const f32x4 gg = *(const f32x4*)(g + c), bb = *(const f32x4*)(bta + c);
            const f32x4 o = v[i] * rs * gg + bb;
            *(f32x4*)(xout + (size_t)t * 1024 + c) = o;
            if (xb) { u32x2 w; w.x = pk2(o[0], o[1]); w.y = pk2(o[2], o[3]); *(u32x2*)(xb + (size_t)t * 1024 + c) = w; }
        }
    }
}

constexpr int RT_STRIDE = 36;
constexpr int RT_SCR_OFF = 1024 * RT_STRIDE * 4;
__device__ __forceinline__ void ln1_router_phase(PRef p, int layer, const float* xin, char* smem, int bid, int nb) {
    float* wl = (float*)smem;
    const int tid = otid(), lane = tid & 63, wave = tid >> 6;
    float* lgs = (float*)(smem + RT_SCR_OFF + wave * 640);
    int* pick = (int*)(lgs + 32);
    float* pgate = (float*)(pick + 64);
    {
        const float* rw = p.router_w + (size_t)layer * 1024 * 32;
        for (int e = tid; e < 32768; e += NTHR) {
            const int k = e >> 5, ex = e & 31, rem = k & 255;
            wl[((k & ~255) + (rem & 3) * 64 + (rem >> 2)) * RT_STRIDE + ex] = rw[e];
        }
    }
    __syncthreads();
    const float* addb = (const float*)(p.ws + OFF_MIX);
    const float* g = p.ln1_g + (size_t)layer * 1024; const float* bta = p.ln1_b + (size_t)layer * 1024;
    float* xout = (float*)(p.ws + OFF_XR); bf16_t* xb = (bf16_t*)(p.ws + OFF_XB);
    int* cnt = (int*)(p.ws + OFF_CNT) + layer * 32;
    int* LIST = (int*)(p.ws + OFF_LIST);
    float* GATE = (float*)(p.ws + OFF_GATE);
    const float rbias = p.router_b[(size_t)layer * 32 + (lane >> 1)];
    const int rstep = nb * 8;
    f32x4 xa[4], xm[4];
    {
        const int t0 = bid * 8 + wave;
        if (t0 < T_) {
#pragma unroll
            for (int i = 0; i < 4; ++i) { const int c = i * 256 + lane * 4; xa[i] = *(const f32x4*)(xin + (size_t)t0 * 1024 + c); xm[i] = *(const f32x4*)(addb + (size_t)t0 * 1024 + c); }
        }
    }
    for (int tb = bid * 8 + wave; tb < T_; tb += rstep * 16) {
        int nrow = 0;
#pragma unroll 1
        for (int t = tb; t < T_ && nrow < 16; t += rstep, ++nrow) {
            f32x4 v[4];
            float s = 0.f;
#pragma unroll
            for (int i = 0; i < 4; ++i) { v[i] = xa[i] * ALPHA + xm[i]; s += v[i][0] + v[i][1] + v[i][2] + v[i][3]; }
            if (t + rstep < T_) {
#pragma unroll
                for (int i = 0; i < 4; ++i) { const int c = i * 256 + lane * 4; xa[i] = *(const f32x4*)(xin + (size_t)(t + rstep) * 1024 + c); xm[i] = *(const f32x4*)(addb + (size_t)(t + rstep) * 1024 + c); }
            }
            const float mu = wave_sum(s) * (1.f / 1024.f);
            float q = 0.f;
#pragma unroll
            for (int i = 0; i < 4; ++i) { v[i] -= mu; q += v[i][0] * v[i][0] + v[i][1] * v[i][1] + v[i][2] * v[i][2] + v[i][3] * v[i][3]; }
            const float rs = rsqrtf(wave_sum(q) * (1.f / 1024.f) + LN_EPS);
#pragma unroll
            for (int i = 0; i < 4; ++i) {
                const int c = i * 256 + lane * 4;
                const f32x4 gg = *(const f32x4*)(g + c), bb = *(const f32x4*)(bta + c);
                v[i] = v[i] * rs * gg + bb;
                *(f32x4*)(xout + (size_t)t * 1024 + c) = v[i];
                u32x2 w; w.x = pk2(v[i][0], v[i][1]); w.y = pk2(v[i][2], v[i][3]); *(u32x2*)(xb + (size_t)t * 1024 + c) = w;
            }
            f32x4 acc[8];
#pragma unroll
            for (int e = 0; e < 8; ++e) acc[e] = (f32x4){0.f, 0.f, 0.f, 0.f};
#pragma unroll
            for (int i = 0; i < 4; ++i)
#pragma unroll
                for (int j = 0; j < 4; ++j) {
                    const f32x4* wr_ = (const f32x4*)(wl + (i * 256 + j * 64 + lane) * RT_STRIDE);
                    const float xv = v[i][j];
#pragma unroll
                    for (int e = 0; e < 8; ++e) acc[e] += wr_[e] * xv;
                }
            float k16[16], k8[8], k4[4], k2[2];
            { const bool hb = lane & 32;
#pragma unroll
              for (int a = 0; a < 16; ++a) { const float lo = acc[a >> 2][a & 3], hi = acc[(a + 16) >> 2][a & 3]; const float mine = hb ? hi : lo, send = hb ? lo : hi; k16[a] = mine + __shfl_xor(send, 32, 64); } }
            { const bool hb = lane & 16;
#pragma unroll
              for (int a = 0; a < 8; ++a) { const float mine = hb ? k16[a + 8] : k16[a], send = hb ? k16[a] : k16[a + 8]; k8[a] = mine + __shfl_xor(send, 16, 64); } }
            { const bool hb = lane & 8;
#pragma unroll
              for (int a = 0; a < 4; ++a) { const float mine = hb ? k8[a + 4] : k8[a], send = hb ? k8[a] : k8[a + 4]; k4[a] = mine + __shfl_xor(send, 8, 64); } }
            { const bool hb = lane & 4;
#pragma unroll
              for (int a = 0; a < 2; ++a) { const float mine = hb ? k4[a + 2] : k4[a], send = hb ? k4[a] : k4[a + 2]; k2[a] = mine + __shfl_xor(send, 4, 64); } }
            float lg;
            { const bool hb = lane & 2; const float mine = hb ? k2[1] : k2[0], send = hb ? k2[0] : k2[1]; lg = mine + __shfl_xor(send, 2, 64); }
            lg += __shfl_xor(lg, 1, 64);
            lg += rbias;
            float cand = (lane & 1) ? -INFINITY : lg;
            float tv[4]; int te[4];
#pragma unroll
            for (int r = 0; r < 4; ++r) {
                float mxv = cand;
#pragma unroll
                for (int sft = 32; sft >= 1; sft >>= 1) mxv = fmaxf(mxv, __shfl_xor(mxv, sft, 64));
                const unsigned long long bal = __builtin_amdgcn_ballot_w64(cand == mxv);
                const int first = __builtin_ctzll(bal);
                tv[r] = mxv; te[r] = first >> 1;
                if (lane == first) cand = -INFINITY;
            }
            if (lane == 0) {
                const float e1 = __expf(tv[1] - tv[0]), e2 = __expf(tv[2] - tv[0]), e3 = __expf(tv[3] - tv[0]);
                const float inv = 1.f / (1.f + e1 + e2 + e3);
                pick[nrow * 4 + 0] = te[0]; pick[nrow * 4 + 1] = te[1]; pick[nrow * 4 + 2] = te[2]; pick[nrow * 4 + 3] = te[3];
                pgate[nrow * 4 + 0] = inv; pgate[nrow * 4 + 1] = e1 * inv; pgate[nrow * 4 + 2] = e2 * inv; pgate[nrow * 4 + 3] = e3 * inv;
            }
        }
        if ((lane >> 2) < nrow) {
            const int t = tb + (lane >> 2) * rstep, ex = pick[lane], pair = t * 4 + (lane & 3);
            const int pos = atomicAdd(&cnt[ex], 1);
            LIST[(size_t)ex * LISTCAP + pos] = pair;
            GATE[pair] = pgate[lane];
        }
    }
}

__device__ __forceinline__ void topk_phase(PRef p, int layer, int bid, int nb) {
    const float* LG = (const float*)(p.ws + OFF_LOGIT);
    int* cnt = (int*)(p.ws + OFF_CNT) + layer * 32;
    int* LIST = (int*)(p.ws + OFF_LIST);
    float* GATE = (float*)(p.ws + OFF_GATE);
    for (int t = bid * NTHR + otid(); t < T_; t += nb * NTHR) {
        float v0 = -INFINITY, v1 = -INFINITY, v2 = -INFINITY, v3 = -INFINITY; int i0 = 0, i1 = 0, i2 = 0, i3 = 0;
#pragma unroll
        for (int q = 0; q < 8; ++q) {
            const f32x4 l4 = *(const f32x4*)(LG + (size_t)t * 32 + q * 4);
#pragma unroll
            for (int r = 0; r < 4; ++r) {
                const float v = l4[r]; const int e = q * 4 + r;
                if (v > v0) { v3 = v2; i3 = i2; v2 = v1; i2 = i1; v1 = v0; i1 = i0; v0 = v; i0 = e; }
                else if (v > v1) { v3 = v2; i3 = i2; v2 = v1; i2 = i1; v1 = v; i1 = e; }
                else if (v > v2) { v3 = v2; i3 = i2; v2 = v; i2 = e; }
                else if (v > v3) { v3 = v; i3 = e; }
            }
        }
        const float e1 = __expf(v1 - v0), e2 = __expf(v2 - v0), e3 = __expf(v3 - v0);
        const float inv = 1.f / (1.f + e1 + e2 + e3);
        int pos;
        pos = atomicAdd(&cnt[i0], 1); LIST[(size_t)i0 * LISTCAP + pos] = t * 4 + 0; GATE[t * 4 + 0] = inv;
        pos = atomicAdd(&cnt[i1], 1); LIST[(size_t)i1 * LISTCAP + pos] = t * 4 + 1; GATE[t * 4 + 1] = e1 * inv;
        pos = atomicAdd(&cnt[i2], 1); LIST[(size_t)i2 * LISTCAP + pos] = t * 4 + 2; GATE[t * 4 + 2] = e2 * inv;
        pos = atomicAdd(&cnt[i3], 1); LIST[(size_t)i3 * LISTCAP + pos] = t * 4 + 3; GATE[t * 4 + 3] = e3 * inv;
    }
}

template <int WHICH, bool NOEPI = false>
__device__ __forceinline__ void moe_gemm_phase(PRef p, int layer, char* smem, int bid, int nb) {
    const int* cnt = (const int*)(p.ws + OFF_CNT) + layer * 32;
    const int* LIST = (const int*)(p.ws + OFF_LIST);
    constexpr int NTN = WHICH == 1 ? 8 : 4;
    int total = 0;
    for (int i = 0; i < 32; ++i) total += ((cnt[i] + 255) >> 8) * NTN;
    XcdSeq sq(total, bid, nb);
    int e = 0, base = 0, ce = cnt[0], mt = (ce + 255) >> 8;
    auto src = [&](int i, G8Desc& d) -> bool {
        const int t = sq.q + i * sq.step;
        if (t >= sq.qend) return false;
        while (e < 32 && t >= base + mt * NTN) { base += mt * NTN; ++e; if (e < 32) { ce = cnt[e]; mt = (ce + 255) >> 8; } }
        if (e >= 32) return false;
        int mi, ni;
        { const int loc = t - base, pf = mt >> 2, full = pf * 4 * NTN;
          if (loc < full) { const int pn = loc / (4 * NTN), r = loc - pn * 4 * NTN; ni = r >> 2; mi = pn * 4 + (r & 3); }
          else { const int ph = mt - pf * 4, r = loc - full; ni = r / ph; mi = pf * 4 + (r - ni * ph); } }
        d.m0 = 0; d.n0 = ni * 256; d.list = LIST + (size_t)e * LISTCAP + mi * 256; d.count = ce - mi * 256; d.u0 = e;
        if (WHICH == 1) { d.A = (const bf16_t*)(p.ws + OFF_XB); d.Bt = (const bf16_t*)(p.ws + OFF_WT_W1) + (size_t)(layer * 32 + e) * 2048 * 1024; }
        else { d.A = (const bf16_t*)(p.ws + OFF_ACT); d.Bt = (const bf16_t*)(p.ws + OFF_WT_W2) + (size_t)(layer * 32 + e) * 1024 * 1024; }
        return true; };
    if (WHICH == 1) {
        bf16_t* ACT = (bf16_t*)(p.ws + OFF_ACT);
        gemm256_stream<true, 2>(src, 1024, 1024, 1024, smem,
            [&](int, int e_, f32x4 (&acc)[4][2], int rt0, int c0, int fr, int fq, const int* sRow) {
                const float* b1 = p.moe_b1 + (size_t)(layer * 32 + e_) * 2048;
                const int gcol = (c0 >> 5) * 16 + 4 * fq;
                const f32x4 bg = *(const f32x4*)(b1 + gcol), bl = *(const f32x4*)(b1 + 1024 + gcol);
#pragma unroll
                for (int m = 0; m < 4; ++m) {
                    const int pair = NOEPI ? -1 : sRow[rt0 + m * 16 + fr];
                    if (pair >= 0) {
                        float a[4];
#pragma unroll
                        for (int r = 0; r < 4; ++r) {
                            const float gl = fminf(acc[m][0][r] + bg[r], 7.f);
                            const float li = fminf(fmaxf(acc[m][1][r] + bl[r], -7.f), 7.f);
                            a[r] = gl * sigmoidf_(1.702f * gl) * (li + 1.f);
                        }
                        u32x2 w; w.x = pk2(a[0], a[1]); w.y = pk2(a[2], a[3]);
                        *(u32x2*)(ACT + (size_t)pair * 1024 + gcol) = w;
                    }
                }
            });
    } else {
        const float* GATE = (const float*)(p.ws + OFF_GATE);
        bf16_t* SLOT = (bf16_t*)(p.ws + OFF_SLOT);
        gemm256_stream<true, 0>(src, 1024, 1024, 1024, smem,
            [&](int, int e_, f32x4 (&acc)[4][2], int rt0, int c0, int fr, int fq, const int* sRow) {
                const float* b2 = p.moe_b2 + (size_t)(layer * 32 + e_) * 1024;
                const int col = c0 + 8 * fq;
                const f32x4 b20 = *(const f32x4*)(b2 + col), b21 = *(const f32x4*)(b2 + col + 4);
#pragma unroll
                for (int m = 0; m < 4; ++m) {
                    const int pair = NOEPI ? -1 : sRow[rt0 + m * 16 + fr];
                    if (pair >= 0) {
                        const float gt = GATE[pair];
                        const f32x4 y0 = (acc[m][0] + b20) * gt, y1 = (acc[m][1] + b21) * gt;
                        u32x4 w; w.x = pk2(y0[0], y0[1]); w.y = pk2(y0[2], y0[3]); w.z = pk2(y1[0], y1[1]); w.w = pk2(y1[2], y1[3]);
                        *(u32x4*)(SLOT + (size_t)pair * 1024 + col) = w;
                    }
                }
            });
    }
}

__device__ __forceinline__ void epi_od_in(PRef p, f32x4 (&acc)[4][2], int row0, int c0, int fr, int fq) {
    char* ws = p.ws;
    bf16_t* PO = (bf16_t*)(ws + OFF_PO); float* WI = (float*)(ws + OFF_WI); bf16_t* VTC = (bf16_t*)(ws + OFF_VTC); bf16_t* VTD = (bf16_t*)(ws + OFF_VTD);
    const int col = c0 + 8 * fq;
#pragma unroll
    for (int m = 0; m < 4; ++m) {
        const int t = row0 + m * 16 + fr;
        if (c0 < 6464) {
            u32x4 w; w.x = pk2(acc[m][0][0], acc[m][0][1]); w.y = pk2(acc[m][0][2], acc[m][0][3]); w.z = pk2(acc[m][1][0], acc[m][1][1]); w.w = pk2(acc[m][1][2], acc[m][1][3]);
            *(u32x4*)(PO + (size_t)t * OD_N + col) = w;
            const int b = t >> 14, pos = t & (L_ - 1);
            bf16_t* vp = nullptr;
            if (c0 >= 1024 && c0 < 1536) {
                const int c = col - 1024, hd = c >> 6, d = c & 63;
                vp = VTC + ((size_t)((b * 8 + hd) * 64 + d)) * L_ + pos;
            } else if (c0 >= 4864 && c0 < 6400) {
                const int c = col - 4864, g = c >> 9, hd = (c >> 6) & 7, d = c & 63, sh = 2 * g;
                vp = VTD + ((size_t)(((b * 3 + g) * 8 + hd) * 64 + d)) * L_ + (size_t)(pos & ((1 << sh) - 1)) * (L_ >> sh) + (pos >> sh);
            }
            if (vp) {
                vp[0] = (bf16_t)(w.x & 0xffffu); vp[(size_t)L_] = (bf16_t)(w.x >> 16); vp[(size_t)2 * L_] = (bf16_t)(w.y & 0xffffu); vp[(size_t)3 * L_] = (bf16_t)(w.y >> 16);
                vp[(size_t)4 * L_] = (bf16_t)(w.z & 0xffffu); vp[(size_t)5 * L_] = (bf16_t)(w.z >> 16); vp[(size_t)6 * L_] = (bf16_t)(w.w & 0xffffu); vp[(size_t)7 * L_] = (bf16_t)(w.w >> 16);
            }
        } else if (col == 6464) {
            *(f32x4*)(WI + (size_t)t * 4) = acc[m][0];
        }
    }
}

__device__ __forceinline__ void idx_scores(const char* __restrict__ ktile, int kbase, const bf16x8 (&qf)[4][4], const float (&wi)[4], int lane, float (&sc)[16]) {
    const int r = lane & 31, h2 = lane >> 5;
    const char* kp = ktile + (kbase + r) * 144 + h2 * 16;
    bf16x8 kf[4];
#pragma unroll
    for (int s = 0; s < 4; ++s) kf[s] = *(const bf16x8*)(kp + s * 32);
#pragma unroll
    for (int i = 0; i < 16; ++i) sc[i] = 0.f;
#pragma unroll
    for (int hd = 0; hd < 4; ++hd) {
        f32x16 a;
#pragma unroll
        for (int i = 0; i < 16; ++i) a[i] = 0.f;
#pragma unroll
        for (int s = 0; s < 4; ++s) a = __builtin_amdgcn_mfma_f32_32x32x16_bf16(kf[s], qf[hd][s], a, 0, 0, 0);
#pragma unroll
        for (int i = 0; i < 16; ++i) { const int ai = __float_as_int(a[i]); sc[i] += wi[hd] * __int_as_float(ai > 0 ? ai : 0); }
    }
}
__device__ __forceinline__ unsigned ord_key(float s) {
    const unsigned u = __float_as_uint(s);
    return u ^ ((unsigned)((int)u >> 31) | 0x80000000u);
}

constexpr int SEL_KT = 128 * 144;
__device__ __forceinline__ void dsa_select_item(PRef p, int b, int qb, char* smem) {
    unsigned* hist = (unsigned*)smem;
    unsigned* pref = (unsigned*)(smem + 66048);
    int* krem = (int*)(smem + 66048 + 256);
    unsigned* GW = (unsigned*)(smem + 66048 + 512);
    unsigned* EW = (unsigned*)(smem + 66048 + 512 + 1024);
    char* kbuf = smem + 69632;
    const bf16_t* PO = (const bf16_t*)(p.ws + OFF_PO);
    const float* WI = (const float*)(p.ws + OFF_WI);
    unsigned long long* BMT = (unsigned long long*)(p.ws + OFF_BM);
    const int tid = otid(), lane = tid & 63, wave = tid >> 6, kw = wave >> 1, qw = wave & 1, h2 = lane >> 5;
    const int p0 = qb * 64;
    const int ql = qw * 32 + (lane & 31);
    const int qpos = p0 + ql;
    const size_t tq = (size_t)b * L_ + qpos;
    const int nkt = (p0 + 64 + 127) >> 7;
    bf16x8 qf[4][4]; float wi[4];
#pragma unroll
    for (int hd = 0; hd < 4; ++hd) {
        wi[hd] = WI[tq * 4 + hd];
#pragma unroll
        for (int s = 0; s < 4; ++s) qf[hd][s] = *(const bf16x8*)(PO + tq * OD_N + OD_QI + hd * 64 + s * 16 + h2 * 8);
    }
    const int srow = tid >> 3, sch = tid & 7;
    const bf16_t* ksrc = PO + ((size_t)b * L_ + srow) * OD_N + OD_KI + sch * 8;
    char* kdst = kbuf + srow * 144 + sch * 16;
    for (int e = tid; e < 64 * 257; e += NTHR) hist[e] = 0u;
    if (tid < 64) { pref[tid] = 0u; krem[tid] = 256; }
    __syncthreads();
    const bool selall = qpos < 256;
    const int npass = (p0 + 63 >= 256) ? 3 : 0;
    for (int pass = 0; pass <= npass; ++pass) {
        const bool maskpass = pass == npass;
        const int sh = 24 - 8 * pass;
        const unsigned mypref = pref[ql];
        int ceq = 0;
        const int rsel = tid < 64 ? krem[tid] : 0;
        u32x4 r0 = *(const u32x4*)ksrc, r1 = *(const u32x4*)(ksrc + (size_t)64 * OD_N);
        *(u32x4*)kdst = r0; *(u32x4*)(kdst + 64 * 144) = r1;
        __syncthreads();
        for (int kt = 0; kt < nkt; ++kt) {
            const bool more = kt + 1 < nkt;
            if (more) { r0 = *(const u32x4*)(ksrc + (size_t)(kt + 1) * 128 * OD_N); r1 = *(const u32x4*)(ksrc + (size_t)((kt + 1) * 128 + 64) * OD_N); }
            float sc[16];
            idx_scores(kbuf + (kt & 1) * SEL_KT, kw * 32, qf, wi, lane, sc);
            const int keybase = kt * 128 + kw * 32;
            const bool diag = kt == nkt - 1;
            if (!maskpass) {
#pragma unroll
                for (int i = 0; i < 16; ++i) {
                    const int key = keybase + (i & 3) + 8 * (i >> 2) + 4 * h2;
                    const unsigned k32 = ord_key(sc[i]);
                    const bool match = pass == 0 ? true : ((k32 >> (sh + 8)) == mypref);
                    const bool valid = diag ? key <= qpos : true;
                    if (valid && !selall && match) atomicAdd(&hist[ql * 257 + ((k32 >> sh) & 255u)], 1u);
                }
                if (more) { char* nd = kdst + ((kt + 1) & 1) * SEL_KT; *(u32x4*)nd = r0; *(u32x4*)(nd + 64 * 144) = r1; }
                __syncthreads();
            } else {
                unsigned gw = 0u, ew = 0u;
#pragma unroll
                for (int i = 0; i < 16; ++i) {
                    const int ko = (i & 3) + 8 * (i >> 2) + 4 * h2;
                    const int key = keybase + ko;
                    const unsigned k24 = ord_key(sc[i]) >> 8;
                    const bool valid = diag ? key <= qpos : true;
                    const bool g = valid && (selall || k24 > mypref);
                    const bool e = valid && !selall && k24 == mypref;
                    gw |= (g ? 1u : 0u) << ko; ew |= (e ? 1u : 0u) << ko;
                }
                gw |= __shfl_xor(gw, 32, 64); ew |= __shfl_xor(ew, 32, 64);
                if (h2 == 0) { GW[ql * 4 + kw] = gw; EW[ql * 4 + kw] = ew; }
                if (more) { char* nd = kdst + ((kt + 1) & 1) * SEL_KT; *(u32x4*)nd = r0; *(u32x4*)(nd + 64 * 144) = r1; }
                __syncthreads();
                if (tid < 64) {
                    unsigned g4[4], e4[4];
#pragma unroll
                    for (int w = 0; w < 4; ++w) { g4[w] = GW[tid * 4 + w]; e4[w] = EW[tid * 4 + w]; }
                    int need = rsel - ceq; if (need < 0) need = 0;
#pragma unroll
                    for (int w = 0; w < 4; ++w) {
                        const int pc = __popc(e4[w]);
                        ceq += pc;
                        if (need >= pc) need -= pc;
                        else { unsigned m = e4[w], kept = 0u; for (int k = 0; k < need; ++k) { const unsigned low = m & (0u - m); kept |= low; m ^= low; } e4[w] = kept; need = 0; }
                        g4[w] |= e4[w];
                    }
                    BMT[((size_t)(b * 256 + 2 * kt)) * L_ + p0 + tid] = (unsigned long long)g4[0] | ((unsigned long long)g4[1] << 32);
                    BMT[((size_t)(b * 256 + 2 * kt + 1)) * L_ + p0 + tid] = (unsigned long long)g4[2] | ((unsigned long long)g4[3] << 32);
                }
                __syncthreads();
            }
        }
        if (!maskpass) {
            const int q = tid >> 3, part = tid & 7;
            unsigned c32[32]; unsigned tot = 0u;
#pragma unroll
            for (int i = 0; i < 32; ++i) { c32[i] = hist[q * 257 + part * 32 + i]; tot += c32[i]; }
            unsigned above = 0u;
#pragma unroll
            for (int d = 1; d < 8; ++d) { const unsigned o = __shfl(tot, (lane & ~7) + ((part + d) & 7), 64); if (part + d < 8) above += o; }
            const unsigned need = (unsigned)krem[q];
            __syncthreads();
            if ((p0 + q) >= 256 && above < need && above + tot >= need) {
                unsigned cum = above; int dg = 31;
#pragma unroll
                for (int i = 31; i >= 0; --i) { if (i == dg) { if (cum + c32[i] >= need) {   } else { cum += c32[i]; dg = i - 1; } } }
                pref[q] = (pref[q] << 8) | (unsigned)(part * 32 + dg);
                krem[q] = (int)(need - cum);
            }
            for (int e = tid; e < 64 * 257; e += NTHR) hist[e] = 0u;
            __syncthreads();
        }
    }
}

template <int MODE, int NQT>
__device__ __forceinline__ void attn_wave(PRef p, int b, int head, int qcol, int kcol, const bf16_t* __restrict__ VT, int voff,
                                          int i0, int sh  , int rho, int kt_lo, int kt_hi, int grp) {
    const bf16_t* PO = (const bf16_t*)(p.ws + OFF_PO);
    const unsigned* BM32 = (const unsigned*)(p.ws + OFF_BM);
    const int lane = otid() & 63, r = lane & 31, h2 = lane >> 5;
    const int pr = (r & 0x13) | ((r & 4) << 1) | ((r & 8) >> 1);
    const float SC = 0.125f * 1.4426950408889634f;
    bf16x8 qf[NQT][4]; size_t tq[NQT]; int qi[NQT];
#pragma unroll
    for (int qt = 0; qt < NQT; ++qt) {
        qi[qt] = i0 + qt * 32 + r;
        tq[qt] = (size_t)b * L_ + ((size_t)qi[qt] << sh) + rho;
#pragma unroll
        for (int s = 0; s < 4; ++s) qf[qt][s] = *(const bf16x8*)(PO + tq[qt] * OD_N + qcol + head * 64 + s * 16 + h2 * 8);
    }
    f32x16 oacc[NQT][2];
#pragma unroll
    for (int a = 0; a < NQT; ++a)
#pragma unroll
        for (int c = 0; c < 2; ++c)
#pragma unroll
            for (int i = 0; i < 16; ++i) oacc[a][c][i] = 0.f;
    float mrun[NQT], lrun[NQT];
#pragma unroll
    for (int a = 0; a < NQT; ++a) { mrun[a] = -1e30f; lrun[a] = 0.f; }
    bf16x8 kf[4]; unsigned mw[NQT];
    auto load_k = [&](int kt, bf16x8 (&k_)[4], unsigned (&m_)[NQT]) {
        const size_t krow = (size_t)b * L_ + ((size_t)(kt * 32 + pr) << sh) + rho;
#pragma unroll
        for (int s = 0; s < 4; ++s) k_[s] = *(const bf16x8*)(PO + krow * OD_N + kcol + head * 64 + s * 16 + h2 * 8);
#pragma unroll
        for (int a = 0; a < NQT; ++a) m_[a] = MODE == 0 ? BM32[tq[a] * 512 + kt] : 0u;
    };
    load_k(kt_lo, kf, mw);
#pragma unroll 1
    for (int kt = kt_lo; kt <= kt_hi; ++kt) {
        bf16x8 vf[2][2];
#pragma unroll
        for (int db = 0; db < 2; ++db)
#pragma unroll
            for (int s2 = 0; s2 < 2; ++s2) vf[db][s2] = *(const bf16x8*)(VT + (size_t)(db * 32 + r) * L_ + voff + kt * 32 + s2 * 16 + h2 * 8);
        bf16x8 kn[4]; unsigned mn[NQT];
#pragma unroll
        for (int a = 0; a < NQT; ++a) mn[a] = 0u;
        if (kt < kt_hi) load_k(kt + 1, kn, mn);
#pragma unroll
        for (int qt = 0; qt < NQT; ++qt) {
            f32x16 s;
#pragma unroll
            for (int i = 0; i < 16; ++i) s[i] = 0.f;
#pragma unroll
            for (int ks = 0; ks < 4; ++ks) s = __builtin_amdgcn_mfma_f32_32x32x16_bf16(kf[ks], qf[qt][ks], s, 0, 0, 0);
            unsigned selm = 0u; float mx = -1e30f;
#pragma unroll
            for (int i = 0; i < 16; ++i) {
                const int ko = 16 * (i >> 3) + 8 * h2 + 4 * ((i >> 2) & 1) + (i & 3);
                bool sl;
                if (MODE == 0) sl = (mw[qt] >> ko) & 1u;
                else { const int kk = kt * 32 + ko; sl = (kk <= qi[qt]) && (kk >= qi[qt] - 128); }
                selm |= (sl ? 1u : 0u) << i;
                s[i] = sl ? s[i] * SC : -1e30f;
                mx = fmaxf(mx, s[i]);
            }
            mx = fmaxf(mx, __shfl_xor(mx, 32, 64));
            const float mnew = fmaxf(mrun[qt], mx);
            const float corr = __builtin_amdgcn_exp2f(mrun[qt] - mnew);
            mrun[qt] = mnew;
            float ps = 0.f;
#pragma unroll
            for (int i = 0; i < 16; ++i) { s[i] = ((selm >> i) & 1u) ? __builtin_amdgcn_exp2f(s[i] - mnew) : 0.f; ps += s[i]; }
            lrun[qt] = lrun[qt] * corr + ps;
#pragma unroll
            for (int db = 0; db < 2; ++db)
#pragma unroll
                for (int i = 0; i < 16; ++i) oacc[qt][db][i] *= corr;
#pragma unroll
            for (int s2 = 0; s2 < 2; ++s2) {
                u32x4 pw; pw.x = pk2(s[8 * s2], s[8 * s2 + 1]); pw.y = pk2(s[8 * s2 + 2], s[8 * s2 + 3]); pw.z = pk2(s[8 * s2 + 4], s[8 * s2 + 5]); pw.w = pk2(s[8 * s2 + 6], s[8 * s2 + 7]);
                const bf16x8 pf = __builtin_bit_cast(bf16x8, pw);
#pragma unroll
                for (int db = 0; db < 2; ++db) oacc[qt][db] = __builtin_amdgcn_mfma_f32_32x32x16_bf16(vf[db][s2], pf, oacc[qt][db], 0, 0, 0);
            }
        }
        if (kt < kt_hi) {
#pragma unroll
            for (int s = 0; s < 4; ++s) kf[s] = kn[s];
#pragma unroll
            for (int a = 0; a < NQT; ++a) mw[a] = mn[a];
        }
    }
#pragma unroll
    for (int qt = 0; qt < NQT; ++qt) {
        const float lt = lrun[qt] + __shfl_xor(lrun[qt], 32, 64);
        const float inv = 1.f / lt;
        if (MODE == 0) {
            bf16_t* CC = (bf16_t*)(p.ws + OFF_CC);
#pragma unroll
            for (int db = 0; db < 2; ++db)
#pragma unroll
                for (int i = 0; i < 16; ++i) {
                    const int d = db * 32 + (i & 3) + 8 * (i >> 2) + 4 * h2;
                    CC[tq[qt] * 1024 + head * 64 + d] = f2bf(oacc[qt][db][i] * inv);
                }
        } else {
            float* OD = (float*)(p.ws + OFF_OD) + (size_t)grp * T_ * 512;
#pragma unroll
            for (int db = 0; db < 2; ++db)
#pragma unroll
                for (int i = 0; i < 16; ++i) {
                    const int d = db * 32 + (i & 3) + 8 * (i >> 2) + 4 * h2;
                    OD[tq[qt] * 512 + head * 64 + d] = oacc[qt][db][i] * inv;
                }
            if (h2 == 0) ((float*)(p.ws + OFF_LSE))[((size_t)grp * T_ + tq[qt]) * 8 + head] = mrun[qt] + log2f(lt);
        }
    }
}

__device__ __forceinline__ void dil_combine_phase(PRef p, int bid, int nb) {
    const float* OD = (const float*)(p.ws + OFF_OD); const float* LSE = (const float*)(p.ws + OFF_LSE);
    bf16_t* CC = (bf16_t*)(p.ws + OFF_CC);
    const long n = (long)T_ * 128;
    for (long c = (long)bid * NTHR + otid(); c < n; c += (long)nb * NTHR) {
        const long t = c >> 7; const int ch = (int)(c & 127) * 4, hd = ch >> 6;
        const float l0 = LSE[((size_t)0 * T_ + t) * 8 + hd], l1 = LSE[((size_t)1 * T_ + t) * 8 + hd], l2 = LSE[((size_t)2 * T_ + t) * 8 + hd];
        const float mx = fmaxf(l0, fmaxf(l1, l2));
        const float w0 = exp2f(l0 - mx), w1 = exp2f(l1 - mx), w2 = exp2f(l2 - mx);
        const float inv = 1.f / (w0 + w1 + w2);
        const f32x4 a = *(const f32x4*)(OD + ((size_t)0 * T_ + t) * 512 + ch), bq = *(const f32x4*)(OD + ((size_t)1 * T_ + t) * 512 + ch),
                    cq = *(const f32x4*)(OD + ((size_t)2 * T_ + t) * 512 + ch);
        const f32x4 o = (a * w0 + bq * w1 + cq * w2) * inv;
        u32x2 w; w.x = pk2(o[0], o[1]); w.y = pk2(o[2], o[3]);
        *(u32x2*)(CC + (size_t)t * 1024 + 512 + ch) = w;
    }
}

constexpr int DA_ROW = 144;
constexpr int DA_TILE = 64 * DA_ROW;
__device__ __forceinline__ void dsa_attn_item(PRef p, int b, int head, int qb, char* smem) {
    const bf16_t* PO = (const bf16_t*)(p.ws + OFF_PO);
    const bf16_t* VT = (const bf16_t*)(p.ws + OFF_VTC) + ((size_t)(b * 8 + head)) * 64 * L_;
    const int tid = otid(), lane = tid & 63, wave = tid >> 6, r = lane & 31, h2 = lane >> 5;
    const int pr = (r & 0x13) | ((r & 4) << 1) | ((r & 8) >> 1);
    const float SC = 0.125f * 1.4426950408889634f;
    const int i0 = qb * 256 + wave * 32, qi = i0 + r;
    const unsigned long long* BMT = (const unsigned long long*)(p.ws + OFF_BM) + (size_t)b * 256 * L_ + qi;
    const size_t tq = (size_t)b * L_ + qi;
    bf16x8 qf[4];
#pragma unroll
    for (int s = 0; s < 4; ++s) qf[s] = *(const bf16x8*)(PO + tq * OD_N + head * 64 + s * 16 + h2 * 8);
    f32x16 oacc[2];
#pragma unroll
    for (int c = 0; c < 2; ++c)
#pragma unroll
        for (int i = 0; i < 16; ++i) oacc[c][i] = 0.f;
    float mrun = -1e30f, lrun = 0.f;
    const int nkt = qb * 4 + 4, my_last = (i0 + 31) >> 6;
    const int srow = tid >> 3, sch = tid & 7;
    const bf16_t* ksrc = PO + ((size_t)b * L_ + srow) * OD_N + 512 + head * 64 + sch * 8;
    const bf16_t* vsrc = VT + (size_t)srow * L_ + sch * 8;
    u32x4 rk = *(const u32x4*)ksrc, rv = *(const u32x4*)vsrc;
    __syncthreads();
    *(u32x4*)(smem + srow * DA_ROW + sch * 16) = rk;
    *(u32x4*)(smem + DA_TILE + srow * DA_ROW + sch * 16) = rv;
    __syncthreads();
    unsigned long long mwn = BMT[0];
#pragma unroll 1
    for (int kt = 0; kt < nkt; ++kt) {
        const bool more = kt + 1 < nkt;
        if (more) { rk = *(const u32x4*)(ksrc + (size_t)(kt + 1) * 64 * OD_N); rv = *(const u32x4*)(vsrc + (kt + 1) * 64); }
        const unsigned long long mw64 = mwn;
        if (kt < my_last) mwn = BMT[(size_t)(kt + 1) * L_];
        if (kt <= my_last) {
            const char* kb = smem + (kt & 1) * 2 * DA_TILE; const char* vb = kb + DA_TILE;
#pragma unroll
            for (int sub = 0; sub < 2; ++sub) {
                const unsigned mw = sub == 0 ? (unsigned)mw64 : (unsigned)(mw64 >> 32);
                bf16x8 kf[4], vf[2][2];
#pragma unroll
                for (int s = 0; s < 4; ++s) kf[s] = *(const bf16x8*)(kb + (sub * 32 + pr) * DA_ROW + (s * 16 + h2 * 8) * 2);
#pragma unroll
                for (int db = 0; db < 2; ++db)
#pragma unroll
                    for (int s2 = 0; s2 < 2; ++s2) vf[db][s2] = *(const bf16x8*)(vb + (db * 32 + r) * DA_ROW + (sub * 32 + s2 * 16 + h2 * 8) * 2);
                f32x16 s;
#pragma unroll
                for (int i = 0; i < 16; ++i) s[i] = 0.f;
#pragma unroll
                for (int ks = 0; ks < 4; ++ks) s = __builtin_amdgcn_mfma_f32_32x32x16_bf16(kf[ks], qf[ks], s, 0, 0, 0);
                float mx = fmaxf(fmaxf(s[0], s[1]), fmaxf(s[2], s[3]));
#pragma unroll
                for (int i = 4; i < 16; i += 2) mx = fmaxf(mx, fmaxf(s[i], s[i + 1]));
                mx = fmaxf(mx, __shfl_xor(mx, 32, 64)) * SC;
                if (__builtin_amdgcn_ballot_w64(mx > mrun) != 0ull) {
                    const float mnew = fmaxf(mrun, mx);
                    const float corr = __builtin_amdgcn_exp2f(mrun - mnew);
                    mrun = mnew; lrun *= corr;
#pragma unroll
                    for (int db = 0; db < 2; ++db)
#pragma unroll
                        for (int i = 0; i < 16; ++i) oacc[db][i] *= corr;
                }
                float ps = 0.f;
                const int mws = (int)(mw >> (8 * h2));
#pragma unroll
                for (int i = 0; i < 16; ++i) {
                    const int ko = 16 * (i >> 3) + 4 * ((i >> 2) & 1) + (i & 3);
                    const float e = __builtin_amdgcn_exp2f(__builtin_fmaf(s[i], SC, -mrun));
                    s[i] = __uint_as_float(__float_as_uint(e) & (unsigned)__builtin_amdgcn_sbfe(mws, ko, 1));
                    ps += s[i];
                }
                lrun += ps;
#pragma unroll
                for (int s2 = 0; s2 < 2; ++s2) {
                    u32x4 pw; pw.x = pk2(s[8 * s2], s[8 * s2 + 1]); pw.y = pk2(s[8 * s2 + 2], s[8 * s2 + 3]); pw.z = pk2(s[8 * s2 + 4], s[8 * s2 + 5]); pw.w = pk2(s[8 * s2 + 6], s[8 * s2 + 7]);
                    const bf16x8 pf = __builtin_bit_cast(bf16x8, pw);
#pragma unroll
                    for (int db = 0; db < 2; ++db) oacc[db] = __builtin_amdgcn_mfma_f32_32x32x16_bf16(vf[db][s2], pf, oacc[db], 0, 0, 0);
                }
            }
        }
        if (more) {
            char* nbuf = smem + ((kt + 1) & 1) * 2 * DA_TILE;
            *(u32x4*)(nbuf + srow * DA_ROW + sch * 16) = rk;
            *(u32x4*)(nbuf + DA_TILE + srow * DA_ROW + sch * 16) = rv;
        }
        __syncthreads();
    }
    const float lt = lrun + __shfl_xor(lrun, 32, 64);
    const float inv = 1.f / lt;
    bf16_t* CC = (bf16_t*)(p.ws + OFF_CC);
#pragma unroll
    for (int db = 0; db < 2; ++db)
#pragma unroll
        for (int i = 0; i < 16; i += 4) {
            const int d = db * 32 + 8 * (i >> 2) + 4 * h2;
            u32x2 w; w.x = pk2(oacc[db][i] * inv, oacc[db][i + 1] * inv); w.y = pk2(oacc[db][i + 2] * inv, oacc[db][i + 3] * inv);
            *(u32x2*)(CC + tq * 1024 + head * 64 + d) = w;
        }
}


enum { K_PRO = 0, K_E1, K_E2, K_E3, K_E4, K_E5, K_E6, K_LN1, K_O1, K_O2, K_O3, K_O4, K_M1, K_M2, K_M3, K_M4, K_LN2, K_COUNT };

template <int KIND, bool NOEPI = false>
__device__ __forceinline__ void run_phase(PRef p, int layer, char* smem, int bid, int nb) {
    char* ws = p.ws;
    const int j = layer >> 1;
    if (KIND == K_PRO) {
        conv_phase(p, smem, bid, nb);
        __syncthreads();
        for (int u = nb - 1 - bid; u < 64; u += nb) s5mat_unit(p, u >> 5, u & 31, smem);
    } else if (KIND == K_E1) {
        gemm256_phase((const bf16_t*)(ws + OFF_XB), 1024, T_, (const bf16_t*)(ws + OFF_WT_EVIN) + (size_t)j * EV_N * 1024, 1024, EV_N, 1024, smem, bid, nb,
                   [&](f32x4 (&acc)[4][2], int row0, int c0, int fr, int fq) { epi_ev_in(p, acc, row0, c0, fr, fq); });
    } else if (KIND == K_E2) {
        for (int it = bid; it < 2048; it += nb) gla_a_item(p, j, it, smem);
        s5_g_phase(p, j, smem, bid, nb);
    } else if (KIND == K_E3) {
        scan_phase(p, j, bid);
    } else if (KIND == K_E4) {
        for (int it = bid; it < 2048; it += nb) gla_c_item(p, j, it, smem);
        s5_y_phase(p, j, smem, bid, nb);
    } else if (KIND == K_E5) {
        const bf16_t* YA = (const bf16_t*)(ws + OFF_YA); bf16_t* CC = (bf16_t*)(ws + OFF_CC); const float* bg = p.s5_b_glu + (size_t)j * 512;
        gemm256_phase(YA, 512, T_, (const bf16_t*)(ws + OFF_WT_GLU) + (size_t)j * 512 * 512, 512, 512, 512, smem, bid, nb,
                   [&](f32x4 (&acc)[4][2], int row0, int c0, int fr, int fq) {
                       const int col = c0 + 8 * fq;
                       const f32x4 g0 = *(const f32x4*)(bg + col), g1 = *(const f32x4*)(bg + col + 4);
#pragma unroll
                       for (int m = 0; m < 4; ++m) {
                           const size_t t = (size_t)(row0 + m * 16 + fr);
                           const u32x4 yw = *(const u32x4*)(YA + t * 512 + col);
                           float o[8];
#pragma unroll
                           for (int q = 0; q < 4; ++q) {
                               const unsigned y2 = q == 0 ? yw.x : q == 1 ? yw.y : q == 2 ? yw.z : yw.w;
                               const float y0 = __uint_as_float(y2 << 16), y1 = __uint_as_float(y2 & 0xffff0000u);
                               const float a0 = q < 2 ? acc[m][0][2 * q] + g0[2 * q] : acc[m][1][2 * q - 4] + g1[2 * q - 4];
                               const float a1 = q < 2 ? acc[m][0][2 * q + 1] + g0[2 * q + 1] : acc[m][1][2 * q - 3] + g1[2 * q - 3];
                               o[2 * q] = y0 * sigmoidf_(a0); o[2 * q + 1] = y1 * sigmoidf_(a1);
                           }
                           u32x4 w; w.x = pk2(o[0], o[1]); w.y = pk2(o[2], o[3]); w.z = pk2(o[4], o[5]); w.w = pk2(o[6], o[7]);
                           *(u32x4*)(CC + t * 1024 + 512 + col) = w;
                       }
                   });
    } else if (KIND == K_E6 || KIND == K_O4) {
        float* MIX = (float*)(ws + OFF_MIX);
        const bf16_t* W = (const bf16_t*)(ws + (KIND == K_E6 ? OFF_WT_EVOUT : OFF_WT_ODOUT)) + (size_t)j * 1024 * 1024;
        gemm256_phase((const bf16_t*)(ws + OFF_CC), 1024, T_, W, 1024, 1024, 1024, smem, bid, nb,
                   [&](f32x4 (&acc)[4][2], int row0, int c0, int fr, int fq) {
#pragma unroll
                       for (int m = 0; m < 4; ++m) {
                           float* o = MIX + (size_t)(row0 + m * 16 + fr) * 1024 + c0 + 8 * fq;
                           *(f32x4*)o = acc[m][0]; *(f32x4*)(o + 4) = acc[m][1];
                       }
                   });
    } else if (KIND == K_LN1) {
        const float* xin = layer == 0 ? p.x : (const float*)(ws + OFF_XR);
        ln1_router_phase(p, layer, xin, smem, bid, nb);
    } else if (KIND == K_O1) {
        gemm256_phase((const bf16_t*)(ws + OFF_XB), 1024, T_, (const bf16_t*)(ws + OFF_WT_ODIN) + (size_t)j * OD_N * 1024, 1024, OD_N, 1024, smem, bid, nb,
                   [&](f32x4 (&acc)[4][2], int row0, int c0, int fr, int fq) { epi_od_in(p, acc, row0, c0, fr, fq); });
    } else if (KIND == K_O2) {
        for (int k = bid; k < 256; k += nb) {
            dsa_select_item(p, k & 1, k >> 1, smem);
            __syncthreads();
            const int k2 = 511 - k;
            dsa_select_item(p, k2 & 1, k2 >> 1, smem);
            __syncthreads();
        }
        const int head = otid() >> 6;
        for (int it = bid; it < 1536; it += nb) {
            const int b = it / 768, rem = it - b * 768, g = rem >> 8, u = rem & 255;
            const int sh = g * 2, per = 256 >> sh, rho = u / per, qblk = u - rho * per;
            const bf16_t* VT = (const bf16_t*)(ws + OFF_VTD) + ((size_t)((b * 3 + g) * 8 + head)) * 64 * L_;
#pragma unroll 1
            for (int hf = 0; hf < 2; ++hf) {
                const int hi = 2 * qblk + hf, lo = hi - 4;
                attn_wave<1, 1>(p, b, head, OD_DIL + g * 512, OD_DIL + 1536 + g * 512, VT, rho * (L_ >> sh), qblk * 64 + hf * 32, sh, rho, lo < 0 ? 0 : lo, hi, g);
            }
        }
    } else if (KIND == K_O3) {
        for (int k = bid; k < 512; k += nb) {
            const int bh = k >> 5, q0 = k & 31;
#pragma unroll 1
            for (int half = 0; half < 2; ++half) dsa_attn_item(p, bh >> 3, bh & 7, half == 0 ? q0 : 63 - q0, smem);
        }
        dil_combine_phase(p, bid, nb);
    } else if (KIND == K_M1) {
        float* LG = (float*)(ws + OFF_LOGIT); const float* rb = p.router_b + (size_t)layer * 32;
        gemm_phase((const bf16_t*)(ws + OFF_XB), 1024, T_, (const bf16_t*)(ws + OFF_WT_RT) + (size_t)layer * 128 * 1024, 1024, 128, 1024, smem, bid, nb,
                   [&](f32x4 (&acc)[4][2], int row0, int c0, int fr, int fq) {
#pragma unroll
                       for (int n = 0; n < 2; ++n) {
                           const int col = c0 + n * 16 + fr;
                           if (col < 32) {
#pragma unroll
                               for (int m = 0; m < 4; ++m)
#pragma unroll
                                   for (int r = 0; r < 4; ++r) LG[(size_t)(row0 + m * 16 + fq * 4 + r) * 32 + col] = acc[m][n][r] + rb[col];
                           }
                       }
                   });
    } else if (KIND == K_M2) {
        topk_phase(p, layer, bid, nb);
    } else if (KIND == K_M3) {
        moe_gemm_phase<1, NOEPI>(p, layer, smem, bid, nb);
    } else if (KIND == K_M4) {
        moe_gemm_phase<2, NOEPI>(p, layer, smem, bid, nb);
    } else if (KIND == K_LN2) {
        float* xo = layer == 3 ? p.out : (float*)(ws + OFF_XR);
        ln_phase<true>(p, (const float*)(ws + OFF_XR), (const float*)(ws + OFF_SLOT), p.ln2_g + (size_t)layer * 1024, p.ln2_b + (size_t)layer * 1024, xo,
                       layer == 3 ? (bf16_t*)nullptr : (bf16_t*)(ws + OFF_XB), bid, nb);
    }
}

extern __shared__ __attribute__((aligned(16))) char dyn_smem[];

#if !MEGA
template <int KIND>
__global__ void __launch_bounds__(NTHR, 2) k_phase(Params p, int layer) { run_phase<KIND>(p, layer, dyn_smem, blockIdx.x, gridDim.x); }
#else
#ifndef DUPMASK
#define DUPMASK 0
#endif
typedef const __attribute__((address_space(4))) Params* KParams;
#define RUNP(K) do { KParams _q = kp0; asm volatile("" : "+s"(_q)); run_phase<K>(*_q, layer, smem, bid, nb); } while (0)
#ifndef DUPNOEPI
#define DUPNOEPI 0
#endif
#define RUNP2(K) do { KParams _q = kp0; asm volatile("" : "+s"(_q)); run_phase<K, (DUPNOEPI != 0)>(*_q, layer, smem, bid, nb); } while (0)
#define PHASE(K) do { RUNP(K); xcd_barrier(bar); if ((DUPMASK >> K) & 1) { RUNP2(K); xcd_barrier(bar); } } while (0)
template <int LAYER>
__device__ __forceinline__ void mega_layer(KParams kp0, char* smem, int bid, int nb, const XcdBarrier& bar) {
    constexpr int layer = LAYER;
    if ((layer & 1) == 0) { PHASE(K_E1); PHASE(K_E2); PHASE(K_E3); PHASE(K_E4); PHASE(K_E5); PHASE(K_E6); }
    else { PHASE(K_O1); PHASE(K_O2); PHASE(K_O3); PHASE(K_O4); }
    PHASE(K_LN1); PHASE(K_M3); PHASE(K_M4);
    RUNP(K_LN2);
    if (layer < 3) xcd_barrier(bar);
}
__global__ void __launch_bounds__(NTHR, 2) k_mega(Params p) {
    char* smem = dyn_smem;
    const int bid = blockIdx.x, nb = gridDim.x;
    volatile LAS unsigned* st = (volatile LAS unsigned*)(dyn_smem + LDS_BYTES - 16);
    if (otid() == 0) { st[0] = 0u; st[1] = 0u; }
    __syncthreads();
    KParams kp0 = (KParams)__builtin_amdgcn_kernarg_segment_ptr();
    XcdBarrier bar = xcd_barrier_post((unsigned*)(kp0->ws + OFF_BAR), st);
    { const int layer = 0; PHASE(K_PRO); }
    mega_layer<0>(kp0, smem, bid, nb, bar);
    mega_layer<1>(kp0, smem, bid, nb, bar);
    mega_layer<2>(kp0, smem, bid, nb, bar);
    mega_layer<3>(kp0, smem, bid, nb, bar);
}
#endif

extern "C" void kernel_launch(void* const* d_in, const int* in_sizes, int n_in, void* d_out, int out_size, void* d_ws, size_t ws_size, hipStream_t stream) {
    Params p{};
    const float** f = (const float**)&p;
    for (int i = 0; i < 28; ++i) f[i] = (const float*)d_in[i];
    p.out = (float*)d_out; p.ws = (char*)d_ws;
    if (ws_size < WS_NEED) { fprintf(stderr, "workspace too small: %zu < %zu\n", ws_size, (size_t)WS_NEED); return; }
#if !MEGA
#define SETATTR(K) hipFuncSetAttribute((const void*)k_phase<K>, hipFuncAttributeMaxDynamicSharedMemorySize, LDS_BYTES)
#define LAUNCH(K, layer) k_phase<K><<<256, NTHR, LDS_BYTES, stream>>>(p, layer)
    static bool attr_done = false;
    if (!attr_done) {
        SETATTR(K_PRO); SETATTR(K_E1); SETATTR(K_E2); SETATTR(K_E3); SETATTR(K_E4); SETATTR(K_E5); SETATTR(K_E6); SETATTR(K_LN1); SETATTR(K_O1); SETATTR(K_O2); SETATTR(K_O3);
        SETATTR(K_O4); SETATTR(K_M1); SETATTR(K_M2); SETATTR(K_M3); SETATTR(K_M4); SETATTR(K_LN2);
        attr_done = true;
    }
    LAUNCH(K_PRO, 0);
    for (int layer = 0; layer < 4; ++layer) {
        if ((layer & 1) == 0) { LAUNCH(K_E1, layer); LAUNCH(K_E2, layer); LAUNCH(K_E3, layer); LAUNCH(K_E4, layer); LAUNCH(K_E5, layer); LAUNCH(K_E6, layer); }
        else { LAUNCH(K_O1, layer); LAUNCH(K_O2, layer); LAUNCH(K_O3, layer); LAUNCH(K_O4, layer); }
        LAUNCH(K_LN1, layer); LAUNCH(K_M3, layer); LAUNCH(K_M4, layer); LAUNCH(K_LN2, layer);
    }
#else
    static int grid = 0;
    if (!grid) {
        hipFuncSetAttribute((const void*)k_mega, hipFuncAttributeMaxDynamicSharedMemorySize, LDS_BYTES);
        int dev = 0, cus = 0, per_cu = 0;
        hipGetDevice(&dev);
        hipDeviceGetAttribute(&cus, hipDeviceAttributeMultiprocessorCount, dev);
        hipOccupancyMaxActiveBlocksPerMultiprocessor(&per_cu, (const void*)k_mega, NTHR, LDS_BYTES);
        grid = cus * (per_cu < 1 ? per_cu : 1);
        if (grid <= 0) grid = 0;
    }
    if (!grid) { fprintf(stderr, "occupancy query says 0 blocks per CU\n"); return; }
    hipMemsetAsync((char*)d_ws + OFF_BAR, 0, XCD_BAR_WORDS * sizeof(unsigned), stream);
    k_mega<<<grid, NTHR, LDS_BYTES, stream>>>(p);
#endif
}
```

```cpp
#include <hip/hip_runtime.h>
#include <stdint.h>
#include <stdio.h>

#ifndef MEGA
#define MEGA 1
#define DUPMASK 0
#define DUPNOEPI 0
#endif

typedef unsigned short bf16_t;
typedef short bf16x8 __attribute__((ext_vector_type(8)));
typedef float f32x4 __attribute__((ext_vector_type(4)));
typedef float f32x16 __attribute__((ext_vector_type(16)));
typedef unsigned u32x4 __attribute__((ext_vector_type(4)));
typedef unsigned u32x2 __attribute__((ext_vector_type(2)));

constexpr int T_ = 32768, D_ = 1024, L_ = 16384, NB_ = 2;
constexpr int NTHR = 512;
constexpr float ALPHA = 1.681792830507429f;
constexpr float LN_EPS = 1e-5f;
constexpr int EV_N = 2304;
constexpr int EV_P = 1792;
constexpr int PE_W = 1024;
constexpr int OD_N = 6656;
constexpr int OD_P = 4608;
constexpr int OD_QI = 1024, OD_DIL = 1280, OD_KI = 4352, OD_WI = 4416;
constexpr int UHW = 1152;
constexpr int LISTCAP = 131072;

constexpr size_t OFF_BAR = 0;
constexpr size_t OFF_CNT = 16384;
constexpr size_t OFF_A64 = 32768;
constexpr size_t OFF_WT_EVIN = 131072;
constexpr size_t OFF_WT_ODIN = OFF_WT_EVIN + (size_t)2 * EV_N * 1024 * 2;
constexpr size_t OFF_WT_EVOUT = OFF_WT_ODIN + (size_t)2 * OD_N * 1024 * 2;
constexpr size_t OFF_WT_ODOUT = OFF_WT_EVOUT + (size_t)2 * 1024 * 1024 * 2;
constexpr size_t OFF_WT_GLU = OFF_WT_ODOUT + (size_t)2 * 1024 * 1024 * 2;
constexpr size_t OFF_WT_RT = OFF_WT_GLU + (size_t)2 * 512 * 512 * 2;
constexpr size_t OFF_WT_W1 = OFF_WT_RT + (size_t)4 * 128 * 1024 * 2;
constexpr size_t OFF_WT_W2 = OFF_WT_W1 + (size_t)4 * 32 * 2048 * 1024 * 2;
constexpr size_t OFF_TH = OFF_WT_W2 + (size_t)4 * 32 * 1024 * 1024 * 2;
constexpr size_t OFF_GM = OFF_TH + (size_t)2 * 32 * 1024 * UHW * 2;
constexpr size_t OFF_XR = OFF_GM + (size_t)2 * 32 * 128 * 1024 * 2;
constexpr size_t OFF_XB = OFF_XR + (size_t)T_ * 1024 * 4;
constexpr size_t OFF_MIX = OFF_XB + (size_t)T_ * 1024 * 2;
constexpr size_t OFF_CC = OFF_MIX + (size_t)T_ * 1024 * 4;
constexpr size_t OFF_LOGIT = OFF_CC + (size_t)T_ * 1024 * 2;
constexpr size_t OFF_LIST = OFF_LOGIT + (size_t)T_ * 32 * 4;
constexpr size_t OFF_GATE = OFF_LIST + (size_t)32 * LISTCAP * 4;
constexpr size_t OFF_ACT = OFF_GATE + (size_t)T_ * 4 * 4;
constexpr size_t OFF_SLOT = OFF_ACT + (size_t)T_ * 4 * 1024 * 2;
constexpr size_t OFF_MIXER = OFF_SLOT + (size_t)T_ * 4 * 1024 * 4;
constexpr size_t OFF_PE = OFF_MIXER;
constexpr size_t OFF_UH = OFF_PE + (size_t)T_ * 1536 * 2;
constexpr size_t OFF_GLR = OFF_UH + (size_t)(T_ / 64) * 32 * UHW * 2;
constexpr size_t OFF_VTE = OFF_GLR + (size_t)T_ * 16 * 4;
constexpr size_t OFF_KV = OFF_VTE + (size_t)2 * 4 * 128 * L_ * 2;
constexpr size_t OFF_SST = OFF_KV + (size_t)2 * 256 * 4 * 64 * 128 * 4;
constexpr size_t OFF_DEC = OFF_SST + (size_t)2 * 256 * 4 * 64 * 128 * 4;
constexpr size_t OFF_GBUF = OFF_DEC + (size_t)2 * 256 * 4 * 64 * 4;
constexpr size_t OFF_YA = OFF_GBUF + (size_t)512 * 32 * 128 * 4;
constexpr size_t END_EVEN = OFF_YA + (size_t)T_ * 512 * 2;
constexpr size_t OFF_PO = OFF_MIXER;
constexpr size_t OFF_WI = OFF_PO + (size_t)T_ * OD_N * 2;
constexpr size_t OFF_VTC = OFF_WI + (size_t)T_ * 4 * 4;
constexpr size_t OFF_VTD = OFF_VTC + (size_t)2 * 8 * 64 * L_ * 2;
constexpr size_t OFF_BM = OFF_VTD + (size_t)2 * 3 * 8 * 64 * L_ * 2;
constexpr size_t OFF_OD = OFF_BM + (size_t)T_ * 256 * 8;
constexpr size_t OFF_LSE = OFF_OD + (size_t)3 * T_ * 512 * 4;
constexpr size_t END_ODD = OFF_LSE + (size_t)3 * T_ * 8 * 4;
constexpr size_t WS_NEED = END_ODD > END_EVEN ? END_ODD : END_EVEN;
static_assert(WS_NEED < (size_t)4200000000ull, "workspace too large");

constexpr int LDS_BYTES = 153600;

struct Params {
    const float *x, *ev_w_in, *gla_w_gate2, *gla_b_gate2, *gla_norm_g, *s5_a_re, *s5_a_im, *s5_log_dt, *s5_b_re, *s5_b_im, *s5_c_re, *s5_c_im, *s5_d,
        *s5_w_glu, *s5_b_glu, *ev_w_out, *od_w_in, *od_w_out, *ln1_g, *ln1_b, *ln2_g, *ln2_b, *router_w, *router_b, *moe_w1, *moe_b1, *moe_w2, *moe_b2;
    float* out;
    char* ws;
};

#if MEGA
typedef const __attribute__((address_space(4))) Params& PRef;
#else
typedef const Params& PRef;
#endif

__device__ __forceinline__ unsigned pk2(float lo, float hi) { unsigned r; asm("v_cvt_pk_bf16_f32 %0, %1, %2" : "=v"(r) : "v"(lo), "v"(hi)); return r; }
__device__ __forceinline__ bf16_t f2bf(float f) { return (bf16_t)(pk2(f, 0.f) & 0xffffu); }
__device__ __forceinline__ float bf2f(bf16_t h) { return __uint_as_float(((unsigned)h) << 16); }
__device__ __forceinline__ float sigmoidf_(float x) { return __builtin_amdgcn_rcpf(1.f + __expf(-x)); }
template <int CTRL> __device__ __forceinline__ float dppf(float v) { return __int_as_float(__builtin_amdgcn_update_dpp(0, __float_as_int(v), CTRL, 0xF, 0xF, false)); }
constexpr int DPP_X1 = 0xB1  , DPP_X2 = 0x4E  , DPP_HMIR = 0x141  , DPP_MIR = 0x140  , DPP_ROR8 = 0x128;
__device__ __forceinline__ float xor16_sum(float v) { const unsigned u = __float_as_uint(v); auto r = __builtin_amdgcn_permlane16_swap(u, u, false, false); return __uint_as_float(r[0]) + __uint_as_float(r[1]); }
__device__ __forceinline__ float xor16_max(float v) { const unsigned u = __float_as_uint(v); auto r = __builtin_amdgcn_permlane16_swap(u, u, false, false); return fmaxf(__uint_as_float(r[0]), __uint_as_float(r[1])); }
__device__ __forceinline__ float xor32_sum_(float v) { const unsigned u = __float_as_uint(v); auto r = __builtin_amdgcn_permlane32_swap(u, u, false, false); return __uint_as_float(r[0]) + __uint_as_float(r[1]); }
__device__ __forceinline__ float xor32_max_(float v) { const unsigned u = __float_as_uint(v); auto r = __builtin_amdgcn_permlane32_swap(u, u, false, false); return fmaxf(__uint_as_float(r[0]), __uint_as_float(r[1])); }
__device__ __forceinline__ float wave_sum(float v) {
    v += dppf<DPP_X1>(v); v += dppf<DPP_X2>(v); v += dppf<DPP_HMIR>(v); v += dppf<DPP_MIR>(v);
    return xor32_sum_(xor16_sum(v));
}
__device__ __forceinline__ float wave_max(float v) {
    v = fmaxf(v, dppf<DPP_X1>(v)); v = fmaxf(v, dppf<DPP_X2>(v)); v = fmaxf(v, dppf<DPP_HMIR>(v)); v = fmaxf(v, dppf<DPP_MIR>(v));
    return xor32_max_(xor16_max(v));
}
__device__ __forceinline__ float gelu_tanh(float x) {
    const float k0 = 0.7978845608028654f, k1 = 0.044715f;
    float u = k0 * (x + k1 * x * x * x);
    float t = 1.f - 2.f * __builtin_amdgcn_rcpf(1.f + __expf(2.f * u));
    return 0.5f * x * (1.f + t);
}
__device__ __forceinline__ float xor32_max(float v) { const unsigned u = __float_as_uint(v); auto r = __builtin_amdgcn_permlane32_swap(u, u, false, false); return fmaxf(__uint_as_float(r[0]), __uint_as_float(r[1])); }
__device__ __forceinline__ float xor32_sum(float v) { const unsigned u = __float_as_uint(v); auto r = __builtin_amdgcn_permlane32_swap(u, u, false, false); return __uint_as_float(r[0]) + __uint_as_float(r[1]); }
__device__ __forceinline__ unsigned xor32_or(unsigned u) { auto r = __builtin_amdgcn_permlane32_swap(u, u, false, false); return r[0] | r[1]; }
__device__ __forceinline__ int otid() { int t = threadIdx.x; asm volatile("" : "+v"(t)); return t; }

#define XB_TMO      128
#define XB_XCNT(j)  (256  + 64 * (j))
#define XB_XSUB(j)  (1280 + 64 * (j))
#define XB_XGEN(j)  (2304 + 64 * (j))
#define XB_TOP      3328
#define XB_TOPGEN   3392
#define XCD_BAR_WORDS 3456
#define XB_SPIN_CAP (1u << 21)
#define LAS __attribute__((address_space(3)))

__device__ __forceinline__ unsigned xb_ld(unsigned* p)              { return __hip_atomic_load(p, __ATOMIC_RELAXED, __HIP_MEMORY_SCOPE_AGENT); }
__device__ __forceinline__ unsigned xb_add(unsigned* p, unsigned v) { return __hip_atomic_fetch_add(p, v, __ATOMIC_RELAXED, __HIP_MEMORY_SCOPE_AGENT); }
__device__ __forceinline__ unsigned xb_xcc_id() { return (unsigned)__builtin_amdgcn_s_getreg((3 << 11) | 20) & 0xFu; }
#define XB_SPIN(cond, bar) do { unsigned _sp = 0; while (cond) { __builtin_amdgcn_s_sleep(1); \
    if ((++_sp & 255u) == 0u) { if (xb_ld(&(bar)[XB_TMO])) break; if (_sp > XB_SPIN_CAP) { atomicAdd(&(bar)[XB_TMO], 1u); break; } } } } while (0)

struct XcdBarrier { unsigned* bar; unsigned x; volatile LAS unsigned* st; };

__device__ __forceinline__ XcdBarrier xcd_barrier_post(unsigned* bar, volatile LAS unsigned* st) {
    XcdBarrier b; b.bar = bar; b.x = xb_xcc_id(); b.st = st;
    if (threadIdx.x == 0) (void)xb_add(&bar[XB_XCNT(b.x)], 1u);
    return b;
}
__device__ __forceinline__ void xcd_barrier_complete(unsigned* bar, unsigned x, unsigned& nloc, unsigned& nx) {
    const unsigned G = gridDim.x * gridDim.y * gridDim.z;
    unsigned sum, cnt, mine, sp = 0u;
    for (;;) {
        sum = 0u; cnt = 0u; mine = 0u;
#pragma unroll
        for (unsigned j = 0; j < 16; ++j) { const unsigned c = xb_ld(&bar[XB_XCNT(j)]); sum += c; cnt += (c > 0u) ? 1u : 0u; mine = (j == x) ? c : mine; }
        if (sum == G) break;
        __builtin_amdgcn_s_sleep(1);
        if ((++sp & 255u) == 0u) { if (xb_ld(&bar[XB_TMO])) break; if (sp > XB_SPIN_CAP) { atomicAdd(&bar[XB_TMO], 1u); break; } }
    }
    nloc = mine > 0u ? mine : 1u; nx = cnt > 0u ? cnt : 1u;
}
__device__ __forceinline__ void xcd_barrier(const XcdBarrier& b) {
    asm volatile("s_waitcnt vmcnt(0)" ::: "memory");
    __syncthreads();
    if (threadIdx.x == 0) {
        unsigned* bar = b.bar;
        __builtin_amdgcn_s_waitcnt(0);
        unsigned nloc = b.st[0], nx = b.st[1];
        if (nloc == 0u) { xcd_barrier_complete(bar, b.x, nloc, nx); b.st[0] = nloc; b.st[1] = nx; }
        const unsigned old = xb_add(&bar[XB_XSUB(b.x)], 1u);
        const unsigned gen = old / nloc;
        if (old + 1u == (gen + 1u) * nloc) {
            __builtin_amdgcn_fence(__ATOMIC_RELEASE, "agent");
            asm volatile("s_waitcnt vmcnt(0)" ::: "memory");
            const unsigned og = xb_add(&bar[XB_TOP], 1u);
            const unsigned tg = og / nx;
            if (og + 1u == (tg + 1u) * nx) xb_add(&bar[XB_TOPGEN], 1u);
            else XB_SPIN(xb_ld(&bar[XB_TOPGEN]) == tg, bar);
            __builtin_amdgcn_fence(__ATOMIC_ACQUIRE, "agent");
            xb_add(&bar[XB_XGEN(b.x)], 1u);
            asm volatile("s_waitcnt vmcnt(0)" ::: "memory");
        } else {
            XB_SPIN(xb_ld(&bar[XB_XGEN(b.x)]) == gen, bar);
            __builtin_amdgcn_fence(__ATOMIC_ACQUIRE, "agent");
            asm volatile("s_waitcnt vmcnt(0)" ::: "memory");
        }
    }
    __syncthreads();
}

constexpr int G_LROW = 144;
constexpr int G_ASZ = 256 * G_LROW;
constexpr int G_BSZ = 128 * G_LROW;
constexpr int G_STAGE = G_ASZ + G_BSZ;
constexpr int G_ROWS_OFF = 2 * G_STAGE;

template <bool GATHER, class Epi>
__device__ __forceinline__ void gemm_tile(const bf16_t* __restrict__ A, long lda, int shift, int m0, const bf16_t* __restrict__ Bt, long ldb, int n0, int K,
                                          char* smem, Epi&& epi) {
    const int tid = otid(), lane = tid & 63, wave = tid >> 6, wr = wave >> 1, wc = wave & 1, fr = lane & 15, fq = lane >> 4;
    const int lrow = tid >> 3, lchunk = tid & 7;
    const int* sRow = (const int*)(smem + G_ROWS_OFF);
    const bf16_t* pa[4]; const bf16_t* pb[2];
#pragma unroll
    for (int i = 0; i < 4; ++i) {
        int r = lrow + 64 * i; long arow;
        if (GATHER) { int v = sRow[r]; arow = v < 0 ? 0 : (v >> shift); } else arow = m0 + r;
        pa[i] = A + arow * lda + lchunk * 8;
    }
#pragma unroll
    for (int i = 0; i < 2; ++i) pb[i] = Bt + (long)(n0 + lrow + 64 * i) * ldb + lchunk * 8;
    f32x4 acc[4][4];
#pragma unroll
    for (int m = 0; m < 4; ++m)
#pragma unroll
        for (int n = 0; n < 4; ++n) acc[m][n] = (f32x4){0.f, 0.f, 0.f, 0.f};
    u32x4 ra[4], rb[2];
    const int nk = K >> 6;
#pragma unroll
    for (int i = 0; i < 4; ++i) ra[i] = *(const u32x4*)(pa[i]);
#pragma unroll
    for (int i = 0; i < 2; ++i) rb[i] = *(const u32x4*)(pb[i]);
    {
        char* sa = smem; char* sb = smem + G_ASZ;
#pragma unroll
        for (int i = 0; i < 4; ++i) *(u32x4*)(sa + (lrow + 64 * i) * G_LROW + lchunk * 16) = ra[i];
#pragma unroll
        for (int i = 0; i < 2; ++i) *(u32x4*)(sb + (lrow + 64 * i) * G_LROW + lchunk * 16) = rb[i];
    }
    __syncthreads();
    for (int kt = 0; kt < nk; ++kt) {
        const bool more = (kt + 1 < nk);
        if (more) {
#pragma unroll
            for (int i = 0; i < 4; ++i) ra[i] = *(const u32x4*)(pa[i] + (kt + 1) * 64);
#pragma unroll
            for (int i = 0; i < 2; ++i) rb[i] = *(const u32x4*)(pb[i] + (kt + 1) * 64);
        }
        const char* sa = smem + (kt & 1) * G_STAGE; const char* sb = sa + G_ASZ;
#pragma unroll
        for (int ks = 0; ks < 2; ++ks) {
            bf16x8 af[4], bfr[4];
#pragma unroll
            for (int m = 0; m < 4; ++m) af[m] = *(const bf16x8*)(sa + (wr * 64 + m * 16 + fr) * G_LROW + (ks * 32 + fq * 8) * 2);
#pragma unroll
            for (int n = 0; n < 4; ++n) bfr[n] = *(const bf16x8*)(sb + (wc * 64 + n * 16 + fr) * G_LROW + (ks * 32 + fq * 8) * 2);
#pragma unroll
            for (int m = 0; m < 4; ++m)
#pragma unroll
                for (int n = 0; n < 4; ++n) acc[m][n] = __builtin_amdgcn_mfma_f32_16x16x32_bf16(af[m], bfr[n], acc[m][n], 0, 0, 0);
        }
        if (more) {
            char* wa = smem + ((kt + 1) & 1) * G_STAGE; char* wb = wa + G_ASZ;
#pragma unroll
            for (int i = 0; i < 4; ++i) *(u32x4*)(wa + (lrow + 64 * i) * G_LROW + lchunk * 16) = ra[i];
#pragma unroll
            for (int i = 0; i < 2; ++i) *(u32x4*)(wb + (lrow + 64 * i) * G_LROW + lchunk * 16) = rb[i];
        }
        __syncthreads();
    }
    {
        f32x4 h0[4][2], h1[4][2];
#pragma unroll
        for (int m = 0; m < 4; ++m) { h0[m][0] = acc[m][0]; h0[m][1] = acc[m][1]; h1[m][0] = acc[m][2]; h1[m][1] = acc[m][3]; }
        epi(h0, wr * 64, n0 + wc * 64, fr, fq);
        epi(h1, wr * 64, n0 + wc * 64 + 32, fr, fq);
    }
}

template <class Epi>
__device__ __forceinline__ void gemm_phase(const bf16_t* A, long lda, int M, const bf16_t* Bt, long ldb, int N, int K, char* smem, int bid, int nb, Epi&& epi) {
    const int ntn = N / 128, ntm = M / 256, nt = ntn * ntm;
    for (int t = bid; t < nt; t += nb) {
        const int mi = t / ntn, ni = t - mi * ntn;
        gemm_tile<false>(A, lda, 0, mi * 256, Bt, ldb, ni * 128, K, smem,
                         [&](f32x4 (&acc)[4][2], int rt0, int c0, int fr, int fq) { epi(acc, mi * 256 + rt0, c0, fr, fq); });
    }
}

constexpr int G8_HT = 128 * 64 * 2;
constexpr int G8_ROWS_OFF = 8 * G8_HT;

__device__ __forceinline__ int g8_lds_byte(int r, int c) {
    const int st = (r >> 4) * 2 + (c >> 5), rr = r & 15, cc = c & 31, ob = rr * 64 + cc * 2;
    return st * 1024 + (ob ^ (((ob >> 9) & 1) << 5));
}
__device__ __forceinline__ void g8_stage_rc(int b, int& R, int& C) {
    const int st = b / 1024, sb = b % 1024, swz = sb ^ (((sb >> 9) & 1) << 5);
    R = (st >> 1) * 16 + swz / 64; C = (st & 1) * 32 + (swz % 64) / 2;
}

#define G8_SA(b, h) (lds + ((b) * 2 + (h)) * G8_HT)
#define G8_SB(b, h) (lds + (4 + (b) * 2 + (h)) * G8_HT)
#define G8_STAGE(P, RS, OFF, soff) do { \
    _Pragma("unroll") for (int _i = 0; _i < 2; ++_i) \
        __builtin_amdgcn_raw_ptr_buffer_load_lds((RS), (LAS unsigned*)((P) + tid * 16 + _i * 8192), 16, (OFF)[_i], (soff), 0, 0); } while (0)
#define G8_LDA(dst, b, h) do { _Pragma("unroll") for (int m = 0; m < 4; ++m) _Pragma("unroll") for (int k = 0; k < 2; ++k) \
    dst[m][k] = *(const LAS bf16x8*)(G8_SA(b, h) + g8_lds_byte(wr * 64 + m * 16 + fr, k * 32 + fq * 8)); } while (0)
#define G8_LDB(dst, b, h) do { _Pragma("unroll") for (int n = 0; n < 2; ++n) _Pragma("unroll") for (int k = 0; k < 2; ++k) \
    dst[n][k] = *(const LAS bf16x8*)(G8_SB(b, h) + g8_lds_byte(wc * 32 + n * 16 + fr, k * 32 + fq * 8)); } while (0)
#define G8_MMA(ai, bj, At, Bt_) do { __builtin_amdgcn_s_setprio(1); \
    _Pragma("unroll") for (int m = 0; m < 4; ++m) _Pragma("unroll") for (int n = 0; n < 2; ++n) _Pragma("unroll") for (int k = 0; k < 2; ++k) \
        acc[ai][bj][m][n] = __builtin_amdgcn_mfma_f32_16x16x32_bf16(Bt_[n][k], At[m][k], acc[ai][bj][m][n], 0, 0, 0); \
    __builtin_amdgcn_s_setprio(0); } while (0)
#define G8_WAIT_V(n) asm volatile("s_waitcnt vmcnt(" #n ")" ::: "memory")
#define G8_WAIT_L(n) asm volatile("s_waitcnt lgkmcnt(" #n ")" ::: "memory")
#define G8_BAR __builtin_amdgcn_s_barrier()
#define G8_SCHED __builtin_amdgcn_sched_barrier(0)

template <bool GATHER, class Epi>
__device__ __forceinline__ void gemm256_tile(const bf16_t* __restrict__ A, long lda, int shift, int m0, const bf16_t* __restrict__ Bt, long ldb, int n0, int K,
                                             char* smem, Epi&& epi) {
    LAS char* lds = (LAS char*)smem;
    int tid = otid();
    int wid = tid >> 6, lane = tid & 63, wr = wid >> 2, wc = wid & 3, fr = lane & 15, fq = lane >> 4;
    unsigned aoff[2][2], boff[2];
    {
        const LAS int* sRow = (const LAS int*)(lds + G8_ROWS_OFF);
#pragma unroll
        for (int i = 0; i < 2; ++i) {
            int R, C; g8_stage_rc(tid * 16 + i * 8192, R, C);
            { const int rho = R & 31, nn = rho >> 4, ii = rho & 15; const int Rp = (R & ~31) + 8 * (ii >> 2) + 4 * nn + (ii & 3);
              boff[i] = (unsigned)((long)Rp * ldb + C) * 2u; }
#pragma unroll
            for (int h = 0; h < 2; ++h) {
                long arow;
                if (GATHER) { const int v = sRow[h * 128 + R]; arow = v < 0 ? 0 : (v >> shift); } else arow = m0 + h * 128 + R;
                aoff[h][i] = (unsigned)(arow * lda + C) * 2u;
            }
        }
    }
    f32x4 acc[2][2][4][2];
#pragma unroll
    for (int a = 0; a < 2; ++a)
#pragma unroll
        for (int b = 0; b < 2; ++b)
#pragma unroll
            for (int m = 0; m < 4; ++m)
#pragma unroll
                for (int n = 0; n < 2; ++n) acc[a][b][m][n] = (f32x4){0.f, 0.f, 0.f, 0.f};
    bf16x8 At[4][2], B0[2][2], B1[2][2];
    const int nt = K / 64;
    const __amdgpu_buffer_rsrc_t rA = __builtin_amdgcn_make_buffer_rsrc((void*)A, 0, 0x7fffffff, 0x00020000);
    const __amdgpu_buffer_rsrc_t rB = __builtin_amdgcn_make_buffer_rsrc((void*)(Bt + (size_t)n0 * ldb), 0, 0x7fffffff, 0x00020000);
    const int bh = (int)(128 * ldb * 2);
    G8_STAGE(G8_SB(0, 0), rB, boff, 0); G8_STAGE(G8_SA(0, 0), rA, aoff[0], 0);
    G8_STAGE(G8_SB(0, 1), rB, boff, bh); G8_STAGE(G8_SA(0, 1), rA, aoff[1], 0);
    if (wr == 1) G8_BAR;
    G8_WAIT_V(4); G8_BAR;
    G8_STAGE(G8_SB(1, 0), rB, boff, 128); G8_STAGE(G8_SA(1, 0), rA, aoff[0], 128); G8_STAGE(G8_SB(1, 1), rB, boff, 128 + bh);
    G8_WAIT_V(6); G8_BAR;
    for (int t = 0; t < nt - 2; t += 2) {
        G8_LDB(B0, 0, 0); G8_SCHED; G8_LDA(At, 0, 0); G8_STAGE(G8_SA(1, 1), rA, aoff[1], (t + 1) * 128);
        G8_WAIT_L(8); G8_BAR; G8_WAIT_L(0); G8_MMA(0, 0, At, B0); G8_BAR; G8_SCHED;
        G8_LDB(B1, 0, 1); G8_STAGE(G8_SB(0, 0), rB, boff, (t + 2) * 128);
        G8_BAR; G8_WAIT_L(0); G8_MMA(0, 1, At, B1); G8_BAR;
        G8_LDA(At, 0, 1); G8_STAGE(G8_SA(0, 0), rA, aoff[0], (t + 2) * 128);
        G8_BAR; G8_WAIT_L(0); G8_MMA(1, 0, At, B0); G8_BAR; G8_SCHED;
        G8_STAGE(G8_SB(0, 1), rB, boff, (t + 2) * 128 + bh);
        G8_WAIT_V(6); G8_BAR; G8_MMA(1, 1, At, B1); G8_BAR;
        G8_LDB(B0, 1, 0); G8_SCHED; G8_LDA(At, 1, 0); G8_STAGE(G8_SA(0, 1), rA, aoff[1], (t + 2) * 128);
        G8_WAIT_L(8); G8_BAR; G8_WAIT_L(0); G8_MMA(0, 0, At, B0); G8_BAR; G8_SCHED;
        G8_LDB(B1, 1, 1); G8_STAGE(G8_SB(1, 0), rB, boff, (t + 3) * 128);
        G8_BAR; G8_WAIT_L(0); G8_MMA(0, 1, At, B1); G8_BAR;
        G8_LDA(At, 1, 1); G8_STAGE(G8_SA(1, 0), rA, aoff[0], (t + 3) * 128);
        G8_BAR; G8_WAIT_L(0); G8_MMA(1, 0, At, B0); G8_BAR; G8_SCHED;
        G8_STAGE(G8_SB(1, 1), rB, boff, (t + 3) * 128 + bh);
        G8_WAIT_V(6); G8_BAR; G8_MMA(1, 1, At, B1); G8_BAR;
    }
    { G8_LDB(B0, 0, 0); G8_WAIT_V(0); G8_LDA(At, 0, 0); G8_STAGE(G8_SA(1, 1), rA, aoff[1], (nt - 1) * 128);
      G8_BAR; G8_WAIT_L(0); G8_MMA(0, 0, At, B0); G8_BAR;
      G8_LDB(B1, 0, 1); G8_BAR; G8_WAIT_L(0); G8_MMA(0, 1, At, B1); G8_BAR;
      G8_LDA(At, 0, 1); G8_WAIT_V(4); G8_BAR; G8_WAIT_L(0); G8_MMA(1, 0, At, B0); G8_MMA(1, 1, At, B1); G8_BAR; }
    { G8_LDB(B0, 1, 0); G8_LDA(At, 1, 0); G8_WAIT_V(2); G8_BAR; G8_WAIT_L(0); G8_MMA(0, 0, At, B0); G8_BAR;
      G8_LDB(B1, 1, 1); G8_WAIT_V(0); G8_BAR; G8_WAIT_L(0); G8_MMA(0, 1, At, B1); G8_BAR;
      G8_LDA(At, 1, 1); G8_BAR; G8_WAIT_L(0); G8_MMA(1, 0, At, B0); G8_MMA(1, 1, At, B1); G8_BAR; }
    if (wr == 0) G8_BAR;
    int tz = otid(); wid = tz >> 6; lane = tz & 63; wr = wid >> 2; wc = wid & 3; fr = lane & 15; fq = lane >> 4;
#pragma unroll
    for (int ai = 0; ai < 2; ++ai)
#pragma unroll
        for (int bj = 0; bj < 2; ++bj) epi(acc[ai][bj], ai * 128 + wr * 64, n0 + bj * 128 + wc * 32, fr, fq);
}

struct G8Desc { const bf16_t* A; const bf16_t* Bt; const int* list; int m0, n0, count, u0, ldb; };

template <bool GATHER, int SHIFT, class Src, class Epi>
__device__ __forceinline__ void gemm256_stream(Src&& src, const int lda, const int K, char* smem, Epi&& epi) {
    LAS char* lds = (LAS char*)smem;
    int tid = otid();
    int wid = tid >> 6, lane = tid & 63, wr = wid >> 2, wc = wid & 3, fr = lane & 15, fq = lane >> 4;
    G8Desc nxt;
    if (!src(0, nxt)) return;
    int cm0 = nxt.m0, cn0 = nxt.n0, cu0 = nxt.u0;
    int* sRowG = (int*)(smem + G8_ROWS_OFF);
    __syncthreads();
    if (GATHER) { if (tid < 256) sRowG[tid] = tid < nxt.count ? nxt.list[tid] : -1; __syncthreads(); }
    unsigned aoff[2][2], boff[2];
    __amdgpu_buffer_rsrc_t rA, rB;
    int bh;
#define G8_PREP(D, SLOT) do { \
        const LAS int* _sr = (const LAS int*)(lds + G8_ROWS_OFF) + (SLOT) * 256; \
        _Pragma("unroll") for (int i = 0; i < 2; ++i) { \
            int R, C; g8_stage_rc(tid * 16 + i * 8192, R, C); \
            { const int rho = R & 31, nn = rho >> 4, ii = rho & 15; const int Rp = (R & ~31) + 8 * (ii >> 2) + 4 * nn + (ii & 3); boff[i] = (unsigned)(Rp * (D).ldb + C) * 2u; } \
            _Pragma("unroll") for (int h = 0; h < 2; ++h) { \
                int arow; \
                if (GATHER) { const int v = _sr[h * 128 + R]; arow = v < 0 ? 0 : (v >> SHIFT); } else arow = (D).m0 + h * 128 + R; \
                aoff[h][i] = (unsigned)(arow * lda + C) * 2u; } } \
        rA = __builtin_amdgcn_make_buffer_rsrc((void*)(D).A, 0, 0x7fffffff, 0x00020000); \
        rB = __builtin_amdgcn_make_buffer_rsrc((void*)((D).Bt + (size_t)(D).n0 * (D).ldb), 0, 0x7fffffff, 0x00020000); bh = 128 * (D).ldb * 2; } while (0)
#define G8_PRO1() do { G8_STAGE(G8_SB(0, 0), rB, boff, 0); G8_STAGE(G8_SA(0, 0), rA, aoff[0], 0); G8_STAGE(G8_SB(0, 1), rB, boff, bh); G8_STAGE(G8_SA(0, 1), rA, aoff[1], 0); } while (0)
    G8_PREP(nxt, 0);
    G8_PRO1();
    f32x4 acc[2][2][4][2];
    const int nt = K / 64;
    for (int it = 0;; ++it) {
#pragma unroll
        for (int a = 0; a < 2; ++a)
#pragma unroll
            for (int b = 0; b < 2; ++b)
#pragma unroll
                for (int m = 0; m < 4; ++m)
#pragma unroll
                    for (int n = 0; n < 2; ++n) acc[a][b][m][n] = (f32x4){0.f, 0.f, 0.f, 0.f};
        const bool has_next = src(it + 1, nxt);
        if (GATHER && has_next && tid < 256) sRowG[((it + 1) % 3) * 256 + tid] = tid < nxt.count ? nxt.list[tid] : -1;
        bf16x8 At[4][2], B0[2][2], B1[2][2];
        if (wr == 1) G8_BAR;
        G8_WAIT_V(4); G8_BAR;
        G8_STAGE(G8_SB(1, 0), rB, boff, 128); G8_STAGE(G8_SA(1, 0), rA, aoff[0], 128); G8_STAGE(G8_SB(1, 1), rB, boff, 128 + bh);
        G8_WAIT_V(6); G8_BAR;
        for (int t = 0; t < nt - 2; t += 2) {
            G8_LDB(B0, 0, 0); G8_SCHED; G8_LDA(At, 0, 0); G8_STAGE(G8_SA(1, 1), rA, aoff[1], (t + 1) * 128);
            G8_WAIT_L(8); G8_BAR; G8_WAIT_L(0); G8_MMA(0, 0, At, B0); G8_BAR; G8_SCHED;
            G8_LDB(B1, 0, 1); G8_STAGE(G8_SB(0, 0), rB, boff, (t + 2) * 128);
            G8_BAR; G8_WAIT_L(0); G8_MMA(0, 1, At, B1); G8_BAR;
            G8_LDA(At, 0, 1); G8_STAGE(G8_SA(0, 0), rA, aoff[0], (t + 2) * 128);
            G8_BAR; G8_WAIT_L(0); G8_MMA(1, 0, At, B0); G8_BAR; G8_SCHED;
            G8_STAGE(G8_SB(0, 1), rB, boff, (t + 2) * 128 + bh);
            G8_WAIT_V(6); G8_BAR; G8_MMA(1, 1, At, B1); G8_BAR;
            G8_LDB(B0, 1, 0); G8_SCHED; G8_LDA(At, 1, 0); G8_STAGE(G8_SA(0, 1), rA, aoff[1], (t + 2) * 128);
            G8_WAIT_L(8); G8_BAR; G8_WAIT_L(0); G8_MMA(0, 0, At, B0); G8_BAR; G8_SCHED;
            G8_LDB(B1, 1, 1); G8_STAGE(G8_SB(1, 0), rB, boff, (t + 3) * 128);
            G8_BAR; G8_WAIT_L(0); G8_MMA(0, 1, At, B1); G8_BAR;
            G8_LDA(At, 1, 1); G8_STAGE(G8_SA(1, 0), rA, aoff[0], (t + 3) * 128);
            G8_BAR; G8_WAIT_L(0); G8_MMA(1, 0, At, B0); G8_BAR; G8_SCHED;
            G8_STAGE(G8_SB(1, 1), rB, boff, (t + 3) * 128 + bh);
            G8_WAIT_V(6); G8_BAR; G8_MMA(1, 1, At, B1); G8_BAR;
        }
        { G8_LDB(B0, 0, 0); G8_WAIT_V(0); G8_LDA(At, 0, 0); G8_STAGE(G8_SA(1, 1), rA, aoff[1], (nt - 1) * 128);
          G8_BAR; G8_WAIT_L(0); G8_MMA(0, 0, At, B0); G8_BAR;
          G8_LDB(B1, 0, 1); G8_BAR; G8_WAIT_L(0); G8_MMA(0, 1, At, B1); G8_BAR;
          G8_LDA(At, 0, 1); G8_WAIT_V(4); G8_BAR; G8_WAIT_L(0); G8_MMA(1, 0, At, B0); G8_MMA(1, 1, At, B1); G8_BAR; }
        { G8_LDB(B0, 1, 0); G8_LDA(At, 1, 0); G8_WAIT_V(2); G8_BAR; G8_WAIT_L(0); G8_MMA(0, 0, At, B0); G8_BAR;
          G8_LDB(B1, 1, 1); G8_WAIT_V(0); G8_BAR; G8_WAIT_L(0); G8_MMA(0, 1, At, B1); G8_BAR;
          G8_LDA(At, 1, 1); G8_BAR; G8_WAIT_L(0); G8_MMA(1, 0, At, B0); G8_MMA(1, 1, At, B1); G8_BAR; }
        if (wr == 0) G8_BAR;
        tid = otid(); wid = tid >> 6; lane = tid & 63; wr = wid >> 2; wc = wid & 3; fr = lane & 15; fq = lane >> 4;
        if (has_next) { G8_PREP(nxt, (it + 1) % 3); G8_PRO1(); }
        {
            const int* sr = sRowG + (it % 3) * 256;
#pragma unroll
            for (int ai = 0; ai < 2; ++ai)
#pragma unroll
                for (int bj = 0; bj < 2; ++bj) epi(cm0, cu0, acc[ai][bj], ai * 128 + wr * 64, cn0 + bj * 128 + wc * 32, fr, fq, sr);
        }
        if (!has_next) break;
        cm0 = nxt.m0; cn0 = nxt.n0; cu0 = nxt.u0;
    }
#undef G8_PREP
#undef G8_PRO1
}

struct XcdSeq {
    int q, qend, step;
    __device__ __forceinline__ XcdSeq(int total, int bid, int nb) {
        if ((nb & 7) == 0) { const int chunk = (total + 7) >> 3, x = bid & 7; q = x * chunk + (bid >> 3); const int e = (x + 1) * chunk; qend = e < total ? e : total; step = nb >> 3; }
        else { q = bid; qend = total; step = nb; }
    }
};

template <class Epi>
__device__ __forceinline__ void gemm256_phase(const bf16_t* A, long lda, int M, const bf16_t* Bt, long ldb, int N, int K, char* smem, int bid, int nb, Epi&& epi) {
    const int ntn = N / 256, ntm = M / 256, nt = ntn * ntm;
    XcdSeq s(nt, bid, nb);
    gemm256_stream<false, 0>(
        [&](int i, G8Desc& d) -> bool {
            const int Q = s.q + i * s.step; if (Q >= s.qend) return false;
            const int pnl = Q / (4 * ntn), r = Q - pnl * 4 * ntn;
            d.A = A; d.Bt = Bt; d.list = nullptr; d.m0 = (pnl * 4 + (r & 3)) * 256; d.n0 = (r >> 2) * 256; d.count = 0; d.u0 = 0; d.ldb = (int)ldb;
            return true; },
        (int)lda, K, smem,
        [&](int m0, int, f32x4 (&acc)[4][2], int rt0, int c0, int fr, int fq, const int*) { epi(acc, m0 + rt0, c0, fr, fq); });
}


__device__ __forceinline__ int colmap(int kind, int n, int nsrc) {
    if (kind == 0) return n < nsrc ? n : -1;
    if (kind == 1) { if (n < 512) return n; if (n < 1024) return n + 512; if (n < 1536) return n + 528; if (n < 1552) return n; if (n < 1792) return -1; return n - 1280; }
    if (kind == 2) { if (n < 1024) return n; if (n < 1280) return n + 512; if (n < 4352) return n + 580; if (n < 4420) return n - 2560; if (n < 4608) return -1; if (n < 5120) return n - 3584; return n - 188; }
    { const int grp = n >> 5, w = n & 31; return ((w >> 2) & 1) * 1024 + grp * 16 + 4 * (w >> 3) + (w & 3); }
}
struct ConvTile { const float* src; bf16_t* dst; int sld, sc, K, n0, k0; };
__device__ __forceinline__ ConvTile conv_decode(PRef p, int t, int n4) {
    constexpr int S0 = 128 * 32 * 4, S1 = S0 + 128 * 16 * 4, S2 = S1 + 2 * 36 * 4, S3 = S2 + 2 * 104 * 4, S4 = S3 + 2 * 16 * 4, S5 = S4 + 2 * 16 * 4, S6 = S5 + 2 * 8 * 2;
    char* ws = p.ws;
    ConvTile c; int nsrc, kind, NT, loc;
    if (t < S0) { loc = t; const int mat = loc / (32 * 4); loc -= mat * 32 * 4; c.src = p.moe_w1 + (size_t)mat * 1024 * 2048; c.dst = (bf16_t*)(ws + OFF_WT_W1) + (size_t)mat * 2048 * 1024; c.sld = 2048; nsrc = 2048; kind = 3; c.K = 1024; NT = 32; }
    else if (t < S1) { loc = t - S0; const int mat = loc / 64; loc -= mat * 64; c.src = p.moe_w2 + (size_t)mat * 1024 * 1024; c.dst = (bf16_t*)(ws + OFF_WT_W2) + (size_t)mat * 1024 * 1024; c.sld = 1024; nsrc = 1024; kind = 0; c.K = 1024; NT = 16; }
    else if (t < S2) { loc = t - S1; const int mat = loc / (36 * 4); loc -= mat * 36 * 4; c.src = p.ev_w_in + (size_t)mat * 1024 * 2064; c.dst = (bf16_t*)(ws + OFF_WT_EVIN) + (size_t)mat * EV_N * 1024; c.sld = 2064; nsrc = 2064; kind = 1; c.K = 1024; NT = 36; }
    else if (t < S3) { loc = t - S2; const int mat = loc / (104 * 4); loc -= mat * 104 * 4; c.src = p.od_w_in + (size_t)mat * 1024 * 6468; c.dst = (bf16_t*)(ws + OFF_WT_ODIN) + (size_t)mat * OD_N * 1024; c.sld = 6468; nsrc = 6468; kind = 2; c.K = 1024; NT = 104; }
    else if (t < S4) { loc = t - S3; const int mat = loc / 64; loc -= mat * 64; c.src = p.ev_w_out + (size_t)mat * 1024 * 1024; c.dst = (bf16_t*)(ws + OFF_WT_EVOUT) + (size_t)mat * 1024 * 1024; c.sld = 1024; nsrc = 1024; kind = 0; c.K = 1024; NT = 16; }
    else if (t < S5) { loc = t - S4; const int mat = loc / 64; loc -= mat * 64; c.src = p.od_w_out + (size_t)mat * 1024 * 1024; c.dst = (bf16_t*)(ws + OFF_WT_ODOUT) + (size_t)mat * 1024 * 1024; c.sld = 1024; nsrc = 1024; kind = 0; c.K = 1024; NT = 16; }
    else if (t < S6) { loc = t - S5; const int mat = loc / 16; loc -= mat * 16; c.src = p.s5_w_glu + (size_t)mat * 512 * 512; c.dst = (bf16_t*)(ws + OFF_WT_GLU) + (size_t)mat * 512 * 512; c.sld = 512; nsrc = 512; kind = 0; c.K = 512; NT = 8; }
    else { loc = t - S6; const int mat = loc / 8; loc -= mat * 8; c.src = p.router_w + (size_t)mat * 1024 * 32; c.dst = (bf16_t*)(ws + OFF_WT_RT) + (size_t)mat * 128 * 1024; c.sld = 32; nsrc = 32; kind = 0; c.K = 1024; NT = 2; }
    const int kt = loc / NT, nt = loc - kt * NT;
    c.n0 = nt * 64; c.k0 = kt * 256;
    c.sc = colmap(kind, c.n0 + n4 * 4, nsrc);
    return c;
}
__device__ __forceinline__ void conv_load(const ConvTile& c, int kp, f32x4 (&v)[8]) {
#pragma unroll
    for (int i = 0; i < 4; ++i)
#pragma unroll
        for (int e = 0; e < 2; ++e) {
            const int k = c.k0 + 2 * (kp + 32 * i) + e;
            v[2 * i + e] = c.sc >= 0 ? *(const f32x4*)(c.src + (size_t)k * c.sld + c.sc) : (f32x4){0.f, 0.f, 0.f, 0.f};
        }
}

__device__ __forceinline__ void conv_phase(PRef p, char* smem, int bid, int nb) {
    char* ws = p.ws;
    constexpr int NTILES = 128 * 32 * 4 + 128 * 16 * 4 + 2 * 36 * 4 + 2 * 104 * 4 + 2 * 16 * 4 + 2 * 16 * 4 + 2 * 8 * 2 + 4 * 2 * 4;
    bf16_t* tile = (bf16_t*)smem;
    const int tid = otid(), n4 = tid & 15, kp = tid >> 4;
    if (bid < NTILES) {
        ConvTile cur = conv_decode(p, bid, n4);
        f32x4 v[8];
        conv_load(cur, kp, v);
        for (int t = bid; t < NTILES; t += nb) {
            const bool more = t + nb < NTILES;
            ConvTile nxt = cur; f32x4 w[8];
            if (more) { nxt = conv_decode(p, t + nb, n4); conv_load(nxt, kp, w); }
#pragma unroll
            for (int i = 0; i < 4; ++i)
#pragma unroll
                for (int j = 0; j < 4; ++j)
                    *(unsigned*)(tile + (n4 * 4 + j) * 258 + 2 * (kp + 32 * i)) = pk2(v[2 * i][j], v[2 * i + 1][j]);
            __syncthreads();
#pragma unroll
            for (int i = 0; i < 4; ++i) {
                const int c = tid + 512 * i, n = c >> 5, kc = c & 31;
                const unsigned* tp = (const unsigned*)(tile + n * 258 + kc * 8);
                u32x4 o; o.x = tp[0]; o.y = tp[1]; o.z = tp[2]; o.w = tp[3];
                *(u32x4*)(cur.dst + (size_t)(cur.n0 + n) * cur.K + cur.k0 + kc * 8) = o;
            }
            __syncthreads();
            if (more) {
                cur = nxt;
#pragma unroll
                for (int i = 0; i < 8; ++i) v[i] = w[i];
            }
        }
    }
    {
        const float* x = p.x; bf16_t* xb = (bf16_t*)(ws + OFF_XB);
        const long nch = (long)T_ * 1024 / 8;
        for (long c = (long)bid * NTHR + otid(); c < nch; c += (long)nb * NTHR) {
            const f32x4 a = *(const f32x4*)(x + c * 8), b = *(const f32x4*)(x + c * 8 + 4);
            u32x4 w; w.x = pk2(a[0], a[1]); w.y = pk2(a[2], a[3]); w.z = pk2(b[0], b[1]); w.w = pk2(b[2], b[3]);
            *(u32x4*)(xb + c * 8) = w;
        }
    }
    if (bid == 0 && otid() < 128) ((int*)(ws + OFF_CNT))[otid()] = 0;
}

__device__ __forceinline__ void s5mat_unit(PRef p, int j, int g, char* smem) {
    float* cre = (float*)smem;
    float* cim = cre + 1024;
    float* bbr = cim + 1024;
    float* bbi = bbr + 1024;
    float* pwr = bbi + 1024;
    float* pwi = pwr + 65 * 64;
    float* zr = pwi + 65 * 64;
    float* zi = zr + 64;
    float* Kd = zi + 64;
    const int tid = otid();
    const int jg = j * 32 + g;
    if (tid < 64) {
        const int pp = tid;
        const float lre = fminf(p.s5_a_re[jg * 64 + pp], -1e-4f), lim = p.s5_a_im[jg * 64 + pp];
        const float dt = expf(p.s5_log_dt[jg]);
        const float xr = lre * dt, th = lim * dt;
        const float mag = expf(xr);
        const float ar = mag * cosf(th), ai = mag * sinf(th);
        const float inv = 1.f / (lre * lre + lim * lim);
        zr[pp] = ((ar - 1.f) * lre + ai * lim) * inv;
        zi[pp] = (ai * lre - (ar - 1.f) * lim) * inv;
        const double thd = (double)th;
        for (int d = 0; d <= 64; ++d) {
            const float mg = expf((float)d * xr);
            double ang = (double)d * thd;
            const double kk = rint(ang * 0.15915494309189535);
            ang -= kk * 6.283185307179586;
            const float a = (float)ang;
            pwr[d * 64 + pp] = mg * cosf(a);
            pwi[d * 64 + pp] = mg * sinf(a);
        }
    }
    for (int e = tid; e < 1024; e += NTHR) {
        cre[e] = p.s5_c_re[(size_t)jg * 1024 + e];
        cim[e] = p.s5_c_im[(size_t)jg * 1024 + e];
    }
    __syncthreads();
    for (int e = tid; e < 1024; e += NTHR) {
        const int pp = e >> 4;
        const float br = p.s5_b_re[(size_t)jg * 1024 + e], bi = p.s5_b_im[(size_t)jg * 1024 + e];
        bbr[e] = zr[pp] * br - zi[pp] * bi;
        bbi[e] = zr[pp] * bi + zi[pp] * br;
    }
    __syncthreads();
    for (int e = tid; e < 64 * 256; e += NTHR) {
        const int d = e >> 8, n = (e >> 4) & 15, m = e & 15;
        float s = 0.f;
        for (int pp = 0; pp < 64; ++pp) {
            const float cr = cre[n * 64 + pp], ci = cim[n * 64 + pp], qr = pwr[d * 64 + pp], qi = pwi[d * 64 + pp];
            const float wr_ = cr * qr - ci * qi, wi_ = cr * qi + ci * qr;
            s += wr_ * bbr[pp * 16 + m] - wi_ * bbi[pp * 16 + m];
        }
        Kd[e] = s;
    }
    __syncthreads();
    bf16_t* TH = (bf16_t*)(p.ws + OFF_TH) + (size_t)jg * 1024 * UHW;
    for (int c = tid; c < 1024 * 144; c += NTHR) {
        const int row = c / 144, ch = c - row * 144;
        const int tau = row >> 4, n = row & 15;
        float v[8];
        if (ch < 128) {
            const int s = ch >> 1, m0 = (ch & 1) * 8;
            if (s <= tau) {
#pragma unroll
                for (int i = 0; i < 8; ++i) v[i] = Kd[(tau - s) * 256 + n * 16 + m0 + i];
            } else {
#pragma unroll
                for (int i = 0; i < 8; ++i) v[i] = 0.f;
            }
        } else {
            const int p0 = (ch - 128) * 4;
#pragma unroll
            for (int i = 0; i < 4; ++i) {
                const int pp = p0 + i;
                const float cr = cre[n * 64 + pp], ci = cim[n * 64 + pp], qr = pwr[(tau + 1) * 64 + pp], qi = pwi[(tau + 1) * 64 + pp];
                v[2 * i] = cr * qr - ci * qi;
                v[2 * i + 1] = -(cr * qi + ci * qr);
            }
        }
        u32x4 w; w.x = pk2(v[0], v[1]); w.y = pk2(v[2], v[3]); w.z = pk2(v[4], v[5]); w.w = pk2(v[6], v[7]);
        *(u32x4*)(TH + (size_t)row * UHW + ch * 8) = w;
    }
    bf16_t* GM = (bf16_t*)(p.ws + OFF_GM) + (size_t)jg * 128 * 1024;
    for (int c = tid; c < 128 * 128; c += NTHR) {
        const int row = c >> 7, ch = c & 127;
        const int pp = row >> 1, ri = row & 1;
        const int s = ch >> 1, m0 = (ch & 1) * 8;
        const float qr = pwr[(63 - s) * 64 + pp], qi = pwi[(63 - s) * 64 + pp];
        float v[8];
#pragma unroll
        for (int i = 0; i < 8; ++i) {
            const float br = bbr[pp * 16 + m0 + i], bi = bbi[pp * 16 + m0 + i];
            v[i] = ri == 0 ? (qr * br - qi * bi) : (qr * bi + qi * br);
        }
        u32x4 w; w.x = pk2(v[0], v[1]); w.y = pk2(v[2], v[3]); w.z = pk2(v[4], v[5]); w.w = pk2(v[6], v[7]);
        *(u32x4*)(GM + (size_t)row * 1024 + ch * 8) = w;
    }
    if (tid < 64) {
        float* A64 = (float*)(p.ws + OFF_A64) + (size_t)jg * 128;
        A64[tid * 2] = pwr[64 * 64 + tid];
        A64[tid * 2 + 1] = pwi[64 * 64 + tid];
    }
    __syncthreads();
}

__device__ __forceinline__ void epi_ev_in(PRef p, f32x4 (&acc)[4][2], int row0, int c0, int fr, int fq) {
    char* ws = p.ws;
    bf16_t* PE = (bf16_t*)(ws + OFF_PE); bf16_t* UH = (bf16_t*)(ws + OFF_UH); float* GLR = (float*)(ws + OFF_GLR);
    const int col = c0 + 8 * fq;
#pragma unroll
    for (int m = 0; m < 4; ++m) {
        const int t = row0 + m * 16 + fr;
        u32x4 w; w.x = pk2(acc[m][0][0], acc[m][0][1]); w.y = pk2(acc[m][0][2], acc[m][0][3]); w.z = pk2(acc[m][1][0], acc[m][1][1]); w.w = pk2(acc[m][1][2], acc[m][1][3]);
        if (c0 < 1024) {
            *(u32x4*)(PE + (size_t)t * PE_W + col) = w;
        } else if (c0 < 1536) {
            const int ch = col - 1024, g = ch >> 4, mm = ch & 15;
            *(u32x4*)(UH + ((size_t)(t >> 6) * 32 + g) * UHW + (t & 63) * 16 + mm) = w;
        } else if (col < 1552) {
            *(f32x4*)(GLR + (size_t)t * 16 + (col - 1536)) = acc[m][0];
            *(f32x4*)(GLR + (size_t)t * 16 + (col - 1536) + 4) = acc[m][1];
        }
    }
}
__device__ __forceinline__ void epi_vt(bf16_t* __restrict__ img_row0, f32x4 (&acc)[4][2], int rt0, int c0, int fr, int fq) {
#pragma unroll
    for (int m = 0; m < 4; ++m) {
        u32x4 w; w.x = pk2(acc[m][0][0], acc[m][0][1]); w.y = pk2(acc[m][0][2], acc[m][0][3]); w.z = pk2(acc[m][1][0], acc[m][1][1]); w.w = pk2(acc[m][1][2], acc[m][1][3]);
        *(u32x4*)(img_row0 + (size_t)(rt0 + m * 16 + fr) * L_ + c0 + 8 * fq) = w;
    }
}

__device__ __forceinline__ void gla_decay(PRef p, int j, int t0, int h, float* sB) {
    const float* GLR = (const float*)(p.ws + OFF_GLR);
    const float* w2 = p.gla_w_gate2 + (size_t)j * 16 * 256;
    const float* b2 = p.gla_b_gate2 + (size_t)j * 256;
    const int tid = otid();
    for (int e = tid; e < 4096; e += NTHR) {
        const int tau = e >> 6, d = e & 63;
        float a = b2[h * 64 + d];
#pragma unroll
        for (int r = 0; r < 16; ++r) a += GLR[(size_t)(t0 + tau) * 16 + r] * w2[r * 256 + h * 64 + d];
        const float ls = fminf(a, 0.f) - __logf(1.f + __expf(-fabsf(a)));
        sB[tau * 65 + d] = ls * (1.f / 16.f);
    }
    __syncthreads();
    if (tid < 64) { float run = 0.f; for (int tau = 0; tau < 64; ++tau) { run += sB[tau * 65 + tid]; sB[tau * 65 + tid] = run; } }
    __syncthreads();
}

__device__ __forceinline__ void gla_a_item(PRef p, int j, int item, char* smem) {
    const int h = item & 3, c = (item >> 2) & 255, b = item >> 10;
    const int t0 = b * L_ + c * 64;
    float* sB = (float*)smem;
    bf16_t* AK = (bf16_t*)(smem + 16640);
    const bf16_t* PE = (const bf16_t*)(p.ws + OFF_PE);
    const bf16_t* VTE = (const bf16_t*)(p.ws + OFF_VTE);
    const int tid = otid(), lane = tid & 63, wave = tid >> 6, fr = lane & 15, fq = lane >> 4;
    gla_decay(p, j, t0, h, sB);
    for (int e = tid; e < 4096; e += NTHR) {
        const int tau = e >> 6, d = e & 63;
        const float k = bf2f(PE[(size_t)(t0 + tau) * PE_W + 256 + h * 64 + d]);
        AK[d * 72 + tau] = f2bf(k * __expf(sB[63 * 65 + d] - sB[tau * 65 + d]));
    }
    __syncthreads();
    const int dblk = wave >> 1, vb = (wave & 1) * 64;
    f32x4 acc[4];
#pragma unroll
    for (int n = 0; n < 4; ++n) acc[n] = (f32x4){0.f, 0.f, 0.f, 0.f};
#pragma unroll
    for (int ks = 0; ks < 2; ++ks) {
        const bf16x8 af = *(const bf16x8*)(AK + (dblk * 16 + fr) * 72 + ks * 32 + fq * 8);
#pragma unroll
        for (int n = 0; n < 4; ++n) {
            const int v = vb + n * 16 + fr;
            const bf16x8 bfr = *(const bf16x8*)(VTE + ((size_t)((b * 4 + h) * 128 + v)) * L_ + (c * 64 + ks * 32 + fq * 8));
            acc[n] = __builtin_amdgcn_mfma_f32_16x16x32_bf16(af, bfr, acc[n], 0, 0, 0);
        }
    }
    float* KV = (float*)(p.ws + OFF_KV) + ((size_t)((b * 256 + c) * 4 + h)) * 64 * 128;
#pragma unroll
    for (int n = 0; n < 4; ++n)
#pragma unroll
        for (int r = 0; r < 4; ++r) KV[(dblk * 16 + fq * 4 + r) * 128 + vb + n * 16 + fr] = acc[n][r];
    if (tid < 64) ((float*)(p.ws + OFF_DEC))[((size_t)((b * 256 + c) * 4 + h)) * 64 + tid] = __expf(sB[63 * 65 + tid]);
    __syncthreads();
}

__device__ __forceinline__ void scan_phase(PRef p, int j, int bid) {
    const int gid = bid * NTHR + otid();
    if (gid < 65536) {
        const int v = gid & 127, d = (gid >> 7) & 63, h = (gid >> 13) & 3, b = gid >> 15;
        const float* KV = (const float*)(p.ws + OFF_KV); float* SST = (float*)(p.ws + OFF_SST); const float* DEC = (const float*)(p.ws + OFF_DEC);
        float S = 0.f;
        for (int c0 = 0; c0 < 256; c0 += 8) {
            float kv[8], dc[8];
#pragma unroll
            for (int i = 0; i < 8; ++i) {
                const size_t blk = (size_t)((b * 256 + c0 + i) * 4 + h);
                kv[i] = KV[(blk * 64 + d) * 128 + v]; dc[i] = DEC[blk * 64 + d];
            }
#pragma unroll
            for (int i = 0; i < 8; ++i) {
                const size_t blk = (size_t)((b * 256 + c0 + i) * 4 + h);
                SST[(blk * 64 + d) * 128 + v] = S;
                S = dc[i] * S + kv[i];
            }
        }
    } else if (gid < 65536 + 4096) {
        const int e = gid - 65536, pp = e & 63, g = (e >> 6) & 31, b = e >> 11;
        const float* A64 = (const float*)(p.ws + OFF_A64) + (size_t)(j * 32 + g) * 128;
        const float ar = A64[pp * 2], ai = A64[pp * 2 + 1];
        const float* GB = (const float*)(p.ws + OFF_GBUF); bf16_t* UH = (bf16_t*)(p.ws + OFF_UH);
        float hr = 0.f, hi = 0.f;
        for (int c0 = 0; c0 < 256; c0 += 8) {
            float gr[8], gi[8];
#pragma unroll
            for (int i = 0; i < 8; ++i) { const size_t row = (size_t)(b * 256 + c0 + i) * 32 + g; gr[i] = GB[row * 128 + 2 * pp]; gi[i] = GB[row * 128 + 2 * pp + 1]; }
#pragma unroll
            for (int i = 0; i < 8; ++i) {
                const size_t row = (size_t)(b * 256 + c0 + i) * 32 + g;
                *(unsigned*)(UH + row * UHW + 1024 + 2 * pp) = pk2(hr, hi);
                const float nr = ar * hr - ai * hi + gr[i], ni = ar * hi + ai * hr + gi[i];
                hr = nr; hi = ni;
            }
        }
    }
}

__device__ __forceinline__ void gla_c_item(PRef p, int j, int item, char* smem) {
    const int h = item & 3, c = (item >> 2) & 255, b = item >> 10;
    const int t0 = b * L_ + c * 64;
    float* sB = (float*)smem;
    bf16_t* QT = (bf16_t*)(smem + 16640);
    bf16_t* KT = (bf16_t*)(smem + 16640 + 9216);
    bf16_t* ATT = (bf16_t*)(smem + 16640 + 18432);
    float* OS = (float*)(smem + 16640 + 27648);
    const bf16_t* PE = (const bf16_t*)(p.ws + OFF_PE);
    const bf16_t* VTE = (const bf16_t*)(p.ws + OFF_VTE);
    const int tid = otid(), lane = tid & 63, wave = tid >> 6, fr = lane & 15, fq = lane >> 4;
    gla_decay(p, j, t0, h, sB);
    for (int e = tid; e < 4096; e += NTHR) {
        const int tau = e >> 6, d = e & 63;
        const float bb = sB[tau * 65 + d];
        const float q = bf2f(PE[(size_t)(t0 + tau) * PE_W + h * 64 + d]);
        const float k = bf2f(PE[(size_t)(t0 + tau) * PE_W + 256 + h * 64 + d]);
        QT[tau * 72 + d] = f2bf(q * 0.125f * __expf(bb));
        KT[tau * 72 + d] = f2bf(k * __expf(-bb));
    }
    __syncthreads();
    const int iblk = wave >> 1;
    {
        f32x4 acc[2];
        acc[0] = (f32x4){0.f, 0.f, 0.f, 0.f}; acc[1] = acc[0];
#pragma unroll
        for (int ks = 0; ks < 2; ++ks) {
            const bf16x8 af = *(const bf16x8*)(QT + (iblk * 16 + fr) * 72 + ks * 32 + fq * 8);
#pragma unroll
            for (int n = 0; n < 2; ++n) {
                const int jb = (wave & 1) * 2 + n;
                const bf16x8 bfr = *(const bf16x8*)(KT + (jb * 16 + fr) * 72 + ks * 32 + fq * 8);
                acc[n] = __builtin_amdgcn_mfma_f32_16x16x32_bf16(af, bfr, acc[n], 0, 0, 0);
            }
        }
#pragma unroll
        for (int n = 0; n < 2; ++n) {
            const int jj = ((wave & 1) * 2 + n) * 16 + fr;
#pragma unroll
            for (int r = 0; r < 4; ++r) { const int ii = iblk * 16 + fq * 4 + r; ATT[ii * 72 + jj] = f2bf(jj <= ii ? acc[n][r] : 0.f); }
        }
    }
    __syncthreads();
    {
        const int vb = (wave & 1) * 64;
        const float* SST = (const float*)(p.ws + OFF_SST) + ((size_t)((b * 256 + c) * 4 + h)) * 64 * 128;
        f32x4 acc[4];
#pragma unroll
        for (int n = 0; n < 4; ++n) acc[n] = (f32x4){0.f, 0.f, 0.f, 0.f};
#pragma unroll
        for (int ks = 0; ks < 2; ++ks) {
            const bf16x8 af = *(const bf16x8*)(ATT + (iblk * 16 + fr) * 72 + ks * 32 + fq * 8);
            const bf16x8 aq = *(const bf16x8*)(QT + (iblk * 16 + fr) * 72 + ks * 32 + fq * 8);
#pragma unroll
            for (int n = 0; n < 4; ++n) {
                const int v = vb + n * 16 + fr;
                const bf16x8 bv = *(const bf16x8*)(VTE + ((size_t)((b * 4 + h) * 128 + v)) * L_ + (c * 64 + ks * 32 + fq * 8));
                acc[n] = __builtin_amdgcn_mfma_f32_16x16x32_bf16(af, bv, acc[n], 0, 0, 0);
                bf16x8 bs;
#pragma unroll
                for (int i = 0; i < 8; ++i) bs[i] = (short)f2bf(SST[(ks * 32 + fq * 8 + i) * 128 + v]);
                acc[n] = __builtin_amdgcn_mfma_f32_16x16x32_bf16(aq, bs, acc[n], 0, 0, 0);
            }
        }
#pragma unroll
        for (int n = 0; n < 4; ++n)
#pragma unroll
            for (int r = 0; r < 4; ++r) OS[(iblk * 16 + fq * 4 + r) * 132 + vb + n * 16 + fr] = acc[n][r];
    }
    __syncthreads();
    {
        const int i = tid >> 3, seg = tid & 7;
        float o[16]; float ss = 0.f;
#pragma unroll
        for (int q = 0; q < 16; ++q) { o[q] = OS[i * 132 + seg * 16 + q]; ss += o[q] * o[q]; }
        ss += __shfl_xor(ss, 1, 64); ss += __shfl_xor(ss, 2, 64); ss += __shfl_xor(ss, 4, 64);
        const float rs = rsqrtf(ss * (1.f / 128.f) + LN_EPS);
        const float* ng = p.gla_norm_g + (size_t)j * 128;
        bf16_t* CC = (bf16_t*)(p.ws + OFF_CC);
        const size_t t = (size_t)(t0 + i);
        unsigned w[8];
#pragma unroll
        for (int q = 0; q < 16; q += 2) {
            const int v0 = seg * 16 + q;
            const float r0 = bf2f(PE[t * PE_W + 512 + h * 128 + v0]), r1 = bf2f(PE[t * PE_W + 512 + h * 128 + v0 + 1]);
            const float a0 = o[q] * rs * ng[v0] * (r0 * sigmoidf_(r0)), a1 = o[q + 1] * rs * ng[v0 + 1] * (r1 * sigmoidf_(r1));
            w[q >> 1] = pk2(a0, a1);
        }
        u32x4 w0, w1; w0.x = w[0]; w0.y = w[1]; w0.z = w[2]; w0.w = w[3]; w1.x = w[4]; w1.y = w[5]; w1.z = w[6]; w1.w = w[7];
        *(u32x4*)(CC + t * 1024 + h * 128 + seg * 16) = w0;
        *(u32x4*)(CC + t * 1024 + h * 128 + seg * 16 + 8) = w1;
    }
    __syncthreads();
}

__device__ __forceinline__ void s5_g_phase(PRef p, int j, char* smem, int bid, int nb) {
    const bf16_t* UH = (const bf16_t*)(p.ws + OFF_UH);
    float* GB = (float*)(p.ws + OFF_GBUF);
    for (int t = bid; t < 64; t += nb) {
        const int g = t >> 1, mi = t & 1;
        const bf16_t* Bt = (const bf16_t*)(p.ws + OFF_GM) + (size_t)(j * 32 + g) * 128 * 1024;
        gemm_tile<false>(UH + (size_t)g * UHW, (long)32 * UHW, 0, mi * 256, Bt, 1024, 0, 1024, smem,
            [&](f32x4 (&acc)[4][2], int rt0, int c0, int fr, int fq) {
#pragma unroll
                for (int m = 0; m < 4; ++m)
#pragma unroll
                    for (int n = 0; n < 2; ++n)
#pragma unroll
                        for (int r = 0; r < 4; ++r) {
                            const int row = mi * 256 + rt0 + m * 16 + fq * 4 + r;
                            GB[((size_t)row * 32 + g) * 128 + c0 + n * 16 + fr] = acc[m][n][r];
                        }
            });
    }
}
__device__ __forceinline__ void s5_y_phase(PRef p, int j, char* smem, int bid, int nb) {
    const bf16_t* UH = (const bf16_t*)(p.ws + OFF_UH);
    bf16_t* YA = (bf16_t*)(p.ws + OFF_YA);
    const float* dsk = p.s5_d + (size_t)j * 512;
    XcdSeq sq(32 * 2 * 4, bid, nb);
    for (int t = sq.q; t < sq.qend; t += sq.step) {
        const int g = t >> 3, mi = (t >> 2) & 1, ni = t & 3;
        const bf16_t* Bt = (const bf16_t*)(p.ws + OFF_TH) + (size_t)(j * 32 + g) * 1024 * UHW;
        gemm256_tile<false>(UH + (size_t)g * UHW, (long)32 * UHW, 0, mi * 256, Bt, UHW, ni * 256, UHW, smem,
            [&](f32x4 (&acc)[4][2], int rt0, int c0, int fr, int fq) {
                const int col = c0 + 8 * fq;
                const int tau = col >> 4, nn = col & 15, ch = g * 16 + nn;
                const f32x4 d0 = *(const f32x4*)(dsk + ch), d1 = *(const f32x4*)(dsk + ch + 4);
#pragma unroll
                for (int m = 0; m < 4; ++m) {
                    const int row = mi * 256 + rt0 + m * 16 + fr;
                    const u32x4 uw = *(const u32x4*)(UH + ((size_t)row * 32 + g) * UHW + col);
                    float y[8];
#pragma unroll
                    for (int q = 0; q < 4; ++q) {
                        const unsigned u2 = q == 0 ? uw.x : q == 1 ? uw.y : q == 2 ? uw.z : uw.w;
                        const float u0 = __uint_as_float(u2 << 16), u1 = __uint_as_float(u2 & 0xffff0000u);
                        const float a0 = q < 2 ? acc[m][0][2 * q] : acc[m][1][2 * q - 4], a1 = q < 2 ? acc[m][0][2 * q + 1] : acc[m][1][2 * q - 3];
                        const float dd0 = q < 2 ? d0[2 * q] : d1[2 * q - 4], dd1 = q < 2 ? d0[2 * q + 1] : d1[2 * q - 3];
                        y[2 * q] = gelu_tanh(a0 + dd0 * u0); y[2 * q + 1] = gelu_tanh(a1 + dd1 * u1);
                    }
                    u32x4 w; w.x = pk2(y[0], y[1]); w.y = pk2(y[2], y[3]); w.z = pk2(y[4], y[5]); w.w = pk2(y[6], y[7]);
                    *(u32x4*)(YA + ((size_t)row * 64 + tau) * 512 + ch) = w;
                }
            });
    }
}

template <bool SLOTS, bool NOEPI = false>
__device__ __forceinline__ void ln_phase(PRef p, const float* xin, const float* addb, const float* g, const float* bta, float* xout, bf16_t* xb, int bid, int nb) {
    const int lane = otid() & 63, wave = otid() >> 6;
    for (int t = bid * 8 + wave; t < T_; t += nb * 8) {
        f32x4 v[4];
        float s = 0.f;
#pragma unroll
        for (int i = 0; i < 4; ++i) {
            const int c = i * 256 + lane * 4;
            f32x4 a = *(const f32x4*)(xin + (size_t)t * 1024 + c);
            f32x4 m;
            if (SLOTS) {
                const bf16_t* sl = (const bf16_t*)addb;
                m = (f32x4){0.f, 0.f, 0.f, 0.f};
#pragma unroll
                for (int k = 0; k < 4; ++k) {
                    const u32x2 w = *(const u32x2*)(sl + ((size_t)t * 4 + k) * 1024 + c);
                    m[0] += __uint_as_float(w.x << 16); m[1] += __uint_as_float(w.x & 0xffff0000u); m[2] += __uint_as_float(w.y << 16); m[3] += __uint_as_float(w.y & 0xffff0000u);
                }
            } else m = *(const f32x4*)(addb + (size_t)t * 1024 + c);
            v[i] = a * ALPHA + m;
            s += v[i][0] + v[i][1] + v[i][2] + v[i][3];
        }
        const float mu = wave_sum(s) * (1.f / 1024.f);
        float q = 0.f;
#pragma unroll
        for (int i = 0; i < 4; ++i) { v[i] -= mu; q += v[i][0] * v[i][0] + v[i][1] * v[i][1] + v[i][2] * v[i][2] + v[i][3] * v[i][3]; }
        const float rs = rsqrtf(wave_sum(q) * (1.f / 1024.f) + LN_EPS);
#pragma unroll
        for (int i = 0; i < 4; ++i) {
            const int c = i * 256 + lane * 4;
            const f32x4 gg = *(const f32x4*)(g + c), bb = *(const f32x4*)(bta + c);
            const f32x4 o = v[i] * rs * gg + bb;
            if (!NOEPI) *(f32x4*)(xout + (size_t)t * 1024 + c) = o;
            if (xb && !NOEPI) { u32x2 w; w.x = pk2(o[0], o[1]); w.y = pk2(o[2], o[3]); *(u32x2*)(xb + (size_t)t * 1024 + c) = w; }
        }
    }
}

constexpr int RT_STRIDE = 36;
constexpr int RT_SCR_OFF = 1024 * RT_STRIDE * 4;
template <bool NOEPI = false>
__device__ __forceinline__ void ln1_router_phase(PRef p, int layer, const float* xin, char* smem, int bid, int nb) {
    float* wl = (float*)smem;
    const int tid = otid(), lane = tid & 63, wave = tid >> 6;
    float* lgs = (float*)(smem + RT_SCR_OFF + wave * 640);
    int* pick = (int*)(lgs + 32);
    float* pgate = (float*)(pick + 64);
    {
        const float* rw = p.router_w + (size_t)layer * 1024 * 32;
        for (int e = tid; e < 32768; e += NTHR) {
            const int k = e >> 5, ex = e & 31, rem = k & 255;
            wl[((k & ~255) + (rem & 3) * 64 + (rem >> 2)) * RT_STRIDE + ex] = rw[e];
        }
    }
    __syncthreads();
    const float* addb = (const float*)(p.ws + OFF_MIX);
    const float* g = p.ln1_g + (size_t)layer * 1024; const float* bta = p.ln1_b + (size_t)layer * 1024;
    float* xout = (float*)(p.ws + OFF_XR); bf16_t* xb = (bf16_t*)(p.ws + OFF_XB);
    int* cnt = (int*)(p.ws + OFF_CNT) + layer * 32;
    int* LIST = (int*)(p.ws + OFF_LIST);
    float* GATE = (float*)(p.ws + OFF_GATE);
    const float rbias = p.router_b[(size_t)layer * 32 + (lane >> 1)];
    const int rstep = nb * 8;
    f32x4 xa[4], xm[4];
    {
        const int t0 = bid * 8 + wave;
        if (t0 < T_) {
#pragma unroll
            for (int i = 0; i < 4; ++i) { const int c = i * 256 + lane * 4; xa[i] = *(const f32x4*)(xin + (size_t)t0 * 1024 + c); xm[i] = *(const f32x4*)(addb + (size_t)t0 * 1024 + c); }
        }
    }
    for (int tb = bid * 8 + wave; tb < T_; tb += rstep * 16) {
        int nrow = 0;
#pragma unroll 1
        for (int t = tb; t < T_ && nrow < 16; t += rstep, ++nrow) {
            f32x4 v[4];
            float s = 0.f;
#pragma unroll
            for (int i = 0; i < 4; ++i) { v[i] = xa[i] * ALPHA + xm[i]; s += v[i][0] + v[i][1] + v[i][2] + v[i][3]; }
            if (t + rstep < T_) {
#pragma unroll
                for (int i = 0; i < 4; ++i) { const int c = i * 256 + lane * 4; xa[i] = *(const f32x4*)(xin + (size_t)(t + rstep) * 1024 + c); xm[i] = *(const f32x4*)(addb + (size_t)(t + rstep) * 1024 + c); }
            }
            const float mu = wave_sum(s) * (1.f / 1024.f);
            float q = 0.f;
#pragma unroll
            for (int i = 0; i < 4; ++i) { v[i] -= mu; q += v[i][0] * v[i][0] + v[i][1] * v[i][1] + v[i][2] * v[i][2] + v[i][3] * v[i][3]; }
            const float rs = rsqrtf(wave_sum(q) * (1.f / 1024.f) + LN_EPS);
#pragma unroll
            for (int i = 0; i < 4; ++i) {
                const int c = i * 256 + lane * 4;
                const f32x4 gg = *(const f32x4*)(g + c), bb = *(const f32x4*)(bta + c);
                v[i] = v[i] * rs * gg + bb;
                if (!NOEPI) { *(f32x4*)(xout + (size_t)t * 1024 + c) = v[i];
                u32x2 w; w.x = pk2(v[i][0], v[i][1]); w.y = pk2(v[i][2], v[i][3]); *(u32x2*)(xb + (size_t)t * 1024 + c) = w; }
            }
            f32x4 acc[8];
#pragma unroll
            for (int e = 0; e < 8; ++e) acc[e] = (f32x4){0.f, 0.f, 0.f, 0.f};
#pragma unroll
            for (int i = 0; i < 4; ++i)
#pragma unroll
                for (int j = 0; j < 4; ++j) {
                    const f32x4* wr_ = (const f32x4*)(wl + (i * 256 + j * 64 + lane) * RT_STRIDE);
                    const float xv = v[i][j];
#pragma unroll
                    for (int e = 0; e < 8; ++e) acc[e] += wr_[e] * xv;
                }
            float k16[16], k8[8], k4[4], k2[2];
#pragma unroll
            for (int a = 0; a < 16; ++a) { auto r = __builtin_amdgcn_permlane32_swap(__float_as_uint(acc[a >> 2][a & 3]), __float_as_uint(acc[(a + 16) >> 2][a & 3]), false, false); k16[a] = __uint_as_float(r[0]) + __uint_as_float(r[1]); }
#pragma unroll
            for (int a = 0; a < 8; ++a) { auto r = __builtin_amdgcn_permlane16_swap(__float_as_uint(k16[a]), __float_as_uint(k16[a + 8]), false, false); k8[a] = __uint_as_float(r[0]) + __uint_as_float(r[1]); }
            { const bool hb = lane & 8;
#pragma unroll
              for (int a = 0; a < 4; ++a) { const float mine = hb ? k8[a + 4] : k8[a], send = hb ? k8[a] : k8[a + 4]; k4[a] = mine + dppf<DPP_ROR8>(send); } }
            { const bool hb = lane & 4;
#pragma unroll
              for (int a = 0; a < 2; ++a) { const float mine = hb ? k4[a + 2] : k4[a], send = hb ? k4[a] : k4[a + 2]; k2[a] = mine + dppf<DPP_HMIR>(send); } }
            float lg;
            { const bool hb = lane & 2; const float mine = hb ? k2[1] : k2[0], send = hb ? k2[0] : k2[1]; lg = mine + dppf<DPP_X2>(send); }
            lg += dppf<DPP_X1>(lg);
            lg += rbias;
            float cand = (lane & 1) ? -INFINITY : lg;
            float tv[4]; int te[4];
#pragma unroll
            for (int r = 0; r < 4; ++r) {
                const float mxv = wave_max(cand);
                const unsigned long long bal = __builtin_amdgcn_ballot_w64(cand == mxv);
                const int first = __builtin_ctzll(bal);
                tv[r] = mxv; te[r] = first >> 1;
                if (lane == first) cand = -INFINITY;
            }
            if (lane == 0) {
                const float e1 = __expf(tv[1] - tv[0]), e2 = __expf(tv[2] - tv[0]), e3 = __expf(tv[3] - tv[0]);
                const float inv = 1.f / (1.f + e1 + e2 + e3);
                pick[nrow * 4 + 0] = te[0]; pick[nrow * 4 + 1] = te[1]; pick[nrow * 4 + 2] = te[2]; pick[nrow * 4 + 3] = te[3];
                pgate[nrow * 4 + 0] = inv; pgate[nrow * 4 + 1] = e1 * inv; pgate[nrow * 4 + 2] = e2 * inv; pgate[nrow * 4 + 3] = e3 * inv;
            }
        }
        if ((lane >> 2) < nrow && (!NOEPI || pgate[lane] < -1.f)) {
            const int t = tb + (lane >> 2) * rstep, ex = pick[lane], pair = t * 4 + (lane & 3);
            const int pos = atomicAdd(&cnt[ex], 1);
            LIST[(size_t)ex * LISTCAP + pos] = pair;
            GATE[pair] = pgate[lane];
        }
    }
}

__device__ __forceinline__ void topk_phase(PRef p, int layer, int bid, int nb) {
    const float* LG = (const float*)(p.ws + OFF_LOGIT);
    int* cnt = (int*)(p.ws + OFF_CNT) + layer * 32;
    int* LIST = (int*)(p.ws + OFF_LIST);
    float* GATE = (float*)(p.ws + OFF_GATE);
    for (int t = bid * NTHR + otid(); t < T_; t += nb * NTHR) {
        float v0 = -INFINITY, v1 = -INFINITY, v2 = -INFINITY, v3 = -INFINITY; int i0 = 0, i1 = 0, i2 = 0, i3 = 0;
#pragma unroll
        for (int q = 0; q < 8; ++q) {
            const f32x4 l4 = *(const f32x4*)(LG + (size_t)t * 32 + q * 4);
#pragma unroll
            for (int r = 0; r < 4; ++r) {
                const float v = l4[r]; const int e = q * 4 + r;
                if (v > v0) { v3 = v2; i3 = i2; v2 = v1; i2 = i1; v1 = v0; i1 = i0; v0 = v; i0 = e; }
                else if (v > v1) { v3 = v2; i3 = i2; v2 = v1; i2 = i1; v1 = v; i1 = e; }
                else if (v > v2) { v3 = v2; i3 = i2; v2 = v; i2 = e; }
                else if (v > v3) { v3 = v; i3 = e; }
            }
        }
        const float e1 = __expf(v1 - v0), e2 = __expf(v2 - v0), e3 = __expf(v3 - v0);
        const float inv = 1.f / (1.f + e1 + e2 + e3);
        int pos;
        pos = atomicAdd(&cnt[i0], 1); LIST[(size_t)i0 * LISTCAP + pos] = t * 4 + 0; GATE[t * 4 + 0] = inv;
        pos = atomicAdd(&cnt[i1], 1); LIST[(size_t)i1 * LISTCAP + pos] = t * 4 + 1; GATE[t * 4 + 1] = e1 * inv;
        pos = atomicAdd(&cnt[i2], 1); LIST[(size_t)i2 * LISTCAP + pos] = t * 4 + 2; GATE[t * 4 + 2] = e2 * inv;
        pos = atomicAdd(&cnt[i3], 1); LIST[(size_t)i3 * LISTCAP + pos] = t * 4 + 3; GATE[t * 4 + 3] = e3 * inv;
    }
}

template <int WHICH, bool NOEPI = false>
__device__ __forceinline__ void moe_gemm_phase(PRef p, int layer, char* smem, int bid, int nb) {
    const int* cnt = (const int*)(p.ws + OFF_CNT) + layer * 32;
    const int* LIST = (const int*)(p.ws + OFF_LIST);
    constexpr int NTN = WHICH == 1 ? 8 : 4;
    int total = 0;
    for (int i = 0; i < 32; ++i) total += ((cnt[i] + 255) >> 8) * NTN;
    XcdSeq sq(total, bid, nb);
    int e = 0, base = 0, ce = cnt[0], mt = (ce + 255) >> 8;
    auto src = [&](int i, G8Desc& d) -> bool {
        const int t = sq.q + i * sq.step;
        if (t >= sq.qend) return false;
        while (e < 32 && t >= base + mt * NTN) { base += mt * NTN; ++e; if (e < 32) { ce = cnt[e]; mt = (ce + 255) >> 8; } }
        if (e >= 32) return false;
        int mi, ni;
        { const int loc = t - base, pf = mt >> 2, full = pf * 4 * NTN;
          if (loc < full) { const int pn = loc / (4 * NTN), r = loc - pn * 4 * NTN; ni = r >> 2; mi = pn * 4 + (r & 3); }
          else { const int ph = mt - pf * 4, r = loc - full; ni = r / ph; mi = pf * 4 + (r - ni * ph); } }
        d.m0 = 0; d.n0 = ni * 256; d.list = LIST + (size_t)e * LISTCAP + mi * 256; d.count = ce - mi * 256; d.u0 = e; d.ldb = 1024;
        if (WHICH == 1) { d.A = (const bf16_t*)(p.ws + OFF_XB); d.Bt = (const bf16_t*)(p.ws + OFF_WT_W1) + (size_t)(layer * 32 + e) * 2048 * 1024; }
        else { d.A = (const bf16_t*)(p.ws + OFF_ACT); d.Bt = (const bf16_t*)(p.ws + OFF_WT_W2) + (size_t)(layer * 32 + e) * 1024 * 1024; }
        return true; };
    if (WHICH == 1) {
        bf16_t* ACT = (bf16_t*)(p.ws + OFF_ACT);
        gemm256_stream<true, 2>(src, 1024, 1024, smem,
            [&](int, int e_, f32x4 (&acc)[4][2], int rt0, int c0, int fr, int fq, const int* sRow) {
                const float* b1 = p.moe_b1 + (size_t)(layer * 32 + e_) * 2048;
                const int gcol = (c0 >> 5) * 16 + 4 * fq;
                const f32x4 bg = *(const f32x4*)(b1 + gcol), bl = *(const f32x4*)(b1 + 1024 + gcol);
#pragma unroll
                for (int m = 0; m < 4; ++m) {
                    const int pair = NOEPI ? -1 : sRow[rt0 + m * 16 + fr];
                    if (pair >= 0) {
                        float a[4];
#pragma unroll
                        for (int r = 0; r < 4; ++r) {
                            const float gl = fminf(acc[m][0][r] + bg[r], 7.f);
                            const float li = fminf(fmaxf(acc[m][1][r] + bl[r], -7.f), 7.f);
                            a[r] = gl * sigmoidf_(1.702f * gl) * (li + 1.f);
                        }
                        u32x2 w; w.x = pk2(a[0], a[1]); w.y = pk2(a[2], a[3]);
                        *(u32x2*)(ACT + (size_t)pair * 1024 + gcol) = w;
                    }
                }
            });
    } else {
        const float* GATE = (const float*)(p.ws + OFF_GATE);
        bf16_t* SLOT = (bf16_t*)(p.ws + OFF_SLOT);
        gemm256_stream<true, 0>(src, 1024, 1024, smem,
            [&](int, int e_, f32x4 (&acc)[4][2], int rt0, int c0, int fr, int fq, const int* sRow) {
                const float* b2 = p.moe_b2 + (size_t)(layer * 32 + e_) * 1024;
                const int col = c0 + 8 * fq;
                const f32x4 b20 = *(const f32x4*)(b2 + col), b21 = *(const f32x4*)(b2 + col + 4);
#pragma unroll
                for (int m = 0; m < 4; ++m) {
                    const int pair = NOEPI ? -1 : sRow[rt0 + m * 16 + fr];
                    if (pair >= 0) {
                        const float gt = GATE[pair];
                        const f32x4 y0 = (acc[m][0] + b20) * gt, y1 = (acc[m][1] + b21) * gt;
                        u32x4 w; w.x = pk2(y0[0], y0[1]); w.y = pk2(y0[2], y0[3]); w.z = pk2(y1[0], y1[1]); w.w = pk2(y1[2], y1[3]);
                        *(u32x4*)(SLOT + (size_t)pair * 1024 + col) = w;
                    }
                }
            });
    }
}

__device__ __forceinline__ void epi_od_in(PRef p, f32x4 (&acc)[4][2], int row0, int c0, int fr, int fq) {
    char* ws = p.ws;
    bf16_t* PO = (bf16_t*)(ws + OFF_PO); float* WI = (float*)(ws + OFF_WI);
    const int col = c0 + 8 * fq;
#pragma unroll
    for (int m = 0; m < 4; ++m) {
        const int t = row0 + m * 16 + fr;
        if (c0 < OD_WI) {
            u32x4 w; w.x = pk2(acc[m][0][0], acc[m][0][1]); w.y = pk2(acc[m][0][2], acc[m][0][3]); w.z = pk2(acc[m][1][0], acc[m][1][1]); w.w = pk2(acc[m][1][2], acc[m][1][3]);
            *(u32x4*)(PO + (size_t)t * OD_P + col) = w;
        } else if (col == OD_WI) {
            *(f32x4*)(WI + (size_t)t * 4) = acc[m][0];
        }
    }
}

__device__ __forceinline__ void idx_scores(const char* __restrict__ ktile, int kbase, const bf16x8 (&qf)[4][4], const float (&wi)[4], int lane, float (&sc)[16]) {
    const int r = lane & 31, h2 = lane >> 5;
    const char* kp = ktile + (kbase + r) * 144 + h2 * 16;
    bf16x8 kf[4];
#pragma unroll
    for (int s = 0; s < 4; ++s) kf[s] = *(const bf16x8*)(kp + s * 32);
#pragma unroll
    for (int i = 0; i < 16; ++i) sc[i] = 0.f;
#pragma unroll
    for (int hd = 0; hd < 4; ++hd) {
        f32x16 a;
#pragma unroll
        for (int i = 0; i < 16; ++i) a[i] = 0.f;
#pragma unroll
        for (int s = 0; s < 4; ++s) a = __builtin_amdgcn_mfma_f32_32x32x16_bf16(kf[s], qf[hd][s], a, 0, 0, 0);
#pragma unroll
        for (int i = 0; i < 16; ++i) { const int ai = __float_as_int(a[i]); sc[i] += wi[hd] * __int_as_float(ai > 0 ? ai : 0); }
    }
}
__device__ __forceinline__ unsigned ord_key(float s) {
    const unsigned u = __float_as_uint(s);
    return u ^ ((unsigned)((int)u >> 31) | 0x80000000u);
}

constexpr int SEL_KT = 128 * 144;
__device__ __forceinline__ void dsa_select_item(PRef p, int b, int qb, char* smem) {
    unsigned* hist = (unsigned*)smem;
    unsigned* pref = (unsigned*)(smem + 66048);
    int* krem = (int*)(smem + 66048 + 256);
    unsigned* GW = (unsigned*)(smem + 66048 + 512);
    unsigned* EW = (unsigned*)(smem + 66048 + 512 + 1024);
    char* kbuf = smem + 69632;
    const bf16_t* PO = (const bf16_t*)(p.ws + OFF_PO);
    const float* WI = (const float*)(p.ws + OFF_WI);
    unsigned long long* BMT = (unsigned long long*)(p.ws + OFF_BM);
    const int tid = otid(), lane = tid & 63, wave = tid >> 6, kw = wave >> 1, qw = wave & 1, h2 = lane >> 5;
    const int p0 = qb * 64;
    const int ql = qw * 32 + (lane & 31);
    const int qpos = p0 + ql;
    const size_t tq = (size_t)b * L_ + qpos;
    const int nkt = (p0 + 64 + 127) >> 7;
    bf16x8 qf[4][4]; float wi[4];
#pragma unroll
    for (int hd = 0; hd < 4; ++hd) {
        wi[hd] = WI[tq * 4 + hd];
#pragma unroll
        for (int s = 0; s < 4; ++s) qf[hd][s] = *(const bf16x8*)(PO + tq * OD_P + OD_QI + hd * 64 + s * 16 + h2 * 8);
    }
    const int srow = tid >> 3, sch = tid & 7;
    const bf16_t* ksrc = PO + ((size_t)b * L_ + srow) * OD_P + OD_KI + sch * 8;
    char* kdst = kbuf + srow * 144 + sch * 16;
    for (int e = tid; e < 64 * 257; e += NTHR) hist[e] = 0u;
    if (tid < 64) { pref[tid] = 0u; krem[tid] = 256; }
    __syncthreads();
    const bool selall = qpos < 256;
    const int npass = (p0 + 63 >= 256) ? 3 : 0;
    for (int pass = 0; pass <= npass; ++pass) {
        const bool maskpass = pass == npass;
        const int sh = 24 - 8 * pass;
        const unsigned mypref = pref[ql];
        int ceq = 0;
        const int rsel = tid < 64 ? krem[tid] : 0;
        u32x4 r0 = *(const u32x4*)ksrc, r1 = *(const u32x4*)(ksrc + (size_t)64 * OD_P);
        *(u32x4*)kdst = r0; *(u32x4*)(kdst + 64 * 144) = r1;
        __syncthreads();
        for (int kt = 0; kt < nkt; ++kt) {
            const bool more = kt + 1 < nkt;
            if (more) { r0 = *(const u32x4*)(ksrc + (size_t)(kt + 1) * 128 * OD_P); r1 = *(const u32x4*)(ksrc + (size_t)((kt + 1) * 128 + 64) * OD_P); }
            float sc[16];
            idx_scores(kbuf + (kt & 1) * SEL_KT, kw * 32, qf, wi, lane, sc);
            const int keybase = kt * 128 + kw * 32;
            const bool diag = kt == nkt - 1;
            if (!maskpass) {
                if (pass == 0 && !diag && p0 >= 256) {
#pragma unroll
                    for (int i = 0; i < 16; ++i) atomicAdd(&hist[ql * 257 + (ord_key(sc[i]) >> 24)], 1u);
                } else {
#pragma unroll
                    for (int i = 0; i < 16; ++i) {
                        const int key = keybase + (i & 3) + 8 * (i >> 2) + 4 * h2;
                        const unsigned k32 = ord_key(sc[i]);
                        const bool match = pass == 0 ? true : ((k32 >> (sh + 8)) == mypref);
                        const bool valid = diag ? key <= qpos : true;
                        if (valid && !selall && match) atomicAdd(&hist[ql * 257 + ((k32 >> sh) & 255u)], 1u);
                    }
                }
                if (more) { char* nd = kdst + ((kt + 1) & 1) * SEL_KT; *(u32x4*)nd = r0; *(u32x4*)(nd + 64 * 144) = r1; }
                __syncthreads();
            } else {
                unsigned gw = 0u, ew = 0u;
#pragma unroll
                for (int i = 0; i < 16; ++i) {
                    const int ko = (i & 3) + 8 * (i >> 2) + 4 * h2;
                    const int key = keybase + ko;
                    const unsigned k24 = ord_key(sc[i]) >> 8;
                    const bool valid = diag ? key <= qpos : true;
                    const bool g = valid && (selall || k24 > mypref);
                    const bool e = valid && !selall && k24 == mypref;
                    gw |= (g ? 1u : 0u) << ko; ew |= (e ? 1u : 0u) << ko;
                }
                gw = xor32_or(gw); ew = xor32_or(ew);
                if (h2 == 0) { GW[ql * 4 + kw] = gw; EW[ql * 4 + kw] = ew; }
                if (more) { char* nd = kdst + ((kt + 1) & 1) * SEL_KT; *(u32x4*)nd = r0; *(u32x4*)(nd + 64 * 144) = r1; }
                __syncthreads();
                if (tid < 64) {
                    unsigned g4[4], e4[4];
#pragma unroll
                    for (int w = 0; w < 4; ++w) { g4[w] = GW[tid * 4 + w]; e4[w] = EW[tid * 4 + w]; }
                    int need = rsel - ceq; if (need < 0) need = 0;
#pragma unroll
                    for (int w = 0; w < 4; ++w) {
                        const int pc = __popc(e4[w]);
                        ceq += pc;
                        if (need >= pc) need -= pc;
                        else { unsigned m = e4[w], kept = 0u; for (int k = 0; k < need; ++k) { const unsigned low = m & (0u - m); kept |= low; m ^= low; } e4[w] = kept; need = 0; }
                        g4[w] |= e4[w];
                    }
                    BMT[((size_t)(b * 256 + 2 * kt)) * L_ + p0 + tid] = (unsigned long long)g4[0] | ((unsigned long long)g4[1] << 32);
                    BMT[((size_t)(b * 256 + 2 * kt + 1)) * L_ + p0 + tid] = (unsigned long long)g4[2] | ((unsigned long long)g4[3] << 32);
                }
                __syncthreads();
            }
        }
        if (!maskpass) {
            const int q = tid >> 3, part = tid & 7;
            unsigned c32[32]; unsigned tot = 0u;
#pragma unroll
            for (int i = 0; i < 32; ++i) { c32[i] = hist[q * 257 + part * 32 + i]; tot += c32[i]; }
            unsigned above = 0u;
#pragma unroll
            for (int d = 1; d < 8; ++d) { const unsigned o = __shfl(tot, (lane & ~7) + ((part + d) & 7), 64); if (part + d < 8) above += o; }
            const unsigned need = (unsigned)krem[q];
            __syncthreads();
            if ((p0 + q) >= 256 && above < need && above + tot >= need) {
                unsigned cum = above; int dg = 31;
#pragma unroll
                for (int i = 31; i >= 0; --i) { if (i == dg) { if (cum + c32[i] >= need) {   } else { cum += c32[i]; dg = i - 1; } } }
                pref[q] = (pref[q] << 8) | (unsigned)(part * 32 + dg);
                krem[q] = (int)(need - cum);
            }
            for (int e = tid; e < 64 * 257; e += NTHR) hist[e] = 0u;
            __syncthreads();
        }
    }
}

template <int MODE, int NQT>
__device__ __forceinline__ void attn_wave(PRef p, int b, int head, int qcol, int kcol, const bf16_t* __restrict__ VT, int voff,
                                          int i0, int sh  , int rho, int kt_lo, int kt_hi, int grp) {
    const bf16_t* PO = (const bf16_t*)(p.ws + OFF_PO);
    const unsigned* BM32 = (const unsigned*)(p.ws + OFF_BM);
    const int lane = otid() & 63, r = lane & 31, h2 = lane >> 5;
    const int pr = (r & 0x13) | ((r & 4) << 1) | ((r & 8) >> 1);
    const float SC = 0.125f * 1.4426950408889634f;
    bf16x8 qf[NQT][4]; size_t tq[NQT]; int qi[NQT];
#pragma unroll
    for (int qt = 0; qt < NQT; ++qt) {
        qi[qt] = i0 + qt * 32 + r;
        tq[qt] = (size_t)b * L_ + ((size_t)qi[qt] << sh) + rho;
#pragma unroll
        for (int s = 0; s < 4; ++s) qf[qt][s] = *(const bf16x8*)(PO + tq[qt] * OD_P + qcol + head * 64 + s * 16 + h2 * 8);
    }
    f32x16 oacc[NQT][2];
#pragma unroll
    for (int a = 0; a < NQT; ++a)
#pragma unroll
        for (int c = 0; c < 2; ++c)
#pragma unroll
            for (int i = 0; i < 16; ++i) oacc[a][c][i] = 0.f;
    float mrun[NQT], lrun[NQT];
#pragma unroll
    for (int a = 0; a < NQT; ++a) { mrun[a] = -1e30f; lrun[a] = 0.f; }
    bf16x8 kf[4]; unsigned mw[NQT];
    auto load_k = [&](int kt, bf16x8 (&k_)[4], unsigned (&m_)[NQT]) {
        const size_t krow = (size_t)b * L_ + ((size_t)(kt * 32 + pr) << sh) + rho;
#pragma unroll
        for (int s = 0; s < 4; ++s) k_[s] = *(const bf16x8*)(PO + krow * OD_P + kcol + head * 64 + s * 16 + h2 * 8);
#pragma unroll
        for (int a = 0; a < NQT; ++a) m_[a] = MODE == 0 ? BM32[tq[a] * 512 + kt] : 0u;
    };
    load_k(kt_lo, kf, mw);
#pragma unroll 1
    for (int kt = kt_lo; kt <= kt_hi; ++kt) {
        bf16x8 vf[2][2];
#pragma unroll
        for (int db = 0; db < 2; ++db)
#pragma unroll
            for (int s2 = 0; s2 < 2; ++s2) vf[db][s2] = *(const bf16x8*)(VT + (size_t)(db * 32 + r) * L_ + voff + kt * 32 + s2 * 16 + h2 * 8);
        bf16x8 kn[4]; unsigned mn[NQT];
#pragma unroll
        for (int a = 0; a < NQT; ++a) mn[a] = 0u;
        if (kt < kt_hi) load_k(kt + 1, kn, mn);
#pragma unroll
        for (int qt = 0; qt < NQT; ++qt) {
            f32x16 s;
#pragma unroll
            for (int i = 0; i < 16; ++i) s[i] = 0.f;
#pragma unroll
            for (int ks = 0; ks < 4; ++ks) s = __builtin_amdgcn_mfma_f32_32x32x16_bf16(kf[ks], qf[qt][ks], s, 0, 0, 0);
            unsigned selm = 0u; float mx = -1e30f;
#pragma unroll
            for (int i = 0; i < 16; ++i) {
                const int ko = 16 * (i >> 3) + 8 * h2 + 4 * ((i >> 2) & 1) + (i & 3);
                bool sl;
                if (MODE == 0) sl = (mw[qt] >> ko) & 1u;
                else { const int kk = kt * 32 + ko; sl = (kk <= qi[qt]) && (kk >= qi[qt] - 128); }
                selm |= (sl ? 1u : 0u) << i;
                s[i] = sl ? s[i] * SC : -1e30f;
                mx = fmaxf(mx, s[i]);
            }
            mx = xor32_max(mx);
            const float mnew = fmaxf(mrun[qt], mx);
            const float corr = __builtin_amdgcn_exp2f(mrun[qt] - mnew);
            mrun[qt] = mnew;
            float ps = 0.f;
#pragma unroll
            for (int i = 0; i < 16; ++i) { s[i] = ((selm >> i) & 1u) ? __builtin_amdgcn_exp2f(s[i] - mnew) : 0.f; ps += s[i]; }
            lrun[qt] = lrun[qt] * corr + ps;
#pragma unroll
            for (int db = 0; db < 2; ++db)
#pragma unroll
                for (int i = 0; i < 16; ++i) oacc[qt][db][i] *= corr;
#pragma unroll
            for (int s2 = 0; s2 < 2; ++s2) {
                u32x4 pw; pw.x = pk2(s[8 * s2], s[8 * s2 + 1]); pw.y = pk2(s[8 * s2 + 2], s[8 * s2 + 3]); pw.z = pk2(s[8 * s2 + 4], s[8 * s2 + 5]); pw.w = pk2(s[8 * s2 + 6], s[8 * s2 + 7]);
                const bf16x8 pf = __builtin_bit_cast(bf16x8, pw);
#pragma unroll
                for (int db = 0; db < 2; ++db) oacc[qt][db] = __builtin_amdgcn_mfma_f32_32x32x16_bf16(vf[db][s2], pf, oacc[qt][db], 0, 0, 0);
            }
        }
        if (kt < kt_hi) {
#pragma unroll
            for (int s = 0; s < 4; ++s) kf[s] = kn[s];
#pragma unroll
            for (int a = 0; a < NQT; ++a) mw[a] = mn[a];
        }
    }
#pragma unroll
    for (int qt = 0; qt < NQT; ++qt) {
        const float lt = xor32_sum(lrun[qt]);
        const float inv = 1.f / lt;
        if (MODE == 0) {
            bf16_t* CC = (bf16_t*)(p.ws + OFF_CC);
#pragma unroll
            for (int db = 0; db < 2; ++db)
#pragma unroll
                for (int i = 0; i < 16; ++i) {
                    const int d = db * 32 + (i & 3) + 8 * (i >> 2) + 4 * h2;
                    CC[tq[qt] * 1024 + head * 64 + d] = f2bf(oacc[qt][db][i] * inv);
                }
        } else {
            float* OD = (float*)(p.ws + OFF_OD) + (size_t)grp * T_ * 512;
#pragma unroll
            for (int db = 0; db < 2; ++db)
#pragma unroll
                for (int i = 0; i < 16; i += 4) {
                    const int d = db * 32 + 8 * (i >> 2) + 4 * h2;
                    *(f32x4*)(OD + tq[qt] * 512 + head * 64 + d) = (f32x4){oacc[qt][db][i] * inv, oacc[qt][db][i + 1] * inv, oacc[qt][db][i + 2] * inv, oacc[qt][db][i + 3] * inv};
                }
            if (h2 == 0) ((float*)(p.ws + OFF_LSE))[((size_t)grp * T_ + tq[qt]) * 8 + head] = mrun[qt] + log2f(lt);
        }
    }
}

__device__ __forceinline__ void dil_combine_phase(PRef p, int bid, int nb) {
    const float* OD = (const float*)(p.ws + OFF_OD); const float* LSE = (const float*)(p.ws + OFF_LSE);
    bf16_t* CC = (bf16_t*)(p.ws + OFF_CC);
    const long n = (long)T_ * 128;
    for (long c = (long)bid * NTHR + otid(); c < n; c += (long)nb * NTHR) {
        const long t = c >> 7; const int ch = (int)(c & 127) * 4, hd = ch >> 6;
        const float l0 = LSE[((size_t)0 * T_ + t) * 8 + hd], l1 = LSE[((size_t)1 * T_ + t) * 8 + hd], l2 = LSE[((size_t)2 * T_ + t) * 8 + hd];
        const float mx = fmaxf(l0, fmaxf(l1, l2));
        const float w0 = __builtin_amdgcn_exp2f(l0 - mx), w1 = __builtin_amdgcn_exp2f(l1 - mx), w2 = __builtin_amdgcn_exp2f(l2 - mx);
        const float inv = __builtin_amdgcn_rcpf(w0 + w1 + w2);
        const f32x4 a = *(const f32x4*)(OD + ((size_t)0 * T_ + t) * 512 + ch), bq = *(const f32x4*)(OD + ((size_t)1 * T_ + t) * 512 + ch),
                    cq = *(const f32x4*)(OD + ((size_t)2 * T_ + t) * 512 + ch);
        const f32x4 o = (a * w0 + bq * w1 + cq * w2) * inv;
        u32x2 w; w.x = pk2(o[0], o[1]); w.y = pk2(o[2], o[3]);
        *(u32x2*)(CC + (size_t)t * 1024 + 512 + ch) = w;
    }
}

constexpr int DA_ROW = 144;
constexpr int DA_TILE = 64 * DA_ROW;
__device__ __forceinline__ void dsa_attn_item(PRef p, int b, int head, int qb, char* smem) {
    const bf16_t* PO = (const bf16_t*)(p.ws + OFF_PO);
    const bf16_t* VT = (const bf16_t*)(p.ws + OFF_VTC) + ((size_t)(b * 8 + head)) * 64 * L_;
    const int tid = otid(), lane = tid & 63, wave = tid >> 6, r = lane & 31, h2 = lane >> 5;
    const int pr = (r & 0x13) | ((r & 4) << 1) | ((r & 8) >> 1);
    const float SC = 0.125f * 1.4426950408889634f;
    const int i0 = qb * 256 + wave * 32, qi = i0 + r;
    const unsigned long long* BMT = (const unsigned long long*)(p.ws + OFF_BM) + (size_t)b * 256 * L_ + qi;
    const size_t tq = (size_t)b * L_ + qi;
    bf16x8 qf[4];
#pragma unroll
    for (int s = 0; s < 4; ++s) qf[s] = *(const bf16x8*)(PO + tq * OD_P + head * 64 + s * 16 + h2 * 8);
    f32x16 oacc[2];
#pragma unroll
    for (int c = 0; c < 2; ++c)
#pragma unroll
        for (int i = 0; i < 16; ++i) oacc[c][i] = 0.f;
    float mrun = -1e30f, lrun = 0.f;
    const int nkt = qb * 4 + 4, my_last = (i0 + 31) >> 6;
    const int srow = tid >> 3, sch = tid & 7;
    const bf16_t* ksrc = PO + ((size_t)b * L_ + srow) * OD_P + 512 + head * 64 + sch * 8;
    const bf16_t* vsrc = VT + (size_t)srow * L_ + sch * 8;
    u32x4 rk = *(const u32x4*)ksrc, rv = *(const u32x4*)vsrc;
    __syncthreads();
    *(u32x4*)(smem + srow * DA_ROW + sch * 16) = rk;
    *(u32x4*)(smem + DA_TILE + srow * DA_ROW + sch * 16) = rv;
    __syncthreads();
    unsigned long long mwn = BMT[0];
#pragma unroll 1
    for (int kt = 0; kt < nkt; ++kt) {
        const bool more = kt + 1 < nkt;
        if (more) { rk = *(const u32x4*)(ksrc + (size_t)(kt + 1) * 64 * OD_P); rv = *(const u32x4*)(vsrc + (kt + 1) * 64); }
        const unsigned long long mw64 = mwn;
        if (kt < my_last) mwn = BMT[(size_t)(kt + 1) * L_];
        if (kt <= my_last) {
            const char* kb = smem + (kt & 1) * 2 * DA_TILE; const char* vb = kb + DA_TILE;
#pragma unroll
            for (int sub = 0; sub < 2; ++sub) {
                const unsigned mw = sub == 0 ? (unsigned)mw64 : (unsigned)(mw64 >> 32);
                bf16x8 kf[4], vf[2][2];
#pragma unroll
                for (int s = 0; s < 4; ++s) kf[s] = *(const bf16x8*)(kb + (sub * 32 + pr) * DA_ROW + (s * 16 + h2 * 8) * 2);
#pragma unroll
                for (int db = 0; db < 2; ++db)
#pragma unroll
                    for (int s2 = 0; s2 < 2; ++s2) vf[db][s2] = *(const bf16x8*)(vb + (db * 32 + r) * DA_ROW + (sub * 32 + s2 * 16 + h2 * 8) * 2);
                f32x16 s;
#pragma unroll
                for (int i = 0; i < 16; ++i) s[i] = 0.f;
#pragma unroll
                for (int ks = 0; ks < 4; ++ks) s = __builtin_amdgcn_mfma_f32_32x32x16_bf16(kf[ks], qf[ks], s, 0, 0, 0);
                float mx = fmaxf(fmaxf(s[0], s[1]), fmaxf(s[2], s[3]));
#pragma unroll
                for (int i = 4; i < 16; i += 2) mx = fmaxf(mx, fmaxf(s[i], s[i + 1]));
                mx = xor32_max(mx) * SC;
                if (__builtin_amdgcn_ballot_w64(mx > mrun) != 0ull) {
                    const float mnew = fmaxf(mrun, mx);
                    const float corr = __builtin_amdgcn_exp2f(mrun - mnew);
                    mrun = mnew; lrun *= corr;
#pragma unroll
                    for (int db = 0; db < 2; ++db)
#pragma unroll
                        for (int i = 0; i < 16; ++i) oacc[db][i] *= corr;
                }
                float ps = 0.f;
                const int mws = (int)(mw >> (8 * h2));
#pragma unroll
                for (int i = 0; i < 16; ++i) {
                    const int ko = 16 * (i >> 3) + 4 * ((i >> 2) & 1) + (i & 3);
                    const float e = __builtin_amdgcn_exp2f(__builtin_fmaf(s[i], SC, -mrun));
                    s[i] = __uint_as_float(__float_as_uint(e) & (unsigned)__builtin_amdgcn_sbfe(mws, ko, 1));
                    ps += s[i];
                }
                lrun += ps;
#pragma unroll
                for (int s2 = 0; s2 < 2; ++s2) {
                    u32x4 pw; pw.x = pk2(s[8 * s2], s[8 * s2 + 1]); pw.y = pk2(s[8 * s2 + 2], s[8 * s2 + 3]); pw.z = pk2(s[8 * s2 + 4], s[8 * s2 + 5]); pw.w = pk2(s[8 * s2 + 6], s[8 * s2 + 7]);
                    const bf16x8 pf = __builtin_bit_cast(bf16x8, pw);
#pragma unroll
                    for (int db = 0; db < 2; ++db) oacc[db] = __builtin_amdgcn_mfma_f32_32x32x16_bf16(vf[db][s2], pf, oacc[db], 0, 0, 0);
                }
            }
        }
        if (more) {
            char* nbuf = smem + ((kt + 1) & 1) * 2 * DA_TILE;
            *(u32x4*)(nbuf + srow * DA_ROW + sch * 16) = rk;
            *(u32x4*)(nbuf + DA_TILE + srow * DA_ROW + sch * 16) = rv;
        }
        __syncthreads();
    }
    const float lt = xor32_sum(lrun);
    const float inv = 1.f / lt;
    bf16_t* CC = (bf16_t*)(p.ws + OFF_CC);
#pragma unroll
    for (int db = 0; db < 2; ++db)
#pragma unroll
        for (int i = 0; i < 16; i += 4) {
            const int d = db * 32 + 8 * (i >> 2) + 4 * h2;
            u32x2 w; w.x = pk2(oacc[db][i] * inv, oacc[db][i + 1] * inv); w.y = pk2(oacc[db][i + 2] * inv, oacc[db][i + 3] * inv);
            *(u32x2*)(CC + tq * 1024 + head * 64 + d) = w;
        }
}


template <bool ODD>
__device__ __forceinline__ void inproj_phase(PRef p, int j, char* smem, int bid, int nb) {
    char* ws = p.ws;
    constexpr int NTN = ODD ? OD_P / 256 : EV_P / 256, NMAIN = 128 * NTN, NVT = ODD ? 1024 : 256;
    const bf16_t* XB = (const bf16_t*)(ws + OFF_XB);
    const bf16_t* W = ODD ? (const bf16_t*)(ws + OFF_WT_ODIN) + (size_t)j * OD_N * 1024 : (const bf16_t*)(ws + OFF_WT_EVIN) + (size_t)j * EV_N * 1024;
    XcdSeq s(NMAIN + NVT, bid, nb);
    gemm256_stream<false, 0>(
        [&](int i, G8Desc& d) -> bool {
            const int Q = s.q + i * s.step; if (Q >= s.qend) return false;
            d.list = nullptr; d.count = 0;
            if (Q < NMAIN) {
                const int pnl = Q / (4 * NTN), r = Q - pnl * 4 * NTN;
                d.A = XB; d.Bt = W; d.m0 = (pnl * 4 + (r & 3)) * 256; d.n0 = (r >> 2) * 256; d.u0 = -1; d.ldb = 1024;
            } else {
                const int v = Q - NMAIN; d.m0 = 0; d.n0 = 0; d.u0 = v;
                if (ODD) {
                    const int combo = v & 7, src = combo >> 1, mt = combo & 1, bn = v >> 3, b = bn >> 6, lam0 = (bn & 63) * 256;
                    const int sh = src < 2 ? 0 : (src == 2 ? 2 : 4), rho = lam0 >> (14 - sh), i0 = lam0 & ((L_ >> sh) - 1);
                    d.A = W + (size_t)(OD_P + src * 512 + mt * 256) * 1024;
                    d.Bt = XB + ((size_t)b * L_ + ((size_t)i0 << sh) + rho) * 1024; d.ldb = 1024 << sh;
                } else {
                    const int mt = v & 1, bn = v >> 1;
                    d.A = W + (size_t)(EV_P + mt * 256) * 1024;
                    d.Bt = XB + (size_t)bn * 256 * 1024; d.ldb = 1024;
                }
            }
            return true; },
        1024, 1024, smem,
        [&](int m0, int u0, f32x4 (&acc)[4][2], int rt0, int c0, int fr, int fq, const int*) {
            if (u0 < 0) { if (ODD) epi_od_in(p, acc, m0 + rt0, c0, fr, fq); else epi_ev_in(p, acc, m0 + rt0, c0, fr, fq); }
            else if (ODD) {
                const int combo = u0 & 7, src = combo >> 1, mt = combo & 1, bn = u0 >> 3, b = bn >> 6, lam0 = (bn & 63) * 256;
                bf16_t* img = src == 0 ? (bf16_t*)(ws + OFF_VTC) + ((size_t)(b * 8) * 64 + mt * 256) * L_ + lam0
                                       : (bf16_t*)(ws + OFF_VTD) + ((size_t)((b * 3 + src - 1) * 8) * 64 + mt * 256) * L_ + lam0;
                epi_vt(img, acc, rt0, c0, fr, fq);
            } else {
                const int mt = u0 & 1, bn = u0 >> 1, b = bn >> 6, lam0 = (bn & 63) * 256;
                epi_vt((bf16_t*)(ws + OFF_VTE) + ((size_t)(b * 4) * 128 + mt * 256) * L_ + lam0, acc, rt0, c0, fr, fq);
            }
        });
}

enum { K_PRO = 0, K_E1, K_E2, K_E3, K_E4, K_E5, K_E6, K_LN1, K_O1, K_O2, K_O3, K_O4, K_M1, K_M2, K_M3, K_M4, K_LN2, K_COUNT };

template <int KIND, bool NOEPI = false>
__device__ __forceinline__ void run_phase(PRef p, int layer, char* smem, int bid, int nb) {
    char* ws = p.ws;
    const int j = layer >> 1;
    if (KIND == K_PRO) {
        conv_phase(p, smem, bid, nb);
        __syncthreads();
        for (int u = nb - 1 - bid; u < 64; u += nb) s5mat_unit(p, u >> 5, u & 31, smem);
    } else if (KIND == K_E1) {
        inproj_phase<false>(p, j, smem, bid, nb);
    } else if (KIND == K_E2) {
        for (int it = bid; it < 2048; it += nb) gla_a_item(p, j, it, smem);
        s5_g_phase(p, j, smem, bid, nb);
    } else if (KIND == K_E3) {
        scan_phase(p, j, bid);
    } else if (KIND == K_E4) {
        for (int it = bid; it < 2048; it += nb) gla_c_item(p, j, it, smem);
        s5_y_phase(p, j, smem, bid, nb);
    } else if (KIND == K_E5) {
        const bf16_t* YA = (const bf16_t*)(ws + OFF_YA); bf16_t* CC = (bf16_t*)(ws + OFF_CC); const float* bg = p.s5_b_glu + (size_t)j * 512;
        gemm256_phase(YA, 512, T_, (const bf16_t*)(ws + OFF_WT_GLU) + (size_t)j * 512 * 512, 512, 512, 512, smem, bid, nb,
                   [&](f32x4 (&acc)[4][2], int row0, int c0, int fr, int fq) {
                       const int col = c0 + 8 * fq;
                       const f32x4 g0 = *(const f32x4*)(bg + col), g1 = *(const f32x4*)(bg + col + 4);
#pragma unroll
                       for (int m = 0; m < 4; ++m) {
                           const size_t t = (size_t)(row0 + m * 16 + fr);
                           const u32x4 yw = *(const u32x4*)(YA + t * 512 + col);
                           float o[8];
#pragma unroll
                           for (int q = 0; q < 4; ++q) {
                               const unsigned y2 = q == 0 ? yw.x : q == 1 ? yw.y : q == 2 ? yw.z : yw.w;
                               const float y0 = __uint_as_float(y2 << 16), y1 = __uint_as_float(y2 & 0xffff0000u);
                               const float a0 = q < 2 ? acc[m][0][2 * q] + g0[2 * q] : acc[m][1][2 * q - 4] + g1[2 * q - 4];
                               const float a1 = q < 2 ? acc[m][0][2 * q + 1] + g0[2 * q + 1] : acc[m][1][2 * q - 3] + g1[2 * q - 3];
                               o[2 * q] = y0 * sigmoidf_(a0); o[2 * q + 1] = y1 * sigmoidf_(a1);
                           }
                           u32x4 w; w.x = pk2(o[0], o[1]); w.y = pk2(o[2], o[3]); w.z = pk2(o[4], o[5]); w.w = pk2(o[6], o[7]);
                           *(u32x4*)(CC + t * 1024 + 512 + col) = w;
                       }
                   });
    } else if (KIND == K_E6 || KIND == K_O4) {
        float* MIX = (float*)(ws + OFF_MIX);
        const bf16_t* W = (const bf16_t*)(ws + (KIND == K_E6 ? OFF_WT_EVOUT : OFF_WT_ODOUT)) + (size_t)j * 1024 * 1024;
        gemm256_phase((const bf16_t*)(ws + OFF_CC), 1024, T_, W, 1024, 1024, 1024, smem, bid, nb,
                   [&](f32x4 (&acc)[4][2], int row0, int c0, int fr, int fq) {
#pragma unroll
                       for (int m = 0; m < 4; ++m) {
                           float* o = MIX + (size_t)(row0 + m * 16 + fr) * 1024 + c0 + 8 * fq;
                           *(f32x4*)o = acc[m][0]; *(f32x4*)(o + 4) = acc[m][1];
                       }
                   });
    } else if (KIND == K_LN1) {
        const float* xin = layer == 0 ? p.x : (const float*)(ws + OFF_XR);
        ln1_router_phase<NOEPI>(p, layer, xin, smem, bid, nb);
    } else if (KIND == K_O1) {
        inproj_phase<true>(p, j, smem, bid, nb);
    } else if (KIND == K_O2) {
        if (!NOEPI) for (int k = bid; k < 256; k += nb) {
            dsa_select_item(p, k & 1, k >> 1, smem);
            __syncthreads();
            const int k2 = 511 - k;
            dsa_select_item(p, k2 & 1, k2 >> 1, smem);
            __syncthreads();
        }
        const int head = otid() >> 6;
        for (int it = bid; it < 1536; it += nb) {
            const int b = it / 768, rem = it - b * 768, g = rem >> 8, u = rem & 255;
            const int sh = g * 2, per = 256 >> sh, rho = u / per, qblk = u - rho * per;
            const bf16_t* VT = (const bf16_t*)(ws + OFF_VTD) + ((size_t)((b * 3 + g) * 8 + head)) * 64 * L_;
#pragma unroll 1
            for (int hf = 0; hf < 2; ++hf) {
                const int hi = 2 * qblk + hf, lo = hi - 4;
                attn_wave<1, 1>(p, b, head, OD_DIL + g * 512, OD_DIL + 1536 + g * 512, VT, rho * (L_ >> sh), qblk * 64 + hf * 32, sh, rho, lo < 0 ? 0 : lo, hi, g);
            }
        }
    } else if (KIND == K_O3) {
        for (int k = bid; k < 512; k += nb) {
            const int bh = k >> 5, q0 = k & 31;
#pragma unroll 1
            for (int half = 0; half < 2; ++half) dsa_attn_item(p, bh >> 3, bh & 7, half == 0 ? q0 : 63 - q0, smem);
        }
        dil_combine_phase(p, bid, nb);
    } else if (KIND == K_M1) {
        float* LG = (float*)(ws + OFF_LOGIT); const float* rb = p.router_b + (size_t)layer * 32;
        gemm_phase((const bf16_t*)(ws + OFF_XB), 1024, T_, (const bf16_t*)(ws + OFF_WT_RT) + (size_t)layer * 128 * 1024, 1024, 128, 1024, smem, bid, nb,
                   [&](f32x4 (&acc)[4][2], int row0, int c0, int fr, int fq) {
#pragma unroll
                       for (int n = 0; n < 2; ++n) {
                           const int col = c0 + n * 16 + fr;
                           if (col < 32) {
#pragma unroll
                               for (int m = 0; m < 4; ++m)
#pragma unroll
                                   for (int r = 0; r < 4; ++r) LG[(size_t)(row0 + m * 16 + fq * 4 + r) * 32 + col] = acc[m][n][r] + rb[col];
                           }
                       }
                   });
    } else if (KIND == K_M2) {
        topk_phase(p, layer, bid, nb);
    } else if (KIND == K_M3) {
        moe_gemm_phase<1, NOEPI>(p, layer, smem, bid, nb);
    } else if (KIND == K_M4) {
        moe_gemm_phase<2, NOEPI>(p, layer, smem, bid, nb);
    } else if (KIND == K_LN2) {
        float* xo = layer == 3 ? p.out : (float*)(ws + OFF_XR);
        ln_phase<true, NOEPI>(p, (const float*)(ws + OFF_XR), (const float*)(ws + OFF_SLOT), p.ln2_g + (size_t)layer * 1024, p.ln2_b + (size_t)layer * 1024, xo,
                       layer == 3 ? (bf16_t*)nullptr : (bf16_t*)(ws + OFF_XB), bid, nb);
    }
}

extern __shared__ __attribute__((aligned(16))) char dyn_smem[];

#if !MEGA
template <int KIND>
__global__ void __launch_bounds__(NTHR, 2) k_phase(Params p, int layer) { run_phase<KIND>(p, layer, dyn_smem, blockIdx.x, gridDim.x); }
#else
#ifndef DUPMASK
#define DUPMASK 0
#endif
typedef const __attribute__((address_space(4))) Params* KParams;
#define RUNP(K) do { KParams _q = kp0; asm volatile("" : "+s"(_q)); run_phase<K>(*_q, layer, smem, bid, nb); } while (0)
#ifndef DUPNOEPI
#define DUPNOEPI 0
#endif
#define RUNP2(K) do { KParams _q = kp0; asm volatile("" : "+s"(_q)); run_phase<K, (DUPNOEPI != 0)>(*_q, layer, smem, bid, nb); } while (0)
#define PHASE(K) do { RUNP(K); xcd_barrier(bar); if ((DUPMASK >> 30) & 1) xcd_barrier(bar); if ((DUPMASK >> K) & 1) { RUNP2(K); xcd_barrier(bar); } } while (0)
template <int LAYER>
__device__ __forceinline__ void mega_layer(KParams kp0, char* smem, int bid, int nb, const XcdBarrier& bar) {
    constexpr int layer = LAYER;
    if ((layer & 1) == 0) { PHASE(K_E1); PHASE(K_E2); PHASE(K_E3); PHASE(K_E4); PHASE(K_E5); PHASE(K_E6); }
    else { PHASE(K_O1); PHASE(K_O2); PHASE(K_O3); PHASE(K_O4); }
    PHASE(K_LN1); PHASE(K_M3); PHASE(K_M4);
    RUNP(K_LN2);
    if (layer < 3) xcd_barrier(bar);
}
__global__ void __launch_bounds__(NTHR, 2) k_mega(Params p) {
    char* smem = dyn_smem;
    const int bid = blockIdx.x, nb = gridDim.x;
    volatile LAS unsigned* st = (volatile LAS unsigned*)(dyn_smem + LDS_BYTES - 16);
    if (otid() == 0) { st[0] = 0u; st[1] = 0u; }
    __syncthreads();
    KParams kp0 = (KParams)__builtin_amdgcn_kernarg_segment_ptr();
    XcdBarrier bar = xcd_barrier_post((unsigned*)(kp0->ws + OFF_BAR), st);
    { const int layer = 0; PHASE(K_PRO); }
    mega_layer<0>(kp0, smem, bid, nb, bar);
    mega_layer<1>(kp0, smem, bid, nb, bar);
    mega_layer<2>(kp0, smem, bid, nb, bar);
    mega_layer<3>(kp0, smem, bid, nb, bar);
}
#endif

extern "C" void kernel_launch(void* const* d_in, const int* in_sizes, int n_in, void* d_out, int out_size, void* d_ws, size_t ws_size, hipStream_t stream) {
    Params p{};
    const float** f = (const float**)&p;
    for (int i = 0; i < 28; ++i) f[i] = (const float*)d_in[i];
    p.out = (float*)d_out; p.ws = (char*)d_ws;
    if (ws_size < WS_NEED) { fprintf(stderr, "workspace too small: %zu < %zu\n", ws_size, (size_t)WS_NEED); return; }
#if !MEGA
#define SETATTR(K) hipFuncSetAttribute((const void*)k_phase<K>, hipFuncAttributeMaxDynamicSharedMemorySize, LDS_BYTES)
#define LAUNCH(K, layer) k_phase<K><<<256, NTHR, LDS_BYTES, stream>>>(p, layer)
    static bool attr_done = false;
    if (!attr_done) {
        SETATTR(K_PRO); SETATTR(K_E1); SETATTR(K_E2); SETATTR(K_E3); SETATTR(K_E4); SETATTR(K_E5); SETATTR(K_E6); SETATTR(K_LN1); SETATTR(K_O1); SETATTR(K_O2); SETATTR(K_O3);
        SETATTR(K_O4); SETATTR(K_M1); SETATTR(K_M2); SETATTR(K_M3); SETATTR(K_M4); SETATTR(K_LN2);
        attr_done = true;
    }
    LAUNCH(K_PRO, 0);
    for (int layer = 0; layer < 4; ++layer) {
        if ((layer & 1) == 0) { LAUNCH(K_E1, layer); LAUNCH(K_E2, layer); LAUNCH(K_E3, layer); LAUNCH(K_E4, layer); LAUNCH(K_E5, layer); LAUNCH(K_E6, layer); }
        else { LAUNCH(K_O1, layer); LAUNCH(K_O2, layer); LAUNCH(K_O3, layer); LAUNCH(K_O4, layer); }
        LAUNCH(K_LN1, layer); LAUNCH(K_M3, layer); LAUNCH(K_M4, layer); LAUNCH(K_LN2, layer);
    }
#else
    static int grid = 0;
    if (!grid) {
        hipFuncSetAttribute((const void*)k_mega, hipFuncAttributeMaxDynamicSharedMemorySize, LDS_BYTES);
        int dev = 0, cus = 0, per_cu = 0;
        hipGetDevice(&dev);
        hipDeviceGetAttribute(&cus, hipDeviceAttributeMultiprocessorCount, dev);
        hipOccupancyMaxActiveBlocksPerMultiprocessor(&per_cu, (const void*)k_mega, NTHR, LDS_BYTES);
        grid = cus * (per_cu < 1 ? per_cu : 1);
        if (grid <= 0) grid = 0;
    }
    if (!grid) { fprintf(stderr, "occupancy query says 0 blocks per CU\n"); return; }
    hipMemsetAsync((char*)d_ws + OFF_BAR, 0, XCD_BAR_WORDS * sizeof(unsigned), stream);
    k_mega<<<grid, NTHR, LDS_BYTES, stream>>>(p);
#endif
}
```

```cpp
#include <hip/hip_runtime.h>
#include <stdint.h>
#include <stdio.h>

#ifndef MEGA
#define MEGA 1
#define DUPMASK 0
#define DUPNOEPI 0
#endif

typedef unsigned short bf16_t;
typedef short bf16x8 __attribute__((ext_vector_type(8)));
typedef float f32x4 __attribute__((ext_vector_type(4)));
typedef float f32x16 __attribute__((ext_vector_type(16)));
typedef unsigned u32x4 __attribute__((ext_vector_type(4)));
typedef unsigned u32x2 __attribute__((ext_vector_type(2)));

constexpr int T_ = 32768, D_ = 1024, L_ = 16384, NB_ = 2;
constexpr int NTHR = 512;
constexpr float ALPHA = 1.681792830507429f;
constexpr float LN_EPS = 1e-5f;
constexpr int EV_N = 2304;
constexpr int EV_P = 1792;
constexpr int PE_W = 1024;
constexpr int OD_N = 6656;
constexpr int OD_P = 4608;
constexpr int OD_QI = 1024, OD_DIL = 1280, OD_KI = 4352, OD_WI = 4416;
constexpr int UHW = 1152;
constexpr int LISTCAP = 131072;

constexpr size_t OFF_BAR = 0;
constexpr size_t OFF_CNT = 16384;
constexpr size_t OFF_A64 = 32768;
constexpr size_t OFF_WT_EVIN = 131072;
constexpr size_t OFF_WT_ODIN = OFF_WT_EVIN + (size_t)2 * EV_N * 1024 * 2;
constexpr size_t OFF_WT_EVOUT = OFF_WT_ODIN + (size_t)2 * OD_N * 1024 * 2;
constexpr size_t OFF_WT_ODOUT = OFF_WT_EVOUT + (size_t)2 * 1024 * 1024 * 2;
constexpr size_t OFF_WT_GLU = OFF_WT_ODOUT + (size_t)2 * 1024 * 1024 * 2;
constexpr size_t OFF_WT_RT = OFF_WT_GLU + (size_t)2 * 512 * 512 * 2;
constexpr size_t OFF_WT_W1 = OFF_WT_RT + (size_t)4 * 128 * 1024 * 2;
constexpr size_t OFF_WT_W2 = OFF_WT_W1 + (size_t)4 * 32 * 2048 * 1024 * 2;
constexpr size_t OFF_TH = OFF_WT_W2 + (size_t)4 * 32 * 1024 * 1024 * 2;
constexpr size_t OFF_GM = OFF_TH + (size_t)2 * 32 * 1024 * UHW * 2;
constexpr size_t OFF_XR = OFF_GM + (size_t)2 * 32 * 128 * 1024 * 2;
constexpr size_t OFF_XB = OFF_XR + (size_t)T_ * 1024 * 4;
constexpr size_t OFF_MIX = OFF_XB + (size_t)T_ * 1024 * 2;
constexpr size_t OFF_CC = OFF_MIX + (size_t)T_ * 1024 * 4;
constexpr size_t OFF_LOGIT = OFF_CC + (size_t)T_ * 1024 * 2;
constexpr size_t OFF_LIST = OFF_LOGIT + (size_t)T_ * 32 * 4;
constexpr size_t OFF_GATE = OFF_LIST + (size_t)32 * LISTCAP * 4;
constexpr size_t OFF_ACT = OFF_GATE + (size_t)T_ * 4 * 4;
constexpr size_t OFF_SLOT = OFF_ACT + (size_t)T_ * 4 * 1024 * 2;
constexpr size_t OFF_MIXER = OFF_SLOT + (size_t)T_ * 4 * 1024 * 4;
constexpr size_t OFF_PE = OFF_MIXER;
constexpr size_t OFF_UH = OFF_PE + (size_t)T_ * 1536 * 2;
constexpr size_t OFF_GLR = OFF_UH + (size_t)(T_ / 64) * 32 * UHW * 2;
constexpr size_t OFF_VTE = OFF_GLR + (size_t)T_ * 16 * 4;
constexpr size_t OFF_KV = OFF_VTE + (size_t)2 * 4 * 128 * L_ * 2;
constexpr size_t OFF_SST = OFF_KV + (size_t)2 * 256 * 4 * 64 * 128 * 4;
constexpr size_t OFF_DEC = OFF_SST + (size_t)2 * 256 * 4 * 64 * 128 * 4;
constexpr size_t OFF_GBUF = OFF_DEC + (size_t)2 * 256 * 4 * 64 * 4;
constexpr size_t OFF_YA = OFF_GBUF + (size_t)512 * 32 * 128 * 4;
constexpr size_t END_EVEN = OFF_YA + (size_t)T_ * 512 * 2;
constexpr size_t OFF_PO = OFF_MIXER;
constexpr size_t OFF_WI = OFF_PO + (size_t)T_ * OD_N * 2;
constexpr size_t OFF_VTC = OFF_WI + (size_t)T_ * 4 * 4;
constexpr size_t OFF_VTD = OFF_VTC + (size_t)2 * 8 * 64 * L_ * 2;
constexpr size_t OFF_BM = OFF_VTD + (size_t)2 * 3 * 8 * 64 * L_ * 2;
constexpr size_t OFF_OD = OFF_BM + (size_t)T_ * 256 * 8;
constexpr size_t OFF_LSE = OFF_OD + (size_t)3 * T_ * 512 * 4;
constexpr size_t END_ODD = OFF_LSE + (size_t)3 * T_ * 8 * 4;
constexpr size_t WS_NEED = END_ODD > END_EVEN ? END_ODD : END_EVEN;
static_assert(WS_NEED < (size_t)4200000000ull, "workspace too large");

constexpr int LDS_BYTES = 153600;

struct Params {
    const float *x, *ev_w_in, *gla_w_gate2, *gla_b_gate2, *gla_norm_g, *s5_a_re, *s5_a_im, *s5_log_dt, *s5_b_re, *s5_b_im, *s5_c_re, *s5_c_im, *s5_d,
        *s5_w_glu, *s5_b_glu, *ev_w_out, *od_w_in, *od_w_out, *ln1_g, *ln1_b, *ln2_g, *ln2_b, *router_w, *router_b, *moe_w1, *moe_b1, *moe_w2, *moe_b2;
    float* out;
    char* ws;
};

#if MEGA
typedef const __attribute__((address_space(4))) Params& PRef;
#else
typedef const Params& PRef;
#endif

__device__ __forceinline__ unsigned pk2(float lo, float hi) { unsigned r; asm("v_cvt_pk_bf16_f32 %0, %1, %2" : "=v"(r) : "v"(lo), "v"(hi)); return r; }
__device__ __forceinline__ bf16_t f2bf(float f) { return (bf16_t)(pk2(f, 0.f) & 0xffffu); }
__device__ __forceinline__ float bf2f(bf16_t h) { return __uint_as_float(((unsigned)h) << 16); }
__device__ __forceinline__ float sigmoidf_(float x) { return __builtin_amdgcn_rcpf(1.f + __expf(-x)); }
template <int CTRL> __device__ __forceinline__ float dppf(float v) { return __int_as_float(__builtin_amdgcn_update_dpp(0, __float_as_int(v), CTRL, 0xF, 0xF, false)); }
constexpr int DPP_X1 = 0xB1  , DPP_X2 = 0x4E  , DPP_HMIR = 0x141  , DPP_MIR = 0x140  , DPP_ROR8 = 0x128;
__device__ __forceinline__ float xor16_sum(float v) { const unsigned u = __float_as_uint(v); auto r = __builtin_amdgcn_permlane16_swap(u, u, false, false); return __uint_as_float(r[0]) + __uint_as_float(r[1]); }
__device__ __forceinline__ float xor16_max(float v) { const unsigned u = __float_as_uint(v); auto r = __builtin_amdgcn_permlane16_swap(u, u, false, false); return fmaxf(__uint_as_float(r[0]), __uint_as_float(r[1])); }
__device__ __forceinline__ float xor32_sum_(float v) { const unsigned u = __float_as_uint(v); auto r = __builtin_amdgcn_permlane32_swap(u, u, false, false); return __uint_as_float(r[0]) + __uint_as_float(r[1]); }
__device__ __forceinline__ float xor32_max_(float v) { const unsigned u = __float_as_uint(v); auto r = __builtin_amdgcn_permlane32_swap(u, u, false, false); return fmaxf(__uint_as_float(r[0]), __uint_as_float(r[1])); }
__device__ __forceinline__ float wave_sum(float v) {
    v += dppf<DPP_X1>(v); v += dppf<DPP_X2>(v); v += dppf<DPP_HMIR>(v); v += dppf<DPP_MIR>(v);
    return xor32_sum_(xor16_sum(v));
}
__device__ __forceinline__ float wave_max(float v) {
    v = fmaxf(v, dppf<DPP_X1>(v)); v = fmaxf(v, dppf<DPP_X2>(v)); v = fmaxf(v, dppf<DPP_HMIR>(v)); v = fmaxf(v, dppf<DPP_MIR>(v));
    return xor32_max_(xor16_max(v));
}
__device__ __forceinline__ float gelu_tanh(float x) {
    const float k0 = 0.7978845608028654f, k1 = 0.044715f;
    float u = k0 * (x + k1 * x * x * x);
    float t = 1.f - 2.f * __builtin_amdgcn_rcpf(1.f + __expf(2.f * u));
    return 0.5f * x * (1.f + t);
}
__device__ __forceinline__ float xor32_max(float v) { const unsigned u = __float_as_uint(v); auto r = __builtin_amdgcn_permlane32_swap(u, u, false, false); return fmaxf(__uint_as_float(r[0]), __uint_as_float(r[1])); }
__device__ __forceinline__ float xor32_sum(float v) { const unsigned u = __float_as_uint(v); auto r = __builtin_amdgcn_permlane32_swap(u, u, false, false); return __uint_as_float(r[0]) + __uint_as_float(r[1]); }
__device__ __forceinline__ unsigned xor32_or(unsigned u) { auto r = __builtin_amdgcn_permlane32_swap(u, u, false, false); return r[0] | r[1]; }
template <int BIT> __device__ __forceinline__ unsigned bitmask32(int w) { unsigned m; asm("v_bfe_i32 %0, %1, %2, 1" : "=v"(m) : "v"(w), "n"(BIT)); return m; }
__device__ __forceinline__ int otid() { int t = threadIdx.x; asm volatile("" : "+v"(t)); return t; }

#define XB_TMO      128
#define XB_XCNT(j)  (256  + 64 * (j))
#define XB_XSUB(j)  (1280 + 64 * (j))
#define XB_XGEN(j)  (2304 + 64 * (j))
#define XB_TOP      3328
#define XB_TOPGEN   3392
#define XCD_BAR_WORDS 3456
#define XB_SPIN_CAP (1u << 21)
#define LAS __attribute__((address_space(3)))

__device__ __forceinline__ unsigned xb_ld(unsigned* p)              { return __hip_atomic_load(p, __ATOMIC_RELAXED, __HIP_MEMORY_SCOPE_AGENT); }
__device__ __forceinline__ unsigned xb_add(unsigned* p, unsigned v) { return __hip_atomic_fetch_add(p, v, __ATOMIC_RELAXED, __HIP_MEMORY_SCOPE_AGENT); }
__device__ __forceinline__ unsigned xb_xcc_id() { return (unsigned)__builtin_amdgcn_s_getreg((3 << 11) | 20) & 0xFu; }
#define XB_SPIN(cond, bar) do { unsigned _sp = 0; while (cond) { __builtin_amdgcn_s_sleep(1); \
    if ((++_sp & 255u) == 0u) { if (xb_ld(&(bar)[XB_TMO])) break; if (_sp > XB_SPIN_CAP) { atomicAdd(&(bar)[XB_TMO], 1u); break; } } } } while (0)

struct XcdBarrier { unsigned* bar; unsigned x; volatile LAS unsigned* st; };

__device__ __forceinline__ XcdBarrier xcd_barrier_post(unsigned* bar, volatile LAS unsigned* st) {
    XcdBarrier b; b.bar = bar; b.x = xb_xcc_id(); b.st = st;
    if (threadIdx.x == 0) (void)xb_add(&bar[XB_XCNT(b.x)], 1u);
    return b;
}
__device__ __forceinline__ void xcd_barrier_complete(unsigned* bar, unsigned x, unsigned& nloc, unsigned& nx) {
    const unsigned G = gridDim.x * gridDim.y * gridDim.z;
    unsigned sum, cnt, mine, sp = 0u;
    for (;;) {
        sum = 0u; cnt = 0u; mine = 0u;
#pragma unroll
        for (unsigned j = 0; j < 16; ++j) { const unsigned c = xb_ld(&bar[XB_XCNT(j)]); sum += c; cnt += (c > 0u) ? 1u : 0u; mine = (j == x) ? c : mine; }
        if (sum == G) break;
        __builtin_amdgcn_s_sleep(1);
        if ((++sp & 255u) == 0u) { if (xb_ld(&bar[XB_TMO])) break; if (sp > XB_SPIN_CAP) { atomicAdd(&bar[XB_TMO], 1u); break; } }
    }
    nloc = mine > 0u ? mine : 1u; nx = cnt > 0u ? cnt : 1u;
}
__device__ __forceinline__ void xcd_barrier(const XcdBarrier& b) {
    asm volatile("s_waitcnt vmcnt(0)" ::: "memory");
    __syncthreads();
    if (threadIdx.x == 0) {
        unsigned* bar = b.bar;
        __builtin_amdgcn_s_waitcnt(0);
        unsigned nloc = b.st[0], nx = b.st[1];
        if (nloc == 0u) { xcd_barrier_complete(bar, b.x, nloc, nx); b.st[0] = nloc; b.st[1] = nx; }
        const unsigned old = xb_add(&bar[XB_XSUB(b.x)], 1u);
        const unsigned gen = old / nloc;
        if (old + 1u == (gen + 1u) * nloc) {
            __builtin_amdgcn_fence(__ATOMIC_RELEASE, "agent");
            asm volatile("s_waitcnt vmcnt(0)" ::: "memory");
            const unsigned og = xb_add(&bar[XB_TOP], 1u);
            const unsigned tg = og / nx;
            if (og + 1u == (tg + 1u) * nx) xb_add(&bar[XB_TOPGEN], 1u);
            else XB_SPIN(xb_ld(&bar[XB_TOPGEN]) == tg, bar);
            __builtin_amdgcn_fence(__ATOMIC_ACQUIRE, "agent");
            xb_add(&bar[XB_XGEN(b.x)], 1u);
            asm volatile("s_waitcnt vmcnt(0)" ::: "memory");
        } else {
            XB_SPIN(xb_ld(&bar[XB_XGEN(b.x)]) == gen, bar);
            __builtin_amdgcn_fence(__ATOMIC_ACQUIRE, "agent");
            asm volatile("s_waitcnt vmcnt(0)" ::: "memory");
        }
    }
    __syncthreads();
}

constexpr int G_LROW = 144;
constexpr int G_ASZ = 256 * G_LROW;
constexpr int G_BSZ = 128 * G_LROW;
constexpr int G_STAGE = G_ASZ + G_BSZ;
constexpr int G_ROWS_OFF = 2 * G_STAGE;

template <bool GATHER, class Epi>
__device__ __forceinline__ void gemm_tile(const bf16_t* __restrict__ A, long lda, int shift, int m0, const bf16_t* __restrict__ Bt, long ldb, int n0, int K,
                                          char* smem, Epi&& epi) {
    const int tid = otid(), lane = tid & 63, wave = tid >> 6, wr = wave >> 1, wc = wave & 1, fr = lane & 15, fq = lane >> 4;
    const int lrow = tid >> 3, lchunk = tid & 7;
    const int* sRow = (const int*)(smem + G_ROWS_OFF);
    const bf16_t* pa[4]; const bf16_t* pb[2];
#pragma unroll
    for (int i = 0; i < 4; ++i) {
        int r = lrow + 64 * i; long arow;
        if (GATHER) { int v = sRow[r]; arow = v < 0 ? 0 : (v >> shift); } else arow = m0 + r;
        pa[i] = A + arow * lda + lchunk * 8;
    }
#pragma unroll
    for (int i = 0; i < 2; ++i) pb[i] = Bt + (long)(n0 + lrow + 64 * i) * ldb + lchunk * 8;
    f32x4 acc[4][4];
#pragma unroll
    for (int m = 0; m < 4; ++m)
#pragma unroll
        for (int n = 0; n < 4; ++n) acc[m][n] = (f32x4){0.f, 0.f, 0.f, 0.f};
    u32x4 ra[4], rb[2];
    const int nk = K >> 6;
#pragma unroll
    for (int i = 0; i < 4; ++i) ra[i] = *(const u32x4*)(pa[i]);
#pragma unroll
    for (int i = 0; i < 2; ++i) rb[i] = *(const u32x4*)(pb[i]);
    {
        char* sa = smem; char* sb = smem + G_ASZ;
#pragma unroll
        for (int i = 0; i < 4; ++i) *(u32x4*)(sa + (lrow + 64 * i) * G_LROW + lchunk * 16) = ra[i];
#pragma unroll
        for (int i = 0; i < 2; ++i) *(u32x4*)(sb + (lrow + 64 * i) * G_LROW + lchunk * 16) = rb[i];
    }
    __syncthreads();
    for (int kt = 0; kt < nk; ++kt) {
        const bool more = (kt + 1 < nk);
        if (more) {
#pragma unroll
            for (int i = 0; i < 4; ++i) ra[i] = *(const u32x4*)(pa[i] + (kt + 1) * 64);
#pragma unroll
            for (int i = 0; i < 2; ++i) rb[i] = *(const u32x4*)(pb[i] + (kt + 1) * 64);
        }
        const char* sa = smem + (kt & 1) * G_STAGE; const char* sb = sa + G_ASZ;
#pragma unroll
        for (int ks = 0; ks < 2; ++ks) {
            bf16x8 af[4], bfr[4];
#pragma unroll
            for (int m = 0; m < 4; ++m) af[m] = *(const bf16x8*)(sa + (wr * 64 + m * 16 + fr) * G_LROW + (ks * 32 + fq * 8) * 2);
#pragma unroll
            for (int n = 0; n < 4; ++n) bfr[n] = *(const bf16x8*)(sb + (wc * 64 + n * 16 + fr) * G_LROW + (ks * 32 + fq * 8) * 2);
#pragma unroll
            for (int m = 0; m < 4; ++m)
#pragma unroll
                for (int n = 0; n < 4; ++n) acc[m][n] = __builtin_amdgcn_mfma_f32_16x16x32_bf16(af[m], bfr[n], acc[m][n], 0, 0, 0);
        }
        if (more) {
            char* wa = smem + ((kt + 1) & 1) * G_STAGE; char* wb = wa + G_ASZ;
#pragma unroll
            for (int i = 0; i < 4; ++i) *(u32x4*)(wa + (lrow + 64 * i) * G_LROW + lchunk * 16) = ra[i];
#pragma unroll
            for (int i = 0; i < 2; ++i) *(u32x4*)(wb + (lrow + 64 * i) * G_LROW + lchunk * 16) = rb[i];
        }
        __syncthreads();
    }
    {
        f32x4 h0[4][2], h1[4][2];
#pragma unroll
        for (int m = 0; m < 4; ++m) { h0[m][0] = acc[m][0]; h0[m][1] = acc[m][1]; h1[m][0] = acc[m][2]; h1[m][1] = acc[m][3]; }
        epi(h0, wr * 64, n0 + wc * 64, fr, fq);
        epi(h1, wr * 64, n0 + wc * 64 + 32, fr, fq);
    }
}

template <class Epi>
__device__ __forceinline__ void gemm_phase(const bf16_t* A, long lda, int M, const bf16_t* Bt, long ldb, int N, int K, char* smem, int bid, int nb, Epi&& epi) {
    const int ntn = N / 128, ntm = M / 256, nt = ntn * ntm;
    for (int t = bid; t < nt; t += nb) {
        const int mi = t / ntn, ni = t - mi * ntn;
        gemm_tile<false>(A, lda, 0, mi * 256, Bt, ldb, ni * 128, K, smem,
                         [&](f32x4 (&acc)[4][2], int rt0, int c0, int fr, int fq) { epi(acc, mi * 256 + rt0, c0, fr, fq); });
    }
}

constexpr int G8_HT = 128 * 64 * 2;
constexpr int G8_ROWS_OFF = 8 * G8_HT;

__device__ __forceinline__ int g8_lds_byte(int r, int c) {
    const int st = (r >> 4) * 2 + (c >> 5), rr = r & 15, cc = c & 31, ob = rr * 64 + cc * 2;
    return st * 1024 + (ob ^ (((ob >> 9) & 1) << 5));
}
__device__ __forceinline__ void g8_stage_rc(int b, int& R, int& C) {
    const int st = b / 1024, sb = b % 1024, swz = sb ^ (((sb >> 9) & 1) << 5);
    R = (st >> 1) * 16 + swz / 64; C = (st & 1) * 32 + (swz % 64) / 2;
}

#define G8_SA(b, h) (lds + ((b) * 2 + (h)) * G8_HT)
#define G8_SB(b, h) (lds + (4 + (b) * 2 + (h)) * G8_HT)
#define G8_STAGE(P, RS, OFF, soff) do { \
    _Pragma("unroll") for (int _i = 0; _i < 2; ++_i) \
        __builtin_amdgcn_raw_ptr_buffer_load_lds((RS), (LAS unsigned*)((P) + tid * 16 + _i * 8192), 16, (OFF)[_i], (soff), 0, 0); } while (0)
#define G8_LDA(dst, b, h) do { _Pragma("unroll") for (int m = 0; m < 4; ++m) _Pragma("unroll") for (int k = 0; k < 2; ++k) \
    dst[m][k] = *(const LAS bf16x8*)(G8_SA(b, h) + g8_lds_byte(wr * 64 + m * 16 + fr, k * 32 + fq * 8)); } while (0)
#define G8_LDB(dst, b, h) do { _Pragma("unroll") for (int n = 0; n < 2; ++n) _Pragma("unroll") for (int k = 0; k < 2; ++k) \
    dst[n][k] = *(const LAS bf16x8*)(G8_SB(b, h) + g8_lds_byte(wc * 32 + n * 16 + fr, k * 32 + fq * 8)); } while (0)
#define G8_MMA(ai, bj, At, Bt_) do { __builtin_amdgcn_s_setprio(1); \
    _Pragma("unroll") for (int m = 0; m < 4; ++m) _Pragma("unroll") for (int n = 0; n < 2; ++n) _Pragma("unroll") for (int k = 0; k < 2; ++k) \
        acc[ai][bj][m][n] = __builtin_amdgcn_mfma_f32_16x16x32_bf16(Bt_[n][k], At[m][k], acc[ai][bj][m][n], 0, 0, 0); \
    __builtin_amdgcn_s_setprio(0); } while (0)
#define G8_WAIT_V(n) asm volatile("s_waitcnt vmcnt(" #n ")" ::: "memory")
#define G8_WAIT_L(n) asm volatile("s_waitcnt lgkmcnt(" #n ")" ::: "memory")
#define G8_BAR __builtin_amdgcn_s_barrier()
#define G8_SCHED __builtin_amdgcn_sched_barrier(0)

template <bool GATHER, class Epi>
__device__ __forceinline__ void gemm256_tile(const bf16_t* __restrict__ A, long lda, int shift, int m0, const bf16_t* __restrict__ Bt, long ldb, int n0, int K,
                                             char* smem, Epi&& epi) {
    LAS char* lds = (LAS char*)smem;
    int tid = otid();
    int wid = tid >> 6, lane = tid & 63, wr = wid >> 2, wc = wid & 3, fr = lane & 15, fq = lane >> 4;
    unsigned aoff[2][2], boff[2];
    {
        const LAS int* sRow = (const LAS int*)(lds + G8_ROWS_OFF);
#pragma unroll
        for (int i = 0; i < 2; ++i) {
            int R, C; g8_stage_rc(tid * 16 + i * 8192, R, C);
            { const int rho = R & 31, nn = rho >> 4, ii = rho & 15; const int Rp = (R & ~31) + 8 * (ii >> 2) + 4 * nn + (ii & 3);
              boff[i] = (unsigned)((long)Rp * ldb + C) * 2u; }
#pragma unroll
            for (int h = 0; h < 2; ++h) {
                long arow;
                if (GATHER) { const int v = sRow[h * 128 + R]; arow = v < 0 ? 0 : (v >> shift); } else arow = m0 + h * 128 + R;
                aoff[h][i] = (unsigned)(arow * lda + C) * 2u;
            }
        }
    }
    f32x4 acc[2][2][4][2];
#pragma unroll
    for (int a = 0; a < 2; ++a)
#pragma unroll
        for (int b = 0; b < 2; ++b)
#pragma unroll
            for (int m = 0; m < 4; ++m)
#pragma unroll
                for (int n = 0; n < 2; ++n) acc[a][b][m][n] = (f32x4){0.f, 0.f, 0.f, 0.f};
    bf16x8 At[4][2], B0[2][2], B1[2][2];
    const int nt = K / 64;
    const __amdgpu_buffer_rsrc_t rA = __builtin_amdgcn_make_buffer_rsrc((void*)A, 0, 0x7fffffff, 0x00020000);
    const __amdgpu_buffer_rsrc_t rB = __builtin_amdgcn_make_buffer_rsrc((void*)(Bt + (size_t)n0 * ldb), 0, 0x7fffffff, 0x00020000);
    const int bh = (int)(128 * ldb * 2);
    G8_STAGE(G8_SB(0, 0), rB, boff, 0); G8_STAGE(G8_SA(0, 0), rA, aoff[0], 0);
    G8_STAGE(G8_SB(0, 1), rB, boff, bh); G8_STAGE(G8_SA(0, 1), rA, aoff[1], 0);
    if (wr == 1) G8_BAR;
    G8_WAIT_V(4); G8_BAR;
    G8_STAGE(G8_SB(1, 0), rB, boff, 128); G8_STAGE(G8_SA(1, 0), rA, aoff[0], 128); G8_STAGE(G8_SB(1, 1), rB, boff, 128 + bh);
    G8_WAIT_V(6); G8_BAR;
    for (int t = 0; t < nt - 2; t += 2) {
        G8_LDB(B0, 0, 0); G8_SCHED; G8_LDA(At, 0, 0); G8_STAGE(G8_SA(1, 1), rA, aoff[1], (t + 1) * 128);
        G8_WAIT_L(8); G8_BAR; G8_WAIT_L(0); G8_MMA(0, 0, At, B0); G8_BAR; G8_SCHED;
        G8_LDB(B1, 0, 1); G8_STAGE(G8_SB(0, 0), rB, boff, (t + 2) * 128);
        G8_BAR; G8_WAIT_L(0); G8_MMA(0, 1, At, B1); G8_BAR;
        G8_LDA(At, 0, 1); G8_STAGE(G8_SA(0, 0), rA, aoff[0], (t + 2) * 128);
        G8_BAR; G8_WAIT_L(0); G8_MMA(1, 0, At, B0); G8_BAR; G8_SCHED;
        G8_STAGE(G8_SB(0, 1), rB, boff, (t + 2) * 128 + bh);
        G8_WAIT_V(6); G8_BAR; G8_MMA(1, 1, At, B1); G8_BAR;
        G8_LDB(B0, 1, 0); G8_SCHED; G8_LDA(At, 1, 0); G8_STAGE(G8_SA(0, 1), rA, aoff[1], (t + 2) * 128);
        G8_WAIT_L(8); G8_BAR; G8_WAIT_L(0); G8_MMA(0, 0, At, B0); G8_BAR; G8_SCHED;
        G8_LDB(B1, 1, 1); G8_STAGE(G8_SB(1, 0), rB, boff, (t + 3) * 128);
        G8_BAR; G8_WAIT_L(0); G8_MMA(0, 1, At, B1); G8_BAR;
        G8_LDA(At, 1, 1); G8_STAGE(G8_SA(1, 0), rA, aoff[0], (t + 3) * 128);
        G8_BAR; G8_WAIT_L(0); G8_MMA(1, 0, At, B0); G8_BAR; G8_SCHED;
        G8_STAGE(G8_SB(1, 1), rB, boff, (t + 3) * 128 + bh);
        G8_WAIT_V(6); G8_BAR; G8_MMA(1, 1, At, B1); G8_BAR;
    }
    { G8_LDB(B0, 0, 0); G8_WAIT_V(0); G8_LDA(At, 0, 0); G8_STAGE(G8_SA(1, 1), rA, aoff[1], (nt - 1) * 128);
      G8_BAR; G8_WAIT_L(0); G8_MMA(0, 0, At, B0); G8_BAR;
      G8_LDB(B1, 0, 1); G8_BAR; G8_WAIT_L(0); G8_MMA(0, 1, At, B1); G8_BAR;
      G8_LDA(At, 0, 1); G8_WAIT_V(4); G8_BAR; G8_WAIT_L(0); G8_MMA(1, 0, At, B0); G8_MMA(1, 1, At, B1); G8_BAR; }
    { G8_LDB(B0, 1, 0); G8_LDA(At, 1, 0); G8_WAIT_V(2); G8_BAR; G8_WAIT_L(0); G8_MMA(0, 0, At, B0); G8_BAR;
      G8_LDB(B1, 1, 1); G8_WAIT_V(0); G8_BAR; G8_WAIT_L(0); G8_MMA(0, 1, At, B1); G8_BAR;
      G8_LDA(At, 1, 1); G8_BAR; G8_WAIT_L(0); G8_MMA(1, 0, At, B0); G8_MMA(1, 1, At, B1); G8_BAR; }
    if (wr == 0) G8_BAR;
    int tz = otid(); wid = tz >> 6; lane = tz & 63; wr = wid >> 2; wc = wid & 3; fr = lane & 15; fq = lane >> 4;
#pragma unroll
    for (int ai = 0; ai < 2; ++ai)
#pragma unroll
        for (int bj = 0; bj < 2; ++bj) epi(acc[ai][bj], ai * 128 + wr * 64, n0 + bj * 128 + wc * 32, fr, fq);
}

struct G8Desc { const bf16_t* A; const bf16_t* Bt; const int* list; int m0, n0, count, u0, ldb; };

template <bool GATHER, int SHIFT, class Src, class Epi>
__device__ __forceinline__ void gemm256_stream(Src&& src, const int lda, const int K, char* smem, Epi&& epi) {
    LAS char* lds = (LAS char*)smem;
    int tid = otid();
    int wid = tid >> 6, lane = tid & 63, wr = wid >> 2, wc = wid & 3, fr = lane & 15, fq = lane >> 4;
    G8Desc nxt;
    if (!src(0, nxt)) return;
    int cm0 = nxt.m0, cn0 = nxt.n0, cu0 = nxt.u0;
    int* sRowG = (int*)(smem + G8_ROWS_OFF);
    __syncthreads();
    if (GATHER) { if (tid < 256) sRowG[tid] = tid < nxt.count ? nxt.list[tid] : -1; __syncthreads(); }
    unsigned aoff[2][2], boff[2];
    __amdgpu_buffer_rsrc_t rA, rB;
    int bh;
#define G8_PREP(D, SLOT) do { \
        const LAS int* _sr = (const LAS int*)(lds + G8_ROWS_OFF) + (SLOT) * 256; \
        _Pragma("unroll") for (int i = 0; i < 2; ++i) { \
            int R, C; g8_stage_rc(tid * 16 + i * 8192, R, C); \
            { const int rho = R & 31, nn = rho >> 4, ii = rho & 15; const int Rp = (R & ~31) + 8 * (ii >> 2) + 4 * nn + (ii & 3); boff[i] = (unsigned)(Rp * (D).ldb + C) * 2u; } \
            _Pragma("unroll") for (int h = 0; h < 2; ++h) { \
                int arow; \
                if (GATHER) { const int v = _sr[h * 128 + R]; arow = v < 0 ? 0 : (v >> SHIFT); } else arow = (D).m0 + h * 128 + R; \
                aoff[h][i] = (unsigned)(arow * lda + C) * 2u; } } \
        rA = __builtin_amdgcn_make_buffer_rsrc((void*)(D).A, 0, 0x7fffffff, 0x00020000); \
        rB = __builtin_amdgcn_make_buffer_rsrc((void*)((D).Bt + (size_t)(D).n0 * (D).ldb), 0, 0x7fffffff, 0x00020000); bh = 128 * (D).ldb * 2; } while (0)
#define G8_PRO1() do { G8_STAGE(G8_SB(0, 0), rB, boff, 0); G8_STAGE(G8_SA(0, 0), rA, aoff[0], 0); G8_STAGE(G8_SB(0, 1), rB, boff, bh); G8_STAGE(G8_SA(0, 1), rA, aoff[1], 0); } while (0)
    G8_PREP(nxt, 0);
    G8_PRO1();
    f32x4 acc[2][2][4][2];
    const int nt = K / 64;
    for (int it = 0;; ++it) {
#pragma unroll
        for (int a = 0; a < 2; ++a)
#pragma unroll
            for (int b = 0; b < 2; ++b)
#pragma unroll
                for (int m = 0; m < 4; ++m)
#pragma unroll
                    for (int n = 0; n < 2; ++n) acc[a][b][m][n] = (f32x4){0.f, 0.f, 0.f, 0.f};
        const bool has_next = src(it + 1, nxt);
        if (GATHER && has_next && tid < 256) sRowG[((it + 1) % 3) * 256 + tid] = tid < nxt.count ? nxt.list[tid] : -1;
        bf16x8 At[4][2], B0[2][2], B1[2][2];
        if (wr == 1) G8_BAR;
        G8_WAIT_V(4); G8_BAR;
        G8_STAGE(G8_SB(1, 0), rB, boff, 128); G8_STAGE(G8_SA(1, 0), rA, aoff[0], 128); G8_STAGE(G8_SB(1, 1), rB, boff, 128 + bh);
        G8_WAIT_V(6); G8_BAR;
        for (int t = 0; t < nt - 2; t += 2) {
            G8_LDB(B0, 0, 0); G8_SCHED; G8_LDA(At, 0, 0); G8_STAGE(G8_SA(1, 1), rA, aoff[1], (t + 1) * 128);
            G8_WAIT_L(8); G8_BAR; G8_WAIT_L(0); G8_MMA(0, 0, At, B0); G8_BAR; G8_SCHED;
            G8_LDB(B1, 0, 1); G8_STAGE(G8_SB(0, 0), rB, boff, (t + 2) * 128);
            G8_BAR; G8_WAIT_L(0); G8_MMA(0, 1, At, B1); G8_BAR;
            G8_LDA(At, 0, 1); G8_STAGE(G8_SA(0, 0), rA, aoff[0], (t + 2) * 128);
            G8_BAR; G8_WAIT_L(0); G8_MMA(1, 0, At, B0); G8_BAR; G8_SCHED;
            G8_STAGE(G8_SB(0, 1), rB, boff, (t + 2) * 128 + bh);
            G8_WAIT_V(6); G8_BAR; G8_MMA(1, 1, At, B1); G8_BAR;
            G8_LDB(B0, 1, 0); G8_SCHED; G8_LDA(At, 1, 0); G8_STAGE(G8_SA(0, 1), rA, aoff[1], (t + 2) * 128);
            G8_WAIT_L(8); G8_BAR; G8_WAIT_L(0); G8_MMA(0, 0, At, B0); G8_BAR; G8_SCHED;
            G8_LDB(B1, 1, 1); G8_STAGE(G8_SB(1, 0), rB, boff, (t + 3) * 128);
            G8_BAR; G8_WAIT_L(0); G8_MMA(0, 1, At, B1); G8_BAR;
            G8_LDA(At, 1, 1); G8_STAGE(G8_SA(1, 0), rA, aoff[0], (t + 3) * 128);
            G8_BAR; G8_WAIT_L(0); G8_MMA(1, 0, At, B0); G8_BAR; G8_SCHED;
            G8_STAGE(G8_SB(1, 1), rB, boff, (t + 3) * 128 + bh);
            G8_WAIT_V(6); G8_BAR; G8_MMA(1, 1, At, B1); G8_BAR;
        }
        { G8_LDB(B0, 0, 0); G8_WAIT_V(0); G8_LDA(At, 0, 0); G8_STAGE(G8_SA(1, 1), rA, aoff[1], (nt - 1) * 128);
          G8_BAR; G8_WAIT_L(0); G8_MMA(0, 0, At, B0); G8_BAR;
          G8_LDB(B1, 0, 1); G8_BAR; G8_WAIT_L(0); G8_MMA(0, 1, At, B1); G8_BAR;
          G8_LDA(At, 0, 1); G8_WAIT_V(4); G8_BAR; G8_WAIT_L(0); G8_MMA(1, 0, At, B0); G8_MMA(1, 1, At, B1); G8_BAR; }
        { G8_LDB(B0, 1, 0); G8_LDA(At, 1, 0); G8_WAIT_V(2); G8_BAR; G8_WAIT_L(0); G8_MMA(0, 0, At, B0); G8_BAR;
          G8_LDB(B1, 1, 1); G8_WAIT_V(0); G8_BAR; G8_WAIT_L(0); G8_MMA(0, 1, At, B1); G8_BAR;
          G8_LDA(At, 1, 1); G8_BAR; G8_WAIT_L(0); G8_MMA(1, 0, At, B0); G8_MMA(1, 1, At, B1); G8_BAR; }
        if (wr == 0) G8_BAR;
        tid = otid(); wid = tid >> 6; lane = tid & 63; wr = wid >> 2; wc = wid & 3; fr = lane & 15; fq = lane >> 4;
        if (has_next) { G8_PREP(nxt, (it + 1) % 3); G8_PRO1(); }
        {
            const int* sr = sRowG + (it % 3) * 256;
#pragma unroll
            for (int ai = 0; ai < 2; ++ai)
#pragma unroll
                for (int bj = 0; bj < 2; ++bj) epi(cm0, cu0, acc[ai][bj], ai * 128 + wr * 64, cn0 + bj * 128 + wc * 32, fr, fq, sr);
        }
        if (!has_next) break;
        cm0 = nxt.m0; cn0 = nxt.n0; cu0 = nxt.u0;
    }
#undef G8_PREP
#undef G8_PRO1
}

struct XcdSeq {
    int q, qend, step;
    __device__ __forceinline__ XcdSeq(int total, int bid, int nb) {
        if ((nb & 7) == 0) { const int chunk = (total + 7) >> 3, x = bid & 7; q = x * chunk + (bid >> 3); const int e = (x + 1) * chunk; qend = e < total ? e : total; step = nb >> 3; }
        else { q = bid; qend = total; step = nb; }
    }
};

template <class Epi>
__device__ __forceinline__ void gemm256_phase(const bf16_t* A, long lda, int M, const bf16_t* Bt, long ldb, int N, int K, char* smem, int bid, int nb, Epi&& epi) {
    const int ntn = N / 256, ntm = M / 256, nt = ntn * ntm;
    XcdSeq s(nt, bid, nb);
    gemm256_stream<false, 0>(
        [&](int i, G8Desc& d) -> bool {
            const int Q = s.q + i * s.step; if (Q >= s.qend) return false;
            const int pnl = Q / (4 * ntn), r = Q - pnl * 4 * ntn;
            d.A = A; d.Bt = Bt; d.list = nullptr; d.m0 = (pnl * 4 + (r & 3)) * 256; d.n0 = (r >> 2) * 256; d.count = 0; d.u0 = 0; d.ldb = (int)ldb;
            return true; },
        (int)lda, K, smem,
        [&](int m0, int, f32x4 (&acc)[4][2], int rt0, int c0, int fr, int fq, const int*) { epi(acc, m0 + rt0, c0, fr, fq); });
}


__device__ __forceinline__ int colmap(int kind, int n, int nsrc) {
    if (kind == 0) return n < nsrc ? n : -1;
    if (kind == 1) { if (n < 512) return n; if (n < 1024) return n + 512; if (n < 1536) return n + 528; if (n < 1552) return n; if (n < 1792) return -1; return n - 1280; }
    if (kind == 2) { if (n < 1024) return n; if (n < 1280) return n + 512; if (n < 4352) return n + 580; if (n < 4420) return n - 2560; if (n < 4608) return -1; if (n < 5120) return n - 3584; return n - 188; }
    { const int grp = n >> 5, w = n & 31; return ((w >> 2) & 1) * 1024 + grp * 16 + 4 * (w >> 3) + (w & 3); }
}
struct ConvTile { const float* src; bf16_t* dst; int sld, sc, K, n0, k0; };
__device__ __forceinline__ ConvTile conv_decode(PRef p, int t, int n4) {
    constexpr int S0 = 128 * 32 * 4, S1 = S0 + 128 * 16 * 4, S2 = S1 + 2 * 36 * 4, S3 = S2 + 2 * 104 * 4, S4 = S3 + 2 * 16 * 4, S5 = S4 + 2 * 16 * 4, S6 = S5 + 2 * 8 * 2;
    char* ws = p.ws;
    ConvTile c; int nsrc, kind, NT, loc;
    if (t < S0) { loc = t; const int mat = loc / (32 * 4); loc -= mat * 32 * 4; c.src = p.moe_w1 + (size_t)mat * 1024 * 2048; c.dst = (bf16_t*)(ws + OFF_WT_W1) + (size_t)mat * 2048 * 1024; c.sld = 2048; nsrc = 2048; kind = 3; c.K = 1024; NT = 32; }
    else if (t < S1) { loc = t - S0; const int mat = loc / 64; loc -= mat * 64; c.src = p.moe_w2 + (size_t)mat * 1024 * 1024; c.dst = (bf16_t*)(ws + OFF_WT_W2) + (size_t)mat * 1024 * 1024; c.sld = 1024; nsrc = 1024; kind = 0; c.K = 1024; NT = 16; }
    else if (t < S2) { loc = t - S1; const int mat = loc / (36 * 4); loc -= mat * 36 * 4; c.src = p.ev_w_in + (size_t)mat * 1024 * 2064; c.dst = (bf16_t*)(ws + OFF_WT_EVIN) + (size_t)mat * EV_N * 1024; c.sld = 2064; nsrc = 2064; kind = 1; c.K = 1024; NT = 36; }
    else if (t < S3) { loc = t - S2; const int mat = loc / (104 * 4); loc -= mat * 104 * 4; c.src = p.od_w_in + (size_t)mat * 1024 * 6468; c.dst = (bf16_t*)(ws + OFF_WT_ODIN) + (size_t)mat * OD_N * 1024; c.sld = 6468; nsrc = 6468; kind = 2; c.K = 1024; NT = 104; }
    else if (t < S4) { loc = t - S3; const int mat = loc / 64; loc -= mat * 64; c.src = p.ev_w_out + (size_t)mat * 1024 * 1024; c.dst = (bf16_t*)(ws + OFF_WT_EVOUT) + (size_t)mat * 1024 * 1024; c.sld = 1024; nsrc = 1024; kind = 0; c.K = 1024; NT = 16; }
    else if (t < S5) { loc = t - S4; const int mat = loc / 64; loc -= mat * 64; c.src = p.od_w_out + (size_t)mat * 1024 * 1024; c.dst = (bf16_t*)(ws + OFF_WT_ODOUT) + (size_t)mat * 1024 * 1024; c.sld = 1024; nsrc = 1024; kind = 0; c.K = 1024; NT = 16; }
    else if (t < S6) { loc = t - S5; const int mat = loc / 16; loc -= mat * 16; c.src = p.s5_w_glu + (size_t)mat * 512 * 512; c.dst = (bf16_t*)(ws + OFF_WT_GLU) + (size_t)mat * 512 * 512; c.sld = 512; nsrc = 512; kind = 0; c.K = 512; NT = 8; }
    else { loc = t - S6; const int mat = loc / 8; loc -= mat * 8; c.src = p.router_w + (size_t)mat * 1024 * 32; c.dst = (bf16_t*)(ws + OFF_WT_RT) + (size_t)mat * 128 * 1024; c.sld = 32; nsrc = 32; kind = 0; c.K = 1024; NT = 2; }
    const int kt = loc / NT, nt = loc - kt * NT;
    c.n0 = nt * 64; c.k0 = kt * 256;
    c.sc = colmap(kind, c.n0 + n4 * 4, nsrc);
    return c;
}
__device__ __forceinline__ void conv_load(const ConvTile& c, int kp, f32x4 (&v)[8]) {
#pragma unroll
    for (int i = 0; i < 4; ++i)
#pragma unroll
        for (int e = 0; e < 2; ++e) {
            const int k = c.k0 + 2 * (kp + 32 * i) + e;
            v[2 * i + e] = c.sc >= 0 ? *(const f32x4*)(c.src + (size_t)k * c.sld + c.sc) : (f32x4){0.f, 0.f, 0.f, 0.f};
        }
}

__device__ __forceinline__ void conv_phase(PRef p, char* smem, int bid, int nb) {
    char* ws = p.ws;
    constexpr int NTILES = 128 * 32 * 4 + 128 * 16 * 4 + 2 * 36 * 4 + 2 * 104 * 4 + 2 * 16 * 4 + 2 * 16 * 4 + 2 * 8 * 2 + 4 * 2 * 4;
    bf16_t* tile = (bf16_t*)smem;
    const int tid = otid(), n4 = tid & 15, kp = tid >> 4;
    if (bid < NTILES) {
        ConvTile cur = conv_decode(p, bid, n4);
        f32x4 v[8];
        conv_load(cur, kp, v);
        for (int t = bid; t < NTILES; t += nb) {
            const bool more = t + nb < NTILES;
            ConvTile nxt = cur; f32x4 w[8];
            if (more) { nxt = conv_decode(p, t + nb, n4); conv_load(nxt, kp, w); }
#pragma unroll
            for (int i = 0; i < 4; ++i)
#pragma unroll
                for (int j = 0; j < 4; ++j)
                    *(unsigned*)(tile + (n4 * 4 + j) * 258 + 2 * (kp + 32 * i)) = pk2(v[2 * i][j], v[2 * i + 1][j]);
            __syncthreads();
#pragma unroll
            for (int i = 0; i < 4; ++i) {
                const int c = tid + 512 * i, n = c >> 5, kc = c & 31;
                const unsigned* tp = (const unsigned*)(tile + n * 258 + kc * 8);
                u32x4 o; o.x = tp[0]; o.y = tp[1]; o.z = tp[2]; o.w = tp[3];
                *(u32x4*)(cur.dst + (size_t)(cur.n0 + n) * cur.K + cur.k0 + kc * 8) = o;
            }
            __syncthreads();
            if (more) {
                cur = nxt;
#pragma unroll
                for (int i = 0; i < 8; ++i) v[i] = w[i];
            }
        }
    }
    {
        const float* x = p.x; bf16_t* xb = (bf16_t*)(ws + OFF_XB);
        const long nch = (long)T_ * 1024 / 8;
        for (long c = (long)bid * NTHR + otid(); c < nch; c += (long)nb * NTHR) {
            const f32x4 a = *(const f32x4*)(x + c * 8), b = *(const f32x4*)(x + c * 8 + 4);
            u32x4 w; w.x = pk2(a[0], a[1]); w.y = pk2(a[2], a[3]); w.z = pk2(b[0], b[1]); w.w = pk2(b[2], b[3]);
            *(u32x4*)(xb + c * 8) = w;
        }
    }
    if (bid == 0 && otid() < 128) ((int*)(ws + OFF_CNT))[otid()] = 0;
}

__device__ __forceinline__ void s5mat_unit(PRef p, int j, int g, char* smem) {
    float* cre = (float*)smem;
    float* cim = cre + 1024;
    float* bbr = cim + 1024;
    float* bbi = bbr + 1024;
    float* pwr = bbi + 1024;
    float* pwi = pwr + 65 * 64;
    float* zr = pwi + 65 * 64;
    float* zi = zr + 64;
    float* Kd = zi + 64;
    const int tid = otid();
    const int jg = j * 32 + g;
    if (tid < 64) {
        const int pp = tid;
        const float lre = fminf(p.s5_a_re[jg * 64 + pp], -1e-4f), lim = p.s5_a_im[jg * 64 + pp];
        const float dt = expf(p.s5_log_dt[jg]);
        const float xr = lre * dt, th = lim * dt;
        const float mag = expf(xr);
        const float ar = mag * cosf(th), ai = mag * sinf(th);
        const float inv = 1.f / (lre * lre + lim * lim);
        zr[pp] = ((ar - 1.f) * lre + ai * lim) * inv;
        zi[pp] = (ai * lre - (ar - 1.f) * lim) * inv;
        const double thd = (double)th;
        for (int d = 0; d <= 64; ++d) {
            const float mg = expf((float)d * xr);
            double ang = (double)d * thd;
            const double kk = rint(ang * 0.15915494309189535);
            ang -= kk * 6.283185307179586;
            const float a = (float)ang;
            pwr[d * 64 + pp] = mg * cosf(a);
            pwi[d * 64 + pp] = mg * sinf(a);
        }
    }
    for (int e = tid; e < 1024; e += NTHR) {
        cre[e] = p.s5_c_re[(size_t)jg * 1024 + e];
        cim[e] = p.s5_c_im[(size_t)jg * 1024 + e];
    }
    __syncthreads();
    for (int e = tid; e < 1024; e += NTHR) {
        const int pp = e >> 4;
        const float br = p.s5_b_re[(size_t)jg * 1024 + e], bi = p.s5_b_im[(size_t)jg * 1024 + e];
        bbr[e] = zr[pp] * br - zi[pp] * bi;
        bbi[e] = zr[pp] * bi + zi[pp] * br;
    }
    __syncthreads();
    for (int e = tid; e < 64 * 256; e += NTHR) {
        const int d = e >> 8, n = (e >> 4) & 15, m = e & 15;
        float s = 0.f;
        for (int pp = 0; pp < 64; ++pp) {
            const float cr = cre[n * 64 + pp], ci = cim[n * 64 + pp], qr = pwr[d * 64 + pp], qi = pwi[d * 64 + pp];
            const float wr_ = cr * qr - ci * qi, wi_ = cr * qi + ci * qr;
            s += wr_ * bbr[pp * 16 + m] - wi_ * bbi[pp * 16 + m];
        }
        Kd[e] = s;
    }
    __syncthreads();
    bf16_t* TH = (bf16_t*)(p.ws + OFF_TH) + (size_t)jg * 1024 * UHW;
    for (int c = tid; c < 1024 * 144; c += NTHR) {
        const int row = c / 144, ch = c - row * 144;
        const int tau = row >> 4, n = row & 15;
        float v[8];
        if (ch < 128) {
            const int s = ch >> 1, m0 = (ch & 1) * 8;
            if (s <= tau) {
#pragma unroll
                for (int i = 0; i < 8; ++i) v[i] = Kd[(tau - s) * 256 + n * 16 + m0 + i];
            } else {
#pragma unroll
                for (int i = 0; i < 8; ++i) v[i] = 0.f;
            }
        } else {
            const int p0 = (ch - 128) * 4;
#pragma unroll
            for (int i = 0; i < 4; ++i) {
                const int pp = p0 + i;
                const float cr = cre[n * 64 + pp], ci = cim[n * 64 + pp], qr = pwr[(tau + 1) * 64 + pp], qi = pwi[(tau + 1) * 64 + pp];
                v[2 * i] = cr * qr - ci * qi;
                v[2 * i + 1] = -(cr * qi + ci * qr);
            }
        }
        u32x4 w; w.x = pk2(v[0], v[1]); w.y = pk2(v[2], v[3]); w.z = pk2(v[4], v[5]); w.w = pk2(v[6], v[7]);
        *(u32x4*)(TH + (size_t)row * UHW + ch * 8) = w;
    }
    bf16_t* GM = (bf16_t*)(p.ws + OFF_GM) + (size_t)jg * 128 * 1024;
    for (int c = tid; c < 128 * 128; c += NTHR) {
        const int row = c >> 7, ch = c & 127;
        const int pp = row >> 1, ri = row & 1;
        const int s = ch >> 1, m0 = (ch & 1) * 8;
        const float qr = pwr[(63 - s) * 64 + pp], qi = pwi[(63 - s) * 64 + pp];
        float v[8];
#pragma unroll
        for (int i = 0; i < 8; ++i) {
            const float br = bbr[pp * 16 + m0 + i], bi = bbi[pp * 16 + m0 + i];
            v[i] = ri == 0 ? (qr * br - qi * bi) : (qr * bi + qi * br);
        }
        u32x4 w; w.x = pk2(v[0], v[1]); w.y = pk2(v[2], v[3]); w.z = pk2(v[4], v[5]); w.w = pk2(v[6], v[7]);
        *(u32x4*)(GM + (size_t)row * 1024 + ch * 8) = w;
    }
    if (tid < 64) {
        float* A64 = (float*)(p.ws + OFF_A64) + (size_t)jg * 128;
        A64[tid * 2] = pwr[64 * 64 + tid];
        A64[tid * 2 + 1] = pwi[64 * 64 + tid];
    }
    __syncthreads();
}

__device__ __forceinline__ void epi_ev_in(PRef p, f32x4 (&acc)[4][2], int row0, int c0, int fr, int fq) {
    char* ws = p.ws;
    bf16_t* PE = (bf16_t*)(ws + OFF_PE); bf16_t* UH = (bf16_t*)(ws + OFF_UH); float* GLR = (float*)(ws + OFF_GLR);
    const int col = c0 + 8 * fq;
#pragma unroll
    for (int m = 0; m < 4; ++m) {
        const int t = row0 + m * 16 + fr;
        u32x4 w; w.x = pk2(acc[m][0][0], acc[m][0][1]); w.y = pk2(acc[m][0][2], acc[m][0][3]); w.z = pk2(acc[m][1][0], acc[m][1][1]); w.w = pk2(acc[m][1][2], acc[m][1][3]);
        if (c0 < 1024) {
            *(u32x4*)(PE + (size_t)t * PE_W + col) = w;
        } else if (c0 < 1536) {
            const int ch = col - 1024, g = ch >> 4, mm = ch & 15;
            *(u32x4*)(UH + ((size_t)(t >> 6) * 32 + g) * UHW + (t & 63) * 16 + mm) = w;
        } else if (col < 1552) {
            *(f32x4*)(GLR + (size_t)t * 16 + (col - 1536)) = acc[m][0];
            *(f32x4*)(GLR + (size_t)t * 16 + (col - 1536) + 4) = acc[m][1];
        }
    }
}
__device__ __forceinline__ void epi_vt(bf16_t* __restrict__ img_row0, f32x4 (&acc)[4][2], int rt0, int c0, int fr, int fq) {
#pragma unroll
    for (int m = 0; m < 4; ++m) {
        u32x4 w; w.x = pk2(acc[m][0][0], acc[m][0][1]); w.y = pk2(acc[m][0][2], acc[m][0][3]); w.z = pk2(acc[m][1][0], acc[m][1][1]); w.w = pk2(acc[m][1][2], acc[m][1][3]);
        *(u32x4*)(img_row0 + (size_t)(rt0 + m * 16 + fr) * L_ + c0 + 8 * fq) = w;
    }
}

__device__ __forceinline__ void gla_decay(PRef p, int j, int t0, int h, float* sB) {
    const float* GLR = (const float*)(p.ws + OFF_GLR);
    const float* w2 = p.gla_w_gate2 + (size_t)j * 16 * 256;
    const float* b2 = p.gla_b_gate2 + (size_t)j * 256;
    const int tid = otid();
    for (int e = tid; e < 4096; e += NTHR) {
        const int tau = e >> 6, d = e & 63;
        float a = b2[h * 64 + d];
#pragma unroll
        for (int r = 0; r < 16; ++r) a += GLR[(size_t)(t0 + tau) * 16 + r] * w2[r * 256 + h * 64 + d];
        const float ls = fminf(a, 0.f) - __logf(1.f + __expf(-fabsf(a)));
        sB[tau * 65 + d] = ls * (1.f / 16.f);
    }
    __syncthreads();
    if (tid < 64) { float run = 0.f; for (int tau = 0; tau < 64; ++tau) { run += sB[tau * 65 + tid]; sB[tau * 65 + tid] = run; } }
    __syncthreads();
}

__device__ __forceinline__ void gla_a_item(PRef p, int j, int item, char* smem) {
    const int h = item & 3, c = (item >> 2) & 255, b = item >> 10;
    const int t0 = b * L_ + c * 64;
    float* sB = (float*)smem;
    bf16_t* AK = (bf16_t*)(smem + 16640);
    const bf16_t* PE = (const bf16_t*)(p.ws + OFF_PE);
    const bf16_t* VTE = (const bf16_t*)(p.ws + OFF_VTE);
    const int tid = otid(), lane = tid & 63, wave = tid >> 6, fr = lane & 15, fq = lane >> 4;
    gla_decay(p, j, t0, h, sB);
    for (int e = tid; e < 4096; e += NTHR) {
        const int tau = e >> 6, d = e & 63;
        const float k = bf2f(PE[(size_t)(t0 + tau) * PE_W + 256 + h * 64 + d]);
        AK[d * 72 + tau] = f2bf(k * __expf(sB[63 * 65 + d] - sB[tau * 65 + d]));
    }
    __syncthreads();
    const int dblk = wave >> 1, vb = (wave & 1) * 64;
    f32x4 acc[4];
#pragma unroll
    for (int n = 0; n < 4; ++n) acc[n] = (f32x4){0.f, 0.f, 0.f, 0.f};
#pragma unroll
    for (int ks = 0; ks < 2; ++ks) {
        const bf16x8 af = *(const bf16x8*)(AK + (dblk * 16 + fr) * 72 + ks * 32 + fq * 8);
#pragma unroll
        for (int n = 0; n < 4; ++n) {
            const int v = vb + n * 16 + fr;
            const bf16x8 bfr = *(const bf16x8*)(VTE + ((size_t)((b * 4 + h) * 128 + v)) * L_ + (c * 64 + ks * 32 + fq * 8));
            acc[n] = __builtin_amdgcn_mfma_f32_16x16x32_bf16(af, bfr, acc[n], 0, 0, 0);
        }
    }
    float* KV = (float*)(p.ws + OFF_KV) + ((size_t)((b * 256 + c) * 4 + h)) * 64 * 128;
#pragma unroll
    for (int n = 0; n < 4; ++n)
#pragma unroll
        for (int r = 0; r < 4; ++r) KV[(dblk * 16 + fq * 4 + r) * 128 + vb + n * 16 + fr] = acc[n][r];
    if (tid < 64) ((float*)(p.ws + OFF_DEC))[((size_t)((b * 256 + c) * 4 + h)) * 64 + tid] = __expf(sB[63 * 65 + tid]);
    __syncthreads();
}

__device__ __forceinline__ void scan_phase(PRef p, int j, int bid) {
    const int gid = bid * NTHR + otid();
    if (gid < 65536) {
        const int v = gid & 127, d = (gid >> 7) & 63, h = (gid >> 13) & 3, b = gid >> 15;
        const float* KV = (const float*)(p.ws + OFF_KV); float* SST = (float*)(p.ws + OFF_SST); const float* DEC = (const float*)(p.ws + OFF_DEC);
        float S = 0.f;
        for (int c0 = 0; c0 < 256; c0 += 8) {
            float kv[8], dc[8];
#pragma unroll
            for (int i = 0; i < 8; ++i) {
                const size_t blk = (size_t)((b * 256 + c0 + i) * 4 + h);
                kv[i] = KV[(blk * 64 + d) * 128 + v]; dc[i] = DEC[blk * 64 + d];
            }
#pragma unroll
            for (int i = 0; i < 8; ++i) {
                const size_t blk = (size_t)((b * 256 + c0 + i) * 4 + h);
                SST[(blk * 64 + d) * 128 + v] = S;
                S = dc[i] * S + kv[i];
            }
        }
    } else if (gid < 65536 + 4096) {
        const int e = gid - 65536, pp = e & 63, g = (e >> 6) & 31, b = e >> 11;
        const float* A64 = (const float*)(p.ws + OFF_A64) + (size_t)(j * 32 + g) * 128;
        const float ar = A64[pp * 2], ai = A64[pp * 2 + 1];
        const float* GB = (const float*)(p.ws + OFF_GBUF); bf16_t* UH = (bf16_t*)(p.ws + OFF_UH);
        float hr = 0.f, hi = 0.f;
        for (int c0 = 0; c0 < 256; c0 += 8) {
            float gr[8], gi[8];
#pragma unroll
            for (int i = 0; i < 8; ++i) { const size_t row = (size_t)(b * 256 + c0 + i) * 32 + g; gr[i] = GB[row * 128 + 2 * pp]; gi[i] = GB[row * 128 + 2 * pp + 1]; }
#pragma unroll
            for (int i = 0; i < 8; ++i) {
                const size_t row = (size_t)(b * 256 + c0 + i) * 32 + g;
                *(unsigned*)(UH + row * UHW + 1024 + 2 * pp) = pk2(hr, hi);
                const float nr = ar * hr - ai * hi + gr[i], ni = ar * hi + ai * hr + gi[i];
                hr = nr; hi = ni;
            }
        }
    }
}

__device__ __forceinline__ void gla_c_item(PRef p, int j, int item, char* smem) {
    const int h = item & 3, c = (item >> 2) & 255, b = item >> 10;
    const int t0 = b * L_ + c * 64;
    float* sB = (float*)smem;
    bf16_t* QT = (bf16_t*)(smem + 16640);
    bf16_t* KT = (bf16_t*)(smem + 16640 + 9216);
    bf16_t* ATT = (bf16_t*)(smem + 16640 + 18432);
    float* OS = (float*)(smem + 16640 + 27648);
    const bf16_t* PE = (const bf16_t*)(p.ws + OFF_PE);
    const bf16_t* VTE = (const bf16_t*)(p.ws + OFF_VTE);
    const int tid = otid(), lane = tid & 63, wave = tid >> 6, fr = lane & 15, fq = lane >> 4;
    gla_decay(p, j, t0, h, sB);
    for (int e = tid; e < 4096; e += NTHR) {
        const int tau = e >> 6, d = e & 63;
        const float bb = sB[tau * 65 + d];
        const float q = bf2f(PE[(size_t)(t0 + tau) * PE_W + h * 64 + d]);
        const float k = bf2f(PE[(size_t)(t0 + tau) * PE_W + 256 + h * 64 + d]);
        QT[tau * 72 + d] = f2bf(q * 0.125f * __expf(bb));
        KT[tau * 72 + d] = f2bf(k * __expf(-bb));
    }
    __syncthreads();
    const int iblk = wave >> 1;
    {
        f32x4 acc[2];
        acc[0] = (f32x4){0.f, 0.f, 0.f, 0.f}; acc[1] = acc[0];
#pragma unroll
        for (int ks = 0; ks < 2; ++ks) {
            const bf16x8 af = *(const bf16x8*)(QT + (iblk * 16 + fr) * 72 + ks * 32 + fq * 8);
#pragma unroll
            for (int n = 0; n < 2; ++n) {
                const int jb = (wave & 1) * 2 + n;
                const bf16x8 bfr = *(const bf16x8*)(KT + (jb * 16 + fr) * 72 + ks * 32 + fq * 8);
                acc[n] = __builtin_amdgcn_mfma_f32_16x16x32_bf16(af, bfr, acc[n], 0, 0, 0);
            }
        }
#pragma unroll
        for (int n = 0; n < 2; ++n) {
            const int jj = ((wave & 1) * 2 + n) * 16 + fr;
#pragma unroll
            for (int r = 0; r < 4; ++r) { const int ii = iblk * 16 + fq * 4 + r; ATT[ii * 72 + jj] = f2bf(jj <= ii ? acc[n][r] : 0.f); }
        }
    }
    __syncthreads();
    {
        const int vb = (wave & 1) * 64;
        const float* SST = (const float*)(p.ws + OFF_SST) + ((size_t)((b * 256 + c) * 4 + h)) * 64 * 128;
        f32x4 acc[4];
#pragma unroll
        for (int n = 0; n < 4; ++n) acc[n] = (f32x4){0.f, 0.f, 0.f, 0.f};
#pragma unroll
        for (int ks = 0; ks < 2; ++ks) {
            const bf16x8 af = *(const bf16x8*)(ATT + (iblk * 16 + fr) * 72 + ks * 32 + fq * 8);
            const bf16x8 aq = *(const bf16x8*)(QT + (iblk * 16 + fr) * 72 + ks * 32 + fq * 8);
#pragma unroll
            for (int n = 0; n < 4; ++n) {
                const int v = vb + n * 16 + fr;
                const bf16x8 bv = *(const bf16x8*)(VTE + ((size_t)((b * 4 + h) * 128 + v)) * L_ + (c * 64 + ks * 32 + fq * 8));
                acc[n] = __builtin_amdgcn_mfma_f32_16x16x32_bf16(af, bv, acc[n], 0, 0, 0);
                bf16x8 bs;
#pragma unroll
                for (int i = 0; i < 8; ++i) bs[i] = (short)f2bf(SST[(ks * 32 + fq * 8 + i) * 128 + v]);
                acc[n] = __builtin_amdgcn_mfma_f32_16x16x32_bf16(aq, bs, acc[n], 0, 0, 0);
            }
        }
#pragma unroll
        for (int n = 0; n < 4; ++n)
#pragma unroll
            for (int r = 0; r < 4; ++r) OS[(iblk * 16 + fq * 4 + r) * 132 + vb + n * 16 + fr] = acc[n][r];
    }
    __syncthreads();
    {
        const int i = tid >> 3, seg = tid & 7;
        float o[16]; float ss = 0.f;
#pragma unroll
        for (int q = 0; q < 16; ++q) { o[q] = OS[i * 132 + seg * 16 + q]; ss += o[q] * o[q]; }
        ss += __shfl_xor(ss, 1, 64); ss += __shfl_xor(ss, 2, 64); ss += __shfl_xor(ss, 4, 64);
        const float rs = rsqrtf(ss * (1.f / 128.f) + LN_EPS);
        const float* ng = p.gla_norm_g + (size_t)j * 128;
        bf16_t* CC = (bf16_t*)(p.ws + OFF_CC);
        const size_t t = (size_t)(t0 + i);
        unsigned w[8];
#pragma unroll
        for (int q = 0; q < 16; q += 2) {
            const int v0 = seg * 16 + q;
            const float r0 = bf2f(PE[t * PE_W + 512 + h * 128 + v0]), r1 = bf2f(PE[t * PE_W + 512 + h * 128 + v0 + 1]);
            const float a0 = o[q] * rs * ng[v0] * (r0 * sigmoidf_(r0)), a1 = o[q + 1] * rs * ng[v0 + 1] * (r1 * sigmoidf_(r1));
            w[q >> 1] = pk2(a0, a1);
        }
        u32x4 w0, w1; w0.x = w[0]; w0.y = w[1]; w0.z = w[2]; w0.w = w[3]; w1.x = w[4]; w1.y = w[5]; w1.z = w[6]; w1.w = w[7];
        *(u32x4*)(CC + t * 1024 + h * 128 + seg * 16) = w0;
        *(u32x4*)(CC + t * 1024 + h * 128 + seg * 16 + 8) = w1;
    }
    __syncthreads();
}

__device__ __forceinline__ void s5_g_phase(PRef p, int j, char* smem, int bid, int nb) {
    const bf16_t* UH = (const bf16_t*)(p.ws + OFF_UH);
    float* GB = (float*)(p.ws + OFF_GBUF);
    for (int t = bid; t < 64; t += nb) {
        const int g = t >> 1, mi = t & 1;
        const bf16_t* Bt = (const bf16_t*)(p.ws + OFF_GM) + (size_t)(j * 32 + g) * 128 * 1024;
        gemm_tile<false>(UH + (size_t)g * UHW, (long)32 * UHW, 0, mi * 256, Bt, 1024, 0, 1024, smem,
            [&](f32x4 (&acc)[4][2], int rt0, int c0, int fr, int fq) {
#pragma unroll
                for (int m = 0; m < 4; ++m)
#pragma unroll
                    for (int n = 0; n < 2; ++n)
#pragma unroll
                        for (int r = 0; r < 4; ++r) {
                            const int row = mi * 256 + rt0 + m * 16 + fq * 4 + r;
                            GB[((size_t)row * 32 + g) * 128 + c0 + n * 16 + fr] = acc[m][n][r];
                        }
            });
    }
}
__device__ __forceinline__ void s5_y_phase(PRef p, int j, char* smem, int bid, int nb) {
    const bf16_t* UH = (const bf16_t*)(p.ws + OFF_UH);
    bf16_t* YA = (bf16_t*)(p.ws + OFF_YA);
    const float* dsk = p.s5_d + (size_t)j * 512;
    XcdSeq sq(32 * 2 * 4, bid, nb);
    for (int t = sq.q; t < sq.qend; t += sq.step) {
        const int g = t >> 3, mi = (t >> 2) & 1, ni = t & 3;
        const bf16_t* Bt = (const bf16_t*)(p.ws + OFF_TH) + (size_t)(j * 32 + g) * 1024 * UHW;
        gemm256_tile<false>(UH + (size_t)g * UHW, (long)32 * UHW, 0, mi * 256, Bt, UHW, ni * 256, UHW, smem,
            [&](f32x4 (&acc)[4][2], int rt0, int c0, int fr, int fq) {
                const int col = c0 + 8 * fq;
                const int tau = col >> 4, nn = col & 15, ch = g * 16 + nn;
                const f32x4 d0 = *(const f32x4*)(dsk + ch), d1 = *(const f32x4*)(dsk + ch + 4);
#pragma unroll
                for (int m = 0; m < 4; ++m) {
                    const int row = mi * 256 + rt0 + m * 16 + fr;
                    const u32x4 uw = *(const u32x4*)(UH + ((size_t)row * 32 + g) * UHW + col);
                    float y[8];
#pragma unroll
                    for (int q = 0; q < 4; ++q) {
                        const unsigned u2 = q == 0 ? uw.x : q == 1 ? uw.y : q == 2 ? uw.z : uw.w;
                        const float u0 = __uint_as_float(u2 << 16), u1 = __uint_as_float(u2 & 0xffff0000u);
                        const float a0 = q < 2 ? acc[m][0][2 * q] : acc[m][1][2 * q - 4], a1 = q < 2 ? acc[m][0][2 * q + 1] : acc[m][1][2 * q - 3];
                        const float dd0 = q < 2 ? d0[2 * q] : d1[2 * q - 4], dd1 = q < 2 ? d0[2 * q + 1] : d1[2 * q - 3];
                        y[2 * q] = gelu_tanh(a0 + dd0 * u0); y[2 * q + 1] = gelu_tanh(a1 + dd1 * u1);
                    }
                    u32x4 w; w.x = pk2(y[0], y[1]); w.y = pk2(y[2], y[3]); w.z = pk2(y[4], y[5]); w.w = pk2(y[6], y[7]);
                    *(u32x4*)(YA + ((size_t)row * 64 + tau) * 512 + ch) = w;
                }
            });
    }
}

template <bool SLOTS, bool NOEPI = false>
__device__ __forceinline__ void ln_phase(PRef p, const float* xin, const float* addb, const float* g, const float* bta, float* xout, bf16_t* xb, int bid, int nb) {
    const int lane = otid() & 63, wave = otid() >> 6;
    for (int t = bid * 8 + wave; t < T_; t += nb * 8) {
        f32x4 v[4];
        float s = 0.f;
#pragma unroll
        for (int i = 0; i < 4; ++i) {
            const int c = i * 256 + lane * 4;
            f32x4 a = *(const f32x4*)(xin + (size_t)t * 1024 + c);
            f32x4 m;
            if (SLOTS) {
                const bf16_t* sl = (const bf16_t*)addb;
                m = (f32x4){0.f, 0.f, 0.f, 0.f};
#pragma unroll
                for (int k = 0; k < 4; ++k) {
                    const u32x2 w = *(const u32x2*)(sl + ((size_t)t * 4 + k) * 1024 + c);
                    m[0] += __uint_as_float(w.x << 16); m[1] += __uint_as_float(w.x & 0xffff0000u); m[2] += __uint_as_float(w.y << 16); m[3] += __uint_as_float(w.y & 0xffff0000u);
                }
            } else m = *(const f32x4*)(addb + (size_t)t * 1024 + c);
            v[i] = a * ALPHA + m;
            s += v[i][0] + v[i][1] + v[i][2] + v[i][3];
        }
        const float mu = wave_sum(s) * (1.f / 1024.f);
        float q = 0.f;
#pragma unroll
        for (int i = 0; i < 4; ++i) { v[i] -= mu; q += v[i][0] * v[i][0] + v[i][1] * v[i][1] + v[i][2] * v[i][2] + v[i][3] * v[i][3]; }
        const float rs = rsqrtf(wave_sum(q) * (1.f / 1024.f) + LN_EPS);
#pragma unroll
        for (int i = 0; i < 4; ++i) {
            const int c = i * 256 + lane * 4;
            const f32x4 gg = *(const f32x4*)(g + c), bb = *(const f32x4*)(bta + c);
            const f32x4 o = v[i] * rs * gg + bb;
            if (!NOEPI) *(f32x4*)(xout + (size_t)t * 1024 + c) = o;
            if (xb && !NOEPI) { u32x2 w; w.x = pk2(o[0], o[1]); w.y = pk2(o[2], o[3]); *(u32x2*)(xb + (size_t)t * 1024 + c) = w; }
        }
    }
}

constexpr int RT_STRIDE = 36;
constexpr int RT_SCR_OFF = 1024 * RT_STRIDE * 4;
template <bool NOEPI = false>
__device__ __forceinline__ void ln1_router_phase(PRef p, int layer, const float* xin, char* smem, int bid, int nb) {
    float* wl = (float*)smem;
    const int tid = otid(), lane = tid & 63, wave = tid >> 6;
    float* lgs = (float*)(smem + RT_SCR_OFF + wave * 640);
    int* pick = (int*)(lgs + 32);
    float* pgate = (float*)(pick + 64);
    {
        const float* rw = p.router_w + (size_t)layer * 1024 * 32;
        for (int e = tid; e < 32768; e += NTHR) {
            const int k = e >> 5, ex = e & 31, rem = k & 255;
            wl[((k & ~255) + (rem & 3) * 64 + (rem >> 2)) * RT_STRIDE + ex] = rw[e];
        }
    }
    __syncthreads();
    const float* addb = (const float*)(p.ws + OFF_MIX);
    const float* g = p.ln1_g + (size_t)layer * 1024; const float* bta = p.ln1_b + (size_t)layer * 1024;
    float* xout = (float*)(p.ws + OFF_XR); bf16_t* xb = (bf16_t*)(p.ws + OFF_XB);
    int* cnt = (int*)(p.ws + OFF_CNT) + layer * 32;
    int* LIST = (int*)(p.ws + OFF_LIST);
    float* GATE = (float*)(p.ws + OFF_GATE);
    const float rbias = p.router_b[(size_t)layer * 32 + (lane >> 1)];
    const int rstep = nb * 8;
    f32x4 xa[4], xm[4];
    {
        const int t0 = bid * 8 + wave;
        if (t0 < T_) {
#pragma unroll
            for (int i = 0; i < 4; ++i) { const int c = i * 256 + lane * 4; xa[i] = *(const f32x4*)(xin + (size_t)t0 * 1024 + c); xm[i] = *(const f32x4*)(addb + (size_t)t0 * 1024 + c); }
        }
    }
    for (int tb = bid * 8 + wave; tb < T_; tb += rstep * 16) {
        int nrow = 0;
#pragma unroll 1
        for (int t = tb; t < T_ && nrow < 16; t += rstep, ++nrow) {
            f32x4 v[4];
            float s = 0.f;
#pragma unroll
            for (int i = 0; i < 4; ++i) { v[i] = xa[i] * ALPHA + xm[i]; s += v[i][0] + v[i][1] + v[i][2] + v[i][3]; }
            if (t + rstep < T_) {
#pragma unroll
                for (int i = 0; i < 4; ++i) { const int c = i * 256 + lane * 4; xa[i] = *(const f32x4*)(xin + (size_t)(t + rstep) * 1024 + c); xm[i] = *(const f32x4*)(addb + (size_t)(t + rstep) * 1024 + c); }
            }
            const float mu = wave_sum(s) * (1.f / 1024.f);
            float q = 0.f;
#pragma unroll
            for (int i = 0; i < 4; ++i) { v[i] -= mu; q += v[i][0] * v[i][0] + v[i][1] * v[i][1] + v[i][2] * v[i][2] + v[i][3] * v[i][3]; }
            const float rs = rsqrtf(wave_sum(q) * (1.f / 1024.f) + LN_EPS);
#pragma unroll
            for (int i = 0; i < 4; ++i) {
                const int c = i * 256 + lane * 4;
                const f32x4 gg = *(const f32x4*)(g + c), bb = *(const f32x4*)(bta + c);
                v[i] = v[i] * rs * gg + bb;
                if (!NOEPI) { *(f32x4*)(xout + (size_t)t * 1024 + c) = v[i];
                u32x2 w; w.x = pk2(v[i][0], v[i][1]); w.y = pk2(v[i][2], v[i][3]); *(u32x2*)(xb + (size_t)t * 1024 + c) = w; }
            }
            f32x4 acc[8];
#pragma unroll
            for (int e = 0; e < 8; ++e) acc[e] = (f32x4){0.f, 0.f, 0.f, 0.f};
#pragma unroll
            for (int i = 0; i < 4; ++i)
#pragma unroll
                for (int j = 0; j < 4; ++j) {
                    const f32x4* wr_ = (const f32x4*)(wl + (i * 256 + j * 64 + lane) * RT_STRIDE);
                    const float xv = v[i][j];
#pragma unroll
                    for (int e = 0; e < 8; ++e) acc[e] += wr_[e] * xv;
                }
            float k16[16], k8[8], k4[4], k2[2];
#pragma unroll
            for (int a = 0; a < 16; ++a) { auto r = __builtin_amdgcn_permlane32_swap(__float_as_uint(acc[a >> 2][a & 3]), __float_as_uint(acc[(a + 16) >> 2][a & 3]), false, false); k16[a] = __uint_as_float(r[0]) + __uint_as_float(r[1]); }
#pragma unroll
            for (int a = 0; a < 8; ++a) { auto r = __builtin_amdgcn_permlane16_swap(__float_as_uint(k16[a]), __float_as_uint(k16[a + 8]), false, false); k8[a] = __uint_as_float(r[0]) + __uint_as_float(r[1]); }
            { const bool hb = lane & 8;
#pragma unroll
              for (int a = 0; a < 4; ++a) { const float mine = hb ? k8[a + 4] : k8[a], send = hb ? k8[a] : k8[a + 4]; k4[a] = mine + dppf<DPP_ROR8>(send); } }
            { const bool hb = lane & 4;
#pragma unroll
              for (int a = 0; a < 2; ++a) { const float mine = hb ? k4[a + 2] : k4[a], send = hb ? k4[a] : k4[a + 2]; k2[a] = mine + dppf<DPP_HMIR>(send); } }
            float lg;
            { const bool hb = lane & 2; const float mine = hb ? k2[1] : k2[0], send = hb ? k2[0] : k2[1]; lg = mine + dppf<DPP_X2>(send); }
            lg += dppf<DPP_X1>(lg);
            lg += rbias;
            float cand = (lane & 1) ? -INFINITY : lg;
            float tv[4]; int te[4];
#pragma unroll
            for (int r = 0; r < 4; ++r) {
                const float mxv = wave_max(cand);
                const unsigned long long bal = __builtin_amdgcn_ballot_w64(cand == mxv);
                const int first = __builtin_ctzll(bal);
                tv[r] = mxv; te[r] = first >> 1;
                if (lane == first) cand = -INFINITY;
            }
            if (lane == 0) {
                const float e1 = __expf(tv[1] - tv[0]), e2 = __expf(tv[2] - tv[0]), e3 = __expf(tv[3] - tv[0]);
                const float inv = 1.f / (1.f + e1 + e2 + e3);
                pick[nrow * 4 + 0] = te[0]; pick[nrow * 4 + 1] = te[1]; pick[nrow * 4 + 2] = te[2]; pick[nrow * 4 + 3] = te[3];
                pgate[nrow * 4 + 0] = inv; pgate[nrow * 4 + 1] = e1 * inv; pgate[nrow * 4 + 2] = e2 * inv; pgate[nrow * 4 + 3] = e3 * inv;
            }
        }
        if ((lane >> 2) < nrow && (!NOEPI || pgate[lane] < -1.f)) {
            const int t = tb + (lane >> 2) * rstep, ex = pick[lane], pair = t * 4 + (lane & 3);
            const int pos = atomicAdd(&cnt[ex], 1);
            LIST[(size_t)ex * LISTCAP + pos] = pair;
            GATE[pair] = pgate[lane];
        }
    }
}

__device__ __forceinline__ void topk_phase(PRef p, int layer, int bid, int nb) {
    const float* LG = (const float*)(p.ws + OFF_LOGIT);
    int* cnt = (int*)(p.ws + OFF_CNT) + layer * 32;
    int* LIST = (int*)(p.ws + OFF_LIST);
    float* GATE = (float*)(p.ws + OFF_GATE);
    for (int t = bid * NTHR + otid(); t < T_; t += nb * NTHR) {
        float v0 = -INFINITY, v1 = -INFINITY, v2 = -INFINITY, v3 = -INFINITY; int i0 = 0, i1 = 0, i2 = 0, i3 = 0;
#pragma unroll
        for (int q = 0; q < 8; ++q) {
            const f32x4 l4 = *(const f32x4*)(LG + (size_t)t * 32 + q * 4);
#pragma unroll
            for (int r = 0; r < 4; ++r) {
                const float v = l4[r]; const int e = q * 4 + r;
                if (v > v0) { v3 = v2; i3 = i2; v2 = v1; i2 = i1; v1 = v0; i1 = i0; v0 = v; i0 = e; }
                else if (v > v1) { v3 = v2; i3 = i2; v2 = v1; i2 = i1; v1 = v; i1 = e; }
                else if (v > v2) { v3 = v2; i3 = i2; v2 = v; i2 = e; }
                else if (v > v3) { v3 = v; i3 = e; }
            }
        }
        const float e1 = __expf(v1 - v0), e2 = __expf(v2 - v0), e3 = __expf(v3 - v0);
        const float inv = 1.f / (1.f + e1 + e2 + e3);
        int pos;
        pos = atomicAdd(&cnt[i0], 1); LIST[(size_t)i0 * LISTCAP + pos] = t * 4 + 0; GATE[t * 4 + 0] = inv;
        pos = atomicAdd(&cnt[i1], 1); LIST[(size_t)i1 * LISTCAP + pos] = t * 4 + 1; GATE[t * 4 + 1] = e1 * inv;
        pos = atomicAdd(&cnt[i2], 1); LIST[(size_t)i2 * LISTCAP + pos] = t * 4 + 2; GATE[t * 4 + 2] = e2 * inv;
        pos = atomicAdd(&cnt[i3], 1); LIST[(size_t)i3 * LISTCAP + pos] = t * 4 + 3; GATE[t * 4 + 3] = e3 * inv;
    }
}

template <int WHICH, bool NOEPI = false>
__device__ __forceinline__ void moe_gemm_phase(PRef p, int layer, char* smem, int bid, int nb) {
    const int* cnt = (const int*)(p.ws + OFF_CNT) + layer * 32;
    const int* LIST = (const int*)(p.ws + OFF_LIST);
    constexpr int NTN = WHICH == 1 ? 8 : 4;
    int total = 0;
    for (int i = 0; i < 32; ++i) total += ((cnt[i] + 255) >> 8) * NTN;
    XcdSeq sq(total, bid, nb);
    int e = 0, base = 0, ce = cnt[0], mt = (ce + 255) >> 8;
    auto src = [&](int i, G8Desc& d) -> bool {
        const int t = sq.q + i * sq.step;
        if (t >= sq.qend) return false;
        while (e < 32 && t >= base + mt * NTN) { base += mt * NTN; ++e; if (e < 32) { ce = cnt[e]; mt = (ce + 255) >> 8; } }
        if (e >= 32) return false;
        int mi, ni;
        { const int loc = t - base, pf = mt >> 2, full = pf * 4 * NTN;
          if (loc < full) { const int pn = loc / (4 * NTN), r = loc - pn * 4 * NTN; ni = r >> 2; mi = pn * 4 + (r & 3); }
          else { const int ph = mt - pf * 4, r = loc - full; ni = r / ph; mi = pf * 4 + (r - ni * ph); } }
        d.m0 = 0; d.n0 = ni * 256; d.list = LIST + (size_t)e * LISTCAP + mi * 256; d.count = ce - mi * 256; d.u0 = e; d.ldb = 1024;
        if (WHICH == 1) { d.A = (const bf16_t*)(p.ws + OFF_XB); d.Bt = (const bf16_t*)(p.ws + OFF_WT_W1) + (size_t)(layer * 32 + e) * 2048 * 1024; }
        else { d.A = (const bf16_t*)(p.ws + OFF_ACT); d.Bt = (const bf16_t*)(p.ws + OFF_WT_W2) + (size_t)(layer * 32 + e) * 1024 * 1024; }
        return true; };
    if (WHICH == 1) {
        bf16_t* ACT = (bf16_t*)(p.ws + OFF_ACT);
        gemm256_stream<true, 2>(src, 1024, 1024, smem,
            [&](int, int e_, f32x4 (&acc)[4][2], int rt0, int c0, int fr, int fq, const int* sRow) {
                const float* b1 = p.moe_b1 + (size_t)(layer * 32 + e_) * 2048;
                const int gcol = (c0 >> 5) * 16 + 4 * fq;
                const f32x4 bg = *(const f32x4*)(b1 + gcol), bl = *(const f32x4*)(b1 + 1024 + gcol);
#pragma unroll
                for (int m = 0; m < 4; ++m) {
                    const int pair = NOEPI ? -1 : sRow[rt0 + m * 16 + fr];
                    if (pair >= 0) {
                        float a[4];
#pragma unroll
                        for (int r = 0; r < 4; ++r) {
                            const float gl = fminf(acc[m][0][r] + bg[r], 7.f);
                            const float li = fminf(fmaxf(acc[m][1][r] + bl[r], -7.f), 7.f);
                            a[r] = gl * sigmoidf_(1.702f * gl) * (li + 1.f);
                        }
                        u32x2 w; w.x = pk2(a[0], a[1]); w.y = pk2(a[2], a[3]);
                        *(u32x2*)(ACT + (size_t)pair * 1024 + gcol) = w;
                    }
                }
            });
    } else {
        const float* GATE = (const float*)(p.ws + OFF_GATE);
        bf16_t* SLOT = (bf16_t*)(p.ws + OFF_SLOT);
        gemm256_stream<true, 0>(src, 1024, 1024, smem,
            [&](int, int e_, f32x4 (&acc)[4][2], int rt0, int c0, int fr, int fq, const int* sRow) {
                const float* b2 = p.moe_b2 + (size_t)(layer * 32 + e_) * 1024;
                const int col = c0 + 8 * fq;
                const f32x4 b20 = *(const f32x4*)(b2 + col), b21 = *(const f32x4*)(b2 + col + 4);
#pragma unroll
                for (int m = 0; m < 4; ++m) {
                    const int pair = NOEPI ? -1 : sRow[rt0 + m * 16 + fr];
                    if (pair >= 0) {
                        const float gt = GATE[pair];
                        const f32x4 y0 = (acc[m][0] + b20) * gt, y1 = (acc[m][1] + b21) * gt;
                        u32x4 w; w.x = pk2(y0[0], y0[1]); w.y = pk2(y0[2], y0[3]); w.z = pk2(y1[0], y1[1]); w.w = pk2(y1[2], y1[3]);
                        *(u32x4*)(SLOT + (size_t)pair * 1024 + col) = w;
                    }
                }
            });
    }
}

__device__ __forceinline__ void epi_od_in(PRef p, f32x4 (&acc)[4][2], int row0, int c0, int fr, int fq) {
    char* ws = p.ws;
    bf16_t* PO = (bf16_t*)(ws + OFF_PO); float* WI = (float*)(ws + OFF_WI);
    const int col = c0 + 8 * fq;
#pragma unroll
    for (int m = 0; m < 4; ++m) {
        const int t = row0 + m * 16 + fr;
        if (c0 < OD_WI) {
            u32x4 w; w.x = pk2(acc[m][0][0], acc[m][0][1]); w.y = pk2(acc[m][0][2], acc[m][0][3]); w.z = pk2(acc[m][1][0], acc[m][1][1]); w.w = pk2(acc[m][1][2], acc[m][1][3]);
            *(u32x4*)(PO + (size_t)t * OD_P + col) = w;
        } else if (col == OD_WI) {
            *(f32x4*)(WI + (size_t)t * 4) = acc[m][0];
        }
    }
}

__device__ __forceinline__ void idx_scores(const char* __restrict__ ktile, int kbase, const bf16x8 (&qf)[4][4], const float (&wi)[4], int lane, float (&sc)[16]) {
    const int r = lane & 31, h2 = lane >> 5;
    const char* kp = ktile + (kbase + r) * 144 + h2 * 16;
    bf16x8 kf[4];
#pragma unroll
    for (int s = 0; s < 4; ++s) kf[s] = *(const bf16x8*)(kp + s * 32);
#pragma unroll
    for (int i = 0; i < 16; ++i) sc[i] = 0.f;
#pragma unroll
    for (int hd = 0; hd < 4; ++hd) {
        f32x16 a;
#pragma unroll
        for (int i = 0; i < 16; ++i) a[i] = 0.f;
#pragma unroll
        for (int s = 0; s < 4; ++s) a = __builtin_amdgcn_mfma_f32_32x32x16_bf16(kf[s], qf[hd][s], a, 0, 0, 0);
#pragma unroll
        for (int i = 0; i < 16; ++i) { const int ai = __float_as_int(a[i]); sc[i] += wi[hd] * __int_as_float(ai > 0 ? ai : 0); }
    }
}
__device__ __forceinline__ unsigned ord_key(float s) {
    const unsigned u = __float_as_uint(s);
    return u ^ ((unsigned)((int)u >> 31) | 0x80000000u);
}

constexpr int SEL_KT = 128 * 144;
__device__ __forceinline__ void dsa_select_item(PRef p, int b, int qb, char* smem) {
    unsigned* hist = (unsigned*)smem;
    unsigned* pref = (unsigned*)(smem + 66048);
    int* krem = (int*)(smem + 66048 + 256);
    unsigned* GW = (unsigned*)(smem + 66048 + 512);
    unsigned* EW = (unsigned*)(smem + 66048 + 512 + 1024);
    char* kbuf = smem + 69632;
    const bf16_t* PO = (const bf16_t*)(p.ws + OFF_PO);
    const float* WI = (const float*)(p.ws + OFF_WI);
    unsigned long long* BMT = (unsigned long long*)(p.ws + OFF_BM);
    const int tid = otid(), lane = tid & 63, wave = tid >> 6, kw = wave >> 1, qw = wave & 1, h2 = lane >> 5;
    const int p0 = qb * 64;
    const int ql = qw * 32 + (lane & 31);
    const int qpos = p0 + ql;
    const size_t tq = (size_t)b * L_ + qpos;
    const int nkt = (p0 + 64 + 127) >> 7;
    bf16x8 qf[4][4]; float wi[4];
#pragma unroll
    for (int hd = 0; hd < 4; ++hd) {
        wi[hd] = WI[tq * 4 + hd];
#pragma unroll
        for (int s = 0; s < 4; ++s) qf[hd][s] = *(const bf16x8*)(PO + tq * OD_P + OD_QI + hd * 64 + s * 16 + h2 * 8);
    }
    const int srow = tid >> 3, sch = tid & 7;
    const bf16_t* ksrc = PO + ((size_t)b * L_ + srow) * OD_P + OD_KI + sch * 8;
    char* kdst = kbuf + srow * 144 + sch * 16;
    for (int e = tid; e < 64 * 257; e += NTHR) hist[e] = 0u;
    if (tid < 64) { pref[tid] = 0u; krem[tid] = 256; }
    __syncthreads();
    const bool selall = qpos < 256;
    const int npass = (p0 + 63 >= 256) ? 3 : 0;
    for (int pass = 0; pass <= npass; ++pass) {
        const bool maskpass = pass == npass;
        const int sh = 24 - 8 * pass;
        const unsigned mypref = pref[ql];
        int ceq = 0;
        const int rsel = tid < 64 ? krem[tid] : 0;
        u32x4 r0 = *(const u32x4*)ksrc, r1 = *(const u32x4*)(ksrc + (size_t)64 * OD_P);
        *(u32x4*)kdst = r0; *(u32x4*)(kdst + 64 * 144) = r1;
        __syncthreads();
        for (int kt = 0; kt < nkt; ++kt) {
            const bool more = kt + 1 < nkt;
            if (more) { r0 = *(const u32x4*)(ksrc + (size_t)(kt + 1) * 128 * OD_P); r1 = *(const u32x4*)(ksrc + (size_t)((kt + 1) * 128 + 64) * OD_P); }
            float sc[16];
            idx_scores(kbuf + (kt & 1) * SEL_KT, kw * 32, qf, wi, lane, sc);
            const int keybase = kt * 128 + kw * 32;
            const bool diag = kt == nkt - 1;
            if (!maskpass) {
                if (pass == 0 && !diag && p0 >= 256) {
#pragma unroll
                    for (int i = 0; i < 16; ++i) atomicAdd(&hist[ql * 257 + (ord_key(sc[i]) >> 24)], 1u);
                } else {
#pragma unroll
                    for (int i = 0; i < 16; ++i) {
                        const int key = keybase + (i & 3) + 8 * (i >> 2) + 4 * h2;
                        const unsigned k32 = ord_key(sc[i]);
                        const bool match = pass == 0 ? true : ((k32 >> (sh + 8)) == mypref);
                        const bool valid = diag ? key <= qpos : true;
                        if (valid && !selall && match) atomicAdd(&hist[ql * 257 + ((k32 >> sh) & 255u)], 1u);
                    }
                }
                if (more) { char* nd = kdst + ((kt + 1) & 1) * SEL_KT; *(u32x4*)nd = r0; *(u32x4*)(nd + 64 * 144) = r1; }
                __syncthreads();
            } else {
                unsigned gw = 0u, ew = 0u;
#pragma unroll
                for (int i = 0; i < 16; ++i) {
                    const int ko = (i & 3) + 8 * (i >> 2) + 4 * h2;
                    const int key = keybase + ko;
                    const unsigned k24 = ord_key(sc[i]) >> 8;
                    const bool valid = diag ? key <= qpos : true;
                    const bool g = valid && (selall || k24 > mypref);
                    const bool e = valid && !selall && k24 == mypref;
                    gw |= (g ? 1u : 0u) << ko; ew |= (e ? 1u : 0u) << ko;
                }
                gw = xor32_or(gw); ew = xor32_or(ew);
                if (h2 == 0) { GW[ql * 4 + kw] = gw; EW[ql * 4 + kw] = ew; }
                if (more) { char* nd = kdst + ((kt + 1) & 1) * SEL_KT; *(u32x4*)nd = r0; *(u32x4*)(nd + 64 * 144) = r1; }
                __syncthreads();
                if (tid < 64) {
                    unsigned g4[4], e4[4];
#pragma unroll
                    for (int w = 0; w < 4; ++w) { g4[w] = GW[tid * 4 + w]; e4[w] = EW[tid * 4 + w]; }
                    int need = rsel - ceq; if (need < 0) need = 0;
#pragma unroll
                    for (int w = 0; w < 4; ++w) {
                        const int pc = __popc(e4[w]);
                        ceq += pc;
                        if (need >= pc) need -= pc;
                        else { unsigned m = e4[w], kept = 0u; for (int k = 0; k < need; ++k) { const unsigned low = m & (0u - m); kept |= low; m ^= low; } e4[w] = kept; need = 0; }
                        g4[w] |= e4[w];
                    }
                    BMT[((size_t)(b * 256 + 2 * kt)) * L_ + p0 + tid] = (unsigned long long)g4[0] | ((unsigned long long)g4[1] << 32);
                    BMT[((size_t)(b * 256 + 2 * kt + 1)) * L_ + p0 + tid] = (unsigned long long)g4[2] | ((unsigned long long)g4[3] << 32);
                }
                __syncthreads();
            }
        }
        if (!maskpass) {
            const int q = tid >> 3, part = tid & 7;
            unsigned c32[32]; unsigned tot = 0u;
#pragma unroll
            for (int i = 0; i < 32; ++i) { c32[i] = hist[q * 257 + part * 32 + i]; tot += c32[i]; }
            unsigned above = 0u;
#pragma unroll
            for (int d = 1; d < 8; ++d) { const unsigned o = __shfl(tot, (lane & ~7) + ((part + d) & 7), 64); if (part + d < 8) above += o; }
            const unsigned need = (unsigned)krem[q];
            __syncthreads();
            if ((p0 + q) >= 256 && above < need && above + tot >= need) {
                unsigned cum = above; int dg = 31;
#pragma unroll
                for (int i = 31; i >= 0; --i) { if (i == dg) { if (cum + c32[i] >= need) {   } else { cum += c32[i]; dg = i - 1; } } }
                pref[q] = (pref[q] << 8) | (unsigned)(part * 32 + dg);
                krem[q] = (int)(need - cum);
            }
            for (int e = tid; e < 64 * 257; e += NTHR) hist[e] = 0u;
            __syncthreads();
        }
    }
}

template <int MODE, int NQT>
__device__ __forceinline__ void attn_wave(PRef p, int b, int head, int qcol, int kcol, const bf16_t* __restrict__ VT, int voff,
                                          int i0, int sh  , int rho, int kt_lo, int kt_hi, int grp) {
    const bf16_t* PO = (const bf16_t*)(p.ws + OFF_PO);
    const unsigned* BM32 = (const unsigned*)(p.ws + OFF_BM);
    const int lane = otid() & 63, r = lane & 31, h2 = lane >> 5;
    const int pr = (r & 0x13) | ((r & 4) << 1) | ((r & 8) >> 1);
    const float SC = 0.125f * 1.4426950408889634f;
    bf16x8 qf[NQT][4]; size_t tq[NQT]; int qi[NQT];
#pragma unroll
    for (int qt = 0; qt < NQT; ++qt) {
        qi[qt] = i0 + qt * 32 + r;
        tq[qt] = (size_t)b * L_ + ((size_t)qi[qt] << sh) + rho;
#pragma unroll
        for (int s = 0; s < 4; ++s) qf[qt][s] = *(const bf16x8*)(PO + tq[qt] * OD_P + qcol + head * 64 + s * 16 + h2 * 8);
    }
    f32x16 oacc[NQT][2];
#pragma unroll
    for (int a = 0; a < NQT; ++a)
#pragma unroll
        for (int c = 0; c < 2; ++c)
#pragma unroll
            for (int i = 0; i < 16; ++i) oacc[a][c][i] = 0.f;
    float mrun[NQT], lrun[NQT];
#pragma unroll
    for (int a = 0; a < NQT; ++a) { mrun[a] = -64.f; lrun[a] = 0.f; }
    bf16x8 kf[4]; unsigned mw[NQT];
    auto load_k = [&](int kt, bf16x8 (&k_)[4], unsigned (&m_)[NQT]) {
        const size_t krow = (size_t)b * L_ + ((size_t)(kt * 32 + pr) << sh) + rho;
#pragma unroll
        for (int s = 0; s < 4; ++s) k_[s] = *(const bf16x8*)(PO + krow * OD_P + kcol + head * 64 + s * 16 + h2 * 8);
#pragma unroll
        for (int a = 0; a < NQT; ++a) m_[a] = MODE == 0 ? BM32[tq[a] * 512 + kt] : 0u;
    };
    load_k(kt_lo, kf, mw);
#pragma unroll 1
    for (int kt = kt_lo; kt <= kt_hi; ++kt) {
        bf16x8 vf[2][2];
#pragma unroll
        for (int db = 0; db < 2; ++db)
#pragma unroll
            for (int s2 = 0; s2 < 2; ++s2) vf[db][s2] = *(const bf16x8*)(VT + (size_t)(db * 32 + r) * L_ + voff + kt * 32 + s2 * 16 + h2 * 8);
        bf16x8 kn[4]; unsigned mn[NQT];
#pragma unroll
        for (int a = 0; a < NQT; ++a) mn[a] = 0u;
        if (kt < kt_hi) load_k(kt + 1, kn, mn);
#pragma unroll
        for (int qt = 0; qt < NQT; ++qt) {
            f32x16 s;
#pragma unroll
            for (int i = 0; i < 16; ++i) s[i] = 0.f;
#pragma unroll
            for (int ks = 0; ks < 4; ++ks) s = __builtin_amdgcn_mfma_f32_32x32x16_bf16(kf[ks], qf[qt][ks], s, 0, 0, 0);
            unsigned wsel;
            if (MODE == 0) wsel = mw[qt];
            else {
                const int hi = qi[qt] - kt * 32, lo = hi - 128;
                const unsigned mh = hi < 0 ? 0u : (hi >= 31 ? 0xffffffffu : ((2u << hi) - 1u)), ml = lo <= 0 ? 0xffffffffu : (lo > 31 ? 0u : ~((1u << lo) - 1u));
                wsel = mh & ml;
            }
#pragma unroll
            for (int i = 0; i < 16; ++i) s[i] = __builtin_fmaf(s[i], SC, -mrun[qt]);
            float mx = fmaxf(fmaxf(s[0], s[1]), fmaxf(s[2], s[3]));
#pragma unroll
            for (int i = 4; i < 16; i += 2) mx = fmaxf(mx, fmaxf(s[i], s[i + 1]));
            mx = xor32_max(mx);
            if (__builtin_amdgcn_ballot_w64(mx > 0.f) != 0ull) {
                const float dlt = fmaxf(mx, 0.f);
                const float corr = __builtin_amdgcn_exp2f(-dlt);
                mrun[qt] += dlt; lrun[qt] *= corr;
#pragma unroll
                for (int db = 0; db < 2; ++db)
#pragma unroll
                    for (int i = 0; i < 16; ++i) oacc[qt][db][i] *= corr;
#pragma unroll
                for (int i = 0; i < 16; ++i) s[i] -= dlt;
            }
            float ps = 0.f;
            const int mws = (int)(wsel >> (8 * h2));
#define DA_P(i, KO) { const float e = __builtin_amdgcn_exp2f(s[i]); s[i] = __uint_as_float(__float_as_uint(e) & bitmask32<KO>(mws)); ps += s[i]; }
            DA_P(0, 0) DA_P(1, 1) DA_P(2, 2) DA_P(3, 3) DA_P(4, 4) DA_P(5, 5) DA_P(6, 6) DA_P(7, 7)
            DA_P(8, 16) DA_P(9, 17) DA_P(10, 18) DA_P(11, 19) DA_P(12, 20) DA_P(13, 21) DA_P(14, 22) DA_P(15, 23)
#undef DA_P
            lrun[qt] += ps;
#pragma unroll
            for (int s2 = 0; s2 < 2; ++s2) {
                u32x4 pw; pw.x = pk2(s[8 * s2], s[8 * s2 + 1]); pw.y = pk2(s[8 * s2 + 2], s[8 * s2 + 3]); pw.z = pk2(s[8 * s2 + 4], s[8 * s2 + 5]); pw.w = pk2(s[8 * s2 + 6], s[8 * s2 + 7]);
                const bf16x8 pf = __builtin_bit_cast(bf16x8, pw);
#pragma unroll
                for (int db = 0; db < 2; ++db) oacc[qt][db] = __builtin_amdgcn_mfma_f32_32x32x16_bf16(vf[db][s2], pf, oacc[qt][db], 0, 0, 0);
            }
        }
        if (kt < kt_hi) {
#pragma unroll
            for (int s = 0; s < 4; ++s) kf[s] = kn[s];
#pragma unroll
            for (int a = 0; a < NQT; ++a) mw[a] = mn[a];
        }
    }
#pragma unroll
    for (int qt = 0; qt < NQT; ++qt) {
        const float lt = xor32_sum(lrun[qt]);
        const float inv = 1.f / lt;
        if (MODE == 0) {
            bf16_t* CC = (bf16_t*)(p.ws + OFF_CC);
#pragma unroll
            for (int db = 0; db < 2; ++db)
#pragma unroll
                for (int i = 0; i < 16; ++i) {
                    const int d = db * 32 + (i & 3) + 8 * (i >> 2) + 4 * h2;
                    CC[tq[qt] * 1024 + head * 64 + d] = f2bf(oacc[qt][db][i] * inv);
                }
        } else {
            float* OD = (float*)(p.ws + OFF_OD) + (size_t)grp * T_ * 512;
#pragma unroll
            for (int db = 0; db < 2; ++db)
#pragma unroll
                for (int i = 0; i < 16; i += 4) {
                    const int d = db * 32 + 8 * (i >> 2) + 4 * h2;
                    *(f32x4*)(OD + tq[qt] * 512 + head * 64 + d) = (f32x4){oacc[qt][db][i] * inv, oacc[qt][db][i + 1] * inv, oacc[qt][db][i + 2] * inv, oacc[qt][db][i + 3] * inv};
                }
            if (h2 == 0) ((float*)(p.ws + OFF_LSE))[((size_t)grp * T_ + tq[qt]) * 8 + head] = mrun[qt] + log2f(lt);
        }
    }
}

__device__ __forceinline__ void dil_combine_phase(PRef p, int bid, int nb) {
    const float* OD = (const float*)(p.ws + OFF_OD); const float* LSE = (const float*)(p.ws + OFF_LSE);
    bf16_t* CC = (bf16_t*)(p.ws + OFF_CC);
    const long n = (long)T_ * 128;
    for (long c = (long)bid * NTHR + otid(); c < n; c += (long)nb * NTHR) {
        const long t = c >> 7; const int ch = (int)(c & 127) * 4, hd = ch >> 6;
        const float l0 = LSE[((size_t)0 * T_ + t) * 8 + hd], l1 = LSE[((size_t)1 * T_ + t) * 8 + hd], l2 = LSE[((size_t)2 * T_ + t) * 8 + hd];
        const float mx = fmaxf(l0, fmaxf(l1, l2));
        const float w0 = __builtin_amdgcn_exp2f(l0 - mx), w1 = __builtin_amdgcn_exp2f(l1 - mx), w2 = __builtin_amdgcn_exp2f(l2 - mx);
        const float inv = __builtin_amdgcn_rcpf(w0 + w1 + w2);
        const f32x4 a = *(const f32x4*)(OD + ((size_t)0 * T_ + t) * 512 + ch), bq = *(const f32x4*)(OD + ((size_t)1 * T_ + t) * 512 + ch),
                    cq = *(const f32x4*)(OD + ((size_t)2 * T_ + t) * 512 + ch);
        const f32x4 o = (a * w0 + bq * w1 + cq * w2) * inv;
        u32x2 w; w.x = pk2(o[0], o[1]); w.y = pk2(o[2], o[3]);
        *(u32x2*)(CC + (size_t)t * 1024 + 512 + ch) = w;
    }
}

constexpr int DA_ROW = 144;
constexpr int DA_TILE = 64 * DA_ROW;
__device__ __forceinline__ void dsa_attn_item(PRef p, int b, int head, int qb, char* smem) {
    const bf16_t* PO = (const bf16_t*)(p.ws + OFF_PO);
    const bf16_t* VT = (const bf16_t*)(p.ws + OFF_VTC) + ((size_t)(b * 8 + head)) * 64 * L_;
    const int tid = otid(), lane = tid & 63, wave = tid >> 6, r = lane & 31, h2 = lane >> 5;
    const int pr = (r & 0x13) | ((r & 4) << 1) | ((r & 8) >> 1);
    const float SC = 0.125f * 1.4426950408889634f;
    const int i0 = qb * 256 + wave * 32, qi = i0 + r;
    const unsigned long long* BMT = (const unsigned long long*)(p.ws + OFF_BM) + (size_t)b * 256 * L_ + qi;
    const size_t tq = (size_t)b * L_ + qi;
    bf16x8 qf[4];
#pragma unroll
    for (int s = 0; s < 4; ++s) qf[s] = *(const bf16x8*)(PO + tq * OD_P + head * 64 + s * 16 + h2 * 8);
    f32x16 oacc[2];
#pragma unroll
    for (int c = 0; c < 2; ++c)
#pragma unroll
        for (int i = 0; i < 16; ++i) oacc[c][i] = 0.f;
    float mrun = -64.f, lrun = 0.f;
    const int nkt = qb * 4 + 4, my_last = (i0 + 31) >> 6;
    const int srow = tid >> 3, sch = tid & 7;
    const bf16_t* ksrc = PO + ((size_t)b * L_ + srow) * OD_P + 512 + head * 64 + sch * 8;
    const bf16_t* vsrc = VT + (size_t)srow * L_ + sch * 8;
    u32x4 rk = *(const u32x4*)ksrc, rv = *(const u32x4*)vsrc;
    __syncthreads();
    *(u32x4*)(smem + srow * DA_ROW + sch * 16) = rk;
    *(u32x4*)(smem + DA_TILE + srow * DA_ROW + sch * 16) = rv;
    __syncthreads();
    unsigned long long mwn = BMT[0];
#pragma unroll 1
    for (int kt = 0; kt < nkt; ++kt) {
        const bool more = kt + 1 < nkt;
        if (more) { rk = *(const u32x4*)(ksrc + (size_t)(kt + 1) * 64 * OD_P); rv = *(const u32x4*)(vsrc + (kt + 1) * 64); }
        const unsigned long long mw64 = mwn;
        if (kt < my_last) mwn = BMT[(size_t)(kt + 1) * L_];
        if (kt <= my_last) {
            const char* kb = smem + (kt & 1) * 2 * DA_TILE; const char* vb = kb + DA_TILE;
            f32x16 sa[2];
#pragma unroll
            for (int sub = 0; sub < 2; ++sub) {
                bf16x8 kf[4];
#pragma unroll
                for (int s = 0; s < 4; ++s) kf[s] = *(const bf16x8*)(kb + (sub * 32 + pr) * DA_ROW + (s * 16 + h2 * 8) * 2);
#pragma unroll
                for (int i = 0; i < 16; ++i) sa[sub][i] = 0.f;
#pragma unroll
                for (int ks = 0; ks < 4; ++ks) sa[sub] = __builtin_amdgcn_mfma_f32_32x32x16_bf16(kf[ks], qf[ks], sa[sub], 0, 0, 0);
            }
#pragma unroll
            for (int sub = 0; sub < 2; ++sub) {
                const unsigned mw = sub == 0 ? (unsigned)mw64 : (unsigned)(mw64 >> 32);
                f32x16& s = sa[sub];
                bf16x8 vf[2][2];
#pragma unroll
                for (int db = 0; db < 2; ++db)
#pragma unroll
                    for (int s2 = 0; s2 < 2; ++s2) vf[db][s2] = *(const bf16x8*)(vb + (db * 32 + r) * DA_ROW + (sub * 32 + s2 * 16 + h2 * 8) * 2);
#pragma unroll
                for (int i = 0; i < 16; ++i) s[i] = __builtin_fmaf(s[i], SC, -mrun);
                float mx = fmaxf(fmaxf(s[0], s[1]), fmaxf(s[2], s[3]));
#pragma unroll
                for (int i = 4; i < 16; i += 2) mx = fmaxf(mx, fmaxf(s[i], s[i + 1]));
                mx = xor32_max(mx);
                if (__builtin_amdgcn_ballot_w64(mx > 0.f) != 0ull) {
                    const float dlt = fmaxf(mx, 0.f);
                    const float corr = __builtin_amdgcn_exp2f(-dlt);
                    mrun += dlt; lrun *= corr;
#pragma unroll
                    for (int db = 0; db < 2; ++db)
#pragma unroll
                        for (int i = 0; i < 16; ++i) oacc[db][i] *= corr;
#pragma unroll
                    for (int i = 0; i < 16; ++i) s[i] -= dlt;
                }
                float ps = 0.f;
                const int mws = (int)(mw >> (8 * h2));
#define DA_P(i, KO) { const float e = __builtin_amdgcn_exp2f(s[i]); s[i] = __uint_as_float(__float_as_uint(e) & bitmask32<KO>(mws)); ps += s[i]; }
                DA_P(0, 0) DA_P(1, 1) DA_P(2, 2) DA_P(3, 3) DA_P(4, 4) DA_P(5, 5) DA_P(6, 6) DA_P(7, 7)
                DA_P(8, 16) DA_P(9, 17) DA_P(10, 18) DA_P(11, 19) DA_P(12, 20) DA_P(13, 21) DA_P(14, 22) DA_P(15, 23)
#undef DA_P
                lrun += ps;
#pragma unroll
                for (int s2 = 0; s2 < 2; ++s2) {
                    u32x4 pw; pw.x = pk2(s[8 * s2], s[8 * s2 + 1]); pw.y = pk2(s[8 * s2 + 2], s[8 * s2 + 3]); pw.z = pk2(s[8 * s2 + 4], s[8 * s2 + 5]); pw.w = pk2(s[8 * s2 + 6], s[8 * s2 + 7]);
                    const bf16x8 pf = __builtin_bit_cast(bf16x8, pw);
#pragma unroll
                    for (int db = 0; db < 2; ++db) oacc[db] = __builtin_amdgcn_mfma_f32_32x32x16_bf16(vf[db][s2], pf, oacc[db], 0, 0, 0);
                }
            }
        }
        if (more) {
            char* nbuf = smem + ((kt + 1) & 1) * 2 * DA_TILE;
            *(u32x4*)(nbuf + srow * DA_ROW + sch * 16) = rk;
            *(u32x4*)(nbuf + DA_TILE + srow * DA_ROW + sch * 16) = rv;
        }
        __syncthreads();
    }
    const float lt = xor32_sum(lrun);
    const float inv = 1.f / lt;
    bf16_t* CC = (bf16_t*)(p.ws + OFF_CC);
#pragma unroll
    for (int db = 0; db < 2; ++db)
#pragma unroll
        for (int i = 0; i < 16; i += 4) {
            const int d = db * 32 + 8 * (i >> 2) + 4 * h2;
            u32x2 w; w.x = pk2(oacc[db][i] * inv, oacc[db][i + 1] * inv); w.y = pk2(oacc[db][i + 2] * inv, oacc[db][i + 3] * inv);
            *(u32x2*)(CC + tq * 1024 + head * 64 + d) = w;
        }
}


template <bool ODD>
__device__ __forceinline__ void inproj_phase(PRef p, int j, char* smem, int bid, int nb) {
    char* ws = p.ws;
    constexpr int NTN = ODD ? OD_P / 256 : EV_P / 256, NMAIN = 128 * NTN, NVT = ODD ? 1024 : 256;
    const bf16_t* XB = (const bf16_t*)(ws + OFF_XB);
    const bf16_t* W = ODD ? (const bf16_t*)(ws + OFF_WT_ODIN) + (size_t)j * OD_N * 1024 : (const bf16_t*)(ws + OFF_WT_EVIN) + (size_t)j * EV_N * 1024;
    XcdSeq s(NMAIN + NVT, bid, nb);
    gemm256_stream<false, 0>(
        [&](int i, G8Desc& d) -> bool {
            const int Q = s.q + i * s.step; if (Q >= s.qend) return false;
            d.list = nullptr; d.count = 0;
            if (Q < NMAIN) {
                const int pnl = Q / (4 * NTN), r = Q - pnl * 4 * NTN;
                d.A = XB; d.Bt = W; d.m0 = (pnl * 4 + (r & 3)) * 256; d.n0 = (r >> 2) * 256; d.u0 = -1; d.ldb = 1024;
            } else {
                const int v = Q - NMAIN; d.m0 = 0; d.n0 = 0; d.u0 = v;
                if (ODD) {
                    const int combo = v & 7, src = combo >> 1, mt = combo & 1, bn = v >> 3, b = bn >> 6, lam0 = (bn & 63) * 256;
                    const int sh = src < 2 ? 0 : (src == 2 ? 2 : 4), rho = lam0 >> (14 - sh), i0 = lam0 & ((L_ >> sh) - 1);
                    d.A = W + (size_t)(OD_P + src * 512 + mt * 256) * 1024;
                    d.Bt = XB + ((size_t)b * L_ + ((size_t)i0 << sh) + rho) * 1024; d.ldb = 1024 << sh;
                } else {
                    const int mt = v & 1, bn = v >> 1;
                    d.A = W + (size_t)(EV_P + mt * 256) * 1024;
                    d.Bt = XB + (size_t)bn * 256 * 1024; d.ldb = 1024;
                }
            }
            return true; },
        1024, 1024, smem,
        [&](int m0, int u0, f32x4 (&acc)[4][2], int rt0, int c0, int fr, int fq, const int*) {
            if (u0 < 0) { if (ODD) epi_od_in(p, acc, m0 + rt0, c0, fr, fq); else epi_ev_in(p, acc, m0 + rt0, c0, fr, fq); }
            else if (ODD) {
                const int combo = u0 & 7, src = combo >> 1, mt = combo & 1, bn = u0 >> 3, b = bn >> 6, lam0 = (bn & 63) * 256;
                bf16_t* img = src == 0 ? (bf16_t*)(ws + OFF_VTC) + ((size_t)(b * 8) * 64 + mt * 256) * L_ + lam0
                                       : (bf16_t*)(ws + OFF_VTD) + ((size_t)((b * 3 + src - 1) * 8) * 64 + mt * 256) * L_ + lam0;
                epi_vt(img, acc, rt0, c0, fr, fq);
            } else {
                const int mt = u0 & 1, bn = u0 >> 1, b = bn >> 6, lam0 = (bn & 63) * 256;
                epi_vt((bf16_t*)(ws + OFF_VTE) + ((size_t)(b * 4) * 128 + mt * 256) * L_ + lam0, acc, rt0, c0, fr, fq);
            }
        });
}

enum { K_PRO = 0, K_E1, K_E2, K_E3, K_E4, K_E5, K_E6, K_LN1, K_O1, K_O2, K_O3, K_O4, K_M1, K_M2, K_M3, K_M4, K_LN2, K_COUNT };

template <int KIND, bool NOEPI = false>
__device__ __forceinline__ void run_phase(PRef p, int layer, char* smem, int bid, int nb) {
    char* ws = p.ws;
    const int j = layer >> 1;
    if (KIND == K_PRO) {
        conv_phase(p, smem, bid, nb);
        __syncthreads();
        for (int u = nb - 1 - bid; u < 64; u += nb) s5mat_unit(p, u >> 5, u & 31, smem);
    } else if (KIND == K_E1) {
        inproj_phase<false>(p, j, smem, bid, nb);
    } else if (KIND == K_E2) {
        for (int it = bid; it < 2048; it += nb) gla_a_item(p, j, it, smem);
        s5_g_phase(p, j, smem, bid, nb);
    } else if (KIND == K_E3) {
        scan_phase(p, j, bid);
    } else if (KIND == K_E4) {
        for (int it = bid; it < 2048; it += nb) gla_c_item(p, j, it, smem);
        s5_y_phase(p, j, smem, bid, nb);
    } else if (KIND == K_E5) {
        const bf16_t* YA = (const bf16_t*)(ws + OFF_YA); bf16_t* CC = (bf16_t*)(ws + OFF_CC); const float* bg = p.s5_b_glu + (size_t)j * 512;
        gemm256_phase(YA, 512, T_, (const bf16_t*)(ws + OFF_WT_GLU) + (size_t)j * 512 * 512, 512, 512, 512, smem, bid, nb,
                   [&](f32x4 (&acc)[4][2], int row0, int c0, int fr, int fq) {
                       const int col = c0 + 8 * fq;
                       const f32x4 g0 = *(const f32x4*)(bg + col), g1 = *(const f32x4*)(bg + col + 4);
#pragma unroll
                       for (int m = 0; m < 4; ++m) {
                           const size_t t = (size_t)(row0 + m * 16 + fr);
                           const u32x4 yw = *(const u32x4*)(YA + t * 512 + col);
                           float o[8];
#pragma unroll
                           for (int q = 0; q < 4; ++q) {
                               const unsigned y2 = q == 0 ? yw.x : q == 1 ? yw.y : q == 2 ? yw.z : yw.w;
                               const float y0 = __uint_as_float(y2 << 16), y1 = __uint_as_float(y2 & 0xffff0000u);
                               const float a0 = q < 2 ? acc[m][0][2 * q] + g0[2 * q] : acc[m][1][2 * q - 4] + g1[2 * q - 4];
                               const float a1 = q < 2 ? acc[m][0][2 * q + 1] + g0[2 * q + 1] : acc[m][1][2 * q - 3] + g1[2 * q - 3];
                               o[2 * q] = y0 * sigmoidf_(a0); o[2 * q + 1] = y1 * sigmoidf_(a1);
                           }
                           u32x4 w; w.x = pk2(o[0], o[1]); w.y = pk2(o[2], o[3]); w.z = pk2(o[4], o[5]); w.w = pk2(o[6], o[7]);
                           *(u32x4*)(CC + t * 1024 + 512 + col) = w;
                       }
                   });
    } else if (KIND == K_E6 || KIND == K_O4) {
        float* MIX = (float*)(ws + OFF_MIX);
        const bf16_t* W = (const bf16_t*)(ws + (KIND == K_E6 ? OFF_WT_EVOUT : OFF_WT_ODOUT)) + (size_t)j * 1024 * 1024;
        gemm256_phase((const bf16_t*)(ws + OFF_CC), 1024, T_, W, 1024, 1024, 1024, smem, bid, nb,
                   [&](f32x4 (&acc)[4][2], int row0, int c0, int fr, int fq) {
#pragma unroll
                       for (int m = 0; m < 4; ++m) {
                           float* o = MIX + (size_t)(row0 + m * 16 + fr) * 1024 + c0 + 8 * fq;
                           *(f32x4*)o = acc[m][0]; *(f32x4*)(o + 4) = acc[m][1];
                       }
                   });
    } else if (KIND == K_LN1) {
        const float* xin = layer == 0 ? p.x : (const float*)(ws + OFF_XR);
        ln1_router_phase<NOEPI>(p, layer, xin, smem, bid, nb);
    } else if (KIND == K_O1) {
        inproj_phase<true>(p, j, smem, bid, nb);
    } else if (KIND == K_O2) {
        if (!NOEPI) for (int k = bid; k < 256; k += nb) {
            dsa_select_item(p, k & 1, k >> 1, smem);
            __syncthreads();
            const int k2 = 511 - k;
            dsa_select_item(p, k2 & 1, k2 >> 1, smem);
            __syncthreads();
        }
        const int head = otid() >> 6;
        for (int it = bid; it < 1536; it += nb) {
            const int b = it / 768, rem = it - b * 768, g = rem >> 8, u = rem & 255;
            const int sh = g * 2, per = 256 >> sh, rho = u / per, qblk = u - rho * per;
            const bf16_t* VT = (const bf16_t*)(ws + OFF_VTD) + ((size_t)((b * 3 + g) * 8 + head)) * 64 * L_;
#pragma unroll 1
            for (int hf = 0; hf < 2; ++hf) {
                const int hi = 2 * qblk + hf, lo = hi - 4;
                attn_wave<1, 1>(p, b, head, OD_DIL + g * 512, OD_DIL + 1536 + g * 512, VT, rho * (L_ >> sh), qblk * 64 + hf * 32, sh, rho, lo < 0 ? 0 : lo, hi, g);
            }
        }
    } else if (KIND == K_O3) {
        for (int k = bid; k < 512; k += nb) {
            const int bh = k >> 5, q0 = k & 31;
#pragma unroll 1
            for (int half = 0; half < 2; ++half) dsa_attn_item(p, bh >> 3, bh & 7, half == 0 ? q0 : 63 - q0, smem);
        }
        dil_combine_phase(p, bid, nb);
    } else if (KIND == K_M1) {
        float* LG = (float*)(ws + OFF_LOGIT); const float* rb = p.router_b + (size_t)layer * 32;
        gemm_phase((const bf16_t*)(ws + OFF_XB), 1024, T_, (const bf16_t*)(ws + OFF_WT_RT) + (size_t)layer * 128 * 1024, 1024, 128, 1024, smem, bid, nb,
                   [&](f32x4 (&acc)[4][2], int row0, int c0, int fr, int fq) {
#pragma unroll
                       for (int n = 0; n < 2; ++n) {
                           const int col = c0 + n * 16 + fr;
                           if (col < 32) {
#pragma unroll
                               for (int m = 0; m < 4; ++m)
#pragma unroll
                                   for (int r = 0; r < 4; ++r) LG[(size_t)(row0 + m * 16 + fq * 4 + r) * 32 + col] = acc[m][n][r] + rb[col];
                           }
                       }
                   });
    } else if (KIND == K_M2) {
        topk_phase(p, layer, bid, nb);
    } else if (KIND == K_M3) {
        moe_gemm_phase<1, NOEPI>(p, layer, smem, bid, nb);
    } else if (KIND == K_M4) {
        moe_gemm_phase<2, NOEPI>(p, layer, smem, bid, nb);
    } else if (KIND == K_LN2) {
        float* xo = layer == 3 ? p.out : (float*)(ws + OFF_XR);
        ln_phase<true, NOEPI>(p, (const float*)(ws + OFF_XR), (const float*)(ws + OFF_SLOT), p.ln2_g + (size_t)layer * 1024, p.ln2_b + (size_t)layer * 1024, xo,
                       layer == 3 ? (bf16_t*)nullptr : (bf16_t*)(ws + OFF_XB), bid, nb);
    }
}

extern __shared__ __attribute__((aligned(16))) char dyn_smem[];

#if !MEGA
template <int KIND>
__global__ void __launch_bounds__(NTHR, 2) k_phase(Params p, int layer) { run_phase<KIND>(p, layer, dyn_smem, blockIdx.x, gridDim.x); }
#else
#ifndef DUPMASK
#define DUPMASK 0
#endif
typedef const __attribute__((address_space(4))) Params* KParams;
#define RUNP(K) do { KParams _q = kp0; asm volatile("" : "+s"(_q)); run_phase<K>(*_q, layer, smem, bid, nb); } while (0)
#ifndef DUPNOEPI
#define DUPNOEPI 0
#endif
#define RUNP2(K) do { KParams _q = kp0; asm volatile("" : "+s"(_q)); run_phase<K, (DUPNOEPI != 0)>(*_q, layer, smem, bid, nb); } while (0)
#define PHASE(K) do { RUNP(K); xcd_barrier(bar); if ((DUPMASK >> 30) & 1) xcd_barrier(bar); if ((DUPMASK >> K) & 1) { RUNP2(K); xcd_barrier(bar); } } while (0)
template <int LAYER>
__device__ __forceinline__ void mega_layer(KParams kp0, char* smem, int bid, int nb, const XcdBarrier& bar) {
    constexpr int layer = LAYER;
    if ((layer & 1) == 0) { PHASE(K_E1); PHASE(K_E2); PHASE(K_E3); PHASE(K_E4); PHASE(K_E5); PHASE(K_E6); }
    else { PHASE(K_O1); PHASE(K_O2); PHASE(K_O3); PHASE(K_O4); }
    PHASE(K_LN1); PHASE(K_M3); PHASE(K_M4);
    RUNP(K_LN2);
    if (layer < 3) xcd_barrier(bar);
}
__global__ void __launch_bounds__(NTHR, 2) k_mega(Params p) {
    char* smem = dyn_smem;
    const int bid = blockIdx.x, nb = gridDim.x;
    volatile LAS unsigned* st = (volatile LAS unsigned*)(dyn_smem + LDS_BYTES - 16);
    if (otid() == 0) { st[0] = 0u; st[1] = 0u; }
    __syncthreads();
    KParams kp0 = (KParams)__builtin_amdgcn_kernarg_segment_ptr();
    XcdBarrier bar = xcd_barrier_post((unsigned*)(kp0->ws + OFF_BAR), st);
    { const int layer = 0; PHASE(K_PRO); }
    mega_layer<0>(kp0, smem, bid, nb, bar);
    mega_layer<1>(kp0, smem, bid, nb, bar);
    mega_layer<2>(kp0, smem, bid, nb, bar);
    mega_layer<3>(kp0, smem, bid, nb, bar);
}
#endif

extern "C" void kernel_launch(void* const* d_in, const int* in_sizes, int n_in, void* d_out, int out_size, void* d_ws, size_t ws_size, hipStream_t stream) {
    Params p{};
    const float** f = (const float**)&p;
    for (int i = 0; i < 28; ++i) f[i] = (const float*)d_in[i];
    p.out = (float*)d_out; p.ws = (char*)d_ws;
    if (ws_size < WS_NEED) { fprintf(stderr, "workspace too small: %zu < %zu\n", ws_size, (size_t)WS_NEED); return; }
#if !MEGA
#define SETATTR(K) hipFuncSetAttribute((const void*)k_phase<K>, hipFuncAttributeMaxDynamicSharedMemorySize, LDS_BYTES)
#define LAUNCH(K, layer) k_phase<K><<<256, NTHR, LDS_BYTES, stream>>>(p, layer)
    static bool attr_done = false;
    if (!attr_done) {
        SETATTR(K_PRO); SETATTR(K_E1); SETATTR(K_E2); SETATTR(K_E3); SETATTR(K_E4); SETATTR(K_E5); SETATTR(K_E6); SETATTR(K_LN1); SETATTR(K_O1); SETATTR(K_O2); SETATTR(K_O3);
        SETATTR(K_O4); SETATTR(K_M1); SETATTR(K_M2); SETATTR(K_M3); SETATTR(K_M4); SETATTR(K_LN2);
        attr_done = true;
    }
    LAUNCH(K_PRO, 0);
    for (int layer = 0; layer < 4; ++layer) {
        if ((layer & 1) == 0) { LAUNCH(K_E1, layer); LAUNCH(K_E2, layer); LAUNCH(K_E3, layer); LAUNCH(K_E4, layer); LAUNCH(K_E5, layer); LAUNCH(K_E6, layer); }
        else { LAUNCH(K_O1, layer); LAUNCH(K_O2, layer); LAUNCH(K_O3, layer); LAUNCH(K_O4, layer); }
        LAUNCH(K_LN1, layer); LAUNCH(K_M3, layer); LAUNCH(K_M4, layer); LAUNCH(K_LN2, layer);
    }
#else
    static int grid = 0;
    if (!grid) {
        hipFuncSetAttribute((const void*)k_mega, hipFuncAttributeMaxDynamicSharedMemorySize, LDS_BYTES);
        int dev = 0, cus = 0, per_cu = 0;
        hipGetDevice(&dev);
        hipDeviceGetAttribute(&cus, hipDeviceAttributeMultiprocessorCount, dev);
        hipOccupancyMaxActiveBlocksPerMultiprocessor(&per_cu, (const void*)k_mega, NTHR, LDS_BYTES);
        grid = cus * (per_cu < 1 ? per_cu : 1);
        if (grid <= 0) grid = 0;
    }
    if (!grid) { fprintf(stderr, "occupancy query says 0 blocks per CU\n"); return; }
    hipMemsetAsync((char*)d_ws + OFF_BAR, 0, XCD_BAR_WORDS * sizeof(unsigned), stream);
    k_mega<<<grid, NTHR, LDS_BYTES, stream>>>(p);
#endif
}
```

```cpp
#include <hip/hip_runtime.h>
#include <stdint.h>
#include <stdio.h>

#ifndef MEGA
#define MEGA 1
#define DUPMASK 0
#define DUPNOEPI 0
#endif

typedef unsigned short bf16_t;
typedef short bf16x8 __attribute__((ext_vector_type(8)));
typedef float f32x4 __attribute__((ext_vector_type(4)));
typedef float f32x16 __attribute__((ext_vector_type(16)));
typedef unsigned u32x4 __attribute__((ext_vector_type(4)));
typedef unsigned u32x2 __attribute__((ext_vector_type(2)));

constexpr int T_ = 32768, D_ = 1024, L_ = 16384, NB_ = 2;
constexpr int NTHR = 512;
constexpr float ALPHA = 1.681792830507429f;
constexpr float LN_EPS = 1e-5f;
constexpr int EV_N = 2304;
constexpr int EV_P = 1792;
constexpr int PE_W = 1024;
constexpr int OD_N = 6656;
constexpr int OD_P = 4608;
constexpr int OD_QI = 1024, OD_DIL = 1280, OD_KI = 4352, OD_WI = 4416;
constexpr int UHW = 1152;
constexpr int LISTCAP = 131072;

constexpr size_t OFF_BAR = 0;
constexpr size_t OFF_CNT = 16384;
constexpr size_t OFF_A64 = 32768;
constexpr size_t OFF_WT_EVIN = 131072;
constexpr size_t OFF_WT_ODIN = OFF_WT_EVIN + (size_t)2 * EV_N * 1024 * 2;
constexpr size_t OFF_WT_EVOUT = OFF_WT_ODIN + (size_t)2 * OD_N * 1024 * 2;
constexpr size_t OFF_WT_ODOUT = OFF_WT_EVOUT + (size_t)2 * 1024 * 1024 * 2;
constexpr size_t OFF_WT_GLU = OFF_WT_ODOUT + (size_t)2 * 1024 * 1024 * 2;
constexpr size_t OFF_WT_RT = OFF_WT_GLU + (size_t)2 * 512 * 512 * 2;
constexpr size_t OFF_WT_W1 = OFF_WT_RT + (size_t)4 * 128 * 1024 * 2;
constexpr size_t OFF_WT_W2 = OFF_WT_W1 + (size_t)4 * 32 * 2048 * 1024 * 2;
constexpr size_t OFF_TH = OFF_WT_W2 + (size_t)4 * 32 * 1024 * 1024 * 2;
constexpr size_t OFF_GM = OFF_TH + (size_t)2 * 32 * 1024 * UHW * 2;
constexpr size_t OFF_XR = OFF_GM + (size_t)2 * 32 * 128 * 1024 * 2;
constexpr size_t OFF_XB = OFF_XR + (size_t)T_ * 1024 * 4;
constexpr size_t OFF_MIX = OFF_XB + (size_t)T_ * 1024 * 2;
constexpr size_t OFF_CC = OFF_MIX + (size_t)T_ * 1024 * 4;
constexpr size_t OFF_LOGIT = OFF_CC + (size_t)T_ * 1024 * 2;
constexpr size_t OFF_LIST = OFF_LOGIT + (size_t)T_ * 32 * 4;
constexpr size_t OFF_GATE = OFF_LIST + (size_t)32 * LISTCAP * 4;
constexpr size_t OFF_ACT = OFF_GATE + (size_t)T_ * 4 * 4;
constexpr size_t OFF_SLOT = OFF_ACT + (size_t)T_ * 4 * 1024 * 2;
constexpr size_t OFF_MIXER = OFF_SLOT + (size_t)T_ * 4 * 1024 * 4;
constexpr size_t OFF_PE = OFF_MIXER;
constexpr size_t OFF_UH = OFF_PE + (size_t)T_ * 1536 * 2;
constexpr size_t OFF_GLR = OFF_UH + (size_t)(T_ / 64) * 32 * UHW * 2;
constexpr size_t OFF_VTE = OFF_GLR + (size_t)T_ * 16 * 4;
constexpr size_t OFF_KV = OFF_VTE + (size_t)2 * 4 * 128 * L_ * 2;
constexpr size_t OFF_SST = OFF_KV + (size_t)2 * 256 * 4 * 64 * 128 * 4;
constexpr size_t OFF_DEC = OFF_SST + (size_t)2 * 256 * 4 * 64 * 128 * 4;
constexpr size_t OFF_GBUF = OFF_DEC + (size_t)2 * 256 * 4 * 64 * 4;
constexpr size_t OFF_YA = OFF_GBUF + (size_t)512 * 32 * 128 * 4;
constexpr size_t END_EVEN = OFF_YA + (size_t)T_ * 512 * 2;
constexpr size_t OFF_PO = OFF_MIXER;
constexpr size_t OFF_WI = OFF_PO + (size_t)T_ * OD_N * 2;
constexpr size_t OFF_VTC = OFF_WI + (size_t)T_ * 4 * 4;
constexpr size_t OFF_VTD = OFF_VTC + (size_t)2 * 8 * 64 * L_ * 2;
constexpr size_t OFF_BM = OFF_VTD + (size_t)2 * 3 * 8 * 64 * L_ * 2;
constexpr size_t OFF_OD = OFF_BM + (size_t)T_ * 256 * 8;
constexpr size_t OFF_LSE = OFF_OD + (size_t)3 * T_ * 512 * 4;
constexpr size_t END_ODD = OFF_LSE + (size_t)3 * T_ * 8 * 4;
constexpr size_t WS_NEED = END_ODD > END_EVEN ? END_ODD : END_EVEN;
static_assert(WS_NEED < (size_t)4200000000ull, "workspace too large");

constexpr int LDS_BYTES = 153600;

struct Params {
    const float *x, *ev_w_in, *gla_w_gate2, *gla_b_gate2, *gla_norm_g, *s5_a_re, *s5_a_im, *s5_log_dt, *s5_b_re, *s5_b_im, *s5_c_re, *s5_c_im, *s5_d,
        *s5_w_glu, *s5_b_glu, *ev_w_out, *od_w_in, *od_w_out, *ln1_g, *ln1_b, *ln2_g, *ln2_b, *router_w, *router_b, *moe_w1, *moe_b1, *moe_w2, *moe_b2;
    float* out;
    char* ws;
};

#if MEGA
typedef const __attribute__((address_space(4))) Params& PRef;
#else
typedef const Params& PRef;
#endif

__device__ __forceinline__ unsigned pk2(float lo, float hi) { unsigned r; asm("v_cvt_pk_bf16_f32 %0, %1, %2" : "=v"(r) : "v"(lo), "v"(hi)); return r; }
__device__ __forceinline__ bf16_t f2bf(float f) { return (bf16_t)(pk2(f, 0.f) & 0xffffu); }
__device__ __forceinline__ float bf2f(bf16_t h) { return __uint_as_float(((unsigned)h) << 16); }
__device__ __forceinline__ float sigmoidf_(float x) { return __builtin_amdgcn_rcpf(1.f + __expf(-x)); }
template <int CTRL> __device__ __forceinline__ float dppf(float v) { return __int_as_float(__builtin_amdgcn_update_dpp(0, __float_as_int(v), CTRL, 0xF, 0xF, false)); }
constexpr int DPP_X1 = 0xB1  , DPP_X2 = 0x4E  , DPP_HMIR = 0x141  , DPP_MIR = 0x140  , DPP_ROR8 = 0x128;
__device__ __forceinline__ float xor16_sum(float v) { const unsigned u = __float_as_uint(v); auto r = __builtin_amdgcn_permlane16_swap(u, u, false, false); return __uint_as_float(r[0]) + __uint_as_float(r[1]); }
__device__ __forceinline__ float xor16_max(float v) { const unsigned u = __float_as_uint(v); auto r = __builtin_amdgcn_permlane16_swap(u, u, false, false); return fmaxf(__uint_as_float(r[0]), __uint_as_float(r[1])); }
__device__ __forceinline__ float xor32_sum_(float v) { const unsigned u = __float_as_uint(v); auto r = __builtin_amdgcn_permlane32_swap(u, u, false, false); return __uint_as_float(r[0]) + __uint_as_float(r[1]); }
__device__ __forceinline__ float xor32_max_(float v) { const unsigned u = __float_as_uint(v); auto r = __builtin_amdgcn_permlane32_swap(u, u, false, false); return fmaxf(__uint_as_float(r[0]), __uint_as_float(r[1])); }
__device__ __forceinline__ float wave_sum(float v) {
    v += dppf<DPP_X1>(v); v += dppf<DPP_X2>(v); v += dppf<DPP_HMIR>(v); v += dppf<DPP_MIR>(v);
    return xor32_sum_(xor16_sum(v));
}
__device__ __forceinline__ float wave_max(float v) {
    v = fmaxf(v, dppf<DPP_X1>(v)); v = fmaxf(v, dppf<DPP_X2>(v)); v = fmaxf(v, dppf<DPP_HMIR>(v)); v = fmaxf(v, dppf<DPP_MIR>(v));
    return xor32_max_(xor16_max(v));
}
__device__ __forceinline__ float gelu_tanh(float x) {
    const float k0 = 0.7978845608028654f, k1 = 0.044715f;
    float u = k0 * (x + k1 * x * x * x);
    float t = 1.f - 2.f * __builtin_amdgcn_rcpf(1.f + __expf(2.f * u));
    return 0.5f * x * (1.f + t);
}
__device__ __forceinline__ float xor32_max(float v) { const unsigned u = __float_as_uint(v); auto r = __builtin_amdgcn_permlane32_swap(u, u, false, false); return fmaxf(__uint_as_float(r[0]), __uint_as_float(r[1])); }
__device__ __forceinline__ float xor32_sum(float v) { const unsigned u = __float_as_uint(v); auto r = __builtin_amdgcn_permlane32_swap(u, u, false, false); return __uint_as_float(r[0]) + __uint_as_float(r[1]); }
__device__ __forceinline__ unsigned xor32_or(unsigned u) { auto r = __builtin_amdgcn_permlane32_swap(u, u, false, false); return r[0] | r[1]; }
template <int BIT> __device__ __forceinline__ unsigned bitmask32(int w) { unsigned m; asm("v_bfe_i32 %0, %1, %2, 1" : "=v"(m) : "v"(w), "n"(BIT)); return m; }
__device__ __forceinline__ int otid() { int t = threadIdx.x; asm volatile("" : "+v"(t)); return t; }

#define XB_TMO      128
#define XB_XCNT(j)  (256  + 64 * (j))
#define XB_XSUB(j)  (1280 + 64 * (j))
#define XB_XGEN(j)  (2304 + 64 * (j))
#define XB_TOP      3328
#define XB_TOPGEN   3392
#define XCD_BAR_WORDS 3456
#define XB_SPIN_CAP (1u << 21)
#define LAS __attribute__((address_space(3)))

__device__ __forceinline__ unsigned xb_ld(unsigned* p)              { return __hip_atomic_load(p, __ATOMIC_RELAXED, __HIP_MEMORY_SCOPE_AGENT); }
__device__ __forceinline__ unsigned xb_add(unsigned* p, unsigned v) { return __hip_atomic_fetch_add(p, v, __ATOMIC_RELAXED, __HIP_MEMORY_SCOPE_AGENT); }
__device__ __forceinline__ unsigned xb_xcc_id() { return (unsigned)__builtin_amdgcn_s_getreg((3 << 11) | 20) & 0xFu; }
#define XB_SPIN(cond, bar) do { unsigned _sp = 0; while (cond) { __builtin_amdgcn_s_sleep(1); \
    if ((++_sp & 255u) == 0u) { if (xb_ld(&(bar)[XB_TMO])) break; if (_sp > XB_SPIN_CAP) { atomicAdd(&(bar)[XB_TMO], 1u); break; } } } } while (0)

struct XcdBarrier { unsigned* bar; unsigned x; volatile LAS unsigned* st; };

__device__ __forceinline__ XcdBarrier xcd_barrier_post(unsigned* bar, volatile LAS unsigned* st) {
    XcdBarrier b; b.bar = bar; b.x = xb_xcc_id(); b.st = st;
    if (threadIdx.x == 0) (void)xb_add(&bar[XB_XCNT(b.x)], 1u);
    return b;
}
__device__ __forceinline__ void xcd_barrier_complete(unsigned* bar, unsigned x, unsigned& nloc, unsigned& nx) {
    const unsigned G = gridDim.x * gridDim.y * gridDim.z;
    unsigned sum, cnt, mine, sp = 0u;
    for (;;) {
        sum = 0u; cnt = 0u; mine = 0u;
#pragma unroll
        for (unsigned j = 0; j < 16; ++j) { const unsigned c = xb_ld(&bar[XB_XCNT(j)]); sum += c; cnt += (c > 0u) ? 1u : 0u; mine = (j == x) ? c : mine; }
        if (sum == G) break;
        __builtin_amdgcn_s_sleep(1);
        if ((++sp & 255u) == 0u) { if (xb_ld(&bar[XB_TMO])) break; if (sp > XB_SPIN_CAP) { atomicAdd(&bar[XB_TMO], 1u); break; } }
    }
    nloc = mine > 0u ? mine : 1u; nx = cnt > 0u ? cnt : 1u;
}
__device__ __forceinline__ void xcd_barrier(const XcdBarrier& b) {
    asm volatile("s_waitcnt vmcnt(0)" ::: "memory");
    __syncthreads();
    if (threadIdx.x == 0) {
        unsigned* bar = b.bar;
        __builtin_amdgcn_s_waitcnt(0);
        unsigned nloc = b.st[0], nx = b.st[1];
        if (nloc == 0u) { xcd_barrier_complete(bar, b.x, nloc, nx); b.st[0] = nloc; b.st[1] = nx; }
        const unsigned old = xb_add(&bar[XB_XSUB(b.x)], 1u);
        const unsigned gen = old / nloc;
        if (old + 1u == (gen + 1u) * nloc) {
            __builtin_amdgcn_fence(__ATOMIC_RELEASE, "agent");
            asm volatile("s_waitcnt vmcnt(0)" ::: "memory");
            const unsigned og = xb_add(&bar[XB_TOP], 1u);
            const unsigned tg = og / nx;
            if (og + 1u == (tg + 1u) * nx) xb_add(&bar[XB_TOPGEN], 1u);
            else XB_SPIN(xb_ld(&bar[XB_TOPGEN]) == tg, bar);
            __builtin_amdgcn_fence(__ATOMIC_ACQUIRE, "agent");
            xb_add(&bar[XB_XGEN(b.x)], 1u);
            asm volatile("s_waitcnt vmcnt(0)" ::: "memory");
        } else {
            XB_SPIN(xb_ld(&bar[XB_XGEN(b.x)]) == gen, bar);
            __builtin_amdgcn_fence(__ATOMIC_ACQUIRE, "agent");
            asm volatile("s_waitcnt vmcnt(0)" ::: "memory");
        }
    }
    __syncthreads();
}

constexpr int G_LROW = 144;
constexpr int G_ASZ = 256 * G_LROW;
constexpr int G_BSZ = 128 * G_LROW;
constexpr int G_STAGE = G_ASZ + G_BSZ;
constexpr int G_ROWS_OFF = 2 * G_STAGE;

template <bool GATHER, class Epi>
__device__ __forceinline__ void gemm_tile(const bf16_t* __restrict__ A, long lda, int shift, int m0, const bf16_t* __restrict__ Bt, long ldb, int n0, int K,
                                          char* smem, Epi&& epi) {
    const int tid = otid(), lane = tid & 63, wave = tid >> 6, wr = wave >> 1, wc = wave & 1, fr = lane & 15, fq = lane >> 4;
    const int lrow = tid >> 3, lchunk = tid & 7;
    const int* sRow = (const int*)(smem + G_ROWS_OFF);
    const bf16_t* pa[4]; const bf16_t* pb[2];
#pragma unroll
    for (int i = 0; i < 4; ++i) {
        int r = lrow + 64 * i; long arow;
        if (GATHER) { int v = sRow[r]; arow = v < 0 ? 0 : (v >> shift); } else arow = m0 + r;
        pa[i] = A + arow * lda + lchunk * 8;
    }
#pragma unroll
    for (int i = 0; i < 2; ++i) pb[i] = Bt + (long)(n0 + lrow + 64 * i) * ldb + lchunk * 8;
    f32x4 acc[4][4];
#pragma unroll
    for (int m = 0; m < 4; ++m)
#pragma unroll
        for (int n = 0; n < 4; ++n) acc[m][n] = (f32x4){0.f, 0.f, 0.f, 0.f};
    u32x4 ra[4], rb[2];
    const int nk = K >> 6;
#pragma unroll
    for (int i = 0; i < 4; ++i) ra[i] = *(const u32x4*)(pa[i]);
#pragma unroll
    for (int i = 0; i < 2; ++i) rb[i] = *(const u32x4*)(pb[i]);
    {
        char* sa = smem; char* sb = smem + G_ASZ;
#pragma unroll
        for (int i = 0; i < 4; ++i) *(u32x4*)(sa + (lrow + 64 * i) * G_LROW + lchunk * 16) = ra[i];
#pragma unroll
        for (int i = 0; i < 2; ++i) *(u32x4*)(sb + (lrow + 64 * i) * G_LROW + lchunk * 16) = rb[i];
    }
    __syncthreads();
    for (int kt = 0; kt < nk; ++kt) {
        const bool more = (kt + 1 < nk);
        if (more) {
#pragma unroll
            for (int i = 0; i < 4; ++i) ra[i] = *(const u32x4*)(pa[i] + (kt + 1) * 64);
#pragma unroll
            for (int i = 0; i < 2; ++i) rb[i] = *(const u32x4*)(pb[i] + (kt + 1) * 64);
        }
        const char* sa = smem + (kt & 1) * G_STAGE; const char* sb = sa + G_ASZ;
#pragma unroll
        for (int ks = 0; ks < 2; ++ks) {
            bf16x8 af[4], bfr[4];
#pragma unroll
            for (int m = 0; m < 4; ++m) af[m] = *(const bf16x8*)(sa + (wr * 64 + m * 16 + fr) * G_LROW + (ks * 32 + fq * 8) * 2);
#pragma unroll
            for (int n = 0; n < 4; ++n) bfr[n] = *(const bf16x8*)(sb + (wc * 64 + n * 16 + fr) * G_LROW + (ks * 32 + fq * 8) * 2);
#pragma unroll
            for (int m = 0; m < 4; ++m)
#pragma unroll
                for (int n = 0; n < 4; ++n) acc[m][n] = __builtin_amdgcn_mfma_f32_16x16x32_bf16(af[m], bfr[n], acc[m][n], 0, 0, 0);
        }
        if (more) {
            char* wa = smem + ((kt + 1) & 1) * G_STAGE; char* wb = wa + G_ASZ;
#pragma unroll
            for (int i = 0; i < 4; ++i) *(u32x4*)(wa + (lrow + 64 * i) * G_LROW + lchunk * 16) = ra[i];
#pragma unroll
            for (int i = 0; i < 2; ++i) *(u32x4*)(wb + (lrow + 64 * i) * G_LROW + lchunk * 16) = rb[i];
        }
        __syncthreads();
    }
    {
        f32x4 h0[4][2], h1[4][2];
#pragma unroll
        for (int m = 0; m < 4; ++m) { h0[m][0] = acc[m][0]; h0[m][1] = acc[m][1]; h1[m][0] = acc[m][2]; h1[m][1] = acc[m][3]; }
        epi(h0, wr * 64, n0 + wc * 64, fr, fq);
        epi(h1, wr * 64, n0 + wc * 64 + 32, fr, fq);
    }
}

template <class Epi>
__device__ __forceinline__ void gemm_phase(const bf16_t* A, long lda, int M, const bf16_t* Bt, long ldb, int N, int K, char* smem, int bid, int nb, Epi&& epi) {
    const int ntn = N / 128, ntm = M / 256, nt = ntn * ntm;
    for (int t = bid; t < nt; t += nb) {
        const int mi = t / ntn, ni = t - mi * ntn;
        gemm_tile<false>(A, lda, 0, mi * 256, Bt, ldb, ni * 128, K, smem,
                         [&](f32x4 (&acc)[4][2], int rt0, int c0, int fr, int fq) { epi(acc, mi * 256 + rt0, c0, fr, fq); });
    }
}

constexpr int G8_HT = 128 * 64 * 2;
constexpr int G8_ROWS_OFF = 8 * G8_HT;

__device__ __forceinline__ int g8_lds_byte(int r, int c) {
    const int st = (r >> 4) * 2 + (c >> 5), rr = r & 15, cc = c & 31, ob = rr * 64 + cc * 2;
    return st * 1024 + (ob ^ (((ob >> 9) & 1) << 5));
}
__device__ __forceinline__ void g8_stage_rc(int b, int& R, int& C) {
    const int st = b / 1024, sb = b % 1024, swz = sb ^ (((sb >> 9) & 1) << 5);
    R = (st >> 1) * 16 + swz / 64; C = (st & 1) * 32 + (swz % 64) / 2;
}

#define G8_SA(b, h) (lds + ((b) * 2 + (h)) * G8_HT)
#define G8_SB(b, h) (lds + (4 + (b) * 2 + (h)) * G8_HT)
#define G8_STAGE(P, RS, OFF, soff) do { \
    _Pragma("unroll") for (int _i = 0; _i < 2; ++_i) \
        __builtin_amdgcn_raw_ptr_buffer_load_lds((RS), (LAS unsigned*)((P) + tid * 16 + _i * 8192), 16, (OFF)[_i], (soff), 0, 0); } while (0)
#define G8_LDA(dst, b, h) do { _Pragma("unroll") for (int m = 0; m < 4; ++m) _Pragma("unroll") for (int k = 0; k < 2; ++k) \
    dst[m][k] = *(const LAS bf16x8*)(G8_SA(b, h) + g8_lds_byte(wr * 64 + m * 16 + fr, k * 32 + fq * 8)); } while (0)
#define G8_LDB(dst, b, h) do { _Pragma("unroll") for (int n = 0; n < 2; ++n) _Pragma("unroll") for (int k = 0; k < 2; ++k) \
    dst[n][k] = *(const LAS bf16x8*)(G8_SB(b, h) + g8_lds_byte(wc * 32 + n * 16 + fr, k * 32 + fq * 8)); } while (0)
#define G8_MMA(ai, bj, At, Bt_) do { __builtin_amdgcn_s_setprio(1); \
    _Pragma("unroll") for (int m = 0; m < 4; ++m) _Pragma("unroll") for (int n = 0; n < 2; ++n) _Pragma("unroll") for (int k = 0; k < 2; ++k) \
        acc[ai][bj][m][n] = __builtin_amdgcn_mfma_f32_16x16x32_bf16(Bt_[n][k], At[m][k], acc[ai][bj][m][n], 0, 0, 0); \
    __builtin_amdgcn_s_setprio(0); } while (0)
#define G8_WAIT_V(n) asm volatile("s_waitcnt vmcnt(" #n ")" ::: "memory")
#define G8_WAIT_L(n) asm volatile("s_waitcnt lgkmcnt(" #n ")" ::: "memory")
#define G8_BAR __builtin_amdgcn_s_barrier()
#define G8_SCHED __builtin_amdgcn_sched_barrier(0)

template <bool GATHER, class Epi>
__device__ __forceinline__ void gemm256_tile(const bf16_t* __restrict__ A, long lda, int shift, int m0, const bf16_t* __restrict__ Bt, long ldb, int n0, int K,
                                             char* smem, Epi&& epi) {
    LAS char* lds = (LAS char*)smem;
    int tid = otid();
    int wid = tid >> 6, lane = tid & 63, wr = wid >> 2, wc = wid & 3, fr = lane & 15, fq = lane >> 4;
    unsigned aoff[2][2], boff[2];
    {
        const LAS int* sRow = (const LAS int*)(lds + G8_ROWS_OFF);
#pragma unroll
        for (int i = 0; i < 2; ++i) {
            int R, C; g8_stage_rc(tid * 16 + i * 8192, R, C);
            { const int rho = R & 31, nn = rho >> 4, ii = rho & 15; const int Rp = (R & ~31) + 8 * (ii >> 2) + 4 * nn + (ii & 3);
              boff[i] = (unsigned)((long)Rp * ldb + C) * 2u; }
#pragma unroll
            for (int h = 0; h < 2; ++h) {
                long arow;
                if (GATHER) { const int v = sRow[h * 128 + R]; arow = v < 0 ? 0 : (v >> shift); } else arow = m0 + h * 128 + R;
                aoff[h][i] = (unsigned)(arow * lda + C) * 2u;
            }
        }
    }
    f32x4 acc[2][2][4][2];
#pragma unroll
    for (int a = 0; a < 2; ++a)
#pragma unroll
        for (int b = 0; b < 2; ++b)
#pragma unroll
            for (int m = 0; m < 4; ++m)
#pragma unroll
                for (int n = 0; n < 2; ++n) acc[a][b][m][n] = (f32x4){0.f, 0.f, 0.f, 0.f};
    bf16x8 At[4][2], B0[2][2], B1[2][2];
    const int nt = K / 64;
    const __amdgpu_buffer_rsrc_t rA = __builtin_amdgcn_make_buffer_rsrc((void*)A, 0, 0x7fffffff, 0x00020000);
    const __amdgpu_buffer_rsrc_t rB = __builtin_amdgcn_make_buffer_rsrc((void*)(Bt + (size_t)n0 * ldb), 0, 0x7fffffff, 0x00020000);
    const int bh = (int)(128 * ldb * 2);
    G8_STAGE(G8_SB(0, 0), rB, boff, 0); G8_STAGE(G8_SA(0, 0), rA, aoff[0], 0);
    G8_STAGE(G8_SB(0, 1), rB, boff, bh); G8_STAGE(G8_SA(0, 1), rA, aoff[1], 0);
    if (wr == 1) G8_BAR;
    G8_WAIT_V(4); G8_BAR;
    G8_STAGE(G8_SB(1, 0), rB, boff, 128); G8_STAGE(G8_SA(1, 0), rA, aoff[0], 128); G8_STAGE(G8_SB(1, 1), rB, boff, 128 + bh);
    G8_WAIT_V(6); G8_BAR;
    for (int t = 0; t < nt - 2; t += 2) {
        G8_LDB(B0, 0, 0); G8_SCHED; G8_LDA(At, 0, 0); G8_STAGE(G8_SA(1, 1), rA, aoff[1], (t + 1) * 128);
        G8_WAIT_L(8); G8_BAR; G8_WAIT_L(0); G8_MMA(0, 0, At, B0); G8_BAR; G8_SCHED;
        G8_LDB(B1, 0, 1); G8_STAGE(G8_SB(0, 0), rB, boff, (t + 2) * 128);
        G8_BAR; G8_WAIT_L(0); G8_MMA(0, 1, At, B1); G8_BAR;
        G8_LDA(At, 0, 1); G8_STAGE(G8_SA(0, 0), rA, aoff[0], (t + 2) * 128);
        G8_BAR; G8_WAIT_L(0); G8_MMA(1, 0, At, B0); G8_BAR; G8_SCHED;
        G8_STAGE(G8_SB(0, 1), rB, boff, (t + 2) * 128 + bh);
        G8_WAIT_V(6); G8_BAR; G8_MMA(1, 1, At, B1); G8_BAR;
        G8_LDB(B0, 1, 0); G8_SCHED; G8_LDA(At, 1, 0); G8_STAGE(G8_SA(0, 1), rA, aoff[1], (t + 2) * 128);
        G8_WAIT_L(8); G8_BAR; G8_WAIT_L(0); G8_MMA(0, 0, At, B0); G8_BAR; G8_SCHED;
        G8_LDB(B1, 1, 1); G8_STAGE(G8_SB(1, 0), rB, boff, (t + 3) * 128);
        G8_BAR; G8_WAIT_L(0); G8_MMA(0, 1, At, B1); G8_BAR;
        G8_LDA(At, 1, 1); G8_STAGE(G8_SA(1, 0), rA, aoff[0], (t + 3) * 128);
        G8_BAR; G8_WAIT_L(0); G8_MMA(1, 0, At, B0); G8_BAR; G8_SCHED;
        G8_STAGE(G8_SB(1, 1), rB, boff, (t + 3) * 128 + bh);
        G8_WAIT_V(6); G8_BAR; G8_MMA(1, 1, At, B1); G8_BAR;
    }
    { G8_LDB(B0, 0, 0); G8_WAIT_V(0); G8_LDA(At, 0, 0); G8_STAGE(G8_SA(1, 1), rA, aoff[1], (nt - 1) * 128);
      G8_BAR; G8_WAIT_L(0); G8_MMA(0, 0, At, B0); G8_BAR;
      G8_LDB(B1, 0, 1); G8_BAR; G8_WAIT_L(0); G8_MMA(0, 1, At, B1); G8_BAR;
      G8_LDA(At, 0, 1); G8_WAIT_V(4); G8_BAR; G8_WAIT_L(0); G8_MMA(1, 0, At, B0); G8_MMA(1, 1, At, B1); G8_BAR; }
    { G8_LDB(B0, 1, 0); G8_LDA(At, 1, 0); G8_WAIT_V(2); G8_BAR; G8_WAIT_L(0); G8_MMA(0, 0, At, B0); G8_BAR;
      G8_LDB(B1, 1, 1); G8_WAIT_V(0); G8_BAR; G8_WAIT_L(0); G8_MMA(0, 1, At, B1); G8_BAR;
      G8_LDA(At, 1, 1); G8_BAR; G8_WAIT_L(0); G8_MMA(1, 0, At, B0); G8_MMA(1, 1, At, B1); G8_BAR; }
    if (wr == 0) G8_BAR;
    int tz = otid(); wid = tz >> 6; lane = tz & 63; wr = wid >> 2; wc = wid & 3; fr = lane & 15; fq = lane >> 4;
#pragma unroll
    for (int ai = 0; ai < 2; ++ai)
#pragma unroll
        for (int bj = 0; bj < 2; ++bj) epi(acc[ai][bj], ai * 128 + wr * 64, n0 + bj * 128 + wc * 32, fr, fq);
}

struct G8Desc { const bf16_t* A; const bf16_t* Bt; const int* list; int m0, n0, count, u0, ldb; };

template <bool GATHER, int SHIFT, class Src, class Epi>
__device__ __forceinline__ void gemm256_stream(Src&& src, const int lda, const int K, char* smem, Epi&& epi) {
    LAS char* lds = (LAS char*)smem;
    int tid = otid();
    int wid = tid >> 6, lane = tid & 63, wr = wid >> 2, wc = wid & 3, fr = lane & 15, fq = lane >> 4;
    G8Desc nxt;
    if (!src(0, nxt)) return;
    int cm0 = nxt.m0, cn0 = nxt.n0, cu0 = nxt.u0;
    int* sRowG = (int*)(smem + G8_ROWS_OFF);
    __syncthreads();
    if (GATHER) { if (tid < 256) sRowG[tid] = tid < nxt.count ? nxt.list[tid] : -1; __syncthreads(); }
    unsigned aoff[2][2], boff[2];
    __amdgpu_buffer_rsrc_t rA, rB;
    int bh;
#define G8_PREP(D, SLOT) do { \
        const LAS int* _sr = (const LAS int*)(lds + G8_ROWS_OFF) + (SLOT) * 256; \
        _Pragma("unroll") for (int i = 0; i < 2; ++i) { \
            int R, C; g8_stage_rc(tid * 16 + i * 8192, R, C); \
            { const int rho = R & 31, nn = rho >> 4, ii = rho & 15; const int Rp = (R & ~31) + 8 * (ii >> 2) + 4 * nn + (ii & 3); boff[i] = (unsigned)(Rp * (D).ldb + C) * 2u; } \
            _Pragma("unroll") for (int h = 0; h < 2; ++h) { \
                int arow; \
                if (GATHER) { const int v = _sr[h * 128 + R]; arow = v < 0 ? 0 : (v >> SHIFT); } else arow = (D).m0 + h * 128 + R; \
                aoff[h][i] = (unsigned)(arow * lda + C) * 2u; } } \
        rA = __builtin_amdgcn_make_buffer_rsrc((void*)(D).A, 0, 0x7fffffff, 0x00020000); \
        rB = __builtin_amdgcn_make_buffer_rsrc((void*)((D).Bt + (size_t)(D).n0 * (D).ldb), 0, 0x7fffffff, 0x00020000); bh = 128 * (D).ldb * 2; } while (0)
#define G8_PRO1() do { G8_STAGE(G8_SB(0, 0), rB, boff, 0); G8_STAGE(G8_SA(0, 0), rA, aoff[0], 0); G8_STAGE(G8_SB(0, 1), rB, boff, bh); G8_STAGE(G8_SA(0, 1), rA, aoff[1], 0); } while (0)
    G8_PREP(nxt, 0);
    G8_PRO1();
    f32x4 acc[2][2][4][2];
    const int nt = K / 64;
    for (int it = 0;; ++it) {
#pragma unroll
        for (int a = 0; a < 2; ++a)
#pragma unroll
            for (int b = 0; b < 2; ++b)
#pragma unroll
                for (int m = 0; m < 4; ++m)
#pragma unroll
                    for (int n = 0; n < 2; ++n) acc[a][b][m][n] = (f32x4){0.f, 0.f, 0.f, 0.f};
        const bool has_next = src(it + 1, nxt);
        if (GATHER && has_next && tid < 256) sRowG[((it + 1) % 3) * 256 + tid] = tid < nxt.count ? nxt.list[tid] : -1;
        bf16x8 At[4][2], B0[2][2], B1[2][2];
        if (wr == 1) G8_BAR;
        G8_WAIT_V(4); G8_BAR;
        G8_STAGE(G8_SB(1, 0), rB, boff, 128); G8_STAGE(G8_SA(1, 0), rA, aoff[0], 128); G8_STAGE(G8_SB(1, 1), rB, boff, 128 + bh);
        G8_WAIT_V(6); G8_BAR;
        for (int t = 0; t < nt - 2; t += 2) {
            G8_LDB(B0, 0, 0); G8_SCHED; G8_LDA(At, 0, 0); G8_STAGE(G8_SA(1, 1), rA, aoff[1], (t + 1) * 128);
            G8_WAIT_L(8); G8_BAR; G8_WAIT_L(0); G8_MMA(0, 0, At, B0); G8_BAR; G8_SCHED;
            G8_LDB(B1, 0, 1); G8_STAGE(G8_SB(0, 0), rB, boff, (t + 2) * 128);
            G8_BAR; G8_WAIT_L(0); G8_MMA(0, 1, At, B1); G8_BAR;
            G8_LDA(At, 0, 1); G8_STAGE(G8_SA(0, 0), rA, aoff[0], (t + 2) * 128);
            G8_BAR; G8_WAIT_L(0); G8_MMA(1, 0, At, B0); G8_BAR; G8_SCHED;
            G8_STAGE(G8_SB(0, 1), rB, boff, (t + 2) * 128 + bh);
            G8_WAIT_V(6); G8_BAR; G8_MMA(1, 1, At, B1); G8_BAR;
            G8_LDB(B0, 1, 0); G8_SCHED; G8_LDA(At, 1, 0); G8_STAGE(G8_SA(0, 1), rA, aoff[1], (t + 2) * 128);
            G8_WAIT_L(8); G8_BAR; G8_WAIT_L(0); G8_MMA(0, 0, At, B0); G8_BAR; G8_SCHED;
            G8_LDB(B1, 1, 1); G8_STAGE(G8_SB(1, 0), rB, boff, (t + 3) * 128);
            G8_BAR; G8_WAIT_L(0); G8_MMA(0, 1, At, B1); G8_BAR;
            G8_LDA(At, 1, 1); G8_STAGE(G8_SA(1, 0), rA, aoff[0], (t + 3) * 128);
            G8_BAR; G8_WAIT_L(0); G8_MMA(1, 0, At, B0); G8_BAR; G8_SCHED;
            G8_STAGE(G8_SB(1, 1), rB, boff, (t + 3) * 128 + bh);
            G8_WAIT_V(6); G8_BAR; G8_MMA(1, 1, At, B1); G8_BAR;
        }
        { G8_LDB(B0, 0, 0); G8_WAIT_V(0); G8_LDA(At, 0, 0); G8_STAGE(G8_SA(1, 1), rA, aoff[1], (nt - 1) * 128);
          G8_BAR; G8_WAIT_L(0); G8_MMA(0, 0, At, B0); G8_BAR;
          G8_LDB(B1, 0, 1); G8_BAR; G8_WAIT_L(0); G8_MMA(0, 1, At, B1); G8_BAR;
          G8_LDA(At, 0, 1); G8_WAIT_V(4); G8_BAR; G8_WAIT_L(0); G8_MMA(1, 0, At, B0); G8_MMA(1, 1, At, B1); G8_BAR; }
        { G8_LDB(B0, 1, 0); G8_LDA(At, 1, 0); G8_WAIT_V(2); G8_BAR; G8_WAIT_L(0); G8_MMA(0, 0, At, B0); G8_BAR;
          G8_LDB(B1, 1, 1); G8_WAIT_V(0); G8_BAR; G8_WAIT_L(0); G8_MMA(0, 1, At, B1); G8_BAR;
          G8_LDA(At, 1, 1); G8_BAR; G8_WAIT_L(0); G8_MMA(1, 0, At, B0); G8_MMA(1, 1, At, B1); G8_BAR; }
        if (wr == 0) G8_BAR;
        tid = otid(); wid = tid >> 6; lane = tid & 63; wr = wid >> 2; wc = wid & 3; fr = lane & 15; fq = lane >> 4;
        if (has_next) { G8_PREP(nxt, (it + 1) % 3); G8_PRO1(); }
        {
            const int* sr = sRowG + (it % 3) * 256;
#pragma unroll
            for (int ai = 0; ai < 2; ++ai)
#pragma unroll
                for (int bj = 0; bj < 2; ++bj) epi(cm0, cu0, acc[ai][bj], ai * 128 + wr * 64, cn0 + bj * 128 + wc * 32, fr, fq, sr);
        }
        if (!has_next) break;
        cm0 = nxt.m0; cn0 = nxt.n0; cu0 = nxt.u0;
    }
#undef G8_PREP
#undef G8_PRO1
}

struct XcdSeq {
    int q, qend, step;
    __device__ __forceinline__ XcdSeq(int total, int bid, int nb) {
        if ((nb & 7) == 0) { const int chunk = (total + 7) >> 3, x = bid & 7; q = x * chunk + (bid >> 3); const int e = (x + 1) * chunk; qend = e < total ? e : total; step = nb >> 3; }
        else { q = bid; qend = total; step = nb; }
    }
};

template <class Epi>
__device__ __forceinline__ void gemm256_phase(const bf16_t* A, long lda, int M, const bf16_t* Bt, long ldb, int N, int K, char* smem, int bid, int nb, Epi&& epi) {
    const int ntn = N / 256, ntm = M / 256, nt = ntn * ntm;
    XcdSeq s(nt, bid, nb);
    gemm256_stream<false, 0>(
        [&](int i, G8Desc& d) -> bool {
            const int Q = s.q + i * s.step; if (Q >= s.qend) return false;
            const int pnl = Q / (4 * ntn), r = Q - pnl * 4 * ntn;
            d.A = A; d.Bt = Bt; d.list = nullptr; d.m0 = (pnl * 4 + (r & 3)) * 256; d.n0 = (r >> 2) * 256; d.count = 0; d.u0 = 0; d.ldb = (int)ldb;
            return true; },
        (int)lda, K, smem,
        [&](int m0, int, f32x4 (&acc)[4][2], int rt0, int c0, int fr, int fq, const int*) { epi(acc, m0 + rt0, c0, fr, fq); });
}


__device__ __forceinline__ int colmap(int kind, int n, int nsrc) {
    if (kind == 0) return n < nsrc ? n : -1;
    if (kind == 1) { if (n < 512) return n; if (n < 1024) return n + 512; if (n < 1536) return n + 528; if (n < 1552) return n; if (n < 1792) return -1; return n - 1280; }
    if (kind == 2) { if (n < 1024) return n; if (n < 1280) return n + 512; if (n < 4352) return n + 580; if (n < 4420) return n - 2560; if (n < 4608) return -1; if (n < 5120) return n - 3584; return n - 188; }
    { const int grp = n >> 5, w = n & 31; return ((w >> 2) & 1) * 1024 + grp * 16 + 4 * (w >> 3) + (w & 3); }
}
struct ConvTile { const float* src; bf16_t* dst; int sld, sc, K, n0, k0; };
__device__ __forceinline__ ConvTile conv_decode(PRef p, int t, int n4) {
    constexpr int S0 = 128 * 32 * 4, S1 = S0 + 128 * 16 * 4, S2 = S1 + 2 * 36 * 4, S3 = S2 + 2 * 104 * 4, S4 = S3 + 2 * 16 * 4, S5 = S4 + 2 * 16 * 4, S6 = S5 + 2 * 8 * 2;
    char* ws = p.ws;
    ConvTile c; int nsrc, kind, NT, loc;
    if (t < S0) { loc = t; const int mat = loc / (32 * 4); loc -= mat * 32 * 4; c.src = p.moe_w1 + (size_t)mat * 1024 * 2048; c.dst = (bf16_t*)(ws + OFF_WT_W1) + (size_t)mat * 2048 * 1024; c.sld = 2048; nsrc = 2048; kind = 3; c.K = 1024; NT = 32; }
    else if (t < S1) { loc = t - S0; const int mat = loc / 64; loc -= mat * 64; c.src = p.moe_w2 + (size_t)mat * 1024 * 1024; c.dst = (bf16_t*)(ws + OFF_WT_W2) + (size_t)mat * 1024 * 1024; c.sld = 1024; nsrc = 1024; kind = 0; c.K = 1024; NT = 16; }
    else if (t < S2) { loc = t - S1; const int mat = loc / (36 * 4); loc -= mat * 36 * 4; c.src = p.ev_w_in + (size_t)mat * 1024 * 2064; c.dst = (bf16_t*)(ws + OFF_WT_EVIN) + (size_t)mat * EV_N * 1024; c.sld = 2064; nsrc = 2064; kind = 1; c.K = 1024; NT = 36; }
    else if (t < S3) { loc = t - S2; const int mat = loc / (104 * 4); loc -= mat * 104 * 4; c.src = p.od_w_in + (size_t)mat * 1024 * 6468; c.dst = (bf16_t*)(ws + OFF_WT_ODIN) + (size_t)mat * OD_N * 1024; c.sld = 6468; nsrc = 6468; kind = 2; c.K = 1024; NT = 104; }
    else if (t < S4) { loc = t - S3; const int mat = loc / 64; loc -= mat * 64; c.src = p.ev_w_out + (size_t)mat * 1024 * 1024; c.dst = (bf16_t*)(ws + OFF_WT_EVOUT) + (size_t)mat * 1024 * 1024; c.sld = 1024; nsrc = 1024; kind = 0; c.K = 1024; NT = 16; }
    else if (t < S5) { loc = t - S4; const int mat = loc / 64; loc -= mat * 64; c.src = p.od_w_out + (size_t)mat * 1024 * 1024; c.dst = (bf16_t*)(ws + OFF_WT_ODOUT) + (size_t)mat * 1024 * 1024; c.sld = 1024; nsrc = 1024; kind = 0; c.K = 1024; NT = 16; }
    else if (t < S6) { loc = t - S5; const int mat = loc / 16; loc -= mat * 16; c.src = p.s5_w_glu + (size_t)mat * 512 * 512; c.dst = (bf16_t*)(ws + OFF_WT_GLU) + (size_t)mat * 512 * 512; c.sld = 512; nsrc = 512; kind = 0; c.K = 512; NT = 8; }
    else { loc = t - S6; const int mat = loc / 8; loc -= mat * 8; c.src = p.router_w + (size_t)mat * 1024 * 32; c.dst = (bf16_t*)(ws + OFF_WT_RT) + (size_t)mat * 128 * 1024; c.sld = 32; nsrc = 32; kind = 0; c.K = 1024; NT = 2; }
    const int kt = loc / NT, nt = loc - kt * NT;
    c.n0 = nt * 64; c.k0 = kt * 256;
    c.sc = colmap(kind, c.n0 + n4 * 4, nsrc);
    return c;
}
__device__ __forceinline__ void conv_load(const ConvTile& c, int kp, f32x4 (&v)[8]) {
#pragma unroll
    for (int i = 0; i < 4; ++i)
#pragma unroll
        for (int e = 0; e < 2; ++e) {
            const int k = c.k0 + 2 * (kp + 32 * i) + e;
            v[2 * i + e] = c.sc >= 0 ? *(const f32x4*)(c.src + (size_t)k * c.sld + c.sc) : (f32x4){0.f, 0.f, 0.f, 0.f};
        }
}

__device__ __forceinline__ void conv_phase(PRef p, char* smem, int bid, int nb) {
    char* ws = p.ws;
    constexpr int NTILES = 128 * 32 * 4 + 128 * 16 * 4 + 2 * 36 * 4 + 2 * 104 * 4 + 2 * 16 * 4 + 2 * 16 * 4 + 2 * 8 * 2 + 4 * 2 * 4;
    bf16_t* tile = (bf16_t*)smem;
    const int tid = otid(), n4 = tid & 15, kp = tid >> 4;
    if (bid < NTILES) {
        ConvTile cur = conv_decode(p, bid, n4);
        f32x4 v[8];
        conv_load(cur, kp, v);
        for (int t = bid; t < NTILES; t += nb) {
            const bool more = t + nb < NTILES;
            ConvTile nxt = cur; f32x4 w[8];
            if (more) { nxt = conv_decode(p, t + nb, n4); conv_load(nxt, kp, w); }
#pragma unroll
            for (int i = 0; i < 4; ++i)
#pragma unroll
                for (int j = 0; j < 4; ++j)
                    *(unsigned*)(tile + (n4 * 4 + j) * 258 + 2 * (kp + 32 * i)) = pk2(v[2 * i][j], v[2 * i + 1][j]);
            __syncthreads();
#pragma unroll
            for (int i = 0; i < 4; ++i) {
                const int c = tid + 512 * i, n = c >> 5, kc = c & 31;
                const unsigned* tp = (const unsigned*)(tile + n * 258 + kc * 8);
                u32x4 o; o.x = tp[0]; o.y = tp[1]; o.z = tp[2]; o.w = tp[3];
                *(u32x4*)(cur.dst + (size_t)(cur.n0 + n) * cur.K + cur.k0 + kc * 8) = o;
            }
            __syncthreads();
            if (more) {
                cur = nxt;
#pragma unroll
                for (int i = 0; i < 8; ++i) v[i] = w[i];
            }
        }
    }
    {
        const float* x = p.x; bf16_t* xb = (bf16_t*)(ws + OFF_XB);
        const long nch = (long)T_ * 1024 / 8;
        for (long c = (long)bid * NTHR + otid(); c < nch; c += (long)nb * NTHR) {
            const f32x4 a = *(const f32x4*)(x + c * 8), b = *(const f32x4*)(x + c * 8 + 4);
            u32x4 w; w.x = pk2(a[0], a[1]); w.y = pk2(a[2], a[3]); w.z = pk2(b[0], b[1]); w.w = pk2(b[2], b[3]);
            *(u32x4*)(xb + c * 8) = w;
        }
    }
    if (bid == 0 && otid() < 128) ((int*)(ws + OFF_CNT))[otid()] = 0;
}

__device__ __forceinline__ void s5mat_unit(PRef p, int j, int g, char* smem) {
    float* cre = (float*)smem;
    float* cim = cre + 1024;
    float* bbr = cim + 1024;
    float* bbi = bbr + 1024;
    float* pwr = bbi + 1024;
    float* pwi = pwr + 65 * 64;
    float* zr = pwi + 65 * 64;
    float* zi = zr + 64;
    float* Kd = zi + 64;
    const int tid = otid();
    const int jg = j * 32 + g;
    if (tid < 64) {
        const int pp = tid;
        const float lre = fminf(p.s5_a_re[jg * 64 + pp], -1e-4f), lim = p.s5_a_im[jg * 64 + pp];
        const float dt = expf(p.s5_log_dt[jg]);
        const float xr = lre * dt, th = lim * dt;
        const float mag = expf(xr);
        const float ar = mag * cosf(th), ai = mag * sinf(th);
        const float inv = 1.f / (lre * lre + lim * lim);
        zr[pp] = ((ar - 1.f) * lre + ai * lim) * inv;
        zi[pp] = (ai * lre - (ar - 1.f) * lim) * inv;
        const double thd = (double)th;
        for (int d = 0; d <= 64; ++d) {
            const float mg = expf((float)d * xr);
            double ang = (double)d * thd;
            const double kk = rint(ang * 0.15915494309189535);
            ang -= kk * 6.283185307179586;
            const float a = (float)ang;
            pwr[d * 64 + pp] = mg * cosf(a);
            pwi[d * 64 + pp] = mg * sinf(a);
        }
    }
    for (int e = tid; e < 1024; e += NTHR) {
        cre[e] = p.s5_c_re[(size_t)jg * 1024 + e];
        cim[e] = p.s5_c_im[(size_t)jg * 1024 + e];
    }
    __syncthreads();
    for (int e = tid; e < 1024; e += NTHR) {
        const int pp = e >> 4;
        const float br = p.s5_b_re[(size_t)jg * 1024 + e], bi = p.s5_b_im[(size_t)jg * 1024 + e];
        bbr[e] = zr[pp] * br - zi[pp] * bi;
        bbi[e] = zr[pp] * bi + zi[pp] * br;
    }
    __syncthreads();
    for (int e = tid; e < 64 * 256; e += NTHR) {
        const int d = e >> 8, n = (e >> 4) & 15, m = e & 15;
        float s = 0.f;
        for (int pp = 0; pp < 64; ++pp) {
            const float cr = cre[n * 64 + pp], ci = cim[n * 64 + pp], qr = pwr[d * 64 + pp], qi = pwi[d * 64 + pp];
            const float wr_ = cr * qr - ci * qi, wi_ = cr * qi + ci * qr;
            s += wr_ * bbr[pp * 16 + m] - wi_ * bbi[pp * 16 + m];
        }
        Kd[e] = s;
    }
    __syncthreads();
    bf16_t* TH = (bf16_t*)(p.ws + OFF_TH) + (size_t)jg * 1024 * UHW;
    for (int c = tid; c < 1024 * 144; c += NTHR) {
        const int row = c / 144, ch = c - row * 144;
        const int tau = row >> 4, n = row & 15;
        float v[8];
        if (ch < 128) {
            const int s = ch >> 1, m0 = (ch & 1) * 8;
            if (s <= tau) {
#pragma unroll
                for (int i = 0; i < 8; ++i) v[i] = Kd[(tau - s) * 256 + n * 16 + m0 + i];
            } else {
#pragma unroll
                for (int i = 0; i < 8; ++i) v[i] = 0.f;
            }
        } else {
            const int p0 = (ch - 128) * 4;
#pragma unroll
            for (int i = 0; i < 4; ++i) {
                const int pp = p0 + i;
                const float cr = cre[n * 64 + pp], ci = cim[n * 64 + pp], qr = pwr[(tau + 1) * 64 + pp], qi = pwi[(tau + 1) * 64 + pp];
                v[2 * i] = cr * qr - ci * qi;
                v[2 * i + 1] = -(cr * qi + ci * qr);
            }
        }
        u32x4 w; w.x = pk2(v[0], v[1]); w.y = pk2(v[2], v[3]); w.z = pk2(v[4], v[5]); w.w = pk2(v[6], v[7]);
        *(u32x4*)(TH + (size_t)row * UHW + ch * 8) = w;
    }
    bf16_t* GM = (bf16_t*)(p.ws + OFF_GM) + (size_t)jg * 128 * 1024;
    for (int c = tid; c < 128 * 128; c += NTHR) {
        const int row = c >> 7, ch = c & 127;
        const int pp = row >> 1, ri = row & 1;
        const int s = ch >> 1, m0 = (ch & 1) * 8;
        const float qr = pwr[(63 - s) * 64 + pp], qi = pwi[(63 - s) * 64 + pp];
        float v[8];
#pragma unroll
        for (int i = 0; i < 8; ++i) {
            const float br = bbr[pp * 16 + m0 + i], bi = bbi[pp * 16 + m0 + i];
            v[i] = ri == 0 ? (qr * br - qi * bi) : (qr * bi + qi * br);
        }
        u32x4 w; w.x = pk2(v[0], v[1]); w.y = pk2(v[2], v[3]); w.z = pk2(v[4], v[5]); w.w = pk2(v[6], v[7]);
        *(u32x4*)(GM + (size_t)row * 1024 + ch * 8) = w;
    }
    if (tid < 64) {
        float* A64 = (float*)(p.ws + OFF_A64) + (size_t)jg * 128;
        A64[tid * 2] = pwr[64 * 64 + tid];
        A64[tid * 2 + 1] = pwi[64 * 64 + tid];
    }
    __syncthreads();
}

__device__ __forceinline__ void epi_ev_in(PRef p, f32x4 (&acc)[4][2], int row0, int c0, int fr, int fq) {
    char* ws = p.ws;
    bf16_t* PE = (bf16_t*)(ws + OFF_PE); bf16_t* UH = (bf16_t*)(ws + OFF_UH); float* GLR = (float*)(ws + OFF_GLR);
    const int col = c0 + 8 * fq;
#pragma unroll
    for (int m = 0; m < 4; ++m) {
        const int t = row0 + m * 16 + fr;
        u32x4 w; w.x = pk2(acc[m][0][0], acc[m][0][1]); w.y = pk2(acc[m][0][2], acc[m][0][3]); w.z = pk2(acc[m][1][0], acc[m][1][1]); w.w = pk2(acc[m][1][2], acc[m][1][3]);
        if (c0 < 1024) {
            *(u32x4*)(PE + (size_t)t * PE_W + col) = w;
        } else if (c0 < 1536) {
            const int ch = col - 1024, g = ch >> 4, mm = ch & 15;
            *(u32x4*)(UH + ((size_t)(t >> 6) * 32 + g) * UHW + (t & 63) * 16 + mm) = w;
        } else if (col < 1552) {
            *(f32x4*)(GLR + (size_t)t * 16 + (col - 1536)) = acc[m][0];
            *(f32x4*)(GLR + (size_t)t * 16 + (col - 1536) + 4) = acc[m][1];
        }
    }
}
__device__ __forceinline__ void epi_vt(bf16_t* __restrict__ img_row0, f32x4 (&acc)[4][2], int rt0, int c0, int fr, int fq) {
#pragma unroll
    for (int m = 0; m < 4; ++m) {
        u32x4 w; w.x = pk2(acc[m][0][0], acc[m][0][1]); w.y = pk2(acc[m][0][2], acc[m][0][3]); w.z = pk2(acc[m][1][0], acc[m][1][1]); w.w = pk2(acc[m][1][2], acc[m][1][3]);
        *(u32x4*)(img_row0 + (size_t)(rt0 + m * 16 + fr) * L_ + c0 + 8 * fq) = w;
    }
}

__device__ __forceinline__ void gla_decay(PRef p, int j, int t0, int h, float* sB) {
    const float* GLR = (const float*)(p.ws + OFF_GLR);
    const float* w2 = p.gla_w_gate2 + (size_t)j * 16 * 256;
    const float* b2 = p.gla_b_gate2 + (size_t)j * 256;
    const int tid = otid();
    for (int e = tid; e < 4096; e += NTHR) {
        const int tau = e >> 6, d = e & 63;
        float a = b2[h * 64 + d];
#pragma unroll
        for (int r = 0; r < 16; ++r) a += GLR[(size_t)(t0 + tau) * 16 + r] * w2[r * 256 + h * 64 + d];
        const float ls = fminf(a, 0.f) - __logf(1.f + __expf(-fabsf(a)));
        sB[tau * 65 + d] = ls * (1.f / 16.f);
    }
    __syncthreads();
    if (tid < 64) { float run = 0.f; for (int tau = 0; tau < 64; ++tau) { run += sB[tau * 65 + tid]; sB[tau * 65 + tid] = run; } }
    __syncthreads();
}

__device__ __forceinline__ void gla_a_item(PRef p, int j, int item, char* smem) {
    const int h = item & 3, c = (item >> 2) & 255, b = item >> 10;
    const int t0 = b * L_ + c * 64;
    float* sB = (float*)smem;
    bf16_t* AK = (bf16_t*)(smem + 16640);
    const bf16_t* PE = (const bf16_t*)(p.ws + OFF_PE);
    const bf16_t* VTE = (const bf16_t*)(p.ws + OFF_VTE);
    const int tid = otid(), lane = tid & 63, wave = tid >> 6, fr = lane & 15, fq = lane >> 4;
    gla_decay(p, j, t0, h, sB);
    for (int e = tid; e < 4096; e += NTHR) {
        const int tau = e >> 6, d = e & 63;
        const float k = bf2f(PE[(size_t)(t0 + tau) * PE_W + 256 + h * 64 + d]);
        AK[d * 72 + tau] = f2bf(k * __expf(sB[63 * 65 + d] - sB[tau * 65 + d]));
    }
    __syncthreads();
    const int dblk = wave >> 1, vb = (wave & 1) * 64;
    f32x4 acc[4];
#pragma unroll
    for (int n = 0; n < 4; ++n) acc[n] = (f32x4){0.f, 0.f, 0.f, 0.f};
#pragma unroll
    for (int ks = 0; ks < 2; ++ks) {
        const bf16x8 af = *(const bf16x8*)(AK + (dblk * 16 + fr) * 72 + ks * 32 + fq * 8);
#pragma unroll
        for (int n = 0; n < 4; ++n) {
            const int v = vb + n * 16 + fr;
            const bf16x8 bfr = *(const bf16x8*)(VTE + ((size_t)((b * 4 + h) * 128 + v)) * L_ + (c * 64 + ks * 32 + fq * 8));
            acc[n] = __builtin_amdgcn_mfma_f32_16x16x32_bf16(af, bfr, acc[n], 0, 0, 0);
        }
    }
    float* KV = (float*)(p.ws + OFF_KV) + ((size_t)((b * 256 + c) * 4 + h)) * 64 * 128;
#pragma unroll
    for (int n = 0; n < 4; ++n)
#pragma unroll
        for (int r = 0; r < 4; ++r) KV[(dblk * 16 + fq * 4 + r) * 128 + vb + n * 16 + fr] = acc[n][r];
    if (tid < 64) ((float*)(p.ws + OFF_DEC))[((size_t)((b * 256 + c) * 4 + h)) * 64 + tid] = __expf(sB[63 * 65 + tid]);
    __syncthreads();
}

__device__ __forceinline__ void scan_phase(PRef p, int j, int bid) {
    const int gid = bid * NTHR + otid();
    if (gid < 65536) {
        const int v = gid & 127, d = (gid >> 7) & 63, h = (gid >> 13) & 3, b = gid >> 15;
        const float* KV = (const float*)(p.ws + OFF_KV); float* SST = (float*)(p.ws + OFF_SST); const float* DEC = (const float*)(p.ws + OFF_DEC);
        float S = 0.f;
        for (int c0 = 0; c0 < 256; c0 += 8) {
            float kv[8], dc[8];
#pragma unroll
            for (int i = 0; i < 8; ++i) {
                const size_t blk = (size_t)((b * 256 + c0 + i) * 4 + h);
                kv[i] = KV[(blk * 64 + d) * 128 + v]; dc[i] = DEC[blk * 64 + d];
            }
#pragma unroll
            for (int i = 0; i < 8; ++i) {
                const size_t blk = (size_t)((b * 256 + c0 + i) * 4 + h);
                SST[(blk * 64 + d) * 128 + v] = S;
                S = dc[i] * S + kv[i];
            }
        }
    } else if (gid < 65536 + 4096) {
        const int e = gid - 65536, pp = e & 63, g = (e >> 6) & 31, b = e >> 11;
        const float* A64 = (const float*)(p.ws + OFF_A64) + (size_t)(j * 32 + g) * 128;
        const float ar = A64[pp * 2], ai = A64[pp * 2 + 1];
        const float* GB = (const float*)(p.ws + OFF_GBUF); bf16_t* UH = (bf16_t*)(p.ws + OFF_UH);
        float hr = 0.f, hi = 0.f;
        for (int c0 = 0; c0 < 256; c0 += 8) {
            float gr[8], gi[8];
#pragma unroll
            for (int i = 0; i < 8; ++i) { const size_t row = (size_t)(b * 256 + c0 + i) * 32 + g; gr[i] = GB[row * 128 + 2 * pp]; gi[i] = GB[row * 128 + 2 * pp + 1]; }
#pragma unroll
            for (int i = 0; i < 8; ++i) {
                const size_t row = (size_t)(b * 256 + c0 + i) * 32 + g;
                *(unsigned*)(UH + row * UHW + 1024 + 2 * pp) = pk2(hr, hi);
                const float nr = ar * hr - ai * hi + gr[i], ni = ar * hi + ai * hr + gi[i];
                hr = nr; hi = ni;
            }
        }
    }
}

__device__ __forceinline__ void gla_c_item(PRef p, int j, int item, char* smem) {
    const int h = item & 3, c = (item >> 2) & 255, b = item >> 10;
    const int t0 = b * L_ + c * 64;
    float* sB = (float*)smem;
    bf16_t* QT = (bf16_t*)(smem + 16640);
    bf16_t* KT = (bf16_t*)(smem + 16640 + 9216);
    bf16_t* ATT = (bf16_t*)(smem + 16640 + 18432);
    float* OS = (float*)(smem + 16640 + 27648);
    const bf16_t* PE = (const bf16_t*)(p.ws + OFF_PE);
    const bf16_t* VTE = (const bf16_t*)(p.ws + OFF_VTE);
    const int tid = otid(), lane = tid & 63, wave = tid >> 6, fr = lane & 15, fq = lane >> 4;
    gla_decay(p, j, t0, h, sB);
    for (int e = tid; e < 4096; e += NTHR) {
        const int tau = e >> 6, d = e & 63;
        const float bb = sB[tau * 65 + d];
        const float q = bf2f(PE[(size_t)(t0 + tau) * PE_W + h * 64 + d]);
        const float k = bf2f(PE[(size_t)(t0 + tau) * PE_W + 256 + h * 64 + d]);
        QT[tau * 72 + d] = f2bf(q * 0.125f * __expf(bb));
        KT[tau * 72 + d] = f2bf(k * __expf(-bb));
    }
    __syncthreads();
    const int iblk = wave >> 1;
    {
        f32x4 acc[2];
        acc[0] = (f32x4){0.f, 0.f, 0.f, 0.f}; acc[1] = acc[0];
#pragma unroll
        for (int ks = 0; ks < 2; ++ks) {
            const bf16x8 af = *(const bf16x8*)(QT + (iblk * 16 + fr) * 72 + ks * 32 + fq * 8);
#pragma unroll
            for (int n = 0; n < 2; ++n) {
                const int jb = (wave & 1) * 2 + n;
                const bf16x8 bfr = *(const bf16x8*)(KT + (jb * 16 + fr) * 72 + ks * 32 + fq * 8);
                acc[n] = __builtin_amdgcn_mfma_f32_16x16x32_bf16(af, bfr, acc[n], 0, 0, 0);
            }
        }
#pragma unroll
        for (int n = 0; n < 2; ++n) {
            const int jj = ((wave & 1) * 2 + n) * 16 + fr;
#pragma unroll
            for (int r = 0; r < 4; ++r) { const int ii = iblk * 16 + fq * 4 + r; ATT[ii * 72 + jj] = f2bf(jj <= ii ? acc[n][r] : 0.f); }
        }
    }
    __syncthreads();
    {
        const int vb = (wave & 1) * 64;
        const float* SST = (const float*)(p.ws + OFF_SST) + ((size_t)((b * 256 + c) * 4 + h)) * 64 * 128;
        f32x4 acc[4];
#pragma unroll
        for (int n = 0; n < 4; ++n) acc[n] = (f32x4){0.f, 0.f, 0.f, 0.f};
#pragma unroll
        for (int ks = 0; ks < 2; ++ks) {
            const bf16x8 af = *(const bf16x8*)(ATT + (iblk * 16 + fr) * 72 + ks * 32 + fq * 8);
            const bf16x8 aq = *(const bf16x8*)(QT + (iblk * 16 + fr) * 72 + ks * 32 + fq * 8);
#pragma unroll
            for (int n = 0; n < 4; ++n) {
                const int v = vb + n * 16 + fr;
                const bf16x8 bv = *(const bf16x8*)(VTE + ((size_t)((b * 4 + h) * 128 + v)) * L_ + (c * 64 + ks * 32 + fq * 8));
                acc[n] = __builtin_amdgcn_mfma_f32_16x16x32_bf16(af, bv, acc[n], 0, 0, 0);
                bf16x8 bs;
#pragma unroll
                for (int i = 0; i < 8; ++i) bs[i] = (short)f2bf(SST[(ks * 32 + fq * 8 + i) * 128 + v]);
                acc[n] = __builtin_amdgcn_mfma_f32_16x16x32_bf16(aq, bs, acc[n], 0, 0, 0);
            }
        }
#pragma unroll
        for (int n = 0; n < 4; ++n)
#pragma unroll
            for (int r = 0; r < 4; ++r) OS[(iblk * 16 + fq * 4 + r) * 132 + vb + n * 16 + fr] = acc[n][r];
    }
    __syncthreads();
    {
        const int i = tid >> 3, seg = tid & 7;
        float o[16]; float ss = 0.f;
#pragma unroll
        for (int q = 0; q < 16; ++q) { o[q] = OS[i * 132 + seg * 16 + q]; ss += o[q] * o[q]; }
        ss += __shfl_xor(ss, 1, 64); ss += __shfl_xor(ss, 2, 64); ss += __shfl_xor(ss, 4, 64);
        const float rs = rsqrtf(ss * (1.f / 128.f) + LN_EPS);
        const float* ng = p.gla_norm_g + (size_t)j * 128;
        bf16_t* CC = (bf16_t*)(p.ws + OFF_CC);
        const size_t t = (size_t)(t0 + i);
        unsigned w[8];
#pragma unroll
        for (int q = 0; q < 16; q += 2) {
            const int v0 = seg * 16 + q;
            const float r0 = bf2f(PE[t * PE_W + 512 + h * 128 + v0]), r1 = bf2f(PE[t * PE_W + 512 + h * 128 + v0 + 1]);
            const float a0 = o[q] * rs * ng[v0] * (r0 * sigmoidf_(r0)), a1 = o[q + 1] * rs * ng[v0 + 1] * (r1 * sigmoidf_(r1));
            w[q >> 1] = pk2(a0, a1);
        }
        u32x4 w0, w1; w0.x = w[0]; w0.y = w[1]; w0.z = w[2]; w0.w = w[3]; w1.x = w[4]; w1.y = w[5]; w1.z = w[6]; w1.w = w[7];
        *(u32x4*)(CC + t * 1024 + h * 128 + seg * 16) = w0;
        *(u32x4*)(CC + t * 1024 + h * 128 + seg * 16 + 8) = w1;
    }
    __syncthreads();
}

__device__ __forceinline__ void s5_g_phase(PRef p, int j, char* smem, int bid, int nb) {
    const bf16_t* UH = (const bf16_t*)(p.ws + OFF_UH);
    float* GB = (float*)(p.ws + OFF_GBUF);
    for (int t = bid; t < 64; t += nb) {
        const int g = t >> 1, mi = t & 1;
        const bf16_t* Bt = (const bf16_t*)(p.ws + OFF_GM) + (size_t)(j * 32 + g) * 128 * 1024;
        gemm_tile<false>(UH + (size_t)g * UHW, (long)32 * UHW, 0, mi * 256, Bt, 1024, 0, 1024, smem,
            [&](f32x4 (&acc)[4][2], int rt0, int c0, int fr, int fq) {
#pragma unroll
                for (int m = 0; m < 4; ++m)
#pragma unroll
                    for (int n = 0; n < 2; ++n)
#pragma unroll
                        for (int r = 0; r < 4; ++r) {
                            const int row = mi * 256 + rt0 + m * 16 + fq * 4 + r;
                            GB[((size_t)row * 32 + g) * 128 + c0 + n * 16 + fr] = acc[m][n][r];
                        }
            });
    }
}
__device__ __forceinline__ void s5_y_phase(PRef p, int j, char* smem, int bid, int nb) {
    const bf16_t* UH = (const bf16_t*)(p.ws + OFF_UH);
    bf16_t* YA = (bf16_t*)(p.ws + OFF_YA);
    const float* dsk = p.s5_d + (size_t)j * 512;
    XcdSeq sq(32 * 2 * 4, bid, nb);
    for (int t = sq.q; t < sq.qend; t += sq.step) {
        const int g = t >> 3, mi = (t >> 2) & 1, ni = t & 3;
        const bf16_t* Bt = (const bf16_t*)(p.ws + OFF_TH) + (size_t)(j * 32 + g) * 1024 * UHW;
        gemm256_tile<false>(UH + (size_t)g * UHW, (long)32 * UHW, 0, mi * 256, Bt, UHW, ni * 256, UHW, smem,
            [&](f32x4 (&acc)[4][2], int rt0, int c0, int fr, int fq) {
                const int col = c0 + 8 * fq;
                const int tau = col >> 4, nn = col & 15, ch = g * 16 + nn;
                const f32x4 d0 = *(const f32x4*)(dsk + ch), d1 = *(const f32x4*)(dsk + ch + 4);
#pragma unroll
                for (int m = 0; m < 4; ++m) {
                    const int row = mi * 256 + rt0 + m * 16 + fr;
                    const u32x4 uw = *(const u32x4*)(UH + ((size_t)row * 32 + g) * UHW + col);
                    float y[8];
#pragma unroll
                    for (int q = 0; q < 4; ++q) {
                        const unsigned u2 = q == 0 ? uw.x : q == 1 ? uw.y : q == 2 ? uw.z : uw.w;
                        const float u0 = __uint_as_float(u2 << 16), u1 = __uint_as_float(u2 & 0xffff0000u);
                        const float a0 = q < 2 ? acc[m][0][2 * q] : acc[m][1][2 * q - 4], a1 = q < 2 ? acc[m][0][2 * q + 1] : acc[m][1][2 * q - 3];
                        const float dd0 = q < 2 ? d0[2 * q] : d1[2 * q - 4], dd1 = q < 2 ? d0[2 * q + 1] : d1[2 * q - 3];
                        y[2 * q] = gelu_tanh(a0 + dd0 * u0); y[2 * q + 1] = gelu_tanh(a1 + dd1 * u1);
                    }
                    u32x4 w; w.x = pk2(y[0], y[1]); w.y = pk2(y[2], y[3]); w.z = pk2(y[4], y[5]); w.w = pk2(y[6], y[7]);
                    *(u32x4*)(YA + ((size_t)row * 64 + tau) * 512 + ch) = w;
                }
            });
    }
}

template <bool SLOTS, bool NOEPI = false>
__device__ __forceinline__ void ln_phase(PRef p, const float* xin, const float* addb, const float* g, const float* bta, float* xout, bf16_t* xb, int bid, int nb) {
    const int lane = otid() & 63, wave = otid() >> 6;
    for (int t = bid * 8 + wave; t < T_; t += nb * 8) {
        f32x4 v[4];
        float s = 0.f;
#pragma unroll
        for (int i = 0; i < 4; ++i) {
            const int c = i * 256 + lane * 4;
            f32x4 a = *(const f32x4*)(xin + (size_t)t * 1024 + c);
            f32x4 m;
            if (SLOTS) {
                const bf16_t* sl = (const bf16_t*)addb;
                m = (f32x4){0.f, 0.f, 0.f, 0.f};
#pragma unroll
                for (int k = 0; k < 4; ++k) {
                    const u32x2 w = *(const u32x2*)(sl + ((size_t)t * 4 + k) * 1024 + c);
                    m[0] += __uint_as_float(w.x << 16); m[1] += __uint_as_float(w.x & 0xffff0000u); m[2] += __uint_as_float(w.y << 16); m[3] += __uint_as_float(w.y & 0xffff0000u);
                }
            } else m = *(const f32x4*)(addb + (size_t)t * 1024 + c);
            v[i] = a * ALPHA + m;
            s += v[i][0] + v[i][1] + v[i][2] + v[i][3];
        }
        const float mu = wave_sum(s) * (1.f / 1024.f);
        float q = 0.f;
#pragma unroll
        for (int i = 0; i < 4; ++i) { v[i] -= mu; q += v[i][0] * v[i][0] + v[i][1] * v[i][1] + v[i][2] * v[i][2] + v[i][3] * v[i][3]; }
        const float rs = rsqrtf(wave_sum(q) * (1.f / 1024.f) + LN_EPS);
#pragma unroll
        for (int i = 0; i < 4; ++i) {
            const int c = i * 256 + lane * 4;
            const f32x4 gg = *(const f32x4*)(g + c), bb = *(const f32x4*)(bta + c);
            const f32x4 o = v[i] * rs * gg + bb;
            if (!NOEPI) *(f32x4*)(xout + (size_t)t * 1024 + c) = o;
            if (xb && !NOEPI) { u32x2 w; w.x = pk2(o[0], o[1]); w.y = pk2(o[2], o[3]); *(u32x2*)(xb + (size_t)t * 1024 + c) = w; }
        }
    }
}

constexpr int RT_STRIDE = 36;
constexpr int RT_SCR_OFF = 1024 * RT_STRIDE * 4;
template <bool NOEPI = false>
__device__ __forceinline__ void ln1_router_phase(PRef p, int layer, const float* xin, char* smem, int bid, int nb) {
    float* wl = (float*)smem;
    const int tid = otid(), lane = tid & 63, wave = tid >> 6;
    float* lgs = (float*)(smem + RT_SCR_OFF + wave * 640);
    int* pick = (int*)(lgs + 32);
    float* pgate = (float*)(pick + 64);
    {
        const float* rw = p.router_w + (size_t)layer * 1024 * 32;
        for (int e = tid; e < 32768; e += NTHR) {
            const int k = e >> 5, ex = e & 31, rem = k & 255;
            wl[((k & ~255) + (rem & 3) * 64 + (rem >> 2)) * RT_STRIDE + ex] = rw[e];
        }
    }
    __syncthreads();
    const bf16_t* addb = (const bf16_t*)(p.ws + OFF_MIX);
    const float* g = p.ln1_g + (size_t)layer * 1024; const float* bta = p.ln1_b + (size_t)layer * 1024;
    float* xout = (float*)(p.ws + OFF_XR); bf16_t* xb = (bf16_t*)(p.ws + OFF_XB);
    int* cnt = (int*)(p.ws + OFF_CNT) + layer * 32;
    int* LIST = (int*)(p.ws + OFF_LIST);
    float* GATE = (float*)(p.ws + OFF_GATE);
    const float rbias = p.router_b[(size_t)layer * 32 + (lane >> 1)];
    const int rstep = nb * 8;
    f32x4 xa[4], xm[4];
    {
        const int t0 = bid * 8 + wave;
        if (t0 < T_) {
#pragma unroll
            for (int i = 0; i < 4; ++i) { const int c = i * 256 + lane * 4; xa[i] = *(const f32x4*)(xin + (size_t)t0 * 1024 + c); { const u32x2 mw = *(const u32x2*)(addb + (size_t)t0 * 1024 + c); xm[i] = (f32x4){__uint_as_float(mw.x << 16), __uint_as_float(mw.x & 0xffff0000u), __uint_as_float(mw.y << 16), __uint_as_float(mw.y & 0xffff0000u)}; } }
        }
    }
    for (int tb = bid * 8 + wave; tb < T_; tb += rstep * 16) {
        int nrow = 0;
#pragma unroll 1
        for (int t = tb; t < T_ && nrow < 16; t += rstep, ++nrow) {
            f32x4 v[4];
            float s = 0.f;
#pragma unroll
            for (int i = 0; i < 4; ++i) { v[i] = xa[i] * ALPHA + xm[i]; s += v[i][0] + v[i][1] + v[i][2] + v[i][3]; }
            if (t + rstep < T_) {
#pragma unroll
                for (int i = 0; i < 4; ++i) { const int c = i * 256 + lane * 4; xa[i] = *(const f32x4*)(xin + (size_t)(t + rstep) * 1024 + c); { const u32x2 mw = *(const u32x2*)(addb + (size_t)(t + rstep) * 1024 + c); xm[i] = (f32x4){__uint_as_float(mw.x << 16), __uint_as_float(mw.x & 0xffff0000u), __uint_as_float(mw.y << 16), __uint_as_float(mw.y & 0xffff0000u)}; } }
            }
            const float mu = wave_sum(s) * (1.f / 1024.f);
            float q = 0.f;
#pragma unroll
            for (int i = 0; i < 4; ++i) { v[i] -= mu; q += v[i][0] * v[i][0] + v[i][1] * v[i][1] + v[i][2] * v[i][2] + v[i][3] * v[i][3]; }
            const float rs = rsqrtf(wave_sum(q) * (1.f / 1024.f) + LN_EPS);
#pragma unroll
            for (int i = 0; i < 4; ++i) {
                const int c = i * 256 + lane * 4;
                const f32x4 gg = *(const f32x4*)(g + c), bb = *(const f32x4*)(bta + c);
                v[i] = v[i] * rs * gg + bb;
                if (!NOEPI) { *(f32x4*)(xout + (size_t)t * 1024 + c) = v[i];
                u32x2 w; w.x = pk2(v[i][0], v[i][1]); w.y = pk2(v[i][2], v[i][3]); *(u32x2*)(xb + (size_t)t * 1024 + c) = w; }
            }
            f32x4 acc[8];
#pragma unroll
            for (int e = 0; e < 8; ++e) acc[e] = (f32x4){0.f, 0.f, 0.f, 0.f};
#pragma unroll
            for (int i = 0; i < 4; ++i)
#pragma unroll
                for (int j = 0; j < 4; ++j) {
                    const f32x4* wr_ = (const f32x4*)(wl + (i * 256 + j * 64 + lane) * RT_STRIDE);
                    const float xv = v[i][j];
#pragma unroll
                    for (int e = 0; e < 8; ++e) acc[e] += wr_[e] * xv;
                }
            float k16[16], k8[8], k4[4], k2[2];
#pragma unroll
            for (int a = 0; a < 16; ++a) { auto r = __builtin_amdgcn_permlane32_swap(__float_as_uint(acc[a >> 2][a & 3]), __float_as_uint(acc[(a + 16) >> 2][a & 3]), false, false); k16[a] = __uint_as_float(r[0]) + __uint_as_float(r[1]); }
#pragma unroll
            for (int a = 0; a < 8; ++a) { auto r = __builtin_amdgcn_permlane16_swap(__float_as_uint(k16[a]), __float_as_uint(k16[a + 8]), false, false); k8[a] = __uint_as_float(r[0]) + __uint_as_float(r[1]); }
            { const bool hb = lane & 8;
#pragma unroll
              for (int a = 0; a < 4; ++a) { const float mine = hb ? k8[a + 4] : k8[a], send = hb ? k8[a] : k8[a + 4]; k4[a] = mine + dppf<DPP_ROR8>(send); } }
            { const bool hb = lane & 4;
#pragma unroll
              for (int a = 0; a < 2; ++a) { const float mine = hb ? k4[a + 2] : k4[a], send = hb ? k4[a] : k4[a + 2]; k2[a] = mine + dppf<DPP_HMIR>(send); } }
            float lg;
            { const bool hb = lane & 2; const float mine = hb ? k2[1] : k2[0], send = hb ? k2[0] : k2[1]; lg = mine + dppf<DPP_X2>(send); }
            lg += dppf<DPP_X1>(lg);
            lg += rbias;
            float cand = (lane & 1) ? -INFINITY : lg;
            float tv[4]; int te[4];
#pragma unroll
            for (int r = 0; r < 4; ++r) {
                const float mxv = wave_max(cand);
                const unsigned long long bal = __builtin_amdgcn_ballot_w64(cand == mxv);
                const int first = __builtin_ctzll(bal);
                tv[r] = mxv; te[r] = first >> 1;
                if (lane == first) cand = -INFINITY;
            }
            if (lane == 0) {
                const float e1 = __expf(tv[1] - tv[0]), e2 = __expf(tv[2] - tv[0]), e3 = __expf(tv[3] - tv[0]);
                const float inv = 1.f / (1.f + e1 + e2 + e3);
                pick[nrow * 4 + 0] = te[0]; pick[nrow * 4 + 1] = te[1]; pick[nrow * 4 + 2] = te[2]; pick[nrow * 4 + 3] = te[3];
                pgate[nrow * 4 + 0] = inv; pgate[nrow * 4 + 1] = e1 * inv; pgate[nrow * 4 + 2] = e2 * inv; pgate[nrow * 4 + 3] = e3 * inv;
            }
        }
        if ((lane >> 2) < nrow && (!NOEPI || pgate[lane] < -1.f)) {
            const int t = tb + (lane >> 2) * rstep, ex = pick[lane], pair = t * 4 + (lane & 3);
            const int pos = atomicAdd(&cnt[ex], 1);
            LIST[(size_t)ex * LISTCAP + pos] = pair;
            GATE[pair] = pgate[lane];
        }
    }
}

__device__ __forceinline__ void topk_phase(PRef p, int layer, int bid, int nb) {
    const float* LG = (const float*)(p.ws + OFF_LOGIT);
    int* cnt = (int*)(p.ws + OFF_CNT) + layer * 32;
    int* LIST = (int*)(p.ws + OFF_LIST);
    float* GATE = (float*)(p.ws + OFF_GATE);
    for (int t = bid * NTHR + otid(); t < T_; t += nb * NTHR) {
        float v0 = -INFINITY, v1 = -INFINITY, v2 = -INFINITY, v3 = -INFINITY; int i0 = 0, i1 = 0, i2 = 0, i3 = 0;
#pragma unroll
        for (int q = 0; q < 8; ++q) {
            const f32x4 l4 = *(const f32x4*)(LG + (size_t)t * 32 + q * 4);
#pragma unroll
            for (int r = 0; r < 4; ++r) {
                const float v = l4[r]; const int e = q * 4 + r;
                if (v > v0) { v3 = v2; i3 = i2; v2 = v1; i2 = i1; v1 = v0; i1 = i0; v0 = v; i0 = e; }
                else if (v > v1) { v3 = v2; i3 = i2; v2 = v1; i2 = i1; v1 = v; i1 = e; }
                else if (v > v2) { v3 = v2; i3 = i2; v2 = v; i2 = e; }
                else if (v > v3) { v3 = v; i3 = e; }
            }
        }
        const float e1 = __expf(v1 - v0), e2 = __expf(v2 - v0), e3 = __expf(v3 - v0);
        const float inv = 1.f / (1.f + e1 + e2 + e3);
        int pos;
        pos = atomicAdd(&cnt[i0], 1); LIST[(size_t)i0 * LISTCAP + pos] = t * 4 + 0; GATE[t * 4 + 0] = inv;
        pos = atomicAdd(&cnt[i1], 1); LIST[(size_t)i1 * LISTCAP + pos] = t * 4 + 1; GATE[t * 4 + 1] = e1 * inv;
        pos = atomicAdd(&cnt[i2], 1); LIST[(size_t)i2 * LISTCAP + pos] = t * 4 + 2; GATE[t * 4 + 2] = e2 * inv;
        pos = atomicAdd(&cnt[i3], 1); LIST[(size_t)i3 * LISTCAP + pos] = t * 4 + 3; GATE[t * 4 + 3] = e3 * inv;
    }
}

template <int WHICH, bool NOEPI = false>
__device__ __forceinline__ void moe_gemm_phase(PRef p, int layer, char* smem, int bid, int nb) {
    const int* cnt = (const int*)(p.ws + OFF_CNT) + layer * 32;
    const int* LIST = (const int*)(p.ws + OFF_LIST);
    constexpr int NTN = WHICH == 1 ? 8 : 4;
    int total = 0;
    for (int i = 0; i < 32; ++i) total += ((cnt[i] + 255) >> 8) * NTN;
    XcdSeq sq(total, bid, nb);
    int e = 0, base = 0, ce = cnt[0], mt = (ce + 255) >> 8;
    auto src = [&](int i, G8Desc& d) -> bool {
        const int t = sq.q + i * sq.step;
        if (t >= sq.qend) return false;
        while (e < 32 && t >= base + mt * NTN) { base += mt * NTN; ++e; if (e < 32) { ce = cnt[e]; mt = (ce + 255) >> 8; } }
        if (e >= 32) return false;
        int mi, ni;
        { const int loc = t - base, pf = mt >> 2, full = pf * 4 * NTN;
          if (loc < full) { const int pn = loc / (4 * NTN), r = loc - pn * 4 * NTN; ni = r >> 2; mi = pn * 4 + (r & 3); }
          else { const int ph = mt - pf * 4, r = loc - full; ni = r / ph; mi = pf * 4 + (r - ni * ph); } }
        d.m0 = 0; d.n0 = ni * 256; d.list = LIST + (size_t)e * LISTCAP + mi * 256; d.count = ce - mi * 256; d.u0 = e; d.ldb = 1024;
        if (WHICH == 1) { d.A = (const bf16_t*)(p.ws + OFF_XB); d.Bt = (const bf16_t*)(p.ws + OFF_WT_W1) + (size_t)(layer * 32 + e) * 2048 * 1024; }
        else { d.A = (const bf16_t*)(p.ws + OFF_ACT); d.Bt = (const bf16_t*)(p.ws + OFF_WT_W2) + (size_t)(layer * 32 + e) * 1024 * 1024; }
        return true; };
    if (WHICH == 1) {
        bf16_t* ACT = (bf16_t*)(p.ws + OFF_ACT);
        gemm256_stream<true, 2>(src, 1024, 1024, smem,
            [&](int, int e_, f32x4 (&acc)[4][2], int rt0, int c0, int fr, int fq, const int* sRow) {
                const float* b1 = p.moe_b1 + (size_t)(layer * 32 + e_) * 2048;
                const int gcol = (c0 >> 5) * 16 + 4 * fq;
                const f32x4 bg = *(const f32x4*)(b1 + gcol), bl = *(const f32x4*)(b1 + 1024 + gcol);
#pragma unroll
                for (int m = 0; m < 4; ++m) {
                    const int pair = NOEPI ? -1 : sRow[rt0 + m * 16 + fr];
                    if (pair >= 0) {
                        float a[4];
#pragma unroll
                        for (int r = 0; r < 4; ++r) {
                            const float gl = fminf(acc[m][0][r] + bg[r], 7.f);
                            const float li = fminf(fmaxf(acc[m][1][r] + bl[r], -7.f), 7.f);
                            a[r] = gl * sigmoidf_(1.702f * gl) * (li + 1.f);
                        }
                        u32x2 w; w.x = pk2(a[0], a[1]); w.y = pk2(a[2], a[3]);
                        *(u32x2*)(ACT + (size_t)pair * 1024 + gcol) = w;
                    }
                }
            });
    } else {
        const float* GATE = (const float*)(p.ws + OFF_GATE);
        bf16_t* SLOT = (bf16_t*)(p.ws + OFF_SLOT);
        gemm256_stream<true, 0>(src, 1024, 1024, smem,
            [&](int, int e_, f32x4 (&acc)[4][2], int rt0, int c0, int fr, int fq, const int* sRow) {
                const float* b2 = p.moe_b2 + (size_t)(layer * 32 + e_) * 1024;
                const int col = c0 + 8 * fq;
                const f32x4 b20 = *(const f32x4*)(b2 + col), b21 = *(const f32x4*)(b2 + col + 4);
#pragma unroll
                for (int m = 0; m < 4; ++m) {
                    const int pair = NOEPI ? -1 : sRow[rt0 + m * 16 + fr];
                    if (pair >= 0) {
                        const float gt = GATE[pair];
                        const f32x4 y0 = (acc[m][0] + b20) * gt, y1 = (acc[m][1] + b21) * gt;
                        u32x4 w; w.x = pk2(y0[0], y0[1]); w.y = pk2(y0[2], y0[3]); w.z = pk2(y1[0], y1[1]); w.w = pk2(y1[2], y1[3]);
                        *(u32x4*)(SLOT + (size_t)pair * 1024 + col) = w;
                    }
                }
            });
    }
}

__device__ __forceinline__ void epi_od_in(PRef p, f32x4 (&acc)[4][2], int row0, int c0, int fr, int fq) {
    char* ws = p.ws;
    bf16_t* PO = (bf16_t*)(ws + OFF_PO); float* WI = (float*)(ws + OFF_WI);
    const int col = c0 + 8 * fq;
#pragma unroll
    for (int m = 0; m < 4; ++m) {
        const int t = row0 + m * 16 + fr;
        if (c0 < OD_WI) {
            u32x4 w; w.x = pk2(acc[m][0][0], acc[m][0][1]); w.y = pk2(acc[m][0][2], acc[m][0][3]); w.z = pk2(acc[m][1][0], acc[m][1][1]); w.w = pk2(acc[m][1][2], acc[m][1][3]);
            *(u32x4*)(PO + (size_t)t * OD_P + col) = w;
        } else if (col == OD_WI) {
            *(f32x4*)(WI + (size_t)t * 4) = acc[m][0];
        }
    }
}

__device__ __forceinline__ void idx_scores(const char* __restrict__ ktile, int kbase, const bf16x8 (&qf)[4][4], const float (&wi)[4], int lane, float (&sc)[16]) {
    const int r = lane & 31, h2 = lane >> 5;
    const char* kp = ktile + (kbase + r) * 144 + h2 * 16;
    bf16x8 kf[4];
#pragma unroll
    for (int s = 0; s < 4; ++s) kf[s] = *(const bf16x8*)(kp + s * 32);
#pragma unroll
    for (int i = 0; i < 16; ++i) sc[i] = 0.f;
#pragma unroll
    for (int hd = 0; hd < 4; ++hd) {
        f32x16 a;
#pragma unroll
        for (int i = 0; i < 16; ++i) a[i] = 0.f;
#pragma unroll
        for (int s = 0; s < 4; ++s) a = __builtin_amdgcn_mfma_f32_32x32x16_bf16(kf[s], qf[hd][s], a, 0, 0, 0);
#pragma unroll
        for (int i = 0; i < 16; ++i) { const int ai = __float_as_int(a[i]); sc[i] += wi[hd] * __int_as_float(ai > 0 ? ai : 0); }
    }
}
__device__ __forceinline__ unsigned ord_key(float s) {
    const unsigned u = __float_as_uint(s);
    return u ^ ((unsigned)((int)u >> 31) | 0x80000000u);
}

constexpr int SEL_KT = 128 * 144;
__device__ __forceinline__ void dsa_select_item(PRef p, int b, int qb, char* smem) {
    unsigned* hist = (unsigned*)smem;
    unsigned* pref = (unsigned*)(smem + 66048);
    int* krem = (int*)(smem + 66048 + 256);
    unsigned* GW = (unsigned*)(smem + 66048 + 512);
    unsigned* EW = (unsigned*)(smem + 66048 + 512 + 2048);
    char* kbuf = smem + 71680;
    const bf16_t* PO = (const bf16_t*)(p.ws + OFF_PO);
    const float* WI = (const float*)(p.ws + OFF_WI);
    unsigned long long* BMT = (unsigned long long*)(p.ws + OFF_BM);
    const int tid = otid(), lane = tid & 63, wave = tid >> 6, kw = wave >> 1, qw = wave & 1, h2 = lane >> 5;
    const int p0 = qb * 64;
    const int ql = qw * 32 + (lane & 31);
    const int qpos = p0 + ql;
    const size_t tq = (size_t)b * L_ + qpos;
    const int nkt = (p0 + 64 + 127) >> 7;
    bf16x8 qf[4][4]; float wi[4];
#pragma unroll
    for (int hd = 0; hd < 4; ++hd) {
        wi[hd] = WI[tq * 4 + hd];
#pragma unroll
        for (int s = 0; s < 4; ++s) qf[hd][s] = *(const bf16x8*)(PO + tq * OD_P + OD_QI + hd * 64 + s * 16 + h2 * 8);
    }
    const int srow = tid >> 3, sch = tid & 7;
    const bf16_t* ksrc = PO + ((size_t)b * L_ + srow) * OD_P + OD_KI + sch * 8;
    char* kdst = kbuf + srow * 144 + sch * 16;
    for (int e = tid; e < 64 * 257; e += NTHR) hist[e] = 0u;
    if (tid < 64) { pref[tid] = 0u; krem[tid] = 256; }
    __syncthreads();
    const bool selall = qpos < 256;
    const int npass = (p0 + 63 >= 256) ? 3 : 0;
    for (int pass = 0; pass <= npass; ++pass) {
        const bool maskpass = pass == npass;
        const int sh = 24 - 8 * pass;
        const unsigned mypref = pref[ql];
        int ceq = 0;
        const int rsel = tid < 64 ? krem[tid] : 0;
        const int npair = (nkt + 1) >> 1;
        u32x4 r0, r1, r2 = (u32x4){0u, 0u, 0u, 0u}, r3 = r2;
        r0 = *(const u32x4*)ksrc; r1 = *(const u32x4*)(ksrc + (size_t)64 * OD_P);
        if (nkt > 1) { r2 = *(const u32x4*)(ksrc + (size_t)128 * OD_P); r3 = *(const u32x4*)(ksrc + (size_t)192 * OD_P); }
        *(u32x4*)kdst = r0; *(u32x4*)(kdst + 64 * 144) = r1; *(u32x4*)(kdst + SEL_KT) = r2; *(u32x4*)(kdst + SEL_KT + 64 * 144) = r3;
        __syncthreads();
        for (int kp = 0; kp < npair; ++kp) {
            const bool more = kp + 1 < npair;
            const bool more2 = 2 * kp + 3 < nkt;
            if (more) {
                r0 = *(const u32x4*)(ksrc + (size_t)(2 * kp + 2) * 128 * OD_P); r1 = *(const u32x4*)(ksrc + (size_t)((2 * kp + 2) * 128 + 64) * OD_P);
                if (more2) { r2 = *(const u32x4*)(ksrc + (size_t)(2 * kp + 3) * 128 * OD_P); r3 = *(const u32x4*)(ksrc + (size_t)((2 * kp + 3) * 128 + 64) * OD_P); }
            }
            const char* kcur = kbuf + (kp & 1) * 2 * SEL_KT;
            const bool two = 2 * kp + 1 < nkt;
            unsigned gwp[2] = {0u, 0u}, ewp[2] = {0u, 0u};
#pragma unroll
            for (int tt = 0; tt < 2; ++tt) {
                if (tt == 1 && !two) break;
                const int kt = 2 * kp + tt;
                float sc[16];
                idx_scores(kcur + tt * SEL_KT, kw * 32, qf, wi, lane, sc);
                const int keybase = kt * 128 + kw * 32;
                const bool diag = kt == nkt - 1;
                if (!maskpass) {
                    if (pass == 0 && !diag && p0 >= 256) {
#pragma unroll
                        for (int i = 0; i < 16; ++i) atomicAdd(&hist[ql * 257 + (ord_key(sc[i]) >> 24)], 1u);
                    } else {
#pragma unroll
                        for (int i = 0; i < 16; ++i) {
                            const int key = keybase + (i & 3) + 8 * (i >> 2) + 4 * h2;
                            const unsigned k32 = ord_key(sc[i]);
                            const bool match = pass == 0 ? true : ((k32 >> (sh + 8)) == mypref);
                            const bool valid = diag ? key <= qpos : true;
                            if (valid && !selall && match) atomicAdd(&hist[ql * 257 + ((k32 >> sh) & 255u)], 1u);
                        }
                    }
                } else {
                    unsigned gw = 0u, ew = 0u;
#pragma unroll
                    for (int i = 0; i < 16; ++i) {
                        const int ko = (i & 3) + 8 * (i >> 2) + 4 * h2;
                        const int key = keybase + ko;
                        const unsigned k24 = ord_key(sc[i]) >> 8;
                        const bool valid = diag ? key <= qpos : true;
                        const bool g = valid && (selall || k24 > mypref);
                        const bool e = valid && !selall && k24 == mypref;
                        gw |= (g ? 1u : 0u) << ko; ew |= (e ? 1u : 0u) << ko;
                    }
                    gwp[tt] = xor32_or(gw); ewp[tt] = xor32_or(ew);
                }
            }
            if (maskpass && h2 == 0) { GW[ql * 8 + kw] = gwp[0]; EW[ql * 8 + kw] = ewp[0]; GW[ql * 8 + 4 + kw] = gwp[1]; EW[ql * 8 + 4 + kw] = ewp[1]; }
            if (more) {
                char* nd = kdst + ((kp + 1) & 1) * 2 * SEL_KT;
                *(u32x4*)nd = r0; *(u32x4*)(nd + 64 * 144) = r1;
                if (more2) { *(u32x4*)(nd + SEL_KT) = r2; *(u32x4*)(nd + SEL_KT + 64 * 144) = r3; }
            }
            __syncthreads();
            if (maskpass) {
                if (tid < 64) {
#pragma unroll
                    for (int tt = 0; tt < 2; ++tt) {
                        if (tt == 1 && !two) break;
                        const int kt = 2 * kp + tt;
                        unsigned g4[4], e4[4];
#pragma unroll
                        for (int w = 0; w < 4; ++w) { g4[w] = GW[tid * 8 + tt * 4 + w]; e4[w] = EW[tid * 8 + tt * 4 + w]; }
                        int need = rsel - ceq; if (need < 0) need = 0;
#pragma unroll
                        for (int w = 0; w < 4; ++w) {
                            const int pc = __popc(e4[w]);
                            ceq += pc;
                            if (need >= pc) need -= pc;
                            else { unsigned m = e4[w], kept = 0u; for (int k = 0; k < need; ++k) { const unsigned low = m & (0u - m); kept |= low; m ^= low; } e4[w] = kept; need = 0; }
                            g4[w] |= e4[w];
                        }
                        BMT[((size_t)(b * 256 + 2 * kt)) * L_ + p0 + tid] = (unsigned long long)g4[0] | ((unsigned long long)g4[1] << 32);
                        BMT[((size_t)(b * 256 + 2 * kt + 1)) * L_ + p0 + tid] = (unsigned long long)g4[2] | ((unsigned long long)g4[3] << 32);
                    }
                }
                __syncthreads();
            }
        }
        if (!maskpass) {
            const int q = tid >> 3, part = tid & 7;
            unsigned c32[32]; unsigned tot = 0u;
#pragma unroll
            for (int i = 0; i < 32; ++i) { c32[i] = hist[q * 257 + part * 32 + i]; tot += c32[i]; }
            unsigned above = 0u;
#pragma unroll
            for (int d = 1; d < 8; ++d) { const unsigned o = __shfl(tot, (lane & ~7) + ((part + d) & 7), 64); if (part + d < 8) above += o; }
            const unsigned need = (unsigned)krem[q];
            __syncthreads();
            if ((p0 + q) >= 256 && above < need && above + tot >= need) {
                unsigned cum = above; int dg = 31;
#pragma unroll
                for (int i = 31; i >= 0; --i) { if (i == dg) { if (cum + c32[i] >= need) {   } else { cum += c32[i]; dg = i - 1; } } }
                pref[q] = (pref[q] << 8) | (unsigned)(part * 32 + dg);
                krem[q] = (int)(need - cum);
            }
            for (int e = tid; e < 64 * 257; e += NTHR) hist[e] = 0u;
            __syncthreads();
        }
    }
}

template <int MODE, int NQT>
__device__ __forceinline__ void attn_wave(PRef p, int b, int head, int qcol, int kcol, const bf16_t* __restrict__ VT, int voff,
                                          int i0, int sh  , int rho, int kt_lo, int kt_hi, int grp) {
    const bf16_t* PO = (const bf16_t*)(p.ws + OFF_PO);
    const unsigned* BM32 = (const unsigned*)(p.ws + OFF_BM);
    const int lane = otid() & 63, r = lane & 31, h2 = lane >> 5;
    const int pr = (r & 0x13) | ((r & 4) << 1) | ((r & 8) >> 1);
    const float SC = 0.125f * 1.4426950408889634f;
    bf16x8 qf[NQT][4]; size_t tq[NQT]; int qi[NQT];
#pragma unroll
    for (int qt = 0; qt < NQT; ++qt) {
        qi[qt] = i0 + qt * 32 + r;
        tq[qt] = (size_t)b * L_ + ((size_t)qi[qt] << sh) + rho;
#pragma unroll
        for (int s = 0; s < 4; ++s) qf[qt][s] = *(const bf16x8*)(PO + tq[qt] * OD_P + qcol + head * 64 + s * 16 + h2 * 8);
    }
    f32x16 oacc[NQT][2];
#pragma unroll
    for (int a = 0; a < NQT; ++a)
#pragma unroll
        for (int c = 0; c < 2; ++c)
#pragma unroll
            for (int i = 0; i < 16; ++i) oacc[a][c][i] = 0.f;
    float mrun[NQT], lrun[NQT];
#pragma unroll
    for (int a = 0; a < NQT; ++a) { mrun[a] = -64.f; lrun[a] = 0.f; }
    bf16x8 kf[4]; unsigned mw[NQT];
    auto load_k = [&](int kt, bf16x8 (&k_)[4], unsigned (&m_)[NQT]) {
        const size_t krow = (size_t)b * L_ + ((size_t)(kt * 32 + pr) << sh) + rho;
#pragma unroll
        for (int s = 0; s < 4; ++s) k_[s] = *(const bf16x8*)(PO + krow * OD_P + kcol + head * 64 + s * 16 + h2 * 8);
#pragma unroll
        for (int a = 0; a < NQT; ++a) m_[a] = MODE == 0 ? BM32[tq[a] * 512 + kt] : 0u;
    };
    load_k(kt_lo, kf, mw);
#pragma unroll 1
    for (int kt = kt_lo; kt <= kt_hi; ++kt) {
        bf16x8 vf[2][2];
#pragma unroll
        for (int db = 0; db < 2; ++db)
#pragma unroll
            for (int s2 = 0; s2 < 2; ++s2) vf[db][s2] = *(const bf16x8*)(VT + (size_t)(db * 32 + r) * L_ + voff + kt * 32 + s2 * 16 + h2 * 8);
        bf16x8 kn[4]; unsigned mn[NQT];
#pragma unroll
        for (int a = 0; a < NQT; ++a) mn[a] = 0u;
        if (kt < kt_hi) load_k(kt + 1, kn, mn);
#pragma unroll
        for (int qt = 0; qt < NQT; ++qt) {
            f32x16 s;
#pragma unroll
            for (int i = 0; i < 16; ++i) s[i] = 0.f;
#pragma unroll
            for (int ks = 0; ks < 4; ++ks) s = __builtin_amdgcn_mfma_f32_32x32x16_bf16(kf[ks], qf[qt][ks], s, 0, 0, 0);
            unsigned wsel;
            if (MODE == 0) wsel = mw[qt];
            else {
                const int hi = qi[qt] - kt * 32, lo = hi - 128;
                const unsigned mh = hi < 0 ? 0u : (hi >= 31 ? 0xffffffffu : ((2u << hi) - 1u)), ml = lo <= 0 ? 0xffffffffu : (lo > 31 ? 0u : ~((1u << lo) - 1u));
                wsel = mh & ml;
            }
#pragma unroll
            for (int i = 0; i < 16; ++i) s[i] = __builtin_fmaf(s[i], SC, -mrun[qt]);
            float mx = fmaxf(fmaxf(s[0], s[1]), fmaxf(s[2], s[3]));
#pragma unroll
            for (int i = 4; i < 16; i += 2) mx = fmaxf(mx, fmaxf(s[i], s[i + 1]));
            mx = xor32_max(mx);
            if (__builtin_amdgcn_ballot_w64(mx > 0.f) != 0ull) {
                const float dlt = fmaxf(mx, 0.f);
                const float corr = __builtin_amdgcn_exp2f(-dlt);
                mrun[qt] += dlt; lrun[qt] *= corr;
#pragma unroll
                for (int db = 0; db < 2; ++db)
#pragma unroll
                    for (int i = 0; i < 16; ++i) oacc[qt][db][i] *= corr;
#pragma unroll
                for (int i = 0; i < 16; ++i) s[i] -= dlt;
            }
            float ps = 0.f;
            const int mws = (int)(wsel >> (8 * h2));
#define DA_P(i, KO) { const float e = __builtin_amdgcn_exp2f(s[i]); s[i] = __uint_as_float(__float_as_uint(e) & bitmask32<KO>(mws)); ps += s[i]; }
            DA_P(0, 0) DA_P(1, 1) DA_P(2, 2) DA_P(3, 3) DA_P(4, 4) DA_P(5, 5) DA_P(6, 6) DA_P(7, 7)
            DA_P(8, 16) DA_P(9, 17) DA_P(10, 18) DA_P(11, 19) DA_P(12, 20) DA_P(13, 21) DA_P(14, 22) DA_P(15, 23)
#undef DA_P
            lrun[qt] += ps;
#pragma unroll
            for (int s2 = 0; s2 < 2; ++s2) {
                u32x4 pw; pw.x = pk2(s[8 * s2], s[8 * s2 + 1]); pw.y = pk2(s[8 * s2 + 2], s[8 * s2 + 3]); pw.z = pk2(s[8 * s2 + 4], s[8 * s2 + 5]); pw.w = pk2(s[8 * s2 + 6], s[8 * s2 + 7]);
                const bf16x8 pf = __builtin_bit_cast(bf16x8, pw);
#pragma unroll
                for (int db = 0; db < 2; ++db) oacc[qt][db] = __builtin_amdgcn_mfma_f32_32x32x16_bf16(vf[db][s2], pf, oacc[qt][db], 0, 0, 0);
            }
        }
        if (kt < kt_hi) {
#pragma unroll
            for (int s = 0; s < 4; ++s) kf[s] = kn[s];
#pragma unroll
            for (int a = 0; a < NQT; ++a) mw[a] = mn[a];
        }
    }
#pragma unroll
    for (int qt = 0; qt < NQT; ++qt) {
        const float lt = xor32_sum(lrun[qt]);
        const float inv = 1.f / lt;
        if (MODE == 0) {
            bf16_t* CC = (bf16_t*)(p.ws + OFF_CC);
#pragma unroll
            for (int db = 0; db < 2; ++db)
#pragma unroll
                for (int i = 0; i < 16; ++i) {
                    const int d = db * 32 + (i & 3) + 8 * (i >> 2) + 4 * h2;
                    CC[tq[qt] * 1024 + head * 64 + d] = f2bf(oacc[qt][db][i] * inv);
                }
        } else {
            bf16_t* OD = (bf16_t*)(p.ws + OFF_OD) + (size_t)grp * T_ * 512;
#pragma unroll
            for (int db = 0; db < 2; ++db)
#pragma unroll
                for (int i = 0; i < 16; i += 4) {
                    const int d = db * 32 + 8 * (i >> 2) + 4 * h2;
                    { u32x2 w; w.x = pk2(oacc[qt][db][i] * inv, oacc[qt][db][i + 1] * inv); w.y = pk2(oacc[qt][db][i + 2] * inv, oacc[qt][db][i + 3] * inv); *(u32x2*)(OD + tq[qt] * 512 + head * 64 + d) = w; }
                }
            if (h2 == 0) ((float*)(p.ws + OFF_LSE))[((size_t)grp * T_ + tq[qt]) * 8 + head] = mrun[qt] + log2f(lt);
        }
    }
}

__device__ __forceinline__ void dil_combine_phase(PRef p, int bid, int nb) {
    const bf16_t* OD = (const bf16_t*)(p.ws + OFF_OD); const float* LSE = (const float*)(p.ws + OFF_LSE);
    bf16_t* CC = (bf16_t*)(p.ws + OFF_CC);
    const long n = (long)T_ * 128;
    for (long c = (long)bid * NTHR + otid(); c < n; c += (long)nb * NTHR) {
        const long t = c >> 7; const int ch = (int)(c & 127) * 4, hd = ch >> 6;
        const float l0 = LSE[((size_t)0 * T_ + t) * 8 + hd], l1 = LSE[((size_t)1 * T_ + t) * 8 + hd], l2 = LSE[((size_t)2 * T_ + t) * 8 + hd];
        const float mx = fmaxf(l0, fmaxf(l1, l2));
        const float w0 = __builtin_amdgcn_exp2f(l0 - mx), w1 = __builtin_amdgcn_exp2f(l1 - mx), w2 = __builtin_amdgcn_exp2f(l2 - mx);
        const float inv = __builtin_amdgcn_rcpf(w0 + w1 + w2);
        const u32x2 a = *(const u32x2*)(OD + ((size_t)0 * T_ + t) * 512 + ch), bq = *(const u32x2*)(OD + ((size_t)1 * T_ + t) * 512 + ch), cq = *(const u32x2*)(OD + ((size_t)2 * T_ + t) * 512 + ch);
        float o[4];
#define BFLO(x) __uint_as_float((x) << 16)
#define BFHI(x) __uint_as_float((x) & 0xffff0000u)
        o[0] = (BFLO(a.x) * w0 + BFLO(bq.x) * w1 + BFLO(cq.x) * w2) * inv; o[1] = (BFHI(a.x) * w0 + BFHI(bq.x) * w1 + BFHI(cq.x) * w2) * inv;
        o[2] = (BFLO(a.y) * w0 + BFLO(bq.y) * w1 + BFLO(cq.y) * w2) * inv; o[3] = (BFHI(a.y) * w0 + BFHI(bq.y) * w1 + BFHI(cq.y) * w2) * inv;
#undef BFLO
#undef BFHI
        u32x2 w; w.x = pk2(o[0], o[1]); w.y = pk2(o[2], o[3]);
        *(u32x2*)(CC + (size_t)t * 1024 + 512 + ch) = w;
    }
}

constexpr int DA_ROW = 144;
constexpr int DA_TILE = 64 * DA_ROW;
__device__ __forceinline__ void dsa_attn_item(PRef p, int b, int head, int qb, char* smem) {
    const bf16_t* PO = (const bf16_t*)(p.ws + OFF_PO);
    const bf16_t* VT = (const bf16_t*)(p.ws + OFF_VTC) + ((size_t)(b * 8 + head)) * 64 * L_;
    const int tid = otid(), lane = tid & 63, wave = tid >> 6, r = lane & 31, h2 = lane >> 5;
    const int pr = (r & 0x13) | ((r & 4) << 1) | ((r & 8) >> 1);
    const float SC = 0.125f * 1.4426950408889634f;
    const int i0 = qb * 256 + wave * 32, qi = i0 + r;
    const unsigned long long* BMT = (const unsigned long long*)(p.ws + OFF_BM) + (size_t)b * 256 * L_ + qi;
    const size_t tq = (size_t)b * L_ + qi;
    bf16x8 qf[4];
#pragma unroll
    for (int s = 0; s < 4; ++s) qf[s] = *(const bf16x8*)(PO + tq * OD_P + head * 64 + s * 16 + h2 * 8);
    f32x16 oacc[2];
#pragma unroll
    for (int c = 0; c < 2; ++c)
#pragma unroll
        for (int i = 0; i < 16; ++i) oacc[c][i] = 0.f;
    float mrun = -64.f, lrun = 0.f;
    const int nkt = qb * 4 + 4, my_last = (i0 + 31) >> 6;
    const int srow = tid >> 3, sch = tid & 7;
    const bf16_t* ksrc = PO + ((size_t)b * L_ + srow) * OD_P + 512 + head * 64 + sch * 8;
    const bf16_t* vsrc = VT + (size_t)srow * L_ + sch * 8;
    u32x4 rk = *(const u32x4*)ksrc, rv = *(const u32x4*)vsrc;
    __syncthreads();
    *(u32x4*)(smem + srow * DA_ROW + sch * 16) = rk;
    *(u32x4*)(smem + DA_TILE + srow * DA_ROW + sch * 16) = rv;
    __syncthreads();
    unsigned long long mwn = BMT[0];
#pragma unroll 1
    for (int kt = 0; kt < nkt; ++kt) {
        const bool more = kt + 1 < nkt;
        if (more) { rk = *(const u32x4*)(ksrc + (size_t)(kt + 1) * 64 * OD_P); rv = *(const u32x4*)(vsrc + (kt + 1) * 64); }
        const unsigned long long mw64 = mwn;
        if (kt < my_last) mwn = BMT[(size_t)(kt + 1) * L_];
        if (kt <= my_last) {
            const char* kb = smem + (kt & 1) * 2 * DA_TILE; const char* vb = kb + DA_TILE;
            f32x16 sa[2];
#pragma unroll
            for (int sub = 0; sub < 2; ++sub) {
                bf16x8 kf[4];
#pragma unroll
                for (int s = 0; s < 4; ++s) kf[s] = *(const bf16x8*)(kb + (sub * 32 + pr) * DA_ROW + (s * 16 + h2 * 8) * 2);
#pragma unroll
                for (int i = 0; i < 16; ++i) sa[sub][i] = 0.f;
#pragma unroll
                for (int ks = 0; ks < 4; ++ks) sa[sub] = __builtin_amdgcn_mfma_f32_32x32x16_bf16(kf[ks], qf[ks], sa[sub], 0, 0, 0);
            }
#pragma unroll
            for (int sub = 0; sub < 2; ++sub) {
                const unsigned mw = sub == 0 ? (unsigned)mw64 : (unsigned)(mw64 >> 32);
                f32x16& s = sa[sub];
                bf16x8 vf[2][2];
#pragma unroll
                for (int db = 0; db < 2; ++db)
#pragma unroll
                    for (int s2 = 0; s2 < 2; ++s2) vf[db][s2] = *(const bf16x8*)(vb + (db * 32 + r) * DA_ROW + (sub * 32 + s2 * 16 + h2 * 8) * 2);
#pragma unroll
                for (int i = 0; i < 16; ++i) s[i] = __builtin_fmaf(s[i], SC, -mrun);
                float mx = fmaxf(fmaxf(s[0], s[1]), fmaxf(s[2], s[3]));
#pragma unroll
                for (int i = 4; i < 16; i += 2) mx = fmaxf(mx, fmaxf(s[i], s[i + 1]));
                mx = xor32_max(mx);
                if (__builtin_amdgcn_ballot_w64(mx > 0.f) != 0ull) {
                    const float dlt = fmaxf(mx, 0.f);
                    const float corr = __builtin_amdgcn_exp2f(-dlt);
                    mrun += dlt; lrun *= corr;
#pragma unroll
                    for (int db = 0; db < 2; ++db)
#pragma unroll
                        for (int i = 0; i < 16; ++i) oacc[db][i] *= corr;
#pragma unroll
                    for (int i = 0; i < 16; ++i) s[i] -= dlt;
                }
                float ps = 0.f;
                const int mws = (int)(mw >> (8 * h2));
#define DA_P(i, KO) { const float e = __builtin_amdgcn_exp2f(s[i]); s[i] = __uint_as_float(__float_as_uint(e) & bitmask32<KO>(mws)); ps += s[i]; }
                DA_P(0, 0) DA_P(1, 1) DA_P(2, 2) DA_P(3, 3) DA_P(4, 4) DA_P(5, 5) DA_P(6, 6) DA_P(7, 7)
                DA_P(8, 16) DA_P(9, 17) DA_P(10, 18) DA_P(11, 19) DA_P(12, 20) DA_P(13, 21) DA_P(14, 22) DA_P(15, 23)
#undef DA_P
                lrun += ps;
#pragma unroll
                for (int s2 = 0; s2 < 2; ++s2) {
                    u32x4 pw; pw.x = pk2(s[8 * s2], s[8 * s2 + 1]); pw.y = pk2(s[8 * s2 + 2], s[8 * s2 + 3]); pw.z = pk2(s[8 * s2 + 4], s[8 * s2 + 5]); pw.w = pk2(s[8 * s2 + 6], s[8 * s2 + 7]);
                    const bf16x8 pf = __builtin_bit_cast(bf16x8, pw);
#pragma unroll
                    for (int db = 0; db < 2; ++db) oacc[db] = __builtin_amdgcn_mfma_f32_32x32x16_bf16(vf[db][s2], pf, oacc[db], 0, 0, 0);
                }
            }
        }
        if (more) {
            char* nbuf = smem + ((kt + 1) & 1) * 2 * DA_TILE;
            *(u32x4*)(nbuf + srow * DA_ROW + sch * 16) = rk;
            *(u32x4*)(nbuf + DA_TILE + srow * DA_ROW + sch * 16) = rv;
        }
        __syncthreads();
    }
    const float lt = xor32_sum(lrun);
    const float inv = 1.f / lt;
    bf16_t* CC = (bf16_t*)(p.ws + OFF_CC);
#pragma unroll
    for (int db = 0; db < 2; ++db)
#pragma unroll
        for (int i = 0; i < 16; i += 4) {
            const int d = db * 32 + 8 * (i >> 2) + 4 * h2;
            u32x2 w; w.x = pk2(oacc[db][i] * inv, oacc[db][i + 1] * inv); w.y = pk2(oacc[db][i + 2] * inv, oacc[db][i + 3] * inv);
            *(u32x2*)(CC + tq * 1024 + head * 64 + d) = w;
        }
}


template <bool ODD>
__device__ __forceinline__ void inproj_phase(PRef p, int j, char* smem, int bid, int nb) {
    char* ws = p.ws;
    constexpr int NTN = ODD ? OD_P / 256 : EV_P / 256, NMAIN = 128 * NTN, NVT = ODD ? 1024 : 256;
    const bf16_t* XB = (const bf16_t*)(ws + OFF_XB);
    const bf16_t* W = ODD ? (const bf16_t*)(ws + OFF_WT_ODIN) + (size_t)j * OD_N * 1024 : (const bf16_t*)(ws + OFF_WT_EVIN) + (size_t)j * EV_N * 1024;
    XcdSeq s(NMAIN + NVT, bid, nb);
    gemm256_stream<false, 0>(
        [&](int i, G8Desc& d) -> bool {
            const int Q = s.q + i * s.step; if (Q >= s.qend) return false;
            d.list = nullptr; d.count = 0;
            if (Q < NMAIN) {
                const int pnl = Q / (4 * NTN), r = Q - pnl * 4 * NTN;
                d.A = XB; d.Bt = W; d.m0 = (pnl * 4 + (r & 3)) * 256; d.n0 = (r >> 2) * 256; d.u0 = -1; d.ldb = 1024;
            } else {
                const int v = Q - NMAIN; d.m0 = 0; d.n0 = 0; d.u0 = v;
                if (ODD) {
                    const int combo = v & 7, src = combo >> 1, mt = combo & 1, bn = v >> 3, b = bn >> 6, lam0 = (bn & 63) * 256;
                    const int sh = src < 2 ? 0 : (src == 2 ? 2 : 4), rho = lam0 >> (14 - sh), i0 = lam0 & ((L_ >> sh) - 1);
                    d.A = W + (size_t)(OD_P + src * 512 + mt * 256) * 1024;
                    d.Bt = XB + ((size_t)b * L_ + ((size_t)i0 << sh) + rho) * 1024; d.ldb = 1024 << sh;
                } else {
                    const int mt = v & 1, bn = v >> 1;
                    d.A = W + (size_t)(EV_P + mt * 256) * 1024;
                    d.Bt = XB + (size_t)bn * 256 * 1024; d.ldb = 1024;
                }
            }
            return true; },
        1024, 1024, smem,
        [&](int m0, int u0, f32x4 (&acc)[4][2], int rt0, int c0, int fr, int fq, const int*) {
            if (u0 < 0) { if (ODD) epi_od_in(p, acc, m0 + rt0, c0, fr, fq); else epi_ev_in(p, acc, m0 + rt0, c0, fr, fq); }
            else if (ODD) {
                const int combo = u0 & 7, src = combo >> 1, mt = combo & 1, bn = u0 >> 3, b = bn >> 6, lam0 = (bn & 63) * 256;
                bf16_t* img = src == 0 ? (bf16_t*)(ws + OFF_VTC) + ((size_t)(b * 8) * 64 + mt * 256) * L_ + lam0
                                       : (bf16_t*)(ws + OFF_VTD) + ((size_t)((b * 3 + src - 1) * 8) * 64 + mt * 256) * L_ + lam0;
                epi_vt(img, acc, rt0, c0, fr, fq);
            } else {
                const int mt = u0 & 1, bn = u0 >> 1, b = bn >> 6, lam0 = (bn & 63) * 256;
                epi_vt((bf16_t*)(ws + OFF_VTE) + ((size_t)(b * 4) * 128 + mt * 256) * L_ + lam0, acc, rt0, c0, fr, fq);
            }
        });
}

enum { K_PRO = 0, K_E1, K_E2, K_E3, K_E4, K_E5, K_E6, K_LN1, K_O1, K_O2, K_O3, K_O4, K_M1, K_M2, K_M3, K_M4, K_LN2, K_COUNT };

template <int KIND, bool NOEPI = false>
__device__ __forceinline__ void run_phase(PRef p, int layer, char* smem, int bid, int nb) {
    char* ws = p.ws;
    const int j = layer >> 1;
    if (KIND == K_PRO) {
        conv_phase(p, smem, bid, nb);
        __syncthreads();
        for (int u = nb - 1 - bid; u < 64; u += nb) s5mat_unit(p, u >> 5, u & 31, smem);
    } else if (KIND == K_E1) {
        inproj_phase<false>(p, j, smem, bid, nb);
    } else if (KIND == K_E2) {
        for (int it = bid; it < 2048; it += nb) gla_a_item(p, j, it, smem);
        s5_g_phase(p, j, smem, bid, nb);
    } else if (KIND == K_E3) {
        scan_phase(p, j, bid);
    } else if (KIND == K_E4) {
        for (int it = bid; it < 2048; it += nb) gla_c_item(p, j, it, smem);
        s5_y_phase(p, j, smem, bid, nb);
    } else if (KIND == K_E5) {
        const bf16_t* YA = (const bf16_t*)(ws + OFF_YA); bf16_t* CC = (bf16_t*)(ws + OFF_CC); const float* bg = p.s5_b_glu + (size_t)j * 512;
        gemm256_phase(YA, 512, T_, (const bf16_t*)(ws + OFF_WT_GLU) + (size_t)j * 512 * 512, 512, 512, 512, smem, bid, nb,
                   [&](f32x4 (&acc)[4][2], int row0, int c0, int fr, int fq) {
                       const int col = c0 + 8 * fq;
                       const f32x4 g0 = *(const f32x4*)(bg + col), g1 = *(const f32x4*)(bg + col + 4);
#pragma unroll
                       for (int m = 0; m < 4; ++m) {
                           const size_t t = (size_t)(row0 + m * 16 + fr);
                           const u32x4 yw = *(const u32x4*)(YA + t * 512 + col);
                           float o[8];
#pragma unroll
                           for (int q = 0; q < 4; ++q) {
                               const unsigned y2 = q == 0 ? yw.x : q == 1 ? yw.y : q == 2 ? yw.z : yw.w;
                               const float y0 = __uint_as_float(y2 << 16), y1 = __uint_as_float(y2 & 0xffff0000u);
                               const float a0 = q < 2 ? acc[m][0][2 * q] + g0[2 * q] : acc[m][1][2 * q - 4] + g1[2 * q - 4];
                               const float a1 = q < 2 ? acc[m][0][2 * q + 1] + g0[2 * q + 1] : acc[m][1][2 * q - 3] + g1[2 * q - 3];
                               o[2 * q] = y0 * sigmoidf_(a0); o[2 * q + 1] = y1 * sigmoidf_(a1);
                           }
                           u32x4 w; w.x = pk2(o[0], o[1]); w.y = pk2(o[2], o[3]); w.z = pk2(o[4], o[5]); w.w = pk2(o[6], o[7]);
                           *(u32x4*)(CC + t * 1024 + 512 + col) = w;
                       }
                   });
    } else if (KIND == K_E6 || KIND == K_O4) {
        bf16_t* MIX = (bf16_t*)(ws + OFF_MIX);
        const bf16_t* W = (const bf16_t*)(ws + (KIND == K_E6 ? OFF_WT_EVOUT : OFF_WT_ODOUT)) + (size_t)j * 1024 * 1024;
        gemm256_phase((const bf16_t*)(ws + OFF_CC), 1024, T_, W, 1024, 1024, 1024, smem, bid, nb,
                   [&](f32x4 (&acc)[4][2], int row0, int c0, int fr, int fq) {
#pragma unroll
                       for (int m = 0; m < 4; ++m) {
                           u32x4 w; w.x = pk2(acc[m][0][0], acc[m][0][1]); w.y = pk2(acc[m][0][2], acc[m][0][3]); w.z = pk2(acc[m][1][0], acc[m][1][1]); w.w = pk2(acc[m][1][2], acc[m][1][3]);
                           *(u32x4*)(MIX + (size_t)(row0 + m * 16 + fr) * 1024 + c0 + 8 * fq) = w;
                       }
                   });
    } else if (KIND == K_LN1) {
        const float* xin = layer == 0 ? p.x : (const float*)(ws + OFF_XR);
        ln1_router_phase<NOEPI>(p, layer, xin, smem, bid, nb);
    } else if (KIND == K_O1) {
        inproj_phase<true>(p, j, smem, bid, nb);
    } else if (KIND == K_O2) {
        if (!NOEPI) for (int k = bid; k < 256; k += nb) {
            dsa_select_item(p, k & 1, k >> 1, smem);
            __syncthreads();
            const int k2 = 511 - k;
            dsa_select_item(p, k2 & 1, k2 >> 1, smem);
            __syncthreads();
        }
        const int head = otid() >> 6;
        for (int it = bid; it < 1536; it += nb) {
            const int b = it / 768, rem = it - b * 768, g = rem >> 8, u = rem & 255;
            const int sh = g * 2, per = 256 >> sh, rho = u / per, qblk = u - rho * per;
            const bf16_t* VT = (const bf16_t*)(ws + OFF_VTD) + ((size_t)((b * 3 + g) * 8 + head)) * 64 * L_;
#pragma unroll 1
            for (int hf = 0; hf < 2; ++hf) {
                const int hi = 2 * qblk + hf, lo = hi - 4;
                attn_wave<1, 1>(p, b, head, OD_DIL + g * 512, OD_DIL + 1536 + g * 512, VT, rho * (L_ >> sh), qblk * 64 + hf * 32, sh, rho, lo < 0 ? 0 : lo, hi, g);
            }
        }
    } else if (KIND == K_O3) {
        for (int k = bid; k < 512; k += nb) {
            const int bh = k >> 5, q0 = k & 31;
#pragma unroll 1
            for (int half = 0; half < 2; ++half) dsa_attn_item(p, bh >> 3, bh & 7, half == 0 ? q0 : 63 - q0, smem);
        }
        dil_combine_phase(p, bid, nb);
    } else if (KIND == K_M1) {
        float* LG = (float*)(ws + OFF_LOGIT); const float* rb = p.router_b + (size_t)layer * 32;
        gemm_phase((const bf16_t*)(ws + OFF_XB), 1024, T_, (const bf16_t*)(ws + OFF_WT_RT) + (size_t)layer * 128 * 1024, 1024, 128, 1024, smem, bid, nb,
                   [&](f32x4 (&acc)[4][2], int row0, int c0, int fr, int fq) {
#pragma unroll
                       for (int n = 0; n < 2; ++n) {
                           const int col = c0 + n * 16 + fr;
                           if (col < 32) {
#pragma unroll
                               for (int m = 0; m < 4; ++m)
#pragma unroll
                                   for (int r = 0; r < 4; ++r) LG[(size_t)(row0 + m * 16 + fq * 4 + r) * 32 + col] = acc[m][n][r] + rb[col];
                           }
                       }
                   });
    } else if (KIND == K_M2) {
        topk_phase(p, layer, bid, nb);
    } else if (KIND == K_M3) {
        moe_gemm_phase<1, NOEPI>(p, layer, smem, bid, nb);
    } else if (KIND == K_M4) {
        moe_gemm_phase<2, NOEPI>(p, layer, smem, bid, nb);
    } else if (KIND == K_LN2) {
        float* xo = layer == 3 ? p.out : (float*)(ws + OFF_XR);
        ln_phase<true, NOEPI>(p, (const float*)(ws + OFF_XR), (const float*)(ws + OFF_SLOT), p.ln2_g + (size_t)layer * 1024, p.ln2_b + (size_t)layer * 1024, xo,
                       layer == 3 ? (bf16_t*)nullptr : (bf16_t*)(ws + OFF_XB), bid, nb);
    }
}

extern __shared__ __attribute__((aligned(16))) char dyn_smem[];

#if !MEGA
template <int KIND>
__global__ void __launch_bounds__(NTHR, 2) k_phase(Params p, int layer) { run_phase<KIND>(p, layer, dyn_smem, blockIdx.x, gridDim.x); }
#else
#ifndef DUPMASK
#define DUPMASK 0
#endif
typedef const __attribute__((address_space(4))) Params* KParams;
#define RUNP(K) do { KParams _q = kp0; asm volatile("" : "+s"(_q)); run_phase<K>(*_q, layer, smem, bid, nb); } while (0)
#ifndef DUPNOEPI
#define DUPNOEPI 0
#endif
#define RUNP2(K) do { KParams _q = kp0; asm volatile("" : "+s"(_q)); run_phase<K, (DUPNOEPI != 0)>(*_q, layer, smem, bid, nb); } while (0)
#define PHASE(K) do { RUNP(K); xcd_barrier(bar); if ((DUPMASK >> 30) & 1) xcd_barrier(bar); if ((DUPMASK >> K) & 1) { RUNP2(K); xcd_barrier(bar); } } while (0)
template <int LAYER>
__device__ __forceinline__ void mega_layer(KParams kp0, char* smem, int bid, int nb, const XcdBarrier& bar) {
    constexpr int layer = LAYER;
    if ((layer & 1) == 0) { PHASE(K_E1); PHASE(K_E2); PHASE(K_E3); PHASE(K_E4); PHASE(K_E5); PHASE(K_E6); }
    else { PHASE(K_O1); PHASE(K_O2); PHASE(K_O3); PHASE(K_O4); }
    PHASE(K_LN1); PHASE(K_M3); PHASE(K_M4);
    RUNP(K_LN2);
    if (layer < 3) xcd_barrier(bar);
}
__global__ void __launch_bounds__(NTHR, 2) k_mega(Params p) {
    char* smem = dyn_smem;
    const int bid = blockIdx.x, nb = gridDim.x;
    volatile LAS unsigned* st = (volatile LAS unsigned*)(dyn_smem + LDS_BYTES - 16);
    if (otid() == 0) { st[0] = 0u; st[1] = 0u; }
    __syncthreads();
    KParams kp0 = (KParams)__builtin_amdgcn_kernarg_segment_ptr();
    XcdBarrier bar = xcd_barrier_post((unsigned*)(kp0->ws + OFF_BAR), st);
    { const int layer = 0; PHASE(K_PRO); }
    mega_layer<0>(kp0, smem, bid, nb, bar);
    mega_layer<1>(kp0, smem, bid, nb, bar);
    mega_layer<2>(kp0, smem, bid, nb, bar);
    mega_layer<3>(kp0, smem, bid, nb, bar);
}
#endif

extern "C" void kernel_launch(void* const* d_in, const int* in_sizes, int n_in, void* d_out, int out_size, void* d_ws, size_t ws_size, hipStream_t stream) {
    Params p{};
    const float** f = (const float**)&p;
    for (int i = 0; i < 28; ++i) f[i] = (const float*)d_in[i];
    p.out = (float*)d_out; p.ws = (char*)d_ws;
    if (ws_size < WS_NEED) { fprintf(stderr, "workspace too small: %zu < %zu\n", ws_size, (size_t)WS_NEED); return; }
#if !MEGA
#define SETATTR(K) hipFuncSetAttribute((const void*)k_phase<K>, hipFuncAttributeMaxDynamicSharedMemorySize, LDS_BYTES)
#define LAUNCH(K, layer) k_phase<K><<<256, NTHR, LDS_BYTES, stream>>>(p, layer)
    static bool attr_done = false;
    if (!attr_done) {
        SETATTR(K_PRO); SETATTR(K_E1); SETATTR(K_E2); SETATTR(K_E3); SETATTR(K_E4); SETATTR(K_E5); SETATTR(K_E6); SETATTR(K_LN1); SETATTR(K_O1); SETATTR(K_O2); SETATTR(K_O3);
        SETATTR(K_O4); SETATTR(K_M1); SETATTR(K_M2); SETATTR(K_M3); SETATTR(K_M4); SETATTR(K_LN2);
        attr_done = true;
    }
    LAUNCH(K_PRO, 0);
    for (int layer = 0; layer < 4; ++layer) {
        if ((layer & 1) == 0) { LAUNCH(K_E1, layer); LAUNCH(K_E2, layer); LAUNCH(K_E3, layer); LAUNCH(K_E4, layer); LAUNCH(K_E5, layer); LAUNCH(K_E6, layer); }
        else { LAUNCH(K_O1, layer); LAUNCH(K_O2, layer); LAUNCH(K_O3, layer); LAUNCH(K_O4, layer); }
        LAUNCH(K_LN1, layer); LAUNCH(K_M3, layer); LAUNCH(K_M4, layer); LAUNCH(K_LN2, layer);
    }
#else
    static int grid = 0;
    if (!grid) {
        hipFuncSetAttribute((const void*)k_mega, hipFuncAttributeMaxDynamicSharedMemorySize, LDS_BYTES);
        int dev = 0, cus = 0, per_cu = 0;
        hipGetDevice(&dev);
        hipDeviceGetAttribute(&cus, hipDeviceAttributeMultiprocessorCount, dev);
        hipOccupancyMaxActiveBlocksPerMultiprocessor(&per_cu, (const void*)k_mega, NTHR, LDS_BYTES);
        grid = cus * (per_cu < 1 ? per_cu : 1);
        if (grid <= 0) grid = 0;
    }
    if (!grid) { fprintf(stderr, "occupancy query says 0 blocks per CU\n"); return; }
    hipMemsetAsync((char*)d_ws + OFF_BAR, 0, XCD_BAR_WORDS * sizeof(unsigned), stream);
    k_mega<<<grid, NTHR, LDS_BYTES, stream>>>(p);
#endif
}
```

```cpp
#include <hip/hip_runtime.h>
#include <stdint.h>
#include <stdio.h>

#ifndef MEGA
#define MEGA 1
#define DUPMASK 0
#define DUPNOEPI 0
#endif

typedef unsigned short bf16_t;
typedef short bf16x8 __attribute__((ext_vector_type(8)));
typedef float f32x4 __attribute__((ext_vector_type(4)));
typedef float f32x16 __attribute__((ext_vector_type(16)));
typedef unsigned u32x4 __attribute__((ext_vector_type(4)));
typedef unsigned u32x2 __attribute__((ext_vector_type(2)));

constexpr int T_ = 32768, D_ = 1024, L_ = 16384, NB_ = 2;
constexpr int NTHR = 512;
constexpr float ALPHA = 1.681792830507429f;
constexpr float LN_EPS = 1e-5f;
constexpr int EV_N = 2304;
constexpr int EV_P = 1792;
constexpr int PE_W = 1024;
constexpr int OD_N = 6656;
constexpr int OD_P = 4608;
constexpr int OD_QI = 1024, OD_DIL = 1280, OD_KI = 4352, OD_WI = 4416;
constexpr int UHW = 1152;
constexpr int LISTCAP = 131072;

constexpr size_t OFF_BAR = 0;
constexpr size_t OFF_CNT = 16384;
constexpr size_t OFF_A64 = 32768;
constexpr size_t OFF_WT_EVIN = 131072;
constexpr size_t OFF_WT_ODIN = OFF_WT_EVIN + (size_t)2 * EV_N * 1024 * 2;
constexpr size_t OFF_WT_EVOUT = OFF_WT_ODIN + (size_t)2 * OD_N * 1024 * 2;
constexpr size_t OFF_WT_ODOUT = OFF_WT_EVOUT + (size_t)2 * 1024 * 1024 * 2;
constexpr size_t OFF_WT_GLU = OFF_WT_ODOUT + (size_t)2 * 1024 * 1024 * 2;
constexpr size_t OFF_WT_RT = OFF_WT_GLU + (size_t)2 * 512 * 512 * 2;
constexpr size_t OFF_WT_W1 = OFF_WT_RT + (size_t)4 * 128 * 1024 * 2;
constexpr size_t OFF_WT_W2 = OFF_WT_W1 + (size_t)4 * 32 * 2048 * 1024 * 2;
constexpr size_t OFF_TH = OFF_WT_W2 + (size_t)4 * 32 * 1024 * 1024 * 2;
constexpr size_t OFF_GM = OFF_TH + (size_t)2 * 32 * 1024 * UHW * 2;
constexpr size_t OFF_XR = OFF_GM + (size_t)2 * 32 * 128 * 1024 * 2;
constexpr size_t OFF_XB = OFF_XR + (size_t)T_ * 1024 * 4;
constexpr size_t OFF_MIX = OFF_XB + (size_t)T_ * 1024 * 2;
constexpr size_t OFF_CC = OFF_MIX + (size_t)T_ * 1024 * 4;
constexpr size_t OFF_LOGIT = OFF_CC + (size_t)T_ * 1024 * 2;
constexpr size_t OFF_LIST = OFF_LOGIT + (size_t)T_ * 32 * 4;
constexpr size_t OFF_GATE = OFF_LIST + (size_t)32 * LISTCAP * 4;
constexpr size_t OFF_ACT = OFF_GATE + (size_t)T_ * 4 * 4;
constexpr size_t OFF_SLOT = OFF_ACT + (size_t)T_ * 4 * 1024 * 2;
constexpr size_t OFF_MIXER = OFF_SLOT + (size_t)T_ * 4 * 1024 * 4;
constexpr size_t OFF_PE = OFF_MIXER;
constexpr size_t OFF_UH = OFF_PE + (size_t)T_ * 1536 * 2;
constexpr size_t OFF_GLR = OFF_UH + (size_t)(T_ / 64) * 32 * UHW * 2;
constexpr size_t OFF_VTE = OFF_GLR + (size_t)T_ * 16 * 4;
constexpr size_t OFF_KV = OFF_VTE + (size_t)2 * 4 * 128 * L_ * 2;
constexpr size_t OFF_SST = OFF_KV + (size_t)2 * 256 * 4 * 64 * 128 * 4;
constexpr size_t OFF_DEC = OFF_SST + (size_t)2 * 256 * 4 * 64 * 128 * 4;
constexpr size_t OFF_GBUF = OFF_DEC + (size_t)2 * 256 * 4 * 64 * 4;
constexpr size_t OFF_YA = OFF_GBUF + (size_t)512 * 32 * 128 * 4;
constexpr size_t END_EVEN = OFF_YA + (size_t)T_ * 512 * 2;
constexpr size_t OFF_PO = OFF_MIXER;
constexpr size_t OFF_WI = OFF_PO + (size_t)T_ * OD_N * 2;
constexpr size_t OFF_VTC = OFF_WI + (size_t)T_ * 4 * 4;
constexpr size_t OFF_VTD = OFF_VTC + (size_t)2 * 8 * 64 * L_ * 2;
constexpr size_t OFF_BM = OFF_VTD + (size_t)2 * 3 * 8 * 64 * L_ * 2;
constexpr size_t OFF_OD = OFF_BM + (size_t)T_ * 256 * 8;
constexpr size_t OFF_LSE = OFF_OD + (size_t)3 * T_ * 512 * 4;
constexpr size_t END_ODD = OFF_LSE + (size_t)3 * T_ * 8 * 4;
constexpr size_t WS_NEED = END_ODD > END_EVEN ? END_ODD : END_EVEN;
static_assert(WS_NEED < (size_t)4200000000ull, "workspace too large");

constexpr int LDS_BYTES = 153600;

struct Params {
    const float *x, *ev_w_in, *gla_w_gate2, *gla_b_gate2, *gla_norm_g, *s5_a_re, *s5_a_im, *s5_log_dt, *s5_b_re, *s5_b_im, *s5_c_re, *s5_c_im, *s5_d,
        *s5_w_glu, *s5_b_glu, *ev_w_out, *od_w_in, *od_w_out, *ln1_g, *ln1_b, *ln2_g, *ln2_b, *router_w, *router_b, *moe_w1, *moe_b1, *moe_w2, *moe_b2;
    float* out;
    char* ws;
};

#if MEGA
typedef const __attribute__((address_space(4))) Params& PRef;
#else
typedef const Params& PRef;
#endif

__device__ __forceinline__ unsigned pk2(float lo, float hi) { unsigned r; asm("v_cvt_pk_bf16_f32 %0, %1, %2" : "=v"(r) : "v"(lo), "v"(hi)); return r; }
__device__ __forceinline__ bf16_t f2bf(float f) { return (bf16_t)(pk2(f, 0.f) & 0xffffu); }
__device__ __forceinline__ float bf2f(bf16_t h) { return __uint_as_float(((unsigned)h) << 16); }
__device__ __forceinline__ float sigmoidf_(float x) { return __builtin_amdgcn_rcpf(1.f + __expf(-x)); }
template <int CTRL> __device__ __forceinline__ float dppf(float v) { return __int_as_float(__builtin_amdgcn_update_dpp(0, __float_as_int(v), CTRL, 0xF, 0xF, false)); }
constexpr int DPP_X1 = 0xB1  , DPP_X2 = 0x4E  , DPP_HMIR = 0x141  , DPP_MIR = 0x140  , DPP_ROR8 = 0x128;
__device__ __forceinline__ float xor16_sum(float v) { const unsigned u = __float_as_uint(v); auto r = __builtin_amdgcn_permlane16_swap(u, u, false, false); return __uint_as_float(r[0]) + __uint_as_float(r[1]); }
__device__ __forceinline__ float xor16_max(float v) { const unsigned u = __float_as_uint(v); auto r = __builtin_amdgcn_permlane16_swap(u, u, false, false); return fmaxf(__uint_as_float(r[0]), __uint_as_float(r[1])); }
__device__ __forceinline__ float xor32_sum_(float v) { const unsigned u = __float_as_uint(v); auto r = __builtin_amdgcn_permlane32_swap(u, u, false, false); return __uint_as_float(r[0]) + __uint_as_float(r[1]); }
__device__ __forceinline__ float xor32_max_(float v) { const unsigned u = __float_as_uint(v); auto r = __builtin_amdgcn_permlane32_swap(u, u, false, false); return fmaxf(__uint_as_float(r[0]), __uint_as_float(r[1])); }
__device__ __forceinline__ float wave_sum(float v) {
    v += dppf<DPP_X1>(v); v += dppf<DPP_X2>(v); v += dppf<DPP_HMIR>(v); v += dppf<DPP_MIR>(v);
    return xor32_sum_(xor16_sum(v));
}
__device__ __forceinline__ float wave_max(float v) {
    v = fmaxf(v, dppf<DPP_X1>(v)); v = fmaxf(v, dppf<DPP_X2>(v)); v = fmaxf(v, dppf<DPP_HMIR>(v)); v = fmaxf(v, dppf<DPP_MIR>(v));
    return xor32_max_(xor16_max(v));
}
__device__ __forceinline__ float gelu_tanh(float x) {
    const float k0 = 0.7978845608028654f, k1 = 0.044715f;
    float u = k0 * (x + k1 * x * x * x);
    float t = 1.f - 2.f * __builtin_amdgcn_rcpf(1.f + __expf(2.f * u));
    return 0.5f * x * (1.f + t);
}
__device__ __forceinline__ float xor32_max(float v) { const unsigned u = __float_as_uint(v); auto r = __builtin_amdgcn_permlane32_swap(u, u, false, false); return fmaxf(__uint_as_float(r[0]), __uint_as_float(r[1])); }
__device__ __forceinline__ float xor32_sum(float v) { const unsigned u = __float_as_uint(v); auto r = __builtin_amdgcn_permlane32_swap(u, u, false, false); return __uint_as_float(r[0]) + __uint_as_float(r[1]); }
__device__ __forceinline__ unsigned xor32_or(unsigned u) { auto r = __builtin_amdgcn_permlane32_swap(u, u, false, false); return r[0] | r[1]; }
template <int BIT> __device__ __forceinline__ unsigned bitmask32(int w) { unsigned m; asm("v_bfe_i32 %0, %1, %2, 1" : "=v"(m) : "v"(w), "n"(BIT)); return m; }
__device__ __forceinline__ int otid() { int t = threadIdx.x; asm volatile("" : "+v"(t)); return t; }

#define XB_TMO      128
#define XB_XCNT(j)  (256  + 64 * (j))
#define XB_XSUB(j)  (1280 + 64 * (j))
#define XB_XGEN(j)  (2304 + 64 * (j))
#define XB_TOP      3328
#define XB_TOPGEN   3392
#define XCD_BAR_WORDS 3456
#define XB_SPIN_CAP (1u << 21)
#define LAS __attribute__((address_space(3)))

__device__ __forceinline__ unsigned xb_ld(unsigned* p)              { return __hip_atomic_load(p, __ATOMIC_RELAXED, __HIP_MEMORY_SCOPE_AGENT); }
__device__ __forceinline__ unsigned xb_add(unsigned* p, unsigned v) { return __hip_atomic_fetch_add(p, v, __ATOMIC_RELAXED, __HIP_MEMORY_SCOPE_AGENT); }
__device__ __forceinline__ unsigned xb_xcc_id() { return (unsigned)__builtin_amdgcn_s_getreg((3 << 11) | 20) & 0xFu; }
#define XB_SPIN(cond, bar) do { unsigned _sp = 0; while (cond) { __builtin_amdgcn_s_sleep(1); \
    if ((++_sp & 255u) == 0u) { if (xb_ld(&(bar)[XB_TMO])) break; if (_sp > XB_SPIN_CAP) { atomicAdd(&(bar)[XB_TMO], 1u); break; } } } } while (0)

struct XcdBarrier { unsigned* bar; unsigned x; volatile LAS unsigned* st; };

__device__ __forceinline__ XcdBarrier xcd_barrier_post(unsigned* bar, volatile LAS unsigned* st) {
    XcdBarrier b; b.bar = bar; b.x = xb_xcc_id(); b.st = st;
    if (threadIdx.x == 0) (void)xb_add(&bar[XB_XCNT(b.x)], 1u);
    return b;
}
__device__ __forceinline__ void xcd_barrier_complete(unsigned* bar, unsigned x, unsigned& nloc, unsigned& nx) {
    const unsigned G = gridDim.x * gridDim.y * gridDim.z;
    unsigned sum, cnt, mine, sp = 0u;
    for (;;) {
        sum = 0u; cnt = 0u; mine = 0u;
#pragma unroll
        for (unsigned j = 0; j < 16; ++j) { const unsigned c = xb_ld(&bar[XB_XCNT(j)]); sum += c; cnt += (c > 0u) ? 1u : 0u; mine = (j == x) ? c : mine; }
        if (sum == G) break;
        __builtin_amdgcn_s_sleep(1);
        if ((++sp & 255u) == 0u) { if (xb_ld(&bar[XB_TMO])) break; if (sp > XB_SPIN_CAP) { atomicAdd(&bar[XB_TMO], 1u); break; } }
    }
    nloc = mine > 0u ? mine : 1u; nx = cnt > 0u ? cnt : 1u;
}
__device__ __forceinline__ void xcd_barrier(const XcdBarrier& b) {
    asm volatile("s_waitcnt vmcnt(0)" ::: "memory");
    __syncthreads();
    if (threadIdx.x == 0) {
        unsigned* bar = b.bar;
        __builtin_amdgcn_s_waitcnt(0);
        unsigned nloc = b.st[0], nx = b.st[1];
        if (nloc == 0u) { xcd_barrier_complete(bar, b.x, nloc, nx); b.st[0] = nloc; b.st[1] = nx; }
        const unsigned old = xb_add(&bar[XB_XSUB(b.x)], 1u);
        const unsigned gen = old / nloc;
        if (old + 1u == (gen + 1u) * nloc) {
            __builtin_amdgcn_fence(__ATOMIC_RELEASE, "agent");
            asm volatile("s_waitcnt vmcnt(0)" ::: "memory");
            const unsigned og = xb_add(&bar[XB_TOP], 1u);
            const unsigned tg = og / nx;
            if (og + 1u == (tg + 1u) * nx) xb_add(&bar[XB_TOPGEN], 1u);
            else XB_SPIN(xb_ld(&bar[XB_TOPGEN]) == tg, bar);
            __builtin_amdgcn_fence(__ATOMIC_ACQUIRE, "agent");
            xb_add(&bar[XB_XGEN(b.x)], 1u);
            asm volatile("s_waitcnt vmcnt(0)" ::: "memory");
        } else {
            XB_SPIN(xb_ld(&bar[XB_XGEN(b.x)]) == gen, bar);
            __builtin_amdgcn_fence(__ATOMIC_ACQUIRE, "agent");
            asm volatile("s_waitcnt vmcnt(0)" ::: "memory");
        }
    }
    __syncthreads();
}

constexpr int G_LROW = 144;
constexpr int G_ASZ = 256 * G_LROW;
constexpr int G_BSZ = 128 * G_LROW;
constexpr int G_STAGE = G_ASZ + G_BSZ;
constexpr int G_ROWS_OFF = 2 * G_STAGE;

template <bool GATHER, class Epi>
__device__ __forceinline__ void gemm_tile(const bf16_t* __restrict__ A, long lda, int shift, int m0, const bf16_t* __restrict__ Bt, long ldb, int n0, int K,
                                          char* smem, Epi&& epi) {
    const int tid = otid(), lane = tid & 63, wave = tid >> 6, wr = wave >> 1, wc = wave & 1, fr = lane & 15, fq = lane >> 4;
    const int lrow = tid >> 3, lchunk = tid & 7;
    const int* sRow = (const int*)(smem + G_ROWS_OFF);
    const bf16_t* pa[4]; const bf16_t* pb[2];
#pragma unroll
    for (int i = 0; i < 4; ++i) {
        int r = lrow + 64 * i; long arow;
        if (GATHER) { int v = sRow[r]; arow = v < 0 ? 0 : (v >> shift); } else arow = m0 + r;
        pa[i] = A + arow * lda + lchunk * 8;
    }
#pragma unroll
    for (int i = 0; i < 2; ++i) pb[i] = Bt + (long)(n0 + lrow + 64 * i) * ldb + lchunk * 8;
    f32x4 acc[4][4];
#pragma unroll
    for (int m = 0; m < 4; ++m)
#pragma unroll
        for (int n = 0; n < 4; ++n) acc[m][n] = (f32x4){0.f, 0.f, 0.f, 0.f};
    u32x4 ra[4], rb[2];
    const int nk = K >> 6;
#pragma unroll
    for (int i = 0; i < 4; ++i) ra[i] = *(const u32x4*)(pa[i]);
#pragma unroll
    for (int i = 0; i < 2; ++i) rb[i] = *(const u32x4*)(pb[i]);
    {
        char* sa = smem; char* sb = smem + G_ASZ;
#pragma unroll
        for (int i = 0; i < 4; ++i) *(u32x4*)(sa + (lrow + 64 * i) * G_LROW + lchunk * 16) = ra[i];
#pragma unroll
        for (int i = 0; i < 2; ++i) *(u32x4*)(sb + (lrow + 64 * i) * G_LROW + lchunk * 16) = rb[i];
    }
    __syncthreads();
    for (int kt = 0; kt < nk; ++kt) {
        const bool more = (kt + 1 < nk);
        if (more) {
#pragma unroll
            for (int i = 0; i < 4; ++i) ra[i] = *(const u32x4*)(pa[i] + (kt + 1) * 64);
#pragma unroll
            for (int i = 0; i < 2; ++i) rb[i] = *(const u32x4*)(pb[i] + (kt + 1) * 64);
        }
        const char* sa = smem + (kt & 1) * G_STAGE; const char* sb = sa + G_ASZ;
#pragma unroll
        for (int ks = 0; ks < 2; ++ks) {
            bf16x8 af[4], bfr[4];
#pragma unroll
            for (int m = 0; m < 4; ++m) af[m] = *(const bf16x8*)(sa + (wr * 64 + m * 16 + fr) * G_LROW + (ks * 32 + fq * 8) * 2);
#pragma unroll
            for (int n = 0; n < 4; ++n) bfr[n] = *(const bf16x8*)(sb + (wc * 64 + n * 16 + fr) * G_LROW + (ks * 32 + fq * 8) * 2);
#pragma unroll
            for (int m = 0; m < 4; ++m)
#pragma unroll
                for (int n = 0; n < 4; ++n) acc[m][n] = __builtin_amdgcn_mfma_f32_16x16x32_bf16(af[m], bfr[n], acc[m][n], 0, 0, 0);
        }
        if (more) {
            char* wa = smem + ((kt + 1) & 1) * G_STAGE; char* wb = wa + G_ASZ;
#pragma unroll
            for (int i = 0; i < 4; ++i) *(u32x4*)(wa + (lrow + 64 * i) * G_LROW + lchunk * 16) = ra[i];
#pragma unroll
            for (int i = 0; i < 2; ++i) *(u32x4*)(wb + (lrow + 64 * i) * G_LROW + lchunk * 16) = rb[i];
        }
        __syncthreads();
    }
    {
        f32x4 h0[4][2], h1[4][2];
#pragma unroll
        for (int m = 0; m < 4; ++m) { h0[m][0] = acc[m][0]; h0[m][1] = acc[m][1]; h1[m][0] = acc[m][2]; h1[m][1] = acc[m][3]; }
        epi(h0, wr * 64, n0 + wc * 64, fr, fq);
        epi(h1, wr * 64, n0 + wc * 64 + 32, fr, fq);
    }
}

template <class Epi>
__device__ __forceinline__ void gemm_phase(const bf16_t* A, long lda, int M, const bf16_t* Bt, long ldb, int N, int K, char* smem, int bid, int nb, Epi&& epi) {
    const int ntn = N / 128, ntm = M / 256, nt = ntn * ntm;
    for (int t = bid; t < nt; t += nb) {
        const int mi = t / ntn, ni = t - mi * ntn;
        gemm_tile<false>(A, lda, 0, mi * 256, Bt, ldb, ni * 128, K, smem,
                         [&](f32x4 (&acc)[4][2], int rt0, int c0, int fr, int fq) { epi(acc, mi * 256 + rt0, c0, fr, fq); });
    }
}

constexpr int G8_HT = 128 * 64 * 2;
constexpr int G8_ROWS_OFF = 8 * G8_HT;

__device__ __forceinline__ int g8_lds_byte(int r, int c) {
    const int st = (r >> 4) * 2 + (c >> 5), rr = r & 15, cc = c & 31, ob = rr * 64 + cc * 2;
    return st * 1024 + (ob ^ (((ob >> 9) & 1) << 5));
}
__device__ __forceinline__ void g8_stage_rc(int b, int& R, int& C) {
    const int st = b / 1024, sb = b % 1024, swz = sb ^ (((sb >> 9) & 1) << 5);
    R = (st >> 1) * 16 + swz / 64; C = (st & 1) * 32 + (swz % 64) / 2;
}

#define G8_SA(b, h) (lds + ((b) * 2 + (h)) * G8_HT)
#define G8_SB(b, h) (lds + (4 + (b) * 2 + (h)) * G8_HT)
#define G8_STAGE(P, RS, OFF, soff) do { \
    _Pragma("unroll") for (int _i = 0; _i < 2; ++_i) \
        __builtin_amdgcn_raw_ptr_buffer_load_lds((RS), (LAS unsigned*)((P) + tid * 16 + _i * 8192), 16, (OFF)[_i], (soff), 0, 0); } while (0)
#define G8_LDA(dst, b, h) do { _Pragma("unroll") for (int m = 0; m < 4; ++m) _Pragma("unroll") for (int k = 0; k < 2; ++k) \
    dst[m][k] = *(const LAS bf16x8*)(G8_SA(b, h) + g8_lds_byte(wr * 64 + m * 16 + fr, k * 32 + fq * 8)); } while (0)
#define G8_LDB(dst, b, h) do { _Pragma("unroll") for (int n = 0; n < 2; ++n) _Pragma("unroll") for (int k = 0; k < 2; ++k) \
    dst[n][k] = *(const LAS bf16x8*)(G8_SB(b, h) + g8_lds_byte(wc * 32 + n * 16 + fr, k * 32 + fq * 8)); } while (0)
#define G8_MMA(ai, bj, At, Bt_) do { __builtin_amdgcn_s_setprio(1); \
    _Pragma("unroll") for (int m = 0; m < 4; ++m) _Pragma("unroll") for (int n = 0; n < 2; ++n) _Pragma("unroll") for (int k = 0; k < 2; ++k) \
        acc[ai][bj][m][n] = __builtin_amdgcn_mfma_f32_16x16x32_bf16(Bt_[n][k], At[m][k], acc[ai][bj][m][n], 0, 0, 0); \
    __builtin_amdgcn_s_setprio(0); } while (0)
#define G8_WAIT_V(n) asm volatile("s_waitcnt vmcnt(" #n ")" ::: "memory")
#define G8_WAIT_L(n) asm volatile("s_waitcnt lgkmcnt(" #n ")" ::: "memory")
#define G8_BAR __builtin_amdgcn_s_barrier()
#define G8_SCHED __builtin_amdgcn_sched_barrier(0)

template <bool GATHER, class Epi>
__device__ __forceinline__ void gemm256_tile(const bf16_t* __restrict__ A, long lda, int shift, int m0, const bf16_t* __restrict__ Bt, long ldb, int n0, int K,
                                             char* smem, Epi&& epi) {
    LAS char* lds = (LAS char*)smem;
    int tid = otid();
    int wid = tid >> 6, lane = tid & 63, wr = wid >> 2, wc = wid & 3, fr = lane & 15, fq = lane >> 4;
    unsigned aoff[2][2], boff[2];
    {
        const LAS int* sRow = (const LAS int*)(lds + G8_ROWS_OFF);
#pragma unroll
        for (int i = 0; i < 2; ++i) {
            int R, C; g8_stage_rc(tid * 16 + i * 8192, R, C);
            { const int rho = R & 31, nn = rho >> 4, ii = rho & 15; const int Rp = (R & ~31) + 8 * (ii >> 2) + 4 * nn + (ii & 3);
              boff[i] = (unsigned)((long)Rp * ldb + C) * 2u; }
#pragma unroll
            for (int h = 0; h < 2; ++h) {
                long arow;
                if (GATHER) { const int v = sRow[h * 128 + R]; arow = v < 0 ? 0 : (v >> shift); } else arow = m0 + h * 128 + R;
                aoff[h][i] = (unsigned)(arow * lda + C) * 2u;
            }
        }
    }
    f32x4 acc[2][2][4][2];
#pragma unroll
    for (int a = 0; a < 2; ++a)
#pragma unroll
        for (int b = 0; b < 2; ++b)
#pragma unroll
            for (int m = 0; m < 4; ++m)
#pragma unroll
                for (int n = 0; n < 2; ++n) acc[a][b][m][n] = (f32x4){0.f, 0.f, 0.f, 0.f};
    bf16x8 At[4][2], B0[2][2], B1[2][2];
    const int nt = K / 64;
    const __amdgpu_buffer_rsrc_t rA = __builtin_amdgcn_make_buffer_rsrc((void*)A, 0, 0x7fffffff, 0x00020000);
    const __amdgpu_buffer_rsrc_t rB = __builtin_amdgcn_make_buffer_rsrc((void*)(Bt + (size_t)n0 * ldb), 0, 0x7fffffff, 0x00020000);
    const int bh = (int)(128 * ldb * 2);
    G8_STAGE(G8_SB(0, 0), rB, boff, 0); G8_STAGE(G8_SA(0, 0), rA, aoff[0], 0);
    G8_STAGE(G8_SB(0, 1), rB, boff, bh); G8_STAGE(G8_SA(0, 1), rA, aoff[1], 0);
    if (wr == 1) G8_BAR;
    G8_WAIT_V(4); G8_BAR;
    G8_STAGE(G8_SB(1, 0), rB, boff, 128); G8_STAGE(G8_SA(1, 0), rA, aoff[0], 128); G8_STAGE(G8_SB(1, 1), rB, boff, 128 + bh);
    G8_WAIT_V(6); G8_BAR;
    for (int t = 0; t < nt - 2; t += 2) {
        G8_LDB(B0, 0, 0); G8_SCHED; G8_LDA(At, 0, 0); G8_STAGE(G8_SA(1, 1), rA, aoff[1], (t + 1) * 128);
        G8_WAIT_L(8); G8_BAR; G8_WAIT_L(0); G8_MMA(0, 0, At, B0); G8_BAR; G8_SCHED;
        G8_LDB(B1, 0, 1); G8_STAGE(G8_SB(0, 0), rB, boff, (t + 2) * 128);
        G8_BAR; G8_WAIT_L(0); G8_MMA(0, 1, At, B1); G8_BAR;
        G8_LDA(At, 0, 1); G8_STAGE(G8_SA(0, 0), rA, aoff[0], (t + 2) * 128);
        G8_BAR; G8_WAIT_L(0); G8_MMA(1, 0, At, B0); G8_BAR; G8_SCHED;
        G8_STAGE(G8_SB(0, 1), rB, boff, (t + 2) * 128 + bh);
        G8_WAIT_V(6); G8_BAR; G8_MMA(1, 1, At, B1); G8_BAR;
        G8_LDB(B0, 1, 0); G8_SCHED; G8_LDA(At, 1, 0); G8_STAGE(G8_SA(0, 1), rA, aoff[1], (t + 2) * 128);
        G8_WAIT_L(8); G8_BAR; G8_WAIT_L(0); G8_MMA(0, 0, At, B0); G8_BAR; G8_SCHED;
        G8_LDB(B1, 1, 1); G8_STAGE(G8_SB(1, 0), rB, boff, (t + 3) * 128);
        G8_BAR; G8_WAIT_L(0); G8_MMA(0, 1, At, B1); G8_BAR;
        G8_LDA(At, 1, 1); G8_STAGE(G8_SA(1, 0), rA, aoff[0], (t + 3) * 128);
        G8_BAR; G8_WAIT_L(0); G8_MMA(1, 0, At, B0); G8_BAR; G8_SCHED;
        G8_STAGE(G8_SB(1, 1), rB, boff, (t + 3) * 128 + bh);
        G8_WAIT_V(6); G8_BAR; G8_MMA(1, 1, At, B1); G8_BAR;
    }
    { G8_LDB(B0, 0, 0); G8_WAIT_V(0); G8_LDA(At, 0, 0); G8_STAGE(G8_SA(1, 1), rA, aoff[1], (nt - 1) * 128);
      G8_BAR; G8_WAIT_L(0); G8_MMA(0, 0, At, B0); G8_BAR;
      G8_LDB(B1, 0, 1); G8_BAR; G8_WAIT_L(0); G8_MMA(0, 1, At, B1); G8_BAR;
      G8_LDA(At, 0, 1); G8_WAIT_V(4); G8_BAR; G8_WAIT_L(0); G8_MMA(1, 0, At, B0); G8_MMA(1, 1, At, B1); G8_BAR; }
    { G8_LDB(B0, 1, 0); G8_LDA(At, 1, 0); G8_WAIT_V(2); G8_BAR; G8_WAIT_L(0); G8_MMA(0, 0, At, B0); G8_BAR;
      G8_LDB(B1, 1, 1); G8_WAIT_V(0); G8_BAR; G8_WAIT_L(0); G8_MMA(0, 1, At, B1); G8_BAR;
      G8_LDA(At, 1, 1); G8_BAR; G8_WAIT_L(0); G8_MMA(1, 0, At, B0); G8_MMA(1, 1, At, B1); G8_BAR; }
    if (wr == 0) G8_BAR;
    int tz = otid(); wid = tz >> 6; lane = tz & 63; wr = wid >> 2; wc = wid & 3; fr = lane & 15; fq = lane >> 4;
#pragma unroll
    for (int ai = 0; ai < 2; ++ai)
#pragma unroll
        for (int bj = 0; bj < 2; ++bj) epi(acc[ai][bj], ai * 128 + wr * 64, n0 + bj * 128 + wc * 32, fr, fq);
}

struct G8Desc { const bf16_t* A; const bf16_t* Bt; const int* list; int m0, n0, count, u0, ldb; };

template <bool GATHER, int SHIFT, class Src, class Epi>
__device__ __forceinline__ void gemm256_stream(Src&& src, const int lda, const int K, char* smem, Epi&& epi) {
    LAS char* lds = (LAS char*)smem;
    int tid = otid();
    int wid = tid >> 6, lane = tid & 63, wr = wid >> 2, wc = wid & 3, fr = lane & 15, fq = lane >> 4;
    G8Desc nxt;
    if (!src(0, nxt)) return;
    int cm0 = nxt.m0, cn0 = nxt.n0, cu0 = nxt.u0;
    int* sRowG = (int*)(smem + G8_ROWS_OFF);
    __syncthreads();
    if (GATHER) { if (tid < 256) sRowG[tid] = tid < nxt.count ? nxt.list[tid] : -1; __syncthreads(); }
    unsigned aoff[2][2], boff[2];
    __amdgpu_buffer_rsrc_t rA, rB;
    int bh;
#define G8_PREP(D, SLOT) do { \
        const LAS int* _sr = (const LAS int*)(lds + G8_ROWS_OFF) + (SLOT) * 256; \
        _Pragma("unroll") for (int i = 0; i < 2; ++i) { \
            int R, C; g8_stage_rc(tid * 16 + i * 8192, R, C); \
            { const int rho = R & 31, nn = rho >> 4, ii = rho & 15; const int Rp = (R & ~31) + 8 * (ii >> 2) + 4 * nn + (ii & 3); boff[i] = (unsigned)(Rp * (D).ldb + C) * 2u; } \
            _Pragma("unroll") for (int h = 0; h < 2; ++h) { \
                int arow; \
                if (GATHER) { const int v = _sr[h * 128 + R]; arow = v < 0 ? 0 : (v >> SHIFT); } else arow = (D).m0 + h * 128 + R; \
                aoff[h][i] = (unsigned)(arow * lda + C) * 2u; } } \
        rA = __builtin_amdgcn_make_buffer_rsrc((void*)(D).A, 0, 0x7fffffff, 0x00020000); \
        rB = __builtin_amdgcn_make_buffer_rsrc((void*)((D).Bt + (size_t)(D).n0 * (D).ldb), 0, 0x7fffffff, 0x00020000); bh = 128 * (D).ldb * 2; } while (0)
#define G8_PRO1() do { G8_STAGE(G8_SB(0, 0), rB, boff, 0); G8_STAGE(G8_SA(0, 0), rA, aoff[0], 0); G8_STAGE(G8_SB(0, 1), rB, boff, bh); G8_STAGE(G8_SA(0, 1), rA, aoff[1], 0); } while (0)
    G8_PREP(nxt, 0);
    G8_PRO1();
    f32x4 acc[2][2][4][2];
    const int nt = K / 64;
    for (int it = 0;; ++it) {
#pragma unroll
        for (int a = 0; a < 2; ++a)
#pragma unroll
            for (int b = 0; b < 2; ++b)
#pragma unroll
                for (int m = 0; m < 4; ++m)
#pragma unroll
                    for (int n = 0; n < 2; ++n) acc[a][b][m][n] = (f32x4){0.f, 0.f, 0.f, 0.f};
        const bool has_next = src(it + 1, nxt);
        if (GATHER && has_next && tid < 256) sRowG[((it + 1) % 3) * 256 + tid] = tid < nxt.count ? nxt.list[tid] : -1;
        bf16x8 At[4][2], B0[2][2], B1[2][2];
        if (wr == 1) G8_BAR;
        G8_WAIT_V(4); G8_BAR;
        G8_STAGE(G8_SB(1, 0), rB, boff, 128); G8_STAGE(G8_SA(1, 0), rA, aoff[0], 128); G8_STAGE(G8_SB(1, 1), rB, boff, 128 + bh);
        G8_WAIT_V(6); G8_BAR;
        for (int t = 0; t < nt - 2; t += 2) {
            G8_LDB(B0, 0, 0); G8_SCHED; G8_LDA(At, 0, 0); G8_STAGE(G8_SA(1, 1), rA, aoff[1], (t + 1) * 128);
            G8_WAIT_L(8); G8_BAR; G8_WAIT_L(0); G8_MMA(0, 0, At, B0); G8_BAR; G8_SCHED;
            G8_LDB(B1, 0, 1); G8_STAGE(G8_SB(0, 0), rB, boff, (t + 2) * 128);
            G8_BAR; G8_WAIT_L(0); G8_MMA(0, 1, At, B1); G8_BAR;
            G8_LDA(At, 0, 1); G8_STAGE(G8_SA(0, 0), rA, aoff[0], (t + 2) * 128);
            G8_BAR; G8_WAIT_L(0); G8_MMA(1, 0, At, B0); G8_BAR; G8_SCHED;
            G8_STAGE(G8_SB(0, 1), rB, boff, (t + 2) * 128 + bh);
            G8_WAIT_V(6); G8_BAR; G8_MMA(1, 1, At, B1); G8_BAR;
            G8_LDB(B0, 1, 0); G8_SCHED; G8_LDA(At, 1, 0); G8_STAGE(G8_SA(0, 1), rA, aoff[1], (t + 2) * 128);
            G8_WAIT_L(8); G8_BAR; G8_WAIT_L(0); G8_MMA(0, 0, At, B0); G8_BAR; G8_SCHED;
            G8_LDB(B1, 1, 1); G8_STAGE(G8_SB(1, 0), rB, boff, (t + 3) * 128);
            G8_BAR; G8_WAIT_L(0); G8_MMA(0, 1, At, B1); G8_BAR;
            G8_LDA(At, 1, 1); G8_STAGE(G8_SA(1, 0), rA, aoff[0], (t + 3) * 128);
            G8_BAR; G8_WAIT_L(0); G8_MMA(1, 0, At, B0); G8_BAR; G8_SCHED;
            G8_STAGE(G8_SB(1, 1), rB, boff, (t + 3) * 128 + bh);
            G8_WAIT_V(6); G8_BAR; G8_MMA(1, 1, At, B1); G8_BAR;
        }
        { G8_LDB(B0, 0, 0); G8_WAIT_V(0); G8_LDA(At, 0, 0); G8_STAGE(G8_SA(1, 1), rA, aoff[1], (nt - 1) * 128);
          G8_BAR; G8_WAIT_L(0); G8_MMA(0, 0, At, B0); G8_BAR;
          G8_LDB(B1, 0, 1); G8_BAR; G8_WAIT_L(0); G8_MMA(0, 1, At, B1); G8_BAR;
          G8_LDA(At, 0, 1); G8_WAIT_V(4); G8_BAR; G8_WAIT_L(0); G8_MMA(1, 0, At, B0); G8_MMA(1, 1, At, B1); G8_BAR; }
        { G8_LDB(B0, 1, 0); G8_LDA(At, 1, 0); G8_WAIT_V(2); G8_BAR; G8_WAIT_L(0); G8_MMA(0, 0, At, B0); G8_BAR;
          G8_LDB(B1, 1, 1); G8_WAIT_V(0); G8_BAR; G8_WAIT_L(0); G8_MMA(0, 1, At, B1); G8_BAR;
          G8_LDA(At, 1, 1); G8_BAR; G8_WAIT_L(0); G8_MMA(1, 0, At, B0); G8_MMA(1, 1, At, B1); G8_BAR; }
        if (wr == 0) G8_BAR;
        tid = otid(); wid = tid >> 6; lane = tid & 63; wr = wid >> 2; wc = wid & 3; fr = lane & 15; fq = lane >> 4;
        if (has_next) { G8_PREP(nxt, (it + 1) % 3); G8_PRO1(); }
        {
            const int* sr = sRowG + (it % 3) * 256;
#pragma unroll
            for (int ai = 0; ai < 2; ++ai)
#pragma unroll
                for (int bj = 0; bj < 2; ++bj) epi(cm0, cu0, acc[ai][bj], ai * 128 + wr * 64, cn0 + bj * 128 + wc * 32, fr, fq, sr);
        }
        if (!has_next) break;
        cm0 = nxt.m0; cn0 = nxt.n0; cu0 = nxt.u0;
    }
#undef G8_PREP
#undef G8_PRO1
}

struct XcdSeq {
    int q, qend, step;
    __device__ __forceinline__ XcdSeq(int total, int bid, int nb) {
        if ((nb & 7) == 0) { const int chunk = (total + 7) >> 3, x = bid & 7; q = x * chunk + (bid >> 3); const int e = (x + 1) * chunk; qend = e < total ? e : total; step = nb >> 3; }
        else { q = bid; qend = total; step = nb; }
    }
};

template <class Epi>
__device__ __forceinline__ void gemm256_phase(const bf16_t* A, long lda, int M, const bf16_t* Bt, long ldb, int N, int K, char* smem, int bid, int nb, Epi&& epi) {
    const int ntn = N / 256, ntm = M / 256, nt = ntn * ntm;
    XcdSeq s(nt, bid, nb);
    gemm256_stream<false, 0>(
        [&](int i, G8Desc& d) -> bool {
            const int Q = s.q + i * s.step; if (Q >= s.qend) return false;
            const int pnl = Q / (4 * ntn), r = Q - pnl * 4 * ntn;
            d.A = A; d.Bt = Bt; d.list = nullptr; d.m0 = (pnl * 4 + (r & 3)) * 256; d.n0 = (r >> 2) * 256; d.count = 0; d.u0 = 0; d.ldb = (int)ldb;
            return true; },
        (int)lda, K, smem,
        [&](int m0, int, f32x4 (&acc)[4][2], int rt0, int c0, int fr, int fq, const int*) { epi(acc, m0 + rt0, c0, fr, fq); });
}


__device__ __forceinline__ int colmap(int kind, int n, int nsrc) {
    if (kind == 0) return n < nsrc ? n : -1;
    if (kind == 1) { if (n < 512) return n; if (n < 1024) return n + 512; if (n < 1536) return n + 528; if (n < 1552) return n; if (n < 1792) return -1; return n - 1280; }
    if (kind == 2) { if (n < 1024) return n; if (n < 1280) return n + 512; if (n < 4352) return n + 580; if (n < 4420) return n - 2560; if (n < 4608) return -1; if (n < 5120) return n - 3584; return n - 188; }
    { const int grp = n >> 5, w = n & 31; return ((w >> 2) & 1) * 1024 + grp * 16 + 4 * (w >> 3) + (w & 3); }
}
struct ConvTile { const float* src; bf16_t* dst; int sld, sc, K, n0, k0; };
__device__ __forceinline__ ConvTile conv_decode(PRef p, int t, int n4) {
    constexpr int S0 = 128 * 32 * 4, S1 = S0 + 128 * 16 * 4, S2 = S1 + 2 * 36 * 4, S3 = S2 + 2 * 104 * 4, S4 = S3 + 2 * 16 * 4, S5 = S4 + 2 * 16 * 4, S6 = S5 + 2 * 8 * 2;
    char* ws = p.ws;
    ConvTile c; int nsrc, kind, NT, loc;
    if (t < S0) { loc = t; const int mat = loc / (32 * 4); loc -= mat * 32 * 4; c.src = p.moe_w1 + (size_t)mat * 1024 * 2048; c.dst = (bf16_t*)(ws + OFF_WT_W1) + (size_t)mat * 2048 * 1024; c.sld = 2048; nsrc = 2048; kind = 3; c.K = 1024; NT = 32; }
    else if (t < S1) { loc = t - S0; const int mat = loc / 64; loc -= mat * 64; c.src = p.moe_w2 + (size_t)mat * 1024 * 1024; c.dst = (bf16_t*)(ws + OFF_WT_W2) + (size_t)mat * 1024 * 1024; c.sld = 1024; nsrc = 1024; kind = 0; c.K = 1024; NT = 16; }
    else if (t < S2) { loc = t - S1; const int mat = loc / (36 * 4); loc -= mat * 36 * 4; c.src = p.ev_w_in + (size_t)mat * 1024 * 2064; c.dst = (bf16_t*)(ws + OFF_WT_EVIN) + (size_t)mat * EV_N * 1024; c.sld = 2064; nsrc = 2064; kind = 1; c.K = 1024; NT = 36; }
    else if (t < S3) { loc = t - S2; const int mat = loc / (104 * 4); loc -= mat * 104 * 4; c.src = p.od_w_in + (size_t)mat * 1024 * 6468; c.dst = (bf16_t*)(ws + OFF_WT_ODIN) + (size_t)mat * OD_N * 1024; c.sld = 6468; nsrc = 6468; kind = 2; c.K = 1024; NT = 104; }
    else if (t < S4) { loc = t - S3; const int mat = loc / 64; loc -= mat * 64; c.src = p.ev_w_out + (size_t)mat * 1024 * 1024; c.dst = (bf16_t*)(ws + OFF_WT_EVOUT) + (size_t)mat * 1024 * 1024; c.sld = 1024; nsrc = 1024; kind = 0; c.K = 1024; NT = 16; }
    else if (t < S5) { loc = t - S4; const int mat = loc / 64; loc -= mat * 64; c.src = p.od_w_out + (size_t)mat * 1024 * 1024; c.dst = (bf16_t*)(ws + OFF_WT_ODOUT) + (size_t)mat * 1024 * 1024; c.sld = 1024; nsrc = 1024; kind = 0; c.K = 1024; NT = 16; }
    else if (t < S6) { loc = t - S5; const int mat = loc / 16; loc -= mat * 16; c.src = p.s5_w_glu + (size_t)mat * 512 * 512; c.dst = (bf16_t*)(ws + OFF_WT_GLU) + (size_t)mat * 512 * 512; c.sld = 512; nsrc = 512; kind = 0; c.K = 512; NT = 8; }
    else { loc = t - S6; const int mat = loc / 8; loc -= mat * 8; c.src = p.router_w + (size_t)mat * 1024 * 32; c.dst = (bf16_t*)(ws + OFF_WT_RT) + (size_t)mat * 128 * 1024; c.sld = 32; nsrc = 32; kind = 0; c.K = 1024; NT = 2; }
    const int kt = loc / NT, nt = loc - kt * NT;
    c.n0 = nt * 64; c.k0 = kt * 256;
    c.sc = colmap(kind, c.n0 + n4 * 4, nsrc);
    return c;
}
__device__ __forceinline__ void conv_load(const ConvTile& c, int kp, f32x4 (&v)[8]) {
#pragma unroll
    for (int i = 0; i < 4; ++i)
#pragma unroll
        for (int e = 0; e < 2; ++e) {
            const int k = c.k0 + 2 * (kp + 32 * i) + e;
            v[2 * i + e] = c.sc >= 0 ? *(const f32x4*)(c.src + (size_t)k * c.sld + c.sc) : (f32x4){0.f, 0.f, 0.f, 0.f};
        }
}

__device__ __forceinline__ void conv_phase(PRef p, char* smem, int bid, int nb) {
    char* ws = p.ws;
    constexpr int NTILES = 128 * 32 * 4 + 128 * 16 * 4 + 2 * 36 * 4 + 2 * 104 * 4 + 2 * 16 * 4 + 2 * 16 * 4 + 2 * 8 * 2 + 4 * 2 * 4;
    bf16_t* tile = (bf16_t*)smem;
    const int tid = otid(), n4 = tid & 15, kp = tid >> 4;
    if (bid < NTILES) {
        ConvTile cur = conv_decode(p, bid, n4);
        f32x4 v[8];
        conv_load(cur, kp, v);
        for (int t = bid; t < NTILES; t += nb) {
            const bool more = t + nb < NTILES;
            ConvTile nxt = cur; f32x4 w[8];
            if (more) { nxt = conv_decode(p, t + nb, n4); conv_load(nxt, kp, w); }
#pragma unroll
            for (int i = 0; i < 4; ++i)
#pragma unroll
                for (int j = 0; j < 4; ++j)
                    *(unsigned*)(tile + (n4 * 4 + j) * 258 + 2 * (kp + 32 * i)) = pk2(v[2 * i][j], v[2 * i + 1][j]);
            __syncthreads();
#pragma unroll
            for (int i = 0; i < 4; ++i) {
                const int c = tid + 512 * i, n = c >> 5, kc = c & 31;
                const unsigned* tp = (const unsigned*)(tile + n * 258 + kc * 8);
                u32x4 o; o.x = tp[0]; o.y = tp[1]; o.z = tp[2]; o.w = tp[3];
                *(u32x4*)(cur.dst + (size_t)(cur.n0 + n) * cur.K + cur.k0 + kc * 8) = o;
            }
            __syncthreads();
            if (more) {
                cur = nxt;
#pragma unroll
                for (int i = 0; i < 8; ++i) v[i] = w[i];
            }
        }
    }
    {
        const float* x = p.x; bf16_t* xb = (bf16_t*)(ws + OFF_XB);
        const long nch = (long)T_ * 1024 / 8;
        for (long c = (long)bid * NTHR + otid(); c < nch; c += (long)nb * NTHR) {
            const f32x4 a = *(const f32x4*)(x + c * 8), b = *(const f32x4*)(x + c * 8 + 4);
            u32x4 w; w.x = pk2(a[0], a[1]); w.y = pk2(a[2], a[3]); w.z = pk2(b[0], b[1]); w.w = pk2(b[2], b[3]);
            *(u32x4*)(xb + c * 8) = w;
        }
    }
    if (bid == 0 && otid() < 128) ((int*)(ws + OFF_CNT))[otid()] = 0;
}

__device__ __forceinline__ void s5mat_unit(PRef p, int u, char* smem) {
    float* cre = (float*)smem;
    float* cim = cre + 16 * 65;
    float* bbr = cim + 16 * 65;
    float* bbi = bbr + 1024;
    float* pwr = bbi + 1024;
    float* pwi = pwr + 65 * 65;
    float* zr = pwi + 65 * 65;
    float* zi = zr + 64;
    float* Kd = zi + 64 + 2;
    const int tid = otid();
    const int jg = u >> 2, q = u & 3;
    if (tid < 64) {
        const int pp = tid;
        const float lre = fminf(p.s5_a_re[jg * 64 + pp], -1e-4f), lim = p.s5_a_im[jg * 64 + pp];
        const float dt = expf(p.s5_log_dt[jg]);
        const float xr = lre * dt, th = lim * dt;
        const float mag = expf(xr);
        const float ar = mag * cosf(th), ai = mag * sinf(th);
        const float inv = 1.f / (lre * lre + lim * lim);
        zr[pp] = ((ar - 1.f) * lre + ai * lim) * inv;
        zi[pp] = (ai * lre - (ar - 1.f) * lim) * inv;
        float wr_ = 1.f, wi_ = 0.f;
        for (int d = 0; d <= 64; ++d) {
            pwr[d * 65 + pp] = wr_; pwi[d * 65 + pp] = wi_;
            const float nr = wr_ * ar - wi_ * ai, ni = wr_ * ai + wi_ * ar;
            wr_ = nr; wi_ = ni;
        }
    } else {
        for (int e = tid - 64; e < 1024; e += NTHR - 64) {
            const int n = e >> 6, pp = e & 63;
            cre[n * 65 + pp] = p.s5_c_re[(size_t)jg * 1024 + e];
            cim[n * 65 + pp] = p.s5_c_im[(size_t)jg * 1024 + e];
        }
    }
    __syncthreads();
    for (int e = tid; e < 1024; e += NTHR) {
        const int pp = e >> 4;
        const float br = p.s5_b_re[(size_t)jg * 1024 + e], bi = p.s5_b_im[(size_t)jg * 1024 + e];
        bbr[e] = zr[pp] * br - zi[pp] * bi;
        bbi[e] = zr[pp] * bi + zi[pp] * br;
    }
    __syncthreads();
    if (tid < 256) {
        const int mh = tid & 1, nl = (tid >> 1) & 3, dp = tid >> 3, n = 4 * q + nl;
        float acc0[8], acc1[8];
#pragma unroll
        for (int i = 0; i < 8; ++i) { acc0[i] = 0.f; acc1[i] = 0.f; }
#pragma unroll 2
        for (int pp = 0; pp < 64; ++pp) {
            const float cr = cre[n * 65 + pp], ci = cim[n * 65 + pp];
            const float q0r = pwr[(2 * dp) * 65 + pp], q0i = pwi[(2 * dp) * 65 + pp], q1r = pwr[(2 * dp + 1) * 65 + pp], q1i = pwi[(2 * dp + 1) * 65 + pp];
            const float v0r = cr * q0r - ci * q0i, v0i = cr * q0i + ci * q0r, v1r = cr * q1r - ci * q1i, v1i = cr * q1i + ci * q1r;
            const f32x4 ba = *(const f32x4*)(bbr + pp * 16 + mh * 8), bb_ = *(const f32x4*)(bbr + pp * 16 + mh * 8 + 4);
            const f32x4 ia = *(const f32x4*)(bbi + pp * 16 + mh * 8), ib = *(const f32x4*)(bbi + pp * 16 + mh * 8 + 4);
#pragma unroll
            for (int i = 0; i < 8; ++i) {
                const float br = i < 4 ? ba[i & 3] : bb_[i & 3], bi = i < 4 ? ia[i & 3] : ib[i & 3];
                acc0[i] += v0r * br - v0i * bi;
                acc1[i] += v1r * br - v1i * bi;
            }
        }
        float* k0 = Kd + ((2 * dp) * 4 + nl) * 16 + mh * 8;
        *(f32x4*)(k0) = (f32x4){acc0[0], acc0[1], acc0[2], acc0[3]};
        *(f32x4*)(k0 + 4) = (f32x4){acc0[4], acc0[5], acc0[6], acc0[7]};
        *(f32x4*)(k0 + 64) = (f32x4){acc1[0], acc1[1], acc1[2], acc1[3]};
        *(f32x4*)(k0 + 68) = (f32x4){acc1[4], acc1[5], acc1[6], acc1[7]};
    }
    __syncthreads();
    bf16_t* TH = (bf16_t*)(p.ws + OFF_TH) + (size_t)jg * 1024 * UHW;
    for (int c = tid; c < 256 * 144; c += NTHR) {
        const int rl = c / 144, ch = c - rl * 144;
        const int tau = rl >> 2, nl = rl & 3, n = 4 * q + nl;
        float v[8];
        if (ch < 128) {
            const int s = ch >> 1, m0 = (ch & 1) * 8;
            if (s <= tau) {
                const f32x4 a = *(const f32x4*)(Kd + ((tau - s) * 4 + nl) * 16 + m0), b = *(const f32x4*)(Kd + ((tau - s) * 4 + nl) * 16 + m0 + 4);
#pragma unroll
                for (int i = 0; i < 4; ++i) { v[i] = a[i]; v[4 + i] = b[i]; }
            } else {
#pragma unroll
                for (int i = 0; i < 8; ++i) v[i] = 0.f;
            }
        } else {
            const int p0 = (ch - 128) * 4;
#pragma unroll
            for (int i = 0; i < 4; ++i) {
                const int pp = p0 + i;
                const float cr = cre[n * 65 + pp], ci = cim[n * 65 + pp], qr = pwr[(tau + 1) * 65 + pp], qi = pwi[(tau + 1) * 65 + pp];
                v[2 * i] = cr * qr - ci * qi;
                v[2 * i + 1] = -(cr * qi + ci * qr);
            }
        }
        u32x4 w; w.x = pk2(v[0], v[1]); w.y = pk2(v[2], v[3]); w.z = pk2(v[4], v[5]); w.w = pk2(v[6], v[7]);
        *(u32x4*)(TH + (size_t)(tau * 16 + n) * UHW + ch * 8) = w;
    }
    bf16_t* GM = (bf16_t*)(p.ws + OFF_GM) + (size_t)jg * 128 * 1024;
    for (int c = tid; c < 32 * 128; c += NTHR) {
        const int row = 32 * q + (c >> 7), ch = c & 127;
        const int pp = row >> 1, ri = row & 1;
        const int s = ch >> 1, m0 = (ch & 1) * 8;
        const float qr = pwr[(63 - s) * 65 + pp], qi = pwi[(63 - s) * 65 + pp];
        float v[8];
#pragma unroll
        for (int i = 0; i < 8; ++i) {
            const float br = bbr[pp * 16 + m0 + i], bi = bbi[pp * 16 + m0 + i];
            v[i] = ri == 0 ? (qr * br - qi * bi) : (qr * bi + qi * br);
        }
        u32x4 w; w.x = pk2(v[0], v[1]); w.y = pk2(v[2], v[3]); w.z = pk2(v[4], v[5]); w.w = pk2(v[6], v[7]);
        *(u32x4*)(GM + (size_t)row * 1024 + ch * 8) = w;
    }
    if (q == 0 && tid < 64) {
        float* A64 = (float*)(p.ws + OFF_A64) + (size_t)jg * 128;
        A64[tid * 2] = pwr[64 * 65 + tid];
        A64[tid * 2 + 1] = pwi[64 * 65 + tid];
    }
    __syncthreads();
}

__device__ __forceinline__ void epi_ev_in(PRef p, f32x4 (&acc)[4][2], int row0, int c0, int fr, int fq) {
    char* ws = p.ws;
    bf16_t* PE = (bf16_t*)(ws + OFF_PE); bf16_t* UH = (bf16_t*)(ws + OFF_UH); float* GLR = (float*)(ws + OFF_GLR);
    const int col = c0 + 8 * fq;
#pragma unroll
    for (int m = 0; m < 4; ++m) {
        const int t = row0 + m * 16 + fr;
        u32x4 w; w.x = pk2(acc[m][0][0], acc[m][0][1]); w.y = pk2(acc[m][0][2], acc[m][0][3]); w.z = pk2(acc[m][1][0], acc[m][1][1]); w.w = pk2(acc[m][1][2], acc[m][1][3]);
        if (c0 < 1024) {
            *(u32x4*)(PE + (size_t)t * PE_W + col) = w;
        } else if (c0 < 1536) {
            const int ch = col - 1024, g = ch >> 4, mm = ch & 15;
            *(u32x4*)(UH + ((size_t)(t >> 6) * 32 + g) * UHW + (t & 63) * 16 + mm) = w;
        } else if (col < 1552) {
            *(f32x4*)(GLR + (size_t)t * 16 + (col - 1536)) = acc[m][0];
            *(f32x4*)(GLR + (size_t)t * 16 + (col - 1536) + 4) = acc[m][1];
        }
    }
}
__device__ __forceinline__ void epi_vt(bf16_t* __restrict__ img_row0, f32x4 (&acc)[4][2], int rt0, int c0, int fr, int fq) {
#pragma unroll
    for (int m = 0; m < 4; ++m) {
        u32x4 w; w.x = pk2(acc[m][0][0], acc[m][0][1]); w.y = pk2(acc[m][0][2], acc[m][0][3]); w.z = pk2(acc[m][1][0], acc[m][1][1]); w.w = pk2(acc[m][1][2], acc[m][1][3]);
        *(u32x4*)(img_row0 + (size_t)(rt0 + m * 16 + fr) * L_ + c0 + 8 * fq) = w;
    }
}

__device__ __forceinline__ void gla_decay(PRef p, int j, int t0, int h, float* sB) {
    const float* GLR = (const float*)(p.ws + OFF_GLR);
    const float* w2 = p.gla_w_gate2 + (size_t)j * 16 * 256;
    const float* b2 = p.gla_b_gate2 + (size_t)j * 256;
    const int tid = otid();
    for (int e = tid; e < 4096; e += NTHR) {
        const int tau = e >> 6, d = e & 63;
        float a = b2[h * 64 + d];
#pragma unroll
        for (int r = 0; r < 16; ++r) a += GLR[(size_t)(t0 + tau) * 16 + r] * w2[r * 256 + h * 64 + d];
        const float ls = fminf(a, 0.f) - __logf(1.f + __expf(-fabsf(a)));
        sB[tau * 65 + d] = ls * (1.f / 16.f);
    }
    __syncthreads();
    if (tid < 64) { float run = 0.f; for (int tau = 0; tau < 64; ++tau) { run += sB[tau * 65 + tid]; sB[tau * 65 + tid] = run; } }
    __syncthreads();
}

__device__ __forceinline__ void gla_a_item(PRef p, int j, int item, char* smem) {
    const int h = item & 3, c = (item >> 2) & 255, b = item >> 10;
    const int t0 = b * L_ + c * 64;
    float* sB = (float*)smem;
    bf16_t* AK = (bf16_t*)(smem + 16640);
    const bf16_t* PE = (const bf16_t*)(p.ws + OFF_PE);
    const bf16_t* VTE = (const bf16_t*)(p.ws + OFF_VTE);
    const int tid = otid(), lane = tid & 63, wave = tid >> 6, fr = lane & 15, fq = lane >> 4;
    gla_decay(p, j, t0, h, sB);
    for (int e = tid; e < 4096; e += NTHR) {
        const int tau = e >> 6, d = e & 63;
        const float k = bf2f(PE[(size_t)(t0 + tau) * PE_W + 256 + h * 64 + d]);
        AK[d * 72 + tau] = f2bf(k * __expf(sB[63 * 65 + d] - sB[tau * 65 + d]));
    }
    __syncthreads();
    const int dblk = wave >> 1, vb = (wave & 1) * 64;
    f32x4 acc[4];
#pragma unroll
    for (int n = 0; n < 4; ++n) acc[n] = (f32x4){0.f, 0.f, 0.f, 0.f};
#pragma unroll
    for (int ks = 0; ks < 2; ++ks) {
        const bf16x8 af = *(const bf16x8*)(AK + (dblk * 16 + fr) * 72 + ks * 32 + fq * 8);
#pragma unroll
        for (int n = 0; n < 4; ++n) {
            const int v = vb + n * 16 + fr;
            const bf16x8 bfr = *(const bf16x8*)(VTE + ((size_t)((b * 4 + h) * 128 + v)) * L_ + (c * 64 + ks * 32 + fq * 8));
            acc[n] = __builtin_amdgcn_mfma_f32_16x16x32_bf16(af, bfr, acc[n], 0, 0, 0);
        }
    }
    float* KV = (float*)(p.ws + OFF_KV) + ((size_t)((b * 256 + c) * 4 + h)) * 64 * 128;
#pragma unroll
    for (int n = 0; n < 4; ++n)
#pragma unroll
        for (int r = 0; r < 4; ++r) KV[(dblk * 16 + fq * 4 + r) * 128 + vb + n * 16 + fr] = acc[n][r];
    if (tid < 64) ((float*)(p.ws + OFF_DEC))[((size_t)((b * 256 + c) * 4 + h)) * 64 + tid] = __expf(sB[63 * 65 + tid]);
    __syncthreads();
}

__device__ __forceinline__ void scan_phase(PRef p, int j, int bid) {
    const int gid = bid * NTHR + otid();
    if (gid < 65536) {
        const int v = gid & 127, d = (gid >> 7) & 63, h = (gid >> 13) & 3, b = gid >> 15;
        const float* KV = (const float*)(p.ws + OFF_KV); float* SST = (float*)(p.ws + OFF_SST); const float* DEC = (const float*)(p.ws + OFF_DEC);
        float S = 0.f;
        for (int c0 = 0; c0 < 256; c0 += 8) {
            float kv[8], dc[8];
#pragma unroll
            for (int i = 0; i < 8; ++i) {
                const size_t blk = (size_t)((b * 256 + c0 + i) * 4 + h);
                kv[i] = KV[(blk * 64 + d) * 128 + v]; dc[i] = DEC[blk * 64 + d];
            }
#pragma unroll
            for (int i = 0; i < 8; ++i) {
                const size_t blk = (size_t)((b * 256 + c0 + i) * 4 + h);
                SST[(blk * 64 + d) * 128 + v] = S;
                S = dc[i] * S + kv[i];
            }
        }
    } else if (gid < 65536 + 4096) {
        const int e = gid - 65536, pp = e & 63, g = (e >> 6) & 31, b = e >> 11;
        const float* A64 = (const float*)(p.ws + OFF_A64) + (size_t)(j * 32 + g) * 128;
        const float ar = A64[pp * 2], ai = A64[pp * 2 + 1];
        const float* GB = (const float*)(p.ws + OFF_GBUF); bf16_t* UH = (bf16_t*)(p.ws + OFF_UH);
        float hr = 0.f, hi = 0.f;
        for (int c0 = 0; c0 < 256; c0 += 8) {
            float gr[8], gi[8];
#pragma unroll
            for (int i = 0; i < 8; ++i) { const size_t row = (size_t)(b * 256 + c0 + i) * 32 + g; gr[i] = GB[row * 128 + 2 * pp]; gi[i] = GB[row * 128 + 2 * pp + 1]; }
#pragma unroll
            for (int i = 0; i < 8; ++i) {
                const size_t row = (size_t)(b * 256 + c0 + i) * 32 + g;
                *(unsigned*)(UH + row * UHW + 1024 + 2 * pp) = pk2(hr, hi);
                const float nr = ar * hr - ai * hi + gr[i], ni = ar * hi + ai * hr + gi[i];
                hr = nr; hi = ni;
            }
        }
    }
}

__device__ __forceinline__ void gla_c_item(PRef p, int j, int item, char* smem) {
    const int h = item & 3, c = (item >> 2) & 255, b = item >> 10;
    const int t0 = b * L_ + c * 64;
    float* sB = (float*)smem;
    bf16_t* QT = (bf16_t*)(smem + 16640);
    bf16_t* KT = (bf16_t*)(smem + 16640 + 9216);
    bf16_t* ATT = (bf16_t*)(smem + 16640 + 18432);
    float* OS = (float*)(smem + 16640 + 27648);
    const bf16_t* PE = (const bf16_t*)(p.ws + OFF_PE);
    const bf16_t* VTE = (const bf16_t*)(p.ws + OFF_VTE);
    const int tid = otid(), lane = tid & 63, wave = tid >> 6, fr = lane & 15, fq = lane >> 4;
    gla_decay(p, j, t0, h, sB);
    for (int e = tid; e < 4096; e += NTHR) {
        const int tau = e >> 6, d = e & 63;
        const float bb = sB[tau * 65 + d];
        const float q = bf2f(PE[(size_t)(t0 + tau) * PE_W + h * 64 + d]);
        const float k = bf2f(PE[(size_t)(t0 + tau) * PE_W + 256 + h * 64 + d]);
        QT[tau * 72 + d] = f2bf(q * 0.125f * __expf(bb));
        KT[tau * 72 + d] = f2bf(k * __expf(-bb));
    }
    __syncthreads();
    const int iblk = wave >> 1;
    {
        f32x4 acc[2];
        acc[0] = (f32x4){0.f, 0.f, 0.f, 0.f}; acc[1] = acc[0];
#pragma unroll
        for (int ks = 0; ks < 2; ++ks) {
            const bf16x8 af = *(const bf16x8*)(QT + (iblk * 16 + fr) * 72 + ks * 32 + fq * 8);
#pragma unroll
            for (int n = 0; n < 2; ++n) {
                const int jb = (wave & 1) * 2 + n;
                const bf16x8 bfr = *(const bf16x8*)(KT + (jb * 16 + fr) * 72 + ks * 32 + fq * 8);
                acc[n] = __builtin_amdgcn_mfma_f32_16x16x32_bf16(af, bfr, acc[n], 0, 0, 0);
            }
        }
#pragma unroll
        for (int n = 0; n < 2; ++n) {
            const int jj = ((wave & 1) * 2 + n) * 16 + fr;
#pragma unroll
            for (int r = 0; r < 4; ++r) { const int ii = iblk * 16 + fq * 4 + r; ATT[ii * 72 + jj] = f2bf(jj <= ii ? acc[n][r] : 0.f); }
        }
    }
    __syncthreads();
    {
        const int vb = (wave & 1) * 64;
        const float* SST = (const float*)(p.ws + OFF_SST) + ((size_t)((b * 256 + c) * 4 + h)) * 64 * 128;
        f32x4 acc[4];
#pragma unroll
        for (int n = 0; n < 4; ++n) acc[n] = (f32x4){0.f, 0.f, 0.f, 0.f};
#pragma unroll
        for (int ks = 0; ks < 2; ++ks) {
            const bf16x8 af = *(const bf16x8*)(ATT + (iblk * 16 + fr) * 72 + ks * 32 + fq * 8);
            const bf16x8 aq = *(const bf16x8*)(QT + (iblk * 16 + fr) * 72 + ks * 32 + fq * 8);
#pragma unroll
            for (int n = 0; n < 4; ++n) {
                const int v = vb + n * 16 + fr;
                const bf16x8 bv = *(const bf16x8*)(VTE + ((size_t)((b * 4 + h) * 128 + v)) * L_ + (c * 64 + ks * 32 + fq * 8));
                acc[n] = __builtin_amdgcn_mfma_f32_16x16x32_bf16(af, bv, acc[n], 0, 0, 0);
                bf16x8 bs;
#pragma unroll
                for (int i = 0; i < 8; ++i) bs[i] = (short)f2bf(SST[(ks * 32 + fq * 8 + i) * 128 + v]);
                acc[n] = __builtin_amdgcn_mfma_f32_16x16x32_bf16(aq, bs, acc[n], 0, 0, 0);
            }
        }
#pragma unroll
        for (int n = 0; n < 4; ++n)
#pragma unroll
            for (int r = 0; r < 4; ++r) OS[(iblk * 16 + fq * 4 + r) * 132 + vb + n * 16 + fr] = acc[n][r];
    }
    __syncthreads();
    {
        const int i = tid >> 3, seg = tid & 7;
        float o[16]; float ss = 0.f;
#pragma unroll
        for (int q = 0; q < 16; ++q) { o[q] = OS[i * 132 + seg * 16 + q]; ss += o[q] * o[q]; }
        ss += __shfl_xor(ss, 1, 64); ss += __shfl_xor(ss, 2, 64); ss += __shfl_xor(ss, 4, 64);
        const float rs = rsqrtf(ss * (1.f / 128.f) + LN_EPS);
        const float* ng = p.gla_norm_g + (size_t)j * 128;
        bf16_t* CC = (bf16_t*)(p.ws + OFF_CC);
        const size_t t = (size_t)(t0 + i);
        unsigned w[8];
#pragma unroll
        for (int q = 0; q < 16; q += 2) {
            const int v0 = seg * 16 + q;
            const float r0 = bf2f(PE[t * PE_W + 512 + h * 128 + v0]), r1 = bf2f(PE[t * PE_W + 512 + h * 128 + v0 + 1]);
            const float a0 = o[q] * rs * ng[v0] * (r0 * sigmoidf_(r0)), a1 = o[q + 1] * rs * ng[v0 + 1] * (r1 * sigmoidf_(r1));
            w[q >> 1] = pk2(a0, a1);
        }
        u32x4 w0, w1; w0.x = w[0]; w0.y = w[1]; w0.z = w[2]; w0.w = w[3]; w1.x = w[4]; w1.y = w[5]; w1.z = w[6]; w1.w = w[7];
        *(u32x4*)(CC + t * 1024 + h * 128 + seg * 16) = w0;
        *(u32x4*)(CC + t * 1024 + h * 128 + seg * 16 + 8) = w1;
    }
    __syncthreads();
}

__device__ __forceinline__ void s5_g_phase(PRef p, int j, char* smem, int bid, int nb) {
    const bf16_t* UH = (const bf16_t*)(p.ws + OFF_UH);
    float* GB = (float*)(p.ws + OFF_GBUF);
    for (int t = bid; t < 64; t += nb) {
        const int g = t >> 1, mi = t & 1;
        const bf16_t* Bt = (const bf16_t*)(p.ws + OFF_GM) + (size_t)(j * 32 + g) * 128 * 1024;
        gemm_tile<false>(UH + (size_t)g * UHW, (long)32 * UHW, 0, mi * 256, Bt, 1024, 0, 1024, smem,
            [&](f32x4 (&acc)[4][2], int rt0, int c0, int fr, int fq) {
#pragma unroll
                for (int m = 0; m < 4; ++m)
#pragma unroll
                    for (int n = 0; n < 2; ++n)
#pragma unroll
                        for (int r = 0; r < 4; ++r) {
                            const int row = mi * 256 + rt0 + m * 16 + fq * 4 + r;
                            GB[((size_t)row * 32 + g) * 128 + c0 + n * 16 + fr] = acc[m][n][r];
                        }
            });
    }
}
__device__ __forceinline__ void s5_y_phase(PRef p, int j, char* smem, int bid, int nb) {
    const bf16_t* UH = (const bf16_t*)(p.ws + OFF_UH);
    bf16_t* YA = (bf16_t*)(p.ws + OFF_YA);
    const float* dsk = p.s5_d + (size_t)j * 512;
    XcdSeq sq(32 * 2 * 4, bid, nb);
    for (int t = sq.q; t < sq.qend; t += sq.step) {
        const int g = t >> 3, mi = (t >> 2) & 1, ni = t & 3;
        const bf16_t* Bt = (const bf16_t*)(p.ws + OFF_TH) + (size_t)(j * 32 + g) * 1024 * UHW;
        gemm256_tile<false>(UH + (size_t)g * UHW, (long)32 * UHW, 0, mi * 256, Bt, UHW, ni * 256, UHW, smem,
            [&](f32x4 (&acc)[4][2], int rt0, int c0, int fr, int fq) {
                const int col = c0 + 8 * fq;
                const int tau = col >> 4, nn = col & 15, ch = g * 16 + nn;
                const f32x4 d0 = *(const f32x4*)(dsk + ch), d1 = *(const f32x4*)(dsk + ch + 4);
#pragma unroll
                for (int m = 0; m < 4; ++m) {
                    const int row = mi * 256 + rt0 + m * 16 + fr;
                    const u32x4 uw = *(const u32x4*)(UH + ((size_t)row * 32 + g) * UHW + col);
                    float y[8];
#pragma unroll
                    for (int q = 0; q < 4; ++q) {
                        const unsigned u2 = q == 0 ? uw.x : q == 1 ? uw.y : q == 2 ? uw.z : uw.w;
                        const float u0 = __uint_as_float(u2 << 16), u1 = __uint_as_float(u2 & 0xffff0000u);
                        const float a0 = q < 2 ? acc[m][0][2 * q] : acc[m][1][2 * q - 4], a1 = q < 2 ? acc[m][0][2 * q + 1] : acc[m][1][2 * q - 3];
                        const float dd0 = q < 2 ? d0[2 * q] : d1[2 * q - 4], dd1 = q < 2 ? d0[2 * q + 1] : d1[2 * q - 3];
                        y[2 * q] = gelu_tanh(a0 + dd0 * u0); y[2 * q + 1] = gelu_tanh(a1 + dd1 * u1);
                    }
                    u32x4 w; w.x = pk2(y[0], y[1]); w.y = pk2(y[2], y[3]); w.z = pk2(y[4], y[5]); w.w = pk2(y[6], y[7]);
                    *(u32x4*)(YA + ((size_t)row * 64 + tau) * 512 + ch) = w;
                }
            });
    }
}

template <bool SLOTS, bool NOEPI = false>
__device__ __forceinline__ void ln_phase(PRef p, const float* xin, const float* addb, const float* g, const float* bta, float* xout, bf16_t* xb, int bid, int nb) {
    const int lane = otid() & 63, wave = otid() >> 6;
    for (int t = bid * 8 + wave; t < T_; t += nb * 8) {
        f32x4 v[4];
        float s = 0.f;
#pragma unroll
        for (int i = 0; i < 4; ++i) {
            const int c = i * 256 + lane * 4;
            f32x4 a = *(const f32x4*)(xin + (size_t)t * 1024 + c);
            f32x4 m;
            if (SLOTS) {
                const bf16_t* sl = (const bf16_t*)addb;
                m = (f32x4){0.f, 0.f, 0.f, 0.f};
#pragma unroll
                for (int k = 0; k < 4; ++k) {
                    const u32x2 w = *(const u32x2*)(sl + ((size_t)t * 4 + k) * 1024 + c);
                    m[0] += __uint_as_float(w.x << 16); m[1] += __uint_as_float(w.x & 0xffff0000u); m[2] += __uint_as_float(w.y << 16); m[3] += __uint_as_float(w.y & 0xffff0000u);
                }
            } else m = *(const f32x4*)(addb + (size_t)t * 1024 + c);
            v[i] = a * ALPHA + m;
            s += v[i][0] + v[i][1] + v[i][2] + v[i][3];
        }
        const float mu = wave_sum(s) * (1.f / 1024.f);
        float q = 0.f;
#pragma unroll
        for (int i = 0; i < 4; ++i) { v[i] -= mu; q += v[i][0] * v[i][0] + v[i][1] * v[i][1] + v[i][2] * v[i][2] + v[i][3] * v[i][3]; }
        const float rs = rsqrtf(wave_sum(q) * (1.f / 1024.f) + LN_EPS);
#pragma unroll
        for (int i = 0; i < 4; ++i) {
            const int c = i * 256 + lane * 4;
            const f32x4 gg = *(const f32x4*)(g + c), bb = *(const f32x4*)(bta + c);
            const f32x4 o = v[i] * rs * gg + bb;
            if (!NOEPI) *(f32x4*)(xout + (size_t)t * 1024 + c) = o;
            if (xb && !NOEPI) { u32x2 w; w.x = pk2(o[0], o[1]); w.y = pk2(o[2], o[3]); *(u32x2*)(xb + (size_t)t * 1024 + c) = w; }
        }
    }
}

constexpr int RT_STRIDE = 36;
constexpr int RT_SCR_OFF = 1024 * RT_STRIDE * 4;
template <bool NOEPI = false>
__device__ __forceinline__ void ln1_router_phase(PRef p, int layer, const float* xin, char* smem, int bid, int nb) {
    float* wl = (float*)smem;
    const int tid = otid(), lane = tid & 63, wave = tid >> 6;
    float* lgs = (float*)(smem + RT_SCR_OFF + wave * 640);
    int* pick = (int*)(lgs + 32);
    float* pgate = (float*)(pick + 64);
    {
        const float* rw = p.router_w + (size_t)layer * 1024 * 32;
        for (int e = tid; e < 32768; e += NTHR) {
            const int k = e >> 5, ex = e & 31, rem = k & 255;
            wl[((k & ~255) + (rem & 3) * 64 + (rem >> 2)) * RT_STRIDE + ex] = rw[e];
        }
    }
    __syncthreads();
    const bf16_t* addb = (const bf16_t*)(p.ws + OFF_MIX);
    const float* g = p.ln1_g + (size_t)layer * 1024; const float* bta = p.ln1_b + (size_t)layer * 1024;
    float* xout = (float*)(p.ws + OFF_XR); bf16_t* xb = (bf16_t*)(p.ws + OFF_XB);
    int* cnt = (int*)(p.ws + OFF_CNT) + layer * 32;
    int* LIST = (int*)(p.ws + OFF_LIST);
    float* GATE = (float*)(p.ws + OFF_GATE);
    const float rbias = p.router_b[(size_t)layer * 32 + (lane >> 1)];
    const int rstep = nb * 8;
    f32x4 xa[4], xm[4];
    {
        const int t0 = bid * 8 + wave;
        if (t0 < T_) {
#pragma unroll
            for (int i = 0; i < 4; ++i) { const int c = i * 256 + lane * 4; xa[i] = *(const f32x4*)(xin + (size_t)t0 * 1024 + c); { const u32x2 mw = *(const u32x2*)(addb + (size_t)t0 * 1024 + c); xm[i] = (f32x4){__uint_as_float(mw.x << 16), __uint_as_float(mw.x & 0xffff0000u), __uint_as_float(mw.y << 16), __uint_as_float(mw.y & 0xffff0000u)}; } }
        }
    }
    for (int tb = bid * 8 + wave; tb < T_; tb += rstep * 16) {
        int nrow = 0;
#pragma unroll 1
        for (int t = tb; t < T_ && nrow < 16; t += rstep, ++nrow) {
            f32x4 v[4];
            float s = 0.f;
#pragma unroll
            for (int i = 0; i < 4; ++i) { v[i] = xa[i] * ALPHA + xm[i]; s += v[i][0] + v[i][1] + v[i][2] + v[i][3]; }
            if (t + rstep < T_) {
#pragma unroll
                for (int i = 0; i < 4; ++i) { const int c = i * 256 + lane * 4; xa[i] = *(const f32x4*)(xin + (size_t)(t + rstep) * 1024 + c); { const u32x2 mw = *(const u32x2*)(addb + (size_t)(t + rstep) * 1024 + c); xm[i] = (f32x4){__uint_as_float(mw.x << 16), __uint_as_float(mw.x & 0xffff0000u), __uint_as_float(mw.y << 16), __uint_as_float(mw.y & 0xffff0000u)}; } }
            }
            const float mu = wave_sum(s) * (1.f / 1024.f);
            float q = 0.f;
#pragma unroll
            for (int i = 0; i < 4; ++i) { v[i] -= mu; q += v[i][0] * v[i][0] + v[i][1] * v[i][1] + v[i][2] * v[i][2] + v[i][3] * v[i][3]; }
            const float rs = rsqrtf(wave_sum(q) * (1.f / 1024.f) + LN_EPS);
#pragma unroll
            for (int i = 0; i < 4; ++i) {
                const int c = i * 256 + lane * 4;
                const f32x4 gg = *(const f32x4*)(g + c), bb = *(const f32x4*)(bta + c);
                v[i] = v[i] * rs * gg + bb;
                if (!NOEPI) { *(f32x4*)(xout + (size_t)t * 1024 + c) = v[i];
                u32x2 w; w.x = pk2(v[i][0], v[i][1]); w.y = pk2(v[i][2], v[i][3]); *(u32x2*)(xb + (size_t)t * 1024 + c) = w; }
            }
            f32x4 acc[8];
#pragma unroll
            for (int e = 0; e < 8; ++e) acc[e] = (f32x4){0.f, 0.f, 0.f, 0.f};
#pragma unroll
            for (int i = 0; i < 4; ++i)
#pragma unroll
                for (int j = 0; j < 4; ++j) {
                    const f32x4* wr_ = (const f32x4*)(wl + (i * 256 + j * 64 + lane) * RT_STRIDE);
                    const float xv = v[i][j];
#pragma unroll
                    for (int e = 0; e < 8; ++e) acc[e] += wr_[e] * xv;
                }
            float k16[16], k8[8], k4[4], k2[2];
#pragma unroll
            for (int a = 0; a < 16; ++a) { auto r = __builtin_amdgcn_permlane32_swap(__float_as_uint(acc[a >> 2][a & 3]), __float_as_uint(acc[(a + 16) >> 2][a & 3]), false, false); k16[a] = __uint_as_float(r[0]) + __uint_as_float(r[1]); }
#pragma unroll
            for (int a = 0; a < 8; ++a) { auto r = __builtin_amdgcn_permlane16_swap(__float_as_uint(k16[a]), __float_as_uint(k16[a + 8]), false, false); k8[a] = __uint_as_float(r[0]) + __uint_as_float(r[1]); }
            { const bool hb = lane & 8;
#pragma unroll
              for (int a = 0; a < 4; ++a) { const float mine = hb ? k8[a + 4] : k8[a], send = hb ? k8[a] : k8[a + 4]; k4[a] = mine + dppf<DPP_ROR8>(send); } }
            { const bool hb = lane & 4;
#pragma unroll
              for (int a = 0; a < 2; ++a) { const float mine = hb ? k4[a + 2] : k4[a], send = hb ? k4[a] : k4[a + 2]; k2[a] = mine + dppf<DPP_HMIR>(send); } }
            float lg;
            { const bool hb = lane & 2; const float mine = hb ? k2[1] : k2[0], send = hb ? k2[0] : k2[1]; lg = mine + dppf<DPP_X2>(send); }
            lg += dppf<DPP_X1>(lg);
            lg += rbias;
            float cand = (lane & 1) ? -INFINITY : lg;
            float tv[4]; int te[4];
#pragma unroll
            for (int r = 0; r < 4; ++r) {
                const float mxv = wave_max(cand);
                const unsigned long long bal = __builtin_amdgcn_ballot_w64(cand == mxv);
                const int first = __builtin_ctzll(bal);
                tv[r] = mxv; te[r] = first >> 1;
                if (lane == first) cand = -INFINITY;
            }
            if (lane == 0) {
                const float e1 = __expf(tv[1] - tv[0]), e2 = __expf(tv[2] - tv[0]), e3 = __expf(tv[3] - tv[0]);
                const float inv = 1.f / (1.f + e1 + e2 + e3);
                pick[nrow * 4 + 0] = te[0]; pick[nrow * 4 + 1] = te[1]; pick[nrow * 4 + 2] = te[2]; pick[nrow * 4 + 3] = te[3];
                pgate[nrow * 4 + 0] = inv; pgate[nrow * 4 + 1] = e1 * inv; pgate[nrow * 4 + 2] = e2 * inv; pgate[nrow * 4 + 3] = e3 * inv;
            }
        }
        if ((lane >> 2) < nrow && (!NOEPI || pgate[lane] < -1.f)) {
            const int t = tb + (lane >> 2) * rstep, ex = pick[lane], pair = t * 4 + (lane & 3);
            const int pos = atomicAdd(&cnt[ex], 1);
            LIST[(size_t)ex * LISTCAP + pos] = pair;
            GATE[pair] = pgate[lane];
        }
    }
}

__device__ __forceinline__ void topk_phase(PRef p, int layer, int bid, int nb) {
    const float* LG = (const float*)(p.ws + OFF_LOGIT);
    int* cnt = (int*)(p.ws + OFF_CNT) + layer * 32;
    int* LIST = (int*)(p.ws + OFF_LIST);
    float* GATE = (float*)(p.ws + OFF_GATE);
    for (int t = bid * NTHR + otid(); t < T_; t += nb * NTHR) {
        float v0 = -INFINITY, v1 = -INFINITY, v2 = -INFINITY, v3 = -INFINITY; int i0 = 0, i1 = 0, i2 = 0, i3 = 0;
#pragma unroll
        for (int q = 0; q < 8; ++q) {
            const f32x4 l4 = *(const f32x4*)(LG + (size_t)t * 32 + q * 4);
#pragma unroll
            for (int r = 0; r < 4; ++r) {
                const float v = l4[r]; const int e = q * 4 + r;
                if (v > v0) { v3 = v2; i3 = i2; v2 = v1; i2 = i1; v1 = v0; i1 = i0; v0 = v; i0 = e; }
                else if (v > v1) { v3 = v2; i3 = i2; v2 = v1; i2 = i1; v1 = v; i1 = e; }
                else if (v > v2) { v3 = v2; i3 = i2; v2 = v; i2 = e; }
                else if (v > v3) { v3 = v; i3 = e; }
            }
        }
        const float e1 = __expf(v1 - v0), e2 = __expf(v2 - v0), e3 = __expf(v3 - v0);
        const float inv = 1.f / (1.f + e1 + e2 + e3);
        int pos;
        pos = atomicAdd(&cnt[i0], 1); LIST[(size_t)i0 * LISTCAP + pos] = t * 4 + 0; GATE[t * 4 + 0] = inv;
        pos = atomicAdd(&cnt[i1], 1); LIST[(size_t)i1 * LISTCAP + pos] = t * 4 + 1; GATE[t * 4 + 1] = e1 * inv;
        pos = atomicAdd(&cnt[i2], 1); LIST[(size_t)i2 * LISTCAP + pos] = t * 4 + 2; GATE[t * 4 + 2] = e2 * inv;
        pos = atomicAdd(&cnt[i3], 1); LIST[(size_t)i3 * LISTCAP + pos] = t * 4 + 3; GATE[t * 4 + 3] = e3 * inv;
    }
}

template <int WHICH, bool NOEPI = false>
__device__ __forceinline__ void moe_gemm_phase(PRef p, int layer, char* smem, int bid, int nb) {
    const int* cnt = (const int*)(p.ws + OFF_CNT) + layer * 32;
    const int* LIST = (const int*)(p.ws + OFF_LIST);
    constexpr int NTN = WHICH == 1 ? 8 : 4;
    int total = 0;
    for (int i = 0; i < 32; ++i) total += ((cnt[i] + 255) >> 8) * NTN;
    XcdSeq sq(total, bid, nb);
    int e = 0, base = 0, ce = cnt[0], mt = (ce + 255) >> 8;
    auto src = [&](int i, G8Desc& d) -> bool {
        const int t = sq.q + i * sq.step;
        if (t >= sq.qend) return false;
        while (e < 32 && t >= base + mt * NTN) { base += mt * NTN; ++e; if (e < 32) { ce = cnt[e]; mt = (ce + 255) >> 8; } }
        if (e >= 32) return false;
        int mi, ni;
        { const int loc = t - base, pf = mt >> 2, full = pf * 4 * NTN;
          if (loc < full) { const int pn = loc / (4 * NTN), r = loc - pn * 4 * NTN; ni = r >> 2; mi = pn * 4 + (r & 3); }
          else { const int ph = mt - pf * 4, r = loc - full; ni = r / ph; mi = pf * 4 + (r - ni * ph); } }
        d.m0 = 0; d.n0 = ni * 256; d.list = LIST + (size_t)e * LISTCAP + mi * 256; d.count = ce - mi * 256; d.u0 = e; d.ldb = 1024;
        if (WHICH == 1) { d.A = (const bf16_t*)(p.ws + OFF_XB); d.Bt = (const bf16_t*)(p.ws + OFF_WT_W1) + (size_t)(layer * 32 + e) * 2048 * 1024; }
        else { d.A = (const bf16_t*)(p.ws + OFF_ACT); d.Bt = (const bf16_t*)(p.ws + OFF_WT_W2) + (size_t)(layer * 32 + e) * 1024 * 1024; }
        return true; };
    if (WHICH == 1) {
        bf16_t* ACT = (bf16_t*)(p.ws + OFF_ACT);
        gemm256_stream<true, 2>(src, 1024, 1024, smem,
            [&](int, int e_, f32x4 (&acc)[4][2], int rt0, int c0, int fr, int fq, const int* sRow) {
                const float* b1 = p.moe_b1 + (size_t)(layer * 32 + e_) * 2048;
                const int gcol = (c0 >> 5) * 16 + 4 * fq;
                const f32x4 bg = *(const f32x4*)(b1 + gcol), bl = *(const f32x4*)(b1 + 1024 + gcol);
#pragma unroll
                for (int m = 0; m < 4; ++m) {
                    const int pair = NOEPI ? -1 : sRow[rt0 + m * 16 + fr];
                    if (pair >= 0) {
                        float a[4];
#pragma unroll
                        for (int r = 0; r < 4; ++r) {
                            const float gl = fminf(acc[m][0][r] + bg[r], 7.f);
                            const float li = fminf(fmaxf(acc[m][1][r] + bl[r], -7.f), 7.f);
                            a[r] = gl * sigmoidf_(1.702f * gl) * (li + 1.f);
                        }
                        u32x2 w; w.x = pk2(a[0], a[1]); w.y = pk2(a[2], a[3]);
                        *(u32x2*)(ACT + (size_t)pair * 1024 + gcol) = w;
                    }
                }
            });
    } else {
        const float* GATE = (const float*)(p.ws + OFF_GATE);
        bf16_t* SLOT = (bf16_t*)(p.ws + OFF_SLOT);
        gemm256_stream<true, 0>(src, 1024, 1024, smem,
            [&](int, int e_, f32x4 (&acc)[4][2], int rt0, int c0, int fr, int fq, const int* sRow) {
                const float* b2 = p.moe_b2 + (size_t)(layer * 32 + e_) * 1024;
                const int col = c0 + 8 * fq;
                const f32x4 b20 = *(const f32x4*)(b2 + col), b21 = *(const f32x4*)(b2 + col + 4);
#pragma unroll
                for (int m = 0; m < 4; ++m) {
                    const int pair = NOEPI ? -1 : sRow[rt0 + m * 16 + fr];
                    if (pair >= 0) {
                        const float gt = GATE[pair];
                        const f32x4 y0 = (acc[m][0] + b20) * gt, y1 = (acc[m][1] + b21) * gt;
                        u32x4 w; w.x = pk2(y0[0], y0[1]); w.y = pk2(y0[2], y0[3]); w.z = pk2(y1[0], y1[1]); w.w = pk2(y1[2], y1[3]);
                        *(u32x4*)(SLOT + (size_t)pair * 1024 + col) = w;
                    }
                }
            });
    }
}

__device__ __forceinline__ void epi_od_in(PRef p, f32x4 (&acc)[4][2], int row0, int c0, int fr, int fq) {
    char* ws = p.ws;
    bf16_t* PO = (bf16_t*)(ws + OFF_PO); float* WI = (float*)(ws + OFF_WI);
    const int col = c0 + 8 * fq;
#pragma unroll
    for (int m = 0; m < 4; ++m) {
        const int t = row0 + m * 16 + fr;
        if (c0 < OD_WI) {
            u32x4 w; w.x = pk2(acc[m][0][0], acc[m][0][1]); w.y = pk2(acc[m][0][2], acc[m][0][3]); w.z = pk2(acc[m][1][0], acc[m][1][1]); w.w = pk2(acc[m][1][2], acc[m][1][3]);
            *(u32x4*)(PO + (size_t)t * OD_P + col) = w;
        } else if (col == OD_WI) {
            *(f32x4*)(WI + (size_t)t * 4) = acc[m][0];
        }
    }
}

__device__ __forceinline__ void idx_scores(const char* __restrict__ ktile, int kbase, const bf16x8 (&qf)[4][4], const float (&wi)[4], int lane, float (&sc)[16]) {
    const int r = lane & 31, h2 = lane >> 5;
    const char* kp = ktile + (kbase + r) * 144 + h2 * 16;
    bf16x8 kf[4];
#pragma unroll
    for (int s = 0; s < 4; ++s) kf[s] = *(const bf16x8*)(kp + s * 32);
#pragma unroll
    for (int i = 0; i < 16; ++i) sc[i] = 0.f;
#pragma unroll
    for (int hd = 0; hd < 4; ++hd) {
        f32x16 a;
#pragma unroll
        for (int i = 0; i < 16; ++i) a[i] = 0.f;
#pragma unroll
        for (int s = 0; s < 4; ++s) a = __builtin_amdgcn_mfma_f32_32x32x16_bf16(kf[s], qf[hd][s], a, 0, 0, 0);
#pragma unroll
        for (int i = 0; i < 16; ++i) { const int ai = __float_as_int(a[i]); sc[i] += wi[hd] * __int_as_float(ai > 0 ? ai : 0); }
    }
}
__device__ __forceinline__ unsigned ord_key(float s) {
    const unsigned u = __float_as_uint(s);
    return u ^ ((unsigned)((int)u >> 31) | 0x80000000u);
}

constexpr int SEL_KT = 128 * 144;
__device__ __forceinline__ void dsa_select_item(PRef p, int b, int qb, char* smem) {
    unsigned* hist = (unsigned*)smem;
    unsigned* pref = (unsigned*)(smem + 66048);
    int* krem = (int*)(smem + 66048 + 256);
    unsigned* GW = (unsigned*)(smem + 66048 + 512);
    unsigned* EW = (unsigned*)(smem + 66048 + 512 + 2048);
    char* kbuf = smem + 71680;
    const bf16_t* PO = (const bf16_t*)(p.ws + OFF_PO);
    const float* WI = (const float*)(p.ws + OFF_WI);
    unsigned long long* BMT = (unsigned long long*)(p.ws + OFF_BM);
    const int tid = otid(), lane = tid & 63, wave = tid >> 6, kw = wave >> 1, qw = wave & 1, h2 = lane >> 5;
    const int p0 = qb * 64;
    const int ql = qw * 32 + (lane & 31);
    const int qpos = p0 + ql;
    const size_t tq = (size_t)b * L_ + qpos;
    const int nkt = (p0 + 64 + 127) >> 7;
    bf16x8 qf[4][4]; float wi[4];
#pragma unroll
    for (int hd = 0; hd < 4; ++hd) {
        wi[hd] = WI[tq * 4 + hd];
#pragma unroll
        for (int s = 0; s < 4; ++s) qf[hd][s] = *(const bf16x8*)(PO + tq * OD_P + OD_QI + hd * 64 + s * 16 + h2 * 8);
    }
    const int srow = tid >> 3, sch = tid & 7;
    const bf16_t* ksrc = PO + ((size_t)b * L_ + srow) * OD_P + OD_KI + sch * 8;
    char* kdst = kbuf + srow * 144 + sch * 16;
    for (int e = tid; e < 64 * 257; e += NTHR) hist[e] = 0u;
    if (tid < 64) { pref[tid] = 0u; krem[tid] = 256; }
    __syncthreads();
    const bool selall = qpos < 256;
    const int npass = (p0 + 63 >= 256) ? 3 : 0;
    for (int pass = 0; pass <= npass; ++pass) {
        const bool maskpass = pass == npass;
        const int sh = 24 - 8 * pass;
        const unsigned mypref = pref[ql];
        int ceq = 0;
        const int rsel = tid < 64 ? krem[tid] : 0;
        const int npair = (nkt + 1) >> 1;
        u32x4 r0, r1, r2 = (u32x4){0u, 0u, 0u, 0u}, r3 = r2;
        r0 = *(const u32x4*)ksrc; r1 = *(const u32x4*)(ksrc + (size_t)64 * OD_P);
        if (nkt > 1) { r2 = *(const u32x4*)(ksrc + (size_t)128 * OD_P); r3 = *(const u32x4*)(ksrc + (size_t)192 * OD_P); }
        *(u32x4*)kdst = r0; *(u32x4*)(kdst + 64 * 144) = r1; *(u32x4*)(kdst + SEL_KT) = r2; *(u32x4*)(kdst + SEL_KT + 64 * 144) = r3;
        __syncthreads();
        for (int kp = 0; kp < npair; ++kp) {
            const bool more = kp + 1 < npair;
            const bool more2 = 2 * kp + 3 < nkt;
            if (more) {
                r0 = *(const u32x4*)(ksrc + (size_t)(2 * kp + 2) * 128 * OD_P); r1 = *(const u32x4*)(ksrc + (size_t)((2 * kp + 2) * 128 + 64) * OD_P);
                if (more2) { r2 = *(const u32x4*)(ksrc + (size_t)(2 * kp + 3) * 128 * OD_P); r3 = *(const u32x4*)(ksrc + (size_t)((2 * kp + 3) * 128 + 64) * OD_P); }
            }
            const char* kcur = kbuf + (kp & 1) * 2 * SEL_KT;
            const bool two = 2 * kp + 1 < nkt;
            unsigned gwp[2] = {0u, 0u}, ewp[2] = {0u, 0u};
#pragma unroll
            for (int tt = 0; tt < 2; ++tt) {
                if (tt == 1 && !two) break;
                const int kt = 2 * kp + tt;
                float sc[16];
                idx_scores(kcur + tt * SEL_KT, kw * 32, qf, wi, lane, sc);
                const int keybase = kt * 128 + kw * 32;
                const bool diag = kt == nkt - 1;
                if (!maskpass) {
                    if (pass == 0 && !diag && p0 >= 256) {
#pragma unroll
                        for (int i = 0; i < 16; ++i) atomicAdd(&hist[ql * 257 + (ord_key(sc[i]) >> 24)], 1u);
                    } else {
#pragma unroll
                        for (int i = 0; i < 16; ++i) {
                            const int key = keybase + (i & 3) + 8 * (i >> 2) + 4 * h2;
                            const unsigned k32 = ord_key(sc[i]);
                            const bool match = pass == 0 ? true : ((k32 >> (sh + 8)) == mypref);
                            const bool valid = diag ? key <= qpos : true;
                            if (valid && !selall && match) atomicAdd(&hist[ql * 257 + ((k32 >> sh) & 255u)], 1u);
                        }
                    }
                } else {
                    unsigned gw = 0u, ew = 0u;
#pragma unroll
                    for (int i = 0; i < 16; ++i) {
                        const int ko = (i & 3) + 8 * (i >> 2) + 4 * h2;
                        const int key = keybase + ko;
                        const unsigned k24 = ord_key(sc[i]) >> 8;
                        const bool valid = diag ? key <= qpos : true;
                        const bool g = valid && (selall || k24 > mypref);
                        const bool e = valid && !selall && k24 == mypref;
                        gw |= (g ? 1u : 0u) << ko; ew |= (e ? 1u : 0u) << ko;
                    }
                    gwp[tt] = xor32_or(gw); ewp[tt] = xor32_or(ew);
                }
            }
            if (maskpass && h2 == 0) { GW[ql * 8 + kw] = gwp[0]; EW[ql * 8 + kw] = ewp[0]; GW[ql * 8 + 4 + kw] = gwp[1]; EW[ql * 8 + 4 + kw] = ewp[1]; }
            if (more) {
                char* nd = kdst + ((kp + 1) & 1) * 2 * SEL_KT;
                *(u32x4*)nd = r0; *(u32x4*)(nd + 64 * 144) = r1;
                if (more2) { *(u32x4*)(nd + SEL_KT) = r2; *(u32x4*)(nd + SEL_KT + 64 * 144) = r3; }
            }
            __syncthreads();
            if (maskpass) {
                if (tid < 64) {
#pragma unroll
                    for (int tt = 0; tt < 2; ++tt) {
                        if (tt == 1 && !two) break;
                        const int kt = 2 * kp + tt;
                        unsigned g4[4], e4[4];
#pragma unroll
                        for (int w = 0; w < 4; ++w) { g4[w] = GW[tid * 8 + tt * 4 + w]; e4[w] = EW[tid * 8 + tt * 4 + w]; }
                        int need = rsel - ceq; if (need < 0) need = 0;
#pragma unroll
                        for (int w = 0; w < 4; ++w) {
                            const int pc = __popc(e4[w]);
                            ceq += pc;
                            if (need >= pc) need -= pc;
                            else { unsigned m = e4[w], kept = 0u; for (int k = 0; k < need; ++k) { const unsigned low = m & (0u - m); kept |= low; m ^= low; } e4[w] = kept; need = 0; }
                            g4[w] |= e4[w];
                        }
                        BMT[((size_t)(b * 256 + 2 * kt)) * L_ + p0 + tid] = (unsigned long long)g4[0] | ((unsigned long long)g4[1] << 32);
                        BMT[((size_t)(b * 256 + 2 * kt + 1)) * L_ + p0 + tid] = (unsigned long long)g4[2] | ((unsigned long long)g4[3] << 32);
                    }
                }
                __syncthreads();
            }
        }
        if (!maskpass) {
            const int q = tid >> 3, part = tid & 7;
            unsigned c32[32]; unsigned tot = 0u;
#pragma unroll
            for (int i = 0; i < 32; ++i) { c32[i] = hist[q * 257 + part * 32 + i]; tot += c32[i]; }
            unsigned above = 0u;
#pragma unroll
            for (int d = 1; d < 8; ++d) { const unsigned o = __shfl(tot, (lane & ~7) + ((part + d) & 7), 64); if (part + d < 8) above += o; }
            const unsigned need = (unsigned)krem[q];
            __syncthreads();
            if ((p0 + q) >= 256 && above < need && above + tot >= need) {
                unsigned cum = above; int dg = 31;
#pragma unroll
                for (int i = 31; i >= 0; --i) { if (i == dg) { if (cum + c32[i] >= need) {   } else { cum += c32[i]; dg = i - 1; } } }
                pref[q] = (pref[q] << 8) | (unsigned)(part * 32 + dg);
                krem[q] = (int)(need - cum);
            }
            for (int e = tid; e < 64 * 257; e += NTHR) hist[e] = 0u;
            __syncthreads();
        }
    }
}

template <int MODE, int NQT>
__device__ __forceinline__ void attn_wave(PRef p, int b, int head, int qcol, int kcol, const bf16_t* __restrict__ VT, int voff,
                                          int i0, int sh  , int rho, int kt_lo, int kt_hi, int grp) {
    const bf16_t* PO = (const bf16_t*)(p.ws + OFF_PO);
    const unsigned* BM32 = (const unsigned*)(p.ws + OFF_BM);
    const int lane = otid() & 63, r = lane & 31, h2 = lane >> 5;
    const int pr = (r & 0x13) | ((r & 4) << 1) | ((r & 8) >> 1);
    const float SC = 0.125f * 1.4426950408889634f;
    bf16x8 qf[NQT][4]; size_t tq[NQT]; int qi[NQT];
#pragma unroll
    for (int qt = 0; qt < NQT; ++qt) {
        qi[qt] = i0 + qt * 32 + r;
        tq[qt] = (size_t)b * L_ + ((size_t)qi[qt] << sh) + rho;
#pragma unroll
        for (int s = 0; s < 4; ++s) qf[qt][s] = *(const bf16x8*)(PO + tq[qt] * OD_P + qcol + head * 64 + s * 16 + h2 * 8);
    }
    f32x16 oacc[NQT][2];
#pragma unroll
    for (int a = 0; a < NQT; ++a)
#pragma unroll
        for (int c = 0; c < 2; ++c)
#pragma unroll
            for (int i = 0; i < 16; ++i) oacc[a][c][i] = 0.f;
    float mrun[NQT], lrun[NQT];
#pragma unroll
    for (int a = 0; a < NQT; ++a) { mrun[a] = -64.f; lrun[a] = 0.f; }
    bf16x8 kf[4]; unsigned mw[NQT];
    auto load_k = [&](int kt, bf16x8 (&k_)[4], unsigned (&m_)[NQT]) {
        const size_t krow = (size_t)b * L_ + ((size_t)(kt * 32 + pr) << sh) + rho;
#pragma unroll
        for (int s = 0; s < 4; ++s) k_[s] = *(const bf16x8*)(PO + krow * OD_P + kcol + head * 64 + s * 16 + h2 * 8);
#pragma unroll
        for (int a = 0; a < NQT; ++a) m_[a] = MODE == 0 ? BM32[tq[a] * 512 + kt] : 0u;
    };
    load_k(kt_lo, kf, mw);
#pragma unroll 1
    for (int kt = kt_lo; kt <= kt_hi; ++kt) {
        bf16x8 vf[2][2];
#pragma unroll
        for (int db = 0; db < 2; ++db)
#pragma unroll
            for (int s2 = 0; s2 < 2; ++s2) vf[db][s2] = *(const bf16x8*)(VT + (size_t)(db * 32 + r) * L_ + voff + kt * 32 + s2 * 16 + h2 * 8);
        bf16x8 kn[4]; unsigned mn[NQT];
#pragma unroll
        for (int a = 0; a < NQT; ++a) mn[a] = 0u;
        if (kt < kt_hi) load_k(kt + 1, kn, mn);
#pragma unroll
        for (int qt = 0; qt < NQT; ++qt) {
            f32x16 s;
#pragma unroll
            for (int i = 0; i < 16; ++i) s[i] = 0.f;
#pragma unroll
            for (int ks = 0; ks < 4; ++ks) s = __builtin_amdgcn_mfma_f32_32x32x16_bf16(kf[ks], qf[qt][ks], s, 0, 0, 0);
            unsigned wsel;
            if (MODE == 0) wsel = mw[qt];
            else {
                const int hi = qi[qt] - kt * 32, lo = hi - 128;
                const unsigned mh = hi < 0 ? 0u : (hi >= 31 ? 0xffffffffu : ((2u << hi) - 1u)), ml = lo <= 0 ? 0xffffffffu : (lo > 31 ? 0u : ~((1u << lo) - 1u));
                wsel = mh & ml;
            }
#pragma unroll
            for (int i = 0; i < 16; ++i) s[i] = __builtin_fmaf(s[i], SC, -mrun[qt]);
            float mx = fmaxf(fmaxf(s[0], s[1]), fmaxf(s[2], s[3]));
#pragma unroll
            for (int i = 4; i < 16; i += 2) mx = fmaxf(mx, fmaxf(s[i], s[i + 1]));
            mx = xor32_max(mx);
            if (__builtin_amdgcn_ballot_w64(mx > 0.f) != 0ull) {
                const float dlt = fmaxf(mx, 0.f);
                const float corr = __builtin_amdgcn_exp2f(-dlt);
                mrun[qt] += dlt; lrun[qt] *= corr;
#pragma unroll
                for (int db = 0; db < 2; ++db)
#pragma unroll
                    for (int i = 0; i < 16; ++i) oacc[qt][db][i] *= corr;
#pragma unroll
                for (int i = 0; i < 16; ++i) s[i] -= dlt;
            }
            float ps = 0.f;
            const int mws = (int)(wsel >> (8 * h2));
#define DA_P(i, KO) { const float e = __builtin_amdgcn_exp2f(s[i]); s[i] = __uint_as_float(__float_as_uint(e) & bitmask32<KO>(mws)); ps += s[i]; }
            DA_P(0, 0) DA_P(1, 1) DA_P(2, 2) DA_P(3, 3) DA_P(4, 4) DA_P(5, 5) DA_P(6, 6) DA_P(7, 7)
            DA_P(8, 16) DA_P(9, 17) DA_P(10, 18) DA_P(11, 19) DA_P(12, 20) DA_P(13, 21) DA_P(14, 22) DA_P(15, 23)
#undef DA_P
            lrun[qt] += ps;
#pragma unroll
            for (int s2 = 0; s2 < 2; ++s2) {
                u32x4 pw; pw.x = pk2(s[8 * s2], s[8 * s2 + 1]); pw.y = pk2(s[8 * s2 + 2], s[8 * s2 + 3]); pw.z = pk2(s[8 * s2 + 4], s[8 * s2 + 5]); pw.w = pk2(s[8 * s2 + 6], s[8 * s2 + 7]);
                const bf16x8 pf = __builtin_bit_cast(bf16x8, pw);
#pragma unroll
                for (int db = 0; db < 2; ++db) oacc[qt][db] = __builtin_amdgcn_mfma_f32_32x32x16_bf16(vf[db][s2], pf, oacc[qt][db], 0, 0, 0);
            }
        }
        if (kt < kt_hi) {
#pragma unroll
            for (int s = 0; s < 4; ++s) kf[s] = kn[s];
#pragma unroll
            for (int a = 0; a < NQT; ++a) mw[a] = mn[a];
        }
    }
#pragma unroll
    for (int qt = 0; qt < NQT; ++qt) {
        const float lt = xor32_sum(lrun[qt]);
        const float inv = 1.f / lt;
        if (MODE == 0) {
            bf16_t* CC = (bf16_t*)(p.ws + OFF_CC);
#pragma unroll
            for (int db = 0; db < 2; ++db)
#pragma unroll
                for (int i = 0; i < 16; ++i) {
                    const int d = db * 32 + (i & 3) + 8 * (i >> 2) + 4 * h2;
                    CC[tq[qt] * 1024 + head * 64 + d] = f2bf(oacc[qt][db][i] * inv);
                }
        } else {
            bf16_t* OD = (bf16_t*)(p.ws + OFF_OD) + (size_t)grp * T_ * 512;
#pragma unroll
            for (int db = 0; db < 2; ++db)
#pragma unroll
                for (int i = 0; i < 16; i += 4) {
                    const int d = db * 32 + 8 * (i >> 2) + 4 * h2;
                    { u32x2 w; w.x = pk2(oacc[qt][db][i] * inv, oacc[qt][db][i + 1] * inv); w.y = pk2(oacc[qt][db][i + 2] * inv, oacc[qt][db][i + 3] * inv); *(u32x2*)(OD + tq[qt] * 512 + head * 64 + d) = w; }
                }
            if (h2 == 0) ((float*)(p.ws + OFF_LSE))[((size_t)grp * T_ + tq[qt]) * 8 + head] = mrun[qt] + log2f(lt);
        }
    }
}

__device__ __forceinline__ void dil_combine_phase(PRef p, int bid, int nb) {
    const bf16_t* OD = (const bf16_t*)(p.ws + OFF_OD); const float* LSE = (const float*)(p.ws + OFF_LSE);
    bf16_t* CC = (bf16_t*)(p.ws + OFF_CC);
    const long n = (long)T_ * 128;
    for (long c = (long)bid * NTHR + otid(); c < n; c += (long)nb * NTHR) {
        const long t = c >> 7; const int ch = (int)(c & 127) * 4, hd = ch >> 6;
        const float l0 = LSE[((size_t)0 * T_ + t) * 8 + hd], l1 = LSE[((size_t)1 * T_ + t) * 8 + hd], l2 = LSE[((size_t)2 * T_ + t) * 8 + hd];
        const float mx = fmaxf(l0, fmaxf(l1, l2));
        const float w0 = __builtin_amdgcn_exp2f(l0 - mx), w1 = __builtin_amdgcn_exp2f(l1 - mx), w2 = __builtin_amdgcn_exp2f(l2 - mx);
        const float inv = __builtin_amdgcn_rcpf(w0 + w1 + w2);
        const u32x2 a = *(const u32x2*)(OD + ((size_t)0 * T_ + t) * 512 + ch), bq = *(const u32x2*)(OD + ((size_t)1 * T_ + t) * 512 + ch), cq = *(const u32x2*)(OD + ((size_t)2 * T_ + t) * 512 + ch);
        float o[4];
#define BFLO(x) __uint_as_float((x) << 16)
#define BFHI(x) __uint_as_float((x) & 0xffff0000u)
        o[0] = (BFLO(a.x) * w0 + BFLO(bq.x) * w1 + BFLO(cq.x) * w2) * inv; o[1] = (BFHI(a.x) * w0 + BFHI(bq.x) * w1 + BFHI(cq.x) * w2) * inv;
        o[2] = (BFLO(a.y) * w0 + BFLO(bq.y) * w1 + BFLO(cq.y) * w2) * inv; o[3] = (BFHI(a.y) * w0 + BFHI(bq.y) * w1 + BFHI(cq.y) * w2) * inv;
#undef BFLO
#undef BFHI
        u32x2 w; w.x = pk2(o[0], o[1]); w.y = pk2(o[2], o[3]);
        *(u32x2*)(CC + (size_t)t * 1024 + 512 + ch) = w;
    }
}

constexpr int DA_ROW = 144;
constexpr int DA_TILE = 64 * DA_ROW;
__device__ __forceinline__ void dsa_attn_item(PRef p, int b, int head, int qb, char* smem) {
    const bf16_t* PO = (const bf16_t*)(p.ws + OFF_PO);
    const bf16_t* VT = (const bf16_t*)(p.ws + OFF_VTC) + ((size_t)(b * 8 + head)) * 64 * L_;
    const int tid = otid(), lane = tid & 63, wave = tid >> 6, r = lane & 31, h2 = lane >> 5;
    const int pr = (r & 0x13) | ((r & 4) << 1) | ((r & 8) >> 1);
    const float SC = 0.125f * 1.4426950408889634f;
    const int i0 = qb * 256 + wave * 32, qi = i0 + r;
    const unsigned long long* BMT = (const unsigned long long*)(p.ws + OFF_BM) + (size_t)b * 256 * L_ + qi;
    const size_t tq = (size_t)b * L_ + qi;
    bf16x8 qf[4];
#pragma unroll
    for (int s = 0; s < 4; ++s) qf[s] = *(const bf16x8*)(PO + tq * OD_P + head * 64 + s * 16 + h2 * 8);
    f32x16 oacc[2];
#pragma unroll
    for (int c = 0; c < 2; ++c)
#pragma unroll
        for (int i = 0; i < 16; ++i) oacc[c][i] = 0.f;
    float mrun = -64.f, lrun = 0.f;
    const int nkt = qb * 4 + 4, my_last = (i0 + 31) >> 6;
    const int srow = tid >> 3, sch = tid & 7;
    const bf16_t* ksrc = PO + ((size_t)b * L_ + srow) * OD_P + 512 + head * 64 + sch * 8;
    const bf16_t* vsrc = VT + (size_t)srow * L_ + sch * 8;
    u32x4 rk = *(const u32x4*)ksrc, rv = *(const u32x4*)vsrc;
    __syncthreads();
    *(u32x4*)(smem + srow * DA_ROW + sch * 16) = rk;
    *(u32x4*)(smem + DA_TILE + srow * DA_ROW + sch * 16) = rv;
    __syncthreads();
    unsigned long long mwn = BMT[0];
#pragma unroll 1
    for (int kt = 0; kt < nkt; ++kt) {
        const bool more = kt + 1 < nkt;
        if (more) { rk = *(const u32x4*)(ksrc + (size_t)(kt + 1) * 64 * OD_P); rv = *(const u32x4*)(vsrc + (kt + 1) * 64); }
        const unsigned long long mw64 = mwn;
        if (kt < my_last) mwn = BMT[(size_t)(kt + 1) * L_];
        if (kt <= my_last) {
            const char* kb = smem + (kt & 1) * 2 * DA_TILE; const char* vb = kb + DA_TILE;
            f32x16 sa[2];
#pragma unroll
            for (int sub = 0; sub < 2; ++sub) {
                bf16x8 kf[4];
#pragma unroll
                for (int s = 0; s < 4; ++s) kf[s] = *(const bf16x8*)(kb + (sub * 32 + pr) * DA_ROW + (s * 16 + h2 * 8) * 2);
#pragma unroll
                for (int i = 0; i < 16; ++i) sa[sub][i] = 0.f;
#pragma unroll
                for (int ks = 0; ks < 4; ++ks) sa[sub] = __builtin_amdgcn_mfma_f32_32x32x16_bf16(kf[ks], qf[ks], sa[sub], 0, 0, 0);
            }
#pragma unroll
            for (int sub = 0; sub < 2; ++sub) {
                const unsigned mw = sub == 0 ? (unsigned)mw64 : (unsigned)(mw64 >> 32);
                f32x16& s = sa[sub];
                bf16x8 vf[2][2];
#pragma unroll
                for (int db = 0; db < 2; ++db)
#pragma unroll
                    for (int s2 = 0; s2 < 2; ++s2) vf[db][s2] = *(const bf16x8*)(vb + (db * 32 + r) * DA_ROW + (sub * 32 + s2 * 16 + h2 * 8) * 2);
#pragma unroll
                for (int i = 0; i < 16; ++i) s[i] = __builtin_fmaf(s[i], SC, -mrun);
                float mx = fmaxf(fmaxf(s[0], s[1]), fmaxf(s[2], s[3]));
#pragma unroll
                for (int i = 4; i < 16; i += 2) mx = fmaxf(mx, fmaxf(s[i], s[i + 1]));
                mx = xor32_max(mx);
                if (__builtin_amdgcn_ballot_w64(mx > 0.f) != 0ull) {
                    const float dlt = fmaxf(mx, 0.f);
                    const float corr = __builtin_amdgcn_exp2f(-dlt);
                    mrun += dlt; lrun *= corr;
#pragma unroll
                    for (int db = 0; db < 2; ++db)
#pragma unroll
                        for (int i = 0; i < 16; ++i) oacc[db][i] *= corr;
#pragma unroll
                    for (int i = 0; i < 16; ++i) s[i] -= dlt;
                }
                float ps = 0.f;
                const int mws = (int)(mw >> (8 * h2));
#define DA_P(i, KO) { const float e = __builtin_amdgcn_exp2f(s[i]); s[i] = __uint_as_float(__float_as_uint(e) & bitmask32<KO>(mws)); ps += s[i]; }
                DA_P(0, 0) DA_P(1, 1) DA_P(2, 2) DA_P(3, 3) DA_P(4, 4) DA_P(5, 5) DA_P(6, 6) DA_P(7, 7)
                DA_P(8, 16) DA_P(9, 17) DA_P(10, 18) DA_P(11, 19) DA_P(12, 20) DA_P(13, 21) DA_P(14, 22) DA_P(15, 23)
#undef DA_P
                lrun += ps;
#pragma unroll
                for (int s2 = 0; s2 < 2; ++s2) {
                    u32x4 pw; pw.x = pk2(s[8 * s2], s[8 * s2 + 1]); pw.y = pk2(s[8 * s2 + 2], s[8 * s2 + 3]); pw.z = pk2(s[8 * s2 + 4], s[8 * s2 + 5]); pw.w = pk2(s[8 * s2 + 6], s[8 * s2 + 7]);
                    const bf16x8 pf = __builtin_bit_cast(bf16x8, pw);
#pragma unroll
                    for (int db = 0; db < 2; ++db) oacc[db] = __builtin_amdgcn_mfma_f32_32x32x16_bf16(vf[db][s2], pf, oacc[db], 0, 0, 0);
                }
            }
        }
        if (more) {
            char* nbuf = smem + ((kt + 1) & 1) * 2 * DA_TILE;
            *(u32x4*)(nbuf + srow * DA_ROW + sch * 16) = rk;
            *(u32x4*)(nbuf + DA_TILE + srow * DA_ROW + sch * 16) = rv;
        }
        __syncthreads();
    }
    const float lt = xor32_sum(lrun);
    const float inv = 1.f / lt;
    bf16_t* CC = (bf16_t*)(p.ws + OFF_CC);
#pragma unroll
    for (int db = 0; db < 2; ++db)
#pragma unroll
        for (int i = 0; i < 16; i += 4) {
            const int d = db * 32 + 8 * (i >> 2) + 4 * h2;
            u32x2 w; w.x = pk2(oacc[db][i] * inv, oacc[db][i + 1] * inv); w.y = pk2(oacc[db][i + 2] * inv, oacc[db][i + 3] * inv);
            *(u32x2*)(CC + tq * 1024 + head * 64 + d) = w;
        }
}


template <bool ODD>
__device__ __forceinline__ void inproj_phase(PRef p, int j, char* smem, int bid, int nb) {
    char* ws = p.ws;
    constexpr int NTN = ODD ? OD_P / 256 : EV_P / 256, NMAIN = 128 * NTN, NVT = ODD ? 1024 : 256;
    const bf16_t* XB = (const bf16_t*)(ws + OFF_XB);
    const bf16_t* W = ODD ? (const bf16_t*)(ws + OFF_WT_ODIN) + (size_t)j * OD_N * 1024 : (const bf16_t*)(ws + OFF_WT_EVIN) + (size_t)j * EV_N * 1024;
    XcdSeq s(NMAIN + NVT, bid, nb);
    gemm256_stream<false, 0>(
        [&](int i, G8Desc& d) -> bool {
            const int Q = s.q + i * s.step; if (Q >= s.qend) return false;
            d.list = nullptr; d.count = 0;
            if (Q < NMAIN) {
                const int pnl = Q / (4 * NTN), r = Q - pnl * 4 * NTN;
                d.A = XB; d.Bt = W; d.m0 = (pnl * 4 + (r & 3)) * 256; d.n0 = (r >> 2) * 256; d.u0 = -1; d.ldb = 1024;
            } else {
                const int v = Q - NMAIN; d.m0 = 0; d.n0 = 0; d.u0 = v;
                if (ODD) {
                    const int combo = v & 7, src = combo >> 1, mt = combo & 1, bn = v >> 3, b = bn >> 6, lam0 = (bn & 63) * 256;
                    const int sh = src < 2 ? 0 : (src == 2 ? 2 : 4), rho = lam0 >> (14 - sh), i0 = lam0 & ((L_ >> sh) - 1);
                    d.A = W + (size_t)(OD_P + src * 512 + mt * 256) * 1024;
                    d.Bt = XB + ((size_t)b * L_ + ((size_t)i0 << sh) + rho) * 1024; d.ldb = 1024 << sh;
                } else {
                    const int mt = v & 1, bn = v >> 1;
                    d.A = W + (size_t)(EV_P + mt * 256) * 1024;
                    d.Bt = XB + (size_t)bn * 256 * 1024; d.ldb = 1024;
                }
            }
            return true; },
        1024, 1024, smem,
        [&](int m0, int u0, f32x4 (&acc)[4][2], int rt0, int c0, int fr, int fq, const int*) {
            if (u0 < 0) { if (ODD) epi_od_in(p, acc, m0 + rt0, c0, fr, fq); else epi_ev_in(p, acc, m0 + rt0, c0, fr, fq); }
            else if (ODD) {
                const int combo = u0 & 7, src = combo >> 1, mt = combo & 1, bn = u0 >> 3, b = bn >> 6, lam0 = (bn & 63) * 256;
                bf16_t* img = src == 0 ? (bf16_t*)(ws + OFF_VTC) + ((size_t)(b * 8) * 64 + mt * 256) * L_ + lam0
                                       : (bf16_t*)(ws + OFF_VTD) + ((size_t)((b * 3 + src - 1) * 8) * 64 + mt * 256) * L_ + lam0;
                epi_vt(img, acc, rt0, c0, fr, fq);
            } else {
                const int mt = u0 & 1, bn = u0 >> 1, b = bn >> 6, lam0 = (bn & 63) * 256;
                epi_vt((bf16_t*)(ws + OFF_VTE) + ((size_t)(b * 4) * 128 + mt * 256) * L_ + lam0, acc, rt0, c0, fr, fq);
            }
        });
}

enum { K_PRO = 0, K_E1, K_E2, K_E3, K_E4, K_E5, K_E6, K_LN1, K_O1, K_O2, K_O3, K_O4, K_M1, K_M2, K_M3, K_M4, K_LN2, K_COUNT };

template <int KIND, bool NOEPI = false>
__device__ __forceinline__ void run_phase(PRef p, int layer, char* smem, int bid, int nb) {
    char* ws = p.ws;
    const int j = layer >> 1;
    if (KIND == K_PRO) {
        conv_phase(p, smem, bid, nb);
        __syncthreads();
        for (int u = bid; u < 256; u += nb) s5mat_unit(p, u, smem);
    } else if (KIND == K_E1) {
        inproj_phase<false>(p, j, smem, bid, nb);
    } else if (KIND == K_E2) {
        for (int it = bid; it < 2048; it += nb) gla_a_item(p, j, it, smem);
        s5_g_phase(p, j, smem, bid, nb);
    } else if (KIND == K_E3) {
        scan_phase(p, j, bid);
    } else if (KIND == K_E4) {
        for (int it = bid; it < 2048; it += nb) gla_c_item(p, j, it, smem);
        s5_y_phase(p, j, smem, bid, nb);
    } else if (KIND == K_E5) {
        const bf16_t* YA = (const bf16_t*)(ws + OFF_YA); bf16_t* CC = (bf16_t*)(ws + OFF_CC); const float* bg = p.s5_b_glu + (size_t)j * 512;
        gemm256_phase(YA, 512, T_, (const bf16_t*)(ws + OFF_WT_GLU) + (size_t)j * 512 * 512, 512, 512, 512, smem, bid, nb,
                   [&](f32x4 (&acc)[4][2], int row0, int c0, int fr, int fq) {
                       const int col = c0 + 8 * fq;
                       const f32x4 g0 = *(const f32x4*)(bg + col), g1 = *(const f32x4*)(bg + col + 4);
#pragma unroll
                       for (int m = 0; m < 4; ++m) {
                           const size_t t = (size_t)(row0 + m * 16 + fr);
                           const u32x4 yw = *(const u32x4*)(YA + t * 512 + col);
                           float o[8];
#pragma unroll
                           for (int q = 0; q < 4; ++q) {
                               const unsigned y2 = q == 0 ? yw.x : q == 1 ? yw.y : q == 2 ? yw.z : yw.w;
                               const float y0 = __uint_as_float(y2 << 16), y1 = __uint_as_float(y2 & 0xffff0000u);
                               const float a0 = q < 2 ? acc[m][0][2 * q] + g0[2 * q] : acc[m][1][2 * q - 4] + g1[2 * q - 4];
                               const float a1 = q < 2 ? acc[m][0][2 * q + 1] + g0[2 * q + 1] : acc[m][1][2 * q - 3] + g1[2 * q - 3];
                               o[2 * q] = y0 * sigmoidf_(a0); o[2 * q + 1] = y1 * sigmoidf_(a1);
                           }
                           u32x4 w; w.x = pk2(o[0], o[1]); w.y = pk2(o[2], o[3]); w.z = pk2(o[4], o[5]); w.w = pk2(o[6], o[7]);
                           *(u32x4*)(CC + t * 1024 + 512 + col) = w;
                       }
                   });
    } else if (KIND == K_E6 || KIND == K_O4) {
        bf16_t* MIX = (bf16_t*)(ws + OFF_MIX);
        const bf16_t* W = (const bf16_t*)(ws + (KIND == K_E6 ? OFF_WT_EVOUT : OFF_WT_ODOUT)) + (size_t)j * 1024 * 1024;
        gemm256_phase((const bf16_t*)(ws + OFF_CC), 1024, T_, W, 1024, 1024, 1024, smem, bid, nb,
                   [&](f32x4 (&acc)[4][2], int row0, int c0, int fr, int fq) {
#pragma unroll
                       for (int m = 0; m < 4; ++m) {
                           u32x4 w; w.x = pk2(acc[m][0][0], acc[m][0][1]); w.y = pk2(acc[m][0][2], acc[m][0][3]); w.z = pk2(acc[m][1][0], acc[m][1][1]); w.w = pk2(acc[m][1][2], acc[m][1][3]);
                           *(u32x4*)(MIX + (size_t)(row0 + m * 16 + fr) * 1024 + c0 + 8 * fq) = w;
                       }
                   });
    } else if (KIND == K_LN1) {
        const float* xin = layer == 0 ? p.x : (const float*)(ws + OFF_XR);
        ln1_router_phase<NOEPI>(p, layer, xin, smem, bid, nb);
    } else if (KIND == K_O1) {
        inproj_phase<true>(p, j, smem, bid, nb);
    } else if (KIND == K_O2) {
        if (!NOEPI) for (int k = bid; k < 256; k += nb) {
            dsa_select_item(p, k & 1, k >> 1, smem);
            __syncthreads();
            const int k2 = 511 - k;
            dsa_select_item(p, k2 & 1, k2 >> 1, smem);
            __syncthreads();
        }
        const int head = otid() >> 6;
        for (int it = bid; it < 1536; it += nb) {
            const int b = it / 768, rem = it - b * 768, g = rem >> 8, u = rem & 255;
            const int sh = g * 2, per = 256 >> sh, rho = u / per, qblk = u - rho * per;
            const bf16_t* VT = (const bf16_t*)(ws + OFF_VTD) + ((size_t)((b * 3 + g) * 8 + head)) * 64 * L_;
#pragma unroll 1
            for (int hf = 0; hf < 2; ++hf) {
                const int hi = 2 * qblk + hf, lo = hi - 4;
                attn_wave<1, 1>(p, b, head, OD_DIL + g * 512, OD_DIL + 1536 + g * 512, VT, rho * (L_ >> sh), qblk * 64 + hf * 32, sh, rho, lo < 0 ? 0 : lo, hi, g);
            }
        }
    } else if (KIND == K_O3) {
        for (int k = bid; k < 512; k += nb) {
            const int bh = k >> 5, q0 = k & 31;
#pragma unroll 1
            for (int half = 0; half < 2; ++half) dsa_attn_item(p, bh >> 3, bh & 7, half == 0 ? q0 : 63 - q0, smem);
        }
        dil_combine_phase(p, bid, nb);
    } else if (KIND == K_M1) {
        float* LG = (float*)(ws + OFF_LOGIT); const float* rb = p.router_b + (size_t)layer * 32;
        gemm_phase((const bf16_t*)(ws + OFF_XB), 1024, T_, (const bf16_t*)(ws + OFF_WT_RT) + (size_t)layer * 128 * 1024, 1024, 128, 1024, smem, bid, nb,
                   [&](f32x4 (&acc)[4][2], int row0, int c0, int fr, int fq) {
#pragma unroll
                       for (int n = 0; n < 2; ++n) {
                           const int col = c0 + n * 16 + fr;
                           if (col < 32) {
#pragma unroll
                               for (int m = 0; m < 4; ++m)
#pragma unroll
                                   for (int r = 0; r < 4; ++r) LG[(size_t)(row0 + m * 16 + fq * 4 + r) * 32 + col] = acc[m][n][r] + rb[col];
                           }
                       }
                   });
    } else if (KIND == K_M2) {
        topk_phase(p, layer, bid, nb);
    } else if (KIND == K_M3) {
        moe_gemm_phase<1, NOEPI>(p, layer, smem, bid, nb);
    } else if (KIND == K_M4) {
        moe_gemm_phase<2, NOEPI>(p, layer, smem, bid, nb);
    } else if (KIND == K_LN2) {
        float* xo = layer == 3 ? p.out : (float*)(ws + OFF_XR);
        ln_phase<true, NOEPI>(p, (const float*)(ws + OFF_XR), (const float*)(ws + OFF_SLOT), p.ln2_g + (size_t)layer * 1024, p.ln2_b + (size_t)layer * 1024, xo,
                       layer == 3 ? (bf16_t*)nullptr : (bf16_t*)(ws + OFF_XB), bid, nb);
    }
}

extern __shared__ __attribute__((aligned(16))) char dyn_smem[];

#if !MEGA
template <int KIND>
__global__ void __launch_bounds__(NTHR, 2) k_phase(Params p, int layer) { run_phase<KIND>(p, layer, dyn_smem, blockIdx.x, gridDim.x); }
#else
#ifndef DUPMASK
#define DUPMASK 0
#endif
typedef const __attribute__((address_space(4))) Params* KParams;
#define RUNP(K) do { KParams _q = kp0; asm volatile("" : "+s"(_q)); run_phase<K>(*_q, layer, smem, bid, nb); } while (0)
#ifndef DUPNOEPI
#define DUPNOEPI 0
#endif
#define RUNP2(K) do { KParams _q = kp0; asm volatile("" : "+s"(_q)); run_phase<K, (DUPNOEPI != 0)>(*_q, layer, smem, bid, nb); } while (0)
#define PHASE(K) do { RUNP(K); xcd_barrier(bar); if ((DUPMASK >> 30) & 1) xcd_barrier(bar); if ((DUPMASK >> K) & 1) { RUNP2(K); xcd_barrier(bar); } } while (0)
template <int LAYER>
__device__ __forceinline__ void mega_layer(KParams kp0, char* smem, int bid, int nb, const XcdBarrier& bar) {
    constexpr int layer = LAYER;
    if ((layer & 1) == 0) { PHASE(K_E1); PHASE(K_E2); PHASE(K_E3); PHASE(K_E4); PHASE(K_E5); PHASE(K_E6); }
    else { PHASE(K_O1); PHASE(K_O2); PHASE(K_O3); PHASE(K_O4); }
    PHASE(K_LN1); PHASE(K_M3); PHASE(K_M4);
    RUNP(K_LN2);
    if (layer < 3) xcd_barrier(bar);
}
__global__ void __launch_bounds__(NTHR, 2) k_mega(Params p) {
    char* smem = dyn_smem;
    const int bid = blockIdx.x, nb = gridDim.x;
    volatile LAS unsigned* st = (volatile LAS unsigned*)(dyn_smem + LDS_BYTES - 16);
    if (otid() == 0) { st[0] = 0u; st[1] = 0u; }
    __syncthreads();
    KParams kp0 = (KParams)__builtin_amdgcn_kernarg_segment_ptr();
    XcdBarrier bar = xcd_barrier_post((unsigned*)(kp0->ws + OFF_BAR), st);
    { const int layer = 0; PHASE(K_PRO); }
    mega_layer<0>(kp0, smem, bid, nb, bar);
    mega_layer<1>(kp0, smem, bid, nb, bar);
    mega_layer<2>(kp0, smem, bid, nb, bar);
    mega_layer<3>(kp0, smem, bid, nb, bar);
}
#endif

extern "C" void kernel_launch(void* const* d_in, const int* in_sizes, int n_in, void* d_out, int out_size, void* d_ws, size_t ws_size, hipStream_t stream) {
    Params p{};
    const float** f = (const float**)&p;
    for (int i = 0; i < 28; ++i) f[i] = (const float*)d_in[i];
    p.out = (float*)d_out; p.ws = (char*)d_ws;
    if (ws_size < WS_NEED) { fprintf(stderr, "workspace too small: %zu < %zu\n", ws_size, (size_t)WS_NEED); return; }
#if !MEGA
#define SETATTR(K) hipFuncSetAttribute((const void*)k_phase<K>, hipFuncAttributeMaxDynamicSharedMemorySize, LDS_BYTES)
#define LAUNCH(K, layer) k_phase<K><<<256, NTHR, LDS_BYTES, stream>>>(p, layer)
    static bool attr_done = false;
    if (!attr_done) {
        SETATTR(K_PRO); SETATTR(K_E1); SETATTR(K_E2); SETATTR(K_E3); SETATTR(K_E4); SETATTR(K_E5); SETATTR(K_E6); SETATTR(K_LN1); SETATTR(K_O1); SETATTR(K_O2); SETATTR(K_O3);
        SETATTR(K_O4); SETATTR(K_M1); SETATTR(K_M2); SETATTR(K_M3); SETATTR(K_M4); SETATTR(K_LN2);
        attr_done = true;
    }
    LAUNCH(K_PRO, 0);
    for (int layer = 0; layer < 4; ++layer) {
        if ((layer & 1) == 0) { LAUNCH(K_E1, layer); LAUNCH(K_E2, layer); LAUNCH(K_E3, layer); LAUNCH(K_E4, layer); LAUNCH(K_E5, layer); LAUNCH(K_E6, layer); }
        else { LAUNCH(K_O1, layer); LAUNCH(K_O2, layer); LAUNCH(K_O3, layer); LAUNCH(K_O4, layer); }
        LAUNCH(K_LN1, layer); LAUNCH(K_M3, layer); LAUNCH(K_M4, layer); LAUNCH(K_LN2, layer);
    }
#else
    static int grid = 0;
    if (!grid) {
        hipFuncSetAttribute((const void*)k_mega, hipFuncAttributeMaxDynamicSharedMemorySize, LDS_BYTES);
        int dev = 0, cus = 0, per_cu = 0;
        hipGetDevice(&dev);
        hipDeviceGetAttribute(&cus, hipDeviceAttributeMultiprocessorCount, dev);
        hipOccupancyMaxActiveBlocksPerMultiprocessor(&per_cu, (const void*)k_mega, NTHR, LDS_BYTES);
        grid = cus * (per_cu < 1 ? per_cu : 1);
        if (grid <= 0) grid = 0;
    }
    if (!grid) { fprintf(stderr, "occupancy query says 0 blocks per CU\n"); return; }
    hipMemsetAsync((char*)d_ws + OFF_BAR, 0, XCD_BAR_WORDS * sizeof(unsigned), stream);
    k_mega<<<grid, NTHR, LDS_BYTES, stream>>>(p);
#endif
}
```

```cpp
#include <hip/hip_runtime.h>
#include <stdint.h>
#include <stdio.h>

#ifndef MEGA
#define MEGA 1
#define DUPMASK 0
#define DUPNOEPI 0
#endif

typedef unsigned short bf16_t;
typedef short bf16x8 __attribute__((ext_vector_type(8)));
typedef float f32x4 __attribute__((ext_vector_type(4)));
typedef float f32x16 __attribute__((ext_vector_type(16)));
typedef unsigned u32x4 __attribute__((ext_vector_type(4)));
typedef unsigned u32x2 __attribute__((ext_vector_type(2)));

constexpr int T_ = 32768, D_ = 1024, L_ = 16384, NB_ = 2;
constexpr int NTHR = 512;
constexpr float ALPHA = 1.681792830507429f;
constexpr float LN_EPS = 1e-5f;
constexpr int EV_N = 2304;
constexpr int EV_P = 1792;
constexpr int PE_W = 1024;
constexpr int OD_N = 6656;
constexpr int OD_P = 4608;
constexpr int OD_QI = 1024, OD_DIL = 1280, OD_KI = 4352, OD_WI = 4416;
constexpr int UHW = 1152;
constexpr int LISTCAP = 131072;

constexpr size_t OFF_BAR = 0;
constexpr size_t OFF_CNT = 16384;
constexpr size_t OFF_A64 = 32768;
constexpr size_t OFF_WT_EVIN = 131072;
constexpr size_t OFF_WT_ODIN = OFF_WT_EVIN + (size_t)2 * EV_N * 1024 * 2;
constexpr size_t OFF_WT_EVOUT = OFF_WT_ODIN + (size_t)2 * OD_N * 1024 * 2;
constexpr size_t OFF_WT_ODOUT = OFF_WT_EVOUT + (size_t)2 * 1024 * 1024 * 2;
constexpr size_t OFF_WT_GLU = OFF_WT_ODOUT + (size_t)2 * 1024 * 1024 * 2;
constexpr size_t OFF_WT_RT = OFF_WT_GLU + (size_t)2 * 512 * 512 * 2;
constexpr size_t OFF_WT_W1 = OFF_WT_RT + (size_t)4 * 128 * 1024 * 2;
constexpr size_t OFF_WT_W2 = OFF_WT_W1 + (size_t)4 * 32 * 2048 * 1024 * 2;
constexpr size_t OFF_TH = OFF_WT_W2 + (size_t)4 * 32 * 1024 * 1024 * 2;
constexpr size_t OFF_GM = OFF_TH + (size_t)2 * 32 * 1024 * UHW * 2;
constexpr size_t OFF_XR = OFF_GM + (size_t)2 * 32 * 128 * 1024 * 2;
constexpr size_t OFF_XB = OFF_XR + (size_t)T_ * 1024 * 4;
constexpr size_t OFF_MIX = OFF_XB + (size_t)T_ * 1024 * 2;
constexpr size_t OFF_CC = OFF_MIX + (size_t)T_ * 1024 * 4;
constexpr size_t OFF_LOGIT = OFF_CC + (size_t)T_ * 1024 * 2;
constexpr size_t OFF_LIST = OFF_LOGIT + (size_t)T_ * 32 * 4;
constexpr size_t OFF_GATE = OFF_LIST + (size_t)32 * LISTCAP * 4;
constexpr size_t OFF_ACT = OFF_GATE + (size_t)T_ * 4 * 4;
constexpr size_t OFF_SLOT = OFF_ACT + (size_t)T_ * 4 * 1024 * 2;
constexpr size_t OFF_MIXER = OFF_SLOT + (size_t)T_ * 4 * 1024 * 4;
constexpr size_t OFF_PE = OFF_MIXER;
constexpr size_t OFF_UH = OFF_PE + (size_t)T_ * 1536 * 2;
constexpr size_t OFF_GLR = OFF_UH + (size_t)(T_ / 64) * 32 * UHW * 2;
constexpr size_t OFF_VTE = OFF_GLR + (size_t)T_ * 16 * 4;
constexpr size_t OFF_KV = OFF_VTE + (size_t)2 * 4 * 128 * L_ * 2;
constexpr size_t OFF_SST = OFF_KV + (size_t)2 * 256 * 4 * 64 * 128 * 4;
constexpr size_t OFF_DEC = OFF_SST + (size_t)2 * 256 * 4 * 64 * 128 * 4;
constexpr size_t OFF_GBUF = OFF_DEC + (size_t)2 * 256 * 4 * 64 * 4;
constexpr size_t OFF_YA = OFF_GBUF + (size_t)512 * 32 * 128 * 4;
constexpr size_t END_EVEN = OFF_YA + (size_t)T_ * 512 * 2;
constexpr size_t OFF_PO = OFF_MIXER;
constexpr size_t OFF_WI = OFF_PO + (size_t)T_ * OD_N * 2;
constexpr size_t OFF_VTC = OFF_WI + (size_t)T_ * 4 * 4;
constexpr size_t OFF_VTD = OFF_VTC + (size_t)2 * 8 * 64 * L_ * 2;
constexpr size_t OFF_BM = OFF_VTD + (size_t)2 * 3 * 8 * 64 * L_ * 2;
constexpr size_t OFF_OD = OFF_BM + (size_t)T_ * 256 * 8;
constexpr size_t OFF_LSE = OFF_OD + (size_t)3 * T_ * 512 * 4;
constexpr size_t END_ODD = OFF_LSE + (size_t)3 * T_ * 8 * 4;
constexpr size_t WS_NEED = END_ODD > END_EVEN ? END_ODD : END_EVEN;
static_assert(WS_NEED < (size_t)4200000000ull, "workspace too large");

constexpr int LDS_BYTES = 153600;

struct Params {
    const float *x, *ev_w_in, *gla_w_gate2, *gla_b_gate2, *gla_norm_g, *s5_a_re, *s5_a_im, *s5_log_dt, *s5_b_re, *s5_b_im, *s5_c_re, *s5_c_im, *s5_d,
        *s5_w_glu, *s5_b_glu, *ev_w_out, *od_w_in, *od_w_out, *ln1_g, *ln1_b, *ln2_g, *ln2_b, *router_w, *router_b, *moe_w1, *moe_b1, *moe_w2, *moe_b2;
    float* out;
    char* ws;
};

#if MEGA
typedef const __attribute__((address_space(4))) Params& PRef;
#else
typedef const Params& PRef;
#endif

__device__ __forceinline__ unsigned pk2(float lo, float hi) { unsigned r; asm("v_cvt_pk_bf16_f32 %0, %1, %2" : "=v"(r) : "v"(lo), "v"(hi)); return r; }
__device__ __forceinline__ bf16_t f2bf(float f) { return (bf16_t)(pk2(f, 0.f) & 0xffffu); }
__device__ __forceinline__ float bf2f(bf16_t h) { return __uint_as_float(((unsigned)h) << 16); }
__device__ __forceinline__ float sigmoidf_(float x) { return __builtin_amdgcn_rcpf(1.f + __expf(-x)); }
template <int CTRL> __device__ __forceinline__ float dppf(float v) { return __int_as_float(__builtin_amdgcn_update_dpp(0, __float_as_int(v), CTRL, 0xF, 0xF, false)); }
constexpr int DPP_X1 = 0xB1  , DPP_X2 = 0x4E  , DPP_HMIR = 0x141  , DPP_MIR = 0x140  , DPP_ROR8 = 0x128;
__device__ __forceinline__ float xor16_sum(float v) { const unsigned u = __float_as_uint(v); auto r = __builtin_amdgcn_permlane16_swap(u, u, false, false); return __uint_as_float(r[0]) + __uint_as_float(r[1]); }
__device__ __forceinline__ float xor16_max(float v) { const unsigned u = __float_as_uint(v); auto r = __builtin_amdgcn_permlane16_swap(u, u, false, false); return fmaxf(__uint_as_float(r[0]), __uint_as_float(r[1])); }
__device__ __forceinline__ float xor32_sum_(float v) { const unsigned u = __float_as_uint(v); auto r = __builtin_amdgcn_permlane32_swap(u, u, false, false); return __uint_as_float(r[0]) + __uint_as_float(r[1]); }
__device__ __forceinline__ float xor32_max_(float v) { const unsigned u = __float_as_uint(v); auto r = __builtin_amdgcn_permlane32_swap(u, u, false, false); return fmaxf(__uint_as_float(r[0]), __uint_as_float(r[1])); }
__device__ __forceinline__ float wave_sum(float v) {
    v += dppf<DPP_X1>(v); v += dppf<DPP_X2>(v); v += dppf<DPP_HMIR>(v); v += dppf<DPP_MIR>(v);
    return xor32_sum_(xor16_sum(v));
}
__device__ __forceinline__ float wave_max(float v) {
    v = fmaxf(v, dppf<DPP_X1>(v)); v = fmaxf(v, dppf<DPP_X2>(v)); v = fmaxf(v, dppf<DPP_HMIR>(v)); v = fmaxf(v, dppf<DPP_MIR>(v));
    return xor32_max_(xor16_max(v));
}
__device__ __forceinline__ float gelu_tanh(float x) {
    const float k0 = 0.7978845608028654f, k1 = 0.044715f;
    float u = k0 * (x + k1 * x * x * x);
    float t = 1.f - 2.f * __builtin_amdgcn_rcpf(1.f + __expf(2.f * u));
    return 0.5f * x * (1.f + t);
}
__device__ __forceinline__ float xor32_max(float v) { const unsigned u = __float_as_uint(v); auto r = __builtin_amdgcn_permlane32_swap(u, u, false, false); return fmaxf(__uint_as_float(r[0]), __uint_as_float(r[1])); }
__device__ __forceinline__ float xor32_sum(float v) { const unsigned u = __float_as_uint(v); auto r = __builtin_amdgcn_permlane32_swap(u, u, false, false); return __uint_as_float(r[0]) + __uint_as_float(r[1]); }
__device__ __forceinline__ unsigned xor32_or(unsigned u) { auto r = __builtin_amdgcn_permlane32_swap(u, u, false, false); return r[0] | r[1]; }
template <int BIT> __device__ __forceinline__ unsigned bitmask32(int w) { unsigned m; asm("v_bfe_i32 %0, %1, %2, 1" : "=v"(m) : "v"(w), "n"(BIT)); return m; }
__device__ __forceinline__ int otid() { int t = threadIdx.x; asm volatile("" : "+v"(t)); return t; }

#define XB_TMO      128
#define XB_XCNT(j)  (256  + 64 * (j))
#define XB_XSUB(j)  (1280 + 64 * (j))
#define XB_XGEN(j)  (2304 + 64 * (j))
#define XB_TOP      3328
#define XB_TOPGEN   3392
#define XCD_BAR_WORDS 3456
#define XB_SPIN_CAP (1u << 21)
#define LAS __attribute__((address_space(3)))

__device__ __forceinline__ unsigned xb_ld(unsigned* p)              { return __hip_atomic_load(p, __ATOMIC_RELAXED, __HIP_MEMORY_SCOPE_AGENT); }
__device__ __forceinline__ unsigned xb_add(unsigned* p, unsigned v) { return __hip_atomic_fetch_add(p, v, __ATOMIC_RELAXED, __HIP_MEMORY_SCOPE_AGENT); }
__device__ __forceinline__ unsigned xb_xcc_id() { return (unsigned)__builtin_amdgcn_s_getreg((3 << 11) | 20) & 0xFu; }
#define XB_SPIN(cond, bar) do { unsigned _sp = 0; while (cond) { __builtin_amdgcn_s_sleep(1); \
    if ((++_sp & 255u) == 0u) { if (xb_ld(&(bar)[XB_TMO])) break; if (_sp > XB_SPIN_CAP) { atomicAdd(&(bar)[XB_TMO], 1u); break; } } } } while (0)

struct XcdBarrier { unsigned* bar; unsigned x; volatile LAS unsigned* st; };

__device__ __forceinline__ XcdBarrier xcd_barrier_post(unsigned* bar, volatile LAS unsigned* st) {
    XcdBarrier b; b.bar = bar; b.x = xb_xcc_id(); b.st = st;
    if (threadIdx.x == 0) (void)xb_add(&bar[XB_XCNT(b.x)], 1u);
    return b;
}
__device__ __forceinline__ void xcd_barrier_complete(unsigned* bar, unsigned x, unsigned& nloc, unsigned& nx) {
    const unsigned G = gridDim.x * gridDim.y * gridDim.z;
    unsigned sum, cnt, mine, sp = 0u;
    for (;;) {
        sum = 0u; cnt = 0u; mine = 0u;
#pragma unroll
        for (unsigned j = 0; j < 16; ++j) { const unsigned c = xb_ld(&bar[XB_XCNT(j)]); sum += c; cnt += (c > 0u) ? 1u : 0u; mine = (j == x) ? c : mine; }
        if (sum == G) break;
        __builtin_amdgcn_s_sleep(1);
        if ((++sp & 255u) == 0u) { if (xb_ld(&bar[XB_TMO])) break; if (sp > XB_SPIN_CAP) { atomicAdd(&bar[XB_TMO], 1u); break; } }
    }
    nloc = mine > 0u ? mine : 1u; nx = cnt > 0u ? cnt : 1u;
}
__device__ __forceinline__ void xcd_barrier(const XcdBarrier& b) {
    asm volatile("s_waitcnt vmcnt(0)" ::: "memory");
    __syncthreads();
    if (threadIdx.x == 0) {
        unsigned* bar = b.bar;
        __builtin_amdgcn_s_waitcnt(0);
        unsigned nloc = b.st[0], nx = b.st[1];
        if (nloc == 0u) { xcd_barrier_complete(bar, b.x, nloc, nx); b.st[0] = nloc; b.st[1] = nx; }
        const unsigned old = xb_add(&bar[XB_XSUB(b.x)], 1u);
        const unsigned gen = old / nloc;
        if (old + 1u == (gen + 1u) * nloc) {
            __builtin_amdgcn_fence(__ATOMIC_RELEASE, "agent");
            asm volatile("s_waitcnt vmcnt(0)" ::: "memory");
            const unsigned og = xb_add(&bar[XB_TOP], 1u);
            const unsigned tg = og / nx;
            if (og + 1u == (tg + 1u) * nx) xb_add(&bar[XB_TOPGEN], 1u);
            else XB_SPIN(xb_ld(&bar[XB_TOPGEN]) == tg, bar);
            __builtin_amdgcn_fence(__ATOMIC_ACQUIRE, "agent");
            xb_add(&bar[XB_XGEN(b.x)], 1u);
            asm volatile("s_waitcnt vmcnt(0)" ::: "memory");
        } else {
            XB_SPIN(xb_ld(&bar[XB_XGEN(b.x)]) == gen, bar);
            __builtin_amdgcn_fence(__ATOMIC_ACQUIRE, "agent");
            asm volatile("s_waitcnt vmcnt(0)" ::: "memory");
        }
    }
    __syncthreads();
}

constexpr int G_LROW = 144;
constexpr int G_ASZ = 256 * G_LROW;
constexpr int G_BSZ = 128 * G_LROW;
constexpr int G_STAGE = G_ASZ + G_BSZ;
constexpr int G_ROWS_OFF = 2 * G_STAGE;

template <bool GATHER, class Epi>
__device__ __forceinline__ void gemm_tile(const bf16_t* __restrict__ A, long lda, int shift, int m0, const bf16_t* __restrict__ Bt, long ldb, int n0, int K,
                                          char* smem, Epi&& epi) {
    const int tid = otid(), lane = tid & 63, wave = tid >> 6, wr = wave >> 1, wc = wave & 1, fr = lane & 15, fq = lane >> 4;
    const int lrow = tid >> 3, lchunk = tid & 7;
    const int* sRow = (const int*)(smem + G_ROWS_OFF);
    const bf16_t* pa[4]; const bf16_t* pb[2];
#pragma unroll
    for (int i = 0; i < 4; ++i) {
        int r = lrow + 64 * i; long arow;
        if (GATHER) { int v = sRow[r]; arow = v < 0 ? 0 : (v >> shift); } else arow = m0 + r;
        pa[i] = A + arow * lda + lchunk * 8;
    }
#pragma unroll
    for (int i = 0; i < 2; ++i) pb[i] = Bt + (long)(n0 + lrow + 64 * i) * ldb + lchunk * 8;
    f32x4 acc[4][4];
#pragma unroll
    for (int m = 0; m < 4; ++m)
#pragma unroll
        for (int n = 0; n < 4; ++n) acc[m][n] = (f32x4){0.f, 0.f, 0.f, 0.f};
    u32x4 ra[4], rb[2];
    const int nk = K >> 6;
#pragma unroll
    for (int i = 0; i < 4; ++i) ra[i] = *(const u32x4*)(pa[i]);
#pragma unroll
    for (int i = 0; i < 2; ++i) rb[i] = *(const u32x4*)(pb[i]);
    {
        char* sa = smem; char* sb = smem + G_ASZ;
#pragma unroll
        for (int i = 0; i < 4; ++i) *(u32x4*)(sa + (lrow + 64 * i) * G_LROW + lchunk * 16) = ra[i];
#pragma unroll
        for (int i = 0; i < 2; ++i) *(u32x4*)(sb + (lrow + 64 * i) * G_LROW + lchunk * 16) = rb[i];
    }
    __syncthreads();
    for (int kt = 0; kt < nk; ++kt) {
        const bool more = (kt + 1 < nk);
        if (more) {
#pragma unroll
            for (int i = 0; i < 4; ++i) ra[i] = *(const u32x4*)(pa[i] + (kt + 1) * 64);
#pragma unroll
            for (int i = 0; i < 2; ++i) rb[i] = *(const u32x4*)(pb[i] + (kt + 1) * 64);
        }
        const char* sa = smem + (kt & 1) * G_STAGE; const char* sb = sa + G_ASZ;
#pragma unroll
        for (int ks = 0; ks < 2; ++ks) {
            bf16x8 af[4], bfr[4];
#pragma unroll
            for (int m = 0; m < 4; ++m) af[m] = *(const bf16x8*)(sa + (wr * 64 + m * 16 + fr) * G_LROW + (ks * 32 + fq * 8) * 2);
#pragma unroll
            for (int n = 0; n < 4; ++n) bfr[n] = *(const bf16x8*)(sb + (wc * 64 + n * 16 + fr) * G_LROW + (ks * 32 + fq * 8) * 2);
#pragma unroll
            for (int m = 0; m < 4; ++m)
#pragma unroll
                for (int n = 0; n < 4; ++n) acc[m][n] = __builtin_amdgcn_mfma_f32_16x16x32_bf16(af[m], bfr[n], acc[m][n], 0, 0, 0);
        }
        if (more) {
            char* wa = smem + ((kt + 1) & 1) * G_STAGE; char* wb = wa + G_ASZ;
#pragma unroll
            for (int i = 0; i < 4; ++i) *(u32x4*)(wa + (lrow + 64 * i) * G_LROW + lchunk * 16) = ra[i];
#pragma unroll
            for (int i = 0; i < 2; ++i) *(u32x4*)(wb + (lrow + 64 * i) * G_LROW + lchunk * 16) = rb[i];
        }
        __syncthreads();
    }
    {
        f32x4 h0[4][2], h1[4][2];
#pragma unroll
        for (int m = 0; m < 4; ++m) { h0[m][0] = acc[m][0]; h0[m][1] = acc[m][1]; h1[m][0] = acc[m][2]; h1[m][1] = acc[m][3]; }
        epi(h0, wr * 64, n0 + wc * 64, fr, fq);
        epi(h1, wr * 64, n0 + wc * 64 + 32, fr, fq);
    }
}

template <class Epi>
__device__ __forceinline__ void gemm_phase(const bf16_t* A, long lda, int M, const bf16_t* Bt, long ldb, int N, int K, char* smem, int bid, int nb, Epi&& epi) {
    const int ntn = N / 128, ntm = M / 256, nt = ntn * ntm;
    for (int t = bid; t < nt; t += nb) {
        const int mi = t / ntn, ni = t - mi * ntn;
        gemm_tile<false>(A, lda, 0, mi * 256, Bt, ldb, ni * 128, K, smem,
                         [&](f32x4 (&acc)[4][2], int rt0, int c0, int fr, int fq) { epi(acc, mi * 256 + rt0, c0, fr, fq); });
    }
}

constexpr int G8_HT = 128 * 64 * 2;
constexpr int G8_ROWS_OFF = 8 * G8_HT;

__device__ __forceinline__ int g8_lds_byte(int r, int c) {
    const int st = (r >> 4) * 2 + (c >> 5), rr = r & 15, cc = c & 31, ob = rr * 64 + cc * 2;
    return st * 1024 + (ob ^ (((ob >> 9) & 1) << 5));
}
__device__ __forceinline__ void g8_stage_rc(int b, int& R, int& C) {
    const int st = b / 1024, sb = b % 1024, swz = sb ^ (((sb >> 9) & 1) << 5);
    R = (st >> 1) * 16 + swz / 64; C = (st & 1) * 32 + (swz % 64) / 2;
}

#define G8_SA(b, h) (lds + ((b) * 2 + (h)) * G8_HT)
#define G8_SB(b, h) (lds + (4 + (b) * 2 + (h)) * G8_HT)
#define G8_STAGE(P, RS, OFF, soff) do { \
    _Pragma("unroll") for (int _i = 0; _i < 2; ++_i) \
        __builtin_amdgcn_raw_ptr_buffer_load_lds((RS), (LAS unsigned*)((P) + tid * 16 + _i * 8192), 16, (OFF)[_i], (soff), 0, 0); } while (0)
#define G8_LDA(dst, b, h) do { _Pragma("unroll") for (int m = 0; m < 4; ++m) _Pragma("unroll") for (int k = 0; k < 2; ++k) \
    dst[m][k] = *(const LAS bf16x8*)(G8_SA(b, h) + g8_lds_byte(wr * 64 + m * 16 + fr, k * 32 + fq * 8)); } while (0)
#define G8_LDB(dst, b, h) do { _Pragma("unroll") for (int n = 0; n < 2; ++n) _Pragma("unroll") for (int k = 0; k < 2; ++k) \
    dst[n][k] = *(const LAS bf16x8*)(G8_SB(b, h) + g8_lds_byte(wc * 32 + n * 16 + fr, k * 32 + fq * 8)); } while (0)
#define G8_MMA(ai, bj, At, Bt_) do { __builtin_amdgcn_s_setprio(1); \
    _Pragma("unroll") for (int m = 0; m < 4; ++m) _Pragma("unroll") for (int n = 0; n < 2; ++n) _Pragma("unroll") for (int k = 0; k < 2; ++k) \
        acc[ai][bj][m][n] = __builtin_amdgcn_mfma_f32_16x16x32_bf16(Bt_[n][k], At[m][k], acc[ai][bj][m][n], 0, 0, 0); \
    __builtin_amdgcn_s_setprio(0); } while (0)
#define G8_WAIT_V(n) asm volatile("s_waitcnt vmcnt(" #n ")" ::: "memory")
#define G8_WAIT_L(n) asm volatile("s_waitcnt lgkmcnt(" #n ")" ::: "memory")
#define G8_BAR __builtin_amdgcn_s_barrier()
#define G8_SCHED __builtin_amdgcn_sched_barrier(0)

template <bool GATHER, class Epi>
__device__ __forceinline__ void gemm256_tile(const bf16_t* __restrict__ A, long lda, int shift, int m0, const bf16_t* __restrict__ Bt, long ldb, int n0, int K,
                                             char* smem, Epi&& epi) {
    LAS char* lds = (LAS char*)smem;
    int tid = otid();
    int wid = tid >> 6, lane = tid & 63, wr = wid >> 2, wc = wid & 3, fr = lane & 15, fq = lane >> 4;
    unsigned aoff[2][2], boff[2];
    {
        const LAS int* sRow = (const LAS int*)(lds + G8_ROWS_OFF);
#pragma unroll
        for (int i = 0; i < 2; ++i) {
            int R, C; g8_stage_rc(tid * 16 + i * 8192, R, C);
            { const int rho = R & 31, nn = rho >> 4, ii = rho & 15; const int Rp = (R & ~31) + 8 * (ii >> 2) + 4 * nn + (ii & 3);
              boff[i] = (unsigned)((long)Rp * ldb + C) * 2u; }
#pragma unroll
            for (int h = 0; h < 2; ++h) {
                long arow;
                if (GATHER) { const int v = sRow[h * 128 + R]; arow = v < 0 ? 0 : (v >> shift); } else arow = m0 + h * 128 + R;
                aoff[h][i] = (unsigned)(arow * lda + C) * 2u;
            }
        }
    }
    f32x4 acc[2][2][4][2];
#pragma unroll
    for (int a = 0; a < 2; ++a)
#pragma unroll
        for (int b = 0; b < 2; ++b)
#pragma unroll
            for (int m = 0; m < 4; ++m)
#pragma unroll
                for (int n = 0; n < 2; ++n) acc[a][b][m][n] = (f32x4){0.f, 0.f, 0.f, 0.f};
    bf16x8 At[4][2], B0[2][2], B1[2][2];
    const int nt = K / 64;
    const __amdgpu_buffer_rsrc_t rA = __builtin_amdgcn_make_buffer_rsrc((void*)A, 0, 0x7fffffff, 0x00020000);
    const __amdgpu_buffer_rsrc_t rB = __builtin_amdgcn_make_buffer_rsrc((void*)(Bt + (size_t)n0 * ldb), 0, 0x7fffffff, 0x00020000);
    const int bh = (int)(128 * ldb * 2);
    G8_STAGE(G8_SB(0, 0), rB, boff, 0); G8_STAGE(G8_SA(0, 0), rA, aoff[0], 0);
    G8_STAGE(G8_SB(0, 1), rB, boff, bh); G8_STAGE(G8_SA(0, 1), rA, aoff[1], 0);
    if (wr == 1) G8_BAR;
    G8_WAIT_V(4); G8_BAR;
    G8_STAGE(G8_SB(1, 0), rB, boff, 128); G8_STAGE(G8_SA(1, 0), rA, aoff[0], 128); G8_STAGE(G8_SB(1, 1), rB, boff, 128 + bh);
    G8_WAIT_V(6); G8_BAR;
    for (int t = 0; t < nt - 2; t += 2) {
        G8_LDB(B0, 0, 0); G8_SCHED; G8_LDA(At, 0, 0); G8_STAGE(G8_SA(1, 1), rA, aoff[1], (t + 1) * 128);
        G8_WAIT_L(8); G8_BAR; G8_WAIT_L(0); G8_MMA(0, 0, At, B0); G8_BAR; G8_SCHED;
        G8_LDB(B1, 0, 1); G8_STAGE(G8_SB(0, 0), rB, boff, (t + 2) * 128);
        G8_BAR; G8_WAIT_L(0); G8_MMA(0, 1, At, B1); G8_BAR;
        G8_LDA(At, 0, 1); G8_STAGE(G8_SA(0, 0), rA, aoff[0], (t + 2) * 128);
        G8_BAR; G8_WAIT_L(0); G8_MMA(1, 0, At, B0); G8_BAR; G8_SCHED;
        G8_STAGE(G8_SB(0, 1), rB, boff, (t + 2) * 128 + bh);
        G8_WAIT_V(6); G8_BAR; G8_MMA(1, 1, At, B1); G8_BAR;
        G8_LDB(B0, 1, 0); G8_SCHED; G8_LDA(At, 1, 0); G8_STAGE(G8_SA(0, 1), rA, aoff[1], (t + 2) * 128);
        G8_WAIT_L(8); G8_BAR; G8_WAIT_L(0); G8_MMA(0, 0, At, B0); G8_BAR; G8_SCHED;
        G8_LDB(B1, 1, 1); G8_STAGE(G8_SB(1, 0), rB, boff, (t + 3) * 128);
        G8_BAR; G8_WAIT_L(0); G8_MMA(0, 1, At, B1); G8_BAR;
        G8_LDA(At, 1, 1); G8_STAGE(G8_SA(1, 0), rA, aoff[0], (t + 3) * 128);
        G8_BAR; G8_WAIT_L(0); G8_MMA(1, 0, At, B0); G8_BAR; G8_SCHED;
        G8_STAGE(G8_SB(1, 1), rB, boff, (t + 3) * 128 + bh);
        G8_WAIT_V(6); G8_BAR; G8_MMA(1, 1, At, B1); G8_BAR;
    }
    { G8_LDB(B0, 0, 0); G8_WAIT_V(0); G8_LDA(At, 0, 0); G8_STAGE(G8_SA(1, 1), rA, aoff[1], (nt - 1) * 128);
      G8_BAR; G8_WAIT_L(0); G8_MMA(0, 0, At, B0); G8_BAR;
      G8_LDB(B1, 0, 1); G8_BAR; G8_WAIT_L(0); G8_MMA(0, 1, At, B1); G8_BAR;
      G8_LDA(At, 0, 1); G8_WAIT_V(4); G8_BAR; G8_WAIT_L(0); G8_MMA(1, 0, At, B0); G8_MMA(1, 1, At, B1); G8_BAR; }
    { G8_LDB(B0, 1, 0); G8_LDA(At, 1, 0); G8_WAIT_V(2); G8_BAR; G8_WAIT_L(0); G8_MMA(0, 0, At, B0); G8_BAR;
      G8_LDB(B1, 1, 1); G8_WAIT_V(0); G8_BAR; G8_WAIT_L(0); G8_MMA(0, 1, At, B1); G8_BAR;
      G8_LDA(At, 1, 1); G8_BAR; G8_WAIT_L(0); G8_MMA(1, 0, At, B0); G8_MMA(1, 1, At, B1); G8_BAR; }
    if (wr == 0) G8_BAR;
    int tz = otid(); wid = tz >> 6; lane = tz & 63; wr = wid >> 2; wc = wid & 3; fr = lane & 15; fq = lane >> 4;
#pragma unroll
    for (int ai = 0; ai < 2; ++ai)
#pragma unroll
        for (int bj = 0; bj < 2; ++bj) epi(acc[ai][bj], ai * 128 + wr * 64, n0 + bj * 128 + wc * 32, fr, fq);
}

struct G8Desc { const bf16_t* A; const bf16_t* Bt; const int* list; int m0, n0, count, u0, ldb; };

template <bool GATHER, int SHIFT, class Src, class Epi>
__device__ __forceinline__ void gemm256_stream(Src&& src, const int lda, const int K, char* smem, Epi&& epi) {
    LAS char* lds = (LAS char*)smem;
    int tid = otid();
    int wid = tid >> 6, lane = tid & 63, wr = wid >> 2, wc = wid & 3, fr = lane & 15, fq = lane >> 4;
    G8Desc nxt;
    if (!src(0, nxt)) return;
    int cm0 = nxt.m0, cn0 = nxt.n0, cu0 = nxt.u0;
    int* sRowG = (int*)(smem + G8_ROWS_OFF);
    __syncthreads();
    if (GATHER) { if (tid < 256) sRowG[tid] = tid < nxt.count ? nxt.list[tid] : -1; __syncthreads(); }
    unsigned aoff[2][2], boff[2];
    __amdgpu_buffer_rsrc_t rA, rB;
    int bh;
#define G8_PREP(D, SLOT) do { \
        const LAS int* _sr = (const LAS int*)(lds + G8_ROWS_OFF) + (SLOT) * 256; \
        _Pragma("unroll") for (int i = 0; i < 2; ++i) { \
            int R, C; g8_stage_rc(tid * 16 + i * 8192, R, C); \
            { const int rho = R & 31, nn = rho >> 4, ii = rho & 15; const int Rp = (R & ~31) + 8 * (ii >> 2) + 4 * nn + (ii & 3); boff[i] = (unsigned)(Rp * (D).ldb + C) * 2u; } \
            _Pragma("unroll") for (int h = 0; h < 2; ++h) { \
                int arow; \
                if (GATHER) { const int v = _sr[h * 128 + R]; arow = v < 0 ? 0 : (v >> SHIFT); } else arow = (D).m0 + h * 128 + R; \
                aoff[h][i] = (unsigned)(arow * lda + C) * 2u; } } \
        rA = __builtin_amdgcn_make_buffer_rsrc((void*)(D).A, 0, 0x7fffffff, 0x00020000); \
        rB = __builtin_amdgcn_make_buffer_rsrc((void*)((D).Bt + (size_t)(D).n0 * (D).ldb), 0, 0x7fffffff, 0x00020000); bh = 128 * (D).ldb * 2; } while (0)
#define G8_PRO1() do { G8_STAGE(G8_SB(0, 0), rB, boff, 0); G8_STAGE(G8_SA(0, 0), rA, aoff[0], 0); G8_STAGE(G8_SB(0, 1), rB, boff, bh); G8_STAGE(G8_SA(0, 1), rA, aoff[1], 0); } while (0)
    G8_PREP(nxt, 0);
    G8_PRO1();
    f32x4 acc[2][2][4][2];
    const int nt = K / 64;
    for (int it = 0;; ++it) {
#pragma unroll
        for (int a = 0; a < 2; ++a)
#pragma unroll
            for (int b = 0; b < 2; ++b)
#pragma unroll
                for (int m = 0; m < 4; ++m)
#pragma unroll
                    for (int n = 0; n < 2; ++n) acc[a][b][m][n] = (f32x4){0.f, 0.f, 0.f, 0.f};
        const bool has_next = src(it + 1, nxt);
        if (GATHER && has_next && tid < 256) sRowG[((it + 1) % 3) * 256 + tid] = tid < nxt.count ? nxt.list[tid] : -1;
        bf16x8 At[4][2], B0[2][2], B1[2][2];
        if (wr == 1) G8_BAR;
        G8_WAIT_V(4); G8_BAR;
        G8_STAGE(G8_SB(1, 0), rB, boff, 128); G8_STAGE(G8_SA(1, 0), rA, aoff[0], 128); G8_STAGE(G8_SB(1, 1), rB, boff, 128 + bh);
        G8_WAIT_V(6); G8_BAR;
        for (int t = 0; t < nt - 2; t += 2) {
            G8_LDB(B0, 0, 0); G8_SCHED; G8_LDA(At, 0, 0); G8_STAGE(G8_SA(1, 1), rA, aoff[1], (t + 1) * 128);
            G8_WAIT_L(8); G8_BAR; G8_WAIT_L(0); G8_MMA(0, 0, At, B0); G8_BAR; G8_SCHED;
            G8_LDB(B1, 0, 1); G8_STAGE(G8_SB(0, 0), rB, boff, (t + 2) * 128);
            G8_BAR; G8_WAIT_L(0); G8_MMA(0, 1, At, B1); G8_BAR;
            G8_LDA(At, 0, 1); G8_STAGE(G8_SA(0, 0), rA, aoff[0], (t + 2) * 128);
            G8_BAR; G8_WAIT_L(0); G8_MMA(1, 0, At, B0); G8_BAR; G8_SCHED;
            G8_STAGE(G8_SB(0, 1), rB, boff, (t + 2) * 128 + bh);
            G8_WAIT_V(6); G8_BAR; G8_MMA(1, 1, At, B1); G8_BAR;
            G8_LDB(B0, 1, 0); G8_SCHED; G8_LDA(At, 1, 0); G8_STAGE(G8_SA(0, 1), rA, aoff[1], (t + 2) * 128);
            G8_WAIT_L(8); G8_BAR; G8_WAIT_L(0); G8_MMA(0, 0, At, B0); G8_BAR; G8_SCHED;
            G8_LDB(B1, 1, 1); G8_STAGE(G8_SB(1, 0), rB, boff, (t + 3) * 128);
            G8_BAR; G8_WAIT_L(0); G8_MMA(0, 1, At, B1); G8_BAR;
            G8_LDA(At, 1, 1); G8_STAGE(G8_SA(1, 0), rA, aoff[0], (t + 3) * 128);
            G8_BAR; G8_WAIT_L(0); G8_MMA(1, 0, At, B0); G8_BAR; G8_SCHED;
            G8_STAGE(G8_SB(1, 1), rB, boff, (t + 3) * 128 + bh);
            G8_WAIT_V(6); G8_BAR; G8_MMA(1, 1, At, B1); G8_BAR;
        }
        { G8_LDB(B0, 0, 0); G8_WAIT_V(0); G8_LDA(At, 0, 0); G8_STAGE(G8_SA(1, 1), rA, aoff[1], (nt - 1) * 128);
          G8_BAR; G8_WAIT_L(0); G8_MMA(0, 0, At, B0); G8_BAR;
          G8_LDB(B1, 0, 1); G8_BAR; G8_WAIT_L(0); G8_MMA(0, 1, At, B1); G8_BAR;
          G8_LDA(At, 0, 1); G8_WAIT_V(4); G8_BAR; G8_WAIT_L(0); G8_MMA(1, 0, At, B0); G8_MMA(1, 1, At, B1); G8_BAR; }
        { G8_LDB(B0, 1, 0); G8_LDA(At, 1, 0); G8_WAIT_V(2); G8_BAR; G8_WAIT_L(0); G8_MMA(0, 0, At, B0); G8_BAR;
          G8_LDB(B1, 1, 1); G8_WAIT_V(0); G8_BAR; G8_WAIT_L(0); G8_MMA(0, 1, At, B1); G8_BAR;
          G8_LDA(At, 1, 1); G8_BAR; G8_WAIT_L(0); G8_MMA(1, 0, At, B0); G8_MMA(1, 1, At, B1); G8_BAR; }
        if (wr == 0) G8_BAR;
        tid = otid(); wid = tid >> 6; lane = tid & 63; wr = wid >> 2; wc = wid & 3; fr = lane & 15; fq = lane >> 4;
        if (has_next) { G8_PREP(nxt, (it + 1) % 3); G8_PRO1(); }
        {
            const int* sr = sRowG + (it % 3) * 256;
#pragma unroll
            for (int ai = 0; ai < 2; ++ai)
#pragma unroll
                for (int bj = 0; bj < 2; ++bj) epi(cm0, cu0, acc[ai][bj], ai * 128 + wr * 64, cn0 + bj * 128 + wc * 32, fr, fq, sr);
        }
        if (!has_next) break;
        cm0 = nxt.m0; cn0 = nxt.n0; cu0 = nxt.u0;
    }
#undef G8_PREP
#undef G8_PRO1
}

struct XcdSeq {
    int q, qend, step;
    __device__ __forceinline__ XcdSeq(int total, int bid, int nb) {
        if ((nb & 7) == 0) { const int chunk = (total + 7) >> 3, x = bid & 7; q = x * chunk + (bid >> 3); const int e = (x + 1) * chunk; qend = e < total ? e : total; step = nb >> 3; }
        else { q = bid; qend = total; step = nb; }
    }
};

template <class Epi>
__device__ __forceinline__ void gemm256_phase(const bf16_t* A, long lda, int M, const bf16_t* Bt, long ldb, int N, int K, char* smem, int bid, int nb, Epi&& epi) {
    const int ntn = N / 256, ntm = M / 256, nt = ntn * ntm;
    XcdSeq s(nt, bid, nb);
    gemm256_stream<false, 0>(
        [&](int i, G8Desc& d) -> bool {
            const int Q = s.q + i * s.step; if (Q >= s.qend) return false;
            const int pnl = Q / (4 * ntn), r = Q - pnl * 4 * ntn;
            d.A = A; d.Bt = Bt; d.list = nullptr; d.m0 = (pnl * 4 + (r & 3)) * 256; d.n0 = (r >> 2) * 256; d.count = 0; d.u0 = 0; d.ldb = (int)ldb;
            return true; },
        (int)lda, K, smem,
        [&](int m0, int, f32x4 (&acc)[4][2], int rt0, int c0, int fr, int fq, const int*) { epi(acc, m0 + rt0, c0, fr, fq); });
}


__device__ __forceinline__ int colmap(int kind, int n, int nsrc) {
    if (kind == 0) return n < nsrc ? n : -1;
    if (kind == 1) { if (n < 512) return n; if (n < 1024) return n + 512; if (n < 1536) return n + 528; if (n < 1552) return n; if (n < 1792) return -1; return n - 1280; }
    if (kind == 2) { if (n < 1024) return n; if (n < 1280) return n + 512; if (n < 4352) return n + 580; if (n < 4420) return n - 2560; if (n < 4608) return -1; if (n < 5120) return n - 3584; return n - 188; }
    { const int grp = n >> 5, w = n & 31; return ((w >> 2) & 1) * 1024 + grp * 16 + 4 * (w >> 3) + (w & 3); }
}
struct ConvTile { const float* src; bf16_t* dst; int sld, sc, K, n0, k0; };
__device__ __forceinline__ ConvTile conv_decode(PRef p, int t, int n4) {
    constexpr int S0 = 128 * 32 * 4, S1 = S0 + 128 * 16 * 4, S2 = S1 + 2 * 36 * 4, S3 = S2 + 2 * 104 * 4, S4 = S3 + 2 * 16 * 4, S5 = S4 + 2 * 16 * 4, S6 = S5 + 2 * 8 * 2;
    char* ws = p.ws;
    ConvTile c; int nsrc, kind, NT, loc;
    if (t < S0) { loc = t; const int mat = loc / (32 * 4); loc -= mat * 32 * 4; c.src = p.moe_w1 + (size_t)mat * 1024 * 2048; c.dst = (bf16_t*)(ws + OFF_WT_W1) + (size_t)mat * 2048 * 1024; c.sld = 2048; nsrc = 2048; kind = 3; c.K = 1024; NT = 32; }
    else if (t < S1) { loc = t - S0; const int mat = loc / 64; loc -= mat * 64; c.src = p.moe_w2 + (size_t)mat * 1024 * 1024; c.dst = (bf16_t*)(ws + OFF_WT_W2) + (size_t)mat * 1024 * 1024; c.sld = 1024; nsrc = 1024; kind = 0; c.K = 1024; NT = 16; }
    else if (t < S2) { loc = t - S1; const int mat = loc / (36 * 4); loc -= mat * 36 * 4; c.src = p.ev_w_in + (size_t)mat * 1024 * 2064; c.dst = (bf16_t*)(ws + OFF_WT_EVIN) + (size_t)mat * EV_N * 1024; c.sld = 2064; nsrc = 2064; kind = 1; c.K = 1024; NT = 36; }
    else if (t < S3) { loc = t - S2; const int mat = loc / (104 * 4); loc -= mat * 104 * 4; c.src = p.od_w_in + (size_t)mat * 1024 * 6468; c.dst = (bf16_t*)(ws + OFF_WT_ODIN) + (size_t)mat * OD_N * 1024; c.sld = 6468; nsrc = 6468; kind = 2; c.K = 1024; NT = 104; }
    else if (t < S4) { loc = t - S3; const int mat = loc / 64; loc -= mat * 64; c.src = p.ev_w_out + (size_t)mat * 1024 * 1024; c.dst = (bf16_t*)(ws + OFF_WT_EVOUT) + (size_t)mat * 1024 * 1024; c.sld = 1024; nsrc = 1024; kind = 0; c.K = 1024; NT = 16; }
    else if (t < S5) { loc = t - S4; const int mat = loc / 64; loc -= mat * 64; c.src = p.od_w_out + (size_t)mat * 1024 * 1024; c.dst = (bf16_t*)(ws + OFF_WT_ODOUT) + (size_t)mat * 1024 * 1024; c.sld = 1024; nsrc = 1024; kind = 0; c.K = 1024; NT = 16; }
    else if (t < S6) { loc = t - S5; const int mat = loc / 16; loc -= mat * 16; c.src = p.s5_w_glu + (size_t)mat * 512 * 512; c.dst = (bf16_t*)(ws + OFF_WT_GLU) + (size_t)mat * 512 * 512; c.sld = 512; nsrc = 512; kind = 0; c.K = 512; NT = 8; }
    else { loc = t - S6; const int mat = loc / 8; loc -= mat * 8; c.src = p.router_w + (size_t)mat * 1024 * 32; c.dst = (bf16_t*)(ws + OFF_WT_RT) + (size_t)mat * 128 * 1024; c.sld = 32; nsrc = 32; kind = 0; c.K = 1024; NT = 2; }
    const int kt = loc / NT, nt = loc - kt * NT;
    c.n0 = nt * 64; c.k0 = kt * 256;
    c.sc = colmap(kind, c.n0 + n4 * 4, nsrc);
    return c;
}
__device__ __forceinline__ void conv_load(const ConvTile& c, int kp, f32x4 (&v)[8]) {
#pragma unroll
    for (int i = 0; i < 4; ++i)
#pragma unroll
        for (int e = 0; e < 2; ++e) {
            const int k = c.k0 + 2 * (kp + 32 * i) + e;
            v[2 * i + e] = c.sc >= 0 ? *(const f32x4*)(c.src + (size_t)k * c.sld + c.sc) : (f32x4){0.f, 0.f, 0.f, 0.f};
        }
}

__device__ __forceinline__ void conv_phase(PRef p, char* smem, int bid, int nb) {
    char* ws = p.ws;
    constexpr int NTILES = 128 * 32 * 4 + 128 * 16 * 4 + 2 * 36 * 4 + 2 * 104 * 4 + 2 * 16 * 4 + 2 * 16 * 4 + 2 * 8 * 2 + 4 * 2 * 4;
    bf16_t* tile = (bf16_t*)smem;
    const int tid = otid(), n4 = tid & 15, kp = tid >> 4;
    if (bid < NTILES) {
        ConvTile cur = conv_decode(p, bid, n4);
        f32x4 v[8];
        conv_load(cur, kp, v);
        for (int t = bid; t < NTILES; t += nb) {
            const bool more = t + nb < NTILES;
            ConvTile nxt = cur; f32x4 w[8];
            if (more) { nxt = conv_decode(p, t + nb, n4); conv_load(nxt, kp, w); }
#pragma unroll
            for (int i = 0; i < 4; ++i)
#pragma unroll
                for (int j = 0; j < 4; ++j)
                    *(unsigned*)(tile + (n4 * 4 + j) * 258 + 2 * (kp + 32 * i)) = pk2(v[2 * i][j], v[2 * i + 1][j]);
            __syncthreads();
#pragma unroll
            for (int i = 0; i < 4; ++i) {
                const int c = tid + 512 * i, n = c >> 5, kc = c & 31;
                const unsigned* tp = (const unsigned*)(tile + n * 258 + kc * 8);
                u32x4 o; o.x = tp[0]; o.y = tp[1]; o.z = tp[2]; o.w = tp[3];
                *(u32x4*)(cur.dst + (size_t)(cur.n0 + n) * cur.K + cur.k0 + kc * 8) = o;
            }
            __syncthreads();
            if (more) {
                cur = nxt;
#pragma unroll
                for (int i = 0; i < 8; ++i) v[i] = w[i];
            }
        }
    }
    {
        const float* x = p.x; bf16_t* xb = (bf16_t*)(ws + OFF_XB);
        const long nch = (long)T_ * 1024 / 8;
        for (long c = (long)bid * NTHR + otid(); c < nch; c += (long)nb * NTHR) {
            const f32x4 a = *(const f32x4*)(x + c * 8), b = *(const f32x4*)(x + c * 8 + 4);
            u32x4 w; w.x = pk2(a[0], a[1]); w.y = pk2(a[2], a[3]); w.z = pk2(b[0], b[1]); w.w = pk2(b[2], b[3]);
            *(u32x4*)(xb + c * 8) = w;
        }
    }
    if (bid == 0 && otid() < 128) ((int*)(ws + OFF_CNT))[otid()] = 0;
}

__device__ __forceinline__ void s5mat_unit(PRef p, int u, char* smem) {
    float* cre = (float*)smem;
    float* cim = cre + 16 * 65;
    float* bbr = cim + 16 * 65;
    float* bbi = bbr + 1024;
    float* pwr = bbi + 1024;
    float* pwi = pwr + 65 * 65;
    float* zr = pwi + 65 * 65;
    float* zi = zr + 64;
    float* Kd = zi + 64 + 2;
    const int tid = otid();
    const int jg = u >> 2, q = u & 3;
    if (tid < 64) {
        const int pp = tid;
        const float lre = fminf(p.s5_a_re[jg * 64 + pp], -1e-4f), lim = p.s5_a_im[jg * 64 + pp];
        const float dt = expf(p.s5_log_dt[jg]);
        const float xr = lre * dt, th = lim * dt;
        const float mag = expf(xr);
        const float ar = mag * cosf(th), ai = mag * sinf(th);
        const float inv = 1.f / (lre * lre + lim * lim);
        zr[pp] = ((ar - 1.f) * lre + ai * lim) * inv;
        zi[pp] = (ai * lre - (ar - 1.f) * lim) * inv;
        float wr_ = 1.f, wi_ = 0.f;
        for (int d = 0; d <= 64; ++d) {
            pwr[d * 65 + pp] = wr_; pwi[d * 65 + pp] = wi_;
            const float nr = wr_ * ar - wi_ * ai, ni = wr_ * ai + wi_ * ar;
            wr_ = nr; wi_ = ni;
        }
    } else {
        for (int e = tid - 64; e < 1024; e += NTHR - 64) {
            const int n = e >> 6, pp = e & 63;
            cre[n * 65 + pp] = p.s5_c_re[(size_t)jg * 1024 + e];
            cim[n * 65 + pp] = p.s5_c_im[(size_t)jg * 1024 + e];
        }
    }
    __syncthreads();
    for (int e = tid; e < 1024; e += NTHR) {
        const int pp = e >> 4;
        const float br = p.s5_b_re[(size_t)jg * 1024 + e], bi = p.s5_b_im[(size_t)jg * 1024 + e];
        bbr[e] = zr[pp] * br - zi[pp] * bi;
        bbi[e] = zr[pp] * bi + zi[pp] * br;
    }
    __syncthreads();
    if (tid < 256) {
        const int mh = tid & 1, nl = (tid >> 1) & 3, dp = tid >> 3, n = 4 * q + nl;
        float acc0[8], acc1[8];
#pragma unroll
        for (int i = 0; i < 8; ++i) { acc0[i] = 0.f; acc1[i] = 0.f; }
#pragma unroll 2
        for (int pp = 0; pp < 64; ++pp) {
            const float cr = cre[n * 65 + pp], ci = cim[n * 65 + pp];
            const float q0r = pwr[(2 * dp) * 65 + pp], q0i = pwi[(2 * dp) * 65 + pp], q1r = pwr[(2 * dp + 1) * 65 + pp], q1i = pwi[(2 * dp + 1) * 65 + pp];
            const float v0r = cr * q0r - ci * q0i, v0i = cr * q0i + ci * q0r, v1r = cr * q1r - ci * q1i, v1i = cr * q1i + ci * q1r;
            const f32x4 ba = *(const f32x4*)(bbr + pp * 16 + mh * 8), bb_ = *(const f32x4*)(bbr + pp * 16 + mh * 8 + 4);
            const f32x4 ia = *(const f32x4*)(bbi + pp * 16 + mh * 8), ib = *(const f32x4*)(bbi + pp * 16 + mh * 8 + 4);
#pragma unroll
            for (int i = 0; i < 8; ++i) {
                const float br = i < 4 ? ba[i & 3] : bb_[i & 3], bi = i < 4 ? ia[i & 3] : ib[i & 3];
                acc0[i] += v0r * br - v0i * bi;
                acc1[i] += v1r * br - v1i * bi;
            }
        }
        float* k0 = Kd + ((2 * dp) * 4 + nl) * 16 + mh * 8;
        *(f32x4*)(k0) = (f32x4){acc0[0], acc0[1], acc0[2], acc0[3]};
        *(f32x4*)(k0 + 4) = (f32x4){acc0[4], acc0[5], acc0[6], acc0[7]};
        *(f32x4*)(k0 + 64) = (f32x4){acc1[0], acc1[1], acc1[2], acc1[3]};
        *(f32x4*)(k0 + 68) = (f32x4){acc1[4], acc1[5], acc1[6], acc1[7]};
    }
    __syncthreads();
    bf16_t* TH = (bf16_t*)(p.ws + OFF_TH) + (size_t)jg * 1024 * UHW;
    for (int c = tid; c < 256 * 144; c += NTHR) {
        const int rl = c / 144, ch = c - rl * 144;
        const int tau = rl >> 2, nl = rl & 3, n = 4 * q + nl;
        float v[8];
        if (ch < 128) {
            const int s = ch >> 1, m0 = (ch & 1) * 8;
            if (s <= tau) {
                const f32x4 a = *(const f32x4*)(Kd + ((tau - s) * 4 + nl) * 16 + m0), b = *(const f32x4*)(Kd + ((tau - s) * 4 + nl) * 16 + m0 + 4);
#pragma unroll
                for (int i = 0; i < 4; ++i) { v[i] = a[i]; v[4 + i] = b[i]; }
            } else {
#pragma unroll
                for (int i = 0; i < 8; ++i) v[i] = 0.f;
            }
        } else {
            const int p0 = (ch - 128) * 4;
#pragma unroll
            for (int i = 0; i < 4; ++i) {
                const int pp = p0 + i;
                const float cr = cre[n * 65 + pp], ci = cim[n * 65 + pp], qr = pwr[(tau + 1) * 65 + pp], qi = pwi[(tau + 1) * 65 + pp];
                v[2 * i] = cr * qr - ci * qi;
                v[2 * i + 1] = -(cr * qi + ci * qr);
            }
        }
        u32x4 w; w.x = pk2(v[0], v[1]); w.y = pk2(v[2], v[3]); w.z = pk2(v[4], v[5]); w.w = pk2(v[6], v[7]);
        *(u32x4*)(TH + (size_t)(tau * 16 + n) * UHW + ch * 8) = w;
    }
    bf16_t* GM = (bf16_t*)(p.ws + OFF_GM) + (size_t)jg * 128 * 1024;
    for (int c = tid; c < 32 * 128; c += NTHR) {
        const int row = 32 * q + (c >> 7), ch = c & 127;
        const int pp = row >> 1, ri = row & 1;
        const int s = ch >> 1, m0 = (ch & 1) * 8;
        const float qr = pwr[(63 - s) * 65 + pp], qi = pwi[(63 - s) * 65 + pp];
        float v[8];
#pragma unroll
        for (int i = 0; i < 8; ++i) {
            const float br = bbr[pp * 16 + m0 + i], bi = bbi[pp * 16 + m0 + i];
            v[i] = ri == 0 ? (qr * br - qi * bi) : (qr * bi + qi * br);
        }
        u32x4 w; w.x = pk2(v[0], v[1]); w.y = pk2(v[2], v[3]); w.z = pk2(v[4], v[5]); w.w = pk2(v[6], v[7]);
        *(u32x4*)(GM + (size_t)row * 1024 + ch * 8) = w;
    }
    if (q == 0 && tid < 64) {
        float* A64 = (float*)(p.ws + OFF_A64) + (size_t)jg * 128;
        A64[tid * 2] = pwr[64 * 65 + tid];
        A64[tid * 2 + 1] = pwi[64 * 65 + tid];
    }
    __syncthreads();
}

__device__ __forceinline__ void epi_ev_in(PRef p, f32x4 (&acc)[4][2], int row0, int c0, int fr, int fq) {
    char* ws = p.ws;
    bf16_t* PE = (bf16_t*)(ws + OFF_PE); bf16_t* UH = (bf16_t*)(ws + OFF_UH); float* GLR = (float*)(ws + OFF_GLR);
    const int col = c0 + 8 * fq;
#pragma unroll
    for (int m = 0; m < 4; ++m) {
        const int t = row0 + m * 16 + fr;
        u32x4 w; w.x = pk2(acc[m][0][0], acc[m][0][1]); w.y = pk2(acc[m][0][2], acc[m][0][3]); w.z = pk2(acc[m][1][0], acc[m][1][1]); w.w = pk2(acc[m][1][2], acc[m][1][3]);
        if (c0 < 1024) {
            *(u32x4*)(PE + (size_t)t * PE_W + col) = w;
        } else if (c0 < 1536) {
            const int ch = col - 1024, g = ch >> 4, mm = ch & 15;
            *(u32x4*)(UH + ((size_t)(t >> 6) * 32 + g) * UHW + (t & 63) * 16 + mm) = w;
        } else if (col < 1552) {
            *(f32x4*)(GLR + (size_t)t * 16 + (col - 1536)) = acc[m][0];
            *(f32x4*)(GLR + (size_t)t * 16 + (col - 1536) + 4) = acc[m][1];
        }
    }
}
__device__ __forceinline__ void epi_vt(bf16_t* __restrict__ img_row0, f32x4 (&acc)[4][2], int rt0, int c0, int fr, int fq) {
#pragma unroll
    for (int m = 0; m < 4; ++m) {
        u32x4 w; w.x = pk2(acc[m][0][0], acc[m][0][1]); w.y = pk2(acc[m][0][2], acc[m][0][3]); w.z = pk2(acc[m][1][0], acc[m][1][1]); w.w = pk2(acc[m][1][2], acc[m][1][3]);
        *(u32x4*)(img_row0 + (size_t)(rt0 + m * 16 + fr) * L_ + c0 + 8 * fq) = w;
    }
}

__device__ __forceinline__ void gla_decay(PRef p, int j, int t0, int h, float* sB) {
    const float* GLR = (const float*)(p.ws + OFF_GLR);
    const float* w2 = p.gla_w_gate2 + (size_t)j * 16 * 256;
    const float* b2 = p.gla_b_gate2 + (size_t)j * 256;
    const int tid = otid();
    for (int e = tid; e < 4096; e += NTHR) {
        const int tau = e >> 6, d = e & 63;
        float a = b2[h * 64 + d];
#pragma unroll
        for (int r = 0; r < 16; ++r) a += GLR[(size_t)(t0 + tau) * 16 + r] * w2[r * 256 + h * 64 + d];
        const float ls = fminf(a, 0.f) - __logf(1.f + __expf(-fabsf(a)));
        sB[tau * 65 + d] = ls * (1.f / 16.f);
    }
    __syncthreads();
    if (tid < 64) { float run = 0.f; for (int tau = 0; tau < 64; ++tau) { run += sB[tau * 65 + tid]; sB[tau * 65 + tid] = run; } }
    __syncthreads();
}

__device__ __forceinline__ void gla_a_item(PRef p, int j, int item, char* smem) {
    const int h = item & 3, c = (item >> 2) & 255, b = item >> 10;
    const int t0 = b * L_ + c * 64;
    float* sB = (float*)smem;
    bf16_t* AK = (bf16_t*)(smem + 16640);
    const bf16_t* PE = (const bf16_t*)(p.ws + OFF_PE);
    const bf16_t* VTE = (const bf16_t*)(p.ws + OFF_VTE);
    const int tid = otid(), lane = tid & 63, wave = tid >> 6, fr = lane & 15, fq = lane >> 4;
    gla_decay(p, j, t0, h, sB);
    for (int e = tid; e < 4096; e += NTHR) {
        const int tau = e >> 6, d = e & 63;
        const float k = bf2f(PE[(size_t)(t0 + tau) * PE_W + 256 + h * 64 + d]);
        AK[d * 72 + tau] = f2bf(k * __expf(sB[63 * 65 + d] - sB[tau * 65 + d]));
    }
    __syncthreads();
    const int dblk = wave >> 1, vb = (wave & 1) * 64;
    f32x4 acc[4];
#pragma unroll
    for (int n = 0; n < 4; ++n) acc[n] = (f32x4){0.f, 0.f, 0.f, 0.f};
#pragma unroll
    for (int ks = 0; ks < 2; ++ks) {
        const bf16x8 af = *(const bf16x8*)(AK + (dblk * 16 + fr) * 72 + ks * 32 + fq * 8);
#pragma unroll
        for (int n = 0; n < 4; ++n) {
            const int v = vb + n * 16 + fr;
            const bf16x8 bfr = *(const bf16x8*)(VTE + ((size_t)((b * 4 + h) * 128 + v)) * L_ + (c * 64 + ks * 32 + fq * 8));
            acc[n] = __builtin_amdgcn_mfma_f32_16x16x32_bf16(af, bfr, acc[n], 0, 0, 0);
        }
    }
    float* KV = (float*)(p.ws + OFF_KV) + ((size_t)((b * 256 + c) * 4 + h)) * 64 * 128;
#pragma unroll
    for (int n = 0; n < 4; ++n)
#pragma unroll
        for (int r = 0; r < 4; ++r) KV[(dblk * 16 + fq * 4 + r) * 128 + vb + n * 16 + fr] = acc[n][r];
    if (tid < 64) ((float*)(p.ws + OFF_DEC))[((size_t)((b * 256 + c) * 4 + h)) * 64 + tid] = __expf(sB[63 * 65 + tid]);
    __syncthreads();
}

__device__ __forceinline__ void scan_phase(PRef p, int j, int bid) {
    const int gid = bid * NTHR + otid();
    if (gid < 65536) {
        const int v = gid & 127, d = (gid >> 7) & 63, h = (gid >> 13) & 3, b = gid >> 15;
        const float* KV = (const float*)(p.ws + OFF_KV); float* SST = (float*)(p.ws + OFF_SST); const float* DEC = (const float*)(p.ws + OFF_DEC);
        float S = 0.f;
        for (int c0 = 0; c0 < 256; c0 += 8) {
            float kv[8], dc[8];
#pragma unroll
            for (int i = 0; i < 8; ++i) {
                const size_t blk = (size_t)((b * 256 + c0 + i) * 4 + h);
                kv[i] = KV[(blk * 64 + d) * 128 + v]; dc[i] = DEC[blk * 64 + d];
            }
#pragma unroll
            for (int i = 0; i < 8; ++i) {
                const size_t blk = (size_t)((b * 256 + c0 + i) * 4 + h);
                SST[(blk * 64 + d) * 128 + v] = S;
                S = dc[i] * S + kv[i];
            }
        }
    } else if (gid < 65536 + 4096) {
        const int e = gid - 65536, pp = e & 63, g = (e >> 6) & 31, b = e >> 11;
        const float* A64 = (const float*)(p.ws + OFF_A64) + (size_t)(j * 32 + g) * 128;
        const float ar = A64[pp * 2], ai = A64[pp * 2 + 1];
        const float* GB = (const float*)(p.ws + OFF_GBUF); bf16_t* UH = (bf16_t*)(p.ws + OFF_UH);
        float hr = 0.f, hi = 0.f;
        for (int c0 = 0; c0 < 256; c0 += 8) {
            float gr[8], gi[8];
#pragma unroll
            for (int i = 0; i < 8; ++i) { const size_t row = (size_t)(b * 256 + c0 + i) * 32 + g; gr[i] = GB[row * 128 + 2 * pp]; gi[i] = GB[row * 128 + 2 * pp + 1]; }
#pragma unroll
            for (int i = 0; i < 8; ++i) {
                const size_t row = (size_t)(b * 256 + c0 + i) * 32 + g;
                *(unsigned*)(UH + row * UHW + 1024 + 2 * pp) = pk2(hr, hi);
                const float nr = ar * hr - ai * hi + gr[i], ni = ar * hi + ai * hr + gi[i];
                hr = nr; hi = ni;
            }
        }
    }
}

__device__ __forceinline__ void gla_c_item(PRef p, int j, int item, char* smem) {
    const int h = item & 3, c = (item >> 2) & 255, b = item >> 10;
    const int t0 = b * L_ + c * 64;
    float* sB = (float*)smem;
    bf16_t* QT = (bf16_t*)(smem + 16640);
    bf16_t* KT = (bf16_t*)(smem + 16640 + 9216);
    bf16_t* ATT = (bf16_t*)(smem + 16640 + 18432);
    float* OS = (float*)(smem + 16640 + 27648);
    const bf16_t* PE = (const bf16_t*)(p.ws + OFF_PE);
    const bf16_t* VTE = (const bf16_t*)(p.ws + OFF_VTE);
    const int tid = otid(), lane = tid & 63, wave = tid >> 6, fr = lane & 15, fq = lane >> 4;
    gla_decay(p, j, t0, h, sB);
    for (int e = tid; e < 4096; e += NTHR) {
        const int tau = e >> 6, d = e & 63;
        const float bb = sB[tau * 65 + d];
        const float q = bf2f(PE[(size_t)(t0 + tau) * PE_W + h * 64 + d]);
        const float k = bf2f(PE[(size_t)(t0 + tau) * PE_W + 256 + h * 64 + d]);
        QT[tau * 72 + d] = f2bf(q * 0.125f * __expf(bb));
        KT[tau * 72 + d] = f2bf(k * __expf(-bb));
    }
    __syncthreads();
    const int iblk = wave >> 1;
    {
        f32x4 acc[2];
        acc[0] = (f32x4){0.f, 0.f, 0.f, 0.f}; acc[1] = acc[0];
#pragma unroll
        for (int ks = 0; ks < 2; ++ks) {
            const bf16x8 af = *(const bf16x8*)(QT + (iblk * 16 + fr) * 72 + ks * 32 + fq * 8);
#pragma unroll
            for (int n = 0; n < 2; ++n) {
                const int jb = (wave & 1) * 2 + n;
                const bf16x8 bfr = *(const bf16x8*)(KT + (jb * 16 + fr) * 72 + ks * 32 + fq * 8);
                acc[n] = __builtin_amdgcn_mfma_f32_16x16x32_bf16(af, bfr, acc[n], 0, 0, 0);
            }
        }
#pragma unroll
        for (int n = 0; n < 2; ++n) {
            const int jj = ((wave & 1) * 2 + n) * 16 + fr;
#pragma unroll
            for (int r = 0; r < 4; ++r) { const int ii = iblk * 16 + fq * 4 + r; ATT[ii * 72 + jj] = f2bf(jj <= ii ? acc[n][r] : 0.f); }
        }
    }
    __syncthreads();
    {
        const int vb = (wave & 1) * 64;
        const float* SST = (const float*)(p.ws + OFF_SST) + ((size_t)((b * 256 + c) * 4 + h)) * 64 * 128;
        f32x4 acc[4];
#pragma unroll
        for (int n = 0; n < 4; ++n) acc[n] = (f32x4){0.f, 0.f, 0.f, 0.f};
#pragma unroll
        for (int ks = 0; ks < 2; ++ks) {
            const bf16x8 af = *(const bf16x8*)(ATT + (iblk * 16 + fr) * 72 + ks * 32 + fq * 8);
            const bf16x8 aq = *(const bf16x8*)(QT + (iblk * 16 + fr) * 72 + ks * 32 + fq * 8);
#pragma unroll
            for (int n = 0; n < 4; ++n) {
                const int v = vb + n * 16 + fr;
                const bf16x8 bv = *(const bf16x8*)(VTE + ((size_t)((b * 4 + h) * 128 + v)) * L_ + (c * 64 + ks * 32 + fq * 8));
                acc[n] = __builtin_amdgcn_mfma_f32_16x16x32_bf16(af, bv, acc[n], 0, 0, 0);
                bf16x8 bs;
#pragma unroll
                for (int i = 0; i < 8; ++i) bs[i] = (short)f2bf(SST[(ks * 32 + fq * 8 + i) * 128 + v]);
                acc[n] = __builtin_amdgcn_mfma_f32_16x16x32_bf16(aq, bs, acc[n], 0, 0, 0);
            }
        }
#pragma unroll
        for (int n = 0; n < 4; ++n)
#pragma unroll
            for (int r = 0; r < 4; ++r) OS[(iblk * 16 + fq * 4 + r) * 132 + vb + n * 16 + fr] = acc[n][r];
    }
    __syncthreads();
    {
        const int i = tid >> 3, seg = tid & 7;
        float o[16]; float ss = 0.f;
#pragma unroll
        for (int q = 0; q < 16; ++q) { o[q] = OS[i * 132 + seg * 16 + q]; ss += o[q] * o[q]; }
        ss += __shfl_xor(ss, 1, 64); ss += __shfl_xor(ss, 2, 64); ss += __shfl_xor(ss, 4, 64);
        const float rs = rsqrtf(ss * (1.f / 128.f) + LN_EPS);
        const float* ng = p.gla_norm_g + (size_t)j * 128;
        bf16_t* CC = (bf16_t*)(p.ws + OFF_CC);
        const size_t t = (size_t)(t0 + i);
        unsigned w[8];
#pragma unroll
        for (int q = 0; q < 16; q += 2) {
            const int v0 = seg * 16 + q;
            const float r0 = bf2f(PE[t * PE_W + 512 + h * 128 + v0]), r1 = bf2f(PE[t * PE_W + 512 + h * 128 + v0 + 1]);
            const float a0 = o[q] * rs * ng[v0] * (r0 * sigmoidf_(r0)), a1 = o[q + 1] * rs * ng[v0 + 1] * (r1 * sigmoidf_(r1));
            w[q >> 1] = pk2(a0, a1);
        }
        u32x4 w0, w1; w0.x = w[0]; w0.y = w[1]; w0.z = w[2]; w0.w = w[3]; w1.x = w[4]; w1.y = w[5]; w1.z = w[6]; w1.w = w[7];
        *(u32x4*)(CC + t * 1024 + h * 128 + seg * 16) = w0;
        *(u32x4*)(CC + t * 1024 + h * 128 + seg * 16 + 8) = w1;
    }
    __syncthreads();
}

__device__ __forceinline__ void s5_g_phase(PRef p, int j, char* smem, int bid, int nb) {
    const bf16_t* UH = (const bf16_t*)(p.ws + OFF_UH);
    float* GB = (float*)(p.ws + OFF_GBUF);
    for (int t = bid; t < 64; t += nb) {
        const int g = t >> 1, mi = t & 1;
        const bf16_t* Bt = (const bf16_t*)(p.ws + OFF_GM) + (size_t)(j * 32 + g) * 128 * 1024;
        gemm_tile<false>(UH + (size_t)g * UHW, (long)32 * UHW, 0, mi * 256, Bt, 1024, 0, 1024, smem,
            [&](f32x4 (&acc)[4][2], int rt0, int c0, int fr, int fq) {
#pragma unroll
                for (int m = 0; m < 4; ++m)
#pragma unroll
                    for (int n = 0; n < 2; ++n)
#pragma unroll
                        for (int r = 0; r < 4; ++r) {
                            const int row = mi * 256 + rt0 + m * 16 + fq * 4 + r;
                            GB[((size_t)row * 32 + g) * 128 + c0 + n * 16 + fr] = acc[m][n][r];
                        }
            });
    }
}
__device__ __forceinline__ void s5_y_phase(PRef p, int j, char* smem, int bid, int nb) {
    const bf16_t* UH = (const bf16_t*)(p.ws + OFF_UH);
    bf16_t* YA = (bf16_t*)(p.ws + OFF_YA);
    const float* dsk = p.s5_d + (size_t)j * 512;
    XcdSeq sq(32 * 2 * 4, bid, nb);
    for (int t = sq.q; t < sq.qend; t += sq.step) {
        const int g = t >> 3, mi = (t >> 2) & 1, ni = t & 3;
        const bf16_t* Bt = (const bf16_t*)(p.ws + OFF_TH) + (size_t)(j * 32 + g) * 1024 * UHW;
        gemm256_tile<false>(UH + (size_t)g * UHW, (long)32 * UHW, 0, mi * 256, Bt, UHW, ni * 256, UHW, smem,
            [&](f32x4 (&acc)[4][2], int rt0, int c0, int fr, int fq) {
                const int col = c0 + 8 * fq;
                const int tau = col >> 4, nn = col & 15, ch = g * 16 + nn;
                const f32x4 d0 = *(const f32x4*)(dsk + ch), d1 = *(const f32x4*)(dsk + ch + 4);
#pragma unroll
                for (int m = 0; m < 4; ++m) {
                    const int row = mi * 256 + rt0 + m * 16 + fr;
                    const u32x4 uw = *(const u32x4*)(UH + ((size_t)row * 32 + g) * UHW + col);
                    float y[8];
#pragma unroll
                    for (int q = 0; q < 4; ++q) {
                        const unsigned u2 = q == 0 ? uw.x : q == 1 ? uw.y : q == 2 ? uw.z : uw.w;
                        const float u0 = __uint_as_float(u2 << 16), u1 = __uint_as_float(u2 & 0xffff0000u);
                        const float a0 = q < 2 ? acc[m][0][2 * q] : acc[m][1][2 * q - 4], a1 = q < 2 ? acc[m][0][2 * q + 1] : acc[m][1][2 * q - 3];
                        const float dd0 = q < 2 ? d0[2 * q] : d1[2 * q - 4], dd1 = q < 2 ? d0[2 * q + 1] : d1[2 * q - 3];
                        y[2 * q] = gelu_tanh(a0 + dd0 * u0); y[2 * q + 1] = gelu_tanh(a1 + dd1 * u1);
                    }
                    u32x4 w; w.x = pk2(y[0], y[1]); w.y = pk2(y[2], y[3]); w.z = pk2(y[4], y[5]); w.w = pk2(y[6], y[7]);
                    *(u32x4*)(YA + ((size_t)row * 64 + tau) * 512 + ch) = w;
                }
            });
    }
}

template <bool SLOTS, bool NOEPI = false>
__device__ __forceinline__ void ln_phase(PRef p, const bf16_t* xin, const float* addb, const float* g, const float* bta, float* xout, bf16_t* xb, int bid, int nb) {
    const int lane = otid() & 63, wave = otid() >> 6;
    for (int t = bid * 8 + wave; t < T_; t += nb * 8) {
        f32x4 v[4];
        float s = 0.f;
#pragma unroll
        for (int i = 0; i < 4; ++i) {
            const int c = i * 256 + lane * 4;
            f32x4 a;
            { const u32x2 xw = *(const u32x2*)(xin + (size_t)t * 1024 + c); a = (f32x4){__uint_as_float(xw.x << 16), __uint_as_float(xw.x & 0xffff0000u), __uint_as_float(xw.y << 16), __uint_as_float(xw.y & 0xffff0000u)}; }
            f32x4 m;
            if (SLOTS) {
                const bf16_t* sl = (const bf16_t*)addb;
                m = (f32x4){0.f, 0.f, 0.f, 0.f};
#pragma unroll
                for (int k = 0; k < 4; ++k) {
                    const u32x2 w = *(const u32x2*)(sl + ((size_t)t * 4 + k) * 1024 + c);
                    m[0] += __uint_as_float(w.x << 16); m[1] += __uint_as_float(w.x & 0xffff0000u); m[2] += __uint_as_float(w.y << 16); m[3] += __uint_as_float(w.y & 0xffff0000u);
                }
            } else m = *(const f32x4*)(addb + (size_t)t * 1024 + c);
            v[i] = a * ALPHA + m;
            s += v[i][0] + v[i][1] + v[i][2] + v[i][3];
        }
        const float mu = wave_sum(s) * (1.f / 1024.f);
        float q = 0.f;
#pragma unroll
        for (int i = 0; i < 4; ++i) { v[i] -= mu; q += v[i][0] * v[i][0] + v[i][1] * v[i][1] + v[i][2] * v[i][2] + v[i][3] * v[i][3]; }
        const float rs = rsqrtf(wave_sum(q) * (1.f / 1024.f) + LN_EPS);
#pragma unroll
        for (int i = 0; i < 4; ++i) {
            const int c = i * 256 + lane * 4;
            const f32x4 gg = *(const f32x4*)(g + c), bb = *(const f32x4*)(bta + c);
            const f32x4 o = v[i] * rs * gg + bb;
            if (xout && !NOEPI) *(f32x4*)(xout + (size_t)t * 1024 + c) = o;
            if (xb && !NOEPI) { u32x2 w; w.x = pk2(o[0], o[1]); w.y = pk2(o[2], o[3]); *(u32x2*)(xb + (size_t)t * 1024 + c) = w; }
        }
    }
}

constexpr int RT_STRIDE = 36;
constexpr int RT_SCR_OFF = 1024 * RT_STRIDE * 4;
template <bool NOEPI = false>
__device__ __forceinline__ void ln1_router_phase(PRef p, int layer, char* smem, int bid, int nb) {
    float* wl = (float*)smem;
    const int tid = otid(), lane = tid & 63, wave = tid >> 6;
    float* lgs = (float*)(smem + RT_SCR_OFF + wave * 640);
    int* pick = (int*)(lgs + 32);
    float* pgate = (float*)(pick + 64);
    {
        const float* rw = p.router_w + (size_t)layer * 1024 * 32;
        for (int e = tid; e < 32768; e += NTHR) {
            const int k = e >> 5, ex = e & 31, rem = k & 255;
            wl[((k & ~255) + (rem & 3) * 64 + (rem >> 2)) * RT_STRIDE + ex] = rw[e];
        }
    }
    __syncthreads();
    const bf16_t* addb = (const bf16_t*)(p.ws + OFF_MIX);
    const float* g = p.ln1_g + (size_t)layer * 1024; const float* bta = p.ln1_b + (size_t)layer * 1024;
    bf16_t* xb = (bf16_t*)(p.ws + OFF_XB);
    const bf16_t* xin = xb;
    int* cnt = (int*)(p.ws + OFF_CNT) + layer * 32;
    int* LIST = (int*)(p.ws + OFF_LIST);
    float* GATE = (float*)(p.ws + OFF_GATE);
    const float rbias = p.router_b[(size_t)layer * 32 + (lane >> 1)];
    const int rstep = nb * 8;
    f32x4 xa[4], xm[4];
    {
        const int t0 = bid * 8 + wave;
        if (t0 < T_) {
#pragma unroll
            for (int i = 0; i < 4; ++i) { const int c = i * 256 + lane * 4; { const u32x2 xw = *(const u32x2*)(xin + (size_t)t0 * 1024 + c); xa[i] = (f32x4){__uint_as_float(xw.x << 16), __uint_as_float(xw.x & 0xffff0000u), __uint_as_float(xw.y << 16), __uint_as_float(xw.y & 0xffff0000u)}; } { const u32x2 mw = *(const u32x2*)(addb + (size_t)t0 * 1024 + c); xm[i] = (f32x4){__uint_as_float(mw.x << 16), __uint_as_float(mw.x & 0xffff0000u), __uint_as_float(mw.y << 16), __uint_as_float(mw.y & 0xffff0000u)}; } }
        }
    }
    for (int tb = bid * 8 + wave; tb < T_; tb += rstep * 16) {
        int nrow = 0;
#pragma unroll 1
        for (int t = tb; t < T_ && nrow < 16; t += rstep, ++nrow) {
            f32x4 v[4];
            float s = 0.f;
#pragma unroll
            for (int i = 0; i < 4; ++i) { v[i] = xa[i] * ALPHA + xm[i]; s += v[i][0] + v[i][1] + v[i][2] + v[i][3]; }
            if (t + rstep < T_) {
#pragma unroll
                for (int i = 0; i < 4; ++i) { const int c = i * 256 + lane * 4; { const u32x2 xw = *(const u32x2*)(xin + (size_t)(t + rstep) * 1024 + c); xa[i] = (f32x4){__uint_as_float(xw.x << 16), __uint_as_float(xw.x & 0xffff0000u), __uint_as_float(xw.y << 16), __uint_as_float(xw.y & 0xffff0000u)}; } { const u32x2 mw = *(const u32x2*)(addb + (size_t)(t + rstep) * 1024 + c); xm[i] = (f32x4){__uint_as_float(mw.x << 16), __uint_as_float(mw.x & 0xffff0000u), __uint_as_float(mw.y << 16), __uint_as_float(mw.y & 0xffff0000u)}; } }
            }
            const float mu = wave_sum(s) * (1.f / 1024.f);
            float q = 0.f;
#pragma unroll
            for (int i = 0; i < 4; ++i) { v[i] -= mu; q += v[i][0] * v[i][0] + v[i][1] * v[i][1] + v[i][2] * v[i][2] + v[i][3] * v[i][3]; }
            const float rs = rsqrtf(wave_sum(q) * (1.f / 1024.f) + LN_EPS);
#pragma unroll
            for (int i = 0; i < 4; ++i) {
                const int c = i * 256 + lane * 4;
                const f32x4 gg = *(const f32x4*)(g + c), bb = *(const f32x4*)(bta + c);
                v[i] = v[i] * rs * gg + bb;
                if (!NOEPI) {
                u32x2 w; w.x = pk2(v[i][0], v[i][1]); w.y = pk2(v[i][2], v[i][3]); *(u32x2*)(xb + (size_t)t * 1024 + c) = w; }
            }
            f32x4 acc[8];
#pragma unroll
            for (int e = 0; e < 8; ++e) acc[e] = (f32x4){0.f, 0.f, 0.f, 0.f};
#pragma unroll
            for (int i = 0; i < 4; ++i)
#pragma unroll
                for (int j = 0; j < 4; ++j) {
                    const f32x4* wr_ = (const f32x4*)(wl + (i * 256 + j * 64 + lane) * RT_STRIDE);
                    const float xv = v[i][j];
#pragma unroll
                    for (int e = 0; e < 8; ++e) acc[e] += wr_[e] * xv;
                }
            float k16[16], k8[8], k4[4], k2[2];
#pragma unroll
            for (int a = 0; a < 16; ++a) { auto r = __builtin_amdgcn_permlane32_swap(__float_as_uint(acc[a >> 2][a & 3]), __float_as_uint(acc[(a + 16) >> 2][a & 3]), false, false); k16[a] = __uint_as_float(r[0]) + __uint_as_float(r[1]); }
#pragma unroll
            for (int a = 0; a < 8; ++a) { auto r = __builtin_amdgcn_permlane16_swap(__float_as_uint(k16[a]), __float_as_uint(k16[a + 8]), false, false); k8[a] = __uint_as_float(r[0]) + __uint_as_float(r[1]); }
            { const bool hb = lane & 8;
#pragma unroll
              for (int a = 0; a < 4; ++a) { const float mine = hb ? k8[a + 4] : k8[a], send = hb ? k8[a] : k8[a + 4]; k4[a] = mine + dppf<DPP_ROR8>(send); } }
            { const bool hb = lane & 4;
#pragma unroll
              for (int a = 0; a < 2; ++a) { const float mine = hb ? k4[a + 2] : k4[a], send = hb ? k4[a] : k4[a + 2]; k2[a] = mine + dppf<DPP_HMIR>(send); } }
            float lg;
            { const bool hb = lane & 2; const float mine = hb ? k2[1] : k2[0], send = hb ? k2[0] : k2[1]; lg = mine + dppf<DPP_X2>(send); }
            lg += dppf<DPP_X1>(lg);
            lg += rbias;
            float cand = (lane & 1) ? -INFINITY : lg;
            float tv[4]; int te[4];
#pragma unroll
            for (int r = 0; r < 4; ++r) {
                const float mxv = wave_max(cand);
                const unsigned long long bal = __builtin_amdgcn_ballot_w64(cand == mxv);
                const int first = __builtin_ctzll(bal);
                tv[r] = mxv; te[r] = first >> 1;
                if (lane == first) cand = -INFINITY;
            }
            if (lane == 0) {
                const float e1 = __expf(tv[1] - tv[0]), e2 = __expf(tv[2] - tv[0]), e3 = __expf(tv[3] - tv[0]);
                const float inv = 1.f / (1.f + e1 + e2 + e3);
                pick[nrow * 4 + 0] = te[0]; pick[nrow * 4 + 1] = te[1]; pick[nrow * 4 + 2] = te[2]; pick[nrow * 4 + 3] = te[3];
                pgate[nrow * 4 + 0] = inv; pgate[nrow * 4 + 1] = e1 * inv; pgate[nrow * 4 + 2] = e2 * inv; pgate[nrow * 4 + 3] = e3 * inv;
            }
        }
        if ((lane >> 2) < nrow && (!NOEPI || pgate[lane] < -1.f)) {
            const int t = tb + (lane >> 2) * rstep, ex = pick[lane], pair = t * 4 + (lane & 3);
            const int pos = atomicAdd(&cnt[ex], 1);
            LIST[(size_t)ex * LISTCAP + pos] = pair;
            GATE[pair] = pgate[lane];
        }
    }
}

__device__ __forceinline__ void topk_phase(PRef p, int layer, int bid, int nb) {
    const float* LG = (const float*)(p.ws + OFF_LOGIT);
    int* cnt = (int*)(p.ws + OFF_CNT) + layer * 32;
    int* LIST = (int*)(p.ws + OFF_LIST);
    float* GATE = (float*)(p.ws + OFF_GATE);
    for (int t = bid * NTHR + otid(); t < T_; t += nb * NTHR) {
        float v0 = -INFINITY, v1 = -INFINITY, v2 = -INFINITY, v3 = -INFINITY; int i0 = 0, i1 = 0, i2 = 0, i3 = 0;
#pragma unroll
        for (int q = 0; q < 8; ++q) {
            const f32x4 l4 = *(const f32x4*)(LG + (size_t)t * 32 + q * 4);
#pragma unroll
            for (int r = 0; r < 4; ++r) {
                const float v = l4[r]; const int e = q * 4 + r;
                if (v > v0) { v3 = v2; i3 = i2; v2 = v1; i2 = i1; v1 = v0; i1 = i0; v0 = v; i0 = e; }
                else if (v > v1) { v3 = v2; i3 = i2; v2 = v1; i2 = i1; v1 = v; i1 = e; }
                else if (v > v2) { v3 = v2; i3 = i2; v2 = v; i2 = e; }
                else if (v > v3) { v3 = v; i3 = e; }
            }
        }
        const float e1 = __expf(v1 - v0), e2 = __expf(v2 - v0), e3 = __expf(v3 - v0);
        const float inv = 1.f / (1.f + e1 + e2 + e3);
        int pos;
        pos = atomicAdd(&cnt[i0], 1); LIST[(size_t)i0 * LISTCAP + pos] = t * 4 + 0; GATE[t * 4 + 0] = inv;
        pos = atomicAdd(&cnt[i1], 1); LIST[(size_t)i1 * LISTCAP + pos] = t * 4 + 1; GATE[t * 4 + 1] = e1 * inv;
        pos = atomicAdd(&cnt[i2], 1); LIST[(size_t)i2 * LISTCAP + pos] = t * 4 + 2; GATE[t * 4 + 2] = e2 * inv;
        pos = atomicAdd(&cnt[i3], 1); LIST[(size_t)i3 * LISTCAP + pos] = t * 4 + 3; GATE[t * 4 + 3] = e3 * inv;
    }
}

template <int WHICH, bool NOEPI = false>
__device__ __forceinline__ void moe_gemm_phase(PRef p, int layer, char* smem, int bid, int nb) {
    const int* cnt = (const int*)(p.ws + OFF_CNT) + layer * 32;
    const int* LIST = (const int*)(p.ws + OFF_LIST);
    constexpr int NTN = WHICH == 1 ? 8 : 4;
    int total = 0;
    for (int i = 0; i < 32; ++i) total += ((cnt[i] + 255) >> 8) * NTN;
    XcdSeq sq(total, bid, nb);
    int e = 0, base = 0, ce = cnt[0], mt = (ce + 255) >> 8;
    auto src = [&](int i, G8Desc& d) -> bool {
        const int t = sq.q + i * sq.step;
        if (t >= sq.qend) return false;
        while (e < 32 && t >= base + mt * NTN) { base += mt * NTN; ++e; if (e < 32) { ce = cnt[e]; mt = (ce + 255) >> 8; } }
        if (e >= 32) return false;
        int mi, ni;
        { const int loc = t - base, pf = mt >> 2, full = pf * 4 * NTN;
          if (loc < full) { const int pn = loc / (4 * NTN), r = loc - pn * 4 * NTN; ni = r >> 2; mi = pn * 4 + (r & 3); }
          else { const int ph = mt - pf * 4, r = loc - full; ni = r / ph; mi = pf * 4 + (r - ni * ph); } }
        d.m0 = 0; d.n0 = ni * 256; d.list = LIST + (size_t)e * LISTCAP + mi * 256; d.count = ce - mi * 256; d.u0 = e; d.ldb = 1024;
        if (WHICH == 1) { d.A = (const bf16_t*)(p.ws + OFF_XB); d.Bt = (const bf16_t*)(p.ws + OFF_WT_W1) + (size_t)(layer * 32 + e) * 2048 * 1024; }
        else { d.A = (const bf16_t*)(p.ws + OFF_ACT); d.Bt = (const bf16_t*)(p.ws + OFF_WT_W2) + (size_t)(layer * 32 + e) * 1024 * 1024; }
        return true; };
    if (WHICH == 1) {
        bf16_t* ACT = (bf16_t*)(p.ws + OFF_ACT);
        gemm256_stream<true, 2>(src, 1024, 1024, smem,
            [&](int, int e_, f32x4 (&acc)[4][2], int rt0, int c0, int fr, int fq, const int* sRow) {
                const float* b1 = p.moe_b1 + (size_t)(layer * 32 + e_) * 2048;
                const int gcol = (c0 >> 5) * 16 + 4 * fq;
                const f32x4 bg = *(const f32x4*)(b1 + gcol), bl = *(const f32x4*)(b1 + 1024 + gcol);
#pragma unroll
                for (int m = 0; m < 4; ++m) {
                    const int pair = NOEPI ? -1 : sRow[rt0 + m * 16 + fr];
                    if (pair >= 0) {
                        float a[4];
#pragma unroll
                        for (int r = 0; r < 4; ++r) {
                            const float gl = fminf(acc[m][0][r] + bg[r], 7.f);
                            const float li = fminf(fmaxf(acc[m][1][r] + bl[r], -7.f), 7.f);
                            a[r] = gl * sigmoidf_(1.702f * gl) * (li + 1.f);
                        }
                        u32x2 w; w.x = pk2(a[0], a[1]); w.y = pk2(a[2], a[3]);
                        *(u32x2*)(ACT + (size_t)pair * 1024 + gcol) = w;
                    }
                }
            });
    } else {
        const float* GATE = (const float*)(p.ws + OFF_GATE);
        bf16_t* SLOT = (bf16_t*)(p.ws + OFF_SLOT);
        gemm256_stream<true, 0>(src, 1024, 1024, smem,
            [&](int, int e_, f32x4 (&acc)[4][2], int rt0, int c0, int fr, int fq, const int* sRow) {
                const float* b2 = p.moe_b2 + (size_t)(layer * 32 + e_) * 1024;
                const int col = c0 + 8 * fq;
                const f32x4 b20 = *(const f32x4*)(b2 + col), b21 = *(const f32x4*)(b2 + col + 4);
#pragma unroll
                for (int m = 0; m < 4; ++m) {
                    const int pair = NOEPI ? -1 : sRow[rt0 + m * 16 + fr];
                    if (pair >= 0) {
                        const float gt = GATE[pair];
                        const f32x4 y0 = (acc[m][0] + b20) * gt, y1 = (acc[m][1] + b21) * gt;
                        u32x4 w; w.x = pk2(y0[0], y0[1]); w.y = pk2(y0[2], y0[3]); w.z = pk2(y1[0], y1[1]); w.w = pk2(y1[2], y1[3]);
                        *(u32x4*)(SLOT + (size_t)pair * 1024 + col) = w;
                    }
                }
            });
    }
}

__device__ __forceinline__ void epi_od_in(PRef p, f32x4 (&acc)[4][2], int row0, int c0, int fr, int fq) {
    char* ws = p.ws;
    bf16_t* PO = (bf16_t*)(ws + OFF_PO); float* WI = (float*)(ws + OFF_WI);
    const int col = c0 + 8 * fq;
#pragma unroll
    for (int m = 0; m < 4; ++m) {
        const int t = row0 + m * 16 + fr;
        if (c0 < OD_WI) {
            u32x4 w; w.x = pk2(acc[m][0][0], acc[m][0][1]); w.y = pk2(acc[m][0][2], acc[m][0][3]); w.z = pk2(acc[m][1][0], acc[m][1][1]); w.w = pk2(acc[m][1][2], acc[m][1][3]);
            *(u32x4*)(PO + (size_t)t * OD_P + col) = w;
        } else if (col == OD_WI) {
            *(f32x4*)(WI + (size_t)t * 4) = acc[m][0];
        }
    }
}

__device__ __forceinline__ void idx_scores(const char* __restrict__ ktile, int kbase, const bf16x8 (&qf)[4][4], const float (&wi)[4], int lane, float (&sc)[16]) {
    const int r = lane & 31, h2 = lane >> 5;
    const char* kp = ktile + (kbase + r) * 144 + h2 * 16;
    bf16x8 kf[4];
#pragma unroll
    for (int s = 0; s < 4; ++s) kf[s] = *(const bf16x8*)(kp + s * 32);
#pragma unroll
    for (int i = 0; i < 16; ++i) sc[i] = 0.f;
#pragma unroll
    for (int hd = 0; hd < 4; ++hd) {
        f32x16 a;
#pragma unroll
        for (int i = 0; i < 16; ++i) a[i] = 0.f;
#pragma unroll
        for (int s = 0; s < 4; ++s) a = __builtin_amdgcn_mfma_f32_32x32x16_bf16(kf[s], qf[hd][s], a, 0, 0, 0);
#pragma unroll
        for (int i = 0; i < 16; ++i) { const int ai = __float_as_int(a[i]); sc[i] += wi[hd] * __int_as_float(ai > 0 ? ai : 0); }
    }
}
__device__ __forceinline__ unsigned ord_key(float s) {
    const unsigned u = __float_as_uint(s);
    return u ^ ((unsigned)((int)u >> 31) | 0x80000000u);
}

constexpr int SEL_KT = 128 * 144;
__device__ __forceinline__ void dsa_select_item(PRef p, int b, int qb, char* smem) {
    unsigned* hist = (unsigned*)smem;
    unsigned* pref = (unsigned*)(smem + 66048);
    int* krem = (int*)(smem + 66048 + 256);
    unsigned* GW = (unsigned*)(smem + 66048 + 512);
    unsigned* EW = (unsigned*)(smem + 66048 + 512 + 2048);
    char* kbuf = smem + 71680;
    const bf16_t* PO = (const bf16_t*)(p.ws + OFF_PO);
    const float* WI = (const float*)(p.ws + OFF_WI);
    unsigned long long* BMT = (unsigned long long*)(p.ws + OFF_BM);
    const int tid = otid(), lane = tid & 63, wave = tid >> 6, kw = wave >> 1, qw = wave & 1, h2 = lane >> 5;
    const int p0 = qb * 64;
    const int ql = qw * 32 + (lane & 31);
    const int qpos = p0 + ql;
    const size_t tq = (size_t)b * L_ + qpos;
    const int nkt = (p0 + 64 + 127) >> 7;
    bf16x8 qf[4][4]; float wi[4];
#pragma unroll
    for (int hd = 0; hd < 4; ++hd) {
        wi[hd] = WI[tq * 4 + hd];
#pragma unroll
        for (int s = 0; s < 4; ++s) qf[hd][s] = *(const bf16x8*)(PO + tq * OD_P + OD_QI + hd * 64 + s * 16 + h2 * 8);
    }
    const int srow = tid >> 3, sch = tid & 7;
    const bf16_t* ksrc = PO + ((size_t)b * L_ + srow) * OD_P + OD_KI + sch * 8;
    char* kdst = kbuf + srow * 144 + sch * 16;
    for (int e = tid; e < 64 * 257; e += NTHR) hist[e] = 0u;
    if (tid < 64) { pref[tid] = 0u; krem[tid] = 256; }
    __syncthreads();
    const bool selall = qpos < 256;
    const int npass = (p0 + 63 >= 256) ? 3 : 0;
    for (int pass = 0; pass <= npass; ++pass) {
        const bool maskpass = pass == npass;
        const int sh = 24 - 8 * pass;
        const unsigned mypref = pref[ql];
        int ceq = 0;
        const int rsel = tid < 64 ? krem[tid] : 0;
        const int npair = (nkt + 1) >> 1;
        u32x4 r0, r1, r2 = (u32x4){0u, 0u, 0u, 0u}, r3 = r2;
        r0 = *(const u32x4*)ksrc; r1 = *(const u32x4*)(ksrc + (size_t)64 * OD_P);
        if (nkt > 1) { r2 = *(const u32x4*)(ksrc + (size_t)128 * OD_P); r3 = *(const u32x4*)(ksrc + (size_t)192 * OD_P); }
        *(u32x4*)kdst = r0; *(u32x4*)(kdst + 64 * 144) = r1; *(u32x4*)(kdst + SEL_KT) = r2; *(u32x4*)(kdst + SEL_KT + 64 * 144) = r3;
        __syncthreads();
        for (int kp = 0; kp < npair; ++kp) {
            const bool more = kp + 1 < npair;
            const bool more2 = 2 * kp + 3 < nkt;
            if (more) {
                r0 = *(const u32x4*)(ksrc + (size_t)(2 * kp + 2) * 128 * OD_P); r1 = *(const u32x4*)(ksrc + (size_t)((2 * kp + 2) * 128 + 64) * OD_P);
                if (more2) { r2 = *(const u32x4*)(ksrc + (size_t)(2 * kp + 3) * 128 * OD_P); r3 = *(const u32x4*)(ksrc + (size_t)((2 * kp + 3) * 128 + 64) * OD_P); }
            }
            const char* kcur = kbuf + (kp & 1) * 2 * SEL_KT;
            const bool two = 2 * kp + 1 < nkt;
            unsigned gwp[2] = {0u, 0u}, ewp[2] = {0u, 0u};
#pragma unroll
            for (int tt = 0; tt < 2; ++tt) {
                if (tt == 1 && !two) break;
                const int kt = 2 * kp + tt;
                float sc[16];
                idx_scores(kcur + tt * SEL_KT, kw * 32, qf, wi, lane, sc);
                const int keybase = kt * 128 + kw * 32;
                const bool diag = kt == nkt - 1;
                if (!maskpass) {
                    if (pass == 0 && !diag && p0 >= 256) {
#pragma unroll
                        for (int i = 0; i < 16; ++i) atomicAdd(&hist[ql * 257 + (ord_key(sc[i]) >> 24)], 1u);
                    } else {
#pragma unroll
                        for (int i = 0; i < 16; ++i) {
                            const int key = keybase + (i & 3) + 8 * (i >> 2) + 4 * h2;
                            const unsigned k32 = ord_key(sc[i]);
                            const bool match = pass == 0 ? true : ((k32 >> (sh + 8)) == mypref);
                            const bool valid = diag ? key <= qpos : true;
                            if (valid && !selall && match) atomicAdd(&hist[ql * 257 + ((k32 >> sh) & 255u)], 1u);
                        }
                    }
                } else {
                    unsigned gw = 0u, ew = 0u;
#pragma unroll
                    for (int i = 0; i < 16; ++i) {
                        const int ko = (i & 3) + 8 * (i >> 2) + 4 * h2;
                        const int key = keybase + ko;
                        const unsigned k24 = ord_key(sc[i]) >> 8;
                        const bool valid = diag ? key <= qpos : true;
                        const bool g = valid && (selall || k24 > mypref);
                        const bool e = valid && !selall && k24 == mypref;
                        gw |= (g ? 1u : 0u) << ko; ew |= (e ? 1u : 0u) << ko;
                    }
                    gwp[tt] = xor32_or(gw); ewp[tt] = xor32_or(ew);
                }
            }
            if (maskpass && h2 == 0) { GW[ql * 8 + kw] = gwp[0]; EW[ql * 8 + kw] = ewp[0]; GW[ql * 8 + 4 + kw] = gwp[1]; EW[ql * 8 + 4 + kw] = ewp[1]; }
            if (more) {
                char* nd = kdst + ((kp + 1) & 1) * 2 * SEL_KT;
                *(u32x4*)nd = r0; *(u32x4*)(nd + 64 * 144) = r1;
                if (more2) { *(u32x4*)(nd + SEL_KT) = r2; *(u32x4*)(nd + SEL_KT + 64 * 144) = r3; }
            }
            __syncthreads();
            if (maskpass) {
                if (tid < 64) {
#pragma unroll
                    for (int tt = 0; tt < 2; ++tt) {
                        if (tt == 1 && !two) break;
                        const int kt = 2 * kp + tt;
                        unsigned g4[4], e4[4];
#pragma unroll
                        for (int w = 0; w < 4; ++w) { g4[w] = GW[tid * 8 + tt * 4 + w]; e4[w] = EW[tid * 8 + tt * 4 + w]; }
                        int need = rsel - ceq; if (need < 0) need = 0;
#pragma unroll
                        for (int w = 0; w < 4; ++w) {
                            const int pc = __popc(e4[w]);
                            ceq += pc;
                            if (need >= pc) need -= pc;
                            else { unsigned m = e4[w], kept = 0u; for (int k = 0; k < need; ++k) { const unsigned low = m & (0u - m); kept |= low; m ^= low; } e4[w] = kept; need = 0; }
                            g4[w] |= e4[w];
                        }
                        BMT[((size_t)(b * 256 + 2 * kt)) * L_ + p0 + tid] = (unsigned long long)g4[0] | ((unsigned long long)g4[1] << 32);
                        BMT[((size_t)(b * 256 + 2 * kt + 1)) * L_ + p0 + tid] = (unsigned long long)g4[2] | ((unsigned long long)g4[3] << 32);
                    }
                }
                __syncthreads();
            }
        }
        if (!maskpass) {
            const int q = tid >> 3, part = tid & 7;
            unsigned c32[32]; unsigned tot = 0u;
#pragma unroll
            for (int i = 0; i < 32; ++i) { c32[i] = hist[q * 257 + part * 32 + i]; tot += c32[i]; }
            unsigned above = 0u;
#pragma unroll
            for (int d = 1; d < 8; ++d) { const unsigned o = __shfl(tot, (lane & ~7) + ((part + d) & 7), 64); if (part + d < 8) above += o; }
            const unsigned need = (unsigned)krem[q];
            __syncthreads();
            if ((p0 + q) >= 256 && above < need && above + tot >= need) {
                unsigned cum = above; int dg = 31;
#pragma unroll
                for (int i = 31; i >= 0; --i) { if (i == dg) { if (cum + c32[i] >= need) {   } else { cum += c32[i]; dg = i - 1; } } }
                pref[q] = (pref[q] << 8) | (unsigned)(part * 32 + dg);
                krem[q] = (int)(need - cum);
            }
            for (int e = tid; e < 64 * 257; e += NTHR) hist[e] = 0u;
            __syncthreads();
        }
    }
}

template <int MODE, int NQT>
__device__ __forceinline__ void attn_wave(PRef p, int b, int head, int qcol, int kcol, const bf16_t* __restrict__ VT, int voff,
                                          int i0, int sh  , int rho, int kt_lo, int kt_hi, int grp) {
    const bf16_t* PO = (const bf16_t*)(p.ws + OFF_PO);
    const unsigned* BM32 = (const unsigned*)(p.ws + OFF_BM);
    const int lane = otid() & 63, r = lane & 31, h2 = lane >> 5;
    const int pr = (r & 0x13) | ((r & 4) << 1) | ((r & 8) >> 1);
    const float SC = 0.125f * 1.4426950408889634f;
    bf16x8 qf[NQT][4]; size_t tq[NQT]; int qi[NQT];
#pragma unroll
    for (int qt = 0; qt < NQT; ++qt) {
        qi[qt] = i0 + qt * 32 + r;
        tq[qt] = (size_t)b * L_ + ((size_t)qi[qt] << sh) + rho;
#pragma unroll
        for (int s = 0; s < 4; ++s) qf[qt][s] = *(const bf16x8*)(PO + tq[qt] * OD_P + qcol + head * 64 + s * 16 + h2 * 8);
    }
    f32x16 oacc[NQT][2];
#pragma unroll
    for (int a = 0; a < NQT; ++a)
#pragma unroll
        for (int c = 0; c < 2; ++c)
#pragma unroll
            for (int i = 0; i < 16; ++i) oacc[a][c][i] = 0.f;
    float mrun[NQT], lrun[NQT];
#pragma unroll
    for (int a = 0; a < NQT; ++a) { mrun[a] = -64.f; lrun[a] = 0.f; }
    bf16x8 kf[4]; unsigned mw[NQT];
    auto load_k = [&](int kt, bf16x8 (&k_)[4], unsigned (&m_)[NQT]) {
        const size_t krow = (size_t)b * L_ + ((size_t)(kt * 32 + pr) << sh) + rho;
#pragma unroll
        for (int s = 0; s < 4; ++s) k_[s] = *(const bf16x8*)(PO + krow * OD_P + kcol + head * 64 + s * 16 + h2 * 8);
#pragma unroll
        for (int a = 0; a < NQT; ++a) m_[a] = MODE == 0 ? BM32[tq[a] * 512 + kt] : 0u;
    };
    load_k(kt_lo, kf, mw);
#pragma unroll 1
    for (int kt = kt_lo; kt <= kt_hi; ++kt) {
        bf16x8 vf[2][2];
#pragma unroll
        for (int db = 0; db < 2; ++db)
#pragma unroll
            for (int s2 = 0; s2 < 2; ++s2) vf[db][s2] = *(const bf16x8*)(VT + (size_t)(db * 32 + r) * L_ + voff + kt * 32 + s2 * 16 + h2 * 8);
        bf16x8 kn[4]; unsigned mn[NQT];
#pragma unroll
        for (int a = 0; a < NQT; ++a) mn[a] = 0u;
        if (kt < kt_hi) load_k(kt + 1, kn, mn);
#pragma unroll
        for (int qt = 0; qt < NQT; ++qt) {
            f32x16 s;
#pragma unroll
            for (int i = 0; i < 16; ++i) s[i] = 0.f;
#pragma unroll
            for (int ks = 0; ks < 4; ++ks) s = __builtin_amdgcn_mfma_f32_32x32x16_bf16(kf[ks], qf[qt][ks], s, 0, 0, 0);
            unsigned wsel;
            if (MODE == 0) wsel = mw[qt];
            else {
                const int hi = qi[qt] - kt * 32, lo = hi - 128;
                const unsigned mh = hi < 0 ? 0u : (hi >= 31 ? 0xffffffffu : ((2u << hi) - 1u)), ml = lo <= 0 ? 0xffffffffu : (lo > 31 ? 0u : ~((1u << lo) - 1u));
                wsel = mh & ml;
            }
#pragma unroll
            for (int i = 0; i < 16; ++i) s[i] = __builtin_fmaf(s[i], SC, -mrun[qt]);
            float mx = fmaxf(fmaxf(s[0], s[1]), fmaxf(s[2], s[3]));
#pragma unroll
            for (int i = 4; i < 16; i += 2) mx = fmaxf(mx, fmaxf(s[i], s[i + 1]));
            mx = xor32_max(mx);
            if (__builtin_amdgcn_ballot_w64(mx > 0.f) != 0ull) {
                const float dlt = fmaxf(mx, 0.f);
                const float corr = __builtin_amdgcn_exp2f(-dlt);
                mrun[qt] += dlt; lrun[qt] *= corr;
#pragma unroll
                for (int db = 0; db < 2; ++db)
#pragma unroll
                    for (int i = 0; i < 16; ++i) oacc[qt][db][i] *= corr;
#pragma unroll
                for (int i = 0; i < 16; ++i) s[i] -= dlt;
            }
            float ps = 0.f;
            const int mws = (int)(wsel >> (8 * h2));
#define DA_P(i, KO) { const float e = __builtin_amdgcn_exp2f(s[i]); s[i] = __uint_as_float(__float_as_uint(e) & bitmask32<KO>(mws)); ps += s[i]; }
            DA_P(0, 0) DA_P(1, 1) DA_P(2, 2) DA_P(3, 3) DA_P(4, 4) DA_P(5, 5) DA_P(6, 6) DA_P(7, 7)
            DA_P(8, 16) DA_P(9, 17) DA_P(10, 18) DA_P(11, 19) DA_P(12, 20) DA_P(13, 21) DA_P(14, 22) DA_P(15, 23)
#undef DA_P
            lrun[qt] += ps;
#pragma unroll
            for (int s2 = 0; s2 < 2; ++s2) {
                u32x4 pw; pw.x = pk2(s[8 * s2], s[8 * s2 + 1]); pw.y = pk2(s[8 * s2 + 2], s[8 * s2 + 3]); pw.z = pk2(s[8 * s2 + 4], s[8 * s2 + 5]); pw.w = pk2(s[8 * s2 + 6], s[8 * s2 + 7]);
                const bf16x8 pf = __builtin_bit_cast(bf16x8, pw);
#pragma unroll
                for (int db = 0; db < 2; ++db) oacc[qt][db] = __builtin_amdgcn_mfma_f32_32x32x16_bf16(vf[db][s2], pf, oacc[qt][db], 0, 0, 0);
            }
        }
        if (kt < kt_hi) {
#pragma unroll
            for (int s = 0; s < 4; ++s) kf[s] = kn[s];
#pragma unroll
            for (int a = 0; a < NQT; ++a) mw[a] = mn[a];
        }
    }
#pragma unroll
    for (int qt = 0; qt < NQT; ++qt) {
        const float lt = xor32_sum(lrun[qt]);
        const float inv = 1.f / lt;
        if (MODE == 0) {
            bf16_t* CC = (bf16_t*)(p.ws + OFF_CC);
#pragma unroll
            for (int db = 0; db < 2; ++db)
#pragma unroll
                for (int i = 0; i < 16; ++i) {
                    const int d = db * 32 + (i & 3) + 8 * (i >> 2) + 4 * h2;
                    CC[tq[qt] * 1024 + head * 64 + d] = f2bf(oacc[qt][db][i] * inv);
                }
        } else {
            bf16_t* OD = (bf16_t*)(p.ws + OFF_OD) + (size_t)grp * T_ * 512;
#pragma unroll
            for (int db = 0; db < 2; ++db)
#pragma unroll
                for (int i = 0; i < 16; i += 4) {
                    const int d = db * 32 + 8 * (i >> 2) + 4 * h2;
                    { u32x2 w; w.x = pk2(oacc[qt][db][i] * inv, oacc[qt][db][i + 1] * inv); w.y = pk2(oacc[qt][db][i + 2] * inv, oacc[qt][db][i + 3] * inv); *(u32x2*)(OD + tq[qt] * 512 + head * 64 + d) = w; }
                }
            if (h2 == 0) ((float*)(p.ws + OFF_LSE))[((size_t)grp * T_ + tq[qt]) * 8 + head] = mrun[qt] + log2f(lt);
        }
    }
}

__device__ __forceinline__ void dil_combine_phase(PRef p, int bid, int nb) {
    const bf16_t* OD = (const bf16_t*)(p.ws + OFF_OD); const float* LSE = (const float*)(p.ws + OFF_LSE);
    bf16_t* CC = (bf16_t*)(p.ws + OFF_CC);
    const long n = (long)T_ * 128;
    for (long c = (long)bid * NTHR + otid(); c < n; c += (long)nb * NTHR) {
        const long t = c >> 7; const int ch = (int)(c & 127) * 4, hd = ch >> 6;
        const float l0 = LSE[((size_t)0 * T_ + t) * 8 + hd], l1 = LSE[((size_t)1 * T_ + t) * 8 + hd], l2 = LSE[((size_t)2 * T_ + t) * 8 + hd];
        const float mx = fmaxf(l0, fmaxf(l1, l2));
        const float w0 = __builtin_amdgcn_exp2f(l0 - mx), w1 = __builtin_amdgcn_exp2f(l1 - mx), w2 = __builtin_amdgcn_exp2f(l2 - mx);
        const float inv = __builtin_amdgcn_rcpf(w0 + w1 + w2);
        const u32x2 a = *(const u32x2*)(OD + ((size_t)0 * T_ + t) * 512 + ch), bq = *(const u32x2*)(OD + ((size_t)1 * T_ + t) * 512 + ch), cq = *(const u32x2*)(OD + ((size_t)2 * T_ + t) * 512 + ch);
        float o[4];
#define BFLO(x) __uint_as_float((x) << 16)
#define BFHI(x) __uint_as_float((x) & 0xffff0000u)
        o[0] = (BFLO(a.x) * w0 + BFLO(bq.x) * w1 + BFLO(cq.x) * w2) * inv; o[1] = (BFHI(a.x) * w0 + BFHI(bq.x) * w1 + BFHI(cq.x) * w2) * inv;
        o[2] = (BFLO(a.y) * w0 + BFLO(bq.y) * w1 + BFLO(cq.y) * w2) * inv; o[3] = (BFHI(a.y) * w0 + BFHI(bq.y) * w1 + BFHI(cq.y) * w2) * inv;
#undef BFLO
#undef BFHI
        u32x2 w; w.x = pk2(o[0], o[1]); w.y = pk2(o[2], o[3]);
        *(u32x2*)(CC + (size_t)t * 1024 + 512 + ch) = w;
    }
}

constexpr int DA_ROW = 144;
constexpr int DA_TILE = 64 * DA_ROW;
__device__ __forceinline__ void dsa_attn_item(PRef p, int b, int head, int qb, char* smem) {
    const bf16_t* PO = (const bf16_t*)(p.ws + OFF_PO);
    const bf16_t* VT = (const bf16_t*)(p.ws + OFF_VTC) + ((size_t)(b * 8 + head)) * 64 * L_;
    const int tid = otid(), lane = tid & 63, wave = tid >> 6, r = lane & 31, h2 = lane >> 5;
    const int pr = (r & 0x13) | ((r & 4) << 1) | ((r & 8) >> 1);
    const float SC = 0.125f * 1.4426950408889634f;
    const int i0 = qb * 256 + wave * 32, qi = i0 + r;
    const unsigned long long* BMT = (const unsigned long long*)(p.ws + OFF_BM) + (size_t)b * 256 * L_ + qi;
    const size_t tq = (size_t)b * L_ + qi;
    bf16x8 qf[4];
#pragma unroll
    for (int s = 0; s < 4; ++s) qf[s] = *(const bf16x8*)(PO + tq * OD_P + head * 64 + s * 16 + h2 * 8);
    f32x16 oacc[2];
#pragma unroll
    for (int c = 0; c < 2; ++c)
#pragma unroll
        for (int i = 0; i < 16; ++i) oacc[c][i] = 0.f;
    float mrun = -64.f, lrun = 0.f;
    const int nkt = qb * 4 + 4, my_last = (i0 + 31) >> 6;
    const int srow = tid >> 3, sch = tid & 7;
    const bf16_t* ksrc = PO + ((size_t)b * L_ + srow) * OD_P + 512 + head * 64 + sch * 8;
    const bf16_t* vsrc = VT + (size_t)srow * L_ + sch * 8;
    u32x4 rk = *(const u32x4*)ksrc, rv = *(const u32x4*)vsrc;
    __syncthreads();
    *(u32x4*)(smem + srow * DA_ROW + sch * 16) = rk;
    *(u32x4*)(smem + DA_TILE + srow * DA_ROW + sch * 16) = rv;
    __syncthreads();
    unsigned long long mwn = BMT[0];
#pragma unroll 1
    for (int kt = 0; kt < nkt; ++kt) {
        const bool more = kt + 1 < nkt;
        if (more) { rk = *(const u32x4*)(ksrc + (size_t)(kt + 1) * 64 * OD_P); rv = *(const u32x4*)(vsrc + (kt + 1) * 64); }
        const unsigned long long mw64 = mwn;
        if (kt < my_last) mwn = BMT[(size_t)(kt + 1) * L_];
        if (kt <= my_last) {
            const char* kb = smem + (kt & 1) * 2 * DA_TILE; const char* vb = kb + DA_TILE;
            f32x16 sa[2];
#pragma unroll
            for (int sub = 0; sub < 2; ++sub) {
                bf16x8 kf[4];
#pragma unroll
                for (int s = 0; s < 4; ++s) kf[s] = *(const bf16x8*)(kb + (sub * 32 + pr) * DA_ROW + (s * 16 + h2 * 8) * 2);
#pragma unroll
                for (int i = 0; i < 16; ++i) sa[sub][i] = 0.f;
#pragma unroll
                for (int ks = 0; ks < 4; ++ks) sa[sub] = __builtin_amdgcn_mfma_f32_32x32x16_bf16(kf[ks], qf[ks], sa[sub], 0, 0, 0);
            }
#pragma unroll
            for (int sub = 0; sub < 2; ++sub) {
                const unsigned mw = sub == 0 ? (unsigned)mw64 : (unsigned)(mw64 >> 32);
                f32x16& s = sa[sub];
                bf16x8 vf[2][2];
#pragma unroll
                for (int db = 0; db < 2; ++db)
#pragma unroll
                    for (int s2 = 0; s2 < 2; ++s2) vf[db][s2] = *(const bf16x8*)(vb + (db * 32 + r) * DA_ROW + (sub * 32 + s2 * 16 + h2 * 8) * 2);
#pragma unroll
                for (int i = 0; i < 16; ++i) s[i] = __builtin_fmaf(s[i], SC, -mrun);
                float mx = fmaxf(fmaxf(s[0], s[1]), fmaxf(s[2], s[3]));
#pragma unroll
                for (int i = 4; i < 16; i += 2) mx = fmaxf(mx, fmaxf(s[i], s[i + 1]));
                mx = xor32_max(mx);
                if (__builtin_amdgcn_ballot_w64(mx > 0.f) != 0ull) {
                    const float dlt = fmaxf(mx, 0.f);
                    const float corr = __builtin_amdgcn_exp2f(-dlt);
                    mrun += dlt; lrun *= corr;
#pragma unroll
                    for (int db = 0; db < 2; ++db)
#pragma unroll
                        for (int i = 0; i < 16; ++i) oacc[db][i] *= corr;
#pragma unroll
                    for (int i = 0; i < 16; ++i) s[i] -= dlt;
                }
                float ps = 0.f;
                const int mws = (int)(mw >> (8 * h2));
#define DA_P(i, KO) { const float e = __builtin_amdgcn_exp2f(s[i]); s[i] = __uint_as_float(__float_as_uint(e) & bitmask32<KO>(mws)); ps += s[i]; }
                DA_P(0, 0) DA_P(1, 1) DA_P(2, 2) DA_P(3, 3) DA_P(4, 4) DA_P(5, 5) DA_P(6, 6) DA_P(7, 7)
                DA_P(8, 16) DA_P(9, 17) DA_P(10, 18) DA_P(11, 19) DA_P(12, 20) DA_P(13, 21) DA_P(14, 22) DA_P(15, 23)
#undef DA_P
                lrun += ps;
#pragma unroll
                for (int s2 = 0; s2 < 2; ++s2) {
                    u32x4 pw; pw.x = pk2(s[8 * s2], s[8 * s2 + 1]); pw.y = pk2(s[8 * s2 + 2], s[8 * s2 + 3]); pw.z = pk2(s[8 * s2 + 4], s[8 * s2 + 5]); pw.w = pk2(s[8 * s2 + 6], s[8 * s2 + 7]);
                    const bf16x8 pf = __builtin_bit_cast(bf16x8, pw);
#pragma unroll
                    for (int db = 0; db < 2; ++db) oacc[db] = __builtin_amdgcn_mfma_f32_32x32x16_bf16(vf[db][s2], pf, oacc[db], 0, 0, 0);
                }
            }
        }
        if (more) {
            char* nbuf = smem + ((kt + 1) & 1) * 2 * DA_TILE;
            *(u32x4*)(nbuf + srow * DA_ROW + sch * 16) = rk;
            *(u32x4*)(nbuf + DA_TILE + srow * DA_ROW + sch * 16) = rv;
        }
        __syncthreads();
    }
    const float lt = xor32_sum(lrun);
    const float inv = 1.f / lt;
    bf16_t* CC = (bf16_t*)(p.ws + OFF_CC);
#pragma unroll
    for (int db = 0; db < 2; ++db)
#pragma unroll
        for (int i = 0; i < 16; i += 4) {
            const int d = db * 32 + 8 * (i >> 2) + 4 * h2;
            u32x2 w; w.x = pk2(oacc[db][i] * inv, oacc[db][i + 1] * inv); w.y = pk2(oacc[db][i + 2] * inv, oacc[db][i + 3] * inv);
            *(u32x2*)(CC + tq * 1024 + head * 64 + d) = w;
        }
}


template <bool ODD>
__device__ __forceinline__ void inproj_phase(PRef p, int j, char* smem, int bid, int nb) {
    char* ws = p.ws;
    constexpr int NTN = ODD ? OD_P / 256 : EV_P / 256, NMAIN = 128 * NTN, NVT = ODD ? 1024 : 256;
    const bf16_t* XB = (const bf16_t*)(ws + OFF_XB);
    const bf16_t* W = ODD ? (const bf16_t*)(ws + OFF_WT_ODIN) + (size_t)j * OD_N * 1024 : (const bf16_t*)(ws + OFF_WT_EVIN) + (size_t)j * EV_N * 1024;
    XcdSeq s(NMAIN + NVT, bid, nb);
    gemm256_stream<false, 0>(
        [&](int i, G8Desc& d) -> bool {
            const int Q = s.q + i * s.step; if (Q >= s.qend) return false;
            d.list = nullptr; d.count = 0;
            if (Q < NMAIN) {
                const int pnl = Q / (4 * NTN), r = Q - pnl * 4 * NTN;
                d.A = XB; d.Bt = W; d.m0 = (pnl * 4 + (r & 3)) * 256; d.n0 = (r >> 2) * 256; d.u0 = -1; d.ldb = 1024;
            } else {
                const int v = Q - NMAIN; d.m0 = 0; d.n0 = 0; d.u0 = v;
                if (ODD) {
                    const int combo = v & 7, src = combo >> 1, mt = combo & 1, bn = v >> 3, b = bn >> 6, lam0 = (bn & 63) * 256;
                    const int sh = src < 2 ? 0 : (src == 2 ? 2 : 4), rho = lam0 >> (14 - sh), i0 = lam0 & ((L_ >> sh) - 1);
                    d.A = W + (size_t)(OD_P + src * 512 + mt * 256) * 1024;
                    d.Bt = XB + ((size_t)b * L_ + ((size_t)i0 << sh) + rho) * 1024; d.ldb = 1024 << sh;
                } else {
                    const int mt = v & 1, bn = v >> 1;
                    d.A = W + (size_t)(EV_P + mt * 256) * 1024;
                    d.Bt = XB + (size_t)bn * 256 * 1024; d.ldb = 1024;
                }
            }
            return true; },
        1024, 1024, smem,
        [&](int m0, int u0, f32x4 (&acc)[4][2], int rt0, int c0, int fr, int fq, const int*) {
            if (u0 < 0) { if (ODD) epi_od_in(p, acc, m0 + rt0, c0, fr, fq); else epi_ev_in(p, acc, m0 + rt0, c0, fr, fq); }
            else if (ODD) {
                const int combo = u0 & 7, src = combo >> 1, mt = combo & 1, bn = u0 >> 3, b = bn >> 6, lam0 = (bn & 63) * 256;
                bf16_t* img = src == 0 ? (bf16_t*)(ws + OFF_VTC) + ((size_t)(b * 8) * 64 + mt * 256) * L_ + lam0
                                       : (bf16_t*)(ws + OFF_VTD) + ((size_t)((b * 3 + src - 1) * 8) * 64 + mt * 256) * L_ + lam0;
                epi_vt(img, acc, rt0, c0, fr, fq);
            } else {
                const int mt = u0 & 1, bn = u0 >> 1, b = bn >> 6, lam0 = (bn & 63) * 256;
                epi_vt((bf16_t*)(ws + OFF_VTE) + ((size_t)(b * 4) * 128 + mt * 256) * L_ + lam0, acc, rt0, c0, fr, fq);
            }
        });
}

enum { K_PRO = 0, K_E1, K_E2, K_E3, K_E4, K_E5, K_E6, K_LN1, K_O1, K_O2, K_O3, K_O4, K_M1, K_M2, K_M3, K_M4, K_LN2, K_COUNT };

template <int KIND, bool NOEPI = false>
__device__ __forceinline__ void run_phase(PRef p, int layer, char* smem, int bid, int nb) {
    char* ws = p.ws;
    const int j = layer >> 1;
    if (KIND == K_PRO) {
        conv_phase(p, smem, bid, nb);
        __syncthreads();
        for (int u = bid; u < 256; u += nb) s5mat_unit(p, u, smem);
    } else if (KIND == K_E1) {
        inproj_phase<false>(p, j, smem, bid, nb);
    } else if (KIND == K_E2) {
        for (int it = bid; it < 2048; it += nb) gla_a_item(p, j, it, smem);
        s5_g_phase(p, j, smem, bid, nb);
    } else if (KIND == K_E3) {
        scan_phase(p, j, bid);
    } else if (KIND == K_E4) {
        for (int it = bid; it < 2048; it += nb) gla_c_item(p, j, it, smem);
        s5_y_phase(p, j, smem, bid, nb);
    } else if (KIND == K_E5) {
        const bf16_t* YA = (const bf16_t*)(ws + OFF_YA); bf16_t* CC = (bf16_t*)(ws + OFF_CC); const float* bg = p.s5_b_glu + (size_t)j * 512;
        gemm256_phase(YA, 512, T_, (const bf16_t*)(ws + OFF_WT_GLU) + (size_t)j * 512 * 512, 512, 512, 512, smem, bid, nb,
                   [&](f32x4 (&acc)[4][2], int row0, int c0, int fr, int fq) {
                       const int col = c0 + 8 * fq;
                       const f32x4 g0 = *(const f32x4*)(bg + col), g1 = *(const f32x4*)(bg + col + 4);
#pragma unroll
                       for (int m = 0; m < 4; ++m) {
                           const size_t t = (size_t)(row0 + m * 16 + fr);
                           const u32x4 yw = *(const u32x4*)(YA + t * 512 + col);
                           float o[8];
#pragma unroll
                           for (int q = 0; q < 4; ++q) {
                               const unsigned y2 = q == 0 ? yw.x : q == 1 ? yw.y : q == 2 ? yw.z : yw.w;
                               const float y0 = __uint_as_float(y2 << 16), y1 = __uint_as_float(y2 & 0xffff0000u);
                               const float a0 = q < 2 ? acc[m][0][2 * q] + g0[2 * q] : acc[m][1][2 * q - 4] + g1[2 * q - 4];
                               const float a1 = q < 2 ? acc[m][0][2 * q + 1] + g0[2 * q + 1] : acc[m][1][2 * q - 3] + g1[2 * q - 3];
                               o[2 * q] = y0 * sigmoidf_(a0); o[2 * q + 1] = y1 * sigmoidf_(a1);
                           }
                           u32x4 w; w.x = pk2(o[0], o[1]); w.y = pk2(o[2], o[3]); w.z = pk2(o[4], o[5]); w.w = pk2(o[6], o[7]);
                           *(u32x4*)(CC + t * 1024 + 512 + col) = w;
                       }
                   });
    } else if (KIND == K_E6 || KIND == K_O4) {
        bf16_t* MIX = (bf16_t*)(ws + OFF_MIX);
        const bf16_t* W = (const bf16_t*)(ws + (KIND == K_E6 ? OFF_WT_EVOUT : OFF_WT_ODOUT)) + (size_t)j * 1024 * 1024;
        gemm256_phase((const bf16_t*)(ws + OFF_CC), 1024, T_, W, 1024, 1024, 1024, smem, bid, nb,
                   [&](f32x4 (&acc)[4][2], int row0, int c0, int fr, int fq) {
#pragma unroll
                       for (int m = 0; m < 4; ++m) {
                           u32x4 w; w.x = pk2(acc[m][0][0], acc[m][0][1]); w.y = pk2(acc[m][0][2], acc[m][0][3]); w.z = pk2(acc[m][1][0], acc[m][1][1]); w.w = pk2(acc[m][1][2], acc[m][1][3]);
                           *(u32x4*)(MIX + (size_t)(row0 + m * 16 + fr) * 1024 + c0 + 8 * fq) = w;
                       }
                   });
    } else if (KIND == K_LN1) {
        ln1_router_phase<NOEPI>(p, layer, smem, bid, nb);
    } else if (KIND == K_O1) {
        inproj_phase<true>(p, j, smem, bid, nb);
    } else if (KIND == K_O2) {
        if (!NOEPI) for (int k = bid; k < 256; k += nb) {
            dsa_select_item(p, k & 1, k >> 1, smem);
            __syncthreads();
            const int k2 = 511 - k;
            dsa_select_item(p, k2 & 1, k2 >> 1, smem);
            __syncthreads();
        }
        const int head = otid() >> 6;
        for (int it = bid; it < 1536; it += nb) {
            const int b = it / 768, rem = it - b * 768, g = rem >> 8, u = rem & 255;
            const int sh = g * 2, per = 256 >> sh, rho = u / per, qblk = u - rho * per;
            const bf16_t* VT = (const bf16_t*)(ws + OFF_VTD) + ((size_t)((b * 3 + g) * 8 + head)) * 64 * L_;
#pragma unroll 1
            for (int hf = 0; hf < 2; ++hf) {
                const int hi = 2 * qblk + hf, lo = hi - 4;
                attn_wave<1, 1>(p, b, head, OD_DIL + g * 512, OD_DIL + 1536 + g * 512, VT, rho * (L_ >> sh), qblk * 64 + hf * 32, sh, rho, lo < 0 ? 0 : lo, hi, g);
            }
        }
    } else if (KIND == K_O3) {
        for (int k = bid; k < 512; k += nb) {
            const int bh = k >> 5, q0 = k & 31;
#pragma unroll 1
            for (int half = 0; half < 2; ++half) dsa_attn_item(p, bh >> 3, bh & 7, half == 0 ? q0 : 63 - q0, smem);
        }
        dil_combine_phase(p, bid, nb);
    } else if (KIND == K_M1) {
        float* LG = (float*)(ws + OFF_LOGIT); const float* rb = p.router_b + (size_t)layer * 32;
        gemm_phase((const bf16_t*)(ws + OFF_XB), 1024, T_, (const bf16_t*)(ws + OFF_WT_RT) + (size_t)layer * 128 * 1024, 1024, 128, 1024, smem, bid, nb,
                   [&](f32x4 (&acc)[4][2], int row0, int c0, int fr, int fq) {
#pragma unroll
                       for (int n = 0; n < 2; ++n) {
                           const int col = c0 + n * 16 + fr;
                           if (col < 32) {
#pragma unroll
                               for (int m = 0; m < 4; ++m)
#pragma unroll
                                   for (int r = 0; r < 4; ++r) LG[(size_t)(row0 + m * 16 + fq * 4 + r) * 32 + col] = acc[m][n][r] + rb[col];
                           }
                       }
                   });
    } else if (KIND == K_M2) {
        topk_phase(p, layer, bid, nb);
    } else if (KIND == K_M3) {
        moe_gemm_phase<1, NOEPI>(p, layer, smem, bid, nb);
    } else if (KIND == K_M4) {
        moe_gemm_phase<2, NOEPI>(p, layer, smem, bid, nb);
    } else if (KIND == K_LN2) {
        float* xo = layer == 3 ? p.out : (float*)nullptr;
        ln_phase<true, NOEPI>(p, (const bf16_t*)(ws + OFF_XB), (const float*)(ws + OFF_SLOT), p.ln2_g + (size_t)layer * 1024, p.ln2_b + (size_t)layer * 1024, xo,
                       layer == 3 ? (bf16_t*)nullptr : (bf16_t*)(ws + OFF_XB), bid, nb);
    }
}

extern __shared__ __attribute__((aligned(16))) char dyn_smem[];

#if !MEGA
template <int KIND>
__global__ void __launch_bounds__(NTHR, 2) k_phase(Params p, int layer) { run_phase<KIND>(p, layer, dyn_smem, blockIdx.x, gridDim.x); }
#else
#ifndef DUPMASK
#define DUPMASK 0
#endif
typedef const __attribute__((address_space(4))) Params* KParams;
#define RUNP(K) do { KParams _q = kp0; asm volatile("" : "+s"(_q)); run_phase<K>(*_q, layer, smem, bid, nb); } while (0)
#ifndef DUPNOEPI
#define DUPNOEPI 0
#endif
#define RUNP2(K) do { KParams _q = kp0; asm volatile("" : "+s"(_q)); run_phase<K, (DUPNOEPI != 0)>(*_q, layer, smem, bid, nb); } while (0)
#define PHASE(K) do { RUNP(K); xcd_barrier(bar); if ((DUPMASK >> 30) & 1) xcd_barrier(bar); if ((DUPMASK >> K) & 1) { RUNP2(K); xcd_barrier(bar); } } while (0)
template <int LAYER>
__device__ __forceinline__ void mega_layer(KParams kp0, char* smem, int bid, int nb, const XcdBarrier& bar) {
    constexpr int layer = LAYER;
    if ((layer & 1) == 0) { PHASE(K_E1); PHASE(K_E2); PHASE(K_E3); PHASE(K_E4); PHASE(K_E5); PHASE(K_E6); }
    else { PHASE(K_O1); PHASE(K_O2); PHASE(K_O3); PHASE(K_O4); }
    PHASE(K_LN1); PHASE(K_M3); PHASE(K_M4);
    RUNP(K_LN2);
    if (layer < 3) xcd_barrier(bar);
}
__global__ void __launch_bounds__(NTHR, 2) k_mega(Params p) {
    char* smem = dyn_smem;
    const int bid = blockIdx.x, nb = gridDim.x;
    volatile LAS unsigned* st = (volatile LAS unsigned*)(dyn_smem + LDS_BYTES - 16);
    if (otid() == 0) { st[0] = 0u; st[1] = 0u; }
    __syncthreads();
    KParams kp0 = (KParams)__builtin_amdgcn_kernarg_segment_ptr();
    XcdBarrier bar = xcd_barrier_post((unsigned*)(kp0->ws + OFF_BAR), st);
    { const int layer = 0; PHASE(K_PRO); }
    mega_layer<0>(kp0, smem, bid, nb, bar);
    mega_layer<1>(kp0, smem, bid, nb, bar);
    mega_layer<2>(kp0, smem, bid, nb, bar);
    mega_layer<3>(kp0, smem, bid, nb, bar);
}
#endif

extern "C" void kernel_launch(void* const* d_in, const int* in_sizes, int n_in, void* d_out, int out_size, void* d_ws, size_t ws_size, hipStream_t stream) {
    Params p{};
    const float** f = (const float**)&p;
    for (int i = 0; i < 28; ++i) f[i] = (const float*)d_in[i];
    p.out = (float*)d_out; p.ws = (char*)d_ws;
    if (ws_size < WS_NEED) { fprintf(stderr, "workspace too small: %zu < %zu\n", ws_size, (size_t)WS_NEED); return; }
#if !MEGA
#define SETATTR(K) hipFuncSetAttribute((const void*)k_phase<K>, hipFuncAttributeMaxDynamicSharedMemorySize, LDS_BYTES)
#define LAUNCH(K, layer) k_phase<K><<<256, NTHR, LDS_BYTES, stream>>>(p, layer)
    static bool attr_done = false;
    if (!attr_done) {
        SETATTR(K_PRO); SETATTR(K_E1); SETATTR(K_E2); SETATTR(K_E3); SETATTR(K_E4); SETATTR(K_E5); SETATTR(K_E6); SETATTR(K_LN1); SETATTR(K_O1); SETATTR(K_O2); SETATTR(K_O3);
        SETATTR(K_O4); SETATTR(K_M1); SETATTR(K_M2); SETATTR(K_M3); SETATTR(K_M4); SETATTR(K_LN2);
        attr_done = true;
    }
    LAUNCH(K_PRO, 0);
    for (int layer = 0; layer < 4; ++layer) {
        if ((layer & 1) == 0) { LAUNCH(K_E1, layer); LAUNCH(K_E2, layer); LAUNCH(K_E3, layer); LAUNCH(K_E4, layer); LAUNCH(K_E5, layer); LAUNCH(K_E6, layer); }
        else { LAUNCH(K_O1, layer); LAUNCH(K_O2, layer); LAUNCH(K_O3, layer); LAUNCH(K_O4, layer); }
        LAUNCH(K_LN1, layer); LAUNCH(K_M3, layer); LAUNCH(K_M4, layer); LAUNCH(K_LN2, layer);
    }
#else
    static int grid = 0;
    if (!grid) {
        hipFuncSetAttribute((const void*)k_mega, hipFuncAttributeMaxDynamicSharedMemorySize, LDS_BYTES);
        int dev = 0, cus = 0, per_cu = 0;
        hipGetDevice(&dev);
        hipDeviceGetAttribute(&cus, hipDeviceAttributeMultiprocessorCount, dev);
        hipOccupancyMaxActiveBlocksPerMultiprocessor(&per_cu, (const void*)k_mega, NTHR, LDS_BYTES);
        grid = cus * (per_cu < 1 ? per_cu : 1);
        if (grid <= 0) grid = 0;
    }
    if (!grid) { fprintf(stderr, "occupancy query says 0 blocks per CU\n"); return; }
    hipMemsetAsync((char*)d_ws + OFF_BAR, 0, XCD_BAR_WORDS * sizeof(unsigned), stream);
    k_mega<<<grid, NTHR, LDS_BYTES, stream>>>(p);
#endif
}
```

```cpp
#include <hip/hip_runtime.h>
#include <stdint.h>
#include <stdio.h>

#ifndef MEGA
#define MEGA 1
#define DUPMASK 0
#define DUPNOEPI 0
#endif

typedef unsigned short bf16_t;
typedef short bf16x8 __attribute__((ext_vector_type(8)));
typedef float f32x4 __attribute__((ext_vector_type(4)));
typedef float f32x16 __attribute__((ext_vector_type(16)));
typedef unsigned u32x4 __attribute__((ext_vector_type(4)));
typedef unsigned u32x2 __attribute__((ext_vector_type(2)));

constexpr int T_ = 32768, D_ = 1024, L_ = 16384, NB_ = 2;
constexpr int NTHR = 512;
constexpr float ALPHA = 1.681792830507429f;
constexpr float LN_EPS = 1e-5f;
constexpr int EV_N = 2304;
constexpr int EV_P = 1792;
constexpr int PE_W = 1024;
constexpr int OD_N = 6656;
constexpr int OD_P = 4608;
constexpr int OD_QI = 1024, OD_DIL = 1280, OD_KI = 4352, OD_WI = 4416;
constexpr int UHW = 1152;
constexpr int LISTCAP = 131072;

constexpr size_t OFF_BAR = 0;
constexpr size_t OFF_CNT = 16384;
constexpr size_t OFF_A64 = 32768;
constexpr size_t OFF_WT_EVIN = 131072;
constexpr size_t OFF_WT_ODIN = OFF_WT_EVIN + (size_t)2 * EV_N * 1024 * 2;
constexpr size_t OFF_WT_EVOUT = OFF_WT_ODIN + (size_t)2 * OD_N * 1024 * 2;
constexpr size_t OFF_WT_ODOUT = OFF_WT_EVOUT + (size_t)2 * 1024 * 1024 * 2;
constexpr size_t OFF_WT_GLU = OFF_WT_ODOUT + (size_t)2 * 1024 * 1024 * 2;
constexpr size_t OFF_WT_RT = OFF_WT_GLU + (size_t)2 * 512 * 512 * 2;
constexpr size_t OFF_WT_W1 = OFF_WT_RT + (size_t)4 * 128 * 1024 * 2;
constexpr size_t OFF_WT_W2 = OFF_WT_W1 + (size_t)4 * 32 * 2048 * 1024 * 2;
constexpr size_t OFF_TH = OFF_WT_W2 + (size_t)4 * 32 * 1024 * 1024 * 2;
constexpr size_t OFF_GM = OFF_TH + (size_t)2 * 32 * 1024 * UHW * 2;
constexpr size_t OFF_XR = OFF_GM + (size_t)2 * 32 * 128 * 1024 * 2;
constexpr size_t OFF_XB = OFF_XR + (size_t)T_ * 1024 * 4;
constexpr size_t OFF_MIX = OFF_XB + (size_t)T_ * 1024 * 2;
constexpr size_t OFF_CC = OFF_MIX + (size_t)T_ * 1024 * 4;
constexpr size_t OFF_LOGIT = OFF_CC + (size_t)T_ * 1024 * 2;
constexpr size_t OFF_LIST = OFF_LOGIT + (size_t)T_ * 32 * 4;
constexpr size_t OFF_GATE = OFF_LIST + (size_t)32 * LISTCAP * 4;
constexpr size_t OFF_ACT = OFF_GATE + (size_t)T_ * 4 * 4;
constexpr size_t OFF_SLOT = OFF_ACT + (size_t)T_ * 4 * 1024 * 2;
constexpr size_t OFF_MIXER = OFF_SLOT + (size_t)T_ * 4 * 1024 * 4;
constexpr size_t OFF_PE = OFF_MIXER;
constexpr size_t OFF_UH = OFF_PE + (size_t)T_ * 1536 * 2;
constexpr size_t OFF_GLR = OFF_UH + (size_t)(T_ / 64) * 32 * UHW * 2;
constexpr size_t OFF_VTE = OFF_GLR + (size_t)T_ * 16 * 4;
constexpr size_t OFF_KV = OFF_VTE + (size_t)2 * 4 * 128 * L_ * 2;
constexpr size_t OFF_SST = OFF_KV + (size_t)2 * 256 * 4 * 64 * 128 * 4;
constexpr size_t OFF_DEC = OFF_SST + (size_t)2 * 256 * 4 * 64 * 128 * 4;
constexpr size_t OFF_GBUF = OFF_DEC + (size_t)2 * 256 * 4 * 64 * 4;
constexpr size_t OFF_YA = OFF_GBUF + (size_t)512 * 32 * 128 * 4;
constexpr size_t END_EVEN = OFF_YA + (size_t)T_ * 512 * 2;
constexpr size_t OFF_PO = OFF_MIXER;
constexpr size_t OFF_WI = OFF_PO + (size_t)T_ * OD_N * 2;
constexpr size_t OFF_VTC = OFF_WI + (size_t)T_ * 4 * 4;
constexpr size_t OFF_VTD = OFF_VTC + (size_t)2 * 8 * 64 * L_ * 2;
constexpr size_t OFF_BM = OFF_VTD + (size_t)2 * 3 * 8 * 64 * L_ * 2;
constexpr size_t OFF_OD = OFF_BM + (size_t)T_ * 256 * 8;
constexpr size_t OFF_LSE = OFF_OD + (size_t)3 * T_ * 512 * 4;
constexpr size_t END_ODD = OFF_LSE + (size_t)3 * T_ * 8 * 4;
constexpr size_t WS_NEED = END_ODD > END_EVEN ? END_ODD : END_EVEN;
static_assert(WS_NEED < (size_t)4200000000ull, "workspace too large");

constexpr int LDS_BYTES = 153600;

struct Params {
    const float *x, *ev_w_in, *gla_w_gate2, *gla_b_gate2, *gla_norm_g, *s5_a_re, *s5_a_im, *s5_log_dt, *s5_b_re, *s5_b_im, *s5_c_re, *s5_c_im, *s5_d,
        *s5_w_glu, *s5_b_glu, *ev_w_out, *od_w_in, *od_w_out, *ln1_g, *ln1_b, *ln2_g, *ln2_b, *router_w, *router_b, *moe_w1, *moe_b1, *moe_w2, *moe_b2;
    float* out;
    char* ws;
};

#if MEGA
typedef const __attribute__((address_space(4))) Params& PRef;
#else
typedef const Params& PRef;
#endif

__device__ __forceinline__ unsigned pk2(float lo, float hi) { unsigned r; asm("v_cvt_pk_bf16_f32 %0, %1, %2" : "=v"(r) : "v"(lo), "v"(hi)); return r; }
__device__ __forceinline__ bf16_t f2bf(float f) { return (bf16_t)(pk2(f, 0.f) & 0xffffu); }
__device__ __forceinline__ float bf2f(bf16_t h) { return __uint_as_float(((unsigned)h) << 16); }
__device__ __forceinline__ float sigmoidf_(float x) { return __builtin_amdgcn_rcpf(1.f + __expf(-x)); }
template <int CTRL> __device__ __forceinline__ float dppf(float v) { return __int_as_float(__builtin_amdgcn_update_dpp(0, __float_as_int(v), CTRL, 0xF, 0xF, false)); }
constexpr int DPP_X1 = 0xB1  , DPP_X2 = 0x4E  , DPP_HMIR = 0x141  , DPP_MIR = 0x140  , DPP_ROR8 = 0x128;
__device__ __forceinline__ float xor16_sum(float v) { const unsigned u = __float_as_uint(v); auto r = __builtin_amdgcn_permlane16_swap(u, u, false, false); return __uint_as_float(r[0]) + __uint_as_float(r[1]); }
__device__ __forceinline__ float xor16_max(float v) { const unsigned u = __float_as_uint(v); auto r = __builtin_amdgcn_permlane16_swap(u, u, false, false); return fmaxf(__uint_as_float(r[0]), __uint_as_float(r[1])); }
__device__ __forceinline__ float xor32_sum_(float v) { const unsigned u = __float_as_uint(v); auto r = __builtin_amdgcn_permlane32_swap(u, u, false, false); return __uint_as_float(r[0]) + __uint_as_float(r[1]); }
__device__ __forceinline__ float xor32_max_(float v) { const unsigned u = __float_as_uint(v); auto r = __builtin_amdgcn_permlane32_swap(u, u, false, false); return fmaxf(__uint_as_float(r[0]), __uint_as_float(r[1])); }
__device__ __forceinline__ float wave_sum(float v) {
    v += dppf<DPP_X1>(v); v += dppf<DPP_X2>(v); v += dppf<DPP_HMIR>(v); v += dppf<DPP_MIR>(v);
    return xor32_sum_(xor16_sum(v));
}
__device__ __forceinline__ float wave_max(float v) {
    v = fmaxf(v, dppf<DPP_X1>(v)); v = fmaxf(v, dppf<DPP_X2>(v)); v = fmaxf(v, dppf<DPP_HMIR>(v)); v = fmaxf(v, dppf<DPP_MIR>(v));
    return xor32_max_(xor16_max(v));
}
__device__ __forceinline__ float gelu_tanh(float x) {
    const float k0 = 0.7978845608028654f, k1 = 0.044715f;
    float u = k0 * (x + k1 * x * x * x);
    float t = 1.f - 2.f * __builtin_amdgcn_rcpf(1.f + __expf(2.f * u));
    return 0.5f * x * (1.f + t);
}
__device__ __forceinline__ float xor32_max(float v) { const unsigned u = __float_as_uint(v); auto r = __builtin_amdgcn_permlane32_swap(u, u, false, false); return fmaxf(__uint_as_float(r[0]), __uint_as_float(r[1])); }
__device__ __forceinline__ float xor32_sum(float v) { const unsigned u = __float_as_uint(v); auto r = __builtin_amdgcn_permlane32_swap(u, u, false, false); return __uint_as_float(r[0]) + __uint_as_float(r[1]); }
__device__ __forceinline__ unsigned xor32_or(unsigned u) { auto r = __builtin_amdgcn_permlane32_swap(u, u, false, false); return r[0] | r[1]; }
template <int BIT> __device__ __forceinline__ unsigned bitmask32(int w) { unsigned m; asm("v_bfe_i32 %0, %1, %2, 1" : "=v"(m) : "v"(w), "n"(BIT)); return m; }
__device__ __forceinline__ int otid() { int t = threadIdx.x; asm volatile("" : "+v"(t)); return t; }

#define XB_TMO      128
#define XB_XCNT(j)  (256  + 64 * (j))
#define XB_XSUB(j)  (1280 + 64 * (j))
#define XB_XGEN(j)  (2304 + 64 * (j))
#define XB_TOP      3328
#define XB_TOPGEN   3392
#define XCD_BAR_WORDS 3456
#define XB_SPIN_CAP (1u << 21)
#define LAS __attribute__((address_space(3)))

__device__ __forceinline__ unsigned xb_ld(unsigned* p)              { return __hip_atomic_load(p, __ATOMIC_RELAXED, __HIP_MEMORY_SCOPE_AGENT); }
__device__ __forceinline__ unsigned xb_add(unsigned* p, unsigned v) { return __hip_atomic_fetch_add(p, v, __ATOMIC_RELAXED, __HIP_MEMORY_SCOPE_AGENT); }
__device__ __forceinline__ unsigned xb_xcc_id() { return (unsigned)__builtin_amdgcn_s_getreg((3 << 11) | 20) & 0xFu; }
#define XB_SPIN(cond, bar) do { unsigned _sp = 0; while (cond) { __builtin_amdgcn_s_sleep(1); \
    if ((++_sp & 255u) == 0u) { if (xb_ld(&(bar)[XB_TMO])) break; if (_sp > XB_SPIN_CAP) { atomicAdd(&(bar)[XB_TMO], 1u); break; } } } } while (0)

struct XcdBarrier { unsigned* bar; unsigned x; volatile LAS unsigned* st; };

__device__ __forceinline__ XcdBarrier xcd_barrier_post(unsigned* bar, volatile LAS unsigned* st) {
    XcdBarrier b; b.bar = bar; b.x = xb_xcc_id(); b.st = st;
    if (threadIdx.x == 0) (void)xb_add(&bar[XB_XCNT(b.x)], 1u);
    return b;
}
__device__ __forceinline__ void xcd_barrier_complete(unsigned* bar, unsigned x, unsigned& nloc, unsigned& nx) {
    const unsigned G = gridDim.x * gridDim.y * gridDim.z;
    unsigned sum, cnt, mine, sp = 0u;
    for (;;) {
        sum = 0u; cnt = 0u; mine = 0u;
#pragma unroll
        for (unsigned j = 0; j < 16; ++j) { const unsigned c = xb_ld(&bar[XB_XCNT(j)]); sum += c; cnt += (c > 0u) ? 1u : 0u; mine = (j == x) ? c : mine; }
        if (sum == G) break;
        __builtin_amdgcn_s_sleep(1);
        if ((++sp & 255u) == 0u) { if (xb_ld(&bar[XB_TMO])) break; if (sp > XB_SPIN_CAP) { atomicAdd(&bar[XB_TMO], 1u); break; } }
    }
    nloc = mine > 0u ? mine : 1u; nx = cnt > 0u ? cnt : 1u;
}
__device__ __forceinline__ void xcd_barrier(const XcdBarrier& b) {
    asm volatile("s_waitcnt vmcnt(0)" ::: "memory");
    __syncthreads();
    if (threadIdx.x == 0) {
        unsigned* bar = b.bar;
        __builtin_amdgcn_s_waitcnt(0);
        unsigned nloc = b.st[0], nx = b.st[1];
        if (nloc == 0u) { xcd_barrier_complete(bar, b.x, nloc, nx); b.st[0] = nloc; b.st[1] = nx; }
        const unsigned old = xb_add(&bar[XB_XSUB(b.x)], 1u);
        const unsigned gen = old / nloc;
        if (old + 1u == (gen + 1u) * nloc) {
            __builtin_amdgcn_fence(__ATOMIC_RELEASE, "agent");
            asm volatile("s_waitcnt vmcnt(0)" ::: "memory");
            const unsigned og = xb_add(&bar[XB_TOP], 1u);
            const unsigned tg = og / nx;
            if (og + 1u == (tg + 1u) * nx) xb_add(&bar[XB_TOPGEN], 1u);
            else XB_SPIN(xb_ld(&bar[XB_TOPGEN]) == tg, bar);
            __builtin_amdgcn_fence(__ATOMIC_ACQUIRE, "agent");
            xb_add(&bar[XB_XGEN(b.x)], 1u);
            asm volatile("s_waitcnt vmcnt(0)" ::: "memory");
        } else {
            XB_SPIN(xb_ld(&bar[XB_XGEN(b.x)]) == gen, bar);
            __builtin_amdgcn_fence(__ATOMIC_ACQUIRE, "agent");
            asm volatile("s_waitcnt vmcnt(0)" ::: "memory");
        }
    }
    __syncthreads();
}

constexpr int G_LROW = 144;
constexpr int G_ASZ = 256 * G_LROW;
constexpr int G_BSZ = 128 * G_LROW;
constexpr int G_STAGE = G_ASZ + G_BSZ;
constexpr int G_ROWS_OFF = 2 * G_STAGE;

template <bool GATHER, class Epi>
__device__ __forceinline__ void gemm_tile(const bf16_t* __restrict__ A, long lda, int shift, int m0, const bf16_t* __restrict__ Bt, long ldb, int n0, int K,
                                          char* smem, Epi&& epi) {
    const int tid = otid(), lane = tid & 63, wave = tid >> 6, wr = wave >> 1, wc = wave & 1, fr = lane & 15, fq = lane >> 4;
    const int lrow = tid >> 3, lchunk = tid & 7;
    const int* sRow = (const int*)(smem + G_ROWS_OFF);
    const bf16_t* pa[4]; const bf16_t* pb[2];
#pragma unroll
    for (int i = 0; i < 4; ++i) {
        int r = lrow + 64 * i; long arow;
        if (GATHER) { int v = sRow[r]; arow = v < 0 ? 0 : (v >> shift); } else arow = m0 + r;
        pa[i] = A + arow * lda + lchunk * 8;
    }
#pragma unroll
    for (int i = 0; i < 2; ++i) pb[i] = Bt + (long)(n0 + lrow + 64 * i) * ldb + lchunk * 8;
    f32x4 acc[4][4];
#pragma unroll
    for (int m = 0; m < 4; ++m)
#pragma unroll
        for (int n = 0; n < 4; ++n) acc[m][n] = (f32x4){0.f, 0.f, 0.f, 0.f};
    u32x4 ra[4], rb[2];
    const int nk = K >> 6;
#pragma unroll
    for (int i = 0; i < 4; ++i) ra[i] = *(const u32x4*)(pa[i]);
#pragma unroll
    for (int i = 0; i < 2; ++i) rb[i] = *(const u32x4*)(pb[i]);
    {
        char* sa = smem; char* sb = smem + G_ASZ;
#pragma unroll
        for (int i = 0; i < 4; ++i) *(u32x4*)(sa + (lrow + 64 * i) * G_LROW + lchunk * 16) = ra[i];
#pragma unroll
        for (int i = 0; i < 2; ++i) *(u32x4*)(sb + (lrow + 64 * i) * G_LROW + lchunk * 16) = rb[i];
    }
    __syncthreads();
    for (int kt = 0; kt < nk; ++kt) {
        const bool more = (kt + 1 < nk);
        if (more) {
#pragma unroll
            for (int i = 0; i < 4; ++i) ra[i] = *(const u32x4*)(pa[i] + (kt + 1) * 64);
#pragma unroll
            for (int i = 0; i < 2; ++i) rb[i] = *(const u32x4*)(pb[i] + (kt + 1) * 64);
        }
        const char* sa = smem + (kt & 1) * G_STAGE; const char* sb = sa + G_ASZ;
#pragma unroll
        for (int ks = 0; ks < 2; ++ks) {
            bf16x8 af[4], bfr[4];
#pragma unroll
            for (int m = 0; m < 4; ++m) af[m] = *(const bf16x8*)(sa + (wr * 64 + m * 16 + fr) * G_LROW + (ks * 32 + fq * 8) * 2);
#pragma unroll
            for (int n = 0; n < 4; ++n) bfr[n] = *(const bf16x8*)(sb + (wc * 64 + n * 16 + fr) * G_LROW + (ks * 32 + fq * 8) * 2);
#pragma unroll
            for (int m = 0; m < 4; ++m)
#pragma unroll
                for (int n = 0; n < 4; ++n) acc[m][n] = __builtin_amdgcn_mfma_f32_16x16x32_bf16(af[m], bfr[n], acc[m][n], 0, 0, 0);
        }
        if (more) {
            char* wa = smem + ((kt + 1) & 1) * G_STAGE; char* wb = wa + G_ASZ;
#pragma unroll
            for (int i = 0; i < 4; ++i) *(u32x4*)(wa + (lrow + 64 * i) * G_LROW + lchunk * 16) = ra[i];
#pragma unroll
            for (int i = 0; i < 2; ++i) *(u32x4*)(wb + (lrow + 64 * i) * G_LROW + lchunk * 16) = rb[i];
        }
        __syncthreads();
    }
    {
        f32x4 h0[4][2], h1[4][2];
#pragma unroll
        for (int m = 0; m < 4; ++m) { h0[m][0] = acc[m][0]; h0[m][1] = acc[m][1]; h1[m][0] = acc[m][2]; h1[m][1] = acc[m][3]; }
        epi(h0, wr * 64, n0 + wc * 64, fr, fq);
        epi(h1, wr * 64, n0 + wc * 64 + 32, fr, fq);
    }
}

template <class Epi>
__device__ __forceinline__ void gemm_phase(const bf16_t* A, long lda, int M, const bf16_t* Bt, long ldb, int N, int K, char* smem, int bid, int nb, Epi&& epi) {
    const int ntn = N / 128, ntm = M / 256, nt = ntn * ntm;
    for (int t = bid; t < nt; t += nb) {
        const int mi = t / ntn, ni = t - mi * ntn;
        gemm_tile<false>(A, lda, 0, mi * 256, Bt, ldb, ni * 128, K, smem,
                         [&](f32x4 (&acc)[4][2], int rt0, int c0, int fr, int fq) { epi(acc, mi * 256 + rt0, c0, fr, fq); });
    }
}

constexpr int G8_HT = 128 * 64 * 2;
constexpr int G8_ROWS_OFF = 8 * G8_HT;

__device__ __forceinline__ int g8_lds_byte(int r, int c) {
    const int st = (r >> 4) * 2 + (c >> 5), rr = r & 15, cc = c & 31, ob = rr * 64 + cc * 2;
    return st * 1024 + (ob ^ (((ob >> 9) & 1) << 5));
}
__device__ __forceinline__ void g8_stage_rc(int b, int& R, int& C) {
    const int st = b / 1024, sb = b % 1024, swz = sb ^ (((sb >> 9) & 1) << 5);
    R = (st >> 1) * 16 + swz / 64; C = (st & 1) * 32 + (swz % 64) / 2;
}

#define G8_SA(b, h) (lds + ((b) * 2 + (h)) * G8_HT)
#define G8_SB(b, h) (lds + (4 + (b) * 2 + (h)) * G8_HT)
#define G8_STAGE(P, RS, OFF, soff) do { \
    _Pragma("unroll") for (int _i = 0; _i < 2; ++_i) \
        __builtin_amdgcn_raw_ptr_buffer_load_lds((RS), (LAS unsigned*)((P) + tid * 16 + _i * 8192), 16, (OFF)[_i], (soff), 0, 0); } while (0)
#define G8_LDA(dst, b, h) do { _Pragma("unroll") for (int m = 0; m < 4; ++m) _Pragma("unroll") for (int k = 0; k < 2; ++k) \
    dst[m][k] = *(const LAS bf16x8*)(G8_SA(b, h) + g8_lds_byte(wr * 64 + m * 16 + fr, k * 32 + fq * 8)); } while (0)
#define G8_LDB(dst, b, h) do { _Pragma("unroll") for (int n = 0; n < 2; ++n) _Pragma("unroll") for (int k = 0; k < 2; ++k) \
    dst[n][k] = *(const LAS bf16x8*)(G8_SB(b, h) + g8_lds_byte(wc * 32 + n * 16 + fr, k * 32 + fq * 8)); } while (0)
#define G8_MMA(ai, bj, At, Bt_) do { __builtin_amdgcn_s_setprio(1); \
    _Pragma("unroll") for (int m = 0; m < 4; ++m) _Pragma("unroll") for (int n = 0; n < 2; ++n) _Pragma("unroll") for (int k = 0; k < 2; ++k) \
        acc[ai][bj][m][n] = __builtin_amdgcn_mfma_f32_16x16x32_bf16(Bt_[n][k], At[m][k], acc[ai][bj][m][n], 0, 0, 0); \
    __builtin_amdgcn_s_setprio(0); } while (0)
#define G8_WAIT_V(n) asm volatile("s_waitcnt vmcnt(" #n ")" ::: "memory")
#define G8_WAIT_L(n) asm volatile("s_waitcnt lgkmcnt(" #n ")" ::: "memory")
#define G8_BAR __builtin_amdgcn_s_barrier()
#define G8_SCHED __builtin_amdgcn_sched_barrier(0)

template <bool GATHER, class Epi>
__device__ __forceinline__ void gemm256_tile(const bf16_t* __restrict__ A, long lda, int shift, int m0, const bf16_t* __restrict__ Bt, long ldb, int n0, int K,
                                             char* smem, Epi&& epi) {
    LAS char* lds = (LAS char*)smem;
    int tid = otid();
    int wid = tid >> 6, lane = tid & 63, wr = wid >> 2, wc = wid & 3, fr = lane & 15, fq = lane >> 4;
    unsigned aoff[2][2], boff[2];
    {
        const LAS int* sRow = (const LAS int*)(lds + G8_ROWS_OFF);
#pragma unroll
        for (int i = 0; i < 2; ++i) {
            int R, C; g8_stage_rc(tid * 16 + i * 8192, R, C);
            { const int rho = R & 31, nn = rho >> 4, ii = rho & 15; const int Rp = (R & ~31) + 8 * (ii >> 2) + 4 * nn + (ii & 3);
              boff[i] = (unsigned)((long)Rp * ldb + C) * 2u; }
#pragma unroll
            for (int h = 0; h < 2; ++h) {
                long arow;
                if (GATHER) { const int v = sRow[h * 128 + R]; arow = v < 0 ? 0 : (v >> shift); } else arow = m0 + h * 128 + R;
                aoff[h][i] = (unsigned)(arow * lda + C) * 2u;
            }
        }
    }
    f32x4 acc[2][2][4][2];
#pragma unroll
    for (int a = 0; a < 2; ++a)
#pragma unroll
        for (int b = 0; b < 2; ++b)
#pragma unroll
            for (int m = 0; m < 4; ++m)
#pragma unroll
                for (int n = 0; n < 2; ++n) acc[a][b][m][n] = (f32x4){0.f, 0.f, 0.f, 0.f};
    bf16x8 At[4][2], B0[2][2], B1[2][2];
    const int nt = K / 64;
    const __amdgpu_buffer_rsrc_t rA = __builtin_amdgcn_make_buffer_rsrc((void*)A, 0, 0x7fffffff, 0x00020000);
    const __amdgpu_buffer_rsrc_t rB = __builtin_amdgcn_make_buffer_rsrc((void*)(Bt + (size_t)n0 * ldb), 0, 0x7fffffff, 0x00020000);
    const int bh = (int)(128 * ldb * 2);
    G8_STAGE(G8_SB(0, 0), rB, boff, 0); G8_STAGE(G8_SA(0, 0), rA, aoff[0], 0);
    G8_STAGE(G8_SB(0, 1), rB, boff, bh); G8_STAGE(G8_SA(0, 1), rA, aoff[1], 0);
    if (wr == 1) G8_BAR;
    G8_WAIT_V(4); G8_BAR;
    G8_STAGE(G8_SB(1, 0), rB, boff, 128); G8_STAGE(G8_SA(1, 0), rA, aoff[0], 128); G8_STAGE(G8_SB(1, 1), rB, boff, 128 + bh);
    G8_WAIT_V(6); G8_BAR;
    for (int t = 0; t < nt - 2; t += 2) {
        G8_LDB(B0, 0, 0); G8_SCHED; G8_LDA(At, 0, 0); G8_STAGE(G8_SA(1, 1), rA, aoff[1], (t + 1) * 128);
        G8_WAIT_L(8); G8_BAR; G8_WAIT_L(0); G8_MMA(0, 0, At, B0); G8_BAR; G8_SCHED;
        G8_LDB(B1, 0, 1); G8_STAGE(G8_SB(0, 0), rB, boff, (t + 2) * 128);
        G8_BAR; G8_WAIT_L(0); G8_MMA(0, 1, At, B1); G8_BAR;
        G8_LDA(At, 0, 1); G8_STAGE(G8_SA(0, 0), rA, aoff[0], (t + 2) * 128);
        G8_BAR; G8_WAIT_L(0); G8_MMA(1, 0, At, B0); G8_BAR; G8_SCHED;
        G8_STAGE(G8_SB(0, 1), rB, boff, (t + 2) * 128 + bh);
        G8_WAIT_V(6); G8_BAR; G8_MMA(1, 1, At, B1); G8_BAR;
        G8_LDB(B0, 1, 0); G8_SCHED; G8_LDA(At, 1, 0); G8_STAGE(G8_SA(0, 1), rA, aoff[1], (t + 2) * 128);
        G8_WAIT_L(8); G8_BAR; G8_WAIT_L(0); G8_MMA(0, 0, At, B0); G8_BAR; G8_SCHED;
        G8_LDB(B1, 1, 1); G8_STAGE(G8_SB(1, 0), rB, boff, (t + 3) * 128);
        G8_BAR; G8_WAIT_L(0); G8_MMA(0, 1, At, B1); G8_BAR;
        G8_LDA(At, 1, 1); G8_STAGE(G8_SA(1, 0), rA, aoff[0], (t + 3) * 128);
        G8_BAR; G8_WAIT_L(0); G8_MMA(1, 0, At, B0); G8_BAR; G8_SCHED;
        G8_STAGE(G8_SB(1, 1), rB, boff, (t + 3) * 128 + bh);
        G8_WAIT_V(6); G8_BAR; G8_MMA(1, 1, At, B1); G8_BAR;
    }
    { G8_LDB(B0, 0, 0); G8_WAIT_V(0); G8_LDA(At, 0, 0); G8_STAGE(G8_SA(1, 1), rA, aoff[1], (nt - 1) * 128);
      G8_BAR; G8_WAIT_L(0); G8_MMA(0, 0, At, B0); G8_BAR;
      G8_LDB(B1, 0, 1); G8_BAR; G8_WAIT_L(0); G8_MMA(0, 1, At, B1); G8_BAR;
      G8_LDA(At, 0, 1); G8_WAIT_V(4); G8_BAR; G8_WAIT_L(0); G8_MMA(1, 0, At, B0); G8_MMA(1, 1, At, B1); G8_BAR; }
    { G8_LDB(B0, 1, 0); G8_LDA(At, 1, 0); G8_WAIT_V(2); G8_BAR; G8_WAIT_L(0); G8_MMA(0, 0, At, B0); G8_BAR;
      G8_LDB(B1, 1, 1); G8_WAIT_V(0); G8_BAR; G8_WAIT_L(0); G8_MMA(0, 1, At, B1); G8_BAR;
      G8_LDA(At, 1, 1); G8_BAR; G8_WAIT_L(0); G8_MMA(1, 0, At, B0); G8_MMA(1, 1, At, B1); G8_BAR; }
    if (wr == 0) G8_BAR;
    int tz = otid(); wid = tz >> 6; lane = tz & 63; wr = wid >> 2; wc = wid & 3; fr = lane & 15; fq = lane >> 4;
#pragma unroll
    for (int ai = 0; ai < 2; ++ai)
#pragma unroll
        for (int bj = 0; bj < 2; ++bj) epi(acc[ai][bj], ai * 128 + wr * 64, n0 + bj * 128 + wc * 32, fr, fq);
}

struct G8Desc { const bf16_t* A; const bf16_t* Bt; const int* list; int m0, n0, count, u0, ldb; };

template <bool GATHER, int SHIFT, class Src, class Epi>
__device__ __forceinline__ void gemm256_stream(Src&& src, const int lda, const int K, char* smem, Epi&& epi) {
    LAS char* lds = (LAS char*)smem;
    int tid = otid();
    int wid = tid >> 6, lane = tid & 63, wr = wid >> 2, wc = wid & 3, fr = lane & 15, fq = lane >> 4;
    G8Desc nxt;
    if (!src(0, nxt)) return;
    int cm0 = nxt.m0, cn0 = nxt.n0, cu0 = nxt.u0;
    int* sRowG = (int*)(smem + G8_ROWS_OFF);
    __syncthreads();
    if (GATHER) { if (tid < 256) sRowG[tid] = tid < nxt.count ? nxt.list[tid] : -1; __syncthreads(); }
    unsigned aoff[2][2], boff[2];
    __amdgpu_buffer_rsrc_t rA, rB;
    int bh;
#define G8_PREP(D, SLOT) do { \
        const LAS int* _sr = (const LAS int*)(lds + G8_ROWS_OFF) + (SLOT) * 256; \
        _Pragma("unroll") for (int i = 0; i < 2; ++i) { \
            int R, C; g8_stage_rc(tid * 16 + i * 8192, R, C); \
            { const int rho = R & 31, nn = rho >> 4, ii = rho & 15; const int Rp = (R & ~31) + 8 * (ii >> 2) + 4 * nn + (ii & 3); boff[i] = (unsigned)(Rp * (D).ldb + C) * 2u; } \
            _Pragma("unroll") for (int h = 0; h < 2; ++h) { \
                int arow; \
                if (GATHER) { const int v = _sr[h * 128 + R]; arow = v < 0 ? 0 : (v >> SHIFT); } else arow = (D).m0 + h * 128 + R; \
                aoff[h][i] = (unsigned)(arow * lda + C) * 2u; } } \
        rA = __builtin_amdgcn_make_buffer_rsrc((void*)(D).A, 0, 0x7fffffff, 0x00020000); \
        rB = __builtin_amdgcn_make_buffer_rsrc((void*)((D).Bt + (size_t)(D).n0 * (D).ldb), 0, 0x7fffffff, 0x00020000); bh = 128 * (D).ldb * 2; } while (0)
#define G8_PRO1() do { G8_STAGE(G8_SB(0, 0), rB, boff, 0); G8_STAGE(G8_SA(0, 0), rA, aoff[0], 0); G8_STAGE(G8_SB(0, 1), rB, boff, bh); G8_STAGE(G8_SA(0, 1), rA, aoff[1], 0); } while (0)
    G8_PREP(nxt, 0);
    G8_PRO1();
    f32x4 acc[2][2][4][2];
    const int nt = K / 64;
    for (int it = 0;; ++it) {
#pragma unroll
        for (int a = 0; a < 2; ++a)
#pragma unroll
            for (int b = 0; b < 2; ++b)
#pragma unroll
                for (int m = 0; m < 4; ++m)
#pragma unroll
                    for (int n = 0; n < 2; ++n) acc[a][b][m][n] = (f32x4){0.f, 0.f, 0.f, 0.f};
        const bool has_next = src(it + 1, nxt);
        if (GATHER && has_next && tid < 256) sRowG[((it + 1) % 3) * 256 + tid] = tid < nxt.count ? nxt.list[tid] : -1;
        bf16x8 At[4][2], B0[2][2], B1[2][2];
        if (wr == 1) G8_BAR;
        G8_WAIT_V(4); G8_BAR;
        G8_STAGE(G8_SB(1, 0), rB, boff, 128); G8_STAGE(G8_SA(1, 0), rA, aoff[0], 128); G8_STAGE(G8_SB(1, 1), rB, boff, 128 + bh);
        G8_WAIT_V(6); G8_BAR;
        for (int t = 0; t < nt - 2; t += 2) {
            G8_LDB(B0, 0, 0); G8_SCHED; G8_LDA(At, 0, 0); G8_STAGE(G8_SA(1, 1), rA, aoff[1], (t + 1) * 128);
            G8_WAIT_L(8); G8_BAR; G8_WAIT_L(0); G8_MMA(0, 0, At, B0); G8_BAR; G8_SCHED;
            G8_LDB(B1, 0, 1); G8_STAGE(G8_SB(0, 0), rB, boff, (t + 2) * 128);
            G8_BAR; G8_WAIT_L(0); G8_MMA(0, 1, At, B1); G8_BAR;
            G8_LDA(At, 0, 1); G8_STAGE(G8_SA(0, 0), rA, aoff[0], (t + 2) * 128);
            G8_BAR; G8_WAIT_L(0); G8_MMA(1, 0, At, B0); G8_BAR; G8_SCHED;
            G8_STAGE(G8_SB(0, 1), rB, boff, (t + 2) * 128 + bh);
            G8_WAIT_V(6); G8_BAR; G8_MMA(1, 1, At, B1); G8_BAR;
            G8_LDB(B0, 1, 0); G8_SCHED; G8_LDA(At, 1, 0); G8_STAGE(G8_SA(0, 1), rA, aoff[1], (t + 2) * 128);
            G8_WAIT_L(8); G8_BAR; G8_WAIT_L(0); G8_MMA(0, 0, At, B0); G8_BAR; G8_SCHED;
            G8_LDB(B1, 1, 1); G8_STAGE(G8_SB(1, 0), rB, boff, (t + 3) * 128);
            G8_BAR; G8_WAIT_L(0); G8_MMA(0, 1, At, B1); G8_BAR;
            G8_LDA(At, 1, 1); G8_STAGE(G8_SA(1, 0), rA, aoff[0], (t + 3) * 128);
            G8_BAR; G8_WAIT_L(0); G8_MMA(1, 0, At, B0); G8_BAR; G8_SCHED;
            G8_STAGE(G8_SB(1, 1), rB, boff, (t + 3) * 128 + bh);
            G8_WAIT_V(6); G8_BAR; G8_MMA(1, 1, At, B1); G8_BAR;
        }
        { G8_LDB(B0, 0, 0); G8_WAIT_V(0); G8_LDA(At, 0, 0); G8_STAGE(G8_SA(1, 1), rA, aoff[1], (nt - 1) * 128);
          G8_BAR; G8_WAIT_L(0); G8_MMA(0, 0, At, B0); G8_BAR;
          G8_LDB(B1, 0, 1); G8_BAR; G8_WAIT_L(0); G8_MMA(0, 1, At, B1); G8_BAR;
          G8_LDA(At, 0, 1); G8_WAIT_V(4); G8_BAR; G8_WAIT_L(0); G8_MMA(1, 0, At, B0); G8_MMA(1, 1, At, B1); G8_BAR; }
        { G8_LDB(B0, 1, 0); G8_LDA(At, 1, 0); G8_WAIT_V(2); G8_BAR; G8_WAIT_L(0); G8_MMA(0, 0, At, B0); G8_BAR;
          G8_LDB(B1, 1, 1); G8_WAIT_V(0); G8_BAR; G8_WAIT_L(0); G8_MMA(0, 1, At, B1); G8_BAR;
          G8_LDA(At, 1, 1); G8_BAR; G8_WAIT_L(0); G8_MMA(1, 0, At, B0); G8_MMA(1, 1, At, B1); G8_BAR; }
        if (wr == 0) G8_BAR;
        tid = otid(); wid = tid >> 6; lane = tid & 63; wr = wid >> 2; wc = wid & 3; fr = lane & 15; fq = lane >> 4;
        if (has_next) { G8_PREP(nxt, (it + 1) % 3); G8_PRO1(); }
        {
            const int* sr = sRowG + (it % 3) * 256;
#pragma unroll
            for (int ai = 0; ai < 2; ++ai)
#pragma unroll
                for (int bj = 0; bj < 2; ++bj) epi(cm0, cu0, acc[ai][bj], ai * 128 + wr * 64, cn0 + bj * 128 + wc * 32, fr, fq, sr);
        }
        if (!has_next) break;
        cm0 = nxt.m0; cn0 = nxt.n0; cu0 = nxt.u0;
    }
#undef G8_PREP
#undef G8_PRO1
}

struct XcdSeq {
    int q, qend, step;
    __device__ __forceinline__ XcdSeq(int total, int bid, int nb) {
        if ((nb & 7) == 0) { const int chunk = (total + 7) >> 3, x = bid & 7; q = x * chunk + (bid >> 3); const int e = (x + 1) * chunk; qend = e < total ? e : total; step = nb >> 3; }
        else { q = bid; qend = total; step = nb; }
    }
};

template <class Epi>
__device__ __forceinline__ void gemm256_phase(const bf16_t* A, long lda, int M, const bf16_t* Bt, long ldb, int N, int K, char* smem, int bid, int nb, Epi&& epi) {
    const int ntn = N / 256, ntm = M / 256, nt = ntn * ntm;
    XcdSeq s(nt, bid, nb);
    gemm256_stream<false, 0>(
        [&](int i, G8Desc& d) -> bool {
            const int Q = s.q + i * s.step; if (Q >= s.qend) return false;
            const int pnl = Q / (4 * ntn), r = Q - pnl * 4 * ntn;
            d.A = A; d.Bt = Bt; d.list = nullptr; d.m0 = (pnl * 4 + (r & 3)) * 256; d.n0 = (r >> 2) * 256; d.count = 0; d.u0 = 0; d.ldb = (int)ldb;
            return true; },
        (int)lda, K, smem,
        [&](int m0, int, f32x4 (&acc)[4][2], int rt0, int c0, int fr, int fq, const int*) { epi(acc, m0 + rt0, c0, fr, fq); });
}


__device__ __forceinline__ int colmap(int kind, int n, int nsrc) {
    if (kind == 0) return n < nsrc ? n : -1;
    if (kind == 1) { if (n < 512) return n; if (n < 1024) return n + 512; if (n < 1536) return n + 528; if (n < 1552) return n; if (n < 1792) return -1; return n - 1280; }
    if (kind == 2) { if (n < 1024) return n; if (n < 1280) return n + 512; if (n < 4352) return n + 580; if (n < 4420) return n - 2560; if (n < 4608) return -1; if (n < 5120) return n - 3584; return n - 188; }
    { const int grp = n >> 5, w = n & 31; return ((w >> 2) & 1) * 1024 + grp * 16 + 4 * (w >> 3) + (w & 3); }
}
struct ConvTile { const float* src; bf16_t* dst; int sld, sc, K, n0, k0; };
__device__ __forceinline__ ConvTile conv_decode(PRef p, int t, int n4) {
    constexpr int S0 = 128 * 32 * 4, S1 = S0 + 128 * 16 * 4, S2 = S1 + 2 * 36 * 4, S3 = S2 + 2 * 104 * 4, S4 = S3 + 2 * 16 * 4, S5 = S4 + 2 * 16 * 4, S6 = S5 + 2 * 8 * 2;
    char* ws = p.ws;
    ConvTile c; int nsrc, kind, NT, loc;
    if (t < S0) { loc = t; const int mat = loc / (32 * 4); loc -= mat * 32 * 4; c.src = p.moe_w1 + (size_t)mat * 1024 * 2048; c.dst = (bf16_t*)(ws + OFF_WT_W1) + (size_t)mat * 2048 * 1024; c.sld = 2048; nsrc = 2048; kind = 3; c.K = 1024; NT = 32; }
    else if (t < S1) { loc = t - S0; const int mat = loc / 64; loc -= mat * 64; c.src = p.moe_w2 + (size_t)mat * 1024 * 1024; c.dst = (bf16_t*)(ws + OFF_WT_W2) + (size_t)mat * 1024 * 1024; c.sld = 1024; nsrc = 1024; kind = 0; c.K = 1024; NT = 16; }
    else if (t < S2) { loc = t - S1; const int mat = loc / (36 * 4); loc -= mat * 36 * 4; c.src = p.ev_w_in + (size_t)mat * 1024 * 2064; c.dst = (bf16_t*)(ws + OFF_WT_EVIN) + (size_t)mat * EV_N * 1024; c.sld = 2064; nsrc = 2064; kind = 1; c.K = 1024; NT = 36; }
    else if (t < S3) { loc = t - S2; const int mat = loc / (104 * 4); loc -= mat * 104 * 4; c.src = p.od_w_in + (size_t)mat * 1024 * 6468; c.dst = (bf16_t*)(ws + OFF_WT_ODIN) + (size_t)mat * OD_N * 1024; c.sld = 6468; nsrc = 6468; kind = 2; c.K = 1024; NT = 104; }
    else if (t < S4) { loc = t - S3; const int mat = loc / 64; loc -= mat * 64; c.src = p.ev_w_out + (size_t)mat * 1024 * 1024; c.dst = (bf16_t*)(ws + OFF_WT_EVOUT) + (size_t)mat * 1024 * 1024; c.sld = 1024; nsrc = 1024; kind = 0; c.K = 1024; NT = 16; }
    else if (t < S5) { loc = t - S4; const int mat = loc / 64; loc -= mat * 64; c.src = p.od_w_out + (size_t)mat * 1024 * 1024; c.dst = (bf16_t*)(ws + OFF_WT_ODOUT) + (size_t)mat * 1024 * 1024; c.sld = 1024; nsrc = 1024; kind = 0; c.K = 1024; NT = 16; }
    else if (t < S6) { loc = t - S5; const int mat = loc / 16; loc -= mat * 16; c.src = p.s5_w_glu + (size_t)mat * 512 * 512; c.dst = (bf16_t*)(ws + OFF_WT_GLU) + (size_t)mat * 512 * 512; c.sld = 512; nsrc = 512; kind = 0; c.K = 512; NT = 8; }
    else { loc = t - S6; const int mat = loc / 8; loc -= mat * 8; c.src = p.router_w + (size_t)mat * 1024 * 32; c.dst = (bf16_t*)(ws + OFF_WT_RT) + (size_t)mat * 128 * 1024; c.sld = 32; nsrc = 32; kind = 0; c.K = 1024; NT = 2; }
    const int kt = loc / NT, nt = loc - kt * NT;
    c.n0 = nt * 64; c.k0 = kt * 256;
    c.sc = colmap(kind, c.n0 + n4 * 4, nsrc);
    return c;
}
__device__ __forceinline__ void conv_load(const ConvTile& c, int kp, f32x4 (&v)[8]) {
#pragma unroll
    for (int i = 0; i < 4; ++i)
#pragma unroll
        for (int e = 0; e < 2; ++e) {
            const int k = c.k0 + 2 * (kp + 32 * i) + e;
            v[2 * i + e] = c.sc >= 0 ? *(const f32x4*)(c.src + (size_t)k * c.sld + c.sc) : (f32x4){0.f, 0.f, 0.f, 0.f};
        }
}

__device__ __forceinline__ void conv_phase(PRef p, char* smem, int bid, int nb) {
    char* ws = p.ws;
    constexpr int NTILES = 128 * 32 * 4 + 128 * 16 * 4 + 2 * 36 * 4 + 2 * 104 * 4 + 2 * 16 * 4 + 2 * 16 * 4 + 2 * 8 * 2 + 4 * 2 * 4;
    bf16_t* tile = (bf16_t*)smem;
    const int tid = otid(), n4 = tid & 15, kp = tid >> 4;
    if (bid < NTILES) {
        ConvTile cur = conv_decode(p, bid, n4);
        f32x4 v[8];
        conv_load(cur, kp, v);
        for (int t = bid; t < NTILES; t += nb) {
            const bool more = t + nb < NTILES;
            ConvTile nxt = cur; f32x4 w[8];
            if (more) { nxt = conv_decode(p, t + nb, n4); conv_load(nxt, kp, w); }
#pragma unroll
            for (int i = 0; i < 4; ++i)
#pragma unroll
                for (int j = 0; j < 4; ++j)
                    *(unsigned*)(tile + (n4 * 4 + j) * 258 + 2 * (kp + 32 * i)) = pk2(v[2 * i][j], v[2 * i + 1][j]);
            __syncthreads();
#pragma unroll
            for (int i = 0; i < 4; ++i) {
                const int c = tid + 512 * i, n = c >> 5, kc = c & 31;
                const unsigned* tp = (const unsigned*)(tile + n * 258 + kc * 8);
                u32x4 o; o.x = tp[0]; o.y = tp[1]; o.z = tp[2]; o.w = tp[3];
                *(u32x4*)(cur.dst + (size_t)(cur.n0 + n) * cur.K + cur.k0 + kc * 8) = o;
            }
            __syncthreads();
            if (more) {
                cur = nxt;
#pragma unroll
                for (int i = 0; i < 8; ++i) v[i] = w[i];
            }
        }
    }
    {
        const float* x = p.x; bf16_t* xb = (bf16_t*)(ws + OFF_XB);
        const long nch = (long)T_ * 1024 / 8;
        for (long c = (long)bid * NTHR + otid(); c < nch; c += (long)nb * NTHR) {
            const f32x4 a = *(const f32x4*)(x + c * 8), b = *(const f32x4*)(x + c * 8 + 4);
            u32x4 w; w.x = pk2(a[0], a[1]); w.y = pk2(a[2], a[3]); w.z = pk2(b[0], b[1]); w.w = pk2(b[2], b[3]);
            *(u32x4*)(xb + c * 8) = w;
        }
    }
    if (bid == 0 && otid() < 128) ((int*)(ws + OFF_CNT))[otid()] = 0;
}

__device__ __forceinline__ void s5mat_unit(PRef p, int u, char* smem) {
    float* cre = (float*)smem;
    float* cim = cre + 16 * 65;
    float* bbr = cim + 16 * 65;
    float* bbi = bbr + 1024;
    float* pwr = bbi + 1024;
    float* pwi = pwr + 65 * 65;
    float* zr = pwi + 65 * 65;
    float* zi = zr + 64;
    float* Kd = zi + 64 + 2;
    const int tid = otid();
    const int jg = u >> 2, q = u & 3;
    if (tid < 64) {
        const int pp = tid;
        const float lre = fminf(p.s5_a_re[jg * 64 + pp], -1e-4f), lim = p.s5_a_im[jg * 64 + pp];
        const float dt = expf(p.s5_log_dt[jg]);
        const float xr = lre * dt, th = lim * dt;
        const float mag = expf(xr);
        const float ar = mag * cosf(th), ai = mag * sinf(th);
        const float inv = 1.f / (lre * lre + lim * lim);
        zr[pp] = ((ar - 1.f) * lre + ai * lim) * inv;
        zi[pp] = (ai * lre - (ar - 1.f) * lim) * inv;
        float wr_ = 1.f, wi_ = 0.f;
        for (int d = 0; d <= 64; ++d) {
            pwr[d * 65 + pp] = wr_; pwi[d * 65 + pp] = wi_;
            const float nr = wr_ * ar - wi_ * ai, ni = wr_ * ai + wi_ * ar;
            wr_ = nr; wi_ = ni;
        }
    } else {
        for (int e = tid - 64; e < 1024; e += NTHR - 64) {
            const int n = e >> 6, pp = e & 63;
            cre[n * 65 + pp] = p.s5_c_re[(size_t)jg * 1024 + e];
            cim[n * 65 + pp] = p.s5_c_im[(size_t)jg * 1024 + e];
        }
    }
    __syncthreads();
    for (int e = tid; e < 1024; e += NTHR) {
        const int pp = e >> 4;
        const float br = p.s5_b_re[(size_t)jg * 1024 + e], bi = p.s5_b_im[(size_t)jg * 1024 + e];
        bbr[e] = zr[pp] * br - zi[pp] * bi;
        bbi[e] = zr[pp] * bi + zi[pp] * br;
    }
    __syncthreads();
    if (tid < 256) {
        const int mh = tid & 1, nl = (tid >> 1) & 3, dp = tid >> 3, n = 4 * q + nl;
        float acc0[8], acc1[8];
#pragma unroll
        for (int i = 0; i < 8; ++i) { acc0[i] = 0.f; acc1[i] = 0.f; }
#pragma unroll 2
        for (int pp = 0; pp < 64; ++pp) {
            const float cr = cre[n * 65 + pp], ci = cim[n * 65 + pp];
            const float q0r = pwr[(2 * dp) * 65 + pp], q0i = pwi[(2 * dp) * 65 + pp], q1r = pwr[(2 * dp + 1) * 65 + pp], q1i = pwi[(2 * dp + 1) * 65 + pp];
            const float v0r = cr * q0r - ci * q0i, v0i = cr * q0i + ci * q0r, v1r = cr * q1r - ci * q1i, v1i = cr * q1i + ci * q1r;
            const f32x4 ba = *(const f32x4*)(bbr + pp * 16 + mh * 8), bb_ = *(const f32x4*)(bbr + pp * 16 + mh * 8 + 4);
            const f32x4 ia = *(const f32x4*)(bbi + pp * 16 + mh * 8), ib = *(const f32x4*)(bbi + pp * 16 + mh * 8 + 4);
#pragma unroll
            for (int i = 0; i < 8; ++i) {
                const float br = i < 4 ? ba[i & 3] : bb_[i & 3], bi = i < 4 ? ia[i & 3] : ib[i & 3];
                acc0[i] += v0r * br - v0i * bi;
                acc1[i] += v1r * br - v1i * bi;
            }
        }
        float* k0 = Kd + ((2 * dp) * 4 + nl) * 16 + mh * 8;
        *(f32x4*)(k0) = (f32x4){acc0[0], acc0[1], acc0[2], acc0[3]};
        *(f32x4*)(k0 + 4) = (f32x4){acc0[4], acc0[5], acc0[6], acc0[7]};
        *(f32x4*)(k0 + 64) = (f32x4){acc1[0], acc1[1], acc1[2], acc1[3]};
        *(f32x4*)(k0 + 68) = (f32x4){acc1[4], acc1[5], acc1[6], acc1[7]};
    }
    __syncthreads();
    bf16_t* TH = (bf16_t*)(p.ws + OFF_TH) + (size_t)jg * 1024 * UHW;
    for (int c = tid; c < 256 * 144; c += NTHR) {
        const int rl = c / 144, ch = c - rl * 144;
        const int tau = rl >> 2, nl = rl & 3, n = 4 * q + nl;
        float v[8];
        if (ch < 128) {
            const int s = ch >> 1, m0 = (ch & 1) * 8;
            if (s <= tau) {
                const f32x4 a = *(const f32x4*)(Kd + ((tau - s) * 4 + nl) * 16 + m0), b = *(const f32x4*)(Kd + ((tau - s) * 4 + nl) * 16 + m0 + 4);
#pragma unroll
                for (int i = 0; i < 4; ++i) { v[i] = a[i]; v[4 + i] = b[i]; }
            } else {
#pragma unroll
                for (int i = 0; i < 8; ++i) v[i] = 0.f;
            }
        } else {
            const int p0 = (ch - 128) * 4;
#pragma unroll
            for (int i = 0; i < 4; ++i) {
                const int pp = p0 + i;
                const float cr = cre[n * 65 + pp], ci = cim[n * 65 + pp], qr = pwr[(tau + 1) * 65 + pp], qi = pwi[(tau + 1) * 65 + pp];
                v[2 * i] = cr * qr - ci * qi;
                v[2 * i + 1] = -(cr * qi + ci * qr);
            }
        }
        u32x4 w; w.x = pk2(v[0], v[1]); w.y = pk2(v[2], v[3]); w.z = pk2(v[4], v[5]); w.w = pk2(v[6], v[7]);
        *(u32x4*)(TH + (size_t)(tau * 16 + n) * UHW + ch * 8) = w;
    }
    bf16_t* GM = (bf16_t*)(p.ws + OFF_GM) + (size_t)jg * 128 * 1024;
    for (int c = tid; c < 32 * 128; c += NTHR) {
        const int row = 32 * q + (c >> 7), ch = c & 127;
        const int pp = row >> 1, ri = row & 1;
        const int s = ch >> 1, m0 = (ch & 1) * 8;
        const float qr = pwr[(63 - s) * 65 + pp], qi = pwi[(63 - s) * 65 + pp];
        float v[8];
#pragma unroll
        for (int i = 0; i < 8; ++i) {
            const float br = bbr[pp * 16 + m0 + i], bi = bbi[pp * 16 + m0 + i];
            v[i] = ri == 0 ? (qr * br - qi * bi) : (qr * bi + qi * br);
        }
        u32x4 w; w.x = pk2(v[0], v[1]); w.y = pk2(v[2], v[3]); w.z = pk2(v[4], v[5]); w.w = pk2(v[6], v[7]);
        *(u32x4*)(GM + (size_t)row * 1024 + ch * 8) = w;
    }
    if (q == 0 && tid < 64) {
        float* A64 = (float*)(p.ws + OFF_A64) + (size_t)jg * 128;
        A64[tid * 2] = pwr[64 * 65 + tid];
        A64[tid * 2 + 1] = pwi[64 * 65 + tid];
    }
    __syncthreads();
}

__device__ __forceinline__ void epi_ev_in(PRef p, f32x4 (&acc)[4][2], int row0, int c0, int fr, int fq) {
    char* ws = p.ws;
    bf16_t* PE = (bf16_t*)(ws + OFF_PE); bf16_t* UH = (bf16_t*)(ws + OFF_UH); float* GLR = (float*)(ws + OFF_GLR);
    const int col = c0 + 8 * fq;
#pragma unroll
    for (int m = 0; m < 4; ++m) {
        const int t = row0 + m * 16 + fr;
        u32x4 w; w.x = pk2(acc[m][0][0], acc[m][0][1]); w.y = pk2(acc[m][0][2], acc[m][0][3]); w.z = pk2(acc[m][1][0], acc[m][1][1]); w.w = pk2(acc[m][1][2], acc[m][1][3]);
        if (c0 < 1024) {
            *(u32x4*)(PE + (size_t)t * PE_W + col) = w;
        } else if (c0 < 1536) {
            const int ch = col - 1024, g = ch >> 4, mm = ch & 15;
            *(u32x4*)(UH + ((size_t)(t >> 6) * 32 + g) * UHW + (t & 63) * 16 + mm) = w;
        } else if (col < 1552) {
            *(f32x4*)(GLR + (size_t)t * 16 + (col - 1536)) = acc[m][0];
            *(f32x4*)(GLR + (size_t)t * 16 + (col - 1536) + 4) = acc[m][1];
        }
    }
}
__device__ __forceinline__ void epi_vt(bf16_t* __restrict__ img_row0, f32x4 (&acc)[4][2], int rt0, int c0, int fr, int fq) {
#pragma unroll
    for (int m = 0; m < 4; ++m) {
        u32x4 w; w.x = pk2(acc[m][0][0], acc[m][0][1]); w.y = pk2(acc[m][0][2], acc[m][0][3]); w.z = pk2(acc[m][1][0], acc[m][1][1]); w.w = pk2(acc[m][1][2], acc[m][1][3]);
        *(u32x4*)(img_row0 + (size_t)(rt0 + m * 16 + fr) * L_ + c0 + 8 * fq) = w;
    }
}

__device__ __forceinline__ void gla_decay(PRef p, int j, int t0, int h, float* sB) {
    const float* GLR = (const float*)(p.ws + OFF_GLR);
    const float* w2 = p.gla_w_gate2 + (size_t)j * 16 * 256;
    const float* b2 = p.gla_b_gate2 + (size_t)j * 256;
    const int tid = otid();
    for (int e = tid; e < 4096; e += NTHR) {
        const int tau = e >> 6, d = e & 63;
        float a = b2[h * 64 + d];
#pragma unroll
        for (int r = 0; r < 16; ++r) a += GLR[(size_t)(t0 + tau) * 16 + r] * w2[r * 256 + h * 64 + d];
        const float ls = fminf(a, 0.f) - __logf(1.f + __expf(-fabsf(a)));
        sB[tau * 65 + d] = ls * (1.f / 16.f);
    }
    __syncthreads();
    if (tid < 64) { float run = 0.f; for (int tau = 0; tau < 64; ++tau) { run += sB[tau * 65 + tid]; sB[tau * 65 + tid] = run; } }
    __syncthreads();
}

__device__ __forceinline__ void gla_a_item(PRef p, int j, int item, char* smem) {
    const int h = item & 3, c = (item >> 2) & 255, b = item >> 10;
    const int t0 = b * L_ + c * 64;
    float* sB = (float*)smem;
    bf16_t* AK = (bf16_t*)(smem + 16640);
    const bf16_t* PE = (const bf16_t*)(p.ws + OFF_PE);
    const bf16_t* VTE = (const bf16_t*)(p.ws + OFF_VTE);
    const int tid = otid(), lane = tid & 63, wave = tid >> 6, fr = lane & 15, fq = lane >> 4;
    gla_decay(p, j, t0, h, sB);
    for (int e = tid; e < 4096; e += NTHR) {
        const int tau = e >> 6, d = e & 63;
        const float k = bf2f(PE[(size_t)(t0 + tau) * PE_W + 256 + h * 64 + d]);
        AK[d * 72 + tau] = f2bf(k * __expf(sB[63 * 65 + d] - sB[tau * 65 + d]));
    }
    __syncthreads();
    const int dblk = wave >> 1, vb = (wave & 1) * 64;
    f32x4 acc[4];
#pragma unroll
    for (int n = 0; n < 4; ++n) acc[n] = (f32x4){0.f, 0.f, 0.f, 0.f};
#pragma unroll
    for (int ks = 0; ks < 2; ++ks) {
        const bf16x8 af = *(const bf16x8*)(AK + (dblk * 16 + fr) * 72 + ks * 32 + fq * 8);
#pragma unroll
        for (int n = 0; n < 4; ++n) {
            const int v = vb + n * 16 + fr;
            const bf16x8 bfr = *(const bf16x8*)(VTE + ((size_t)((b * 4 + h) * 128 + v)) * L_ + (c * 64 + ks * 32 + fq * 8));
            acc[n] = __builtin_amdgcn_mfma_f32_16x16x32_bf16(af, bfr, acc[n], 0, 0, 0);
        }
    }
    float* KV = (float*)(p.ws + OFF_KV) + ((size_t)((b * 256 + c) * 4 + h)) * 64 * 128;
#pragma unroll
    for (int n = 0; n < 4; ++n)
#pragma unroll
        for (int r = 0; r < 4; ++r) KV[(dblk * 16 + fq * 4 + r) * 128 + vb + n * 16 + fr] = acc[n][r];
    if (tid < 64) ((float*)(p.ws + OFF_DEC))[((size_t)((b * 256 + c) * 4 + h)) * 64 + tid] = __expf(sB[63 * 65 + tid]);
    __syncthreads();
}

__device__ __forceinline__ void scan_phase(PRef p, int j, int bid) {
    const int gid = bid * NTHR + otid();
    if (gid < 65536) {
        const int v = gid & 127, d = (gid >> 7) & 63, h = (gid >> 13) & 3, b = gid >> 15;
        const float* KV = (const float*)(p.ws + OFF_KV); float* SST = (float*)(p.ws + OFF_SST); const float* DEC = (const float*)(p.ws + OFF_DEC);
        float S = 0.f;
        for (int c0 = 0; c0 < 256; c0 += 8) {
            float kv[8], dc[8];
#pragma unroll
            for (int i = 0; i < 8; ++i) {
                const size_t blk = (size_t)((b * 256 + c0 + i) * 4 + h);
                kv[i] = KV[(blk * 64 + d) * 128 + v]; dc[i] = DEC[blk * 64 + d];
            }
#pragma unroll
            for (int i = 0; i < 8; ++i) {
                const size_t blk = (size_t)((b * 256 + c0 + i) * 4 + h);
                SST[(blk * 64 + d) * 128 + v] = S;
                S = dc[i] * S + kv[i];
            }
        }
    } else if (gid < 65536 + 4096) {
        const int e = gid - 65536, pp = e & 63, g = (e >> 6) & 31, b = e >> 11;
        const float* A64 = (const float*)(p.ws + OFF_A64) + (size_t)(j * 32 + g) * 128;
        const float ar = A64[pp * 2], ai = A64[pp * 2 + 1];
        const float* GB = (const float*)(p.ws + OFF_GBUF); bf16_t* UH = (bf16_t*)(p.ws + OFF_UH);
        float hr = 0.f, hi = 0.f;
        for (int c0 = 0; c0 < 256; c0 += 8) {
            float gr[8], gi[8];
#pragma unroll
            for (int i = 0; i < 8; ++i) { const size_t row = (size_t)(b * 256 + c0 + i) * 32 + g; gr[i] = GB[row * 128 + 2 * pp]; gi[i] = GB[row * 128 + 2 * pp + 1]; }
#pragma unroll
            for (int i = 0; i < 8; ++i) {
                const size_t row = (size_t)(b * 256 + c0 + i) * 32 + g;
                *(unsigned*)(UH + row * UHW + 1024 + 2 * pp) = pk2(hr, hi);
                const float nr = ar * hr - ai * hi + gr[i], ni = ar * hi + ai * hr + gi[i];
                hr = nr; hi = ni;
            }
        }
    }
}

__device__ __forceinline__ void gla_c_item(PRef p, int j, int item, char* smem) {
    const int h = item & 3, c = (item >> 2) & 255, b = item >> 10;
    const int t0 = b * L_ + c * 64;
    float* sB = (float*)smem;
    bf16_t* QT = (bf16_t*)(smem + 16640);
    bf16_t* KT = (bf16_t*)(smem + 16640 + 9216);
    bf16_t* ATT = (bf16_t*)(smem + 16640 + 18432);
    float* OS = (float*)(smem + 16640 + 27648);
    const bf16_t* PE = (const bf16_t*)(p.ws + OFF_PE);
    const bf16_t* VTE = (const bf16_t*)(p.ws + OFF_VTE);
    const int tid = otid(), lane = tid & 63, wave = tid >> 6, fr = lane & 15, fq = lane >> 4;
    gla_decay(p, j, t0, h, sB);
    for (int e = tid; e < 4096; e += NTHR) {
        const int tau = e >> 6, d = e & 63;
        const float bb = sB[tau * 65 + d];
        const float q = bf2f(PE[(size_t)(t0 + tau) * PE_W + h * 64 + d]);
        const float k = bf2f(PE[(size_t)(t0 + tau) * PE_W + 256 + h * 64 + d]);
        QT[tau * 72 + d] = f2bf(q * 0.125f * __expf(bb));
        KT[tau * 72 + d] = f2bf(k * __expf(-bb));
    }
    __syncthreads();
    const int iblk = wave >> 1;
    {
        f32x4 acc[2];
        acc[0] = (f32x4){0.f, 0.f, 0.f, 0.f}; acc[1] = acc[0];
#pragma unroll
        for (int ks = 0; ks < 2; ++ks) {
            const bf16x8 af = *(const bf16x8*)(QT + (iblk * 16 + fr) * 72 + ks * 32 + fq * 8);
#pragma unroll
            for (int n = 0; n < 2; ++n) {
                const int jb = (wave & 1) * 2 + n;
                const bf16x8 bfr = *(const bf16x8*)(KT + (jb * 16 + fr) * 72 + ks * 32 + fq * 8);
                acc[n] = __builtin_amdgcn_mfma_f32_16x16x32_bf16(af, bfr, acc[n], 0, 0, 0);
            }
        }
#pragma unroll
        for (int n = 0; n < 2; ++n) {
            const int jj = ((wave & 1) * 2 + n) * 16 + fr;
#pragma unroll
            for (int r = 0; r < 4; ++r) { const int ii = iblk * 16 + fq * 4 + r; ATT[ii * 72 + jj] = f2bf(jj <= ii ? acc[n][r] : 0.f); }
        }
    }
    __syncthreads();
    {
        const int vb = (wave & 1) * 64;
        const float* SST = (const float*)(p.ws + OFF_SST) + ((size_t)((b * 256 + c) * 4 + h)) * 64 * 128;
        f32x4 acc[4];
#pragma unroll
        for (int n = 0; n < 4; ++n) acc[n] = (f32x4){0.f, 0.f, 0.f, 0.f};
#pragma unroll
        for (int ks = 0; ks < 2; ++ks) {
            const bf16x8 af = *(const bf16x8*)(ATT + (iblk * 16 + fr) * 72 + ks * 32 + fq * 8);
            const bf16x8 aq = *(const bf16x8*)(QT + (iblk * 16 + fr) * 72 + ks * 32 + fq * 8);
#pragma unroll
            for (int n = 0; n < 4; ++n) {
                const int v = vb + n * 16 + fr;
                const bf16x8 bv = *(const bf16x8*)(VTE + ((size_t)((b * 4 + h) * 128 + v)) * L_ + (c * 64 + ks * 32 + fq * 8));
                acc[n] = __builtin_amdgcn_mfma_f32_16x16x32_bf16(af, bv, acc[n], 0, 0, 0);
                bf16x8 bs;
#pragma unroll
                for (int i = 0; i < 8; ++i) bs[i] = (short)f2bf(SST[(ks * 32 + fq * 8 + i) * 128 + v]);
                acc[n] = __builtin_amdgcn_mfma_f32_16x16x32_bf16(aq, bs, acc[n], 0, 0, 0);
            }
        }
#pragma unroll
        for (int n = 0; n < 4; ++n)
#pragma unroll
            for (int r = 0; r < 4; ++r) OS[(iblk * 16 + fq * 4 + r) * 132 + vb + n * 16 + fr] = acc[n][r];
    }
    __syncthreads();
    {
        const int i = tid >> 3, seg = tid & 7;
        float o[16]; float ss = 0.f;
#pragma unroll
        for (int q = 0; q < 16; ++q) { o[q] = OS[i * 132 + seg * 16 + q]; ss += o[q] * o[q]; }
        ss += __shfl_xor(ss, 1, 64); ss += __shfl_xor(ss, 2, 64); ss += __shfl_xor(ss, 4, 64);
        const float rs = rsqrtf(ss * (1.f / 128.f) + LN_EPS);
        const float* ng = p.gla_norm_g + (size_t)j * 128;
        bf16_t* CC = (bf16_t*)(p.ws + OFF_CC);
        const size_t t = (size_t)(t0 + i);
        unsigned w[8];
#pragma unroll
        for (int q = 0; q < 16; q += 2) {
            const int v0 = seg * 16 + q;
            const float r0 = bf2f(PE[t * PE_W + 512 + h * 128 + v0]), r1 = bf2f(PE[t * PE_W + 512 + h * 128 + v0 + 1]);
            const float a0 = o[q] * rs * ng[v0] * (r0 * sigmoidf_(r0)), a1 = o[q + 1] * rs * ng[v0 + 1] * (r1 * sigmoidf_(r1));
            w[q >> 1] = pk2(a0, a1);
        }
        u32x4 w0, w1; w0.x = w[0]; w0.y = w[1]; w0.z = w[2]; w0.w = w[3]; w1.x = w[4]; w1.y = w[5]; w1.z = w[6]; w1.w = w[7];
        *(u32x4*)(CC + t * 1024 + h * 128 + seg * 16) = w0;
        *(u32x4*)(CC + t * 1024 + h * 128 + seg * 16 + 8) = w1;
    }
    __syncthreads();
}

__device__ __forceinline__ void s5_g_phase(PRef p, int j, char* smem, int bid, int nb) {
    const bf16_t* UH = (const bf16_t*)(p.ws + OFF_UH);
    float* GB = (float*)(p.ws + OFF_GBUF);
    for (int t = bid; t < 64; t += nb) {
        const int g = t >> 1, mi = t & 1;
        const bf16_t* Bt = (const bf16_t*)(p.ws + OFF_GM) + (size_t)(j * 32 + g) * 128 * 1024;
        gemm_tile<false>(UH + (size_t)g * UHW, (long)32 * UHW, 0, mi * 256, Bt, 1024, 0, 1024, smem,
            [&](f32x4 (&acc)[4][2], int rt0, int c0, int fr, int fq) {
#pragma unroll
                for (int m = 0; m < 4; ++m)
#pragma unroll
                    for (int n = 0; n < 2; ++n)
#pragma unroll
                        for (int r = 0; r < 4; ++r) {
                            const int row = mi * 256 + rt0 + m * 16 + fq * 4 + r;
                            GB[((size_t)row * 32 + g) * 128 + c0 + n * 16 + fr] = acc[m][n][r];
                        }
            });
    }
}
__device__ __forceinline__ void s5_y_phase(PRef p, int j, char* smem, int bid, int nb) {
    const bf16_t* UH = (const bf16_t*)(p.ws + OFF_UH);
    bf16_t* YA = (bf16_t*)(p.ws + OFF_YA);
    const float* dsk = p.s5_d + (size_t)j * 512;
    XcdSeq sq(32 * 2 * 4, bid, nb);
    for (int t = sq.q; t < sq.qend; t += sq.step) {
        const int g = t >> 3, mi = (t >> 2) & 1, ni = t & 3;
        const bf16_t* Bt = (const bf16_t*)(p.ws + OFF_TH) + (size_t)(j * 32 + g) * 1024 * UHW;
        gemm256_tile<false>(UH + (size_t)g * UHW, (long)32 * UHW, 0, mi * 256, Bt, UHW, ni * 256, UHW, smem,
            [&](f32x4 (&acc)[4][2], int rt0, int c0, int fr, int fq) {
                const int col = c0 + 8 * fq;
                const int tau = col >> 4, nn = col & 15, ch = g * 16 + nn;
                const f32x4 d0 = *(const f32x4*)(dsk + ch), d1 = *(const f32x4*)(dsk + ch + 4);
#pragma unroll
                for (int m = 0; m < 4; ++m) {
                    const int row = mi * 256 + rt0 + m * 16 + fr;
                    const u32x4 uw = *(const u32x4*)(UH + ((size_t)row * 32 + g) * UHW + col);
                    float y[8];
#pragma unroll
                    for (int q = 0; q < 4; ++q) {
                        const unsigned u2 = q == 0 ? uw.x : q == 1 ? uw.y : q == 2 ? uw.z : uw.w;
                        const float u0 = __uint_as_float(u2 << 16), u1 = __uint_as_float(u2 & 0xffff0000u);
                        const float a0 = q < 2 ? acc[m][0][2 * q] : acc[m][1][2 * q - 4], a1 = q < 2 ? acc[m][0][2 * q + 1] : acc[m][1][2 * q - 3];
                        const float dd0 = q < 2 ? d0[2 * q] : d1[2 * q - 4], dd1 = q < 2 ? d0[2 * q + 1] : d1[2 * q - 3];
                        y[2 * q] = gelu_tanh(a0 + dd0 * u0); y[2 * q + 1] = gelu_tanh(a1 + dd1 * u1);
                    }
                    u32x4 w; w.x = pk2(y[0], y[1]); w.y = pk2(y[2], y[3]); w.z = pk2(y[4], y[5]); w.w = pk2(y[6], y[7]);
                    *(u32x4*)(YA + ((size_t)row * 64 + tau) * 512 + ch) = w;
                }
            });
    }
}

template <bool SLOTS, bool NOEPI = false>
__device__ __forceinline__ void ln_phase(PRef p, const bf16_t* xin, const float* addb, const float* g, const float* bta, float* xout, bf16_t* xb, int bid, int nb) {
    const int lane = otid() & 63, wave = otid() >> 6;
    for (int t = bid * 8 + wave; t < T_; t += nb * 8) {
        f32x4 v[4];
        float s = 0.f;
#pragma unroll
        for (int i = 0; i < 4; ++i) {
            const int c = i * 256 + lane * 4;
            f32x4 a;
            { const u32x2 xw = *(const u32x2*)(xin + (size_t)t * 1024 + c); a = (f32x4){__uint_as_float(xw.x << 16), __uint_as_float(xw.x & 0xffff0000u), __uint_as_float(xw.y << 16), __uint_as_float(xw.y & 0xffff0000u)}; }
            f32x4 m;
            if (SLOTS) {
                const bf16_t* sl = (const bf16_t*)addb;
                m = (f32x4){0.f, 0.f, 0.f, 0.f};
#pragma unroll
                for (int k = 0; k < 4; ++k) {
                    const u32x2 w = *(const u32x2*)(sl + ((size_t)t * 4 + k) * 1024 + c);
                    m[0] += __uint_as_float(w.x << 16); m[1] += __uint_as_float(w.x & 0xffff0000u); m[2] += __uint_as_float(w.y << 16); m[3] += __uint_as_float(w.y & 0xffff0000u);
                }
            } else m = *(const f32x4*)(addb + (size_t)t * 1024 + c);
            v[i] = a * ALPHA + m;
            s += v[i][0] + v[i][1] + v[i][2] + v[i][3];
        }
        const float mu = wave_sum(s) * (1.f / 1024.f);
        float q = 0.f;
#pragma unroll
        for (int i = 0; i < 4; ++i) { v[i] -= mu; q += v[i][0] * v[i][0] + v[i][1] * v[i][1] + v[i][2] * v[i][2] + v[i][3] * v[i][3]; }
        const float rs = rsqrtf(wave_sum(q) * (1.f / 1024.f) + LN_EPS);
#pragma unroll
        for (int i = 0; i < 4; ++i) {
            const int c = i * 256 + lane * 4;
            const f32x4 gg = *(const f32x4*)(g + c), bb = *(const f32x4*)(bta + c);
            const f32x4 o = v[i] * rs * gg + bb;
            if (xout && (!NOEPI || rs == -1.f)) *(f32x4*)(xout + (size_t)t * 1024 + c) = o;
            if (xb && (!NOEPI || rs == -1.f)) { u32x2 w; w.x = pk2(o[0], o[1]); w.y = pk2(o[2], o[3]); *(u32x2*)(xb + (size_t)t * 1024 + c) = w; }
        }
    }
}

constexpr int RT_STRIDE = 36;
constexpr int RT_SCR_OFF = 1024 * RT_STRIDE * 4;
template <bool NOEPI = false>
__device__ __forceinline__ void ln1_router_phase(PRef p, int layer, char* smem, int bid, int nb) {
    float* wl = (float*)smem;
    const int tid = otid(), lane = tid & 63, wave = tid >> 6;
    float* lgs = (float*)(smem + RT_SCR_OFF + wave * 640);
    int* pick = (int*)(lgs + 32);
    float* pgate = (float*)(pick + 64);
    {
        const float* rw = p.router_w + (size_t)layer * 1024 * 32;
        for (int e = tid; e < 32768; e += NTHR) {
            const int k = e >> 5, ex = e & 31, rem = k & 255;
            wl[((k & ~255) + (rem & 3) * 64 + (rem >> 2)) * RT_STRIDE + ex] = rw[e];
        }
    }
    __syncthreads();
    const bf16_t* addb = (const bf16_t*)(p.ws + OFF_MIX);
    const float* g = p.ln1_g + (size_t)layer * 1024; const float* bta = p.ln1_b + (size_t)layer * 1024;
    bf16_t* xb = (bf16_t*)(p.ws + OFF_XB);
    const bf16_t* xin = xb;
    int* cnt = (int*)(p.ws + OFF_CNT) + layer * 32;
    int* LIST = (int*)(p.ws + OFF_LIST);
    float* GATE = (float*)(p.ws + OFF_GATE);
    const float rbias = p.router_b[(size_t)layer * 32 + (lane >> 1)];
    const int rstep = nb * 8;
    u32x2 xw[2][4], mw[2][4];
#define ROWLOAD(T, R) do { _Pragma("unroll") for (int i_ = 0; i_ < 4; ++i_) { const int c_ = i_ * 256 + lane * 4; xw[R][i_] = *(const u32x2*)(xin + (size_t)(T) * 1024 + c_); mw[R][i_] = *(const u32x2*)(addb + (size_t)(T) * 1024 + c_); } } while (0)
    {
        const int t0 = bid * 8 + wave;
        if (t0 < T_) ROWLOAD(t0, 0);
        if (t0 + rstep < T_) ROWLOAD(t0 + rstep, 1);
    }
    for (int tb = bid * 8 + wave; tb < T_; tb += rstep * 16) {
        int nrow = 0;
#pragma unroll 1
        for (int t = tb; t < T_ && nrow < 16; t += 2 * rstep) {
            const bool has1 = t + rstep < T_;
            f32x4 v[2][4];
            float s[2];
#pragma unroll
            for (int r = 0; r < 2; ++r) {
                s[r] = 0.f;
#pragma unroll
                for (int i = 0; i < 4; ++i) {
                    const f32x4 a = (f32x4){__uint_as_float(xw[r][i].x << 16), __uint_as_float(xw[r][i].x & 0xffff0000u), __uint_as_float(xw[r][i].y << 16), __uint_as_float(xw[r][i].y & 0xffff0000u)};
                    const f32x4 m = (f32x4){__uint_as_float(mw[r][i].x << 16), __uint_as_float(mw[r][i].x & 0xffff0000u), __uint_as_float(mw[r][i].y << 16), __uint_as_float(mw[r][i].y & 0xffff0000u)};
                    v[r][i] = a * ALPHA + m; s[r] += v[r][i][0] + v[r][i][1] + v[r][i][2] + v[r][i][3];
                }
            }
            if (t + 2 * rstep < T_) ROWLOAD(t + 2 * rstep, 0);
            if (t + 3 * rstep < T_) ROWLOAD(t + 3 * rstep, 1);
#pragma unroll
            for (int r = 0; r < 2; ++r) {
                const float mu = wave_sum(s[r]) * (1.f / 1024.f);
                float q = 0.f;
#pragma unroll
                for (int i = 0; i < 4; ++i) { v[r][i] -= mu; q += v[r][i][0] * v[r][i][0] + v[r][i][1] * v[r][i][1] + v[r][i][2] * v[r][i][2] + v[r][i][3] * v[r][i][3]; }
                const float rs = rsqrtf(wave_sum(q) * (1.f / 1024.f) + LN_EPS);
#pragma unroll
                for (int i = 0; i < 4; ++i) {
                    const int c = i * 256 + lane * 4;
                    const f32x4 gg = *(const f32x4*)(g + c), bb = *(const f32x4*)(bta + c);
                    v[r][i] = v[r][i] * rs * gg + bb;
                    if ((r == 0 || has1) && (!NOEPI || rs == -1.f)) {
                    u32x2 w; w.x = pk2(v[r][i][0], v[r][i][1]); w.y = pk2(v[r][i][2], v[r][i][3]); *(u32x2*)(xb + (size_t)(t + r * rstep) * 1024 + c) = w; }
                }
            }
            f32x4 acc[2][8];
#pragma unroll
            for (int e = 0; e < 8; ++e) { acc[0][e] = (f32x4){0.f, 0.f, 0.f, 0.f}; acc[1][e] = (f32x4){0.f, 0.f, 0.f, 0.f}; }
#pragma unroll
            for (int i = 0; i < 4; ++i)
#pragma unroll
                for (int j = 0; j < 4; ++j) {
                    const f32x4* wr_ = (const f32x4*)(wl + (i * 256 + j * 64 + lane) * RT_STRIDE);
                    const float xv0 = v[0][i][j], xv1 = v[1][i][j];
#pragma unroll
                    for (int e = 0; e < 8; ++e) { const f32x4 w = wr_[e]; acc[0][e] += w * xv0; acc[1][e] += w * xv1; }
                    if (j & 1) __builtin_amdgcn_sched_barrier(0);
                }
#pragma unroll
            for (int e = 0; e < 8; ++e)
#pragma unroll
                for (int k = 0; k < 4; ++k) { float a0 = acc[0][e][k], a1 = acc[1][e][k]; asm volatile("" : "+v"(a0), "+v"(a1)); acc[0][e][k] = a0; acc[1][e][k] = a1; }
#pragma unroll
            for (int r = 0; r < 2; ++r) {
                float k16[16], k8[8], k4[4], k2[2];
#pragma unroll
                for (int a = 0; a < 16; ++a) { auto rr = __builtin_amdgcn_permlane32_swap(__float_as_uint(acc[r][a >> 2][a & 3]), __float_as_uint(acc[r][(a + 16) >> 2][a & 3]), false, false); k16[a] = __uint_as_float(rr[0]) + __uint_as_float(rr[1]); }
#pragma unroll
                for (int a = 0; a < 8; ++a) { auto rr = __builtin_amdgcn_permlane16_swap(__float_as_uint(k16[a]), __float_as_uint(k16[a + 8]), false, false); k8[a] = __uint_as_float(rr[0]) + __uint_as_float(rr[1]); }
                { const bool hb = lane & 8;
#pragma unroll
                  for (int a = 0; a < 4; ++a) { const float mine = hb ? k8[a + 4] : k8[a], send = hb ? k8[a] : k8[a + 4]; k4[a] = mine + dppf<DPP_ROR8>(send); } }
                { const bool hb = lane & 4;
#pragma unroll
                  for (int a = 0; a < 2; ++a) { const float mine = hb ? k4[a + 2] : k4[a], send = hb ? k4[a] : k4[a + 2]; k2[a] = mine + dppf<DPP_HMIR>(send); } }
                float lg;
                { const bool hb = lane & 2; const float mine = hb ? k2[1] : k2[0], send = hb ? k2[0] : k2[1]; lg = mine + dppf<DPP_X2>(send); }
                lg += dppf<DPP_X1>(lg);
                lg += rbias;
                float cand = (lane & 1) ? -INFINITY : lg;
                float tv[4]; int te[4];
#pragma unroll
                for (int k = 0; k < 4; ++k) {
                    const float mxv = wave_max(cand);
                    const unsigned long long bal = __builtin_amdgcn_ballot_w64(cand == mxv);
                    const int first = __builtin_ctzll(bal);
                    tv[k] = mxv; te[k] = first >> 1;
                    if (lane == first) cand = -INFINITY;
                }
                if (lane == 0 && (r == 0 || has1)) {
                    const float e1 = __expf(tv[1] - tv[0]), e2 = __expf(tv[2] - tv[0]), e3 = __expf(tv[3] - tv[0]);
                    const float inv = 1.f / (1.f + e1 + e2 + e3);
                    const int nr = nrow + r;
                    pick[nr * 4 + 0] = te[0]; pick[nr * 4 + 1] = te[1]; pick[nr * 4 + 2] = te[2]; pick[nr * 4 + 3] = te[3];
                    pgate[nr * 4 + 0] = inv; pgate[nr * 4 + 1] = e1 * inv; pgate[nr * 4 + 2] = e2 * inv; pgate[nr * 4 + 3] = e3 * inv;
                }
            }
            nrow += has1 ? 2 : 1;
        }
        if ((lane >> 2) < nrow && (!NOEPI || pgate[lane] < -1.f)) {
            const int t = tb + (lane >> 2) * rstep, ex = pick[lane], pair = t * 4 + (lane & 3);
            const int pos = atomicAdd(&cnt[ex], 1);
            LIST[(size_t)ex * LISTCAP + pos] = pair;
            GATE[pair] = pgate[lane];
        }
    }
}

__device__ __forceinline__ void topk_phase(PRef p, int layer, int bid, int nb) {
    const float* LG = (const float*)(p.ws + OFF_LOGIT);
    int* cnt = (int*)(p.ws + OFF_CNT) + layer * 32;
    int* LIST = (int*)(p.ws + OFF_LIST);
    float* GATE = (float*)(p.ws + OFF_GATE);
    for (int t = bid * NTHR + otid(); t < T_; t += nb * NTHR) {
        float v0 = -INFINITY, v1 = -INFINITY, v2 = -INFINITY, v3 = -INFINITY; int i0 = 0, i1 = 0, i2 = 0, i3 = 0;
#pragma unroll
        for (int q = 0; q < 8; ++q) {
            const f32x4 l4 = *(const f32x4*)(LG + (size_t)t * 32 + q * 4);
#pragma unroll
            for (int r = 0; r < 4; ++r) {
                const float v = l4[r]; const int e = q * 4 + r;
                if (v > v0) { v3 = v2; i3 = i2; v2 = v1; i2 = i1; v1 = v0; i1 = i0; v0 = v; i0 = e; }
                else if (v > v1) { v3 = v2; i3 = i2; v2 = v1; i2 = i1; v1 = v; i1 = e; }
                else if (v > v2) { v3 = v2; i3 = i2; v2 = v; i2 = e; }
                else if (v > v3) { v3 = v; i3 = e; }
            }
        }
        const float e1 = __expf(v1 - v0), e2 = __expf(v2 - v0), e3 = __expf(v3 - v0);
        const float inv = 1.f / (1.f + e1 + e2 + e3);
        int pos;
        pos = atomicAdd(&cnt[i0], 1); LIST[(size_t)i0 * LISTCAP + pos] = t * 4 + 0; GATE[t * 4 + 0] = inv;
        pos = atomicAdd(&cnt[i1], 1); LIST[(size_t)i1 * LISTCAP + pos] = t * 4 + 1; GATE[t * 4 + 1] = e1 * inv;
        pos = atomicAdd(&cnt[i2], 1); LIST[(size_t)i2 * LISTCAP + pos] = t * 4 + 2; GATE[t * 4 + 2] = e2 * inv;
        pos = atomicAdd(&cnt[i3], 1); LIST[(size_t)i3 * LISTCAP + pos] = t * 4 + 3; GATE[t * 4 + 3] = e3 * inv;
    }
}

template <int WHICH, bool NOEPI = false>
__device__ __forceinline__ void moe_gemm_phase(PRef p, int layer, char* smem, int bid, int nb) {
    const int* cnt = (const int*)(p.ws + OFF_CNT) + layer * 32;
    const int* LIST = (const int*)(p.ws + OFF_LIST);
    constexpr int NTN = WHICH == 1 ? 8 : 4;
    int total = 0;
    for (int i = 0; i < 32; ++i) total += ((cnt[i] + 255) >> 8) * NTN;
    XcdSeq sq(total, bid, nb);
    int e = 0, base = 0, ce = cnt[0], mt = (ce + 255) >> 8;
    auto src = [&](int i, G8Desc& d) -> bool {
        const int t = sq.q + i * sq.step;
        if (t >= sq.qend) return false;
        while (e < 32 && t >= base + mt * NTN) { base += mt * NTN; ++e; if (e < 32) { ce = cnt[e]; mt = (ce + 255) >> 8; } }
        if (e >= 32) return false;
        int mi, ni;
        { const int loc = t - base, pf = mt >> 2, full = pf * 4 * NTN;
          if (loc < full) { const int pn = loc / (4 * NTN), r = loc - pn * 4 * NTN; ni = r >> 2; mi = pn * 4 + (r & 3); }
          else { const int ph = mt - pf * 4, r = loc - full; ni = r / ph; mi = pf * 4 + (r - ni * ph); } }
        d.m0 = 0; d.n0 = ni * 256; d.list = LIST + (size_t)e * LISTCAP + mi * 256; d.count = ce - mi * 256; d.u0 = e; d.ldb = 1024;
        if (WHICH == 1) { d.A = (const bf16_t*)(p.ws + OFF_XB); d.Bt = (const bf16_t*)(p.ws + OFF_WT_W1) + (size_t)(layer * 32 + e) * 2048 * 1024; }
        else { d.A = (const bf16_t*)(p.ws + OFF_ACT); d.Bt = (const bf16_t*)(p.ws + OFF_WT_W2) + (size_t)(layer * 32 + e) * 1024 * 1024; }
        return true; };
    if (WHICH == 1) {
        bf16_t* ACT = (bf16_t*)(p.ws + OFF_ACT);
        gemm256_stream<true, 2>(src, 1024, 1024, smem,
            [&](int, int e_, f32x4 (&acc)[4][2], int rt0, int c0, int fr, int fq, const int* sRow) {
                const float* b1 = p.moe_b1 + (size_t)(layer * 32 + e_) * 2048;
                const int gcol = (c0 >> 5) * 16 + 4 * fq;
                const f32x4 bg = *(const f32x4*)(b1 + gcol), bl = *(const f32x4*)(b1 + 1024 + gcol);
#pragma unroll
                for (int m = 0; m < 4; ++m) {
                    const int pair = NOEPI ? -1 : sRow[rt0 + m * 16 + fr];
                    if (pair >= 0) {
                        float a[4];
#pragma unroll
                        for (int r = 0; r < 4; ++r) {
                            const float gl = fminf(acc[m][0][r] + bg[r], 7.f);
                            const float li = fminf(fmaxf(acc[m][1][r] + bl[r], -7.f), 7.f);
                            a[r] = gl * sigmoidf_(1.702f * gl) * (li + 1.f);
                        }
                        u32x2 w; w.x = pk2(a[0], a[1]); w.y = pk2(a[2], a[3]);
                        *(u32x2*)(ACT + (size_t)pair * 1024 + gcol) = w;
                    }
                }
            });
    } else {
        const float* GATE = (const float*)(p.ws + OFF_GATE);
        bf16_t* SLOT = (bf16_t*)(p.ws + OFF_SLOT);
        gemm256_stream<true, 0>(src, 1024, 1024, smem,
            [&](int, int e_, f32x4 (&acc)[4][2], int rt0, int c0, int fr, int fq, const int* sRow) {
                const float* b2 = p.moe_b2 + (size_t)(layer * 32 + e_) * 1024;
                const int col = c0 + 8 * fq;
                const f32x4 b20 = *(const f32x4*)(b2 + col), b21 = *(const f32x4*)(b2 + col + 4);
#pragma unroll
                for (int m = 0; m < 4; ++m) {
                    const int pair = NOEPI ? -1 : sRow[rt0 + m * 16 + fr];
                    if (pair >= 0) {
                        const float gt = GATE[pair];
                        const f32x4 y0 = (acc[m][0] + b20) * gt, y1 = (acc[m][1] + b21) * gt;
                        u32x4 w; w.x = pk2(y0[0], y0[1]); w.y = pk2(y0[2], y0[3]); w.z = pk2(y1[0], y1[1]); w.w = pk2(y1[2], y1[3]);
                        *(u32x4*)(SLOT + (size_t)pair * 1024 + col) = w;
                    }
                }
            });
    }
}

__device__ __forceinline__ void epi_od_in(PRef p, f32x4 (&acc)[4][2], int row0, int c0, int fr, int fq) {
    char* ws = p.ws;
    bf16_t* PO = (bf16_t*)(ws + OFF_PO); float* WI = (float*)(ws + OFF_WI);
    const int col = c0 + 8 * fq;
#pragma unroll
    for (int m = 0; m < 4; ++m) {
        const int t = row0 + m * 16 + fr;
        if (c0 < OD_WI) {
            u32x4 w; w.x = pk2(acc[m][0][0], acc[m][0][1]); w.y = pk2(acc[m][0][2], acc[m][0][3]); w.z = pk2(acc[m][1][0], acc[m][1][1]); w.w = pk2(acc[m][1][2], acc[m][1][3]);
            *(u32x4*)(PO + (size_t)t * OD_P + col) = w;
        } else if (col == OD_WI) {
            *(f32x4*)(WI + (size_t)t * 4) = acc[m][0];
        }
    }
}

__device__ __forceinline__ void idx_scores(const char* __restrict__ ktile, int kbase, const bf16x8 (&qf)[4][4], const float (&wi)[4], int lane, float (&sc)[16]) {
    const int r = lane & 31, h2 = lane >> 5;
    const char* kp = ktile + (kbase + r) * 144 + h2 * 16;
    bf16x8 kf[4];
#pragma unroll
    for (int s = 0; s < 4; ++s) kf[s] = *(const bf16x8*)(kp + s * 32);
#pragma unroll
    for (int i = 0; i < 16; ++i) sc[i] = 0.f;
#pragma unroll
    for (int hd = 0; hd < 4; ++hd) {
        f32x16 a;
#pragma unroll
        for (int i = 0; i < 16; ++i) a[i] = 0.f;
#pragma unroll
        for (int s = 0; s < 4; ++s) a = __builtin_amdgcn_mfma_f32_32x32x16_bf16(kf[s], qf[hd][s], a, 0, 0, 0);
#pragma unroll
        for (int i = 0; i < 16; ++i) { const int ai = __float_as_int(a[i]); sc[i] += wi[hd] * __int_as_float(ai > 0 ? ai : 0); }
    }
}
__device__ __forceinline__ unsigned ord_key(float s) {
    const unsigned u = __float_as_uint(s);
    return u ^ ((unsigned)((int)u >> 31) | 0x80000000u);
}

constexpr int SEL_KT = 128 * 144;
__device__ __forceinline__ void dsa_select_item(PRef p, int b, int qb, char* smem) {
    unsigned* hist = (unsigned*)smem;
    unsigned* pref = (unsigned*)(smem + 66048);
    int* krem = (int*)(smem + 66048 + 256);
    unsigned* GW = (unsigned*)(smem + 66048 + 512);
    unsigned* EW = (unsigned*)(smem + 66048 + 512 + 2048);
    char* kbuf = smem + 71680;
    const bf16_t* PO = (const bf16_t*)(p.ws + OFF_PO);
    const float* WI = (const float*)(p.ws + OFF_WI);
    unsigned long long* BMT = (unsigned long long*)(p.ws + OFF_BM);
    const int tid = otid(), lane = tid & 63, wave = tid >> 6, kw = wave >> 1, qw = wave & 1, h2 = lane >> 5;
    const int p0 = qb * 64;
    const int ql = qw * 32 + (lane & 31);
    const int qpos = p0 + ql;
    const size_t tq = (size_t)b * L_ + qpos;
    const int nkt = (p0 + 64 + 127) >> 7;
    bf16x8 qf[4][4]; float wi[4];
#pragma unroll
    for (int hd = 0; hd < 4; ++hd) {
        wi[hd] = WI[tq * 4 + hd];
#pragma unroll
        for (int s = 0; s < 4; ++s) qf[hd][s] = *(const bf16x8*)(PO + tq * OD_P + OD_QI + hd * 64 + s * 16 + h2 * 8);
    }
    const int srow = tid >> 3, sch = tid & 7;
    const bf16_t* ksrc = PO + ((size_t)b * L_ + srow) * OD_P + OD_KI + sch * 8;
    char* kdst = kbuf + srow * 144 + sch * 16;
    for (int e = tid; e < 64 * 257; e += NTHR) hist[e] = 0u;
    if (tid < 64) { pref[tid] = 0u; krem[tid] = 256; }
    __syncthreads();
    const bool selall = qpos < 256;
    const int npass = (p0 + 63 >= 256) ? 3 : 0;
    for (int pass = 0; pass <= npass; ++pass) {
        const bool maskpass = pass == npass;
        const int sh = 24 - 8 * pass;
        const unsigned mypref = pref[ql];
        int ceq = 0;
        const int rsel = tid < 64 ? krem[tid] : 0;
        const int npair = (nkt + 1) >> 1;
        u32x4 r0, r1, r2 = (u32x4){0u, 0u, 0u, 0u}, r3 = r2;
        r0 = *(const u32x4*)ksrc; r1 = *(const u32x4*)(ksrc + (size_t)64 * OD_P);
        if (nkt > 1) { r2 = *(const u32x4*)(ksrc + (size_t)128 * OD_P); r3 = *(const u32x4*)(ksrc + (size_t)192 * OD_P); }
        *(u32x4*)kdst = r0; *(u32x4*)(kdst + 64 * 144) = r1; *(u32x4*)(kdst + SEL_KT) = r2; *(u32x4*)(kdst + SEL_KT + 64 * 144) = r3;
        __syncthreads();
        for (int kp = 0; kp < npair; ++kp) {
            const bool more = kp + 1 < npair;
            const bool more2 = 2 * kp + 3 < nkt;
            if (more) {
                r0 = *(const u32x4*)(ksrc + (size_t)(2 * kp + 2) * 128 * OD_P); r1 = *(const u32x4*)(ksrc + (size_t)((2 * kp + 2) * 128 + 64) * OD_P);
                if (more2) { r2 = *(const u32x4*)(ksrc + (size_t)(2 * kp + 3) * 128 * OD_P); r3 = *(const u32x4*)(ksrc + (size_t)((2 * kp + 3) * 128 + 64) * OD_P); }
            }
            const char* kcur = kbuf + (kp & 1) * 2 * SEL_KT;
            const bool two = 2 * kp + 1 < nkt;
            unsigned gwp[2] = {0u, 0u}, ewp[2] = {0u, 0u};
#pragma unroll
            for (int tt = 0; tt < 2; ++tt) {
                if (tt == 1 && !two) break;
                const int kt = 2 * kp + tt;
                float sc[16];
                idx_scores(kcur + tt * SEL_KT, kw * 32, qf, wi, lane, sc);
                const int keybase = kt * 128 + kw * 32;
                const bool diag = kt == nkt - 1;
                if (!maskpass) {
                    if (pass == 0 && !diag && p0 >= 256) {
#pragma unroll
                        for (int i = 0; i < 16; ++i) atomicAdd(&hist[ql * 257 + (ord_key(sc[i]) >> 24)], 1u);
                    } else {
#pragma unroll
                        for (int i = 0; i < 16; ++i) {
                            const int key = keybase + (i & 3) + 8 * (i >> 2) + 4 * h2;
                            const unsigned k32 = ord_key(sc[i]);
                            const bool match = pass == 0 ? true : ((k32 >> (sh + 8)) == mypref);
                            const bool valid = diag ? key <= qpos : true;
                            if (valid && !selall && match) atomicAdd(&hist[ql * 257 + ((k32 >> sh) & 255u)], 1u);
                        }
                    }
                } else {
                    unsigned gw = 0u, ew = 0u;
#pragma unroll
                    for (int i = 0; i < 16; ++i) {
                        const int ko = (i & 3) + 8 * (i >> 2) + 4 * h2;
                        const int key = keybase + ko;
                        const unsigned k24 = ord_key(sc[i]) >> 8;
                        const bool valid = diag ? key <= qpos : true;
                        const bool g = valid && (selall || k24 > mypref);
                        const bool e = valid && !selall && k24 == mypref;
                        gw |= (g ? 1u : 0u) << ko; ew |= (e ? 1u : 0u) << ko;
                    }
                    gwp[tt] = xor32_or(gw); ewp[tt] = xor32_or(ew);
                }
            }
            if (maskpass && h2 == 0) { GW[ql * 8 + kw] = gwp[0]; EW[ql * 8 + kw] = ewp[0]; GW[ql * 8 + 4 + kw] = gwp[1]; EW[ql * 8 + 4 + kw] = ewp[1]; }
            if (more) {
                char* nd = kdst + ((kp + 1) & 1) * 2 * SEL_KT;
                *(u32x4*)nd = r0; *(u32x4*)(nd + 64 * 144) = r1;
                if (more2) { *(u32x4*)(nd + SEL_KT) = r2; *(u32x4*)(nd + SEL_KT + 64 * 144) = r3; }
            }
            __syncthreads();
            if (maskpass) {
                if (tid < 64) {
#pragma unroll
                    for (int tt = 0; tt < 2; ++tt) {
                        if (tt == 1 && !two) break;
                        const int kt = 2 * kp + tt;
                        unsigned g4[4], e4[4];
#pragma unroll
                        for (int w = 0; w < 4; ++w) { g4[w] = GW[tid * 8 + tt * 4 + w]; e4[w] = EW[tid * 8 + tt * 4 + w]; }
                        int need = rsel - ceq; if (need < 0) need = 0;
#pragma unroll
                        for (int w = 0; w < 4; ++w) {
                            const int pc = __popc(e4[w]);
                            ceq += pc;
                            if (need >= pc) need -= pc;
                            else { unsigned m = e4[w], kept = 0u; for (int k = 0; k < need; ++k) { const unsigned low = m & (0u - m); kept |= low; m ^= low; } e4[w] = kept; need = 0; }
                            g4[w] |= e4[w];
                        }
                        BMT[((size_t)(b * 256 + 2 * kt)) * L_ + p0 + tid] = (unsigned long long)g4[0] | ((unsigned long long)g4[1] << 32);
                        BMT[((size_t)(b * 256 + 2 * kt + 1)) * L_ + p0 + tid] = (unsigned long long)g4[2] | ((unsigned long long)g4[3] << 32);
                    }
                }
                __syncthreads();
            }
        }
        if (!maskpass) {
            const int q = tid >> 3, part = tid & 7;
            unsigned c32[32]; unsigned tot = 0u;
#pragma unroll
            for (int i = 0; i < 32; ++i) { c32[i] = hist[q * 257 + part * 32 + i]; tot += c32[i]; }
            unsigned above = 0u;
#pragma unroll
            for (int d = 1; d < 8; ++d) { const unsigned o = __shfl(tot, (lane & ~7) + ((part + d) & 7), 64); if (part + d < 8) above += o; }
            const unsigned need = (unsigned)krem[q];
            __syncthreads();
            if ((p0 + q) >= 256 && above < need && above + tot >= need) {
                unsigned cum = above; int dg = 31;
#pragma unroll
                for (int i = 31; i >= 0; --i) { if (i == dg) { if (cum + c32[i] >= need) {   } else { cum += c32[i]; dg = i - 1; } } }
                pref[q] = (pref[q] << 8) | (unsigned)(part * 32 + dg);
                krem[q] = (int)(need - cum);
            }
            for (int e = tid; e < 64 * 257; e += NTHR) hist[e] = 0u;
            __syncthreads();
        }
    }
}

template <int MODE, int NQT>
__device__ __forceinline__ void attn_wave(PRef p, int b, int head, int qcol, int kcol, const bf16_t* __restrict__ VT, int voff,
                                          int i0, int sh  , int rho, int kt_lo, int kt_hi, int grp) {
    const bf16_t* PO = (const bf16_t*)(p.ws + OFF_PO);
    const unsigned* BM32 = (const unsigned*)(p.ws + OFF_BM);
    const int lane = otid() & 63, r = lane & 31, h2 = lane >> 5;
    const int pr = (r & 0x13) | ((r & 4) << 1) | ((r & 8) >> 1);
    const float SC = 0.125f * 1.4426950408889634f;
    bf16x8 qf[NQT][4]; size_t tq[NQT]; int qi[NQT];
#pragma unroll
    for (int qt = 0; qt < NQT; ++qt) {
        qi[qt] = i0 + qt * 32 + r;
        tq[qt] = (size_t)b * L_ + ((size_t)qi[qt] << sh) + rho;
#pragma unroll
        for (int s = 0; s < 4; ++s) qf[qt][s] = *(const bf16x8*)(PO + tq[qt] * OD_P + qcol + head * 64 + s * 16 + h2 * 8);
    }
    f32x16 oacc[NQT][2];
#pragma unroll
    for (int a = 0; a < NQT; ++a)
#pragma unroll
        for (int c = 0; c < 2; ++c)
#pragma unroll
            for (int i = 0; i < 16; ++i) oacc[a][c][i] = 0.f;
    float mrun[NQT], lrun[NQT];
#pragma unroll
    for (int a = 0; a < NQT; ++a) { mrun[a] = -64.f; lrun[a] = 0.f; }
    bf16x8 kf[4]; unsigned mw[NQT];
    auto load_k = [&](int kt, bf16x8 (&k_)[4], unsigned (&m_)[NQT]) {
        const size_t krow = (size_t)b * L_ + ((size_t)(kt * 32 + pr) << sh) + rho;
#pragma unroll
        for (int s = 0; s < 4; ++s) k_[s] = *(const bf16x8*)(PO + krow * OD_P + kcol + head * 64 + s * 16 + h2 * 8);
#pragma unroll
        for (int a = 0; a < NQT; ++a) m_[a] = MODE == 0 ? BM32[tq[a] * 512 + kt] : 0u;
    };
    load_k(kt_lo, kf, mw);
#pragma unroll 1
    for (int kt = kt_lo; kt <= kt_hi; ++kt) {
        bf16x8 vf[2][2];
#pragma unroll
        for (int db = 0; db < 2; ++db)
#pragma unroll
            for (int s2 = 0; s2 < 2; ++s2) vf[db][s2] = *(const bf16x8*)(VT + (size_t)(db * 32 + r) * L_ + voff + kt * 32 + s2 * 16 + h2 * 8);
        bf16x8 kn[4]; unsigned mn[NQT];
#pragma unroll
        for (int a = 0; a < NQT; ++a) mn[a] = 0u;
        if (kt < kt_hi) load_k(kt + 1, kn, mn);
#pragma unroll
        for (int qt = 0; qt < NQT; ++qt) {
            f32x16 s;
#pragma unroll
            for (int i = 0; i < 16; ++i) s[i] = 0.f;
#pragma unroll
            for (int ks = 0; ks < 4; ++ks) s = __builtin_amdgcn_mfma_f32_32x32x16_bf16(kf[ks], qf[qt][ks], s, 0, 0, 0);
            unsigned wsel;
            if (MODE == 0) wsel = mw[qt];
            else {
                const int hi = qi[qt] - kt * 32, lo = hi - 128;
                const unsigned mh = hi < 0 ? 0u : (hi >= 31 ? 0xffffffffu : ((2u << hi) - 1u)), ml = lo <= 0 ? 0xffffffffu : (lo > 31 ? 0u : ~((1u << lo) - 1u));
                wsel = mh & ml;
            }
#pragma unroll
            for (int i = 0; i < 16; ++i) s[i] = __builtin_fmaf(s[i], SC, -mrun[qt]);
            float mx = fmaxf(fmaxf(s[0], s[1]), fmaxf(s[2], s[3]));
#pragma unroll
            for (int i = 4; i < 16; i += 2) mx = fmaxf(mx, fmaxf(s[i], s[i + 1]));
            mx = xor32_max(mx);
            if (__builtin_amdgcn_ballot_w64(mx > 0.f) != 0ull) {
                const float dlt = fmaxf(mx, 0.f);
                const float corr = __builtin_amdgcn_exp2f(-dlt);
                mrun[qt] += dlt; lrun[qt] *= corr;
#pragma unroll
                for (int db = 0; db < 2; ++db)
#pragma unroll
                    for (int i = 0; i < 16; ++i) oacc[qt][db][i] *= corr;
#pragma unroll
                for (int i = 0; i < 16; ++i) s[i] -= dlt;
            }
            float ps = 0.f;
            const int mws = (int)(wsel >> (8 * h2));
#define DA_P(i, KO) { const float e = __builtin_amdgcn_exp2f(s[i]); s[i] = __uint_as_float(__float_as_uint(e) & bitmask32<KO>(mws)); ps += s[i]; }
            DA_P(0, 0) DA_P(1, 1) DA_P(2, 2) DA_P(3, 3) DA_P(4, 4) DA_P(5, 5) DA_P(6, 6) DA_P(7, 7)
            DA_P(8, 16) DA_P(9, 17) DA_P(10, 18) DA_P(11, 19) DA_P(12, 20) DA_P(13, 21) DA_P(14, 22) DA_P(15, 23)
#undef DA_P
            lrun[qt] += ps;
#pragma unroll
            for (int s2 = 0; s2 < 2; ++s2) {
                u32x4 pw; pw.x = pk2(s[8 * s2], s[8 * s2 + 1]); pw.y = pk2(s[8 * s2 + 2], s[8 * s2 + 3]); pw.z = pk2(s[8 * s2 + 4], s[8 * s2 + 5]); pw.w = pk2(s[8 * s2 + 6], s[8 * s2 + 7]);
                const bf16x8 pf = __builtin_bit_cast(bf16x8, pw);
#pragma unroll
                for (int db = 0; db < 2; ++db) oacc[qt][db] = __builtin_amdgcn_mfma_f32_32x32x16_bf16(vf[db][s2], pf, oacc[qt][db], 0, 0, 0);
            }
        }
        if (kt < kt_hi) {
#pragma unroll
            for (int s = 0; s < 4; ++s) kf[s] = kn[s];
#pragma unroll
            for (int a = 0; a < NQT; ++a) mw[a] = mn[a];
        }
    }
#pragma unroll
    for (int qt = 0; qt < NQT; ++qt) {
        const float lt = xor32_sum(lrun[qt]);
        const float inv = 1.f / lt;
        if (MODE == 0) {
            bf16_t* CC = (bf16_t*)(p.ws + OFF_CC);
#pragma unroll
            for (int db = 0; db < 2; ++db)
#pragma unroll
                for (int i = 0; i < 16; ++i) {
                    const int d = db * 32 + (i & 3) + 8 * (i >> 2) + 4 * h2;
                    CC[tq[qt] * 1024 + head * 64 + d] = f2bf(oacc[qt][db][i] * inv);
                }
        } else {
            bf16_t* OD = (bf16_t*)(p.ws + OFF_OD) + (size_t)grp * T_ * 512;
#pragma unroll
            for (int db = 0; db < 2; ++db)
#pragma unroll
                for (int i = 0; i < 16; i += 4) {
                    const int d = db * 32 + 8 * (i >> 2) + 4 * h2;
                    { u32x2 w; w.x = pk2(oacc[qt][db][i] * inv, oacc[qt][db][i + 1] * inv); w.y = pk2(oacc[qt][db][i + 2] * inv, oacc[qt][db][i + 3] * inv); *(u32x2*)(OD + tq[qt] * 512 + head * 64 + d) = w; }
                }
            if (h2 == 0) ((float*)(p.ws + OFF_LSE))[((size_t)grp * T_ + tq[qt]) * 8 + head] = mrun[qt] + log2f(lt);
        }
    }
}

__device__ __forceinline__ void dil_combine_phase(PRef p, int bid, int nb) {
    const bf16_t* OD = (const bf16_t*)(p.ws + OFF_OD); const float* LSE = (const float*)(p.ws + OFF_LSE);
    bf16_t* CC = (bf16_t*)(p.ws + OFF_CC);
    const long n = (long)T_ * 128;
    for (long c = (long)bid * NTHR + otid(); c < n; c += (long)nb * NTHR) {
        const long t = c >> 7; const int ch = (int)(c & 127) * 4, hd = ch >> 6;
        const float l0 = LSE[((size_t)0 * T_ + t) * 8 + hd], l1 = LSE[((size_t)1 * T_ + t) * 8 + hd], l2 = LSE[((size_t)2 * T_ + t) * 8 + hd];
        const float mx = fmaxf(l0, fmaxf(l1, l2));
        const float w0 = __builtin_amdgcn_exp2f(l0 - mx), w1 = __builtin_amdgcn_exp2f(l1 - mx), w2 = __builtin_amdgcn_exp2f(l2 - mx);
        const float inv = __builtin_amdgcn_rcpf(w0 + w1 + w2);
        const u32x2 a = *(const u32x2*)(OD + ((size_t)0 * T_ + t) * 512 + ch), bq = *(const u32x2*)(OD + ((size_t)1 * T_ + t) * 512 + ch), cq = *(const u32x2*)(OD + ((size_t)2 * T_ + t) * 512 + ch);
        float o[4];
#define BFLO(x) __uint_as_float((x) << 16)
#define BFHI(x) __uint_as_float((x) & 0xffff0000u)
        o[0] = (BFLO(a.x) * w0 + BFLO(bq.x) * w1 + BFLO(cq.x) * w2) * inv; o[1] = (BFHI(a.x) * w0 + BFHI(bq.x) * w1 + BFHI(cq.x) * w2) * inv;
        o[2] = (BFLO(a.y) * w0 + BFLO(bq.y) * w1 + BFLO(cq.y) * w2) * inv; o[3] = (BFHI(a.y) * w0 + BFHI(bq.y) * w1 + BFHI(cq.y) * w2) * inv;
#undef BFLO
#undef BFHI
        u32x2 w; w.x = pk2(o[0], o[1]); w.y = pk2(o[2], o[3]);
        *(u32x2*)(CC + (size_t)t * 1024 + 512 + ch) = w;
    }
}

constexpr int DA_ROW = 144;
constexpr int DA_TILE = 64 * DA_ROW;
__device__ __forceinline__ void dsa_attn_item(PRef p, int b, int head, int qb, char* smem) {
    const bf16_t* PO = (const bf16_t*)(p.ws + OFF_PO);
    const bf16_t* VT = (const bf16_t*)(p.ws + OFF_VTC) + ((size_t)(b * 8 + head)) * 64 * L_;
    const int tid = otid(), lane = tid & 63, wave = tid >> 6, r = lane & 31, h2 = lane >> 5;
    const int pr = (r & 0x13) | ((r & 4) << 1) | ((r & 8) >> 1);
    const float SC = 0.125f * 1.4426950408889634f;
    const int i0 = qb * 256 + wave * 32, qi = i0 + r;
    const unsigned long long* BMT = (const unsigned long long*)(p.ws + OFF_BM) + (size_t)b * 256 * L_ + qi;
    const size_t tq = (size_t)b * L_ + qi;
    bf16x8 qf[4];
#pragma unroll
    for (int s = 0; s < 4; ++s) qf[s] = *(const bf16x8*)(PO + tq * OD_P + head * 64 + s * 16 + h2 * 8);
    f32x16 oacc[2];
#pragma unroll
    for (int c = 0; c < 2; ++c)
#pragma unroll
        for (int i = 0; i < 16; ++i) oacc[c][i] = 0.f;
    float mrun = -64.f, lrun = 0.f;
    const int nkt = qb * 4 + 4, my_last = (i0 + 31) >> 6;
    const int srow = tid >> 3, sch = tid & 7;
    const bf16_t* ksrc = PO + ((size_t)b * L_ + srow) * OD_P + 512 + head * 64 + sch * 8;
    const bf16_t* vsrc = VT + (size_t)srow * L_ + sch * 8;
    u32x4 rk = *(const u32x4*)ksrc, rv = *(const u32x4*)vsrc;
    __syncthreads();
    *(u32x4*)(smem + srow * DA_ROW + sch * 16) = rk;
    *(u32x4*)(smem + DA_TILE + srow * DA_ROW + sch * 16) = rv;
    __syncthreads();
    unsigned long long mwn = BMT[0];
#pragma unroll 1
    for (int kt = 0; kt < nkt; ++kt) {
        const bool more = kt + 1 < nkt;
        if (more) { rk = *(const u32x4*)(ksrc + (size_t)(kt + 1) * 64 * OD_P); rv = *(const u32x4*)(vsrc + (kt + 1) * 64); }
        const unsigned long long mw64 = mwn;
        if (kt < my_last) mwn = BMT[(size_t)(kt + 1) * L_];
        if (kt <= my_last) {
            const char* kb = smem + (kt & 1) * 2 * DA_TILE; const char* vb = kb + DA_TILE;
            f32x16 sa[2];
#pragma unroll
            for (int sub = 0; sub < 2; ++sub) {
                bf16x8 kf[4];
#pragma unroll
                for (int s = 0; s < 4; ++s) kf[s] = *(const bf16x8*)(kb + (sub * 32 + pr) * DA_ROW + (s * 16 + h2 * 8) * 2);
#pragma unroll
                for (int i = 0; i < 16; ++i) sa[sub][i] = 0.f;
#pragma unroll
                for (int ks = 0; ks < 4; ++ks) sa[sub] = __builtin_amdgcn_mfma_f32_32x32x16_bf16(kf[ks], qf[ks], sa[sub], 0, 0, 0);
            }
#pragma unroll
            for (int sub = 0; sub < 2; ++sub) {
                const unsigned mw = sub == 0 ? (unsigned)mw64 : (unsigned)(mw64 >> 32);
                f32x16& s = sa[sub];
                bf16x8 vf[2][2];
#pragma unroll
                for (int db = 0; db < 2; ++db)
#pragma unroll
                    for (int s2 = 0; s2 < 2; ++s2) vf[db][s2] = *(const bf16x8*)(vb + (db * 32 + r) * DA_ROW + (sub * 32 + s2 * 16 + h2 * 8) * 2);
#pragma unroll
                for (int i = 0; i < 16; ++i) s[i] = __builtin_fmaf(s[i], SC, -mrun);
                float mx = fmaxf(fmaxf(s[0], s[1]), fmaxf(s[2], s[3]));
#pragma unroll
                for (int i = 4; i < 16; i += 2) mx = fmaxf(mx, fmaxf(s[i], s[i + 1]));
                mx = xor32_max(mx);
                if (__builtin_amdgcn_ballot_w64(mx > 0.f) != 0ull) {
                    const float dlt = fmaxf(mx, 0.f);
                    const float corr = __builtin_amdgcn_exp2f(-dlt);
                    mrun += dlt; lrun *= corr;
#pragma unroll
                    for (int db = 0; db < 2; ++db)
#pragma unroll
                        for (int i = 0; i < 16; ++i) oacc[db][i] *= corr;
#pragma unroll
                    for (int i = 0; i < 16; ++i) s[i] -= dlt;
                }
                float ps = 0.f;
                const int mws = (int)(mw >> (8 * h2));
#define DA_P(i, KO) { const float e = __builtin_amdgcn_exp2f(s[i]); s[i] = __uint_as_float(__float_as_uint(e) & bitmask32<KO>(mws)); ps += s[i]; }
                DA_P(0, 0) DA_P(1, 1) DA_P(2, 2) DA_P(3, 3) DA_P(4, 4) DA_P(5, 5) DA_P(6, 6) DA_P(7, 7)
                DA_P(8, 16) DA_P(9, 17) DA_P(10, 18) DA_P(11, 19) DA_P(12, 20) DA_P(13, 21) DA_P(14, 22) DA_P(15, 23)
#undef DA_P
                lrun += ps;
#pragma unroll
                for (int s2 = 0; s2 < 2; ++s2) {
                    u32x4 pw; pw.x = pk2(s[8 * s2], s[8 * s2 + 1]); pw.y = pk2(s[8 * s2 + 2], s[8 * s2 + 3]); pw.z = pk2(s[8 * s2 + 4], s[8 * s2 + 5]); pw.w = pk2(s[8 * s2 + 6], s[8 * s2 + 7]);
                    const bf16x8 pf = __builtin_bit_cast(bf16x8, pw);
#pragma unroll
                    for (int db = 0; db < 2; ++db) oacc[db] = __builtin_amdgcn_mfma_f32_32x32x16_bf16(vf[db][s2], pf, oacc[db], 0, 0, 0);
                }
            }
        }
        if (more) {
            char* nbuf = smem + ((kt + 1) & 1) * 2 * DA_TILE;
            *(u32x4*)(nbuf + srow * DA_ROW + sch * 16) = rk;
            *(u32x4*)(nbuf + DA_TILE + srow * DA_ROW + sch * 16) = rv;
        }
        __syncthreads();
    }
    const float lt = xor32_sum(lrun);
    const float inv = 1.f / lt;
    bf16_t* CC = (bf16_t*)(p.ws + OFF_CC);
#pragma unroll
    for (int db = 0; db < 2; ++db)
#pragma unroll
        for (int i = 0; i < 16; i += 4) {
            const int d = db * 32 + 8 * (i >> 2) + 4 * h2;
            u32x2 w; w.x = pk2(oacc[db][i] * inv, oacc[db][i + 1] * inv); w.y = pk2(oacc[db][i + 2] * inv, oacc[db][i + 3] * inv);
            *(u32x2*)(CC + tq * 1024 + head * 64 + d) = w;
        }
}


template <bool ODD>
__device__ __forceinline__ void inproj_phase(PRef p, int j, char* smem, int bid, int nb) {
    char* ws = p.ws;
    constexpr int NTN = ODD ? OD_P / 256 : EV_P / 256, NMAIN = 128 * NTN, NVT = ODD ? 1024 : 256;
    const bf16_t* XB = (const bf16_t*)(ws + OFF_XB);
    const bf16_t* W = ODD ? (const bf16_t*)(ws + OFF_WT_ODIN) + (size_t)j * OD_N * 1024 : (const bf16_t*)(ws + OFF_WT_EVIN) + (size_t)j * EV_N * 1024;
    XcdSeq s(NMAIN + NVT, bid, nb);
    gemm256_stream<false, 0>(
        [&](int i, G8Desc& d) -> bool {
            const int Q = s.q + i * s.step; if (Q >= s.qend) return false;
            d.list = nullptr; d.count = 0;
            if (Q < NMAIN) {
                const int pnl = Q / (4 * NTN), r = Q - pnl * 4 * NTN;
                d.A = XB; d.Bt = W; d.m0 = (pnl * 4 + (r & 3)) * 256; d.n0 = (r >> 2) * 256; d.u0 = -1; d.ldb = 1024;
            } else {
                const int v = Q - NMAIN; d.m0 = 0; d.n0 = 0; d.u0 = v;
                if (ODD) {
                    const int combo = v & 7, src = combo >> 1, mt = combo & 1, bn = v >> 3, b = bn >> 6, lam0 = (bn & 63) * 256;
                    const int sh = src < 2 ? 0 : (src == 2 ? 2 : 4), rho = lam0 >> (14 - sh), i0 = lam0 & ((L_ >> sh) - 1);
                    d.A = W + (size_t)(OD_P + src * 512 + mt * 256) * 1024;
                    d.Bt = XB + ((size_t)b * L_ + ((size_t)i0 << sh) + rho) * 1024; d.ldb = 1024 << sh;
                } else {
                    const int mt = v & 1, bn = v >> 1;
                    d.A = W + (size_t)(EV_P + mt * 256) * 1024;
                    d.Bt = XB + (size_t)bn * 256 * 1024; d.ldb = 1024;
                }
            }
            return true; },
        1024, 1024, smem,
        [&](int m0, int u0, f32x4 (&acc)[4][2], int rt0, int c0, int fr, int fq, const int*) {
            if (u0 < 0) { if (ODD) epi_od_in(p, acc, m0 + rt0, c0, fr, fq); else epi_ev_in(p, acc, m0 + rt0, c0, fr, fq); }
            else if (ODD) {
                const int combo = u0 & 7, src = combo >> 1, mt = combo & 1, bn = u0 >> 3, b = bn >> 6, lam0 = (bn & 63) * 256;
                bf16_t* img = src == 0 ? (bf16_t*)(ws + OFF_VTC) + ((size_t)(b * 8) * 64 + mt * 256) * L_ + lam0
                                       : (bf16_t*)(ws + OFF_VTD) + ((size_t)((b * 3 + src - 1) * 8) * 64 + mt * 256) * L_ + lam0;
                epi_vt(img, acc, rt0, c0, fr, fq);
            } else {
                const int mt = u0 & 1, bn = u0 >> 1, b = bn >> 6, lam0 = (bn & 63) * 256;
                epi_vt((bf16_t*)(ws + OFF_VTE) + ((size_t)(b * 4) * 128 + mt * 256) * L_ + lam0, acc, rt0, c0, fr, fq);
            }
        });
}

enum { K_PRO = 0, K_E1, K_E2, K_E3, K_E4, K_E5, K_E6, K_LN1, K_O1, K_O2, K_O3, K_O4, K_M1, K_M2, K_M3, K_M4, K_LN2, K_COUNT };

template <int KIND, bool NOEPI = false>
__device__ __forceinline__ void run_phase(PRef p, int layer, char* smem, int bid, int nb) {
    char* ws = p.ws;
    const int j = layer >> 1;
    if (KIND == K_PRO) {
        conv_phase(p, smem, bid, nb);
        __syncthreads();
        for (int u = bid; u < 256; u += nb) s5mat_unit(p, u, smem);
    } else if (KIND == K_E1) {
        inproj_phase<false>(p, j, smem, bid, nb);
    } else if (KIND == K_E2) {
        for (int it = bid; it < 2048; it += nb) gla_a_item(p, j, it, smem);
        s5_g_phase(p, j, smem, bid, nb);
    } else if (KIND == K_E3) {
        scan_phase(p, j, bid);
    } else if (KIND == K_E4) {
        for (int it = bid; it < 2048; it += nb) gla_c_item(p, j, it, smem);
        s5_y_phase(p, j, smem, bid, nb);
    } else if (KIND == K_E5) {
        const bf16_t* YA = (const bf16_t*)(ws + OFF_YA); bf16_t* CC = (bf16_t*)(ws + OFF_CC); const float* bg = p.s5_b_glu + (size_t)j * 512;
        gemm256_phase(YA, 512, T_, (const bf16_t*)(ws + OFF_WT_GLU) + (size_t)j * 512 * 512, 512, 512, 512, smem, bid, nb,
                   [&](f32x4 (&acc)[4][2], int row0, int c0, int fr, int fq) {
                       const int col = c0 + 8 * fq;
                       const f32x4 g0 = *(const f32x4*)(bg + col), g1 = *(const f32x4*)(bg + col + 4);
#pragma unroll
                       for (int m = 0; m < 4; ++m) {
                           const size_t t = (size_t)(row0 + m * 16 + fr);
                           const u32x4 yw = *(const u32x4*)(YA + t * 512 + col);
                           float o[8];
#pragma unroll
                           for (int q = 0; q < 4; ++q) {
                               const unsigned y2 = q == 0 ? yw.x : q == 1 ? yw.y : q == 2 ? yw.z : yw.w;
                               const float y0 = __uint_as_float(y2 << 16), y1 = __uint_as_float(y2 & 0xffff0000u);
                               const float a0 = q < 2 ? acc[m][0][2 * q] + g0[2 * q] : acc[m][1][2 * q - 4] + g1[2 * q - 4];
                               const float a1 = q < 2 ? acc[m][0][2 * q + 1] + g0[2 * q + 1] : acc[m][1][2 * q - 3] + g1[2 * q - 3];
                               o[2 * q] = y0 * sigmoidf_(a0); o[2 * q + 1] = y1 * sigmoidf_(a1);
                           }
                           u32x4 w; w.x = pk2(o[0], o[1]); w.y = pk2(o[2], o[3]); w.z = pk2(o[4], o[5]); w.w = pk2(o[6], o[7]);
                           *(u32x4*)(CC + t * 1024 + 512 + col) = w;
                       }
                   });
    } else if (KIND == K_E6 || KIND == K_O4) {
        bf16_t* MIX = (bf16_t*)(ws + OFF_MIX);
        const bf16_t* W = (const bf16_t*)(ws + (KIND == K_E6 ? OFF_WT_EVOUT : OFF_WT_ODOUT)) + (size_t)j * 1024 * 1024;
        gemm256_phase((const bf16_t*)(ws + OFF_CC), 1024, T_, W, 1024, 1024, 1024, smem, bid, nb,
                   [&](f32x4 (&acc)[4][2], int row0, int c0, int fr, int fq) {
#pragma unroll
                       for (int m = 0; m < 4; ++m) {
                           u32x4 w; w.x = pk2(acc[m][0][0], acc[m][0][1]); w.y = pk2(acc[m][0][2], acc[m][0][3]); w.z = pk2(acc[m][1][0], acc[m][1][1]); w.w = pk2(acc[m][1][2], acc[m][1][3]);
                           *(u32x4*)(MIX + (size_t)(row0 + m * 16 + fr) * 1024 + c0 + 8 * fq) = w;
                       }
                   });
    } else if (KIND == K_LN1) {
        ln1_router_phase<NOEPI>(p, layer, smem, bid, nb);
    } else if (KIND == K_O1) {
        inproj_phase<true>(p, j, smem, bid, nb);
    } else if (KIND == K_O2) {
        if (!NOEPI) for (int k = bid; k < 256; k += nb) {
            dsa_select_item(p, k & 1, k >> 1, smem);
            __syncthreads();
            const int k2 = 511 - k;
            dsa_select_item(p, k2 & 1, k2 >> 1, smem);
            __syncthreads();
        }
        const int head = otid() >> 6;
        for (int it = bid; it < 1536; it += nb) {
            const int b = it / 768, rem = it - b * 768, g = rem >> 8, u = rem & 255;
            const int sh = g * 2, per = 256 >> sh, rho = u / per, qblk = u - rho * per;
            const bf16_t* VT = (const bf16_t*)(ws + OFF_VTD) + ((size_t)((b * 3 + g) * 8 + head)) * 64 * L_;
#pragma unroll 1
            for (int hf = 0; hf < 2; ++hf) {
                const int hi = 2 * qblk + hf, lo = hi - 4;
                attn_wave<1, 1>(p, b, head, OD_DIL + g * 512, OD_DIL + 1536 + g * 512, VT, rho * (L_ >> sh), qblk * 64 + hf * 32, sh, rho, lo < 0 ? 0 : lo, hi, g);
            }
        }
    } else if (KIND == K_O3) {
        for (int k = bid; k < 512; k += nb) {
            const int bh = k >> 5, q0 = k & 31;
#pragma unroll 1
            for (int half = 0; half < 2; ++half) dsa_attn_item(p, bh >> 3, bh & 7, half == 0 ? q0 : 63 - q0, smem);
        }
        dil_combine_phase(p, bid, nb);
    } else if (KIND == K_M1) {
        float* LG = (float*)(ws + OFF_LOGIT); const float* rb = p.router_b + (size_t)layer * 32;
        gemm_phase((const bf16_t*)(ws + OFF_XB), 1024, T_, (const bf16_t*)(ws + OFF_WT_RT) + (size_t)layer * 128 * 1024, 1024, 128, 1024, smem, bid, nb,
                   [&](f32x4 (&acc)[4][2], int row0, int c0, int fr, int fq) {
#pragma unroll
                       for (int n = 0; n < 2; ++n) {
                           const int col = c0 + n * 16 + fr;
                           if (col < 32) {
#pragma unroll
                               for (int m = 0; m < 4; ++m)
#pragma unroll
                                   for (int r = 0; r < 4; ++r) LG[(size_t)(row0 + m * 16 + fq * 4 + r) * 32 + col] = acc[m][n][r] + rb[col];
                           }
                       }
                   });
    } else if (KIND == K_M2) {
        topk_phase(p, layer, bid, nb);
    } else if (KIND == K_M3) {
        moe_gemm_phase<1, NOEPI>(p, layer, smem, bid, nb);
    } else if (KIND == K_M4) {
        moe_gemm_phase<2, NOEPI>(p, layer, smem, bid, nb);
    } else if (KIND == K_LN2) {
        float* xo = layer == 3 ? p.out : (float*)nullptr;
        ln_phase<true, NOEPI>(p, (const bf16_t*)(ws + OFF_XB), (const float*)(ws + OFF_SLOT), p.ln2_g + (size_t)layer * 1024, p.ln2_b + (size_t)layer * 1024, xo,
                       layer == 3 ? (bf16_t*)nullptr : (bf16_t*)(ws + OFF_XB), bid, nb);
    }
}

extern __shared__ __attribute__((aligned(16))) char dyn_smem[];

#if !MEGA
template <int KIND>
__global__ void __launch_bounds__(NTHR, 2) k_phase(Params p, int layer) { run_phase<KIND>(p, layer, dyn_smem, blockIdx.x, gridDim.x); }
#else
#ifndef DUPMASK
#define DUPMASK 0
#endif
typedef const __attribute__((address_space(4))) Params* KParams;
#define RUNP(K) do { KParams _q = kp0; asm volatile("" : "+s"(_q)); run_phase<K>(*_q, layer, smem, bid, nb); } while (0)
#ifndef DUPNOEPI
#define DUPNOEPI 0
#endif
#define RUNP2(K) do { KParams _q = kp0; asm volatile("" : "+s"(_q)); run_phase<K, (DUPNOEPI != 0)>(*_q, layer, smem, bid, nb); } while (0)
#define PHASE(K) do { RUNP(K); xcd_barrier(bar); if ((DUPMASK >> 30) & 1) xcd_barrier(bar); if ((DUPMASK >> K) & 1) { RUNP2(K); xcd_barrier(bar); } } while (0)
template <int LAYER>
__device__ __forceinline__ void mega_layer(KParams kp0, char* smem, int bid, int nb, const XcdBarrier& bar) {
    constexpr int layer = LAYER;
    if ((layer & 1) == 0) { PHASE(K_E1); PHASE(K_E2); PHASE(K_E3); PHASE(K_E4); PHASE(K_E5); PHASE(K_E6); }
    else { PHASE(K_O1); PHASE(K_O2); PHASE(K_O3); PHASE(K_O4); }
    PHASE(K_LN1); PHASE(K_M3); PHASE(K_M4);
    RUNP(K_LN2);
    if ((DUPMASK >> K_LN2) & 1) { xcd_barrier(bar); RUNP2(K_LN2); }
    if (layer < 3) xcd_barrier(bar);
}
__global__ void __launch_bounds__(NTHR, 2) k_mega(Params p) {
    char* smem = dyn_smem;
    const int bid = blockIdx.x, nb = gridDim.x;
    volatile LAS unsigned* st = (volatile LAS unsigned*)(dyn_smem + LDS_BYTES - 16);
    if (otid() == 0) { st[0] = 0u; st[1] = 0u; }
    __syncthreads();
    KParams kp0 = (KParams)__builtin_amdgcn_kernarg_segment_ptr();
    XcdBarrier bar = xcd_barrier_post((unsigned*)(kp0->ws + OFF_BAR), st);
    { const int layer = 0; PHASE(K_PRO); }
    mega_layer<0>(kp0, smem, bid, nb, bar);
    mega_layer<1>(kp0, smem, bid, nb, bar);
    mega_layer<2>(kp0, smem, bid, nb, bar);
    mega_layer<3>(kp0, smem, bid, nb, bar);
}
#endif

extern "C" void kernel_launch(void* const* d_in, const int* in_sizes, int n_in, void* d_out, int out_size, void* d_ws, size_t ws_size, hipStream_t stream) {
    Params p{};
    const float** f = (const float**)&p;
    for (int i = 0; i < 28; ++i) f[i] = (const float*)d_in[i];
    p.out = (float*)d_out; p.ws = (char*)d_ws;
    if (ws_size < WS_NEED) { fprintf(stderr, "workspace too small: %zu < %zu\n", ws_size, (size_t)WS_NEED); return; }
#if !MEGA
#define SETATTR(K) hipFuncSetAttribute((const void*)k_phase<K>, hipFuncAttributeMaxDynamicSharedMemorySize, LDS_BYTES)
#define LAUNCH(K, layer) k_phase<K><<<256, NTHR, LDS_BYTES, stream>>>(p, layer)
    static bool attr_done = false;
    if (!attr_done) {
        SETATTR(K_PRO); SETATTR(K_E1); SETATTR(K_E2); SETATTR(K_E3); SETATTR(K_E4); SETATTR(K_E5); SETATTR(K_E6); SETATTR(K_LN1); SETATTR(K_O1); SETATTR(K_O2); SETATTR(K_O3);
        SETATTR(K_O4); SETATTR(K_M1); SETATTR(K_M2); SETATTR(K_M3); SETATTR(K_M4); SETATTR(K_LN2);
        attr_done = true;
    }
    LAUNCH(K_PRO, 0);
    for (int layer = 0; layer < 4; ++layer) {
        if ((layer & 1) == 0) { LAUNCH(K_E1, layer); LAUNCH(K_E2, layer); LAUNCH(K_E3, layer); LAUNCH(K_E4, layer); LAUNCH(K_E5, layer); LAUNCH(K_E6, layer); }
        else { LAUNCH(K_O1, layer); LAUNCH(K_O2, layer); LAUNCH(K_O3, layer); LAUNCH(K_O4, layer); }
        LAUNCH(K_LN1, layer); LAUNCH(K_M3, layer); LAUNCH(K_M4, layer); LAUNCH(K_LN2, layer);
    }
#else
    static int grid = 0;
    if (!grid) {
        hipFuncSetAttribute((const void*)k_mega, hipFuncAttributeMaxDynamicSharedMemorySize, LDS_BYTES);
        int dev = 0, cus = 0, per_cu = 0;
        hipGetDevice(&dev);
        hipDeviceGetAttribute(&cus, hipDeviceAttributeMultiprocessorCount, dev);
        hipOccupancyMaxActiveBlocksPerMultiprocessor(&per_cu, (const void*)k_mega, NTHR, LDS_BYTES);
        grid = cus * (per_cu < 1 ? per_cu : 1);
        if (grid <= 0) grid = 0;
    }
    if (!grid) { fprintf(stderr, "occupancy query says 0 blocks per CU\n"); return; }
    hipMemsetAsync((char*)d_ws + OFF_BAR, 0, XCD_BAR_WORDS * sizeof(unsigned), stream);
    k_mega<<<grid, NTHR, LDS_BYTES, stream>>>(p);
#endif
}
```

```cpp
#include <hip/hip_runtime.h>
#include <stdint.h>
#include <stdio.h>

#ifndef MEGA
#define MEGA 1
#define DUPMASK 0
#define DUPNOEPI 0
#endif

typedef unsigned short bf16_t;
typedef short bf16x8 __attribute__((ext_vector_type(8)));
typedef float f32x2 __attribute__((ext_vector_type(2)));
typedef float f32x4 __attribute__((ext_vector_type(4)));
typedef float f32x16 __attribute__((ext_vector_type(16)));
typedef unsigned u32x4 __attribute__((ext_vector_type(4)));
typedef unsigned u32x2 __attribute__((ext_vector_type(2)));

constexpr int T_ = 32768, D_ = 1024, L_ = 16384, NB_ = 2;
constexpr int NTHR = 512;
constexpr float ALPHA = 1.681792830507429f;
constexpr float LN_EPS = 1e-5f;
constexpr int EV_N = 2304;
constexpr int EV_P = 1792;
constexpr int PE_W = 1024;
constexpr int OD_N = 6656;
constexpr int OD_P = 4608;
constexpr int OD_QI = 1024, OD_DIL = 1280, OD_KI = 4352, OD_WI = 4416;
constexpr int UHW = 1152;
constexpr int LISTCAP = 131072;

constexpr size_t OFF_BAR = 0;
constexpr size_t OFF_CNT = 16384;
constexpr size_t OFF_A64 = 32768;
constexpr size_t OFF_WT_EVIN = 131072;
constexpr size_t OFF_WT_ODIN = OFF_WT_EVIN + (size_t)2 * EV_N * 1024 * 2;
constexpr size_t OFF_WT_EVOUT = OFF_WT_ODIN + (size_t)2 * OD_N * 1024 * 2;
constexpr size_t OFF_WT_ODOUT = OFF_WT_EVOUT + (size_t)2 * 1024 * 1024 * 2;
constexpr size_t OFF_WT_GLU = OFF_WT_ODOUT + (size_t)2 * 1024 * 1024 * 2;
constexpr size_t OFF_WT_RT = OFF_WT_GLU + (size_t)2 * 512 * 512 * 2;
constexpr size_t OFF_WT_W1 = OFF_WT_RT + (size_t)4 * 128 * 1024 * 2;
constexpr size_t OFF_WT_W2 = OFF_WT_W1 + (size_t)4 * 32 * 2048 * 1024 * 2;
constexpr size_t OFF_TH = OFF_WT_W2 + (size_t)4 * 32 * 1024 * 1024 * 2;
constexpr size_t OFF_GM = OFF_TH + (size_t)2 * 32 * 1024 * UHW * 2;
constexpr size_t OFF_XR = OFF_GM + (size_t)2 * 32 * 128 * 1024 * 2;
constexpr size_t OFF_XB = OFF_XR + (size_t)T_ * 1024 * 4;
constexpr size_t OFF_MIX = OFF_XB + (size_t)T_ * 1024 * 2;
constexpr size_t OFF_CC = OFF_MIX + (size_t)T_ * 1024 * 4;
constexpr size_t OFF_LOGIT = OFF_CC + (size_t)T_ * 1024 * 2;
constexpr size_t OFF_LIST = OFF_LOGIT + (size_t)T_ * 32 * 4;
constexpr size_t OFF_GATE = OFF_LIST + (size_t)32 * LISTCAP * 4;
constexpr size_t OFF_ACT = OFF_GATE + (size_t)T_ * 4 * 4;
constexpr size_t OFF_SLOT = OFF_ACT + (size_t)T_ * 4 * 1024 * 2;
constexpr size_t OFF_MIXER = OFF_SLOT + (size_t)T_ * 4 * 1024 * 4;
constexpr size_t OFF_PE = OFF_MIXER;
constexpr size_t OFF_UH = OFF_PE + (size_t)T_ * 1536 * 2;
constexpr size_t OFF_GLR = OFF_UH + (size_t)(T_ / 64) * 32 * UHW * 2;
constexpr size_t OFF_VTE = OFF_GLR + (size_t)T_ * 16 * 4;
constexpr size_t OFF_KV = OFF_VTE + (size_t)2 * 4 * 128 * L_ * 2;
constexpr size_t OFF_SST = OFF_KV + (size_t)2 * 256 * 4 * 64 * 128 * 4;
constexpr size_t OFF_DEC = OFF_SST + (size_t)2 * 256 * 4 * 64 * 128 * 4;
constexpr size_t OFF_GBUF = OFF_DEC + (size_t)2 * 256 * 4 * 64 * 4;
constexpr size_t OFF_YA = OFF_GBUF + (size_t)512 * 32 * 128 * 4;
constexpr size_t END_EVEN = OFF_YA + (size_t)T_ * 512 * 2;
constexpr size_t OFF_PO = OFF_MIXER;
constexpr size_t OFF_WI = OFF_PO + (size_t)T_ * OD_N * 2;
constexpr size_t OFF_VTC = OFF_WI + (size_t)T_ * 4 * 4;
constexpr size_t OFF_VTD = OFF_VTC + (size_t)2 * 8 * 64 * L_ * 2;
constexpr size_t OFF_BM = OFF_VTD + (size_t)2 * 3 * 8 * 64 * L_ * 2;
constexpr size_t OFF_OD = OFF_BM + (size_t)T_ * 256 * 8;
constexpr size_t OFF_LSE = OFF_OD + (size_t)3 * T_ * 512 * 4;
constexpr size_t END_ODD = OFF_LSE + (size_t)3 * T_ * 8 * 4;
constexpr size_t WS_NEED = END_ODD > END_EVEN ? END_ODD : END_EVEN;
static_assert(WS_NEED < (size_t)4200000000ull, "workspace too large");

constexpr int LDS_BYTES = 153600;

struct Params {
    const float *x, *ev_w_in, *gla_w_gate2, *gla_b_gate2, *gla_norm_g, *s5_a_re, *s5_a_im, *s5_log_dt, *s5_b_re, *s5_b_im, *s5_c_re, *s5_c_im, *s5_d,
        *s5_w_glu, *s5_b_glu, *ev_w_out, *od_w_in, *od_w_out, *ln1_g, *ln1_b, *ln2_g, *ln2_b, *router_w, *router_b, *moe_w1, *moe_b1, *moe_w2, *moe_b2;
    float* out;
    char* ws;
};

#if MEGA
typedef const __attribute__((address_space(4))) Params& PRef;
#else
typedef const Params& PRef;
#endif

__device__ __forceinline__ unsigned pk2(float lo, float hi) { unsigned r; asm("v_cvt_pk_bf16_f32 %0, %1, %2" : "=v"(r) : "v"(lo), "v"(hi)); return r; }
__device__ __forceinline__ bf16_t f2bf(float f) { return (bf16_t)(pk2(f, 0.f) & 0xffffu); }
__device__ __forceinline__ float bf2f(bf16_t h) { return __uint_as_float(((unsigned)h) << 16); }
__device__ __forceinline__ float sigmoidf_(float x) { return __builtin_amdgcn_rcpf(1.f + __expf(-x)); }
template <int CTRL> __device__ __forceinline__ float dppf(float v) { return __int_as_float(__builtin_amdgcn_update_dpp(0, __float_as_int(v), CTRL, 0xF, 0xF, false)); }
constexpr int DPP_X1 = 0xB1  , DPP_X2 = 0x4E  , DPP_HMIR = 0x141  , DPP_MIR = 0x140  , DPP_ROR8 = 0x128;
__device__ __forceinline__ float xor16_sum(float v) { const unsigned u = __float_as_uint(v); auto r = __builtin_amdgcn_permlane16_swap(u, u, false, false); return __uint_as_float(r[0]) + __uint_as_float(r[1]); }
__device__ __forceinline__ float xor16_max(float v) { const unsigned u = __float_as_uint(v); auto r = __builtin_amdgcn_permlane16_swap(u, u, false, false); return fmaxf(__uint_as_float(r[0]), __uint_as_float(r[1])); }
__device__ __forceinline__ float xor32_sum_(float v) { const unsigned u = __float_as_uint(v); auto r = __builtin_amdgcn_permlane32_swap(u, u, false, false); return __uint_as_float(r[0]) + __uint_as_float(r[1]); }
__device__ __forceinline__ float xor32_max_(float v) { const unsigned u = __float_as_uint(v); auto r = __builtin_amdgcn_permlane32_swap(u, u, false, false); return fmaxf(__uint_as_float(r[0]), __uint_as_float(r[1])); }
__device__ __forceinline__ float wave_sum(float v) {
    v += dppf<DPP_X1>(v); v += dppf<DPP_X2>(v); v += dppf<DPP_HMIR>(v); v += dppf<DPP_MIR>(v);
    return xor32_sum_(xor16_sum(v));
}
__device__ __forceinline__ float wave_max(float v) {
    v = fmaxf(v, dppf<DPP_X1>(v)); v = fmaxf(v, dppf<DPP_X2>(v)); v = fmaxf(v, dppf<DPP_HMIR>(v)); v = fmaxf(v, dppf<DPP_MIR>(v));
    return xor32_max_(xor16_max(v));
}
__device__ __forceinline__ float gelu_tanh(float x) {
    const float k0 = 0.7978845608028654f, k1 = 0.044715f;
    float u = k0 * (x + k1 * x * x * x);
    float t = 1.f - 2.f * __builtin_amdgcn_rcpf(1.f + __expf(2.f * u));
    return 0.5f * x * (1.f + t);
}
__device__ __forceinline__ float xor32_max(float v) { const unsigned u = __float_as_uint(v); auto r = __builtin_amdgcn_permlane32_swap(u, u, false, false); return fmaxf(__uint_as_float(r[0]), __uint_as_float(r[1])); }
__device__ __forceinline__ float xor32_sum(float v) { const unsigned u = __float_as_uint(v); auto r = __builtin_amdgcn_permlane32_swap(u, u, false, false); return __uint_as_float(r[0]) + __uint_as_float(r[1]); }
__device__ __forceinline__ unsigned xor32_or(unsigned u) { auto r = __builtin_amdgcn_permlane32_swap(u, u, false, false); return r[0] | r[1]; }
template <int BIT> __device__ __forceinline__ unsigned bitmask32(int w) { unsigned m; asm("v_bfe_i32 %0, %1, %2, 1" : "=v"(m) : "v"(w), "n"(BIT)); return m; }
__device__ __forceinline__ int otid() { int t = threadIdx.x; asm volatile("" : "+v"(t)); return t; }

#define XB_TMO      128
#define XB_XCNT(j)  (256  + 64 * (j))
#define XB_XSUB(j)  (1280 + 64 * (j))
#define XB_XGEN(j)  (2304 + 64 * (j))
#define XB_TOP      3328
#define XB_TOPGEN   3392
#define XCD_BAR_WORDS 3456
#define XB_SPIN_CAP (1u << 21)
#define LAS __attribute__((address_space(3)))

__device__ __forceinline__ unsigned xb_ld(unsigned* p)              { return __hip_atomic_load(p, __ATOMIC_RELAXED, __HIP_MEMORY_SCOPE_AGENT); }
__device__ __forceinline__ unsigned xb_add(unsigned* p, unsigned v) { return __hip_atomic_fetch_add(p, v, __ATOMIC_RELAXED, __HIP_MEMORY_SCOPE_AGENT); }
__device__ __forceinline__ unsigned xb_xcc_id() { return (unsigned)__builtin_amdgcn_s_getreg((3 << 11) | 20) & 0xFu; }
#define XB_SPIN(cond, bar) do { unsigned _sp = 0; while (cond) { __builtin_amdgcn_s_sleep(1); \
    if ((++_sp & 255u) == 0u) { if (xb_ld(&(bar)[XB_TMO])) break; if (_sp > XB_SPIN_CAP) { atomicAdd(&(bar)[XB_TMO], 1u); break; } } } } while (0)

struct XcdBarrier { unsigned* bar; unsigned x; volatile LAS unsigned* st; };

__device__ __forceinline__ XcdBarrier xcd_barrier_post(unsigned* bar, volatile LAS unsigned* st) {
    XcdBarrier b; b.bar = bar; b.x = xb_xcc_id(); b.st = st;
    if (threadIdx.x == 0) (void)xb_add(&bar[XB_XCNT(b.x)], 1u);
    return b;
}
__device__ __forceinline__ void xcd_barrier_complete(unsigned* bar, unsigned x, unsigned& nloc, unsigned& nx) {
    const unsigned G = gridDim.x * gridDim.y * gridDim.z;
    unsigned sum, cnt, mine, sp = 0u;
    for (;;) {
        sum = 0u; cnt = 0u; mine = 0u;
#pragma unroll
        for (unsigned j = 0; j < 16; ++j) { const unsigned c = xb_ld(&bar[XB_XCNT(j)]); sum += c; cnt += (c > 0u) ? 1u : 0u; mine = (j == x) ? c : mine; }
        if (sum == G) break;
        __builtin_amdgcn_s_sleep(1);
        if ((++sp & 255u) == 0u) { if (xb_ld(&bar[XB_TMO])) break; if (sp > XB_SPIN_CAP) { atomicAdd(&bar[XB_TMO], 1u); break; } }
    }
    nloc = mine > 0u ? mine : 1u; nx = cnt > 0u ? cnt : 1u;
}
__device__ __forceinline__ void xcd_barrier(const XcdBarrier& b) {
    asm volatile("s_waitcnt vmcnt(0)" ::: "memory");
    __syncthreads();
    if (threadIdx.x == 0) {
        unsigned* bar = b.bar;
        __builtin_amdgcn_s_waitcnt(0);
        unsigned nloc = b.st[0], nx = b.st[1];
        if (nloc == 0u) { xcd_barrier_complete(bar, b.x, nloc, nx); b.st[0] = nloc; b.st[1] = nx; }
        const unsigned old = xb_add(&bar[XB_XSUB(b.x)], 1u);
        const unsigned gen = old / nloc;
        if (old + 1u == (gen + 1u) * nloc) {
            __builtin_amdgcn_fence(__ATOMIC_RELEASE, "agent");
            asm volatile("s_waitcnt vmcnt(0)" ::: "memory");
            const unsigned og = xb_add(&bar[XB_TOP], 1u);
            const unsigned tg = og / nx;
            if (og + 1u == (tg + 1u) * nx) xb_add(&bar[XB_TOPGEN], 1u);
            else XB_SPIN(xb_ld(&bar[XB_TOPGEN]) == tg, bar);
            __builtin_amdgcn_fence(__ATOMIC_ACQUIRE, "agent");
            xb_add(&bar[XB_XGEN(b.x)], 1u);
            asm volatile("s_waitcnt vmcnt(0)" ::: "memory");
        } else {
            XB_SPIN(xb_ld(&bar[XB_XGEN(b.x)]) == gen, bar);
            __builtin_amdgcn_fence(__ATOMIC_ACQUIRE, "agent");
            asm volatile("s_waitcnt vmcnt(0)" ::: "memory");
        }
    }
    __syncthreads();
}

constexpr int G_LROW = 144;
constexpr int G_ASZ = 256 * G_LROW;
constexpr int G_BSZ = 128 * G_LROW;
constexpr int G_STAGE = G_ASZ + G_BSZ;
constexpr int G_ROWS_OFF = 2 * G_STAGE;

template <bool GATHER, class Epi>
__device__ __forceinline__ void gemm_tile(const bf16_t* __restrict__ A, long lda, int shift, int m0, const bf16_t* __restrict__ Bt, long ldb, int n0, int K,
                                          char* smem, Epi&& epi) {
    const int tid = otid(), lane = tid & 63, wave = tid >> 6, wr = wave >> 1, wc = wave & 1, fr = lane & 15, fq = lane >> 4;
    const int lrow = tid >> 3, lchunk = tid & 7;
    const int* sRow = (const int*)(smem + G_ROWS_OFF);
    const bf16_t* pa[4]; const bf16_t* pb[2];
#pragma unroll
    for (int i = 0; i < 4; ++i) {
        int r = lrow + 64 * i; long arow;
        if (GATHER) { int v = sRow[r]; arow = v < 0 ? 0 : (v >> shift); } else arow = m0 + r;
        pa[i] = A + arow * lda + lchunk * 8;
    }
#pragma unroll
    for (int i = 0; i < 2; ++i) pb[i] = Bt + (long)(n0 + lrow + 64 * i) * ldb + lchunk * 8;
    f32x4 acc[4][4];
#pragma unroll
    for (int m = 0; m < 4; ++m)
#pragma unroll
        for (int n = 0; n < 4; ++n) acc[m][n] = (f32x4){0.f, 0.f, 0.f, 0.f};
    u32x4 ra[4], rb[2];
    const int nk = K >> 6;
#pragma unroll
    for (int i = 0; i < 4; ++i) ra[i] = *(const u32x4*)(pa[i]);
#pragma unroll
    for (int i = 0; i < 2; ++i) rb[i] = *(const u32x4*)(pb[i]);
    {
        char* sa = smem; char* sb = smem + G_ASZ;
#pragma unroll
        for (int i = 0; i < 4; ++i) *(u32x4*)(sa + (lrow + 64 * i) * G_LROW + lchunk * 16) = ra[i];
#pragma unroll
        for (int i = 0; i < 2; ++i) *(u32x4*)(sb + (lrow + 64 * i) * G_LROW + lchunk * 16) = rb[i];
    }
    __syncthreads();
    for (int kt = 0; kt < nk; ++kt) {
        const bool more = (kt + 1 < nk);
        if (more) {
#pragma unroll
            for (int i = 0; i < 4; ++i) ra[i] = *(const u32x4*)(pa[i] + (kt + 1) * 64);
#pragma unroll
            for (int i = 0; i < 2; ++i) rb[i] = *(const u32x4*)(pb[i] + (kt + 1) * 64);
        }
        const char* sa = smem + (kt & 1) * G_STAGE; const char* sb = sa + G_ASZ;
#pragma unroll
        for (int ks = 0; ks < 2; ++ks) {
            bf16x8 af[4], bfr[4];
#pragma unroll
            for (int m = 0; m < 4; ++m) af[m] = *(const bf16x8*)(sa + (wr * 64 + m * 16 + fr) * G_LROW + (ks * 32 + fq * 8) * 2);
#pragma unroll
            for (int n = 0; n < 4; ++n) bfr[n] = *(const bf16x8*)(sb + (wc * 64 + n * 16 + fr) * G_LROW + (ks * 32 + fq * 8) * 2);
#pragma unroll
            for (int m = 0; m < 4; ++m)
#pragma unroll
                for (int n = 0; n < 4; ++n) acc[m][n] = __builtin_amdgcn_mfma_f32_16x16x32_bf16(af[m], bfr[n], acc[m][n], 0, 0, 0);
        }
        if (more) {
            char* wa = smem + ((kt + 1) & 1) * G_STAGE; char* wb = wa + G_ASZ;
#pragma unroll
            for (int i = 0; i < 4; ++i) *(u32x4*)(wa + (lrow + 64 * i) * G_LROW + lchunk * 16) = ra[i];
#pragma unroll
            for (int i = 0; i < 2; ++i) *(u32x4*)(wb + (lrow + 64 * i) * G_LROW + lchunk * 16) = rb[i];
        }
        __syncthreads();
    }
    {
        f32x4 h0[4][2], h1[4][2];
#pragma unroll
        for (int m = 0; m < 4; ++m) { h0[m][0] = acc[m][0]; h0[m][1] = acc[m][1]; h1[m][0] = acc[m][2]; h1[m][1] = acc[m][3]; }
        epi(h0, wr * 64, n0 + wc * 64, fr, fq);
        epi(h1, wr * 64, n0 + wc * 64 + 32, fr, fq);
    }
}

template <class Epi>
__device__ __forceinline__ void gemm_phase(const bf16_t* A, long lda, int M, const bf16_t* Bt, long ldb, int N, int K, char* smem, int bid, int nb, Epi&& epi) {
    const int ntn = N / 128, ntm = M / 256, nt = ntn * ntm;
    for (int t = bid; t < nt; t += nb) {
        const int mi = t / ntn, ni = t - mi * ntn;
        gemm_tile<false>(A, lda, 0, mi * 256, Bt, ldb, ni * 128, K, smem,
                         [&](f32x4 (&acc)[4][2], int rt0, int c0, int fr, int fq) { epi(acc, mi * 256 + rt0, c0, fr, fq); });
    }
}

constexpr int G8_HT = 128 * 64 * 2;
constexpr int G8_ROWS_OFF = 8 * G8_HT;

__device__ __forceinline__ int g8_lds_byte(int r, int c) {
    const int st = (r >> 4) * 2 + (c >> 5), rr = r & 15, cc = c & 31, ob = rr * 64 + cc * 2;
    return st * 1024 + (ob ^ (((ob >> 9) & 1) << 5));
}
__device__ __forceinline__ void g8_stage_rc(int b, int& R, int& C) {
    const int st = b / 1024, sb = b % 1024, swz = sb ^ (((sb >> 9) & 1) << 5);
    R = (st >> 1) * 16 + swz / 64; C = (st & 1) * 32 + (swz % 64) / 2;
}

#define G8_SA(b, h) (lds + ((b) * 2 + (h)) * G8_HT)
#define G8_SB(b, h) (lds + (4 + (b) * 2 + (h)) * G8_HT)
#define G8_STAGE(P, RS, OFF, soff) do { \
    _Pragma("unroll") for (int _i = 0; _i < 2; ++_i) \
        __builtin_amdgcn_raw_ptr_buffer_load_lds((RS), (LAS unsigned*)((P) + tid * 16 + _i * 8192), 16, (OFF)[_i], (soff), 0, 0); } while (0)
#define G8_LDA(dst, b, h) do { _Pragma("unroll") for (int m = 0; m < 4; ++m) _Pragma("unroll") for (int k = 0; k < 2; ++k) \
    dst[m][k] = *(const LAS bf16x8*)(G8_SA(b, h) + g8_lds_byte(wr * 64 + m * 16 + fr, k * 32 + fq * 8)); } while (0)
#define G8_LDB(dst, b, h) do { _Pragma("unroll") for (int n = 0; n < 2; ++n) _Pragma("unroll") for (int k = 0; k < 2; ++k) \
    dst[n][k] = *(const LAS bf16x8*)(G8_SB(b, h) + g8_lds_byte(wc * 32 + n * 16 + fr, k * 32 + fq * 8)); } while (0)
#define G8_MMA(ai, bj, At, Bt_) do { __builtin_amdgcn_s_setprio(1); \
    _Pragma("unroll") for (int m = 0; m < 4; ++m) _Pragma("unroll") for (int n = 0; n < 2; ++n) _Pragma("unroll") for (int k = 0; k < 2; ++k) \
        acc[ai][bj][m][n] = __builtin_amdgcn_mfma_f32_16x16x32_bf16(Bt_[n][k], At[m][k], acc[ai][bj][m][n], 0, 0, 0); \
    __builtin_amdgcn_s_setprio(0); } while (0)
#define G8_WAIT_V(n) asm volatile("s_waitcnt vmcnt(" #n ")" ::: "memory")
#define G8_WAIT_L(n) asm volatile("s_waitcnt lgkmcnt(" #n ")" ::: "memory")
#define G8_BAR __builtin_amdgcn_s_barrier()
#define G8_SCHED __builtin_amdgcn_sched_barrier(0)

template <bool GATHER, class Epi>
__device__ __forceinline__ void gemm256_tile(const bf16_t* __restrict__ A, long lda, int shift, int m0, const bf16_t* __restrict__ Bt, long ldb, int n0, int K,
                                             char* smem, Epi&& epi) {
    LAS char* lds = (LAS char*)smem;
    int tid = otid();
    int wid = tid >> 6, lane = tid & 63, wr = wid >> 2, wc = wid & 3, fr = lane & 15, fq = lane >> 4;
    unsigned aoff[2][2], boff[2];
    {
        const LAS int* sRow = (const LAS int*)(lds + G8_ROWS_OFF);
#pragma unroll
        for (int i = 0; i < 2; ++i) {
            int R, C; g8_stage_rc(tid * 16 + i * 8192, R, C);
            { const int rho = R & 31, nn = rho >> 4, ii = rho & 15; const int Rp = (R & ~31) + 8 * (ii >> 2) + 4 * nn + (ii & 3);
              boff[i] = (unsigned)((long)Rp * ldb + C) * 2u; }
#pragma unroll
            for (int h = 0; h < 2; ++h) {
                long arow;
                if (GATHER) { const int v = sRow[h * 128 + R]; arow = v < 0 ? 0 : (v >> shift); } else arow = m0 + h * 128 + R;
                aoff[h][i] = (unsigned)(arow * lda + C) * 2u;
            }
        }
    }
    f32x4 acc[2][2][4][2];
#pragma unroll
    for (int a = 0; a < 2; ++a)
#pragma unroll
        for (int b = 0; b < 2; ++b)
#pragma unroll
            for (int m = 0; m < 4; ++m)
#pragma unroll
                for (int n = 0; n < 2; ++n) acc[a][b][m][n] = (f32x4){0.f, 0.f, 0.f, 0.f};
    bf16x8 At[4][2], B0[2][2], B1[2][2];
    const int nt = K / 64;
    const __amdgpu_buffer_rsrc_t rA = __builtin_amdgcn_make_buffer_rsrc((void*)A, 0, 0x7fffffff, 0x00020000);
    const __amdgpu_buffer_rsrc_t rB = __builtin_amdgcn_make_buffer_rsrc((void*)(Bt + (size_t)n0 * ldb), 0, 0x7fffffff, 0x00020000);
    const int bh = (int)(128 * ldb * 2);
    G8_STAGE(G8_SB(0, 0), rB, boff, 0); G8_STAGE(G8_SA(0, 0), rA, aoff[0], 0);
    G8_STAGE(G8_SB(0, 1), rB, boff, bh); G8_STAGE(G8_SA(0, 1), rA, aoff[1], 0);
    if (wr == 1) G8_BAR;
    G8_WAIT_V(4); G8_BAR;
    G8_STAGE(G8_SB(1, 0), rB, boff, 128); G8_STAGE(G8_SA(1, 0), rA, aoff[0], 128); G8_STAGE(G8_SB(1, 1), rB, boff, 128 + bh);
    G8_WAIT_V(6); G8_BAR;
    for (int t = 0; t < nt - 2; t += 2) {
        G8_LDB(B0, 0, 0); G8_SCHED; G8_LDA(At, 0, 0); G8_STAGE(G8_SA(1, 1), rA, aoff[1], (t + 1) * 128);
        G8_WAIT_L(8); G8_BAR; G8_WAIT_L(0); G8_MMA(0, 0, At, B0); G8_BAR; G8_SCHED;
        G8_LDB(B1, 0, 1); G8_STAGE(G8_SB(0, 0), rB, boff, (t + 2) * 128);
        G8_BAR; G8_WAIT_L(0); G8_MMA(0, 1, At, B1); G8_BAR;
        G8_LDA(At, 0, 1); G8_STAGE(G8_SA(0, 0), rA, aoff[0], (t + 2) * 128);
        G8_BAR; G8_WAIT_L(0); G8_MMA(1, 0, At, B0); G8_BAR; G8_SCHED;
        G8_STAGE(G8_SB(0, 1), rB, boff, (t + 2) * 128 + bh);
        G8_WAIT_V(6); G8_BAR; G8_MMA(1, 1, At, B1); G8_BAR;
        G8_LDB(B0, 1, 0); G8_SCHED; G8_LDA(At, 1, 0); G8_STAGE(G8_SA(0, 1), rA, aoff[1], (t + 2) * 128);
        G8_WAIT_L(8); G8_BAR; G8_WAIT_L(0); G8_MMA(0, 0, At, B0); G8_BAR; G8_SCHED;
        G8_LDB(B1, 1, 1); G8_STAGE(G8_SB(1, 0), rB, boff, (t + 3) * 128);
        G8_BAR; G8_WAIT_L(0); G8_MMA(0, 1, At, B1); G8_BAR;
        G8_LDA(At, 1, 1); G8_STAGE(G8_SA(1, 0), rA, aoff[0], (t + 3) * 128);
        G8_BAR; G8_WAIT_L(0); G8_MMA(1, 0, At, B0); G8_BAR; G8_SCHED;
        G8_STAGE(G8_SB(1, 1), rB, boff, (t + 3) * 128 + bh);
        G8_WAIT_V(6); G8_BAR; G8_MMA(1, 1, At, B1); G8_BAR;
    }
    { G8_LDB(B0, 0, 0); G8_WAIT_V(0); G8_LDA(At, 0, 0); G8_STAGE(G8_SA(1, 1), rA, aoff[1], (nt - 1) * 128);
      G8_BAR; G8_WAIT_L(0); G8_MMA(0, 0, At, B0); G8_BAR;
      G8_LDB(B1, 0, 1); G8_BAR; G8_WAIT_L(0); G8_MMA(0, 1, At, B1); G8_BAR;
      G8_LDA(At, 0, 1); G8_WAIT_V(4); G8_BAR; G8_WAIT_L(0); G8_MMA(1, 0, At, B0); G8_MMA(1, 1, At, B1); G8_BAR; }
    { G8_LDB(B0, 1, 0); G8_LDA(At, 1, 0); G8_WAIT_V(2); G8_BAR; G8_WAIT_L(0); G8_MMA(0, 0, At, B0); G8_BAR;
      G8_LDB(B1, 1, 1); G8_WAIT_V(0); G8_BAR; G8_WAIT_L(0); G8_MMA(0, 1, At, B1); G8_BAR;
      G8_LDA(At, 1, 1); G8_BAR; G8_WAIT_L(0); G8_MMA(1, 0, At, B0); G8_MMA(1, 1, At, B1); G8_BAR; }
    if (wr == 0) G8_BAR;
    int tz = otid(); wid = tz >> 6; lane = tz & 63; wr = wid >> 2; wc = wid & 3; fr = lane & 15; fq = lane >> 4;
#pragma unroll
    for (int ai = 0; ai < 2; ++ai)
#pragma unroll
        for (int bj = 0; bj < 2; ++bj) epi(acc[ai][bj], ai * 128 + wr * 64, n0 + bj * 128 + wc * 32, fr, fq);
}

struct G8Desc { const bf16_t* A; const bf16_t* Bt; const int* list; int m0, n0, count, u0, ldb; };

template <bool GATHER, int SHIFT, class Src, class Epi>
__device__ __forceinline__ void gemm256_stream(Src&& src, const int lda, const int K, char* smem, Epi&& epi) {
    LAS char* lds = (LAS char*)smem;
    int tid = otid();
    int wid = tid >> 6, lane = tid & 63, wr = wid >> 2, wc = wid & 3, fr = lane & 15, fq = lane >> 4;
    G8Desc nxt;
    if (!src(0, nxt)) return;
    int cm0 = nxt.m0, cn0 = nxt.n0, cu0 = nxt.u0;
    int* sRowG = (int*)(smem + G8_ROWS_OFF);
    __syncthreads();
    if (GATHER) { if (tid < 256) sRowG[tid] = tid < nxt.count ? nxt.list[tid] : -1; __syncthreads(); }
    unsigned aoff[2][2], boff[2];
    __amdgpu_buffer_rsrc_t rA, rB;
    int bh;
#define G8_PREP(D, SLOT) do { \
        const LAS int* _sr = (const LAS int*)(lds + G8_ROWS_OFF) + (SLOT) * 256; \
        _Pragma("unroll") for (int i = 0; i < 2; ++i) { \
            int R, C; g8_stage_rc(tid * 16 + i * 8192, R, C); \
            { const int rho = R & 31, nn = rho >> 4, ii = rho & 15; const int Rp = (R & ~31) + 8 * (ii >> 2) + 4 * nn + (ii & 3); boff[i] = (unsigned)(Rp * (D).ldb + C) * 2u; } \
            _Pragma("unroll") for (int h = 0; h < 2; ++h) { \
                int arow; \
                if (GATHER) { const int v = _sr[h * 128 + R]; arow = v < 0 ? 0 : (v >> SHIFT); } else arow = (D).m0 + h * 128 + R; \
                aoff[h][i] = (unsigned)(arow * lda + C) * 2u; } } \
        rA = __builtin_amdgcn_make_buffer_rsrc((void*)(D).A, 0, 0x7fffffff, 0x00020000); \
        rB = __builtin_amdgcn_make_buffer_rsrc((void*)((D).Bt + (size_t)(D).n0 * (D).ldb), 0, 0x7fffffff, 0x00020000); bh = 128 * (D).ldb * 2; } while (0)
#define G8_PRO1() do { G8_STAGE(G8_SB(0, 0), rB, boff, 0); G8_STAGE(G8_SA(0, 0), rA, aoff[0], 0); G8_STAGE(G8_SB(0, 1), rB, boff, bh); G8_STAGE(G8_SA(0, 1), rA, aoff[1], 0); } while (0)
    G8_PREP(nxt, 0);
    G8_PRO1();
    f32x4 acc[2][2][4][2];
    const int nt = K / 64;
    for (int it = 0;; ++it) {
#pragma unroll
        for (int a = 0; a < 2; ++a)
#pragma unroll
            for (int b = 0; b < 2; ++b)
#pragma unroll
                for (int m = 0; m < 4; ++m)
#pragma unroll
                    for (int n = 0; n < 2; ++n) acc[a][b][m][n] = (f32x4){0.f, 0.f, 0.f, 0.f};
        const bool has_next = src(it + 1, nxt);
        if (GATHER && has_next && tid < 256) sRowG[((it + 1) % 3) * 256 + tid] = tid < nxt.count ? nxt.list[tid] : -1;
        bf16x8 At[4][2], B0[2][2], B1[2][2];
        if (wr == 1) G8_BAR;
        G8_WAIT_V(4); G8_BAR;
        G8_STAGE(G8_SB(1, 0), rB, boff, 128); G8_STAGE(G8_SA(1, 0), rA, aoff[0], 128); G8_STAGE(G8_SB(1, 1), rB, boff, 128 + bh);
        G8_WAIT_V(6); G8_BAR;
        for (int t = 0; t < nt - 2; t += 2) {
            G8_LDB(B0, 0, 0); G8_SCHED; G8_LDA(At, 0, 0); G8_STAGE(G8_SA(1, 1), rA, aoff[1], (t + 1) * 128);
            G8_WAIT_L(8); G8_BAR; G8_WAIT_L(0); G8_MMA(0, 0, At, B0); G8_BAR; G8_SCHED;
            G8_LDB(B1, 0, 1); G8_STAGE(G8_SB(0, 0), rB, boff, (t + 2) * 128);
            G8_BAR; G8_WAIT_L(0); G8_MMA(0, 1, At, B1); G8_BAR;
            G8_LDA(At, 0, 1); G8_STAGE(G8_SA(0, 0), rA, aoff[0], (t + 2) * 128);
            G8_BAR; G8_WAIT_L(0); G8_MMA(1, 0, At, B0); G8_BAR; G8_SCHED;
            G8_STAGE(G8_SB(0, 1), rB, boff, (t + 2) * 128 + bh);
            G8_WAIT_V(6); G8_BAR; G8_MMA(1, 1, At, B1); G8_BAR;
            G8_LDB(B0, 1, 0); G8_SCHED; G8_LDA(At, 1, 0); G8_STAGE(G8_SA(0, 1), rA, aoff[1], (t + 2) * 128);
            G8_WAIT_L(8); G8_BAR; G8_WAIT_L(0); G8_MMA(0, 0, At, B0); G8_BAR; G8_SCHED;
            G8_LDB(B1, 1, 1); G8_STAGE(G8_SB(1, 0), rB, boff, (t + 3) * 128);
            G8_BAR; G8_WAIT_L(0); G8_MMA(0, 1, At, B1); G8_BAR;
            G8_LDA(At, 1, 1); G8_STAGE(G8_SA(1, 0), rA, aoff[0], (t + 3) * 128);
            G8_BAR; G8_WAIT_L(0); G8_MMA(1, 0, At, B0); G8_BAR; G8_SCHED;
            G8_STAGE(G8_SB(1, 1), rB, boff, (t + 3) * 128 + bh);
            G8_WAIT_V(6); G8_BAR; G8_MMA(1, 1, At, B1); G8_BAR;
        }
        { G8_LDB(B0, 0, 0); G8_WAIT_V(0); G8_LDA(At, 0, 0); G8_STAGE(G8_SA(1, 1), rA, aoff[1], (nt - 1) * 128);
          G8_BAR; G8_WAIT_L(0); G8_MMA(0, 0, At, B0); G8_BAR;
          G8_LDB(B1, 0, 1); G8_BAR; G8_WAIT_L(0); G8_MMA(0, 1, At, B1); G8_BAR;
          G8_LDA(At, 0, 1); G8_WAIT_V(4); G8_BAR; G8_WAIT_L(0); G8_MMA(1, 0, At, B0); G8_MMA(1, 1, At, B1); G8_BAR; }
        { G8_LDB(B0, 1, 0); G8_LDA(At, 1, 0); G8_WAIT_V(2); G8_BAR; G8_WAIT_L(0); G8_MMA(0, 0, At, B0); G8_BAR;
          G8_LDB(B1, 1, 1); G8_WAIT_V(0); G8_BAR; G8_WAIT_L(0); G8_MMA(0, 1, At, B1); G8_BAR;
          G8_LDA(At, 1, 1); G8_BAR; G8_WAIT_L(0); G8_MMA(1, 0, At, B0); G8_MMA(1, 1, At, B1); G8_BAR; }
        if (wr == 0) G8_BAR;
        tid = otid(); wid = tid >> 6; lane = tid & 63; wr = wid >> 2; wc = wid & 3; fr = lane & 15; fq = lane >> 4;
        if (has_next) { G8_PREP(nxt, (it + 1) % 3); G8_PRO1(); }
        {
            const int* sr = sRowG + (it % 3) * 256;
#pragma unroll
            for (int ai = 0; ai < 2; ++ai)
#pragma unroll
                for (int bj = 0; bj < 2; ++bj) epi(cm0, cu0, acc[ai][bj], ai * 128 + wr * 64, cn0 + bj * 128 + wc * 32, fr, fq, sr);
        }
        if (!has_next) break;
        cm0 = nxt.m0; cn0 = nxt.n0; cu0 = nxt.u0;
    }
#undef G8_PREP
#undef G8_PRO1
}

struct XcdSeq {
    int q, qend, step;
    __device__ __forceinline__ XcdSeq(int total, int bid, int nb) {
        if ((nb & 7) == 0) { const int chunk = (total + 7) >> 3, x = bid & 7; q = x * chunk + (bid >> 3); const int e = (x + 1) * chunk; qend = e < total ? e : total; step = nb >> 3; }
        else { q = bid; qend = total; step = nb; }
    }
};

template <class Epi>
__device__ __forceinline__ void gemm256_phase(const bf16_t* A, long lda, int M, const bf16_t* Bt, long ldb, int N, int K, char* smem, int bid, int nb, Epi&& epi) {
    const int ntn = N / 256, ntm = M / 256, nt = ntn * ntm;
    XcdSeq s(nt, bid, nb);
    gemm256_stream<false, 0>(
        [&](int i, G8Desc& d) -> bool {
            const int Q = s.q + i * s.step; if (Q >= s.qend) return false;
            const int pnl = Q / (4 * ntn), r = Q - pnl * 4 * ntn;
            d.A = A; d.Bt = Bt; d.list = nullptr; d.m0 = (pnl * 4 + (r & 3)) * 256; d.n0 = (r >> 2) * 256; d.count = 0; d.u0 = 0; d.ldb = (int)ldb;
            return true; },
        (int)lda, K, smem,
        [&](int m0, int, f32x4 (&acc)[4][2], int rt0, int c0, int fr, int fq, const int*) { epi(acc, m0 + rt0, c0, fr, fq); });
}


__device__ __forceinline__ int colmap(int kind, int n, int nsrc) {
    if (kind == 0) return n < nsrc ? n : -1;
    if (kind == 1) { if (n < 512) return n; if (n < 1024) return n + 512; if (n < 1536) return n + 528; if (n < 1552) return n; if (n < 1792) return -1; return n - 1280; }
    if (kind == 2) { if (n < 1024) return n; if (n < 1280) return n + 512; if (n < 4352) return n + 580; if (n < 4420) return n - 2560; if (n < 4608) return -1; if (n < 5120) return n - 3584; return n - 188; }
    { const int grp = n >> 5, w = n & 31; return ((w >> 2) & 1) * 1024 + grp * 16 + 4 * (w >> 3) + (w & 3); }
}
struct ConvTile { const float* src; bf16_t* dst; int sld, sc, K, n0, k0; };
__device__ __forceinline__ ConvTile conv_decode(PRef p, int t, int n4) {
    constexpr int S0 = 128 * 32 * 4, S1 = S0 + 128 * 16 * 4, S2 = S1 + 2 * 36 * 4, S3 = S2 + 2 * 104 * 4, S4 = S3 + 2 * 16 * 4, S5 = S4 + 2 * 16 * 4, S6 = S5 + 2 * 8 * 2;
    char* ws = p.ws;
    ConvTile c; int nsrc, kind, NT, loc;
    if (t < S0) { loc = t; const int mat = loc / (32 * 4); loc -= mat * 32 * 4; c.src = p.moe_w1 + (size_t)mat * 1024 * 2048; c.dst = (bf16_t*)(ws + OFF_WT_W1) + (size_t)mat * 2048 * 1024; c.sld = 2048; nsrc = 2048; kind = 3; c.K = 1024; NT = 32; }
    else if (t < S1) { loc = t - S0; const int mat = loc / 64; loc -= mat * 64; c.src = p.moe_w2 + (size_t)mat * 1024 * 1024; c.dst = (bf16_t*)(ws + OFF_WT_W2) + (size_t)mat * 1024 * 1024; c.sld = 1024; nsrc = 1024; kind = 0; c.K = 1024; NT = 16; }
    else if (t < S2) { loc = t - S1; const int mat = loc / (36 * 4); loc -= mat * 36 * 4; c.src = p.ev_w_in + (size_t)mat * 1024 * 2064; c.dst = (bf16_t*)(ws + OFF_WT_EVIN) + (size_t)mat * EV_N * 1024; c.sld = 2064; nsrc = 2064; kind = 1; c.K = 1024; NT = 36; }
    else if (t < S3) { loc = t - S2; const int mat = loc / (104 * 4); loc -= mat * 104 * 4; c.src = p.od_w_in + (size_t)mat * 1024 * 6468; c.dst = (bf16_t*)(ws + OFF_WT_ODIN) + (size_t)mat * OD_N * 1024; c.sld = 6468; nsrc = 6468; kind = 2; c.K = 1024; NT = 104; }
    else if (t < S4) { loc = t - S3; const int mat = loc / 64; loc -= mat * 64; c.src = p.ev_w_out + (size_t)mat * 1024 * 1024; c.dst = (bf16_t*)(ws + OFF_WT_EVOUT) + (size_t)mat * 1024 * 1024; c.sld = 1024; nsrc = 1024; kind = 0; c.K = 1024; NT = 16; }
    else if (t < S5) { loc = t - S4; const int mat = loc / 64; loc -= mat * 64; c.src = p.od_w_out + (size_t)mat * 1024 * 1024; c.dst = (bf16_t*)(ws + OFF_WT_ODOUT) + (size_t)mat * 1024 * 1024; c.sld = 1024; nsrc = 1024; kind = 0; c.K = 1024; NT = 16; }
    else if (t < S6) { loc = t - S5; const int mat = loc / 16; loc -= mat * 16; c.src = p.s5_w_glu + (size_t)mat * 512 * 512; c.dst = (bf16_t*)(ws + OFF_WT_GLU) + (size_t)mat * 512 * 512; c.sld = 512; nsrc = 512; kind = 0; c.K = 512; NT = 8; }
    else { loc = t - S6; const int mat = loc / 8; loc -= mat * 8; c.src = p.router_w + (size_t)mat * 1024 * 32; c.dst = (bf16_t*)(ws + OFF_WT_RT) + (size_t)mat * 128 * 1024; c.sld = 32; nsrc = 32; kind = 0; c.K = 1024; NT = 2; }
    const int kt = loc / NT, nt = loc - kt * NT;
    c.n0 = nt * 64; c.k0 = kt * 256;
    c.sc = colmap(kind, c.n0 + n4 * 4, nsrc);
    return c;
}
__device__ __forceinline__ void conv_load(const ConvTile& c, int kp, f32x4 (&v)[8]) {
#pragma unroll
    for (int i = 0; i < 4; ++i)
#pragma unroll
        for (int e = 0; e < 2; ++e) {
            const int k = c.k0 + 2 * (kp + 32 * i) + e;
            v[2 * i + e] = c.sc >= 0 ? *(const f32x4*)(c.src + (size_t)k * c.sld + c.sc) : (f32x4){0.f, 0.f, 0.f, 0.f};
        }
}

__device__ __forceinline__ void conv_phase(PRef p, char* smem, int bid, int nb) {
    char* ws = p.ws;
    constexpr int NTILES = 128 * 32 * 4 + 128 * 16 * 4 + 2 * 36 * 4 + 2 * 104 * 4 + 2 * 16 * 4 + 2 * 16 * 4 + 2 * 8 * 2 + 4 * 2 * 4;
    bf16_t* tile = (bf16_t*)smem;
    const int tid = otid(), n4 = tid & 15, kp = tid >> 4;
    if (bid < NTILES) {
        ConvTile cur = conv_decode(p, bid, n4);
        f32x4 v[8];
        conv_load(cur, kp, v);
        for (int t = bid; t < NTILES; t += nb) {
            const bool more = t + nb < NTILES;
            ConvTile nxt = cur; f32x4 w[8];
            if (more) { nxt = conv_decode(p, t + nb, n4); conv_load(nxt, kp, w); }
#pragma unroll
            for (int i = 0; i < 4; ++i)
#pragma unroll
                for (int j = 0; j < 4; ++j)
                    *(unsigned*)(tile + (n4 * 4 + j) * 258 + 2 * (kp + 32 * i)) = pk2(v[2 * i][j], v[2 * i + 1][j]);
            __syncthreads();
#pragma unroll
            for (int i = 0; i < 4; ++i) {
                const int c = tid + 512 * i, n = c >> 5, kc = c & 31;
                const unsigned* tp = (const unsigned*)(tile + n * 258 + kc * 8);
                u32x4 o; o.x = tp[0]; o.y = tp[1]; o.z = tp[2]; o.w = tp[3];
                *(u32x4*)(cur.dst + (size_t)(cur.n0 + n) * cur.K + cur.k0 + kc * 8) = o;
            }
            __syncthreads();
            if (more) {
                cur = nxt;
#pragma unroll
                for (int i = 0; i < 8; ++i) v[i] = w[i];
            }
        }
    }
    {
        const float* x = p.x; bf16_t* xb = (bf16_t*)(ws + OFF_XB);
        const long nch = (long)T_ * 1024 / 8;
        for (long c = (long)bid * NTHR + otid(); c < nch; c += (long)nb * NTHR) {
            const f32x4 a = *(const f32x4*)(x + c * 8), b = *(const f32x4*)(x + c * 8 + 4);
            u32x4 w; w.x = pk2(a[0], a[1]); w.y = pk2(a[2], a[3]); w.z = pk2(b[0], b[1]); w.w = pk2(b[2], b[3]);
            *(u32x4*)(xb + c * 8) = w;
        }
    }
    if (bid == 0 && otid() < 128) ((int*)(ws + OFF_CNT))[otid()] = 0;
}

__device__ __forceinline__ void s5mat_unit(PRef p, int u, char* smem) {
    float* cre = (float*)smem;
    float* cim = cre + 16 * 65;
    float* bbr = cim + 16 * 65;
    float* bbi = bbr + 1024;
    float* pwr = bbi + 1024;
    float* pwi = pwr + 65 * 65;
    float* zr = pwi + 65 * 65;
    float* zi = zr + 64;
    float* Kd = zi + 64 + 2;
    const int tid = otid();
    const int jg = u >> 2, q = u & 3;
    if (tid < 64) {
        const int pp = tid;
        const float lre = fminf(p.s5_a_re[jg * 64 + pp], -1e-4f), lim = p.s5_a_im[jg * 64 + pp];
        const float dt = expf(p.s5_log_dt[jg]);
        const float xr = lre * dt, th = lim * dt;
        const float mag = expf(xr);
        const float ar = mag * cosf(th), ai = mag * sinf(th);
        const float inv = 1.f / (lre * lre + lim * lim);
        zr[pp] = ((ar - 1.f) * lre + ai * lim) * inv;
        zi[pp] = (ai * lre - (ar - 1.f) * lim) * inv;
        float wr_ = 1.f, wi_ = 0.f;
        for (int d = 0; d <= 64; ++d) {
            pwr[d * 65 + pp] = wr_; pwi[d * 65 + pp] = wi_;
            const float nr = wr_ * ar - wi_ * ai, ni = wr_ * ai + wi_ * ar;
            wr_ = nr; wi_ = ni;
        }
    } else {
        for (int e = tid - 64; e < 1024; e += NTHR - 64) {
            const int n = e >> 6, pp = e & 63;
            cre[n * 65 + pp] = p.s5_c_re[(size_t)jg * 1024 + e];
            cim[n * 65 + pp] = p.s5_c_im[(size_t)jg * 1024 + e];
        }
    }
    __syncthreads();
    for (int e = tid; e < 1024; e += NTHR) {
        const int pp = e >> 4;
        const float br = p.s5_b_re[(size_t)jg * 1024 + e], bi = p.s5_b_im[(size_t)jg * 1024 + e];
        bbr[e] = zr[pp] * br - zi[pp] * bi;
        bbi[e] = zr[pp] * bi + zi[pp] * br;
    }
    __syncthreads();
    if (tid < 256) {
        const int mh = tid & 1, nl = (tid >> 1) & 3, dp = tid >> 3, n = 4 * q + nl;
        float acc0[8], acc1[8];
#pragma unroll
        for (int i = 0; i < 8; ++i) { acc0[i] = 0.f; acc1[i] = 0.f; }
#pragma unroll 2
        for (int pp = 0; pp < 64; ++pp) {
            const float cr = cre[n * 65 + pp], ci = cim[n * 65 + pp];
            const float q0r = pwr[(2 * dp) * 65 + pp], q0i = pwi[(2 * dp) * 65 + pp], q1r = pwr[(2 * dp + 1) * 65 + pp], q1i = pwi[(2 * dp + 1) * 65 + pp];
            const float v0r = cr * q0r - ci * q0i, v0i = cr * q0i + ci * q0r, v1r = cr * q1r - ci * q1i, v1i = cr * q1i + ci * q1r;
            const f32x4 ba = *(const f32x4*)(bbr + pp * 16 + mh * 8), bb_ = *(const f32x4*)(bbr + pp * 16 + mh * 8 + 4);
            const f32x4 ia = *(const f32x4*)(bbi + pp * 16 + mh * 8), ib = *(const f32x4*)(bbi + pp * 16 + mh * 8 + 4);
#pragma unroll
            for (int i = 0; i < 8; ++i) {
                const float br = i < 4 ? ba[i & 3] : bb_[i & 3], bi = i < 4 ? ia[i & 3] : ib[i & 3];
                acc0[i] += v0r * br - v0i * bi;
                acc1[i] += v1r * br - v1i * bi;
            }
        }
        float* k0 = Kd + ((2 * dp) * 4 + nl) * 16 + mh * 8;
        *(f32x4*)(k0) = (f32x4){acc0[0], acc0[1], acc0[2], acc0[3]};
        *(f32x4*)(k0 + 4) = (f32x4){acc0[4], acc0[5], acc0[6], acc0[7]};
        *(f32x4*)(k0 + 64) = (f32x4){acc1[0], acc1[1], acc1[2], acc1[3]};
        *(f32x4*)(k0 + 68) = (f32x4){acc1[4], acc1[5], acc1[6], acc1[7]};
    }
    __syncthreads();
    bf16_t* TH = (bf16_t*)(p.ws + OFF_TH) + (size_t)jg * 1024 * UHW;
    for (int c = tid; c < 256 * 144; c += NTHR) {
        const int rl = c / 144, ch = c - rl * 144;
        const int tau = rl >> 2, nl = rl & 3, n = 4 * q + nl;
        float v[8];
        if (ch < 128) {
            const int s = ch >> 1, m0 = (ch & 1) * 8;
            if (s <= tau) {
                const f32x4 a = *(const f32x4*)(Kd + ((tau - s) * 4 + nl) * 16 + m0), b = *(const f32x4*)(Kd + ((tau - s) * 4 + nl) * 16 + m0 + 4);
#pragma unroll
                for (int i = 0; i < 4; ++i) { v[i] = a[i]; v[4 + i] = b[i]; }
            } else {
#pragma unroll
                for (int i = 0; i < 8; ++i) v[i] = 0.f;
            }
        } else {
            const int p0 = (ch - 128) * 4;
#pragma unroll
            for (int i = 0; i < 4; ++i) {
                const int pp = p0 + i;
                const float cr = cre[n * 65 + pp], ci = cim[n * 65 + pp], qr = pwr[(tau + 1) * 65 + pp], qi = pwi[(tau + 1) * 65 + pp];
                v[2 * i] = cr * qr - ci * qi;
                v[2 * i + 1] = -(cr * qi + ci * qr);
            }
        }
        u32x4 w; w.x = pk2(v[0], v[1]); w.y = pk2(v[2], v[3]); w.z = pk2(v[4], v[5]); w.w = pk2(v[6], v[7]);
        *(u32x4*)(TH + (size_t)(tau * 16 + n) * UHW + ch * 8) = w;
    }
    bf16_t* GM = (bf16_t*)(p.ws + OFF_GM) + (size_t)jg * 128 * 1024;
    for (int c = tid; c < 32 * 128; c += NTHR) {
        const int row = 32 * q + (c >> 7), ch = c & 127;
        const int pp = row >> 1, ri = row & 1;
        const int s = ch >> 1, m0 = (ch & 1) * 8;
        const float qr = pwr[(63 - s) * 65 + pp], qi = pwi[(63 - s) * 65 + pp];
        float v[8];
#pragma unroll
        for (int i = 0; i < 8; ++i) {
            const float br = bbr[pp * 16 + m0 + i], bi = bbi[pp * 16 + m0 + i];
            v[i] = ri == 0 ? (qr * br - qi * bi) : (qr * bi + qi * br);
        }
        u32x4 w; w.x = pk2(v[0], v[1]); w.y = pk2(v[2], v[3]); w.z = pk2(v[4], v[5]); w.w = pk2(v[6], v[7]);
        *(u32x4*)(GM + (size_t)row * 1024 + ch * 8) = w;
    }
    if (q == 0 && tid < 64) {
        float* A64 = (float*)(p.ws + OFF_A64) + (size_t)jg * 128;
        A64[tid * 2] = pwr[64 * 65 + tid];
        A64[tid * 2 + 1] = pwi[64 * 65 + tid];
    }
    __syncthreads();
}

__device__ __forceinline__ void epi_ev_in(PRef p, f32x4 (&acc)[4][2], int row0, int c0, int fr, int fq) {
    char* ws = p.ws;
    bf16_t* PE = (bf16_t*)(ws + OFF_PE); bf16_t* UH = (bf16_t*)(ws + OFF_UH); float* GLR = (float*)(ws + OFF_GLR);
    const int col = c0 + 8 * fq;
#pragma unroll
    for (int m = 0; m < 4; ++m) {
        const int t = row0 + m * 16 + fr;
        u32x4 w; w.x = pk2(acc[m][0][0], acc[m][0][1]); w.y = pk2(acc[m][0][2], acc[m][0][3]); w.z = pk2(acc[m][1][0], acc[m][1][1]); w.w = pk2(acc[m][1][2], acc[m][1][3]);
        if (c0 < 1024) {
            *(u32x4*)(PE + (size_t)t * PE_W + col) = w;
        } else if (c0 < 1536) {
            const int ch = col - 1024, g = ch >> 4, mm = ch & 15;
            *(u32x4*)(UH + ((size_t)(t >> 6) * 32 + g) * UHW + (t & 63) * 16 + mm) = w;
        } else if (col < 1552) {
            *(f32x4*)(GLR + (size_t)t * 16 + (col - 1536)) = acc[m][0];
            *(f32x4*)(GLR + (size_t)t * 16 + (col - 1536) + 4) = acc[m][1];
        }
    }
}
__device__ __forceinline__ void epi_vt(bf16_t* __restrict__ img_row0, f32x4 (&acc)[4][2], int rt0, int c0, int fr, int fq) {
#pragma unroll
    for (int m = 0; m < 4; ++m) {
        u32x4 w; w.x = pk2(acc[m][0][0], acc[m][0][1]); w.y = pk2(acc[m][0][2], acc[m][0][3]); w.z = pk2(acc[m][1][0], acc[m][1][1]); w.w = pk2(acc[m][1][2], acc[m][1][3]);
        *(u32x4*)(img_row0 + (size_t)(rt0 + m * 16 + fr) * L_ + c0 + 8 * fq) = w;
    }
}

__device__ __forceinline__ void gla_decay(PRef p, int j, int t0, int h, float* sB) {
    const float* GLR = (const float*)(p.ws + OFF_GLR);
    const float* w2 = p.gla_w_gate2 + (size_t)j * 16 * 256;
    const float* b2 = p.gla_b_gate2 + (size_t)j * 256;
    const int tid = otid();
    for (int e = tid; e < 4096; e += NTHR) {
        const int tau = e >> 6, d = e & 63;
        float a = b2[h * 64 + d];
#pragma unroll
        for (int r = 0; r < 16; ++r) a += GLR[(size_t)(t0 + tau) * 16 + r] * w2[r * 256 + h * 64 + d];
        const float ls = fminf(a, 0.f) - __logf(1.f + __expf(-fabsf(a)));
        sB[tau * 65 + d] = ls * (1.f / 16.f);
    }
    __syncthreads();
    if (tid < 64) { float run = 0.f; for (int tau = 0; tau < 64; ++tau) { run += sB[tau * 65 + tid]; sB[tau * 65 + tid] = run; } }
    __syncthreads();
}

__device__ __forceinline__ void gla_a_item(PRef p, int j, int item, char* smem) {
    const int h = item & 3, c = (item >> 2) & 255, b = item >> 10;
    const int t0 = b * L_ + c * 64;
    float* sB = (float*)smem;
    bf16_t* AK = (bf16_t*)(smem + 16640);
    const bf16_t* PE = (const bf16_t*)(p.ws + OFF_PE);
    const bf16_t* VTE = (const bf16_t*)(p.ws + OFF_VTE);
    const int tid = otid(), lane = tid & 63, wave = tid >> 6, fr = lane & 15, fq = lane >> 4;
    gla_decay(p, j, t0, h, sB);
    for (int e = tid; e < 4096; e += NTHR) {
        const int tau = e >> 6, d = e & 63;
        const float k = bf2f(PE[(size_t)(t0 + tau) * PE_W + 256 + h * 64 + d]);
        AK[d * 72 + tau] = f2bf(k * __expf(sB[63 * 65 + d] - sB[tau * 65 + d]));
    }
    __syncthreads();
    const int dblk = wave >> 1, vb = (wave & 1) * 64;
    f32x4 acc[4];
#pragma unroll
    for (int n = 0; n < 4; ++n) acc[n] = (f32x4){0.f, 0.f, 0.f, 0.f};
#pragma unroll
    for (int ks = 0; ks < 2; ++ks) {
        const bf16x8 af = *(const bf16x8*)(AK + (dblk * 16 + fr) * 72 + ks * 32 + fq * 8);
#pragma unroll
        for (int n = 0; n < 4; ++n) {
            const int v = vb + n * 16 + fr;
            const bf16x8 bfr = *(const bf16x8*)(VTE + ((size_t)((b * 4 + h) * 128 + v)) * L_ + (c * 64 + ks * 32 + fq * 8));
            acc[n] = __builtin_amdgcn_mfma_f32_16x16x32_bf16(af, bfr, acc[n], 0, 0, 0);
        }
    }
    float* KV = (float*)(p.ws + OFF_KV) + ((size_t)((b * 256 + c) * 4 + h)) * 64 * 128;
#pragma unroll
    for (int n = 0; n < 4; ++n)
#pragma unroll
        for (int r = 0; r < 4; ++r) KV[(dblk * 16 + fq * 4 + r) * 128 + vb + n * 16 + fr] = acc[n][r];
    if (tid < 64) ((float*)(p.ws + OFF_DEC))[((size_t)((b * 256 + c) * 4 + h)) * 64 + tid] = __expf(sB[63 * 65 + tid]);
    __syncthreads();
}

__device__ __forceinline__ void scan_phase(PRef p, int j, int bid) {
    const int gid = bid * NTHR + otid();
    if (gid < 65536) {
        const int v = gid & 127, d = (gid >> 7) & 63, h = (gid >> 13) & 3, b = gid >> 15;
        const float* KV = (const float*)(p.ws + OFF_KV); float* SST = (float*)(p.ws + OFF_SST); const float* DEC = (const float*)(p.ws + OFF_DEC);
        float S = 0.f;
        for (int c0 = 0; c0 < 256; c0 += 8) {
            float kv[8], dc[8];
#pragma unroll
            for (int i = 0; i < 8; ++i) {
                const size_t blk = (size_t)((b * 256 + c0 + i) * 4 + h);
                kv[i] = KV[(blk * 64 + d) * 128 + v]; dc[i] = DEC[blk * 64 + d];
            }
#pragma unroll
            for (int i = 0; i < 8; ++i) {
                const size_t blk = (size_t)((b * 256 + c0 + i) * 4 + h);
                SST[(blk * 64 + d) * 128 + v] = S;
                S = dc[i] * S + kv[i];
            }
        }
    } else if (gid < 65536 + 4096) {
        const int e = gid - 65536, pp = e & 63, g = (e >> 6) & 31, b = e >> 11;
        const float* A64 = (const float*)(p.ws + OFF_A64) + (size_t)(j * 32 + g) * 128;
        const float ar = A64[pp * 2], ai = A64[pp * 2 + 1];
        const float* GB = (const float*)(p.ws + OFF_GBUF); bf16_t* UH = (bf16_t*)(p.ws + OFF_UH);
        float hr = 0.f, hi = 0.f;
        for (int c0 = 0; c0 < 256; c0 += 8) {
            float gr[8], gi[8];
#pragma unroll
            for (int i = 0; i < 8; ++i) { const size_t row = (size_t)(b * 256 + c0 + i) * 32 + g; gr[i] = GB[row * 128 + 2 * pp]; gi[i] = GB[row * 128 + 2 * pp + 1]; }
#pragma unroll
            for (int i = 0; i < 8; ++i) {
                const size_t row = (size_t)(b * 256 + c0 + i) * 32 + g;
                *(unsigned*)(UH + row * UHW + 1024 + 2 * pp) = pk2(hr, hi);
                const float nr = ar * hr - ai * hi + gr[i], ni = ar * hi + ai * hr + gi[i];
                hr = nr; hi = ni;
            }
        }
    }
}

__device__ __forceinline__ void gla_c_item(PRef p, int j, int item, char* smem) {
    const int h = item & 3, c = (item >> 2) & 255, b = item >> 10;
    const int t0 = b * L_ + c * 64;
    float* sB = (float*)smem;
    bf16_t* QT = (bf16_t*)(smem + 16640);
    bf16_t* KT = (bf16_t*)(smem + 16640 + 9216);
    bf16_t* ATT = (bf16_t*)(smem + 16640 + 18432);
    float* OS = (float*)(smem + 16640 + 27648);
    const bf16_t* PE = (const bf16_t*)(p.ws + OFF_PE);
    const bf16_t* VTE = (const bf16_t*)(p.ws + OFF_VTE);
    const int tid = otid(), lane = tid & 63, wave = tid >> 6, fr = lane & 15, fq = lane >> 4;
    gla_decay(p, j, t0, h, sB);
    for (int e = tid; e < 4096; e += NTHR) {
        const int tau = e >> 6, d = e & 63;
        const float bb = sB[tau * 65 + d];
        const float q = bf2f(PE[(size_t)(t0 + tau) * PE_W + h * 64 + d]);
        const float k = bf2f(PE[(size_t)(t0 + tau) * PE_W + 256 + h * 64 + d]);
        QT[tau * 72 + d] = f2bf(q * 0.125f * __expf(bb));
        KT[tau * 72 + d] = f2bf(k * __expf(-bb));
    }
    __syncthreads();
    const int iblk = wave >> 1;
    {
        f32x4 acc[2];
        acc[0] = (f32x4){0.f, 0.f, 0.f, 0.f}; acc[1] = acc[0];
#pragma unroll
        for (int ks = 0; ks < 2; ++ks) {
            const bf16x8 af = *(const bf16x8*)(QT + (iblk * 16 + fr) * 72 + ks * 32 + fq * 8);
#pragma unroll
            for (int n = 0; n < 2; ++n) {
                const int jb = (wave & 1) * 2 + n;
                const bf16x8 bfr = *(const bf16x8*)(KT + (jb * 16 + fr) * 72 + ks * 32 + fq * 8);
                acc[n] = __builtin_amdgcn_mfma_f32_16x16x32_bf16(af, bfr, acc[n], 0, 0, 0);
            }
        }
#pragma unroll
        for (int n = 0; n < 2; ++n) {
            const int jj = ((wave & 1) * 2 + n) * 16 + fr;
#pragma unroll
            for (int r = 0; r < 4; ++r) { const int ii = iblk * 16 + fq * 4 + r; ATT[ii * 72 + jj] = f2bf(jj <= ii ? acc[n][r] : 0.f); }
        }
    }
    __syncthreads();
    {
        const int vb = (wave & 1) * 64;
        const float* SST = (const float*)(p.ws + OFF_SST) + ((size_t)((b * 256 + c) * 4 + h)) * 64 * 128;
        f32x4 acc[4];
#pragma unroll
        for (int n = 0; n < 4; ++n) acc[n] = (f32x4){0.f, 0.f, 0.f, 0.f};
#pragma unroll
        for (int ks = 0; ks < 2; ++ks) {
            const bf16x8 af = *(const bf16x8*)(ATT + (iblk * 16 + fr) * 72 + ks * 32 + fq * 8);
            const bf16x8 aq = *(const bf16x8*)(QT + (iblk * 16 + fr) * 72 + ks * 32 + fq * 8);
#pragma unroll
            for (int n = 0; n < 4; ++n) {
                const int v = vb + n * 16 + fr;
                const bf16x8 bv = *(const bf16x8*)(VTE + ((size_t)((b * 4 + h) * 128 + v)) * L_ + (c * 64 + ks * 32 + fq * 8));
                acc[n] = __builtin_amdgcn_mfma_f32_16x16x32_bf16(af, bv, acc[n], 0, 0, 0);
                bf16x8 bs;
#pragma unroll
                for (int i = 0; i < 8; ++i) bs[i] = (short)f2bf(SST[(ks * 32 + fq * 8 + i) * 128 + v]);
                acc[n] = __builtin_amdgcn_mfma_f32_16x16x32_bf16(aq, bs, acc[n], 0, 0, 0);
            }
        }
#pragma unroll
        for (int n = 0; n < 4; ++n)
#pragma unroll
            for (int r = 0; r < 4; ++r) OS[(iblk * 16 + fq * 4 + r) * 132 + vb + n * 16 + fr] = acc[n][r];
    }
    __syncthreads();
    {
        const int i = tid >> 3, seg = tid & 7;
        float o[16]; float ss = 0.f;
#pragma unroll
        for (int q = 0; q < 16; ++q) { o[q] = OS[i * 132 + seg * 16 + q]; ss += o[q] * o[q]; }
        ss += __shfl_xor(ss, 1, 64); ss += __shfl_xor(ss, 2, 64); ss += __shfl_xor(ss, 4, 64);
        const float rs = rsqrtf(ss * (1.f / 128.f) + LN_EPS);
        const float* ng = p.gla_norm_g + (size_t)j * 128;
        bf16_t* CC = (bf16_t*)(p.ws + OFF_CC);
        const size_t t = (size_t)(t0 + i);
        unsigned w[8];
#pragma unroll
        for (int q = 0; q < 16; q += 2) {
            const int v0 = seg * 16 + q;
            const float r0 = bf2f(PE[t * PE_W + 512 + h * 128 + v0]), r1 = bf2f(PE[t * PE_W + 512 + h * 128 + v0 + 1]);
            const float a0 = o[q] * rs * ng[v0] * (r0 * sigmoidf_(r0)), a1 = o[q + 1] * rs * ng[v0 + 1] * (r1 * sigmoidf_(r1));
            w[q >> 1] = pk2(a0, a1);
        }
        u32x4 w0, w1; w0.x = w[0]; w0.y = w[1]; w0.z = w[2]; w0.w = w[3]; w1.x = w[4]; w1.y = w[5]; w1.z = w[6]; w1.w = w[7];
        *(u32x4*)(CC + t * 1024 + h * 128 + seg * 16) = w0;
        *(u32x4*)(CC + t * 1024 + h * 128 + seg * 16 + 8) = w1;
    }
    __syncthreads();
}

__device__ __forceinline__ void s5_g_phase(PRef p, int j, char* smem, int bid, int nb) {
    const bf16_t* UH = (const bf16_t*)(p.ws + OFF_UH);
    float* GB = (float*)(p.ws + OFF_GBUF);
    for (int t = bid; t < 64; t += nb) {
        const int g = t >> 1, mi = t & 1;
        const bf16_t* Bt = (const bf16_t*)(p.ws + OFF_GM) + (size_t)(j * 32 + g) * 128 * 1024;
        gemm_tile<false>(UH + (size_t)g * UHW, (long)32 * UHW, 0, mi * 256, Bt, 1024, 0, 1024, smem,
            [&](f32x4 (&acc)[4][2], int rt0, int c0, int fr, int fq) {
#pragma unroll
                for (int m = 0; m < 4; ++m)
#pragma unroll
                    for (int n = 0; n < 2; ++n)
#pragma unroll
                        for (int r = 0; r < 4; ++r) {
                            const int row = mi * 256 + rt0 + m * 16 + fq * 4 + r;
                            GB[((size_t)row * 32 + g) * 128 + c0 + n * 16 + fr] = acc[m][n][r];
                        }
            });
    }
}
__device__ __forceinline__ void s5_y_phase(PRef p, int j, char* smem, int bid, int nb) {
    const bf16_t* UH = (const bf16_t*)(p.ws + OFF_UH);
    bf16_t* YA = (bf16_t*)(p.ws + OFF_YA);
    const float* dsk = p.s5_d + (size_t)j * 512;
    XcdSeq sq(32 * 2 * 4, bid, nb);
    for (int t = sq.q; t < sq.qend; t += sq.step) {
        const int g = t >> 3, mi = (t >> 2) & 1, ni = t & 3;
        const bf16_t* Bt = (const bf16_t*)(p.ws + OFF_TH) + (size_t)(j * 32 + g) * 1024 * UHW;
        gemm256_tile<false>(UH + (size_t)g * UHW, (long)32 * UHW, 0, mi * 256, Bt, UHW, ni * 256, UHW, smem,
            [&](f32x4 (&acc)[4][2], int rt0, int c0, int fr, int fq) {
                const int col = c0 + 8 * fq;
                const int tau = col >> 4, nn = col & 15, ch = g * 16 + nn;
                const f32x4 d0 = *(const f32x4*)(dsk + ch), d1 = *(const f32x4*)(dsk + ch + 4);
#pragma unroll
                for (int m = 0; m < 4; ++m) {
                    const int row = mi * 256 + rt0 + m * 16 + fr;
                    const u32x4 uw = *(const u32x4*)(UH + ((size_t)row * 32 + g) * UHW + col);
                    float y[8];
#pragma unroll
                    for (int q = 0; q < 4; ++q) {
                        const unsigned u2 = q == 0 ? uw.x : q == 1 ? uw.y : q == 2 ? uw.z : uw.w;
                        const float u0 = __uint_as_float(u2 << 16), u1 = __uint_as_float(u2 & 0xffff0000u);
                        const float a0 = q < 2 ? acc[m][0][2 * q] : acc[m][1][2 * q - 4], a1 = q < 2 ? acc[m][0][2 * q + 1] : acc[m][1][2 * q - 3];
                        const float dd0 = q < 2 ? d0[2 * q] : d1[2 * q - 4], dd1 = q < 2 ? d0[2 * q + 1] : d1[2 * q - 3];
                        y[2 * q] = gelu_tanh(a0 + dd0 * u0); y[2 * q + 1] = gelu_tanh(a1 + dd1 * u1);
                    }
                    u32x4 w; w.x = pk2(y[0], y[1]); w.y = pk2(y[2], y[3]); w.z = pk2(y[4], y[5]); w.w = pk2(y[6], y[7]);
                    *(u32x4*)(YA + ((size_t)row * 64 + tau) * 512 + ch) = w;
                }
            });
    }
}

template <bool SLOTS, bool NOEPI = false>
__device__ __forceinline__ void ln_phase(PRef p, const bf16_t* xin, const float* addb, const float* g, const float* bta, float* xout, bf16_t* xb, int bid, int nb) {
    const int lane = otid() & 63, wave = otid() >> 6;
    for (int t = bid * 8 + wave; t < T_; t += nb * 8) {
        f32x4 v[4];
        float s = 0.f;
#pragma unroll
        for (int i = 0; i < 4; ++i) {
            const int c = i * 256 + lane * 4;
            f32x4 a;
            { const u32x2 xw = *(const u32x2*)(xin + (size_t)t * 1024 + c); a = (f32x4){__uint_as_float(xw.x << 16), __uint_as_float(xw.x & 0xffff0000u), __uint_as_float(xw.y << 16), __uint_as_float(xw.y & 0xffff0000u)}; }
            f32x4 m;
            if (SLOTS) {
                const bf16_t* sl = (const bf16_t*)addb;
                m = (f32x4){0.f, 0.f, 0.f, 0.f};
#pragma unroll
                for (int k = 0; k < 4; ++k) {
                    const u32x2 w = *(const u32x2*)(sl + ((size_t)t * 4 + k) * 1024 + c);
                    m[0] += __uint_as_float(w.x << 16); m[1] += __uint_as_float(w.x & 0xffff0000u); m[2] += __uint_as_float(w.y << 16); m[3] += __uint_as_float(w.y & 0xffff0000u);
                }
            } else m = *(const f32x4*)(addb + (size_t)t * 1024 + c);
            v[i] = a * ALPHA + m;
            s += v[i][0] + v[i][1] + v[i][2] + v[i][3];
        }
        const float mu = wave_sum(s) * (1.f / 1024.f);
        float q = 0.f;
#pragma unroll
        for (int i = 0; i < 4; ++i) { v[i] -= mu; q += v[i][0] * v[i][0] + v[i][1] * v[i][1] + v[i][2] * v[i][2] + v[i][3] * v[i][3]; }
        const float rs = rsqrtf(wave_sum(q) * (1.f / 1024.f) + LN_EPS);
#pragma unroll
        for (int i = 0; i < 4; ++i) {
            const int c = i * 256 + lane * 4;
            const f32x4 gg = *(const f32x4*)(g + c), bb = *(const f32x4*)(bta + c);
            const f32x4 o = v[i] * rs * gg + bb;
            if (xout && (!NOEPI || rs == -1.f)) *(f32x4*)(xout + (size_t)t * 1024 + c) = o;
            if (xb && (!NOEPI || rs == -1.f)) { u32x2 w; w.x = pk2(o[0], o[1]); w.y = pk2(o[2], o[3]); *(u32x2*)(xb + (size_t)t * 1024 + c) = w; }
        }
    }
}

constexpr int RT_STRIDE = 36;
constexpr int RT_SCR_OFF = 1024 * RT_STRIDE * 4;
template <bool NOEPI = false>
__device__ __forceinline__ void ln1_router_phase(PRef p, int layer, char* smem, int bid, int nb) {
    float* wl = (float*)smem;
    const int tid = otid(), lane = tid & 63, wave = tid >> 6;
    float* lgs = (float*)(smem + RT_SCR_OFF + wave * 640);
    int* pick = (int*)(lgs + 32);
    float* pgate = (float*)(pick + 64);
    {
        const float* rw = p.router_w + (size_t)layer * 1024 * 32;
        for (int e = tid; e < 32768; e += NTHR) {
            const int k = e >> 5, ex = e & 31, rem = k & 255;
            wl[((k & ~255) + (rem & 3) * 64 + (rem >> 2)) * RT_STRIDE + ex] = rw[e];
        }
    }
    __syncthreads();
    const bf16_t* addb = (const bf16_t*)(p.ws + OFF_MIX);
    const float* g = p.ln1_g + (size_t)layer * 1024; const float* bta = p.ln1_b + (size_t)layer * 1024;
    bf16_t* xb = (bf16_t*)(p.ws + OFF_XB);
    const bf16_t* xin = xb;
    int* cnt = (int*)(p.ws + OFF_CNT) + layer * 32;
    int* LIST = (int*)(p.ws + OFF_LIST);
    float* GATE = (float*)(p.ws + OFF_GATE);
    const float rbias = p.router_b[(size_t)layer * 32 + (lane >> 1)];
    const int rstep = nb * 8;
    u32x2 xw[2][4], mw[2][4];
#define ROWLOAD(T, R) do { _Pragma("unroll") for (int i_ = 0; i_ < 4; ++i_) { const int c_ = i_ * 256 + lane * 4; xw[R][i_] = *(const u32x2*)(xin + (size_t)(T) * 1024 + c_); mw[R][i_] = *(const u32x2*)(addb + (size_t)(T) * 1024 + c_); } } while (0)
    {
        const int t0 = bid * 8 + wave;
        if (t0 < T_) ROWLOAD(t0, 0);
        if (t0 + rstep < T_) ROWLOAD(t0 + rstep, 1);
    }
    for (int tb = bid * 8 + wave; tb < T_; tb += rstep * 16) {
        int nrow = 0;
#pragma unroll 1
        for (int t = tb; t < T_ && nrow < 16; t += 2 * rstep) {
            const bool has1 = t + rstep < T_;
            f32x4 v[2][4];
            float s[2];
#pragma unroll
            for (int r = 0; r < 2; ++r) {
                s[r] = 0.f;
#pragma unroll
                for (int i = 0; i < 4; ++i) {
                    const f32x4 a = (f32x4){__uint_as_float(xw[r][i].x << 16), __uint_as_float(xw[r][i].x & 0xffff0000u), __uint_as_float(xw[r][i].y << 16), __uint_as_float(xw[r][i].y & 0xffff0000u)};
                    const f32x4 m = (f32x4){__uint_as_float(mw[r][i].x << 16), __uint_as_float(mw[r][i].x & 0xffff0000u), __uint_as_float(mw[r][i].y << 16), __uint_as_float(mw[r][i].y & 0xffff0000u)};
                    v[r][i] = a * ALPHA + m; s[r] += v[r][i][0] + v[r][i][1] + v[r][i][2] + v[r][i][3];
                }
            }
            if (t + 2 * rstep < T_) ROWLOAD(t + 2 * rstep, 0);
            if (t + 3 * rstep < T_) ROWLOAD(t + 3 * rstep, 1);
#pragma unroll
            for (int r = 0; r < 2; ++r) {
                const float mu = wave_sum(s[r]) * (1.f / 1024.f);
                float q = 0.f;
#pragma unroll
                for (int i = 0; i < 4; ++i) { v[r][i] -= mu; q += v[r][i][0] * v[r][i][0] + v[r][i][1] * v[r][i][1] + v[r][i][2] * v[r][i][2] + v[r][i][3] * v[r][i][3]; }
                const float rs = rsqrtf(wave_sum(q) * (1.f / 1024.f) + LN_EPS);
#pragma unroll
                for (int i = 0; i < 4; ++i) {
                    const int c = i * 256 + lane * 4;
                    const f32x4 gg = *(const f32x4*)(g + c), bb = *(const f32x4*)(bta + c);
                    v[r][i] = v[r][i] * rs * gg + bb;
                    if ((r == 0 || has1) && (!NOEPI || rs == -1.f)) {
                    u32x2 w; w.x = pk2(v[r][i][0], v[r][i][1]); w.y = pk2(v[r][i][2], v[r][i][3]); *(u32x2*)(xb + (size_t)(t + r * rstep) * 1024 + c) = w; }
                }
            }
            f32x4 acc[2][8];
#pragma unroll
            for (int e = 0; e < 8; ++e) { acc[0][e] = (f32x4){0.f, 0.f, 0.f, 0.f}; acc[1][e] = (f32x4){0.f, 0.f, 0.f, 0.f}; }
#pragma unroll
            for (int i = 0; i < 4; ++i)
#pragma unroll
                for (int j = 0; j < 4; ++j) {
                    const f32x4* wr_ = (const f32x4*)(wl + (i * 256 + j * 64 + lane) * RT_STRIDE);
                    const float xv0 = v[0][i][j], xv1 = v[1][i][j];
#pragma unroll
                    for (int e = 0; e < 8; ++e) { const f32x4 w = wr_[e]; acc[0][e] += w * xv0; acc[1][e] += w * xv1; }
                    if (j & 1) __builtin_amdgcn_sched_barrier(0);
                }
#pragma unroll
            for (int e = 0; e < 8; ++e)
#pragma unroll
                for (int k = 0; k < 4; ++k) { float a0 = acc[0][e][k], a1 = acc[1][e][k]; asm volatile("" : "+v"(a0), "+v"(a1)); acc[0][e][k] = a0; acc[1][e][k] = a1; }
#pragma unroll
            for (int r = 0; r < 2; ++r) {
                float k16[16], k8[8], k4[4], k2[2];
#pragma unroll
                for (int a = 0; a < 16; ++a) { auto rr = __builtin_amdgcn_permlane32_swap(__float_as_uint(acc[r][a >> 2][a & 3]), __float_as_uint(acc[r][(a + 16) >> 2][a & 3]), false, false); k16[a] = __uint_as_float(rr[0]) + __uint_as_float(rr[1]); }
#pragma unroll
                for (int a = 0; a < 8; ++a) { auto rr = __builtin_amdgcn_permlane16_swap(__float_as_uint(k16[a]), __float_as_uint(k16[a + 8]), false, false); k8[a] = __uint_as_float(rr[0]) + __uint_as_float(rr[1]); }
                { const bool hb = lane & 8;
#pragma unroll
                  for (int a = 0; a < 4; ++a) { const float mine = hb ? k8[a + 4] : k8[a], send = hb ? k8[a] : k8[a + 4]; k4[a] = mine + dppf<DPP_ROR8>(send); } }
                { const bool hb = lane & 4;
#pragma unroll
                  for (int a = 0; a < 2; ++a) { const float mine = hb ? k4[a + 2] : k4[a], send = hb ? k4[a] : k4[a + 2]; k2[a] = mine + dppf<DPP_HMIR>(send); } }
                float lg;
                { const bool hb = lane & 2; const float mine = hb ? k2[1] : k2[0], send = hb ? k2[0] : k2[1]; lg = mine + dppf<DPP_X2>(send); }
                lg += dppf<DPP_X1>(lg);
                lg += rbias;
                float cand = (lane & 1) ? -INFINITY : lg;
                float tv[4]; int te[4];
#pragma unroll
                for (int k = 0; k < 4; ++k) {
                    const float mxv = wave_max(cand);
                    const unsigned long long bal = __builtin_amdgcn_ballot_w64(cand == mxv);
                    const int first = __builtin_ctzll(bal);
                    tv[k] = mxv; te[k] = first >> 1;
                    if (lane == first) cand = -INFINITY;
                }
                if (lane == 0 && (r == 0 || has1)) {
                    const float e1 = __expf(tv[1] - tv[0]), e2 = __expf(tv[2] - tv[0]), e3 = __expf(tv[3] - tv[0]);
                    const float inv = 1.f / (1.f + e1 + e2 + e3);
                    const int nr = nrow + r;
                    pick[nr * 4 + 0] = te[0]; pick[nr * 4 + 1] = te[1]; pick[nr * 4 + 2] = te[2]; pick[nr * 4 + 3] = te[3];
                    pgate[nr * 4 + 0] = inv; pgate[nr * 4 + 1] = e1 * inv; pgate[nr * 4 + 2] = e2 * inv; pgate[nr * 4 + 3] = e3 * inv;
                }
            }
            nrow += has1 ? 2 : 1;
        }
        if ((lane >> 2) < nrow && (!NOEPI || pgate[lane] < -1.f)) {
            const int t = tb + (lane >> 2) * rstep, ex = pick[lane], pair = t * 4 + (lane & 3);
            const int pos = atomicAdd(&cnt[ex], 1);
            LIST[(size_t)ex * LISTCAP + pos] = pair;
            GATE[pair] = pgate[lane];
        }
    }
}

__device__ __forceinline__ void topk_phase(PRef p, int layer, int bid, int nb) {
    const float* LG = (const float*)(p.ws + OFF_LOGIT);
    int* cnt = (int*)(p.ws + OFF_CNT) + layer * 32;
    int* LIST = (int*)(p.ws + OFF_LIST);
    float* GATE = (float*)(p.ws + OFF_GATE);
    for (int t = bid * NTHR + otid(); t < T_; t += nb * NTHR) {
        float v0 = -INFINITY, v1 = -INFINITY, v2 = -INFINITY, v3 = -INFINITY; int i0 = 0, i1 = 0, i2 = 0, i3 = 0;
#pragma unroll
        for (int q = 0; q < 8; ++q) {
            const f32x4 l4 = *(const f32x4*)(LG + (size_t)t * 32 + q * 4);
#pragma unroll
            for (int r = 0; r < 4; ++r) {
                const float v = l4[r]; const int e = q * 4 + r;
                if (v > v0) { v3 = v2; i3 = i2; v2 = v1; i2 = i1; v1 = v0; i1 = i0; v0 = v; i0 = e; }
                else if (v > v1) { v3 = v2; i3 = i2; v2 = v1; i2 = i1; v1 = v; i1 = e; }
                else if (v > v2) { v3 = v2; i3 = i2; v2 = v; i2 = e; }
                else if (v > v3) { v3 = v; i3 = e; }
            }
        }
        const float e1 = __expf(v1 - v0), e2 = __expf(v2 - v0), e3 = __expf(v3 - v0);
        const float inv = 1.f / (1.f + e1 + e2 + e3);
        int pos;
        pos = atomicAdd(&cnt[i0], 1); LIST[(size_t)i0 * LISTCAP + pos] = t * 4 + 0; GATE[t * 4 + 0] = inv;
        pos = atomicAdd(&cnt[i1], 1); LIST[(size_t)i1 * LISTCAP + pos] = t * 4 + 1; GATE[t * 4 + 1] = e1 * inv;
        pos = atomicAdd(&cnt[i2], 1); LIST[(size_t)i2 * LISTCAP + pos] = t * 4 + 2; GATE[t * 4 + 2] = e2 * inv;
        pos = atomicAdd(&cnt[i3], 1); LIST[(size_t)i3 * LISTCAP + pos] = t * 4 + 3; GATE[t * 4 + 3] = e3 * inv;
    }
}

template <int WHICH, bool NOEPI = false>
__device__ __forceinline__ void moe_gemm_phase(PRef p, int layer, char* smem, int bid, int nb) {
    const int* cnt = (const int*)(p.ws + OFF_CNT) + layer * 32;
    const int* LIST = (const int*)(p.ws + OFF_LIST);
    constexpr int NTN = WHICH == 1 ? 8 : 4;
    int total = 0;
    for (int i = 0; i < 32; ++i) total += ((cnt[i] + 255) >> 8) * NTN;
    XcdSeq sq(total, bid, nb);
    int e = 0, base = 0, ce = cnt[0], mt = (ce + 255) >> 8;
    auto src = [&](int i, G8Desc& d) -> bool {
        const int t = sq.q + i * sq.step;
        if (t >= sq.qend) return false;
        while (e < 32 && t >= base + mt * NTN) { base += mt * NTN; ++e; if (e < 32) { ce = cnt[e]; mt = (ce + 255) >> 8; } }
        if (e >= 32) return false;
        int mi, ni;
        { const int loc = t - base, pf = mt >> 2, full = pf * 4 * NTN;
          if (loc < full) { const int pn = loc / (4 * NTN), r = loc - pn * 4 * NTN; ni = r >> 2; mi = pn * 4 + (r & 3); }
          else { const int ph = mt - pf * 4, r = loc - full; ni = r / ph; mi = pf * 4 + (r - ni * ph); } }
        d.m0 = 0; d.n0 = ni * 256; d.list = LIST + (size_t)e * LISTCAP + mi * 256; d.count = ce - mi * 256; d.u0 = e; d.ldb = 1024;
        if (WHICH == 1) { d.A = (const bf16_t*)(p.ws + OFF_XB); d.Bt = (const bf16_t*)(p.ws + OFF_WT_W1) + (size_t)(layer * 32 + e) * 2048 * 1024; }
        else { d.A = (const bf16_t*)(p.ws + OFF_ACT); d.Bt = (const bf16_t*)(p.ws + OFF_WT_W2) + (size_t)(layer * 32 + e) * 1024 * 1024; }
        return true; };
    if (WHICH == 1) {
        bf16_t* ACT = (bf16_t*)(p.ws + OFF_ACT);
        gemm256_stream<true, 2>(src, 1024, 1024, smem,
            [&](int, int e_, f32x4 (&acc)[4][2], int rt0, int c0, int fr, int fq, const int* sRow) {
                const float* b1 = p.moe_b1 + (size_t)(layer * 32 + e_) * 2048;
                const int gcol = (c0 >> 5) * 16 + 4 * fq;
                const f32x4 bg = *(const f32x4*)(b1 + gcol), bl = *(const f32x4*)(b1 + 1024 + gcol);
#pragma unroll
                for (int m = 0; m < 4; ++m) {
                    const int pair = NOEPI ? -1 : sRow[rt0 + m * 16 + fr];
                    if (pair >= 0) {
                        float a[4];
#pragma unroll
                        for (int r = 0; r < 4; ++r) {
                            const float gl = fminf(acc[m][0][r] + bg[r], 7.f);
                            const float li = fminf(fmaxf(acc[m][1][r] + bl[r], -7.f), 7.f);
                            a[r] = gl * sigmoidf_(1.702f * gl) * (li + 1.f);
                        }
                        u32x2 w; w.x = pk2(a[0], a[1]); w.y = pk2(a[2], a[3]);
                        *(u32x2*)(ACT + (size_t)pair * 1024 + gcol) = w;
                    }
                }
            });
    } else {
        const float* GATE = (const float*)(p.ws + OFF_GATE);
        bf16_t* SLOT = (bf16_t*)(p.ws + OFF_SLOT);
        gemm256_stream<true, 0>(src, 1024, 1024, smem,
            [&](int, int e_, f32x4 (&acc)[4][2], int rt0, int c0, int fr, int fq, const int* sRow) {
                const float* b2 = p.moe_b2 + (size_t)(layer * 32 + e_) * 1024;
                const int col = c0 + 8 * fq;
                const f32x4 b20 = *(const f32x4*)(b2 + col), b21 = *(const f32x4*)(b2 + col + 4);
#pragma unroll
                for (int m = 0; m < 4; ++m) {
                    const int pair = NOEPI ? -1 : sRow[rt0 + m * 16 + fr];
                    if (pair >= 0) {
                        const float gt = GATE[pair];
                        const f32x4 y0 = (acc[m][0] + b20) * gt, y1 = (acc[m][1] + b21) * gt;
                        u32x4 w; w.x = pk2(y0[0], y0[1]); w.y = pk2(y0[2], y0[3]); w.z = pk2(y1[0], y1[1]); w.w = pk2(y1[2], y1[3]);
                        *(u32x4*)(SLOT + (size_t)pair * 1024 + col) = w;
                    }
                }
            });
    }
}

__device__ __forceinline__ void epi_od_in(PRef p, f32x4 (&acc)[4][2], int row0, int c0, int fr, int fq) {
    char* ws = p.ws;
    bf16_t* PO = (bf16_t*)(ws + OFF_PO); float* WI = (float*)(ws + OFF_WI);
    const int col = c0 + 8 * fq;
#pragma unroll
    for (int m = 0; m < 4; ++m) {
        const int t = row0 + m * 16 + fr;
        if (c0 < OD_WI) {
            u32x4 w; w.x = pk2(acc[m][0][0], acc[m][0][1]); w.y = pk2(acc[m][0][2], acc[m][0][3]); w.z = pk2(acc[m][1][0], acc[m][1][1]); w.w = pk2(acc[m][1][2], acc[m][1][3]);
            *(u32x4*)(PO + (size_t)t * OD_P + col) = w;
        } else if (col == OD_WI) {
            *(f32x4*)(WI + (size_t)t * 4) = acc[m][0];
        }
    }
}

__device__ __forceinline__ void idx_scores(const char* __restrict__ ktile, int kbase, const bf16x8 (&qf)[4][4], const float (&wi)[4], int lane, float (&sc)[16]) {
    const int r = lane & 31, h2 = lane >> 5;
    const char* kp = ktile + (kbase + r) * 144 + h2 * 16;
    bf16x8 kf[4];
#pragma unroll
    for (int s = 0; s < 4; ++s) kf[s] = *(const bf16x8*)(kp + s * 32);
#pragma unroll
    for (int i = 0; i < 16; ++i) sc[i] = 0.f;
#pragma unroll
    for (int hd = 0; hd < 4; ++hd) {
        f32x16 a;
#pragma unroll
        for (int i = 0; i < 16; ++i) a[i] = 0.f;
#pragma unroll
        for (int s = 0; s < 4; ++s) a = __builtin_amdgcn_mfma_f32_32x32x16_bf16(kf[s], qf[hd][s], a, 0, 0, 0);
#pragma unroll
        for (int i = 0; i < 16; ++i) { const int ai = __float_as_int(a[i]); sc[i] += wi[hd] * __int_as_float(ai > 0 ? ai : 0); }
    }
}
__device__ __forceinline__ unsigned ord_key(float s) {
    const unsigned u = __float_as_uint(s);
    return u ^ ((unsigned)((int)u >> 31) | 0x80000000u);
}

constexpr int SEL_KT = 128 * 144;
__device__ __forceinline__ void dsa_select_item(PRef p, int b, int qb, char* smem) {
    unsigned* hist = (unsigned*)smem;
    unsigned* pref = (unsigned*)(smem + 66048);
    int* krem = (int*)(smem + 66048 + 256);
    unsigned* GW = (unsigned*)(smem + 66048 + 512);
    unsigned* EW = (unsigned*)(smem + 66048 + 512 + 2048);
    char* kbuf = smem + 71680;
    const bf16_t* PO = (const bf16_t*)(p.ws + OFF_PO);
    const float* WI = (const float*)(p.ws + OFF_WI);
    unsigned long long* BMT = (unsigned long long*)(p.ws + OFF_BM);
    const int tid = otid(), lane = tid & 63, wave = tid >> 6, kw = wave >> 1, qw = wave & 1, h2 = lane >> 5;
    const int p0 = qb * 64;
    const int ql = qw * 32 + (lane & 31);
    const int qpos = p0 + ql;
    const size_t tq = (size_t)b * L_ + qpos;
    const int nkt = (p0 + 64 + 127) >> 7;
    bf16x8 qf[4][4]; float wi[4];
#pragma unroll
    for (int hd = 0; hd < 4; ++hd) {
        wi[hd] = WI[tq * 4 + hd];
#pragma unroll
        for (int s = 0; s < 4; ++s) qf[hd][s] = *(const bf16x8*)(PO + tq * OD_P + OD_QI + hd * 64 + s * 16 + h2 * 8);
    }
    const int srow = tid >> 3, sch = tid & 7;
    const bf16_t* ksrc = PO + ((size_t)b * L_ + srow) * OD_P + OD_KI + sch * 8;
    char* kdst = kbuf + srow * 144 + sch * 16;
    for (int e = tid; e < 64 * 257; e += NTHR) hist[e] = 0u;
    if (tid < 64) { pref[tid] = 0u; krem[tid] = 256; }
    __syncthreads();
    const bool selall = qpos < 256;
    const int npass = (p0 + 63 >= 256) ? 3 : 0;
    for (int pass = 0; pass <= npass; ++pass) {
        const bool maskpass = pass == npass;
        const int sh = 24 - 8 * pass;
        const unsigned mypref = pref[ql];
        int ceq = 0;
        const int rsel = tid < 64 ? krem[tid] : 0;
        const int npair = (nkt + 1) >> 1;
        u32x4 r0, r1, r2 = (u32x4){0u, 0u, 0u, 0u}, r3 = r2;
        r0 = *(const u32x4*)ksrc; r1 = *(const u32x4*)(ksrc + (size_t)64 * OD_P);
        if (nkt > 1) { r2 = *(const u32x4*)(ksrc + (size_t)128 * OD_P); r3 = *(const u32x4*)(ksrc + (size_t)192 * OD_P); }
        *(u32x4*)kdst = r0; *(u32x4*)(kdst + 64 * 144) = r1; *(u32x4*)(kdst + SEL_KT) = r2; *(u32x4*)(kdst + SEL_KT + 64 * 144) = r3;
        __syncthreads();
        for (int kp = 0; kp < npair; ++kp) {
            const bool more = kp + 1 < npair;
            const bool more2 = 2 * kp + 3 < nkt;
            if (more) {
                r0 = *(const u32x4*)(ksrc + (size_t)(2 * kp + 2) * 128 * OD_P); r1 = *(const u32x4*)(ksrc + (size_t)((2 * kp + 2) * 128 + 64) * OD_P);
                if (more2) { r2 = *(const u32x4*)(ksrc + (size_t)(2 * kp + 3) * 128 * OD_P); r3 = *(const u32x4*)(ksrc + (size_t)((2 * kp + 3) * 128 + 64) * OD_P); }
            }
            const char* kcur = kbuf + (kp & 1) * 2 * SEL_KT;
            const bool two = 2 * kp + 1 < nkt;
            unsigned gwp[2] = {0u, 0u}, ewp[2] = {0u, 0u};
#pragma unroll
            for (int tt = 0; tt < 2; ++tt) {
                if (tt == 1 && !two) break;
                const int kt = 2 * kp + tt;
                float sc[16];
                idx_scores(kcur + tt * SEL_KT, kw * 32, qf, wi, lane, sc);
                const int keybase = kt * 128 + kw * 32;
                const bool diag = kt == nkt - 1;
                if (!maskpass) {
                    if (pass == 0 && !diag && p0 >= 256) {
#pragma unroll
                        for (int i = 0; i < 16; ++i) atomicAdd(&hist[ql * 257 + (ord_key(sc[i]) >> 24)], 1u);
                    } else {
#pragma unroll
                        for (int i = 0; i < 16; ++i) {
                            const int key = keybase + (i & 3) + 8 * (i >> 2) + 4 * h2;
                            const unsigned k32 = ord_key(sc[i]);
                            const bool match = pass == 0 ? true : ((k32 >> (sh + 8)) == mypref);
                            const bool valid = diag ? key <= qpos : true;
                            if (valid && !selall && match) atomicAdd(&hist[ql * 257 + ((k32 >> sh) & 255u)], 1u);
                        }
                    }
                } else {
                    unsigned gw = 0u, ew = 0u;
#pragma unroll
                    for (int i = 0; i < 16; ++i) {
                        const int ko = (i & 3) + 8 * (i >> 2) + 4 * h2;
                        const int key = keybase + ko;
                        const unsigned k24 = ord_key(sc[i]) >> 8;
                        const bool valid = diag ? key <= qpos : true;
                        const bool g = valid && (selall || k24 > mypref);
                        const bool e = valid && !selall && k24 == mypref;
                        gw |= (g ? 1u : 0u) << ko; ew |= (e ? 1u : 0u) << ko;
                    }
                    gwp[tt] = xor32_or(gw); ewp[tt] = xor32_or(ew);
                }
            }
            if (maskpass && h2 == 0) { GW[ql * 8 + kw] = gwp[0]; EW[ql * 8 + kw] = ewp[0]; GW[ql * 8 + 4 + kw] = gwp[1]; EW[ql * 8 + 4 + kw] = ewp[1]; }
            if (more) {
                char* nd = kdst + ((kp + 1) & 1) * 2 * SEL_KT;
                *(u32x4*)nd = r0; *(u32x4*)(nd + 64 * 144) = r1;
                if (more2) { *(u32x4*)(nd + SEL_KT) = r2; *(u32x4*)(nd + SEL_KT + 64 * 144) = r3; }
            }
            __syncthreads();
            if (maskpass) {
                if (tid < 64) {
#pragma unroll
                    for (int tt = 0; tt < 2; ++tt) {
                        if (tt == 1 && !two) break;
                        const int kt = 2 * kp + tt;
                        unsigned g4[4], e4[4];
#pragma unroll
                        for (int w = 0; w < 4; ++w) { g4[w] = GW[tid * 8 + tt * 4 + w]; e4[w] = EW[tid * 8 + tt * 4 + w]; }
                        int need = rsel - ceq; if (need < 0) need = 0;
#pragma unroll
                        for (int w = 0; w < 4; ++w) {
                            const int pc = __popc(e4[w]);
                            ceq += pc;
                            if (need >= pc) need -= pc;
                            else { unsigned m = e4[w], kept = 0u; for (int k = 0; k < need; ++k) { const unsigned low = m & (0u - m); kept |= low; m ^= low; } e4[w] = kept; need = 0; }
                            g4[w] |= e4[w];
                        }
                        BMT[((size_t)(b * 256 + 2 * kt)) * L_ + p0 + tid] = (unsigned long long)g4[0] | ((unsigned long long)g4[1] << 32);
                        BMT[((size_t)(b * 256 + 2 * kt + 1)) * L_ + p0 + tid] = (unsigned long long)g4[2] | ((unsigned long long)g4[3] << 32);
                    }
                }
                __syncthreads();
            }
        }
        if (!maskpass) {
            const int q = tid >> 3, part = tid & 7;
            unsigned c32[32]; unsigned tot = 0u;
#pragma unroll
            for (int i = 0; i < 32; ++i) { c32[i] = hist[q * 257 + part * 32 + i]; tot += c32[i]; }
            unsigned above = 0u;
#pragma unroll
            for (int d = 1; d < 8; ++d) { const unsigned o = __shfl(tot, (lane & ~7) + ((part + d) & 7), 64); if (part + d < 8) above += o; }
            const unsigned need = (unsigned)krem[q];
            __syncthreads();
            if ((p0 + q) >= 256 && above < need && above + tot >= need) {
                unsigned cum = above; int dg = 31;
#pragma unroll
                for (int i = 31; i >= 0; --i) { if (i == dg) { if (cum + c32[i] >= need) {   } else { cum += c32[i]; dg = i - 1; } } }
                pref[q] = (pref[q] << 8) | (unsigned)(part * 32 + dg);
                krem[q] = (int)(need - cum);
            }
            for (int e = tid; e < 64 * 257; e += NTHR) hist[e] = 0u;
            __syncthreads();
        }
    }
}

template <int MODE, int NQT>
__device__ __forceinline__ void attn_wave(PRef p, int b, int head, int qcol, int kcol, const bf16_t* __restrict__ VT, int voff,
                                          int i0, int sh  , int rho, int kt_lo, int kt_hi, int grp) {
    const bf16_t* PO = (const bf16_t*)(p.ws + OFF_PO);
    const unsigned* BM32 = (const unsigned*)(p.ws + OFF_BM);
    const int lane = otid() & 63, r = lane & 31, h2 = lane >> 5;
    const int pr = (r & 0x13) | ((r & 4) << 1) | ((r & 8) >> 1);
    const float SC = 0.125f * 1.4426950408889634f;
    bf16x8 qf[NQT][4]; size_t tq[NQT]; int qi[NQT];
#pragma unroll
    for (int qt = 0; qt < NQT; ++qt) {
        qi[qt] = i0 + qt * 32 + r;
        tq[qt] = (size_t)b * L_ + ((size_t)qi[qt] << sh) + rho;
#pragma unroll
        for (int s = 0; s < 4; ++s) qf[qt][s] = *(const bf16x8*)(PO + tq[qt] * OD_P + qcol + head * 64 + s * 16 + h2 * 8);
    }
    f32x16 oacc[NQT][2];
#pragma unroll
    for (int a = 0; a < NQT; ++a)
#pragma unroll
        for (int c = 0; c < 2; ++c)
#pragma unroll
            for (int i = 0; i < 16; ++i) oacc[a][c][i] = 0.f;
    float mrun[NQT], lrun[NQT];
#pragma unroll
    for (int a = 0; a < NQT; ++a) { mrun[a] = -64.f; lrun[a] = 0.f; }
    bf16x8 kf[4]; unsigned mw[NQT];
    auto load_k = [&](int kt, bf16x8 (&k_)[4], unsigned (&m_)[NQT]) {
        const size_t krow = (size_t)b * L_ + ((size_t)(kt * 32 + pr) << sh) + rho;
#pragma unroll
        for (int s = 0; s < 4; ++s) k_[s] = *(const bf16x8*)(PO + krow * OD_P + kcol + head * 64 + s * 16 + h2 * 8);
#pragma unroll
        for (int a = 0; a < NQT; ++a) m_[a] = MODE == 0 ? BM32[tq[a] * 512 + kt] : 0u;
    };
    load_k(kt_lo, kf, mw);
#pragma unroll 1
    for (int kt = kt_lo; kt <= kt_hi; ++kt) {
        bf16x8 vf[2][2];
#pragma unroll
        for (int db = 0; db < 2; ++db)
#pragma unroll
            for (int s2 = 0; s2 < 2; ++s2) vf[db][s2] = *(const bf16x8*)(VT + (size_t)(db * 32 + r) * L_ + voff + kt * 32 + s2 * 16 + h2 * 8);
        bf16x8 kn[4]; unsigned mn[NQT];
#pragma unroll
        for (int a = 0; a < NQT; ++a) mn[a] = 0u;
        if (kt < kt_hi) load_k(kt + 1, kn, mn);
#pragma unroll
        for (int qt = 0; qt < NQT; ++qt) {
            f32x16 s;
#pragma unroll
            for (int i = 0; i < 16; ++i) s[i] = 0.f;
#pragma unroll
            for (int ks = 0; ks < 4; ++ks) s = __builtin_amdgcn_mfma_f32_32x32x16_bf16(kf[ks], qf[qt][ks], s, 0, 0, 0);
            unsigned wsel;
            if (MODE == 0) wsel = mw[qt];
            else {
                const int hi = qi[qt] - kt * 32, lo = hi - 128;
                const unsigned mh = hi < 0 ? 0u : (hi >= 31 ? 0xffffffffu : ((2u << hi) - 1u)), ml = lo <= 0 ? 0xffffffffu : (lo > 31 ? 0u : ~((1u << lo) - 1u));
                wsel = mh & ml;
            }
#pragma unroll
            for (int i = 0; i < 16; ++i) s[i] = __builtin_fmaf(s[i], SC, -mrun[qt]);
            float mx = fmaxf(fmaxf(s[0], s[1]), fmaxf(s[2], s[3]));
#pragma unroll
            for (int i = 4; i < 16; i += 2) mx = fmaxf(mx, fmaxf(s[i], s[i + 1]));
            mx = xor32_max(mx);
            if (__builtin_amdgcn_ballot_w64(mx > 0.f) != 0ull) {
                const float dlt = fmaxf(mx, 0.f);
                const float corr = __builtin_amdgcn_exp2f(-dlt);
                mrun[qt] += dlt; lrun[qt] *= corr;
#pragma unroll
                for (int db = 0; db < 2; ++db)
#pragma unroll
                    for (int i = 0; i < 16; ++i) oacc[qt][db][i] *= corr;
#pragma unroll
                for (int i = 0; i < 16; ++i) s[i] -= dlt;
            }
            float ps = 0.f;
            const int mws = (int)(wsel >> (8 * h2));
#define DA_P(i, KO) { const float e = __builtin_amdgcn_exp2f(s[i]); s[i] = __uint_as_float(__float_as_uint(e) & bitmask32<KO>(mws)); ps += s[i]; }
            DA_P(0, 0) DA_P(1, 1) DA_P(2, 2) DA_P(3, 3) DA_P(4, 4) DA_P(5, 5) DA_P(6, 6) DA_P(7, 7)
            DA_P(8, 16) DA_P(9, 17) DA_P(10, 18) DA_P(11, 19) DA_P(12, 20) DA_P(13, 21) DA_P(14, 22) DA_P(15, 23)
#undef DA_P
            lrun[qt] += ps;
#pragma unroll
            for (int s2 = 0; s2 < 2; ++s2) {
                u32x4 pw; pw.x = pk2(s[8 * s2], s[8 * s2 + 1]); pw.y = pk2(s[8 * s2 + 2], s[8 * s2 + 3]); pw.z = pk2(s[8 * s2 + 4], s[8 * s2 + 5]); pw.w = pk2(s[8 * s2 + 6], s[8 * s2 + 7]);
                const bf16x8 pf = __builtin_bit_cast(bf16x8, pw);
#pragma unroll
                for (int db = 0; db < 2; ++db) oacc[qt][db] = __builtin_amdgcn_mfma_f32_32x32x16_bf16(vf[db][s2], pf, oacc[qt][db], 0, 0, 0);
            }
        }
        if (kt < kt_hi) {
#pragma unroll
            for (int s = 0; s < 4; ++s) kf[s] = kn[s];
#pragma unroll
            for (int a = 0; a < NQT; ++a) mw[a] = mn[a];
        }
    }
#pragma unroll
    for (int qt = 0; qt < NQT; ++qt) {
        const float lt = xor32_sum(lrun[qt]);
        const float inv = 1.f / lt;
        if (MODE == 0) {
            bf16_t* CC = (bf16_t*)(p.ws + OFF_CC);
#pragma unroll
            for (int db = 0; db < 2; ++db)
#pragma unroll
                for (int i = 0; i < 16; ++i) {
                    const int d = db * 32 + (i & 3) + 8 * (i >> 2) + 4 * h2;
                    CC[tq[qt] * 1024 + head * 64 + d] = f2bf(oacc[qt][db][i] * inv);
                }
        } else {
            bf16_t* OD = (bf16_t*)(p.ws + OFF_OD) + (size_t)grp * T_ * 512;
#pragma unroll
            for (int db = 0; db < 2; ++db)
#pragma unroll
                for (int i = 0; i < 16; i += 4) {
                    const int d = db * 32 + 8 * (i >> 2) + 4 * h2;
                    { u32x2 w; w.x = pk2(oacc[qt][db][i] * inv, oacc[qt][db][i + 1] * inv); w.y = pk2(oacc[qt][db][i + 2] * inv, oacc[qt][db][i + 3] * inv); *(u32x2*)(OD + tq[qt] * 512 + head * 64 + d) = w; }
                }
            if (h2 == 0) ((float*)(p.ws + OFF_LSE))[((size_t)grp * T_ + tq[qt]) * 8 + head] = mrun[qt] + log2f(lt);
        }
    }
}

__device__ __forceinline__ void dil_combine_phase(PRef p, int bid, int nb) {
    const bf16_t* OD = (const bf16_t*)(p.ws + OFF_OD); const float* LSE = (const float*)(p.ws + OFF_LSE);
    bf16_t* CC = (bf16_t*)(p.ws + OFF_CC);
    const long n = (long)T_ * 128;
    for (long c = (long)bid * NTHR + otid(); c < n; c += (long)nb * NTHR) {
        const long t = c >> 7; const int ch = (int)(c & 127) * 4, hd = ch >> 6;
        const float l0 = LSE[((size_t)0 * T_ + t) * 8 + hd], l1 = LSE[((size_t)1 * T_ + t) * 8 + hd], l2 = LSE[((size_t)2 * T_ + t) * 8 + hd];
        const float mx = fmaxf(l0, fmaxf(l1, l2));
        const float w0 = __builtin_amdgcn_exp2f(l0 - mx), w1 = __builtin_amdgcn_exp2f(l1 - mx), w2 = __builtin_amdgcn_exp2f(l2 - mx);
        const float inv = __builtin_amdgcn_rcpf(w0 + w1 + w2);
        const u32x2 a = *(const u32x2*)(OD + ((size_t)0 * T_ + t) * 512 + ch), bq = *(const u32x2*)(OD + ((size_t)1 * T_ + t) * 512 + ch), cq = *(const u32x2*)(OD + ((size_t)2 * T_ + t) * 512 + ch);
        float o[4];
#define BFLO(x) __uint_as_float((x) << 16)
#define BFHI(x) __uint_as_float((x) & 0xffff0000u)
        o[0] = (BFLO(a.x) * w0 + BFLO(bq.x) * w1 + BFLO(cq.x) * w2) * inv; o[1] = (BFHI(a.x) * w0 + BFHI(bq.x) * w1 + BFHI(cq.x) * w2) * inv;
        o[2] = (BFLO(a.y) * w0 + BFLO(bq.y) * w1 + BFLO(cq.y) * w2) * inv; o[3] = (BFHI(a.y) * w0 + BFHI(bq.y) * w1 + BFHI(cq.y) * w2) * inv;
#undef BFLO
#undef BFHI
        u32x2 w; w.x = pk2(o[0], o[1]); w.y = pk2(o[2], o[3]);
        *(u32x2*)(CC + (size_t)t * 1024 + 512 + ch) = w;
    }
}

constexpr int DA_ROW = 144;
constexpr int DA_TILE = 64 * DA_ROW;
__device__ __forceinline__ void dsa_attn_item(PRef p, int b, int head, int qb, char* smem) {
    const bf16_t* PO = (const bf16_t*)(p.ws + OFF_PO);
    const bf16_t* VT = (const bf16_t*)(p.ws + OFF_VTC) + ((size_t)(b * 8 + head)) * 64 * L_;
    const int tid = otid(), lane = tid & 63, wave = tid >> 6, r = lane & 31, h2 = lane >> 5;
    const int pr = (r & 0x13) | ((r & 4) << 1) | ((r & 8) >> 1);
    const float SC = 0.125f * 1.4426950408889634f;
    const int i0 = qb * 256 + wave * 32, qi = i0 + r;
    const unsigned long long* BMT = (const unsigned long long*)(p.ws + OFF_BM) + (size_t)b * 256 * L_ + qi;
    const size_t tq = (size_t)b * L_ + qi;
    bf16x8 qf[4];
#pragma unroll
    for (int s = 0; s < 4; ++s) qf[s] = *(const bf16x8*)(PO + tq * OD_P + head * 64 + s * 16 + h2 * 8);
    f32x16 oacc[2];
#pragma unroll
    for (int c = 0; c < 2; ++c)
#pragma unroll
        for (int i = 0; i < 16; ++i) oacc[c][i] = 0.f;
    float mrun = -64.f, lrun = 0.f;
    const int nkt = qb * 4 + 4, my_last = (i0 + 31) >> 6;
    const int srow = tid >> 3, sch = tid & 7;
    const bf16_t* ksrc = PO + ((size_t)b * L_ + srow) * OD_P + 512 + head * 64 + sch * 8;
    const bf16_t* vsrc = VT + (size_t)srow * L_ + sch * 8;
    u32x4 rk = *(const u32x4*)ksrc, rv = *(const u32x4*)vsrc;
    __syncthreads();
    *(u32x4*)(smem + srow * DA_ROW + sch * 16) = rk;
    *(u32x4*)(smem + DA_TILE + srow * DA_ROW + sch * 16) = rv;
    __syncthreads();
    unsigned long long mwn = BMT[0];
#pragma unroll 1
    for (int kt = 0; kt < nkt; ++kt) {
        const bool more = kt + 1 < nkt;
        if (more) { rk = *(const u32x4*)(ksrc + (size_t)(kt + 1) * 64 * OD_P); rv = *(const u32x4*)(vsrc + (kt + 1) * 64); }
        const unsigned long long mw64 = mwn;
        if (kt < my_last) mwn = BMT[(size_t)(kt + 1) * L_];
        if (kt <= my_last) {
            const char* kb = smem + (kt & 1) * 2 * DA_TILE; const char* vb = kb + DA_TILE;
            f32x16 sa[2];
#pragma unroll
            for (int sub = 0; sub < 2; ++sub) {
                bf16x8 kf[4];
#pragma unroll
                for (int s = 0; s < 4; ++s) kf[s] = *(const bf16x8*)(kb + (sub * 32 + pr) * DA_ROW + (s * 16 + h2 * 8) * 2);
#pragma unroll
                for (int i = 0; i < 16; ++i) sa[sub][i] = 0.f;
#pragma unroll
                for (int ks = 0; ks < 4; ++ks) sa[sub] = __builtin_amdgcn_mfma_f32_32x32x16_bf16(kf[ks], qf[ks], sa[sub], 0, 0, 0);
            }
#pragma unroll
            for (int sub = 0; sub < 2; ++sub) {
                const unsigned mw = sub == 0 ? (unsigned)mw64 : (unsigned)(mw64 >> 32);
                f32x16& s = sa[sub];
                bf16x8 vf[2][2];
#pragma unroll
                for (int db = 0; db < 2; ++db)
#pragma unroll
                    for (int s2 = 0; s2 < 2; ++s2) vf[db][s2] = *(const bf16x8*)(vb + (db * 32 + r) * DA_ROW + (sub * 32 + s2 * 16 + h2 * 8) * 2);
#pragma unroll
                for (int i = 0; i < 16; ++i) s[i] = __builtin_fmaf(s[i], SC, -mrun);
                float mxa = __builtin_fmaxf(__builtin_fmaxf(s[0], s[1]), s[2]), mxb = __builtin_fmaxf(__builtin_fmaxf(s[3], s[4]), s[5]);
                mxa = __builtin_fmaxf(__builtin_fmaxf(mxa, s[6]), s[7]); mxb = __builtin_fmaxf(__builtin_fmaxf(mxb, s[8]), s[9]);
                mxa = __builtin_fmaxf(__builtin_fmaxf(mxa, s[10]), s[11]); mxb = __builtin_fmaxf(__builtin_fmaxf(mxb, s[12]), s[13]);
                mxa = __builtin_fmaxf(__builtin_fmaxf(mxa, s[14]), s[15]);
                float mx = xor32_max(__builtin_fmaxf(mxa, mxb));
                if (__builtin_amdgcn_ballot_w64(mx > 0.f) != 0ull) {
                    const float dlt = fmaxf(mx, 0.f);
                    const float corr = __builtin_amdgcn_exp2f(-dlt);
                    mrun += dlt; lrun *= corr;
#pragma unroll
                    for (int db = 0; db < 2; ++db)
#pragma unroll
                        for (int i = 0; i < 16; ++i) oacc[db][i] *= corr;
#pragma unroll
                    for (int i = 0; i < 16; ++i) s[i] -= dlt;
                }
                const int mws = (int)(mw >> (8 * h2));
#define DA_P(i, KO) { const float e = __builtin_amdgcn_exp2f(s[i]); s[i] = __uint_as_float(__float_as_uint(e) & bitmask32<KO>(mws)); }
                DA_P(0, 0) DA_P(1, 1) DA_P(2, 2) DA_P(3, 3) DA_P(4, 4) DA_P(5, 5) DA_P(6, 6) DA_P(7, 7)
                DA_P(8, 16) DA_P(9, 17) DA_P(10, 18) DA_P(11, 19) DA_P(12, 20) DA_P(13, 21) DA_P(14, 22) DA_P(15, 23)
#undef DA_P
                {
                    const f32x2 t0 = (f32x2){s[0], s[1]} + (f32x2){s[2], s[3]}, t1 = (f32x2){s[4], s[5]} + (f32x2){s[6], s[7]};
                    const f32x2 t2 = (f32x2){s[8], s[9]} + (f32x2){s[10], s[11]}, t3 = (f32x2){s[12], s[13]} + (f32x2){s[14], s[15]};
                    const f32x2 u = (t0 + t1) + (t2 + t3);
                    lrun += u[0] + u[1];
                }
#pragma unroll
                for (int s2 = 0; s2 < 2; ++s2) {
                    u32x4 pw; pw.x = pk2(s[8 * s2], s[8 * s2 + 1]); pw.y = pk2(s[8 * s2 + 2], s[8 * s2 + 3]); pw.z = pk2(s[8 * s2 + 4], s[8 * s2 + 5]); pw.w = pk2(s[8 * s2 + 6], s[8 * s2 + 7]);
                    const bf16x8 pf = __builtin_bit_cast(bf16x8, pw);
#pragma unroll
                    for (int db = 0; db < 2; ++db) oacc[db] = __builtin_amdgcn_mfma_f32_32x32x16_bf16(vf[db][s2], pf, oacc[db], 0, 0, 0);
                }
            }
        }
        if (more) {
            char* nbuf = smem + ((kt + 1) & 1) * 2 * DA_TILE;
            *(u32x4*)(nbuf + srow * DA_ROW + sch * 16) = rk;
            *(u32x4*)(nbuf + DA_TILE + srow * DA_ROW + sch * 16) = rv;
        }
        __syncthreads();
    }
    const float lt = xor32_sum(lrun);
    const float inv = 1.f / lt;
    bf16_t* CC = (bf16_t*)(p.ws + OFF_CC);
#pragma unroll
    for (int db = 0; db < 2; ++db)
#pragma unroll
        for (int i = 0; i < 16; i += 4) {
            const int d = db * 32 + 8 * (i >> 2) + 4 * h2;
            u32x2 w; w.x = pk2(oacc[db][i] * inv, oacc[db][i + 1] * inv); w.y = pk2(oacc[db][i + 2] * inv, oacc[db][i + 3] * inv);
            *(u32x2*)(CC + tq * 1024 + head * 64 + d) = w;
        }
}


template <bool ODD>
__device__ __forceinline__ void inproj_phase(PRef p, int j, char* smem, int bid, int nb) {
    char* ws = p.ws;
    constexpr int NTN = ODD ? OD_P / 256 : EV_P / 256, NMAIN = 128 * NTN, NVT = ODD ? 1024 : 256;
    const bf16_t* XB = (const bf16_t*)(ws + OFF_XB);
    const bf16_t* W = ODD ? (const bf16_t*)(ws + OFF_WT_ODIN) + (size_t)j * OD_N * 1024 : (const bf16_t*)(ws + OFF_WT_EVIN) + (size_t)j * EV_N * 1024;
    XcdSeq s(NMAIN + NVT, bid, nb);
    gemm256_stream<false, 0>(
        [&](int i, G8Desc& d) -> bool {
            const int Q = s.q + i * s.step; if (Q >= s.qend) return false;
            d.list = nullptr; d.count = 0;
            if (Q < NMAIN) {
                const int pnl = Q / (4 * NTN), r = Q - pnl * 4 * NTN;
                d.A = XB; d.Bt = W; d.m0 = (pnl * 4 + (r & 3)) * 256; d.n0 = (r >> 2) * 256; d.u0 = -1; d.ldb = 1024;
            } else {
                const int v = Q - NMAIN; d.m0 = 0; d.n0 = 0; d.u0 = v;
                if (ODD) {
                    const int combo = v & 7, src = combo >> 1, mt = combo & 1, bn = v >> 3, b = bn >> 6, lam0 = (bn & 63) * 256;
                    const int sh = src < 2 ? 0 : (src == 2 ? 2 : 4), rho = lam0 >> (14 - sh), i0 = lam0 & ((L_ >> sh) - 1);
                    d.A = W + (size_t)(OD_P + src * 512 + mt * 256) * 1024;
                    d.Bt = XB + ((size_t)b * L_ + ((size_t)i0 << sh) + rho) * 1024; d.ldb = 1024 << sh;
                } else {
                    const int mt = v & 1, bn = v >> 1;
                    d.A = W + (size_t)(EV_P + mt * 256) * 1024;
                    d.Bt = XB + (size_t)bn * 256 * 1024; d.ldb = 1024;
                }
            }
            return true; },
        1024, 1024, smem,
        [&](int m0, int u0, f32x4 (&acc)[4][2], int rt0, int c0, int fr, int fq, const int*) {
            if (u0 < 0) { if (ODD) epi_od_in(p, acc, m0 + rt0, c0, fr, fq); else epi_ev_in(p, acc, m0 + rt0, c0, fr, fq); }
            else if (ODD) {
                const int combo = u0 & 7, src = combo >> 1, mt = combo & 1, bn = u0 >> 3, b = bn >> 6, lam0 = (bn & 63) * 256;
                bf16_t* img = src == 0 ? (bf16_t*)(ws + OFF_VTC) + ((size_t)(b * 8) * 64 + mt * 256) * L_ + lam0
                                       : (bf16_t*)(ws + OFF_VTD) + ((size_t)((b * 3 + src - 1) * 8) * 64 + mt * 256) * L_ + lam0;
                epi_vt(img, acc, rt0, c0, fr, fq);
            } else {
                const int mt = u0 & 1, bn = u0 >> 1, b = bn >> 6, lam0 = (bn & 63) * 256;
                epi_vt((bf16_t*)(ws + OFF_VTE) + ((size_t)(b * 4) * 128 + mt * 256) * L_ + lam0, acc, rt0, c0, fr, fq);
            }
        });
}

enum { K_PRO = 0, K_E1, K_E2, K_E3, K_E4, K_E5, K_E6, K_LN1, K_O1, K_O2, K_O3, K_O4, K_M1, K_M2, K_M3, K_M4, K_LN2, K_COUNT };

template <int KIND, bool NOEPI = false>
__device__ __forceinline__ void run_phase(PRef p, int layer, char* smem, int bid, int nb) {
    char* ws = p.ws;
    const int j = layer >> 1;
    if (KIND == K_PRO) {
        conv_phase(p, smem, bid, nb);
        __syncthreads();
        for (int u = bid; u < 256; u += nb) s5mat_unit(p, u, smem);
    } else if (KIND == K_E1) {
        inproj_phase<false>(p, j, smem, bid, nb);
    } else if (KIND == K_E2) {
        for (int it = bid; it < 2048; it += nb) gla_a_item(p, j, it, smem);
        s5_g_phase(p, j, smem, bid, nb);
    } else if (KIND == K_E3) {
        scan_phase(p, j, bid);
    } else if (KIND == K_E4) {
        for (int it = bid; it < 2048; it += nb) gla_c_item(p, j, it, smem);
        s5_y_phase(p, j, smem, bid, nb);
    } else if (KIND == K_E5) {
        const bf16_t* YA = (const bf16_t*)(ws + OFF_YA); bf16_t* CC = (bf16_t*)(ws + OFF_CC); const float* bg = p.s5_b_glu + (size_t)j * 512;
        gemm256_phase(YA, 512, T_, (const bf16_t*)(ws + OFF_WT_GLU) + (size_t)j * 512 * 512, 512, 512, 512, smem, bid, nb,
                   [&](f32x4 (&acc)[4][2], int row0, int c0, int fr, int fq) {
                       const int col = c0 + 8 * fq;
                       const f32x4 g0 = *(const f32x4*)(bg + col), g1 = *(const f32x4*)(bg + col + 4);
#pragma unroll
                       for (int m = 0; m < 4; ++m) {
                           const size_t t = (size_t)(row0 + m * 16 + fr);
                           const u32x4 yw = *(const u32x4*)(YA + t * 512 + col);
                           float o[8];
#pragma unroll
                           for (int q = 0; q < 4; ++q) {
                               const unsigned y2 = q == 0 ? yw.x : q == 1 ? yw.y : q == 2 ? yw.z : yw.w;
                               const float y0 = __uint_as_float(y2 << 16), y1 = __uint_as_float(y2 & 0xffff0000u);
                               const float a0 = q < 2 ? acc[m][0][2 * q] + g0[2 * q] : acc[m][1][2 * q - 4] + g1[2 * q - 4];
                               const float a1 = q < 2 ? acc[m][0][2 * q + 1] + g0[2 * q + 1] : acc[m][1][2 * q - 3] + g1[2 * q - 3];
                               o[2 * q] = y0 * sigmoidf_(a0); o[2 * q + 1] = y1 * sigmoidf_(a1);
                           }
                           u32x4 w; w.x = pk2(o[0], o[1]); w.y = pk2(o[2], o[3]); w.z = pk2(o[4], o[5]); w.w = pk2(o[6], o[7]);
                           *(u32x4*)(CC + t * 1024 + 512 + col) = w;
                       }
                   });
    } else if (KIND == K_E6 || KIND == K_O4) {
        bf16_t* MIX = (bf16_t*)(ws + OFF_MIX);
        const bf16_t* W = (const bf16_t*)(ws + (KIND == K_E6 ? OFF_WT_EVOUT : OFF_WT_ODOUT)) + (size_t)j * 1024 * 1024;
        gemm256_phase((const bf16_t*)(ws + OFF_CC), 1024, T_, W, 1024, 1024, 1024, smem, bid, nb,
                   [&](f32x4 (&acc)[4][2], int row0, int c0, int fr, int fq) {
#pragma unroll
                       for (int m = 0; m < 4; ++m) {
                           u32x4 w; w.x = pk2(acc[m][0][0], acc[m][0][1]); w.y = pk2(acc[m][0][2], acc[m][0][3]); w.z = pk2(acc[m][1][0], acc[m][1][1]); w.w = pk2(acc[m][1][2], acc[m][1][3]);
                           *(u32x4*)(MIX + (size_t)(row0 + m * 16 + fr) * 1024 + c0 + 8 * fq) = w;
                       }
                   });
    } else if (KIND == K_LN1) {
        ln1_router_phase<NOEPI>(p, layer, smem, bid, nb);
    } else if (KIND == K_O1) {
        inproj_phase<true>(p, j, smem, bid, nb);
    } else if (KIND == K_O2) {
        if (!NOEPI) for (int k = bid; k < 256; k += nb) {
            dsa_select_item(p, k & 1, k >> 1, smem);
            __syncthreads();
            const int k2 = 511 - k;
            dsa_select_item(p, k2 & 1, k2 >> 1, smem);
            __syncthreads();
        }
        const int head = otid() >> 6;
        for (int it = bid; it < 1536; it += nb) {
            const int b = it / 768, rem = it - b * 768, g = rem >> 8, u = rem & 255;
            const int sh = g * 2, per = 256 >> sh, rho = u / per, qblk = u - rho * per;
            const bf16_t* VT = (const bf16_t*)(ws + OFF_VTD) + ((size_t)((b * 3 + g) * 8 + head)) * 64 * L_;
#pragma unroll 1
            for (int hf = 0; hf < 2; ++hf) {
                const int hi = 2 * qblk + hf, lo = hi - 4;
                attn_wave<1, 1>(p, b, head, OD_DIL + g * 512, OD_DIL + 1536 + g * 512, VT, rho * (L_ >> sh), qblk * 64 + hf * 32, sh, rho, lo < 0 ? 0 : lo, hi, g);
            }
        }
    } else if (KIND == K_O3) {
        for (int k = bid; k < 512; k += nb) {
            const int bh = k >> 5, q0 = k & 31;
#pragma unroll 1
            for (int half = 0; half < 2; ++half) dsa_attn_item(p, bh >> 3, bh & 7, half == 0 ? q0 : 63 - q0, smem);
        }
        dil_combine_phase(p, bid, nb);
    } else if (KIND == K_M1) {
        float* LG = (float*)(ws + OFF_LOGIT); const float* rb = p.router_b + (size_t)layer * 32;
        gemm_phase((const bf16_t*)(ws + OFF_XB), 1024, T_, (const bf16_t*)(ws + OFF_WT_RT) + (size_t)layer * 128 * 1024, 1024, 128, 1024, smem, bid, nb,
                   [&](f32x4 (&acc)[4][2], int row0, int c0, int fr, int fq) {
#pragma unroll
                       for (int n = 0; n < 2; ++n) {
                           const int col = c0 + n * 16 + fr;
                           if (col < 32) {
#pragma unroll
                               for (int m = 0; m < 4; ++m)
#pragma unroll
                                   for (int r = 0; r < 4; ++r) LG[(size_t)(row0 + m * 16 + fq * 4 + r) * 32 + col] = acc[m][n][r] + rb[col];
                           }
                       }
                   });
    } else if (KIND == K_M2) {
        topk_phase(p, layer, bid, nb);
    } else if (KIND == K_M3) {
        moe_gemm_phase<1, NOEPI>(p, layer, smem, bid, nb);
    } else if (KIND == K_M4) {
        moe_gemm_phase<2, NOEPI>(p, layer, smem, bid, nb);
    } else if (KIND == K_LN2) {
        float* xo = layer == 3 ? p.out : (float*)nullptr;
        ln_phase<true, NOEPI>(p, (const bf16_t*)(ws + OFF_XB), (const float*)(ws + OFF_SLOT), p.ln2_g + (size_t)layer * 1024, p.ln2_b + (size_t)layer * 1024, xo,
                       layer == 3 ? (bf16_t*)nullptr : (bf16_t*)(ws + OFF_XB), bid, nb);
    }
}

extern __shared__ __attribute__((aligned(16))) char dyn_smem[];

#if !MEGA
template <int KIND>
__global__ void __launch_bounds__(NTHR, 2) k_phase(Params p, int layer) { run_phase<KIND>(p, layer, dyn_smem, blockIdx.x, gridDim.x); }
#else
#ifndef DUPMASK
#define DUPMASK 0
#endif
typedef const __attribute__((address_space(4))) Params* KParams;
#define RUNP(K) do { KParams _q = kp0; asm volatile("" : "+s"(_q)); run_phase<K>(*_q, layer, smem, bid, nb); } while (0)
#ifndef DUPNOEPI
#define DUPNOEPI 0
#endif
#define RUNP2(K) do { KParams _q = kp0; asm volatile("" : "+s"(_q)); run_phase<K, (DUPNOEPI != 0)>(*_q, layer, smem, bid, nb); } while (0)
#define PHASE(K) do { RUNP(K); xcd_barrier(bar); if ((DUPMASK >> 30) & 1) xcd_barrier(bar); if ((DUPMASK >> K) & 1) { RUNP2(K); xcd_barrier(bar); } } while (0)
template <int LAYER>
__device__ __forceinline__ void mega_layer(KParams kp0, char* smem, int bid, int nb, const XcdBarrier& bar) {
    constexpr int layer = LAYER;
    if ((layer & 1) == 0) { PHASE(K_E1); PHASE(K_E2); PHASE(K_E3); PHASE(K_E4); PHASE(K_E5); PHASE(K_E6); }
    else { PHASE(K_O1); PHASE(K_O2); PHASE(K_O3); PHASE(K_O4); }
    PHASE(K_LN1); PHASE(K_M3); PHASE(K_M4);
    RUNP(K_LN2);
    if ((DUPMASK >> K_LN2) & 1) { xcd_barrier(bar); RUNP2(K_LN2); }
    if (layer < 3) xcd_barrier(bar);
}
__global__ void __launch_bounds__(NTHR, 2) k_mega(Params p) {
    char* smem = dyn_smem;
    const int bid = blockIdx.x, nb = gridDim.x;
    volatile LAS unsigned* st = (volatile LAS unsigned*)(dyn_smem + LDS_BYTES - 16);
    if (otid() == 0) { st[0] = 0u; st[1] = 0u; }
    __syncthreads();
    KParams kp0 = (KParams)__builtin_amdgcn_kernarg_segment_ptr();
    XcdBarrier bar = xcd_barrier_post((unsigned*)(kp0->ws + OFF_BAR), st);
    { const int layer = 0; PHASE(K_PRO); }
    mega_layer<0>(kp0, smem, bid, nb, bar);
    mega_layer<1>(kp0, smem, bid, nb, bar);
    mega_layer<2>(kp0, smem, bid, nb, bar);
    mega_layer<3>(kp0, smem, bid, nb, bar);
}
#endif

extern "C" void kernel_launch(void* const* d_in, const int* in_sizes, int n_in, void* d_out, int out_size, void* d_ws, size_t ws_size, hipStream_t stream) {
    Params p{};
    const float** f = (const float**)&p;
    for (int i = 0; i < 28; ++i) f[i] = (const float*)d_in[i];
    p.out = (float*)d_out; p.ws = (char*)d_ws;
    if (ws_size < WS_NEED) { fprintf(stderr, "workspace too small: %zu < %zu\n", ws_size, (size_t)WS_NEED); return; }
#if !MEGA
#define SETATTR(K) hipFuncSetAttribute((const void*)k_phase<K>, hipFuncAttributeMaxDynamicSharedMemorySize, LDS_BYTES)
#define LAUNCH(K, layer) k_phase<K><<<256, NTHR, LDS_BYTES, stream>>>(p, layer)
    static bool attr_done = false;
    if (!attr_done) {
        SETATTR(K_PRO); SETATTR(K_E1); SETATTR(K_E2); SETATTR(K_E3); SETATTR(K_E4); SETATTR(K_E5); SETATTR(K_E6); SETATTR(K_LN1); SETATTR(K_O1); SETATTR(K_O2); SETATTR(K_O3);
        SETATTR(K_O4); SETATTR(K_M1); SETATTR(K_M2); SETATTR(K_M3); SETATTR(K_M4); SETATTR(K_LN2);
        attr_done = true;
    }
    LAUNCH(K_PRO, 0);
    for (int layer = 0; layer < 4; ++layer) {
        if ((layer & 1) == 0) { LAUNCH(K_E1, layer); LAUNCH(K_E2, layer); LAUNCH(K_E3, layer); LAUNCH(K_E4, layer); LAUNCH(K_E5, layer); LAUNCH(K_E6, layer); }
        else { LAUNCH(K_O1, layer); LAUNCH(K_O2, layer); LAUNCH(K_O3, layer); LAUNCH(K_O4, layer); }
        LAUNCH(K_LN1, layer); LAUNCH(K_M3, layer); LAUNCH(K_M4, layer); LAUNCH(K_LN2, layer);
    }
#else
    static int grid = 0;
    if (!grid) {
        hipFuncSetAttribute((const void*)k_mega, hipFuncAttributeMaxDynamicSharedMemorySize, LDS_BYTES);
        int dev = 0, cus = 0, per_cu = 0;
        hipGetDevice(&dev);
        hipDeviceGetAttribute(&cus, hipDeviceAttributeMultiprocessorCount, dev);
        hipOccupancyMaxActiveBlocksPerMultiprocessor(&per_cu, (const void*)k_mega, NTHR, LDS_BYTES);
        grid = cus * (per_cu < 1 ? per_cu : 1);
        if (grid <= 0) grid = 0;
    }
    if (!grid) { fprintf(stderr, "occupancy query says 0 blocks per CU\n"); return; }
    hipMemsetAsync((char*)d_ws + OFF_BAR, 0, XCD_BAR_WORDS * sizeof(unsigned), stream);
    k_mega<<<grid, NTHR, LDS_BYTES, stream>>>(p);
#endif
}
```

```cpp
#include <hip/hip_runtime.h>
#include <stdint.h>
#include <stdio.h>

#ifndef MEGA
#define MEGA 1
#define DUPMASK 0
#define DUPNOEPI 0
#endif

typedef unsigned short bf16_t;
typedef short bf16x8 __attribute__((ext_vector_type(8)));
typedef float f32x2 __attribute__((ext_vector_type(2)));
typedef float f32x4 __attribute__((ext_vector_type(4)));
typedef float f32x16 __attribute__((ext_vector_type(16)));
typedef unsigned u32x4 __attribute__((ext_vector_type(4)));
typedef unsigned u32x2 __attribute__((ext_vector_type(2)));

constexpr int T_ = 32768, D_ = 1024, L_ = 16384, NB_ = 2;
constexpr int NTHR = 512;
constexpr float ALPHA = 1.681792830507429f;
constexpr float LN_EPS = 1e-5f;
constexpr int EV_N = 2304;
constexpr int EV_P = 1792;
constexpr int PE_W = 1024;
constexpr int OD_N = 6656;
constexpr int OD_P = 4608;
constexpr int OD_QI = 1024, OD_DIL = 1280, OD_KI = 4352, OD_WI = 4416;
constexpr int UHW = 1152;
constexpr int LISTCAP = 131072;

constexpr size_t OFF_BAR = 0;
constexpr size_t OFF_CNT = 16384;
constexpr size_t OFF_A64 = 32768;
constexpr size_t OFF_WT_EVIN = 131072;
constexpr size_t OFF_WT_ODIN = OFF_WT_EVIN + (size_t)2 * EV_N * 1024 * 2;
constexpr size_t OFF_WT_EVOUT = OFF_WT_ODIN + (size_t)2 * OD_N * 1024 * 2;
constexpr size_t OFF_WT_ODOUT = OFF_WT_EVOUT + (size_t)2 * 1024 * 1024 * 2;
constexpr size_t OFF_WT_GLU = OFF_WT_ODOUT + (size_t)2 * 1024 * 1024 * 2;
constexpr size_t OFF_WT_RT = OFF_WT_GLU + (size_t)2 * 512 * 512 * 2;
constexpr size_t OFF_WT_W1 = OFF_WT_RT + (size_t)4 * 128 * 1024 * 2;
constexpr size_t OFF_WT_W2 = OFF_WT_W1 + (size_t)4 * 32 * 2048 * 1024 * 2;
constexpr size_t OFF_TH = OFF_WT_W2 + (size_t)4 * 32 * 1024 * 1024 * 2;
constexpr size_t OFF_GM = OFF_TH + (size_t)2 * 32 * 1024 * UHW * 2;
constexpr size_t OFF_XR = OFF_GM + (size_t)2 * 32 * 128 * 1024 * 2;
constexpr size_t OFF_XB = OFF_XR + (size_t)T_ * 1024 * 4;
constexpr size_t OFF_MIX = OFF_XB + (size_t)T_ * 1024 * 2;
constexpr size_t OFF_CC = OFF_MIX + (size_t)T_ * 1024 * 4;
constexpr size_t OFF_LOGIT = OFF_CC + (size_t)T_ * 1024 * 2;
constexpr size_t OFF_LIST = OFF_LOGIT + (size_t)T_ * 32 * 4;
constexpr size_t OFF_GATE = OFF_LIST + (size_t)32 * LISTCAP * 4;
constexpr size_t OFF_ACT = OFF_GATE + (size_t)T_ * 4 * 4;
constexpr size_t OFF_SLOT = OFF_ACT + (size_t)T_ * 4 * 1024 * 2;
constexpr size_t OFF_MIXER = OFF_SLOT + (size_t)T_ * 4 * 1024 * 4;
constexpr size_t OFF_PE = OFF_MIXER;
constexpr size_t OFF_UH = OFF_PE + (size_t)T_ * 1536 * 2;
constexpr size_t OFF_GLR = OFF_UH + (size_t)(T_ / 64) * 32 * UHW * 2;
constexpr size_t OFF_VTE = OFF_GLR + (size_t)T_ * 16 * 4;
constexpr size_t OFF_KV = OFF_VTE + (size_t)2 * 4 * 128 * L_ * 2;
constexpr size_t OFF_SST = OFF_KV + (size_t)2 * 256 * 4 * 64 * 128 * 4;
constexpr size_t OFF_DEC = OFF_SST + (size_t)2 * 256 * 4 * 64 * 128 * 4;
constexpr size_t OFF_GBUF = OFF_DEC + (size_t)2 * 256 * 4 * 64 * 4;
constexpr size_t OFF_YA = OFF_GBUF + (size_t)512 * 32 * 128 * 4;
constexpr size_t END_EVEN = OFF_YA + (size_t)T_ * 512 * 2;
constexpr size_t OFF_PO = OFF_MIXER;
constexpr size_t OFF_WI = OFF_PO + (size_t)T_ * OD_N * 2;
constexpr size_t OFF_VTC = OFF_WI + (size_t)T_ * 4 * 4;
constexpr size_t OFF_VTD = OFF_VTC + (size_t)2 * 8 * 64 * L_ * 2;
constexpr size_t OFF_BM = OFF_VTD + (size_t)2 * 3 * 8 * 64 * L_ * 2;
constexpr size_t OFF_OD = OFF_BM + (size_t)T_ * 256 * 8;
constexpr size_t OFF_LSE = OFF_OD + (size_t)3 * T_ * 512 * 4;
constexpr size_t END_ODD = OFF_LSE + (size_t)3 * T_ * 8 * 4;
constexpr size_t WS_NEED = END_ODD > END_EVEN ? END_ODD : END_EVEN;
static_assert(WS_NEED < (size_t)4200000000ull, "workspace too large");

constexpr int LDS_BYTES = 153600;

struct Params {
    const float *x, *ev_w_in, *gla_w_gate2, *gla_b_gate2, *gla_norm_g, *s5_a_re, *s5_a_im, *s5_log_dt, *s5_b_re, *s5_b_im, *s5_c_re, *s5_c_im, *s5_d,
        *s5_w_glu, *s5_b_glu, *ev_w_out, *od_w_in, *od_w_out, *ln1_g, *ln1_b, *ln2_g, *ln2_b, *router_w, *router_b, *moe_w1, *moe_b1, *moe_w2, *moe_b2;
    float* out;
    char* ws;
};

#if MEGA
typedef const __attribute__((address_space(4))) Params& PRef;
#else
typedef const Params& PRef;
#endif

__device__ __forceinline__ unsigned pk2(float lo, float hi) { unsigned r; asm("v_cvt_pk_bf16_f32 %0, %1, %2" : "=v"(r) : "v"(lo), "v"(hi)); return r; }
__device__ __forceinline__ bf16_t f2bf(float f) { return (bf16_t)(pk2(f, 0.f) & 0xffffu); }
__device__ __forceinline__ float bf2f(bf16_t h) { return __uint_as_float(((unsigned)h) << 16); }
__device__ __forceinline__ float sigmoidf_(float x) { return __builtin_amdgcn_rcpf(1.f + __expf(-x)); }
template <int CTRL> __device__ __forceinline__ float dppf(float v) { return __int_as_float(__builtin_amdgcn_update_dpp(0, __float_as_int(v), CTRL, 0xF, 0xF, false)); }
constexpr int DPP_X1 = 0xB1  , DPP_X2 = 0x4E  , DPP_HMIR = 0x141  , DPP_MIR = 0x140  , DPP_ROR8 = 0x128;
__device__ __forceinline__ float xor16_sum(float v) { const unsigned u = __float_as_uint(v); auto r = __builtin_amdgcn_permlane16_swap(u, u, false, false); return __uint_as_float(r[0]) + __uint_as_float(r[1]); }
__device__ __forceinline__ float xor16_max(float v) { const unsigned u = __float_as_uint(v); auto r = __builtin_amdgcn_permlane16_swap(u, u, false, false); return fmaxf(__uint_as_float(r[0]), __uint_as_float(r[1])); }
__device__ __forceinline__ float xor32_sum_(float v) { const unsigned u = __float_as_uint(v); auto r = __builtin_amdgcn_permlane32_swap(u, u, false, false); return __uint_as_float(r[0]) + __uint_as_float(r[1]); }
__device__ __forceinline__ float xor32_max_(float v) { const unsigned u = __float_as_uint(v); auto r = __builtin_amdgcn_permlane32_swap(u, u, false, false); return fmaxf(__uint_as_float(r[0]), __uint_as_float(r[1])); }
__device__ __forceinline__ float wave_sum(float v) {
    v += dppf<DPP_X1>(v); v += dppf<DPP_X2>(v); v += dppf<DPP_HMIR>(v); v += dppf<DPP_MIR>(v);
    return xor32_sum_(xor16_sum(v));
}
__device__ __forceinline__ float wave_max(float v) {
    v = fmaxf(v, dppf<DPP_X1>(v)); v = fmaxf(v, dppf<DPP_X2>(v)); v = fmaxf(v, dppf<DPP_HMIR>(v)); v = fmaxf(v, dppf<DPP_MIR>(v));
    return xor32_max_(xor16_max(v));
}
__device__ __forceinline__ float gelu_tanh(float x) {
    const float k0 = 0.7978845608028654f, k1 = 0.044715f;
    float u = k0 * (x + k1 * x * x * x);
    float t = 1.f - 2.f * __builtin_amdgcn_rcpf(1.f + __expf(2.f * u));
    return 0.5f * x * (1.f + t);
}
__device__ __forceinline__ float xor32_max(float v) { const unsigned u = __float_as_uint(v); auto r = __builtin_amdgcn_permlane32_swap(u, u, false, false); return fmaxf(__uint_as_float(r[0]), __uint_as_float(r[1])); }
__device__ __forceinline__ float xor32_sum(float v) { const unsigned u = __float_as_uint(v); auto r = __builtin_amdgcn_permlane32_swap(u, u, false, false); return __uint_as_float(r[0]) + __uint_as_float(r[1]); }
__device__ __forceinline__ unsigned xor32_or(unsigned u) { auto r = __builtin_amdgcn_permlane32_swap(u, u, false, false); return r[0] | r[1]; }
template <int BIT> __device__ __forceinline__ unsigned bitmask32(int w) { unsigned m; asm("v_bfe_i32 %0, %1, %2, 1" : "=v"(m) : "v"(w), "n"(BIT)); return m; }
__device__ __forceinline__ int otid() { int t = threadIdx.x; asm volatile("" : "+v"(t)); return t; }

#define XB_TMO      128
#define XB_XCNT(j)  (256  + 64 * (j))
#define XB_XSUB(j)  (1280 + 64 * (j))
#define XB_XGEN(j)  (2304 + 64 * (j))
#define XB_TOP      3328
#define XB_TOPGEN   3392
#define XCD_BAR_WORDS 3456
#define XB_SPIN_CAP (1u << 21)
#define LAS __attribute__((address_space(3)))

__device__ __forceinline__ unsigned xb_ld(unsigned* p)              { return __hip_atomic_load(p, __ATOMIC_RELAXED, __HIP_MEMORY_SCOPE_AGENT); }
__device__ __forceinline__ unsigned xb_add(unsigned* p, unsigned v) { return __hip_atomic_fetch_add(p, v, __ATOMIC_RELAXED, __HIP_MEMORY_SCOPE_AGENT); }
__device__ __forceinline__ unsigned xb_xcc_id() { return (unsigned)__builtin_amdgcn_s_getreg((3 << 11) | 20) & 0xFu; }
#define XB_SPIN(cond, bar) do { unsigned _sp = 0; while (cond) { __builtin_amdgcn_s_sleep(1); \
    if ((++_sp & 255u) == 0u) { if (xb_ld(&(bar)[XB_TMO])) break; if (_sp > XB_SPIN_CAP) { atomicAdd(&(bar)[XB_TMO], 1u); break; } } } } while (0)

struct XcdBarrier { unsigned* bar; unsigned x; volatile LAS unsigned* st; };

__device__ __forceinline__ XcdBarrier xcd_barrier_post(unsigned* bar, volatile LAS unsigned* st) {
    XcdBarrier b; b.bar = bar; b.x = xb_xcc_id(); b.st = st;
    if (threadIdx.x == 0) (void)xb_add(&bar[XB_XCNT(b.x)], 1u);
    return b;
}
__device__ __forceinline__ void xcd_barrier_complete(unsigned* bar, unsigned x, unsigned& nloc, unsigned& nx) {
    const unsigned G = gridDim.x * gridDim.y * gridDim.z;
    unsigned sum, cnt, mine, sp = 0u;
    for (;;) {
        sum = 0u; cnt = 0u; mine = 0u;
#pragma unroll
        for (unsigned j = 0; j < 16; ++j) { const unsigned c = xb_ld(&bar[XB_XCNT(j)]); sum += c; cnt += (c > 0u) ? 1u : 0u; mine = (j == x) ? c : mine; }
        if (sum == G) break;
        __builtin_amdgcn_s_sleep(1);
        if ((++sp & 255u) == 0u) { if (xb_ld(&bar[XB_TMO])) break; if (sp > XB_SPIN_CAP) { atomicAdd(&bar[XB_TMO], 1u); break; } }
    }
    nloc = mine > 0u ? mine : 1u; nx = cnt > 0u ? cnt : 1u;
}
__device__ __forceinline__ void xcd_barrier(const XcdBarrier& b) {
    asm volatile("s_waitcnt vmcnt(0)" ::: "memory");
    __syncthreads();
    if (threadIdx.x == 0) {
        unsigned* bar = b.bar;
        __builtin_amdgcn_s_waitcnt(0);
        unsigned nloc = b.st[0], nx = b.st[1];
        if (nloc == 0u) { xcd_barrier_complete(bar, b.x, nloc, nx); b.st[0] = nloc; b.st[1] = nx; }
        const unsigned old = xb_add(&bar[XB_XSUB(b.x)], 1u);
        const unsigned gen = old / nloc;
        if (old + 1u == (gen + 1u) * nloc) {
            __builtin_amdgcn_fence(__ATOMIC_RELEASE, "agent");
            asm volatile("s_waitcnt vmcnt(0)" ::: "memory");
            const unsigned og = xb_add(&bar[XB_TOP], 1u);
            const unsigned tg = og / nx;
            if (og + 1u == (tg + 1u) * nx) xb_add(&bar[XB_TOPGEN], 1u);
            else XB_SPIN(xb_ld(&bar[XB_TOPGEN]) == tg, bar);
            __builtin_amdgcn_fence(__ATOMIC_ACQUIRE, "agent");
            xb_add(&bar[XB_XGEN(b.x)], 1u);
            asm volatile("s_waitcnt vmcnt(0)" ::: "memory");
        } else {
            XB_SPIN(xb_ld(&bar[XB_XGEN(b.x)]) == gen, bar);
            __builtin_amdgcn_fence(__ATOMIC_ACQUIRE, "agent");
            asm volatile("s_waitcnt vmcnt(0)" ::: "memory");
        }
    }
    __syncthreads();
}

constexpr int G_LROW = 144;
constexpr int G_ASZ = 256 * G_LROW;
constexpr int G_BSZ = 128 * G_LROW;
constexpr int G_STAGE = G_ASZ + G_BSZ;
constexpr int G_ROWS_OFF = 2 * G_STAGE;

template <bool GATHER, class Epi>
__device__ __forceinline__ void gemm_tile(const bf16_t* __restrict__ A, long lda, int shift, int m0, const bf16_t* __restrict__ Bt, long ldb, int n0, int K,
                                          char* smem, Epi&& epi) {
    const int tid = otid(), lane = tid & 63, wave = tid >> 6, wr = wave >> 1, wc = wave & 1, fr = lane & 15, fq = lane >> 4;
    const int lrow = tid >> 3, lchunk = tid & 7;
    const int* sRow = (const int*)(smem + G_ROWS_OFF);
    const bf16_t* pa[4]; const bf16_t* pb[2];
#pragma unroll
    for (int i = 0; i < 4; ++i) {
        int r = lrow + 64 * i; long arow;
        if (GATHER) { int v = sRow[r]; arow = v < 0 ? 0 : (v >> shift); } else arow = m0 + r;
        pa[i] = A + arow * lda + lchunk * 8;
    }
#pragma unroll
    for (int i = 0; i < 2; ++i) pb[i] = Bt + (long)(n0 + lrow + 64 * i) * ldb + lchunk * 8;
    f32x4 acc[4][4];
#pragma unroll
    for (int m = 0; m < 4; ++m)
#pragma unroll
        for (int n = 0; n < 4; ++n) acc[m][n] = (f32x4){0.f, 0.f, 0.f, 0.f};
    u32x4 ra[4], rb[2];
    const int nk = K >> 6;
#pragma unroll
    for (int i = 0; i < 4; ++i) ra[i] = *(const u32x4*)(pa[i]);
#pragma unroll
    for (int i = 0; i < 2; ++i) rb[i] = *(const u32x4*)(pb[i]);
    {
        char* sa = smem; char* sb = smem + G_ASZ;
#pragma unroll
        for (int i = 0; i < 4; ++i) *(u32x4*)(sa + (lrow + 64 * i) * G_LROW + lchunk * 16) = ra[i];
#pragma unroll
        for (int i = 0; i < 2; ++i) *(u32x4*)(sb + (lrow + 64 * i) * G_LROW + lchunk * 16) = rb[i];
    }
    __syncthreads();
    for (int kt = 0; kt < nk; ++kt) {
        const bool more = (kt + 1 < nk);
        if (more) {
#pragma unroll
            for (int i = 0; i < 4; ++i) ra[i] = *(const u32x4*)(pa[i] + (kt + 1) * 64);
#pragma unroll
            for (int i = 0; i < 2; ++i) rb[i] = *(const u32x4*)(pb[i] + (kt + 1) * 64);
        }
        const char* sa = smem + (kt & 1) * G_STAGE; const char* sb = sa + G_ASZ;
#pragma unroll
        for (int ks = 0; ks < 2; ++ks) {
            bf16x8 af[4], bfr[4];
#pragma unroll
            for (int m = 0; m < 4; ++m) af[m] = *(const bf16x8*)(sa + (wr * 64 + m * 16 + fr) * G_LROW + (ks * 32 + fq * 8) * 2);
#pragma unroll
            for (int n = 0; n < 4; ++n) bfr[n] = *(const bf16x8*)(sb + (wc * 64 + n * 16 + fr) * G_LROW + (ks * 32 + fq * 8) * 2);
#pragma unroll
            for (int m = 0; m < 4; ++m)
#pragma unroll
                for (int n = 0; n < 4; ++n) acc[m][n] = __builtin_amdgcn_mfma_f32_16x16x32_bf16(af[m], bfr[n], acc[m][n], 0, 0, 0);
        }
        if (more) {
            char* wa = smem + ((kt + 1) & 1) * G_STAGE; char* wb = wa + G_ASZ;
#pragma unroll
            for (int i = 0; i < 4; ++i) *(u32x4*)(wa + (lrow + 64 * i) * G_LROW + lchunk * 16) = ra[i];
#pragma unroll
            for (int i = 0; i < 2; ++i) *(u32x4*)(wb + (lrow + 64 * i) * G_LROW + lchunk * 16) = rb[i];
        }
        __syncthreads();
    }
    {
        f32x4 h0[4][2], h1[4][2];
#pragma unroll
        for (int m = 0; m < 4; ++m) { h0[m][0] = acc[m][0]; h0[m][1] = acc[m][1]; h1[m][0] = acc[m][2]; h1[m][1] = acc[m][3]; }
        epi(h0, wr * 64, n0 + wc * 64, fr, fq);
        epi(h1, wr * 64, n0 + wc * 64 + 32, fr, fq);
    }
}

template <class Epi>
__device__ __forceinline__ void gemm_phase(const bf16_t* A, long lda, int M, const bf16_t* Bt, long ldb, int N, int K, char* smem, int bid, int nb, Epi&& epi) {
    const int ntn = N / 128, ntm = M / 256, nt = ntn * ntm;
    for (int t = bid; t < nt; t += nb) {
        const int mi = t / ntn, ni = t - mi * ntn;
        gemm_tile<false>(A, lda, 0, mi * 256, Bt, ldb, ni * 128, K, smem,
                         [&](f32x4 (&acc)[4][2], int rt0, int c0, int fr, int fq) { epi(acc, mi * 256 + rt0, c0, fr, fq); });
    }
}

constexpr int G8_HT = 128 * 64 * 2;
constexpr int G8_ROWS_OFF = 8 * G8_HT;

__device__ __forceinline__ int g8_lds_byte(int r, int c) {
    const int st = (r >> 4) * 2 + (c >> 5), rr = r & 15, cc = c & 31, ob = rr * 64 + cc * 2;
    return st * 1024 + (ob ^ (((ob >> 9) & 1) << 5));
}
__device__ __forceinline__ void g8_stage_rc(int b, int& R, int& C) {
    const int st = b / 1024, sb = b % 1024, swz = sb ^ (((sb >> 9) & 1) << 5);
    R = (st >> 1) * 16 + swz / 64; C = (st & 1) * 32 + (swz % 64) / 2;
}

#define G8_SA(b, h) (lds + ((b) * 2 + (h)) * G8_HT)
#define G8_SB(b, h) (lds + (4 + (b) * 2 + (h)) * G8_HT)
#define G8_STAGE(P, RS, OFF, soff) do { \
    _Pragma("unroll") for (int _i = 0; _i < 2; ++_i) \
        __builtin_amdgcn_raw_ptr_buffer_load_lds((RS), (LAS unsigned*)((P) + tid * 16 + _i * 8192), 16, (OFF)[_i], (soff), 0, 0); } while (0)
#define G8_LDA(dst, b, h) do { _Pragma("unroll") for (int m = 0; m < 4; ++m) _Pragma("unroll") for (int k = 0; k < 2; ++k) \
    dst[m][k] = *(const LAS bf16x8*)(G8_SA(b, h) + g8_lds_byte(wr * 64 + m * 16 + fr, k * 32 + fq * 8)); } while (0)
#define G8_LDB(dst, b, h) do { _Pragma("unroll") for (int n = 0; n < 2; ++n) _Pragma("unroll") for (int k = 0; k < 2; ++k) \
    dst[n][k] = *(const LAS bf16x8*)(G8_SB(b, h) + g8_lds_byte(wc * 32 + n * 16 + fr, k * 32 + fq * 8)); } while (0)
#define G8_MMA(ai, bj, At, Bt_) do { __builtin_amdgcn_s_setprio(1); \
    _Pragma("unroll") for (int m = 0; m < 4; ++m) _Pragma("unroll") for (int n = 0; n < 2; ++n) _Pragma("unroll") for (int k = 0; k < 2; ++k) \
        acc[ai][bj][m][n] = __builtin_amdgcn_mfma_f32_16x16x32_bf16(Bt_[n][k], At[m][k], acc[ai][bj][m][n], 0, 0, 0); \
    __builtin_amdgcn_s_setprio(0); } while (0)
#define G8_WAIT_V(n) asm volatile("s_waitcnt vmcnt(" #n ")" ::: "memory")
#define G8_WAIT_L(n) asm volatile("s_waitcnt lgkmcnt(" #n ")" ::: "memory")
#define G8_BAR __builtin_amdgcn_s_barrier()
#define G8_SCHED __builtin_amdgcn_sched_barrier(0)

template <bool GATHER, class Epi>
__device__ __forceinline__ void gemm256_tile(const bf16_t* __restrict__ A, long lda, int shift, int m0, const bf16_t* __restrict__ Bt, long ldb, int n0, int K,
                                             char* smem, Epi&& epi) {
    LAS char* lds = (LAS char*)smem;
    int tid = otid();
    int wid = tid >> 6, lane = tid & 63, wr = wid >> 2, wc = wid & 3, fr = lane & 15, fq = lane >> 4;
    unsigned aoff[2][2], boff[2];
    {
        const LAS int* sRow = (const LAS int*)(lds + G8_ROWS_OFF);
#pragma unroll
        for (int i = 0; i < 2; ++i) {
            int R, C; g8_stage_rc(tid * 16 + i * 8192, R, C);
            { const int rho = R & 31, nn = rho >> 4, ii = rho & 15; const int Rp = (R & ~31) + 8 * (ii >> 2) + 4 * nn + (ii & 3);
              boff[i] = (unsigned)((long)Rp * ldb + C) * 2u; }
#pragma unroll
            for (int h = 0; h < 2; ++h) {
                long arow;
                if (GATHER) { const int v = sRow[h * 128 + R]; arow = v < 0 ? 0 : (v >> shift); } else arow = m0 + h * 128 + R;
                aoff[h][i] = (unsigned)(arow * lda + C) * 2u;
            }
        }
    }
    f32x4 acc[2][2][4][2];
#pragma unroll
    for (int a = 0; a < 2; ++a)
#pragma unroll
        for (int b = 0; b < 2; ++b)
#pragma unroll
            for (int m = 0; m < 4; ++m)
#pragma unroll
                for (int n = 0; n < 2; ++n) acc[a][b][m][n] = (f32x4){0.f, 0.f, 0.f, 0.f};
    bf16x8 At[4][2], B0[2][2], B1[2][2];
    const int nt = K / 64;
    const __amdgpu_buffer_rsrc_t rA = __builtin_amdgcn_make_buffer_rsrc((void*)A, 0, 0x7fffffff, 0x00020000);
    const __amdgpu_buffer_rsrc_t rB = __builtin_amdgcn_make_buffer_rsrc((void*)(Bt + (size_t)n0 * ldb), 0, 0x7fffffff, 0x00020000);
    const int bh = (int)(128 * ldb * 2);
    G8_STAGE(G8_SB(0, 0), rB, boff, 0); G8_STAGE(G8_SA(0, 0), rA, aoff[0], 0);
    G8_STAGE(G8_SB(0, 1), rB, boff, bh); G8_STAGE(G8_SA(0, 1), rA, aoff[1], 0);
    if (wr == 1) G8_BAR;
    G8_WAIT_V(4); G8_BAR;
    G8_STAGE(G8_SB(1, 0), rB, boff, 128); G8_STAGE(G8_SA(1, 0), rA, aoff[0], 128); G8_STAGE(G8_SB(1, 1), rB, boff, 128 + bh);
    G8_WAIT_V(6); G8_BAR;
    for (int t = 0; t < nt - 2; t += 2) {
        G8_LDB(B0, 0, 0); G8_SCHED; G8_LDA(At, 0, 0); G8_STAGE(G8_SA(1, 1), rA, aoff[1], (t + 1) * 128);
        G8_WAIT_L(8); G8_BAR; G8_WAIT_L(0); G8_MMA(0, 0, At, B0); G8_BAR; G8_SCHED;
        G8_LDB(B1, 0, 1); G8_STAGE(G8_SB(0, 0), rB, boff, (t + 2) * 128);
        G8_BAR; G8_WAIT_L(0); G8_MMA(0, 1, At, B1); G8_BAR;
        G8_LDA(At, 0, 1); G8_STAGE(G8_SA(0, 0), rA, aoff[0], (t + 2) * 128);
        G8_BAR; G8_WAIT_L(0); G8_MMA(1, 0, At, B0); G8_BAR; G8_SCHED;
        G8_STAGE(G8_SB(0, 1), rB, boff, (t + 2) * 128 + bh);
        G8_WAIT_V(6); G8_BAR; G8_MMA(1, 1, At, B1); G8_BAR;
        G8_LDB(B0, 1, 0); G8_SCHED; G8_LDA(At, 1, 0); G8_STAGE(G8_SA(0, 1), rA, aoff[1], (t + 2) * 128);
        G8_WAIT_L(8); G8_BAR; G8_WAIT_L(0); G8_MMA(0, 0, At, B0); G8_BAR; G8_SCHED;
        G8_LDB(B1, 1, 1); G8_STAGE(G8_SB(1, 0), rB, boff, (t + 3) * 128);
        G8_BAR; G8_WAIT_L(0); G8_MMA(0, 1, At, B1); G8_BAR;
        G8_LDA(At, 1, 1); G8_STAGE(G8_SA(1, 0), rA, aoff[0], (t + 3) * 128);
        G8_BAR; G8_WAIT_L(0); G8_MMA(1, 0, At, B0); G8_BAR; G8_SCHED;
        G8_STAGE(G8_SB(1, 1), rB, boff, (t + 3) * 128 + bh);
        G8_WAIT_V(6); G8_BAR; G8_MMA(1, 1, At, B1); G8_BAR;
    }
    { G8_LDB(B0, 0, 0); G8_WAIT_V(0); G8_LDA(At, 0, 0); G8_STAGE(G8_SA(1, 1), rA, aoff[1], (nt - 1) * 128);
      G8_BAR; G8_WAIT_L(0); G8_MMA(0, 0, At, B0); G8_BAR;
      G8_LDB(B1, 0, 1); G8_BAR; G8_WAIT_L(0); G8_MMA(0, 1, At, B1); G8_BAR;
      G8_LDA(At, 0, 1); G8_WAIT_V(4); G8_BAR; G8_WAIT_L(0); G8_MMA(1, 0, At, B0); G8_MMA(1, 1, At, B1); G8_BAR; }
    { G8_LDB(B0, 1, 0); G8_LDA(At, 1, 0); G8_WAIT_V(2); G8_BAR; G8_WAIT_L(0); G8_MMA(0, 0, At, B0); G8_BAR;
      G8_LDB(B1, 1, 1); G8_WAIT_V(0); G8_BAR; G8_WAIT_L(0); G8_MMA(0, 1, At, B1); G8_BAR;
      G8_LDA(At, 1, 1); G8_BAR; G8_WAIT_L(0); G8_MMA(1, 0, At, B0); G8_MMA(1, 1, At, B1); G8_BAR; }
    if (wr == 0) G8_BAR;
    int tz = otid(); wid = tz >> 6; lane = tz & 63; wr = wid >> 2; wc = wid & 3; fr = lane & 15; fq = lane >> 4;
#pragma unroll
    for (int ai = 0; ai < 2; ++ai)
#pragma unroll
        for (int bj = 0; bj < 2; ++bj) epi(acc[ai][bj], ai * 128 + wr * 64, n0 + bj * 128 + wc * 32, fr, fq);
}

struct G8Desc { const bf16_t* A; const bf16_t* Bt; const int* list; int m0, n0, count, u0, ldb; };

template <bool GATHER, int SHIFT, class Src, class Epi>
__device__ __forceinline__ void gemm256_stream(Src&& src, const int lda, const int K, char* smem, Epi&& epi) {
    LAS char* lds = (LAS char*)smem;
    int tid = otid();
    int wid = tid >> 6, lane = tid & 63, wr = wid >> 2, wc = wid & 3, fr = lane & 15, fq = lane >> 4;
    G8Desc nxt;
    if (!src(0, nxt)) return;
    int cm0 = nxt.m0, cn0 = nxt.n0, cu0 = nxt.u0;
    int* sRowG = (int*)(smem + G8_ROWS_OFF);
    __syncthreads();
    if (GATHER) { if (tid < 256) sRowG[tid] = tid < nxt.count ? nxt.list[tid] : -1; __syncthreads(); }
    unsigned aoff[2][2], boff[2];
    __amdgpu_buffer_rsrc_t rA, rB;
    int bh;
#define G8_PREP(D, SLOT) do { \
        const LAS int* _sr = (const LAS int*)(lds + G8_ROWS_OFF) + (SLOT) * 256; \
        _Pragma("unroll") for (int i = 0; i < 2; ++i) { \
            int R, C; g8_stage_rc(tid * 16 + i * 8192, R, C); \
            { const int rho = R & 31, nn = rho >> 4, ii = rho & 15; const int Rp = (R & ~31) + 8 * (ii >> 2) + 4 * nn + (ii & 3); boff[i] = (unsigned)(Rp * (D).ldb + C) * 2u; } \
            _Pragma("unroll") for (int h = 0; h < 2; ++h) { \
                int arow; \
                if (GATHER) { const int v = _sr[h * 128 + R]; arow = v < 0 ? 0 : (v >> SHIFT); } else arow = (D).m0 + h * 128 + R; \
                aoff[h][i] = (unsigned)(arow * lda + C) * 2u; } } \
        rA = __builtin_amdgcn_make_buffer_rsrc((void*)(D).A, 0, 0x7fffffff, 0x00020000); \
        rB = __builtin_amdgcn_make_buffer_rsrc((void*)((D).Bt + (size_t)(D).n0 * (D).ldb), 0, 0x7fffffff, 0x00020000); bh = 128 * (D).ldb * 2; } while (0)
#define G8_PRO1() do { G8_STAGE(G8_SB(0, 0), rB, boff, 0); G8_STAGE(G8_SA(0, 0), rA, aoff[0], 0); G8_STAGE(G8_SB(0, 1), rB, boff, bh); G8_STAGE(G8_SA(0, 1), rA, aoff[1], 0); } while (0)
    G8_PREP(nxt, 0);
    G8_PRO1();
    f32x4 acc[2][2][4][2];
    const int nt = K / 64;
    for (int it = 0;; ++it) {
#pragma unroll
        for (int a = 0; a < 2; ++a)
#pragma unroll
            for (int b = 0; b < 2; ++b)
#pragma unroll
                for (int m = 0; m < 4; ++m)
#pragma unroll
                    for (int n = 0; n < 2; ++n) acc[a][b][m][n] = (f32x4){0.f, 0.f, 0.f, 0.f};
        const bool has_next = src(it + 1, nxt);
        if (GATHER && has_next && tid < 256) sRowG[((it + 1) % 3) * 256 + tid] = tid < nxt.count ? nxt.list[tid] : -1;
        bf16x8 At[4][2], B0[2][2], B1[2][2];
        if (wr == 1) G8_BAR;
        G8_WAIT_V(4); G8_BAR;
        G8_STAGE(G8_SB(1, 0), rB, boff, 128); G8_STAGE(G8_SA(1, 0), rA, aoff[0], 128); G8_STAGE(G8_SB(1, 1), rB, boff, 128 + bh);
        G8_WAIT_V(6); G8_BAR;
        for (int t = 0; t < nt - 2; t += 2) {
            G8_LDB(B0, 0, 0); G8_SCHED; G8_LDA(At, 0, 0); G8_STAGE(G8_SA(1, 1), rA, aoff[1], (t + 1) * 128);
            G8_WAIT_L(8); G8_BAR; G8_WAIT_L(0); G8_MMA(0, 0, At, B0); G8_BAR; G8_SCHED;
            G8_LDB(B1, 0, 1); G8_STAGE(G8_SB(0, 0), rB, boff, (t + 2) * 128);
            G8_BAR; G8_WAIT_L(0); G8_MMA(0, 1, At, B1); G8_BAR;
            G8_LDA(At, 0, 1); G8_STAGE(G8_SA(0, 0), rA, aoff[0], (t + 2) * 128);
            G8_BAR; G8_WAIT_L(0); G8_MMA(1, 0, At, B0); G8_BAR; G8_SCHED;
            G8_STAGE(G8_SB(0, 1), rB, boff, (t + 2) * 128 + bh);
            G8_WAIT_V(6); G8_BAR; G8_MMA(1, 1, At, B1); G8_BAR;
            G8_LDB(B0, 1, 0); G8_SCHED; G8_LDA(At, 1, 0); G8_STAGE(G8_SA(0, 1), rA, aoff[1], (t + 2) * 128);
            G8_WAIT_L(8); G8_BAR; G8_WAIT_L(0); G8_MMA(0, 0, At, B0); G8_BAR; G8_SCHED;
            G8_LDB(B1, 1, 1); G8_STAGE(G8_SB(1, 0), rB, boff, (t + 3) * 128);
            G8_BAR; G8_WAIT_L(0); G8_MMA(0, 1, At, B1); G8_BAR;
            G8_LDA(At, 1, 1); G8_STAGE(G8_SA(1, 0), rA, aoff[0], (t + 3) * 128);
            G8_BAR; G8_WAIT_L(0); G8_MMA(1, 0, At, B0); G8_BAR; G8_SCHED;
            G8_STAGE(G8_SB(1, 1), rB, boff, (t + 3) * 128 + bh);
            G8_WAIT_V(6); G8_BAR; G8_MMA(1, 1, At, B1); G8_BAR;
        }
        { G8_LDB(B0, 0, 0); G8_WAIT_V(0); G8_LDA(At, 0, 0); G8_STAGE(G8_SA(1, 1), rA, aoff[1], (nt - 1) * 128);
          G8_BAR; G8_WAIT_L(0); G8_MMA(0, 0, At, B0); G8_BAR;
          G8_LDB(B1, 0, 1); G8_BAR; G8_WAIT_L(0); G8_MMA(0, 1, At, B1); G8_BAR;
          G8_LDA(At, 0, 1); G8_WAIT_V(4); G8_BAR; G8_WAIT_L(0); G8_MMA(1, 0, At, B0); G8_MMA(1, 1, At, B1); G8_BAR; }
        { G8_LDB(B0, 1, 0); G8_LDA(At, 1, 0); G8_WAIT_V(2); G8_BAR; G8_WAIT_L(0); G8_MMA(0, 0, At, B0); G8_BAR;
          G8_LDB(B1, 1, 1); G8_WAIT_V(0); G8_BAR; G8_WAIT_L(0); G8_MMA(0, 1, At, B1); G8_BAR;
          G8_LDA(At, 1, 1); G8_BAR; G8_WAIT_L(0); G8_MMA(1, 0, At, B0); G8_MMA(1, 1, At, B1); G8_BAR; }
        if (wr == 0) G8_BAR;
        tid = otid(); wid = tid >> 6; lane = tid & 63; wr = wid >> 2; wc = wid & 3; fr = lane & 15; fq = lane >> 4;
        if (has_next) { G8_PREP(nxt, (it + 1) % 3); G8_PRO1(); }
        {
            const int* sr = sRowG + (it % 3) * 256;
#pragma unroll
            for (int ai = 0; ai < 2; ++ai)
#pragma unroll
                for (int bj = 0; bj < 2; ++bj) epi(cm0, cu0, acc[ai][bj], ai * 128 + wr * 64, cn0 + bj * 128 + wc * 32, fr, fq, sr);
        }
        if (!has_next) break;
        cm0 = nxt.m0; cn0 = nxt.n0; cu0 = nxt.u0;
    }
#undef G8_PREP
#undef G8_PRO1
}

struct XcdSeq {
    int q, qend, step;
    __device__ __forceinline__ XcdSeq(int total, int bid, int nb) {
        if ((nb & 7) == 0) { const int chunk = (total + 7) >> 3, x = bid & 7; q = x * chunk + (bid >> 3); const int e = (x + 1) * chunk; qend = e < total ? e : total; step = nb >> 3; }
        else { q = bid; qend = total; step = nb; }
    }
};

template <class Epi>
__device__ __forceinline__ void gemm256_phase(const bf16_t* A, long lda, int M, const bf16_t* Bt, long ldb, int N, int K, char* smem, int bid, int nb, Epi&& epi) {
    const int ntn = N / 256, ntm = M / 256, nt = ntn * ntm;
    XcdSeq s(nt, bid, nb);
    gemm256_stream<false, 0>(
        [&](int i, G8Desc& d) -> bool {
            const int Q = s.q + i * s.step; if (Q >= s.qend) return false;
            const int pnl = Q / (4 * ntn), r = Q - pnl * 4 * ntn;
            d.A = A; d.Bt = Bt; d.list = nullptr; d.m0 = (pnl * 4 + (r & 3)) * 256; d.n0 = (r >> 2) * 256; d.count = 0; d.u0 = 0; d.ldb = (int)ldb;
            return true; },
        (int)lda, K, smem,
        [&](int m0, int, f32x4 (&acc)[4][2], int rt0, int c0, int fr, int fq, const int*) { epi(acc, m0 + rt0, c0, fr, fq); });
}


__device__ __forceinline__ int colmap(int kind, int n, int nsrc) {
    if (kind == 0) return n < nsrc ? n : -1;
    if (kind == 1) { if (n < 512) return n; if (n < 1024) return n + 512; if (n < 1536) return n + 528; if (n < 1552) return n; if (n < 1792) return -1; return n - 1280; }
    if (kind == 2) { if (n < 1024) return n; if (n < 1280) return n + 512; if (n < 4352) return n + 580; if (n < 4420) return n - 2560; if (n < 4608) return -1; if (n < 5120) return n - 3584; return n - 188; }
    { const int grp = n >> 5, w = n & 31; return ((w >> 2) & 1) * 1024 + grp * 16 + 4 * (w >> 3) + (w & 3); }
}
struct ConvTile { const float* src; bf16_t* dst; int sld, sc, K, n0, k0; };
__device__ __forceinline__ ConvTile conv_decode(PRef p, int t, int n4) {
    constexpr int S0 = 128 * 32 * 4, S1 = S0 + 128 * 16 * 4, S2 = S1 + 2 * 36 * 4, S3 = S2 + 2 * 104 * 4, S4 = S3 + 2 * 16 * 4, S5 = S4 + 2 * 16 * 4, S6 = S5 + 2 * 8 * 2;
    char* ws = p.ws;
    ConvTile c; int nsrc, kind, NT, loc;
    if (t < S0) { loc = t; const int mat = loc / (32 * 4); loc -= mat * 32 * 4; c.src = p.moe_w1 + (size_t)mat * 1024 * 2048; c.dst = (bf16_t*)(ws + OFF_WT_W1) + (size_t)mat * 2048 * 1024; c.sld = 2048; nsrc = 2048; kind = 3; c.K = 1024; NT = 32; }
    else if (t < S1) { loc = t - S0; const int mat = loc / 64; loc -= mat * 64; c.src = p.moe_w2 + (size_t)mat * 1024 * 1024; c.dst = (bf16_t*)(ws + OFF_WT_W2) + (size_t)mat * 1024 * 1024; c.sld = 1024; nsrc = 1024; kind = 0; c.K = 1024; NT = 16; }
    else if (t < S2) { loc = t - S1; const int mat = loc / (36 * 4); loc -= mat * 36 * 4; c.src = p.ev_w_in + (size_t)mat * 1024 * 2064; c.dst = (bf16_t*)(ws + OFF_WT_EVIN) + (size_t)mat * EV_N * 1024; c.sld = 2064; nsrc = 2064; kind = 1; c.K = 1024; NT = 36; }
    else if (t < S3) { loc = t - S2; const int mat = loc / (104 * 4); loc -= mat * 104 * 4; c.src = p.od_w_in + (size_t)mat * 1024 * 6468; c.dst = (bf16_t*)(ws + OFF_WT_ODIN) + (size_t)mat * OD_N * 1024; c.sld = 6468; nsrc = 6468; kind = 2; c.K = 1024; NT = 104; }
    else if (t < S4) { loc = t - S3; const int mat = loc / 64; loc -= mat * 64; c.src = p.ev_w_out + (size_t)mat * 1024 * 1024; c.dst = (bf16_t*)(ws + OFF_WT_EVOUT) + (size_t)mat * 1024 * 1024; c.sld = 1024; nsrc = 1024; kind = 0; c.K = 1024; NT = 16; }
    else if (t < S5) { loc = t - S4; const int mat = loc / 64; loc -= mat * 64; c.src = p.od_w_out + (size_t)mat * 1024 * 1024; c.dst = (bf16_t*)(ws + OFF_WT_ODOUT) + (size_t)mat * 1024 * 1024; c.sld = 1024; nsrc = 1024; kind = 0; c.K = 1024; NT = 16; }
    else if (t < S6) { loc = t - S5; const int mat = loc / 16; loc -= mat * 16; c.src = p.s5_w_glu + (size_t)mat * 512 * 512; c.dst = (bf16_t*)(ws + OFF_WT_GLU) + (size_t)mat * 512 * 512; c.sld = 512; nsrc = 512; kind = 0; c.K = 512; NT = 8; }
    else { loc = t - S6; const int mat = loc / 8; loc -= mat * 8; c.src = p.router_w + (size_t)mat * 1024 * 32; c.dst = (bf16_t*)(ws + OFF_WT_RT) + (size_t)mat * 128 * 1024; c.sld = 32; nsrc = 32; kind = 0; c.K = 1024; NT = 2; }
    const int kt = loc / NT, nt = loc - kt * NT;
    c.n0 = nt * 64; c.k0 = kt * 256;
    c.sc = colmap(kind, c.n0 + n4 * 4, nsrc);
    return c;
}
__device__ __forceinline__ void conv_load(const ConvTile& c, int kp, f32x4 (&v)[8]) {
#pragma unroll
    for (int i = 0; i < 4; ++i)
#pragma unroll
        for (int e = 0; e < 2; ++e) {
            const int k = c.k0 + 2 * (kp + 32 * i) + e;
            v[2 * i + e] = c.sc >= 0 ? *(const f32x4*)(c.src + (size_t)k * c.sld + c.sc) : (f32x4){0.f, 0.f, 0.f, 0.f};
        }
}

__device__ __forceinline__ void conv_phase(PRef p, char* smem, int bid, int nb) {
    char* ws = p.ws;
    constexpr int NTILES = 128 * 32 * 4 + 128 * 16 * 4 + 2 * 36 * 4 + 2 * 104 * 4 + 2 * 16 * 4 + 2 * 16 * 4 + 2 * 8 * 2 + 4 * 2 * 4;
    bf16_t* tile = (bf16_t*)smem;
    const int tid = otid(), n4 = tid & 15, kp = tid >> 4;
    if (bid < NTILES) {
        ConvTile cur = conv_decode(p, bid, n4);
        f32x4 v[8];
        conv_load(cur, kp, v);
        for (int t = bid; t < NTILES; t += nb) {
            const bool more = t + nb < NTILES;
            ConvTile nxt = cur; f32x4 w[8];
            if (more) { nxt = conv_decode(p, t + nb, n4); conv_load(nxt, kp, w); }
#pragma unroll
            for (int i = 0; i < 4; ++i)
#pragma unroll
                for (int j = 0; j < 4; ++j)
                    *(unsigned*)(tile + (n4 * 4 + j) * 258 + 2 * (kp + 32 * i)) = pk2(v[2 * i][j], v[2 * i + 1][j]);
            __syncthreads();
#pragma unroll
            for (int i = 0; i < 4; ++i) {
                const int c = tid + 512 * i, n = c >> 5, kc = c & 31;
                const unsigned* tp = (const unsigned*)(tile + n * 258 + kc * 8);
                u32x4 o; o.x = tp[0]; o.y = tp[1]; o.z = tp[2]; o.w = tp[3];
                *(u32x4*)(cur.dst + (size_t)(cur.n0 + n) * cur.K + cur.k0 + kc * 8) = o;
            }
            __syncthreads();
            if (more) {
                cur = nxt;
#pragma unroll
                for (int i = 0; i < 8; ++i) v[i] = w[i];
            }
        }
    }
    {
        const float* x = p.x; bf16_t* xb = (bf16_t*)(ws + OFF_XB);
        const long nch = (long)T_ * 1024 / 8;
        for (long c = (long)bid * NTHR + otid(); c < nch; c += (long)nb * NTHR) {
            const f32x4 a = *(const f32x4*)(x + c * 8), b = *(const f32x4*)(x + c * 8 + 4);
            u32x4 w; w.x = pk2(a[0], a[1]); w.y = pk2(a[2], a[3]); w.z = pk2(b[0], b[1]); w.w = pk2(b[2], b[3]);
            *(u32x4*)(xb + c * 8) = w;
        }
    }
    if (bid == 0 && otid() < 128) ((int*)(ws + OFF_CNT))[otid()] = 0;
}

__device__ __forceinline__ void s5mat_unit(PRef p, int u, char* smem) {
    float* cre = (float*)smem;
    float* cim = cre + 16 * 65;
    float* bbr = cim + 16 * 65;
    float* bbi = bbr + 1024;
    float* pwr = bbi + 1024;
    float* pwi = pwr + 65 * 65;
    float* zr = pwi + 65 * 65;
    float* zi = zr + 64;
    float* Kd = zi + 64 + 2;
    const int tid = otid();
    const int jg = u >> 2, q = u & 3;
    if (tid < 64) {
        const int pp = tid;
        const float lre = fminf(p.s5_a_re[jg * 64 + pp], -1e-4f), lim = p.s5_a_im[jg * 64 + pp];
        const float dt = expf(p.s5_log_dt[jg]);
        const float xr = lre * dt, th = lim * dt;
        const float mag = expf(xr);
        const float ar = mag * cosf(th), ai = mag * sinf(th);
        const float inv = 1.f / (lre * lre + lim * lim);
        zr[pp] = ((ar - 1.f) * lre + ai * lim) * inv;
        zi[pp] = (ai * lre - (ar - 1.f) * lim) * inv;
        float wr_ = 1.f, wi_ = 0.f;
        for (int d = 0; d <= 64; ++d) {
            pwr[d * 65 + pp] = wr_; pwi[d * 65 + pp] = wi_;
            const float nr = wr_ * ar - wi_ * ai, ni = wr_ * ai + wi_ * ar;
            wr_ = nr; wi_ = ni;
        }
    } else {
        for (int e = tid - 64; e < 1024; e += NTHR - 64) {
            const int n = e >> 6, pp = e & 63;
            cre[n * 65 + pp] = p.s5_c_re[(size_t)jg * 1024 + e];
            cim[n * 65 + pp] = p.s5_c_im[(size_t)jg * 1024 + e];
        }
    }
    __syncthreads();
    for (int e = tid; e < 1024; e += NTHR) {
        const int pp = e >> 4;
        const float br = p.s5_b_re[(size_t)jg * 1024 + e], bi = p.s5_b_im[(size_t)jg * 1024 + e];
        bbr[e] = zr[pp] * br - zi[pp] * bi;
        bbi[e] = zr[pp] * bi + zi[pp] * br;
    }
    __syncthreads();
    if (tid < 256) {
        const int mh = tid & 1, nl = (tid >> 1) & 3, dp = tid >> 3, n = 4 * q + nl;
        float acc0[8], acc1[8];
#pragma unroll
        for (int i = 0; i < 8; ++i) { acc0[i] = 0.f; acc1[i] = 0.f; }
#pragma unroll 2
        for (int pp = 0; pp < 64; ++pp) {
            const float cr = cre[n * 65 + pp], ci = cim[n * 65 + pp];
            const float q0r = pwr[(2 * dp) * 65 + pp], q0i = pwi[(2 * dp) * 65 + pp], q1r = pwr[(2 * dp + 1) * 65 + pp], q1i = pwi[(2 * dp + 1) * 65 + pp];
            const float v0r = cr * q0r - ci * q0i, v0i = cr * q0i + ci * q0r, v1r = cr * q1r - ci * q1i, v1i = cr * q1i + ci * q1r;
            const f32x4 ba = *(const f32x4*)(bbr + pp * 16 + mh * 8), bb_ = *(const f32x4*)(bbr + pp * 16 + mh * 8 + 4);
            const f32x4 ia = *(const f32x4*)(bbi + pp * 16 + mh * 8), ib = *(const f32x4*)(bbi + pp * 16 + mh * 8 + 4);
#pragma unroll
            for (int i = 0; i < 8; ++i) {
                const float br = i < 4 ? ba[i & 3] : bb_[i & 3], bi = i < 4 ? ia[i & 3] : ib[i & 3];
                acc0[i] += v0r * br - v0i * bi;
                acc1[i] += v1r * br - v1i * bi;
            }
        }
        float* k0 = Kd + ((2 * dp) * 4 + nl) * 16 + mh * 8;
        *(f32x4*)(k0) = (f32x4){acc0[0], acc0[1], acc0[2], acc0[3]};
        *(f32x4*)(k0 + 4) = (f32x4){acc0[4], acc0[5], acc0[6], acc0[7]};
        *(f32x4*)(k0 + 64) = (f32x4){acc1[0], acc1[1], acc1[2], acc1[3]};
        *(f32x4*)(k0 + 68) = (f32x4){acc1[4], acc1[5], acc1[6], acc1[7]};
    }
    __syncthreads();
    bf16_t* TH = (bf16_t*)(p.ws + OFF_TH) + (size_t)jg * 1024 * UHW;
    for (int c = tid; c < 256 * 144; c += NTHR) {
        const int rl = c / 144, ch = c - rl * 144;
        const int tau = rl >> 2, nl = rl & 3, n = 4 * q + nl;
        float v[8];
        if (ch < 128) {
            const int s = ch >> 1, m0 = (ch & 1) * 8;
            if (s <= tau) {
                const f32x4 a = *(const f32x4*)(Kd + ((tau - s) * 4 + nl) * 16 + m0), b = *(const f32x4*)(Kd + ((tau - s) * 4 + nl) * 16 + m0 + 4);
#pragma unroll
                for (int i = 0; i < 4; ++i) { v[i] = a[i]; v[4 + i] = b[i]; }
            } else {
#pragma unroll
                for (int i = 0; i < 8; ++i) v[i] = 0.f;
            }
        } else {
            const int p0 = (ch - 128) * 4;
#pragma unroll
            for (int i = 0; i < 4; ++i) {
                const int pp = p0 + i;
                const float cr = cre[n * 65 + pp], ci = cim[n * 65 + pp], qr = pwr[(tau + 1) * 65 + pp], qi = pwi[(tau + 1) * 65 + pp];
                v[2 * i] = cr * qr - ci * qi;
                v[2 * i + 1] = -(cr * qi + ci * qr);
            }
        }
        u32x4 w; w.x = pk2(v[0], v[1]); w.y = pk2(v[2], v[3]); w.z = pk2(v[4], v[5]); w.w = pk2(v[6], v[7]);
        *(u32x4*)(TH + (size_t)(tau * 16 + n) * UHW + ch * 8) = w;
    }
    bf16_t* GM = (bf16_t*)(p.ws + OFF_GM) + (size_t)jg * 128 * 1024;
    for (int c = tid; c < 32 * 128; c += NTHR) {
        const int row = 32 * q + (c >> 7), ch = c & 127;
        const int pp = row >> 1, ri = row & 1;
        const int s = ch >> 1, m0 = (ch & 1) * 8;
        const float qr = pwr[(63 - s) * 65 + pp], qi = pwi[(63 - s) * 65 + pp];
        float v[8];
#pragma unroll
        for (int i = 0; i < 8; ++i) {
            const float br = bbr[pp * 16 + m0 + i], bi = bbi[pp * 16 + m0 + i];
            v[i] = ri == 0 ? (qr * br - qi * bi) : (qr * bi + qi * br);
        }
        u32x4 w; w.x = pk2(v[0], v[1]); w.y = pk2(v[2], v[3]); w.z = pk2(v[4], v[5]); w.w = pk2(v[6], v[7]);
        *(u32x4*)(GM + (size_t)row * 1024 + ch * 8) = w;
    }
    if (q == 0 && tid < 64) {
        float* A64 = (float*)(p.ws + OFF_A64) + (size_t)jg * 128;
        A64[tid * 2] = pwr[64 * 65 + tid];
        A64[tid * 2 + 1] = pwi[64 * 65 + tid];
    }
    __syncthreads();
}

__device__ __forceinline__ void epi_ev_in(PRef p, f32x4 (&acc)[4][2], int row0, int c0, int fr, int fq) {
    char* ws = p.ws;
    bf16_t* PE = (bf16_t*)(ws + OFF_PE); bf16_t* UH = (bf16_t*)(ws + OFF_UH); float* GLR = (float*)(ws + OFF_GLR);
    const int col = c0 + 8 * fq;
#pragma unroll
    for (int m = 0; m < 4; ++m) {
        const int t = row0 + m * 16 + fr;
        u32x4 w; w.x = pk2(acc[m][0][0], acc[m][0][1]); w.y = pk2(acc[m][0][2], acc[m][0][3]); w.z = pk2(acc[m][1][0], acc[m][1][1]); w.w = pk2(acc[m][1][2], acc[m][1][3]);
        if (c0 < 1024) {
            *(u32x4*)(PE + (size_t)t * PE_W + col) = w;
        } else if (c0 < 1536) {
            const int ch = col - 1024, g = ch >> 4, mm = ch & 15;
            *(u32x4*)(UH + ((size_t)(t >> 6) * 32 + g) * UHW + (t & 63) * 16 + mm) = w;
        } else if (col < 1552) {
            *(f32x4*)(GLR + (size_t)t * 16 + (col - 1536)) = acc[m][0];
            *(f32x4*)(GLR + (size_t)t * 16 + (col - 1536) + 4) = acc[m][1];
        }
    }
}
__device__ __forceinline__ void epi_vt(bf16_t* __restrict__ img_row0, f32x4 (&acc)[4][2], int rt0, int c0, int fr, int fq) {
#pragma unroll
    for (int m = 0; m < 4; ++m) {
        u32x4 w; w.x = pk2(acc[m][0][0], acc[m][0][1]); w.y = pk2(acc[m][0][2], acc[m][0][3]); w.z = pk2(acc[m][1][0], acc[m][1][1]); w.w = pk2(acc[m][1][2], acc[m][1][3]);
        *(u32x4*)(img_row0 + (size_t)(rt0 + m * 16 + fr) * L_ + c0 + 8 * fq) = w;
    }
}

__device__ __forceinline__ void gla_decay(PRef p, int j, int t0, int h, float* sB) {
    const float* GLR = (const float*)(p.ws + OFF_GLR);
    const float* w2 = p.gla_w_gate2 + (size_t)j * 16 * 256;
    const float* b2 = p.gla_b_gate2 + (size_t)j * 256;
    const int tid = otid();
    for (int e = tid; e < 4096; e += NTHR) {
        const int tau = e >> 6, d = e & 63;
        float a = b2[h * 64 + d];
#pragma unroll
        for (int r = 0; r < 16; ++r) a += GLR[(size_t)(t0 + tau) * 16 + r] * w2[r * 256 + h * 64 + d];
        const float ls = fminf(a, 0.f) - __logf(1.f + __expf(-fabsf(a)));
        sB[tau * 65 + d] = ls * (1.f / 16.f);
    }
    __syncthreads();
    if (tid < 64) { float run = 0.f; for (int tau = 0; tau < 64; ++tau) { run += sB[tau * 65 + tid]; sB[tau * 65 + tid] = run; } }
    __syncthreads();
}

__device__ __forceinline__ void gla_a_item(PRef p, int j, int item, char* smem) {
    const int h = item & 3, c = (item >> 2) & 255, b = item >> 10;
    const int t0 = b * L_ + c * 64;
    float* sB = (float*)smem;
    bf16_t* AK = (bf16_t*)(smem + 16640);
    const bf16_t* PE = (const bf16_t*)(p.ws + OFF_PE);
    const bf16_t* VTE = (const bf16_t*)(p.ws + OFF_VTE);
    const int tid = otid(), lane = tid & 63, wave = tid >> 6, fr = lane & 15, fq = lane >> 4;
    gla_decay(p, j, t0, h, sB);
    for (int e = tid; e < 4096; e += NTHR) {
        const int tau = e >> 6, d = e & 63;
        const float k = bf2f(PE[(size_t)(t0 + tau) * PE_W + 256 + h * 64 + d]);
        AK[d * 72 + tau] = f2bf(k * __expf(sB[63 * 65 + d] - sB[tau * 65 + d]));
    }
    __syncthreads();
    const int dblk = wave >> 1, vb = (wave & 1) * 64;
    f32x4 acc[4];
#pragma unroll
    for (int n = 0; n < 4; ++n) acc[n] = (f32x4){0.f, 0.f, 0.f, 0.f};
#pragma unroll
    for (int ks = 0; ks < 2; ++ks) {
        const bf16x8 af = *(const bf16x8*)(AK + (dblk * 16 + fr) * 72 + ks * 32 + fq * 8);
#pragma unroll
        for (int n = 0; n < 4; ++n) {
            const int v = vb + n * 16 + fr;
            const bf16x8 bfr = *(const bf16x8*)(VTE + ((size_t)((b * 4 + h) * 128 + v)) * L_ + (c * 64 + ks * 32 + fq * 8));
            acc[n] = __builtin_amdgcn_mfma_f32_16x16x32_bf16(af, bfr, acc[n], 0, 0, 0);
        }
    }
    float* KV = (float*)(p.ws + OFF_KV) + ((size_t)((b * 256 + c) * 4 + h)) * 64 * 128;
#pragma unroll
    for (int n = 0; n < 4; ++n)
#pragma unroll
        for (int r = 0; r < 4; ++r) KV[(dblk * 16 + fq * 4 + r) * 128 + vb + n * 16 + fr] = acc[n][r];
    if (tid < 64) ((float*)(p.ws + OFF_DEC))[((size_t)((b * 256 + c) * 4 + h)) * 64 + tid] = __expf(sB[63 * 65 + tid]);
    __syncthreads();
}

__device__ __forceinline__ void scan_phase(PRef p, int j, int bid) {
    const int gid = bid * NTHR + otid();
    if (gid < 65536) {
        const int v = gid & 127, d = (gid >> 7) & 63, h = (gid >> 13) & 3, b = gid >> 15;
        const float* KV = (const float*)(p.ws + OFF_KV); float* SST = (float*)(p.ws + OFF_SST); const float* DEC = (const float*)(p.ws + OFF_DEC);
        float S = 0.f;
        for (int c0 = 0; c0 < 256; c0 += 8) {
            float kv[8], dc[8];
#pragma unroll
            for (int i = 0; i < 8; ++i) {
                const size_t blk = (size_t)((b * 256 + c0 + i) * 4 + h);
                kv[i] = KV[(blk * 64 + d) * 128 + v]; dc[i] = DEC[blk * 64 + d];
            }
#pragma unroll
            for (int i = 0; i < 8; ++i) {
                const size_t blk = (size_t)((b * 256 + c0 + i) * 4 + h);
                SST[(blk * 64 + d) * 128 + v] = S;
                S = dc[i] * S + kv[i];
            }
        }
    } else if (gid < 65536 + 4096) {
        const int e = gid - 65536, pp = e & 63, g = (e >> 6) & 31, b = e >> 11;
        const float* A64 = (const float*)(p.ws + OFF_A64) + (size_t)(j * 32 + g) * 128;
        const float ar = A64[pp * 2], ai = A64[pp * 2 + 1];
        const float* GB = (const float*)(p.ws + OFF_GBUF); bf16_t* UH = (bf16_t*)(p.ws + OFF_UH);
        float hr = 0.f, hi = 0.f;
        for (int c0 = 0; c0 < 256; c0 += 8) {
            float gr[8], gi[8];
#pragma unroll
            for (int i = 0; i < 8; ++i) { const size_t row = (size_t)(b * 256 + c0 + i) * 32 + g; gr[i] = GB[row * 128 + 2 * pp]; gi[i] = GB[row * 128 + 2 * pp + 1]; }
#pragma unroll
            for (int i = 0; i < 8; ++i) {
                const size_t row = (size_t)(b * 256 + c0 + i) * 32 + g;
                *(unsigned*)(UH + row * UHW + 1024 + 2 * pp) = pk2(hr, hi);
                const float nr = ar * hr - ai * hi + gr[i], ni = ar * hi + ai * hr + gi[i];
                hr = nr; hi = ni;
            }
        }
    }
}

__device__ __forceinline__ void gla_c_item(PRef p, int j, int item, char* smem) {
    const int h = item & 3, c = (item >> 2) & 255, b = item >> 10;
    const int t0 = b * L_ + c * 64;
    float* sB = (float*)smem;
    bf16_t* QT = (bf16_t*)(smem + 16640);
    bf16_t* KT = (bf16_t*)(smem + 16640 + 9216);
    bf16_t* ATT = (bf16_t*)(smem + 16640 + 18432);
    float* OS = (float*)(smem + 16640 + 27648);
    const bf16_t* PE = (const bf16_t*)(p.ws + OFF_PE);
    const bf16_t* VTE = (const bf16_t*)(p.ws + OFF_VTE);
    const int tid = otid(), lane = tid & 63, wave = tid >> 6, fr = lane & 15, fq = lane >> 4;
    gla_decay(p, j, t0, h, sB);
    for (int e = tid; e < 4096; e += NTHR) {
        const int tau = e >> 6, d = e & 63;
        const float bb = sB[tau * 65 + d];
        const float q = bf2f(PE[(size_t)(t0 + tau) * PE_W + h * 64 + d]);
        const float k = bf2f(PE[(size_t)(t0 + tau) * PE_W + 256 + h * 64 + d]);
        QT[tau * 72 + d] = f2bf(q * 0.125f * __expf(bb));
        KT[tau * 72 + d] = f2bf(k * __expf(-bb));
    }
    __syncthreads();
    const int iblk = wave >> 1;
    {
        f32x4 acc[2];
        acc[0] = (f32x4){0.f, 0.f, 0.f, 0.f}; acc[1] = acc[0];
#pragma unroll
        for (int ks = 0; ks < 2; ++ks) {
            const bf16x8 af = *(const bf16x8*)(QT + (iblk * 16 + fr) * 72 + ks * 32 + fq * 8);
#pragma unroll
            for (int n = 0; n < 2; ++n) {
                const int jb = (wave & 1) * 2 + n;
                const bf16x8 bfr = *(const bf16x8*)(KT + (jb * 16 + fr) * 72 + ks * 32 + fq * 8);
                acc[n] = __builtin_amdgcn_mfma_f32_16x16x32_bf16(af, bfr, acc[n], 0, 0, 0);
            }
        }
#pragma unroll
        for (int n = 0; n < 2; ++n) {
            const int jj = ((wave & 1) * 2 + n) * 16 + fr;
#pragma unroll
            for (int r = 0; r < 4; ++r) { const int ii = iblk * 16 + fq * 4 + r; ATT[ii * 72 + jj] = f2bf(jj <= ii ? acc[n][r] : 0.f); }
        }
    }
    __syncthreads();
    {
        const int vb = (wave & 1) * 64;
        const float* SST = (const float*)(p.ws + OFF_SST) + ((size_t)((b * 256 + c) * 4 + h)) * 64 * 128;
        f32x4 acc[4];
#pragma unroll
        for (int n = 0; n < 4; ++n) acc[n] = (f32x4){0.f, 0.f, 0.f, 0.f};
#pragma unroll
        for (int ks = 0; ks < 2; ++ks) {
            const bf16x8 af = *(const bf16x8*)(ATT + (iblk * 16 + fr) * 72 + ks * 32 + fq * 8);
            const bf16x8 aq = *(const bf16x8*)(QT + (iblk * 16 + fr) * 72 + ks * 32 + fq * 8);
#pragma unroll
            for (int n = 0; n < 4; ++n) {
                const int v = vb + n * 16 + fr;
                const bf16x8 bv = *(const bf16x8*)(VTE + ((size_t)((b * 4 + h) * 128 + v)) * L_ + (c * 64 + ks * 32 + fq * 8));
                acc[n] = __builtin_amdgcn_mfma_f32_16x16x32_bf16(af, bv, acc[n], 0, 0, 0);
                bf16x8 bs;
#pragma unroll
                for (int i = 0; i < 8; ++i) bs[i] = (short)f2bf(SST[(ks * 32 + fq * 8 + i) * 128 + v]);
                acc[n] = __builtin_amdgcn_mfma_f32_16x16x32_bf16(aq, bs, acc[n], 0, 0, 0);
            }
        }
#pragma unroll
        for (int n = 0; n < 4; ++n)
#pragma unroll
            for (int r = 0; r < 4; ++r) OS[(iblk * 16 + fq * 4 + r) * 132 + vb + n * 16 + fr] = acc[n][r];
    }
    __syncthreads();
    {
        const int i = tid >> 3, seg = tid & 7;
        float o[16]; float ss = 0.f;
#pragma unroll
        for (int q = 0; q < 16; ++q) { o[q] = OS[i * 132 + seg * 16 + q]; ss += o[q] * o[q]; }
        ss += __shfl_xor(ss, 1, 64); ss += __shfl_xor(ss, 2, 64); ss += __shfl_xor(ss, 4, 64);
        const float rs = rsqrtf(ss * (1.f / 128.f) + LN_EPS);
        const float* ng = p.gla_norm_g + (size_t)j * 128;
        bf16_t* CC = (bf16_t*)(p.ws + OFF_CC);
        const size_t t = (size_t)(t0 + i);
        unsigned w[8];
#pragma unroll
        for (int q = 0; q < 16; q += 2) {
            const int v0 = seg * 16 + q;
            const float r0 = bf2f(PE[t * PE_W + 512 + h * 128 + v0]), r1 = bf2f(PE[t * PE_W + 512 + h * 128 + v0 + 1]);
            const float a0 = o[q] * rs * ng[v0] * (r0 * sigmoidf_(r0)), a1 = o[q + 1] * rs * ng[v0 + 1] * (r1 * sigmoidf_(r1));
            w[q >> 1] = pk2(a0, a1);
        }
        u32x4 w0, w1; w0.x = w[0]; w0.y = w[1]; w0.z = w[2]; w0.w = w[3]; w1.x = w[4]; w1.y = w[5]; w1.z = w[6]; w1.w = w[7];
        *(u32x4*)(CC + t * 1024 + h * 128 + seg * 16) = w0;
        *(u32x4*)(CC + t * 1024 + h * 128 + seg * 16 + 8) = w1;
    }
    __syncthreads();
}

__device__ __forceinline__ void s5_g_phase(PRef p, int j, char* smem, int bid, int nb) {
    const bf16_t* UH = (const bf16_t*)(p.ws + OFF_UH);
    float* GB = (float*)(p.ws + OFF_GBUF);
    for (int t = bid; t < 64; t += nb) {
        const int g = t >> 1, mi = t & 1;
        const bf16_t* Bt = (const bf16_t*)(p.ws + OFF_GM) + (size_t)(j * 32 + g) * 128 * 1024;
        gemm_tile<false>(UH + (size_t)g * UHW, (long)32 * UHW, 0, mi * 256, Bt, 1024, 0, 1024, smem,
            [&](f32x4 (&acc)[4][2], int rt0, int c0, int fr, int fq) {
#pragma unroll
                for (int m = 0; m < 4; ++m)
#pragma unroll
                    for (int n = 0; n < 2; ++n)
#pragma unroll
                        for (int r = 0; r < 4; ++r) {
                            const int row = mi * 256 + rt0 + m * 16 + fq * 4 + r;
                            GB[((size_t)row * 32 + g) * 128 + c0 + n * 16 + fr] = acc[m][n][r];
                        }
            });
    }
}
__device__ __forceinline__ void s5_y_phase(PRef p, int j, char* smem, int bid, int nb) {
    const bf16_t* UH = (const bf16_t*)(p.ws + OFF_UH);
    bf16_t* YA = (bf16_t*)(p.ws + OFF_YA);
    const float* dsk = p.s5_d + (size_t)j * 512;
    XcdSeq sq(32 * 2 * 4, bid, nb);
    for (int t = sq.q; t < sq.qend; t += sq.step) {
        const int g = t >> 3, mi = (t >> 2) & 1, ni = t & 3;
        const bf16_t* Bt = (const bf16_t*)(p.ws + OFF_TH) + (size_t)(j * 32 + g) * 1024 * UHW;
        gemm256_tile<false>(UH + (size_t)g * UHW, (long)32 * UHW, 0, mi * 256, Bt, UHW, ni * 256, UHW, smem,
            [&](f32x4 (&acc)[4][2], int rt0, int c0, int fr, int fq) {
                const int col = c0 + 8 * fq;
                const int tau = col >> 4, nn = col & 15, ch = g * 16 + nn;
                const f32x4 d0 = *(const f32x4*)(dsk + ch), d1 = *(const f32x4*)(dsk + ch + 4);
#pragma unroll
                for (int m = 0; m < 4; ++m) {
                    const int row = mi * 256 + rt0 + m * 16 + fr;
                    const u32x4 uw = *(const u32x4*)(UH + ((size_t)row * 32 + g) * UHW + col);
                    float y[8];
#pragma unroll
                    for (int q = 0; q < 4; ++q) {
                        const unsigned u2 = q == 0 ? uw.x : q == 1 ? uw.y : q == 2 ? uw.z : uw.w;
                        const float u0 = __uint_as_float(u2 << 16), u1 = __uint_as_float(u2 & 0xffff0000u);
                        const float a0 = q < 2 ? acc[m][0][2 * q] : acc[m][1][2 * q - 4], a1 = q < 2 ? acc[m][0][2 * q + 1] : acc[m][1][2 * q - 3];
                        const float dd0 = q < 2 ? d0[2 * q] : d1[2 * q - 4], dd1 = q < 2 ? d0[2 * q + 1] : d1[2 * q - 3];
                        y[2 * q] = gelu_tanh(a0 + dd0 * u0); y[2 * q + 1] = gelu_tanh(a1 + dd1 * u1);
                    }
                    u32x4 w; w.x = pk2(y[0], y[1]); w.y = pk2(y[2], y[3]); w.z = pk2(y[4], y[5]); w.w = pk2(y[6], y[7]);
                    *(u32x4*)(YA + ((size_t)row * 64 + tau) * 512 + ch) = w;
                }
            });
    }
}

template <bool SLOTS, bool NOEPI = false>
__device__ __forceinline__ void ln_phase(PRef p, const bf16_t* xin, const float* addb, const float* g, const float* bta, float* xout, bf16_t* xb, int bid, int nb) {
    const int lane = otid() & 63, wave = otid() >> 6;
    for (int t = bid * 8 + wave; t < T_; t += nb * 8) {
        f32x4 v[4];
        float s = 0.f;
#pragma unroll
        for (int i = 0; i < 4; ++i) {
            const int c = i * 256 + lane * 4;
            f32x4 a;
            { const u32x2 xw = *(const u32x2*)(xin + (size_t)t * 1024 + c); a = (f32x4){__uint_as_float(xw.x << 16), __uint_as_float(xw.x & 0xffff0000u), __uint_as_float(xw.y << 16), __uint_as_float(xw.y & 0xffff0000u)}; }
            f32x4 m;
            if (SLOTS) {
                const bf16_t* sl = (const bf16_t*)addb;
                m = (f32x4){0.f, 0.f, 0.f, 0.f};
#pragma unroll
                for (int k = 0; k < 4; ++k) {
                    const u32x2 w = *(const u32x2*)(sl + ((size_t)t * 4 + k) * 1024 + c);
                    m[0] += __uint_as_float(w.x << 16); m[1] += __uint_as_float(w.x & 0xffff0000u); m[2] += __uint_as_float(w.y << 16); m[3] += __uint_as_float(w.y & 0xffff0000u);
                }
            } else m = *(const f32x4*)(addb + (size_t)t * 1024 + c);
            v[i] = a * ALPHA + m;
            s += v[i][0] + v[i][1] + v[i][2] + v[i][3];
        }
        const float mu = wave_sum(s) * (1.f / 1024.f);
        float q = 0.f;
#pragma unroll
        for (int i = 0; i < 4; ++i) { v[i] -= mu; q += v[i][0] * v[i][0] + v[i][1] * v[i][1] + v[i][2] * v[i][2] + v[i][3] * v[i][3]; }
        const float rs = rsqrtf(wave_sum(q) * (1.f / 1024.f) + LN_EPS);
#pragma unroll
        for (int i = 0; i < 4; ++i) {
            const int c = i * 256 + lane * 4;
            const f32x4 gg = *(const f32x4*)(g + c), bb = *(const f32x4*)(bta + c);
            const f32x4 o = v[i] * rs * gg + bb;
            if (xout && (!NOEPI || rs == -1.f)) *(f32x4*)(xout + (size_t)t * 1024 + c) = o;
            if (xb && (!NOEPI || rs == -1.f)) { u32x2 w; w.x = pk2(o[0], o[1]); w.y = pk2(o[2], o[3]); *(u32x2*)(xb + (size_t)t * 1024 + c) = w; }
        }
    }
}

constexpr int RT_STRIDE = 36;
constexpr int RT_SCR_OFF = 1024 * RT_STRIDE * 4;
template <bool NOEPI = false>
__device__ __forceinline__ void ln1_router_phase(PRef p, int layer, char* smem, int bid, int nb) {
    float* wl = (float*)smem;
    const int tid = otid(), lane = tid & 63, wave = tid >> 6;
    float* lgs = (float*)(smem + RT_SCR_OFF + wave * 640);
    int* pick = (int*)(lgs + 32);
    float* pgate = (float*)(pick + 64);
    {
        const float* rw = p.router_w + (size_t)layer * 1024 * 32;
        for (int e = tid; e < 32768; e += NTHR) {
            const int k = e >> 5, ex = e & 31, rem = k & 255;
            wl[((k & ~255) + (rem & 3) * 64 + (rem >> 2)) * RT_STRIDE + ex] = rw[e];
        }
    }
    __syncthreads();
    const bf16_t* addb = (const bf16_t*)(p.ws + OFF_MIX);
    const float* g = p.ln1_g + (size_t)layer * 1024; const float* bta = p.ln1_b + (size_t)layer * 1024;
    bf16_t* xb = (bf16_t*)(p.ws + OFF_XB);
    const bf16_t* xin = xb;
    int* cnt = (int*)(p.ws + OFF_CNT) + layer * 32;
    int* LIST = (int*)(p.ws + OFF_LIST);
    float* GATE = (float*)(p.ws + OFF_GATE);
    const float rbias = p.router_b[(size_t)layer * 32 + (lane >> 1)];
    const int rstep = nb * 8;
    u32x2 xw[2][4], mw[2][4];
#define ROWLOAD(T, R) do { _Pragma("unroll") for (int i_ = 0; i_ < 4; ++i_) { const int c_ = i_ * 256 + lane * 4; xw[R][i_] = *(const u32x2*)(xin + (size_t)(T) * 1024 + c_); mw[R][i_] = *(const u32x2*)(addb + (size_t)(T) * 1024 + c_); } } while (0)
    {
        const int t0 = bid * 8 + wave;
        if (t0 < T_) ROWLOAD(t0, 0);
        if (t0 + rstep < T_) ROWLOAD(t0 + rstep, 1);
    }
    for (int tb = bid * 8 + wave; tb < T_; tb += rstep * 16) {
        int nrow = 0;
#pragma unroll 1
        for (int t = tb; t < T_ && nrow < 16; t += 2 * rstep) {
            const bool has1 = t + rstep < T_;
            f32x4 v[2][4];
            float s[2];
#pragma unroll
            for (int r = 0; r < 2; ++r) {
                s[r] = 0.f;
#pragma unroll
                for (int i = 0; i < 4; ++i) {
                    const f32x4 a = (f32x4){__uint_as_float(xw[r][i].x << 16), __uint_as_float(xw[r][i].x & 0xffff0000u), __uint_as_float(xw[r][i].y << 16), __uint_as_float(xw[r][i].y & 0xffff0000u)};
                    const f32x4 m = (f32x4){__uint_as_float(mw[r][i].x << 16), __uint_as_float(mw[r][i].x & 0xffff0000u), __uint_as_float(mw[r][i].y << 16), __uint_as_float(mw[r][i].y & 0xffff0000u)};
                    v[r][i] = a * ALPHA + m; s[r] += v[r][i][0] + v[r][i][1] + v[r][i][2] + v[r][i][3];
                }
            }
            if (t + 2 * rstep < T_) ROWLOAD(t + 2 * rstep, 0);
            if (t + 3 * rstep < T_) ROWLOAD(t + 3 * rstep, 1);
#pragma unroll
            for (int r = 0; r < 2; ++r) {
                const float mu = wave_sum(s[r]) * (1.f / 1024.f);
                float q = 0.f;
#pragma unroll
                for (int i = 0; i < 4; ++i) { v[r][i] -= mu; q += v[r][i][0] * v[r][i][0] + v[r][i][1] * v[r][i][1] + v[r][i][2] * v[r][i][2] + v[r][i][3] * v[r][i][3]; }
                const float rs = rsqrtf(wave_sum(q) * (1.f / 1024.f) + LN_EPS);
#pragma unroll
                for (int i = 0; i < 4; ++i) {
                    const int c = i * 256 + lane * 4;
                    const f32x4 gg = *(const f32x4*)(g + c), bb = *(const f32x4*)(bta + c);
                    v[r][i] = v[r][i] * rs * gg + bb;
                    if ((r == 0 || has1) && (!NOEPI || rs == -1.f)) {
                    u32x2 w; w.x = pk2(v[r][i][0], v[r][i][1]); w.y = pk2(v[r][i][2], v[r][i][3]); *(u32x2*)(xb + (size_t)(t + r * rstep) * 1024 + c) = w; }
                }
            }
            f32x4 acc[2][8];
#pragma unroll
            for (int e = 0; e < 8; ++e) { acc[0][e] = (f32x4){0.f, 0.f, 0.f, 0.f}; acc[1][e] = (f32x4){0.f, 0.f, 0.f, 0.f}; }
#pragma unroll
            for (int i = 0; i < 4; ++i)
#pragma unroll
                for (int j = 0; j < 4; ++j) {
                    const f32x4* wr_ = (const f32x4*)(wl + (i * 256 + j * 64 + lane) * RT_STRIDE);
                    const float xv0 = v[0][i][j], xv1 = v[1][i][j];
#pragma unroll
                    for (int e = 0; e < 8; ++e) { const f32x4 w = wr_[e]; acc[0][e] += w * xv0; acc[1][e] += w * xv1; }
                    if (j & 1) __builtin_amdgcn_sched_barrier(0);
                }
#pragma unroll
            for (int e = 0; e < 8; ++e)
#pragma unroll
                for (int k = 0; k < 4; ++k) { float a0 = acc[0][e][k], a1 = acc[1][e][k]; asm volatile("" : "+v"(a0), "+v"(a1)); acc[0][e][k] = a0; acc[1][e][k] = a1; }
#pragma unroll
            for (int r = 0; r < 2; ++r) {
                float k16[16], k8[8], k4[4], k2[2];
#pragma unroll
                for (int a = 0; a < 16; ++a) { auto rr = __builtin_amdgcn_permlane32_swap(__float_as_uint(acc[r][a >> 2][a & 3]), __float_as_uint(acc[r][(a + 16) >> 2][a & 3]), false, false); k16[a] = __uint_as_float(rr[0]) + __uint_as_float(rr[1]); }
#pragma unroll
                for (int a = 0; a < 8; ++a) { auto rr = __builtin_amdgcn_permlane16_swap(__float_as_uint(k16[a]), __float_as_uint(k16[a + 8]), false, false); k8[a] = __uint_as_float(rr[0]) + __uint_as_float(rr[1]); }
                { const bool hb = lane & 8;
#pragma unroll
                  for (int a = 0; a < 4; ++a) { const float mine = hb ? k8[a + 4] : k8[a], send = hb ? k8[a] : k8[a + 4]; k4[a] = mine + dppf<DPP_ROR8>(send); } }
                { const bool hb = lane & 4;
#pragma unroll
                  for (int a = 0; a < 2; ++a) { const float mine = hb ? k4[a + 2] : k4[a], send = hb ? k4[a] : k4[a + 2]; k2[a] = mine + dppf<DPP_HMIR>(send); } }
                float lg;
                { const bool hb = lane & 2; const float mine = hb ? k2[1] : k2[0], send = hb ? k2[0] : k2[1]; lg = mine + dppf<DPP_X2>(send); }
                lg += dppf<DPP_X1>(lg);
                lg += rbias;
                float cand = (lane & 1) ? -INFINITY : lg;
                float tv[4]; int te[4];
#pragma unroll
                for (int k = 0; k < 4; ++k) {
                    const float mxv = wave_max(cand);
                    const unsigned long long bal = __builtin_amdgcn_ballot_w64(cand == mxv);
                    const int first = __builtin_ctzll(bal);
                    tv[k] = mxv; te[k] = first >> 1;
                    if (lane == first) cand = -INFINITY;
                }
                if (lane == 0 && (r == 0 || has1)) {
                    const float e1 = __expf(tv[1] - tv[0]), e2 = __expf(tv[2] - tv[0]), e3 = __expf(tv[3] - tv[0]);
                    const float inv = 1.f / (1.f + e1 + e2 + e3);
                    const int nr = nrow + r;
                    pick[nr * 4 + 0] = te[0]; pick[nr * 4 + 1] = te[1]; pick[nr * 4 + 2] = te[2]; pick[nr * 4 + 3] = te[3];
                    pgate[nr * 4 + 0] = inv; pgate[nr * 4 + 1] = e1 * inv; pgate[nr * 4 + 2] = e2 * inv; pgate[nr * 4 + 3] = e3 * inv;
                }
            }
            nrow += has1 ? 2 : 1;
        }
        if ((lane >> 2) < nrow && (!NOEPI || pgate[lane] < -1.f)) {
            const int t = tb + (lane >> 2) * rstep, ex = pick[lane], pair = t * 4 + (lane & 3);
            const int pos = atomicAdd(&cnt[ex], 1);
            LIST[(size_t)ex * LISTCAP + pos] = pair;
            GATE[pair] = pgate[lane];
        }
    }
}

__device__ __forceinline__ void topk_phase(PRef p, int layer, int bid, int nb) {
    const float* LG = (const float*)(p.ws + OFF_LOGIT);
    int* cnt = (int*)(p.ws + OFF_CNT) + layer * 32;
    int* LIST = (int*)(p.ws + OFF_LIST);
    float* GATE = (float*)(p.ws + OFF_GATE);
    for (int t = bid * NTHR + otid(); t < T_; t += nb * NTHR) {
        float v0 = -INFINITY, v1 = -INFINITY, v2 = -INFINITY, v3 = -INFINITY; int i0 = 0, i1 = 0, i2 = 0, i3 = 0;
#pragma unroll
        for (int q = 0; q < 8; ++q) {
            const f32x4 l4 = *(const f32x4*)(LG + (size_t)t * 32 + q * 4);
#pragma unroll
            for (int r = 0; r < 4; ++r) {
                const float v = l4[r]; const int e = q * 4 + r;
                if (v > v0) { v3 = v2; i3 = i2; v2 = v1; i2 = i1; v1 = v0; i1 = i0; v0 = v; i0 = e; }
                else if (v > v1) { v3 = v2; i3 = i2; v2 = v1; i2 = i1; v1 = v; i1 = e; }
                else if (v > v2) { v3 = v2; i3 = i2; v2 = v; i2 = e; }
                else if (v > v3) { v3 = v; i3 = e; }
            }
        }
        const float e1 = __expf(v1 - v0), e2 = __expf(v2 - v0), e3 = __expf(v3 - v0);
        const float inv = 1.f / (1.f + e1 + e2 + e3);
        int pos;
        pos = atomicAdd(&cnt[i0], 1); LIST[(size_t)i0 * LISTCAP + pos] = t * 4 + 0; GATE[t * 4 + 0] = inv;
        pos = atomicAdd(&cnt[i1], 1); LIST[(size_t)i1 * LISTCAP + pos] = t * 4 + 1; GATE[t * 4 + 1] = e1 * inv;
        pos = atomicAdd(&cnt[i2], 1); LIST[(size_t)i2 * LISTCAP + pos] = t * 4 + 2; GATE[t * 4 + 2] = e2 * inv;
        pos = atomicAdd(&cnt[i3], 1); LIST[(size_t)i3 * LISTCAP + pos] = t * 4 + 3; GATE[t * 4 + 3] = e3 * inv;
    }
}

template <int WHICH, bool NOEPI = false>
__device__ __forceinline__ void moe_gemm_phase(PRef p, int layer, char* smem, int bid, int nb) {
    const int* cnt = (const int*)(p.ws + OFF_CNT) + layer * 32;
    const int* LIST = (const int*)(p.ws + OFF_LIST);
    constexpr int NTN = WHICH == 1 ? 8 : 4;
    int total = 0;
    for (int i = 0; i < 32; ++i) total += ((cnt[i] + 255) >> 8) * NTN;
    XcdSeq sq(total, bid, nb);
    int e = 0, base = 0, ce = cnt[0], mt = (ce + 255) >> 8;
    auto src = [&](int i, G8Desc& d) -> bool {
        const int t = sq.q + i * sq.step;
        if (t >= sq.qend) return false;
        while (e < 32 && t >= base + mt * NTN) { base += mt * NTN; ++e; if (e < 32) { ce = cnt[e]; mt = (ce + 255) >> 8; } }
        if (e >= 32) return false;
        int mi, ni;
        { const int loc = t - base, pf = mt >> 2, full = pf * 4 * NTN;
          if (loc < full) { const int pn = loc / (4 * NTN), r = loc - pn * 4 * NTN; ni = r >> 2; mi = pn * 4 + (r & 3); }
          else { const int ph = mt - pf * 4, r = loc - full; ni = r / ph; mi = pf * 4 + (r - ni * ph); } }
        d.m0 = 0; d.n0 = ni * 256; d.list = LIST + (size_t)e * LISTCAP + mi * 256; d.count = ce - mi * 256; d.u0 = e; d.ldb = 1024;
        if (WHICH == 1) { d.A = (const bf16_t*)(p.ws + OFF_XB); d.Bt = (const bf16_t*)(p.ws + OFF_WT_W1) + (size_t)(layer * 32 + e) * 2048 * 1024; }
        else { d.A = (const bf16_t*)(p.ws + OFF_ACT); d.Bt = (const bf16_t*)(p.ws + OFF_WT_W2) + (size_t)(layer * 32 + e) * 1024 * 1024; }
        return true; };
    if (WHICH == 1) {
        bf16_t* ACT = (bf16_t*)(p.ws + OFF_ACT);
        gemm256_stream<true, 2>(src, 1024, 1024, smem,
            [&](int, int e_, f32x4 (&acc)[4][2], int rt0, int c0, int fr, int fq, const int* sRow) {
                const float* b1 = p.moe_b1 + (size_t)(layer * 32 + e_) * 2048;
                const int gcol = (c0 >> 5) * 16 + 4 * fq;
                const f32x4 bg = *(const f32x4*)(b1 + gcol), bl = *(const f32x4*)(b1 + 1024 + gcol);
#pragma unroll
                for (int m = 0; m < 4; ++m) {
                    const int pair = NOEPI ? -1 : sRow[rt0 + m * 16 + fr];
                    if (pair >= 0) {
                        float a[4];
#pragma unroll
                        for (int r = 0; r < 4; ++r) {
                            const float gl = fminf(acc[m][0][r] + bg[r], 7.f);
                            const float li = fminf(fmaxf(acc[m][1][r] + bl[r], -7.f), 7.f);
                            a[r] = gl * sigmoidf_(1.702f * gl) * (li + 1.f);
                        }
                        u32x2 w; w.x = pk2(a[0], a[1]); w.y = pk2(a[2], a[3]);
                        *(u32x2*)(ACT + (size_t)pair * 1024 + gcol) = w;
                    }
                }
            });
    } else {
        const float* GATE = (const float*)(p.ws + OFF_GATE);
        bf16_t* SLOT = (bf16_t*)(p.ws + OFF_SLOT);
        gemm256_stream<true, 0>(src, 1024, 1024, smem,
            [&](int, int e_, f32x4 (&acc)[4][2], int rt0, int c0, int fr, int fq, const int* sRow) {
                const float* b2 = p.moe_b2 + (size_t)(layer * 32 + e_) * 1024;
                const int col = c0 + 8 * fq;
                const f32x4 b20 = *(const f32x4*)(b2 + col), b21 = *(const f32x4*)(b2 + col + 4);
#pragma unroll
                for (int m = 0; m < 4; ++m) {
                    const int pair = NOEPI ? -1 : sRow[rt0 + m * 16 + fr];
                    if (pair >= 0) {
                        const float gt = GATE[pair];
                        const f32x4 y0 = (acc[m][0] + b20) * gt, y1 = (acc[m][1] + b21) * gt;
                        u32x4 w; w.x = pk2(y0[0], y0[1]); w.y = pk2(y0[2], y0[3]); w.z = pk2(y1[0], y1[1]); w.w = pk2(y1[2], y1[3]);
                        *(u32x4*)(SLOT + (size_t)pair * 1024 + col) = w;
                    }
                }
            });
    }
}

__device__ __forceinline__ void epi_od_in(PRef p, f32x4 (&acc)[4][2], int row0, int c0, int fr, int fq) {
    char* ws = p.ws;
    bf16_t* PO = (bf16_t*)(ws + OFF_PO); float* WI = (float*)(ws + OFF_WI);
    const int col = c0 + 8 * fq;
#pragma unroll
    for (int m = 0; m < 4; ++m) {
        const int t = row0 + m * 16 + fr;
        if (c0 < OD_WI) {
            u32x4 w; w.x = pk2(acc[m][0][0], acc[m][0][1]); w.y = pk2(acc[m][0][2], acc[m][0][3]); w.z = pk2(acc[m][1][0], acc[m][1][1]); w.w = pk2(acc[m][1][2], acc[m][1][3]);
            *(u32x4*)(PO + (size_t)t * OD_P + col) = w;
        } else if (col == OD_WI) {
            *(f32x4*)(WI + (size_t)t * 4) = acc[m][0];
        }
    }
}

__device__ __forceinline__ void idx_scores(const char* __restrict__ ktile, int kbase, const bf16x8 (&qf)[4][4], const float (&wi)[4], int lane, float (&sc)[16]) {
    const int r = lane & 31, h2 = lane >> 5;
    const char* kp = ktile + (kbase + r) * 144 + h2 * 16;
    bf16x8 kf[4];
#pragma unroll
    for (int s = 0; s < 4; ++s) kf[s] = *(const bf16x8*)(kp + s * 32);
#pragma unroll
    for (int i = 0; i < 16; ++i) sc[i] = 0.f;
#pragma unroll
    for (int hd = 0; hd < 4; ++hd) {
        f32x16 a;
#pragma unroll
        for (int i = 0; i < 16; ++i) a[i] = 0.f;
#pragma unroll
        for (int s = 0; s < 4; ++s) a = __builtin_amdgcn_mfma_f32_32x32x16_bf16(kf[s], qf[hd][s], a, 0, 0, 0);
#pragma unroll
        for (int i = 0; i < 16; ++i) { const int ai = __float_as_int(a[i]); sc[i] += wi[hd] * __int_as_float(ai > 0 ? ai : 0); }
    }
}
__device__ __forceinline__ unsigned ord_key(float s) {
    const unsigned u = __float_as_uint(s);
    return u ^ ((unsigned)((int)u >> 31) | 0x80000000u);
}

constexpr int SEL_KT = 128 * 144;
__device__ __forceinline__ void dsa_select_item(PRef p, int b, int qb, char* smem) {
    unsigned* hist = (unsigned*)smem;
    unsigned* pref = (unsigned*)(smem + 66048);
    int* krem = (int*)(smem + 66048 + 256);
    unsigned* GW = (unsigned*)(smem + 66048 + 512);
    unsigned* EW = (unsigned*)(smem + 66048 + 512 + 2048);
    char* kbuf = smem + 71680;
    const bf16_t* PO = (const bf16_t*)(p.ws + OFF_PO);
    const float* WI = (const float*)(p.ws + OFF_WI);
    unsigned long long* BMT = (unsigned long long*)(p.ws + OFF_BM);
    const int tid = otid(), lane = tid & 63, wave = tid >> 6, kw = wave >> 1, qw = wave & 1, h2 = lane >> 5;
    const int p0 = qb * 64;
    const int ql = qw * 32 + (lane & 31);
    const int qpos = p0 + ql;
    const size_t tq = (size_t)b * L_ + qpos;
    const int nkt = (p0 + 64 + 127) >> 7;
    bf16x8 qf[4][4]; float wi[4];
#pragma unroll
    for (int hd = 0; hd < 4; ++hd) {
        wi[hd] = WI[tq * 4 + hd];
#pragma unroll
        for (int s = 0; s < 4; ++s) qf[hd][s] = *(const bf16x8*)(PO + tq * OD_P + OD_QI + hd * 64 + s * 16 + h2 * 8);
    }
    const int srow = tid >> 3, sch = tid & 7;
    const bf16_t* ksrc = PO + ((size_t)b * L_ + srow) * OD_P + OD_KI + sch * 8;
    char* kdst = kbuf + srow * 144 + sch * 16;
    for (int e = tid; e < 64 * 257; e += NTHR) hist[e] = 0u;
    if (tid < 64) { pref[tid] = 0u; krem[tid] = 256; }
    __syncthreads();
    const bool selall = qpos < 256;
    const int npass = (p0 + 63 >= 256) ? 3 : 0;
    for (int pass = 0; pass <= npass; ++pass) {
        const bool maskpass = pass == npass;
        const int sh = 24 - 8 * pass;
        const unsigned mypref = pref[ql];
        int ceq = 0;
        const int rsel = tid < 64 ? krem[tid] : 0;
        const int npair = (nkt + 1) >> 1;
        u32x4 r0, r1, r2 = (u32x4){0u, 0u, 0u, 0u}, r3 = r2;
        r0 = *(const u32x4*)ksrc; r1 = *(const u32x4*)(ksrc + (size_t)64 * OD_P);
        if (nkt > 1) { r2 = *(const u32x4*)(ksrc + (size_t)128 * OD_P); r3 = *(const u32x4*)(ksrc + (size_t)192 * OD_P); }
        *(u32x4*)kdst = r0; *(u32x4*)(kdst + 64 * 144) = r1; *(u32x4*)(kdst + SEL_KT) = r2; *(u32x4*)(kdst + SEL_KT + 64 * 144) = r3;
        __syncthreads();
        for (int kp = 0; kp < npair; ++kp) {
            const bool more = kp + 1 < npair;
            const bool more2 = 2 * kp + 3 < nkt;
            if (more) {
                r0 = *(const u32x4*)(ksrc + (size_t)(2 * kp + 2) * 128 * OD_P); r1 = *(const u32x4*)(ksrc + (size_t)((2 * kp + 2) * 128 + 64) * OD_P);
                if (more2) { r2 = *(const u32x4*)(ksrc + (size_t)(2 * kp + 3) * 128 * OD_P); r3 = *(const u32x4*)(ksrc + (size_t)((2 * kp + 3) * 128 + 64) * OD_P); }
            }
            const char* kcur = kbuf + (kp & 1) * 2 * SEL_KT;
            const bool two = 2 * kp + 1 < nkt;
            unsigned gwp[2] = {0u, 0u}, ewp[2] = {0u, 0u};
#pragma unroll
            for (int tt = 0; tt < 2; ++tt) {
                if (tt == 1 && !two) break;
                const int kt = 2 * kp + tt;
                float sc[16];
                idx_scores(kcur + tt * SEL_KT, kw * 32, qf, wi, lane, sc);
                const int keybase = kt * 128 + kw * 32;
                const bool diag = kt == nkt - 1;
                if (!maskpass) {
                    if (pass == 0 && !diag && p0 >= 256) {
#pragma unroll
                        for (int i = 0; i < 16; ++i) atomicAdd(&hist[ql * 257 + (ord_key(sc[i]) >> 24)], 1u);
                    } else {
#pragma unroll
                        for (int i = 0; i < 16; ++i) {
                            const int key = keybase + (i & 3) + 8 * (i >> 2) + 4 * h2;
                            const unsigned k32 = ord_key(sc[i]);
                            const bool match = pass == 0 ? true : ((k32 >> (sh + 8)) == mypref);
                            const bool valid = diag ? key <= qpos : true;
                            if (valid && !selall && match) atomicAdd(&hist[ql * 257 + ((k32 >> sh) & 255u)], 1u);
                        }
                    }
                } else {
                    unsigned gw = 0u, ew = 0u;
#pragma unroll
                    for (int i = 0; i < 16; ++i) {
                        const int ko = (i & 3) + 8 * (i >> 2) + 4 * h2;
                        const int key = keybase + ko;
                        const unsigned k24 = ord_key(sc[i]) >> 8;
                        const bool valid = diag ? key <= qpos : true;
                        const bool g = valid && (selall || k24 > mypref);
                        const bool e = valid && !selall && k24 == mypref;
                        gw |= (g ? 1u : 0u) << ko; ew |= (e ? 1u : 0u) << ko;
                    }
                    gwp[tt] = xor32_or(gw); ewp[tt] = xor32_or(ew);
                }
            }
            if (maskpass && h2 == 0) { GW[ql * 8 + kw] = gwp[0]; EW[ql * 8 + kw] = ewp[0]; GW[ql * 8 + 4 + kw] = gwp[1]; EW[ql * 8 + 4 + kw] = ewp[1]; }
            if (more) {
                char* nd = kdst + ((kp + 1) & 1) * 2 * SEL_KT;
                *(u32x4*)nd = r0; *(u32x4*)(nd + 64 * 144) = r1;
                if (more2) { *(u32x4*)(nd + SEL_KT) = r2; *(u32x4*)(nd + SEL_KT + 64 * 144) = r3; }
            }
            __syncthreads();
            if (maskpass) {
                if (tid < 64) {
#pragma unroll
                    for (int tt = 0; tt < 2; ++tt) {
                        if (tt == 1 && !two) break;
                        const int kt = 2 * kp + tt;
                        unsigned g4[4], e4[4];
#pragma unroll
                        for (int w = 0; w < 4; ++w) { g4[w] = GW[tid * 8 + tt * 4 + w]; e4[w] = EW[tid * 8 + tt * 4 + w]; }
                        int need = rsel - ceq; if (need < 0) need = 0;
#pragma unroll
                        for (int w = 0; w < 4; ++w) {
                            const int pc = __popc(e4[w]);
                            ceq += pc;
                            if (need >= pc) need -= pc;
                            else { unsigned m = e4[w], kept = 0u; for (int k = 0; k < need; ++k) { const unsigned low = m & (0u - m); kept |= low; m ^= low; } e4[w] = kept; need = 0; }
                            g4[w] |= e4[w];
                        }
                        BMT[((size_t)(b * 256 + 2 * kt)) * L_ + p0 + tid] = (unsigned long long)g4[0] | ((unsigned long long)g4[1] << 32);
                        BMT[((size_t)(b * 256 + 2 * kt + 1)) * L_ + p0 + tid] = (unsigned long long)g4[2] | ((unsigned long long)g4[3] << 32);
                    }
                }
                __syncthreads();
            }
        }
        if (!maskpass) {
            const int q = tid >> 3, part = tid & 7;
            unsigned c32[32]; unsigned tot = 0u;
#pragma unroll
            for (int i = 0; i < 32; ++i) { c32[i] = hist[q * 257 + part * 32 + i]; tot += c32[i]; }
            unsigned above = 0u;
#pragma unroll
            for (int d = 1; d < 8; ++d) { const unsigned o = __shfl(tot, (lane & ~7) + ((part + d) & 7), 64); if (part + d < 8) above += o; }
            const unsigned need = (unsigned)krem[q];
            __syncthreads();
            if ((p0 + q) >= 256 && above < need && above + tot >= need) {
                unsigned cum = above; int dg = 31;
#pragma unroll
                for (int i = 31; i >= 0; --i) { if (i == dg) { if (cum + c32[i] >= need) {   } else { cum += c32[i]; dg = i - 1; } } }
                pref[q] = (pref[q] << 8) | (unsigned)(part * 32 + dg);
                krem[q] = (int)(need - cum);
            }
            for (int e = tid; e < 64 * 257; e += NTHR) hist[e] = 0u;
            __syncthreads();
        }
    }
}

template <int MODE, int NQT>
__device__ __forceinline__ void attn_wave(PRef p, int b, int head, int qcol, int kcol, const bf16_t* __restrict__ VT, int voff,
                                          int i0, int sh  , int rho, int kt_lo, int kt_hi, int grp) {
    const bf16_t* PO = (const bf16_t*)(p.ws + OFF_PO);
    const unsigned* BM32 = (const unsigned*)(p.ws + OFF_BM);
    const int lane = otid() & 63, r = lane & 31, h2 = lane >> 5;
    const int pr = (r & 0x13) | ((r & 4) << 1) | ((r & 8) >> 1);
    const float SC = 0.125f * 1.4426950408889634f;
    bf16x8 qf[NQT][4]; size_t tq[NQT]; int qi[NQT];
#pragma unroll
    for (int qt = 0; qt < NQT; ++qt) {
        qi[qt] = i0 + qt * 32 + r;
        tq[qt] = (size_t)b * L_ + ((size_t)qi[qt] << sh) + rho;
#pragma unroll
        for (int s = 0; s < 4; ++s) qf[qt][s] = *(const bf16x8*)(PO + tq[qt] * OD_P + qcol + head * 64 + s * 16 + h2 * 8);
    }
    f32x16 oacc[NQT][2];
#pragma unroll
    for (int a = 0; a < NQT; ++a)
#pragma unroll
        for (int c = 0; c < 2; ++c)
#pragma unroll
            for (int i = 0; i < 16; ++i) oacc[a][c][i] = 0.f;
    float mrun[NQT], lrun[NQT];
#pragma unroll
    for (int a = 0; a < NQT; ++a) { mrun[a] = -64.f; lrun[a] = 0.f; }
    bf16x8 kf[4]; unsigned mw[NQT];
    auto load_k = [&](int kt, bf16x8 (&k_)[4], unsigned (&m_)[NQT]) {
        const size_t krow = (size_t)b * L_ + ((size_t)(kt * 32 + pr) << sh) + rho;
#pragma unroll
        for (int s = 0; s < 4; ++s) k_[s] = *(const bf16x8*)(PO + krow * OD_P + kcol + head * 64 + s * 16 + h2 * 8);
#pragma unroll
        for (int a = 0; a < NQT; ++a) m_[a] = MODE == 0 ? BM32[tq[a] * 512 + kt] : 0u;
    };
    load_k(kt_lo, kf, mw);
#pragma unroll 1
    for (int kt = kt_lo; kt <= kt_hi; ++kt) {
        bf16x8 vf[2][2];
#pragma unroll
        for (int db = 0; db < 2; ++db)
#pragma unroll
            for (int s2 = 0; s2 < 2; ++s2) vf[db][s2] = *(const bf16x8*)(VT + (size_t)(db * 32 + r) * L_ + voff + kt * 32 + s2 * 16 + h2 * 8);
        bf16x8 kn[4]; unsigned mn[NQT];
#pragma unroll
        for (int a = 0; a < NQT; ++a) mn[a] = 0u;
        if (kt < kt_hi) load_k(kt + 1, kn, mn);
#pragma unroll
        for (int qt = 0; qt < NQT; ++qt) {
            if (MODE == 1 && NQT == 2) { const int hq = (i0 >> 5) + qt; if (kt > hq || kt < hq - 4) continue; }
            f32x16 s;
#pragma unroll
            for (int i = 0; i < 16; ++i) s[i] = 0.f;
#pragma unroll
            for (int ks = 0; ks < 4; ++ks) s = __builtin_amdgcn_mfma_f32_32x32x16_bf16(kf[ks], qf[qt][ks], s, 0, 0, 0);
            unsigned wsel;
            if (MODE == 0) wsel = mw[qt];
            else {
                const int hi = qi[qt] - kt * 32, lo = hi - 128;
                const unsigned mh = hi < 0 ? 0u : (hi >= 31 ? 0xffffffffu : ((2u << hi) - 1u)), ml = lo <= 0 ? 0xffffffffu : (lo > 31 ? 0u : ~((1u << lo) - 1u));
                wsel = mh & ml;
            }
#pragma unroll
            for (int i = 0; i < 16; ++i) s[i] = __builtin_fmaf(s[i], SC, -mrun[qt]);
            float mx = fmaxf(fmaxf(s[0], s[1]), fmaxf(s[2], s[3]));
#pragma unroll
            for (int i = 4; i < 16; i += 2) mx = fmaxf(mx, fmaxf(s[i], s[i + 1]));
            mx = xor32_max(mx);
            if (__builtin_amdgcn_ballot_w64(mx > 0.f) != 0ull) {
                const float dlt = fmaxf(mx, 0.f);
                const float corr = __builtin_amdgcn_exp2f(-dlt);
                mrun[qt] += dlt; lrun[qt] *= corr;
#pragma unroll
                for (int db = 0; db < 2; ++db)
#pragma unroll
                    for (int i = 0; i < 16; ++i) oacc[qt][db][i] *= corr;
#pragma unroll
                for (int i = 0; i < 16; ++i) s[i] -= dlt;
            }
            float ps = 0.f;
            const int mws = (int)(wsel >> (8 * h2));
#define DA_P(i, KO) { const float e = __builtin_amdgcn_exp2f(s[i]); s[i] = __uint_as_float(__float_as_uint(e) & bitmask32<KO>(mws)); ps += s[i]; }
            DA_P(0, 0) DA_P(1, 1) DA_P(2, 2) DA_P(3, 3) DA_P(4, 4) DA_P(5, 5) DA_P(6, 6) DA_P(7, 7)
            DA_P(8, 16) DA_P(9, 17) DA_P(10, 18) DA_P(11, 19) DA_P(12, 20) DA_P(13, 21) DA_P(14, 22) DA_P(15, 23)
#undef DA_P
            lrun[qt] += ps;
#pragma unroll
            for (int s2 = 0; s2 < 2; ++s2) {
                u32x4 pw; pw.x = pk2(s[8 * s2], s[8 * s2 + 1]); pw.y = pk2(s[8 * s2 + 2], s[8 * s2 + 3]); pw.z = pk2(s[8 * s2 + 4], s[8 * s2 + 5]); pw.w = pk2(s[8 * s2 + 6], s[8 * s2 + 7]);
                const bf16x8 pf = __builtin_bit_cast(bf16x8, pw);
#pragma unroll
                for (int db = 0; db < 2; ++db) oacc[qt][db] = __builtin_amdgcn_mfma_f32_32x32x16_bf16(vf[db][s2], pf, oacc[qt][db], 0, 0, 0);
            }
        }
        if (kt < kt_hi) {
#pragma unroll
            for (int s = 0; s < 4; ++s) kf[s] = kn[s];
#pragma unroll
            for (int a = 0; a < NQT; ++a) mw[a] = mn[a];
        }
    }
#pragma unroll
    for (int qt = 0; qt < NQT; ++qt) {
        const float lt = xor32_sum(lrun[qt]);
        const float inv = 1.f / lt;
        if (MODE == 0) {
            bf16_t* CC = (bf16_t*)(p.ws + OFF_CC);
#pragma unroll
            for (int db = 0; db < 2; ++db)
#pragma unroll
                for (int i = 0; i < 16; ++i) {
                    const int d = db * 32 + (i & 3) + 8 * (i >> 2) + 4 * h2;
                    CC[tq[qt] * 1024 + head * 64 + d] = f2bf(oacc[qt][db][i] * inv);
                }
        } else {
            bf16_t* OD = (bf16_t*)(p.ws + OFF_OD) + (size_t)grp * T_ * 512;
#pragma unroll
            for (int db = 0; db < 2; ++db)
#pragma unroll
                for (int i = 0; i < 16; i += 4) {
                    const int d = db * 32 + 8 * (i >> 2) + 4 * h2;
                    { u32x2 w; w.x = pk2(oacc[qt][db][i] * inv, oacc[qt][db][i + 1] * inv); w.y = pk2(oacc[qt][db][i + 2] * inv, oacc[qt][db][i + 3] * inv); *(u32x2*)(OD + tq[qt] * 512 + head * 64 + d) = w; }
                }
            if (h2 == 0) ((float*)(p.ws + OFF_LSE))[((size_t)grp * T_ + tq[qt]) * 8 + head] = mrun[qt] + log2f(lt);
        }
    }
}

__device__ __forceinline__ void dil_combine_phase(PRef p, int bid, int nb) {
    const bf16_t* OD = (const bf16_t*)(p.ws + OFF_OD); const float* LSE = (const float*)(p.ws + OFF_LSE);
    bf16_t* CC = (bf16_t*)(p.ws + OFF_CC);
    const long n = (long)T_ * 128;
    for (long c = (long)bid * NTHR + otid(); c < n; c += (long)nb * NTHR) {
        const long t = c >> 7; const int ch = (int)(c & 127) * 4, hd = ch >> 6;
        const float l0 = LSE[((size_t)0 * T_ + t) * 8 + hd], l1 = LSE[((size_t)1 * T_ + t) * 8 + hd], l2 = LSE[((size_t)2 * T_ + t) * 8 + hd];
        const float mx = fmaxf(l0, fmaxf(l1, l2));
        const float w0 = __builtin_amdgcn_exp2f(l0 - mx), w1 = __builtin_amdgcn_exp2f(l1 - mx), w2 = __builtin_amdgcn_exp2f(l2 - mx);
        const float inv = __builtin_amdgcn_rcpf(w0 + w1 + w2);
        const u32x2 a = *(const u32x2*)(OD + ((size_t)0 * T_ + t) * 512 + ch), bq = *(const u32x2*)(OD + ((size_t)1 * T_ + t) * 512 + ch), cq = *(const u32x2*)(OD + ((size_t)2 * T_ + t) * 512 + ch);
        float o[4];
#define BFLO(x) __uint_as_float((x) << 16)
#define BFHI(x) __uint_as_float((x) & 0xffff0000u)
        o[0] = (BFLO(a.x) * w0 + BFLO(bq.x) * w1 + BFLO(cq.x) * w2) * inv; o[1] = (BFHI(a.x) * w0 + BFHI(bq.x) * w1 + BFHI(cq.x) * w2) * inv;
        o[2] = (BFLO(a.y) * w0 + BFLO(bq.y) * w1 + BFLO(cq.y) * w2) * inv; o[3] = (BFHI(a.y) * w0 + BFHI(bq.y) * w1 + BFHI(cq.y) * w2) * inv;
#undef BFLO
#undef BFHI
        u32x2 w; w.x = pk2(o[0], o[1]); w.y = pk2(o[2], o[3]);
        *(u32x2*)(CC + (size_t)t * 1024 + 512 + ch) = w;
    }
}

constexpr int DA_ROW = 144;
constexpr int DA_TILE = 64 * DA_ROW;
__device__ __forceinline__ void dsa_attn_item(PRef p, int b, int head, int qb, char* smem) {
    const bf16_t* PO = (const bf16_t*)(p.ws + OFF_PO);
    const bf16_t* VT = (const bf16_t*)(p.ws + OFF_VTC) + ((size_t)(b * 8 + head)) * 64 * L_;
    const int tid = otid(), lane = tid & 63, wave = tid >> 6, r = lane & 31, h2 = lane >> 5;
    const int pr = (r & 0x13) | ((r & 4) << 1) | ((r & 8) >> 1);
    const float SC = 0.125f * 1.4426950408889634f;
    const int i0 = qb * 256 + wave * 32, qi = i0 + r;
    const unsigned long long* BMT = (const unsigned long long*)(p.ws + OFF_BM) + (size_t)b * 256 * L_ + qi;
    const size_t tq = (size_t)b * L_ + qi;
    bf16x8 qf[4];
#pragma unroll
    for (int s = 0; s < 4; ++s) qf[s] = *(const bf16x8*)(PO + tq * OD_P + head * 64 + s * 16 + h2 * 8);
    f32x16 oacc[2];
#pragma unroll
    for (int c = 0; c < 2; ++c)
#pragma unroll
        for (int i = 0; i < 16; ++i) oacc[c][i] = 0.f;
    float mrun = -64.f, lrun = 0.f;
    const int nkt = qb * 4 + 4, my_last = (i0 + 31) >> 6;
    const int srow = tid >> 3, sch = tid & 7;
    const bf16_t* ksrc = PO + ((size_t)b * L_ + srow) * OD_P + 512 + head * 64 + sch * 8;
    const bf16_t* vsrc = VT + (size_t)srow * L_ + sch * 8;
    u32x4 rk = *(const u32x4*)ksrc, rv = *(const u32x4*)vsrc;
    __syncthreads();
    *(u32x4*)(smem + srow * DA_ROW + sch * 16) = rk;
    *(u32x4*)(smem + DA_TILE + srow * DA_ROW + sch * 16) = rv;
    __syncthreads();
    unsigned long long mwn = BMT[0];
#pragma unroll 1
    for (int kt = 0; kt < nkt; ++kt) {
        const bool more = kt + 1 < nkt;
        if (more) { rk = *(const u32x4*)(ksrc + (size_t)(kt + 1) * 64 * OD_P); rv = *(const u32x4*)(vsrc + (kt + 1) * 64); }
        const unsigned long long mw64 = mwn;
        if (kt < my_last) mwn = BMT[(size_t)(kt + 1) * L_];
        if (kt <= my_last) {
            const char* kb = smem + (kt & 1) * 2 * DA_TILE; const char* vb = kb + DA_TILE;
            f32x16 sa[2];
#pragma unroll
            for (int sub = 0; sub < 2; ++sub) {
                bf16x8 kf[4];
#pragma unroll
                for (int s = 0; s < 4; ++s) kf[s] = *(const bf16x8*)(kb + (sub * 32 + pr) * DA_ROW + (s * 16 + h2 * 8) * 2);
#pragma unroll
                for (int i = 0; i < 16; ++i) sa[sub][i] = 0.f;
#pragma unroll
                for (int ks = 0; ks < 4; ++ks) sa[sub] = __builtin_amdgcn_mfma_f32_32x32x16_bf16(kf[ks], qf[ks], sa[sub], 0, 0, 0);
            }
#pragma unroll
            for (int sub = 0; sub < 2; ++sub) {
                const unsigned mw = sub == 0 ? (unsigned)mw64 : (unsigned)(mw64 >> 32);
                f32x16& s = sa[sub];
                bf16x8 vf[2][2];
#pragma unroll
                for (int db = 0; db < 2; ++db)
#pragma unroll
                    for (int s2 = 0; s2 < 2; ++s2) vf[db][s2] = *(const bf16x8*)(vb + (db * 32 + r) * DA_ROW + (sub * 32 + s2 * 16 + h2 * 8) * 2);
#pragma unroll
                for (int i = 0; i < 16; ++i) s[i] = __builtin_fmaf(s[i], SC, -mrun);
                float mxa = __builtin_fmaxf(__builtin_fmaxf(s[0], s[1]), s[2]), mxb = __builtin_fmaxf(__builtin_fmaxf(s[3], s[4]), s[5]);
                mxa = __builtin_fmaxf(__builtin_fmaxf(mxa, s[6]), s[7]); mxb = __builtin_fmaxf(__builtin_fmaxf(mxb, s[8]), s[9]);
                mxa = __builtin_fmaxf(__builtin_fmaxf(mxa, s[10]), s[11]); mxb = __builtin_fmaxf(__builtin_fmaxf(mxb, s[12]), s[13]);
                mxa = __builtin_fmaxf(__builtin_fmaxf(mxa, s[14]), s[15]);
                float mx = xor32_max(__builtin_fmaxf(mxa, mxb));
                if (__builtin_amdgcn_ballot_w64(mx > 0.f) != 0ull) {
                    const float dlt = fmaxf(mx, 0.f);
                    const float corr = __builtin_amdgcn_exp2f(-dlt);
                    mrun += dlt; lrun *= corr;
#pragma unroll
                    for (int db = 0; db < 2; ++db)
#pragma unroll
                        for (int i = 0; i < 16; ++i) oacc[db][i] *= corr;
#pragma unroll
                    for (int i = 0; i < 16; ++i) s[i] -= dlt;
                }
                const int mws = (int)(mw >> (8 * h2));
#define DA_P(i, KO) { const float e = __builtin_amdgcn_exp2f(s[i]); s[i] = __uint_as_float(__float_as_uint(e) & bitmask32<KO>(mws)); }
                DA_P(0, 0) DA_P(1, 1) DA_P(2, 2) DA_P(3, 3) DA_P(4, 4) DA_P(5, 5) DA_P(6, 6) DA_P(7, 7)
                DA_P(8, 16) DA_P(9, 17) DA_P(10, 18) DA_P(11, 19) DA_P(12, 20) DA_P(13, 21) DA_P(14, 22) DA_P(15, 23)
#undef DA_P
                {
                    const f32x2 t0 = (f32x2){s[0], s[1]} + (f32x2){s[2], s[3]}, t1 = (f32x2){s[4], s[5]} + (f32x2){s[6], s[7]};
                    const f32x2 t2 = (f32x2){s[8], s[9]} + (f32x2){s[10], s[11]}, t3 = (f32x2){s[12], s[13]} + (f32x2){s[14], s[15]};
                    const f32x2 u = (t0 + t1) + (t2 + t3);
                    lrun += u[0] + u[1];
                }
#pragma unroll
                for (int s2 = 0; s2 < 2; ++s2) {
                    u32x4 pw; pw.x = pk2(s[8 * s2], s[8 * s2 + 1]); pw.y = pk2(s[8 * s2 + 2], s[8 * s2 + 3]); pw.z = pk2(s[8 * s2 + 4], s[8 * s2 + 5]); pw.w = pk2(s[8 * s2 + 6], s[8 * s2 + 7]);
                    const bf16x8 pf = __builtin_bit_cast(bf16x8, pw);
#pragma unroll
                    for (int db = 0; db < 2; ++db) oacc[db] = __builtin_amdgcn_mfma_f32_32x32x16_bf16(vf[db][s2], pf, oacc[db], 0, 0, 0);
                }
            }
        }
        if (more) {
            char* nbuf = smem + ((kt + 1) & 1) * 2 * DA_TILE;
            *(u32x4*)(nbuf + srow * DA_ROW + sch * 16) = rk;
            *(u32x4*)(nbuf + DA_TILE + srow * DA_ROW + sch * 16) = rv;
        }
        __syncthreads();
    }
    const float lt = xor32_sum(lrun);
    const float inv = 1.f / lt;
    bf16_t* CC = (bf16_t*)(p.ws + OFF_CC);
#pragma unroll
    for (int db = 0; db < 2; ++db)
#pragma unroll
        for (int i = 0; i < 16; i += 4) {
            const int d = db * 32 + 8 * (i >> 2) + 4 * h2;
            u32x2 w; w.x = pk2(oacc[db][i] * inv, oacc[db][i + 1] * inv); w.y = pk2(oacc[db][i + 2] * inv, oacc[db][i + 3] * inv);
            *(u32x2*)(CC + tq * 1024 + head * 64 + d) = w;
        }
}


template <bool ODD>
__device__ __forceinline__ void inproj_phase(PRef p, int j, char* smem, int bid, int nb) {
    char* ws = p.ws;
    constexpr int NTN = ODD ? OD_P / 256 : EV_P / 256, NMAIN = 128 * NTN, NVT = ODD ? 1024 : 256;
    const bf16_t* XB = (const bf16_t*)(ws + OFF_XB);
    const bf16_t* W = ODD ? (const bf16_t*)(ws + OFF_WT_ODIN) + (size_t)j * OD_N * 1024 : (const bf16_t*)(ws + OFF_WT_EVIN) + (size_t)j * EV_N * 1024;
    XcdSeq s(NMAIN + NVT, bid, nb);
    gemm256_stream<false, 0>(
        [&](int i, G8Desc& d) -> bool {
            const int Q = s.q + i * s.step; if (Q >= s.qend) return false;
            d.list = nullptr; d.count = 0;
            if (Q < NMAIN) {
                const int pnl = Q / (4 * NTN), r = Q - pnl * 4 * NTN;
                d.A = XB; d.Bt = W; d.m0 = (pnl * 4 + (r & 3)) * 256; d.n0 = (r >> 2) * 256; d.u0 = -1; d.ldb = 1024;
            } else {
                const int v = Q - NMAIN; d.m0 = 0; d.n0 = 0; d.u0 = v;
                if (ODD) {
                    const int combo = v & 7, src = combo >> 1, mt = combo & 1, bn = v >> 3, b = bn >> 6, lam0 = (bn & 63) * 256;
                    const int sh = src < 2 ? 0 : (src == 2 ? 2 : 4), rho = lam0 >> (14 - sh), i0 = lam0 & ((L_ >> sh) - 1);
                    d.A = W + (size_t)(OD_P + src * 512 + mt * 256) * 1024;
                    d.Bt = XB + ((size_t)b * L_ + ((size_t)i0 << sh) + rho) * 1024; d.ldb = 1024 << sh;
                } else {
                    const int mt = v & 1, bn = v >> 1;
                    d.A = W + (size_t)(EV_P + mt * 256) * 1024;
                    d.Bt = XB + (size_t)bn * 256 * 1024; d.ldb = 1024;
                }
            }
            return true; },
        1024, 1024, smem,
        [&](int m0, int u0, f32x4 (&acc)[4][2], int rt0, int c0, int fr, int fq, const int*) {
            if (u0 < 0) { if (ODD) epi_od_in(p, acc, m0 + rt0, c0, fr, fq); else epi_ev_in(p, acc, m0 + rt0, c0, fr, fq); }
            else if (ODD) {
                const int combo = u0 & 7, src = combo >> 1, mt = combo & 1, bn = u0 >> 3, b = bn >> 6, lam0 = (bn & 63) * 256;
                bf16_t* img = src == 0 ? (bf16_t*)(ws + OFF_VTC) + ((size_t)(b * 8) * 64 + mt * 256) * L_ + lam0
                                       : (bf16_t*)(ws + OFF_VTD) + ((size_t)((b * 3 + src - 1) * 8) * 64 + mt * 256) * L_ + lam0;
                epi_vt(img, acc, rt0, c0, fr, fq);
            } else {
                const int mt = u0 & 1, bn = u0 >> 1, b = bn >> 6, lam0 = (bn & 63) * 256;
                epi_vt((bf16_t*)(ws + OFF_VTE) + ((size_t)(b * 4) * 128 + mt * 256) * L_ + lam0, acc, rt0, c0, fr, fq);
            }
        });
}

enum { K_PRO = 0, K_E1, K_E2, K_E3, K_E4, K_E5, K_E6, K_LN1, K_O1, K_O2, K_O3, K_O4, K_M1, K_M2, K_M3, K_M4, K_LN2, K_COUNT };

template <int KIND, bool NOEPI = false>
__device__ __forceinline__ void run_phase(PRef p, int layer, char* smem, int bid, int nb) {
    char* ws = p.ws;
    const int j = layer >> 1;
    if (KIND == K_PRO) {
        conv_phase(p, smem, bid, nb);
        __syncthreads();
        for (int u = bid; u < 256; u += nb) s5mat_unit(p, u, smem);
    } else if (KIND == K_E1) {
        inproj_phase<false>(p, j, smem, bid, nb);
    } else if (KIND == K_E2) {
        for (int it = bid; it < 2048; it += nb) gla_a_item(p, j, it, smem);
        s5_g_phase(p, j, smem, bid, nb);
    } else if (KIND == K_E3) {
        scan_phase(p, j, bid);
    } else if (KIND == K_E4) {
        for (int it = bid; it < 2048; it += nb) gla_c_item(p, j, it, smem);
        s5_y_phase(p, j, smem, bid, nb);
    } else if (KIND == K_E5) {
        const bf16_t* YA = (const bf16_t*)(ws + OFF_YA); bf16_t* CC = (bf16_t*)(ws + OFF_CC); const float* bg = p.s5_b_glu + (size_t)j * 512;
        gemm256_phase(YA, 512, T_, (const bf16_t*)(ws + OFF_WT_GLU) + (size_t)j * 512 * 512, 512, 512, 512, smem, bid, nb,
                   [&](f32x4 (&acc)[4][2], int row0, int c0, int fr, int fq) {
                       const int col = c0 + 8 * fq;
                       const f32x4 g0 = *(const f32x4*)(bg + col), g1 = *(const f32x4*)(bg + col + 4);
#pragma unroll
                       for (int m = 0; m < 4; ++m) {
                           const size_t t = (size_t)(row0 + m * 16 + fr);
                           const u32x4 yw = *(const u32x4*)(YA + t * 512 + col);
                           float o[8];
#pragma unroll
                           for (int q = 0; q < 4; ++q) {
                               const unsigned y2 = q == 0 ? yw.x : q == 1 ? yw.y : q == 2 ? yw.z : yw.w;
                               const float y0 = __uint_as_float(y2 << 16), y1 = __uint_as_float(y2 & 0xffff0000u);
                               const float a0 = q < 2 ? acc[m][0][2 * q] + g0[2 * q] : acc[m][1][2 * q - 4] + g1[2 * q - 4];
                               const float a1 = q < 2 ? acc[m][0][2 * q + 1] + g0[2 * q + 1] : acc[m][1][2 * q - 3] + g1[2 * q - 3];
                               o[2 * q] = y0 * sigmoidf_(a0); o[2 * q + 1] = y1 * sigmoidf_(a1);
                           }
                           u32x4 w; w.x = pk2(o[0], o[1]); w.y = pk2(o[2], o[3]); w.z = pk2(o[4], o[5]); w.w = pk2(o[6], o[7]);
                           *(u32x4*)(CC + t * 1024 + 512 + col) = w;
                       }
                   });
    } else if (KIND == K_E6 || KIND == K_O4) {
        bf16_t* MIX = (bf16_t*)(ws + OFF_MIX);
        const bf16_t* W = (const bf16_t*)(ws + (KIND == K_E6 ? OFF_WT_EVOUT : OFF_WT_ODOUT)) + (size_t)j * 1024 * 1024;
        gemm256_phase((const bf16_t*)(ws + OFF_CC), 1024, T_, W, 1024, 1024, 1024, smem, bid, nb,
                   [&](f32x4 (&acc)[4][2], int row0, int c0, int fr, int fq) {
#pragma unroll
                       for (int m = 0; m < 4; ++m) {
                           u32x4 w; w.x = pk2(acc[m][0][0], acc[m][0][1]); w.y = pk2(acc[m][0][2], acc[m][0][3]); w.z = pk2(acc[m][1][0], acc[m][1][1]); w.w = pk2(acc[m][1][2], acc[m][1][3]);
                           *(u32x4*)(MIX + (size_t)(row0 + m * 16 + fr) * 1024 + c0 + 8 * fq) = w;
                       }
                   });
    } else if (KIND == K_LN1) {
        ln1_router_phase<NOEPI>(p, layer, smem, bid, nb);
    } else if (KIND == K_O1) {
        inproj_phase<true>(p, j, smem, bid, nb);
    } else if (KIND == K_O2) {
        if (!NOEPI) for (int k = bid; k < 256; k += nb) {
            dsa_select_item(p, k & 1, k >> 1, smem);
            __syncthreads();
            const int k2 = 511 - k;
            dsa_select_item(p, k2 & 1, k2 >> 1, smem);
            __syncthreads();
        }
        const int head = otid() >> 6;
        for (int it = bid; it < 1536; it += nb) {
            const int b = it / 768, rem = it - b * 768, g = rem >> 8, u = rem & 255;
            const int sh = g * 2, per = 256 >> sh, rho = u / per, qblk = u - rho * per;
            const bf16_t* VT = (const bf16_t*)(ws + OFF_VTD) + ((size_t)((b * 3 + g) * 8 + head)) * 64 * L_;
            {
                const int hi = 2 * qblk + 1, lo = 2 * qblk - 4;
                attn_wave<1, 2>(p, b, head, OD_DIL + g * 512, OD_DIL + 1536 + g * 512, VT, rho * (L_ >> sh), qblk * 64, sh, rho, lo < 0 ? 0 : lo, hi, g);
            }
        }
    } else if (KIND == K_O3) {
        for (int k = bid; k < 512; k += nb) {
            const int bh = k >> 5, q0 = k & 31;
#pragma unroll 1
            for (int half = 0; half < 2; ++half) dsa_attn_item(p, bh >> 3, bh & 7, half == 0 ? q0 : 63 - q0, smem);
        }
        dil_combine_phase(p, bid, nb);
    } else if (KIND == K_M1) {
        float* LG = (float*)(ws + OFF_LOGIT); const float* rb = p.router_b + (size_t)layer * 32;
        gemm_phase((const bf16_t*)(ws + OFF_XB), 1024, T_, (const bf16_t*)(ws + OFF_WT_RT) + (size_t)layer * 128 * 1024, 1024, 128, 1024, smem, bid, nb,
                   [&](f32x4 (&acc)[4][2], int row0, int c0, int fr, int fq) {
#pragma unroll
                       for (int n = 0; n < 2; ++n) {
                           const int col = c0 + n * 16 + fr;
                           if (col < 32) {
#pragma unroll
                               for (int m = 0; m < 4; ++m)
#pragma unroll
                                   for (int r = 0; r < 4; ++r) LG[(size_t)(row0 + m * 16 + fq * 4 + r) * 32 + col] = acc[m][n][r] + rb[col];
                           }
                       }
                   });
    } else if (KIND == K_M2) {
        topk_phase(p, layer, bid, nb);
    } else if (KIND == K_M3) {
        moe_gemm_phase<1, NOEPI>(p, layer, smem, bid, nb);
    } else if (KIND == K_M4) {
        moe_gemm_phase<2, NOEPI>(p, layer, smem, bid, nb);
    } else if (KIND == K_LN2) {
        float* xo = layer == 3 ? p.out : (float*)nullptr;
        ln_phase<true, NOEPI>(p, (const bf16_t*)(ws + OFF_XB), (const float*)(ws + OFF_SLOT), p.ln2_g + (size_t)layer * 1024, p.ln2_b + (size_t)layer * 1024, xo,
                       layer == 3 ? (bf16_t*)nullptr : (bf16_t*)(ws + OFF_XB), bid, nb);
    }
}

extern __shared__ __attribute__((aligned(16))) char dyn_smem[];

#if !MEGA
template <int KIND>
__global__ void __launch_bounds__(NTHR, 2) k_phase(Params p, int layer) { run_phase<KIND>(p, layer, dyn_smem, blockIdx.x, gridDim.x); }
#else
#ifndef DUPMASK
#define DUPMASK 0
#endif
typedef const __attribute__((address_space(4))) Params* KParams;
#define RUNP(K) do { KParams _q = kp0; asm volatile("" : "+s"(_q)); run_phase<K>(*_q, layer, smem, bid, nb); } while (0)
#ifndef DUPNOEPI
#define DUPNOEPI 0
#endif
#define RUNP2(K) do { KParams _q = kp0; asm volatile("" : "+s"(_q)); run_phase<K, (DUPNOEPI != 0)>(*_q, layer, smem, bid, nb); } while (0)
#define PHASE(K) do { RUNP(K); xcd_barrier(bar); if ((DUPMASK >> 30) & 1) xcd_barrier(bar); if ((DUPMASK >> K) & 1) { RUNP2(K); xcd_barrier(bar); } } while (0)
template <int LAYER>
__device__ __forceinline__ void mega_layer(KParams kp0, char* smem, int bid, int nb, const XcdBarrier& bar) {
    constexpr int layer = LAYER;
    if ((layer & 1) == 0) { PHASE(K_E1); PHASE(K_E2); PHASE(K_E3); PHASE(K_E4); PHASE(K_E5); PHASE(K_E6); }
    else { PHASE(K_O1); PHASE(K_O2); PHASE(K_O3); PHASE(K_O4); }
    PHASE(K_LN1); PHASE(K_M3); PHASE(K_M4);
    RUNP(K_LN2);
    if ((DUPMASK >> K_LN2) & 1) { xcd_barrier(bar); RUNP2(K_LN2); }
    if (layer < 3) xcd_barrier(bar);
}
__global__ void __launch_bounds__(NTHR, 2) k_mega(Params p) {
    char* smem = dyn_smem;
    const int bid = blockIdx.x, nb = gridDim.x;
    volatile LAS unsigned* st = (volatile LAS unsigned*)(dyn_smem + LDS_BYTES - 16);
    if (otid() == 0) { st[0] = 0u; st[1] = 0u; }
    __syncthreads();
    KParams kp0 = (KParams)__builtin_amdgcn_kernarg_segment_ptr();
    XcdBarrier bar = xcd_barrier_post((unsigned*)(kp0->ws + OFF_BAR), st);
    { const int layer = 0; PHASE(K_PRO); }
    mega_layer<0>(kp0, smem, bid, nb, bar);
    mega_layer<1>(kp0, smem, bid, nb, bar);
    mega_layer<2>(kp0, smem, bid, nb, bar);
    mega_layer<3>(kp0, smem, bid, nb, bar);
}
#endif

extern "C" void kernel_launch(void* const* d_in, const int* in_sizes, int n_in, void* d_out, int out_size, void* d_ws, size_t ws_size, hipStream_t stream) {
    Params p{};
    const float** f = (const float**)&p;
    for (int i = 0; i < 28; ++i) f[i] = (const float*)d_in[i];
    p.out = (float*)d_out; p.ws = (char*)d_ws;
    if (ws_size < WS_NEED) { fprintf(stderr, "workspace too small: %zu < %zu\n", ws_size, (size_t)WS_NEED); return; }
#if !MEGA
#define SETATTR(K) hipFuncSetAttribute((const void*)k_phase<K>, hipFuncAttributeMaxDynamicSharedMemorySize, LDS_BYTES)
#define LAUNCH(K, layer) k_phase<K><<<256, NTHR, LDS_BYTES, stream>>>(p, layer)
    static bool attr_done = false;
    if (!attr_done) {
        SETATTR(K_PRO); SETATTR(K_E1); SETATTR(K_E2); SETATTR(K_E3); SETATTR(K_E4); SETATTR(K_E5); SETATTR(K_E6); SETATTR(K_LN1); SETATTR(K_O1); SETATTR(K_O2); SETATTR(K_O3);
        SETATTR(K_O4); SETATTR(K_M1); SETATTR(K_M2); SETATTR(K_M3); SETATTR(K_M4); SETATTR(K_LN2);
        attr_done = true;
    }
    LAUNCH(K_PRO, 0);
    for (int layer = 0; layer < 4; ++layer) {
        if ((layer & 1) == 0) { LAUNCH(K_E1, layer); LAUNCH(K_E2, layer); LAUNCH(K_E3, layer); LAUNCH(K_E4, layer); LAUNCH(K_E5, layer); LAUNCH(K_E6, layer); }
        else { LAUNCH(K_O1, layer); LAUNCH(K_O2, layer); LAUNCH(K_O3, layer); LAUNCH(K_O4, layer); }
        LAUNCH(K_LN1, layer); LAUNCH(K_M3, layer); LAUNCH(K_M4, layer); LAUNCH(K_LN2, layer);
    }
#else
    static int grid = 0;
    if (!grid) {
        hipFuncSetAttribute((const void*)k_mega, hipFuncAttributeMaxDynamicSharedMemorySize, LDS_BYTES);
        int dev = 0, cus = 0, per_cu = 0;
        hipGetDevice(&dev);
        hipDeviceGetAttribute(&cus, hipDeviceAttributeMultiprocessorCount, dev);
        hipOccupancyMaxActiveBlocksPerMultiprocessor(&per_cu, (const void*)k_mega, NTHR, LDS_BYTES);
        grid = cus * (per_cu < 1 ? per_cu : 1);
        if (grid <= 0) grid = 0;
    }
    if (!grid) { fprintf(stderr, "occupancy query says 0 blocks per CU\n"); return; }
    hipMemsetAsync((char*)d_ws + OFF_BAR, 0, XCD_BAR_WORDS * sizeof(unsigned), stream);
    k_mega<<<grid, NTHR, LDS_BYTES, stream>>>(p);
#endif
}
```

```cpp
#include <hip/hip_runtime.h>
#include <stdint.h>
#include <stdio.h>

#ifndef MEGA
#define MEGA 1
#define DUPMASK 0
#define DUPNOEPI 0
#endif

typedef unsigned short bf16_t;
typedef short bf16x8 __attribute__((ext_vector_type(8)));
typedef float f32x2 __attribute__((ext_vector_type(2)));
typedef float f32x4 __attribute__((ext_vector_type(4)));
typedef float f32x16 __attribute__((ext_vector_type(16)));
typedef unsigned u32x4 __attribute__((ext_vector_type(4)));
typedef unsigned u32x2 __attribute__((ext_vector_type(2)));

constexpr int T_ = 32768, D_ = 1024, L_ = 16384, NB_ = 2;
constexpr int NTHR = 512;
constexpr float ALPHA = 1.681792830507429f;
constexpr float LN_EPS = 1e-5f;
constexpr int EV_N = 2304;
constexpr int EV_P = 1792;
constexpr int PE_W = 1024;
constexpr int OD_N = 6656;
constexpr int OD_P = 4608;
constexpr int OD_QI = 1024, OD_DIL = 1280, OD_KI = 4352, OD_WI = 4416;
constexpr int UHW = 1152;
constexpr int LISTCAP = 131072;

constexpr size_t OFF_BAR = 0;
constexpr size_t OFF_CNT = 16384;
constexpr size_t OFF_A64 = 32768;
constexpr size_t OFF_WT_EVIN = 131072;
constexpr size_t OFF_WT_ODIN = OFF_WT_EVIN + (size_t)2 * EV_N * 1024 * 2;
constexpr size_t OFF_WT_EVOUT = OFF_WT_ODIN + (size_t)2 * OD_N * 1024 * 2;
constexpr size_t OFF_WT_ODOUT = OFF_WT_EVOUT + (size_t)2 * 1024 * 1024 * 2;
constexpr size_t OFF_WT_GLU = OFF_WT_ODOUT + (size_t)2 * 1024 * 1024 * 2;
constexpr size_t OFF_WT_RT = OFF_WT_GLU + (size_t)2 * 512 * 512 * 2;
constexpr size_t OFF_WT_W1 = OFF_WT_RT + (size_t)4 * 128 * 1024 * 2;
constexpr size_t OFF_WT_W2 = OFF_WT_W1 + (size_t)4 * 32 * 2048 * 1024 * 2;
constexpr size_t OFF_TH = OFF_WT_W2 + (size_t)4 * 32 * 1024 * 1024 * 2;
constexpr size_t OFF_GM = OFF_TH + (size_t)2 * 32 * 1024 * UHW * 2;
constexpr size_t OFF_XR = OFF_GM + (size_t)2 * 32 * 128 * 1024 * 2;
constexpr size_t OFF_BDEC = OFF_XR;
constexpr size_t OFF_XB = OFF_XR + (size_t)T_ * 1024 * 4;
constexpr size_t OFF_MIX = OFF_XB + (size_t)T_ * 1024 * 2;
constexpr size_t OFF_CC = OFF_MIX + (size_t)T_ * 1024 * 4;
constexpr size_t OFF_LOGIT = OFF_CC + (size_t)T_ * 1024 * 2;
constexpr size_t OFF_LIST = OFF_LOGIT + (size_t)T_ * 32 * 4;
constexpr size_t OFF_GATE = OFF_LIST + (size_t)32 * LISTCAP * 4;
constexpr size_t OFF_ACT = OFF_GATE + (size_t)T_ * 4 * 4;
constexpr size_t OFF_SLOT = OFF_ACT + (size_t)T_ * 4 * 1024 * 2;
constexpr size_t OFF_MIXER = OFF_SLOT + (size_t)T_ * 4 * 1024 * 4;
constexpr size_t OFF_PE = OFF_MIXER;
constexpr size_t OFF_UH = OFF_PE + (size_t)T_ * 1536 * 2;
constexpr size_t OFF_GLR = OFF_UH + (size_t)(T_ / 64) * 32 * UHW * 2;
constexpr size_t OFF_VTE = OFF_GLR + (size_t)T_ * 16 * 4;
constexpr size_t OFF_KV = OFF_VTE + (size_t)2 * 4 * 128 * L_ * 2;
constexpr size_t OFF_SST = OFF_KV + (size_t)2 * 256 * 4 * 64 * 128 * 4;
constexpr size_t OFF_DEC = OFF_SST + (size_t)2 * 256 * 4 * 64 * 128 * 4;
constexpr size_t OFF_GBUF = OFF_DEC + (size_t)2 * 256 * 4 * 64 * 4;
constexpr size_t OFF_YA = OFF_GBUF + (size_t)512 * 32 * 128 * 4;
constexpr size_t END_EVEN = OFF_YA + (size_t)T_ * 512 * 2;
constexpr size_t OFF_PO = OFF_MIXER;
constexpr size_t OFF_WI = OFF_PO + (size_t)T_ * OD_N * 2;
constexpr size_t OFF_VTC = OFF_WI + (size_t)T_ * 4 * 4;
constexpr size_t OFF_VTD = OFF_VTC + (size_t)2 * 8 * 64 * L_ * 2;
constexpr size_t OFF_BM = OFF_VTD + (size_t)2 * 3 * 8 * 64 * L_ * 2;
constexpr size_t OFF_OD = OFF_BM + (size_t)T_ * 256 * 8;
constexpr size_t OFF_LSE = OFF_OD + (size_t)3 * T_ * 512 * 4;
constexpr size_t END_ODD = OFF_LSE + (size_t)3 * T_ * 8 * 4;
constexpr size_t WS_NEED = END_ODD > END_EVEN ? END_ODD : END_EVEN;
static_assert(WS_NEED < (size_t)4200000000ull, "workspace too large");

constexpr int LDS_BYTES = 153600;

struct Params {
    const float *x, *ev_w_in, *gla_w_gate2, *gla_b_gate2, *gla_norm_g, *s5_a_re, *s5_a_im, *s5_log_dt, *s5_b_re, *s5_b_im, *s5_c_re, *s5_c_im, *s5_d,
        *s5_w_glu, *s5_b_glu, *ev_w_out, *od_w_in, *od_w_out, *ln1_g, *ln1_b, *ln2_g, *ln2_b, *router_w, *router_b, *moe_w1, *moe_b1, *moe_w2, *moe_b2;
    float* out;
    char* ws;
};

#if MEGA
typedef const __attribute__((address_space(4))) Params& PRef;
#else
typedef const Params& PRef;
#endif

__device__ __forceinline__ unsigned pk2(float lo, float hi) { unsigned r; asm("v_cvt_pk_bf16_f32 %0, %1, %2" : "=v"(r) : "v"(lo), "v"(hi)); return r; }
__device__ __forceinline__ bf16_t f2bf(float f) { return (bf16_t)(pk2(f, 0.f) & 0xffffu); }
__device__ __forceinline__ float bf2f(bf16_t h) { return __uint_as_float(((unsigned)h) << 16); }
__device__ __forceinline__ float sigmoidf_(float x) { return __builtin_amdgcn_rcpf(1.f + __expf(-x)); }
template <int CTRL> __device__ __forceinline__ float dppf(float v) { return __int_as_float(__builtin_amdgcn_update_dpp(0, __float_as_int(v), CTRL, 0xF, 0xF, false)); }
constexpr int DPP_X1 = 0xB1  , DPP_X2 = 0x4E  , DPP_HMIR = 0x141  , DPP_MIR = 0x140  , DPP_ROR8 = 0x128;
__device__ __forceinline__ float xor16_sum(float v) { const unsigned u = __float_as_uint(v); auto r = __builtin_amdgcn_permlane16_swap(u, u, false, false); return __uint_as_float(r[0]) + __uint_as_float(r[1]); }
__device__ __forceinline__ float xor16_max(float v) { const unsigned u = __float_as_uint(v); auto r = __builtin_amdgcn_permlane16_swap(u, u, false, false); return fmaxf(__uint_as_float(r[0]), __uint_as_float(r[1])); }
__device__ __forceinline__ float xor32_sum_(float v) { const unsigned u = __float_as_uint(v); auto r = __builtin_amdgcn_permlane32_swap(u, u, false, false); return __uint_as_float(r[0]) + __uint_as_float(r[1]); }
__device__ __forceinline__ float xor32_max_(float v) { const unsigned u = __float_as_uint(v); auto r = __builtin_amdgcn_permlane32_swap(u, u, false, false); return fmaxf(__uint_as_float(r[0]), __uint_as_float(r[1])); }
__device__ __forceinline__ float wave_sum(float v) {
    v += dppf<DPP_X1>(v); v += dppf<DPP_X2>(v); v += dppf<DPP_HMIR>(v); v += dppf<DPP_MIR>(v);
    return xor32_sum_(xor16_sum(v));
}
__device__ __forceinline__ float wave_max(float v) {
    v = fmaxf(v, dppf<DPP_X1>(v)); v = fmaxf(v, dppf<DPP_X2>(v)); v = fmaxf(v, dppf<DPP_HMIR>(v)); v = fmaxf(v, dppf<DPP_MIR>(v));
    return xor32_max_(xor16_max(v));
}
__device__ __forceinline__ float gelu_tanh(float x) {
    const float k0 = 0.7978845608028654f, k1 = 0.044715f;
    float u = k0 * (x + k1 * x * x * x);
    float t = 1.f - 2.f * __builtin_amdgcn_rcpf(1.f + __expf(2.f * u));
    return 0.5f * x * (1.f + t);
}
__device__ __forceinline__ float xor32_max(float v) { const unsigned u = __float_as_uint(v); auto r = __builtin_amdgcn_permlane32_swap(u, u, false, false); return fmaxf(__uint_as_float(r[0]), __uint_as_float(r[1])); }
__device__ __forceinline__ float xor32_sum(float v) { const unsigned u = __float_as_uint(v); auto r = __builtin_amdgcn_permlane32_swap(u, u, false, false); return __uint_as_float(r[0]) + __uint_as_float(r[1]); }
__device__ __forceinline__ unsigned xor32_or(unsigned u) { auto r = __builtin_amdgcn_permlane32_swap(u, u, false, false); return r[0] | r[1]; }
template <int BIT> __device__ __forceinline__ unsigned bitmask32(int w) { unsigned m; asm("v_bfe_i32 %0, %1, %2, 1" : "=v"(m) : "v"(w), "n"(BIT)); return m; }
__device__ __forceinline__ int otid() { int t = threadIdx.x; asm volatile("" : "+v"(t)); return t; }

#define XB_TMO      128
#define XB_XCNT(j)  (256  + 64 * (j))
#define XB_XSUB(j)  (1280 + 64 * (j))
#define XB_XGEN(j)  (2304 + 64 * (j))
#define XB_TOP      3328
#define XB_TOPGEN   3392
#define XCD_BAR_WORDS 3456
#define XB_SPIN_CAP (1u << 21)
#define LAS __attribute__((address_space(3)))

__device__ __forceinline__ unsigned xb_ld(unsigned* p)              { return __hip_atomic_load(p, __ATOMIC_RELAXED, __HIP_MEMORY_SCOPE_AGENT); }
__device__ __forceinline__ unsigned xb_add(unsigned* p, unsigned v) { return __hip_atomic_fetch_add(p, v, __ATOMIC_RELAXED, __HIP_MEMORY_SCOPE_AGENT); }
__device__ __forceinline__ unsigned xb_xcc_id() { return (unsigned)__builtin_amdgcn_s_getreg((3 << 11) | 20) & 0xFu; }
#define XB_SPIN(cond, bar) do { unsigned _sp = 0; while (cond) { __builtin_amdgcn_s_sleep(1); \
    if ((++_sp & 255u) == 0u) { if (xb_ld(&(bar)[XB_TMO])) break; if (_sp > XB_SPIN_CAP) { atomicAdd(&(bar)[XB_TMO], 1u); break; } } } } while (0)

struct XcdBarrier { unsigned* bar; unsigned x; volatile LAS unsigned* st; };

__device__ __forceinline__ XcdBarrier xcd_barrier_post(unsigned* bar, volatile LAS unsigned* st) {
    XcdBarrier b; b.bar = bar; b.x = xb_xcc_id(); b.st = st;
    if (threadIdx.x == 0) (void)xb_add(&bar[XB_XCNT(b.x)], 1u);
    return b;
}
__device__ __forceinline__ void xcd_barrier_complete(unsigned* bar, unsigned x, unsigned& nloc, unsigned& nx) {
    const unsigned G = gridDim.x * gridDim.y * gridDim.z;
    unsigned sum, cnt, mine, sp = 0u;
    for (;;) {
        sum = 0u; cnt = 0u; mine = 0u;
#pragma unroll
        for (unsigned j = 0; j < 16; ++j) { const unsigned c = xb_ld(&bar[XB_XCNT(j)]); sum += c; cnt += (c > 0u) ? 1u : 0u; mine = (j == x) ? c : mine; }
        if (sum == G) break;
        __builtin_amdgcn_s_sleep(1);
        if ((++sp & 255u) == 0u) { if (xb_ld(&bar[XB_TMO])) break; if (sp > XB_SPIN_CAP) { atomicAdd(&bar[XB_TMO], 1u); break; } }
    }
    nloc = mine > 0u ? mine : 1u; nx = cnt > 0u ? cnt : 1u;
}
__device__ __forceinline__ void xcd_barrier(const XcdBarrier& b) {
    asm volatile("s_waitcnt vmcnt(0)" ::: "memory");
    __syncthreads();
    if (threadIdx.x == 0) {
        unsigned* bar = b.bar;
        __builtin_amdgcn_s_waitcnt(0);
        unsigned nloc = b.st[0], nx = b.st[1];
        if (nloc == 0u) { xcd_barrier_complete(bar, b.x, nloc, nx); b.st[0] = nloc; b.st[1] = nx; }
        const unsigned old = xb_add(&bar[XB_XSUB(b.x)], 1u);
        const unsigned gen = old / nloc;
        if (old + 1u == (gen + 1u) * nloc) {
            __builtin_amdgcn_fence(__ATOMIC_RELEASE, "agent");
            asm volatile("s_waitcnt vmcnt(0)" ::: "memory");
            const unsigned og = xb_add(&bar[XB_TOP], 1u);
            const unsigned tg = og / nx;
            if (og + 1u == (tg + 1u) * nx) xb_add(&bar[XB_TOPGEN], 1u);
            else XB_SPIN(xb_ld(&bar[XB_TOPGEN]) == tg, bar);
            __builtin_amdgcn_fence(__ATOMIC_ACQUIRE, "agent");
            xb_add(&bar[XB_XGEN(b.x)], 1u);
            asm volatile("s_waitcnt vmcnt(0)" ::: "memory");
        } else {
            XB_SPIN(xb_ld(&bar[XB_XGEN(b.x)]) == gen, bar);
            __builtin_amdgcn_fence(__ATOMIC_ACQUIRE, "agent");
            asm volatile("s_waitcnt vmcnt(0)" ::: "memory");
        }
    }
    __syncthreads();
}

constexpr int G_LROW = 144;
constexpr int G_ASZ = 256 * G_LROW;
constexpr int G_BSZ = 128 * G_LROW;
constexpr int G_STAGE = G_ASZ + G_BSZ;
constexpr int G_ROWS_OFF = 2 * G_STAGE;

template <bool GATHER, class Epi>
__device__ __forceinline__ void gemm_tile(const bf16_t* __restrict__ A, long lda, int shift, int m0, const bf16_t* __restrict__ Bt, long ldb, int n0, int K,
                                          char* smem, Epi&& epi) {
    const int tid = otid(), lane = tid & 63, wave = tid >> 6, wr = wave >> 1, wc = wave & 1, fr = lane & 15, fq = lane >> 4;
    const int lrow = tid >> 3, lchunk = tid & 7;
    const int* sRow = (const int*)(smem + G_ROWS_OFF);
    const bf16_t* pa[4]; const bf16_t* pb[2];
#pragma unroll
    for (int i = 0; i < 4; ++i) {
        int r = lrow + 64 * i; long arow;
        if (GATHER) { int v = sRow[r]; arow = v < 0 ? 0 : (v >> shift); } else arow = m0 + r;
        pa[i] = A + arow * lda + lchunk * 8;
    }
#pragma unroll
    for (int i = 0; i < 2; ++i) pb[i] = Bt + (long)(n0 + lrow + 64 * i) * ldb + lchunk * 8;
    f32x4 acc[4][4];
#pragma unroll
    for (int m = 0; m < 4; ++m)
#pragma unroll
        for (int n = 0; n < 4; ++n) acc[m][n] = (f32x4){0.f, 0.f, 0.f, 0.f};
    u32x4 ra[4], rb[2];
    const int nk = K >> 6;
#pragma unroll
    for (int i = 0; i < 4; ++i) ra[i] = *(const u32x4*)(pa[i]);
#pragma unroll
    for (int i = 0; i < 2; ++i) rb[i] = *(const u32x4*)(pb[i]);
    {
        char* sa = smem; char* sb = smem + G_ASZ;
#pragma unroll
        for (int i = 0; i < 4; ++i) *(u32x4*)(sa + (lrow + 64 * i) * G_LROW + lchunk * 16) = ra[i];
#pragma unroll
        for (int i = 0; i < 2; ++i) *(u32x4*)(sb + (lrow + 64 * i) * G_LROW + lchunk * 16) = rb[i];
    }
    __syncthreads();
    for (int kt = 0; kt < nk; ++kt) {
        const bool more = (kt + 1 < nk);
        if (more) {
#pragma unroll
            for (int i = 0; i < 4; ++i) ra[i] = *(const u32x4*)(pa[i] + (kt + 1) * 64);
#pragma unroll
            for (int i = 0; i < 2; ++i) rb[i] = *(const u32x4*)(pb[i] + (kt + 1) * 64);
        }
        const char* sa = smem + (kt & 1) * G_STAGE; const char* sb = sa + G_ASZ;
#pragma unroll
        for (int ks = 0; ks < 2; ++ks) {
            bf16x8 af[4], bfr[4];
#pragma unroll
            for (int m = 0; m < 4; ++m) af[m] = *(const bf16x8*)(sa + (wr * 64 + m * 16 + fr) * G_LROW + (ks * 32 + fq * 8) * 2);
#pragma unroll
            for (int n = 0; n < 4; ++n) bfr[n] = *(const bf16x8*)(sb + (wc * 64 + n * 16 + fr) * G_LROW + (ks * 32 + fq * 8) * 2);
#pragma unroll
            for (int m = 0; m < 4; ++m)
#pragma unroll
                for (int n = 0; n < 4; ++n) acc[m][n] = __builtin_amdgcn_mfma_f32_16x16x32_bf16(af[m], bfr[n], acc[m][n], 0, 0, 0);
        }
        if (more) {
            char* wa = smem + ((kt + 1) & 1) * G_STAGE; char* wb = wa + G_ASZ;
#pragma unroll
            for (int i = 0; i < 4; ++i) *(u32x4*)(wa + (lrow + 64 * i) * G_LROW + lchunk * 16) = ra[i];
#pragma unroll
            for (int i = 0; i < 2; ++i) *(u32x4*)(wb + (lrow + 64 * i) * G_LROW + lchunk * 16) = rb[i];
        }
        __syncthreads();
    }
    {
        f32x4 h0[4][2], h1[4][2];
#pragma unroll
        for (int m = 0; m < 4; ++m) { h0[m][0] = acc[m][0]; h0[m][1] = acc[m][1]; h1[m][0] = acc[m][2]; h1[m][1] = acc[m][3]; }
        epi(h0, wr * 64, n0 + wc * 64, fr, fq);
        epi(h1, wr * 64, n0 + wc * 64 + 32, fr, fq);
    }
}

template <class Epi>
__device__ __forceinline__ void gemm_phase(const bf16_t* A, long lda, int M, const bf16_t* Bt, long ldb, int N, int K, char* smem, int bid, int nb, Epi&& epi) {
    const int ntn = N / 128, ntm = M / 256, nt = ntn * ntm;
    for (int t = bid; t < nt; t += nb) {
        const int mi = t / ntn, ni = t - mi * ntn;
        gemm_tile<false>(A, lda, 0, mi * 256, Bt, ldb, ni * 128, K, smem,
                         [&](f32x4 (&acc)[4][2], int rt0, int c0, int fr, int fq) { epi(acc, mi * 256 + rt0, c0, fr, fq); });
    }
}

constexpr int G8_HT = 128 * 64 * 2;
constexpr int G8_ROWS_OFF = 8 * G8_HT;

__device__ __forceinline__ int g8_lds_byte(int r, int c) {
    const int st = (r >> 4) * 2 + (c >> 5), rr = r & 15, cc = c & 31, ob = rr * 64 + cc * 2;
    return st * 1024 + (ob ^ (((ob >> 9) & 1) << 5));
}
__device__ __forceinline__ void g8_stage_rc(int b, int& R, int& C) {
    const int st = b / 1024, sb = b % 1024, swz = sb ^ (((sb >> 9) & 1) << 5);
    R = (st >> 1) * 16 + swz / 64; C = (st & 1) * 32 + (swz % 64) / 2;
}

#define G8_SA(b, h) (lds + ((b) * 2 + (h)) * G8_HT)
#define G8_SB(b, h) (lds + (4 + (b) * 2 + (h)) * G8_HT)
#define G8_STAGE(P, RS, OFF, soff) do { \
    _Pragma("unroll") for (int _i = 0; _i < 2; ++_i) \
        __builtin_amdgcn_raw_ptr_buffer_load_lds((RS), (LAS unsigned*)((P) + tid * 16 + _i * 8192), 16, (OFF)[_i], (soff), 0, 0); } while (0)
#define G8_LDA(dst, b, h) do { _Pragma("unroll") for (int m = 0; m < 4; ++m) _Pragma("unroll") for (int k = 0; k < 2; ++k) \
    dst[m][k] = *(const LAS bf16x8*)(G8_SA(b, h) + g8_lds_byte(wr * 64 + m * 16 + fr, k * 32 + fq * 8)); } while (0)
#define G8_LDB(dst, b, h) do { _Pragma("unroll") for (int n = 0; n < 2; ++n) _Pragma("unroll") for (int k = 0; k < 2; ++k) \
    dst[n][k] = *(const LAS bf16x8*)(G8_SB(b, h) + g8_lds_byte(wc * 32 + n * 16 + fr, k * 32 + fq * 8)); } while (0)
#define G8_MMA(ai, bj, At, Bt_) do { __builtin_amdgcn_s_setprio(1); \
    _Pragma("unroll") for (int m = 0; m < 4; ++m) _Pragma("unroll") for (int n = 0; n < 2; ++n) _Pragma("unroll") for (int k = 0; k < 2; ++k) \
        acc[ai][bj][m][n] = __builtin_amdgcn_mfma_f32_16x16x32_bf16(Bt_[n][k], At[m][k], acc[ai][bj][m][n], 0, 0, 0); \
    __builtin_amdgcn_s_setprio(0); } while (0)
#define G8_WAIT_V(n) asm volatile("s_waitcnt vmcnt(" #n ")" ::: "memory")
#define G8_WAIT_L(n) asm volatile("s_waitcnt lgkmcnt(" #n ")" ::: "memory")
#define G8_BAR __builtin_amdgcn_s_barrier()
#define G8_SCHED __builtin_amdgcn_sched_barrier(0)

template <bool GATHER, class Epi>
__device__ __forceinline__ void gemm256_tile(const bf16_t* __restrict__ A, long lda, int shift, int m0, const bf16_t* __restrict__ Bt, long ldb, int n0, int K,
                                             char* smem, Epi&& epi) {
    LAS char* lds = (LAS char*)smem;
    int tid = otid();
    int wid = tid >> 6, lane = tid & 63, wr = wid >> 2, wc = wid & 3, fr = lane & 15, fq = lane >> 4;
    unsigned aoff[2][2], boff[2];
    {
        const LAS int* sRow = (const LAS int*)(lds + G8_ROWS_OFF);
#pragma unroll
        for (int i = 0; i < 2; ++i) {
            int R, C; g8_stage_rc(tid * 16 + i * 8192, R, C);
            { const int rho = R & 31, nn = rho >> 4, ii = rho & 15; const int Rp = (R & ~31) + 8 * (ii >> 2) + 4 * nn + (ii & 3);
              boff[i] = (unsigned)((long)Rp * ldb + C) * 2u; }
#pragma unroll
            for (int h = 0; h < 2; ++h) {
                long arow;
                if (GATHER) { const int v = sRow[h * 128 + R]; arow = v < 0 ? 0 : (v >> shift); } else arow = m0 + h * 128 + R;
                aoff[h][i] = (unsigned)(arow * lda + C) * 2u;
            }
        }
    }
    f32x4 acc[2][2][4][2];
#pragma unroll
    for (int a = 0; a < 2; ++a)
#pragma unroll
        for (int b = 0; b < 2; ++b)
#pragma unroll
            for (int m = 0; m < 4; ++m)
#pragma unroll
                for (int n = 0; n < 2; ++n) acc[a][b][m][n] = (f32x4){0.f, 0.f, 0.f, 0.f};
    bf16x8 At[4][2], B0[2][2], B1[2][2];
    const int nt = K / 64;
    const __amdgpu_buffer_rsrc_t rA = __builtin_amdgcn_make_buffer_rsrc((void*)A, 0, 0x7fffffff, 0x00020000);
    const __amdgpu_buffer_rsrc_t rB = __builtin_amdgcn_make_buffer_rsrc((void*)(Bt + (size_t)n0 * ldb), 0, 0x7fffffff, 0x00020000);
    const int bh = (int)(128 * ldb * 2);
    G8_STAGE(G8_SB(0, 0), rB, boff, 0); G8_STAGE(G8_SA(0, 0), rA, aoff[0], 0);
    G8_STAGE(G8_SB(0, 1), rB, boff, bh); G8_STAGE(G8_SA(0, 1), rA, aoff[1], 0);
    if (wr == 1) G8_BAR;
    G8_WAIT_V(4); G8_BAR;
    G8_STAGE(G8_SB(1, 0), rB, boff, 128); G8_STAGE(G8_SA(1, 0), rA, aoff[0], 128); G8_STAGE(G8_SB(1, 1), rB, boff, 128 + bh);
    G8_WAIT_V(6); G8_BAR;
    for (int t = 0; t < nt - 2; t += 2) {
        G8_LDB(B0, 0, 0); G8_SCHED; G8_LDA(At, 0, 0); G8_STAGE(G8_SA(1, 1), rA, aoff[1], (t + 1) * 128);
        G8_WAIT_L(8); G8_BAR; G8_WAIT_L(0); G8_MMA(0, 0, At, B0); G8_BAR; G8_SCHED;
        G8_LDB(B1, 0, 1); G8_STAGE(G8_SB(0, 0), rB, boff, (t + 2) * 128);
        G8_BAR; G8_WAIT_L(0); G8_MMA(0, 1, At, B1); G8_BAR;
        G8_LDA(At, 0, 1); G8_STAGE(G8_SA(0, 0), rA, aoff[0], (t + 2) * 128);
        G8_BAR; G8_WAIT_L(0); G8_MMA(1, 0, At, B0); G8_BAR; G8_SCHED;
        G8_STAGE(G8_SB(0, 1), rB, boff, (t + 2) * 128 + bh);
        G8_WAIT_V(6); G8_BAR; G8_MMA(1, 1, At, B1); G8_BAR;
        G8_LDB(B0, 1, 0); G8_SCHED; G8_LDA(At, 1, 0); G8_STAGE(G8_SA(0, 1), rA, aoff[1], (t + 2) * 128);
        G8_WAIT_L(8); G8_BAR; G8_WAIT_L(0); G8_MMA(0, 0, At, B0); G8_BAR; G8_SCHED;
        G8_LDB(B1, 1, 1); G8_STAGE(G8_SB(1, 0), rB, boff, (t + 3) * 128);
        G8_BAR; G8_WAIT_L(0); G8_MMA(0, 1, At, B1); G8_BAR;
        G8_LDA(At, 1, 1); G8_STAGE(G8_SA(1, 0), rA, aoff[0], (t + 3) * 128);
        G8_BAR; G8_WAIT_L(0); G8_MMA(1, 0, At, B0); G8_BAR; G8_SCHED;
        G8_STAGE(G8_SB(1, 1), rB, boff, (t + 3) * 128 + bh);
        G8_WAIT_V(6); G8_BAR; G8_MMA(1, 1, At, B1); G8_BAR;
    }
    { G8_LDB(B0, 0, 0); G8_WAIT_V(0); G8_LDA(At, 0, 0); G8_STAGE(G8_SA(1, 1), rA, aoff[1], (nt - 1) * 128);
      G8_BAR; G8_WAIT_L(0); G8_MMA(0, 0, At, B0); G8_BAR;
      G8_LDB(B1, 0, 1); G8_BAR; G8_WAIT_L(0); G8_MMA(0, 1, At, B1); G8_BAR;
      G8_LDA(At, 0, 1); G8_WAIT_V(4); G8_BAR; G8_WAIT_L(0); G8_MMA(1, 0, At, B0); G8_MMA(1, 1, At, B1); G8_BAR; }
    { G8_LDB(B0, 1, 0); G8_LDA(At, 1, 0); G8_WAIT_V(2); G8_BAR; G8_WAIT_L(0); G8_MMA(0, 0, At, B0); G8_BAR;
      G8_LDB(B1, 1, 1); G8_WAIT_V(0); G8_BAR; G8_WAIT_L(0); G8_MMA(0, 1, At, B1); G8_BAR;
      G8_LDA(At, 1, 1); G8_BAR; G8_WAIT_L(0); G8_MMA(1, 0, At, B0); G8_MMA(1, 1, At, B1); G8_BAR; }
    if (wr == 0) G8_BAR;
    int tz = otid(); wid = tz >> 6; lane = tz & 63; wr = wid >> 2; wc = wid & 3; fr = lane & 15; fq = lane >> 4;
#pragma unroll
    for (int ai = 0; ai < 2; ++ai)
#pragma unroll
        for (int bj = 0; bj < 2; ++bj) epi(acc[ai][bj], ai * 128 + wr * 64, n0 + bj * 128 + wc * 32, fr, fq);
}

struct G8Desc { const bf16_t* A; const bf16_t* Bt; const int* list; int m0, n0, count, u0, ldb; };

template <bool GATHER, int SHIFT, class Src, class Epi>
__device__ __forceinline__ void gemm256_stream(Src&& src, const int lda, const int K, char* smem, Epi&& epi) {
    LAS char* lds = (LAS char*)smem;
    int tid = otid();
    int wid = tid >> 6, lane = tid & 63, wr = wid >> 2, wc = wid & 3, fr = lane & 15, fq = lane >> 4;
    G8Desc nxt;
    if (!src(0, nxt)) return;
    int cm0 = nxt.m0, cn0 = nxt.n0, cu0 = nxt.u0;
    int* sRowG = (int*)(smem + G8_ROWS_OFF);
    __syncthreads();
    if (GATHER) { if (tid < 256) sRowG[tid] = tid < nxt.count ? nxt.list[tid] : -1; __syncthreads(); }
    unsigned aoff[2][2], boff[2];
    __amdgpu_buffer_rsrc_t rA, rB;
    int bh;
#define G8_PREP(D, SLOT) do { \
        const LAS int* _sr = (const LAS int*)(lds + G8_ROWS_OFF) + (SLOT) * 256; \
        _Pragma("unroll") for (int i = 0; i < 2; ++i) { \
            int R, C; g8_stage_rc(tid * 16 + i * 8192, R, C); \
            { const int rho = R & 31, nn = rho >> 4, ii = rho & 15; const int Rp = (R & ~31) + 8 * (ii >> 2) + 4 * nn + (ii & 3); boff[i] = (unsigned)(Rp * (D).ldb + C) * 2u; } \
            _Pragma("unroll") for (int h = 0; h < 2; ++h) { \
                int arow; \
                if (GATHER) { const int v = _sr[h * 128 + R]; arow = v < 0 ? 0 : (v >> SHIFT); } else arow = (D).m0 + h * 128 + R; \
                aoff[h][i] = (unsigned)(arow * lda + C) * 2u; } } \
        rA = __builtin_amdgcn_make_buffer_rsrc((void*)(D).A, 0, 0x7fffffff, 0x00020000); \
        rB = __builtin_amdgcn_make_buffer_rsrc((void*)((D).Bt + (size_t)(D).n0 * (D).ldb), 0, 0x7fffffff, 0x00020000); bh = 128 * (D).ldb * 2; } while (0)
#define G8_PRO1() do { G8_STAGE(G8_SB(0, 0), rB, boff, 0); G8_STAGE(G8_SA(0, 0), rA, aoff[0], 0); G8_STAGE(G8_SB(0, 1), rB, boff, bh); G8_STAGE(G8_SA(0, 1), rA, aoff[1], 0); } while (0)
    G8_PREP(nxt, 0);
    G8_PRO1();
    f32x4 acc[2][2][4][2];
    const int nt = K / 64;
    for (int it = 0;; ++it) {
#pragma unroll
        for (int a = 0; a < 2; ++a)
#pragma unroll
            for (int b = 0; b < 2; ++b)
#pragma unroll
                for (int m = 0; m < 4; ++m)
#pragma unroll
                    for (int n = 0; n < 2; ++n) acc[a][b][m][n] = (f32x4){0.f, 0.f, 0.f, 0.f};
        const bool has_next = src(it + 1, nxt);
        if (GATHER && has_next && tid < 256) sRowG[((it + 1) % 3) * 256 + tid] = tid < nxt.count ? nxt.list[tid] : -1;
        bf16x8 At[4][2], B0[2][2], B1[2][2];
        if (wr == 1) G8_BAR;
        G8_WAIT_V(4); G8_BAR;
        G8_STAGE(G8_SB(1, 0), rB, boff, 128); G8_STAGE(G8_SA(1, 0), rA, aoff[0], 128); G8_STAGE(G8_SB(1, 1), rB, boff, 128 + bh);
        G8_WAIT_V(6); G8_BAR;
        for (int t = 0; t < nt - 2; t += 2) {
            G8_LDB(B0, 0, 0); G8_SCHED; G8_LDA(At, 0, 0); G8_STAGE(G8_SA(1, 1), rA, aoff[1], (t + 1) * 128);
            G8_WAIT_L(8); G8_BAR; G8_WAIT_L(0); G8_MMA(0, 0, At, B0); G8_BAR; G8_SCHED;
            G8_LDB(B1, 0, 1); G8_STAGE(G8_SB(0, 0), rB, boff, (t + 2) * 128);
            G8_BAR; G8_WAIT_L(0); G8_MMA(0, 1, At, B1); G8_BAR;
            G8_LDA(At, 0, 1); G8_STAGE(G8_SA(0, 0), rA, aoff[0], (t + 2) * 128);
            G8_BAR; G8_WAIT_L(0); G8_MMA(1, 0, At, B0); G8_BAR; G8_SCHED;
            G8_STAGE(G8_SB(0, 1), rB, boff, (t + 2) * 128 + bh);
            G8_WAIT_V(6); G8_BAR; G8_MMA(1, 1, At, B1); G8_BAR;
            G8_LDB(B0, 1, 0); G8_SCHED; G8_LDA(At, 1, 0); G8_STAGE(G8_SA(0, 1), rA, aoff[1], (t + 2) * 128);
            G8_WAIT_L(8); G8_BAR; G8_WAIT_L(0); G8_MMA(0, 0, At, B0); G8_BAR; G8_SCHED;
            G8_LDB(B1, 1, 1); G8_STAGE(G8_SB(1, 0), rB, boff, (t + 3) * 128);
            G8_BAR; G8_WAIT_L(0); G8_MMA(0, 1, At, B1); G8_BAR;
            G8_LDA(At, 1, 1); G8_STAGE(G8_SA(1, 0), rA, aoff[0], (t + 3) * 128);
            G8_BAR; G8_WAIT_L(0); G8_MMA(1, 0, At, B0); G8_BAR; G8_SCHED;
            G8_STAGE(G8_SB(1, 1), rB, boff, (t + 3) * 128 + bh);
            G8_WAIT_V(6); G8_BAR; G8_MMA(1, 1, At, B1); G8_BAR;
        }
        { G8_LDB(B0, 0, 0); G8_WAIT_V(0); G8_LDA(At, 0, 0); G8_STAGE(G8_SA(1, 1), rA, aoff[1], (nt - 1) * 128);
          G8_BAR; G8_WAIT_L(0); G8_MMA(0, 0, At, B0); G8_BAR;
          G8_LDB(B1, 0, 1); G8_BAR; G8_WAIT_L(0); G8_MMA(0, 1, At, B1); G8_BAR;
          G8_LDA(At, 0, 1); G8_WAIT_V(4); G8_BAR; G8_WAIT_L(0); G8_MMA(1, 0, At, B0); G8_MMA(1, 1, At, B1); G8_BAR; }
        { G8_LDB(B0, 1, 0); G8_LDA(At, 1, 0); G8_WAIT_V(2); G8_BAR; G8_WAIT_L(0); G8_MMA(0, 0, At, B0); G8_BAR;
          G8_LDB(B1, 1, 1); G8_WAIT_V(0); G8_BAR; G8_WAIT_L(0); G8_MMA(0, 1, At, B1); G8_BAR;
          G8_LDA(At, 1, 1); G8_BAR; G8_WAIT_L(0); G8_MMA(1, 0, At, B0); G8_MMA(1, 1, At, B1); G8_BAR; }
        if (wr == 0) G8_BAR;
        tid = otid(); wid = tid >> 6; lane = tid & 63; wr = wid >> 2; wc = wid & 3; fr = lane & 15; fq = lane >> 4;
        if (has_next) { G8_PREP(nxt, (it + 1) % 3); G8_PRO1(); }
        {
            const int* sr = sRowG + (it % 3) * 256;
#pragma unroll
            for (int ai = 0; ai < 2; ++ai)
#pragma unroll
                for (int bj = 0; bj < 2; ++bj) epi(cm0, cu0, acc[ai][bj], ai * 128 + wr * 64, cn0 + bj * 128 + wc * 32, fr, fq, sr);
        }
        if (!has_next) break;
        cm0 = nxt.m0; cn0 = nxt.n0; cu0 = nxt.u0;
    }
#undef G8_PREP
#undef G8_PRO1
}

struct XcdSeq {
    int q, qend, step;
    __device__ __forceinline__ XcdSeq(int total, int bid, int nb) {
        if ((nb & 7) == 0) { const int chunk = (total + 7) >> 3, x = bid & 7; q = x * chunk + (bid >> 3); const int e = (x + 1) * chunk; qend = e < total ? e : total; step = nb >> 3; }
        else { q = bid; qend = total; step = nb; }
    }
};

template <class Epi>
__device__ __forceinline__ void gemm256_phase(const bf16_t* A, long lda, int M, const bf16_t* Bt, long ldb, int N, int K, char* smem, int bid, int nb, Epi&& epi) {
    const int ntn = N / 256, ntm = M / 256, nt = ntn * ntm;
    XcdSeq s(nt, bid, nb);
    gemm256_stream<false, 0>(
        [&](int i, G8Desc& d) -> bool {
            const int Q = s.q + i * s.step; if (Q >= s.qend) return false;
            const int pnl = Q / (4 * ntn), r = Q - pnl * 4 * ntn;
            d.A = A; d.Bt = Bt; d.list = nullptr; d.m0 = (pnl * 4 + (r & 3)) * 256; d.n0 = (r >> 2) * 256; d.count = 0; d.u0 = 0; d.ldb = (int)ldb;
            return true; },
        (int)lda, K, smem,
        [&](int m0, int, f32x4 (&acc)[4][2], int rt0, int c0, int fr, int fq, const int*) { epi(acc, m0 + rt0, c0, fr, fq); });
}


__device__ __forceinline__ int colmap(int kind, int n, int nsrc) {
    if (kind == 0) return n < nsrc ? n : -1;
    if (kind == 1) { if (n < 512) return n; if (n < 1024) return n + 512; if (n < 1536) return n + 528; if (n < 1552) return n; if (n < 1792) return -1; return n - 1280; }
    if (kind == 2) { if (n < 1024) return n; if (n < 1280) return n + 512; if (n < 4352) return n + 580; if (n < 4420) return n - 2560; if (n < 4608) return -1; if (n < 5120) return n - 3584; return n - 188; }
    { const int grp = n >> 5, w = n & 31; return ((w >> 2) & 1) * 1024 + grp * 16 + 4 * (w >> 3) + (w & 3); }
}
struct ConvTile { const float* src; bf16_t* dst; int sld, sc, K, n0, k0; };
__device__ __forceinline__ ConvTile conv_decode(PRef p, int t, int n4) {
    constexpr int S0 = 128 * 32 * 4, S1 = S0 + 128 * 16 * 4, S2 = S1 + 2 * 36 * 4, S3 = S2 + 2 * 104 * 4, S4 = S3 + 2 * 16 * 4, S5 = S4 + 2 * 16 * 4, S6 = S5 + 2 * 8 * 2;
    char* ws = p.ws;
    ConvTile c; int nsrc, kind, NT, loc;
    if (t < S0) { loc = t; const int mat = loc / (32 * 4); loc -= mat * 32 * 4; c.src = p.moe_w1 + (size_t)mat * 1024 * 2048; c.dst = (bf16_t*)(ws + OFF_WT_W1) + (size_t)mat * 2048 * 1024; c.sld = 2048; nsrc = 2048; kind = 3; c.K = 1024; NT = 32; }
    else if (t < S1) { loc = t - S0; const int mat = loc / 64; loc -= mat * 64; c.src = p.moe_w2 + (size_t)mat * 1024 * 1024; c.dst = (bf16_t*)(ws + OFF_WT_W2) + (size_t)mat * 1024 * 1024; c.sld = 1024; nsrc = 1024; kind = 0; c.K = 1024; NT = 16; }
    else if (t < S2) { loc = t - S1; const int mat = loc / (36 * 4); loc -= mat * 36 * 4; c.src = p.ev_w_in + (size_t)mat * 1024 * 2064; c.dst = (bf16_t*)(ws + OFF_WT_EVIN) + (size_t)mat * EV_N * 1024; c.sld = 2064; nsrc = 2064; kind = 1; c.K = 1024; NT = 36; }
    else if (t < S3) { loc = t - S2; const int mat = loc / (104 * 4); loc -= mat * 104 * 4; c.src = p.od_w_in + (size_t)mat * 1024 * 6468; c.dst = (bf16_t*)(ws + OFF_WT_ODIN) + (size_t)mat * OD_N * 1024; c.sld = 6468; nsrc = 6468; kind = 2; c.K = 1024; NT = 104; }
    else if (t < S4) { loc = t - S3; const int mat = loc / 64; loc -= mat * 64; c.src = p.ev_w_out + (size_t)mat * 1024 * 1024; c.dst = (bf16_t*)(ws + OFF_WT_EVOUT) + (size_t)mat * 1024 * 1024; c.sld = 1024; nsrc = 1024; kind = 0; c.K = 1024; NT = 16; }
    else if (t < S5) { loc = t - S4; const int mat = loc / 64; loc -= mat * 64; c.src = p.od_w_out + (size_t)mat * 1024 * 1024; c.dst = (bf16_t*)(ws + OFF_WT_ODOUT) + (size_t)mat * 1024 * 1024; c.sld = 1024; nsrc = 1024; kind = 0; c.K = 1024; NT = 16; }
    else if (t < S6) { loc = t - S5; const int mat = loc / 16; loc -= mat * 16; c.src = p.s5_w_glu + (size_t)mat * 512 * 512; c.dst = (bf16_t*)(ws + OFF_WT_GLU) + (size_t)mat * 512 * 512; c.sld = 512; nsrc = 512; kind = 0; c.K = 512; NT = 8; }
    else { loc = t - S6; const int mat = loc / 8; loc -= mat * 8; c.src = p.router_w + (size_t)mat * 1024 * 32; c.dst = (bf16_t*)(ws + OFF_WT_RT) + (size_t)mat * 128 * 1024; c.sld = 32; nsrc = 32; kind = 0; c.K = 1024; NT = 2; }
    const int kt = loc / NT, nt = loc - kt * NT;
    c.n0 = nt * 64; c.k0 = kt * 256;
    c.sc = colmap(kind, c.n0 + n4 * 4, nsrc);
    return c;
}
__device__ __forceinline__ void conv_load(const ConvTile& c, int kp, f32x4 (&v)[8]) {
#pragma unroll
    for (int i = 0; i < 4; ++i)
#pragma unroll
        for (int e = 0; e < 2; ++e) {
            const int k = c.k0 + 2 * (kp + 32 * i) + e;
            v[2 * i + e] = c.sc >= 0 ? *(const f32x4*)(c.src + (size_t)k * c.sld + c.sc) : (f32x4){0.f, 0.f, 0.f, 0.f};
        }
}

__device__ __forceinline__ void conv_phase(PRef p, char* smem, int bid, int nb) {
    char* ws = p.ws;
    constexpr int NTILES = 128 * 32 * 4 + 128 * 16 * 4 + 2 * 36 * 4 + 2 * 104 * 4 + 2 * 16 * 4 + 2 * 16 * 4 + 2 * 8 * 2 + 4 * 2 * 4;
    bf16_t* tile = (bf16_t*)smem;
    const int tid = otid(), n4 = tid & 15, kp = tid >> 4;
    if (bid < NTILES) {
        ConvTile cur = conv_decode(p, bid, n4);
        f32x4 v[8];
        conv_load(cur, kp, v);
        for (int t = bid; t < NTILES; t += nb) {
            const bool more = t + nb < NTILES;
            ConvTile nxt = cur; f32x4 w[8];
            if (more) { nxt = conv_decode(p, t + nb, n4); conv_load(nxt, kp, w); }
#pragma unroll
            for (int i = 0; i < 4; ++i)
#pragma unroll
                for (int j = 0; j < 4; ++j)
                    *(unsigned*)(tile + (n4 * 4 + j) * 258 + 2 * (kp + 32 * i)) = pk2(v[2 * i][j], v[2 * i + 1][j]);
            __syncthreads();
#pragma unroll
            for (int i = 0; i < 4; ++i) {
                const int c = tid + 512 * i, n = c >> 5, kc = c & 31;
                const unsigned* tp = (const unsigned*)(tile + n * 258 + kc * 8);
                u32x4 o; o.x = tp[0]; o.y = tp[1]; o.z = tp[2]; o.w = tp[3];
                *(u32x4*)(cur.dst + (size_t)(cur.n0 + n) * cur.K + cur.k0 + kc * 8) = o;
            }
            __syncthreads();
            if (more) {
                cur = nxt;
#pragma unroll
                for (int i = 0; i < 8; ++i) v[i] = w[i];
            }
        }
    }
    {
        const float* x = p.x; bf16_t* xb = (bf16_t*)(ws + OFF_XB);
        const long nch = (long)T_ * 1024 / 8;
        for (long c = (long)bid * NTHR + otid(); c < nch; c += (long)nb * NTHR) {
            const f32x4 a = *(const f32x4*)(x + c * 8), b = *(const f32x4*)(x + c * 8 + 4);
            u32x4 w; w.x = pk2(a[0], a[1]); w.y = pk2(a[2], a[3]); w.z = pk2(b[0], b[1]); w.w = pk2(b[2], b[3]);
            *(u32x4*)(xb + c * 8) = w;
        }
    }
    if (bid == 0 && otid() < 128) ((int*)(ws + OFF_CNT))[otid()] = 0;
}

__device__ __forceinline__ void s5mat_unit(PRef p, int u, char* smem) {
    float* cre = (float*)smem;
    float* cim = cre + 16 * 65;
    float* bbr = cim + 16 * 65;
    float* bbi = bbr + 1024;
    float* pwr = bbi + 1024;
    float* pwi = pwr + 65 * 65;
    float* zr = pwi + 65 * 65;
    float* zi = zr + 64;
    float* Kd = zi + 64 + 2;
    const int tid = otid();
    const int jg = u >> 2, q = u & 3;
    if (tid < 64) {
        const int pp = tid;
        const float lre = fminf(p.s5_a_re[jg * 64 + pp], -1e-4f), lim = p.s5_a_im[jg * 64 + pp];
        const float dt = expf(p.s5_log_dt[jg]);
        const float xr = lre * dt, th = lim * dt;
        const float mag = expf(xr);
        const float ar = mag * cosf(th), ai = mag * sinf(th);
        const float inv = 1.f / (lre * lre + lim * lim);
        zr[pp] = ((ar - 1.f) * lre + ai * lim) * inv;
        zi[pp] = (ai * lre - (ar - 1.f) * lim) * inv;
        float wr_ = 1.f, wi_ = 0.f;
        for (int d = 0; d <= 64; ++d) {
            pwr[d * 65 + pp] = wr_; pwi[d * 65 + pp] = wi_;
            const float nr = wr_ * ar - wi_ * ai, ni = wr_ * ai + wi_ * ar;
            wr_ = nr; wi_ = ni;
        }
    } else {
        for (int e = tid - 64; e < 1024; e += NTHR - 64) {
            const int n = e >> 6, pp = e & 63;
            cre[n * 65 + pp] = p.s5_c_re[(size_t)jg * 1024 + e];
            cim[n * 65 + pp] = p.s5_c_im[(size_t)jg * 1024 + e];
        }
    }
    __syncthreads();
    for (int e = tid; e < 1024; e += NTHR) {
        const int pp = e >> 4;
        const float br = p.s5_b_re[(size_t)jg * 1024 + e], bi = p.s5_b_im[(size_t)jg * 1024 + e];
        bbr[e] = zr[pp] * br - zi[pp] * bi;
        bbi[e] = zr[pp] * bi + zi[pp] * br;
    }
    __syncthreads();
    if (tid < 256) {
        const int mh = tid & 1, nl = (tid >> 1) & 3, dp = tid >> 3, n = 4 * q + nl;
        float acc0[8], acc1[8];
#pragma unroll
        for (int i = 0; i < 8; ++i) { acc0[i] = 0.f; acc1[i] = 0.f; }
#pragma unroll 2
        for (int pp = 0; pp < 64; ++pp) {
            const float cr = cre[n * 65 + pp], ci = cim[n * 65 + pp];
            const float q0r = pwr[(2 * dp) * 65 + pp], q0i = pwi[(2 * dp) * 65 + pp], q1r = pwr[(2 * dp + 1) * 65 + pp], q1i = pwi[(2 * dp + 1) * 65 + pp];
            const float v0r = cr * q0r - ci * q0i, v0i = cr * q0i + ci * q0r, v1r = cr * q1r - ci * q1i, v1i = cr * q1i + ci * q1r;
            const f32x4 ba = *(const f32x4*)(bbr + pp * 16 + mh * 8), bb_ = *(const f32x4*)(bbr + pp * 16 + mh * 8 + 4);
            const f32x4 ia = *(const f32x4*)(bbi + pp * 16 + mh * 8), ib = *(const f32x4*)(bbi + pp * 16 + mh * 8 + 4);
#pragma unroll
            for (int i = 0; i < 8; ++i) {
                const float br = i < 4 ? ba[i & 3] : bb_[i & 3], bi = i < 4 ? ia[i & 3] : ib[i & 3];
                acc0[i] += v0r * br - v0i * bi;
                acc1[i] += v1r * br - v1i * bi;
            }
        }
        float* k0 = Kd + ((2 * dp) * 4 + nl) * 16 + mh * 8;
        *(f32x4*)(k0) = (f32x4){acc0[0], acc0[1], acc0[2], acc0[3]};
        *(f32x4*)(k0 + 4) = (f32x4){acc0[4], acc0[5], acc0[6], acc0[7]};
        *(f32x4*)(k0 + 64) = (f32x4){acc1[0], acc1[1], acc1[2], acc1[3]};
        *(f32x4*)(k0 + 68) = (f32x4){acc1[4], acc1[5], acc1[6], acc1[7]};
    }
    __syncthreads();
    bf16_t* TH = (bf16_t*)(p.ws + OFF_TH) + (size_t)jg * 1024 * UHW;
    for (int c = tid; c < 256 * 144; c += NTHR) {
        const int rl = c / 144, ch = c - rl * 144;
        const int tau = rl >> 2, nl = rl & 3, n = 4 * q + nl;
        float v[8];
        if (ch < 128) {
            const int s = ch >> 1, m0 = (ch & 1) * 8;
            if (s <= tau) {
                const f32x4 a = *(const f32x4*)(Kd + ((tau - s) * 4 + nl) * 16 + m0), b = *(const f32x4*)(Kd + ((tau - s) * 4 + nl) * 16 + m0 + 4);
#pragma unroll
                for (int i = 0; i < 4; ++i) { v[i] = a[i]; v[4 + i] = b[i]; }
            } else {
#pragma unroll
                for (int i = 0; i < 8; ++i) v[i] = 0.f;
            }
        } else {
            const int p0 = (ch - 128) * 4;
#pragma unroll
            for (int i = 0; i < 4; ++i) {
                const int pp = p0 + i;
                const float cr = cre[n * 65 + pp], ci = cim[n * 65 + pp], qr = pwr[(tau + 1) * 65 + pp], qi = pwi[(tau + 1) * 65 + pp];
                v[2 * i] = cr * qr - ci * qi;
                v[2 * i + 1] = -(cr * qi + ci * qr);
            }
        }
        u32x4 w; w.x = pk2(v[0], v[1]); w.y = pk2(v[2], v[3]); w.z = pk2(v[4], v[5]); w.w = pk2(v[6], v[7]);
        *(u32x4*)(TH + (size_t)(tau * 16 + n) * UHW + ch * 8) = w;
    }
    bf16_t* GM = (bf16_t*)(p.ws + OFF_GM) + (size_t)jg * 128 * 1024;
    for (int c = tid; c < 32 * 128; c += NTHR) {
        const int row = 32 * q + (c >> 7), ch = c & 127;
        const int pp = row >> 1, ri = row & 1;
        const int s = ch >> 1, m0 = (ch & 1) * 8;
        const float qr = pwr[(63 - s) * 65 + pp], qi = pwi[(63 - s) * 65 + pp];
        float v[8];
#pragma unroll
        for (int i = 0; i < 8; ++i) {
            const float br = bbr[pp * 16 + m0 + i], bi = bbi[pp * 16 + m0 + i];
            v[i] = ri == 0 ? (qr * br - qi * bi) : (qr * bi + qi * br);
        }
        u32x4 w; w.x = pk2(v[0], v[1]); w.y = pk2(v[2], v[3]); w.z = pk2(v[4], v[5]); w.w = pk2(v[6], v[7]);
        *(u32x4*)(GM + (size_t)row * 1024 + ch * 8) = w;
    }
    if (q == 0 && tid < 64) {
        float* A64 = (float*)(p.ws + OFF_A64) + (size_t)jg * 128;
        A64[tid * 2] = pwr[64 * 65 + tid];
        A64[tid * 2 + 1] = pwi[64 * 65 + tid];
    }
    __syncthreads();
}

__device__ __forceinline__ void epi_ev_in(PRef p, f32x4 (&acc)[4][2], int row0, int c0, int fr, int fq) {
    char* ws = p.ws;
    bf16_t* PE = (bf16_t*)(ws + OFF_PE); bf16_t* UH = (bf16_t*)(ws + OFF_UH); float* GLR = (float*)(ws + OFF_GLR);
    const int col = c0 + 8 * fq;
#pragma unroll
    for (int m = 0; m < 4; ++m) {
        const int t = row0 + m * 16 + fr;
        u32x4 w; w.x = pk2(acc[m][0][0], acc[m][0][1]); w.y = pk2(acc[m][0][2], acc[m][0][3]); w.z = pk2(acc[m][1][0], acc[m][1][1]); w.w = pk2(acc[m][1][2], acc[m][1][3]);
        if (c0 < 1024) {
            *(u32x4*)(PE + (size_t)t * PE_W + col) = w;
        } else if (c0 < 1536) {
            const int ch = col - 1024, g = ch >> 4, mm = ch & 15;
            *(u32x4*)(UH + ((size_t)(t >> 6) * 32 + g) * UHW + (t & 63) * 16 + mm) = w;
        } else if (col < 1552) {
            *(f32x4*)(GLR + (size_t)t * 16 + (col - 1536)) = acc[m][0];
            *(f32x4*)(GLR + (size_t)t * 16 + (col - 1536) + 4) = acc[m][1];
        }
    }
}
__device__ __forceinline__ void epi_vt(bf16_t* __restrict__ img_row0, f32x4 (&acc)[4][2], int rt0, int c0, int fr, int fq) {
#pragma unroll
    for (int m = 0; m < 4; ++m) {
        u32x4 w; w.x = pk2(acc[m][0][0], acc[m][0][1]); w.y = pk2(acc[m][0][2], acc[m][0][3]); w.z = pk2(acc[m][1][0], acc[m][1][1]); w.w = pk2(acc[m][1][2], acc[m][1][3]);
        *(u32x4*)(img_row0 + (size_t)(rt0 + m * 16 + fr) * L_ + c0 + 8 * fq) = w;
    }
}

__device__ __forceinline__ void gla_decay(PRef p, int j, int t0, int h, float* sB) {
    const float* GLR = (const float*)(p.ws + OFF_GLR);
    const float* w2 = p.gla_w_gate2 + (size_t)j * 16 * 256;
    const float* b2 = p.gla_b_gate2 + (size_t)j * 256;
    const int tid = otid(), d = tid & 63, w = tid >> 6;
    float wcol[16];
#pragma unroll
    for (int r = 0; r < 16; ++r) wcol[r] = w2[r * 256 + h * 64 + d];
    const float bias = b2[h * 64 + d];
#pragma unroll
    for (int k = 0; k < 8; ++k) {
        const int tau = w + 8 * k;
        const f32x4* gr = (const f32x4*)(GLR + (size_t)(t0 + tau) * 16);
        float a = bias;
#pragma unroll
        for (int q = 0; q < 4; ++q) { const f32x4 g4 = gr[q]; a += g4[0] * wcol[4 * q] + g4[1] * wcol[4 * q + 1] + g4[2] * wcol[4 * q + 2] + g4[3] * wcol[4 * q + 3]; }
        const float ls = fminf(a, 0.f) - __logf(1.f + __expf(-fabsf(a)));
        sB[tau * 65 + d] = ls * (1.f / 16.f);
    }
    __syncthreads();
    if (tid < 64) { float run = 0.f; for (int tau = 0; tau < 64; ++tau) { run += sB[tau * 65 + tid]; sB[tau * 65 + tid] = run; } }
    __syncthreads();
}

__device__ __forceinline__ void gla_a_item(PRef p, int j, int item, char* smem) {
    const int h = item & 3, c = (item >> 2) & 255, b = item >> 10;
    const int t0 = b * L_ + c * 64;
    float* sB = (float*)smem;
    bf16_t* AK = (bf16_t*)(smem + 16640);
    const bf16_t* PE = (const bf16_t*)(p.ws + OFF_PE);
    const bf16_t* VTE = (const bf16_t*)(p.ws + OFF_VTE);
    const int tid = otid(), lane = tid & 63, wave = tid >> 6, fr = lane & 15, fq = lane >> 4;
    const int dblk = wave >> 1, vb = (wave & 1) * 64;
    bf16_t kraw[8];
#pragma unroll
    for (int k = 0; k < 8; ++k) { const int e = tid + k * NTHR; kraw[k] = PE[(size_t)(t0 + (e >> 6)) * PE_W + 256 + h * 64 + (e & 63)]; }
    bf16x8 bfr[2][4];
#pragma unroll
    for (int ks = 0; ks < 2; ++ks)
#pragma unroll
        for (int n = 0; n < 4; ++n) bfr[ks][n] = *(const bf16x8*)(VTE + ((size_t)((b * 4 + h) * 128 + vb + n * 16 + fr)) * L_ + (c * 64 + ks * 32 + fq * 8));
    gla_decay(p, j, t0, h, sB);
    float* BD = (float*)(p.ws + OFF_BDEC) + (size_t)item * 4096;
#pragma unroll
    for (int k = 0; k < 8; ++k) {
        const int e = tid + k * NTHR, tau = e >> 6, d = e & 63;
        const float bb = sB[tau * 65 + d];
        BD[e] = bb;
        AK[d * 72 + tau] = f2bf(bf2f(kraw[k]) * __expf(sB[63 * 65 + d] - bb));
    }
    __syncthreads();
    f32x4 acc[4];
#pragma unroll
    for (int n = 0; n < 4; ++n) acc[n] = (f32x4){0.f, 0.f, 0.f, 0.f};
#pragma unroll
    for (int ks = 0; ks < 2; ++ks) {
        const bf16x8 af = *(const bf16x8*)(AK + (dblk * 16 + fr) * 72 + ks * 32 + fq * 8);
#pragma unroll
        for (int n = 0; n < 4; ++n) acc[n] = __builtin_amdgcn_mfma_f32_16x16x32_bf16(af, bfr[ks][n], acc[n], 0, 0, 0);
    }
    float* KV = (float*)(p.ws + OFF_KV) + ((size_t)((b * 256 + c) * 4 + h)) * 64 * 128;
#pragma unroll
    for (int n = 0; n < 4; ++n)
#pragma unroll
        for (int r = 0; r < 4; ++r) KV[(dblk * 16 + fq * 4 + r) * 128 + vb + n * 16 + fr] = acc[n][r];
    if (tid < 64) ((float*)(p.ws + OFF_DEC))[((size_t)((b * 256 + c) * 4 + h)) * 64 + tid] = __expf(sB[63 * 65 + tid]);
    __syncthreads();
}

__device__ __forceinline__ void scan_phase(PRef p, int j, int bid) {
    const int gid = bid * NTHR + otid();
    if (gid < 65536) {
        const int v = gid & 127, d = (gid >> 7) & 63, h = (gid >> 13) & 3, b = gid >> 15;
        const float* KV = (const float*)(p.ws + OFF_KV); float* SST = (float*)(p.ws + OFF_SST); const float* DEC = (const float*)(p.ws + OFF_DEC);
        float S = 0.f;
        for (int c0 = 0; c0 < 256; c0 += 8) {
            float kv[8], dc[8];
#pragma unroll
            for (int i = 0; i < 8; ++i) {
                const size_t blk = (size_t)((b * 256 + c0 + i) * 4 + h);
                kv[i] = KV[(blk * 64 + d) * 128 + v]; dc[i] = DEC[blk * 64 + d];
            }
#pragma unroll
            for (int i = 0; i < 8; ++i) {
                const size_t blk = (size_t)((b * 256 + c0 + i) * 4 + h);
                SST[(blk * 64 + d) * 128 + v] = S;
                S = dc[i] * S + kv[i];
            }
        }
    } else if (gid < 65536 + 4096) {
        const int e = gid - 65536, pp = e & 63, g = (e >> 6) & 31, b = e >> 11;
        const float* A64 = (const float*)(p.ws + OFF_A64) + (size_t)(j * 32 + g) * 128;
        const float ar = A64[pp * 2], ai = A64[pp * 2 + 1];
        const float* GB = (const float*)(p.ws + OFF_GBUF); bf16_t* UH = (bf16_t*)(p.ws + OFF_UH);
        float hr = 0.f, hi = 0.f;
        for (int c0 = 0; c0 < 256; c0 += 8) {
            float gr[8], gi[8];
#pragma unroll
            for (int i = 0; i < 8; ++i) { const size_t row = (size_t)(b * 256 + c0 + i) * 32 + g; gr[i] = GB[row * 128 + 2 * pp]; gi[i] = GB[row * 128 + 2 * pp + 1]; }
#pragma unroll
            for (int i = 0; i < 8; ++i) {
                const size_t row = (size_t)(b * 256 + c0 + i) * 32 + g;
                *(unsigned*)(UH + row * UHW + 1024 + 2 * pp) = pk2(hr, hi);
                const float nr = ar * hr - ai * hi + gr[i], ni = ar * hi + ai * hr + gi[i];
                hr = nr; hi = ni;
            }
        }
    }
}

__device__ __forceinline__ void gla_c_item(PRef p, int j, int item, char* smem) {
    const int h = item & 3, c = (item >> 2) & 255, b = item >> 10;
    const int t0 = b * L_ + c * 64;
    float* sB = (float*)smem;
    bf16_t* QT = (bf16_t*)(smem + 16640);
    bf16_t* KT = (bf16_t*)(smem + 16640 + 9216);
    bf16_t* ATT = (bf16_t*)(smem + 16640 + 18432);
    float* OS = (float*)(smem + 16640 + 27648);
    const bf16_t* PE = (const bf16_t*)(p.ws + OFF_PE);
    const bf16_t* VTE = (const bf16_t*)(p.ws + OFF_VTE);
    const int tid = otid(), lane = tid & 63, wave = tid >> 6, fr = lane & 15, fq = lane >> 4;
    const float* BD = (const float*)(p.ws + OFF_BDEC) + (size_t)item * 4096;
    const int iblk = wave >> 1;
    float bbv[8]; bf16_t qraw[8], kraw[8];
#pragma unroll
    for (int k = 0; k < 8; ++k) {
        const int e = tid + k * NTHR, tau = e >> 6, d = e & 63;
        bbv[k] = BD[e];
        qraw[k] = PE[(size_t)(t0 + tau) * PE_W + h * 64 + d];
        kraw[k] = PE[(size_t)(t0 + tau) * PE_W + 256 + h * 64 + d];
    }
    bf16x8 bvv[2][4]; float sst[2][4][8];
    {
        const int vb = (wave & 1) * 64;
        const float* SST = (const float*)(p.ws + OFF_SST) + ((size_t)((b * 256 + c) * 4 + h)) * 64 * 128;
#pragma unroll
        for (int ks = 0; ks < 2; ++ks)
#pragma unroll
            for (int n = 0; n < 4; ++n) {
                const int v = vb + n * 16 + fr;
                bvv[ks][n] = *(const bf16x8*)(VTE + ((size_t)((b * 4 + h) * 128 + v)) * L_ + (c * 64 + ks * 32 + fq * 8));
#pragma unroll
                for (int i = 0; i < 8; ++i) sst[ks][n][i] = SST[(ks * 32 + fq * 8 + i) * 128 + v];
            }
    }
    u32x4 rraw0, rraw1;
    { const bf16_t* rp = PE + (size_t)(t0 + (tid >> 3)) * PE_W + 512 + h * 128 + (tid & 7) * 16; rraw0 = *(const u32x4*)rp; rraw1 = *(const u32x4*)(rp + 8); }
#pragma unroll
    for (int k = 0; k < 8; ++k) {
        const int e = tid + k * NTHR, tau = e >> 6, d = e & 63;
        QT[tau * 72 + d] = f2bf(bf2f(qraw[k]) * 0.125f * __expf(bbv[k]));
        KT[tau * 72 + d] = f2bf(bf2f(kraw[k]) * __expf(-bbv[k]));
    }
    __syncthreads();
    {
        f32x4 acc[2];
        acc[0] = (f32x4){0.f, 0.f, 0.f, 0.f}; acc[1] = acc[0];
#pragma unroll
        for (int ks = 0; ks < 2; ++ks) {
            const bf16x8 af = *(const bf16x8*)(QT + (iblk * 16 + fr) * 72 + ks * 32 + fq * 8);
#pragma unroll
            for (int n = 0; n < 2; ++n) {
                const int jb = (wave & 1) * 2 + n;
                const bf16x8 bfr = *(const bf16x8*)(KT + (jb * 16 + fr) * 72 + ks * 32 + fq * 8);
                acc[n] = __builtin_amdgcn_mfma_f32_16x16x32_bf16(af, bfr, acc[n], 0, 0, 0);
            }
        }
#pragma unroll
        for (int n = 0; n < 2; ++n) {
            const int jj = ((wave & 1) * 2 + n) * 16 + fr;
#pragma unroll
            for (int r = 0; r < 4; ++r) { const int ii = iblk * 16 + fq * 4 + r; ATT[ii * 72 + jj] = f2bf(jj <= ii ? acc[n][r] : 0.f); }
        }
    }
    __syncthreads();
    {
        const int vb = (wave & 1) * 64;
        f32x4 acc[4];
#pragma unroll
        for (int n = 0; n < 4; ++n) acc[n] = (f32x4){0.f, 0.f, 0.f, 0.f};
#pragma unroll
        for (int ks = 0; ks < 2; ++ks) {
            const bf16x8 af = *(const bf16x8*)(ATT + (iblk * 16 + fr) * 72 + ks * 32 + fq * 8);
            const bf16x8 aq = *(const bf16x8*)(QT + (iblk * 16 + fr) * 72 + ks * 32 + fq * 8);
#pragma unroll
            for (int n = 0; n < 4; ++n) {
                acc[n] = __builtin_amdgcn_mfma_f32_16x16x32_bf16(af, bvv[ks][n], acc[n], 0, 0, 0);
                u32x4 bw; bw.x = pk2(sst[ks][n][0], sst[ks][n][1]); bw.y = pk2(sst[ks][n][2], sst[ks][n][3]); bw.z = pk2(sst[ks][n][4], sst[ks][n][5]); bw.w = pk2(sst[ks][n][6], sst[ks][n][7]);
                acc[n] = __builtin_amdgcn_mfma_f32_16x16x32_bf16(aq, __builtin_bit_cast(bf16x8, bw), acc[n], 0, 0, 0);
            }
        }
#pragma unroll
        for (int n = 0; n < 4; ++n)
#pragma unroll
            for (int r = 0; r < 4; ++r) OS[(iblk * 16 + fq * 4 + r) * 132 + vb + n * 16 + fr] = acc[n][r];
    }
    __syncthreads();
    {
        const int i = tid >> 3, seg = tid & 7;
        float o[16]; float ss = 0.f;
#pragma unroll
        for (int q = 0; q < 16; ++q) { o[q] = OS[i * 132 + seg * 16 + q]; ss += o[q] * o[q]; }
        ss += __shfl_xor(ss, 1, 64); ss += __shfl_xor(ss, 2, 64); ss += __shfl_xor(ss, 4, 64);
        const float rs = rsqrtf(ss * (1.f / 128.f) + LN_EPS);
        const float* ng = p.gla_norm_g + (size_t)j * 128;
        bf16_t* CC = (bf16_t*)(p.ws + OFF_CC);
        const size_t t = (size_t)(t0 + i);
        unsigned w[8];
#pragma unroll
        for (int q = 0; q < 16; q += 2) {
            const int v0 = seg * 16 + q;
            const unsigned rw_ = (q >> 1) < 4 ? ((q >> 1) == 0 ? rraw0.x : (q >> 1) == 1 ? rraw0.y : (q >> 1) == 2 ? rraw0.z : rraw0.w) : ((q >> 1) == 4 ? rraw1.x : (q >> 1) == 5 ? rraw1.y : (q >> 1) == 6 ? rraw1.z : rraw1.w);
            const float r0 = __uint_as_float(rw_ << 16), r1 = __uint_as_float(rw_ & 0xffff0000u);
            const float a0 = o[q] * rs * ng[v0] * (r0 * sigmoidf_(r0)), a1 = o[q + 1] * rs * ng[v0 + 1] * (r1 * sigmoidf_(r1));
            w[q >> 1] = pk2(a0, a1);
        }
        u32x4 w0, w1; w0.x = w[0]; w0.y = w[1]; w0.z = w[2]; w0.w = w[3]; w1.x = w[4]; w1.y = w[5]; w1.z = w[6]; w1.w = w[7];
        *(u32x4*)(CC + t * 1024 + h * 128 + seg * 16) = w0;
        *(u32x4*)(CC + t * 1024 + h * 128 + seg * 16 + 8) = w1;
    }
    __syncthreads();
}

__device__ __forceinline__ void s5_g_phase(PRef p, int j, char* smem, int bid, int nb) {
    const bf16_t* UH = (const bf16_t*)(p.ws + OFF_UH);
    float* GB = (float*)(p.ws + OFF_GBUF);
    for (int t = bid; t < 64; t += nb) {
        const int g = t >> 1, mi = t & 1;
        const bf16_t* Bt = (const bf16_t*)(p.ws + OFF_GM) + (size_t)(j * 32 + g) * 128 * 1024;
        gemm_tile<false>(UH + (size_t)g * UHW, (long)32 * UHW, 0, mi * 256, Bt, 1024, 0, 1024, smem,
            [&](f32x4 (&acc)[4][2], int rt0, int c0, int fr, int fq) {
#pragma unroll
                for (int m = 0; m < 4; ++m)
#pragma unroll
                    for (int n = 0; n < 2; ++n)
#pragma unroll
                        for (int r = 0; r < 4; ++r) {
                            const int row = mi * 256 + rt0 + m * 16 + fq * 4 + r;
                            GB[((size_t)row * 32 + g) * 128 + c0 + n * 16 + fr] = acc[m][n][r];
                        }
            });
    }
}
__device__ __forceinline__ void s5_y_phase(PRef p, int j, char* smem, int bid, int nb) {
    const bf16_t* UH = (const bf16_t*)(p.ws + OFF_UH);
    bf16_t* YA = (bf16_t*)(p.ws + OFF_YA);
    const float* dsk = p.s5_d + (size_t)j * 512;
    XcdSeq sq(32 * 2 * 4, bid, nb);
    for (int t = sq.q; t < sq.qend; t += sq.step) {
        const int g = t >> 3, mi = (t >> 2) & 1, ni = t & 3;
        const bf16_t* Bt = (const bf16_t*)(p.ws + OFF_TH) + (size_t)(j * 32 + g) * 1024 * UHW;
        gemm256_tile<false>(UH + (size_t)g * UHW, (long)32 * UHW, 0, mi * 256, Bt, UHW, ni * 256, UHW, smem,
            [&](f32x4 (&acc)[4][2], int rt0, int c0, int fr, int fq) {
                const int col = c0 + 8 * fq;
                const int tau = col >> 4, nn = col & 15, ch = g * 16 + nn;
                const f32x4 d0 = *(const f32x4*)(dsk + ch), d1 = *(const f32x4*)(dsk + ch + 4);
#pragma unroll
                for (int m = 0; m < 4; ++m) {
                    const int row = mi * 256 + rt0 + m * 16 + fr;
                    const u32x4 uw = *(const u32x4*)(UH + ((size_t)row * 32 + g) * UHW + col);
                    float y[8];
#pragma unroll
                    for (int q = 0; q < 4; ++q) {
                        const unsigned u2 = q == 0 ? uw.x : q == 1 ? uw.y : q == 2 ? uw.z : uw.w;
                        const float u0 = __uint_as_float(u2 << 16), u1 = __uint_as_float(u2 & 0xffff0000u);
                        const float a0 = q < 2 ? acc[m][0][2 * q] : acc[m][1][2 * q - 4], a1 = q < 2 ? acc[m][0][2 * q + 1] : acc[m][1][2 * q - 3];
                        const float dd0 = q < 2 ? d0[2 * q] : d1[2 * q - 4], dd1 = q < 2 ? d0[2 * q + 1] : d1[2 * q - 3];
                        y[2 * q] = gelu_tanh(a0 + dd0 * u0); y[2 * q + 1] = gelu_tanh(a1 + dd1 * u1);
                    }
                    u32x4 w; w.x = pk2(y[0], y[1]); w.y = pk2(y[2], y[3]); w.z = pk2(y[4], y[5]); w.w = pk2(y[6], y[7]);
                    *(u32x4*)(YA + ((size_t)row * 64 + tau) * 512 + ch) = w;
                }
            });
    }
}

template <bool SLOTS, bool NOEPI = false>
__device__ __forceinline__ void ln_phase(PRef p, const bf16_t* xin, const float* addb, const float* g, const float* bta, float* xout, bf16_t* xb, int bid, int nb) {
    const int lane = otid() & 63, wave = otid() >> 6;
    for (int t = bid * 8 + wave; t < T_; t += nb * 8) {
        f32x4 v[4];
        float s = 0.f;
#pragma unroll
        for (int i = 0; i < 4; ++i) {
            const int c = i * 256 + lane * 4;
            f32x4 a;
            { const u32x2 xw = *(const u32x2*)(xin + (size_t)t * 1024 + c); a = (f32x4){__uint_as_float(xw.x << 16), __uint_as_float(xw.x & 0xffff0000u), __uint_as_float(xw.y << 16), __uint_as_float(xw.y & 0xffff0000u)}; }
            f32x4 m;
            if (SLOTS) {
                const bf16_t* sl = (const bf16_t*)addb;
                m = (f32x4){0.f, 0.f, 0.f, 0.f};
#pragma unroll
                for (int k = 0; k < 4; ++k) {
                    const u32x2 w = *(const u32x2*)(sl + ((size_t)t * 4 + k) * 1024 + c);
                    m[0] += __uint_as_float(w.x << 16); m[1] += __uint_as_float(w.x & 0xffff0000u); m[2] += __uint_as_float(w.y << 16); m[3] += __uint_as_float(w.y & 0xffff0000u);
                }
            } else m = *(const f32x4*)(addb + (size_t)t * 1024 + c);
            v[i] = a * ALPHA + m;
            s += v[i][0] + v[i][1] + v[i][2] + v[i][3];
        }
        const float mu = wave_sum(s) * (1.f / 1024.f);
        float q = 0.f;
#pragma unroll
        for (int i = 0; i < 4; ++i) { v[i] -= mu; q += v[i][0] * v[i][0] + v[i][1] * v[i][1] + v[i][2] * v[i][2] + v[i][3] * v[i][3]; }
        const float rs = rsqrtf(wave_sum(q) * (1.f / 1024.f) + LN_EPS);
#pragma unroll
        for (int i = 0; i < 4; ++i) {
            const int c = i * 256 + lane * 4;
            const f32x4 gg = *(const f32x4*)(g + c), bb = *(const f32x4*)(bta + c);
            const f32x4 o = v[i] * rs * gg + bb;
            if (xout && (!NOEPI || rs == -1.f)) *(f32x4*)(xout + (size_t)t * 1024 + c) = o;
            if (xb && (!NOEPI || rs == -1.f)) { u32x2 w; w.x = pk2(o[0], o[1]); w.y = pk2(o[2], o[3]); *(u32x2*)(xb + (size_t)t * 1024 + c) = w; }
        }
    }
}

constexpr int RT_STRIDE = 36;
constexpr int RT_SCR_OFF = 1024 * RT_STRIDE * 4;
template <bool NOEPI = false>
__device__ __forceinline__ void ln1_router_phase(PRef p, int layer, char* smem, int bid, int nb) {
    float* wl = (float*)smem;
    const int tid = otid(), lane = tid & 63, wave = tid >> 6;
    float* lgs = (float*)(smem + RT_SCR_OFF + wave * 640);
    int* pick = (int*)(lgs + 32);
    float* pgate = (float*)(pick + 64);
    {
        const float* rw = p.router_w + (size_t)layer * 1024 * 32;
        for (int e = tid; e < 32768; e += NTHR) {
            const int k = e >> 5, ex = e & 31, rem = k & 255;
            wl[((k & ~255) + (rem & 3) * 64 + (rem >> 2)) * RT_STRIDE + ex] = rw[e];
        }
    }
    __syncthreads();
    const bf16_t* addb = (const bf16_t*)(p.ws + OFF_MIX);
    const float* g = p.ln1_g + (size_t)layer * 1024; const float* bta = p.ln1_b + (size_t)layer * 1024;
    bf16_t* xb = (bf16_t*)(p.ws + OFF_XB);
    const bf16_t* xin = xb;
    int* cnt = (int*)(p.ws + OFF_CNT) + layer * 32;
    int* LIST = (int*)(p.ws + OFF_LIST);
    float* GATE = (float*)(p.ws + OFF_GATE);
    const float rbias = p.router_b[(size_t)layer * 32 + (lane >> 1)];
    const int rstep = nb * 8;
    u32x2 xw[2][4], mw[2][4];
#define ROWLOAD(T, R) do { _Pragma("unroll") for (int i_ = 0; i_ < 4; ++i_) { const int c_ = i_ * 256 + lane * 4; xw[R][i_] = *(const u32x2*)(xin + (size_t)(T) * 1024 + c_); mw[R][i_] = *(const u32x2*)(addb + (size_t)(T) * 1024 + c_); } } while (0)
    {
        const int t0 = bid * 8 + wave;
        if (t0 < T_) ROWLOAD(t0, 0);
        if (t0 + rstep < T_) ROWLOAD(t0 + rstep, 1);
    }
    for (int tb = bid * 8 + wave; tb < T_; tb += rstep * 16) {
        int nrow = 0;
#pragma unroll 1
        for (int t = tb; t < T_ && nrow < 16; t += 2 * rstep) {
            const bool has1 = t + rstep < T_;
            f32x4 v[2][4];
            float s[2];
#pragma unroll
            for (int r = 0; r < 2; ++r) {
                s[r] = 0.f;
#pragma unroll
                for (int i = 0; i < 4; ++i) {
                    const f32x4 a = (f32x4){__uint_as_float(xw[r][i].x << 16), __uint_as_float(xw[r][i].x & 0xffff0000u), __uint_as_float(xw[r][i].y << 16), __uint_as_float(xw[r][i].y & 0xffff0000u)};
                    const f32x4 m = (f32x4){__uint_as_float(mw[r][i].x << 16), __uint_as_float(mw[r][i].x & 0xffff0000u), __uint_as_float(mw[r][i].y << 16), __uint_as_float(mw[r][i].y & 0xffff0000u)};
                    v[r][i] = a * ALPHA + m; s[r] += v[r][i][0] + v[r][i][1] + v[r][i][2] + v[r][i][3];
                }
            }
            if (t + 2 * rstep < T_) ROWLOAD(t + 2 * rstep, 0);
            if (t + 3 * rstep < T_) ROWLOAD(t + 3 * rstep, 1);
#pragma unroll
            for (int r = 0; r < 2; ++r) {
                const float mu = wave_sum(s[r]) * (1.f / 1024.f);
                float q = 0.f;
#pragma unroll
                for (int i = 0; i < 4; ++i) { v[r][i] -= mu; q += v[r][i][0] * v[r][i][0] + v[r][i][1] * v[r][i][1] + v[r][i][2] * v[r][i][2] + v[r][i][3] * v[r][i][3]; }
                const float rs = rsqrtf(wave_sum(q) * (1.f / 1024.f) + LN_EPS);
#pragma unroll
                for (int i = 0; i < 4; ++i) {
                    const int c = i * 256 + lane * 4;
                    const f32x4 gg = *(const f32x4*)(g + c), bb = *(const f32x4*)(bta + c);
                    v[r][i] = v[r][i] * rs * gg + bb;
                    if ((r == 0 || has1) && (!NOEPI || rs == -1.f)) {
                    u32x2 w; w.x = pk2(v[r][i][0], v[r][i][1]); w.y = pk2(v[r][i][2], v[r][i][3]); *(u32x2*)(xb + (size_t)(t + r * rstep) * 1024 + c) = w; }
                }
            }
            f32x4 acc[2][8];
#pragma unroll
            for (int e = 0; e < 8; ++e) { acc[0][e] = (f32x4){0.f, 0.f, 0.f, 0.f}; acc[1][e] = (f32x4){0.f, 0.f, 0.f, 0.f}; }
#pragma unroll
            for (int i = 0; i < 4; ++i)
#pragma unroll
                for (int j = 0; j < 4; ++j) {
                    const f32x4* wr_ = (const f32x4*)(wl + (i * 256 + j * 64 + lane) * RT_STRIDE);
                    const float xv0 = v[0][i][j], xv1 = v[1][i][j];
#pragma unroll
                    for (int e = 0; e < 8; ++e) { const f32x4 w = wr_[e]; acc[0][e] += w * xv0; acc[1][e] += w * xv1; }
                    if (j & 1) __builtin_amdgcn_sched_barrier(0);
                }
#pragma unroll
            for (int e = 0; e < 8; ++e)
#pragma unroll
                for (int k = 0; k < 4; ++k) { float a0 = acc[0][e][k], a1 = acc[1][e][k]; asm volatile("" : "+v"(a0), "+v"(a1)); acc[0][e][k] = a0; acc[1][e][k] = a1; }
#pragma unroll
            for (int r = 0; r < 2; ++r) {
                float k16[16], k8[8], k4[4], k2[2];
#pragma unroll
                for (int a = 0; a < 16; ++a) { auto rr = __builtin_amdgcn_permlane32_swap(__float_as_uint(acc[r][a >> 2][a & 3]), __float_as_uint(acc[r][(a + 16) >> 2][a & 3]), false, false); k16[a] = __uint_as_float(rr[0]) + __uint_as_float(rr[1]); }
#pragma unroll
                for (int a = 0; a < 8; ++a) { auto rr = __builtin_amdgcn_permlane16_swap(__float_as_uint(k16[a]), __float_as_uint(k16[a + 8]), false, false); k8[a] = __uint_as_float(rr[0]) + __uint_as_float(rr[1]); }
                { const bool hb = lane & 8;
#pragma unroll
                  for (int a = 0; a < 4; ++a) { const float mine = hb ? k8[a + 4] : k8[a], send = hb ? k8[a] : k8[a + 4]; k4[a] = mine + dppf<DPP_ROR8>(send); } }
                { const bool hb = lane & 4;
#pragma unroll
                  for (int a = 0; a < 2; ++a) { const float mine = hb ? k4[a + 2] : k4[a], send = hb ? k4[a] : k4[a + 2]; k2[a] = mine + dppf<DPP_HMIR>(send); } }
                float lg;
                { const bool hb = lane & 2; const float mine = hb ? k2[1] : k2[0], send = hb ? k2[0] : k2[1]; lg = mine + dppf<DPP_X2>(send); }
                lg += dppf<DPP_X1>(lg);
                lg += rbias;
                float cand = (lane & 1) ? -INFINITY : lg;
                float tv[4]; int te[4];
#pragma unroll
                for (int k = 0; k < 4; ++k) {
                    const float mxv = wave_max(cand);
                    const unsigned long long bal = __builtin_amdgcn_ballot_w64(cand == mxv);
                    const int first = __builtin_ctzll(bal);
                    tv[k] = mxv; te[k] = first >> 1;
                    if (lane == first) cand = -INFINITY;
                }
                if (lane == 0 && (r == 0 || has1)) {
                    const float e1 = __expf(tv[1] - tv[0]), e2 = __expf(tv[2] - tv[0]), e3 = __expf(tv[3] - tv[0]);
                    const float inv = 1.f / (1.f + e1 + e2 + e3);
                    const int nr = nrow + r;
                    pick[nr * 4 + 0] = te[0]; pick[nr * 4 + 1] = te[1]; pick[nr * 4 + 2] = te[2]; pick[nr * 4 + 3] = te[3];
                    pgate[nr * 4 + 0] = inv; pgate[nr * 4 + 1] = e1 * inv; pgate[nr * 4 + 2] = e2 * inv; pgate[nr * 4 + 3] = e3 * inv;
                }
            }
            nrow += has1 ? 2 : 1;
        }
        if ((lane >> 2) < nrow && (!NOEPI || pgate[lane] < -1.f)) {
            const int t = tb + (lane >> 2) * rstep, ex = pick[lane], pair = t * 4 + (lane & 3);
            const int pos = atomicAdd(&cnt[ex], 1);
            LIST[(size_t)ex * LISTCAP + pos] = pair;
            GATE[pair] = pgate[lane];
        }
    }
}

__device__ __forceinline__ void topk_phase(PRef p, int layer, int bid, int nb) {
    const float* LG = (const float*)(p.ws + OFF_LOGIT);
    int* cnt = (int*)(p.ws + OFF_CNT) + layer * 32;
    int* LIST = (int*)(p.ws + OFF_LIST);
    float* GATE = (float*)(p.ws + OFF_GATE);
    for (int t = bid * NTHR + otid(); t < T_; t += nb * NTHR) {
        float v0 = -INFINITY, v1 = -INFINITY, v2 = -INFINITY, v3 = -INFINITY; int i0 = 0, i1 = 0, i2 = 0, i3 = 0;
#pragma unroll
        for (int q = 0; q < 8; ++q) {
            const f32x4 l4 = *(const f32x4*)(LG + (size_t)t * 32 + q * 4);
#pragma unroll
            for (int r = 0; r < 4; ++r) {
                const float v = l4[r]; const int e = q * 4 + r;
                if (v > v0) { v3 = v2; i3 = i2; v2 = v1; i2 = i1; v1 = v0; i1 = i0; v0 = v; i0 = e; }
                else if (v > v1) { v3 = v2; i3 = i2; v2 = v1; i2 = i1; v1 = v; i1 = e; }
                else if (v > v2) { v3 = v2; i3 = i2; v2 = v; i2 = e; }
                else if (v > v3) { v3 = v; i3 = e; }
            }
        }
        const float e1 = __expf(v1 - v0), e2 = __expf(v2 - v0), e3 = __expf(v3 - v0);
        const float inv = 1.f / (1.f + e1 + e2 + e3);
        int pos;
        pos = atomicAdd(&cnt[i0], 1); LIST[(size_t)i0 * LISTCAP + pos] = t * 4 + 0; GATE[t * 4 + 0] = inv;
        pos = atomicAdd(&cnt[i1], 1); LIST[(size_t)i1 * LISTCAP + pos] = t * 4 + 1; GATE[t * 4 + 1] = e1 * inv;
        pos = atomicAdd(&cnt[i2], 1); LIST[(size_t)i2 * LISTCAP + pos] = t * 4 + 2; GATE[t * 4 + 2] = e2 * inv;
        pos = atomicAdd(&cnt[i3], 1); LIST[(size_t)i3 * LISTCAP + pos] = t * 4 + 3; GATE[t * 4 + 3] = e3 * inv;
    }
}

template <int WHICH, bool NOEPI = false>
__device__ __forceinline__ void moe_gemm_phase(PRef p, int layer, char* smem, int bid, int nb) {
    const int* cnt = (const int*)(p.ws + OFF_CNT) + layer * 32;
    const int* LIST = (const int*)(p.ws + OFF_LIST);
    constexpr int NTN = WHICH == 1 ? 8 : 4;
    int total = 0;
    for (int i = 0; i < 32; ++i) total += ((cnt[i] + 255) >> 8) * NTN;
    XcdSeq sq(total, bid, nb);
    int e = 0, base = 0, ce = cnt[0], mt = (ce + 255) >> 8;
    auto src = [&](int i, G8Desc& d) -> bool {
        const int t = sq.q + i * sq.step;
        if (t >= sq.qend) return false;
        while (e < 32 && t >= base + mt * NTN) { base += mt * NTN; ++e; if (e < 32) { ce = cnt[e]; mt = (ce + 255) >> 8; } }
        if (e >= 32) return false;
        int mi, ni;
        { const int loc = t - base, pf = mt >> 2, full = pf * 4 * NTN;
          if (loc < full) { const int pn = loc / (4 * NTN), r = loc - pn * 4 * NTN; ni = r >> 2; mi = pn * 4 + (r & 3); }
          else { const int ph = mt - pf * 4, r = loc - full; ni = r / ph; mi = pf * 4 + (r - ni * ph); } }
        d.m0 = 0; d.n0 = ni * 256; d.list = LIST + (size_t)e * LISTCAP + mi * 256; d.count = ce - mi * 256; d.u0 = e; d.ldb = 1024;
        if (WHICH == 1) { d.A = (const bf16_t*)(p.ws + OFF_XB); d.Bt = (const bf16_t*)(p.ws + OFF_WT_W1) + (size_t)(layer * 32 + e) * 2048 * 1024; }
        else { d.A = (const bf16_t*)(p.ws + OFF_ACT); d.Bt = (const bf16_t*)(p.ws + OFF_WT_W2) + (size_t)(layer * 32 + e) * 1024 * 1024; }
        return true; };
    if (WHICH == 1) {
        bf16_t* ACT = (bf16_t*)(p.ws + OFF_ACT);
        gemm256_stream<true, 2>(src, 1024, 1024, smem,
            [&](int, int e_, f32x4 (&acc)[4][2], int rt0, int c0, int fr, int fq, const int* sRow) {
                const float* b1 = p.moe_b1 + (size_t)(layer * 32 + e_) * 2048;
                const int gcol = (c0 >> 5) * 16 + 4 * fq;
                const f32x4 bg = *(const f32x4*)(b1 + gcol), bl = *(const f32x4*)(b1 + 1024 + gcol);
#pragma unroll
                for (int m = 0; m < 4; ++m) {
                    const int pair = NOEPI ? -1 : sRow[rt0 + m * 16 + fr];
                    if (pair >= 0) {
                        float a[4];
#pragma unroll
                        for (int r = 0; r < 4; ++r) {
                            const float gl = fminf(acc[m][0][r] + bg[r], 7.f);
                            const float li = fminf(fmaxf(acc[m][1][r] + bl[r], -7.f), 7.f);
                            a[r] = gl * sigmoidf_(1.702f * gl) * (li + 1.f);
                        }
                        u32x2 w; w.x = pk2(a[0], a[1]); w.y = pk2(a[2], a[3]);
                        *(u32x2*)(ACT + (size_t)pair * 1024 + gcol) = w;
                    }
                }
            });
    } else {
        const float* GATE = (const float*)(p.ws + OFF_GATE);
        bf16_t* SLOT = (bf16_t*)(p.ws + OFF_SLOT);
        gemm256_stream<true, 0>(src, 1024, 1024, smem,
            [&](int, int e_, f32x4 (&acc)[4][2], int rt0, int c0, int fr, int fq, const int* sRow) {
                const float* b2 = p.moe_b2 + (size_t)(layer * 32 + e_) * 1024;
                const int col = c0 + 8 * fq;
                const f32x4 b20 = *(const f32x4*)(b2 + col), b21 = *(const f32x4*)(b2 + col + 4);
#pragma unroll
                for (int m = 0; m < 4; ++m) {
                    const int pair = NOEPI ? -1 : sRow[rt0 + m * 16 + fr];
                    if (pair >= 0) {
                        const float gt = GATE[pair];
                        const f32x4 y0 = (acc[m][0] + b20) * gt, y1 = (acc[m][1] + b21) * gt;
                        u32x4 w; w.x = pk2(y0[0], y0[1]); w.y = pk2(y0[2], y0[3]); w.z = pk2(y1[0], y1[1]); w.w = pk2(y1[2], y1[3]);
                        *(u32x4*)(SLOT + (size_t)pair * 1024 + col) = w;
                    }
                }
            });
    }
}

__device__ __forceinline__ void epi_od_in(PRef p, f32x4 (&acc)[4][2], int row0, int c0, int fr, int fq) {
    char* ws = p.ws;
    bf16_t* PO = (bf16_t*)(ws + OFF_PO); float* WI = (float*)(ws + OFF_WI);
    const int col = c0 + 8 * fq;
#pragma unroll
    for (int m = 0; m < 4; ++m) {
        const int t = row0 + m * 16 + fr;
        if (c0 < OD_WI) {
            u32x4 w; w.x = pk2(acc[m][0][0], acc[m][0][1]); w.y = pk2(acc[m][0][2], acc[m][0][3]); w.z = pk2(acc[m][1][0], acc[m][1][1]); w.w = pk2(acc[m][1][2], acc[m][1][3]);
            *(u32x4*)(PO + (size_t)t * OD_P + col) = w;
        } else if (col == OD_WI) {
            *(f32x4*)(WI + (size_t)t * 4) = acc[m][0];
        }
    }
}

__device__ __forceinline__ void idx_scores(const char* __restrict__ ktile, int kbase, const bf16x8 (&qf)[4][4], const float (&wi)[4], int lane, float (&sc)[16]) {
    const int r = lane & 31, h2 = lane >> 5;
    const char* kp = ktile + (kbase + r) * 144 + h2 * 16;
    bf16x8 kf[4];
#pragma unroll
    for (int s = 0; s < 4; ++s) kf[s] = *(const bf16x8*)(kp + s * 32);
#pragma unroll
    for (int i = 0; i < 16; ++i) sc[i] = 0.f;
#pragma unroll
    for (int hd = 0; hd < 4; ++hd) {
        f32x16 a;
#pragma unroll
        for (int i = 0; i < 16; ++i) a[i] = 0.f;
#pragma unroll
        for (int s = 0; s < 4; ++s) a = __builtin_amdgcn_mfma_f32_32x32x16_bf16(kf[s], qf[hd][s], a, 0, 0, 0);
#pragma unroll
        for (int i = 0; i < 16; ++i) { const int ai = __float_as_int(a[i]); sc[i] += wi[hd] * __int_as_float(ai > 0 ? ai : 0); }
    }
}
__device__ __forceinline__ unsigned ord_key(float s) {
    const unsigned u = __float_as_uint(s);
    return u ^ ((unsigned)((int)u >> 31) | 0x80000000u);
}

constexpr int SEL_KT = 128 * 144;
__device__ __forceinline__ void dsa_select_item(PRef p, int b, int qb, char* smem) {
    unsigned* hist = (unsigned*)smem;
    unsigned* pref = (unsigned*)(smem + 66048);
    int* krem = (int*)(smem + 66048 + 256);
    unsigned* GW = (unsigned*)(smem + 66048 + 512);
    unsigned* EW = (unsigned*)(smem + 66048 + 512 + 2048);
    char* kbuf = smem + 71680;
    const bf16_t* PO = (const bf16_t*)(p.ws + OFF_PO);
    const float* WI = (const float*)(p.ws + OFF_WI);
    unsigned long long* BMT = (unsigned long long*)(p.ws + OFF_BM);
    const int tid = otid(), lane = tid & 63, wave = tid >> 6, kw = wave >> 1, qw = wave & 1, h2 = lane >> 5;
    const int p0 = qb * 64;
    const int ql = qw * 32 + (lane & 31);
    const int qpos = p0 + ql;
    const size_t tq = (size_t)b * L_ + qpos;
    const int nkt = (p0 + 64 + 127) >> 7;
    bf16x8 qf[4][4]; float wi[4];
#pragma unroll
    for (int hd = 0; hd < 4; ++hd) {
        wi[hd] = WI[tq * 4 + hd];
#pragma unroll
        for (int s = 0; s < 4; ++s) qf[hd][s] = *(const bf16x8*)(PO + tq * OD_P + OD_QI + hd * 64 + s * 16 + h2 * 8);
    }
    const int srow = tid >> 3, sch = tid & 7;
    const bf16_t* ksrc = PO + ((size_t)b * L_ + srow) * OD_P + OD_KI + sch * 8;
    char* kdst = kbuf + srow * 144 + sch * 16;
    for (int e = tid; e < 64 * 257; e += NTHR) hist[e] = 0u;
    if (tid < 64) { pref[tid] = 0u; krem[tid] = 256; }
    __syncthreads();
    const bool selall = qpos < 256;
    const int npass = (p0 + 63 >= 256) ? 3 : 0;
    for (int pass = 0; pass <= npass; ++pass) {
        const bool maskpass = pass == npass;
        const int sh = 24 - 8 * pass;
        const unsigned mypref = pref[ql];
        int ceq = 0;
        const int rsel = tid < 64 ? krem[tid] : 0;
        const int npair = (nkt + 1) >> 1;
        u32x4 r0, r1, r2 = (u32x4){0u, 0u, 0u, 0u}, r3 = r2;
        r0 = *(const u32x4*)ksrc; r1 = *(const u32x4*)(ksrc + (size_t)64 * OD_P);
        if (nkt > 1) { r2 = *(const u32x4*)(ksrc + (size_t)128 * OD_P); r3 = *(const u32x4*)(ksrc + (size_t)192 * OD_P); }
        *(u32x4*)kdst = r0; *(u32x4*)(kdst + 64 * 144) = r1; *(u32x4*)(kdst + SEL_KT) = r2; *(u32x4*)(kdst + SEL_KT + 64 * 144) = r3;
        __syncthreads();
        for (int kp = 0; kp < npair; ++kp) {
            const bool more = kp + 1 < npair;
            const bool more2 = 2 * kp + 3 < nkt;
            if (more) {
                r0 = *(const u32x4*)(ksrc + (size_t)(2 * kp + 2) * 128 * OD_P); r1 = *(const u32x4*)(ksrc + (size_t)((2 * kp + 2) * 128 + 64) * OD_P);
                if (more2) { r2 = *(const u32x4*)(ksrc + (size_t)(2 * kp + 3) * 128 * OD_P); r3 = *(const u32x4*)(ksrc + (size_t)((2 * kp + 3) * 128 + 64) * OD_P); }
            }
            const char* kcur = kbuf + (kp & 1) * 2 * SEL_KT;
            const bool two = 2 * kp + 1 < nkt;
            unsigned gwp[2] = {0u, 0u}, ewp[2] = {0u, 0u};
#pragma unroll
            for (int tt = 0; tt < 2; ++tt) {
                if (tt == 1 && !two) break;
                const int kt = 2 * kp + tt;
                float sc[16];
                idx_scores(kcur + tt * SEL_KT, kw * 32, qf, wi, lane, sc);
                const int keybase = kt * 128 + kw * 32;
                const bool diag = kt == nkt - 1;
                if (!maskpass) {
                    if (pass == 0 && !diag && p0 >= 256) {
#pragma unroll
                        for (int i = 0; i < 16; ++i) atomicAdd(&hist[ql * 257 + (ord_key(sc[i]) >> 24)], 1u);
                    } else {
#pragma unroll
                        for (int i = 0; i < 16; ++i) {
                            const int key = keybase + (i & 3) + 8 * (i >> 2) + 4 * h2;
                            const unsigned k32 = ord_key(sc[i]);
                            const bool match = pass == 0 ? true : ((k32 >> (sh + 8)) == mypref);
                            const bool valid = diag ? key <= qpos : true;
                            if (valid && !selall && match) atomicAdd(&hist[ql * 257 + ((k32 >> sh) & 255u)], 1u);
                        }
                    }
                } else {
                    unsigned gw = 0u, ew = 0u;
#pragma unroll
                    for (int i = 0; i < 16; ++i) {
                        const int ko = (i & 3) + 8 * (i >> 2) + 4 * h2;
                        const int key = keybase + ko;
                        const unsigned k24 = ord_key(sc[i]) >> 8;
                        const bool valid = diag ? key <= qpos : true;
                        const bool g = valid && (selall || k24 > mypref);
                        const bool e = valid && !selall && k24 == mypref;
                        gw |= (g ? 1u : 0u) << ko; ew |= (e ? 1u : 0u) << ko;
                    }
                    gwp[tt] = xor32_or(gw); ewp[tt] = xor32_or(ew);
                }
            }
            if (maskpass && h2 == 0) { GW[ql * 8 + kw] = gwp[0]; EW[ql * 8 + kw] = ewp[0]; GW[ql * 8 + 4 + kw] = gwp[1]; EW[ql * 8 + 4 + kw] = ewp[1]; }
            if (more) {
                char* nd = kdst + ((kp + 1) & 1) * 2 * SEL_KT;
                *(u32x4*)nd = r0; *(u32x4*)(nd + 64 * 144) = r1;
                if (more2) { *(u32x4*)(nd + SEL_KT) = r2; *(u32x4*)(nd + SEL_KT + 64 * 144) = r3; }
            }
            __syncthreads();
            if (maskpass) {
                if (tid < 64) {
#pragma unroll
                    for (int tt = 0; tt < 2; ++tt) {
                        if (tt == 1 && !two) break;
                        const int kt = 2 * kp + tt;
                        unsigned g4[4], e4[4];
#pragma unroll
                        for (int w = 0; w < 4; ++w) { g4[w] = GW[tid * 8 + tt * 4 + w]; e4[w] = EW[tid * 8 + tt * 4 + w]; }
                        int need = rsel - ceq; if (need < 0) need = 0;
#pragma unroll
                        for (int w = 0; w < 4; ++w) {
                            const int pc = __popc(e4[w]);
                            ceq += pc;
                            if (need >= pc) need -= pc;
                            else { unsigned m = e4[w], kept = 0u; for (int k = 0; k < need; ++k) { const unsigned low = m & (0u - m); kept |= low; m ^= low; } e4[w] = kept; need = 0; }
                            g4[w] |= e4[w];
                        }
                        BMT[((size_t)(b * 256 + 2 * kt)) * L_ + p0 + tid] = (unsigned long long)g4[0] | ((unsigned long long)g4[1] << 32);
                        BMT[((size_t)(b * 256 + 2 * kt + 1)) * L_ + p0 + tid] = (unsigned long long)g4[2] | ((unsigned long long)g4[3] << 32);
                    }
                }
                __syncthreads();
            }
        }
        if (!maskpass) {
            const int q = tid >> 3, part = tid & 7;
            unsigned c32[32]; unsigned tot = 0u;
#pragma unroll
            for (int i = 0; i < 32; ++i) { c32[i] = hist[q * 257 + part * 32 + i]; tot += c32[i]; }
            unsigned above = 0u;
#pragma unroll
            for (int d = 1; d < 8; ++d) { const unsigned o = __shfl(tot, (lane & ~7) + ((part + d) & 7), 64); if (part + d < 8) above += o; }
            const unsigned need = (unsigned)krem[q];
            __syncthreads();
            if ((p0 + q) >= 256 && above < need && above + tot >= need) {
                unsigned cum = above; int dg = 31;
#pragma unroll
                for (int i = 31; i >= 0; --i) { if (i == dg) { if (cum + c32[i] >= need) {   } else { cum += c32[i]; dg = i - 1; } } }
                pref[q] = (pref[q] << 8) | (unsigned)(part * 32 + dg);
                krem[q] = (int)(need - cum);
            }
            for (int e = tid; e < 64 * 257; e += NTHR) hist[e] = 0u;
            __syncthreads();
        }
    }
}

template <int MODE, int NQT>
__device__ __forceinline__ void attn_wave(PRef p, int b, int head, int qcol, int kcol, const bf16_t* __restrict__ VT, int voff,
                                          int i0, int sh  , int rho, int kt_lo, int kt_hi, int grp) {
    const bf16_t* PO = (const bf16_t*)(p.ws + OFF_PO);
    const unsigned* BM32 = (const unsigned*)(p.ws + OFF_BM);
    const int lane = otid() & 63, r = lane & 31, h2 = lane >> 5;
    const int pr = (r & 0x13) | ((r & 4) << 1) | ((r & 8) >> 1);
    const float SC = 0.125f * 1.4426950408889634f;
    bf16x8 qf[NQT][4]; size_t tq[NQT]; int qi[NQT];
#pragma unroll
    for (int qt = 0; qt < NQT; ++qt) {
        qi[qt] = i0 + qt * 32 + r;
        tq[qt] = (size_t)b * L_ + ((size_t)qi[qt] << sh) + rho;
#pragma unroll
        for (int s = 0; s < 4; ++s) qf[qt][s] = *(const bf16x8*)(PO + tq[qt] * OD_P + qcol + head * 64 + s * 16 + h2 * 8);
    }
    f32x16 oacc[NQT][2];
#pragma unroll
    for (int a = 0; a < NQT; ++a)
#pragma unroll
        for (int c = 0; c < 2; ++c)
#pragma unroll
            for (int i = 0; i < 16; ++i) oacc[a][c][i] = 0.f;
    float mrun[NQT], lrun[NQT];
#pragma unroll
    for (int a = 0; a < NQT; ++a) { mrun[a] = -64.f; lrun[a] = 0.f; }
    bf16x8 kf[4]; unsigned mw[NQT];
    auto load_k = [&](int kt, bf16x8 (&k_)[4], unsigned (&m_)[NQT]) {
        const size_t krow = (size_t)b * L_ + ((size_t)(kt * 32 + pr) << sh) + rho;
#pragma unroll
        for (int s = 0; s < 4; ++s) k_[s] = *(const bf16x8*)(PO + krow * OD_P + kcol + head * 64 + s * 16 + h2 * 8);
#pragma unroll
        for (int a = 0; a < NQT; ++a) m_[a] = MODE == 0 ? BM32[tq[a] * 512 + kt] : 0u;
    };
    load_k(kt_lo, kf, mw);
#pragma unroll 1
    for (int kt = kt_lo; kt <= kt_hi; ++kt) {
        bf16x8 vf[2][2];
#pragma unroll
        for (int db = 0; db < 2; ++db)
#pragma unroll
            for (int s2 = 0; s2 < 2; ++s2) vf[db][s2] = *(const bf16x8*)(VT + (size_t)(db * 32 + r) * L_ + voff + kt * 32 + s2 * 16 + h2 * 8);
        bf16x8 kn[4]; unsigned mn[NQT];
#pragma unroll
        for (int a = 0; a < NQT; ++a) mn[a] = 0u;
        if (kt < kt_hi) load_k(kt + 1, kn, mn);
#pragma unroll
        for (int qt = 0; qt < NQT; ++qt) {
            if (MODE == 1 && NQT == 2) { const int hq = (i0 >> 5) + qt; if (kt > hq || kt < hq - 4) continue; }
            f32x16 s;
#pragma unroll
            for (int i = 0; i < 16; ++i) s[i] = 0.f;
#pragma unroll
            for (int ks = 0; ks < 4; ++ks) s = __builtin_amdgcn_mfma_f32_32x32x16_bf16(kf[ks], qf[qt][ks], s, 0, 0, 0);
            unsigned wsel;
            if (MODE == 0) wsel = mw[qt];
            else {
                const int hi = qi[qt] - kt * 32, lo = hi - 128;
                const unsigned mh = hi < 0 ? 0u : (hi >= 31 ? 0xffffffffu : ((2u << hi) - 1u)), ml = lo <= 0 ? 0xffffffffu : (lo > 31 ? 0u : ~((1u << lo) - 1u));
                wsel = mh & ml;
            }
#pragma unroll
            for (int i = 0; i < 16; ++i) s[i] = __builtin_fmaf(s[i], SC, -mrun[qt]);
            float mx = fmaxf(fmaxf(s[0], s[1]), fmaxf(s[2], s[3]));
#pragma unroll
            for (int i = 4; i < 16; i += 2) mx = fmaxf(mx, fmaxf(s[i], s[i + 1]));
            mx = xor32_max(mx);
            if (__builtin_amdgcn_ballot_w64(mx > 0.f) != 0ull) {
                const float dlt = fmaxf(mx, 0.f);
                const float corr = __builtin_amdgcn_exp2f(-dlt);
                mrun[qt] += dlt; lrun[qt] *= corr;
#pragma unroll
                for (int db = 0; db < 2; ++db)
#pragma unroll
                    for (int i = 0; i < 16; ++i) oacc[qt][db][i] *= corr;
#pragma unroll
                for (int i = 0; i < 16; ++i) s[i] -= dlt;
            }
            float ps = 0.f;
            const int mws = (int)(wsel >> (8 * h2));
#define DA_P(i, KO) { const float e = __builtin_amdgcn_exp2f(s[i]); s[i] = __uint_as_float(__float_as_uint(e) & bitmask32<KO>(mws)); ps += s[i]; }
            DA_P(0, 0) DA_P(1, 1) DA_P(2, 2) DA_P(3, 3) DA_P(4, 4) DA_P(5, 5) DA_P(6, 6) DA_P(7, 7)
            DA_P(8, 16) DA_P(9, 17) DA_P(10, 18) DA_P(11, 19) DA_P(12, 20) DA_P(13, 21) DA_P(14, 22) DA_P(15, 23)
#undef DA_P
            lrun[qt] += ps;
#pragma unroll
            for (int s2 = 0; s2 < 2; ++s2) {
                u32x4 pw; pw.x = pk2(s[8 * s2], s[8 * s2 + 1]); pw.y = pk2(s[8 * s2 + 2], s[8 * s2 + 3]); pw.z = pk2(s[8 * s2 + 4], s[8 * s2 + 5]); pw.w = pk2(s[8 * s2 + 6], s[8 * s2 + 7]);
                const bf16x8 pf = __builtin_bit_cast(bf16x8, pw);
#pragma unroll
                for (int db = 0; db < 2; ++db) oacc[qt][db] = __builtin_amdgcn_mfma_f32_32x32x16_bf16(vf[db][s2], pf, oacc[qt][db], 0, 0, 0);
            }
        }
        if (kt < kt_hi) {
#pragma unroll
            for (int s = 0; s < 4; ++s) kf[s] = kn[s];
#pragma unroll
            for (int a = 0; a < NQT; ++a) mw[a] = mn[a];
        }
    }
#pragma unroll
    for (int qt = 0; qt < NQT; ++qt) {
        const float lt = xor32_sum(lrun[qt]);
        const float inv = 1.f / lt;
        if (MODE == 0) {
            bf16_t* CC = (bf16_t*)(p.ws + OFF_CC);
#pragma unroll
            for (int db = 0; db < 2; ++db)
#pragma unroll
                for (int i = 0; i < 16; ++i) {
                    const int d = db * 32 + (i & 3) + 8 * (i >> 2) + 4 * h2;
                    CC[tq[qt] * 1024 + head * 64 + d] = f2bf(oacc[qt][db][i] * inv);
                }
        } else {
            bf16_t* OD = (bf16_t*)(p.ws + OFF_OD) + (size_t)grp * T_ * 512;
#pragma unroll
            for (int db = 0; db < 2; ++db)
#pragma unroll
                for (int i = 0; i < 16; i += 4) {
                    const int d = db * 32 + 8 * (i >> 2) + 4 * h2;
                    { u32x2 w; w.x = pk2(oacc[qt][db][i] * inv, oacc[qt][db][i + 1] * inv); w.y = pk2(oacc[qt][db][i + 2] * inv, oacc[qt][db][i + 3] * inv); *(u32x2*)(OD + tq[qt] * 512 + head * 64 + d) = w; }
                }
            if (h2 == 0) ((float*)(p.ws + OFF_LSE))[((size_t)grp * T_ + tq[qt]) * 8 + head] = mrun[qt] + log2f(lt);
        }
    }
}

__device__ __forceinline__ void dil_combine_phase(PRef p, int bid, int nb) {
    const bf16_t* OD = (const bf16_t*)(p.ws + OFF_OD); const float* LSE = (const float*)(p.ws + OFF_LSE);
    bf16_t* CC = (bf16_t*)(p.ws + OFF_CC);
    const long n = (long)T_ * 128;
    for (long c = (long)bid * NTHR + otid(); c < n; c += (long)nb * NTHR) {
        const long t = c >> 7; const int ch = (int)(c & 127) * 4, hd = ch >> 6;
        const float l0 = LSE[((size_t)0 * T_ + t) * 8 + hd], l1 = LSE[((size_t)1 * T_ + t) * 8 + hd], l2 = LSE[((size_t)2 * T_ + t) * 8 + hd];
        const float mx = fmaxf(l0, fmaxf(l1, l2));
        const float w0 = __builtin_amdgcn_exp2f(l0 - mx), w1 = __builtin_amdgcn_exp2f(l1 - mx), w2 = __builtin_amdgcn_exp2f(l2 - mx);
        const float inv = __builtin_amdgcn_rcpf(w0 + w1 + w2);
        const u32x2 a = *(const u32x2*)(OD + ((size_t)0 * T_ + t) * 512 + ch), bq = *(const u32x2*)(OD + ((size_t)1 * T_ + t) * 512 + ch), cq = *(const u32x2*)(OD + ((size_t)2 * T_ + t) * 512 + ch);
        float o[4];
#define BFLO(x) __uint_as_float((x) << 16)
#define BFHI(x) __uint_as_float((x) & 0xffff0000u)
        o[0] = (BFLO(a.x) * w0 + BFLO(bq.x) * w1 + BFLO(cq.x) * w2) * inv; o[1] = (BFHI(a.x) * w0 + BFHI(bq.x) * w1 + BFHI(cq.x) * w2) * inv;
        o[2] = (BFLO(a.y) * w0 + BFLO(bq.y) * w1 + BFLO(cq.y) * w2) * inv; o[3] = (BFHI(a.y) * w0 + BFHI(bq.y) * w1 + BFHI(cq.y) * w2) * inv;
#undef BFLO
#undef BFHI
        u32x2 w; w.x = pk2(o[0], o[1]); w.y = pk2(o[2], o[3]);
        *(u32x2*)(CC + (size_t)t * 1024 + 512 + ch) = w;
    }
}

constexpr int DA_ROW = 144;
constexpr int DA_TILE = 64 * DA_ROW;
__device__ __forceinline__ void dsa_attn_item(PRef p, int b, int head, int qb, char* smem) {
    const bf16_t* PO = (const bf16_t*)(p.ws + OFF_PO);
    const bf16_t* VT = (const bf16_t*)(p.ws + OFF_VTC) + ((size_t)(b * 8 + head)) * 64 * L_;
    const int tid = otid(), lane = tid & 63, wave = tid >> 6, r = lane & 31, h2 = lane >> 5;
    const int pr = (r & 0x13) | ((r & 4) << 1) | ((r & 8) >> 1);
    const float SC = 0.125f * 1.4426950408889634f;
    const int i0 = qb * 256 + wave * 32, qi = i0 + r;
    const unsigned long long* BMT = (const unsigned long long*)(p.ws + OFF_BM) + (size_t)b * 256 * L_ + qi;
    const size_t tq = (size_t)b * L_ + qi;
    bf16x8 qf[4];
#pragma unroll
    for (int s = 0; s < 4; ++s) qf[s] = *(const bf16x8*)(PO + tq * OD_P + head * 64 + s * 16 + h2 * 8);
    f32x16 oacc[2];
#pragma unroll
    for (int c = 0; c < 2; ++c)
#pragma unroll
        for (int i = 0; i < 16; ++i) oacc[c][i] = 0.f;
    float mrun = -64.f, lrun = 0.f;
    const int nkt = qb * 4 + 4, my_last = (i0 + 31) >> 6;
    const int srow = tid >> 3, sch = tid & 7;
    const bf16_t* ksrc = PO + ((size_t)b * L_ + srow) * OD_P + 512 + head * 64 + sch * 8;
    const bf16_t* vsrc = VT + (size_t)srow * L_ + sch * 8;
    u32x4 rk = *(const u32x4*)ksrc, rv = *(const u32x4*)vsrc;
    __syncthreads();
    *(u32x4*)(smem + srow * DA_ROW + sch * 16) = rk;
    *(u32x4*)(smem + DA_TILE + srow * DA_ROW + sch * 16) = rv;
    __syncthreads();
    unsigned long long mwn = BMT[0];
#pragma unroll 1
    for (int kt = 0; kt < nkt; ++kt) {
        const bool more = kt + 1 < nkt;
        if (more) { rk = *(const u32x4*)(ksrc + (size_t)(kt + 1) * 64 * OD_P); rv = *(const u32x4*)(vsrc + (kt + 1) * 64); }
        const unsigned long long mw64 = mwn;
        if (kt < my_last) mwn = BMT[(size_t)(kt + 1) * L_];
        if (kt <= my_last) {
            const char* kb = smem + (kt & 1) * 2 * DA_TILE; const char* vb = kb + DA_TILE;
            f32x16 sa[2];
#pragma unroll
            for (int sub = 0; sub < 2; ++sub) {
                bf16x8 kf[4];
#pragma unroll
                for (int s = 0; s < 4; ++s) kf[s] = *(const bf16x8*)(kb + (sub * 32 + pr) * DA_ROW + (s * 16 + h2 * 8) * 2);
#pragma unroll
                for (int i = 0; i < 16; ++i) sa[sub][i] = 0.f;
#pragma unroll
                for (int ks = 0; ks < 4; ++ks) sa[sub] = __builtin_amdgcn_mfma_f32_32x32x16_bf16(kf[ks], qf[ks], sa[sub], 0, 0, 0);
            }
#pragma unroll
            for (int sub = 0; sub < 2; ++sub) {
                const unsigned mw = sub == 0 ? (unsigned)mw64 : (unsigned)(mw64 >> 32);
                f32x16& s = sa[sub];
                bf16x8 vf[2][2];
#pragma unroll
                for (int db = 0; db < 2; ++db)
#pragma unroll
                    for (int s2 = 0; s2 < 2; ++s2) vf[db][s2] = *(const bf16x8*)(vb + (db * 32 + r) * DA_ROW + (sub * 32 + s2 * 16 + h2 * 8) * 2);
#pragma unroll
                for (int i = 0; i < 16; ++i) s[i] = __builtin_fmaf(s[i], SC, -mrun);
                float mxa = __builtin_fmaxf(__builtin_fmaxf(s[0], s[1]), s[2]), mxb = __builtin_fmaxf(__builtin_fmaxf(s[3], s[4]), s[5]);
                mxa = __builtin_fmaxf(__builtin_fmaxf(mxa, s[6]), s[7]); mxb = __builtin_fmaxf(__builtin_fmaxf(mxb, s[8]), s[9]);
                mxa = __builtin_fmaxf(__builtin_fmaxf(mxa, s[10]), s[11]); mxb = __builtin_fmaxf(__builtin_fmaxf(mxb, s[12]), s[13]);
                mxa = __builtin_fmaxf(__builtin_fmaxf(mxa, s[14]), s[15]);
                float mx = xor32_max(__builtin_fmaxf(mxa, mxb));
                if (__builtin_amdgcn_ballot_w64(mx > 0.f) != 0ull) {
                    const float dlt = fmaxf(mx, 0.f);
                    const float corr = __builtin_amdgcn_exp2f(-dlt);
                    mrun += dlt; lrun *= corr;
#pragma unroll
                    for (int db = 0; db < 2; ++db)
#pragma unroll
                        for (int i = 0; i < 16; ++i) oacc[db][i] *= corr;
#pragma unroll
                    for (int i = 0; i < 16; ++i) s[i] -= dlt;
                }
                const int mws = (int)(mw >> (8 * h2));
#define DA_P(i, KO) { const float e = __builtin_amdgcn_exp2f(s[i]); s[i] = __uint_as_float(__float_as_uint(e) & bitmask32<KO>(mws)); }
                DA_P(0, 0) DA_P(1, 1) DA_P(2, 2) DA_P(3, 3) DA_P(4, 4) DA_P(5, 5) DA_P(6, 6) DA_P(7, 7)
                DA_P(8, 16) DA_P(9, 17) DA_P(10, 18) DA_P(11, 19) DA_P(12, 20) DA_P(13, 21) DA_P(14, 22) DA_P(15, 23)
#undef DA_P
                {
                    const f32x2 t0 = (f32x2){s[0], s[1]} + (f32x2){s[2], s[3]}, t1 = (f32x2){s[4], s[5]} + (f32x2){s[6], s[7]};
                    const f32x2 t2 = (f32x2){s[8], s[9]} + (f32x2){s[10], s[11]}, t3 = (f32x2){s[12], s[13]} + (f32x2){s[14], s[15]};
                    const f32x2 u = (t0 + t1) + (t2 + t3);
                    lrun += u[0] + u[1];
                }
#pragma unroll
                for (int s2 = 0; s2 < 2; ++s2) {
                    u32x4 pw; pw.x = pk2(s[8 * s2], s[8 * s2 + 1]); pw.y = pk2(s[8 * s2 + 2], s[8 * s2 + 3]); pw.z = pk2(s[8 * s2 + 4], s[8 * s2 + 5]); pw.w = pk2(s[8 * s2 + 6], s[8 * s2 + 7]);
                    const bf16x8 pf = __builtin_bit_cast(bf16x8, pw);
#pragma unroll
                    for (int db = 0; db < 2; ++db) oacc[db] = __builtin_amdgcn_mfma_f32_32x32x16_bf16(vf[db][s2], pf, oacc[db], 0, 0, 0);
                }
            }
        }
        if (more) {
            char* nbuf = smem + ((kt + 1) & 1) * 2 * DA_TILE;
            *(u32x4*)(nbuf + srow * DA_ROW + sch * 16) = rk;
            *(u32x4*)(nbuf + DA_TILE + srow * DA_ROW + sch * 16) = rv;
        }
        __syncthreads();
    }
    const float lt = xor32_sum(lrun);
    const float inv = 1.f / lt;
    bf16_t* CC = (bf16_t*)(p.ws + OFF_CC);
#pragma unroll
    for (int db = 0; db < 2; ++db)
#pragma unroll
        for (int i = 0; i < 16; i += 4) {
            const int d = db * 32 + 8 * (i >> 2) + 4 * h2;
            u32x2 w; w.x = pk2(oacc[db][i] * inv, oacc[db][i + 1] * inv); w.y = pk2(oacc[db][i + 2] * inv, oacc[db][i + 3] * inv);
            *(u32x2*)(CC + tq * 1024 + head * 64 + d) = w;
        }
}


template <bool ODD>
__device__ __forceinline__ void inproj_phase(PRef p, int j, char* smem, int bid, int nb) {
    char* ws = p.ws;
    constexpr int NTN = ODD ? OD_P / 256 : EV_P / 256, NMAIN = 128 * NTN, NVT = ODD ? 1024 : 256;
    const bf16_t* XB = (const bf16_t*)(ws + OFF_XB);
    const bf16_t* W = ODD ? (const bf16_t*)(ws + OFF_WT_ODIN) + (size_t)j * OD_N * 1024 : (const bf16_t*)(ws + OFF_WT_EVIN) + (size_t)j * EV_N * 1024;
    XcdSeq s(NMAIN + NVT, bid, nb);
    gemm256_stream<false, 0>(
        [&](int i, G8Desc& d) -> bool {
            const int Q = s.q + i * s.step; if (Q >= s.qend) return false;
            d.list = nullptr; d.count = 0;
            if (Q < NMAIN) {
                const int pnl = Q / (4 * NTN), r = Q - pnl * 4 * NTN;
                d.A = XB; d.Bt = W; d.m0 = (pnl * 4 + (r & 3)) * 256; d.n0 = (r >> 2) * 256; d.u0 = -1; d.ldb = 1024;
            } else {
                const int v = Q - NMAIN; d.m0 = 0; d.n0 = 0; d.u0 = v;
                if (ODD) {
                    const int combo = v & 7, src = combo >> 1, mt = combo & 1, bn = v >> 3, b = bn >> 6, lam0 = (bn & 63) * 256;
                    const int sh = src < 2 ? 0 : (src == 2 ? 2 : 4), rho = lam0 >> (14 - sh), i0 = lam0 & ((L_ >> sh) - 1);
                    d.A = W + (size_t)(OD_P + src * 512 + mt * 256) * 1024;
                    d.Bt = XB + ((size_t)b * L_ + ((size_t)i0 << sh) + rho) * 1024; d.ldb = 1024 << sh;
                } else {
                    const int mt = v & 1, bn = v >> 1;
                    d.A = W + (size_t)(EV_P + mt * 256) * 1024;
                    d.Bt = XB + (size_t)bn * 256 * 1024; d.ldb = 1024;
                }
            }
            return true; },
        1024, 1024, smem,
        [&](int m0, int u0, f32x4 (&acc)[4][2], int rt0, int c0, int fr, int fq, const int*) {
            if (u0 < 0) { if (ODD) epi_od_in(p, acc, m0 + rt0, c0, fr, fq); else epi_ev_in(p, acc, m0 + rt0, c0, fr, fq); }
            else if (ODD) {
                const int combo = u0 & 7, src = combo >> 1, mt = combo & 1, bn = u0 >> 3, b = bn >> 6, lam0 = (bn & 63) * 256;
                bf16_t* img = src == 0 ? (bf16_t*)(ws + OFF_VTC) + ((size_t)(b * 8) * 64 + mt * 256) * L_ + lam0
                                       : (bf16_t*)(ws + OFF_VTD) + ((size_t)((b * 3 + src - 1) * 8) * 64 + mt * 256) * L_ + lam0;
                epi_vt(img, acc, rt0, c0, fr, fq);
            } else {
                const int mt = u0 & 1, bn = u0 >> 1, b = bn >> 6, lam0 = (bn & 63) * 256;
                epi_vt((bf16_t*)(ws + OFF_VTE) + ((size_t)(b * 4) * 128 + mt * 256) * L_ + lam0, acc, rt0, c0, fr, fq);
            }
        });
}

enum { K_PRO = 0, K_E1, K_E2, K_E3, K_E4, K_E5, K_E6, K_LN1, K_O1, K_O2, K_O3, K_O4, K_M1, K_M2, K_M3, K_M4, K_LN2, K_COUNT };

template <int KIND, bool NOEPI = false>
__device__ __forceinline__ void run_phase(PRef p, int layer, char* smem, int bid, int nb) {
    char* ws = p.ws;
    const int j = layer >> 1;
    if (KIND == K_PRO) {
        conv_phase(p, smem, bid, nb);
        __syncthreads();
        for (int u = bid; u < 256; u += nb) s5mat_unit(p, u, smem);
    } else if (KIND == K_E1) {
        inproj_phase<false>(p, j, smem, bid, nb);
    } else if (KIND == K_E2) {
        for (int it = bid; it < 2048; it += nb) gla_a_item(p, j, it, smem);
        s5_g_phase(p, j, smem, bid, nb);
    } else if (KIND == K_E3) {
        scan_phase(p, j, bid);
    } else if (KIND == K_E4) {
        for (int it = bid; it < 2048; it += nb) gla_c_item(p, j, it, smem);
        s5_y_phase(p, j, smem, bid, nb);
    } else if (KIND == K_E5) {
        const bf16_t* YA = (const bf16_t*)(ws + OFF_YA); bf16_t* CC = (bf16_t*)(ws + OFF_CC); const float* bg = p.s5_b_glu + (size_t)j * 512;
        gemm256_phase(YA, 512, T_, (const bf16_t*)(ws + OFF_WT_GLU) + (size_t)j * 512 * 512, 512, 512, 512, smem, bid, nb,
                   [&](f32x4 (&acc)[4][2], int row0, int c0, int fr, int fq) {
                       const int col = c0 + 8 * fq;
                       const f32x4 g0 = *(const f32x4*)(bg + col), g1 = *(const f32x4*)(bg + col + 4);
#pragma unroll
                       for (int m = 0; m < 4; ++m) {
                           const size_t t = (size_t)(row0 + m * 16 + fr);
                           const u32x4 yw = *(const u32x4*)(YA + t * 512 + col);
                           float o[8];
#pragma unroll
                           for (int q = 0; q < 4; ++q) {
                               const unsigned y2 = q == 0 ? yw.x : q == 1 ? yw.y : q == 2 ? yw.z : yw.w;
                               const float y0 = __uint_as_float(y2 << 16), y1 = __uint_as_float(y2 & 0xffff0000u);
                               const float a0 = q < 2 ? acc[m][0][2 * q] + g0[2 * q] : acc[m][1][2 * q - 4] + g1[2 * q - 4];
                               const float a1 = q < 2 ? acc[m][0][2 * q + 1] + g0[2 * q + 1] : acc[m][1][2 * q - 3] + g1[2 * q - 3];
                               o[2 * q] = y0 * sigmoidf_(a0); o[2 * q + 1] = y1 * sigmoidf_(a1);
                           }
                           u32x4 w; w.x = pk2(o[0], o[1]); w.y = pk2(o[2], o[3]); w.z = pk2(o[4], o[5]); w.w = pk2(o[6], o[7]);
                           *(u32x4*)(CC + t * 1024 + 512 + col) = w;
                       }
                   });
    } else if (KIND == K_E6 || KIND == K_O4) {
        bf16_t* MIX = (bf16_t*)(ws + OFF_MIX);
        const bf16_t* W = (const bf16_t*)(ws + (KIND == K_E6 ? OFF_WT_EVOUT : OFF_WT_ODOUT)) + (size_t)j * 1024 * 1024;
        gemm256_phase((const bf16_t*)(ws + OFF_CC), 1024, T_, W, 1024, 1024, 1024, smem, bid, nb,
                   [&](f32x4 (&acc)[4][2], int row0, int c0, int fr, int fq) {
#pragma unroll
                       for (int m = 0; m < 4; ++m) {
                           u32x4 w; w.x = pk2(acc[m][0][0], acc[m][0][1]); w.y = pk2(acc[m][0][2], acc[m][0][3]); w.z = pk2(acc[m][1][0], acc[m][1][1]); w.w = pk2(acc[m][1][2], acc[m][1][3]);
                           *(u32x4*)(MIX + (size_t)(row0 + m * 16 + fr) * 1024 + c0 + 8 * fq) = w;
                       }
                   });
    } else if (KIND == K_LN1) {
        ln1_router_phase<NOEPI>(p, layer, smem, bid, nb);
    } else if (KIND == K_O1) {
        inproj_phase<true>(p, j, smem, bid, nb);
    } else if (KIND == K_O2) {
        if (!NOEPI) for (int k = bid; k < 256; k += nb) {
            dsa_select_item(p, k & 1, k >> 1, smem);
            __syncthreads();
            const int k2 = 511 - k;
            dsa_select_item(p, k2 & 1, k2 >> 1, smem);
            __syncthreads();
        }
        const int head = otid() >> 6;
        for (int it = bid; it < 1536; it += nb) {
            const int b = it / 768, rem = it - b * 768, g = rem >> 8, u = rem & 255;
            const int sh = g * 2, per = 256 >> sh, rho = u / per, qblk = u - rho * per;
            const bf16_t* VT = (const bf16_t*)(ws + OFF_VTD) + ((size_t)((b * 3 + g) * 8 + head)) * 64 * L_;
            {
                const int hi = 2 * qblk + 1, lo = 2 * qblk - 4;
                attn_wave<1, 2>(p, b, head, OD_DIL + g * 512, OD_DIL + 1536 + g * 512, VT, rho * (L_ >> sh), qblk * 64, sh, rho, lo < 0 ? 0 : lo, hi, g);
            }
        }
    } else if (KIND == K_O3) {
        for (int k = bid; k < 512; k += nb) {
            const int bh = k >> 5, q0 = k & 31;
#pragma unroll 1
            for (int half = 0; half < 2; ++half) dsa_attn_item(p, bh >> 3, bh & 7, half == 0 ? q0 : 63 - q0, smem);
        }
        dil_combine_phase(p, bid, nb);
    } else if (KIND == K_M1) {
        float* LG = (float*)(ws + OFF_LOGIT); const float* rb = p.router_b + (size_t)layer * 32;
        gemm_phase((const bf16_t*)(ws + OFF_XB), 1024, T_, (const bf16_t*)(ws + OFF_WT_RT) + (size_t)layer * 128 * 1024, 1024, 128, 1024, smem, bid, nb,
                   [&](f32x4 (&acc)[4][2], int row0, int c0, int fr, int fq) {
#pragma unroll
                       for (int n = 0; n < 2; ++n) {
                           const int col = c0 + n * 16 + fr;
                           if (col < 32) {
#pragma unroll
                               for (int m = 0; m < 4; ++m)
#pragma unroll
                                   for (int r = 0; r < 4; ++r) LG[(size_t)(row0 + m * 16 + fq * 4 + r) * 32 + col] = acc[m][n][r] + rb[col];
                           }
                       }
                   });
    } else if (KIND == K_M2) {
        topk_phase(p, layer, bid, nb);
    } else if (KIND == K_M3) {
        moe_gemm_phase<1, NOEPI>(p, layer, smem, bid, nb);
    } else if (KIND == K_M4) {
        moe_gemm_phase<2, NOEPI>(p, layer, smem, bid, nb);
    } else if (KIND == K_LN2) {
        float* xo = layer == 3 ? p.out : (float*)nullptr;
        ln_phase<true, NOEPI>(p, (const bf16_t*)(ws + OFF_XB), (const float*)(ws + OFF_SLOT), p.ln2_g + (size_t)layer * 1024, p.ln2_b + (size_t)layer * 1024, xo,
                       layer == 3 ? (bf16_t*)nullptr : (bf16_t*)(ws + OFF_XB), bid, nb);
    }
}

extern __shared__ __attribute__((aligned(16))) char dyn_smem[];

#if !MEGA
template <int KIND>
__global__ void __launch_bounds__(NTHR, 2) k_phase(Params p, int layer) { run_phase<KIND>(p, layer, dyn_smem, blockIdx.x, gridDim.x); }
#else
#ifndef DUPMASK
#define DUPMASK 0
#endif
typedef const __attribute__((address_space(4))) Params* KParams;
#define RUNP(K) do { KParams _q = kp0; asm volatile("" : "+s"(_q)); run_phase<K>(*_q, layer, smem, bid, nb); } while (0)
#ifndef DUPNOEPI
#define DUPNOEPI 0
#endif
#define RUNP2(K) do { KParams _q = kp0; asm volatile("" : "+s"(_q)); run_phase<K, (DUPNOEPI != 0)>(*_q, layer, smem, bid, nb); } while (0)
#define PHASE(K) do { RUNP(K); xcd_barrier(bar); if ((DUPMASK >> 30) & 1) xcd_barrier(bar); if ((DUPMASK >> K) & 1) { RUNP2(K); xcd_barrier(bar); } } while (0)
template <int LAYER>
__device__ __forceinline__ void mega_layer(KParams kp0, char* smem, int bid, int nb, const XcdBarrier& bar) {
    constexpr int layer = LAYER;
    if ((layer & 1) == 0) { PHASE(K_E1); PHASE(K_E2); PHASE(K_E3); PHASE(K_E4); PHASE(K_E5); PHASE(K_E6); }
    else { PHASE(K_O1); PHASE(K_O2); PHASE(K_O3); PHASE(K_O4); }
    PHASE(K_LN1); PHASE(K_M3); PHASE(K_M4);
    RUNP(K_LN2);
    if ((DUPMASK >> K_LN2) & 1) { xcd_barrier(bar); RUNP2(K_LN2); }
    if (layer < 3) xcd_barrier(bar);
}
__global__ void __launch_bounds__(NTHR, 2) k_mega(Params p) {
    char* smem = dyn_smem;
    const int bid = blockIdx.x, nb = gridDim.x;
    volatile LAS unsigned* st = (volatile LAS unsigned*)(dyn_smem + LDS_BYTES - 16);
    if (otid() == 0) { st[0] = 0u; st[1] = 0u; }
    __syncthreads();
    KParams kp0 = (KParams)__builtin_amdgcn_kernarg_segment_ptr();
    XcdBarrier bar = xcd_barrier_post((unsigned*)(kp0->ws + OFF_BAR), st);
    { const int layer = 0; PHASE(K_PRO); }
    mega_layer<0>(kp0, smem, bid, nb, bar);
    mega_layer<1>(kp0, smem, bid, nb, bar);
    mega_layer<2>(kp0, smem, bid, nb, bar);
    mega_layer<3>(kp0, smem, bid, nb, bar);
}
#endif

extern "C" void kernel_launch(void* const* d_in, const int* in_sizes, int n_in, void* d_out, int out_size, void* d_ws, size_t ws_size, hipStream_t stream) {
    Params p{};
    const float** f = (const float**)&p;
    for (int i = 0; i < 28; ++i) f[i] = (const float*)d_in[i];
    p.out = (float*)d_out; p.ws = (char*)d_ws;
    if (ws_size < WS_NEED) { fprintf(stderr, "workspace too small: %zu < %zu\n", ws_size, (size_t)WS_NEED); return; }
#if !MEGA
#define SETATTR(K) hipFuncSetAttribute((const void*)k_phase<K>, hipFuncAttributeMaxDynamicSharedMemorySize, LDS_BYTES)
#define LAUNCH(K, layer) k_phase<K><<<256, NTHR, LDS_BYTES, stream>>>(p, layer)
    static bool attr_done = false;
    if (!attr_done) {
        SETATTR(K_PRO); SETATTR(K_E1); SETATTR(K_E2); SETATTR(K_E3); SETATTR(K_E4); SETATTR(K_E5); SETATTR(K_E6); SETATTR(K_LN1); SETATTR(K_O1); SETATTR(K_O2); SETATTR(K_O3);
        SETATTR(K_O4); SETATTR(K_M1); SETATTR(K_M2); SETATTR(K_M3); SETATTR(K_M4); SETATTR(K_LN2);
        attr_done = true;
    }
    LAUNCH(K_PRO, 0);
    for (int layer = 0; layer < 4; ++layer) {
        if ((layer & 1) == 0) { LAUNCH(K_E1, layer); LAUNCH(K_E2, layer); LAUNCH(K_E3, layer); LAUNCH(K_E4, layer); LAUNCH(K_E5, layer); LAUNCH(K_E6, layer); }
        else { LAUNCH(K_O1, layer); LAUNCH(K_O2, layer); LAUNCH(K_O3, layer); LAUNCH(K_O4, layer); }
        LAUNCH(K_LN1, layer); LAUNCH(K_M3, layer); LAUNCH(K_M4, layer); LAUNCH(K_LN2, layer);
    }
#else
    static int grid = 0;
    if (!grid) {
        hipFuncSetAttribute((const void*)k_mega, hipFuncAttributeMaxDynamicSharedMemorySize, LDS_BYTES);
        int dev = 0, cus = 0, per_cu = 0;
        hipGetDevice(&dev);
        hipDeviceGetAttribute(&cus, hipDeviceAttributeMultiprocessorCount, dev);
        hipOccupancyMaxActiveBlocksPerMultiprocessor(&per_cu, (const void*)k_mega, NTHR, LDS_BYTES);
        grid = cus * (per_cu < 1 ? per_cu : 1);
        if (grid <= 0) grid = 0;
    }
    if (!grid) { fprintf(stderr, "occupancy query says 0 blocks per CU\n"); return; }
    hipMemsetAsync((char*)d_ws + OFF_BAR, 0, XCD_BAR_WORDS * sizeof(unsigned), stream);
    k_mega<<<grid, NTHR, LDS_BYTES, stream>>>(p);
#endif
}
```
